# Optimizing an MI355X kernel written in HIP

```python
import math
import jax, jax.numpy as jnp
from jax import lax
import numpy as np

D_MODEL = 2048
BATCH = 8
SEQ = 2048
DEPTH = 1

MIX_WIDTH = D_MODEL
ATT_HEAD_DIM = 128
ATT_WIDTH = MIX_WIDTH // 2
ATT_HEADS = ATT_WIDTH // ATT_HEAD_DIM
MOBA_BLOCK = 256
MOBA_TOPK = 3
Q_BLOCK = 128
REL_BUCKETS = 32
REL_MAX_DIST = 128
SSM_WIDTH = MIX_WIDTH - ATT_WIDTH
SSM_HEAD_DIM = 64
SSM_HEADS = SSM_WIDTH // SSM_HEAD_DIM
SSM_GROUPS = 2
SSM_STATE = 128
SSM_CONV = 4
SSD_CHUNK = 128
CONV_CH = SSM_WIDTH + 2 * SSM_GROUPS * SSM_STATE
IN_PROJ = 3 * ATT_WIDTH + SSM_WIDTH + CONV_CH + SSM_HEADS
PEER_HEADS = 8
PEER_NKEYS = 128
PEER_EXPERTS = PEER_NKEYS * PEER_NKEYS
PEER_QDIM = 256
PEER_TOPK = 16
PEER_TOKEN_BLOCK = 128
EPS = 1e-6

kernel_name = 'hybrid_moba_ssd_peer_layer'


def rms_norm(x, gain):
    xf = x.astype(jnp.float32)
    y = xf * lax.rsqrt(jnp.mean(xf * xf, axis=-1, keepdims=True) + EPS)
    return (y * gain.astype(jnp.float32)).astype(x.dtype)


def t5_bucket(rel):
    n = jnp.maximum(rel, 0)
    max_exact = REL_BUCKETS // 2
    nf = jnp.maximum(n, 1).astype(jnp.float32)
    large = max_exact + (jnp.log(nf / max_exact) / math.log(REL_MAX_DIST / max_exact)
                         * (REL_BUCKETS - max_exact)).astype(jnp.int32)
    large = jnp.minimum(large, REL_BUCKETS - 1)
    return jnp.where(n < max_exact, n, large)


def moba_attention(q, k, v, rel_bias):
    bsz, s, h, hd = q.shape
    nb = -(-s // MOBA_BLOCK)
    pad = nb * MOBA_BLOCK - s
    kp = jnp.pad(k, ((0, 0), (0, pad), (0, 0), (0, 0)))
    vp = jnp.pad(v, ((0, 0), (0, pad), (0, 0), (0, 0)))
    kb = kp.reshape(bsz, nb, MOBA_BLOCK, h, hd).transpose(0, 3, 1, 2, 4)
    vb = vp.reshape(bsz, nb, MOBA_BLOCK, h, hd).transpose(0, 3, 1, 2, 4)
    k_mean = jnp.mean(kb.astype(jnp.float32), axis=3)
    gate = jnp.einsum('bshd,bhnd->bhsn', q.astype(jnp.float32), k_mean)
    n_past = jnp.arange(s) // MOBA_BLOCK
    past_mask = jnp.arange(nb)[None, :] < n_past[:, None]
    gate = jnp.where(past_mask[None, None], gate, -jnp.inf)
    k_sel = min(MOBA_TOPK, nb)
    _, sel = lax.top_k(gate, k_sel)
    qh = q.transpose(0, 2, 1, 3)
    nq = s // Q_BLOCK
    scale = hd ** -0.5
    bias_t = rel_bias.astype(jnp.float32).T
    offs = jnp.arange(MOBA_BLOCK)
    qoffs = jnp.arange(Q_BLOCK)

    def one_block(i):
        b = i // nq
        c = i % nq
        q_c = lax.dynamic_slice(qh, (b, 0, c * Q_BLOCK, 0), (1, h, Q_BLOCK, hd))[0]
        sel_c = lax.dynamic_slice(sel, (b, 0, c * Q_BLOCK, 0), (1, h, Q_BLOCK, k_sel))[0]
        kb_b = kb[b]
        vb_b = vb[b]
        kg = jax.vmap(lambda kh, ih: kh[ih])(kb_b, sel_c)
        vg = jax.vmap(lambda vh, ih: vh[ih])(vb_b, sel_c)
        own = (c * Q_BLOCK) // MOBA_BLOCK
        k_own = kb_b[:, own]
        v_own = vb_b[:, own]
        t = c * Q_BLOCK + qoffs
        rel_past = t[None, :, None, None] - (sel_c[..., None] * MOBA_BLOCK + offs)
        bias_past = jax.vmap(lambda row, bk: row[bk])(bias_t, t5_bucket(rel_past))
        rel_own = t[:, None] - (own * MOBA_BLOCK + offs)[None, :]
        bias_own = bias_t[:, t5_bucket(rel_own)]
        s_past = jnp.einsum('hqd,hqjkd->hqjk', q_c, kg).astype(jnp.float32) * scale + bias_past
        valid = (jnp.arange(k_sel) < own)[None, None, :, None]
        s_past = jnp.where(valid, s_past, -jnp.inf)
        s_own = jnp.einsum('hqd,hkd->hqk', q_c, k_own).astype(jnp.float32) * scale + bias_own
        s_own = jnp.where((rel_own >= 0)[None], s_own, -jnp.inf)
        scores = jnp.concatenate([s_past.reshape(h, Q_BLOCK, k_sel * MOBA_BLOCK), s_own], axis=-1)
        p = jax.nn.softmax(scores, axis=-1)
        p_past = p[..., :k_sel * MOBA_BLOCK].reshape(h, Q_BLOCK, k_sel, MOBA_BLOCK).astype(v.dtype)
        p_own = p[..., k_sel * MOBA_BLOCK:].astype(v.dtype)
        return (jnp.einsum('hqjk,hqjkd->hqd', p_past, vg)
                + jnp.einsum('hqk,hkd->hqd', p_own, v_own))

    o = lax.map(one_block, jnp.arange(bsz * nq))
    o = o.reshape(bsz, nq, h, Q_BLOCK, hd).transpose(0, 1, 3, 2, 4)
    return o.reshape(bsz, s, h * hd)


def causal_dwconv(u, w, b):
    ch = u.shape[-1]
    y = lax.conv_general_dilated(u, w[:, None, :].astype(u.dtype), window_strides=(1,),
                                 padding=[(SSM_CONV - 1, 0)],
                                 dimension_numbers=('NWC', 'WIO', 'NWC'),
                                 feature_group_count=ch)
    return y + b.astype(u.dtype)


def ssd(xs, dt, a, bm, cm, d_skip):
    bsz, s, h, p = xs.shape
    g, n = bm.shape[2], bm.shape[3]
    r = h // g
    L = SSD_CHUNK
    nc = s // L
    x = xs.reshape(bsz, nc, L, g, r, p)
    dtc = dt.reshape(bsz, nc, L, g, r)
    bc = bm.reshape(bsz, nc, L, g, n)
    cc = cm.reshape(bsz, nc, L, g, n)
    cs = jnp.cumsum(dtc * a.reshape(g, r), axis=2)
    seg = cs[:, :, :, None] - cs[:, :, None, :]
    causal = jnp.tril(jnp.ones((L, L), dtype=bool))[None, None, :, :, None, None]
    decay = jnp.exp(jnp.where(causal, seg, -jnp.inf))
    xdt = x * dtc[..., None]
    cb = jnp.einsum('bclgn,bcsgn->bclsg', cc, bc)
    y_diag = jnp.einsum('bclsg,bclsgr,bcsgrp->bclgrp', cb, decay, xdt)
    decay_states = jnp.exp(cs[:, :, -1:] - cs)
    states = jnp.einsum('bclgn,bclgr,bclgrp->bcgrpn', bc, decay_states, xdt)
    chunk_decay = jnp.exp(cs[:, :, -1])

    def step(hs, inp):
        st, dec = inp
        return hs * dec[..., None, None] + st, hs

    h0 = jnp.zeros((bsz, g, r, p, n), jnp.float32)
    _, prev = lax.scan(step, h0, (states.transpose(1, 0, 2, 3, 4, 5), chunk_decay.transpose(1, 0, 2, 3)))
    prev = prev.transpose(1, 0, 2, 3, 4, 5)
    y_off = jnp.einsum('bclgn,bcgrpn,bclgr->bclgrp', cc, prev, jnp.exp(cs))
    y = y_diag + y_off + x * d_skip.reshape(g, r)[..., None]
    return y.reshape(bsz, s, h * p)


def peer_ffn(hx, wq, subkeys, u_tab, v_tab):
    bsz, s, d = hx.shape
    t = bsz * s
    hf = hx.reshape(t, d)
    q = (hf @ wq).reshape(t, PEER_HEADS, 2, PEER_QDIM // 2)
    sc = jnp.einsum('thcd,hckd->thck', q, subkeys).astype(jnp.float32)
    v1, i1 = lax.top_k(sc[:, :, 0], PEER_TOPK)
    v2, i2 = lax.top_k(sc[:, :, 1], PEER_TOPK)
    cand = (v1[..., :, None] + v2[..., None, :]).reshape(t, PEER_HEADS, PEER_TOPK * PEER_TOPK)
    cidx = (i1[..., :, None] * PEER_NKEYS + i2[..., None, :]).reshape(t, PEER_HEADS, PEER_TOPK * PEER_TOPK)
    top_s, pos = lax.top_k(cand, PEER_TOPK)
    eidx = jnp.take_along_axis(cidx, pos, axis=-1)
    gates = jax.nn.softmax(top_s, axis=-1)
    hk = PEER_HEADS * PEER_TOPK
    eidx = eidx.reshape(t, hk)
    gates = gates.reshape(t, hk).astype(hx.dtype)
    nblk = t // PEER_TOKEN_BLOCK

    def blk(args):
        xb, ib, gb = args
        pre = jnp.einsum('td,tkd->tk', xb, u_tab[ib])
        act = jax.nn.gelu(pre, approximate=False) * gb
        return jnp.einsum('tk,tkd->td', act, v_tab[ib])

    out = lax.map(blk, (hf.reshape(nblk, PEER_TOKEN_BLOCK, d),
                        eidx.reshape(nblk, PEER_TOKEN_BLOCK, hk),
                        gates.reshape(nblk, PEER_TOKEN_BLOCK, hk)))
    return out.reshape(bsz, s, d)


def setup_inputs(seed: int = 0) -> dict:
    key = jax.random.key(seed)
    ks = jax.random.split(key, 18)
    f32 = jnp.float32

    def nrm(k, shape, sc):
        return jax.random.normal(k, shape, f32) * sc

    x = nrm(ks[0], (BATCH, SEQ, D_MODEL), 1.0)
    attn_norm = 1.0 + nrm(ks[1], (DEPTH, D_MODEL), 0.02)
    w_in = nrm(ks[2], (DEPTH, D_MODEL, IN_PROJ), D_MODEL ** -0.5)
    conv_w = nrm(ks[3], (DEPTH, SSM_CONV, CONV_CH), SSM_CONV ** -0.5)
    conv_b = nrm(ks[4], (DEPTH, CONV_CH), 0.01)
    dt0 = jnp.exp(jax.random.uniform(ks[5], (DEPTH, SSM_HEADS), f32)
                  * (math.log(0.1) - math.log(1e-3)) + math.log(1e-3))
    dt_bias = dt0 + jnp.log(-jnp.expm1(-dt0))
    a_log = jnp.log(jax.random.uniform(ks[6], (DEPTH, SSM_HEADS), f32, 1.0, 16.0))
    d_skip = 1.0 + nrm(ks[7], (DEPTH, SSM_HEADS), 0.1)
    rel_bias = nrm(ks[8], (REL_BUCKETS, ATT_HEADS), 0.5)
    attn_out_norm = 1.0 + nrm(ks[9], (DEPTH, ATT_WIDTH), 0.02)
    ssm_out_norm = 1.0 + nrm(ks[10], (DEPTH, SSM_WIDTH), 0.02)
    w_out = nrm(ks[11], (DEPTH, MIX_WIDTH, D_MODEL), MIX_WIDTH ** -0.5)
    ffn_norm = 1.0 + nrm(ks[12], (DEPTH, D_MODEL), 0.02)
    peer_wq = nrm(ks[13], (DEPTH, D_MODEL, PEER_HEADS * PEER_QDIM), D_MODEL ** -0.5)
    peer_subkeys = nrm(ks[14], (DEPTH, PEER_HEADS, 2, PEER_NKEYS, PEER_QDIM // 2), (PEER_QDIM // 2) ** -0.5)
    peer_u = nrm(ks[15], (DEPTH, PEER_EXPERTS, D_MODEL), D_MODEL ** -0.5)
    peer_v = nrm(ks[16], (DEPTH, PEER_EXPERTS, D_MODEL), PEER_HEADS ** -0.5)
    final_norm = 1.0 + nrm(ks[17], (D_MODEL,), 0.02)
    return {'x': x, 'attn_norm': attn_norm, 'w_in': w_in, 'conv_w': conv_w, 'conv_b': conv_b,
            'dt_bias': dt_bias, 'a_log': a_log, 'd_skip': d_skip, 'rel_bias': rel_bias,
            'attn_out_norm': attn_out_norm, 'ssm_out_norm': ssm_out_norm, 'w_out': w_out,
            'ffn_norm': ffn_norm, 'peer_wq': peer_wq, 'peer_subkeys': peer_subkeys,
            'peer_u': peer_u, 'peer_v': peer_v, 'final_norm': final_norm}


def reference(x, attn_norm, w_in, conv_w, conv_b, dt_bias, a_log, d_skip, rel_bias,
              attn_out_norm, ssm_out_norm, w_out, ffn_norm, peer_wq, peer_subkeys,
              peer_u, peer_v, final_norm):
    bsz, s, _ = x.shape
    f32 = jnp.float32
    splits = [ATT_WIDTH, 2 * ATT_WIDTH, 3 * ATT_WIDTH, 3 * ATT_WIDTH + SSM_WIDTH,
              3 * ATT_WIDTH + SSM_WIDTH + CONV_CH]
    for l in range(DEPTH):
        hn = rms_norm(x, attn_norm[l])
        proj = hn @ w_in[l]
        q, k, v, z, xbc, dt_raw = jnp.split(proj, splits, axis=-1)
        att = moba_attention(q.reshape(bsz, s, ATT_HEADS, ATT_HEAD_DIM),
                             k.reshape(bsz, s, ATT_HEADS, ATT_HEAD_DIM),
                             v.reshape(bsz, s, ATT_HEADS, ATT_HEAD_DIM), rel_bias)
        att = rms_norm(att, attn_out_norm[l])
        xbc = jax.nn.silu(causal_dwconv(xbc, conv_w[l], conv_b[l]))
        xs, b_ssm, c_ssm = jnp.split(xbc, [SSM_WIDTH, SSM_WIDTH + SSM_GROUPS * SSM_STATE], axis=-1)
        dt = jax.nn.softplus(dt_raw.astype(f32) + dt_bias[l].astype(f32))
        a = -jnp.exp(a_log[l].astype(f32))
        y = ssd(xs.reshape(bsz, s, SSM_HEADS, SSM_HEAD_DIM).astype(f32), dt, a,
                b_ssm.reshape(bsz, s, SSM_GROUPS, SSM_STATE).astype(f32),
                c_ssm.reshape(bsz, s, SSM_GROUPS, SSM_STATE).astype(f32),
                d_skip[l].astype(f32))
        y = y * jax.nn.silu(z.astype(f32))
        y = rms_norm(y.reshape(bsz, s, SSM_GROUPS, SSM_WIDTH // SSM_GROUPS),
                     ssm_out_norm[l].reshape(SSM_GROUPS, SSM_WIDTH // SSM_GROUPS))
        y = y.reshape(bsz, s, SSM_WIDTH).astype(x.dtype)
        x = x + jnp.concatenate([att, y], axis=-1) @ w_out[l]
        x = x + peer_ffn(rms_norm(x, ffn_norm[l]), peer_wq[l], peer_subkeys[l], peer_u[l], peer_v[l])
    return rms_norm(x, final_norm)
```

```cpp
#include <hip/hip_runtime.h>
#include <cstdio>
#include <cstdint>
namespace pg8 {
#define PG8_LAS __attribute__((address_space(3)))
typedef unsigned short bf16_t;
typedef short bf16x8 __attribute__((ext_vector_type(8)));
typedef float f32x4 __attribute__((ext_vector_type(4)));
typedef unsigned u32x4 __attribute__((ext_vector_type(4)));
constexpr int BM = 256, BK = 64, HALF = 128, HTB = HALF * BK * 2  , STAGE_BYTES = 8 * HTB, NXCD = 8, WGM = 8;

__host__ __device__ __forceinline__ int lds_byte(int r, int c) { const int st = (r >> 4) * 2 + (c >> 5), rr = r & 15, cc = c & 31, ob = rr * 64 + cc * 2; return st * 1024 + (ob ^ (((ob >> 9) & 1) << 5)); }
__host__ __device__ __forceinline__ void stage_rc(int b, int& R, int& C) { const int st = b / 1024, sb = b % 1024, swz = sb ^ (((sb >> 9) & 1) << 5); R = (st >> 1) * 16 + swz / 64; C = (st & 1) * 32 + (swz % 64) / 2; }
__host__ __device__ __forceinline__ int perm32(int rho) { const int n = rho >> 4, i = rho & 15; return 8 * (i >> 2) + 4 * n + (i & 3); }

struct Unit { int pm, pn; };
struct Gemm { const bf16_t* A; const bf16_t* Bt; int M, N, K; };

struct StaticOrder {
    int nM, nN, nwg, G, c;
    __host__ __device__ void init(int M, int N, int G_, int c_) { nM = M / BM; nN = N / BM; nwg = nM * nN; G = G_; c = c_; }
    __host__ __device__ bool next(int i, Unit& u) const {
        const long L = (long)i * G + c; if (L >= nwg) return false;
        int wgid = (int)L; { const int q = nwg / NXCD, r = nwg % NXCD, xcd = wgid % NXCD, off = wgid / NXCD; wgid = (xcd < r ? xcd * (q + 1) : r * (q + 1) + (xcd - r) * q) + off; }
        const int nig = WGM * nN, gid = wgid / nig, fm = gid * WGM, gsz = (nM - fm) < WGM ? (nM - fm) : WGM;
        u.pm = fm + ((wgid % nig) % gsz); u.pn = (wgid % nig) / gsz; return true;
    }
    __device__ __forceinline__ void a_ready(const Unit&) const {}
    __device__ __forceinline__ void done(const Unit&) const {}
};

__device__ __forceinline__ unsigned cvt_pk_bf16(float lo, float hi) { unsigned r; asm volatile("v_cvt_pk_bf16_f32 %0, %1, %2" : "=v"(r) : "v"(lo), "v"(hi)); return r; }
typedef float f32x2 __attribute__((ext_vector_type(2)));
__device__ __forceinline__ f32x2 gelu_pk(f32x2 v) {
    const f32x2 av = __builtin_elementwise_abs(v), d = av * 0.2316418882f + 1.0f;
    f32x2 t; t.x = __builtin_amdgcn_rcpf(d.x); t.y = __builtin_amdgcn_rcpf(d.y);
    f32x2 q = t * 0.5307027145f + (-0.7265760135f); q = q * t + 0.7107068705f; q = q * t + (-0.142248368f); q = q * t + 0.127414796f; q = q * t;
    const f32x2 s = (v * v) * (-0.72134752044f);
    f32x2 e; e.x = __builtin_amdgcn_exp2f(s.x); e.y = __builtin_amdgcn_exp2f(s.y);
    const f32x2 m = v * (q * e), r = v - m;
    f32x2 o; o.x = v.x < 0.f ? m.x : r.x; o.y = v.y < 0.f ? m.y : r.y; return o;
}

template <int ACT  > struct EpiBf16 {
    static constexpr bool PERM = true, AFTER_DRAIN = false; static_assert(ACT == 0 || ACT == 1, "EpiBf16: ACT is 0 (none) or 1 (gelu_pk)");
    bf16_t* O; int ldc; const float* bias; int split_cols; size_t split_stride; float scale0;
    __device__ __forceinline__ void operator()(const f32x4 (&acc)[2][2][4][2], const Unit& u, int wr, int wc, int fr, int fq) const {
        const int row0 = u.pm * BM + wr * 64 + fr; int colt = u.pn * BM; bf16_t* base = O;
        float sc = 1.f; if (split_cols) { const int t = colt / split_cols; base += (size_t)t * split_stride; colt -= t * split_cols; if (t == 0) sc = scale0; }
        const int col0 = colt + wc * 32 + 8 * fq, bcol0 = u.pn * BM + wc * 32 + 8 * fq;
        f32x4 bv[2][2];
#pragma unroll
        for (int bj = 0; bj < 2; ++bj)
#pragma unroll
            for (int n = 0; n < 2; ++n) bv[bj][n] = bias ? *(const f32x4*)(bias + bcol0 + bj * HALF + 4 * n) : (f32x4){0.f, 0.f, 0.f, 0.f};
#pragma unroll
        for (int ai = 0; ai < 2; ++ai)
#pragma unroll
            for (int m = 0; m < 4; ++m) { bf16_t* rowp = base + (size_t)(row0 + ai * HALF + m * 16) * ldc + col0;
#pragma unroll
                for (int bj = 0; bj < 2; ++bj) { f32x4 v0 = acc[ai][bj][m][0] + bv[bj][0], v1 = acc[ai][bj][m][1] + bv[bj][1];
                    if (ACT == 1) { f32x2 a = gelu_pk((f32x2){v0[0], v0[1]}), b = gelu_pk((f32x2){v0[2], v0[3]}), c = gelu_pk((f32x2){v1[0], v1[1]}), d = gelu_pk((f32x2){v1[2], v1[3]});
                        v0 = (f32x4){a.x, a.y, b.x, b.y}; v1 = (f32x4){c.x, c.y, d.x, d.y}; }
                    v0 = v0 * sc; v1 = v1 * sc; u32x4 w; w.x = cvt_pk_bf16(v0[0], v0[1]); w.y = cvt_pk_bf16(v0[2], v0[3]); w.z = cvt_pk_bf16(v1[0], v1[1]); w.w = cvt_pk_bf16(v1[2], v1[3]);
                    *(u32x4*)(rowp + bj * HALF) = w; } }
    }
};
template <class Epi, class Sched, bool ALIGN_EPI = false, bool SP2 = false>
__device__ __forceinline__ void gemm_phase(PG8_LAS unsigned char* lds, const Gemm g, const Sched& S, const Epi& E) {
    const int tid = threadIdx.x, wid = __builtin_amdgcn_readfirstlane(tid >> 6), lane = tid & 63, wr = wid >> 2, wc = wid & 3, fr = lane & 15, fq = lane >> 4;
    const int K = g.K, nt = K / BK;
    unsigned voffA[2], voffB[2];
#pragma unroll
    for (int i = 0; i < 2; ++i) { int R, C; stage_rc(tid * 16 + i * 8192, R, C); const int Rb = Epi::PERM ? ((R & ~31) + perm32(R & 31)) : R;
        voffA[i] = (unsigned)(R * K + C) * 2u; voffB[i] = (unsigned)(Rb * K + C) * 2u; }
    const size_t kstep = (size_t)(BK * 2);
    const size_t hstep = (size_t)HALF * K * 2;
    const size_t tstep = 2 * hstep;
    const unsigned ldsw = (unsigned)wid * 1024u;
    const int aoff = lds_byte(wr * 64 + fr, fq * 8), boff = lds_byte(wc * 32 + fr, fq * 8);
#define PG8_SA(b, h) (((b) * 2 + (h)) * HTB)
#define PG8_SB(b, h) ((4 + (b) * 2 + (h)) * HTB)
#define PG8_STAGE(bufoff, gbase, voff) do { _Pragma("unroll") for (int _i = 0; _i < 2; ++_i) \
        __builtin_amdgcn_global_load_lds((const unsigned*)((const char*)(gbase) + (voff)[_i]), (PG8_LAS unsigned*)(lds + (bufoff) + ldsw + _i * 8192), 16, 0, 0); } while (0)
#define PG8_LDA(dst, b, h) do { _Pragma("unroll") for (int m = 0; m < 4; ++m) _Pragma("unroll") for (int k = 0; k < 2; ++k) dst[m][k] = *(const PG8_LAS bf16x8*)(lds + PG8_SA(b, h) + aoff + m * 2048 + k * 1024); } while (0)
#define PG8_LDB(dst, b, h) do { _Pragma("unroll") for (int n = 0; n < 2; ++n) _Pragma("unroll") for (int k = 0; k < 2; ++k) dst[n][k] = *(const PG8_LAS bf16x8*)(lds + PG8_SB(b, h) + boff + n * 2048 + k * 1024); } while (0)
#define PG8_MMA(ai, bj, At, Bt) do { __builtin_amdgcn_s_setprio(1); _Pragma("unroll") for (int m = 0; m < 4; ++m) _Pragma("unroll") for (int n = 0; n < 2; ++n) _Pragma("unroll") for (int k = 0; k < 2; ++k) \
        acc[ai][bj][m][n] = __builtin_amdgcn_mfma_f32_16x16x32_bf16(Bt[n][k], At[m][k], acc[ai][bj][m][n], 0, 0, 0); __builtin_amdgcn_s_setprio(0); } while (0)
#define PG8_WAIT_V(n) asm volatile("s_waitcnt vmcnt(" #n ")" ::: "memory")
#define PG8_WAIT_L(n) asm volatile("s_waitcnt lgkmcnt(" #n ")" ::: "memory")
#define PG8_BAR __builtin_amdgcn_s_barrier()
#define PG8_SCHED __builtin_amdgcn_sched_barrier(0)
    Unit cur, nxt; int ui = 0;
    if (!S.next(0, cur)) return;
    f32x4 acc[2][2][4][2];
#pragma unroll
    for (int a = 0; a < 2; ++a)
#pragma unroll
        for (int b = 0; b < 2; ++b)
#pragma unroll
            for (int m = 0; m < 4; ++m)
#pragma unroll
                for (int n = 0; n < 2; ++n) acc[a][b][m][n] = (f32x4){0.f, 0.f, 0.f, 0.f};
    bf16x8 At[4][2], B0[2][2], B1[2][2];
    const char* cA = (const char*)g.A + (size_t)cur.pm * tstep; const char* cB = (const char*)g.Bt + (size_t)cur.pn * tstep;
    S.a_ready(cur);
    if constexpr (SP2) {
        PG8_STAGE(PG8_SB(0, 0), cB, voffB); PG8_STAGE(PG8_SB(0, 1), cB + hstep, voffB); PG8_STAGE(PG8_SA(0, 0), cA, voffA); PG8_STAGE(PG8_SA(0, 1), cA + hstep, voffA);
        if (wr == 1) PG8_BAR;
        PG8_WAIT_V(2); PG8_BAR;
        PG8_STAGE(PG8_SB(1, 0), cB + kstep, voffB); PG8_STAGE(PG8_SA(1, 0), cA + kstep, voffA); PG8_STAGE(PG8_SB(1, 1), cB + hstep + kstep, voffB);
        PG8_WAIT_V(6); PG8_BAR;
    } else {
        PG8_STAGE(PG8_SB(0, 0), cB, voffB); PG8_STAGE(PG8_SA(0, 0), cA, voffA); PG8_STAGE(PG8_SB(0, 1), cB + hstep, voffB); PG8_STAGE(PG8_SA(0, 1), cA + hstep, voffA);
        if (wr == 1) PG8_BAR;
        PG8_WAIT_V(4); PG8_BAR;
        PG8_STAGE(PG8_SB(1, 0), cB + kstep, voffB); PG8_STAGE(PG8_SA(1, 0), cA + kstep, voffA); PG8_STAGE(PG8_SB(1, 1), cB + hstep + kstep, voffB);
        PG8_WAIT_V(6); PG8_BAR;
    }
    for (;;) {
        const bool has_next = S.next(ui + 1, nxt);
        const char* nA = has_next ? (const char*)g.A + (size_t)nxt.pm * tstep : cA; const char* nB = has_next ? (const char*)g.Bt + (size_t)nxt.pn * tstep : cB;
        for (int t = 0; t < nt; t += 2) {
            const bool last = (t == nt - 2);
            const char* a1 = cA + (size_t)(t + 1) * kstep;
            const char* a2 = last ? nA : cA + (size_t)(t + 2) * kstep; const char* b2 = last ? nB : cB + (size_t)(t + 2) * kstep;
            const char* a3 = a2 + kstep; const char* b3 = b2 + kstep;
            if (last && has_next) S.a_ready(nxt);
            if constexpr (SP2) {
            PG8_LDB(B0, 0, 0); PG8_LDB(B1, 0, 1); PG8_SCHED; PG8_LDA(At, 0, 0); PG8_STAGE(PG8_SA(1, 1), a1 + hstep, voffA);
            PG8_WAIT_V(8); PG8_WAIT_L(0); PG8_BAR; PG8_MMA(0, 0, At, B0); PG8_MMA(0, 1, At, B1); PG8_BAR; PG8_SCHED;
            PG8_LDA(At, 0, 1); PG8_STAGE(PG8_SB(0, 0), b2, voffB); PG8_STAGE(PG8_SB(0, 1), b2 + hstep, voffB); PG8_STAGE(PG8_SA(0, 0), a2, voffA);
            PG8_WAIT_V(8); PG8_WAIT_L(0); PG8_BAR; PG8_MMA(1, 0, At, B0); PG8_MMA(1, 1, At, B1); PG8_BAR; PG8_SCHED;
            PG8_LDB(B0, 1, 0); PG8_LDB(B1, 1, 1); PG8_SCHED; PG8_LDA(At, 1, 0); PG8_STAGE(PG8_SA(0, 1), a2 + hstep, voffA);
            PG8_WAIT_V(8); PG8_WAIT_L(0); PG8_BAR; PG8_MMA(0, 0, At, B0); PG8_MMA(0, 1, At, B1); PG8_BAR; PG8_SCHED;
            PG8_LDA(At, 1, 1); PG8_STAGE(PG8_SB(1, 0), b3, voffB); PG8_STAGE(PG8_SB(1, 1), b3 + hstep, voffB); PG8_STAGE(PG8_SA(1, 0), a3, voffA);
            PG8_WAIT_V(8); PG8_WAIT_L(0); PG8_BAR; PG8_MMA(1, 0, At, B0); PG8_MMA(1, 1, At, B1); PG8_BAR; PG8_SCHED;
            } else {
            PG8_LDB(B0, 0, 0); PG8_SCHED; PG8_LDA(At, 0, 0); PG8_STAGE(PG8_SA(1, 1), a1 + hstep, voffA);
            PG8_WAIT_L(8); PG8_BAR; PG8_WAIT_L(0); PG8_MMA(0, 0, At, B0); PG8_BAR; PG8_SCHED;
            PG8_LDB(B1, 0, 1); PG8_STAGE(PG8_SB(0, 0), b2, voffB);
            PG8_BAR; PG8_WAIT_L(0); PG8_MMA(0, 1, At, B1); PG8_BAR;
            PG8_LDA(At, 0, 1); PG8_STAGE(PG8_SA(0, 0), a2, voffA);
            PG8_BAR; PG8_WAIT_L(0); PG8_MMA(1, 0, At, B0); PG8_BAR; PG8_SCHED;
            PG8_STAGE(PG8_SB(0, 1), b2 + hstep, voffB);
            PG8_WAIT_V(6); PG8_BAR; PG8_MMA(1, 1, At, B1); PG8_BAR;
            PG8_LDB(B0, 1, 0); PG8_SCHED; PG8_LDA(At, 1, 0); PG8_STAGE(PG8_SA(0, 1), a2 + hstep, voffA);
            PG8_WAIT_L(8); PG8_BAR; PG8_WAIT_L(0); PG8_MMA(0, 0, At, B0); PG8_BAR; PG8_SCHED;
            PG8_LDB(B1, 1, 1); PG8_STAGE(PG8_SB(1, 0), b3, voffB);
            PG8_BAR; PG8_WAIT_L(0); PG8_MMA(0, 1, At, B1); PG8_BAR;
            PG8_LDA(At, 1, 1); PG8_STAGE(PG8_SA(1, 0), a3, voffA);
            PG8_BAR; PG8_WAIT_L(0); PG8_MMA(1, 0, At, B0); PG8_BAR; PG8_SCHED;
            PG8_STAGE(PG8_SB(1, 1), b3 + hstep, voffB);
            PG8_WAIT_V(6); PG8_BAR; PG8_MMA(1, 1, At, B1); PG8_BAR;
            }
        }
        if constexpr (ALIGN_EPI) { if (wr == 0) PG8_BAR; }
        if constexpr (!Epi::AFTER_DRAIN) { E(acc, cur, wr, wc, fr, fq); S.done(cur); }
        if (!has_next) break;
#pragma unroll
        for (int a = 0; a < 2; ++a)
#pragma unroll
            for (int b = 0; b < 2; ++b)
#pragma unroll
                for (int m = 0; m < 4; ++m)
#pragma unroll
                    for (int n = 0; n < 2; ++n) acc[a][b][m][n] = (f32x4){0.f, 0.f, 0.f, 0.f};
        cur = nxt; cA = nA; cB = nB; ++ui;
        if constexpr (ALIGN_EPI) { if (wr == 1) PG8_BAR; }
    }
    PG8_WAIT_V(0);
    if constexpr (!ALIGN_EPI) { if (wr == 0) PG8_BAR; }
    PG8_BAR;
    if constexpr (Epi::AFTER_DRAIN) { E.fused(acc, cur, wr, wc, fr, fq, lds, wid, lane); S.done(cur); }
#undef PG8_SA
#undef PG8_SB
#undef PG8_STAGE
#undef PG8_LDA
#undef PG8_LDB
#undef PG8_MMA
#undef PG8_WAIT_V
#undef PG8_WAIT_L
#undef PG8_BAR
#undef PG8_SCHED
}
}
#ifndef PG8_SP2
#define PG8_SP2 true
#endif
#ifndef PG8_ALIGN
#define PG8_ALIGN true
#endif

constexpr int BATCH = 8, SEQ = 2048, DM = 2048, MTOK = BATCH * SEQ;
constexpr int ATT_W = 1024, ATT_H = 8, ATT_HD = 128, MOBA_BLK = 256, NBLK = SEQ / MOBA_BLK;
constexpr int SSM_W = 1024, SSM_H = 16, SSM_P = 64, SSM_N = 128, SSM_L = 128, SSM_NC = SEQ / SSM_L, CONV_CH = 1536;
constexpr int IN_PROJ = 5648, NPROJ = 5632  , NPAD = 5888  ;
constexpr int COL_Q = 0, COL_K = 1024, COL_V = 2048, COL_Z = 3072, COL_XBC = 4096;
constexpr int PEER_H = 8, PEER_NK = 128, PEER_K = 16, PEER_HK = 128;
constexpr float EPS = 1e-6f;
constexpr float SU = 1024.f, SV = 64.f, SH = 16.f, SLO = 16.f;

constexpr size_t MiB = 1u << 20;
constexpr size_t WS_CTL = 0, CTL_ZERO_BYTES = 1 * MiB;
constexpr size_t WS_DT = 1 * MiB;
constexpr size_t WS_SK = 2 * MiB;
constexpr size_t WS_WIN = 4 * MiB;
constexpr size_t WS_WOUT = 28 * MiB;
constexpr size_t WS_WQ = 36 * MiB;
constexpr size_t WS_HN = 44 * MiB;
constexpr size_t WS_PROJ = 108 * MiB;
constexpr size_t WS_X1B = WS_PROJ, WS_QP = WS_PROJ + 64 * MiB;
constexpr size_t WS_U8 = 284 * MiB, WS_V8 = 316 * MiB, WS_END = 348 * MiB;
constexpr int CW_BAR = 4096;
constexpr int CW_Q2 = 8192;
constexpr int CW_KMEAN = 32768;
constexpr int CW_SSQ = 131072;
static_assert((CW_SSQ + MTOK * 4) * 4 <= (int)CTL_ZERO_BYTES, "CTL words inside the memset region");

constexpr int RING_OFF = 0, RING_BYTES = 131072;
constexpr int LDSCTL_OFF = RING_BYTES, MISC_OFF = LDSCTL_OFF + 320;
constexpr int LDS_BYTES = 147456;
constexpr int NWAVES = 8;

#define GAS __attribute__((address_space(1)))
#define LAS __attribute__((address_space(3)))
typedef unsigned short bf16;
typedef unsigned v4u __attribute__((ext_vector_type(4)));
typedef unsigned v2u __attribute__((ext_vector_type(2)));
typedef float f32x4 __attribute__((ext_vector_type(4)));
typedef float f32x2 __attribute__((ext_vector_type(2)));
typedef short bf16x8 __attribute__((ext_vector_type(8)));
typedef short s16x4 __attribute__((ext_vector_type(4)));
typedef GAS unsigned gu32;
#define RLX_AGENT __ATOMIC_RELAXED, __HIP_MEMORY_SCOPE_AGENT
#define LDS_WAIT() asm volatile("s_waitcnt lgkmcnt(0)" ::: "memory")
#define VM_WAIT() asm volatile("s_waitcnt vmcnt(0)" ::: "memory")
__device__ __forceinline__ unsigned f2bf(float f) { unsigned u = __builtin_bit_cast(unsigned, f); return (u + 0x7fffu + ((u >> 16) & 1u)) >> 16; }
__device__ __forceinline__ unsigned pk2(float lo, float hi) { return f2bf(lo) | (f2bf(hi) << 16); }
__device__ __forceinline__ float bflo(unsigned w) { return __builtin_bit_cast(float, w << 16); }
__device__ __forceinline__ float bfhi(unsigned w) { return __builtin_bit_cast(float, w & 0xffff0000u); }
__device__ __forceinline__ float wave_sum(float v) {
#pragma unroll
    for (int o = 1; o < 64; o <<= 1) v += __shfl_xor(v, o);
    return v;
}
__device__ __forceinline__ float silu_f(float x) { return x / (1.f + __expf(-x)); }

#define XB_TMO      128
#define XB_XCNT(j)  (256  + 64 * (j))
#define XB_XSUB(j)  (1280 + 64 * (j))
#define XB_XGEN(j)  (2304 + 64 * (j))
#define XB_TOP      3328
#define XB_TOPGEN   3392
#define XCD_BAR_WORDS 3456
#define XB_SPIN_CAP (1u << 18)

__device__ __forceinline__ unsigned xb_ld(unsigned* p)              { return __hip_atomic_load(p, __ATOMIC_RELAXED, __HIP_MEMORY_SCOPE_AGENT); }
__device__ __forceinline__ unsigned xb_add(unsigned* p, unsigned v) { return __hip_atomic_fetch_add(p, v, __ATOMIC_RELAXED, __HIP_MEMORY_SCOPE_AGENT); }
__device__ __forceinline__ unsigned xb_xcc_id() { return (unsigned)__builtin_amdgcn_s_getreg((3 << 11) | 20) & 0xFu; }
#define XB_SPIN(cond, bar) do { unsigned _sp = 0; while (cond) { __builtin_amdgcn_s_sleep(1); \
    if ((++_sp & 255u) == 0u) { if (xb_ld(&(bar)[XB_TMO])) break; if (_sp > XB_SPIN_CAP) { atomicAdd(&(bar)[XB_TMO], 1u); break; } } } } while (0)

struct XcdBarrier {
    unsigned* bar; unsigned x;
    volatile LAS unsigned* st;
};
__device__ __forceinline__ XcdBarrier xcd_barrier_post(unsigned* bar, volatile LAS unsigned* st) {
    XcdBarrier b; b.bar = bar; b.x = xb_xcc_id(); b.st = st;
    if (threadIdx.x == 0) (void)xb_add(&bar[XB_XCNT(b.x)], 1u);
    return b;
}
__device__ __forceinline__ void xcd_barrier_complete(unsigned* bar, unsigned x, unsigned& nloc, unsigned& nx) {
    const unsigned G = gridDim.x * gridDim.y * gridDim.z;
    unsigned sum, cnt, mine, sp = 0u;
    for (;;) {
        sum = 0u; cnt = 0u; mine = 0u;
#pragma unroll
        for (unsigned j = 0; j < 16; ++j) { const unsigned c = xb_ld(&bar[XB_XCNT(j)]); sum += c; cnt += (c > 0u) ? 1u : 0u; mine = (j == x) ? c : mine; }
        if (sum == G) break;
        __builtin_amdgcn_s_sleep(1);
        if ((++sp & 255u) == 0u) { if (xb_ld(&bar[XB_TMO])) break; if (sp > XB_SPIN_CAP) { atomicAdd(&bar[XB_TMO], 1u); break; } }
    }
    nloc = mine > 0u ? mine : 1u; nx = cnt > 0u ? cnt : 1u;
}
__device__ __forceinline__ void xcd_barrier(const XcdBarrier& b) {
    asm volatile("s_waitcnt vmcnt(0)" ::: "memory");
    __syncthreads();
    if (threadIdx.x == 0) {
        unsigned* bar = b.bar;
        __builtin_amdgcn_s_waitcnt(0);
        unsigned nloc = b.st[0], nx = b.st[1];
        if (nloc == 0u) { xcd_barrier_complete(bar, b.x, nloc, nx); b.st[0] = nloc; b.st[1] = nx; }
        const unsigned old = xb_add(&bar[XB_XSUB(b.x)], 1u);
        const unsigned gen = old / nloc;
        if (old + 1u == (gen + 1u) * nloc) {
            __builtin_amdgcn_fence(__ATOMIC_RELEASE, "agent");
            asm volatile("s_waitcnt vmcnt(0)" ::: "memory");
            const unsigned og = xb_add(&bar[XB_TOP], 1u);
            const unsigned tg = og / nx;
            if (og + 1u == (tg + 1u) * nx) xb_add(&bar[XB_TOPGEN], 1u);
            else XB_SPIN(xb_ld(&bar[XB_TOPGEN]) == tg, bar);
            __builtin_amdgcn_fence(__ATOMIC_ACQUIRE, "agent");
            xb_add(&bar[XB_XGEN(b.x)], 1u);
            asm volatile("s_waitcnt vmcnt(0)" ::: "memory");
        } else {
            XB_SPIN(xb_ld(&bar[XB_XGEN(b.x)]) == gen, bar);
            __builtin_amdgcn_fence(__ATOMIC_ACQUIRE, "agent");
            asm volatile("s_waitcnt vmcnt(0)" ::: "memory");
        }
    }
    __syncthreads();
}

#define CAS __attribute__((address_space(4)))
struct Args { const float* in[18]; float* out; unsigned char* ws; };
__device__ __forceinline__ const CAS unsigned char* kargs() { const CAS unsigned char* p = (const CAS unsigned char*)__builtin_amdgcn_kernarg_segment_ptr(); asm volatile("" : "+s"(p)); return p; }
__device__ __forceinline__ const float* kin(int i) { return *(const float* const CAS*)(kargs() + 8 * i); }
__device__ __forceinline__ float* kout() { return *(float* const CAS*)(kargs() + 8 * 18); }
__device__ __forceinline__ unsigned char* kws() { return *(unsigned char* const CAS*)(kargs() + 8 * 19); }
struct Frame {
    LAS unsigned char* lds;
    volatile LAS unsigned* MISC;
    int tid, lane, wave, G;
    __device__ __forceinline__ const float* x() const { return kin(0); }
    __device__ __forceinline__ const float* attn_norm() const { return kin(1); }
    __device__ __forceinline__ const float* w_in() const { return kin(2); }
    __device__ __forceinline__ const float* conv_w() const { return kin(3); }
    __device__ __forceinline__ const float* conv_b() const { return kin(4); }
    __device__ __forceinline__ const float* dt_bias() const { return kin(5); }
    __device__ __forceinline__ const float* a_log() const { return kin(6); }
    __device__ __forceinline__ const float* d_skip() const { return kin(7); }
    __device__ __forceinline__ const float* rel_bias() const { return kin(8); }
    __device__ __forceinline__ const float* attn_out_norm() const { return kin(9); }
    __device__ __forceinline__ const float* ssm_out_norm() const { return kin(10); }
    __device__ __forceinline__ const float* w_out() const { return kin(11); }
    __device__ __forceinline__ const float* ffn_norm() const { return kin(12); }
    __device__ __forceinline__ const float* peer_wq() const { return kin(13); }
    __device__ __forceinline__ const float* peer_sk() const { return kin(14); }
    __device__ __forceinline__ const float* peer_u() const { return kin(15); }
    __device__ __forceinline__ const float* peer_v() const { return kin(16); }
    __device__ __forceinline__ const float* final_norm() const { return kin(17); }
    __device__ __forceinline__ float* out() const { return kout(); }
    __device__ __forceinline__ unsigned* ctl() const { return (unsigned*)(kws() + WS_CTL); }
    __device__ __forceinline__ float* dtraw() const { return (float*)(kws() + WS_DT); }
    __device__ __forceinline__ bf16* SK() const { return (bf16*)(kws() + WS_SK); }
    __device__ __forceinline__ bf16* WinT() const { return (bf16*)(kws() + WS_WIN); }
    __device__ __forceinline__ bf16* WoutT() const { return (bf16*)(kws() + WS_WOUT); }
    __device__ __forceinline__ bf16* WqT() const { return (bf16*)(kws() + WS_WQ); }
    __device__ __forceinline__ bf16* HN() const { return (bf16*)(kws() + WS_HN); }
    __device__ __forceinline__ bf16* PROJ() const { return (bf16*)(kws() + WS_PROJ); }
    __device__ __forceinline__ bf16* X1B() const { return (bf16*)(kws() + WS_X1B); }
    __device__ __forceinline__ bf16* QP() const { return (bf16*)(kws() + WS_QP); }
    __device__ __forceinline__ unsigned char* U8() const { return kws() + WS_U8; }
    __device__ __forceinline__ unsigned char* V8() const { return kws() + WS_V8; }
    __device__ __forceinline__ float* kmean() const { return (float*)(kws() + WS_CTL) + CW_KMEAN; }
    __device__ __forceinline__ float* ssq() const { return (float*)(kws() + WS_CTL) + CW_SSQ; }
};

__device__ __forceinline__ void p0_transpose_item(const float* W, int K, int N, bf16* WT, const float* gain, LAS float* scr, int item, int lane) {
    const int nblk = (N + 31) / 32, kb = item / nblk, nb = item % nblk, k0 = 64 * kb, n0 = 32 * nb;
    const int nn = n0 + (lane & 31); const bool ok = nn < N;
#pragma unroll 8
    for (int i = 0; i < 32; ++i) { const int kk = 2 * i + (lane >> 5); float v = ok ? W[(size_t)(k0 + kk) * N + nn] : 0.f; if (gain) v *= gain[k0 + kk]; scr[kk * 33 + (lane & 31)] = v; }
    LDS_WAIT(); asm volatile("" ::: "memory");
    const int c = lane & 7;
#pragma unroll
    for (int j = 0; j < 4; ++j) { const int n = (lane >> 3) + 8 * j; const LAS float* s = scr + (8 * c) * 33 + n;
        v4u o; o.x = pk2(s[0 * 33], s[1 * 33]); o.y = pk2(s[2 * 33], s[3 * 33]); o.z = pk2(s[4 * 33], s[5 * 33]); o.w = pk2(s[6 * 33], s[7 * 33]);
        *(GAS v4u*)(WT + (size_t)(n0 + n) * K + k0 + 8 * c) = o; }
    LDS_WAIT(); asm volatile("" ::: "memory");
}
__device__ __forceinline__ void rms_row_to_bf16(const float* xrow, const float* gain, bf16* orow, int lane) {
    const GAS f32x4* xr = (const GAS f32x4*)xrow + lane; const GAS f32x4* gr = (const GAS f32x4*)gain + lane;
    f32x4 v[8]; float s = 0.f;
#pragma unroll
    for (int j = 0; j < 8; ++j) { v[j] = xr[64 * j]; s += (v[j].x * v[j].x + v[j].y * v[j].y) + (v[j].z * v[j].z + v[j].w * v[j].w); }
    const float rstd = 1.f / sqrtf(wave_sum(s) * (1.f / DM) + EPS);
    GAS v2u* o8 = (GAS v2u*)orow + lane;
#pragma unroll
    for (int j = 0; j < 8; ++j) { const f32x4 g = gr[64 * j]; v2u o; o.x = pk2(v[j].x * rstd * g.x, v[j].y * rstd * g.y); o.y = pk2(v[j].z * rstd * g.z, v[j].w * rstd * g.w); o8[64 * j] = o; }
}
__device__ __forceinline__ float clampf(float v, float lim) { return fminf(fmaxf(v, -lim), lim); }
__device__ __forceinline__ v4u cvt16_fp8(const f32x4 a, const f32x4 b, const f32x4 c, const f32x4 d, float sc) {
    v4u o; int w;
    w = __builtin_amdgcn_cvt_pk_fp8_f32(clampf(a.x * sc, 448.f), clampf(a.y * sc, 448.f), 0, false); w = __builtin_amdgcn_cvt_pk_fp8_f32(clampf(a.z * sc, 448.f), clampf(a.w * sc, 448.f), w, true); o.x = (unsigned)w;
    w = __builtin_amdgcn_cvt_pk_fp8_f32(clampf(b.x * sc, 448.f), clampf(b.y * sc, 448.f), 0, false); w = __builtin_amdgcn_cvt_pk_fp8_f32(clampf(b.z * sc, 448.f), clampf(b.w * sc, 448.f), w, true); o.y = (unsigned)w;
    w = __builtin_amdgcn_cvt_pk_fp8_f32(clampf(c.x * sc, 448.f), clampf(c.y * sc, 448.f), 0, false); w = __builtin_amdgcn_cvt_pk_fp8_f32(clampf(c.z * sc, 448.f), clampf(c.w * sc, 448.f), w, true); o.z = (unsigned)w;
    w = __builtin_amdgcn_cvt_pk_fp8_f32(clampf(d.x * sc, 448.f), clampf(d.y * sc, 448.f), 0, false); w = __builtin_amdgcn_cvt_pk_fp8_f32(clampf(d.z * sc, 448.f), clampf(d.w * sc, 448.f), w, true); o.w = (unsigned)w;
    return o;
}
__device__ __forceinline__ void p0_prologue(Frame& F) {
    LAS float* scr = (LAS float*)(F.lds + RING_OFF + F.wave * 16384);
    const int gw = blockIdx.x * NWAVES + F.wave, NGW = F.G * NWAVES;
    constexpr int I_IN = (DM / 64) * ((IN_PROJ + 31) / 32), I_SQ = (DM / 64) * (DM / 32);
    constexpr int NITEMS = I_IN + 2 * I_SQ;
    { const float* const w_in = F.w_in(); const float* const w_out = F.w_out(); const float* const wq = F.peer_wq(); const float* const fg = F.ffn_norm(); bf16* const WinT = F.WinT(); bf16* const WoutT = F.WoutT(); bf16* const WqT = F.WqT();
      for (int it = gw; it < NITEMS; it += NGW) {
        int r = it;
        if (r < I_IN) { p0_transpose_item(w_in, DM, IN_PROJ, WinT, nullptr, scr, r, F.lane); continue; } r -= I_IN;
        if (r < I_SQ) { p0_transpose_item(w_out, DM, DM, WoutT, nullptr, scr, r, F.lane); continue; } r -= I_SQ;
        p0_transpose_item(wq, DM, DM, WqT, fg, scr, r, F.lane);
      } }
    const size_t gt = (size_t)blockIdx.x * (NWAVES * 64) + F.tid, GT = (size_t)F.G * NWAVES * 64;
    { const size_t z0 = (size_t)5664 * DM / 8, z1 = (size_t)NPAD * DM / 8; GAS v4u* p = (GAS v4u*)F.WinT(); for (size_t i = z0 + gt; i < z1; i += GT) p[i] = (v4u){0u, 0u, 0u, 0u}; }
    { const GAS f32x4* s = (const GAS f32x4*)F.peer_sk(); GAS v2u* d = (GAS v2u*)F.SK(); for (size_t i = gt; i < (size_t)16 * 128 * 128 / 4; i += GT) { const f32x4 v = s[i]; v2u o; o.x = pk2(v.x, v.y); o.y = pk2(v.z, v.w); d[i] = o; } }
    { const float* const xg = F.x(); const float* const gn = F.attn_norm(); bf16* const hn = F.HN();
      for (int m = gw; m < MTOK; m += NGW) rms_row_to_bf16(xg + (size_t)m * DM, gn, hn + (size_t)m * DM, F.lane); }
    { const size_t n16 = (size_t)16384 * DM / 16;
      const GAS f32x4* su = (const GAS f32x4*)F.peer_u(); const GAS f32x4* sv = (const GAS f32x4*)F.peer_v(); GAS v4u* du = (GAS v4u*)F.U8(); GAS v4u* dv = (GAS v4u*)F.V8();
      for (size_t i = gt; i < n16; i += GT) { const f32x4 a = su[4 * i], b = su[4 * i + 1], c = su[4 * i + 2], d = su[4 * i + 3]; du[i] = cvt16_fp8(a, b, c, d, SU); }
      for (size_t i = gt; i < n16; i += GT) { const f32x4 a = sv[4 * i], b = sv[4 * i + 1], c = sv[4 * i + 2], d = sv[4 * i + 3]; dv[i] = cvt16_fp8(a, b, c, d, SV); } }
}

struct EpiProj {
    static constexpr bool PERM = true, AFTER_DRAIN = false;
    bf16* O; float* dtraw; float* kmean;
    __device__ __forceinline__ void operator()(const pg8::f32x4 (&acc)[2][2][4][2], const pg8::Unit& u, int wr, int wc, int fr, int fq) const {
        const int row0 = u.pm * 256 + wr * 64 + fr, col0 = u.pn * 256 + wc * 32 + 8 * fq;
        if (u.pn < 22) {
#pragma unroll
            for (int ai = 0; ai < 2; ++ai)
#pragma unroll
                for (int m = 0; m < 4; ++m) { bf16* rowp = O + (size_t)(row0 + ai * 128 + m * 16) * NPROJ + col0;
#pragma unroll
                    for (int bj = 0; bj < 2; ++bj) { const pg8::f32x4 v0 = acc[ai][bj][m][0], v1 = acc[ai][bj][m][1];
                        pg8::u32x4 w; w.x = pg8::cvt_pk_bf16(v0[0], v0[1]); w.y = pg8::cvt_pk_bf16(v0[2], v0[3]); w.z = pg8::cvt_pk_bf16(v1[0], v1[1]); w.w = pg8::cvt_pk_bf16(v1[2], v1[3]);
                        *(pg8::u32x4*)(rowp + bj * 128) = w; } }
        } else if (wc == 0 && fq < 2) {
#pragma unroll
            for (int ai = 0; ai < 2; ++ai)
#pragma unroll
                for (int m = 0; m < 4; ++m) { float* rp = dtraw + (size_t)(row0 + ai * 128 + m * 16) * 16 + 8 * fq;
                    *(pg8::f32x4*)rp = acc[ai][0][m][0]; *(pg8::f32x4*)(rp + 4) = acc[ai][0][m][1]; }
        }
        if (u.pn >= 4 && u.pn < 8) {
#pragma unroll
            for (int bj = 0; bj < 2; ++bj)
#pragma unroll
                for (int n = 0; n < 2; ++n)
#pragma unroll
                    for (int i = 0; i < 4; ++i) { float s = 0.f;
#pragma unroll
                        for (int ai = 0; ai < 2; ++ai)
#pragma unroll
                            for (int m = 0; m < 4; ++m) s += acc[ai][bj][m][n][i];
                        s += __shfl_xor(s, 1); s += __shfl_xor(s, 2); s += __shfl_xor(s, 4); s += __shfl_xor(s, 8);
                        if (fr == 0) unsafeAtomicAdd(kmean + (size_t)u.pm * 1024 + (col0 - 1024) + bj * 128 + 4 * n + i, s); }
        }
    }
};
struct EpiOut {
    static constexpr bool PERM = true, AFTER_DRAIN = false;
    const float* x; float* x1; bf16* x1b; float* ssq;
    __device__ __forceinline__ void operator()(const pg8::f32x4 (&acc)[2][2][4][2], const pg8::Unit& u, int wr, int wc, int fr, int fq) const {
        const int row0 = u.pm * 256 + wr * 64 + fr, col0 = u.pn * 256 + wc * 32 + 8 * fq;
#pragma unroll
        for (int ai = 0; ai < 2; ++ai)
#pragma unroll
            for (int m = 0; m < 4; ++m) { const int row = row0 + ai * 128 + m * 16; const size_t off = (size_t)row * DM + col0; float s = 0.f;
#pragma unroll
                for (int bj = 0; bj < 2; ++bj) {
                    const pg8::f32x4 a0 = *(const pg8::f32x4*)(x + off + bj * 128), a1 = *(const pg8::f32x4*)(x + off + bj * 128 + 4);
                    const pg8::f32x4 v0 = acc[ai][bj][m][0] + a0, v1 = acc[ai][bj][m][1] + a1;
                    *(pg8::f32x4*)(x1 + off + bj * 128) = v0; *(pg8::f32x4*)(x1 + off + bj * 128 + 4) = v1;
                    pg8::u32x4 w; w.x = pg8::cvt_pk_bf16(v0[0], v0[1]); w.y = pg8::cvt_pk_bf16(v0[2], v0[3]); w.z = pg8::cvt_pk_bf16(v1[0], v1[1]); w.w = pg8::cvt_pk_bf16(v1[2], v1[3]);
                    *(pg8::u32x4*)(x1b + off + bj * 128) = w;
                    s += (v0[0] * v0[0] + v0[1] * v0[1]) + (v0[2] * v0[2] + v0[3] * v0[3]) + (v1[0] * v1[0] + v1[1] * v1[1]) + (v1[2] * v1[2] + v1[3] * v1[3]); }
                s += __shfl_xor(s, 16); s += __shfl_xor(s, 32);
                if (fq == 0) unsafeAtomicAdd(ssq + (size_t)row * 4, s);
                asm volatile("" ::: "memory"); }
    }
};
struct EpiQ {
    static constexpr bool PERM = true, AFTER_DRAIN = false;
    bf16* O; const float* ssq;
    __device__ __forceinline__ void operator()(const pg8::f32x4 (&acc)[2][2][4][2], const pg8::Unit& u, int wr, int wc, int fr, int fq) const {
        const int row0 = u.pm * 256 + wr * 64 + fr, col0 = u.pn * 256 + wc * 32 + 8 * fq;
#pragma unroll
        for (int ai = 0; ai < 2; ++ai)
#pragma unroll
            for (int m = 0; m < 4; ++m) { const int row = row0 + ai * 128 + m * 16; bf16* rowp = O + (size_t)row * DM + col0;
                const float rs = 1.f / sqrtf(__hip_atomic_load(ssq + (size_t)row * 4, RLX_AGENT) * (1.f / DM) + EPS);
#pragma unroll
                for (int bj = 0; bj < 2; ++bj) { const pg8::f32x4 v0 = acc[ai][bj][m][0] * rs, v1 = acc[ai][bj][m][1] * rs;
                    pg8::u32x4 w; w.x = pg8::cvt_pk_bf16(v0[0], v0[1]); w.y = pg8::cvt_pk_bf16(v0[2], v0[3]); w.z = pg8::cvt_pk_bf16(v1[0], v1[1]); w.w = pg8::cvt_pk_bf16(v1[2], v1[3]);
                    *(pg8::u32x4*)(rowp + bj * 128) = w; } }
    }
};

constexpr int A_KSTR = 272, A_VSTR = 288;
constexpr int A_KB0 = 0, A_KB1 = 64 * A_KSTR, A_VB0 = 2 * 64 * A_KSTR, A_VB1 = A_VB0 + 64 * A_VSTR, A_KM = A_VB1 + 64 * A_VSTR, A_TAB = A_KM + 8 * 128 * 4, A_END = A_TAB + 128 * 4;
static_assert(A_END <= RING_BYTES && (A_KM % 16) == 0, "attention LDS map");
#define TR16(p) __builtin_amdgcn_ds_read_tr16_b64_v4i16((LAS s16x4*)(p))
#define MFMA16(a, b, c) __builtin_amdgcn_mfma_f32_16x16x32_bf16((a), (b), (c), 0, 0, 0)
__device__ __forceinline__ bf16x8 pack8(const float* v) {
    const unsigned a = pk2(v[0], v[1]), b = pk2(v[2], v[3]), c = pk2(v[4], v[5]), d = pk2(v[6], v[7]);
    const v4u u = {a, b, c, d}; return __builtin_bit_cast(bf16x8, u);
}
__device__ __forceinline__ void attn_unit(Frame& F, int b, int h, int qt) {
    LAS unsigned char* lds = F.lds + RING_OFF;
    const int tid = F.tid, lane = F.lane, w = F.wave, g = lane >> 4, c16 = lane & 15, q4 = c16 >> 2, p4 = lane & 3;
    const int own = qt >> 1, t0 = qt * 128, tq = t0 + 16 * w + c16;
    const size_t rowbase = (size_t)b * SEQ;
    const float NEG_INF = -__builtin_inff();
    constexpr float LOG2E = 1.4426950408889634f, SCL2 = 0.08838834764831845f * 1.4426950408889634f;
    LAS float* km = (LAS float*)(lds + A_KM); LAS float* tab = (LAS float*)(lds + A_TAB);
    const bf16* const PROJ = F.PROJ(); const float* const kmg = F.kmean(); const float* const relb = F.rel_bias();
    for (int i = tid; i < own * 128; i += NWAVES * 64) { const int n = i >> 7, d = i & 127; km[i] = kmg[(size_t)(b * 8 + n) * 1024 + h * 128 + d] * (1.f / 256.f); }
    if (tid < 128) { const int rel = tid; int bucket = rel; if (rel >= 16) { bucket = 16 + (int)(log2f((float)rel * (1.f / 16.f)) * (16.f / 3.f)); bucket = bucket > 31 ? 31 : bucket; }
        tab[tid] = relb[bucket * 8 + h] * LOG2E; }
    bf16x8 qf[4];
    { const bf16* qrow = PROJ + (rowbase + tq) * NPROJ + COL_Q + h * 128 + 8 * g;
#pragma unroll
      for (int ks = 0; ks < 4; ++ks) qf[ks] = *(const GAS bf16x8*)(qrow + 32 * ks); }
    __syncthreads();
    unsigned selmask;
    if (own <= 3) selmask = (1u << own) - 1u;
    else {
        float gate[7];
#pragma unroll
        for (int n = 0; n < 7; ++n) {
            float s = NEG_INF;
            if (n < own) { s = 0.f;
#pragma unroll
                for (int ks = 0; ks < 4; ++ks) { const LAS f32x4* kp = (const LAS f32x4*)(km + n * 128 + 32 * ks + 8 * g); const f32x4 k0 = kp[0], k1 = kp[1]; const v4u qu = __builtin_bit_cast(v4u, qf[ks]);
                    s += bflo(qu.x) * k0.x + bfhi(qu.x) * k0.y + bflo(qu.y) * k0.z + bfhi(qu.y) * k0.w + bflo(qu.z) * k1.x + bfhi(qu.z) * k1.y + bflo(qu.w) * k1.z + bfhi(qu.w) * k1.w; }
                s += __shfl_xor(s, 16); s += __shfl_xor(s, 32); }
            gate[n] = s;
        }
        selmask = 0u;
#pragma unroll
        for (int r = 0; r < 3; ++r) { float best = NEG_INF; int bi = 0;
#pragma unroll
            for (int n = 0; n < 7; ++n) { const bool cand = (n < own) && !((selmask >> n) & 1u) && (gate[n] > best); best = cand ? gate[n] : best; bi = cand ? n : bi; }
            selmask |= 1u << bi; }
    }
    const int nt_own = (qt & 1) ? 4 : 2, nT = nt_own + 4 * own;
    const int sr = tid >> 3, sc = (tid & 7) * 16;
#define A_KEY0(i) ((i) < nt_own ? own * 256 + 64 * (i) : (((i) - nt_own) >> 2) * 256 + (((i) - nt_own) & 3) * 64)
    v4u kr0, kr1, vr0, vr1;
#define A_LOAD(i) do { const bf16* kp_ = PROJ + (rowbase + A_KEY0(i) + sr) * NPROJ + COL_K + h * 128 + sc; \
        kr0 = *(const GAS v4u*)kp_; kr1 = *(const GAS v4u*)(kp_ + 8); vr0 = *(const GAS v4u*)(kp_ + (COL_V - COL_K)); vr1 = *(const GAS v4u*)(kp_ + (COL_V - COL_K) + 8); } while (0)
#define A_STORE(bufi) do { LAS unsigned char* kd_ = lds + ((bufi) ? A_KB1 : A_KB0) + sr * A_KSTR + sc * 2; LAS unsigned char* vd_ = lds + ((bufi) ? A_VB1 : A_VB0) + sr * A_VSTR + sc * 2; \
        *(LAS v4u*)kd_ = kr0; *(LAS v4u*)(kd_ + 16) = kr1; *(LAS v4u*)vd_ = vr0; *(LAS v4u*)(vd_ + 16) = vr1; } while (0)
    A_LOAD(0); A_STORE(0);
    __syncthreads();
    float m_run = NEG_INF, l_run = 0.f;
    f32x4 oacc[8];
#pragma unroll
    for (int db = 0; db < 8; ++db) oacc[db] = (f32x4){0.f, 0.f, 0.f, 0.f};
    for (int i = 0; i < nT; ++i) {
        if (i + 1 < nT) A_LOAD(i + 1);
        const int buf = i & 1, key0 = A_KEY0(i); const bool isown = i < nt_own; const int blk = isown ? own : ((i - nt_own) >> 2);
        LAS unsigned char* Kb = lds + (buf ? A_KB1 : A_KB0); LAS unsigned char* Vb = lds + (buf ? A_VB1 : A_VB0);
        f32x4 sacc[4];
#pragma unroll
        for (int nb = 0; nb < 4; ++nb) { sacc[nb] = (f32x4){0.f, 0.f, 0.f, 0.f};
#pragma unroll
            for (int ks = 0; ks < 4; ++ks) { const bf16x8 kf = *(const LAS bf16x8*)(Kb + (16 * nb + c16) * A_KSTR + (32 * ks + 8 * g) * 2); sacc[nb] = MFMA16(kf, qf[ks], sacc[nb]); } }
        const bool sel = isown || ((selmask >> blk) & 1u);
        const bool far = (key0 + 63 + 128 <= t0 + 16 * w);
        const float bfar = tab[127];
        float sv[16]; float mloc = NEG_INF;
#pragma unroll
        for (int nb = 0; nb < 4; ++nb)
#pragma unroll
            for (int r = 0; r < 4; ++r) { const int rel = tq - (key0 + 16 * nb + 4 * g + r); int ri = rel < 0 ? 0 : rel; ri = ri > 127 ? 127 : ri;
                const float bias = far ? bfar : tab[ri]; float s = sacc[nb][r] * SCL2 + bias; s = (!sel || rel < 0) ? NEG_INF : s; sv[nb * 4 + r] = s; mloc = fmaxf(mloc, s); }
        mloc = fmaxf(mloc, __shfl_xor(mloc, 16)); mloc = fmaxf(mloc, __shfl_xor(mloc, 32));
        const float m_new = fmaxf(m_run, mloc);
        const float alpha = exp2f(m_run - m_new);
        float psum = 0.f;
#pragma unroll
        for (int e = 0; e < 16; ++e) { sv[e] = exp2f(sv[e] - m_new); psum += sv[e]; }
        l_run = l_run * alpha + psum; m_run = m_new;
#pragma unroll
        for (int db = 0; db < 8; ++db) oacc[db] = oacc[db] * alpha;
#pragma unroll
        for (int s = 0; s < 2; ++s) { const bf16x8 pf = pack8(sv + 8 * s);
#pragma unroll
            for (int db = 0; db < 8; ++db) { LAS unsigned char* va = Vb + (32 * s + 4 * g + q4) * A_VSTR + (16 * db + 4 * p4) * 2;
                const s16x4 lo = TR16(va), hi = TR16(va + 16 * A_VSTR); const bf16x8 vf = __builtin_shufflevector(lo, hi, 0, 1, 2, 3, 4, 5, 6, 7);
                oacc[db] = MFMA16(vf, pf, oacc[db]); } }
        if (i + 1 < nT) A_STORE((i + 1) & 1);
        __syncthreads();
    }
    float l_tot = l_run; l_tot += __shfl_xor(l_tot, 16); l_tot += __shfl_xor(l_tot, 32);
    const float inv = 1.f / l_tot; float ssq = 0.f;
    bf16* orow = F.HN() + (rowbase + tq) * DM + h * 128 + 4 * g;
#pragma unroll
    for (int db = 0; db < 8; ++db) { const f32x4 o = oacc[db] * inv; ssq += (o.x * o.x + o.y * o.y) + (o.z * o.z + o.w * o.w); v2u wv; wv.x = pk2(o.x, o.y); wv.y = pk2(o.z, o.w); *(GAS v2u*)(orow + 16 * db) = wv; }
    ssq += __shfl_xor(ssq, 16); ssq += __shfl_xor(ssq, 32);
    if (g == 0) unsafeAtomicAdd(F.ssq() + (rowbase + tq) * 4 + 1, ssq);
#undef A_KEY0
#undef A_LOAD
#undef A_STORE
}

constexpr int S_BSTR = 272, S_XSTR = 144;
constexpr int S_BM = 0, S_CM = 128 * S_BSTR, S_X = 2 * 128 * S_BSTR, S_XW = S_X + 128 * S_XSTR, S_HB = S_XW + 128 * S_XSTR, S_DT = S_HB + 64 * S_BSTR, S_CS = S_DT + 512, S_DA = S_CS + 512, S_END = S_DA + 512;
static_assert(S_END <= RING_BYTES, "ssd LDS map");
__device__ __forceinline__ void ssd_unit(Frame& F, int b, int h) {
    LAS unsigned char* lds = F.lds + RING_OFF;
    const int tid = F.tid, lane = F.lane, w = F.wave, g = lane >> 4, c16 = lane & 15, q4 = c16 >> 2, p4 = lane & 3;
    const int g8 = h >> 3, pbw = w & 3, nhw = w >> 2;
    const float a_h = -__expf(F.a_log()[h]), dtb = F.dt_bias()[h], dsk = F.d_skip()[h];
    const bf16* const PROJ = F.PROJ(); bf16* const MIX = F.HN(); const float* const dtraw = F.dtraw(); const float* const convw = F.conv_w(); const float* const convb = F.conv_b(); float* const ssqp = F.ssq();
    LAS float* dtl = (LAS float*)(lds + S_DT); LAS float* csl = (LAS float*)(lds + S_CS); LAS float* dal = (LAS float*)(lds + S_DA);
    for (int i = tid; i < 64 * S_BSTR / 16; i += NWAVES * 64) ((LAS v4u*)(lds + S_HB))[i] = (v4u){0u, 0u, 0u, 0u};
    f32x4 hacc[4];
#pragma unroll
    for (int i = 0; i < 4; ++i) hacc[i] = (f32x4){0.f, 0.f, 0.f, 0.f};
    for (int c = 0; c < SSM_NC; ++c) {
        const size_t tok0 = (size_t)b * SEQ + (size_t)c * SSM_L;
        if (tid < 128) { const float xr = dtraw[(tok0 + tid) * 16 + h] + dtb; const float dt = xr > 20.f ? xr : log1pf(__expf(xr)); dtl[tid] = dt; dal[tid] = dt * a_h; }
        __syncthreads();
        if (w == 0) { const float v0 = dal[2 * lane], v1 = dal[2 * lane + 1]; float s = v0 + v1;
#pragma unroll
            for (int o = 1; o < 64; o <<= 1) { const float t = __shfl_up(s, o); s += (lane >= o) ? t : 0.f; }
            csl[2 * lane] = s - v1; csl[2 * lane + 1] = s; }
        __syncthreads();
        const float cs_last = csl[127];
        for (int it = 0; it < 10; ++it) {
            const int task = it * (NWAVES * 64) + tid; int arr, l, ch8;
            if (task < 1024) { arr = 0; l = task >> 3; ch8 = task & 7; } else if (task < 3072) { arr = 1; l = (task - 1024) >> 4; ch8 = (task - 1024) & 15; } else { arr = 2; l = (task - 3072) >> 4; ch8 = (task - 3072) & 15; }
            const int chan = (arr == 0) ? h * 64 + ch8 * 8 : ((arr == 1) ? 1024 + g8 * 128 + ch8 * 8 : 1280 + g8 * 128 + ch8 * 8);
            const bf16* src = PROJ + (tok0 + l) * NPROJ + COL_XBC + chan;
            float acc[8];
            { const f32x4 b0 = *(const GAS f32x4*)(convb + chan), b1 = *(const GAS f32x4*)(convb + chan + 4); acc[0] = b0.x; acc[1] = b0.y; acc[2] = b0.z; acc[3] = b0.w; acc[4] = b1.x; acc[5] = b1.y; acc[6] = b1.z; acc[7] = b1.w; }
#pragma unroll
            for (int k = 0; k < 4; ++k) { const int tt = c * SSM_L + l - 3 + k;
                if (tt >= 0) { const v4u raw = *(const GAS v4u*)(src + (ptrdiff_t)(k - 3) * NPROJ);
                    const f32x4 w0 = *(const GAS f32x4*)(convw + k * CONV_CH + chan), w1 = *(const GAS f32x4*)(convw + k * CONV_CH + chan + 4);
                    acc[0] += w0.x * bflo(raw.x); acc[1] += w0.y * bfhi(raw.x); acc[2] += w0.z * bflo(raw.y); acc[3] += w0.w * bfhi(raw.y);
                    acc[4] += w1.x * bflo(raw.z); acc[5] += w1.y * bfhi(raw.z); acc[6] += w1.z * bflo(raw.w); acc[7] += w1.w * bfhi(raw.w); } }
#pragma unroll
            for (int j = 0; j < 8; ++j) acc[j] = silu_f(acc[j]);
            v4u o; o.x = pk2(acc[0], acc[1]); o.y = pk2(acc[2], acc[3]); o.z = pk2(acc[4], acc[5]); o.w = pk2(acc[6], acc[7]);
            if (arr == 0) { *(LAS v4u*)(lds + S_X + l * S_XSTR + ch8 * 16) = o; const float wl = dtl[l] * __expf(cs_last - csl[l]);
                v4u o2; o2.x = pk2(acc[0] * wl, acc[1] * wl); o2.y = pk2(acc[2] * wl, acc[3] * wl); o2.z = pk2(acc[4] * wl, acc[5] * wl); o2.w = pk2(acc[6] * wl, acc[7] * wl);
                *(LAS v4u*)(lds + S_XW + l * S_XSTR + ch8 * 16) = o2; }
            else *(LAS v4u*)(lds + (arr == 1 ? S_BM : S_CM) + l * S_BSTR + ch8 * 16) = o;
        }
        __syncthreads();
        const int lrow = 16 * w + c16;
        bf16x8 cf[4];
#pragma unroll
        for (int ks = 0; ks < 4; ++ks) cf[ks] = *(const LAS bf16x8*)(lds + S_CM + lrow * S_BSTR + (32 * ks + 8 * g) * 2);
        f32x4 yacc[4];
        const float cs_l = csl[lrow]; const float el = __expf(cs_l);
#pragma unroll
        for (int pb = 0; pb < 4; ++pb) { yacc[pb] = (f32x4){0.f, 0.f, 0.f, 0.f};
#pragma unroll
            for (int ks = 0; ks < 4; ++ks) { const bf16x8 hf = *(const LAS bf16x8*)(lds + S_HB + (16 * pb + c16) * S_BSTR + (32 * ks + 8 * g) * 2); yacc[pb] = MFMA16(hf, cf[ks], yacc[pb]); }
            yacc[pb] = yacc[pb] * el; }
        for (int s2 = 0; s2 <= (w >> 1); ++s2) {
            const int sb0 = 2 * s2, sb1 = 2 * s2 + 1; const bool has1 = sb1 <= w;
            f32x4 cb0 = (f32x4){0.f, 0.f, 0.f, 0.f}, cb1 = (f32x4){0.f, 0.f, 0.f, 0.f};
#pragma unroll
            for (int ks = 0; ks < 4; ++ks) { const bf16x8 bf0 = *(const LAS bf16x8*)(lds + S_BM + (16 * sb0 + c16) * S_BSTR + (32 * ks + 8 * g) * 2); cb0 = MFMA16(bf0, cf[ks], cb0); }
            if (has1) {
#pragma unroll
                for (int ks = 0; ks < 4; ++ks) { const bf16x8 bf1 = *(const LAS bf16x8*)(lds + S_BM + (16 * sb1 + c16) * S_BSTR + (32 * ks + 8 * g) * 2); cb1 = MFMA16(bf1, cf[ks], cb1); } }
            float mv[8];
#pragma unroll
            for (int r = 0; r < 4; ++r) { const int s = 16 * sb0 + 4 * g + r; const float e = __expf(fminf(cs_l - csl[s], 0.f)) * dtl[s]; mv[r] = (s <= lrow) ? cb0[r] * e : 0.f; }
#pragma unroll
            for (int r = 0; r < 4; ++r) { const int s = 16 * sb1 + 4 * g + r; const int sc_ = s > 127 ? 127 : s; const float e = __expf(fminf(cs_l - csl[sc_], 0.f)) * dtl[sc_]; mv[4 + r] = (has1 && s <= lrow) ? cb1[r] * e : 0.f; }
            const bf16x8 pf = pack8(mv);
#pragma unroll
            for (int pb = 0; pb < 4; ++pb) { LAS unsigned char* xa = lds + S_X + (32 * s2 + 4 * g + q4) * S_XSTR + (16 * pb + 4 * p4) * 2;
                const s16x4 lo = TR16(xa), hi = TR16(xa + 16 * S_XSTR); const bf16x8 xf = __builtin_shufflevector(lo, hi, 0, 1, 2, 3, 4, 5, 6, 7);
                yacc[pb] = MFMA16(xf, pf, yacc[pb]); }
        }
        { const size_t tok = tok0 + lrow; float ssq = 0.f;
#pragma unroll
          for (int pb = 0; pb < 4; ++pb) { const int p0 = 16 * pb + 4 * g;
              const v2u xr = *(const LAS v2u*)(lds + S_X + lrow * S_XSTR + p0 * 2);
              const v2u zr = *(const GAS v2u*)(PROJ + tok * NPROJ + COL_Z + h * 64 + p0);
              const float o0 = (yacc[pb].x + bflo(xr.x) * dsk) * silu_f(bflo(zr.x)), o1 = (yacc[pb].y + bfhi(xr.x) * dsk) * silu_f(bfhi(zr.x));
              const float o2 = (yacc[pb].z + bflo(xr.y) * dsk) * silu_f(bflo(zr.y)), o3 = (yacc[pb].w + bfhi(xr.y) * dsk) * silu_f(bfhi(zr.y));
              ssq += (o0 * o0 + o1 * o1) + (o2 * o2 + o3 * o3);
              v2u wv; wv.x = pk2(o0, o1); wv.y = pk2(o2, o3); *(GAS v2u*)(MIX + tok * DM + ATT_W + h * 64 + p0) = wv; }
          ssq += __shfl_xor(ssq, 16); ssq += __shfl_xor(ssq, 32);
          if (g == 0) unsafeAtomicAdd(ssqp + tok * 4 + 2 + g8, ssq); }
        { const float cdec = __expf(cs_last);
#pragma unroll
          for (int i = 0; i < 4; ++i) hacc[i] = hacc[i] * cdec;
#pragma unroll
          for (int ks = 0; ks < 4; ++ks) {
              LAS unsigned char* xa = lds + S_XW + (32 * ks + 8 * g + q4) * S_XSTR + (16 * pbw + 4 * p4) * 2;
              const s16x4 xlo = TR16(xa), xhi = TR16(xa + 4 * S_XSTR); const bf16x8 xf = __builtin_shufflevector(xlo, xhi, 0, 1, 2, 3, 4, 5, 6, 7);
#pragma unroll
              for (int i = 0; i < 4; ++i) { const int nb = 4 * nhw + i; LAS unsigned char* ba = lds + S_BM + (32 * ks + 8 * g + q4) * S_BSTR + (16 * nb + 4 * p4) * 2;
                  const s16x4 blo = TR16(ba), bhi = TR16(ba + 4 * S_BSTR); const bf16x8 bfr = __builtin_shufflevector(blo, bhi, 0, 1, 2, 3, 4, 5, 6, 7);
                  hacc[i] = MFMA16(bfr, xf, hacc[i]); } } }
        __syncthreads();
#pragma unroll
        for (int i = 0; i < 4; ++i) { const int nb = 4 * nhw + i; v2u o; o.x = pk2(hacc[i].x, hacc[i].y); o.y = pk2(hacc[i].z, hacc[i].w);
            *(LAS v2u*)(lds + S_HB + (16 * pbw + c16) * S_BSTR + (16 * nb + 4 * g) * 2) = o; }
    }
    __syncthreads();
}

__device__ __forceinline__ void mix_normalize(Frame& F) {
    const int gw = blockIdx.x * NWAVES + F.wave, NGW = F.G * NWAVES, lane = F.lane;
    const float* const ssqp = F.ssq(); bf16* const MIX = F.HN(); const float* const gatt = F.attn_out_norm(); const float* const gssm = F.ssm_out_norm();
    for (int m = gw; m < MTOK; m += NGW) {
        const float* sq = ssqp + (size_t)m * 4;
        const float s1 = __hip_atomic_load(sq + 1, RLX_AGENT), s2 = __hip_atomic_load(sq + 2, RLX_AGENT), s3 = __hip_atomic_load(sq + 3, RLX_AGENT);
        const float ra = 1.f / sqrtf(s1 * (1.f / 1024.f) + EPS), r0 = 1.f / sqrtf(s2 * (1.f / 512.f) + EPS), r1 = 1.f / sqrtf(s3 * (1.f / 512.f) + EPS);
        GAS v4u* row = (GAS v4u*)(MIX + (size_t)m * DM);
#pragma unroll
        for (int j = 0; j < 4; ++j) { const int idx = lane + 64 * j, col = 8 * idx; const float rs = (j < 2) ? ra : ((j == 2) ? r0 : r1);
            const float* gp = (j < 2) ? (gatt + col) : (gssm + (col - ATT_W));
            const f32x4 g0 = *(const GAS f32x4*)gp, g1 = *(const GAS f32x4*)(gp + 4); const v4u v = row[idx]; v4u o;
            o.x = pk2(bflo(v.x) * rs * g0.x, bfhi(v.x) * rs * g0.y); o.y = pk2(bflo(v.y) * rs * g0.z, bfhi(v.y) * rs * g0.w);
            o.z = pk2(bflo(v.z) * rs * g1.x, bfhi(v.z) * rs * g1.y); o.w = pk2(bflo(v.w) * rs * g1.z, bfhi(v.w) * rs * g1.w); row[idx] = o; }
    }
}

constexpr int P_EIDX = 0, P_GATE = 16384, P_LST = 32768, P_HN = 65536, P_ACT = 98304, P_END = 102400;
static_assert(P_END <= RING_BYTES, "peer LDS map");
__constant__ unsigned char PEER_CAND[52] = {0, 1, 2, 3, 4, 5, 6, 7, 8, 9, 10, 11, 12, 13, 14, 15, 16, 17, 18, 19, 20, 21, 22, 23, 32, 33, 34, 35, 36, 48, 49, 50, 51, 64, 65, 66, 80, 81, 96, 97, 112, 113, 128, 144, 160, 176, 192, 208, 224, 240, 255, 255};
__device__ __forceinline__ unsigned f2ord(float f) { const unsigned u = __builtin_bit_cast(unsigned, f); return u ^ ((u >> 31) ? 0xFFFFFFFFu : 0x80000000u); }
__device__ __forceinline__ float ord2f(unsigned u) { return __builtin_bit_cast(float, u ^ ((u >> 31) ? 0x80000000u : 0xFFFFFFFFu)); }
#define CSWAPD(a, b) do { const unsigned hi_ = (a) > (b) ? (a) : (b), lo_ = (a) > (b) ? (b) : (a); (a) = hi_; (b) = lo_; } while (0)
template <int N> __device__ __forceinline__ void bitonic_sort_desc(unsigned (&v)[N]) {
#pragma unroll
    for (int k = 2; k <= N; k <<= 1)
#pragma unroll
        for (int j = k >> 1; j > 0; j >>= 1)
#pragma unroll
            for (int i = 0; i < N; ++i) { const int l = i ^ j; if (l > i) { if ((i & k) == 0) CSWAPD(v[i], v[l]); else CSWAPD(v[l], v[i]); } }
}
__device__ __forceinline__ void merge16_xor(unsigned (&v)[16], int dist) {
    unsigned o[16];
#pragma unroll
    for (int i = 0; i < 16; ++i) o[i] = (unsigned)__shfl_xor((int)v[i], dist);
#pragma unroll
    for (int i = 0; i < 16; ++i) v[i] = v[i] > o[15 - i] ? v[i] : o[15 - i];
#pragma unroll
    for (int j = 8; j > 0; j >>= 1)
#pragma unroll
        for (int i = 0; i < 16; ++i) { const int l = i ^ j; if (l > i) CSWAPD(v[i], v[l]); }
}
__device__ __forceinline__ float gelu_erf(float x) { return 0.5f * x * (1.f + erff(x * 0.70710678118654752f)); }
typedef long i64;
__device__ __forceinline__ void peer_unit(Frame& F, int u) {
    LAS unsigned char* lds = F.lds + RING_OFF;
    const int lane = F.lane, w = F.wave, g = lane >> 4, c16 = lane & 15;
    const int T0 = 32 * u;
    LAS int* eidx = (LAS int*)(lds + P_EIDX); LAS float* gate = (LAS float*)(lds + P_GATE);
    LAS unsigned* lst = (LAS unsigned*)(lds + P_LST) + w * 1024;
    const bf16* const QP = F.QP(); const bf16* const SK = F.SK(); float* const outp = F.out(); const float* const fgain = F.ffn_norm(); const float* const fing = F.final_norm(); const unsigned char* const U8 = F.U8(); const unsigned char* const V8 = F.V8();
#ifndef NO_ROUTE
    for (int tb = 0; tb < 2; ++tb) {
        for (int c = 0; c < 2; ++c) {
            const int p = 2 * w + c;
            bf16x8 qf[4];
            { const bf16* qrow = QP + (size_t)(T0 + 16 * tb + c16) * DM + p * 128 + 8 * g;
#pragma unroll
              for (int ks = 0; ks < 4; ++ks) qf[ks] = *(const GAS bf16x8*)(qrow + 32 * ks); }
            unsigned key[32];
#pragma unroll
            for (int kb = 0; kb < 8; ++kb) { f32x4 acc = (f32x4){0.f, 0.f, 0.f, 0.f};
                const bf16* srow = SK + (size_t)(p * 128 + 16 * kb + c16) * 128 + 8 * g;
#pragma unroll
                for (int ks = 0; ks < 4; ++ks) { const bf16x8 sf = *(const GAS bf16x8*)(srow + 32 * ks); acc = MFMA16(sf, qf[ks], acc); }
#pragma unroll
                for (int r = 0; r < 4; ++r) key[kb * 4 + r] = (f2ord(acc[r]) & ~0x7Fu) | (unsigned)(16 * kb + 4 * g + r);
                if (kb & 1) __builtin_amdgcn_sched_barrier(0); }
            bitonic_sort_desc<32>(key);
            unsigned top[16];
#pragma unroll
            for (int i = 0; i < 16; ++i) top[i] = key[i];
            merge16_xor(top, 16); merge16_xor(top, 32);
            if (g == 0) { LAS v4u* d = (LAS v4u*)(lst + (c * 32 + 16 * tb + c16) * 16);
                d[0] = (v4u){top[0], top[1], top[2], top[3]}; d[1] = (v4u){top[4], top[5], top[6], top[7]}; d[2] = (v4u){top[8], top[9], top[10], top[11]}; d[3] = (v4u){top[12], top[13], top[14], top[15]}; }
        }
        LDS_WAIT();
        const LAS unsigned* l1 = lst + (16 * tb + c16) * 16; const LAS unsigned* l2 = lst + (32 + 16 * tb + c16) * 16;
        unsigned ck[16];
#pragma unroll
        for (int k = 0; k < 13; ++k) { const unsigned ab = PEER_CAND[4 * k + g]; const unsigned a = ab >> 4, bq = ab & 15u;
            const float s = ord2f(l1[a] & ~0x7Fu) + ord2f(l2[bq] & ~0x7Fu); ck[k] = (ab == 255u) ? 0u : ((f2ord(s) & ~0xFFu) | ab); }
        ck[13] = 0u; ck[14] = 0u; ck[15] = 0u;
        bitonic_sort_desc<16>(ck);
        merge16_xor(ck, 16); merge16_xor(ck, 32);
        if (g == 0) { const int tl = 16 * tb + c16; const float m = ord2f(ck[0] & ~0xFFu); float e[16]; float sum = 0.f;
#pragma unroll
            for (int k = 0; k < 16; ++k) { e[k] = __expf(ord2f(ck[k] & ~0xFFu) - m); sum += e[k]; }
            const float inv = 1.f / sum;
#pragma unroll
            for (int k = 0; k < 16; ++k) { const unsigned a = (ck[k] >> 4) & 15u, bq = ck[k] & 15u; const int ex = (int)((l1[a] & 0x7Fu) * 128u + (l2[bq] & 0x7Fu));
                eidx[tl * 128 + w * 16 + k] = ex; gate[tl * 128 + w * 16 + k] = e[k] * inv; } }
    }
#endif
    __syncthreads();
    LAS unsigned char* hnb = lds + P_HN + w * 4096; LAS float* actl = (LAS float*)(lds + P_ACT) + w * 128;
    for (int ti = 0; ti < 4; ++ti) {
        const int tl = w + 8 * ti; const size_t token = (size_t)T0 + tl;
        f32x4 xa[4], xb[4]; float ss = 0.f;
        { const GAS f32x4* xp = (const GAS f32x4*)(outp + token * DM);
#pragma unroll
          for (int j = 0; j < 4; ++j) { xa[j] = xp[4 * lane + j]; xb[j] = xp[256 + 4 * lane + j]; }
#pragma unroll
          for (int j = 0; j < 4; ++j) ss += (xa[j].x * xa[j].x + xa[j].y * xa[j].y) + (xa[j].z * xa[j].z + xa[j].w * xa[j].w) + (xb[j].x * xb[j].x + xb[j].y * xb[j].y) + (xb[j].z * xb[j].z + xb[j].w * xb[j].w); }
        const float rs2 = 1.f / sqrtf(wave_sum(ss) * (1.f / DM) + EPS) * SH;
        {
          const GAS f32x4* gp = (const GAS f32x4*)fgain;
#pragma unroll
          for (int half = 0; half < 2; ++half) { f32x4 hv[4], lv[4];
#pragma unroll
              for (int j = 0; j < 4; ++j) { const f32x4 gg = gp[256 * half + 4 * lane + j]; const f32x4 xv = half ? xb[j] : xa[j]; hv[j] = xv * gg * rs2; }
              const v4u hi8 = cvt16_fp8(hv[0], hv[1], hv[2], hv[3], 1.f);
              const unsigned hw[4] = {hi8.x, hi8.y, hi8.z, hi8.w};
#pragma unroll
              for (int j = 0; j < 4; ++j) { const f32x2 d0 = __builtin_amdgcn_cvt_pk_f32_fp8((int)hw[j], false), d1 = __builtin_amdgcn_cvt_pk_f32_fp8((int)hw[j], true);
                  lv[j] = (f32x4){hv[j].x - d0.x, hv[j].y - d0.y, hv[j].z - d1.x, hv[j].w - d1.y}; }
              const v4u lo8 = cvt16_fp8(lv[0], lv[1], lv[2], lv[3], SLO);
              *(LAS v4u*)(hnb + 1024 * half + 16 * lane) = hi8; *(LAS v4u*)(hnb + 2048 + 1024 * half + 16 * lane) = lo8; } }
        LDS_WAIT();
#ifndef NO_UPH
#pragma unroll 1
        for (int grp = 0; grp < 8; ++grp) {
            const int e = eidx[tl * 128 + 16 * grp + c16];
            const unsigned char* ub = U8 + (size_t)e * DM + 16 * g;
            const LAS unsigned char* hb = hnb + 16 * g + ((c16 == 1) ? 2048 : 0);
            f32x4 acc = (f32x4){0.f, 0.f, 0.f, 0.f};
#pragma unroll 8
            for (int j = 0; j < 32; ++j) { const v4u a = *(const GAS v4u*)(ub + 64 * j); const v4u bb = *(const LAS v4u*)(hb + 64 * j);
                const i64 a0 = (i64)(((unsigned long long)a.y << 32) | a.x), a1 = (i64)(((unsigned long long)a.w << 32) | a.z);
                const i64 b0 = (i64)(((unsigned long long)bb.y << 32) | bb.x), b1 = (i64)(((unsigned long long)bb.w << 32) | bb.z);
                acc = __builtin_amdgcn_mfma_f32_16x16x32_fp8_fp8(a0, b0, acc, 0, 0, 0); acc = __builtin_amdgcn_mfma_f32_16x16x32_fp8_fp8(a1, b1, acc, 0, 0, 0); }
            const float l0 = __shfl_down(acc.x, 1), l1v = __shfl_down(acc.y, 1), l2v = __shfl_down(acc.z, 1), l3 = __shfl_down(acc.w, 1);
            if (c16 == 0) { const int k0 = 16 * grp + 4 * g; constexpr float isc = 1.f / (SU * SH), ilo = 1.f / SLO;
                const f32x4 gt = *(const LAS f32x4*)(gate + tl * 128 + k0);
                f32x4 a4; a4.x = gelu_erf((acc.x + l0 * ilo) * isc) * gt.x; a4.y = gelu_erf((acc.y + l1v * ilo) * isc) * gt.y; a4.z = gelu_erf((acc.z + l2v * ilo) * isc) * gt.z; a4.w = gelu_erf((acc.w + l3 * ilo) * isc) * gt.w;
                *(LAS f32x4*)(actl + k0) = a4; }
        }
#endif
        LDS_WAIT();
        float o[32];
#pragma unroll
        for (int i = 0; i < 32; ++i) o[i] = 0.f;
#ifndef NO_VPH
#pragma unroll 1
        for (int kb = 0; kb < 32; ++kb) {
            v4u va[4], vb[4]; float av[4];
#pragma unroll
            for (int kk = 0; kk < 4; ++kk) { const int k = 4 * kb + kk; const int e = eidx[tl * 128 + k]; av[kk] = actl[k];
                const unsigned char* vp = V8 + (size_t)e * DM + 16 * lane; va[kk] = *(const GAS v4u*)vp; vb[kk] = *(const GAS v4u*)(vp + 1024); }
#pragma unroll
            for (int kk = 0; kk < 4; ++kk) { const float a = av[kk];
                const unsigned vw[8] = {va[kk].x, va[kk].y, va[kk].z, va[kk].w, vb[kk].x, vb[kk].y, vb[kk].z, vb[kk].w};
#pragma unroll
                for (int q = 0; q < 8; ++q) { const f32x2 d0 = __builtin_amdgcn_cvt_pk_f32_fp8((int)vw[q], false), d1 = __builtin_amdgcn_cvt_pk_f32_fp8((int)vw[q], true);
                    o[4 * q] += a * d0.x; o[4 * q + 1] += a * d0.y; o[4 * q + 2] += a * d1.x; o[4 * q + 3] += a * d1.y; }
                __builtin_amdgcn_sched_barrier(0); }
        }
#endif
        { constexpr float isv = 1.f / SV; float s2 = 0.f;
          { const GAS f32x4* xp = (const GAS f32x4*)(outp + token * DM);
#pragma unroll
            for (int j = 0; j < 4; ++j) { xa[j] = xp[4 * lane + j]; xb[j] = xp[256 + 4 * lane + j]; } }
#pragma unroll
          for (int j = 0; j < 4; ++j) { xa[j] = xa[j] + (f32x4){o[4 * j], o[4 * j + 1], o[4 * j + 2], o[4 * j + 3]} * isv; xb[j] = xb[j] + (f32x4){o[16 + 4 * j], o[17 + 4 * j], o[18 + 4 * j], o[19 + 4 * j]} * isv;
              s2 += (xa[j].x * xa[j].x + xa[j].y * xa[j].y) + (xa[j].z * xa[j].z + xa[j].w * xa[j].w) + (xb[j].x * xb[j].x + xb[j].y * xb[j].y) + (xb[j].z * xb[j].z + xb[j].w * xb[j].w); }
          const float rf = 1.f / sqrtf(wave_sum(s2) * (1.f / DM) + EPS);
          const GAS f32x4* fp = (const GAS f32x4*)fing; GAS f32x4* op = (GAS f32x4*)(outp + token * DM);
#pragma unroll
          for (int j = 0; j < 4; ++j) { op[4 * lane + j] = xa[j] * rf * fp[4 * lane + j]; op[256 + 4 * lane + j] = xb[j] * rf * fp[256 + 4 * lane + j]; } }
    }
    __syncthreads();
}

__global__ void __launch_bounds__(NWAVES * 64, 2) hybrid_fwd(Args args) {
    extern __shared__ __attribute__((aligned(16))) unsigned char lds[];
    Frame F;
    F.lds = (LAS unsigned char*)lds;
    F.MISC = (volatile LAS unsigned*)(F.lds + MISC_OFF);
    F.tid = threadIdx.x; F.lane = F.tid & 63; F.wave = __builtin_amdgcn_readfirstlane(F.tid >> 6); F.G = gridDim.x;
    for (int u = F.tid; u < (LDS_BYTES - LDSCTL_OFF) / 4; u += NWAVES * 64) ((LAS unsigned*)(F.lds + LDSCTL_OFF))[u] = 0u;
    __syncthreads();
    (void)args;
    XcdBarrier bar = xcd_barrier_post(F.ctl() + CW_BAR, F.MISC + 8);

#ifndef NO_P0
    p0_prologue(F);
#endif
    xcd_barrier(bar);
#ifndef NO_P1
    { pg8::Gemm gm{F.HN(), F.WinT(), MTOK, NPAD, DM}; pg8::StaticOrder S; S.init(MTOK, NPAD, F.G, (int)blockIdx.x);
      EpiProj E{F.PROJ(), F.dtraw(), F.kmean()};
      pg8::gemm_phase<EpiProj, pg8::StaticOrder, PG8_ALIGN, PG8_SP2>(F.lds + RING_OFF, gm, S, E); }
#endif
    xcd_barrier(bar);
    for (;;) {
        if (F.tid == 0) F.MISC[0] = xb_add(F.ctl() + CW_Q2, 1u);
        __syncthreads();
        const int ui = (int)F.MISC[0];
        __syncthreads();
        if (ui >= 128 + 1024) break;
#ifndef NO_SSD
        if (ui < 128) ssd_unit(F, ui >> 4, ui & 15);
#endif
#ifndef NO_ATT
        if (ui >= 128) { const int a = ui - 128; attn_unit(F, (a & 63) >> 3, a & 7, 15 - (a >> 6)); }
#endif
    }
    xcd_barrier(bar);
#ifndef NO_P25
    mix_normalize(F);
#endif
    xcd_barrier(bar);
#ifndef NO_P3
    { pg8::Gemm gm{F.HN(), F.WoutT(), MTOK, DM, DM}; pg8::StaticOrder S; S.init(MTOK, DM, F.G, (int)blockIdx.x);
      EpiOut E{F.x(), F.out(), F.X1B(), F.ssq()};
      pg8::gemm_phase<EpiOut, pg8::StaticOrder, PG8_ALIGN, PG8_SP2>(F.lds + RING_OFF, gm, S, E); }
#endif
    xcd_barrier(bar);
#ifndef NO_P4
    { pg8::Gemm gm{F.X1B(), F.WqT(), MTOK, DM, DM}; pg8::StaticOrder S; S.init(MTOK, DM, F.G, (int)blockIdx.x);
      EpiQ E{F.QP(), F.ssq()};
      pg8::gemm_phase<EpiQ, pg8::StaticOrder, PG8_ALIGN, PG8_SP2>(F.lds + RING_OFF, gm, S, E); }
#endif
    xcd_barrier(bar);
#ifndef NO_P5
    for (int u = blockIdx.x; u < MTOK / 32; u += F.G) peer_unit(F, u);
#endif
}

extern "C" void kernel_launch(void* const* d_in, const int* in_sizes, int n_in, void* d_out, int out_size, void* d_ws, size_t ws_size, hipStream_t stream) {
    static int grid = 0;
    if (grid == 0) {
        if (n_in != 18 || out_size != MTOK * DM || ws_size < WS_END) { fprintf(stderr, "kernel_launch: unexpected shapes (n_in %d, out %d, ws %zu)\n", n_in, out_size, ws_size); grid = -1; return; }
        int dev = 0, cus = 0, per_cu = 0;
        if (hipGetDevice(&dev) != hipSuccess || hipDeviceGetAttribute(&cus, hipDeviceAttributeMultiprocessorCount, dev) != hipSuccess) { grid = -1; return; }
        if (hipFuncSetAttribute((const void*)hybrid_fwd, hipFuncAttributeMaxDynamicSharedMemorySize, LDS_BYTES) != hipSuccess) { fprintf(stderr, "kernel_launch: hipFuncSetAttribute failed\n"); grid = -1; return; }
        if (hipOccupancyMaxActiveBlocksPerMultiprocessor(&per_cu, (const void*)hybrid_fwd, NWAVES * 64, LDS_BYTES) != hipSuccess || per_cu < 1)
            fprintf(stderr, "kernel_launch: note: occupancy query reports %d workgroups per CU\n", per_cu);
        (void)hipGetLastError();
        grid = cus;
    }
    if (grid < 0) return;
    if (hipMemsetAsync((char*)d_ws + WS_CTL, 0, CTL_ZERO_BYTES, stream) != hipSuccess) return;
    Args a{};
    for (int i = 0; i < 18; ++i) a.in[i] = (const float*)d_in[i];
    a.out = (float*)d_out; a.ws = (unsigned char*)d_ws;
    hipLaunchKernelGGL(hybrid_fwd, dim3(grid), dim3(NWAVES * 64), LDS_BYTES, stream, a);
}
```

```cpp
#include <hip/hip_runtime.h>
#include <cstdio>
#include <cstdint>
namespace pg8 {
#define PG8_LAS __attribute__((address_space(3)))
typedef unsigned short bf16_t;
typedef short bf16x8 __attribute__((ext_vector_type(8)));
typedef float f32x4 __attribute__((ext_vector_type(4)));
typedef unsigned u32x4 __attribute__((ext_vector_type(4)));
constexpr int BM = 256, BK = 64, HALF = 128, HTB = HALF * BK * 2  , STAGE_BYTES = 8 * HTB, NXCD = 8, WGM = 8;

__host__ __device__ __forceinline__ int lds_byte(int r, int c) { const int st = (r >> 4) * 2 + (c >> 5), rr = r & 15, cc = c & 31, ob = rr * 64 + cc * 2; return st * 1024 + (ob ^ (((ob >> 9) & 1) << 5)); }
__host__ __device__ __forceinline__ void stage_rc(int b, int& R, int& C) { const int st = b / 1024, sb = b % 1024, swz = sb ^ (((sb >> 9) & 1) << 5); R = (st >> 1) * 16 + swz / 64; C = (st & 1) * 32 + (swz % 64) / 2; }
__host__ __device__ __forceinline__ int perm32(int rho) { const int n = rho >> 4, i = rho & 15; return 8 * (i >> 2) + 4 * n + (i & 3); }

struct Unit { int pm, pn; };
struct Gemm { const bf16_t* A; const bf16_t* Bt; int M, N, K; };

struct StaticOrder {
    int nM, nN, nwg, G, c;
    __host__ __device__ void init(int M, int N, int G_, int c_) { nM = M / BM; nN = N / BM; nwg = nM * nN; G = G_; c = c_; }
    __host__ __device__ bool next(int i, Unit& u) const {
        const long L = (long)i * G + c; if (L >= nwg) return false;
        int wgid = (int)L; { const int q = nwg / NXCD, r = nwg % NXCD, xcd = wgid % NXCD, off = wgid / NXCD; wgid = (xcd < r ? xcd * (q + 1) : r * (q + 1) + (xcd - r) * q) + off; }
        const int nig = WGM * nN, gid = wgid / nig, fm = gid * WGM, gsz = (nM - fm) < WGM ? (nM - fm) : WGM;
        u.pm = fm + ((wgid % nig) % gsz); u.pn = (wgid % nig) / gsz; return true;
    }
    __device__ __forceinline__ void a_ready(const Unit&) const {}
    __device__ __forceinline__ void done(const Unit&) const {}
};

__device__ __forceinline__ unsigned cvt_pk_bf16(float lo, float hi) { unsigned r; asm volatile("v_cvt_pk_bf16_f32 %0, %1, %2" : "=v"(r) : "v"(lo), "v"(hi)); return r; }
typedef float f32x2 __attribute__((ext_vector_type(2)));
__device__ __forceinline__ f32x2 gelu_pk(f32x2 v) {
    const f32x2 av = __builtin_elementwise_abs(v), d = av * 0.2316418882f + 1.0f;
    f32x2 t; t.x = __builtin_amdgcn_rcpf(d.x); t.y = __builtin_amdgcn_rcpf(d.y);
    f32x2 q = t * 0.5307027145f + (-0.7265760135f); q = q * t + 0.7107068705f; q = q * t + (-0.142248368f); q = q * t + 0.127414796f; q = q * t;
    const f32x2 s = (v * v) * (-0.72134752044f);
    f32x2 e; e.x = __builtin_amdgcn_exp2f(s.x); e.y = __builtin_amdgcn_exp2f(s.y);
    const f32x2 m = v * (q * e), r = v - m;
    f32x2 o; o.x = v.x < 0.f ? m.x : r.x; o.y = v.y < 0.f ? m.y : r.y; return o;
}

template <int ACT  > struct EpiBf16 {
    static constexpr bool PERM = true, AFTER_DRAIN = false; static_assert(ACT == 0 || ACT == 1, "EpiBf16: ACT is 0 (none) or 1 (gelu_pk)");
    bf16_t* O; int ldc; const float* bias; int split_cols; size_t split_stride; float scale0;
    __device__ __forceinline__ void operator()(const f32x4 (&acc)[2][2][4][2], const Unit& u, int wr, int wc, int fr, int fq) const {
        const int row0 = u.pm * BM + wr * 64 + fr; int colt = u.pn * BM; bf16_t* base = O;
        float sc = 1.f; if (split_cols) { const int t = colt / split_cols; base += (size_t)t * split_stride; colt -= t * split_cols; if (t == 0) sc = scale0; }
        const int col0 = colt + wc * 32 + 8 * fq, bcol0 = u.pn * BM + wc * 32 + 8 * fq;
        f32x4 bv[2][2];
#pragma unroll
        for (int bj = 0; bj < 2; ++bj)
#pragma unroll
            for (int n = 0; n < 2; ++n) bv[bj][n] = bias ? *(const f32x4*)(bias + bcol0 + bj * HALF + 4 * n) : (f32x4){0.f, 0.f, 0.f, 0.f};
#pragma unroll
        for (int ai = 0; ai < 2; ++ai)
#pragma unroll
            for (int m = 0; m < 4; ++m) { bf16_t* rowp = base + (size_t)(row0 + ai * HALF + m * 16) * ldc + col0;
#pragma unroll
                for (int bj = 0; bj < 2; ++bj) { f32x4 v0 = acc[ai][bj][m][0] + bv[bj][0], v1 = acc[ai][bj][m][1] + bv[bj][1];
                    if (ACT == 1) { f32x2 a = gelu_pk((f32x2){v0[0], v0[1]}), b = gelu_pk((f32x2){v0[2], v0[3]}), c = gelu_pk((f32x2){v1[0], v1[1]}), d = gelu_pk((f32x2){v1[2], v1[3]});
                        v0 = (f32x4){a.x, a.y, b.x, b.y}; v1 = (f32x4){c.x, c.y, d.x, d.y}; }
                    v0 = v0 * sc; v1 = v1 * sc; u32x4 w; w.x = cvt_pk_bf16(v0[0], v0[1]); w.y = cvt_pk_bf16(v0[2], v0[3]); w.z = cvt_pk_bf16(v1[0], v1[1]); w.w = cvt_pk_bf16(v1[2], v1[3]);
                    *(u32x4*)(rowp + bj * HALF) = w; } }
    }
};
template <class Epi, class Sched, bool ALIGN_EPI = false, bool SP2 = false>
__device__ __forceinline__ void gemm_phase(PG8_LAS unsigned char* lds, const Gemm g, const Sched& S, const Epi& E) {
    const int tid = threadIdx.x, wid = __builtin_amdgcn_readfirstlane(tid >> 6), lane = tid & 63, wr = wid >> 2, wc = wid & 3, fr = lane & 15, fq = lane >> 4;
    const int K = g.K, nt = K / BK;
    unsigned voffA[2], voffB[2];
#pragma unroll
    for (int i = 0; i < 2; ++i) { int R, C; stage_rc(tid * 16 + i * 8192, R, C); const int Rb = Epi::PERM ? ((R & ~31) + perm32(R & 31)) : R;
        voffA[i] = (unsigned)(R * K + C) * 2u; voffB[i] = (unsigned)(Rb * K + C) * 2u; }
    const size_t kstep = (size_t)(BK * 2);
    const size_t hstep = (size_t)HALF * K * 2;
    const size_t tstep = 2 * hstep;
    const unsigned ldsw = (unsigned)wid * 1024u;
    const int aoff = lds_byte(wr * 64 + fr, fq * 8), boff = lds_byte(wc * 32 + fr, fq * 8);
#define PG8_SA(b, h) (((b) * 2 + (h)) * HTB)
#define PG8_SB(b, h) ((4 + (b) * 2 + (h)) * HTB)
#define PG8_STAGE(bufoff, gbase, voff) do { _Pragma("unroll") for (int _i = 0; _i < 2; ++_i) \
        __builtin_amdgcn_global_load_lds((const unsigned*)((const char*)(gbase) + (voff)[_i]), (PG8_LAS unsigned*)(lds + (bufoff) + ldsw + _i * 8192), 16, 0, 0); } while (0)
#define PG8_LDA(dst, b, h) do { _Pragma("unroll") for (int m = 0; m < 4; ++m) _Pragma("unroll") for (int k = 0; k < 2; ++k) dst[m][k] = *(const PG8_LAS bf16x8*)(lds + PG8_SA(b, h) + aoff + m * 2048 + k * 1024); } while (0)
#define PG8_LDB(dst, b, h) do { _Pragma("unroll") for (int n = 0; n < 2; ++n) _Pragma("unroll") for (int k = 0; k < 2; ++k) dst[n][k] = *(const PG8_LAS bf16x8*)(lds + PG8_SB(b, h) + boff + n * 2048 + k * 1024); } while (0)
#define PG8_MMA(ai, bj, At, Bt) do { __builtin_amdgcn_s_setprio(1); _Pragma("unroll") for (int m = 0; m < 4; ++m) _Pragma("unroll") for (int n = 0; n < 2; ++n) _Pragma("unroll") for (int k = 0; k < 2; ++k) \
        acc[ai][bj][m][n] = __builtin_amdgcn_mfma_f32_16x16x32_bf16(Bt[n][k], At[m][k], acc[ai][bj][m][n], 0, 0, 0); __builtin_amdgcn_s_setprio(0); } while (0)
#define PG8_WAIT_V(n) asm volatile("s_waitcnt vmcnt(" #n ")" ::: "memory")
#define PG8_WAIT_L(n) asm volatile("s_waitcnt lgkmcnt(" #n ")" ::: "memory")
#define PG8_BAR __builtin_amdgcn_s_barrier()
#define PG8_SCHED __builtin_amdgcn_sched_barrier(0)
    Unit cur, nxt; int ui = 0;
    if (!S.next(0, cur)) return;
    f32x4 acc[2][2][4][2];
#pragma unroll
    for (int a = 0; a < 2; ++a)
#pragma unroll
        for (int b = 0; b < 2; ++b)
#pragma unroll
            for (int m = 0; m < 4; ++m)
#pragma unroll
                for (int n = 0; n < 2; ++n) acc[a][b][m][n] = (f32x4){0.f, 0.f, 0.f, 0.f};
    bf16x8 At[4][2], B0[2][2], B1[2][2];
    const char* cA = (const char*)g.A + (size_t)cur.pm * tstep; const char* cB = (const char*)g.Bt + (size_t)cur.pn * tstep;
    S.a_ready(cur);
    if constexpr (SP2) {
        PG8_STAGE(PG8_SB(0, 0), cB, voffB); PG8_STAGE(PG8_SB(0, 1), cB + hstep, voffB); PG8_STAGE(PG8_SA(0, 0), cA, voffA); PG8_STAGE(PG8_SA(0, 1), cA + hstep, voffA);
        if (wr == 1) PG8_BAR;
        PG8_WAIT_V(2); PG8_BAR;
        PG8_STAGE(PG8_SB(1, 0), cB + kstep, voffB); PG8_STAGE(PG8_SA(1, 0), cA + kstep, voffA); PG8_STAGE(PG8_SB(1, 1), cB + hstep + kstep, voffB);
        PG8_WAIT_V(6); PG8_BAR;
    } else {
        PG8_STAGE(PG8_SB(0, 0), cB, voffB); PG8_STAGE(PG8_SA(0, 0), cA, voffA); PG8_STAGE(PG8_SB(0, 1), cB + hstep, voffB); PG8_STAGE(PG8_SA(0, 1), cA + hstep, voffA);
        if (wr == 1) PG8_BAR;
        PG8_WAIT_V(4); PG8_BAR;
        PG8_STAGE(PG8_SB(1, 0), cB + kstep, voffB); PG8_STAGE(PG8_SA(1, 0), cA + kstep, voffA); PG8_STAGE(PG8_SB(1, 1), cB + hstep + kstep, voffB);
        PG8_WAIT_V(6); PG8_BAR;
    }
    for (;;) {
        const bool has_next = S.next(ui + 1, nxt);
        const char* nA = has_next ? (const char*)g.A + (size_t)nxt.pm * tstep : cA; const char* nB = has_next ? (const char*)g.Bt + (size_t)nxt.pn * tstep : cB;
        for (int t = 0; t < nt; t += 2) {
            const bool last = (t == nt - 2);
            const char* a1 = cA + (size_t)(t + 1) * kstep;
            const char* a2 = last ? nA : cA + (size_t)(t + 2) * kstep; const char* b2 = last ? nB : cB + (size_t)(t + 2) * kstep;
            const char* a3 = a2 + kstep; const char* b3 = b2 + kstep;
            if (last && has_next) S.a_ready(nxt);
            if constexpr (SP2) {
            PG8_LDB(B0, 0, 0); PG8_LDB(B1, 0, 1); PG8_SCHED; PG8_LDA(At, 0, 0); PG8_STAGE(PG8_SA(1, 1), a1 + hstep, voffA);
            PG8_WAIT_V(8); PG8_WAIT_L(0); PG8_BAR; PG8_MMA(0, 0, At, B0); PG8_MMA(0, 1, At, B1); PG8_BAR; PG8_SCHED;
            PG8_LDA(At, 0, 1); PG8_STAGE(PG8_SB(0, 0), b2, voffB); PG8_STAGE(PG8_SB(0, 1), b2 + hstep, voffB); PG8_STAGE(PG8_SA(0, 0), a2, voffA);
            PG8_WAIT_V(8); PG8_WAIT_L(0); PG8_BAR; PG8_MMA(1, 0, At, B0); PG8_MMA(1, 1, At, B1); PG8_BAR; PG8_SCHED;
            PG8_LDB(B0, 1, 0); PG8_LDB(B1, 1, 1); PG8_SCHED; PG8_LDA(At, 1, 0); PG8_STAGE(PG8_SA(0, 1), a2 + hstep, voffA);
            PG8_WAIT_V(8); PG8_WAIT_L(0); PG8_BAR; PG8_MMA(0, 0, At, B0); PG8_MMA(0, 1, At, B1); PG8_BAR; PG8_SCHED;
            PG8_LDA(At, 1, 1); PG8_STAGE(PG8_SB(1, 0), b3, voffB); PG8_STAGE(PG8_SB(1, 1), b3 + hstep, voffB); PG8_STAGE(PG8_SA(1, 0), a3, voffA);
            PG8_WAIT_V(8); PG8_WAIT_L(0); PG8_BAR; PG8_MMA(1, 0, At, B0); PG8_MMA(1, 1, At, B1); PG8_BAR; PG8_SCHED;
            } else {
            PG8_LDB(B0, 0, 0); PG8_SCHED; PG8_LDA(At, 0, 0); PG8_STAGE(PG8_SA(1, 1), a1 + hstep, voffA);
            PG8_WAIT_L(8); PG8_BAR; PG8_WAIT_L(0); PG8_MMA(0, 0, At, B0); PG8_BAR; PG8_SCHED;
            PG8_LDB(B1, 0, 1); PG8_STAGE(PG8_SB(0, 0), b2, voffB);
            PG8_BAR; PG8_WAIT_L(0); PG8_MMA(0, 1, At, B1); PG8_BAR;
            PG8_LDA(At, 0, 1); PG8_STAGE(PG8_SA(0, 0), a2, voffA);
            PG8_BAR; PG8_WAIT_L(0); PG8_MMA(1, 0, At, B0); PG8_BAR; PG8_SCHED;
            PG8_STAGE(PG8_SB(0, 1), b2 + hstep, voffB);
            PG8_WAIT_V(6); PG8_BAR; PG8_MMA(1, 1, At, B1); PG8_BAR;
            PG8_LDB(B0, 1, 0); PG8_SCHED; PG8_LDA(At, 1, 0); PG8_STAGE(PG8_SA(0, 1), a2 + hstep, voffA);
            PG8_WAIT_L(8); PG8_BAR; PG8_WAIT_L(0); PG8_MMA(0, 0, At, B0); PG8_BAR; PG8_SCHED;
            PG8_LDB(B1, 1, 1); PG8_STAGE(PG8_SB(1, 0), b3, voffB);
            PG8_BAR; PG8_WAIT_L(0); PG8_MMA(0, 1, At, B1); PG8_BAR;
            PG8_LDA(At, 1, 1); PG8_STAGE(PG8_SA(1, 0), a3, voffA);
            PG8_BAR; PG8_WAIT_L(0); PG8_MMA(1, 0, At, B0); PG8_BAR; PG8_SCHED;
            PG8_STAGE(PG8_SB(1, 1), b3 + hstep, voffB);
            PG8_WAIT_V(6); PG8_BAR; PG8_MMA(1, 1, At, B1); PG8_BAR;
            }
        }
        if constexpr (ALIGN_EPI) { if (wr == 0) PG8_BAR; }
        if constexpr (!Epi::AFTER_DRAIN) { E(acc, cur, wr, wc, fr, fq); S.done(cur); }
        if (!has_next) break;
#pragma unroll
        for (int a = 0; a < 2; ++a)
#pragma unroll
            for (int b = 0; b < 2; ++b)
#pragma unroll
                for (int m = 0; m < 4; ++m)
#pragma unroll
                    for (int n = 0; n < 2; ++n) acc[a][b][m][n] = (f32x4){0.f, 0.f, 0.f, 0.f};
        cur = nxt; cA = nA; cB = nB; ++ui;
        if constexpr (ALIGN_EPI) { if (wr == 1) PG8_BAR; }
    }
    PG8_WAIT_V(0);
    if constexpr (!ALIGN_EPI) { if (wr == 0) PG8_BAR; }
    PG8_BAR;
    if constexpr (Epi::AFTER_DRAIN) { E.fused(acc, cur, wr, wc, fr, fq, lds, wid, lane); S.done(cur); }
#undef PG8_SA
#undef PG8_SB
#undef PG8_STAGE
#undef PG8_LDA
#undef PG8_LDB
#undef PG8_MMA
#undef PG8_WAIT_V
#undef PG8_WAIT_L
#undef PG8_BAR
#undef PG8_SCHED
}
}
#ifndef PG8_SP2
#define PG8_SP2 true
#endif
#ifndef PG8_ALIGN
#define PG8_ALIGN true
#endif

constexpr int BATCH = 8, SEQ = 2048, DM = 2048, MTOK = BATCH * SEQ;
constexpr int ATT_W = 1024, ATT_H = 8, ATT_HD = 128, MOBA_BLK = 256, NBLK = SEQ / MOBA_BLK;
constexpr int SSM_W = 1024, SSM_H = 16, SSM_P = 64, SSM_N = 128, SSM_L = 128, SSM_NC = SEQ / SSM_L, CONV_CH = 1536;
constexpr int IN_PROJ = 5648, NPROJ = 5632  , NPAD = 5888  ;
constexpr int COL_Q = 0, COL_K = 1024, COL_V = 2048, COL_Z = 3072, COL_XBC = 4096;
constexpr int PEER_H = 8, PEER_NK = 128, PEER_K = 16, PEER_HK = 128;
constexpr float EPS = 1e-6f;
constexpr float SU = 64.f, SV = 4.f, SH = 16.f, SLO = 16.f;
constexpr int ROWB = DM / 2;

constexpr size_t MiB = 1u << 20;
constexpr size_t WS_CTL = 0, CTL_ZERO_BYTES = 1 * MiB;
constexpr size_t WS_DT = 1 * MiB;
constexpr size_t WS_SK = 2 * MiB;
constexpr size_t WS_WIN = 4 * MiB;
constexpr size_t WS_WOUT = 28 * MiB;
constexpr size_t WS_WQ = 36 * MiB;
constexpr size_t WS_HN = 44 * MiB;
constexpr size_t WS_PROJ = 108 * MiB;
constexpr size_t WS_X1B = WS_PROJ, WS_QP = WS_PROJ + 64 * MiB;
constexpr size_t WS_U8 = 284 * MiB, WS_V8 = 316 * MiB;
constexpr size_t WS_XBC = 348 * MiB;
constexpr size_t WS_DT2 = 3 * MiB;
constexpr size_t WS_END = 396 * MiB;
constexpr int CW_BAR = 4096;
constexpr int CW_Q2 = 8192;
constexpr int CW_KMEAN = 32768;
constexpr int CW_SSQ = 131072;
static_assert((CW_SSQ + MTOK * 4) * 4 <= (int)CTL_ZERO_BYTES, "CTL words inside the memset region");

constexpr int RING_OFF = 0, RING_BYTES = 131072;
constexpr int LDSCTL_OFF = RING_BYTES, MISC_OFF = LDSCTL_OFF + 320;
constexpr int LDS_BYTES = 147456;
constexpr int NWAVES = 8;

#define GAS __attribute__((address_space(1)))
#define LAS __attribute__((address_space(3)))
typedef unsigned short bf16;
typedef unsigned v4u __attribute__((ext_vector_type(4)));
typedef unsigned v2u __attribute__((ext_vector_type(2)));
typedef float f32x4 __attribute__((ext_vector_type(4)));
typedef float f32x2 __attribute__((ext_vector_type(2)));
typedef short bf16x8 __attribute__((ext_vector_type(8)));
typedef short s16x4 __attribute__((ext_vector_type(4)));
typedef GAS unsigned gu32;
#define RLX_AGENT __ATOMIC_RELAXED, __HIP_MEMORY_SCOPE_AGENT
#define LDS_WAIT() asm volatile("s_waitcnt lgkmcnt(0)" ::: "memory")
#define VM_WAIT() asm volatile("s_waitcnt vmcnt(0)" ::: "memory")
__device__ __forceinline__ unsigned f2bf(float f) { unsigned u = __builtin_bit_cast(unsigned, f); return (u + 0x7fffu + ((u >> 16) & 1u)) >> 16; }
typedef __bf16 bf16v2 __attribute__((ext_vector_type(2)));
__device__ __forceinline__ unsigned pk2(float lo, float hi) { bf16v2 v; v.x = (__bf16)lo; v.y = (__bf16)hi; return __builtin_bit_cast(unsigned, v); }
__device__ __forceinline__ float bflo(unsigned w) { return __builtin_bit_cast(float, w << 16); }
__device__ __forceinline__ float bfhi(unsigned w) { return __builtin_bit_cast(float, w & 0xffff0000u); }
__device__ __forceinline__ float wave_sum(float v) {
#pragma unroll
    for (int o = 1; o < 64; o <<= 1) v += __shfl_xor(v, o);
    return v;
}
__device__ __forceinline__ float silu_f(float x) { return x * __builtin_amdgcn_rcpf(1.f + __expf(-x)); }

#define XB_TMO      128
#define XB_XCNT(j)  (256  + 64 * (j))
#define XB_XSUB(j)  (1280 + 64 * (j))
#define XB_XGEN(j)  (2304 + 64 * (j))
#define XB_TOP      3328
#define XB_TOPGEN   3392
#define XCD_BAR_WORDS 3456
#define XB_SPIN_CAP (1u << 18)

__device__ __forceinline__ unsigned xb_ld(unsigned* p)              { return __hip_atomic_load(p, __ATOMIC_RELAXED, __HIP_MEMORY_SCOPE_AGENT); }
__device__ __forceinline__ unsigned xb_add(unsigned* p, unsigned v) { return __hip_atomic_fetch_add(p, v, __ATOMIC_RELAXED, __HIP_MEMORY_SCOPE_AGENT); }
__device__ __forceinline__ unsigned xb_xcc_id() { return (unsigned)__builtin_amdgcn_s_getreg((3 << 11) | 20) & 0xFu; }
#define XB_SPIN(cond, bar) do { unsigned _sp = 0; while (cond) { __builtin_amdgcn_s_sleep(1); \
    if ((++_sp & 255u) == 0u) { if (xb_ld(&(bar)[XB_TMO])) break; if (_sp > XB_SPIN_CAP) { atomicAdd(&(bar)[XB_TMO], 1u); break; } } } } while (0)

struct XcdBarrier {
    unsigned* bar; unsigned x;
    volatile LAS unsigned* st;
};
__device__ __forceinline__ XcdBarrier xcd_barrier_post(unsigned* bar, volatile LAS unsigned* st) {
    XcdBarrier b; b.bar = bar; b.x = xb_xcc_id(); b.st = st;
    if (threadIdx.x == 0) (void)xb_add(&bar[XB_XCNT(b.x)], 1u);
    return b;
}
__device__ __forceinline__ void xcd_barrier_complete(unsigned* bar, unsigned x, unsigned& nloc, unsigned& nx) {
    const unsigned G = gridDim.x * gridDim.y * gridDim.z;
    unsigned sum, cnt, mine, sp = 0u;
    for (;;) {
        sum = 0u; cnt = 0u; mine = 0u;
#pragma unroll
        for (unsigned j = 0; j < 16; ++j) { const unsigned c = xb_ld(&bar[XB_XCNT(j)]); sum += c; cnt += (c > 0u) ? 1u : 0u; mine = (j == x) ? c : mine; }
        if (sum == G) break;
        __builtin_amdgcn_s_sleep(1);
        if ((++sp & 255u) == 0u) { if (xb_ld(&bar[XB_TMO])) break; if (sp > XB_SPIN_CAP) { atomicAdd(&bar[XB_TMO], 1u); break; } }
    }
    nloc = mine > 0u ? mine : 1u; nx = cnt > 0u ? cnt : 1u;
}
__device__ __forceinline__ void xcd_barrier(const XcdBarrier& b) {
    asm volatile("s_waitcnt vmcnt(0)" ::: "memory");
    __syncthreads();
    if (threadIdx.x == 0) {
        unsigned* bar = b.bar;
        __builtin_amdgcn_s_waitcnt(0);
        unsigned nloc = b.st[0], nx = b.st[1];
        if (nloc == 0u) { xcd_barrier_complete(bar, b.x, nloc, nx); b.st[0] = nloc; b.st[1] = nx; }
        const unsigned old = xb_add(&bar[XB_XSUB(b.x)], 1u);
        const unsigned gen = old / nloc;
        if (old + 1u == (gen + 1u) * nloc) {
            __builtin_amdgcn_fence(__ATOMIC_RELEASE, "agent");
            asm volatile("s_waitcnt vmcnt(0)" ::: "memory");
            const unsigned og = xb_add(&bar[XB_TOP], 1u);
            const unsigned tg = og / nx;
            if (og + 1u == (tg + 1u) * nx) xb_add(&bar[XB_TOPGEN], 1u);
            else XB_SPIN(xb_ld(&bar[XB_TOPGEN]) == tg, bar);
            __builtin_amdgcn_fence(__ATOMIC_ACQUIRE, "agent");
            xb_add(&bar[XB_XGEN(b.x)], 1u);
            asm volatile("s_waitcnt vmcnt(0)" ::: "memory");
        } else {
            XB_SPIN(xb_ld(&bar[XB_XGEN(b.x)]) == gen, bar);
            __builtin_amdgcn_fence(__ATOMIC_ACQUIRE, "agent");
            asm volatile("s_waitcnt vmcnt(0)" ::: "memory");
        }
    }
    __syncthreads();
}

#define CAS __attribute__((address_space(4)))
struct Args { const float* in[18]; float* out; unsigned char* ws; };
__device__ __forceinline__ const CAS unsigned char* kargs() { const CAS unsigned char* p = (const CAS unsigned char*)__builtin_amdgcn_kernarg_segment_ptr(); asm volatile("" : "+s"(p)); return p; }
__device__ __forceinline__ const float* kin(int i) { return *(const float* const CAS*)(kargs() + 8 * i); }
__device__ __forceinline__ float* kout() { return *(float* const CAS*)(kargs() + 8 * 18); }
__device__ __forceinline__ unsigned char* kws() { return *(unsigned char* const CAS*)(kargs() + 8 * 19); }
__device__ __forceinline__ int fresh_tid() { int t = threadIdx.x; asm volatile("" : "+v"(t)); return t; }
struct Frame {
    LAS unsigned char* lds;
    volatile LAS unsigned* MISC;
    int tid, lane, wave, G;
    __device__ __forceinline__ const float* x() const { return kin(0); }
    __device__ __forceinline__ const float* attn_norm() const { return kin(1); }
    __device__ __forceinline__ const float* w_in() const { return kin(2); }
    __device__ __forceinline__ const float* conv_w() const { return kin(3); }
    __device__ __forceinline__ const float* conv_b() const { return kin(4); }
    __device__ __forceinline__ const float* dt_bias() const { return kin(5); }
    __device__ __forceinline__ const float* a_log() const { return kin(6); }
    __device__ __forceinline__ const float* d_skip() const { return kin(7); }
    __device__ __forceinline__ const float* rel_bias() const { return kin(8); }
    __device__ __forceinline__ const float* attn_out_norm() const { return kin(9); }
    __device__ __forceinline__ const float* ssm_out_norm() const { return kin(10); }
    __device__ __forceinline__ const float* w_out() const { return kin(11); }
    __device__ __forceinline__ const float* ffn_norm() const { return kin(12); }
    __device__ __forceinline__ const float* peer_wq() const { return kin(13); }
    __device__ __forceinline__ const float* peer_sk() const { return kin(14); }
    __device__ __forceinline__ const float* peer_u() const { return kin(15); }
    __device__ __forceinline__ const float* peer_v() const { return kin(16); }
    __device__ __forceinline__ const float* final_norm() const { return kin(17); }
    __device__ __forceinline__ float* out() const { return kout(); }
    __device__ __forceinline__ unsigned* ctl() const { return (unsigned*)(kws() + WS_CTL); }
    __device__ __forceinline__ float* dtraw() const { return (float*)(kws() + WS_DT); }
    __device__ __forceinline__ bf16* SK() const { return (bf16*)(kws() + WS_SK); }
    __device__ __forceinline__ bf16* WinT() const { return (bf16*)(kws() + WS_WIN); }
    __device__ __forceinline__ bf16* WoutT() const { return (bf16*)(kws() + WS_WOUT); }
    __device__ __forceinline__ bf16* WqT() const { return (bf16*)(kws() + WS_WQ); }
    __device__ __forceinline__ bf16* HN() const { return (bf16*)(kws() + WS_HN); }
    __device__ __forceinline__ bf16* PROJ() const { return (bf16*)(kws() + WS_PROJ); }
    __device__ __forceinline__ bf16* X1B() const { return (bf16*)(kws() + WS_X1B); }
    __device__ __forceinline__ bf16* QP() const { return (bf16*)(kws() + WS_QP); }
    __device__ __forceinline__ unsigned char* U8() const { return kws() + WS_U8; }
    __device__ __forceinline__ unsigned char* V8() const { return kws() + WS_V8; }
    __device__ __forceinline__ bf16* XBC() const { return (bf16*)(kws() + WS_XBC); }
    __device__ __forceinline__ float* DT2() const { return (float*)(kws() + WS_DT2); }
    __device__ __forceinline__ float* kmean() const { return (float*)(kws() + WS_CTL) + CW_KMEAN; }
    __device__ __forceinline__ float* ssq() const { return (float*)(kws() + WS_CTL) + CW_SSQ; }
};

__device__ __forceinline__ void p0_transpose_item(const float* W, int K, int N, bf16* WT, const float* gain, LAS float* scr, int item, int lane) {
    const int nblk = (N + 31) / 32, kb = item / nblk, nb = item % nblk, k0 = 64 * kb, n0 = 32 * nb;
    const int nn = n0 + (lane & 31); const bool ok = nn < N;
#pragma unroll 8
    for (int i = 0; i < 32; ++i) { const int kk = 2 * i + (lane >> 5); float v = ok ? W[(size_t)(k0 + kk) * N + nn] : 0.f; if (gain) v *= gain[k0 + kk]; scr[kk * 33 + (lane & 31)] = v; }
    LDS_WAIT(); asm volatile("" ::: "memory");
    const int c = lane & 7;
#pragma unroll
    for (int j = 0; j < 4; ++j) { const int n = (lane >> 3) + 8 * j; const LAS float* s = scr + (8 * c) * 33 + n;
        v4u o; o.x = pk2(s[0 * 33], s[1 * 33]); o.y = pk2(s[2 * 33], s[3 * 33]); o.z = pk2(s[4 * 33], s[5 * 33]); o.w = pk2(s[6 * 33], s[7 * 33]);
        *(GAS v4u*)(WT + (size_t)(n0 + n) * K + k0 + 8 * c) = o; }
    LDS_WAIT(); asm volatile("" ::: "memory");
}
__device__ __forceinline__ void rms_row_to_bf16(const float* xrow, const float* gain, bf16* orow, int lane) {
    const GAS f32x4* xr = (const GAS f32x4*)xrow + lane; const GAS f32x4* gr = (const GAS f32x4*)gain + lane;
    f32x4 v[8]; float s = 0.f;
#pragma unroll
    for (int j = 0; j < 8; ++j) { v[j] = xr[64 * j]; s += (v[j].x * v[j].x + v[j].y * v[j].y) + (v[j].z * v[j].z + v[j].w * v[j].w); }
    const float rstd = 1.f / sqrtf(wave_sum(s) * (1.f / DM) + EPS);
    GAS v2u* o8 = (GAS v2u*)orow + lane;
#pragma unroll
    for (int j = 0; j < 8; ++j) { const f32x4 g = gr[64 * j]; v2u o; o.x = pk2(v[j].x * rstd * g.x, v[j].y * rstd * g.y); o.y = pk2(v[j].z * rstd * g.z, v[j].w * rstd * g.w); o8[64 * j] = o; }
}
#ifdef PROBE_FP4EMU
__device__ __forceinline__ float fp4grid(float y) { const float a = fabsf(y); float r;
    if (a <= 2.f) r = rintf(a * 2.f) * 0.5f; else if (a <= 4.f) r = rintf(a); else r = (a < 5.f) ? 4.f : 6.f;
    return copysignf(r, y); }
__device__ __forceinline__ float clampf(float v, float lim) { if (lim == 448.5f) return fp4grid(v * (1.f / 16.f)) * 16.f; return fminf(fmaxf(v, -lim), lim); }
#else
__device__ __forceinline__ float clampf(float v, float lim) { return fminf(fmaxf(v, -lim), lim); }
#endif
template <int TAB = 0> __device__ __forceinline__ v4u cvt16_fp8(const f32x4 a, const f32x4 b, const f32x4 c, const f32x4 d, float sc) {
    v4u o; int w; constexpr float LIM = TAB ? 448.5f : 448.f;
    w = __builtin_amdgcn_cvt_pk_fp8_f32(clampf(a.x * sc, LIM), clampf(a.y * sc, LIM), 0, false); w = __builtin_amdgcn_cvt_pk_fp8_f32(clampf(a.z * sc, LIM), clampf(a.w * sc, LIM), w, true); o.x = (unsigned)w;
    w = __builtin_amdgcn_cvt_pk_fp8_f32(clampf(b.x * sc, LIM), clampf(b.y * sc, LIM), 0, false); w = __builtin_amdgcn_cvt_pk_fp8_f32(clampf(b.z * sc, LIM), clampf(b.w * sc, LIM), w, true); o.y = (unsigned)w;
    w = __builtin_amdgcn_cvt_pk_fp8_f32(clampf(c.x * sc, LIM), clampf(c.y * sc, LIM), 0, false); w = __builtin_amdgcn_cvt_pk_fp8_f32(clampf(c.z * sc, LIM), clampf(c.w * sc, LIM), w, true); o.z = (unsigned)w;
    w = __builtin_amdgcn_cvt_pk_fp8_f32(clampf(d.x * sc, LIM), clampf(d.y * sc, LIM), 0, false); w = __builtin_amdgcn_cvt_pk_fp8_f32(clampf(d.z * sc, LIM), clampf(d.w * sc, LIM), w, true); o.w = (unsigned)w;
    return o;
}
__device__ __forceinline__ unsigned fp4_code(float y) { const float a = fabsf(y);
    const unsigned m = (unsigned)(a >= 0.25f) + (unsigned)(a >= 0.75f) + (unsigned)(a >= 1.25f) + (unsigned)(a >= 1.75f) + (unsigned)(a >= 2.5f) + (unsigned)(a >= 3.5f) + (unsigned)(a >= 5.0f);
    return m | ((y < 0.f) ? 8u : 0u); }
__device__ __forceinline__ void p0_prologue(Frame& F) {
    const int tid = fresh_tid(), lane = tid & 63, wave = __builtin_amdgcn_readfirstlane(tid >> 6);
    LAS float* scr = (LAS float*)(F.lds + RING_OFF + wave * 16384);
    const int gw = blockIdx.x * NWAVES + wave, NGW = F.G * NWAVES;
    constexpr int I_IN = (DM / 64) * ((IN_PROJ + 31) / 32), I_SQ = (DM / 64) * (DM / 32);
    constexpr int NITEMS = I_IN + 2 * I_SQ;
    { const float* const w_in = F.w_in(); const float* const w_out = F.w_out(); const float* const wq = F.peer_wq(); const float* const fg = F.ffn_norm(); bf16* const WinT = F.WinT(); bf16* const WoutT = F.WoutT(); bf16* const WqT = F.WqT();
      for (int it = gw; it < NITEMS; it += NGW) {
        int r = it;
        if (r < I_IN) { p0_transpose_item(w_in, DM, IN_PROJ, WinT, nullptr, scr, r, lane); continue; } r -= I_IN;
        if (r < I_SQ) { p0_transpose_item(w_out, DM, DM, WoutT, nullptr, scr, r, lane); continue; } r -= I_SQ;
        p0_transpose_item(wq, DM, DM, WqT, fg, scr, r, lane);
      } }
    const size_t gt = (size_t)blockIdx.x * (NWAVES * 64) + tid, GT = (size_t)F.G * NWAVES * 64;
    { const size_t z0 = (size_t)5664 * DM / 8, z1 = (size_t)NPAD * DM / 8; GAS v4u* p = (GAS v4u*)F.WinT(); for (size_t i = z0 + gt; i < z1; i += GT) p[i] = (v4u){0u, 0u, 0u, 0u}; }
    { const GAS f32x4* s = (const GAS f32x4*)F.peer_sk(); GAS v2u* d = (GAS v2u*)F.SK(); for (size_t i = gt; i < (size_t)16 * 128 * 128 / 4; i += GT) { const f32x4 v = s[i]; v2u o; o.x = pk2(v.x, v.y); o.y = pk2(v.z, v.w); d[i] = o; } }
    { const float* const xg = F.x(); const float* const gn = F.attn_norm(); bf16* const hn = F.HN();
      for (int m = gw; m < MTOK; m += NGW) rms_row_to_bf16(xg + (size_t)m * DM, gn, hn + (size_t)m * DM, lane); }
    { const size_t n32 = (size_t)16384 * DM / 32;
      const GAS f32x4* su = (const GAS f32x4*)F.peer_u(); const GAS f32x4* sv = (const GAS f32x4*)F.peer_v(); GAS v4u* du = (GAS v4u*)F.U8(); GAS v4u* dv = (GAS v4u*)F.V8();
#pragma unroll 1
      for (int tab = 0; tab < 2; ++tab) { const GAS f32x4* src = tab ? sv : su; GAS v4u* dst = tab ? dv : du; const float sc = tab ? SV : SU;
        for (size_t i = gt; i < n32; i += GT) { f32x4 v[8];
#pragma unroll
            for (int j = 0; j < 8; ++j) v[j] = src[8 * i + j];
            unsigned wd[4];
#pragma unroll
            for (int q = 0; q < 4; ++q) { const f32x4 a = v[2 * q] * sc, b = v[2 * q + 1] * sc;
                const float e[8] = {a.x, a.y, a.z, a.w, b.x, b.y, b.z, b.w}; unsigned w = 0u;
#pragma unroll
                for (int t = 0; t < 8; ++t) w |= fp4_code(e[t]) << (4 * t);
                wd[q] = w; }
            dst[i] = (v4u){wd[0], wd[1], wd[2], wd[3]}; } } }
}

struct EpiProj {
    static constexpr bool PERM = true, AFTER_DRAIN = false;
    bf16* O; float* dtraw; float* kmean;
    __device__ __forceinline__ void operator()(const pg8::f32x4 (&acc)[2][2][4][2], const pg8::Unit& u, int wr, int wc, int fr, int fq) const {
        const int row0 = u.pm * 256 + wr * 64 + fr, col0 = u.pn * 256 + wc * 32 + 8 * fq;
        if (u.pn < 22) {
#pragma unroll
            for (int ai = 0; ai < 2; ++ai)
#pragma unroll
                for (int m = 0; m < 4; ++m) { bf16* rowp = O + (size_t)(row0 + ai * 128 + m * 16) * NPROJ + col0;
#pragma unroll
                    for (int bj = 0; bj < 2; ++bj) { const pg8::f32x4 v0 = acc[ai][bj][m][0], v1 = acc[ai][bj][m][1];
                        pg8::u32x4 w; w.x = pg8::cvt_pk_bf16(v0[0], v0[1]); w.y = pg8::cvt_pk_bf16(v0[2], v0[3]); w.z = pg8::cvt_pk_bf16(v1[0], v1[1]); w.w = pg8::cvt_pk_bf16(v1[2], v1[3]);
                        *(pg8::u32x4*)(rowp + bj * 128) = w; } }
        } else if (wc == 0 && fq < 2) {
#pragma unroll
            for (int ai = 0; ai < 2; ++ai)
#pragma unroll
                for (int m = 0; m < 4; ++m) { float* rp = dtraw + (size_t)(row0 + ai * 128 + m * 16) * 16 + 8 * fq;
                    *(pg8::f32x4*)rp = acc[ai][0][m][0]; *(pg8::f32x4*)(rp + 4) = acc[ai][0][m][1]; }
        }
        if (kmean && u.pn >= 4 && u.pn < 8) {
#pragma unroll
            for (int bj = 0; bj < 2; ++bj)
#pragma unroll
                for (int n = 0; n < 2; ++n)
#pragma unroll
                    for (int i = 0; i < 4; ++i) { float s = 0.f;
#pragma unroll
                        for (int ai = 0; ai < 2; ++ai)
#pragma unroll
                            for (int m = 0; m < 4; ++m) s += acc[ai][bj][m][n][i];
                        s += __shfl_xor(s, 1); s += __shfl_xor(s, 2); s += __shfl_xor(s, 4); s += __shfl_xor(s, 8);
                        if (fr == 0) unsafeAtomicAdd(kmean + (size_t)u.pm * 1024 + (col0 - 1024) + bj * 128 + 4 * n + i, s); }
        }
    }
};
struct EpiOut {
    static constexpr bool PERM = true, AFTER_DRAIN = false;
    const float* x; float* x1; bf16* x1b; float* ssq;
    __device__ __forceinline__ void operator()(const pg8::f32x4 (&acc)[2][2][4][2], const pg8::Unit& u, int wr, int wc, int fr, int fq) const {
        const int row0 = u.pm * 256 + wr * 64 + fr, col0 = u.pn * 256 + wc * 32 + 8 * fq;
#pragma unroll
        for (int ai = 0; ai < 2; ++ai)
#pragma unroll
            for (int m = 0; m < 4; ++m) { const int row = row0 + ai * 128 + m * 16; const size_t off = (size_t)row * DM + col0; float s = 0.f;
#pragma unroll
                for (int bj = 0; bj < 2; ++bj) {
                    const pg8::f32x4 a0 = *(const pg8::f32x4*)(x + off + bj * 128), a1 = *(const pg8::f32x4*)(x + off + bj * 128 + 4);
                    const pg8::f32x4 v0 = acc[ai][bj][m][0] + a0, v1 = acc[ai][bj][m][1] + a1;
                    *(pg8::f32x4*)(x1 + off + bj * 128) = v0; *(pg8::f32x4*)(x1 + off + bj * 128 + 4) = v1;
                    pg8::u32x4 w; w.x = pg8::cvt_pk_bf16(v0[0], v0[1]); w.y = pg8::cvt_pk_bf16(v0[2], v0[3]); w.z = pg8::cvt_pk_bf16(v1[0], v1[1]); w.w = pg8::cvt_pk_bf16(v1[2], v1[3]);
                    *(pg8::u32x4*)(x1b + off + bj * 128) = w;
                    s += (v0[0] * v0[0] + v0[1] * v0[1]) + (v0[2] * v0[2] + v0[3] * v0[3]) + (v1[0] * v1[0] + v1[1] * v1[1]) + (v1[2] * v1[2] + v1[3] * v1[3]); }
                s += __shfl_xor(s, 16); s += __shfl_xor(s, 32);
                if (fq == 0 && ssq) unsafeAtomicAdd(ssq + (size_t)row * 4, s);
                asm volatile("" ::: "memory"); }
    }
};
struct EpiQ {
    static constexpr bool PERM = true, AFTER_DRAIN = false;
    bf16* O; const float* ssq;
    __device__ __forceinline__ void operator()(const pg8::f32x4 (&acc)[2][2][4][2], const pg8::Unit& u, int wr, int wc, int fr, int fq) const {
        const int row0 = u.pm * 256 + wr * 64 + fr, col0 = u.pn * 256 + wc * 32 + 8 * fq;
#pragma unroll
        for (int ai = 0; ai < 2; ++ai)
#pragma unroll
            for (int m = 0; m < 4; ++m) { const int row = row0 + ai * 128 + m * 16; bf16* rowp = O + (size_t)row * DM + col0;
                const float rs = 1.f / sqrtf(__hip_atomic_load(ssq + (size_t)row * 4, RLX_AGENT) * (1.f / DM) + EPS);
#pragma unroll
                for (int bj = 0; bj < 2; ++bj) { const pg8::f32x4 v0 = acc[ai][bj][m][0] * rs, v1 = acc[ai][bj][m][1] * rs;
                    pg8::u32x4 w; w.x = pg8::cvt_pk_bf16(v0[0], v0[1]); w.y = pg8::cvt_pk_bf16(v0[2], v0[3]); w.z = pg8::cvt_pk_bf16(v1[0], v1[1]); w.w = pg8::cvt_pk_bf16(v1[2], v1[3]);
                    *(pg8::u32x4*)(rowp + bj * 128) = w; } }
    }
};

constexpr int A_KSTR = 272, A_VSTR = 288;
constexpr int A_KB0 = 0, A_KB1 = 64 * A_KSTR, A_VB0 = 2 * 64 * A_KSTR, A_VB1 = A_VB0 + 64 * A_VSTR, A_KM = A_VB1 + 64 * A_VSTR, A_TAB = A_KM + 8 * 128 * 4, A_END = A_TAB + 128 * 4;
static_assert(A_END <= RING_BYTES && (A_KM % 16) == 0, "attention LDS map");
#define TR16(p) __builtin_amdgcn_ds_read_tr16_b64_v4i16((LAS s16x4*)(p))
#define MFMA16(a, b, c) __builtin_amdgcn_mfma_f32_16x16x32_bf16((a), (b), (c), 0, 0, 0)
__device__ __forceinline__ bf16x8 pack8(const float* v) {
    const unsigned a = pk2(v[0], v[1]), b = pk2(v[2], v[3]), c = pk2(v[4], v[5]), d = pk2(v[6], v[7]);
    const v4u u = {a, b, c, d}; return __builtin_bit_cast(bf16x8, u);
}
__device__ __forceinline__ void attn_unit(Frame& F, int b, int h, int qt, const bool doatom = true) {
    LAS unsigned char* lds = F.lds + RING_OFF;
    const int tid = fresh_tid(), lane = tid & 63, w = __builtin_amdgcn_readfirstlane(tid >> 6), g = lane >> 4, c16 = lane & 15, q4 = c16 >> 2, p4 = lane & 3;
    const int own = qt >> 1, t0 = qt * 128, tq = t0 + 16 * w + c16;
    const size_t rowbase = (size_t)b * SEQ;
    const float NEG_INF = -__builtin_inff();
    constexpr float LOG2E = 1.4426950408889634f, SCL2 = 0.08838834764831845f * 1.4426950408889634f;
    LAS float* km = (LAS float*)(lds + A_KM); LAS float* tab = (LAS float*)(lds + A_TAB);
    const bf16* const PROJ = F.PROJ(); const float* const kmg = F.kmean(); const float* const relb = F.rel_bias();
    for (int i = tid; i < own * 128; i += NWAVES * 64) { const int n = i >> 7, d = i & 127; km[i] = kmg[(size_t)(b * 8 + n) * 1024 + h * 128 + d] * (1.f / 256.f); }
    if (tid < 128) { const int rel = tid; int bucket = rel; if (rel >= 16) { bucket = 16 + (int)(log2f((float)rel * (1.f / 16.f)) * (16.f / 3.f)); bucket = bucket > 31 ? 31 : bucket; }
        tab[tid] = relb[bucket * 8 + h] * LOG2E; }
    bf16x8 qf[4];
    { const bf16* qrow = PROJ + (rowbase + tq) * NPROJ + COL_Q + h * 128 + 8 * g;
#pragma unroll
      for (int ks = 0; ks < 4; ++ks) qf[ks] = *(const GAS bf16x8*)(qrow + 32 * ks); }
    __syncthreads();
    unsigned selmask;
    if (own <= 3) selmask = (1u << own) - 1u;
    else {
        float gate[7];
#pragma unroll
        for (int n = 0; n < 7; ++n) {
            float s = NEG_INF;
            if (n < own) { s = 0.f;
#pragma unroll
                for (int ks = 0; ks < 4; ++ks) { const LAS f32x4* kp = (const LAS f32x4*)(km + n * 128 + 32 * ks + 8 * g); const f32x4 k0 = kp[0], k1 = kp[1]; const v4u qu = __builtin_bit_cast(v4u, qf[ks]);
                    s += bflo(qu.x) * k0.x + bfhi(qu.x) * k0.y + bflo(qu.y) * k0.z + bfhi(qu.y) * k0.w + bflo(qu.z) * k1.x + bfhi(qu.z) * k1.y + bflo(qu.w) * k1.z + bfhi(qu.w) * k1.w; }
                s += __shfl_xor(s, 16); s += __shfl_xor(s, 32); }
            gate[n] = s;
        }
        selmask = 0u;
#pragma unroll
        for (int r = 0; r < 3; ++r) { float best = NEG_INF; int bi = 0;
#pragma unroll
            for (int n = 0; n < 7; ++n) { const bool cand = (n < own) && !((selmask >> n) & 1u) && (gate[n] > best); best = cand ? gate[n] : best; bi = cand ? n : bi; }
            selmask |= 1u << bi; }
    }
    const int nt_own = (qt & 1) ? 4 : 2, nT = nt_own + 4 * own;
    const int sr = tid >> 3, sc = (tid & 7) * 16;
#define A_KEY0(i) ((i) < nt_own ? own * 256 + 64 * (i) : (((i) - nt_own) >> 2) * 256 + (((i) - nt_own) & 3) * 64)
    v4u kr0, kr1, vr0, vr1;
#define A_LOAD(i) do { const bf16* kp_ = PROJ + (rowbase + A_KEY0(i) + sr) * NPROJ + COL_K + h * 128 + sc; \
        kr0 = *(const GAS v4u*)kp_; kr1 = *(const GAS v4u*)(kp_ + 8); vr0 = *(const GAS v4u*)(kp_ + (COL_V - COL_K)); vr1 = *(const GAS v4u*)(kp_ + (COL_V - COL_K) + 8); } while (0)
#define A_STORE(bufi) do { LAS unsigned char* kd_ = lds + ((bufi) ? A_KB1 : A_KB0) + sr * A_KSTR + sc * 2; LAS unsigned char* vd_ = lds + ((bufi) ? A_VB1 : A_VB0) + sr * A_VSTR + sc * 2; \
        *(LAS v4u*)kd_ = kr0; *(LAS v4u*)(kd_ + 16) = kr1; *(LAS v4u*)vd_ = vr0; *(LAS v4u*)(vd_ + 16) = vr1; } while (0)
    A_LOAD(0); A_STORE(0);
    __syncthreads();
    float m_run = NEG_INF, l_run = 0.f;
    f32x4 oacc[8];
#pragma unroll
    for (int db = 0; db < 8; ++db) oacc[db] = (f32x4){0.f, 0.f, 0.f, 0.f};
    for (int i = 0; i < nT; ++i) {
        if (i + 1 < nT) A_LOAD(i + 1);
        const int buf = i & 1, key0 = A_KEY0(i); const bool isown = i < nt_own; const int blk = isown ? own : ((i - nt_own) >> 2);
        LAS unsigned char* Kb = lds + (buf ? A_KB1 : A_KB0); LAS unsigned char* Vb = lds + (buf ? A_VB1 : A_VB0);
        f32x4 sacc[4];
        { bf16x8 kf[16];
#pragma unroll
          for (int nb = 0; nb < 4; ++nb)
#pragma unroll
              for (int ks = 0; ks < 4; ++ks) kf[nb * 4 + ks] = *(const LAS bf16x8*)(Kb + (16 * nb + c16) * A_KSTR + (32 * ks + 8 * g) * 2);
          __builtin_amdgcn_sched_barrier(0);
#pragma unroll
          for (int nb = 0; nb < 4; ++nb) { sacc[nb] = (f32x4){0.f, 0.f, 0.f, 0.f};
#pragma unroll
              for (int ks = 0; ks < 4; ++ks) sacc[nb] = MFMA16(kf[nb * 4 + ks], qf[ks], sacc[nb]); } }
        s16x4 vlo[8], vhi[8];
#pragma unroll
        for (int db = 0; db < 8; ++db) { LAS unsigned char* va = Vb + (4 * g + q4) * A_VSTR + (16 * db + 4 * p4) * 2; vlo[db] = TR16(va); vhi[db] = TR16(va + 16 * A_VSTR); }
        __builtin_amdgcn_sched_barrier(0);
        const bool sel = isown || ((selmask >> blk) & 1u);
        const bool far = (key0 + 63 + 128 <= t0 + 16 * w);
        float sv[16]; float mloc, m_new, alpha;
        if (far) {
            const float bfar = tab[127];
            float mx = fmaxf(fmaxf(sacc[0][0], sacc[0][1]), fmaxf(sacc[0][2], sacc[0][3]));
#pragma unroll
            for (int nb = 1; nb < 4; ++nb) mx = fmaxf(mx, fmaxf(fmaxf(sacc[nb][0], sacc[nb][1]), fmaxf(sacc[nb][2], sacc[nb][3])));
            mloc = sel ? (mx * SCL2 + bfar) : NEG_INF;
            mloc = fmaxf(mloc, __shfl_xor(mloc, 16)); mloc = fmaxf(mloc, __shfl_xor(mloc, 32));
            m_new = fmaxf(m_run, mloc); alpha = __builtin_amdgcn_exp2f(m_run - m_new);
            const float cadd = sel ? (bfar - m_new) : NEG_INF;
#pragma unroll
            for (int nb = 0; nb < 4; ++nb)
#pragma unroll
                for (int r = 0; r < 4; ++r) sv[nb * 4 + r] = __builtin_amdgcn_exp2f(sacc[nb][r] * SCL2 + cadd);
        } else {
            const bool diag = isown && (key0 + 63 > t0 + 16 * w);
            mloc = NEG_INF;
#pragma unroll
            for (int nb = 0; nb < 4; ++nb)
#pragma unroll
                for (int r = 0; r < 4; ++r) { const int rel = tq - (key0 + 16 * nb + 4 * g + r); int ri = rel < 0 ? 0 : rel; ri = ri > 127 ? 127 : ri;
                    float s = sacc[nb][r] * SCL2 + tab[ri]; s = (!sel || (diag && rel < 0)) ? NEG_INF : s; sv[nb * 4 + r] = s; mloc = fmaxf(mloc, s); }
            mloc = fmaxf(mloc, __shfl_xor(mloc, 16)); mloc = fmaxf(mloc, __shfl_xor(mloc, 32));
            m_new = fmaxf(m_run, mloc); alpha = __builtin_amdgcn_exp2f(m_run - m_new);
#pragma unroll
            for (int e = 0; e < 16; ++e) sv[e] = __builtin_amdgcn_exp2f(sv[e] - m_new);
        }
        float psum = 0.f;
#pragma unroll
        for (int e = 0; e < 16; ++e) psum += sv[e];
        l_run = l_run * alpha + psum; m_run = m_new;
#pragma unroll
        for (int db = 0; db < 8; ++db) oacc[db] = oacc[db] * alpha;
        __builtin_amdgcn_sched_barrier(0);
        { const bf16x8 pf0 = pack8(sv), pf1 = pack8(sv + 8);
          s16x4 wlo[8], whi[8];
#pragma unroll
          for (int db = 0; db < 8; ++db) { LAS unsigned char* va = Vb + (32 + 4 * g + q4) * A_VSTR + (16 * db + 4 * p4) * 2; wlo[db] = TR16(va); whi[db] = TR16(va + 16 * A_VSTR); }
          __builtin_amdgcn_sched_barrier(0);
#pragma unroll
          for (int db = 0; db < 8; ++db) { const bf16x8 vf = __builtin_shufflevector(vlo[db], vhi[db], 0, 1, 2, 3, 4, 5, 6, 7); oacc[db] = MFMA16(vf, pf0, oacc[db]); }
#pragma unroll
          for (int db = 0; db < 8; ++db) { const bf16x8 vf = __builtin_shufflevector(wlo[db], whi[db], 0, 1, 2, 3, 4, 5, 6, 7); oacc[db] = MFMA16(vf, pf1, oacc[db]); } }
        if (i + 1 < nT) A_STORE((i + 1) & 1);
        __syncthreads();
    }
    float l_tot = l_run; l_tot += __shfl_xor(l_tot, 16); l_tot += __shfl_xor(l_tot, 32);
    const float inv = 1.f / l_tot; float ssq = 0.f;
    bf16* orow = F.HN() + (rowbase + tq) * DM + h * 128 + 4 * g;
#pragma unroll
    for (int db = 0; db < 8; ++db) { const f32x4 o = oacc[db] * inv; ssq += (o.x * o.x + o.y * o.y) + (o.z * o.z + o.w * o.w); v2u wv; wv.x = pk2(o.x, o.y); wv.y = pk2(o.z, o.w); *(GAS v2u*)(orow + 16 * db) = wv; }
    ssq += __shfl_xor(ssq, 16); ssq += __shfl_xor(ssq, 32);
    if (g == 0 && doatom) unsafeAtomicAdd(F.ssq() + (rowbase + tq) * 4 + 1, ssq);
#undef A_KEY0
#undef A_LOAD
#undef A_STORE
}

constexpr int XBC_W = CONV_CH;
__device__ __forceinline__ void conv_phase(Frame& F) {
    const bf16* const PROJ = F.PROJ(); bf16* const XBC = F.XBC(); const float* const cw = F.conv_w(); const float* const cb = F.conv_b();
    const int gt = blockIdx.x * (NWAVES * 64) + fresh_tid(), GT = F.G * NWAVES * 64;
    for (int task = gt; task < (MTOK / 32) * (CONV_CH / 8); task += GT) {
        const int r = task / (CONV_CH / 8), k = task % (CONV_CH / 8), ch = 8 * k, tok0 = 32 * r;
        float wv[4][8], bias[8];
#pragma unroll
        for (int t = 0; t < 4; ++t) { const f32x4 w0 = *(const GAS f32x4*)(cw + t * CONV_CH + ch), w1 = *(const GAS f32x4*)(cw + t * CONV_CH + ch + 4);
            wv[t][0] = w0.x; wv[t][1] = w0.y; wv[t][2] = w0.z; wv[t][3] = w0.w; wv[t][4] = w1.x; wv[t][5] = w1.y; wv[t][6] = w1.z; wv[t][7] = w1.w; }
        { const f32x4 b0 = *(const GAS f32x4*)(cb + ch), b1 = *(const GAS f32x4*)(cb + ch + 4); bias[0] = b0.x; bias[1] = b0.y; bias[2] = b0.z; bias[3] = b0.w; bias[4] = b1.x; bias[5] = b1.y; bias[6] = b1.z; bias[7] = b1.w; }
        const bf16* src = PROJ + (size_t)tok0 * NPROJ + COL_XBC + ch; bf16* dst = XBC + (size_t)tok0 * XBC_W + ch;
        v4u p0 = (v4u){0u, 0u, 0u, 0u}, p1 = p0, p2 = p0;
        if ((tok0 & (SEQ - 1)) != 0) { p0 = *(const GAS v4u*)(src - 3 * (ptrdiff_t)NPROJ); p1 = *(const GAS v4u*)(src - 2 * (ptrdiff_t)NPROJ); p2 = *(const GAS v4u*)(src - (ptrdiff_t)NPROJ); }
#pragma unroll 1
        for (int i0 = 0; i0 < 32; i0 += 8) {
            v4u cur[8];
#pragma unroll
            for (int i = 0; i < 8; ++i) cur[i] = *(const GAS v4u*)(src + (size_t)(i0 + i) * NPROJ);
#pragma unroll
            for (int i = 0; i < 8; ++i) {
                const v4u c = cur[i]; float acc[8];
                const unsigned a0[4] = {p0.x, p0.y, p0.z, p0.w}, a1[4] = {p1.x, p1.y, p1.z, p1.w}, a2[4] = {p2.x, p2.y, p2.z, p2.w}, a3[4] = {c.x, c.y, c.z, c.w};
#pragma unroll
                for (int j = 0; j < 4; ++j) {
                    acc[2 * j] = bias[2 * j] + wv[0][2 * j] * bflo(a0[j]) + wv[1][2 * j] * bflo(a1[j]) + wv[2][2 * j] * bflo(a2[j]) + wv[3][2 * j] * bflo(a3[j]);
                    acc[2 * j + 1] = bias[2 * j + 1] + wv[0][2 * j + 1] * bfhi(a0[j]) + wv[1][2 * j + 1] * bfhi(a1[j]) + wv[2][2 * j + 1] * bfhi(a2[j]) + wv[3][2 * j + 1] * bfhi(a3[j]); }
#pragma unroll
                for (int j = 0; j < 8; ++j) acc[j] = silu_f(acc[j]);
                v4u o; o.x = pk2(acc[0], acc[1]); o.y = pk2(acc[2], acc[3]); o.z = pk2(acc[4], acc[5]); o.w = pk2(acc[6], acc[7]);
                *(GAS v4u*)(dst + (size_t)(i0 + i) * XBC_W) = o;
                p0 = p1; p1 = p2; p2 = c; }
        }
    }
    { const float* const dtraw = F.dtraw(); float* const dt2 = F.DT2(); const float* const dtb = F.dt_bias();
      for (int i = gt; i < MTOK * 16; i += GT) { const float xr = dtraw[i] + dtb[i & 15]; dt2[i] = xr > 20.f ? xr : log1pf(__expf(xr)); } }
}

constexpr int S_BSTR = 272, S_XSTR = 144;
constexpr int S_BM = 0, S_CM = 128 * S_BSTR, S_X = 2 * 128 * S_BSTR, S_XW = S_X + 128 * S_XSTR, S_HB = S_XW + 128 * S_XSTR, S_DT = S_HB + 64 * S_BSTR, S_CS = S_DT + 512, S_DA = S_CS + 512, S_END = S_DA + 512;
static_assert(S_END <= RING_BYTES, "ssd LDS map");
__device__ __forceinline__ void ssd_unit(Frame& F, int b, int h, const bool doatom = true) {
    LAS unsigned char* lds = F.lds + RING_OFF;
    const int tid = fresh_tid(), lane = tid & 63, w = __builtin_amdgcn_readfirstlane(tid >> 6), g = lane >> 4, c16 = lane & 15, q4 = c16 >> 2, p4 = lane & 3;
    const int g8 = h >> 3, pbw = w & 3, nhw = w >> 2;
    const float a_h = -__expf(F.a_log()[h]), dsk = F.d_skip()[h];
    const bf16* const PROJ = F.PROJ(); bf16* const MIX = F.HN(); const float* const dt2 = F.DT2(); const bf16* const XBC = F.XBC(); float* const ssqp = F.ssq();
    LAS float* dtl = (LAS float*)(lds + S_DT); LAS float* csl = (LAS float*)(lds + S_CS); LAS float* dal = (LAS float*)(lds + S_DA);
    for (int i = tid; i < 64 * S_BSTR / 16; i += NWAVES * 64) ((LAS v4u*)(lds + S_HB))[i] = (v4u){0u, 0u, 0u, 0u};
    f32x4 hacc[4];
#pragma unroll
    for (int i = 0; i < 4; ++i) hacc[i] = (f32x4){0.f, 0.f, 0.f, 0.f};
    const int xl = tid >> 3, xc = tid & 7, bl = tid >> 4, bc = tid & 15;
    v4u xr[2], br[4], cr[4]; float dtv = 0.f;
#define S_PREFETCH(cc) do { const size_t t0_ = (size_t)b * SEQ + (size_t)(cc) * SSM_L; \
        _Pragma("unroll") for (int i_ = 0; i_ < 2; ++i_) xr[i_] = *(const GAS v4u*)(XBC + (t0_ + xl + 64 * i_) * XBC_W + h * 64 + 8 * xc); \
        _Pragma("unroll") for (int i_ = 0; i_ < 4; ++i_) { const bf16* p_ = XBC + (t0_ + bl + 32 * i_) * XBC_W + 1024 + g8 * 128 + 8 * bc; br[i_] = *(const GAS v4u*)p_; cr[i_] = *(const GAS v4u*)(p_ + 256); } \
        if (tid < 128) dtv = dt2[(t0_ + tid) * 16 + h]; } while (0)
    S_PREFETCH(0);
    for (int c = 0; c < SSM_NC; ++c) {
        const size_t tok0 = (size_t)b * SEQ + (size_t)c * SSM_L;
        if (tid < 128) { dtl[tid] = dtv; dal[tid] = dtv * a_h; }
        __syncthreads();
        if (w == 0) { const float v0 = dal[2 * lane], v1 = dal[2 * lane + 1]; float s = v0 + v1;
#pragma unroll
            for (int o = 1; o < 64; o <<= 1) { const float t = __shfl_up(s, o); s += (lane >= o) ? t : 0.f; }
            csl[2 * lane] = s - v1; csl[2 * lane + 1] = s; }
        __syncthreads();
        const float cs_last = csl[127];
#pragma unroll
        for (int i = 0; i < 2; ++i) { const int l = xl + 64 * i; const v4u v = xr[i]; *(LAS v4u*)(lds + S_X + l * S_XSTR + xc * 16) = v; const float wl = dtl[l] * __expf(cs_last - csl[l]);
            v4u o2; o2.x = pk2(bflo(v.x) * wl, bfhi(v.x) * wl); o2.y = pk2(bflo(v.y) * wl, bfhi(v.y) * wl); o2.z = pk2(bflo(v.z) * wl, bfhi(v.z) * wl); o2.w = pk2(bflo(v.w) * wl, bfhi(v.w) * wl);
            *(LAS v4u*)(lds + S_XW + l * S_XSTR + xc * 16) = o2; }
#pragma unroll
        for (int i = 0; i < 4; ++i) { const int l = bl + 32 * i; *(LAS v4u*)(lds + S_BM + l * S_BSTR + bc * 16) = br[i]; *(LAS v4u*)(lds + S_CM + l * S_BSTR + bc * 16) = cr[i]; }
        const int lrow = 16 * w + c16;
        v2u zr[4];
#pragma unroll
        for (int pb = 0; pb < 4; ++pb) zr[pb] = *(const GAS v2u*)(PROJ + (tok0 + lrow) * NPROJ + COL_Z + h * 64 + 16 * pb + 4 * g);
        if (c + 1 < SSM_NC) S_PREFETCH(c + 1);
        __syncthreads();
        bf16x8 cf[4];
#pragma unroll
        for (int ks = 0; ks < 4; ++ks) cf[ks] = *(const LAS bf16x8*)(lds + S_CM + lrow * S_BSTR + (32 * ks + 8 * g) * 2);
        f32x4 yacc[4];
        const float cs_l = csl[lrow]; const float el = __expf(cs_l);
#pragma unroll
        for (int pb = 0; pb < 4; ++pb) { yacc[pb] = (f32x4){0.f, 0.f, 0.f, 0.f};
#pragma unroll
            for (int ks = 0; ks < 4; ++ks) { const bf16x8 hf = *(const LAS bf16x8*)(lds + S_HB + (16 * pb + c16) * S_BSTR + (32 * ks + 8 * g) * 2); yacc[pb] = MFMA16(hf, cf[ks], yacc[pb]); }
            yacc[pb] = yacc[pb] * el; }
        for (int s2 = 0; s2 <= (w >> 1); ++s2) {
            const int sb0 = 2 * s2, sb1 = 2 * s2 + 1; const bool has1 = sb1 <= w;
            f32x4 cb0 = (f32x4){0.f, 0.f, 0.f, 0.f}, cb1 = (f32x4){0.f, 0.f, 0.f, 0.f};
#pragma unroll
            for (int ks = 0; ks < 4; ++ks) { const bf16x8 bf0 = *(const LAS bf16x8*)(lds + S_BM + (16 * sb0 + c16) * S_BSTR + (32 * ks + 8 * g) * 2); cb0 = MFMA16(bf0, cf[ks], cb0); }
            if (has1) {
#pragma unroll
                for (int ks = 0; ks < 4; ++ks) { const bf16x8 bf1 = *(const LAS bf16x8*)(lds + S_BM + (16 * sb1 + c16) * S_BSTR + (32 * ks + 8 * g) * 2); cb1 = MFMA16(bf1, cf[ks], cb1); } }
            float mv[8];
#pragma unroll
            for (int r = 0; r < 4; ++r) { const int s = 16 * sb0 + 4 * g + r; const float e = __expf(fminf(cs_l - csl[s], 0.f)) * dtl[s]; mv[r] = (s <= lrow) ? cb0[r] * e : 0.f; }
#pragma unroll
            for (int r = 0; r < 4; ++r) { const int s = 16 * sb1 + 4 * g + r; const int sc_ = s > 127 ? 127 : s; const float e = __expf(fminf(cs_l - csl[sc_], 0.f)) * dtl[sc_]; mv[4 + r] = (has1 && s <= lrow) ? cb1[r] * e : 0.f; }
            const bf16x8 pf = pack8(mv);
#pragma unroll
            for (int pb = 0; pb < 4; ++pb) { LAS unsigned char* xa = lds + S_X + (32 * s2 + 4 * g + q4) * S_XSTR + (16 * pb + 4 * p4) * 2;
                const s16x4 lo = TR16(xa), hi = TR16(xa + 16 * S_XSTR); const bf16x8 xf = __builtin_shufflevector(lo, hi, 0, 1, 2, 3, 4, 5, 6, 7);
                yacc[pb] = MFMA16(xf, pf, yacc[pb]); }
        }
        { const size_t tok = tok0 + lrow; float ssq = 0.f;
#pragma unroll
          for (int pb = 0; pb < 4; ++pb) { const int p0 = 16 * pb + 4 * g;
              const v2u xs_ = *(const LAS v2u*)(lds + S_X + lrow * S_XSTR + p0 * 2);
              const v2u zr_ = zr[pb];
              const float o0 = (yacc[pb].x + bflo(xs_.x) * dsk) * silu_f(bflo(zr_.x)), o1 = (yacc[pb].y + bfhi(xs_.x) * dsk) * silu_f(bfhi(zr_.x));
              const float o2 = (yacc[pb].z + bflo(xs_.y) * dsk) * silu_f(bflo(zr_.y)), o3 = (yacc[pb].w + bfhi(xs_.y) * dsk) * silu_f(bfhi(zr_.y));
              ssq += (o0 * o0 + o1 * o1) + (o2 * o2 + o3 * o3);
              v2u wv; wv.x = pk2(o0, o1); wv.y = pk2(o2, o3); *(GAS v2u*)(MIX + tok * DM + ATT_W + h * 64 + p0) = wv; }
          ssq += __shfl_xor(ssq, 16); ssq += __shfl_xor(ssq, 32);
          if (g == 0 && doatom) unsafeAtomicAdd(ssqp + tok * 4 + 2 + g8, ssq); }
        { const float cdec = __expf(cs_last);
#pragma unroll
          for (int i = 0; i < 4; ++i) hacc[i] = hacc[i] * cdec;
#pragma unroll
          for (int ks = 0; ks < 4; ++ks) {
              LAS unsigned char* xa = lds + S_XW + (32 * ks + 8 * g + q4) * S_XSTR + (16 * pbw + 4 * p4) * 2;
              const s16x4 xlo = TR16(xa), xhi = TR16(xa + 4 * S_XSTR); const bf16x8 xf = __builtin_shufflevector(xlo, xhi, 0, 1, 2, 3, 4, 5, 6, 7);
#pragma unroll
              for (int i = 0; i < 4; ++i) { const int nb = 4 * nhw + i; LAS unsigned char* ba = lds + S_BM + (32 * ks + 8 * g + q4) * S_BSTR + (16 * nb + 4 * p4) * 2;
                  const s16x4 blo = TR16(ba), bhi = TR16(ba + 4 * S_BSTR); const bf16x8 bfr = __builtin_shufflevector(blo, bhi, 0, 1, 2, 3, 4, 5, 6, 7);
                  hacc[i] = MFMA16(bfr, xf, hacc[i]); } } }
        __syncthreads();
#pragma unroll
        for (int i = 0; i < 4; ++i) { const int nb = 4 * nhw + i; v2u o; o.x = pk2(hacc[i].x, hacc[i].y); o.y = pk2(hacc[i].z, hacc[i].w);
            *(LAS v2u*)(lds + S_HB + (16 * pbw + c16) * S_BSTR + (16 * nb + 4 * g) * 2) = o; }
    }
#undef S_PREFETCH
    __syncthreads();
}

__device__ __forceinline__ void mix_normalize(Frame& F) {
    const int tid_ = fresh_tid(), lane = tid_ & 63; const int gw = blockIdx.x * NWAVES + __builtin_amdgcn_readfirstlane(tid_ >> 6), NGW = F.G * NWAVES;
    const float* const ssqp = F.ssq(); bf16* const MIX = F.HN(); const float* const gatt = F.attn_out_norm(); const float* const gssm = F.ssm_out_norm();
    for (int m = gw; m < MTOK; m += NGW) {
        const float* sq = ssqp + (size_t)m * 4;
        const float s1 = __hip_atomic_load(sq + 1, RLX_AGENT), s2 = __hip_atomic_load(sq + 2, RLX_AGENT), s3 = __hip_atomic_load(sq + 3, RLX_AGENT);
        const float ra = 1.f / sqrtf(s1 * (1.f / 1024.f) + EPS), r0 = 1.f / sqrtf(s2 * (1.f / 512.f) + EPS), r1 = 1.f / sqrtf(s3 * (1.f / 512.f) + EPS);
        GAS v4u* row = (GAS v4u*)(MIX + (size_t)m * DM);
#pragma unroll
        for (int j = 0; j < 4; ++j) { const int idx = lane + 64 * j, col = 8 * idx; const float rs = (j < 2) ? ra : ((j == 2) ? r0 : r1);
            const float* gp = (j < 2) ? (gatt + col) : (gssm + (col - ATT_W));
            const f32x4 g0 = *(const GAS f32x4*)gp, g1 = *(const GAS f32x4*)(gp + 4); const v4u v = row[idx]; v4u o;
            o.x = pk2(bflo(v.x) * rs * g0.x, bfhi(v.x) * rs * g0.y); o.y = pk2(bflo(v.y) * rs * g0.z, bfhi(v.y) * rs * g0.w);
            o.z = pk2(bflo(v.z) * rs * g1.x, bfhi(v.z) * rs * g1.y); o.w = pk2(bflo(v.w) * rs * g1.z, bfhi(v.w) * rs * g1.w); row[idx] = o; }
    }
}

constexpr int P_EIDX = 0, P_GATE = 16384, P_LST = 32768, P_HN = 65536, P_ACT = 98304, P_END = 102400;
static_assert(P_END <= RING_BYTES, "peer LDS map");
__constant__ unsigned char PEER_CAND[52] = {0, 1, 2, 3, 4, 5, 6, 7, 8, 9, 10, 11, 12, 13, 14, 15, 16, 17, 18, 19, 20, 21, 22, 23, 32, 33, 34, 35, 36, 48, 49, 50, 51, 64, 65, 66, 80, 81, 96, 97, 112, 113, 128, 144, 160, 176, 192, 208, 224, 240, 255, 255};
__device__ __forceinline__ unsigned f2ord(float f) { const unsigned u = __builtin_bit_cast(unsigned, f); return u ^ ((u >> 31) ? 0xFFFFFFFFu : 0x80000000u); }
__device__ __forceinline__ float ord2f(unsigned u) { return __builtin_bit_cast(float, u ^ ((u >> 31) ? 0x80000000u : 0xFFFFFFFFu)); }
#define CSWAPD(a, b) do { const unsigned hi_ = (a) > (b) ? (a) : (b), lo_ = (a) > (b) ? (b) : (a); (a) = hi_; (b) = lo_; } while (0)
template <int N> __device__ __forceinline__ void bitonic_sort_desc(unsigned (&v)[N]) {
#pragma unroll
    for (int k = 2; k <= N; k <<= 1)
#pragma unroll
        for (int j = k >> 1; j > 0; j >>= 1)
#pragma unroll
            for (int i = 0; i < N; ++i) { const int l = i ^ j; if (l > i) { if ((i & k) == 0) CSWAPD(v[i], v[l]); else CSWAPD(v[l], v[i]); } }
}
__device__ __forceinline__ void merge16_xor(unsigned (&v)[16], int dist) {
    unsigned o[16];
#pragma unroll
    for (int i = 0; i < 16; ++i) o[i] = (unsigned)__shfl_xor((int)v[i], dist);
#pragma unroll
    for (int i = 0; i < 16; ++i) v[i] = v[i] > o[15 - i] ? v[i] : o[15 - i];
#pragma unroll
    for (int j = 8; j > 0; j >>= 1)
#pragma unroll
        for (int i = 0; i < 16; ++i) { const int l = i ^ j; if (l > i) CSWAPD(v[i], v[l]); }
}
__device__ __forceinline__ float gelu_erf(float x) { return 0.5f * x * (1.f + erff(x * 0.70710678118654752f)); }
__device__ __forceinline__ float fp4_dec1(unsigned n) { const unsigned m = n & 7u; unsigned bits = (m >= 2u) ? (((126u + (m >> 1)) << 23) | ((m & 1u) << 22)) : (m ? 0x3F000000u : 0u); bits |= (n & 8u) << 28; return __builtin_bit_cast(float, bits); }
__device__ __forceinline__ f32x2 fp4_dec2(unsigned x) { f32x2 r; r.x = fp4_dec1(x & 15u); r.y = fp4_dec1((x >> 4) & 15u); return r; }
typedef long i64;
typedef int v8i __attribute__((ext_vector_type(8)));
__device__ __forceinline__ void peer_unit(Frame& F, int u, const bool dry = false) {
    LAS unsigned char* lds = F.lds + RING_OFF;
    const int tid_ = fresh_tid(), lane = tid_ & 63, w = __builtin_amdgcn_readfirstlane(tid_ >> 6), g = lane >> 4, c16 = lane & 15;
    const int T0 = 32 * u;
    LAS int* eidx = (LAS int*)(lds + P_EIDX); LAS float* gate = (LAS float*)(lds + P_GATE);
    LAS unsigned* lst = (LAS unsigned*)(lds + P_LST) + w * 1024;
    const bf16* const QP = F.QP(); const bf16* const SK = F.SK(); float* const outp = F.out(); const float* const fgain = F.ffn_norm(); const float* const fing = F.final_norm(); const unsigned char* const U8 = F.U8(); const unsigned char* const V8 = F.V8();
#ifndef NO_ROUTE
    for (int tb = 0; tb < 2; ++tb) {
        for (int c = 0; c < 2; ++c) {
            const int p = 2 * w + c;
            bf16x8 qf[4];
            { const unsigned qo = ((unsigned)(T0 + 16 * tb + c16) * (unsigned)DM + (unsigned)(p * 128 + 8 * g)) * 2u;
#pragma unroll
              for (int ks = 0; ks < 4; ++ks) qf[ks] = *(const GAS bf16x8*)((const unsigned char*)QP + (qo + 64u * ks)); }
            unsigned key[32];
#pragma unroll
            for (int kb = 0; kb < 8; ++kb) { f32x4 acc = (f32x4){0.f, 0.f, 0.f, 0.f};
                const unsigned so = ((unsigned)(p * 128 + 16 * kb + c16) * 128u + 8u * (unsigned)g) * 2u;
#pragma unroll
                for (int ks = 0; ks < 4; ++ks) { const bf16x8 sf = *(const GAS bf16x8*)((const unsigned char*)SK + (so + 64u * ks)); acc = MFMA16(sf, qf[ks], acc); }
#pragma unroll
                for (int r = 0; r < 4; ++r) key[kb * 4 + r] = (f2ord(acc[r]) & ~0x7Fu) | (unsigned)(16 * kb + 4 * g + r);
                __builtin_amdgcn_sched_barrier(0); }
            bitonic_sort_desc<32>(key);
            unsigned top[16];
#pragma unroll
            for (int i = 0; i < 16; ++i) top[i] = key[i];
            merge16_xor(top, 16); merge16_xor(top, 32);
            if (g == 0) { LAS v4u* d = (LAS v4u*)(lst + (c * 32 + 16 * tb + c16) * 16);
                d[0] = (v4u){top[0], top[1], top[2], top[3]}; d[1] = (v4u){top[4], top[5], top[6], top[7]}; d[2] = (v4u){top[8], top[9], top[10], top[11]}; d[3] = (v4u){top[12], top[13], top[14], top[15]}; }
        }
        LDS_WAIT();
        const LAS unsigned* l1 = lst + (16 * tb + c16) * 16; const LAS unsigned* l2 = lst + (32 + 16 * tb + c16) * 16;
        unsigned ck[16];
#pragma unroll
        for (int k = 0; k < 13; ++k) { const unsigned ab = PEER_CAND[4 * k + g]; const unsigned a = ab >> 4, bq = ab & 15u;
            const float s = ord2f(l1[a] & ~0x7Fu) + ord2f(l2[bq] & ~0x7Fu); ck[k] = (ab == 255u) ? 0u : ((f2ord(s) & ~0xFFu) | ab); }
        ck[13] = 0u; ck[14] = 0u; ck[15] = 0u;
        bitonic_sort_desc<16>(ck);
        merge16_xor(ck, 16); merge16_xor(ck, 32);
        if (g == 0) { const int tl = 16 * tb + c16; const float m = ord2f(ck[0] & ~0xFFu); float e[16]; float sum = 0.f;
#pragma unroll
            for (int k = 0; k < 16; ++k) { e[k] = __expf(ord2f(ck[k] & ~0xFFu) - m); sum += e[k]; }
            const float inv = 1.f / sum;
#pragma unroll
            for (int k = 0; k < 16; ++k) { const unsigned a = (ck[k] >> 4) & 15u, bq = ck[k] & 15u; const int ex = (int)((l1[a] & 0x7Fu) * 128u + (l2[bq] & 0x7Fu));
                eidx[tl * 128 + w * 16 + k] = ex; gate[tl * 128 + w * 16 + k] = e[k] * inv; } }
    }
#endif
    __syncthreads();
    LAS unsigned char* hnb = lds + P_HN + w * 4096; LAS float* actl = (LAS float*)(lds + P_ACT) + w * 128;
    const LAS unsigned char* hb = hnb + 64 * g;
    v4u bA[8], bB[8];
#define PIN16(a, i) asm volatile("" : "+v"(a[i]), "+v"(a[i + 1]), "+v"(a[i + 2]), "+v"(a[i + 3]), "+v"(a[i + 4]), "+v"(a[i + 5]), "+v"(a[i + 6]), "+v"(a[i + 7]), "+v"(a[i + 8]), "+v"(a[i + 9]), "+v"(a[i + 10]), "+v"(a[i + 11]), "+v"(a[i + 12]), "+v"(a[i + 13]), "+v"(a[i + 14]), "+v"(a[i + 15]))
#define U_ISSUE(buf, e_, jb) do { const unsigned uo_ = (unsigned)(e_) * (unsigned)ROWB + 16u * (unsigned)g + 512u * (unsigned)(jb); \
        _Pragma("unroll") for (int jj = 0; jj < 8; ++jj) buf[jj] = *(const GAS v4u*)(U8 + (uo_ + 64u * jj)); __builtin_amdgcn_sched_barrier(0); } while (0)
#define U_CONSUME(buf, jb) do { _Pragma("unroll") for (int jj = 0; jj < 8; ++jj) { const v4u a_ = buf[jj]; const unsigned aw_[4] = {a_.x, a_.y, a_.z, a_.w}; \
        _Pragma("unroll") for (int m = 0; m < 4; ++m) { \
            const v4u af_ = {__builtin_bit_cast(unsigned, __builtin_amdgcn_cvt_scalef32_pk_bf16_fp4(aw_[m], 1.0f, 0)), __builtin_bit_cast(unsigned, __builtin_amdgcn_cvt_scalef32_pk_bf16_fp4(aw_[m], 1.0f, 1)), \
                             __builtin_bit_cast(unsigned, __builtin_amdgcn_cvt_scalef32_pk_bf16_fp4(aw_[m], 1.0f, 2)), __builtin_bit_cast(unsigned, __builtin_amdgcn_cvt_scalef32_pk_bf16_fp4(aw_[m], 1.0f, 3))}; \
            const bf16x8 bf_ = *(const LAS bf16x8*)(hb + 256 * (8 * (jb) + jj) + 16 * m); \
            acc = MFMA16(__builtin_bit_cast(bf16x8, af_), bf_, acc); } } __builtin_amdgcn_sched_barrier(0); } while (0)
#define V_ISSUE(buf, kb_) do { _Pragma("unroll") for (int kk = 0; kk < 8; ++kk) { const int e_ = eidx[tl * 128 + 8 * (kb_) + kk]; const unsigned vo_ = (unsigned)e_ * (unsigned)ROWB + 16u * (unsigned)lane; \
        buf[kk] = *(const GAS v4u*)(V8 + vo_); } __builtin_amdgcn_sched_barrier(0); } while (0)
#ifdef FP4_SOFT_DEC
#define FP4_DEC(x) fp4_dec2(x)
#else
#define FP4_DEC(x) __builtin_amdgcn_cvt_scalef32_pk_f32_fp4((x), 1.0f, 0)
#endif
#ifdef FP4_SWAP_DEC
#define FP4_ACC(oa, ob, d) do { oa += a_ * d.y; ob += a_ * d.x; } while (0)
#else
#define FP4_ACC(oa, ob, d) do { oa += a_ * d.x; ob += a_ * d.y; } while (0)
#endif
#define V_CONSUME(buf, kb_) do { _Pragma("unroll") for (int kk = 0; kk < 8; ++kk) { const float a_ = actl[8 * (kb_) + kk]; \
        const unsigned vw[4] = {buf[kk].x, buf[kk].y, buf[kk].z, buf[kk].w}; \
        _Pragma("unroll") for (int q = 0; q < 4; ++q) { \
            const f32x2 d0 = FP4_DEC(vw[q]), d1 = FP4_DEC(vw[q] >> 8), d2 = FP4_DEC(vw[q] >> 16), d3 = FP4_DEC(vw[q] >> 24); \
            FP4_ACC(o[8 * q], o[8 * q + 1], d0); FP4_ACC(o[8 * q + 2], o[8 * q + 3], d1); FP4_ACC(o[8 * q + 4], o[8 * q + 5], d2); FP4_ACC(o[8 * q + 6], o[8 * q + 7], d3); } \
        PIN16(o, 0); PIN16(o, 16); } } while (0)
#ifndef NO_GATHER
    int e_cur = eidx[w * 128 + c16];
    U_ISSUE(bA, e_cur, 0);
    for (int ti = 0; ti < 4; ++ti) {
        const int tl = w + 8 * ti; const size_t token = (size_t)T0 + tl;
        f32x4 xr[8]; float ss = 0.f;
        const unsigned xo = (unsigned)token * (unsigned)(DM * 4) + 128u * (unsigned)lane;
        { const unsigned char* xp = (const unsigned char*)outp;
#pragma unroll
          for (int j = 0; j < 8; ++j) xr[j] = *(const GAS f32x4*)(xp + (xo + 16u * j));
#pragma unroll
          for (int j = 0; j < 8; ++j) ss += (xr[j].x * xr[j].x + xr[j].y * xr[j].y) + (xr[j].z * xr[j].z + xr[j].w * xr[j].w); }
        const float rs2 = __builtin_amdgcn_rsqf(wave_sum(ss) * (1.f / DM) + EPS);
        {
          const float* fg_ = fgain; asm volatile("" : "+s"(fg_));
          const unsigned char* gp = (const unsigned char*)fg_; const unsigned go = 128u * (unsigned)lane;
#pragma unroll
          for (int j2 = 0; j2 < 4; ++j2) { const f32x4 g0 = *(const GAS f32x4*)(gp + (go + 32u * j2)), g1 = *(const GAS f32x4*)(gp + (go + 32u * j2 + 16u));
              const f32x4 h0 = xr[2 * j2] * g0 * rs2, h1 = xr[2 * j2 + 1] * g1 * rs2; v4u o8; o8.x = pk2(h0.x, h0.y); o8.y = pk2(h0.z, h0.w); o8.z = pk2(h1.x, h1.y); o8.w = pk2(h1.z, h1.w);
              *(LAS v4u*)(hnb + 64 * lane + 16 * j2) = o8; } }
        LDS_WAIT();
#pragma unroll 1
        for (int grp = 0; grp < 8; ++grp) {
            const int gn = grp < 7 ? grp + 1 : 7;
            const int e_nxt = eidx[tl * 128 + 16 * gn + c16];
            f32x4 acc = (f32x4){0.f, 0.f, 0.f, 0.f};
            U_ISSUE(bB, e_cur, 1); U_CONSUME(bA, 0);
            if (grp < 7) U_ISSUE(bA, e_nxt, 0); else V_ISSUE(bA, 0);
            U_CONSUME(bB, 1);
            if (c16 == 0) { const int k0 = 16 * grp + 4 * g; constexpr float isc = 1.f / SU;
                const f32x4 gt = *(const LAS f32x4*)(gate + tl * 128 + k0);
                f32x4 a4; a4.x = gelu_erf(acc.x * isc) * gt.x; a4.y = gelu_erf(acc.y * isc) * gt.y; a4.z = gelu_erf(acc.z * isc) * gt.z; a4.w = gelu_erf(acc.w * isc) * gt.w;
                *(LAS f32x4*)(actl + k0) = a4; }
            e_cur = e_nxt;
        }
        LDS_WAIT();
        float o[32];
#pragma unroll
        for (int i = 0; i < 32; ++i) o[i] = 0.f;
#pragma unroll 1
        for (int kb = 0; kb < 16; kb += 2) {
            V_ISSUE(bB, kb + 1); V_CONSUME(bA, kb);
            if (kb + 2 < 16) V_ISSUE(bA, kb + 2);
            else if (ti < 3) { e_cur = eidx[(tl + 8) * 128 + c16]; U_ISSUE(bA, e_cur, 0); }
            V_CONSUME(bB, kb + 1);
        }
        { constexpr float isv = 1.f / SV; float s2 = 0.f;
          { const unsigned char* xp = (const unsigned char*)outp;
#pragma unroll
            for (int j = 0; j < 8; ++j) xr[j] = *(const GAS f32x4*)(xp + (xo + 16u * j)); }
#pragma unroll
          for (int j = 0; j < 8; ++j) { xr[j] = xr[j] + (f32x4){o[4 * j], o[4 * j + 1], o[4 * j + 2], o[4 * j + 3]} * isv;
              s2 += (xr[j].x * xr[j].x + xr[j].y * xr[j].y) + (xr[j].z * xr[j].z + xr[j].w * xr[j].w); }
          const float rf = __builtin_amdgcn_rsqf(wave_sum(s2) * (1.f / DM) + EPS);
          const float* fi_ = fing; asm volatile("" : "+s"(fi_));
          const unsigned char* fp = (const unsigned char*)fi_; unsigned char* op = (unsigned char*)outp; const unsigned fo = 128u * (unsigned)lane;
          if (!dry || rf == 1.2345e30f)
#pragma unroll
          for (int j = 0; j < 8; ++j) *(GAS f32x4*)(op + (xo + 16u * j)) = xr[j] * rf * *(const GAS f32x4*)(fp + (fo + 16u * j)); }
    }
#endif
#undef U_ISSUE
#undef U_CONSUME
#undef V_ISSUE
#undef V_CONSUME
    __syncthreads();
}

__global__ void __launch_bounds__(NWAVES * 64, 2) hybrid_fwd(Args args) {
    extern __shared__ __attribute__((aligned(16))) unsigned char lds[];
    Frame F;
    F.lds = (LAS unsigned char*)lds;
    F.MISC = (volatile LAS unsigned*)(F.lds + MISC_OFF);
    F.tid = threadIdx.x; F.lane = F.tid & 63; F.wave = __builtin_amdgcn_readfirstlane(F.tid >> 6); F.G = gridDim.x;
    for (int u = F.tid; u < (LDS_BYTES - LDSCTL_OFF) / 4; u += NWAVES * 64) ((LAS unsigned*)(F.lds + LDSCTL_OFF))[u] = 0u;
    __syncthreads();
    (void)args;
    XcdBarrier bar = xcd_barrier_post(F.ctl() + CW_BAR, F.MISC + 8);

#ifndef NO_P0
#ifdef PROBE_P0X2
    { int reps = 2; asm volatile("" : "+s"(reps)); for (int rep = 0; rep < reps; ++rep) p0_prologue(F); }
#else
    p0_prologue(F);
#endif
#endif
    xcd_barrier(bar);
#ifndef NO_P1
#ifdef PROBE_GX2
    { int reps = 2; asm volatile("" : "+s"(reps)); for (int rep = 0; rep < reps; ++rep) {
#else
    { { const int rep = 0, reps = 1;
#endif
      pg8::Gemm gm{F.HN(), F.WinT(), MTOK, NPAD, DM}; pg8::StaticOrder S; S.init(MTOK, NPAD, F.G, (int)blockIdx.x);
      EpiProj E{F.PROJ(), F.dtraw(), (rep + 1 < reps) ? nullptr : F.kmean()};
      pg8::gemm_phase<EpiProj, pg8::StaticOrder, PG8_ALIGN, PG8_SP2>(F.lds + RING_OFF, gm, S, E); } }
#endif
    xcd_barrier(bar);
#ifdef PROBE_P15X2
    conv_phase(F);
#endif
    conv_phase(F);
    xcd_barrier(bar);
#ifdef PROBE_P2X2
    { int reps = 2; asm volatile("" : "+s"(reps)); for (int rep = 0; rep < reps; ++rep) {
#else
    { { const int rep = 0, reps = 1;
#endif
    const bool doatom = rep + 1 == reps;
    for (;;) {
        if (F.tid == 0) F.MISC[0] = xb_add(F.ctl() + CW_Q2 + 64 * rep, 1u);
        __syncthreads();
        const int ui = (int)F.MISC[0];
        __syncthreads();
        if (ui >= 128 + 1024) break;
#ifdef PROBE_P2_SSD
        if (ui < 128 || doatom)
#endif
#ifdef PROBE_P2_ATT
        if (ui >= 128 || doatom)
#endif
        {
        if (ui < 128) ssd_unit(F, ui >> 4, ui & 15, doatom);
        else { const int a = ui - 128; attn_unit(F, (a & 63) >> 3, a & 7, 15 - (a >> 6), doatom); }
        }
    } } }
    xcd_barrier(bar);
#ifndef NO_P25
    mix_normalize(F);
#endif
    xcd_barrier(bar);
#ifndef NO_P3
#ifdef PROBE_GX2
    { int reps = 2; asm volatile("" : "+s"(reps)); for (int rep = 0; rep < reps; ++rep) {
#else
    { { const int rep = 0, reps = 1;
#endif
      pg8::Gemm gm{F.HN(), F.WoutT(), MTOK, DM, DM}; pg8::StaticOrder S; S.init(MTOK, DM, F.G, (int)blockIdx.x);
      EpiOut E{F.x(), F.out(), F.X1B(), (rep + 1 < reps) ? nullptr : F.ssq()};
      pg8::gemm_phase<EpiOut, pg8::StaticOrder, PG8_ALIGN, PG8_SP2>(F.lds + RING_OFF, gm, S, E); } }
#endif
    xcd_barrier(bar);
#ifndef NO_P4
#ifdef PROBE_GX2
    { int reps = 2; asm volatile("" : "+s"(reps)); for (int rep = 0; rep < reps; ++rep) {
#else
    { { const int rep = 0, reps = 1; (void)rep; (void)reps;
#endif
      pg8::Gemm gm{F.X1B(), F.WqT(), MTOK, DM, DM}; pg8::StaticOrder S; S.init(MTOK, DM, F.G, (int)blockIdx.x);
      EpiQ E{F.QP(), F.ssq()};
      pg8::gemm_phase<EpiQ, pg8::StaticOrder, PG8_ALIGN, PG8_SP2>(F.lds + RING_OFF, gm, S, E); } }
#endif
    xcd_barrier(bar);
#ifndef NO_P5
#ifdef PROBE_P5X2
    { int reps = 2; asm volatile("" : "+s"(reps));
      for (int rep = 0; rep < reps; ++rep) for (int u = blockIdx.x; u < MTOK / 32; u += F.G) peer_unit(F, u, rep + 1 < reps); }
#else
    for (int u = blockIdx.x; u < MTOK / 32; u += F.G) peer_unit(F, u);
#endif
#endif
}

extern "C" void kernel_launch(void* const* d_in, const int* in_sizes, int n_in, void* d_out, int out_size, void* d_ws, size_t ws_size, hipStream_t stream) {
    static int grid = 0;
    if (grid == 0) {
        if (n_in != 18 || out_size != MTOK * DM || ws_size < WS_END) { fprintf(stderr, "kernel_launch: unexpected shapes (n_in %d, out %d, ws %zu)\n", n_in, out_size, ws_size); grid = -1; return; }
        int dev = 0, cus = 0, per_cu = 0;
        if (hipGetDevice(&dev) != hipSuccess || hipDeviceGetAttribute(&cus, hipDeviceAttributeMultiprocessorCount, dev) != hipSuccess) { grid = -1; return; }
        if (hipFuncSetAttribute((const void*)hybrid_fwd, hipFuncAttributeMaxDynamicSharedMemorySize, LDS_BYTES) != hipSuccess) { fprintf(stderr, "kernel_launch: hipFuncSetAttribute failed\n"); grid = -1; return; }
        if (hipOccupancyMaxActiveBlocksPerMultiprocessor(&per_cu, (const void*)hybrid_fwd, NWAVES * 64, LDS_BYTES) != hipSuccess || per_cu < 1)
            fprintf(stderr, "kernel_launch: note: occupancy query reports %d workgroups per CU\n", per_cu);
        (void)hipGetLastError();
        grid = cus;
    }
    if (grid < 0) return;
    if (hipMemsetAsync((char*)d_ws + WS_CTL, 0, CTL_ZERO_BYTES, stream) != hipSuccess) return;
    Args a{};
    for (int i = 0; i < 18; ++i) a.in[i] = (const float*)d_in[i];
    a.out = (float*)d_out; a.ws = (unsigned char*)d_ws;
    hipLaunchKernelGGL(hybrid_fwd, dim3(grid), dim3(NWAVES * 64), LDS_BYTES, stream, a);
}
```

```cpp
#include <hip/hip_runtime.h>
#include <cstdio>
#include <cstdint>
namespace pg8 {
#define PG8_LAS __attribute__((address_space(3)))
typedef unsigned short bf16_t;
typedef short bf16x8 __attribute__((ext_vector_type(8)));
typedef float f32x4 __attribute__((ext_vector_type(4)));
typedef unsigned u32x4 __attribute__((ext_vector_type(4)));
constexpr int BM = 256, BK = 64, HALF = 128, HTB = HALF * BK * 2  , STAGE_BYTES = 8 * HTB, NXCD = 8, WGM = 8;

__host__ __device__ __forceinline__ int lds_byte(int r, int c) { const int st = (r >> 4) * 2 + (c >> 5), rr = r & 15, cc = c & 31, ob = rr * 64 + cc * 2; return st * 1024 + (ob ^ (((ob >> 9) & 1) << 5)); }
__host__ __device__ __forceinline__ void stage_rc(int b, int& R, int& C) { const int st = b / 1024, sb = b % 1024, swz = sb ^ (((sb >> 9) & 1) << 5); R = (st >> 1) * 16 + swz / 64; C = (st & 1) * 32 + (swz % 64) / 2; }
__host__ __device__ __forceinline__ int perm32(int rho) { const int n = rho >> 4, i = rho & 15; return 8 * (i >> 2) + 4 * n + (i & 3); }

struct Unit { int pm, pn; };
struct Gemm { const bf16_t* A; const bf16_t* Bt; int M, N, K; };

struct StaticOrder {
    int nM, nN, nwg, G, c;
    __host__ __device__ void init(int M, int N, int G_, int c_) { nM = M / BM; nN = N / BM; nwg = nM * nN; G = G_; c = c_; }
    __host__ __device__ bool next(int i, Unit& u) const {
        const long L = (long)i * G + c; if (L >= nwg) return false;
        int wgid = (int)L; { const int q = nwg / NXCD, r = nwg % NXCD, xcd = wgid % NXCD, off = wgid / NXCD; wgid = (xcd < r ? xcd * (q + 1) : r * (q + 1) + (xcd - r) * q) + off; }
        const int nig = WGM * nN, gid = wgid / nig, fm = gid * WGM, gsz = (nM - fm) < WGM ? (nM - fm) : WGM;
        u.pm = fm + ((wgid % nig) % gsz); u.pn = (wgid % nig) / gsz; return true;
    }
    __device__ __forceinline__ void a_ready(const Unit&) const {}
    __device__ __forceinline__ void done(const Unit&) const {}
};

__device__ __forceinline__ unsigned cvt_pk_bf16(float lo, float hi) { unsigned r; asm volatile("v_cvt_pk_bf16_f32 %0, %1, %2" : "=v"(r) : "v"(lo), "v"(hi)); return r; }
typedef float f32x2 __attribute__((ext_vector_type(2)));
__device__ __forceinline__ f32x2 gelu_pk(f32x2 v) {
    const f32x2 av = __builtin_elementwise_abs(v), d = av * 0.2316418882f + 1.0f;
    f32x2 t; t.x = __builtin_amdgcn_rcpf(d.x); t.y = __builtin_amdgcn_rcpf(d.y);
    f32x2 q = t * 0.5307027145f + (-0.7265760135f); q = q * t + 0.7107068705f; q = q * t + (-0.142248368f); q = q * t + 0.127414796f; q = q * t;
    const f32x2 s = (v * v) * (-0.72134752044f);
    f32x2 e; e.x = __builtin_amdgcn_exp2f(s.x); e.y = __builtin_amdgcn_exp2f(s.y);
    const f32x2 m = v * (q * e), r = v - m;
    f32x2 o; o.x = v.x < 0.f ? m.x : r.x; o.y = v.y < 0.f ? m.y : r.y; return o;
}

template <int ACT  > struct EpiBf16 {
    static constexpr bool PERM = true, AFTER_DRAIN = false, SEG = false; static_assert(ACT == 0 || ACT == 1, "EpiBf16: ACT is 0 (none) or 1 (gelu_pk)");
    bf16_t* O; int ldc; const float* bias; int split_cols; size_t split_stride; float scale0;
    __device__ __forceinline__ void operator()(const f32x4 (&acc)[2][2][4][2], const Unit& u, int wr, int wc, int fr, int fq) const {
        const int row0 = u.pm * BM + wr * 64 + fr; int colt = u.pn * BM; bf16_t* base = O;
        float sc = 1.f; if (split_cols) { const int t = colt / split_cols; base += (size_t)t * split_stride; colt -= t * split_cols; if (t == 0) sc = scale0; }
        const int col0 = colt + wc * 32 + 8 * fq, bcol0 = u.pn * BM + wc * 32 + 8 * fq;
        f32x4 bv[2][2];
#pragma unroll
        for (int bj = 0; bj < 2; ++bj)
#pragma unroll
            for (int n = 0; n < 2; ++n) bv[bj][n] = bias ? *(const f32x4*)(bias + bcol0 + bj * HALF + 4 * n) : (f32x4){0.f, 0.f, 0.f, 0.f};
#pragma unroll
        for (int ai = 0; ai < 2; ++ai)
#pragma unroll
            for (int m = 0; m < 4; ++m) { bf16_t* rowp = base + (size_t)(row0 + ai * HALF + m * 16) * ldc + col0;
#pragma unroll
                for (int bj = 0; bj < 2; ++bj) { f32x4 v0 = acc[ai][bj][m][0] + bv[bj][0], v1 = acc[ai][bj][m][1] + bv[bj][1];
                    if (ACT == 1) { f32x2 a = gelu_pk((f32x2){v0[0], v0[1]}), b = gelu_pk((f32x2){v0[2], v0[3]}), c = gelu_pk((f32x2){v1[0], v1[1]}), d = gelu_pk((f32x2){v1[2], v1[3]});
                        v0 = (f32x4){a.x, a.y, b.x, b.y}; v1 = (f32x4){c.x, c.y, d.x, d.y}; }
                    v0 = v0 * sc; v1 = v1 * sc; u32x4 w; w.x = cvt_pk_bf16(v0[0], v0[1]); w.y = cvt_pk_bf16(v0[2], v0[3]); w.z = cvt_pk_bf16(v1[0], v1[1]); w.w = cvt_pk_bf16(v1[2], v1[3]);
                    *(u32x4*)(rowp + bj * HALF) = w; } }
    }
};
template <class Epi, class Sched, bool ALIGN_EPI = false, bool SP2 = false>
__device__ __forceinline__ void gemm_phase(PG8_LAS unsigned char* lds, const Gemm g, const Sched& S, const Epi& E) {
    const int tid = threadIdx.x, wid = __builtin_amdgcn_readfirstlane(tid >> 6), lane = tid & 63, wr = wid >> 2, wc = wid & 3, fr = lane & 15, fq = lane >> 4;
    const int K = g.K, nt = K / BK;
    unsigned voffA[2], voffB[2];
#pragma unroll
    for (int i = 0; i < 2; ++i) { int R, C; stage_rc(tid * 16 + i * 8192, R, C); const int Rb = Epi::PERM ? ((R & ~31) + perm32(R & 31)) : R;
        voffA[i] = (unsigned)(R * K + C) * 2u; voffB[i] = (unsigned)(Rb * K + C) * 2u; }
    const size_t kstep = (size_t)(BK * 2);
    const size_t hstep = (size_t)HALF * K * 2;
    const size_t tstep = 2 * hstep;
    const unsigned ldsw = (unsigned)wid * 1024u;
    const int aoff = lds_byte(wr * 64 + fr, fq * 8), boff = lds_byte(wc * 32 + fr, fq * 8);
#define PG8_SA(b, h) (((b) * 2 + (h)) * HTB)
#define PG8_SB(b, h) ((4 + (b) * 2 + (h)) * HTB)
#define PG8_STAGE(bufoff, gbase, voff) do { _Pragma("unroll") for (int _i = 0; _i < 2; ++_i) \
        __builtin_amdgcn_global_load_lds((const unsigned*)((const char*)(gbase) + (voff)[_i]), (PG8_LAS unsigned*)(lds + (bufoff) + ldsw + _i * 8192), 16, 0, 0); } while (0)
#define PG8_LDA(dst, b, h) do { _Pragma("unroll") for (int m = 0; m < 4; ++m) _Pragma("unroll") for (int k = 0; k < 2; ++k) dst[m][k] = *(const PG8_LAS bf16x8*)(lds + PG8_SA(b, h) + aoff + m * 2048 + k * 1024); } while (0)
#define PG8_LDB(dst, b, h) do { _Pragma("unroll") for (int n = 0; n < 2; ++n) _Pragma("unroll") for (int k = 0; k < 2; ++k) dst[n][k] = *(const PG8_LAS bf16x8*)(lds + PG8_SB(b, h) + boff + n * 2048 + k * 1024); } while (0)
#define PG8_MMA(ai, bj, At, Bt) do { __builtin_amdgcn_s_setprio(1); _Pragma("unroll") for (int m = 0; m < 4; ++m) _Pragma("unroll") for (int n = 0; n < 2; ++n) _Pragma("unroll") for (int k = 0; k < 2; ++k) \
        acc[ai][bj][m][n] = __builtin_amdgcn_mfma_f32_16x16x32_bf16(Bt[n][k], At[m][k], acc[ai][bj][m][n], 0, 0, 0); __builtin_amdgcn_s_setprio(0); } while (0)
#define PG8_WAIT_V(n) asm volatile("s_waitcnt vmcnt(" #n ")" ::: "memory")
#define PG8_WAIT_L(n) asm volatile("s_waitcnt lgkmcnt(" #n ")" ::: "memory")
#define PG8_BAR __builtin_amdgcn_s_barrier()
#define PG8_SCHED __builtin_amdgcn_sched_barrier(0)
    Unit cur, nxt; int ui = 0;
    if (!S.next(0, cur)) return;
    f32x4 acc[2][2][4][2];
#pragma unroll
    for (int a = 0; a < 2; ++a)
#pragma unroll
        for (int b = 0; b < 2; ++b)
#pragma unroll
            for (int m = 0; m < 4; ++m)
#pragma unroll
                for (int n = 0; n < 2; ++n) acc[a][b][m][n] = (f32x4){0.f, 0.f, 0.f, 0.f};
    bf16x8 At[4][2], B0[2][2], B1[2][2];
    const char* cA = (const char*)g.A + (size_t)cur.pm * tstep; const char* cB = (const char*)g.Bt + (size_t)cur.pn * tstep;
    S.a_ready(cur);
    float segr[16];
    if constexpr (Epi::SEG) E.seg_load(ui, wr, fr, segr);
    if constexpr (SP2) {
        PG8_STAGE(PG8_SB(0, 0), cB, voffB); PG8_STAGE(PG8_SB(0, 1), cB + hstep, voffB); PG8_STAGE(PG8_SA(0, 0), cA, voffA); PG8_STAGE(PG8_SA(0, 1), cA + hstep, voffA);
        if (wr == 1) PG8_BAR;
        PG8_WAIT_V(2); PG8_BAR;
        PG8_STAGE(PG8_SB(1, 0), cB + kstep, voffB); PG8_STAGE(PG8_SA(1, 0), cA + kstep, voffA); PG8_STAGE(PG8_SB(1, 1), cB + hstep + kstep, voffB);
        PG8_WAIT_V(6); PG8_BAR;
    } else {
        PG8_STAGE(PG8_SB(0, 0), cB, voffB); PG8_STAGE(PG8_SA(0, 0), cA, voffA); PG8_STAGE(PG8_SB(0, 1), cB + hstep, voffB); PG8_STAGE(PG8_SA(0, 1), cA + hstep, voffA);
        if (wr == 1) PG8_BAR;
        PG8_WAIT_V(4); PG8_BAR;
        PG8_STAGE(PG8_SB(1, 0), cB + kstep, voffB); PG8_STAGE(PG8_SA(1, 0), cA + kstep, voffA); PG8_STAGE(PG8_SB(1, 1), cB + hstep + kstep, voffB);
        PG8_WAIT_V(6); PG8_BAR;
    }
    for (;;) {
        const bool has_next = S.next(ui + 1, nxt);
        const char* nA = has_next ? (const char*)g.A + (size_t)nxt.pm * tstep : cA; const char* nB = has_next ? (const char*)g.Bt + (size_t)nxt.pn * tstep : cB;
        int t = 0;
#pragma unroll 1
        for (int sgi = 0; sgi < (Epi::SEG ? 3 : 1); ++sgi) {
        int tend = nt; if constexpr (Epi::SEG) tend = (sgi == 0) ? Epi::SEG_T1 : ((sgi == 1) ? Epi::SEG_T2 : nt);
        for (; t < tend; t += 2) {
            const bool last = (t == nt - 2);
            const char* a1 = cA + (size_t)(t + 1) * kstep;
            const char* a2 = last ? nA : cA + (size_t)(t + 2) * kstep; const char* b2 = last ? nB : cB + (size_t)(t + 2) * kstep;
            const char* a3 = a2 + kstep; const char* b3 = b2 + kstep;
            if (last && has_next) S.a_ready(nxt);
            if constexpr (SP2) {
            PG8_LDB(B0, 0, 0); PG8_LDB(B1, 0, 1); PG8_SCHED; PG8_LDA(At, 0, 0); PG8_STAGE(PG8_SA(1, 1), a1 + hstep, voffA);
            PG8_WAIT_V(8); PG8_WAIT_L(0); PG8_BAR; PG8_MMA(0, 0, At, B0); PG8_MMA(0, 1, At, B1); PG8_BAR; PG8_SCHED;
            PG8_LDA(At, 0, 1); PG8_STAGE(PG8_SB(0, 0), b2, voffB); PG8_STAGE(PG8_SB(0, 1), b2 + hstep, voffB); PG8_STAGE(PG8_SA(0, 0), a2, voffA);
            PG8_WAIT_V(8); PG8_WAIT_L(0); PG8_BAR; PG8_MMA(1, 0, At, B0); PG8_MMA(1, 1, At, B1); PG8_BAR; PG8_SCHED;
            PG8_LDB(B0, 1, 0); PG8_LDB(B1, 1, 1); PG8_SCHED; PG8_LDA(At, 1, 0); PG8_STAGE(PG8_SA(0, 1), a2 + hstep, voffA);
            PG8_WAIT_V(8); PG8_WAIT_L(0); PG8_BAR; PG8_MMA(0, 0, At, B0); PG8_MMA(0, 1, At, B1); PG8_BAR; PG8_SCHED;
            PG8_LDA(At, 1, 1); PG8_STAGE(PG8_SB(1, 0), b3, voffB); PG8_STAGE(PG8_SB(1, 1), b3 + hstep, voffB); PG8_STAGE(PG8_SA(1, 0), a3, voffA);
            PG8_WAIT_V(8); PG8_WAIT_L(0); PG8_BAR; PG8_MMA(1, 0, At, B0); PG8_MMA(1, 1, At, B1); PG8_BAR; PG8_SCHED;
            } else {
            PG8_LDB(B0, 0, 0); PG8_SCHED; PG8_LDA(At, 0, 0); PG8_STAGE(PG8_SA(1, 1), a1 + hstep, voffA);
            PG8_WAIT_L(8); PG8_BAR; PG8_WAIT_L(0); PG8_MMA(0, 0, At, B0); PG8_BAR; PG8_SCHED;
            PG8_LDB(B1, 0, 1); PG8_STAGE(PG8_SB(0, 0), b2, voffB);
            PG8_BAR; PG8_WAIT_L(0); PG8_MMA(0, 1, At, B1); PG8_BAR;
            PG8_LDA(At, 0, 1); PG8_STAGE(PG8_SA(0, 0), a2, voffA);
            PG8_BAR; PG8_WAIT_L(0); PG8_MMA(1, 0, At, B0); PG8_BAR; PG8_SCHED;
            PG8_STAGE(PG8_SB(0, 1), b2 + hstep, voffB);
            PG8_WAIT_V(6); PG8_BAR; PG8_MMA(1, 1, At, B1); PG8_BAR;
            PG8_LDB(B0, 1, 0); PG8_SCHED; PG8_LDA(At, 1, 0); PG8_STAGE(PG8_SA(0, 1), a2 + hstep, voffA);
            PG8_WAIT_L(8); PG8_BAR; PG8_WAIT_L(0); PG8_MMA(0, 0, At, B0); PG8_BAR; PG8_SCHED;
            PG8_LDB(B1, 1, 1); PG8_STAGE(PG8_SB(1, 0), b3, voffB);
            PG8_BAR; PG8_WAIT_L(0); PG8_MMA(0, 1, At, B1); PG8_BAR;
            PG8_LDA(At, 1, 1); PG8_STAGE(PG8_SA(1, 0), a3, voffA);
            PG8_BAR; PG8_WAIT_L(0); PG8_MMA(1, 0, At, B0); PG8_BAR; PG8_SCHED;
            PG8_STAGE(PG8_SB(1, 1), b3 + hstep, voffB);
            PG8_WAIT_V(6); PG8_BAR; PG8_MMA(1, 1, At, B1); PG8_BAR;
            }
        }
        if constexpr (Epi::SEG) E.seg_apply(acc, segr, sgi);
        }
        if constexpr (ALIGN_EPI) { if (wr == 0) PG8_BAR; }
        if constexpr (!Epi::AFTER_DRAIN) { if constexpr (Epi::SEG) E(acc, cur, wr, wc, fr, fq, ui); else E(acc, cur, wr, wc, fr, fq); S.done(cur); }
        if (!has_next) break;
#pragma unroll
        for (int a = 0; a < 2; ++a)
#pragma unroll
            for (int b = 0; b < 2; ++b)
#pragma unroll
                for (int m = 0; m < 4; ++m)
#pragma unroll
                    for (int n = 0; n < 2; ++n) acc[a][b][m][n] = (f32x4){0.f, 0.f, 0.f, 0.f};
        cur = nxt; cA = nA; cB = nB; ++ui;
        if constexpr (Epi::SEG) E.seg_load(ui, wr, fr, segr);
        if constexpr (ALIGN_EPI) { if (wr == 1) PG8_BAR; }
    }
    PG8_WAIT_V(0);
    if constexpr (!ALIGN_EPI) { if (wr == 0) PG8_BAR; }
    PG8_BAR;
    if constexpr (Epi::AFTER_DRAIN) { E.fused(acc, cur, wr, wc, fr, fq, lds, wid, lane); S.done(cur); }
#undef PG8_SA
#undef PG8_SB
#undef PG8_STAGE
#undef PG8_LDA
#undef PG8_LDB
#undef PG8_MMA
#undef PG8_WAIT_V
#undef PG8_WAIT_L
#undef PG8_BAR
#undef PG8_SCHED
}
}
#ifndef PG8_SP2
#define PG8_SP2 true
#endif
#ifndef PG8_ALIGN
#define PG8_ALIGN true
#endif

constexpr int BATCH = 8, SEQ = 2048, DM = 2048, MTOK = BATCH * SEQ;
constexpr int ATT_W = 1024, ATT_H = 8, ATT_HD = 128, MOBA_BLK = 256, NBLK = SEQ / MOBA_BLK;
constexpr int SSM_W = 1024, SSM_H = 16, SSM_P = 64, SSM_N = 128, SSM_L = 128, SSM_NC = SEQ / SSM_L, CONV_CH = 1536;
constexpr int IN_PROJ = 5648, NPROJ = 5632  , NPAD = 5888  ;
constexpr int COL_Q = 0, COL_K = 1024, COL_V = 2048, COL_Z = 3072, COL_XBC = 4096;
constexpr int PEER_H = 8, PEER_NK = 128, PEER_K = 16, PEER_HK = 128;
constexpr float EPS = 1e-6f;
constexpr float SU = 64.f, SV = 4.f, SH = 16.f, SLO = 16.f;
constexpr int ROWB = DM / 2;

constexpr size_t MiB = 1u << 20;
constexpr size_t WS_CTL = 0, CTL_ZERO_BYTES = 1 * MiB;
constexpr size_t WS_DT = 1 * MiB;
constexpr size_t WS_SK = 2 * MiB;
constexpr size_t WS_WIN = 4 * MiB;
constexpr size_t WS_WOUT = 28 * MiB;
constexpr size_t WS_WQ = 36 * MiB;
constexpr size_t WS_HN = 44 * MiB;
constexpr size_t WS_PROJ = 108 * MiB;
constexpr size_t WS_X1B = WS_PROJ, WS_QP = WS_PROJ + 64 * MiB;
constexpr size_t WS_U8 = 284 * MiB, WS_V8 = 316 * MiB;
constexpr size_t WS_XBC = 348 * MiB;
constexpr size_t WS_DT2 = 3 * MiB;
constexpr size_t WS_END = 396 * MiB;
constexpr int CW_BAR = 4096;
constexpr int CW_Q2 = 8192;
constexpr int CW_KMEAN = 32768;
constexpr int CW_SSQ = 131072;
static_assert((CW_SSQ + MTOK * 4) * 4 <= (int)CTL_ZERO_BYTES, "CTL words inside the memset region");

constexpr int RING_OFF = 0, RING_BYTES = 131072;
constexpr int LDSCTL_OFF = RING_BYTES, MISC_OFF = LDSCTL_OFF + 320;
constexpr int SEGTAB_OFF = LDSCTL_OFF + 1024;
constexpr int LDS_BYTES = 147456;
constexpr int NWAVES = 8;

#define GAS __attribute__((address_space(1)))
#define LAS __attribute__((address_space(3)))
typedef unsigned short bf16;
typedef unsigned v4u __attribute__((ext_vector_type(4)));
typedef unsigned v2u __attribute__((ext_vector_type(2)));
typedef float f32x4 __attribute__((ext_vector_type(4)));
typedef float f32x2 __attribute__((ext_vector_type(2)));
typedef short bf16x8 __attribute__((ext_vector_type(8)));
typedef short s16x4 __attribute__((ext_vector_type(4)));
typedef GAS unsigned gu32;
#define RLX_AGENT __ATOMIC_RELAXED, __HIP_MEMORY_SCOPE_AGENT
#define LDS_WAIT() asm volatile("s_waitcnt lgkmcnt(0)" ::: "memory")
#define VM_WAIT() asm volatile("s_waitcnt vmcnt(0)" ::: "memory")
__device__ __forceinline__ unsigned f2bf(float f) { unsigned u = __builtin_bit_cast(unsigned, f); return (u + 0x7fffu + ((u >> 16) & 1u)) >> 16; }
typedef __bf16 bf16v2 __attribute__((ext_vector_type(2)));
__device__ __forceinline__ unsigned pk2(float lo, float hi) { bf16v2 v; v.x = (__bf16)lo; v.y = (__bf16)hi; return __builtin_bit_cast(unsigned, v); }
__device__ __forceinline__ float bflo(unsigned w) { return __builtin_bit_cast(float, w << 16); }
__device__ __forceinline__ float bfhi(unsigned w) { return __builtin_bit_cast(float, w & 0xffff0000u); }
__device__ __forceinline__ float wave_sum(float v) {
#pragma unroll
    for (int o = 1; o < 64; o <<= 1) v += __shfl_xor(v, o);
    return v;
}
__device__ __forceinline__ float silu_f(float x) { return x * __builtin_amdgcn_rcpf(1.f + __expf(-x)); }

#define XB_TMO      128
#define XB_XCNT(j)  (256  + 64 * (j))
#define XB_XSUB(j)  (1280 + 64 * (j))
#define XB_XGEN(j)  (2304 + 64 * (j))
#define XB_TOP      3328
#define XB_TOPGEN   3392
#define XCD_BAR_WORDS 3456
#define XB_SPIN_CAP (1u << 18)

__device__ __forceinline__ unsigned xb_ld(unsigned* p)              { return __hip_atomic_load(p, __ATOMIC_RELAXED, __HIP_MEMORY_SCOPE_AGENT); }
__device__ __forceinline__ unsigned xb_add(unsigned* p, unsigned v) { return __hip_atomic_fetch_add(p, v, __ATOMIC_RELAXED, __HIP_MEMORY_SCOPE_AGENT); }
__device__ __forceinline__ unsigned xb_xcc_id() { return (unsigned)__builtin_amdgcn_s_getreg((3 << 11) | 20) & 0xFu; }
#define XB_SPIN(cond, bar) do { unsigned _sp = 0; while (cond) { __builtin_amdgcn_s_sleep(1); \
    if ((++_sp & 255u) == 0u) { if (xb_ld(&(bar)[XB_TMO])) break; if (_sp > XB_SPIN_CAP) { atomicAdd(&(bar)[XB_TMO], 1u); break; } } } } while (0)

struct XcdBarrier {
    unsigned* bar; unsigned x;
    volatile LAS unsigned* st;
};
__device__ __forceinline__ XcdBarrier xcd_barrier_post(unsigned* bar, volatile LAS unsigned* st) {
    XcdBarrier b; b.bar = bar; b.x = xb_xcc_id(); b.st = st;
    if (threadIdx.x == 0) (void)xb_add(&bar[XB_XCNT(b.x)], 1u);
    return b;
}
__device__ __forceinline__ void xcd_barrier_complete(unsigned* bar, unsigned x, unsigned& nloc, unsigned& nx) {
    const unsigned G = gridDim.x * gridDim.y * gridDim.z;
    unsigned sum, cnt, mine, sp = 0u;
    for (;;) {
        sum = 0u; cnt = 0u; mine = 0u;
#pragma unroll
        for (unsigned j = 0; j < 16; ++j) { const unsigned c = xb_ld(&bar[XB_XCNT(j)]); sum += c; cnt += (c > 0u) ? 1u : 0u; mine = (j == x) ? c : mine; }
        if (sum == G) break;
        __builtin_amdgcn_s_sleep(1);
        if ((++sp & 255u) == 0u) { if (xb_ld(&bar[XB_TMO])) break; if (sp > XB_SPIN_CAP) { atomicAdd(&bar[XB_TMO], 1u); break; } }
    }
    nloc = mine > 0u ? mine : 1u; nx = cnt > 0u ? cnt : 1u;
}
__device__ __forceinline__ void xcd_barrier(const XcdBarrier& b) {
    asm volatile("s_waitcnt vmcnt(0)" ::: "memory");
    __syncthreads();
    if (threadIdx.x == 0) {
        unsigned* bar = b.bar;
        __builtin_amdgcn_s_waitcnt(0);
        unsigned nloc = b.st[0], nx = b.st[1];
        if (nloc == 0u) { xcd_barrier_complete(bar, b.x, nloc, nx); b.st[0] = nloc; b.st[1] = nx; }
        const unsigned old = xb_add(&bar[XB_XSUB(b.x)], 1u);
        const unsigned gen = old / nloc;
        if (old + 1u == (gen + 1u) * nloc) {
            __builtin_amdgcn_fence(__ATOMIC_RELEASE, "agent");
            asm volatile("s_waitcnt vmcnt(0)" ::: "memory");
            const unsigned og = xb_add(&bar[XB_TOP], 1u);
            const unsigned tg = og / nx;
            if (og + 1u == (tg + 1u) * nx) xb_add(&bar[XB_TOPGEN], 1u);
            else XB_SPIN(xb_ld(&bar[XB_TOPGEN]) == tg, bar);
            __builtin_amdgcn_fence(__ATOMIC_ACQUIRE, "agent");
            xb_add(&bar[XB_XGEN(b.x)], 1u);
            asm volatile("s_waitcnt vmcnt(0)" ::: "memory");
        } else {
            XB_SPIN(xb_ld(&bar[XB_XGEN(b.x)]) == gen, bar);
            __builtin_amdgcn_fence(__ATOMIC_ACQUIRE, "agent");
            asm volatile("s_waitcnt vmcnt(0)" ::: "memory");
        }
    }
    __syncthreads();
}

#define CAS __attribute__((address_space(4)))
struct Args { const float* in[18]; float* out; unsigned char* ws; };
__device__ __forceinline__ const CAS unsigned char* kargs() { const CAS unsigned char* p = (const CAS unsigned char*)__builtin_amdgcn_kernarg_segment_ptr(); asm volatile("" : "+s"(p)); return p; }
__device__ __forceinline__ const float* kin(int i) { return *(const float* const CAS*)(kargs() + 8 * i); }
__device__ __forceinline__ float* kout() { return *(float* const CAS*)(kargs() + 8 * 18); }
__device__ __forceinline__ unsigned char* kws() { return *(unsigned char* const CAS*)(kargs() + 8 * 19); }
__device__ __forceinline__ int fresh_tid() { int t = threadIdx.x; asm volatile("" : "+v"(t)); return t; }
struct Frame {
    LAS unsigned char* lds;
    volatile LAS unsigned* MISC;
    int tid, lane, wave, G;
    __device__ __forceinline__ const float* x() const { return kin(0); }
    __device__ __forceinline__ const float* attn_norm() const { return kin(1); }
    __device__ __forceinline__ const float* w_in() const { return kin(2); }
    __device__ __forceinline__ const float* conv_w() const { return kin(3); }
    __device__ __forceinline__ const float* conv_b() const { return kin(4); }
    __device__ __forceinline__ const float* dt_bias() const { return kin(5); }
    __device__ __forceinline__ const float* a_log() const { return kin(6); }
    __device__ __forceinline__ const float* d_skip() const { return kin(7); }
    __device__ __forceinline__ const float* rel_bias() const { return kin(8); }
    __device__ __forceinline__ const float* attn_out_norm() const { return kin(9); }
    __device__ __forceinline__ const float* ssm_out_norm() const { return kin(10); }
    __device__ __forceinline__ const float* w_out() const { return kin(11); }
    __device__ __forceinline__ const float* ffn_norm() const { return kin(12); }
    __device__ __forceinline__ const float* peer_wq() const { return kin(13); }
    __device__ __forceinline__ const float* peer_sk() const { return kin(14); }
    __device__ __forceinline__ const float* peer_u() const { return kin(15); }
    __device__ __forceinline__ const float* peer_v() const { return kin(16); }
    __device__ __forceinline__ const float* final_norm() const { return kin(17); }
    __device__ __forceinline__ float* out() const { return kout(); }
    __device__ __forceinline__ unsigned* ctl() const { return (unsigned*)(kws() + WS_CTL); }
    __device__ __forceinline__ float* dtraw() const { return (float*)(kws() + WS_DT); }
    __device__ __forceinline__ bf16* SK() const { return (bf16*)(kws() + WS_SK); }
    __device__ __forceinline__ bf16* WinT() const { return (bf16*)(kws() + WS_WIN); }
    __device__ __forceinline__ bf16* WoutT() const { return (bf16*)(kws() + WS_WOUT); }
    __device__ __forceinline__ bf16* WqT() const { return (bf16*)(kws() + WS_WQ); }
    __device__ __forceinline__ bf16* HN() const { return (bf16*)(kws() + WS_HN); }
    __device__ __forceinline__ bf16* PROJ() const { return (bf16*)(kws() + WS_PROJ); }
    __device__ __forceinline__ bf16* X1B() const { return (bf16*)(kws() + WS_X1B); }
    __device__ __forceinline__ bf16* QP() const { return (bf16*)(kws() + WS_QP); }
    __device__ __forceinline__ unsigned char* U8() const { return kws() + WS_U8; }
    __device__ __forceinline__ unsigned char* V8() const { return kws() + WS_V8; }
    __device__ __forceinline__ bf16* XBC() const { return (bf16*)(kws() + WS_XBC); }
    __device__ __forceinline__ float* DT2() const { return (float*)(kws() + WS_DT2); }
    __device__ __forceinline__ float* kmean() const { return (float*)(kws() + WS_CTL) + CW_KMEAN; }
    __device__ __forceinline__ float* ssq() const { return (float*)(kws() + WS_CTL) + CW_SSQ; }
};

__device__ __forceinline__ void p0_transpose_item(const float* W, int K, int N, bf16* WT, const float* gain, LAS float* scr, int item, int lane) {
    const int nblk = (N + 31) / 32, kb = item / nblk, nb = item % nblk, k0 = 64 * kb, n0 = 32 * nb;
    const int kr = lane >> 3, nc = (lane & 7) * 4; const bool ok = (n0 + nc) < N;
    f32x4 v[8]; float gk[8];
#pragma unroll
    for (int i = 0; i < 8; ++i) { const int kk = 8 * i + kr; v[i] = ok ? *(const GAS f32x4*)(W + (size_t)(k0 + kk) * N + n0 + nc) : (f32x4){0.f, 0.f, 0.f, 0.f}; gk[i] = gain ? gain[k0 + kk] : 1.f; }
#pragma unroll
    for (int i = 0; i < 8; ++i) { const int kk = 8 * i + kr; LAS float* d = scr + kk * 33 + nc; d[0] = v[i].x * gk[i]; d[1] = v[i].y * gk[i]; d[2] = v[i].z * gk[i]; d[3] = v[i].w * gk[i]; }
    LDS_WAIT(); asm volatile("" ::: "memory");
    const int c = lane & 7;
#pragma unroll
    for (int j = 0; j < 4; ++j) { const int n = (lane >> 3) + 8 * j; const LAS float* s = scr + (8 * c) * 33 + n;
        v4u o; o.x = pk2(s[0 * 33], s[1 * 33]); o.y = pk2(s[2 * 33], s[3 * 33]); o.z = pk2(s[4 * 33], s[5 * 33]); o.w = pk2(s[6 * 33], s[7 * 33]);
        *(GAS v4u*)(WT + (size_t)(n0 + n) * K + k0 + 8 * c) = o; }
    LDS_WAIT(); asm volatile("" ::: "memory");
}
__device__ __forceinline__ void rms_2rows_to_bf16(const float* x0, const float* x1, const float* gain, bf16* o0, bf16* o1, int lane) {
    const GAS f32x4* xr0 = (const GAS f32x4*)x0 + lane; const GAS f32x4* xr1 = (const GAS f32x4*)x1 + lane; const GAS f32x4* gr = (const GAS f32x4*)gain + lane;
    f32x4 v[8], u[8]; float s = 0.f, t = 0.f;
#pragma unroll
    for (int j = 0; j < 8; ++j) { v[j] = xr0[64 * j]; u[j] = xr1[64 * j]; }
#pragma unroll
    for (int j = 0; j < 8; ++j) { s += (v[j].x * v[j].x + v[j].y * v[j].y) + (v[j].z * v[j].z + v[j].w * v[j].w); t += (u[j].x * u[j].x + u[j].y * u[j].y) + (u[j].z * u[j].z + u[j].w * u[j].w); }
    const float rs = __builtin_amdgcn_rsqf(wave_sum(s) * (1.f / DM) + EPS), rt = __builtin_amdgcn_rsqf(wave_sum(t) * (1.f / DM) + EPS);
    GAS v2u* p0 = (GAS v2u*)o0 + lane; GAS v2u* p1 = (GAS v2u*)o1 + lane;
#pragma unroll
    for (int j = 0; j < 8; ++j) { const f32x4 g = gr[64 * j]; v2u a, b;
        a.x = pk2(v[j].x * rs * g.x, v[j].y * rs * g.y); a.y = pk2(v[j].z * rs * g.z, v[j].w * rs * g.w); p0[64 * j] = a;
        b.x = pk2(u[j].x * rt * g.x, u[j].y * rt * g.y); b.y = pk2(u[j].z * rt * g.z, u[j].w * rt * g.w); p1[64 * j] = b; }
}
#ifdef PROBE_FP4EMU
__device__ __forceinline__ float fp4grid(float y) { const float a = fabsf(y); float r;
    if (a <= 2.f) r = rintf(a * 2.f) * 0.5f; else if (a <= 4.f) r = rintf(a); else r = (a < 5.f) ? 4.f : 6.f;
    return copysignf(r, y); }
__device__ __forceinline__ float clampf(float v, float lim) { if (lim == 448.5f) return fp4grid(v * (1.f / 16.f)) * 16.f; return fminf(fmaxf(v, -lim), lim); }
#else
__device__ __forceinline__ float clampf(float v, float lim) { return fminf(fmaxf(v, -lim), lim); }
#endif
template <int TAB = 0> __device__ __forceinline__ v4u cvt16_fp8(const f32x4 a, const f32x4 b, const f32x4 c, const f32x4 d, float sc) {
    v4u o; int w; constexpr float LIM = TAB ? 448.5f : 448.f;
    w = __builtin_amdgcn_cvt_pk_fp8_f32(clampf(a.x * sc, LIM), clampf(a.y * sc, LIM), 0, false); w = __builtin_amdgcn_cvt_pk_fp8_f32(clampf(a.z * sc, LIM), clampf(a.w * sc, LIM), w, true); o.x = (unsigned)w;
    w = __builtin_amdgcn_cvt_pk_fp8_f32(clampf(b.x * sc, LIM), clampf(b.y * sc, LIM), 0, false); w = __builtin_amdgcn_cvt_pk_fp8_f32(clampf(b.z * sc, LIM), clampf(b.w * sc, LIM), w, true); o.y = (unsigned)w;
    w = __builtin_amdgcn_cvt_pk_fp8_f32(clampf(c.x * sc, LIM), clampf(c.y * sc, LIM), 0, false); w = __builtin_amdgcn_cvt_pk_fp8_f32(clampf(c.z * sc, LIM), clampf(c.w * sc, LIM), w, true); o.z = (unsigned)w;
    w = __builtin_amdgcn_cvt_pk_fp8_f32(clampf(d.x * sc, LIM), clampf(d.y * sc, LIM), 0, false); w = __builtin_amdgcn_cvt_pk_fp8_f32(clampf(d.z * sc, LIM), clampf(d.w * sc, LIM), w, true); o.w = (unsigned)w;
    return o;
}
__device__ __forceinline__ unsigned fp4_code(float y) { const float a = fabsf(y);
    const unsigned m = (unsigned)(a >= 0.25f) + (unsigned)(a >= 0.75f) + (unsigned)(a >= 1.25f) + (unsigned)(a >= 1.75f) + (unsigned)(a >= 2.5f) + (unsigned)(a >= 3.5f) + (unsigned)(a >= 5.0f);
    return m | ((y < 0.f) ? 8u : 0u); }
__device__ __forceinline__ void p0_prologue(Frame& F) {
    const int tid = fresh_tid(), lane = tid & 63, wave = __builtin_amdgcn_readfirstlane(tid >> 6);
    LAS float* scr = (LAS float*)(F.lds + RING_OFF + wave * 16384);
    const int gw = blockIdx.x * NWAVES + wave, NGW = F.G * NWAVES;
    constexpr int I_IN = (DM / 64) * ((IN_PROJ + 31) / 32), I_SQ = (DM / 64) * (DM / 32);
    constexpr int NITEMS = I_IN + 2 * I_SQ;
    { const float* const w_in = F.w_in(); const float* const w_out = F.w_out(); const float* const wq = F.peer_wq(); const float* const fg = F.ffn_norm(); bf16* const WinT = F.WinT(); bf16* const WoutT = F.WoutT(); bf16* const WqT = F.WqT(); const float* const gatt = F.attn_out_norm(); const float* const gssm = F.ssm_out_norm();
      for (int it = gw; it < NITEMS; it += NGW) {
        int r = it;
        if (r < I_IN) { p0_transpose_item(w_in, DM, IN_PROJ, WinT, nullptr, scr, r, lane); continue; } r -= I_IN;
        if (r < I_SQ) { const int k0_ = 64 * (r / (DM / 32)); p0_transpose_item(w_out, DM, DM, WoutT, (k0_ < ATT_W) ? gatt : (gssm - ATT_W), scr, r, lane); continue; } r -= I_SQ;
        p0_transpose_item(wq, DM, DM, WqT, fg, scr, r, lane);
      } }
    const size_t gt = (size_t)blockIdx.x * (NWAVES * 64) + tid, GT = (size_t)F.G * NWAVES * 64;
    { const size_t z0 = (size_t)5664 * DM / 8, z1 = (size_t)NPAD * DM / 8; GAS v4u* p = (GAS v4u*)F.WinT(); for (size_t i = z0 + gt; i < z1; i += GT) p[i] = (v4u){0u, 0u, 0u, 0u}; }
    { const GAS f32x4* s = (const GAS f32x4*)F.peer_sk(); GAS v2u* d = (GAS v2u*)F.SK(); for (size_t i = gt; i < (size_t)16 * 128 * 128 / 4; i += GT) { const f32x4 v = s[i]; v2u o; o.x = pk2(v.x, v.y); o.y = pk2(v.z, v.w); d[i] = o; } }
    { const float* const xg = F.x(); const float* const gn = F.attn_norm(); bf16* const hn = F.HN();
      for (int m = gw; m < MTOK / 2; m += NGW) rms_2rows_to_bf16(xg + (size_t)(2 * m) * DM, xg + (size_t)(2 * m + 1) * DM, gn, hn + (size_t)(2 * m) * DM, hn + (size_t)(2 * m + 1) * DM, lane); }
    { const size_t n32 = (size_t)16384 * DM / 32;
      const GAS f32x4* su = (const GAS f32x4*)F.peer_u(); const GAS f32x4* sv = (const GAS f32x4*)F.peer_v(); GAS v4u* du = (GAS v4u*)F.U8(); GAS v4u* dv = (GAS v4u*)F.V8();
#pragma unroll 1
      for (int tab = 0; tab < 2; ++tab) { const GAS f32x4* src = tab ? sv : su; GAS v4u* dst = tab ? dv : du; const float sc = tab ? SV : SU;
        f32x4 nx[8];
        if (gt < n32) {
#pragma unroll
            for (int j = 0; j < 8; ++j) nx[j] = src[8 * gt + j]; }
#pragma unroll 1
        for (size_t i = gt; i < n32; i += GT) { f32x4 v[8];
#pragma unroll
            for (int j = 0; j < 8; ++j) v[j] = nx[j];
            if (i + GT < n32) {
#pragma unroll
                for (int j = 0; j < 8; ++j) nx[j] = src[8 * (i + GT) + j]; }
            unsigned wd[4];
#pragma unroll
            for (int q = 0; q < 4; ++q) { const f32x4 a = v[2 * q] * sc, b = v[2 * q + 1] * sc; unsigned w = 0u;
                w = __builtin_amdgcn_cvt_scalef32_pk_fp4_f32(w, clampf(a.x, 6.f), clampf(a.y, 6.f), 1.0f, 0); w = __builtin_amdgcn_cvt_scalef32_pk_fp4_f32(w, clampf(a.z, 6.f), clampf(a.w, 6.f), 1.0f, 1);
                w = __builtin_amdgcn_cvt_scalef32_pk_fp4_f32(w, clampf(b.x, 6.f), clampf(b.y, 6.f), 1.0f, 2); w = __builtin_amdgcn_cvt_scalef32_pk_fp4_f32(w, clampf(b.z, 6.f), clampf(b.w, 6.f), 1.0f, 3); wd[q] = w; }
            dst[i] = (v4u){wd[0], wd[1], wd[2], wd[3]}; } } }
}

struct EpiProj {
    static constexpr bool PERM = true, AFTER_DRAIN = false, SEG = false;
    bf16* O; float* dtraw; float* kmean;
    __device__ __forceinline__ void operator()(const pg8::f32x4 (&acc)[2][2][4][2], const pg8::Unit& u, int wr, int wc, int fr, int fq) const {
        const int row0 = u.pm * 256 + wr * 64 + fr, col0 = u.pn * 256 + wc * 32 + 8 * fq;
        if (u.pn < 22) {
#pragma unroll
            for (int ai = 0; ai < 2; ++ai)
#pragma unroll
                for (int m = 0; m < 4; ++m) { bf16* rowp = O + (size_t)(row0 + ai * 128 + m * 16) * NPROJ + col0;
#pragma unroll
                    for (int bj = 0; bj < 2; ++bj) { const pg8::f32x4 v0 = acc[ai][bj][m][0], v1 = acc[ai][bj][m][1];
                        pg8::u32x4 w; w.x = pg8::cvt_pk_bf16(v0[0], v0[1]); w.y = pg8::cvt_pk_bf16(v0[2], v0[3]); w.z = pg8::cvt_pk_bf16(v1[0], v1[1]); w.w = pg8::cvt_pk_bf16(v1[2], v1[3]);
                        *(pg8::u32x4*)(rowp + bj * 128) = w; } }
        } else if (wc == 0 && fq < 2) {
#pragma unroll
            for (int ai = 0; ai < 2; ++ai)
#pragma unroll
                for (int m = 0; m < 4; ++m) { float* rp = dtraw + (size_t)(row0 + ai * 128 + m * 16) * 16 + 8 * fq;
                    *(pg8::f32x4*)rp = acc[ai][0][m][0]; *(pg8::f32x4*)(rp + 4) = acc[ai][0][m][1]; }
        }
        if (kmean && u.pn >= 4 && u.pn < 8) {
#pragma unroll
            for (int bj = 0; bj < 2; ++bj)
#pragma unroll
                for (int n = 0; n < 2; ++n)
#pragma unroll
                    for (int i = 0; i < 4; ++i) { float s = 0.f;
#pragma unroll
                        for (int ai = 0; ai < 2; ++ai)
#pragma unroll
                            for (int m = 0; m < 4; ++m) s += acc[ai][bj][m][n][i];
                        s += __shfl_xor(s, 1); s += __shfl_xor(s, 2); s += __shfl_xor(s, 4); s += __shfl_xor(s, 8);
                        if (fr == 0) unsafeAtomicAdd(kmean + (size_t)u.pm * 1024 + (col0 - 1024) + bj * 128 + 4 * n + i, s); }
        }
    }
};
struct EpiOut {
    static constexpr bool PERM = true, AFTER_DRAIN = false, SEG = true; static constexpr int SEG_T1 = 16, SEG_T2 = 24;
    const float* x; bf16* x1b; float* ssq; bool doatom; const LAS f32x4* tab;
    __device__ __forceinline__ void seg_load(int ui, int wr, int fr, float (&sr)[16]) const {
#pragma unroll
        for (int i = 0; i < 8; ++i) { const int r = (i >> 2) * 128 + wr * 64 + (i & 3) * 16 + fr; const f32x2 q = *(const LAS f32x2*)(tab + (ui & 1) * 256 + r); sr[2 * i] = q.x; sr[2 * i + 1] = q.y; }
        asm volatile("s_waitcnt lgkmcnt(0)" ::: "memory");
    }
    __device__ __forceinline__ void seg_apply(pg8::f32x4 (&acc)[2][2][4][2], const float (&sr)[16], int which) const {
#pragma unroll
        for (int ai = 0; ai < 2; ++ai)
#pragma unroll
            for (int m = 0; m < 4; ++m) { const float f = (which == 0) ? sr[2 * (ai * 4 + m)] : ((which == 1) ? sr[2 * (ai * 4 + m) + 1] : 1.0f);
#pragma unroll
                for (int bj = 0; bj < 2; ++bj)
#pragma unroll
                    for (int n = 0; n < 2; ++n) acc[ai][bj][m][n] = acc[ai][bj][m][n] * f; }
    }
    __device__ __forceinline__ void operator()(const pg8::f32x4 (&acc)[2][2][4][2], const pg8::Unit& u, int wr, int wc, int fr, int fq, int ui) const {
        const int row0 = u.pm * 256 + wr * 64 + fr, col0 = u.pn * 256 + wc * 32 + 8 * fq;
#pragma unroll
        for (int ai = 0; ai < 2; ++ai)
#pragma unroll
            for (int m = 0; m < 4; ++m) { const int row = row0 + ai * 128 + m * 16; const size_t off = (size_t)row * DM + col0; float s = 0.f;
                const float s1 = (*(const LAS f32x4*)(tab + (ui & 1) * 256 + ai * 128 + wr * 64 + m * 16 + fr)).z;
#pragma unroll
                for (int bj = 0; bj < 2; ++bj) {
                    const pg8::f32x4 a0 = *(const pg8::f32x4*)(x + off + bj * 128), a1 = *(const pg8::f32x4*)(x + off + bj * 128 + 4);
                    const pg8::f32x4 v0 = acc[ai][bj][m][0] * s1 + a0, v1 = acc[ai][bj][m][1] * s1 + a1;
                    pg8::u32x4 w; w.x = pg8::cvt_pk_bf16(v0[0], v0[1]); w.y = pg8::cvt_pk_bf16(v0[2], v0[3]); w.z = pg8::cvt_pk_bf16(v1[0], v1[1]); w.w = pg8::cvt_pk_bf16(v1[2], v1[3]);
                    *(pg8::u32x4*)(x1b + off + bj * 128) = w;
                    s += (v0[0] * v0[0] + v0[1] * v0[1]) + (v0[2] * v0[2] + v0[3] * v0[3]) + (v1[0] * v1[0] + v1[1] * v1[1]) + (v1[2] * v1[2] + v1[3] * v1[3]); }
                s += __shfl_xor(s, 16); s += __shfl_xor(s, 32);
                if (fq == 0 && doatom) unsafeAtomicAdd(ssq + (size_t)row * 4, s);
                asm volatile("" ::: "memory"); }
    }
};
struct EpiQ {
    static constexpr bool PERM = true, AFTER_DRAIN = false, SEG = false;
    bf16* O; const float* ssq;
    __device__ __forceinline__ void operator()(const pg8::f32x4 (&acc)[2][2][4][2], const pg8::Unit& u, int wr, int wc, int fr, int fq) const {
        const int row0 = u.pm * 256 + wr * 64 + fr, col0 = u.pn * 256 + wc * 32 + 8 * fq;
#pragma unroll
        for (int ai = 0; ai < 2; ++ai)
#pragma unroll
            for (int m = 0; m < 4; ++m) { const int row = row0 + ai * 128 + m * 16; bf16* rowp = O + (size_t)row * DM + col0;
                const float rs = 1.f / sqrtf(__hip_atomic_load(ssq + (size_t)row * 4, RLX_AGENT) * (1.f / DM) + EPS);
#pragma unroll
                for (int bj = 0; bj < 2; ++bj) { const pg8::f32x4 v0 = acc[ai][bj][m][0] * rs, v1 = acc[ai][bj][m][1] * rs;
                    pg8::u32x4 w; w.x = pg8::cvt_pk_bf16(v0[0], v0[1]); w.y = pg8::cvt_pk_bf16(v0[2], v0[3]); w.z = pg8::cvt_pk_bf16(v1[0], v1[1]); w.w = pg8::cvt_pk_bf16(v1[2], v1[3]);
                    *(pg8::u32x4*)(rowp + bj * 128) = w; } }
    }
};

constexpr int A_KSTR = 272, A_VSTR = 288;
constexpr int A_KB0 = 0, A_KB1 = 64 * A_KSTR, A_VB0 = 2 * 64 * A_KSTR, A_VB1 = A_VB0 + 64 * A_VSTR, A_KM = A_VB1 + 64 * A_VSTR, A_TAB = A_KM + 8 * 128 * 4, A_END = A_TAB + 128 * 4;
static_assert(A_END <= RING_BYTES && (A_KM % 16) == 0, "attention LDS map");
#define TR16(p) __builtin_amdgcn_ds_read_tr16_b64_v4i16((LAS s16x4*)(p))
#define MFMA16(a, b, c) __builtin_amdgcn_mfma_f32_16x16x32_bf16((a), (b), (c), 0, 0, 0)
__device__ __forceinline__ bf16x8 pack8(const float* v) {
    const unsigned a = pk2(v[0], v[1]), b = pk2(v[2], v[3]), c = pk2(v[4], v[5]), d = pk2(v[6], v[7]);
    const v4u u = {a, b, c, d}; return __builtin_bit_cast(bf16x8, u);
}
__device__ __forceinline__ void attn_unit(Frame& F, int b, int h, int qt, const bool doatom = true) {
    LAS unsigned char* lds = F.lds + RING_OFF;
    const int tid = fresh_tid(), lane = tid & 63, w = __builtin_amdgcn_readfirstlane(tid >> 6), g = lane >> 4, c16 = lane & 15, q4 = c16 >> 2, p4 = lane & 3;
    const int own = qt >> 1, t0 = qt * 128, tq = t0 + 16 * w + c16;
    const size_t rowbase = (size_t)b * SEQ;
    const float NEG_INF = -__builtin_inff();
    constexpr float LOG2E = 1.4426950408889634f, SCL2 = 0.08838834764831845f * 1.4426950408889634f;
    LAS float* km = (LAS float*)(lds + A_KM); LAS float* tab = (LAS float*)(lds + A_TAB);
    const bf16* const PROJ = F.PROJ(); const float* const kmg = F.kmean(); const float* const relb = F.rel_bias();
    for (int i = tid; i < own * 128; i += NWAVES * 64) { const int n = i >> 7, d = i & 127; km[i] = kmg[(size_t)(b * 8 + n) * 1024 + h * 128 + d] * (1.f / 256.f); }
    if (tid < 128) { const int rel = tid; int bucket = rel; if (rel >= 16) { bucket = 16 + (int)(log2f((float)rel * (1.f / 16.f)) * (16.f / 3.f)); bucket = bucket > 31 ? 31 : bucket; }
        tab[tid] = relb[bucket * 8 + h] * LOG2E; }
    bf16x8 qf[4];
    { const bf16* qrow = PROJ + (rowbase + tq) * NPROJ + COL_Q + h * 128 + 8 * g;
#pragma unroll
      for (int ks = 0; ks < 4; ++ks) qf[ks] = *(const GAS bf16x8*)(qrow + 32 * ks); }
    __syncthreads();
    unsigned selmask;
    if (own <= 3) selmask = (1u << own) - 1u;
    else {
        float gate[7];
#pragma unroll
        for (int n = 0; n < 7; ++n) {
            float s = NEG_INF;
            if (n < own) { s = 0.f;
#pragma unroll
                for (int ks = 0; ks < 4; ++ks) { const LAS f32x4* kp = (const LAS f32x4*)(km + n * 128 + 32 * ks + 8 * g); const f32x4 k0 = kp[0], k1 = kp[1]; const v4u qu = __builtin_bit_cast(v4u, qf[ks]);
                    s += bflo(qu.x) * k0.x + bfhi(qu.x) * k0.y + bflo(qu.y) * k0.z + bfhi(qu.y) * k0.w + bflo(qu.z) * k1.x + bfhi(qu.z) * k1.y + bflo(qu.w) * k1.z + bfhi(qu.w) * k1.w; }
                s += __shfl_xor(s, 16); s += __shfl_xor(s, 32); }
            gate[n] = s;
        }
        selmask = 0u;
#pragma unroll
        for (int r = 0; r < 3; ++r) { float best = NEG_INF; int bi = 0;
#pragma unroll
            for (int n = 0; n < 7; ++n) { const bool cand = (n < own) && !((selmask >> n) & 1u) && (gate[n] > best); best = cand ? gate[n] : best; bi = cand ? n : bi; }
            selmask |= 1u << bi; }
    }
    const int nt_own = (qt & 1) ? 4 : 2, nT = nt_own + 4 * own;
    const int sr = tid >> 3, sc = (tid & 7) * 16;
#define A_KEY0(i) ((i) < nt_own ? own * 256 + 64 * (i) : (((i) - nt_own) >> 2) * 256 + (((i) - nt_own) & 3) * 64)
    v4u kr0, kr1, vr0, vr1;
#define A_LOAD(i) do { const bf16* kp_ = PROJ + (rowbase + A_KEY0(i) + sr) * NPROJ + COL_K + h * 128 + sc; \
        kr0 = *(const GAS v4u*)kp_; kr1 = *(const GAS v4u*)(kp_ + 8); vr0 = *(const GAS v4u*)(kp_ + (COL_V - COL_K)); vr1 = *(const GAS v4u*)(kp_ + (COL_V - COL_K) + 8); } while (0)
#define A_STORE(bufi) do { LAS unsigned char* kd_ = lds + ((bufi) ? A_KB1 : A_KB0) + sr * A_KSTR + sc * 2; LAS unsigned char* vd_ = lds + ((bufi) ? A_VB1 : A_VB0) + sr * A_VSTR + sc * 2; \
        *(LAS v4u*)kd_ = kr0; *(LAS v4u*)(kd_ + 16) = kr1; *(LAS v4u*)vd_ = vr0; *(LAS v4u*)(vd_ + 16) = vr1; } while (0)
    A_LOAD(0); A_STORE(0);
    __syncthreads();
    float m_run = NEG_INF, l_run = 0.f;
    f32x4 oacc[8];
#pragma unroll
    for (int db = 0; db < 8; ++db) oacc[db] = (f32x4){0.f, 0.f, 0.f, 0.f};
    for (int i = 0; i < nT; ++i) {
        if (i + 1 < nT) A_LOAD(i + 1);
        const int buf = i & 1, key0 = A_KEY0(i); const bool isown = i < nt_own; const int blk = isown ? own : ((i - nt_own) >> 2);
        LAS unsigned char* Kb = lds + (buf ? A_KB1 : A_KB0); LAS unsigned char* Vb = lds + (buf ? A_VB1 : A_VB0);
        f32x4 sacc[4];
        { bf16x8 kf[16];
#pragma unroll
          for (int nb = 0; nb < 4; ++nb)
#pragma unroll
              for (int ks = 0; ks < 4; ++ks) kf[nb * 4 + ks] = *(const LAS bf16x8*)(Kb + (16 * nb + c16) * A_KSTR + (32 * ks + 8 * g) * 2);
          __builtin_amdgcn_sched_barrier(0);
#pragma unroll
          for (int nb = 0; nb < 4; ++nb) { sacc[nb] = (f32x4){0.f, 0.f, 0.f, 0.f};
#pragma unroll
              for (int ks = 0; ks < 4; ++ks) sacc[nb] = MFMA16(kf[nb * 4 + ks], qf[ks], sacc[nb]); } }
        s16x4 vlo[8], vhi[8];
#pragma unroll
        for (int db = 0; db < 8; ++db) { LAS unsigned char* va = Vb + (4 * g + q4) * A_VSTR + (16 * db + 4 * p4) * 2; vlo[db] = TR16(va); vhi[db] = TR16(va + 16 * A_VSTR); }
        __builtin_amdgcn_sched_barrier(0);
        const bool sel = isown || ((selmask >> blk) & 1u);
        const bool far = (key0 + 63 + 128 <= t0 + 16 * w);
        float sv[16]; float mloc, m_new, alpha;
        if (far) {
            const float bfar = tab[127];
            float mx = fmaxf(fmaxf(sacc[0][0], sacc[0][1]), fmaxf(sacc[0][2], sacc[0][3]));
#pragma unroll
            for (int nb = 1; nb < 4; ++nb) mx = fmaxf(mx, fmaxf(fmaxf(sacc[nb][0], sacc[nb][1]), fmaxf(sacc[nb][2], sacc[nb][3])));
            mloc = sel ? (mx * SCL2 + bfar) : NEG_INF;
            mloc = fmaxf(mloc, __shfl_xor(mloc, 16)); mloc = fmaxf(mloc, __shfl_xor(mloc, 32));
            m_new = fmaxf(m_run, mloc); alpha = __builtin_amdgcn_exp2f(m_run - m_new);
            const float cadd = sel ? (bfar - m_new) : NEG_INF;
#pragma unroll
            for (int nb = 0; nb < 4; ++nb)
#pragma unroll
                for (int r = 0; r < 4; ++r) sv[nb * 4 + r] = __builtin_amdgcn_exp2f(sacc[nb][r] * SCL2 + cadd);
        } else {
            const bool diag = isown && (key0 + 63 > t0 + 16 * w);
            mloc = NEG_INF;
#pragma unroll
            for (int nb = 0; nb < 4; ++nb)
#pragma unroll
                for (int r = 0; r < 4; ++r) { const int rel = tq - (key0 + 16 * nb + 4 * g + r); int ri = rel < 0 ? 0 : rel; ri = ri > 127 ? 127 : ri;
                    float s = sacc[nb][r] * SCL2 + tab[ri]; s = (!sel || (diag && rel < 0)) ? NEG_INF : s; sv[nb * 4 + r] = s; mloc = fmaxf(mloc, s); }
            mloc = fmaxf(mloc, __shfl_xor(mloc, 16)); mloc = fmaxf(mloc, __shfl_xor(mloc, 32));
            m_new = fmaxf(m_run, mloc); alpha = __builtin_amdgcn_exp2f(m_run - m_new);
#pragma unroll
            for (int e = 0; e < 16; ++e) sv[e] = __builtin_amdgcn_exp2f(sv[e] - m_new);
        }
        float psum = 0.f;
#pragma unroll
        for (int e = 0; e < 16; ++e) psum += sv[e];
        l_run = l_run * alpha + psum; m_run = m_new;
#pragma unroll
        for (int db = 0; db < 8; ++db) oacc[db] = oacc[db] * alpha;
        __builtin_amdgcn_sched_barrier(0);
        { const bf16x8 pf0 = pack8(sv), pf1 = pack8(sv + 8);
          s16x4 wlo[8], whi[8];
#pragma unroll
          for (int db = 0; db < 8; ++db) { LAS unsigned char* va = Vb + (32 + 4 * g + q4) * A_VSTR + (16 * db + 4 * p4) * 2; wlo[db] = TR16(va); whi[db] = TR16(va + 16 * A_VSTR); }
          __builtin_amdgcn_sched_barrier(0);
#pragma unroll
          for (int db = 0; db < 8; ++db) { const bf16x8 vf = __builtin_shufflevector(vlo[db], vhi[db], 0, 1, 2, 3, 4, 5, 6, 7); oacc[db] = MFMA16(vf, pf0, oacc[db]); }
#pragma unroll
          for (int db = 0; db < 8; ++db) { const bf16x8 vf = __builtin_shufflevector(wlo[db], whi[db], 0, 1, 2, 3, 4, 5, 6, 7); oacc[db] = MFMA16(vf, pf1, oacc[db]); } }
        if (i + 1 < nT) A_STORE((i + 1) & 1);
        __syncthreads();
    }
    float l_tot = l_run; l_tot += __shfl_xor(l_tot, 16); l_tot += __shfl_xor(l_tot, 32);
    const float inv = 1.f / l_tot; float ssq = 0.f;
    bf16* orow = F.HN() + (rowbase + tq) * DM + h * 128 + 4 * g;
#pragma unroll
    for (int db = 0; db < 8; ++db) { const f32x4 o = oacc[db] * inv; ssq += (o.x * o.x + o.y * o.y) + (o.z * o.z + o.w * o.w); v2u wv; wv.x = pk2(o.x, o.y); wv.y = pk2(o.z, o.w); *(GAS v2u*)(orow + 16 * db) = wv; }
    ssq += __shfl_xor(ssq, 16); ssq += __shfl_xor(ssq, 32);
    if (g == 0 && doatom) unsafeAtomicAdd(F.ssq() + (rowbase + tq) * 4 + 1, ssq);
#undef A_KEY0
#undef A_LOAD
#undef A_STORE
}

constexpr int XBC_W = CONV_CH;
__device__ __forceinline__ void conv_phase(Frame& F) {
    const bf16* const PROJ = F.PROJ(); bf16* const XBC = F.XBC(); const float* const cw = F.conv_w(); const float* const cb = F.conv_b();
    const int gt = blockIdx.x * (NWAVES * 64) + fresh_tid(), GT = F.G * NWAVES * 64;
    for (int task = gt; task < (MTOK / 32) * (CONV_CH / 8); task += GT) {
        const int r = task / (CONV_CH / 8), k = task % (CONV_CH / 8), ch = 8 * k, tok0 = 32 * r;
        float wv[4][8], bias[8];
#pragma unroll
        for (int t = 0; t < 4; ++t) { const f32x4 w0 = *(const GAS f32x4*)(cw + t * CONV_CH + ch), w1 = *(const GAS f32x4*)(cw + t * CONV_CH + ch + 4);
            wv[t][0] = w0.x; wv[t][1] = w0.y; wv[t][2] = w0.z; wv[t][3] = w0.w; wv[t][4] = w1.x; wv[t][5] = w1.y; wv[t][6] = w1.z; wv[t][7] = w1.w; }
        { const f32x4 b0 = *(const GAS f32x4*)(cb + ch), b1 = *(const GAS f32x4*)(cb + ch + 4); bias[0] = b0.x; bias[1] = b0.y; bias[2] = b0.z; bias[3] = b0.w; bias[4] = b1.x; bias[5] = b1.y; bias[6] = b1.z; bias[7] = b1.w; }
        const bf16* src = PROJ + (size_t)tok0 * NPROJ + COL_XBC + ch; bf16* dst = XBC + (size_t)tok0 * XBC_W + ch;
        v4u p0 = (v4u){0u, 0u, 0u, 0u}, p1 = p0, p2 = p0;
        if ((tok0 & (SEQ - 1)) != 0) { p0 = *(const GAS v4u*)(src - 3 * (ptrdiff_t)NPROJ); p1 = *(const GAS v4u*)(src - 2 * (ptrdiff_t)NPROJ); p2 = *(const GAS v4u*)(src - (ptrdiff_t)NPROJ); }
#pragma unroll 1
        for (int i0 = 0; i0 < 32; i0 += 8) {
            v4u cur[8];
#pragma unroll
            for (int i = 0; i < 8; ++i) cur[i] = *(const GAS v4u*)(src + (size_t)(i0 + i) * NPROJ);
#pragma unroll
            for (int i = 0; i < 8; ++i) {
                const v4u c = cur[i]; float acc[8];
                const unsigned a0[4] = {p0.x, p0.y, p0.z, p0.w}, a1[4] = {p1.x, p1.y, p1.z, p1.w}, a2[4] = {p2.x, p2.y, p2.z, p2.w}, a3[4] = {c.x, c.y, c.z, c.w};
#pragma unroll
                for (int j = 0; j < 4; ++j) {
                    acc[2 * j] = bias[2 * j] + wv[0][2 * j] * bflo(a0[j]) + wv[1][2 * j] * bflo(a1[j]) + wv[2][2 * j] * bflo(a2[j]) + wv[3][2 * j] * bflo(a3[j]);
                    acc[2 * j + 1] = bias[2 * j + 1] + wv[0][2 * j + 1] * bfhi(a0[j]) + wv[1][2 * j + 1] * bfhi(a1[j]) + wv[2][2 * j + 1] * bfhi(a2[j]) + wv[3][2 * j + 1] * bfhi(a3[j]); }
#pragma unroll
                for (int j = 0; j < 8; ++j) acc[j] = silu_f(acc[j]);
                v4u o; o.x = pk2(acc[0], acc[1]); o.y = pk2(acc[2], acc[3]); o.z = pk2(acc[4], acc[5]); o.w = pk2(acc[6], acc[7]);
                *(GAS v4u*)(dst + (size_t)(i0 + i) * XBC_W) = o;
                p0 = p1; p1 = p2; p2 = c; }
        }
    }
    { const float* const dtraw = F.dtraw(); float* const dt2 = F.DT2(); const float* const dtb = F.dt_bias();
      for (int i = gt; i < MTOK * 16; i += GT) { const float xr = dtraw[i] + dtb[i & 15]; dt2[i] = xr > 20.f ? xr : log1pf(__expf(xr)); } }
}

constexpr int S_BSTR = 272, S_XSTR = 144;
constexpr int S_BM = 0, S_CM = 128 * S_BSTR, S_X = 2 * 128 * S_BSTR, S_XW = S_X + 128 * S_XSTR, S_HB = S_XW + 128 * S_XSTR, S_DT = S_HB + 64 * S_BSTR, S_CS = S_DT + 512, S_DA = S_CS + 512, S_END = S_DA + 512;
static_assert(S_END <= RING_BYTES, "ssd LDS map");
__device__ __forceinline__ void ssd_unit(Frame& F, int b, int h, const bool doatom = true) {
    LAS unsigned char* lds = F.lds + RING_OFF;
    const int tid = fresh_tid(), lane = tid & 63, w = __builtin_amdgcn_readfirstlane(tid >> 6), g = lane >> 4, c16 = lane & 15, q4 = c16 >> 2, p4 = lane & 3;
    const int g8 = h >> 3, pbw = w & 3, nhw = w >> 2;
    const float a_h = -__expf(F.a_log()[h]), dsk = F.d_skip()[h];
    const bf16* const PROJ = F.PROJ(); bf16* const MIX = F.HN(); const float* const dt2 = F.DT2(); const bf16* const XBC = F.XBC(); float* const ssqp = F.ssq();
    LAS float* dtl = (LAS float*)(lds + S_DT); LAS float* csl = (LAS float*)(lds + S_CS); LAS float* dal = (LAS float*)(lds + S_DA);
    for (int i = tid; i < 64 * S_BSTR / 16; i += NWAVES * 64) ((LAS v4u*)(lds + S_HB))[i] = (v4u){0u, 0u, 0u, 0u};
    f32x4 hacc[4];
#pragma unroll
    for (int i = 0; i < 4; ++i) hacc[i] = (f32x4){0.f, 0.f, 0.f, 0.f};
    const int xl = tid >> 3, xc = tid & 7, bl = tid >> 4, bc = tid & 15;
    v4u xr[2], br[4], cr[4]; float dtv = 0.f;
#define S_PREFETCH(cc) do { const size_t t0_ = (size_t)b * SEQ + (size_t)(cc) * SSM_L; \
        _Pragma("unroll") for (int i_ = 0; i_ < 2; ++i_) xr[i_] = *(const GAS v4u*)(XBC + (t0_ + xl + 64 * i_) * XBC_W + h * 64 + 8 * xc); \
        _Pragma("unroll") for (int i_ = 0; i_ < 4; ++i_) { const bf16* p_ = XBC + (t0_ + bl + 32 * i_) * XBC_W + 1024 + g8 * 128 + 8 * bc; br[i_] = *(const GAS v4u*)p_; cr[i_] = *(const GAS v4u*)(p_ + 256); } \
        if (tid < 128) dtv = dt2[(t0_ + tid) * 16 + h]; } while (0)
    S_PREFETCH(0);
    for (int c = 0; c < SSM_NC; ++c) {
        const size_t tok0 = (size_t)b * SEQ + (size_t)c * SSM_L;
        if (tid < 128) { dtl[tid] = dtv; dal[tid] = dtv * a_h; }
        __syncthreads();
        if (w == 0) { const float v0 = dal[2 * lane], v1 = dal[2 * lane + 1]; float s = v0 + v1;
#pragma unroll
            for (int o = 1; o < 64; o <<= 1) { const float t = __shfl_up(s, o); s += (lane >= o) ? t : 0.f; }
            csl[2 * lane] = s - v1; csl[2 * lane + 1] = s; }
        __syncthreads();
        const float cs_last = csl[127];
#pragma unroll
        for (int i = 0; i < 2; ++i) { const int l = xl + 64 * i; const v4u v = xr[i]; *(LAS v4u*)(lds + S_X + l * S_XSTR + xc * 16) = v; const float wl = dtl[l] * __expf(cs_last - csl[l]);
            v4u o2; o2.x = pk2(bflo(v.x) * wl, bfhi(v.x) * wl); o2.y = pk2(bflo(v.y) * wl, bfhi(v.y) * wl); o2.z = pk2(bflo(v.z) * wl, bfhi(v.z) * wl); o2.w = pk2(bflo(v.w) * wl, bfhi(v.w) * wl);
            *(LAS v4u*)(lds + S_XW + l * S_XSTR + xc * 16) = o2; }
#pragma unroll
        for (int i = 0; i < 4; ++i) { const int l = bl + 32 * i; *(LAS v4u*)(lds + S_BM + l * S_BSTR + bc * 16) = br[i]; *(LAS v4u*)(lds + S_CM + l * S_BSTR + bc * 16) = cr[i]; }
        const int lrow = 16 * w + c16;
        v2u zr[4];
#pragma unroll
        for (int pb = 0; pb < 4; ++pb) zr[pb] = *(const GAS v2u*)(PROJ + (tok0 + lrow) * NPROJ + COL_Z + h * 64 + 16 * pb + 4 * g);
        if (c + 1 < SSM_NC) S_PREFETCH(c + 1);
        __syncthreads();
        bf16x8 cf[4];
#pragma unroll
        for (int ks = 0; ks < 4; ++ks) cf[ks] = *(const LAS bf16x8*)(lds + S_CM + lrow * S_BSTR + (32 * ks + 8 * g) * 2);
        f32x4 yacc[4];
        const float cs_l = csl[lrow]; const float el = __expf(cs_l);
#pragma unroll
        for (int pb = 0; pb < 4; ++pb) { yacc[pb] = (f32x4){0.f, 0.f, 0.f, 0.f};
#pragma unroll
            for (int ks = 0; ks < 4; ++ks) { const bf16x8 hf = *(const LAS bf16x8*)(lds + S_HB + (16 * pb + c16) * S_BSTR + (32 * ks + 8 * g) * 2); yacc[pb] = MFMA16(hf, cf[ks], yacc[pb]); }
            yacc[pb] = yacc[pb] * el; }
        for (int s2 = 0; s2 <= (w >> 1); ++s2) {
            const int sb0 = 2 * s2, sb1 = 2 * s2 + 1; const bool has1 = sb1 <= w;
            f32x4 cb0 = (f32x4){0.f, 0.f, 0.f, 0.f}, cb1 = (f32x4){0.f, 0.f, 0.f, 0.f};
#pragma unroll
            for (int ks = 0; ks < 4; ++ks) { const bf16x8 bf0 = *(const LAS bf16x8*)(lds + S_BM + (16 * sb0 + c16) * S_BSTR + (32 * ks + 8 * g) * 2); cb0 = MFMA16(bf0, cf[ks], cb0); }
            if (has1) {
#pragma unroll
                for (int ks = 0; ks < 4; ++ks) { const bf16x8 bf1 = *(const LAS bf16x8*)(lds + S_BM + (16 * sb1 + c16) * S_BSTR + (32 * ks + 8 * g) * 2); cb1 = MFMA16(bf1, cf[ks], cb1); } }
            float mv[8];
#pragma unroll
            for (int r = 0; r < 4; ++r) { const int s = 16 * sb0 + 4 * g + r; const float e = __expf(fminf(cs_l - csl[s], 0.f)) * dtl[s]; mv[r] = (s <= lrow) ? cb0[r] * e : 0.f; }
#pragma unroll
            for (int r = 0; r < 4; ++r) { const int s = 16 * sb1 + 4 * g + r; const int sc_ = s > 127 ? 127 : s; const float e = __expf(fminf(cs_l - csl[sc_], 0.f)) * dtl[sc_]; mv[4 + r] = (has1 && s <= lrow) ? cb1[r] * e : 0.f; }
            const bf16x8 pf = pack8(mv);
#pragma unroll
            for (int pb = 0; pb < 4; ++pb) { LAS unsigned char* xa = lds + S_X + (32 * s2 + 4 * g + q4) * S_XSTR + (16 * pb + 4 * p4) * 2;
                const s16x4 lo = TR16(xa), hi = TR16(xa + 16 * S_XSTR); const bf16x8 xf = __builtin_shufflevector(lo, hi, 0, 1, 2, 3, 4, 5, 6, 7);
                yacc[pb] = MFMA16(xf, pf, yacc[pb]); }
        }
        { const size_t tok = tok0 + lrow; float ssq = 0.f;
#pragma unroll
          for (int pb = 0; pb < 4; ++pb) { const int p0 = 16 * pb + 4 * g;
              const v2u xs_ = *(const LAS v2u*)(lds + S_X + lrow * S_XSTR + p0 * 2);
              const v2u zr_ = zr[pb];
              const float o0 = (yacc[pb].x + bflo(xs_.x) * dsk) * silu_f(bflo(zr_.x)), o1 = (yacc[pb].y + bfhi(xs_.x) * dsk) * silu_f(bfhi(zr_.x));
              const float o2 = (yacc[pb].z + bflo(xs_.y) * dsk) * silu_f(bflo(zr_.y)), o3 = (yacc[pb].w + bfhi(xs_.y) * dsk) * silu_f(bfhi(zr_.y));
              ssq += (o0 * o0 + o1 * o1) + (o2 * o2 + o3 * o3);
              v2u wv; wv.x = pk2(o0, o1); wv.y = pk2(o2, o3); *(GAS v2u*)(MIX + tok * DM + ATT_W + h * 64 + p0) = wv; }
          ssq += __shfl_xor(ssq, 16); ssq += __shfl_xor(ssq, 32);
          if (g == 0 && doatom) unsafeAtomicAdd(ssqp + tok * 4 + 2 + g8, ssq); }
        { const float cdec = __expf(cs_last);
#pragma unroll
          for (int i = 0; i < 4; ++i) hacc[i] = hacc[i] * cdec;
#pragma unroll
          for (int ks = 0; ks < 4; ++ks) {
              LAS unsigned char* xa = lds + S_XW + (32 * ks + 8 * g + q4) * S_XSTR + (16 * pbw + 4 * p4) * 2;
              const s16x4 xlo = TR16(xa), xhi = TR16(xa + 4 * S_XSTR); const bf16x8 xf = __builtin_shufflevector(xlo, xhi, 0, 1, 2, 3, 4, 5, 6, 7);
#pragma unroll
              for (int i = 0; i < 4; ++i) { const int nb = 4 * nhw + i; LAS unsigned char* ba = lds + S_BM + (32 * ks + 8 * g + q4) * S_BSTR + (16 * nb + 4 * p4) * 2;
                  const s16x4 blo = TR16(ba), bhi = TR16(ba + 4 * S_BSTR); const bf16x8 bfr = __builtin_shufflevector(blo, bhi, 0, 1, 2, 3, 4, 5, 6, 7);
                  hacc[i] = MFMA16(bfr, xf, hacc[i]); } } }
        __syncthreads();
#pragma unroll
        for (int i = 0; i < 4; ++i) { const int nb = 4 * nhw + i; v2u o; o.x = pk2(hacc[i].x, hacc[i].y); o.y = pk2(hacc[i].z, hacc[i].w);
            *(LAS v2u*)(lds + S_HB + (16 * pbw + c16) * S_BSTR + (16 * nb + 4 * g) * 2) = o; }
    }
#undef S_PREFETCH
    __syncthreads();
}

__device__ __forceinline__ void mix_normalize(Frame& F) {
    const int tid_ = fresh_tid(), lane = tid_ & 63; const int gw = blockIdx.x * NWAVES + __builtin_amdgcn_readfirstlane(tid_ >> 6), NGW = F.G * NWAVES;
    const float* const ssqp = F.ssq(); bf16* const MIX = F.HN(); const float* const gatt = F.attn_out_norm(); const float* const gssm = F.ssm_out_norm();
    for (int m = gw; m < MTOK; m += NGW) {
        const float* sq = ssqp + (size_t)m * 4;
        const float s1 = __hip_atomic_load(sq + 1, RLX_AGENT), s2 = __hip_atomic_load(sq + 2, RLX_AGENT), s3 = __hip_atomic_load(sq + 3, RLX_AGENT);
        const float ra = 1.f / sqrtf(s1 * (1.f / 1024.f) + EPS), r0 = 1.f / sqrtf(s2 * (1.f / 512.f) + EPS), r1 = 1.f / sqrtf(s3 * (1.f / 512.f) + EPS);
        GAS v4u* row = (GAS v4u*)(MIX + (size_t)m * DM);
#pragma unroll
        for (int j = 0; j < 4; ++j) { const int idx = lane + 64 * j, col = 8 * idx; const float rs = (j < 2) ? ra : ((j == 2) ? r0 : r1);
            const float* gp = (j < 2) ? (gatt + col) : (gssm + (col - ATT_W));
            const f32x4 g0 = *(const GAS f32x4*)gp, g1 = *(const GAS f32x4*)(gp + 4); const v4u v = row[idx]; v4u o;
            o.x = pk2(bflo(v.x) * rs * g0.x, bfhi(v.x) * rs * g0.y); o.y = pk2(bflo(v.y) * rs * g0.z, bfhi(v.y) * rs * g0.w);
            o.z = pk2(bflo(v.z) * rs * g1.x, bfhi(v.z) * rs * g1.y); o.w = pk2(bflo(v.w) * rs * g1.z, bfhi(v.w) * rs * g1.w); row[idx] = o; }
    }
}

constexpr int P_EIDX = 0, P_GATE = 16384, P_LST = 32768, P_HN = 65536, P_ACT = 98304, P_END = 102400;
static_assert(P_END <= RING_BYTES, "peer LDS map");
__constant__ unsigned char PEER_CAND[52] = {0, 1, 2, 3, 4, 5, 6, 7, 8, 9, 10, 11, 12, 13, 14, 15, 16, 17, 18, 19, 20, 21, 22, 23, 32, 33, 34, 35, 36, 48, 49, 50, 51, 64, 65, 66, 80, 81, 96, 97, 112, 113, 128, 144, 160, 176, 192, 208, 224, 240, 255, 255};
__device__ __forceinline__ unsigned f2ord(float f) { const unsigned u = __builtin_bit_cast(unsigned, f); return u ^ ((u >> 31) ? 0xFFFFFFFFu : 0x80000000u); }
__device__ __forceinline__ float ord2f(unsigned u) { return __builtin_bit_cast(float, u ^ ((u >> 31) ? 0x80000000u : 0xFFFFFFFFu)); }
#define CSWAPD(a, b) do { const unsigned hi_ = (a) > (b) ? (a) : (b), lo_ = (a) > (b) ? (b) : (a); (a) = hi_; (b) = lo_; } while (0)
template <int N> __device__ __forceinline__ void bitonic_sort_desc(unsigned (&v)[N]) {
#pragma unroll
    for (int k = 2; k <= N; k <<= 1)
#pragma unroll
        for (int j = k >> 1; j > 0; j >>= 1)
#pragma unroll
            for (int i = 0; i < N; ++i) { const int l = i ^ j; if (l > i) { if ((i & k) == 0) CSWAPD(v[i], v[l]); else CSWAPD(v[l], v[i]); } }
}
__device__ __forceinline__ void merge16_xor(unsigned (&v)[16], int dist) {
    unsigned o[16];
#pragma unroll
    for (int i = 0; i < 16; ++i) o[i] = (unsigned)__shfl_xor((int)v[i], dist);
#pragma unroll
    for (int i = 0; i < 16; ++i) v[i] = v[i] > o[15 - i] ? v[i] : o[15 - i];
#pragma unroll
    for (int j = 8; j > 0; j >>= 1)
#pragma unroll
        for (int i = 0; i < 16; ++i) { const int l = i ^ j; if (l > i) CSWAPD(v[i], v[l]); }
}
__device__ __forceinline__ float gelu_erf(float x) { return 0.5f * x * (1.f + erff(x * 0.70710678118654752f)); }
__device__ __forceinline__ float fp4_dec1(unsigned n) { const unsigned m = n & 7u; unsigned bits = (m >= 2u) ? (((126u + (m >> 1)) << 23) | ((m & 1u) << 22)) : (m ? 0x3F000000u : 0u); bits |= (n & 8u) << 28; return __builtin_bit_cast(float, bits); }
__device__ __forceinline__ f32x2 fp4_dec2(unsigned x) { f32x2 r; r.x = fp4_dec1(x & 15u); r.y = fp4_dec1((x >> 4) & 15u); return r; }
typedef long i64;
typedef int v8i __attribute__((ext_vector_type(8)));
__device__ __forceinline__ void peer_unit(Frame& F, int u, const bool dry = false) {
    LAS unsigned char* lds = F.lds + RING_OFF;
    const int tid_ = fresh_tid(), lane = tid_ & 63, w = __builtin_amdgcn_readfirstlane(tid_ >> 6), g = lane >> 4, c16 = lane & 15;
    const int T0 = 32 * u;
    LAS int* eidx = (LAS int*)(lds + P_EIDX); LAS float* gate = (LAS float*)(lds + P_GATE);
    LAS unsigned* lst = (LAS unsigned*)(lds + P_LST) + w * 1024;
    const bf16* const QP = F.QP(); const bf16* const SK = F.SK(); float* const outp = F.out(); const bf16* const X1B = F.X1B(); const float* const fgain = F.ffn_norm(); const float* const fing = F.final_norm(); const unsigned char* const U8 = F.U8(); const unsigned char* const V8 = F.V8();
#ifndef NO_ROUTE
    for (int tb = 0; tb < 2; ++tb) {
        for (int c = 0; c < 2; ++c) {
            const int p = 2 * w + c;
            bf16x8 qf[4];
            { const unsigned qo = ((unsigned)(T0 + 16 * tb + c16) * (unsigned)DM + (unsigned)(p * 128 + 8 * g)) * 2u;
#pragma unroll
              for (int ks = 0; ks < 4; ++ks) qf[ks] = *(const GAS bf16x8*)((const unsigned char*)QP + (qo + 64u * ks)); }
            unsigned key[32];
#pragma unroll
            for (int kb = 0; kb < 8; ++kb) { f32x4 acc = (f32x4){0.f, 0.f, 0.f, 0.f};
                const unsigned so = ((unsigned)(p * 128 + 16 * kb + c16) * 128u + 8u * (unsigned)g) * 2u;
#pragma unroll
                for (int ks = 0; ks < 4; ++ks) { const bf16x8 sf = *(const GAS bf16x8*)((const unsigned char*)SK + (so + 64u * ks)); acc = MFMA16(sf, qf[ks], acc); }
#pragma unroll
                for (int r = 0; r < 4; ++r) key[kb * 4 + r] = (f2ord(acc[r]) & ~0x7Fu) | (unsigned)(16 * kb + 4 * g + r);
                __builtin_amdgcn_sched_barrier(0); }
            bitonic_sort_desc<32>(key);
            unsigned top[16];
#pragma unroll
            for (int i = 0; i < 16; ++i) top[i] = key[i];
            merge16_xor(top, 16); merge16_xor(top, 32);
            if (g == 0) { LAS v4u* d = (LAS v4u*)(lst + (c * 32 + 16 * tb + c16) * 16);
                d[0] = (v4u){top[0], top[1], top[2], top[3]}; d[1] = (v4u){top[4], top[5], top[6], top[7]}; d[2] = (v4u){top[8], top[9], top[10], top[11]}; d[3] = (v4u){top[12], top[13], top[14], top[15]}; }
        }
        LDS_WAIT();
        const LAS unsigned* l1 = lst + (16 * tb + c16) * 16; const LAS unsigned* l2 = lst + (32 + 16 * tb + c16) * 16;
        unsigned ck[16];
#pragma unroll
        for (int k = 0; k < 13; ++k) { const unsigned ab = PEER_CAND[4 * k + g]; const unsigned a = ab >> 4, bq = ab & 15u;
            const float s = ord2f(l1[a] & ~0x7Fu) + ord2f(l2[bq] & ~0x7Fu); ck[k] = (ab == 255u) ? 0u : ((f2ord(s) & ~0xFFu) | ab); }
        ck[13] = 0u; ck[14] = 0u; ck[15] = 0u;
        bitonic_sort_desc<16>(ck);
        merge16_xor(ck, 16); merge16_xor(ck, 32);
        if (g == 0) { const int tl = 16 * tb + c16; const float m = ord2f(ck[0] & ~0xFFu); float e[16]; float sum = 0.f;
#pragma unroll
            for (int k = 0; k < 16; ++k) { e[k] = __expf(ord2f(ck[k] & ~0xFFu) - m); sum += e[k]; }
            const float inv = 1.f / sum;
#pragma unroll
            for (int k = 0; k < 16; ++k) { const unsigned a = (ck[k] >> 4) & 15u, bq = ck[k] & 15u; const int ex = (int)((l1[a] & 0x7Fu) * 128u + (l2[bq] & 0x7Fu));
                eidx[tl * 128 + w * 16 + k] = ex; gate[tl * 128 + w * 16 + k] = e[k] * inv; } }
    }
#endif
    __syncthreads();
    LAS unsigned char* hnb = lds + P_HN + w * 4096; LAS float* actl = (LAS float*)(lds + P_ACT) + w * 128;
    const LAS unsigned char* hb = hnb + 64 * g;
    v4u bA[16], bB[16];
#define PIN16(a, i) asm volatile("" : "+v"(a[i]), "+v"(a[i + 1]), "+v"(a[i + 2]), "+v"(a[i + 3]), "+v"(a[i + 4]), "+v"(a[i + 5]), "+v"(a[i + 6]), "+v"(a[i + 7]), "+v"(a[i + 8]), "+v"(a[i + 9]), "+v"(a[i + 10]), "+v"(a[i + 11]), "+v"(a[i + 12]), "+v"(a[i + 13]), "+v"(a[i + 14]), "+v"(a[i + 15]))
#define U_ISSUE(buf, e_) do { const unsigned uo_ = (unsigned)(e_) * (unsigned)ROWB + 16u * (unsigned)g; \
        _Pragma("unroll") for (int jj = 0; jj < 16; ++jj) buf[jj] = *(const GAS v4u*)(U8 + (uo_ + 64u * jj)); __builtin_amdgcn_sched_barrier(0); } while (0)
#define U_CONSUME(buf) do { _Pragma("unroll") for (int jj = 0; jj < 16; ++jj) { const v4u a_ = buf[jj]; const unsigned aw_[4] = {a_.x, a_.y, a_.z, a_.w}; \
        _Pragma("unroll") for (int m = 0; m < 4; ++m) { \
            const v4u af_ = {__builtin_bit_cast(unsigned, __builtin_amdgcn_cvt_scalef32_pk_bf16_fp4(aw_[m], 1.0f, 0)), __builtin_bit_cast(unsigned, __builtin_amdgcn_cvt_scalef32_pk_bf16_fp4(aw_[m], 1.0f, 1)), \
                             __builtin_bit_cast(unsigned, __builtin_amdgcn_cvt_scalef32_pk_bf16_fp4(aw_[m], 1.0f, 2)), __builtin_bit_cast(unsigned, __builtin_amdgcn_cvt_scalef32_pk_bf16_fp4(aw_[m], 1.0f, 3))}; \
            const bf16x8 bf_ = *(const LAS bf16x8*)(hb + 256 * jj + 16 * m); \
            acc = MFMA16(__builtin_bit_cast(bf16x8, af_), bf_, acc); } } __builtin_amdgcn_sched_barrier(0); } while (0)
#define U_ACT(grp_) do { if (c16 == 0) { const int k0 = 16 * (grp_) + 4 * g; constexpr float isc = 1.f / SU; const f32x4 gt = *(const LAS f32x4*)(gate + tl * 128 + k0); \
        f32x4 a4; a4.x = gelu_erf(acc.x * isc) * gt.x; a4.y = gelu_erf(acc.y * isc) * gt.y; a4.z = gelu_erf(acc.z * isc) * gt.z; a4.w = gelu_erf(acc.w * isc) * gt.w; *(LAS f32x4*)(actl + k0) = a4; } } while (0)
#define V_ISSUE(buf, kb_) do { _Pragma("unroll") for (int kk = 0; kk < 16; ++kk) { const int e_ = eidx[tl * 128 + 16 * (kb_) + kk]; const unsigned vo_ = (unsigned)e_ * (unsigned)ROWB + 16u * (unsigned)lane; \
        buf[kk] = *(const GAS v4u*)(V8 + vo_); } __builtin_amdgcn_sched_barrier(0); } while (0)
#ifdef FP4_SOFT_DEC
#define FP4_DEC(x) fp4_dec2(x)
#else
#define FP4_DEC(x) __builtin_amdgcn_cvt_scalef32_pk_f32_fp4((x), 1.0f, 0)
#endif
#ifdef FP4_SWAP_DEC
#define FP4_ACC(oa, ob, d) do { oa += a_ * d.y; ob += a_ * d.x; } while (0)
#else
#define FP4_ACC(oa, ob, d) do { oa += a_ * d.x; ob += a_ * d.y; } while (0)
#endif
#define V_CONSUME(buf, kb_) do { _Pragma("unroll") for (int kk = 0; kk < 16; ++kk) { const float a_ = actl[16 * (kb_) + kk]; \
        const unsigned vw[4] = {buf[kk].x, buf[kk].y, buf[kk].z, buf[kk].w}; \
        _Pragma("unroll") for (int q = 0; q < 4; ++q) { \
            const f32x2 d0 = __builtin_amdgcn_cvt_scalef32_pk_f32_fp4(vw[q], 1.0f, 0), d1 = __builtin_amdgcn_cvt_scalef32_pk_f32_fp4(vw[q], 1.0f, 1), d2 = __builtin_amdgcn_cvt_scalef32_pk_f32_fp4(vw[q], 1.0f, 2), d3 = __builtin_amdgcn_cvt_scalef32_pk_f32_fp4(vw[q], 1.0f, 3); \
            FP4_ACC(o[8 * q], o[8 * q + 1], d0); FP4_ACC(o[8 * q + 2], o[8 * q + 3], d1); FP4_ACC(o[8 * q + 4], o[8 * q + 5], d2); FP4_ACC(o[8 * q + 6], o[8 * q + 7], d3); } \
        PIN16(o, 0); PIN16(o, 16); } } while (0)
#ifndef NO_GATHER
    int e_cur = eidx[w * 128 + c16];
    U_ISSUE(bA, e_cur);
    for (int ti = 0; ti < 4; ++ti) {
        const int tl = w + 8 * ti; const size_t token = (size_t)T0 + tl;
        f32x4 xr[8]; float ss = 0.f;
        const unsigned xo = (unsigned)token * (unsigned)(DM * 4) + 128u * (unsigned)lane;
        { const unsigned char* xp = (const unsigned char*)X1B; const unsigned xb = (unsigned)token * (unsigned)(DM * 2) + 64u * (unsigned)lane;
#pragma unroll
          for (int j = 0; j < 4; ++j) { const v4u r = *(const GAS v4u*)(xp + (xb + 16u * j)); xr[2 * j] = (f32x4){bflo(r.x), bfhi(r.x), bflo(r.y), bfhi(r.y)}; xr[2 * j + 1] = (f32x4){bflo(r.z), bfhi(r.z), bflo(r.w), bfhi(r.w)}; }
#pragma unroll
          for (int j = 0; j < 8; ++j) ss += (xr[j].x * xr[j].x + xr[j].y * xr[j].y) + (xr[j].z * xr[j].z + xr[j].w * xr[j].w); }
        const float rs2 = __builtin_amdgcn_rsqf(wave_sum(ss) * (1.f / DM) + EPS);
        {
          const float* fg_ = fgain; asm volatile("" : "+s"(fg_));
          const unsigned char* gp = (const unsigned char*)fg_; const unsigned go = 128u * (unsigned)lane;
#pragma unroll
          for (int j2 = 0; j2 < 4; ++j2) { const f32x4 g0 = *(const GAS f32x4*)(gp + (go + 32u * j2)), g1 = *(const GAS f32x4*)(gp + (go + 32u * j2 + 16u));
              const f32x4 h0 = xr[2 * j2] * g0 * rs2, h1 = xr[2 * j2 + 1] * g1 * rs2; v4u o8; o8.x = pk2(h0.x, h0.y); o8.y = pk2(h0.z, h0.w); o8.z = pk2(h1.x, h1.y); o8.w = pk2(h1.z, h1.w);
              *(LAS v4u*)(hnb + 64 * lane + 16 * j2) = o8; } }
        LDS_WAIT();
#pragma unroll 1
        for (int grp = 0; grp < 8; grp += 2) {
            const int e_b = eidx[tl * 128 + 16 * (grp + 1) + c16];
            const int gn = grp < 6 ? grp + 2 : 7;
            const int e_nxt = eidx[tl * 128 + 16 * gn + c16];
            f32x4 acc = (f32x4){0.f, 0.f, 0.f, 0.f};
            U_ISSUE(bB, e_b); U_CONSUME(bA);
            U_ACT(grp);
            acc = (f32x4){0.f, 0.f, 0.f, 0.f};
            if (grp < 6) U_ISSUE(bA, e_nxt); else V_ISSUE(bA, 0);
            U_CONSUME(bB);
            U_ACT(grp + 1);
            e_cur = e_nxt;
        }
        LDS_WAIT();
        float o[32];
#pragma unroll
        for (int i = 0; i < 32; ++i) o[i] = 0.f;
#pragma unroll 1
        for (int kb = 0; kb < 8; kb += 2) {
            V_ISSUE(bB, kb + 1); V_CONSUME(bA, kb);
            if (kb + 2 < 8) V_ISSUE(bA, kb + 2);
            else if (ti < 3) { e_cur = eidx[(tl + 8) * 128 + c16]; U_ISSUE(bA, e_cur); }
            V_CONSUME(bB, kb + 1);
        }
        { constexpr float isv = 1.f / SV; float s2 = 0.f;
#pragma unroll
          for (int j = 0; j < 8; ++j) { xr[j] = xr[j] + (f32x4){o[4 * j], o[4 * j + 1], o[4 * j + 2], o[4 * j + 3]} * isv;
              s2 += (xr[j].x * xr[j].x + xr[j].y * xr[j].y) + (xr[j].z * xr[j].z + xr[j].w * xr[j].w); }
          const float rf = __builtin_amdgcn_rsqf(wave_sum(s2) * (1.f / DM) + EPS);
          const float* fi_ = fing; asm volatile("" : "+s"(fi_));
          const unsigned char* fp = (const unsigned char*)fi_; unsigned char* op = (unsigned char*)outp; const unsigned fo = 128u * (unsigned)lane;
          if (!dry || rf == 1.2345e30f)
#pragma unroll
          for (int j = 0; j < 8; ++j) *(GAS f32x4*)(op + (xo + 16u * j)) = xr[j] * rf * *(const GAS f32x4*)(fp + (fo + 16u * j)); }
    }
#endif
#undef U_ISSUE
#undef U_ACT
#undef U_CONSUME
#undef V_ISSUE
#undef V_CONSUME
    __syncthreads();
}

__global__ void __launch_bounds__(NWAVES * 64, 2) hybrid_fwd(Args args) {
    extern __shared__ __attribute__((aligned(16))) unsigned char lds[];
    Frame F;
    F.lds = (LAS unsigned char*)lds;
    F.MISC = (volatile LAS unsigned*)(F.lds + MISC_OFF);
    F.tid = threadIdx.x; F.lane = F.tid & 63; F.wave = __builtin_amdgcn_readfirstlane(F.tid >> 6); F.G = gridDim.x;
    for (int u = F.tid; u < (LDS_BYTES - LDSCTL_OFF) / 4; u += NWAVES * 64) ((LAS unsigned*)(F.lds + LDSCTL_OFF))[u] = 0u;
    __syncthreads();
    (void)args;
    XcdBarrier bar = xcd_barrier_post(F.ctl() + CW_BAR, F.MISC + 8);

#ifndef NO_P0
#ifdef PROBE_P0X2
    { int reps = 2; asm volatile("" : "+s"(reps)); for (int rep = 0; rep < reps; ++rep) p0_prologue(F); }
#else
    p0_prologue(F);
#endif
#endif
    xcd_barrier(bar);
#ifndef NO_P1
#ifdef PROBE_GX2
    { int reps = 2; asm volatile("" : "+s"(reps)); for (int rep = 0; rep < reps; ++rep) {
#else
    { { const int rep = 0, reps = 1;
#endif
      pg8::Gemm gm{F.HN(), F.WinT(), MTOK, NPAD, DM}; pg8::StaticOrder S; S.init(MTOK, NPAD, F.G, (int)blockIdx.x);
      EpiProj E{F.PROJ(), F.dtraw(), (rep + 1 < reps) ? nullptr : F.kmean()};
      pg8::gemm_phase<EpiProj, pg8::StaticOrder, PG8_ALIGN, PG8_SP2>(F.lds + RING_OFF, gm, S, E); } }
#endif
    xcd_barrier(bar);
#ifdef PROBE_P15X2
    conv_phase(F);
#endif
    conv_phase(F);
    xcd_barrier(bar);
#ifdef PROBE_P2X2
    { int reps = 2; asm volatile("" : "+s"(reps)); for (int rep = 0; rep < reps; ++rep) {
#else
    { { const int rep = 0, reps = 1;
#endif
    const bool doatom = rep + 1 == reps;
    for (;;) {
        if (F.tid == 0) F.MISC[0] = xb_add(F.ctl() + CW_Q2 + 64 * rep, 1u);
        __syncthreads();
        const int ui = (int)F.MISC[0];
        __syncthreads();
        if (ui >= 128 + 1024) break;
#ifdef PROBE_P2_SSD
        if (ui < 128 || doatom)
#endif
#ifdef PROBE_P2_ATT
        if (ui >= 128 || doatom)
#endif
        {
        if (ui < 128) ssd_unit(F, ui >> 4, ui & 15, doatom);
        else { const int a = ui - 128; attn_unit(F, (a & 63) >> 3, a & 7, 15 - (a >> 6), doatom); }
        }
    } } }
    xcd_barrier(bar);
#ifndef NO_P3
#ifdef PROBE_GX2
    { int reps = 2; asm volatile("" : "+s"(reps)); for (int rep = 0; rep < reps; ++rep) {
#else
    { { const int rep = 0, reps = 1;
#endif
      pg8::Gemm gm{F.HN(), F.WoutT(), MTOK, DM, DM}; pg8::StaticOrder S; S.init(MTOK, DM, F.G, (int)blockIdx.x);
      {
        const int t_ = fresh_tid(); pg8::Unit uu; const float* const sq = F.ssq();
        if (S.next(t_ >> 8, uu)) { const int row = uu.pm * 256 + (t_ & 255);
            const float q1 = __hip_atomic_load(sq + (size_t)row * 4 + 1, RLX_AGENT), q2 = __hip_atomic_load(sq + (size_t)row * 4 + 2, RLX_AGENT), q3 = __hip_atomic_load(sq + (size_t)row * 4 + 3, RLX_AGENT);
            const float sa = __builtin_amdgcn_rsqf(q1 * (1.f / 1024.f) + EPS), s0 = __builtin_amdgcn_rsqf(q2 * (1.f / 512.f) + EPS), s1 = __builtin_amdgcn_rsqf(q3 * (1.f / 512.f) + EPS);
            *(LAS f32x4*)(F.lds + SEGTAB_OFF + t_ * 16) = (f32x4){sa / s0, s0 / s1, s1, 0.f}; }
        __syncthreads(); }
      EpiOut E{F.x(), F.X1B(), F.ssq(), rep + 1 == reps, (const LAS f32x4*)(F.lds + SEGTAB_OFF)};
      pg8::gemm_phase<EpiOut, pg8::StaticOrder, PG8_ALIGN, PG8_SP2>(F.lds + RING_OFF, gm, S, E); } }
#endif
    xcd_barrier(bar);
#ifndef NO_P4
#ifdef PROBE_GX2
    { int reps = 2; asm volatile("" : "+s"(reps)); for (int rep = 0; rep < reps; ++rep) {
#else
    { { const int rep = 0, reps = 1; (void)rep; (void)reps;
#endif
      pg8::Gemm gm{F.X1B(), F.WqT(), MTOK, DM, DM}; pg8::StaticOrder S; S.init(MTOK, DM, F.G, (int)blockIdx.x);
      EpiQ E{F.QP(), F.ssq()};
      pg8::gemm_phase<EpiQ, pg8::StaticOrder, PG8_ALIGN, PG8_SP2>(F.lds + RING_OFF, gm, S, E); } }
#endif
    xcd_barrier(bar);
#ifndef NO_P5
#ifdef PROBE_P5X2
    { int reps = 2; asm volatile("" : "+s"(reps));
      for (int rep = 0; rep < reps; ++rep) for (int u = blockIdx.x; u < MTOK / 32; u += F.G) peer_unit(F, u, rep + 1 < reps); }
#else
    for (int u = blockIdx.x; u < MTOK / 32; u += F.G) peer_unit(F, u);
#endif
#endif
}

extern "C" void kernel_launch(void* const* d_in, const int* in_sizes, int n_in, void* d_out, int out_size, void* d_ws, size_t ws_size, hipStream_t stream) {
    static int grid = 0;
    if (grid == 0) {
        if (n_in != 18 || out_size != MTOK * DM || ws_size < WS_END) { fprintf(stderr, "kernel_launch: unexpected shapes (n_in %d, out %d, ws %zu)\n", n_in, out_size, ws_size); grid = -1; return; }
        int dev = 0, cus = 0, per_cu = 0;
        if (hipGetDevice(&dev) != hipSuccess || hipDeviceGetAttribute(&cus, hipDeviceAttributeMultiprocessorCount, dev) != hipSuccess) { grid = -1; return; }
        if (hipFuncSetAttribute((const void*)hybrid_fwd, hipFuncAttributeMaxDynamicSharedMemorySize, LDS_BYTES) != hipSuccess) { fprintf(stderr, "kernel_launch: hipFuncSetAttribute failed\n"); grid = -1; return; }
        if (hipOccupancyMaxActiveBlocksPerMultiprocessor(&per_cu, (const void*)hybrid_fwd, NWAVES * 64, LDS_BYTES) != hipSuccess || per_cu < 1)
            fprintf(stderr, "kernel_launch: note: occupancy query reports %d workgroups per CU\n", per_cu);
        (void)hipGetLastError();
        grid = cus;
    }
    if (grid < 0) return;
    if (hipMemsetAsync((char*)d_ws + WS_CTL, 0, CTL_ZERO_BYTES, stream) != hipSuccess) return;
    Args a{};
    for (int i = 0; i < 18; ++i) a.in[i] = (const float*)d_in[i];
    a.out = (float*)d_out; a.ws = (unsigned char*)d_ws;
    hipLaunchKernelGGL(hybrid_fwd, dim3(grid), dim3(NWAVES * 64), LDS_BYTES, stream, a);
}
```

```cpp
#include <hip/hip_runtime.h>
#include <cstdio>
#include <cstdint>
namespace pg8 {
#define PG8_LAS __attribute__((address_space(3)))
typedef unsigned short bf16_t;
typedef short bf16x8 __attribute__((ext_vector_type(8)));
typedef float f32x4 __attribute__((ext_vector_type(4)));
typedef unsigned u32x4 __attribute__((ext_vector_type(4)));
constexpr int BM = 256, BK = 64, HALF = 128, HTB = HALF * BK * 2  , STAGE_BYTES = 8 * HTB, NXCD = 8, WGM = 8;

__host__ __device__ __forceinline__ int lds_byte(int r, int c) { const int st = (r >> 4) * 2 + (c >> 5), rr = r & 15, cc = c & 31, ob = rr * 64 + cc * 2; return st * 1024 + (ob ^ (((ob >> 9) & 1) << 5)); }
__host__ __device__ __forceinline__ void stage_rc(int b, int& R, int& C) { const int st = b / 1024, sb = b % 1024, swz = sb ^ (((sb >> 9) & 1) << 5); R = (st >> 1) * 16 + swz / 64; C = (st & 1) * 32 + (swz % 64) / 2; }
__host__ __device__ __forceinline__ int perm32(int rho) { const int n = rho >> 4, i = rho & 15; return 8 * (i >> 2) + 4 * n + (i & 3); }

struct Unit { int pm, pn; };
struct Gemm { const bf16_t* A; const bf16_t* Bt; int M, N, K; };

struct StaticOrder {
    int nM, nN, nwg, G, c;
    __host__ __device__ void init(int M, int N, int G_, int c_) { nM = M / BM; nN = N / BM; nwg = nM * nN; G = G_; c = c_; }
    __host__ __device__ bool next(int i, Unit& u) const {
        const long L = (long)i * G + c; if (L >= nwg) return false;
        int wgid = (int)L; { const int q = nwg / NXCD, r = nwg % NXCD, xcd = wgid % NXCD, off = wgid / NXCD; wgid = (xcd < r ? xcd * (q + 1) : r * (q + 1) + (xcd - r) * q) + off; }
        const int nig = WGM * nN, gid = wgid / nig, fm = gid * WGM, gsz = (nM - fm) < WGM ? (nM - fm) : WGM;
        u.pm = fm + ((wgid % nig) % gsz); u.pn = (wgid % nig) / gsz; return true;
    }
    __device__ __forceinline__ void a_ready(const Unit&) const {}
    __device__ __forceinline__ void done(const Unit&) const {}
};

__device__ __forceinline__ unsigned cvt_pk_bf16(float lo, float hi) { unsigned r; asm volatile("v_cvt_pk_bf16_f32 %0, %1, %2" : "=v"(r) : "v"(lo), "v"(hi)); return r; }
typedef float f32x2 __attribute__((ext_vector_type(2)));
__device__ __forceinline__ f32x2 gelu_pk(f32x2 v) {
    const f32x2 av = __builtin_elementwise_abs(v), d = av * 0.2316418882f + 1.0f;
    f32x2 t; t.x = __builtin_amdgcn_rcpf(d.x); t.y = __builtin_amdgcn_rcpf(d.y);
    f32x2 q = t * 0.5307027145f + (-0.7265760135f); q = q * t + 0.7107068705f; q = q * t + (-0.142248368f); q = q * t + 0.127414796f; q = q * t;
    const f32x2 s = (v * v) * (-0.72134752044f);
    f32x2 e; e.x = __builtin_amdgcn_exp2f(s.x); e.y = __builtin_amdgcn_exp2f(s.y);
    const f32x2 m = v * (q * e), r = v - m;
    f32x2 o; o.x = v.x < 0.f ? m.x : r.x; o.y = v.y < 0.f ? m.y : r.y; return o;
}

template <int ACT  > struct EpiBf16 {
    static constexpr bool PERM = true, AFTER_DRAIN = false, SEG = false; static_assert(ACT == 0 || ACT == 1, "EpiBf16: ACT is 0 (none) or 1 (gelu_pk)");
    bf16_t* O; int ldc; const float* bias; int split_cols; size_t split_stride; float scale0;
    __device__ __forceinline__ void operator()(const f32x4 (&acc)[2][2][4][2], const Unit& u, int wr, int wc, int fr, int fq) const {
        const int row0 = u.pm * BM + wr * 64 + fr; int colt = u.pn * BM; bf16_t* base = O;
        float sc = 1.f; if (split_cols) { const int t = colt / split_cols; base += (size_t)t * split_stride; colt -= t * split_cols; if (t == 0) sc = scale0; }
        const int col0 = colt + wc * 32 + 8 * fq, bcol0 = u.pn * BM + wc * 32 + 8 * fq;
        f32x4 bv[2][2];
#pragma unroll
        for (int bj = 0; bj < 2; ++bj)
#pragma unroll
            for (int n = 0; n < 2; ++n) bv[bj][n] = bias ? *(const f32x4*)(bias + bcol0 + bj * HALF + 4 * n) : (f32x4){0.f, 0.f, 0.f, 0.f};
#pragma unroll
        for (int ai = 0; ai < 2; ++ai)
#pragma unroll
            for (int m = 0; m < 4; ++m) { bf16_t* rowp = base + (size_t)(row0 + ai * HALF + m * 16) * ldc + col0;
#pragma unroll
                for (int bj = 0; bj < 2; ++bj) { f32x4 v0 = acc[ai][bj][m][0] + bv[bj][0], v1 = acc[ai][bj][m][1] + bv[bj][1];
                    if (ACT == 1) { f32x2 a = gelu_pk((f32x2){v0[0], v0[1]}), b = gelu_pk((f32x2){v0[2], v0[3]}), c = gelu_pk((f32x2){v1[0], v1[1]}), d = gelu_pk((f32x2){v1[2], v1[3]});
                        v0 = (f32x4){a.x, a.y, b.x, b.y}; v1 = (f32x4){c.x, c.y, d.x, d.y}; }
                    v0 = v0 * sc; v1 = v1 * sc; u32x4 w; w.x = cvt_pk_bf16(v0[0], v0[1]); w.y = cvt_pk_bf16(v0[2], v0[3]); w.z = cvt_pk_bf16(v1[0], v1[1]); w.w = cvt_pk_bf16(v1[2], v1[3]);
                    *(u32x4*)(rowp + bj * HALF) = w; } }
    }
};
template <class Epi, class Sched, bool ALIGN_EPI = false, bool SP2 = false>
__device__ __forceinline__ void gemm_phase(PG8_LAS unsigned char* lds, const Gemm g, const Sched& S, const Epi& E) {
    const int tid = threadIdx.x, wid = __builtin_amdgcn_readfirstlane(tid >> 6), lane = tid & 63, wr = wid >> 2, wc = wid & 3, fr = lane & 15, fq = lane >> 4;
    const int K = g.K, nt = K / BK;
    unsigned voffA[2], voffB[2];
#pragma unroll
    for (int i = 0; i < 2; ++i) { int R, C; stage_rc(tid * 16 + i * 8192, R, C); const int Rb = Epi::PERM ? ((R & ~31) + perm32(R & 31)) : R;
        voffA[i] = (unsigned)(R * K + C) * 2u; voffB[i] = (unsigned)(Rb * K + C) * 2u; }
    const size_t kstep = (size_t)(BK * 2);
    const size_t hstep = (size_t)HALF * K * 2;
    const size_t tstep = 2 * hstep;
    const unsigned ldsw = (unsigned)wid * 1024u;
    const int aoff = lds_byte(wr * 64 + fr, fq * 8), boff = lds_byte(wc * 32 + fr, fq * 8);
#define PG8_SA(b, h) (((b) * 2 + (h)) * HTB)
#define PG8_SB(b, h) ((4 + (b) * 2 + (h)) * HTB)
#define PG8_STAGE(bufoff, gbase, voff) do { _Pragma("unroll") for (int _i = 0; _i < 2; ++_i) \
        __builtin_amdgcn_global_load_lds((const unsigned*)((const char*)(gbase) + (voff)[_i]), (PG8_LAS unsigned*)(lds + (bufoff) + ldsw + _i * 8192), 16, 0, 0); } while (0)
#define PG8_LDA(dst, b, h) do { _Pragma("unroll") for (int m = 0; m < 4; ++m) _Pragma("unroll") for (int k = 0; k < 2; ++k) dst[m][k] = *(const PG8_LAS bf16x8*)(lds + PG8_SA(b, h) + aoff + m * 2048 + k * 1024); } while (0)
#define PG8_LDB(dst, b, h) do { _Pragma("unroll") for (int n = 0; n < 2; ++n) _Pragma("unroll") for (int k = 0; k < 2; ++k) dst[n][k] = *(const PG8_LAS bf16x8*)(lds + PG8_SB(b, h) + boff + n * 2048 + k * 1024); } while (0)
#define PG8_MMA(ai, bj, At, Bt) do { __builtin_amdgcn_s_setprio(1); _Pragma("unroll") for (int m = 0; m < 4; ++m) _Pragma("unroll") for (int n = 0; n < 2; ++n) _Pragma("unroll") for (int k = 0; k < 2; ++k) \
        acc[ai][bj][m][n] = __builtin_amdgcn_mfma_f32_16x16x32_bf16(Bt[n][k], At[m][k], acc[ai][bj][m][n], 0, 0, 0); __builtin_amdgcn_s_setprio(0); } while (0)
#define PG8_WAIT_V(n) asm volatile("s_waitcnt vmcnt(" #n ")" ::: "memory")
#define PG8_WAIT_L(n) asm volatile("s_waitcnt lgkmcnt(" #n ")" ::: "memory")
#define PG8_BAR __builtin_amdgcn_s_barrier()
#define PG8_SCHED __builtin_amdgcn_sched_barrier(0)
    Unit cur, nxt; int ui = 0;
    if (!S.next(0, cur)) return;
    f32x4 acc[2][2][4][2];
#pragma unroll
    for (int a = 0; a < 2; ++a)
#pragma unroll
        for (int b = 0; b < 2; ++b)
#pragma unroll
            for (int m = 0; m < 4; ++m)
#pragma unroll
                for (int n = 0; n < 2; ++n) acc[a][b][m][n] = (f32x4){0.f, 0.f, 0.f, 0.f};
    bf16x8 At[4][2], B0[2][2], B1[2][2];
    const char* cA = (const char*)g.A + (size_t)cur.pm * tstep; const char* cB = (const char*)g.Bt + (size_t)cur.pn * tstep;
    S.a_ready(cur);
    float segr[16];
    if constexpr (Epi::SEG) E.seg_load(ui, wr, fr, segr);
    if constexpr (SP2) {
        PG8_STAGE(PG8_SB(0, 0), cB, voffB); PG8_STAGE(PG8_SB(0, 1), cB + hstep, voffB); PG8_STAGE(PG8_SA(0, 0), cA, voffA); PG8_STAGE(PG8_SA(0, 1), cA + hstep, voffA);
        if (wr == 1) PG8_BAR;
        PG8_WAIT_V(2); PG8_BAR;
        PG8_STAGE(PG8_SB(1, 0), cB + kstep, voffB); PG8_STAGE(PG8_SA(1, 0), cA + kstep, voffA); PG8_STAGE(PG8_SB(1, 1), cB + hstep + kstep, voffB);
        PG8_WAIT_V(6); PG8_BAR;
    } else {
        PG8_STAGE(PG8_SB(0, 0), cB, voffB); PG8_STAGE(PG8_SA(0, 0), cA, voffA); PG8_STAGE(PG8_SB(0, 1), cB + hstep, voffB); PG8_STAGE(PG8_SA(0, 1), cA + hstep, voffA);
        if (wr == 1) PG8_BAR;
        PG8_WAIT_V(4); PG8_BAR;
        PG8_STAGE(PG8_SB(1, 0), cB + kstep, voffB); PG8_STAGE(PG8_SA(1, 0), cA + kstep, voffA); PG8_STAGE(PG8_SB(1, 1), cB + hstep + kstep, voffB);
        PG8_WAIT_V(6); PG8_BAR;
    }
    for (;;) {
        const bool has_next = S.next(ui + 1, nxt);
        const char* nA = has_next ? (const char*)g.A + (size_t)nxt.pm * tstep : cA; const char* nB = has_next ? (const char*)g.Bt + (size_t)nxt.pn * tstep : cB;
        int t = 0;
#pragma unroll 1
        for (int sgi = 0; sgi < (Epi::SEG ? 3 : 1); ++sgi) {
        int tend = nt; if constexpr (Epi::SEG) tend = (sgi == 0) ? Epi::SEG_T1 : ((sgi == 1) ? Epi::SEG_T2 : nt);
        for (; t < tend; t += 2) {
            const bool last = (t == nt - 2);
            const char* a1 = cA + (size_t)(t + 1) * kstep;
            const char* a2 = last ? nA : cA + (size_t)(t + 2) * kstep; const char* b2 = last ? nB : cB + (size_t)(t + 2) * kstep;
            const char* a3 = a2 + kstep; const char* b3 = b2 + kstep;
            if (last && has_next) S.a_ready(nxt);
            if constexpr (SP2) {
            PG8_LDB(B0, 0, 0); PG8_LDB(B1, 0, 1); PG8_SCHED; PG8_LDA(At, 0, 0); PG8_STAGE(PG8_SA(1, 1), a1 + hstep, voffA);
            PG8_WAIT_V(8); PG8_WAIT_L(0); PG8_BAR; PG8_MMA(0, 0, At, B0); PG8_MMA(0, 1, At, B1); PG8_BAR; PG8_SCHED;
            PG8_LDA(At, 0, 1); PG8_STAGE(PG8_SB(0, 0), b2, voffB); PG8_STAGE(PG8_SB(0, 1), b2 + hstep, voffB); PG8_STAGE(PG8_SA(0, 0), a2, voffA);
            PG8_WAIT_V(8); PG8_WAIT_L(0); PG8_BAR; PG8_MMA(1, 0, At, B0); PG8_MMA(1, 1, At, B1); PG8_BAR; PG8_SCHED;
            PG8_LDB(B0, 1, 0); PG8_LDB(B1, 1, 1); PG8_SCHED; PG8_LDA(At, 1, 0); PG8_STAGE(PG8_SA(0, 1), a2 + hstep, voffA);
            PG8_WAIT_V(8); PG8_WAIT_L(0); PG8_BAR; PG8_MMA(0, 0, At, B0); PG8_MMA(0, 1, At, B1); PG8_BAR; PG8_SCHED;
            PG8_LDA(At, 1, 1); PG8_STAGE(PG8_SB(1, 0), b3, voffB); PG8_STAGE(PG8_SB(1, 1), b3 + hstep, voffB); PG8_STAGE(PG8_SA(1, 0), a3, voffA);
            PG8_WAIT_V(8); PG8_WAIT_L(0); PG8_BAR; PG8_MMA(1, 0, At, B0); PG8_MMA(1, 1, At, B1); PG8_BAR; PG8_SCHED;
            } else {
            PG8_LDB(B0, 0, 0); PG8_SCHED; PG8_LDA(At, 0, 0); PG8_STAGE(PG8_SA(1, 1), a1 + hstep, voffA);
            PG8_WAIT_L(8); PG8_BAR; PG8_WAIT_L(0); PG8_MMA(0, 0, At, B0); PG8_BAR; PG8_SCHED;
            PG8_LDB(B1, 0, 1); PG8_STAGE(PG8_SB(0, 0), b2, voffB);
            PG8_BAR; PG8_WAIT_L(0); PG8_MMA(0, 1, At, B1); PG8_BAR;
            PG8_LDA(At, 0, 1); PG8_STAGE(PG8_SA(0, 0), a2, voffA);
            PG8_BAR; PG8_WAIT_L(0); PG8_MMA(1, 0, At, B0); PG8_BAR; PG8_SCHED;
            PG8_STAGE(PG8_SB(0, 1), b2 + hstep, voffB);
            PG8_WAIT_V(6); PG8_BAR; PG8_MMA(1, 1, At, B1); PG8_BAR;
            PG8_LDB(B0, 1, 0); PG8_SCHED; PG8_LDA(At, 1, 0); PG8_STAGE(PG8_SA(0, 1), a2 + hstep, voffA);
            PG8_WAIT_L(8); PG8_BAR; PG8_WAIT_L(0); PG8_MMA(0, 0, At, B0); PG8_BAR; PG8_SCHED;
            PG8_LDB(B1, 1, 1); PG8_STAGE(PG8_SB(1, 0), b3, voffB);
            PG8_BAR; PG8_WAIT_L(0); PG8_MMA(0, 1, At, B1); PG8_BAR;
            PG8_LDA(At, 1, 1); PG8_STAGE(PG8_SA(1, 0), a3, voffA);
            PG8_BAR; PG8_WAIT_L(0); PG8_MMA(1, 0, At, B0); PG8_BAR; PG8_SCHED;
            PG8_STAGE(PG8_SB(1, 1), b3 + hstep, voffB);
            PG8_WAIT_V(6); PG8_BAR; PG8_MMA(1, 1, At, B1); PG8_BAR;
            }
        }
        if constexpr (Epi::SEG) E.seg_apply(acc, segr, sgi);
        }
        if constexpr (ALIGN_EPI) { if (wr == 0) PG8_BAR; }
        if constexpr (!Epi::AFTER_DRAIN) { if constexpr (Epi::SEG) E(acc, cur, wr, wc, fr, fq, ui); else E(acc, cur, wr, wc, fr, fq); S.done(cur); }
        if (!has_next) break;
#pragma unroll
        for (int a = 0; a < 2; ++a)
#pragma unroll
            for (int b = 0; b < 2; ++b)
#pragma unroll
                for (int m = 0; m < 4; ++m)
#pragma unroll
                    for (int n = 0; n < 2; ++n) acc[a][b][m][n] = (f32x4){0.f, 0.f, 0.f, 0.f};
        cur = nxt; cA = nA; cB = nB; ++ui;
        if constexpr (Epi::SEG) E.seg_load(ui, wr, fr, segr);
        if constexpr (ALIGN_EPI) { if (wr == 1) PG8_BAR; }
    }
    PG8_WAIT_V(0);
    if constexpr (!ALIGN_EPI) { if (wr == 0) PG8_BAR; }
    PG8_BAR;
    if constexpr (Epi::AFTER_DRAIN) { E.fused(acc, cur, wr, wc, fr, fq, lds, wid, lane); S.done(cur); }
#undef PG8_SA
#undef PG8_SB
#undef PG8_STAGE
#undef PG8_LDA
#undef PG8_LDB
#undef PG8_MMA
#undef PG8_WAIT_V
#undef PG8_WAIT_L
#undef PG8_BAR
#undef PG8_SCHED
}
}
#ifndef PG8_SP2
#define PG8_SP2 true
#endif
#ifndef PG8_ALIGN
#define PG8_ALIGN true
#endif

constexpr int BATCH = 8, SEQ = 2048, DM = 2048, MTOK = BATCH * SEQ;
constexpr int ATT_W = 1024, ATT_H = 8, ATT_HD = 128, MOBA_BLK = 256, NBLK = SEQ / MOBA_BLK;
constexpr int SSM_W = 1024, SSM_H = 16, SSM_P = 64, SSM_N = 128, SSM_L = 128, SSM_NC = SEQ / SSM_L, CONV_CH = 1536;
constexpr int IN_PROJ = 5648, NPROJ = 5632  , NPAD = 5888  ;
constexpr int COL_Q = 0, COL_K = 1024, COL_V = 2048, COL_Z = 3072, COL_XBC = 4096;
constexpr int PEER_H = 8, PEER_NK = 128, PEER_K = 16, PEER_HK = 128;
constexpr float EPS = 1e-6f;
constexpr float SU = 64.f, SV = 4.f, SH = 16.f, SLO = 16.f;
constexpr int ROWB = DM / 2;

constexpr size_t MiB = 1u << 20;
constexpr size_t WS_CTL = 0, CTL_ZERO_BYTES = 1 * MiB;
constexpr size_t WS_DT = 1 * MiB;
constexpr size_t WS_SK = 2 * MiB;
constexpr size_t WS_WIN = 4 * MiB;
constexpr size_t WS_WOUT = 28 * MiB;
constexpr size_t WS_WQ = 36 * MiB;
constexpr size_t WS_HN = 44 * MiB;
constexpr size_t WS_PROJ = 108 * MiB;
constexpr size_t WS_X1B = WS_PROJ, WS_QP = WS_PROJ + 64 * MiB;
constexpr size_t WS_U8 = 284 * MiB, WS_V8 = 316 * MiB;
constexpr size_t WS_XBC = 348 * MiB;
constexpr size_t WS_DT2 = 3 * MiB;
constexpr size_t WS_END = 396 * MiB;
constexpr int CW_BAR = 4096;
constexpr int CW_Q2 = 8192;
constexpr int CW_KMEAN = 32768;
constexpr int CW_SSQ = 131072;
static_assert((CW_SSQ + MTOK * 4) * 4 <= (int)CTL_ZERO_BYTES, "CTL words inside the memset region");

constexpr int RING_OFF = 0, RING_BYTES = 131072;
constexpr int LDSCTL_OFF = RING_BYTES, MISC_OFF = LDSCTL_OFF + 320;
constexpr int SEGTAB_OFF = LDSCTL_OFF + 1024;
constexpr int LDS_BYTES = 147456;
constexpr int NWAVES = 8;

#define GAS __attribute__((address_space(1)))
#define LAS __attribute__((address_space(3)))
typedef unsigned short bf16;
typedef unsigned v4u __attribute__((ext_vector_type(4)));
typedef unsigned v2u __attribute__((ext_vector_type(2)));
typedef float f32x4 __attribute__((ext_vector_type(4)));
typedef float f32x2 __attribute__((ext_vector_type(2)));
typedef short bf16x8 __attribute__((ext_vector_type(8)));
typedef short s16x4 __attribute__((ext_vector_type(4)));
typedef GAS unsigned gu32;
#define RLX_AGENT __ATOMIC_RELAXED, __HIP_MEMORY_SCOPE_AGENT
#define LDS_WAIT() asm volatile("s_waitcnt lgkmcnt(0)" ::: "memory")
#define VM_WAIT() asm volatile("s_waitcnt vmcnt(0)" ::: "memory")
__device__ __forceinline__ unsigned f2bf(float f) { unsigned u = __builtin_bit_cast(unsigned, f); return (u + 0x7fffu + ((u >> 16) & 1u)) >> 16; }
typedef __bf16 bf16v2 __attribute__((ext_vector_type(2)));
__device__ __forceinline__ unsigned pk2(float lo, float hi) { bf16v2 v; v.x = (__bf16)lo; v.y = (__bf16)hi; return __builtin_bit_cast(unsigned, v); }
__device__ __forceinline__ float bflo(unsigned w) { return __builtin_bit_cast(float, w << 16); }
__device__ __forceinline__ float bfhi(unsigned w) { return __builtin_bit_cast(float, w & 0xffff0000u); }
__device__ __forceinline__ float wave_sum(float v) {
#pragma unroll
    for (int o = 1; o < 64; o <<= 1) v += __shfl_xor(v, o);
    return v;
}
__device__ __forceinline__ float silu_f(float x) { return x * __builtin_amdgcn_rcpf(1.f + __expf(-x)); }

#define XB_TMO      128
#define XB_XCNT(j)  (256  + 64 * (j))
#define XB_XSUB(j)  (1280 + 64 * (j))
#define XB_XGEN(j)  (2304 + 64 * (j))
#define XB_TOP      3328
#define XB_TOPGEN   3392
#define XCD_BAR_WORDS 3456
#define XB_SPIN_CAP (1u << 18)

__device__ __forceinline__ unsigned xb_ld(unsigned* p)              { return __hip_atomic_load(p, __ATOMIC_RELAXED, __HIP_MEMORY_SCOPE_AGENT); }
__device__ __forceinline__ unsigned xb_add(unsigned* p, unsigned v) { return __hip_atomic_fetch_add(p, v, __ATOMIC_RELAXED, __HIP_MEMORY_SCOPE_AGENT); }
__device__ __forceinline__ unsigned xb_xcc_id() { return (unsigned)__builtin_amdgcn_s_getreg((3 << 11) | 20) & 0xFu; }
#define XB_SPIN(cond, bar) do { unsigned _sp = 0; while (cond) { __builtin_amdgcn_s_sleep(1); \
    if ((++_sp & 255u) == 0u) { if (xb_ld(&(bar)[XB_TMO])) break; if (_sp > XB_SPIN_CAP) { atomicAdd(&(bar)[XB_TMO], 1u); break; } } } } while (0)

struct XcdBarrier {
    unsigned* bar; unsigned x;
    volatile LAS unsigned* st;
};
__device__ __forceinline__ XcdBarrier xcd_barrier_post(unsigned* bar, volatile LAS unsigned* st) {
    XcdBarrier b; b.bar = bar; b.x = xb_xcc_id(); b.st = st;
    if (threadIdx.x == 0) (void)xb_add(&bar[XB_XCNT(b.x)], 1u);
    return b;
}
__device__ __forceinline__ void xcd_barrier_complete(unsigned* bar, unsigned x, unsigned& nloc, unsigned& nx) {
    const unsigned G = gridDim.x * gridDim.y * gridDim.z;
    unsigned sum, cnt, mine, sp = 0u;
    for (;;) {
        sum = 0u; cnt = 0u; mine = 0u;
#pragma unroll
        for (unsigned j = 0; j < 16; ++j) { const unsigned c = xb_ld(&bar[XB_XCNT(j)]); sum += c; cnt += (c > 0u) ? 1u : 0u; mine = (j == x) ? c : mine; }
        if (sum == G) break;
        __builtin_amdgcn_s_sleep(1);
        if ((++sp & 255u) == 0u) { if (xb_ld(&bar[XB_TMO])) break; if (sp > XB_SPIN_CAP) { atomicAdd(&bar[XB_TMO], 1u); break; } }
    }
    nloc = mine > 0u ? mine : 1u; nx = cnt > 0u ? cnt : 1u;
}
__device__ __forceinline__ void xcd_barrier(const XcdBarrier& b) {
    asm volatile("s_waitcnt vmcnt(0)" ::: "memory");
    __syncthreads();
    if (threadIdx.x == 0) {
        unsigned* bar = b.bar;
        __builtin_amdgcn_s_waitcnt(0);
        unsigned nloc = b.st[0], nx = b.st[1];
        if (nloc == 0u) { xcd_barrier_complete(bar, b.x, nloc, nx); b.st[0] = nloc; b.st[1] = nx; }
        const unsigned old = xb_add(&bar[XB_XSUB(b.x)], 1u);
        const unsigned gen = old / nloc;
        if (old + 1u == (gen + 1u) * nloc) {
            __builtin_amdgcn_fence(__ATOMIC_RELEASE, "agent");
            asm volatile("s_waitcnt vmcnt(0)" ::: "memory");
            const unsigned og = xb_add(&bar[XB_TOP], 1u);
            const unsigned tg = og / nx;
            if (og + 1u == (tg + 1u) * nx) xb_add(&bar[XB_TOPGEN], 1u);
            else XB_SPIN(xb_ld(&bar[XB_TOPGEN]) == tg, bar);
            __builtin_amdgcn_fence(__ATOMIC_ACQUIRE, "agent");
            xb_add(&bar[XB_XGEN(b.x)], 1u);
            asm volatile("s_waitcnt vmcnt(0)" ::: "memory");
        } else {
            XB_SPIN(xb_ld(&bar[XB_XGEN(b.x)]) == gen, bar);
            __builtin_amdgcn_fence(__ATOMIC_ACQUIRE, "agent");
            asm volatile("s_waitcnt vmcnt(0)" ::: "memory");
        }
    }
    __syncthreads();
}

#define CAS __attribute__((address_space(4)))
struct Args { const float* in[18]; float* out; unsigned char* ws; };
__device__ __forceinline__ const CAS unsigned char* kargs() { const CAS unsigned char* p = (const CAS unsigned char*)__builtin_amdgcn_kernarg_segment_ptr(); asm volatile("" : "+s"(p)); return p; }
__device__ __forceinline__ const float* kin(int i) { return *(const float* const CAS*)(kargs() + 8 * i); }
__device__ __forceinline__ float* kout() { return *(float* const CAS*)(kargs() + 8 * 18); }
__device__ __forceinline__ unsigned char* kws() { return *(unsigned char* const CAS*)(kargs() + 8 * 19); }
__device__ __forceinline__ int fresh_tid() { int t = threadIdx.x; asm volatile("" : "+v"(t)); return t; }
struct Frame {
    LAS unsigned char* lds;
    volatile LAS unsigned* MISC;
    int tid, lane, wave, G;
    __device__ __forceinline__ const float* x() const { return kin(0); }
    __device__ __forceinline__ const float* attn_norm() const { return kin(1); }
    __device__ __forceinline__ const float* w_in() const { return kin(2); }
    __device__ __forceinline__ const float* conv_w() const { return kin(3); }
    __device__ __forceinline__ const float* conv_b() const { return kin(4); }
    __device__ __forceinline__ const float* dt_bias() const { return kin(5); }
    __device__ __forceinline__ const float* a_log() const { return kin(6); }
    __device__ __forceinline__ const float* d_skip() const { return kin(7); }
    __device__ __forceinline__ const float* rel_bias() const { return kin(8); }
    __device__ __forceinline__ const float* attn_out_norm() const { return kin(9); }
    __device__ __forceinline__ const float* ssm_out_norm() const { return kin(10); }
    __device__ __forceinline__ const float* w_out() const { return kin(11); }
    __device__ __forceinline__ const float* ffn_norm() const { return kin(12); }
    __device__ __forceinline__ const float* peer_wq() const { return kin(13); }
    __device__ __forceinline__ const float* peer_sk() const { return kin(14); }
    __device__ __forceinline__ const float* peer_u() const { return kin(15); }
    __device__ __forceinline__ const float* peer_v() const { return kin(16); }
    __device__ __forceinline__ const float* final_norm() const { return kin(17); }
    __device__ __forceinline__ float* out() const { return kout(); }
    __device__ __forceinline__ unsigned* ctl() const { return (unsigned*)(kws() + WS_CTL); }
    __device__ __forceinline__ float* dtraw() const { return (float*)(kws() + WS_DT); }
    __device__ __forceinline__ bf16* SK() const { return (bf16*)(kws() + WS_SK); }
    __device__ __forceinline__ bf16* WinT() const { return (bf16*)(kws() + WS_WIN); }
    __device__ __forceinline__ bf16* WoutT() const { return (bf16*)(kws() + WS_WOUT); }
    __device__ __forceinline__ bf16* WqT() const { return (bf16*)(kws() + WS_WQ); }
    __device__ __forceinline__ bf16* HN() const { return (bf16*)(kws() + WS_HN); }
    __device__ __forceinline__ bf16* PROJ() const { return (bf16*)(kws() + WS_PROJ); }
    __device__ __forceinline__ bf16* X1B() const { return (bf16*)(kws() + WS_X1B); }
    __device__ __forceinline__ bf16* QP() const { return (bf16*)(kws() + WS_QP); }
    __device__ __forceinline__ unsigned char* U8() const { return kws() + WS_U8; }
    __device__ __forceinline__ unsigned char* V8() const { return kws() + WS_V8; }
    __device__ __forceinline__ bf16* XBC() const { return (bf16*)(kws() + WS_XBC); }
    __device__ __forceinline__ float* DT2() const { return (float*)(kws() + WS_DT2); }
    __device__ __forceinline__ float* kmean() const { return (float*)(kws() + WS_CTL) + CW_KMEAN; }
    __device__ __forceinline__ float* ssq() const { return (float*)(kws() + WS_CTL) + CW_SSQ; }
};

__device__ __forceinline__ void p0_transpose_item(const float* W, int K, int N, bf16* WT, const float* gain, LAS float* scr, int item, int lane) {
    const int nblk = (N + 31) / 32, kb = item / nblk, nb = item % nblk, k0 = 64 * kb, n0 = 32 * nb;
    const int kr = lane >> 3, nc = (lane & 7) * 4; const bool ok = (n0 + nc) < N;
    f32x4 v[8]; float gk[8];
#pragma unroll
    for (int i = 0; i < 8; ++i) { const int kk = 8 * i + kr; v[i] = ok ? *(const GAS f32x4*)(W + (size_t)(k0 + kk) * N + n0 + nc) : (f32x4){0.f, 0.f, 0.f, 0.f}; gk[i] = gain ? gain[k0 + kk] : 1.f; }
#pragma unroll
    for (int i = 0; i < 8; ++i) { const int kk = 8 * i + kr; LAS float* d = scr + kk * 33 + nc; d[0] = v[i].x * gk[i]; d[1] = v[i].y * gk[i]; d[2] = v[i].z * gk[i]; d[3] = v[i].w * gk[i]; }
    LDS_WAIT(); asm volatile("" ::: "memory");
    const int c = lane & 7;
#pragma unroll
    for (int j = 0; j < 4; ++j) { const int n = (lane >> 3) + 8 * j; const LAS float* s = scr + (8 * c) * 33 + n;
        v4u o; o.x = pk2(s[0 * 33], s[1 * 33]); o.y = pk2(s[2 * 33], s[3 * 33]); o.z = pk2(s[4 * 33], s[5 * 33]); o.w = pk2(s[6 * 33], s[7 * 33]);
        *(GAS v4u*)(WT + (size_t)(n0 + n) * K + k0 + 8 * c) = o; }
    LDS_WAIT(); asm volatile("" ::: "memory");
}
__device__ __forceinline__ void rms_2rows_to_bf16(const float* x0, const float* x1, const float* gain, bf16* o0, bf16* o1, int lane) {
    const GAS f32x4* xr0 = (const GAS f32x4*)x0 + lane; const GAS f32x4* xr1 = (const GAS f32x4*)x1 + lane; const GAS f32x4* gr = (const GAS f32x4*)gain + lane;
    f32x4 v[8], u[8]; float s = 0.f, t = 0.f;
#pragma unroll
    for (int j = 0; j < 8; ++j) { v[j] = xr0[64 * j]; u[j] = xr1[64 * j]; }
#pragma unroll
    for (int j = 0; j < 8; ++j) { s += (v[j].x * v[j].x + v[j].y * v[j].y) + (v[j].z * v[j].z + v[j].w * v[j].w); t += (u[j].x * u[j].x + u[j].y * u[j].y) + (u[j].z * u[j].z + u[j].w * u[j].w); }
    const float rs = __builtin_amdgcn_rsqf(wave_sum(s) * (1.f / DM) + EPS), rt = __builtin_amdgcn_rsqf(wave_sum(t) * (1.f / DM) + EPS);
    GAS v2u* p0 = (GAS v2u*)o0 + lane; GAS v2u* p1 = (GAS v2u*)o1 + lane;
#pragma unroll
    for (int j = 0; j < 8; ++j) { const f32x4 g = gr[64 * j]; v2u a, b;
        a.x = pk2(v[j].x * rs * g.x, v[j].y * rs * g.y); a.y = pk2(v[j].z * rs * g.z, v[j].w * rs * g.w); p0[64 * j] = a;
        b.x = pk2(u[j].x * rt * g.x, u[j].y * rt * g.y); b.y = pk2(u[j].z * rt * g.z, u[j].w * rt * g.w); p1[64 * j] = b; }
}
#ifdef PROBE_FP4EMU
__device__ __forceinline__ float fp4grid(float y) { const float a = fabsf(y); float r;
    if (a <= 2.f) r = rintf(a * 2.f) * 0.5f; else if (a <= 4.f) r = rintf(a); else r = (a < 5.f) ? 4.f : 6.f;
    return copysignf(r, y); }
__device__ __forceinline__ float clampf(float v, float lim) { if (lim == 448.5f) return fp4grid(v * (1.f / 16.f)) * 16.f; return fminf(fmaxf(v, -lim), lim); }
#else
__device__ __forceinline__ float clampf(float v, float lim) { return fminf(fmaxf(v, -lim), lim); }
#endif
template <int TAB = 0> __device__ __forceinline__ v4u cvt16_fp8(const f32x4 a, const f32x4 b, const f32x4 c, const f32x4 d, float sc) {
    v4u o; int w; constexpr float LIM = TAB ? 448.5f : 448.f;
    w = __builtin_amdgcn_cvt_pk_fp8_f32(clampf(a.x * sc, LIM), clampf(a.y * sc, LIM), 0, false); w = __builtin_amdgcn_cvt_pk_fp8_f32(clampf(a.z * sc, LIM), clampf(a.w * sc, LIM), w, true); o.x = (unsigned)w;
    w = __builtin_amdgcn_cvt_pk_fp8_f32(clampf(b.x * sc, LIM), clampf(b.y * sc, LIM), 0, false); w = __builtin_amdgcn_cvt_pk_fp8_f32(clampf(b.z * sc, LIM), clampf(b.w * sc, LIM), w, true); o.y = (unsigned)w;
    w = __builtin_amdgcn_cvt_pk_fp8_f32(clampf(c.x * sc, LIM), clampf(c.y * sc, LIM), 0, false); w = __builtin_amdgcn_cvt_pk_fp8_f32(clampf(c.z * sc, LIM), clampf(c.w * sc, LIM), w, true); o.z = (unsigned)w;
    w = __builtin_amdgcn_cvt_pk_fp8_f32(clampf(d.x * sc, LIM), clampf(d.y * sc, LIM), 0, false); w = __builtin_amdgcn_cvt_pk_fp8_f32(clampf(d.z * sc, LIM), clampf(d.w * sc, LIM), w, true); o.w = (unsigned)w;
    return o;
}
__device__ __forceinline__ unsigned fp4_code(float y) { const float a = fabsf(y);
    const unsigned m = (unsigned)(a >= 0.25f) + (unsigned)(a >= 0.75f) + (unsigned)(a >= 1.25f) + (unsigned)(a >= 1.75f) + (unsigned)(a >= 2.5f) + (unsigned)(a >= 3.5f) + (unsigned)(a >= 5.0f);
    return m | ((y < 0.f) ? 8u : 0u); }
__device__ __forceinline__ void p0_prologue(Frame& F) {
    const int tid = fresh_tid(), lane = tid & 63, wave = __builtin_amdgcn_readfirstlane(tid >> 6);
    LAS float* scr = (LAS float*)(F.lds + RING_OFF + wave * 16384);
    const int gw = blockIdx.x * NWAVES + wave, NGW = F.G * NWAVES;
    constexpr int I_IN = (DM / 64) * ((IN_PROJ + 31) / 32), I_SQ = (DM / 64) * (DM / 32);
    constexpr int NITEMS = I_IN + 2 * I_SQ;
    { const float* const w_in = F.w_in(); const float* const w_out = F.w_out(); const float* const wq = F.peer_wq(); const float* const fg = F.ffn_norm(); bf16* const WinT = F.WinT(); bf16* const WoutT = F.WoutT(); bf16* const WqT = F.WqT(); const float* const gatt = F.attn_out_norm(); const float* const gssm = F.ssm_out_norm();
      for (int it = gw; it < NITEMS; it += NGW) {
        int r = it;
        if (r < I_IN) { p0_transpose_item(w_in, DM, IN_PROJ, WinT, nullptr, scr, r, lane); continue; } r -= I_IN;
        if (r < I_SQ) { const int k0_ = 64 * (r / (DM / 32)); p0_transpose_item(w_out, DM, DM, WoutT, (k0_ < ATT_W) ? gatt : (gssm - ATT_W), scr, r, lane); continue; } r -= I_SQ;
        p0_transpose_item(wq, DM, DM, WqT, fg, scr, r, lane);
      } }
    const size_t gt = (size_t)blockIdx.x * (NWAVES * 64) + tid, GT = (size_t)F.G * NWAVES * 64;
    { const size_t z0 = (size_t)5664 * DM / 8, z1 = (size_t)NPAD * DM / 8; GAS v4u* p = (GAS v4u*)F.WinT(); for (size_t i = z0 + gt; i < z1; i += GT) p[i] = (v4u){0u, 0u, 0u, 0u}; }
    { const GAS f32x4* s = (const GAS f32x4*)F.peer_sk(); GAS v2u* d = (GAS v2u*)F.SK(); for (size_t i = gt; i < (size_t)16 * 128 * 128 / 4; i += GT) { const f32x4 v = s[i]; v2u o; o.x = pk2(v.x, v.y); o.y = pk2(v.z, v.w); d[i] = o; } }
    { const float* const xg = F.x(); const float* const gn = F.attn_norm(); bf16* const hn = F.HN();
      for (int m = gw; m < MTOK / 2; m += NGW) rms_2rows_to_bf16(xg + (size_t)(2 * m) * DM, xg + (size_t)(2 * m + 1) * DM, gn, hn + (size_t)(2 * m) * DM, hn + (size_t)(2 * m + 1) * DM, lane); }
    { const size_t nit = (size_t)16384 * 64;
      const GAS f32x4* su = (const GAS f32x4*)F.peer_u(); const GAS f32x4* sv = (const GAS f32x4*)F.peer_v(); GAS v4u* du = (GAS v4u*)F.U8(); GAS v4u* dv = (GAS v4u*)F.V8();
#pragma unroll 1
      for (int tab = 0; tab < 2; ++tab) { const GAS f32x4* src = tab ? sv : su; GAS v4u* dst = tab ? dv : du; const float sc = tab ? SV : SU;
        f32x4 nx[8];
        if (gt < nit) { const GAS f32x4* p = src + (gt >> 6) * 512 + (gt & 63);
#pragma unroll
            for (int j = 0; j < 8; ++j) nx[j] = p[64 * j]; }
#pragma unroll 1
        for (size_t i = gt; i < nit; i += GT) { f32x4 v[8];
#pragma unroll
            for (int j = 0; j < 8; ++j) v[j] = nx[j];
            if (i + GT < nit) { const size_t i2 = i + GT; const GAS f32x4* p = src + (i2 >> 6) * 512 + (i2 & 63);
#pragma unroll
                for (int j = 0; j < 8; ++j) nx[j] = p[64 * j]; }
            unsigned wd[4];
#pragma unroll
            for (int q = 0; q < 4; ++q) { const f32x4 a = v[2 * q] * sc, b = v[2 * q + 1] * sc; unsigned w = 0u;
                w = __builtin_amdgcn_cvt_scalef32_pk_fp4_f32(w, clampf(a.x, 6.f), clampf(a.y, 6.f), 1.0f, 0); w = __builtin_amdgcn_cvt_scalef32_pk_fp4_f32(w, clampf(a.z, 6.f), clampf(a.w, 6.f), 1.0f, 1);
                w = __builtin_amdgcn_cvt_scalef32_pk_fp4_f32(w, clampf(b.x, 6.f), clampf(b.y, 6.f), 1.0f, 2); w = __builtin_amdgcn_cvt_scalef32_pk_fp4_f32(w, clampf(b.z, 6.f), clampf(b.w, 6.f), 1.0f, 3); wd[q] = w; }
            dst[i] = (v4u){wd[0], wd[1], wd[2], wd[3]}; } } }
}

struct EpiProj {
    static constexpr bool PERM = true, AFTER_DRAIN = false, SEG = false;
    bf16* O; float* dtraw; float* kmean;
    __device__ __forceinline__ void operator()(const pg8::f32x4 (&acc)[2][2][4][2], const pg8::Unit& u, int wr, int wc, int fr, int fq) const {
        const int row0 = u.pm * 256 + wr * 64 + fr, col0 = u.pn * 256 + wc * 32 + 8 * fq;
        if (u.pn < 22) {
#pragma unroll
            for (int ai = 0; ai < 2; ++ai)
#pragma unroll
                for (int m = 0; m < 4; ++m) { bf16* rowp = O + (size_t)(row0 + ai * 128 + m * 16) * NPROJ + col0;
#pragma unroll
                    for (int bj = 0; bj < 2; ++bj) { const pg8::f32x4 v0 = acc[ai][bj][m][0], v1 = acc[ai][bj][m][1];
                        pg8::u32x4 w; w.x = pg8::cvt_pk_bf16(v0[0], v0[1]); w.y = pg8::cvt_pk_bf16(v0[2], v0[3]); w.z = pg8::cvt_pk_bf16(v1[0], v1[1]); w.w = pg8::cvt_pk_bf16(v1[2], v1[3]);
                        *(pg8::u32x4*)(rowp + bj * 128) = w; } }
        } else if (wc == 0 && fq < 2) {
#pragma unroll
            for (int ai = 0; ai < 2; ++ai)
#pragma unroll
                for (int m = 0; m < 4; ++m) { float* rp = dtraw + (size_t)(row0 + ai * 128 + m * 16) * 16 + 8 * fq;
                    *(pg8::f32x4*)rp = acc[ai][0][m][0]; *(pg8::f32x4*)(rp + 4) = acc[ai][0][m][1]; }
        }
        if (kmean && u.pn >= 4 && u.pn < 8) {
#pragma unroll
            for (int bj = 0; bj < 2; ++bj)
#pragma unroll
                for (int n = 0; n < 2; ++n)
#pragma unroll
                    for (int i = 0; i < 4; ++i) { float s = 0.f;
#pragma unroll
                        for (int ai = 0; ai < 2; ++ai)
#pragma unroll
                            for (int m = 0; m < 4; ++m) s += acc[ai][bj][m][n][i];
                        s += __shfl_xor(s, 1); s += __shfl_xor(s, 2); s += __shfl_xor(s, 4); s += __shfl_xor(s, 8);
                        if (fr == 0) unsafeAtomicAdd(kmean + (size_t)u.pm * 1024 + (col0 - 1024) + bj * 128 + 4 * n + i, s); }
        }
    }
};
struct EpiOut {
    static constexpr bool PERM = true, AFTER_DRAIN = false, SEG = true; static constexpr int SEG_T1 = 16, SEG_T2 = 24;
    const float* x; bf16* x1b; float* ssq; bool doatom; const LAS f32x4* tab;
    __device__ __forceinline__ void seg_load(int ui, int wr, int fr, float (&sr)[16]) const {
#pragma unroll
        for (int i = 0; i < 8; ++i) { const int r = (i >> 2) * 128 + wr * 64 + (i & 3) * 16 + fr; const f32x2 q = *(const LAS f32x2*)(tab + (ui & 1) * 256 + r); sr[2 * i] = q.x; sr[2 * i + 1] = q.y; }
        asm volatile("s_waitcnt lgkmcnt(0)" ::: "memory");
    }
    __device__ __forceinline__ void seg_apply(pg8::f32x4 (&acc)[2][2][4][2], const float (&sr)[16], int which) const {
#pragma unroll
        for (int ai = 0; ai < 2; ++ai)
#pragma unroll
            for (int m = 0; m < 4; ++m) { const float f = (which == 0) ? sr[2 * (ai * 4 + m)] : ((which == 1) ? sr[2 * (ai * 4 + m) + 1] : 1.0f);
#pragma unroll
                for (int bj = 0; bj < 2; ++bj)
#pragma unroll
                    for (int n = 0; n < 2; ++n) acc[ai][bj][m][n] = acc[ai][bj][m][n] * f; }
    }
    __device__ __forceinline__ void operator()(const pg8::f32x4 (&acc)[2][2][4][2], const pg8::Unit& u, int wr, int wc, int fr, int fq, int ui) const {
        const int row0 = u.pm * 256 + wr * 64 + fr, col0 = u.pn * 256 + wc * 32 + 8 * fq;
#pragma unroll
        for (int ai = 0; ai < 2; ++ai)
#pragma unroll
            for (int m = 0; m < 4; ++m) { const int row = row0 + ai * 128 + m * 16; const size_t off = (size_t)row * DM + col0; float s = 0.f;
                const float s1 = (*(const LAS f32x4*)(tab + (ui & 1) * 256 + ai * 128 + wr * 64 + m * 16 + fr)).z;
#pragma unroll
                for (int bj = 0; bj < 2; ++bj) {
                    const pg8::f32x4 a0 = *(const pg8::f32x4*)(x + off + bj * 128), a1 = *(const pg8::f32x4*)(x + off + bj * 128 + 4);
                    const pg8::f32x4 v0 = acc[ai][bj][m][0] * s1 + a0, v1 = acc[ai][bj][m][1] * s1 + a1;
                    pg8::u32x4 w; w.x = pg8::cvt_pk_bf16(v0[0], v0[1]); w.y = pg8::cvt_pk_bf16(v0[2], v0[3]); w.z = pg8::cvt_pk_bf16(v1[0], v1[1]); w.w = pg8::cvt_pk_bf16(v1[2], v1[3]);
                    *(pg8::u32x4*)(x1b + off + bj * 128) = w;
                    s += (v0[0] * v0[0] + v0[1] * v0[1]) + (v0[2] * v0[2] + v0[3] * v0[3]) + (v1[0] * v1[0] + v1[1] * v1[1]) + (v1[2] * v1[2] + v1[3] * v1[3]); }
                s += __shfl_xor(s, 16); s += __shfl_xor(s, 32);
                if (fq == 0 && doatom) unsafeAtomicAdd(ssq + (size_t)row * 4, s);
                asm volatile("" ::: "memory"); }
    }
};
struct EpiQ {
    static constexpr bool PERM = true, AFTER_DRAIN = false, SEG = false;
    bf16* O; const float* ssq;
    __device__ __forceinline__ void operator()(const pg8::f32x4 (&acc)[2][2][4][2], const pg8::Unit& u, int wr, int wc, int fr, int fq) const {
        const int row0 = u.pm * 256 + wr * 64 + fr, col0 = u.pn * 256 + wc * 32 + 8 * fq;
#pragma unroll
        for (int ai = 0; ai < 2; ++ai)
#pragma unroll
            for (int m = 0; m < 4; ++m) { const int row = row0 + ai * 128 + m * 16; bf16* rowp = O + (size_t)row * DM + col0;
                const float rs = 1.f / sqrtf(__hip_atomic_load(ssq + (size_t)row * 4, RLX_AGENT) * (1.f / DM) + EPS);
#pragma unroll
                for (int bj = 0; bj < 2; ++bj) { const pg8::f32x4 v0 = acc[ai][bj][m][0] * rs, v1 = acc[ai][bj][m][1] * rs;
                    pg8::u32x4 w; w.x = pg8::cvt_pk_bf16(v0[0], v0[1]); w.y = pg8::cvt_pk_bf16(v0[2], v0[3]); w.z = pg8::cvt_pk_bf16(v1[0], v1[1]); w.w = pg8::cvt_pk_bf16(v1[2], v1[3]);
                    *(pg8::u32x4*)(rowp + bj * 128) = w; } }
    }
};

constexpr int A_KSTR = 272, A_VSTR = 288;
constexpr int A_KB0 = 0, A_KB1 = 64 * A_KSTR, A_VB0 = 2 * 64 * A_KSTR, A_VB1 = A_VB0 + 64 * A_VSTR, A_KM = A_VB1 + 64 * A_VSTR, A_TAB = A_KM + 8 * 128 * 4, A_END = A_TAB + 128 * 4;
static_assert(A_END <= RING_BYTES && (A_KM % 16) == 0, "attention LDS map");
#define PIN16(a, i) asm volatile("" : "+v"(a[i]), "+v"(a[i + 1]), "+v"(a[i + 2]), "+v"(a[i + 3]), "+v"(a[i + 4]), "+v"(a[i + 5]), "+v"(a[i + 6]), "+v"(a[i + 7]), "+v"(a[i + 8]), "+v"(a[i + 9]), "+v"(a[i + 10]), "+v"(a[i + 11]), "+v"(a[i + 12]), "+v"(a[i + 13]), "+v"(a[i + 14]), "+v"(a[i + 15]))
#define TR16(p) __builtin_amdgcn_ds_read_tr16_b64_v4i16((LAS s16x4*)(p))
#define MFMA16(a, b, c) __builtin_amdgcn_mfma_f32_16x16x32_bf16((a), (b), (c), 0, 0, 0)
__device__ __forceinline__ bf16x8 pack8(const float* v) {
    const unsigned a = pk2(v[0], v[1]), b = pk2(v[2], v[3]), c = pk2(v[4], v[5]), d = pk2(v[6], v[7]);
    const v4u u = {a, b, c, d}; return __builtin_bit_cast(bf16x8, u);
}
__device__ __forceinline__ void attn_unit(Frame& F, int b, int h, int blk, const bool doatom = true) {
    LAS unsigned char* lds = F.lds + RING_OFF;
    const int tid = fresh_tid(), lane = tid & 63, w = __builtin_amdgcn_readfirstlane(tid >> 6), g = lane >> 4, c16 = lane & 15, q4 = c16 >> 2, p4 = lane & 3;
    const int own = blk, t0 = blk * 256, tq0 = t0 + 32 * w + c16;
    const size_t rowbase = (size_t)b * SEQ;
    const float NEG_INF = -__builtin_inff();
    constexpr float LOG2E = 1.4426950408889634f, SCL2 = 0.08838834764831845f * 1.4426950408889634f;
    LAS float* km = (LAS float*)(lds + A_KM); LAS float* tab = (LAS float*)(lds + A_TAB);
    const bf16* const PROJ = F.PROJ(); const float* const kmg = F.kmean(); const float* const relb = F.rel_bias();
    for (int i = tid; i < own * 128; i += NWAVES * 64) { const int n = i >> 7, d = i & 127; km[i] = kmg[(size_t)(b * 8 + n) * 1024 + h * 128 + d] * (1.f / 256.f); }
    if (tid < 128) { const int rel = tid; int bucket = rel; if (rel >= 16) { bucket = 16 + (int)(log2f((float)rel * (1.f / 16.f)) * (16.f / 3.f)); bucket = bucket > 31 ? 31 : bucket; }
        tab[tid] = relb[bucket * 8 + h] * LOG2E; }
    bf16x8 qf[2][4];
#pragma unroll
    for (int gi = 0; gi < 2; ++gi) { const bf16* qrow = PROJ + (rowbase + tq0 + 16 * gi) * NPROJ + COL_Q + h * 128 + 8 * g;
#pragma unroll
      for (int ks = 0; ks < 4; ++ks) qf[gi][ks] = *(const GAS bf16x8*)(qrow + 32 * ks); }
    __syncthreads();
    unsigned selmask[2];
    if (own <= 3) { selmask[0] = (1u << own) - 1u; selmask[1] = selmask[0]; }
    else {
#pragma unroll
      for (int gi = 0; gi < 2; ++gi) {
        float gate[7];
#pragma unroll
        for (int n = 0; n < 7; ++n) {
            float s = NEG_INF;
            if (n < own) { s = 0.f;
#pragma unroll
                for (int ks = 0; ks < 4; ++ks) { const LAS f32x4* kp = (const LAS f32x4*)(km + n * 128 + 32 * ks + 8 * g); const f32x4 k0 = kp[0], k1 = kp[1]; const v4u qu = __builtin_bit_cast(v4u, qf[gi][ks]);
                    s += bflo(qu.x) * k0.x + bfhi(qu.x) * k0.y + bflo(qu.y) * k0.z + bfhi(qu.y) * k0.w + bflo(qu.z) * k1.x + bfhi(qu.z) * k1.y + bflo(qu.w) * k1.z + bfhi(qu.w) * k1.w; }
                s += __shfl_xor(s, 16); s += __shfl_xor(s, 32); }
            gate[n] = s;
        }
        unsigned sm = 0u;
#pragma unroll
        for (int r = 0; r < 3; ++r) { float best = NEG_INF; int bi = 0;
#pragma unroll
            for (int n = 0; n < 7; ++n) { const bool cand = (n < own) && !((sm >> n) & 1u) && (gate[n] > best); best = cand ? gate[n] : best; bi = cand ? n : bi; }
            sm |= 1u << bi; }
        selmask[gi] = sm; }
    }
    const int nT = 4 + 4 * own;
    const int sr = tid >> 3, sc = (tid & 7) * 16;
#define A_KEY0(i) ((i) < 4 ? own * 256 + 64 * (i) : (((i) - 4) >> 2) * 256 + (((i) - 4) & 3) * 64)
    v4u kr0, kr1, vr0, vr1;
#define A_LOAD(i) do { const bf16* kp_ = PROJ + (rowbase + A_KEY0(i) + sr) * NPROJ + COL_K + h * 128 + sc; \
        kr0 = *(const GAS v4u*)kp_; kr1 = *(const GAS v4u*)(kp_ + 8); vr0 = *(const GAS v4u*)(kp_ + (COL_V - COL_K)); vr1 = *(const GAS v4u*)(kp_ + (COL_V - COL_K) + 8); } while (0)
#define A_STORE(bufi) do { LAS unsigned char* kd_ = lds + ((bufi) ? A_KB1 : A_KB0) + sr * A_KSTR + sc * 2; LAS unsigned char* vd_ = lds + ((bufi) ? A_VB1 : A_VB0) + sr * A_VSTR + sc * 2; \
        *(LAS v4u*)kd_ = kr0; *(LAS v4u*)(kd_ + 16) = kr1; *(LAS v4u*)vd_ = vr0; *(LAS v4u*)(vd_ + 16) = vr1; } while (0)
    A_LOAD(0); A_STORE(0);
    __syncthreads();
    float m_run[2] = {NEG_INF, NEG_INF}, l_run[2] = {0.f, 0.f};
    f32x4 oacc[2][8];
#pragma unroll
    for (int gi = 0; gi < 2; ++gi)
#pragma unroll
        for (int db = 0; db < 8; ++db) oacc[gi][db] = (f32x4){0.f, 0.f, 0.f, 0.f};
    for (int i = 0; i < nT; ++i) {
        if (i + 1 < nT) A_LOAD(i + 1);
        const int buf = i & 1, key0 = A_KEY0(i); const bool isown = i < 4; const int pblk = isown ? own : ((i - 4) >> 2);
        const bool skipw = isown && (64 * i > 32 * w + 31);
        if (!skipw) {
        LAS unsigned char* Kb = lds + (buf ? A_KB1 : A_KB0); LAS unsigned char* Vb = lds + (buf ? A_VB1 : A_VB0);
        f32x4 sacc[2][4];
#pragma unroll
        for (int hf = 0; hf < 2; ++hf) { bf16x8 kf[8];
#pragma unroll
            for (int n2 = 0; n2 < 2; ++n2)
#pragma unroll
                for (int ks = 0; ks < 4; ++ks) kf[n2 * 4 + ks] = *(const LAS bf16x8*)(Kb + (16 * (2 * hf + n2) + c16) * A_KSTR + (32 * ks + 8 * g) * 2);
            __builtin_amdgcn_sched_barrier(0);
#pragma unroll
            for (int gi = 0; gi < 2; ++gi)
#pragma unroll
                for (int n2 = 0; n2 < 2; ++n2) { f32x4 a = (f32x4){0.f, 0.f, 0.f, 0.f};
#pragma unroll
                    for (int ks = 0; ks < 4; ++ks) a = MFMA16(kf[n2 * 4 + ks], qf[gi][ks], a);
                    sacc[gi][2 * hf + n2] = a; }
            __builtin_amdgcn_sched_barrier(0); }
        const bool far = (key0 + 63 + 128 <= t0 + 32 * w);
        const bool diag = isown && (64 * i + 63 > 32 * w);
        bf16x8 pf[2][2];
#pragma unroll
        for (int gi = 0; gi < 2; ++gi) {
            const int tq = tq0 + 16 * gi; const bool sel = isown || ((selmask[gi] >> pblk) & 1u);
            float sv[16]; float mloc, m_new, alpha;
            if (far) {
                const float bfar = tab[127];
                float mx = fmaxf(fmaxf(sacc[gi][0][0], sacc[gi][0][1]), fmaxf(sacc[gi][0][2], sacc[gi][0][3]));
#pragma unroll
                for (int nb = 1; nb < 4; ++nb) mx = fmaxf(mx, fmaxf(fmaxf(sacc[gi][nb][0], sacc[gi][nb][1]), fmaxf(sacc[gi][nb][2], sacc[gi][nb][3])));
                mloc = sel ? (mx * SCL2 + bfar) : NEG_INF;
                mloc = fmaxf(mloc, __shfl_xor(mloc, 16)); mloc = fmaxf(mloc, __shfl_xor(mloc, 32));
                m_new = fmaxf(m_run[gi], mloc); alpha = __builtin_amdgcn_exp2f(m_run[gi] - m_new);
                const float cadd = sel ? (bfar - m_new) : NEG_INF;
#pragma unroll
                for (int nb = 0; nb < 4; ++nb)
#pragma unroll
                    for (int r = 0; r < 4; ++r) sv[nb * 4 + r] = __builtin_amdgcn_exp2f(sacc[gi][nb][r] * SCL2 + cadd);
            } else {
                const int relb = tq - key0 - 4 * g; float bias[16];
#pragma unroll
                for (int nb = 0; nb < 4; ++nb)
#pragma unroll
                    for (int r = 0; r < 4; ++r) { const int rel = relb - 16 * nb - r; int ri = rel < 0 ? 0 : rel; ri = ri > 127 ? 127 : ri; bias[nb * 4 + r] = tab[ri]; }
                PIN16(bias, 0);
                mloc = NEG_INF;
#pragma unroll
                for (int nb = 0; nb < 4; ++nb)
#pragma unroll
                    for (int r = 0; r < 4; ++r) { const int rel = relb - 16 * nb - r;
                        float s = sacc[gi][nb][r] * SCL2 + bias[nb * 4 + r]; s = (!sel || (diag && rel < 0)) ? NEG_INF : s; sv[nb * 4 + r] = s; mloc = fmaxf(mloc, s); }
                mloc = fmaxf(mloc, __shfl_xor(mloc, 16)); mloc = fmaxf(mloc, __shfl_xor(mloc, 32));
                m_new = fmaxf(m_run[gi], mloc); alpha = __builtin_amdgcn_exp2f(m_run[gi] - m_new);
#pragma unroll
                for (int e = 0; e < 16; ++e) sv[e] = __builtin_amdgcn_exp2f(sv[e] - m_new);
            }
            float psum = 0.f;
#pragma unroll
            for (int e = 0; e < 16; ++e) psum += sv[e];
            l_run[gi] = l_run[gi] * alpha + psum; m_run[gi] = m_new;
#pragma unroll
            for (int db = 0; db < 8; ++db) oacc[gi][db] = oacc[gi][db] * alpha;
            pf[gi][0] = pack8(sv); pf[gi][1] = pack8(sv + 8);
        }
        __builtin_amdgcn_sched_barrier(0);
#pragma unroll
        for (int s = 0; s < 2; ++s) { s16x4 vlo[8], vhi[8];
#pragma unroll
            for (int db = 0; db < 8; ++db) { LAS unsigned char* va = Vb + (32 * s + 4 * g + q4) * A_VSTR + (16 * db + 4 * p4) * 2; vlo[db] = TR16(va); vhi[db] = TR16(va + 16 * A_VSTR); }
            __builtin_amdgcn_sched_barrier(0);
#pragma unroll
            for (int db = 0; db < 8; ++db) { const bf16x8 vf = __builtin_shufflevector(vlo[db], vhi[db], 0, 1, 2, 3, 4, 5, 6, 7);
                oacc[0][db] = MFMA16(vf, pf[0][s], oacc[0][db]); oacc[1][db] = MFMA16(vf, pf[1][s], oacc[1][db]); }
            __builtin_amdgcn_sched_barrier(0); }
        }
        if (i + 1 < nT) A_STORE((i + 1) & 1);
        __syncthreads();
    }
    bf16* const MIXp = F.HN(); float* const ssqp = F.ssq();
#pragma unroll
    for (int gi = 0; gi < 2; ++gi) {
        const int tq = tq0 + 16 * gi;
        float l_tot = l_run[gi]; l_tot += __shfl_xor(l_tot, 16); l_tot += __shfl_xor(l_tot, 32);
        const float inv = 1.f / l_tot; float ssq = 0.f;
        bf16* orow = MIXp + (rowbase + tq) * DM + h * 128 + 4 * g;
#pragma unroll
        for (int db = 0; db < 8; ++db) { const f32x4 o = oacc[gi][db] * inv; ssq += (o.x * o.x + o.y * o.y) + (o.z * o.z + o.w * o.w); v2u wv; wv.x = pk2(o.x, o.y); wv.y = pk2(o.z, o.w); *(GAS v2u*)(orow + 16 * db) = wv; }
        ssq += __shfl_xor(ssq, 16); ssq += __shfl_xor(ssq, 32);
        if (g == 0 && doatom) unsafeAtomicAdd(ssqp + (rowbase + tq) * 4 + 1, ssq);
    }
#undef A_KEY0
#undef A_LOAD
#undef A_STORE
}

constexpr int XBC_W = CONV_CH;
__device__ __forceinline__ void conv_phase(Frame& F) {
    const bf16* const PROJ = F.PROJ(); bf16* const XBC = F.XBC(); const float* const cw = F.conv_w(); const float* const cb = F.conv_b();
    const int gt = blockIdx.x * (NWAVES * 64) + fresh_tid(), GT = F.G * NWAVES * 64;
    for (int task = gt; task < (MTOK / 32) * (CONV_CH / 8); task += GT) {
        const int r = task / (CONV_CH / 8), k = task % (CONV_CH / 8), ch = 8 * k, tok0 = 32 * r;
        float wv[4][8], bias[8];
#pragma unroll
        for (int t = 0; t < 4; ++t) { const f32x4 w0 = *(const GAS f32x4*)(cw + t * CONV_CH + ch), w1 = *(const GAS f32x4*)(cw + t * CONV_CH + ch + 4);
            wv[t][0] = w0.x; wv[t][1] = w0.y; wv[t][2] = w0.z; wv[t][3] = w0.w; wv[t][4] = w1.x; wv[t][5] = w1.y; wv[t][6] = w1.z; wv[t][7] = w1.w; }
        { const f32x4 b0 = *(const GAS f32x4*)(cb + ch), b1 = *(const GAS f32x4*)(cb + ch + 4); bias[0] = b0.x; bias[1] = b0.y; bias[2] = b0.z; bias[3] = b0.w; bias[4] = b1.x; bias[5] = b1.y; bias[6] = b1.z; bias[7] = b1.w; }
        const bf16* src = PROJ + (size_t)tok0 * NPROJ + COL_XBC + ch; bf16* dst = XBC + (size_t)tok0 * XBC_W + ch;
        v4u p0 = (v4u){0u, 0u, 0u, 0u}, p1 = p0, p2 = p0;
        if ((tok0 & (SEQ - 1)) != 0) { p0 = *(const GAS v4u*)(src - 3 * (ptrdiff_t)NPROJ); p1 = *(const GAS v4u*)(src - 2 * (ptrdiff_t)NPROJ); p2 = *(const GAS v4u*)(src - (ptrdiff_t)NPROJ); }
#pragma unroll 1
        for (int i0 = 0; i0 < 32; i0 += 8) {
            v4u cur[8];
#pragma unroll
            for (int i = 0; i < 8; ++i) cur[i] = *(const GAS v4u*)(src + (size_t)(i0 + i) * NPROJ);
#pragma unroll
            for (int i = 0; i < 8; ++i) {
                const v4u c = cur[i]; float acc[8];
                const unsigned a0[4] = {p0.x, p0.y, p0.z, p0.w}, a1[4] = {p1.x, p1.y, p1.z, p1.w}, a2[4] = {p2.x, p2.y, p2.z, p2.w}, a3[4] = {c.x, c.y, c.z, c.w};
#pragma unroll
                for (int j = 0; j < 4; ++j) {
                    acc[2 * j] = bias[2 * j] + wv[0][2 * j] * bflo(a0[j]) + wv[1][2 * j] * bflo(a1[j]) + wv[2][2 * j] * bflo(a2[j]) + wv[3][2 * j] * bflo(a3[j]);
                    acc[2 * j + 1] = bias[2 * j + 1] + wv[0][2 * j + 1] * bfhi(a0[j]) + wv[1][2 * j + 1] * bfhi(a1[j]) + wv[2][2 * j + 1] * bfhi(a2[j]) + wv[3][2 * j + 1] * bfhi(a3[j]); }
#pragma unroll
                for (int j = 0; j < 8; ++j) acc[j] = silu_f(acc[j]);
                v4u o; o.x = pk2(acc[0], acc[1]); o.y = pk2(acc[2], acc[3]); o.z = pk2(acc[4], acc[5]); o.w = pk2(acc[6], acc[7]);
                *(GAS v4u*)(dst + (size_t)(i0 + i) * XBC_W) = o;
                p0 = p1; p1 = p2; p2 = c; }
        }
    }
    { const float* const dtraw = F.dtraw(); float* const dt2 = F.DT2(); const float* const dtb = F.dt_bias();
      for (int i = gt; i < MTOK * 16; i += GT) { const float xr = dtraw[i] + dtb[i & 15]; dt2[i] = xr > 20.f ? xr : log1pf(__expf(xr)); } }
}

constexpr int S_BSTR = 272, S_XSTR = 144;
constexpr int S_BM = 0, S_CM = 128 * S_BSTR, S_X = 2 * 128 * S_BSTR, S_XW = S_X + 128 * S_XSTR, S_HB = S_XW + 128 * S_XSTR, S_DT = S_HB + 64 * S_BSTR, S_CS = S_DT + 512, S_DA = S_CS + 512, S_END = S_DA + 512;
static_assert(S_END <= RING_BYTES, "ssd LDS map");
__device__ __forceinline__ void ssd_unit(Frame& F, int b, int h, const bool doatom = true) {
    LAS unsigned char* lds = F.lds + RING_OFF;
    const int tid = fresh_tid(), lane = tid & 63, w = __builtin_amdgcn_readfirstlane(tid >> 6), g = lane >> 4, c16 = lane & 15, q4 = c16 >> 2, p4 = lane & 3;
    const int g8 = h >> 3, pbw = w & 3, nhw = w >> 2;
    const float a_h = -__expf(F.a_log()[h]), dsk = F.d_skip()[h];
    const bf16* const PROJ = F.PROJ(); bf16* const MIX = F.HN(); const float* const dt2 = F.DT2(); const bf16* const XBC = F.XBC(); float* const ssqp = F.ssq();
    LAS float* dtl = (LAS float*)(lds + S_DT); LAS float* csl = (LAS float*)(lds + S_CS); LAS float* dal = (LAS float*)(lds + S_DA);
    for (int i = tid; i < 64 * S_BSTR / 16; i += NWAVES * 64) ((LAS v4u*)(lds + S_HB))[i] = (v4u){0u, 0u, 0u, 0u};
    f32x4 hacc[4];
#pragma unroll
    for (int i = 0; i < 4; ++i) hacc[i] = (f32x4){0.f, 0.f, 0.f, 0.f};
    const int xl = tid >> 3, xc = tid & 7, bl = tid >> 4, bc = tid & 15;
    v4u xr[2], br[4], cr[4]; float dtv = 0.f;
#define S_PREFETCH(cc) do { const size_t t0_ = (size_t)b * SEQ + (size_t)(cc) * SSM_L; \
        _Pragma("unroll") for (int i_ = 0; i_ < 2; ++i_) xr[i_] = *(const GAS v4u*)(XBC + (t0_ + xl + 64 * i_) * XBC_W + h * 64 + 8 * xc); \
        _Pragma("unroll") for (int i_ = 0; i_ < 4; ++i_) { const bf16* p_ = XBC + (t0_ + bl + 32 * i_) * XBC_W + 1024 + g8 * 128 + 8 * bc; br[i_] = *(const GAS v4u*)p_; cr[i_] = *(const GAS v4u*)(p_ + 256); } \
        if (tid < 128) dtv = dt2[(t0_ + tid) * 16 + h]; } while (0)
    S_PREFETCH(0);
    for (int c = 0; c < SSM_NC; ++c) {
        const size_t tok0 = (size_t)b * SEQ + (size_t)c * SSM_L;
        if (tid < 128) { dtl[tid] = dtv; dal[tid] = dtv * a_h; }
        __syncthreads();
        if (w == 0) { const float v0 = dal[2 * lane], v1 = dal[2 * lane + 1]; float s = v0 + v1;
#pragma unroll
            for (int o = 1; o < 64; o <<= 1) { const float t = __shfl_up(s, o); s += (lane >= o) ? t : 0.f; }
            csl[2 * lane] = s - v1; csl[2 * lane + 1] = s; }
        __syncthreads();
        const float cs_last = csl[127];
#pragma unroll
        for (int i = 0; i < 2; ++i) { const int l = xl + 64 * i; const v4u v = xr[i]; *(LAS v4u*)(lds + S_X + l * S_XSTR + xc * 16) = v; const float wl = dtl[l] * __expf(cs_last - csl[l]);
            v4u o2; o2.x = pk2(bflo(v.x) * wl, bfhi(v.x) * wl); o2.y = pk2(bflo(v.y) * wl, bfhi(v.y) * wl); o2.z = pk2(bflo(v.z) * wl, bfhi(v.z) * wl); o2.w = pk2(bflo(v.w) * wl, bfhi(v.w) * wl);
            *(LAS v4u*)(lds + S_XW + l * S_XSTR + xc * 16) = o2; }
#pragma unroll
        for (int i = 0; i < 4; ++i) { const int l = bl + 32 * i; *(LAS v4u*)(lds + S_BM + l * S_BSTR + bc * 16) = br[i]; *(LAS v4u*)(lds + S_CM + l * S_BSTR + bc * 16) = cr[i]; }
        const int lrow = 16 * w + c16;
        v2u zr[4];
#pragma unroll
        for (int pb = 0; pb < 4; ++pb) zr[pb] = *(const GAS v2u*)(PROJ + (tok0 + lrow) * NPROJ + COL_Z + h * 64 + 16 * pb + 4 * g);
        if (c + 1 < SSM_NC) S_PREFETCH(c + 1);
        __syncthreads();
        bf16x8 cf[4];
#pragma unroll
        for (int ks = 0; ks < 4; ++ks) cf[ks] = *(const LAS bf16x8*)(lds + S_CM + lrow * S_BSTR + (32 * ks + 8 * g) * 2);
        f32x4 yacc[4];
        const float cs_l = csl[lrow]; const float el = __expf(cs_l);
#pragma unroll
        for (int pb = 0; pb < 4; ++pb) { yacc[pb] = (f32x4){0.f, 0.f, 0.f, 0.f};
#pragma unroll
            for (int ks = 0; ks < 4; ++ks) { const bf16x8 hf = *(const LAS bf16x8*)(lds + S_HB + (16 * pb + c16) * S_BSTR + (32 * ks + 8 * g) * 2); yacc[pb] = MFMA16(hf, cf[ks], yacc[pb]); }
            yacc[pb] = yacc[pb] * el; }
        for (int s2 = 0; s2 <= (w >> 1); ++s2) {
            const int sb0 = 2 * s2, sb1 = 2 * s2 + 1; const bool has1 = sb1 <= w;
            f32x4 cb0 = (f32x4){0.f, 0.f, 0.f, 0.f}, cb1 = (f32x4){0.f, 0.f, 0.f, 0.f};
#pragma unroll
            for (int ks = 0; ks < 4; ++ks) { const bf16x8 bf0 = *(const LAS bf16x8*)(lds + S_BM + (16 * sb0 + c16) * S_BSTR + (32 * ks + 8 * g) * 2); cb0 = MFMA16(bf0, cf[ks], cb0); }
            if (has1) {
#pragma unroll
                for (int ks = 0; ks < 4; ++ks) { const bf16x8 bf1 = *(const LAS bf16x8*)(lds + S_BM + (16 * sb1 + c16) * S_BSTR + (32 * ks + 8 * g) * 2); cb1 = MFMA16(bf1, cf[ks], cb1); } }
            float mv[8];
#pragma unroll
            for (int r = 0; r < 4; ++r) { const int s = 16 * sb0 + 4 * g + r; const float e = __expf(fminf(cs_l - csl[s], 0.f)) * dtl[s]; mv[r] = (s <= lrow) ? cb0[r] * e : 0.f; }
#pragma unroll
            for (int r = 0; r < 4; ++r) { const int s = 16 * sb1 + 4 * g + r; const int sc_ = s > 127 ? 127 : s; const float e = __expf(fminf(cs_l - csl[sc_], 0.f)) * dtl[sc_]; mv[4 + r] = (has1 && s <= lrow) ? cb1[r] * e : 0.f; }
            const bf16x8 pf = pack8(mv);
#pragma unroll
            for (int pb = 0; pb < 4; ++pb) { LAS unsigned char* xa = lds + S_X + (32 * s2 + 4 * g + q4) * S_XSTR + (16 * pb + 4 * p4) * 2;
                const s16x4 lo = TR16(xa), hi = TR16(xa + 16 * S_XSTR); const bf16x8 xf = __builtin_shufflevector(lo, hi, 0, 1, 2, 3, 4, 5, 6, 7);
                yacc[pb] = MFMA16(xf, pf, yacc[pb]); }
        }
        { const size_t tok = tok0 + lrow; float ssq = 0.f;
#pragma unroll
          for (int pb = 0; pb < 4; ++pb) { const int p0 = 16 * pb + 4 * g;
              const v2u xs_ = *(const LAS v2u*)(lds + S_X + lrow * S_XSTR + p0 * 2);
              const v2u zr_ = zr[pb];
              const float o0 = (yacc[pb].x + bflo(xs_.x) * dsk) * silu_f(bflo(zr_.x)), o1 = (yacc[pb].y + bfhi(xs_.x) * dsk) * silu_f(bfhi(zr_.x));
              const float o2 = (yacc[pb].z + bflo(xs_.y) * dsk) * silu_f(bflo(zr_.y)), o3 = (yacc[pb].w + bfhi(xs_.y) * dsk) * silu_f(bfhi(zr_.y));
              ssq += (o0 * o0 + o1 * o1) + (o2 * o2 + o3 * o3);
              v2u wv; wv.x = pk2(o0, o1); wv.y = pk2(o2, o3); *(GAS v2u*)(MIX + tok * DM + ATT_W + h * 64 + p0) = wv; }
          ssq += __shfl_xor(ssq, 16); ssq += __shfl_xor(ssq, 32);
          if (g == 0 && doatom) unsafeAtomicAdd(ssqp + tok * 4 + 2 + g8, ssq); }
        { const float cdec = __expf(cs_last);
#pragma unroll
          for (int i = 0; i < 4; ++i) hacc[i] = hacc[i] * cdec;
#pragma unroll
          for (int ks = 0; ks < 4; ++ks) {
              LAS unsigned char* xa = lds + S_XW + (32 * ks + 8 * g + q4) * S_XSTR + (16 * pbw + 4 * p4) * 2;
              const s16x4 xlo = TR16(xa), xhi = TR16(xa + 4 * S_XSTR); const bf16x8 xf = __builtin_shufflevector(xlo, xhi, 0, 1, 2, 3, 4, 5, 6, 7);
#pragma unroll
              for (int i = 0; i < 4; ++i) { const int nb = 4 * nhw + i; LAS unsigned char* ba = lds + S_BM + (32 * ks + 8 * g + q4) * S_BSTR + (16 * nb + 4 * p4) * 2;
                  const s16x4 blo = TR16(ba), bhi = TR16(ba + 4 * S_BSTR); const bf16x8 bfr = __builtin_shufflevector(blo, bhi, 0, 1, 2, 3, 4, 5, 6, 7);
                  hacc[i] = MFMA16(bfr, xf, hacc[i]); } } }
        __syncthreads();
#pragma unroll
        for (int i = 0; i < 4; ++i) { const int nb = 4 * nhw + i; v2u o; o.x = pk2(hacc[i].x, hacc[i].y); o.y = pk2(hacc[i].z, hacc[i].w);
            *(LAS v2u*)(lds + S_HB + (16 * pbw + c16) * S_BSTR + (16 * nb + 4 * g) * 2) = o; }
    }
#undef S_PREFETCH
    __syncthreads();
}

__device__ __forceinline__ void mix_normalize(Frame& F) {
    const int tid_ = fresh_tid(), lane = tid_ & 63; const int gw = blockIdx.x * NWAVES + __builtin_amdgcn_readfirstlane(tid_ >> 6), NGW = F.G * NWAVES;
    const float* const ssqp = F.ssq(); bf16* const MIX = F.HN(); const float* const gatt = F.attn_out_norm(); const float* const gssm = F.ssm_out_norm();
    for (int m = gw; m < MTOK; m += NGW) {
        const float* sq = ssqp + (size_t)m * 4;
        const float s1 = __hip_atomic_load(sq + 1, RLX_AGENT), s2 = __hip_atomic_load(sq + 2, RLX_AGENT), s3 = __hip_atomic_load(sq + 3, RLX_AGENT);
        const float ra = 1.f / sqrtf(s1 * (1.f / 1024.f) + EPS), r0 = 1.f / sqrtf(s2 * (1.f / 512.f) + EPS), r1 = 1.f / sqrtf(s3 * (1.f / 512.f) + EPS);
        GAS v4u* row = (GAS v4u*)(MIX + (size_t)m * DM);
#pragma unroll
        for (int j = 0; j < 4; ++j) { const int idx = lane + 64 * j, col = 8 * idx; const float rs = (j < 2) ? ra : ((j == 2) ? r0 : r1);
            const float* gp = (j < 2) ? (gatt + col) : (gssm + (col - ATT_W));
            const f32x4 g0 = *(const GAS f32x4*)gp, g1 = *(const GAS f32x4*)(gp + 4); const v4u v = row[idx]; v4u o;
            o.x = pk2(bflo(v.x) * rs * g0.x, bfhi(v.x) * rs * g0.y); o.y = pk2(bflo(v.y) * rs * g0.z, bfhi(v.y) * rs * g0.w);
            o.z = pk2(bflo(v.z) * rs * g1.x, bfhi(v.z) * rs * g1.y); o.w = pk2(bflo(v.w) * rs * g1.z, bfhi(v.w) * rs * g1.w); row[idx] = o; }
    }
}

constexpr int P_EIDX = 0, P_GATE = 16384, P_LST = 32768, P_HN = 65536, P_ACT = 98304, P_END = 102400;
static_assert(P_END <= RING_BYTES, "peer LDS map");
__constant__ unsigned char PEER_CAND[52] = {0, 1, 2, 3, 4, 5, 6, 7, 8, 9, 10, 11, 12, 13, 14, 15, 16, 17, 18, 19, 20, 21, 22, 23, 32, 33, 34, 35, 36, 48, 49, 50, 51, 64, 65, 66, 80, 81, 96, 97, 112, 113, 128, 144, 160, 176, 192, 208, 224, 240, 255, 255};
__device__ __forceinline__ unsigned f2ord(float f) { const unsigned u = __builtin_bit_cast(unsigned, f); return u ^ ((u >> 31) ? 0xFFFFFFFFu : 0x80000000u); }
__device__ __forceinline__ float ord2f(unsigned u) { return __builtin_bit_cast(float, u ^ ((u >> 31) ? 0x80000000u : 0xFFFFFFFFu)); }
#define CSWAPD(a, b) do { const unsigned hi_ = (a) > (b) ? (a) : (b), lo_ = (a) > (b) ? (b) : (a); (a) = hi_; (b) = lo_; } while (0)
template <int N> __device__ __forceinline__ void bitonic_sort_desc(unsigned (&v)[N]) {
#pragma unroll
    for (int k = 2; k <= N; k <<= 1)
#pragma unroll
        for (int j = k >> 1; j > 0; j >>= 1)
#pragma unroll
            for (int i = 0; i < N; ++i) { const int l = i ^ j; if (l > i) { if ((i & k) == 0) CSWAPD(v[i], v[l]); else CSWAPD(v[l], v[i]); } }
}
__device__ __forceinline__ void merge16_xor(unsigned (&v)[16], int dist) {
    unsigned o[16];
#pragma unroll
    for (int i = 0; i < 16; ++i) o[i] = (unsigned)__shfl_xor((int)v[i], dist);
#pragma unroll
    for (int i = 0; i < 16; ++i) v[i] = v[i] > o[15 - i] ? v[i] : o[15 - i];
#pragma unroll
    for (int j = 8; j > 0; j >>= 1)
#pragma unroll
        for (int i = 0; i < 16; ++i) { const int l = i ^ j; if (l > i) CSWAPD(v[i], v[l]); }
}
__device__ __forceinline__ float gelu_erf(float x) { return 0.5f * x * (1.f + erff(x * 0.70710678118654752f)); }
__device__ __forceinline__ float fp4_dec1(unsigned n) { const unsigned m = n & 7u; unsigned bits = (m >= 2u) ? (((126u + (m >> 1)) << 23) | ((m & 1u) << 22)) : (m ? 0x3F000000u : 0u); bits |= (n & 8u) << 28; return __builtin_bit_cast(float, bits); }
__device__ __forceinline__ f32x2 fp4_dec2(unsigned x) { f32x2 r; r.x = fp4_dec1(x & 15u); r.y = fp4_dec1((x >> 4) & 15u); return r; }
typedef long i64;
typedef int v8i __attribute__((ext_vector_type(8)));
__device__ __forceinline__ void peer_unit(Frame& F, int u, const bool dry = false) {
    LAS unsigned char* lds = F.lds + RING_OFF;
    const int tid_ = fresh_tid(), lane = tid_ & 63, w = __builtin_amdgcn_readfirstlane(tid_ >> 6), g = lane >> 4, c16 = lane & 15;
    const int T0 = 32 * u;
    LAS int* eidx = (LAS int*)(lds + P_EIDX); LAS float* gate = (LAS float*)(lds + P_GATE);
    LAS unsigned* lst = (LAS unsigned*)(lds + P_LST) + w * 1024;
    const bf16* const QP = F.QP(); const bf16* const SK = F.SK(); float* const outp = F.out(); const bf16* const X1B = F.X1B(); const float* const fgain = F.ffn_norm(); const float* const fing = F.final_norm(); const unsigned char* const U8 = F.U8(); const unsigned char* const V8 = F.V8();
#ifndef NO_ROUTE
    for (int tb = 0; tb < 2; ++tb) {
        for (int c = 0; c < 2; ++c) {
            const int p = 2 * w + c;
            bf16x8 qf[4];
            { const unsigned qo = ((unsigned)(T0 + 16 * tb + c16) * (unsigned)DM + (unsigned)(p * 128 + 8 * g)) * 2u;
#pragma unroll
              for (int ks = 0; ks < 4; ++ks) qf[ks] = *(const GAS bf16x8*)((const unsigned char*)QP + (qo + 64u * ks)); }
            unsigned key[32];
#pragma unroll
            for (int kb = 0; kb < 8; ++kb) { f32x4 acc = (f32x4){0.f, 0.f, 0.f, 0.f};
                const unsigned so = ((unsigned)(p * 128 + 16 * kb + c16) * 128u + 8u * (unsigned)g) * 2u;
#pragma unroll
                for (int ks = 0; ks < 4; ++ks) { const bf16x8 sf = *(const GAS bf16x8*)((const unsigned char*)SK + (so + 64u * ks)); acc = MFMA16(sf, qf[ks], acc); }
#pragma unroll
                for (int r = 0; r < 4; ++r) key[kb * 4 + r] = (f2ord(acc[r]) & ~0x7Fu) | (unsigned)(16 * kb + 4 * g + r);
                __builtin_amdgcn_sched_barrier(0); }
            bitonic_sort_desc<32>(key);
            unsigned top[16];
#pragma unroll
            for (int i = 0; i < 16; ++i) top[i] = key[i];
            merge16_xor(top, 16); merge16_xor(top, 32);
            if (g == 0) { LAS v4u* d = (LAS v4u*)(lst + (c * 32 + 16 * tb + c16) * 16);
                d[0] = (v4u){top[0], top[1], top[2], top[3]}; d[1] = (v4u){top[4], top[5], top[6], top[7]}; d[2] = (v4u){top[8], top[9], top[10], top[11]}; d[3] = (v4u){top[12], top[13], top[14], top[15]}; }
        }
        LDS_WAIT();
        const LAS unsigned* l1 = lst + (16 * tb + c16) * 16; const LAS unsigned* l2 = lst + (32 + 16 * tb + c16) * 16;
        unsigned ck[16];
#pragma unroll
        for (int k = 0; k < 13; ++k) { const unsigned ab = PEER_CAND[4 * k + g]; const unsigned a = ab >> 4, bq = ab & 15u;
            const float s = ord2f(l1[a] & ~0x7Fu) + ord2f(l2[bq] & ~0x7Fu); ck[k] = (ab == 255u) ? 0u : ((f2ord(s) & ~0xFFu) | ab); }
        ck[13] = 0u; ck[14] = 0u; ck[15] = 0u;
        bitonic_sort_desc<16>(ck);
        merge16_xor(ck, 16); merge16_xor(ck, 32);
        if (g == 0) { const int tl = 16 * tb + c16; const float m = ord2f(ck[0] & ~0xFFu); float e[16]; float sum = 0.f;
#pragma unroll
            for (int k = 0; k < 16; ++k) { e[k] = __expf(ord2f(ck[k] & ~0xFFu) - m); sum += e[k]; }
            const float inv = 1.f / sum;
#pragma unroll
            for (int k = 0; k < 16; ++k) { const unsigned a = (ck[k] >> 4) & 15u, bq = ck[k] & 15u; const int ex = (int)((l1[a] & 0x7Fu) * 128u + (l2[bq] & 0x7Fu));
                eidx[tl * 128 + w * 16 + k] = ex; gate[tl * 128 + w * 16 + k] = e[k] * inv; } }
    }
#endif
    __syncthreads();
    LAS unsigned char* hnb = lds + P_HN + w * 4096; LAS float* actl = (LAS float*)(lds + P_ACT) + w * 128;
    const LAS unsigned char* hb = hnb + 64 * g;
    v4u bA[8], bB[8];
#define U_ISSUE(buf, e_, jb) do { const unsigned uo_ = (unsigned)(e_) * (unsigned)ROWB + 16u * (unsigned)g + 512u * (unsigned)(jb); \
        _Pragma("unroll") for (int jj = 0; jj < 8; ++jj) buf[jj] = *(const GAS v4u*)(U8 + (uo_ + 64u * jj)); __builtin_amdgcn_sched_barrier(0); } while (0)
#define U_CONSUME(buf, jb) do { _Pragma("unroll") for (int jj = 0; jj < 8; ++jj) { const v4u a_ = buf[jj]; const unsigned aw_[4] = {a_.x, a_.y, a_.z, a_.w}; \
        _Pragma("unroll") for (int m = 0; m < 4; ++m) { \
            const v4u af_ = {__builtin_bit_cast(unsigned, __builtin_amdgcn_cvt_scalef32_pk_bf16_fp4(aw_[m], 1.0f, 0)), __builtin_bit_cast(unsigned, __builtin_amdgcn_cvt_scalef32_pk_bf16_fp4(aw_[m], 1.0f, 1)), \
                             __builtin_bit_cast(unsigned, __builtin_amdgcn_cvt_scalef32_pk_bf16_fp4(aw_[m], 1.0f, 2)), __builtin_bit_cast(unsigned, __builtin_amdgcn_cvt_scalef32_pk_bf16_fp4(aw_[m], 1.0f, 3))}; \
            const bf16x8 bf_ = *(const LAS bf16x8*)(hb + 256 * (8 * (jb) + jj) + 16 * m); \
            acc = MFMA16(__builtin_bit_cast(bf16x8, af_), bf_, acc); } } __builtin_amdgcn_sched_barrier(0); } while (0)
#define U_ACT(grp_) do { if (c16 == 0) { const int k0 = 16 * (grp_) + 4 * g; constexpr float isc = 1.f / SU; const f32x4 gt = *(const LAS f32x4*)(gate + tl * 128 + k0); \
        f32x4 a4; a4.x = gelu_erf(acc.x * isc) * gt.x; a4.y = gelu_erf(acc.y * isc) * gt.y; a4.z = gelu_erf(acc.z * isc) * gt.z; a4.w = gelu_erf(acc.w * isc) * gt.w; *(LAS f32x4*)(actl + k0) = a4; } } while (0)
#define V_ISSUE(buf, kb_) do { _Pragma("unroll") for (int kk = 0; kk < 8; ++kk) { const int e_ = eidx[tl * 128 + 8 * (kb_) + kk]; const unsigned vo_ = (unsigned)e_ * (unsigned)ROWB + 16u * (unsigned)lane; \
        buf[kk] = *(const GAS v4u*)(V8 + vo_); } __builtin_amdgcn_sched_barrier(0); } while (0)
#ifdef FP4_SOFT_DEC
#define FP4_DEC(x) fp4_dec2(x)
#else
#define FP4_DEC(x) __builtin_amdgcn_cvt_scalef32_pk_f32_fp4((x), 1.0f, 0)
#endif
#ifdef FP4_SWAP_DEC
#define FP4_ACC(oa, ob, d) do { oa += a_ * d.y; ob += a_ * d.x; } while (0)
#else
#define FP4_ACC(oa, ob, d) do { oa += a_ * d.x; ob += a_ * d.y; } while (0)
#endif
#define V_CONSUME(buf, kb_) do { _Pragma("unroll") for (int kk = 0; kk < 8; ++kk) { const float a_ = actl[8 * (kb_) + kk]; \
        const unsigned vw[4] = {buf[kk].x, buf[kk].y, buf[kk].z, buf[kk].w}; \
        _Pragma("unroll") for (int q = 0; q < 4; ++q) { \
            const f32x2 d0 = __builtin_amdgcn_cvt_scalef32_pk_f32_fp4(vw[q], 1.0f, 0), d1 = __builtin_amdgcn_cvt_scalef32_pk_f32_fp4(vw[q], 1.0f, 1), d2 = __builtin_amdgcn_cvt_scalef32_pk_f32_fp4(vw[q], 1.0f, 2), d3 = __builtin_amdgcn_cvt_scalef32_pk_f32_fp4(vw[q], 1.0f, 3); \
            FP4_ACC(o[8 * q], o[8 * q + 1], d0); FP4_ACC(o[8 * q + 2], o[8 * q + 3], d1); FP4_ACC(o[8 * q + 4], o[8 * q + 5], d2); FP4_ACC(o[8 * q + 6], o[8 * q + 7], d3); } \
        PIN16(o, 0); PIN16(o, 16); } } while (0)
#ifndef NO_GATHER
    int e_cur = eidx[w * 128 + c16];
    v2u xn[8];
#define X_ISSUE(tok_) do { const unsigned xb_ = (unsigned)(tok_) * (unsigned)(DM * 2) + 8u * (unsigned)lane; _Pragma("unroll") for (int j = 0; j < 8; ++j) xn[j] = *(const GAS v2u*)((const unsigned char*)X1B + (xb_ + 512u * j)); } while (0)
    X_ISSUE(T0 + w);
    U_ISSUE(bA, e_cur, 0);
    for (int ti = 0; ti < 4; ++ti) {
        const int tl = w + 8 * ti; const size_t token = (size_t)T0 + tl;
        f32x4 xr[8]; float ss = 0.f;
        const unsigned xo = (unsigned)token * (unsigned)(DM * 4) + 16u * (unsigned)lane;
        {
#pragma unroll
          for (int j = 0; j < 8; ++j) { const v2u r = xn[j]; xr[j] = (f32x4){bflo(r.x), bfhi(r.x), bflo(r.y), bfhi(r.y)}; }
#pragma unroll
          for (int j = 0; j < 8; ++j) ss += (xr[j].x * xr[j].x + xr[j].y * xr[j].y) + (xr[j].z * xr[j].z + xr[j].w * xr[j].w); }
        const float rs2 = __builtin_amdgcn_rsqf(wave_sum(ss) * (1.f / DM) + EPS);
        {
          const float* fg_ = fgain; asm volatile("" : "+s"(fg_));
          const unsigned char* gp = (const unsigned char*)fg_; const unsigned go = 16u * (unsigned)lane;
#pragma unroll
          for (int j2 = 0; j2 < 4; ++j2) { const f32x4 g0 = *(const GAS f32x4*)(gp + (go + 2048u * j2)), g1 = *(const GAS f32x4*)(gp + (go + 2048u * j2 + 1024u));
              const f32x4 h0 = xr[2 * j2] * g0 * rs2, h1 = xr[2 * j2 + 1] * g1 * rs2; v4u o8; o8.x = pk2(h0.x, h0.y); o8.y = pk2(h0.z, h0.w); o8.z = pk2(h1.x, h1.y); o8.w = pk2(h1.z, h1.w);
              *(LAS v4u*)(hnb + 64 * lane + 16 * j2) = o8; } }
        LDS_WAIT();
#pragma unroll 1
        for (int grp = 0; grp < 8; ++grp) {
            const int gn = grp < 7 ? grp + 1 : 7;
            const int e_nxt = eidx[tl * 128 + 16 * gn + c16];
            f32x4 acc = (f32x4){0.f, 0.f, 0.f, 0.f};
            U_ISSUE(bB, e_cur, 1); U_CONSUME(bA, 0);
            if (grp < 7) U_ISSUE(bA, e_nxt, 0); else V_ISSUE(bA, 0);
            U_CONSUME(bB, 1);
            U_ACT(grp);
            e_cur = e_nxt;
        }
        LDS_WAIT();
        float o[32];
#pragma unroll
        for (int i = 0; i < 32; ++i) o[i] = 0.f;
#pragma unroll 1
        for (int kb = 0; kb < 16; kb += 2) {
            V_ISSUE(bB, kb + 1); V_CONSUME(bA, kb);
            if (kb + 2 < 16) V_ISSUE(bA, kb + 2);
            else if (ti < 3) { e_cur = eidx[(tl + 8) * 128 + c16]; X_ISSUE(token + 8); U_ISSUE(bA, e_cur, 0); }
            V_CONSUME(bB, kb + 1);
        }
        { constexpr float isv = 1.f / SV; float s2 = 0.f;
#pragma unroll
          for (int j = 0; j < 8; ++j) { xr[j] = xr[j] + (f32x4){o[4 * j], o[4 * j + 1], o[4 * j + 2], o[4 * j + 3]} * isv;
              s2 += (xr[j].x * xr[j].x + xr[j].y * xr[j].y) + (xr[j].z * xr[j].z + xr[j].w * xr[j].w); }
          const float rf = __builtin_amdgcn_rsqf(wave_sum(s2) * (1.f / DM) + EPS);
          const float* fi_ = fing; asm volatile("" : "+s"(fi_));
          const unsigned char* fp = (const unsigned char*)fi_; unsigned char* op = (unsigned char*)outp; const unsigned fo = 16u * (unsigned)lane;
          if (!dry || rf == 1.2345e30f)
#pragma unroll
          for (int j = 0; j < 8; ++j) *(GAS f32x4*)(op + (xo + 1024u * j)) = xr[j] * rf * *(const GAS f32x4*)(fp + (fo + 1024u * j)); }
    }
#endif
#undef U_ISSUE
#undef X_ISSUE
#undef U_ACT
#undef U_CONSUME
#undef V_ISSUE
#undef V_CONSUME
    __syncthreads();
}

__global__ void __launch_bounds__(NWAVES * 64, 2) hybrid_fwd(Args args) {
    extern __shared__ __attribute__((aligned(16))) unsigned char lds[];
    Frame F;
    F.lds = (LAS unsigned char*)lds;
    F.MISC = (volatile LAS unsigned*)(F.lds + MISC_OFF);
    F.tid = threadIdx.x; F.lane = F.tid & 63; F.wave = __builtin_amdgcn_readfirstlane(F.tid >> 6); F.G = gridDim.x;
    for (int u = F.tid; u < (LDS_BYTES - LDSCTL_OFF) / 4; u += NWAVES * 64) ((LAS unsigned*)(F.lds + LDSCTL_OFF))[u] = 0u;
    __syncthreads();
    (void)args;
    XcdBarrier bar = xcd_barrier_post(F.ctl() + CW_BAR, F.MISC + 8);

#ifndef NO_P0
#ifdef PROBE_P0X2
    { int reps = 2; asm volatile("" : "+s"(reps)); for (int rep = 0; rep < reps; ++rep) p0_prologue(F); }
#else
    p0_prologue(F);
#endif
#endif
    xcd_barrier(bar);
#ifndef NO_P1
#ifdef PROBE_GX2
    { int reps = 2; asm volatile("" : "+s"(reps)); for (int rep = 0; rep < reps; ++rep) {
#else
    { { const int rep = 0, reps = 1;
#endif
      pg8::Gemm gm{F.HN(), F.WinT(), MTOK, NPAD, DM}; pg8::StaticOrder S; S.init(MTOK, NPAD, F.G, (int)blockIdx.x);
      EpiProj E{F.PROJ(), F.dtraw(), (rep + 1 < reps) ? nullptr : F.kmean()};
      pg8::gemm_phase<EpiProj, pg8::StaticOrder, PG8_ALIGN, PG8_SP2>(F.lds + RING_OFF, gm, S, E); } }
#endif
    xcd_barrier(bar);
#ifdef PROBE_P15X2
    conv_phase(F);
#endif
    conv_phase(F);
    xcd_barrier(bar);
#ifdef PROBE_P2X2
    { int reps = 2; asm volatile("" : "+s"(reps)); for (int rep = 0; rep < reps; ++rep) {
#else
    { { const int rep = 0, reps = 1;
#endif
    const bool doatom = rep + 1 == reps;
    for (;;) {
        if (F.tid == 0) F.MISC[0] = xb_add(F.ctl() + CW_Q2 + 64 * rep, 1u);
        __syncthreads();
        const int ui = (int)F.MISC[0];
        __syncthreads();
        if (ui >= 128 + 512) break;
#ifdef PROBE_P2_SSD
        if (ui < 128 || doatom)
#endif
#ifdef PROBE_P2_ATT
        if (ui >= 128 || doatom)
#endif
        {
        if (ui < 128) ssd_unit(F, ui >> 4, ui & 15, doatom);
        else { const int a = ui - 128; attn_unit(F, (a & 63) >> 3, a & 7, 7 - (a >> 6), doatom); }
        }
    } } }
    xcd_barrier(bar);
#ifndef NO_P3
#ifdef PROBE_GX2
    { int reps = 2; asm volatile("" : "+s"(reps)); for (int rep = 0; rep < reps; ++rep) {
#else
    { { const int rep = 0, reps = 1;
#endif
      pg8::Gemm gm{F.HN(), F.WoutT(), MTOK, DM, DM}; pg8::StaticOrder S; S.init(MTOK, DM, F.G, (int)blockIdx.x);
      {
        const int t_ = fresh_tid(); pg8::Unit uu; const float* const sq = F.ssq();
        if (S.next(t_ >> 8, uu)) { const int row = uu.pm * 256 + (t_ & 255);
            const float q1 = __hip_atomic_load(sq + (size_t)row * 4 + 1, RLX_AGENT), q2 = __hip_atomic_load(sq + (size_t)row * 4 + 2, RLX_AGENT), q3 = __hip_atomic_load(sq + (size_t)row * 4 + 3, RLX_AGENT);
            const float sa = __builtin_amdgcn_rsqf(q1 * (1.f / 1024.f) + EPS), s0 = __builtin_amdgcn_rsqf(q2 * (1.f / 512.f) + EPS), s1 = __builtin_amdgcn_rsqf(q3 * (1.f / 512.f) + EPS);
            *(LAS f32x4*)(F.lds + SEGTAB_OFF + t_ * 16) = (f32x4){sa / s0, s0 / s1, s1, 0.f}; }
        __syncthreads(); }
      EpiOut E{F.x(), F.X1B(), F.ssq(), rep + 1 == reps, (const LAS f32x4*)(F.lds + SEGTAB_OFF)};
      pg8::gemm_phase<EpiOut, pg8::StaticOrder, PG8_ALIGN, PG8_SP2>(F.lds + RING_OFF, gm, S, E); } }
#endif
    xcd_barrier(bar);
#ifndef NO_P4
#ifdef PROBE_GX2
    { int reps = 2; asm volatile("" : "+s"(reps)); for (int rep = 0; rep < reps; ++rep) {
#else
    { { const int rep = 0, reps = 1; (void)rep; (void)reps;
#endif
      pg8::Gemm gm{F.X1B(), F.WqT(), MTOK, DM, DM}; pg8::StaticOrder S; S.init(MTOK, DM, F.G, (int)blockIdx.x);
      EpiQ E{F.QP(), F.ssq()};
      pg8::gemm_phase<EpiQ, pg8::StaticOrder, PG8_ALIGN, PG8_SP2>(F.lds + RING_OFF, gm, S, E); } }
#endif
    xcd_barrier(bar);
#ifndef NO_P5
#ifdef PROBE_P5X2
    { int reps = 2; asm volatile("" : "+s"(reps));
      for (int rep = 0; rep < reps; ++rep) for (int u = blockIdx.x; u < MTOK / 32; u += F.G) peer_unit(F, u, rep + 1 < reps); }
#else
    for (int u = blockIdx.x; u < MTOK / 32; u += F.G) peer_unit(F, u);
#endif
#endif
}

extern "C" void kernel_launch(void* const* d_in, const int* in_sizes, int n_in, void* d_out, int out_size, void* d_ws, size_t ws_size, hipStream_t stream) {
    static int grid = 0;
    if (grid == 0) {
        if (n_in != 18 || out_size != MTOK * DM || ws_size < WS_END) { fprintf(stderr, "kernel_launch: unexpected shapes (n_in %d, out %d, ws %zu)\n", n_in, out_size, ws_size); grid = -1; return; }
        int dev = 0, cus = 0, per_cu = 0;
        if (hipGetDevice(&dev) != hipSuccess || hipDeviceGetAttribute(&cus, hipDeviceAttributeMultiprocessorCount, dev) != hipSuccess) { grid = -1; return; }
        if (hipFuncSetAttribute((const void*)hybrid_fwd, hipFuncAttributeMaxDynamicSharedMemorySize, LDS_BYTES) != hipSuccess) { fprintf(stderr, "kernel_launch: hipFuncSetAttribute failed\n"); grid = -1; return; }
        if (hipOccupancyMaxActiveBlocksPerMultiprocessor(&per_cu, (const void*)hybrid_fwd, NWAVES * 64, LDS_BYTES) != hipSuccess || per_cu < 1)
            fprintf(stderr, "kernel_launch: note: occupancy query reports %d workgroups per CU\n", per_cu);
        (void)hipGetLastError();
        grid = cus;
    }
    if (grid < 0) return;
    if (hipMemsetAsync((char*)d_ws + WS_CTL, 0, CTL_ZERO_BYTES, stream) != hipSuccess) return;
    Args a{};
    for (int i = 0; i < 18; ++i) a.in[i] = (const float*)d_in[i];
    a.out = (float*)d_out; a.ws = (unsigned char*)d_ws;
    hipLaunchKernelGGL(hybrid_fwd, dim3(grid), dim3(NWAVES * 64), LDS_BYTES, stream, a);
}
```

```cpp
#include <hip/hip_runtime.h>
#include <cstdio>
#include <cstdint>
namespace pg8 {
#define PG8_LAS __attribute__((address_space(3)))
typedef unsigned short bf16_t;
typedef short bf16x8 __attribute__((ext_vector_type(8)));
typedef float f32x4 __attribute__((ext_vector_type(4)));
typedef unsigned u32x4 __attribute__((ext_vector_type(4)));
constexpr int BM = 256, BK = 64, HALF = 128, HTB = HALF * BK * 2  , STAGE_BYTES = 8 * HTB, NXCD = 8, WGM = 8;

__host__ __device__ __forceinline__ int lds_byte(int r, int c) { const int st = (r >> 4) * 2 + (c >> 5), rr = r & 15, cc = c & 31, ob = rr * 64 + cc * 2; return st * 1024 + (ob ^ (((ob >> 9) & 1) << 5)); }
__host__ __device__ __forceinline__ void stage_rc(int b, int& R, int& C) { const int st = b / 1024, sb = b % 1024, swz = sb ^ (((sb >> 9) & 1) << 5); R = (st >> 1) * 16 + swz / 64; C = (st & 1) * 32 + (swz % 64) / 2; }
__host__ __device__ __forceinline__ int perm32(int rho) { const int n = rho >> 4, i = rho & 15; return 8 * (i >> 2) + 4 * n + (i & 3); }

struct Unit { int pm, pn; };
struct Gemm { const bf16_t* A; const bf16_t* Bt; int M, N, K; };

struct StaticOrder {
    int nM, nN, nwg, G, c;
    __host__ __device__ void init(int M, int N, int G_, int c_) { nM = M / BM; nN = N / BM; nwg = nM * nN; G = G_; c = c_; }
    __host__ __device__ bool next(int i, Unit& u) const {
        const long L = (long)i * G + c; if (L >= nwg) return false;
        int wgid = (int)L; { const int q = nwg / NXCD, r = nwg % NXCD, xcd = wgid % NXCD, off = wgid / NXCD; wgid = (xcd < r ? xcd * (q + 1) : r * (q + 1) + (xcd - r) * q) + off; }
        const int nig = WGM * nN, gid = wgid / nig, fm = gid * WGM, gsz = (nM - fm) < WGM ? (nM - fm) : WGM;
        u.pm = fm + ((wgid % nig) % gsz); u.pn = (wgid % nig) / gsz; return true;
    }
    __device__ __forceinline__ void a_ready(const Unit&) const {}
    __device__ __forceinline__ void done(const Unit&) const {}
};

__device__ __forceinline__ unsigned cvt_pk_bf16(float lo, float hi) { unsigned r; asm volatile("v_cvt_pk_bf16_f32 %0, %1, %2" : "=v"(r) : "v"(lo), "v"(hi)); return r; }
typedef float f32x2 __attribute__((ext_vector_type(2)));
__device__ __forceinline__ f32x2 gelu_pk(f32x2 v) {
    const f32x2 av = __builtin_elementwise_abs(v), d = av * 0.2316418882f + 1.0f;
    f32x2 t; t.x = __builtin_amdgcn_rcpf(d.x); t.y = __builtin_amdgcn_rcpf(d.y);
    f32x2 q = t * 0.5307027145f + (-0.7265760135f); q = q * t + 0.7107068705f; q = q * t + (-0.142248368f); q = q * t + 0.127414796f; q = q * t;
    const f32x2 s = (v * v) * (-0.72134752044f);
    f32x2 e; e.x = __builtin_amdgcn_exp2f(s.x); e.y = __builtin_amdgcn_exp2f(s.y);
    const f32x2 m = v * (q * e), r = v - m;
    f32x2 o; o.x = v.x < 0.f ? m.x : r.x; o.y = v.y < 0.f ? m.y : r.y; return o;
}

template <int ACT  > struct EpiBf16 {
    static constexpr bool PERM = true, AFTER_DRAIN = false, SEG = false; static_assert(ACT == 0 || ACT == 1, "EpiBf16: ACT is 0 (none) or 1 (gelu_pk)");
    bf16_t* O; int ldc; const float* bias; int split_cols; size_t split_stride; float scale0;
    __device__ __forceinline__ void operator()(const f32x4 (&acc)[2][2][4][2], const Unit& u, int wr, int wc, int fr, int fq) const {
        const int row0 = u.pm * BM + wr * 64 + fr; int colt = u.pn * BM; bf16_t* base = O;
        float sc = 1.f; if (split_cols) { const int t = colt / split_cols; base += (size_t)t * split_stride; colt -= t * split_cols; if (t == 0) sc = scale0; }
        const int col0 = colt + wc * 32 + 8 * fq, bcol0 = u.pn * BM + wc * 32 + 8 * fq;
        f32x4 bv[2][2];
#pragma unroll
        for (int bj = 0; bj < 2; ++bj)
#pragma unroll
            for (int n = 0; n < 2; ++n) bv[bj][n] = bias ? *(const f32x4*)(bias + bcol0 + bj * HALF + 4 * n) : (f32x4){0.f, 0.f, 0.f, 0.f};
#pragma unroll
        for (int ai = 0; ai < 2; ++ai)
#pragma unroll
            for (int m = 0; m < 4; ++m) { bf16_t* rowp = base + (size_t)(row0 + ai * HALF + m * 16) * ldc + col0;
#pragma unroll
                for (int bj = 0; bj < 2; ++bj) { f32x4 v0 = acc[ai][bj][m][0] + bv[bj][0], v1 = acc[ai][bj][m][1] + bv[bj][1];
                    if (ACT == 1) { f32x2 a = gelu_pk((f32x2){v0[0], v0[1]}), b = gelu_pk((f32x2){v0[2], v0[3]}), c = gelu_pk((f32x2){v1[0], v1[1]}), d = gelu_pk((f32x2){v1[2], v1[3]});
                        v0 = (f32x4){a.x, a.y, b.x, b.y}; v1 = (f32x4){c.x, c.y, d.x, d.y}; }
                    v0 = v0 * sc; v1 = v1 * sc; u32x4 w; w.x = cvt_pk_bf16(v0[0], v0[1]); w.y = cvt_pk_bf16(v0[2], v0[3]); w.z = cvt_pk_bf16(v1[0], v1[1]); w.w = cvt_pk_bf16(v1[2], v1[3]);
                    *(u32x4*)(rowp + bj * HALF) = w; } }
    }
};
template <class Epi, class Sched, bool ALIGN_EPI = false, bool SP2 = false>
__device__ __forceinline__ void gemm_phase(PG8_LAS unsigned char* lds, const Gemm g, const Sched& S, const Epi& E) {
    const int tid = threadIdx.x, wid = __builtin_amdgcn_readfirstlane(tid >> 6), lane = tid & 63, wr = wid >> 2, wc = wid & 3, fr = lane & 15, fq = lane >> 4;
    const int K = g.K, nt = K / BK;
    unsigned voffA[2], voffB[2];
#pragma unroll
    for (int i = 0; i < 2; ++i) { int R, C; stage_rc(tid * 16 + i * 8192, R, C); const int Rb = Epi::PERM ? ((R & ~31) + perm32(R & 31)) : R;
        voffA[i] = (unsigned)(R * K + C) * 2u; voffB[i] = (unsigned)(Rb * K + C) * 2u; }
    const size_t kstep = (size_t)(BK * 2);
    const size_t hstep = (size_t)HALF * K * 2;
    const size_t tstep = 2 * hstep;
    const unsigned ldsw = (unsigned)wid * 1024u;
    const int aoff = lds_byte(wr * 64 + fr, fq * 8), boff = lds_byte(wc * 32 + fr, fq * 8);
#define PG8_SA(b, h) (((b) * 2 + (h)) * HTB)
#define PG8_SB(b, h) ((4 + (b) * 2 + (h)) * HTB)
#define PG8_STAGE(bufoff, gbase, voff) do { _Pragma("unroll") for (int _i = 0; _i < 2; ++_i) \
        __builtin_amdgcn_global_load_lds((const unsigned*)((const char*)(gbase) + (voff)[_i]), (PG8_LAS unsigned*)(lds + (bufoff) + ldsw + _i * 8192), 16, 0, 0); } while (0)
#define PG8_LDA(dst, b, h) do { _Pragma("unroll") for (int m = 0; m < 4; ++m) _Pragma("unroll") for (int k = 0; k < 2; ++k) dst[m][k] = *(const PG8_LAS bf16x8*)(lds + PG8_SA(b, h) + aoff + m * 2048 + k * 1024); } while (0)
#define PG8_LDB(dst, b, h) do { _Pragma("unroll") for (int n = 0; n < 2; ++n) _Pragma("unroll") for (int k = 0; k < 2; ++k) dst[n][k] = *(const PG8_LAS bf16x8*)(lds + PG8_SB(b, h) + boff + n * 2048 + k * 1024); } while (0)
#define PG8_MMA(ai, bj, At, Bt) do { __builtin_amdgcn_s_setprio(1); _Pragma("unroll") for (int m = 0; m < 4; ++m) _Pragma("unroll") for (int n = 0; n < 2; ++n) _Pragma("unroll") for (int k = 0; k < 2; ++k) \
        acc[ai][bj][m][n] = __builtin_amdgcn_mfma_f32_16x16x32_bf16(Bt[n][k], At[m][k], acc[ai][bj][m][n], 0, 0, 0); __builtin_amdgcn_s_setprio(0); } while (0)
#define PG8_WAIT_V(n) asm volatile("s_waitcnt vmcnt(" #n ")" ::: "memory")
#define PG8_WAIT_L(n) asm volatile("s_waitcnt lgkmcnt(" #n ")" ::: "memory")
#define PG8_BAR __builtin_amdgcn_s_barrier()
#define PG8_SCHED __builtin_amdgcn_sched_barrier(0)
    Unit cur, nxt; int ui = 0;
    if (!S.next(0, cur)) return;
    f32x4 acc[2][2][4][2];
#pragma unroll
    for (int a = 0; a < 2; ++a)
#pragma unroll
        for (int b = 0; b < 2; ++b)
#pragma unroll
            for (int m = 0; m < 4; ++m)
#pragma unroll
                for (int n = 0; n < 2; ++n) acc[a][b][m][n] = (f32x4){0.f, 0.f, 0.f, 0.f};
    bf16x8 At[4][2], B0[2][2], B1[2][2];
    const char* cA = (const char*)g.A + (size_t)cur.pm * tstep; const char* cB = (const char*)g.Bt + (size_t)cur.pn * tstep;
    S.a_ready(cur);
    float segr[16];
    if constexpr (Epi::SEG) E.seg_load(ui, wr, fr, segr);
    if constexpr (SP2) {
        PG8_STAGE(PG8_SB(0, 0), cB, voffB); PG8_STAGE(PG8_SB(0, 1), cB + hstep, voffB); PG8_STAGE(PG8_SA(0, 0), cA, voffA); PG8_STAGE(PG8_SA(0, 1), cA + hstep, voffA);
        if (wr == 1) PG8_BAR;
        PG8_WAIT_V(2); PG8_BAR;
        PG8_STAGE(PG8_SB(1, 0), cB + kstep, voffB); PG8_STAGE(PG8_SA(1, 0), cA + kstep, voffA); PG8_STAGE(PG8_SB(1, 1), cB + hstep + kstep, voffB);
        PG8_WAIT_V(6); PG8_BAR;
    } else {
        PG8_STAGE(PG8_SB(0, 0), cB, voffB); PG8_STAGE(PG8_SA(0, 0), cA, voffA); PG8_STAGE(PG8_SB(0, 1), cB + hstep, voffB); PG8_STAGE(PG8_SA(0, 1), cA + hstep, voffA);
        if (wr == 1) PG8_BAR;
        PG8_WAIT_V(4); PG8_BAR;
        PG8_STAGE(PG8_SB(1, 0), cB + kstep, voffB); PG8_STAGE(PG8_SA(1, 0), cA + kstep, voffA); PG8_STAGE(PG8_SB(1, 1), cB + hstep + kstep, voffB);
        PG8_WAIT_V(6); PG8_BAR;
    }
    for (;;) {
        const bool has_next = S.next(ui + 1, nxt);
        const char* nA = has_next ? (const char*)g.A + (size_t)nxt.pm * tstep : cA; const char* nB = has_next ? (const char*)g.Bt + (size_t)nxt.pn * tstep : cB;
        int t = 0;
#pragma unroll 1
        for (int sgi = 0; sgi < (Epi::SEG ? 3 : 1); ++sgi) {
        int tend = nt; if constexpr (Epi::SEG) tend = (sgi == 0) ? Epi::SEG_T1 : ((sgi == 1) ? Epi::SEG_T2 : nt);
        for (; t < tend; t += 2) {
            const bool last = (t == nt - 2);
            const char* a1 = cA + (size_t)(t + 1) * kstep;
            const char* a2 = last ? nA : cA + (size_t)(t + 2) * kstep; const char* b2 = last ? nB : cB + (size_t)(t + 2) * kstep;
            const char* a3 = a2 + kstep; const char* b3 = b2 + kstep;
            if (last && has_next) S.a_ready(nxt);
            if constexpr (SP2) {
            PG8_LDB(B0, 0, 0); PG8_LDB(B1, 0, 1); PG8_SCHED; PG8_LDA(At, 0, 0); PG8_STAGE(PG8_SA(1, 1), a1 + hstep, voffA);
            PG8_WAIT_V(8); PG8_WAIT_L(0); PG8_BAR; PG8_MMA(0, 0, At, B0); PG8_MMA(0, 1, At, B1); PG8_BAR; PG8_SCHED;
            PG8_LDA(At, 0, 1); PG8_STAGE(PG8_SB(0, 0), b2, voffB); PG8_STAGE(PG8_SB(0, 1), b2 + hstep, voffB); PG8_STAGE(PG8_SA(0, 0), a2, voffA);
            PG8_WAIT_V(8); PG8_WAIT_L(0); PG8_BAR; PG8_MMA(1, 0, At, B0); PG8_MMA(1, 1, At, B1); PG8_BAR; PG8_SCHED;
            PG8_LDB(B0, 1, 0); PG8_LDB(B1, 1, 1); PG8_SCHED; PG8_LDA(At, 1, 0); PG8_STAGE(PG8_SA(0, 1), a2 + hstep, voffA);
            PG8_WAIT_V(8); PG8_WAIT_L(0); PG8_BAR; PG8_MMA(0, 0, At, B0); PG8_MMA(0, 1, At, B1); PG8_BAR; PG8_SCHED;
            PG8_LDA(At, 1, 1); PG8_STAGE(PG8_SB(1, 0), b3, voffB); PG8_STAGE(PG8_SB(1, 1), b3 + hstep, voffB); PG8_STAGE(PG8_SA(1, 0), a3, voffA);
            PG8_WAIT_V(8); PG8_WAIT_L(0); PG8_BAR; PG8_MMA(1, 0, At, B0); PG8_MMA(1, 1, At, B1); PG8_BAR; PG8_SCHED;
            } else {
            PG8_LDB(B0, 0, 0); PG8_SCHED; PG8_LDA(At, 0, 0); PG8_STAGE(PG8_SA(1, 1), a1 + hstep, voffA);
            PG8_WAIT_L(8); PG8_BAR; PG8_WAIT_L(0); PG8_MMA(0, 0, At, B0); PG8_BAR; PG8_SCHED;
            PG8_LDB(B1, 0, 1); PG8_STAGE(PG8_SB(0, 0), b2, voffB);
            PG8_BAR; PG8_WAIT_L(0); PG8_MMA(0, 1, At, B1); PG8_BAR;
            PG8_LDA(At, 0, 1); PG8_STAGE(PG8_SA(0, 0), a2, voffA);
            PG8_BAR; PG8_WAIT_L(0); PG8_MMA(1, 0, At, B0); PG8_BAR; PG8_SCHED;
            PG8_STAGE(PG8_SB(0, 1), b2 + hstep, voffB);
            PG8_WAIT_V(6); PG8_BAR; PG8_MMA(1, 1, At, B1); PG8_BAR;
            PG8_LDB(B0, 1, 0); PG8_SCHED; PG8_LDA(At, 1, 0); PG8_STAGE(PG8_SA(0, 1), a2 + hstep, voffA);
            PG8_WAIT_L(8); PG8_BAR; PG8_WAIT_L(0); PG8_MMA(0, 0, At, B0); PG8_BAR; PG8_SCHED;
            PG8_LDB(B1, 1, 1); PG8_STAGE(PG8_SB(1, 0), b3, voffB);
            PG8_BAR; PG8_WAIT_L(0); PG8_MMA(0, 1, At, B1); PG8_BAR;
            PG8_LDA(At, 1, 1); PG8_STAGE(PG8_SA(1, 0), a3, voffA);
            PG8_BAR; PG8_WAIT_L(0); PG8_MMA(1, 0, At, B0); PG8_BAR; PG8_SCHED;
            PG8_STAGE(PG8_SB(1, 1), b3 + hstep, voffB);
            PG8_WAIT_V(6); PG8_BAR; PG8_MMA(1, 1, At, B1); PG8_BAR;
            }
        }
        if constexpr (Epi::SEG) E.seg_apply(acc, segr, sgi);
        }
        if constexpr (ALIGN_EPI) { if (wr == 0) PG8_BAR; }
        if constexpr (!Epi::AFTER_DRAIN) { if constexpr (Epi::SEG) E(acc, cur, wr, wc, fr, fq, ui); else E(acc, cur, wr, wc, fr, fq); S.done(cur); }
        if (!has_next) break;
#pragma unroll
        for (int a = 0; a < 2; ++a)
#pragma unroll
            for (int b = 0; b < 2; ++b)
#pragma unroll
                for (int m = 0; m < 4; ++m)
#pragma unroll
                    for (int n = 0; n < 2; ++n) acc[a][b][m][n] = (f32x4){0.f, 0.f, 0.f, 0.f};
        cur = nxt; cA = nA; cB = nB; ++ui;
        if constexpr (Epi::SEG) E.seg_load(ui, wr, fr, segr);
        if constexpr (ALIGN_EPI) { if (wr == 1) PG8_BAR; }
    }
    PG8_WAIT_V(0);
    if constexpr (!ALIGN_EPI) { if (wr == 0) PG8_BAR; }
    PG8_BAR;
    if constexpr (Epi::AFTER_DRAIN) { E.fused(acc, cur, wr, wc, fr, fq, lds, wid, lane); S.done(cur); }
#undef PG8_SA
#undef PG8_SB
#undef PG8_STAGE
#undef PG8_LDA
#undef PG8_LDB
#undef PG8_MMA
#undef PG8_WAIT_V
#undef PG8_WAIT_L
#undef PG8_BAR
#undef PG8_SCHED
}
}
#ifndef PG8_SP2
#define PG8_SP2 true
#endif
#ifndef PG8_ALIGN
#define PG8_ALIGN true
#endif

constexpr int BATCH = 8, SEQ = 2048, DM = 2048, MTOK = BATCH * SEQ;
constexpr int ATT_W = 1024, ATT_H = 8, ATT_HD = 128, MOBA_BLK = 256, NBLK = SEQ / MOBA_BLK;
constexpr int SSM_W = 1024, SSM_H = 16, SSM_P = 64, SSM_N = 128, SSM_L = 128, SSM_NC = SEQ / SSM_L, CONV_CH = 1536;
constexpr int IN_PROJ = 5648, NPROJ = 5632  , NPAD = 5888  ;
constexpr int COL_Q = 0, COL_K = 1024, COL_V = 2048, COL_Z = 3072, COL_XBC = 4096;
constexpr int PEER_H = 8, PEER_NK = 128, PEER_K = 16, PEER_HK = 128;
constexpr float EPS = 1e-6f;
constexpr float SU = 64.f, SV = 4.f, SH = 16.f, SLO = 16.f;
constexpr float SH4 = 1.5f, SLO4 = 4.f;
constexpr int ROWB = DM / 2;

constexpr size_t MiB = 1u << 20;
constexpr size_t WS_CTL = 0, CTL_ZERO_BYTES = 1 * MiB;
constexpr size_t WS_DT = 1 * MiB;
constexpr size_t WS_SK = 2 * MiB;
constexpr size_t WS_WIN = 4 * MiB;
constexpr size_t WS_WOUT = 28 * MiB;
constexpr size_t WS_WQ = 36 * MiB;
constexpr size_t WS_HN = 44 * MiB;
constexpr size_t WS_PROJ = 108 * MiB;
constexpr size_t WS_X1B = WS_PROJ, WS_QP = WS_PROJ + 64 * MiB;
constexpr size_t WS_U8 = 284 * MiB, WS_V8 = 316 * MiB;
constexpr size_t WS_XBC = 348 * MiB;
constexpr size_t WS_DT2 = 3 * MiB;
constexpr size_t WS_END = 396 * MiB;
constexpr int CW_BAR = 4096;
constexpr int CW_Q2 = 8192;
constexpr int CW_KMEAN = 32768;
constexpr int CW_SSQ = 131072;
static_assert((CW_SSQ + MTOK * 4) * 4 <= (int)CTL_ZERO_BYTES, "CTL words inside the memset region");

constexpr int RING_OFF = 0, RING_BYTES = 131072;
constexpr int LDSCTL_OFF = RING_BYTES, MISC_OFF = LDSCTL_OFF + 320;
constexpr int SEGTAB_OFF = LDSCTL_OFF + 1024;
constexpr int LDS_BYTES = 147456;
constexpr int NWAVES = 8;

#define GAS __attribute__((address_space(1)))
#define LAS __attribute__((address_space(3)))
typedef unsigned short bf16;
typedef unsigned v4u __attribute__((ext_vector_type(4)));
typedef unsigned v2u __attribute__((ext_vector_type(2)));
typedef float f32x4 __attribute__((ext_vector_type(4)));
typedef float f32x2 __attribute__((ext_vector_type(2)));
typedef short bf16x8 __attribute__((ext_vector_type(8)));
typedef short s16x4 __attribute__((ext_vector_type(4)));
typedef GAS unsigned gu32;
#define RLX_AGENT __ATOMIC_RELAXED, __HIP_MEMORY_SCOPE_AGENT
#define LDS_WAIT() asm volatile("s_waitcnt lgkmcnt(0)" ::: "memory")
#define VM_WAIT() asm volatile("s_waitcnt vmcnt(0)" ::: "memory")
__device__ __forceinline__ unsigned f2bf(float f) { unsigned u = __builtin_bit_cast(unsigned, f); return (u + 0x7fffu + ((u >> 16) & 1u)) >> 16; }
typedef __bf16 bf16v2 __attribute__((ext_vector_type(2)));
__device__ __forceinline__ unsigned pk2(float lo, float hi) { bf16v2 v; v.x = (__bf16)lo; v.y = (__bf16)hi; return __builtin_bit_cast(unsigned, v); }
__device__ __forceinline__ float bflo(unsigned w) { return __builtin_bit_cast(float, w << 16); }
__device__ __forceinline__ float bfhi(unsigned w) { return __builtin_bit_cast(float, w & 0xffff0000u); }
__device__ __forceinline__ float wave_sum(float v) {
#pragma unroll
    for (int o = 1; o < 64; o <<= 1) v += __shfl_xor(v, o);
    return v;
}
__device__ __forceinline__ float silu_f(float x) { return x * __builtin_amdgcn_rcpf(1.f + __expf(-x)); }

#define XB_TMO      128
#define XB_XCNT(j)  (256  + 64 * (j))
#define XB_XSUB(j)  (1280 + 64 * (j))
#define XB_XGEN(j)  (2304 + 64 * (j))
#define XB_TOP      3328
#define XB_TOPGEN   3392
#define XCD_BAR_WORDS 3456
#define XB_SPIN_CAP (1u << 18)

__device__ __forceinline__ unsigned xb_ld(unsigned* p)              { return __hip_atomic_load(p, __ATOMIC_RELAXED, __HIP_MEMORY_SCOPE_AGENT); }
__device__ __forceinline__ unsigned xb_add(unsigned* p, unsigned v) { return __hip_atomic_fetch_add(p, v, __ATOMIC_RELAXED, __HIP_MEMORY_SCOPE_AGENT); }
__device__ __forceinline__ unsigned xb_xcc_id() { return (unsigned)__builtin_amdgcn_s_getreg((3 << 11) | 20) & 0xFu; }
#define XB_SPIN(cond, bar) do { unsigned _sp = 0; while (cond) { __builtin_amdgcn_s_sleep(1); \
    if ((++_sp & 255u) == 0u) { if (xb_ld(&(bar)[XB_TMO])) break; if (_sp > XB_SPIN_CAP) { atomicAdd(&(bar)[XB_TMO], 1u); break; } } } } while (0)

struct XcdBarrier {
    unsigned* bar; unsigned x;
    volatile LAS unsigned* st;
};
__device__ __forceinline__ XcdBarrier xcd_barrier_post(unsigned* bar, volatile LAS unsigned* st) {
    XcdBarrier b; b.bar = bar; b.x = xb_xcc_id(); b.st = st;
    if (threadIdx.x == 0) (void)xb_add(&bar[XB_XCNT(b.x)], 1u);
    return b;
}
__device__ __forceinline__ void xcd_barrier_complete(unsigned* bar, unsigned x, unsigned& nloc, unsigned& nx) {
    const unsigned G = gridDim.x * gridDim.y * gridDim.z;
    unsigned sum, cnt, mine, sp = 0u;
    for (;;) {
        sum = 0u; cnt = 0u; mine = 0u;
#pragma unroll
        for (unsigned j = 0; j < 16; ++j) { const unsigned c = xb_ld(&bar[XB_XCNT(j)]); sum += c; cnt += (c > 0u) ? 1u : 0u; mine = (j == x) ? c : mine; }
        if (sum == G) break;
        __builtin_amdgcn_s_sleep(1);
        if ((++sp & 255u) == 0u) { if (xb_ld(&bar[XB_TMO])) break; if (sp > XB_SPIN_CAP) { atomicAdd(&bar[XB_TMO], 1u); break; } }
    }
    nloc = mine > 0u ? mine : 1u; nx = cnt > 0u ? cnt : 1u;
}
__device__ __forceinline__ void xcd_barrier(const XcdBarrier& b) {
    asm volatile("s_waitcnt vmcnt(0)" ::: "memory");
    __syncthreads();
    if (threadIdx.x == 0) {
        unsigned* bar = b.bar;
        __builtin_amdgcn_s_waitcnt(0);
        unsigned nloc = b.st[0], nx = b.st[1];
        if (nloc == 0u) { xcd_barrier_complete(bar, b.x, nloc, nx); b.st[0] = nloc; b.st[1] = nx; }
        const unsigned old = xb_add(&bar[XB_XSUB(b.x)], 1u);
        const unsigned gen = old / nloc;
        if (old + 1u == (gen + 1u) * nloc) {
            __builtin_amdgcn_fence(__ATOMIC_RELEASE, "agent");
            asm volatile("s_waitcnt vmcnt(0)" ::: "memory");
            const unsigned og = xb_add(&bar[XB_TOP], 1u);
            const unsigned tg = og / nx;
            if (og + 1u == (tg + 1u) * nx) xb_add(&bar[XB_TOPGEN], 1u);
            else XB_SPIN(xb_ld(&bar[XB_TOPGEN]) == tg, bar);
            __builtin_amdgcn_fence(__ATOMIC_ACQUIRE, "agent");
            xb_add(&bar[XB_XGEN(b.x)], 1u);
            asm volatile("s_waitcnt vmcnt(0)" ::: "memory");
        } else {
            XB_SPIN(xb_ld(&bar[XB_XGEN(b.x)]) == gen, bar);
            __builtin_amdgcn_fence(__ATOMIC_ACQUIRE, "agent");
            asm volatile("s_waitcnt vmcnt(0)" ::: "memory");
        }
    }
    __syncthreads();
}

#define CAS __attribute__((address_space(4)))
struct Args { const float* in[18]; float* out; unsigned char* ws; };
__device__ __forceinline__ const CAS unsigned char* kargs() { const CAS unsigned char* p = (const CAS unsigned char*)__builtin_amdgcn_kernarg_segment_ptr(); asm volatile("" : "+s"(p)); return p; }
__device__ __forceinline__ const float* kin(int i) { return *(const float* const CAS*)(kargs() + 8 * i); }
__device__ __forceinline__ float* kout() { return *(float* const CAS*)(kargs() + 8 * 18); }
__device__ __forceinline__ unsigned char* kws() { return *(unsigned char* const CAS*)(kargs() + 8 * 19); }
__device__ __forceinline__ int fresh_tid() { int t = threadIdx.x; asm volatile("" : "+v"(t)); return t; }
struct Frame {
    LAS unsigned char* lds;
    volatile LAS unsigned* MISC;
    int tid, lane, wave, G;
    __device__ __forceinline__ const float* x() const { return kin(0); }
    __device__ __forceinline__ const float* attn_norm() const { return kin(1); }
    __device__ __forceinline__ const float* w_in() const { return kin(2); }
    __device__ __forceinline__ const float* conv_w() const { return kin(3); }
    __device__ __forceinline__ const float* conv_b() const { return kin(4); }
    __device__ __forceinline__ const float* dt_bias() const { return kin(5); }
    __device__ __forceinline__ const float* a_log() const { return kin(6); }
    __device__ __forceinline__ const float* d_skip() const { return kin(7); }
    __device__ __forceinline__ const float* rel_bias() const { return kin(8); }
    __device__ __forceinline__ const float* attn_out_norm() const { return kin(9); }
    __device__ __forceinline__ const float* ssm_out_norm() const { return kin(10); }
    __device__ __forceinline__ const float* w_out() const { return kin(11); }
    __device__ __forceinline__ const float* ffn_norm() const { return kin(12); }
    __device__ __forceinline__ const float* peer_wq() const { return kin(13); }
    __device__ __forceinline__ const float* peer_sk() const { return kin(14); }
    __device__ __forceinline__ const float* peer_u() const { return kin(15); }
    __device__ __forceinline__ const float* peer_v() const { return kin(16); }
    __device__ __forceinline__ const float* final_norm() const { return kin(17); }
    __device__ __forceinline__ float* out() const { return kout(); }
    __device__ __forceinline__ unsigned* ctl() const { return (unsigned*)(kws() + WS_CTL); }
    __device__ __forceinline__ float* dtraw() const { return (float*)(kws() + WS_DT); }
    __device__ __forceinline__ bf16* SK() const { return (bf16*)(kws() + WS_SK); }
    __device__ __forceinline__ bf16* WinT() const { return (bf16*)(kws() + WS_WIN); }
    __device__ __forceinline__ bf16* WoutT() const { return (bf16*)(kws() + WS_WOUT); }
    __device__ __forceinline__ bf16* WqT() const { return (bf16*)(kws() + WS_WQ); }
    __device__ __forceinline__ bf16* HN() const { return (bf16*)(kws() + WS_HN); }
    __device__ __forceinline__ bf16* PROJ() const { return (bf16*)(kws() + WS_PROJ); }
    __device__ __forceinline__ bf16* X1B() const { return (bf16*)(kws() + WS_X1B); }
    __device__ __forceinline__ bf16* QP() const { return (bf16*)(kws() + WS_QP); }
    __device__ __forceinline__ unsigned char* U8() const { return kws() + WS_U8; }
    __device__ __forceinline__ unsigned char* V8() const { return kws() + WS_V8; }
    __device__ __forceinline__ bf16* XBC() const { return (bf16*)(kws() + WS_XBC); }
    __device__ __forceinline__ float* DT2() const { return (float*)(kws() + WS_DT2); }
    __device__ __forceinline__ float* kmean() const { return (float*)(kws() + WS_CTL) + CW_KMEAN; }
    __device__ __forceinline__ float* ssq() const { return (float*)(kws() + WS_CTL) + CW_SSQ; }
};

__device__ __forceinline__ void p0_transpose_item(const float* W, int K, int N, bf16* WT, const float* gain, LAS float* scr, int item, int lane) {
    const int nblk = (N + 31) / 32, kb = item / nblk, nb = item % nblk, k0 = 64 * kb, n0 = 32 * nb;
    const int kr = lane >> 3, nc = (lane & 7) * 4; const bool ok = (n0 + nc) < N;
    f32x4 v[8]; float gk[8];
#pragma unroll
    for (int i = 0; i < 8; ++i) { const int kk = 8 * i + kr; v[i] = ok ? *(const GAS f32x4*)(W + (size_t)(k0 + kk) * N + n0 + nc) : (f32x4){0.f, 0.f, 0.f, 0.f}; gk[i] = gain ? gain[k0 + kk] : 1.f; }
#pragma unroll
    for (int i = 0; i < 8; ++i) { const int kk = 8 * i + kr; LAS float* d = scr + kk * 33 + nc; d[0] = v[i].x * gk[i]; d[1] = v[i].y * gk[i]; d[2] = v[i].z * gk[i]; d[3] = v[i].w * gk[i]; }
    LDS_WAIT(); asm volatile("" ::: "memory");
    const int c = lane & 7;
#pragma unroll
    for (int j = 0; j < 4; ++j) { const int n = (lane >> 3) + 8 * j; const LAS float* s = scr + (8 * c) * 33 + n;
        v4u o; o.x = pk2(s[0 * 33], s[1 * 33]); o.y = pk2(s[2 * 33], s[3 * 33]); o.z = pk2(s[4 * 33], s[5 * 33]); o.w = pk2(s[6 * 33], s[7 * 33]);
        *(GAS v4u*)(WT + (size_t)(n0 + n) * K + k0 + 8 * c) = o; }
    LDS_WAIT(); asm volatile("" ::: "memory");
}
__device__ __forceinline__ void rms_2rows_to_bf16(const float* x0, const float* x1, const float* gain, bf16* o0, bf16* o1, int lane) {
    const GAS f32x4* xr0 = (const GAS f32x4*)x0 + lane; const GAS f32x4* xr1 = (const GAS f32x4*)x1 + lane; const GAS f32x4* gr = (const GAS f32x4*)gain + lane;
    f32x4 v[8], u[8]; float s = 0.f, t = 0.f;
#pragma unroll
    for (int j = 0; j < 8; ++j) { v[j] = xr0[64 * j]; u[j] = xr1[64 * j]; }
#pragma unroll
    for (int j = 0; j < 8; ++j) { s += (v[j].x * v[j].x + v[j].y * v[j].y) + (v[j].z * v[j].z + v[j].w * v[j].w); t += (u[j].x * u[j].x + u[j].y * u[j].y) + (u[j].z * u[j].z + u[j].w * u[j].w); }
    const float rs = __builtin_amdgcn_rsqf(wave_sum(s) * (1.f / DM) + EPS), rt = __builtin_amdgcn_rsqf(wave_sum(t) * (1.f / DM) + EPS);
    GAS v2u* p0 = (GAS v2u*)o0 + lane; GAS v2u* p1 = (GAS v2u*)o1 + lane;
#pragma unroll
    for (int j = 0; j < 8; ++j) { const f32x4 g = gr[64 * j]; v2u a, b;
        a.x = pk2(v[j].x * rs * g.x, v[j].y * rs * g.y); a.y = pk2(v[j].z * rs * g.z, v[j].w * rs * g.w); p0[64 * j] = a;
        b.x = pk2(u[j].x * rt * g.x, u[j].y * rt * g.y); b.y = pk2(u[j].z * rt * g.z, u[j].w * rt * g.w); p1[64 * j] = b; }
}
#ifdef PROBE_FP4EMU
__device__ __forceinline__ float fp4grid(float y) { const float a = fabsf(y); float r;
    if (a <= 2.f) r = rintf(a * 2.f) * 0.5f; else if (a <= 4.f) r = rintf(a); else r = (a < 5.f) ? 4.f : 6.f;
    return copysignf(r, y); }
__device__ __forceinline__ float clampf(float v, float lim) { if (lim == 448.5f) return fp4grid(v * (1.f / 16.f)) * 16.f; return fminf(fmaxf(v, -lim), lim); }
#else
__device__ __forceinline__ float clampf(float v, float lim) { return fminf(fmaxf(v, -lim), lim); }
#endif
template <int TAB = 0> __device__ __forceinline__ v4u cvt16_fp8(const f32x4 a, const f32x4 b, const f32x4 c, const f32x4 d, float sc) {
    v4u o; int w; constexpr float LIM = TAB ? 448.5f : 448.f;
    w = __builtin_amdgcn_cvt_pk_fp8_f32(clampf(a.x * sc, LIM), clampf(a.y * sc, LIM), 0, false); w = __builtin_amdgcn_cvt_pk_fp8_f32(clampf(a.z * sc, LIM), clampf(a.w * sc, LIM), w, true); o.x = (unsigned)w;
    w = __builtin_amdgcn_cvt_pk_fp8_f32(clampf(b.x * sc, LIM), clampf(b.y * sc, LIM), 0, false); w = __builtin_amdgcn_cvt_pk_fp8_f32(clampf(b.z * sc, LIM), clampf(b.w * sc, LIM), w, true); o.y = (unsigned)w;
    w = __builtin_amdgcn_cvt_pk_fp8_f32(clampf(c.x * sc, LIM), clampf(c.y * sc, LIM), 0, false); w = __builtin_amdgcn_cvt_pk_fp8_f32(clampf(c.z * sc, LIM), clampf(c.w * sc, LIM), w, true); o.z = (unsigned)w;
    w = __builtin_amdgcn_cvt_pk_fp8_f32(clampf(d.x * sc, LIM), clampf(d.y * sc, LIM), 0, false); w = __builtin_amdgcn_cvt_pk_fp8_f32(clampf(d.z * sc, LIM), clampf(d.w * sc, LIM), w, true); o.w = (unsigned)w;
    return o;
}
__device__ __forceinline__ void tables_convert(Frame& F, size_t lo, size_t hi, size_t tix, size_t ntx) {
      const GAS f32x4* su = (const GAS f32x4*)F.peer_u(); const GAS f32x4* sv = (const GAS f32x4*)F.peer_v(); GAS v4u* du = (GAS v4u*)F.U8(); GAS v4u* dv = (GAS v4u*)F.V8();
#pragma unroll 1
      for (int tab = 0; tab < 2; ++tab) { const GAS f32x4* src = tab ? sv : su; GAS v4u* dst = tab ? dv : du; const float sc = tab ? SV : SU;
        f32x4 nx[8]; const size_t i0 = lo + tix;
        if (i0 < hi) { const GAS f32x4* p = src + (i0 >> 6) * 512 + (i0 & 63);
#pragma unroll
            for (int j = 0; j < 8; ++j) nx[j] = p[64 * j]; }
#pragma unroll 1
        for (size_t i = i0; i < hi; i += ntx) { f32x4 v[8];
#pragma unroll
            for (int j = 0; j < 8; ++j) v[j] = nx[j];
            if (i + ntx < hi) { const size_t i2 = i + ntx; const GAS f32x4* p = src + (i2 >> 6) * 512 + (i2 & 63);
#pragma unroll
                for (int j = 0; j < 8; ++j) nx[j] = p[64 * j]; }
            unsigned wd[4];
#pragma unroll
            for (int q = 0; q < 4; ++q) { const f32x4 a = v[2 * q] * sc, b = v[2 * q + 1] * sc; unsigned w = 0u;
                w = __builtin_amdgcn_cvt_scalef32_pk_fp4_f32(w, clampf(a.x, 6.f), clampf(a.y, 6.f), 1.0f, 0); w = __builtin_amdgcn_cvt_scalef32_pk_fp4_f32(w, clampf(a.z, 6.f), clampf(a.w, 6.f), 1.0f, 1);
                w = __builtin_amdgcn_cvt_scalef32_pk_fp4_f32(w, clampf(b.x, 6.f), clampf(b.y, 6.f), 1.0f, 2); w = __builtin_amdgcn_cvt_scalef32_pk_fp4_f32(w, clampf(b.z, 6.f), clampf(b.w, 6.f), 1.0f, 3); wd[q] = w; }
            dst[i] = (v4u){wd[0], wd[1], wd[2], wd[3]}; } }
}
constexpr size_t TAB_ITEMS = (size_t)16384 * 64;
__device__ __forceinline__ size_t tab_split(int G) { const int rem = ((MTOK / 256) * (NPAD / 256)) % G; return rem ? (TAB_ITEMS / 8) * 5 : TAB_ITEMS; }
__device__ __forceinline__ unsigned fp4_code(float y) { const float a = fabsf(y);
    const unsigned m = (unsigned)(a >= 0.25f) + (unsigned)(a >= 0.75f) + (unsigned)(a >= 1.25f) + (unsigned)(a >= 1.75f) + (unsigned)(a >= 2.5f) + (unsigned)(a >= 3.5f) + (unsigned)(a >= 5.0f);
    return m | ((y < 0.f) ? 8u : 0u); }
__device__ __forceinline__ void p0_prologue(Frame& F) {
    const int tid = fresh_tid(), lane = tid & 63, wave = __builtin_amdgcn_readfirstlane(tid >> 6);
    LAS float* scr = (LAS float*)(F.lds + RING_OFF + wave * 16384);
    const int gw = blockIdx.x * NWAVES + wave, NGW = F.G * NWAVES;
    constexpr int I_IN = (DM / 64) * ((IN_PROJ + 31) / 32), I_SQ = (DM / 64) * (DM / 32);
    constexpr int NITEMS = I_IN + 2 * I_SQ;
    { const float* const w_in = F.w_in(); const float* const w_out = F.w_out(); const float* const wq = F.peer_wq(); const float* const fg = F.ffn_norm(); bf16* const WinT = F.WinT(); bf16* const WoutT = F.WoutT(); bf16* const WqT = F.WqT(); const float* const gatt = F.attn_out_norm(); const float* const gssm = F.ssm_out_norm();
      for (int it = gw; it < NITEMS; it += NGW) {
        int r = it;
        if (r < I_IN) { p0_transpose_item(w_in, DM, IN_PROJ, WinT, nullptr, scr, r, lane); continue; } r -= I_IN;
        if (r < I_SQ) { const int k0_ = 64 * (r / (DM / 32)); p0_transpose_item(w_out, DM, DM, WoutT, (k0_ < ATT_W) ? gatt : (gssm - ATT_W), scr, r, lane); continue; } r -= I_SQ;
        p0_transpose_item(wq, DM, DM, WqT, fg, scr, r, lane);
      } }
    const size_t gt = (size_t)blockIdx.x * (NWAVES * 64) + tid, GT = (size_t)F.G * NWAVES * 64;
    { const size_t z0 = (size_t)5664 * DM / 8, z1 = (size_t)NPAD * DM / 8; GAS v4u* p = (GAS v4u*)F.WinT(); for (size_t i = z0 + gt; i < z1; i += GT) p[i] = (v4u){0u, 0u, 0u, 0u}; }
    { const GAS f32x4* s = (const GAS f32x4*)F.peer_sk(); GAS v2u* d = (GAS v2u*)F.SK(); for (size_t i = gt; i < (size_t)16 * 128 * 128 / 4; i += GT) { const f32x4 v = s[i]; v2u o; o.x = pk2(v.x, v.y); o.y = pk2(v.z, v.w); d[i] = o; } }
    { const float* const xg = F.x(); const float* const gn = F.attn_norm(); bf16* const hn = F.HN();
      for (int m = gw; m < MTOK / 2; m += NGW) rms_2rows_to_bf16(xg + (size_t)(2 * m) * DM, xg + (size_t)(2 * m + 1) * DM, gn, hn + (size_t)(2 * m) * DM, hn + (size_t)(2 * m + 1) * DM, lane); }
    tables_convert(F, 0, tab_split(F.G), gt, GT);
}

struct EpiProj {
    static constexpr bool PERM = true, AFTER_DRAIN = false, SEG = false;
    bf16* O; float* dtraw; float* kmean;
    __device__ __forceinline__ void operator()(const pg8::f32x4 (&acc)[2][2][4][2], const pg8::Unit& u, int wr, int wc, int fr, int fq) const {
        const int row0 = u.pm * 256 + wr * 64 + fr, col0 = u.pn * 256 + wc * 32 + 8 * fq;
        if (u.pn < 22) {
#pragma unroll
            for (int ai = 0; ai < 2; ++ai)
#pragma unroll
                for (int m = 0; m < 4; ++m) { bf16* rowp = O + (size_t)(row0 + ai * 128 + m * 16) * NPROJ + col0;
#pragma unroll
                    for (int bj = 0; bj < 2; ++bj) { const pg8::f32x4 v0 = acc[ai][bj][m][0], v1 = acc[ai][bj][m][1];
                        pg8::u32x4 w; w.x = pg8::cvt_pk_bf16(v0[0], v0[1]); w.y = pg8::cvt_pk_bf16(v0[2], v0[3]); w.z = pg8::cvt_pk_bf16(v1[0], v1[1]); w.w = pg8::cvt_pk_bf16(v1[2], v1[3]);
                        *(pg8::u32x4*)(rowp + bj * 128) = w; } }
        } else if (wc == 0 && fq < 2) {
#pragma unroll
            for (int ai = 0; ai < 2; ++ai)
#pragma unroll
                for (int m = 0; m < 4; ++m) { float* rp = dtraw + (size_t)(row0 + ai * 128 + m * 16) * 16 + 8 * fq;
                    *(pg8::f32x4*)rp = acc[ai][0][m][0]; *(pg8::f32x4*)(rp + 4) = acc[ai][0][m][1]; }
        }
        if (kmean && u.pn >= 4 && u.pn < 8) {
#pragma unroll
            for (int bj = 0; bj < 2; ++bj)
#pragma unroll
                for (int n = 0; n < 2; ++n)
#pragma unroll
                    for (int i = 0; i < 4; ++i) { float s = 0.f;
#pragma unroll
                        for (int ai = 0; ai < 2; ++ai)
#pragma unroll
                            for (int m = 0; m < 4; ++m) s += acc[ai][bj][m][n][i];
                        s += __shfl_xor(s, 1); s += __shfl_xor(s, 2); s += __shfl_xor(s, 4); s += __shfl_xor(s, 8);
                        if (fr == 0) unsafeAtomicAdd(kmean + (size_t)u.pm * 1024 + (col0 - 1024) + bj * 128 + 4 * n + i, s); }
        }
    }
};
struct EpiOut {
    static constexpr bool PERM = true, AFTER_DRAIN = false, SEG = true; static constexpr int SEG_T1 = 16, SEG_T2 = 24;
    const float* x; bf16* x1b; float* ssq; bool doatom; const LAS f32x4* tab;
    __device__ __forceinline__ void seg_load(int ui, int wr, int fr, float (&sr)[16]) const {
#pragma unroll
        for (int i = 0; i < 8; ++i) { const int r = (i >> 2) * 128 + wr * 64 + (i & 3) * 16 + fr; const f32x2 q = *(const LAS f32x2*)(tab + (ui & 1) * 256 + r); sr[2 * i] = q.x; sr[2 * i + 1] = q.y; }
        asm volatile("s_waitcnt lgkmcnt(0)" ::: "memory");
    }
    __device__ __forceinline__ void seg_apply(pg8::f32x4 (&acc)[2][2][4][2], const float (&sr)[16], int which) const {
#pragma unroll
        for (int ai = 0; ai < 2; ++ai)
#pragma unroll
            for (int m = 0; m < 4; ++m) { const float f = (which == 0) ? sr[2 * (ai * 4 + m)] : ((which == 1) ? sr[2 * (ai * 4 + m) + 1] : 1.0f);
#pragma unroll
                for (int bj = 0; bj < 2; ++bj)
#pragma unroll
                    for (int n = 0; n < 2; ++n) acc[ai][bj][m][n] = acc[ai][bj][m][n] * f; }
    }
    __device__ __forceinline__ void operator()(const pg8::f32x4 (&acc)[2][2][4][2], const pg8::Unit& u, int wr, int wc, int fr, int fq, int ui) const {
        const int row0 = u.pm * 256 + wr * 64 + fr, col0 = u.pn * 256 + wc * 32 + 8 * fq;
#pragma unroll
        for (int ai = 0; ai < 2; ++ai)
#pragma unroll
            for (int m = 0; m < 4; ++m) { const int row = row0 + ai * 128 + m * 16; const size_t off = (size_t)row * DM + col0; float s = 0.f;
                const float s1 = (*(const LAS f32x4*)(tab + (ui & 1) * 256 + ai * 128 + wr * 64 + m * 16 + fr)).z;
#pragma unroll
                for (int bj = 0; bj < 2; ++bj) {
                    const pg8::f32x4 a0 = *(const pg8::f32x4*)(x + off + bj * 128), a1 = *(const pg8::f32x4*)(x + off + bj * 128 + 4);
                    const pg8::f32x4 v0 = acc[ai][bj][m][0] * s1 + a0, v1 = acc[ai][bj][m][1] * s1 + a1;
                    pg8::u32x4 w; w.x = pg8::cvt_pk_bf16(v0[0], v0[1]); w.y = pg8::cvt_pk_bf16(v0[2], v0[3]); w.z = pg8::cvt_pk_bf16(v1[0], v1[1]); w.w = pg8::cvt_pk_bf16(v1[2], v1[3]);
                    *(pg8::u32x4*)(x1b + off + bj * 128) = w;
                    s += (v0[0] * v0[0] + v0[1] * v0[1]) + (v0[2] * v0[2] + v0[3] * v0[3]) + (v1[0] * v1[0] + v1[1] * v1[1]) + (v1[2] * v1[2] + v1[3] * v1[3]); }
                s += __shfl_xor(s, 16); s += __shfl_xor(s, 32);
                if (fq == 0 && doatom) unsafeAtomicAdd(ssq + (size_t)row * 4, s);
                asm volatile("" ::: "memory"); }
    }
};
struct EpiQ {
    static constexpr bool PERM = true, AFTER_DRAIN = false, SEG = false;
    bf16* O; const float* ssq;
    __device__ __forceinline__ void operator()(const pg8::f32x4 (&acc)[2][2][4][2], const pg8::Unit& u, int wr, int wc, int fr, int fq) const {
        const int row0 = u.pm * 256 + wr * 64 + fr, col0 = u.pn * 256 + wc * 32 + 8 * fq;
#pragma unroll
        for (int ai = 0; ai < 2; ++ai)
#pragma unroll
            for (int m = 0; m < 4; ++m) { const int row = row0 + ai * 128 + m * 16; bf16* rowp = O + (size_t)row * DM + col0;
                const float rs = 1.f / sqrtf(__hip_atomic_load(ssq + (size_t)row * 4, RLX_AGENT) * (1.f / DM) + EPS);
#pragma unroll
                for (int bj = 0; bj < 2; ++bj) { const pg8::f32x4 v0 = acc[ai][bj][m][0] * rs, v1 = acc[ai][bj][m][1] * rs;
                    pg8::u32x4 w; w.x = pg8::cvt_pk_bf16(v0[0], v0[1]); w.y = pg8::cvt_pk_bf16(v0[2], v0[3]); w.z = pg8::cvt_pk_bf16(v1[0], v1[1]); w.w = pg8::cvt_pk_bf16(v1[2], v1[3]);
                    *(pg8::u32x4*)(rowp + bj * 128) = w; } }
    }
};

constexpr int A_KSTR = 272, A_VSTR = 288;
constexpr int A_KB0 = 0, A_KB1 = 64 * A_KSTR, A_VB0 = 2 * 64 * A_KSTR, A_VB1 = A_VB0 + 64 * A_VSTR, A_KM = A_VB1 + 64 * A_VSTR, A_TAB = A_KM + 8 * 128 * 4, A_END = A_TAB + 128 * 4;
static_assert(A_END <= RING_BYTES && (A_KM % 16) == 0, "attention LDS map");
#define PIN16(a, i) asm volatile("" : "+v"(a[i]), "+v"(a[i + 1]), "+v"(a[i + 2]), "+v"(a[i + 3]), "+v"(a[i + 4]), "+v"(a[i + 5]), "+v"(a[i + 6]), "+v"(a[i + 7]), "+v"(a[i + 8]), "+v"(a[i + 9]), "+v"(a[i + 10]), "+v"(a[i + 11]), "+v"(a[i + 12]), "+v"(a[i + 13]), "+v"(a[i + 14]), "+v"(a[i + 15]))
#define TR16(p) __builtin_amdgcn_ds_read_tr16_b64_v4i16((LAS s16x4*)(p))
#define MFMA16(a, b, c) __builtin_amdgcn_mfma_f32_16x16x32_bf16((a), (b), (c), 0, 0, 0)
__device__ __forceinline__ bf16x8 pack8(const float* v) {
    const unsigned a = pk2(v[0], v[1]), b = pk2(v[2], v[3]), c = pk2(v[4], v[5]), d = pk2(v[6], v[7]);
    const v4u u = {a, b, c, d}; return __builtin_bit_cast(bf16x8, u);
}
__device__ __forceinline__ void attn_unit(Frame& F, int b, int h, int blk, const bool doatom = true) {
    LAS unsigned char* lds = F.lds + RING_OFF;
    const int tid = fresh_tid(), lane = tid & 63, w = __builtin_amdgcn_readfirstlane(tid >> 6), g = lane >> 4, c16 = lane & 15, q4 = c16 >> 2, p4 = lane & 3;
    const int own = blk, t0 = blk * 256, tq0 = t0 + 32 * w + c16;
    const size_t rowbase = (size_t)b * SEQ;
    const float NEG_INF = -__builtin_inff();
    constexpr float LOG2E = 1.4426950408889634f, SCL2 = 0.08838834764831845f * 1.4426950408889634f;
    LAS float* km = (LAS float*)(lds + A_KM); LAS float* tab = (LAS float*)(lds + A_TAB);
    const bf16* const PROJ = F.PROJ(); const float* const kmg = F.kmean(); const float* const relb = F.rel_bias();
    for (int i = tid; i < own * 128; i += NWAVES * 64) { const int n = i >> 7, d = i & 127; km[i] = kmg[(size_t)(b * 8 + n) * 1024 + h * 128 + d] * (1.f / 256.f); }
    if (tid < 128) { const int rel = tid; int bucket = rel; if (rel >= 16) { bucket = 16 + (int)(log2f((float)rel * (1.f / 16.f)) * (16.f / 3.f)); bucket = bucket > 31 ? 31 : bucket; }
        tab[tid] = relb[bucket * 8 + h] * LOG2E; }
    bf16x8 qf[2][4];
#pragma unroll
    for (int gi = 0; gi < 2; ++gi) { const bf16* qrow = PROJ + (rowbase + tq0 + 16 * gi) * NPROJ + COL_Q + h * 128 + 8 * g;
#pragma unroll
      for (int ks = 0; ks < 4; ++ks) qf[gi][ks] = *(const GAS bf16x8*)(qrow + 32 * ks); }
    __syncthreads();
    unsigned selmask[2];
    if (own <= 3) { selmask[0] = (1u << own) - 1u; selmask[1] = selmask[0]; }
    else {
#pragma unroll
      for (int gi = 0; gi < 2; ++gi) {
        float gate[7];
#pragma unroll
        for (int n = 0; n < 7; ++n) {
            float s = NEG_INF;
            if (n < own) { s = 0.f;
#pragma unroll
                for (int ks = 0; ks < 4; ++ks) { const LAS f32x4* kp = (const LAS f32x4*)(km + n * 128 + 32 * ks + 8 * g); const f32x4 k0 = kp[0], k1 = kp[1]; const v4u qu = __builtin_bit_cast(v4u, qf[gi][ks]);
                    s += bflo(qu.x) * k0.x + bfhi(qu.x) * k0.y + bflo(qu.y) * k0.z + bfhi(qu.y) * k0.w + bflo(qu.z) * k1.x + bfhi(qu.z) * k1.y + bflo(qu.w) * k1.z + bfhi(qu.w) * k1.w; }
                s += __shfl_xor(s, 16); s += __shfl_xor(s, 32); }
            gate[n] = s;
        }
        unsigned sm = 0u;
#pragma unroll
        for (int r = 0; r < 3; ++r) { float best = NEG_INF; int bi = 0;
#pragma unroll
            for (int n = 0; n < 7; ++n) { const bool cand = (n < own) && !((sm >> n) & 1u) && (gate[n] > best); best = cand ? gate[n] : best; bi = cand ? n : bi; }
            sm |= 1u << bi; }
        selmask[gi] = sm; }
    }
    const int nT = 4 + 4 * own;
    const int sr = tid >> 3, sc = (tid & 7) * 16;
#define A_KEY0(i) ((i) < 4 ? own * 256 + 64 * (i) : (((i) - 4) >> 2) * 256 + (((i) - 4) & 3) * 64)
    v4u kr0, kr1, vr0, vr1;
#define A_LOAD(i) do { const bf16* kp_ = PROJ + (rowbase + A_KEY0(i) + sr) * NPROJ + COL_K + h * 128 + sc; \
        kr0 = *(const GAS v4u*)kp_; kr1 = *(const GAS v4u*)(kp_ + 8); vr0 = *(const GAS v4u*)(kp_ + (COL_V - COL_K)); vr1 = *(const GAS v4u*)(kp_ + (COL_V - COL_K) + 8); } while (0)
#define A_STORE(bufi) do { LAS unsigned char* kd_ = lds + ((bufi) ? A_KB1 : A_KB0) + sr * A_KSTR + sc * 2; LAS unsigned char* vd_ = lds + ((bufi) ? A_VB1 : A_VB0) + sr * A_VSTR + sc * 2; \
        *(LAS v4u*)kd_ = kr0; *(LAS v4u*)(kd_ + 16) = kr1; *(LAS v4u*)vd_ = vr0; *(LAS v4u*)(vd_ + 16) = vr1; } while (0)
    A_LOAD(0); A_STORE(0);
    __syncthreads();
    float m_run[2] = {NEG_INF, NEG_INF}, l_run[2] = {0.f, 0.f};
    f32x4 oacc[2][8];
#pragma unroll
    for (int gi = 0; gi < 2; ++gi)
#pragma unroll
        for (int db = 0; db < 8; ++db) oacc[gi][db] = (f32x4){0.f, 0.f, 0.f, 0.f};
    for (int i = 0; i < nT; ++i) {
        if (i + 1 < nT) A_LOAD(i + 1);
        const int buf = i & 1, key0 = A_KEY0(i); const bool isown = i < 4; const int pblk = isown ? own : ((i - 4) >> 2);
        const bool skipw = isown && (64 * i > 32 * w + 31);
        if (!skipw) {
        LAS unsigned char* Kb = lds + (buf ? A_KB1 : A_KB0); LAS unsigned char* Vb = lds + (buf ? A_VB1 : A_VB0);
        f32x4 sacc[2][4];
#pragma unroll
        for (int hf = 0; hf < 2; ++hf) { bf16x8 kf[8];
#pragma unroll
            for (int n2 = 0; n2 < 2; ++n2)
#pragma unroll
                for (int ks = 0; ks < 4; ++ks) kf[n2 * 4 + ks] = *(const LAS bf16x8*)(Kb + (16 * (2 * hf + n2) + c16) * A_KSTR + (32 * ks + 8 * g) * 2);
            __builtin_amdgcn_sched_barrier(0);
#pragma unroll
            for (int gi = 0; gi < 2; ++gi)
#pragma unroll
                for (int n2 = 0; n2 < 2; ++n2) { f32x4 a = (f32x4){0.f, 0.f, 0.f, 0.f};
#pragma unroll
                    for (int ks = 0; ks < 4; ++ks) a = MFMA16(kf[n2 * 4 + ks], qf[gi][ks], a);
                    sacc[gi][2 * hf + n2] = a; }
            __builtin_amdgcn_sched_barrier(0); }
        const bool far = (key0 + 63 + 128 <= t0 + 32 * w);
        const bool diag = isown && (64 * i + 63 > 32 * w);
        bf16x8 pf[2][2];
#pragma unroll
        for (int gi = 0; gi < 2; ++gi) {
            const int tq = tq0 + 16 * gi; const bool sel = isown || ((selmask[gi] >> pblk) & 1u);
            float sv[16]; float mloc, m_new, alpha;
            if (far) {
                const float bfar = tab[127];
                float mx = fmaxf(fmaxf(sacc[gi][0][0], sacc[gi][0][1]), fmaxf(sacc[gi][0][2], sacc[gi][0][3]));
#pragma unroll
                for (int nb = 1; nb < 4; ++nb) mx = fmaxf(mx, fmaxf(fmaxf(sacc[gi][nb][0], sacc[gi][nb][1]), fmaxf(sacc[gi][nb][2], sacc[gi][nb][3])));
                mloc = sel ? (mx * SCL2 + bfar) : NEG_INF;
                mloc = fmaxf(mloc, __shfl_xor(mloc, 16)); mloc = fmaxf(mloc, __shfl_xor(mloc, 32));
                m_new = fmaxf(m_run[gi], mloc); alpha = __builtin_amdgcn_exp2f(m_run[gi] - m_new);
                const float cadd = sel ? (bfar - m_new) : NEG_INF;
#pragma unroll
                for (int nb = 0; nb < 4; ++nb)
#pragma unroll
                    for (int r = 0; r < 4; ++r) sv[nb * 4 + r] = __builtin_amdgcn_exp2f(sacc[gi][nb][r] * SCL2 + cadd);
            } else {
                const int relb = tq - key0 - 4 * g; float bias[16];
#pragma unroll
                for (int nb = 0; nb < 4; ++nb)
#pragma unroll
                    for (int r = 0; r < 4; ++r) { const int rel = relb - 16 * nb - r; int ri = rel < 0 ? 0 : rel; ri = ri > 127 ? 127 : ri; bias[nb * 4 + r] = tab[ri]; }
                PIN16(bias, 0);
                mloc = NEG_INF;
#pragma unroll
                for (int nb = 0; nb < 4; ++nb)
#pragma unroll
                    for (int r = 0; r < 4; ++r) { const int rel = relb - 16 * nb - r;
                        float s = sacc[gi][nb][r] * SCL2 + bias[nb * 4 + r]; s = (!sel || (diag && rel < 0)) ? NEG_INF : s; sv[nb * 4 + r] = s; mloc = fmaxf(mloc, s); }
                mloc = fmaxf(mloc, __shfl_xor(mloc, 16)); mloc = fmaxf(mloc, __shfl_xor(mloc, 32));
                m_new = fmaxf(m_run[gi], mloc); alpha = __builtin_amdgcn_exp2f(m_run[gi] - m_new);
#pragma unroll
                for (int e = 0; e < 16; ++e) sv[e] = __builtin_amdgcn_exp2f(sv[e] - m_new);
            }
            float psum = 0.f;
#pragma unroll
            for (int e = 0; e < 16; ++e) psum += sv[e];
            l_run[gi] = l_run[gi] * alpha + psum; m_run[gi] = m_new;
#pragma unroll
            for (int db = 0; db < 8; ++db) oacc[gi][db] = oacc[gi][db] * alpha;
            pf[gi][0] = pack8(sv); pf[gi][1] = pack8(sv + 8);
        }
        __builtin_amdgcn_sched_barrier(0);
#pragma unroll
        for (int s = 0; s < 2; ++s) { s16x4 vlo[8], vhi[8];
#pragma unroll
            for (int db = 0; db < 8; ++db) { LAS unsigned char* va = Vb + (32 * s + 4 * g + q4) * A_VSTR + (16 * db + 4 * p4) * 2; vlo[db] = TR16(va); vhi[db] = TR16(va + 16 * A_VSTR); }
            __builtin_amdgcn_sched_barrier(0);
#pragma unroll
            for (int db = 0; db < 8; ++db) { const bf16x8 vf = __builtin_shufflevector(vlo[db], vhi[db], 0, 1, 2, 3, 4, 5, 6, 7);
                oacc[0][db] = MFMA16(vf, pf[0][s], oacc[0][db]); oacc[1][db] = MFMA16(vf, pf[1][s], oacc[1][db]); }
            __builtin_amdgcn_sched_barrier(0); }
        }
        if (i + 1 < nT) A_STORE((i + 1) & 1);
        __syncthreads();
    }
    bf16* const MIXp = F.HN(); float* const ssqp = F.ssq();
#pragma unroll
    for (int gi = 0; gi < 2; ++gi) {
        const int tq = tq0 + 16 * gi;
        float l_tot = l_run[gi]; l_tot += __shfl_xor(l_tot, 16); l_tot += __shfl_xor(l_tot, 32);
        const float inv = 1.f / l_tot; float ssq = 0.f;
        bf16* orow = MIXp + (rowbase + tq) * DM + h * 128 + 4 * g;
#pragma unroll
        for (int db = 0; db < 8; ++db) { const f32x4 o = oacc[gi][db] * inv; ssq += (o.x * o.x + o.y * o.y) + (o.z * o.z + o.w * o.w); v2u wv; wv.x = pk2(o.x, o.y); wv.y = pk2(o.z, o.w); *(GAS v2u*)(orow + 16 * db) = wv; }
        ssq += __shfl_xor(ssq, 16); ssq += __shfl_xor(ssq, 32);
        if (g == 0 && doatom) unsafeAtomicAdd(ssqp + (rowbase + tq) * 4 + 1, ssq);
    }
#undef A_KEY0
#undef A_LOAD
#undef A_STORE
}

constexpr int XBC_W = CONV_CH;
__device__ __forceinline__ void conv_phase(Frame& F) {
    const bf16* const PROJ = F.PROJ(); bf16* const XBC = F.XBC(); const float* const cw = F.conv_w(); const float* const cb = F.conv_b();
    const int gt = blockIdx.x * (NWAVES * 64) + fresh_tid(), GT = F.G * NWAVES * 64;
    for (int task = gt; task < (MTOK / 32) * (CONV_CH / 8); task += GT) {
        const int r = task / (CONV_CH / 8), k = task % (CONV_CH / 8), ch = 8 * k, tok0 = 32 * r;
        float wv[4][8], bias[8];
#pragma unroll
        for (int t = 0; t < 4; ++t) { const f32x4 w0 = *(const GAS f32x4*)(cw + t * CONV_CH + ch), w1 = *(const GAS f32x4*)(cw + t * CONV_CH + ch + 4);
            wv[t][0] = w0.x; wv[t][1] = w0.y; wv[t][2] = w0.z; wv[t][3] = w0.w; wv[t][4] = w1.x; wv[t][5] = w1.y; wv[t][6] = w1.z; wv[t][7] = w1.w; }
        { const f32x4 b0 = *(const GAS f32x4*)(cb + ch), b1 = *(const GAS f32x4*)(cb + ch + 4); bias[0] = b0.x; bias[1] = b0.y; bias[2] = b0.z; bias[3] = b0.w; bias[4] = b1.x; bias[5] = b1.y; bias[6] = b1.z; bias[7] = b1.w; }
        const bf16* src = PROJ + (size_t)tok0 * NPROJ + COL_XBC + ch; bf16* dst = XBC + (size_t)tok0 * XBC_W + ch;
        v4u p0 = (v4u){0u, 0u, 0u, 0u}, p1 = p0, p2 = p0;
        if ((tok0 & (SEQ - 1)) != 0) { p0 = *(const GAS v4u*)(src - 3 * (ptrdiff_t)NPROJ); p1 = *(const GAS v4u*)(src - 2 * (ptrdiff_t)NPROJ); p2 = *(const GAS v4u*)(src - (ptrdiff_t)NPROJ); }
#pragma unroll 1
        for (int i0 = 0; i0 < 32; i0 += 8) {
            v4u cur[8];
#pragma unroll
            for (int i = 0; i < 8; ++i) cur[i] = *(const GAS v4u*)(src + (size_t)(i0 + i) * NPROJ);
#pragma unroll
            for (int i = 0; i < 8; ++i) {
                const v4u c = cur[i]; float acc[8];
                const unsigned a0[4] = {p0.x, p0.y, p0.z, p0.w}, a1[4] = {p1.x, p1.y, p1.z, p1.w}, a2[4] = {p2.x, p2.y, p2.z, p2.w}, a3[4] = {c.x, c.y, c.z, c.w};
#pragma unroll
                for (int j = 0; j < 4; ++j) {
                    acc[2 * j] = bias[2 * j] + wv[0][2 * j] * bflo(a0[j]) + wv[1][2 * j] * bflo(a1[j]) + wv[2][2 * j] * bflo(a2[j]) + wv[3][2 * j] * bflo(a3[j]);
                    acc[2 * j + 1] = bias[2 * j + 1] + wv[0][2 * j + 1] * bfhi(a0[j]) + wv[1][2 * j + 1] * bfhi(a1[j]) + wv[2][2 * j + 1] * bfhi(a2[j]) + wv[3][2 * j + 1] * bfhi(a3[j]); }
#pragma unroll
                for (int j = 0; j < 8; ++j) acc[j] = silu_f(acc[j]);
                v4u o; o.x = pk2(acc[0], acc[1]); o.y = pk2(acc[2], acc[3]); o.z = pk2(acc[4], acc[5]); o.w = pk2(acc[6], acc[7]);
                *(GAS v4u*)(dst + (size_t)(i0 + i) * XBC_W) = o;
                p0 = p1; p1 = p2; p2 = c; }
        }
    }
    { const float* const dtraw = F.dtraw(); float* const dt2 = F.DT2(); const float* const dtb = F.dt_bias();
      for (int i = gt; i < MTOK * 16; i += GT) { const float xr = dtraw[i] + dtb[i & 15]; dt2[i] = xr > 20.f ? xr : log1pf(__expf(xr)); } }
}

constexpr int S_BSTR = 272, S_XSTR = 144;
constexpr int S_BM = 0, S_CM = 128 * S_BSTR, S_X = 2 * 128 * S_BSTR, S_XW = S_X + 128 * S_XSTR, S_HB = S_XW + 128 * S_XSTR, S_DT = S_HB + 64 * S_BSTR, S_CS = S_DT + 512, S_DA = S_CS + 512, S_END = S_DA + 512;
static_assert(S_END <= RING_BYTES, "ssd LDS map");
__device__ __forceinline__ void ssd_unit(Frame& F, int b, int h, const bool doatom = true) {
    LAS unsigned char* lds = F.lds + RING_OFF;
    const int tid = fresh_tid(), lane = tid & 63, w = __builtin_amdgcn_readfirstlane(tid >> 6), g = lane >> 4, c16 = lane & 15, q4 = c16 >> 2, p4 = lane & 3;
    const int g8 = h >> 3, pbw = w & 3, nhw = w >> 2;
    const float a_h = -__expf(F.a_log()[h]), dsk = F.d_skip()[h];
    const bf16* const PROJ = F.PROJ(); bf16* const MIX = F.HN(); const float* const dt2 = F.DT2(); const bf16* const XBC = F.XBC(); float* const ssqp = F.ssq();
    LAS float* dtl = (LAS float*)(lds + S_DT); LAS float* csl = (LAS float*)(lds + S_CS); LAS float* dal = (LAS float*)(lds + S_DA);
    for (int i = tid; i < 64 * S_BSTR / 16; i += NWAVES * 64) ((LAS v4u*)(lds + S_HB))[i] = (v4u){0u, 0u, 0u, 0u};
    f32x4 hacc[4];
#pragma unroll
    for (int i = 0; i < 4; ++i) hacc[i] = (f32x4){0.f, 0.f, 0.f, 0.f};
    const int xl = tid >> 3, xc = tid & 7, bl = tid >> 4, bc = tid & 15;
    v4u xr[2], br[4], cr[4]; float dtv = 0.f;
#define S_PREFETCH(cc) do { const size_t t0_ = (size_t)b * SEQ + (size_t)(cc) * SSM_L; \
        _Pragma("unroll") for (int i_ = 0; i_ < 2; ++i_) xr[i_] = *(const GAS v4u*)(XBC + (t0_ + xl + 64 * i_) * XBC_W + h * 64 + 8 * xc); \
        _Pragma("unroll") for (int i_ = 0; i_ < 4; ++i_) { const bf16* p_ = XBC + (t0_ + bl + 32 * i_) * XBC_W + 1024 + g8 * 128 + 8 * bc; br[i_] = *(const GAS v4u*)p_; cr[i_] = *(const GAS v4u*)(p_ + 256); } \
        if (tid < 128) dtv = dt2[(t0_ + tid) * 16 + h]; } while (0)
    S_PREFETCH(0);
    for (int c = 0; c < SSM_NC; ++c) {
        const size_t tok0 = (size_t)b * SEQ + (size_t)c * SSM_L;
        if (tid < 128) { dtl[tid] = dtv; dal[tid] = dtv * a_h; }
        __syncthreads();
        if (w == 0) { const float v0 = dal[2 * lane], v1 = dal[2 * lane + 1]; float s = v0 + v1;
#pragma unroll
            for (int o = 1; o < 64; o <<= 1) { const float t = __shfl_up(s, o); s += (lane >= o) ? t : 0.f; }
            csl[2 * lane] = s - v1; csl[2 * lane + 1] = s; }
        __syncthreads();
        const float cs_last = csl[127];
#pragma unroll
        for (int i = 0; i < 2; ++i) { const int l = xl + 64 * i; const v4u v = xr[i]; *(LAS v4u*)(lds + S_X + l * S_XSTR + xc * 16) = v; const float wl = dtl[l] * __expf(cs_last - csl[l]);
            v4u o2; o2.x = pk2(bflo(v.x) * wl, bfhi(v.x) * wl); o2.y = pk2(bflo(v.y) * wl, bfhi(v.y) * wl); o2.z = pk2(bflo(v.z) * wl, bfhi(v.z) * wl); o2.w = pk2(bflo(v.w) * wl, bfhi(v.w) * wl);
            *(LAS v4u*)(lds + S_XW + l * S_XSTR + xc * 16) = o2; }
#pragma unroll
        for (int i = 0; i < 4; ++i) { const int l = bl + 32 * i; *(LAS v4u*)(lds + S_BM + l * S_BSTR + bc * 16) = br[i]; *(LAS v4u*)(lds + S_CM + l * S_BSTR + bc * 16) = cr[i]; }
        const int lrow = 16 * w + c16;
        v2u zr[4];
#pragma unroll
        for (int pb = 0; pb < 4; ++pb) zr[pb] = *(const GAS v2u*)(PROJ + (tok0 + lrow) * NPROJ + COL_Z + h * 64 + 16 * pb + 4 * g);
        if (c + 1 < SSM_NC) S_PREFETCH(c + 1);
        __syncthreads();
        bf16x8 cf[4];
#pragma unroll
        for (int ks = 0; ks < 4; ++ks) cf[ks] = *(const LAS bf16x8*)(lds + S_CM + lrow * S_BSTR + (32 * ks + 8 * g) * 2);
        f32x4 yacc[4];
        const float cs_l = csl[lrow]; const float el = __expf(cs_l);
#pragma unroll
        for (int pb = 0; pb < 4; ++pb) { yacc[pb] = (f32x4){0.f, 0.f, 0.f, 0.f};
#pragma unroll
            for (int ks = 0; ks < 4; ++ks) { const bf16x8 hf = *(const LAS bf16x8*)(lds + S_HB + (16 * pb + c16) * S_BSTR + (32 * ks + 8 * g) * 2); yacc[pb] = MFMA16(hf, cf[ks], yacc[pb]); }
            yacc[pb] = yacc[pb] * el; }
        for (int s2 = 0; s2 <= (w >> 1); ++s2) {
            const int sb0 = 2 * s2, sb1 = 2 * s2 + 1; const bool has1 = sb1 <= w;
            f32x4 cb0 = (f32x4){0.f, 0.f, 0.f, 0.f}, cb1 = (f32x4){0.f, 0.f, 0.f, 0.f};
#pragma unroll
            for (int ks = 0; ks < 4; ++ks) { const bf16x8 bf0 = *(const LAS bf16x8*)(lds + S_BM + (16 * sb0 + c16) * S_BSTR + (32 * ks + 8 * g) * 2); cb0 = MFMA16(bf0, cf[ks], cb0); }
            if (has1) {
#pragma unroll
                for (int ks = 0; ks < 4; ++ks) { const bf16x8 bf1 = *(const LAS bf16x8*)(lds + S_BM + (16 * sb1 + c16) * S_BSTR + (32 * ks + 8 * g) * 2); cb1 = MFMA16(bf1, cf[ks], cb1); } }
            float mv[8];
#pragma unroll
            for (int r = 0; r < 4; ++r) { const int s = 16 * sb0 + 4 * g + r; const float e = __expf(fminf(cs_l - csl[s], 0.f)) * dtl[s]; mv[r] = (s <= lrow) ? cb0[r] * e : 0.f; }
#pragma unroll
            for (int r = 0; r < 4; ++r) { const int s = 16 * sb1 + 4 * g + r; const int sc_ = s > 127 ? 127 : s; const float e = __expf(fminf(cs_l - csl[sc_], 0.f)) * dtl[sc_]; mv[4 + r] = (has1 && s <= lrow) ? cb1[r] * e : 0.f; }
            const bf16x8 pf = pack8(mv);
#pragma unroll
            for (int pb = 0; pb < 4; ++pb) { LAS unsigned char* xa = lds + S_X + (32 * s2 + 4 * g + q4) * S_XSTR + (16 * pb + 4 * p4) * 2;
                const s16x4 lo = TR16(xa), hi = TR16(xa + 16 * S_XSTR); const bf16x8 xf = __builtin_shufflevector(lo, hi, 0, 1, 2, 3, 4, 5, 6, 7);
                yacc[pb] = MFMA16(xf, pf, yacc[pb]); }
        }
        { const size_t tok = tok0 + lrow; float ssq = 0.f;
#pragma unroll
          for (int pb = 0; pb < 4; ++pb) { const int p0 = 16 * pb + 4 * g;
              const v2u xs_ = *(const LAS v2u*)(lds + S_X + lrow * S_XSTR + p0 * 2);
              const v2u zr_ = zr[pb];
              const float o0 = (yacc[pb].x + bflo(xs_.x) * dsk) * silu_f(bflo(zr_.x)), o1 = (yacc[pb].y + bfhi(xs_.x) * dsk) * silu_f(bfhi(zr_.x));
              const float o2 = (yacc[pb].z + bflo(xs_.y) * dsk) * silu_f(bflo(zr_.y)), o3 = (yacc[pb].w + bfhi(xs_.y) * dsk) * silu_f(bfhi(zr_.y));
              ssq += (o0 * o0 + o1 * o1) + (o2 * o2 + o3 * o3);
              v2u wv; wv.x = pk2(o0, o1); wv.y = pk2(o2, o3); *(GAS v2u*)(MIX + tok * DM + ATT_W + h * 64 + p0) = wv; }
          ssq += __shfl_xor(ssq, 16); ssq += __shfl_xor(ssq, 32);
          if (g == 0 && doatom) unsafeAtomicAdd(ssqp + tok * 4 + 2 + g8, ssq); }
        { const float cdec = __expf(cs_last);
#pragma unroll
          for (int i = 0; i < 4; ++i) hacc[i] = hacc[i] * cdec;
#pragma unroll
          for (int ks = 0; ks < 4; ++ks) {
              LAS unsigned char* xa = lds + S_XW + (32 * ks + 8 * g + q4) * S_XSTR + (16 * pbw + 4 * p4) * 2;
              const s16x4 xlo = TR16(xa), xhi = TR16(xa + 4 * S_XSTR); const bf16x8 xf = __builtin_shufflevector(xlo, xhi, 0, 1, 2, 3, 4, 5, 6, 7);
#pragma unroll
              for (int i = 0; i < 4; ++i) { const int nb = 4 * nhw + i; LAS unsigned char* ba = lds + S_BM + (32 * ks + 8 * g + q4) * S_BSTR + (16 * nb + 4 * p4) * 2;
                  const s16x4 blo = TR16(ba), bhi = TR16(ba + 4 * S_BSTR); const bf16x8 bfr = __builtin_shufflevector(blo, bhi, 0, 1, 2, 3, 4, 5, 6, 7);
                  hacc[i] = MFMA16(bfr, xf, hacc[i]); } } }
        __syncthreads();
#pragma unroll
        for (int i = 0; i < 4; ++i) { const int nb = 4 * nhw + i; v2u o; o.x = pk2(hacc[i].x, hacc[i].y); o.y = pk2(hacc[i].z, hacc[i].w);
            *(LAS v2u*)(lds + S_HB + (16 * pbw + c16) * S_BSTR + (16 * nb + 4 * g) * 2) = o; }
    }
#undef S_PREFETCH
    __syncthreads();
}

__device__ __forceinline__ void mix_normalize(Frame& F) {
    const int tid_ = fresh_tid(), lane = tid_ & 63; const int gw = blockIdx.x * NWAVES + __builtin_amdgcn_readfirstlane(tid_ >> 6), NGW = F.G * NWAVES;
    const float* const ssqp = F.ssq(); bf16* const MIX = F.HN(); const float* const gatt = F.attn_out_norm(); const float* const gssm = F.ssm_out_norm();
    for (int m = gw; m < MTOK; m += NGW) {
        const float* sq = ssqp + (size_t)m * 4;
        const float s1 = __hip_atomic_load(sq + 1, RLX_AGENT), s2 = __hip_atomic_load(sq + 2, RLX_AGENT), s3 = __hip_atomic_load(sq + 3, RLX_AGENT);
        const float ra = 1.f / sqrtf(s1 * (1.f / 1024.f) + EPS), r0 = 1.f / sqrtf(s2 * (1.f / 512.f) + EPS), r1 = 1.f / sqrtf(s3 * (1.f / 512.f) + EPS);
        GAS v4u* row = (GAS v4u*)(MIX + (size_t)m * DM);
#pragma unroll
        for (int j = 0; j < 4; ++j) { const int idx = lane + 64 * j, col = 8 * idx; const float rs = (j < 2) ? ra : ((j == 2) ? r0 : r1);
            const float* gp = (j < 2) ? (gatt + col) : (gssm + (col - ATT_W));
            const f32x4 g0 = *(const GAS f32x4*)gp, g1 = *(const GAS f32x4*)(gp + 4); const v4u v = row[idx]; v4u o;
            o.x = pk2(bflo(v.x) * rs * g0.x, bfhi(v.x) * rs * g0.y); o.y = pk2(bflo(v.y) * rs * g0.z, bfhi(v.y) * rs * g0.w);
            o.z = pk2(bflo(v.z) * rs * g1.x, bfhi(v.z) * rs * g1.y); o.w = pk2(bflo(v.w) * rs * g1.z, bfhi(v.w) * rs * g1.w); row[idx] = o; }
    }
}

constexpr int P_EIDX = 0, P_GATE = 16384, P_LST = 32768, P_HN = 65536, P_ACT = 98304, P_END = 102400;
static_assert(P_END <= RING_BYTES, "peer LDS map");
__constant__ unsigned char PEER_CAND[52] = {0, 1, 2, 3, 4, 5, 6, 7, 8, 9, 10, 11, 12, 13, 14, 15, 16, 17, 18, 19, 20, 21, 22, 23, 32, 33, 34, 35, 36, 48, 49, 50, 51, 64, 65, 66, 80, 81, 96, 97, 112, 113, 128, 144, 160, 176, 192, 208, 224, 240, 255, 255};
__device__ __forceinline__ unsigned f2ord(float f) { const unsigned u = __builtin_bit_cast(unsigned, f); return u ^ ((u >> 31) ? 0xFFFFFFFFu : 0x80000000u); }
__device__ __forceinline__ float ord2f(unsigned u) { return __builtin_bit_cast(float, u ^ ((u >> 31) ? 0x80000000u : 0xFFFFFFFFu)); }
#define CSWAPD(a, b) do { const unsigned hi_ = (a) > (b) ? (a) : (b), lo_ = (a) > (b) ? (b) : (a); (a) = hi_; (b) = lo_; } while (0)
template <int N> __device__ __forceinline__ void bitonic_sort_desc(unsigned (&v)[N]) {
#pragma unroll
    for (int k = 2; k <= N; k <<= 1)
#pragma unroll
        for (int j = k >> 1; j > 0; j >>= 1)
#pragma unroll
            for (int i = 0; i < N; ++i) { const int l = i ^ j; if (l > i) { if ((i & k) == 0) CSWAPD(v[i], v[l]); else CSWAPD(v[l], v[i]); } }
}
__device__ __forceinline__ void merge16_xor(unsigned (&v)[16], int dist) {
    unsigned o[16];
#pragma unroll
    for (int i = 0; i < 16; ++i) o[i] = (unsigned)__shfl_xor((int)v[i], dist);
#pragma unroll
    for (int i = 0; i < 16; ++i) v[i] = v[i] > o[15 - i] ? v[i] : o[15 - i];
#pragma unroll
    for (int j = 8; j > 0; j >>= 1)
#pragma unroll
        for (int i = 0; i < 16; ++i) { const int l = i ^ j; if (l > i) CSWAPD(v[i], v[l]); }
}
__device__ __forceinline__ float gelu_erf(float x) { return 0.5f * x * (1.f + erff(x * 0.70710678118654752f)); }
__device__ __forceinline__ float fp4_dec1(unsigned n) { const unsigned m = n & 7u; unsigned bits = (m >= 2u) ? (((126u + (m >> 1)) << 23) | ((m & 1u) << 22)) : (m ? 0x3F000000u : 0u); bits |= (n & 8u) << 28; return __builtin_bit_cast(float, bits); }
__device__ __forceinline__ f32x2 fp4_dec2(unsigned x) { f32x2 r; r.x = fp4_dec1(x & 15u); r.y = fp4_dec1((x >> 4) & 15u); return r; }
typedef long i64;
typedef int v8i __attribute__((ext_vector_type(8)));
__device__ __forceinline__ void peer_unit(Frame& F, int u, const bool dry = false) {
    LAS unsigned char* lds = F.lds + RING_OFF;
    const int tid_ = fresh_tid(), lane = tid_ & 63, w = __builtin_amdgcn_readfirstlane(tid_ >> 6), g = lane >> 4, c16 = lane & 15;
    const int T0 = 32 * u;
    LAS int* eidx = (LAS int*)(lds + P_EIDX); LAS float* gate = (LAS float*)(lds + P_GATE);
    LAS unsigned* lst = (LAS unsigned*)(lds + P_LST) + w * 1024;
    const bf16* const QP = F.QP(); const bf16* const SK = F.SK(); float* const outp = F.out(); const bf16* const X1B = F.X1B(); const float* const fgain = F.ffn_norm(); const float* const fing = F.final_norm(); const unsigned char* const U8 = F.U8(); const unsigned char* const V8 = F.V8();
#ifndef NO_ROUTE
    for (int tb = 0; tb < 2; ++tb) {
        for (int c = 0; c < 2; ++c) {
            const int p = 2 * w + c;
            bf16x8 qf[4];
            { const unsigned qo = ((unsigned)(T0 + 16 * tb + c16) * (unsigned)DM + (unsigned)(p * 128 + 8 * g)) * 2u;
#pragma unroll
              for (int ks = 0; ks < 4; ++ks) qf[ks] = *(const GAS bf16x8*)((const unsigned char*)QP + (qo + 64u * ks)); }
            unsigned key[32];
#pragma unroll
            for (int kb = 0; kb < 8; ++kb) { f32x4 acc = (f32x4){0.f, 0.f, 0.f, 0.f};
                const unsigned so = ((unsigned)(p * 128 + 16 * kb + c16) * 128u + 8u * (unsigned)g) * 2u;
#pragma unroll
                for (int ks = 0; ks < 4; ++ks) { const bf16x8 sf = *(const GAS bf16x8*)((const unsigned char*)SK + (so + 64u * ks)); acc = MFMA16(sf, qf[ks], acc); }
#pragma unroll
                for (int r = 0; r < 4; ++r) key[kb * 4 + r] = (f2ord(acc[r]) & ~0x7Fu) | (unsigned)(16 * kb + 4 * g + r);
                __builtin_amdgcn_sched_barrier(0); }
            bitonic_sort_desc<32>(key);
            unsigned top[16];
#pragma unroll
            for (int i = 0; i < 16; ++i) top[i] = key[i];
            merge16_xor(top, 16); merge16_xor(top, 32);
            if (g == 0) { LAS v4u* d = (LAS v4u*)(lst + (c * 32 + 16 * tb + c16) * 16);
                d[0] = (v4u){top[0], top[1], top[2], top[3]}; d[1] = (v4u){top[4], top[5], top[6], top[7]}; d[2] = (v4u){top[8], top[9], top[10], top[11]}; d[3] = (v4u){top[12], top[13], top[14], top[15]}; }
        }
        LDS_WAIT();
        const LAS unsigned* l1 = lst + (16 * tb + c16) * 16; const LAS unsigned* l2 = lst + (32 + 16 * tb + c16) * 16;
        unsigned ck[16];
#pragma unroll
        for (int k = 0; k < 13; ++k) { const unsigned ab = PEER_CAND[4 * k + g]; const unsigned a = ab >> 4, bq = ab & 15u;
            const float s = ord2f(l1[a] & ~0x7Fu) + ord2f(l2[bq] & ~0x7Fu); ck[k] = (ab == 255u) ? 0u : ((f2ord(s) & ~0xFFu) | ab); }
        ck[13] = 0u; ck[14] = 0u; ck[15] = 0u;
        bitonic_sort_desc<16>(ck);
        merge16_xor(ck, 16); merge16_xor(ck, 32);
        if (g == 0) { const int tl = 16 * tb + c16; const float m = ord2f(ck[0] & ~0xFFu); float e[16]; float sum = 0.f;
#pragma unroll
            for (int k = 0; k < 16; ++k) { e[k] = __expf(ord2f(ck[k] & ~0xFFu) - m); sum += e[k]; }
            const float inv = 1.f / sum;
#pragma unroll
            for (int k = 0; k < 16; ++k) { const unsigned a = (ck[k] >> 4) & 15u, bq = ck[k] & 15u; const int ex = (int)((l1[a] & 0x7Fu) * 128u + (l2[bq] & 0x7Fu));
                eidx[tl * 128 + w * 16 + k] = ex; gate[tl * 128 + w * 16 + k] = e[k] * inv; } }
    }
#endif
    __syncthreads();
    LAS unsigned char* hnb = lds + P_HN + w * 4096; LAS float* actl = (LAS float*)(lds + P_ACT) + w * 128;
    const LAS unsigned char* hb = hnb + 16 * g + ((c16 == 1) ? 1024 : 0);
    v4u bA[8], bB[8];
#define U_ISSUE(buf, e_, jb) do { const unsigned uo_ = (unsigned)(e_) * (unsigned)ROWB + 16u * (unsigned)g + 512u * (unsigned)(jb); \
        _Pragma("unroll") for (int jj = 0; jj < 8; ++jj) buf[jj] = *(const GAS v4u*)(U8 + (uo_ + 64u * jj)); __builtin_amdgcn_sched_barrier(0); } while (0)
#define U_CONSUME(buf, jb) do { v4u bq_[8]; _Pragma("unroll") for (int jj = 0; jj < 8; ++jj) bq_[jj] = *(const LAS v4u*)(hb + 64 * (8 * (jb) + jj)); \
        __builtin_amdgcn_sched_barrier(0); \
        _Pragma("unroll") for (int jj = 0; jj < 8; ++jj) { const v4u a_ = buf[jj]; \
            const v8i av_ = {(int)a_.x, (int)a_.y, (int)a_.z, (int)a_.w, 0, 0, 0, 0}; const v8i bv_ = {(int)bq_[jj].x, (int)bq_[jj].y, (int)bq_[jj].z, (int)bq_[jj].w, 0, 0, 0, 0}; \
            acc = __builtin_amdgcn_mfma_scale_f32_16x16x128_f8f6f4(av_, bv_, acc, 4, 4, 0, 0x7f7f7f7f, 0, 0x7f7f7f7f); } __builtin_amdgcn_sched_barrier(0); } while (0)
#define U_ACT(grp_) do { const float l0_ = __shfl_down(acc.x, 1), l1_ = __shfl_down(acc.y, 1), l2_ = __shfl_down(acc.z, 1), l3_ = __shfl_down(acc.w, 1); \
        if (c16 == 0) { const int k0 = 16 * (grp_) + 4 * g; constexpr float isc = 1.f / (SU * SH4), ilo = 1.f / SLO4; const f32x4 gt = *(const LAS f32x4*)(gate + tl * 128 + k0); \
        f32x4 a4; a4.x = gelu_erf((acc.x + l0_ * ilo) * isc) * gt.x; a4.y = gelu_erf((acc.y + l1_ * ilo) * isc) * gt.y; a4.z = gelu_erf((acc.z + l2_ * ilo) * isc) * gt.z; a4.w = gelu_erf((acc.w + l3_ * ilo) * isc) * gt.w; *(LAS f32x4*)(actl + k0) = a4; } } while (0)
#define V_ISSUE(buf, kb_) do { _Pragma("unroll") for (int kk = 0; kk < 8; ++kk) { const int e_ = eidx[tl * 128 + 8 * (kb_) + kk]; const unsigned vo_ = (unsigned)e_ * (unsigned)ROWB + 16u * (unsigned)lane; \
        buf[kk] = *(const GAS v4u*)(V8 + vo_); } __builtin_amdgcn_sched_barrier(0); } while (0)
#ifdef FP4_SOFT_DEC
#define FP4_DEC(x) fp4_dec2(x)
#else
#define FP4_DEC(x) __builtin_amdgcn_cvt_scalef32_pk_f32_fp4((x), 1.0f, 0)
#endif
#ifdef FP4_SWAP_DEC
#define FP4_ACC(oa, ob, d) do { oa += a_ * d.y; ob += a_ * d.x; } while (0)
#else
#define FP4_ACC(oa, ob, d) do { oa += a_ * d.x; ob += a_ * d.y; } while (0)
#endif
#define PIN8x2(a, i) asm volatile("" : "+v"(a[i]), "+v"(a[i + 1]), "+v"(a[i + 2]), "+v"(a[i + 3]), "+v"(a[i + 4]), "+v"(a[i + 5]), "+v"(a[i + 6]), "+v"(a[i + 7]))
#define V_CONSUME(buf, kb_) do { _Pragma("unroll") for (int kk = 0; kk < 8; ++kk) { const float as_ = actl[8 * (kb_) + kk]; const f32x2 a2_ = {as_, as_}; \
        const unsigned vw[4] = {buf[kk].x, buf[kk].y, buf[kk].z, buf[kk].w}; \
        _Pragma("unroll") for (int q = 0; q < 4; ++q) { \
            o2[4 * q]     = __builtin_elementwise_fma(__builtin_amdgcn_cvt_scalef32_pk_f32_fp4(vw[q], 1.0f, 0), a2_, o2[4 * q]); \
            o2[4 * q + 1] = __builtin_elementwise_fma(__builtin_amdgcn_cvt_scalef32_pk_f32_fp4(vw[q], 1.0f, 1), a2_, o2[4 * q + 1]); \
            o2[4 * q + 2] = __builtin_elementwise_fma(__builtin_amdgcn_cvt_scalef32_pk_f32_fp4(vw[q], 1.0f, 2), a2_, o2[4 * q + 2]); \
            o2[4 * q + 3] = __builtin_elementwise_fma(__builtin_amdgcn_cvt_scalef32_pk_f32_fp4(vw[q], 1.0f, 3), a2_, o2[4 * q + 3]); } \
        PIN8x2(o2, 0); PIN8x2(o2, 8); } } while (0)
#ifndef NO_GATHER
    int e_cur = eidx[w * 128 + c16];
    v2u xn[8];
#define X_ISSUE(tok_) do { const unsigned xb_ = (unsigned)(tok_) * (unsigned)(DM * 2) + 8u * (unsigned)lane; _Pragma("unroll") for (int j = 0; j < 8; ++j) xn[j] = *(const GAS v2u*)((const unsigned char*)X1B + (xb_ + 512u * j)); } while (0)
    X_ISSUE(T0 + w);
    U_ISSUE(bA, e_cur, 0);
    for (int ti = 0; ti < 4; ++ti) {
        const int tl = w + 8 * ti; const size_t token = (size_t)T0 + tl;
        f32x4 xr[8]; float ss = 0.f;
        const unsigned xo = (unsigned)token * (unsigned)(DM * 4) + 16u * (unsigned)lane;
        {
#pragma unroll
          for (int j = 0; j < 8; ++j) { const v2u r = xn[j]; xr[j] = (f32x4){bflo(r.x), bfhi(r.x), bflo(r.y), bfhi(r.y)}; }
#pragma unroll
          for (int j = 0; j < 8; ++j) ss += (xr[j].x * xr[j].x + xr[j].y * xr[j].y) + (xr[j].z * xr[j].z + xr[j].w * xr[j].w); }
        const float rs2 = __builtin_amdgcn_rsqf(wave_sum(ss) * (1.f / DM) + EPS);
        {
          const float* fg_ = fgain; asm volatile("" : "+s"(fg_));
          const unsigned char* gp = (const unsigned char*)fg_; const unsigned go = 16u * (unsigned)lane;
          unsigned hw[4], lw[4];
#pragma unroll
          for (int q = 0; q < 4; ++q) { unsigned wh = 0u, wl = 0u;
#pragma unroll
              for (int t = 0; t < 2; ++t) { const int j = 2 * q + t; const f32x4 gg = *(const GAS f32x4*)(gp + (go + 1024u * j)); const f32x4 hv = xr[j] * gg * (rs2 * SH4);
                  const float h0 = clampf(hv.x, 6.f), h1 = clampf(hv.y, 6.f), h2 = clampf(hv.z, 6.f), h3 = clampf(hv.w, 6.f);
                  const unsigned p0 = __builtin_amdgcn_cvt_scalef32_pk_fp4_f32(0u, h0, h1, 1.0f, 0), p1 = __builtin_amdgcn_cvt_scalef32_pk_fp4_f32(0u, h2, h3, 1.0f, 0);
                  const f32x2 d0 = __builtin_amdgcn_cvt_scalef32_pk_f32_fp4(p0, 1.0f, 0), d1 = __builtin_amdgcn_cvt_scalef32_pk_f32_fp4(p1, 1.0f, 0);
                  const unsigned r0 = __builtin_amdgcn_cvt_scalef32_pk_fp4_f32(0u, clampf((h0 - d0.x) * SLO4, 6.f), clampf((h1 - d0.y) * SLO4, 6.f), 1.0f, 0), r1 = __builtin_amdgcn_cvt_scalef32_pk_fp4_f32(0u, clampf((h2 - d1.x) * SLO4, 6.f), clampf((h3 - d1.y) * SLO4, 6.f), 1.0f, 0);
                  wh |= ((p0 & 0xFFu) | ((p1 & 0xFFu) << 8)) << (16 * t); wl |= ((r0 & 0xFFu) | ((r1 & 0xFFu) << 8)) << (16 * t); }
              hw[q] = wh; lw[q] = wl; }
          *(LAS v4u*)(hnb + 16 * lane) = (v4u){hw[0], hw[1], hw[2], hw[3]}; *(LAS v4u*)(hnb + 1024 + 16 * lane) = (v4u){lw[0], lw[1], lw[2], lw[3]}; }
        LDS_WAIT();
#pragma unroll 1
        for (int grp = 0; grp < 8; ++grp) {
            const int gn = grp < 7 ? grp + 1 : 7;
            const int e_nxt = eidx[tl * 128 + 16 * gn + c16];
            f32x4 acc = (f32x4){0.f, 0.f, 0.f, 0.f};
            U_ISSUE(bB, e_cur, 1); U_CONSUME(bA, 0);
            if (grp < 7) U_ISSUE(bA, e_nxt, 0); else V_ISSUE(bA, 0);
            U_CONSUME(bB, 1);
            U_ACT(grp);
            e_cur = e_nxt;
        }
        LDS_WAIT();
        f32x2 o2[16];
#pragma unroll
        for (int i = 0; i < 16; ++i) o2[i] = (f32x2){0.f, 0.f};
#pragma unroll 1
        for (int kb = 0; kb < 16; kb += 2) {
            V_ISSUE(bB, kb + 1); V_CONSUME(bA, kb);
            if (kb + 2 < 16) V_ISSUE(bA, kb + 2);
            else if (ti < 3) { e_cur = eidx[(tl + 8) * 128 + c16]; X_ISSUE(token + 8); U_ISSUE(bA, e_cur, 0); }
            V_CONSUME(bB, kb + 1);
        }
        { constexpr float isv = 1.f / SV; float s2 = 0.f;
#pragma unroll
          for (int j = 0; j < 8; ++j) { xr[j] = xr[j] + (f32x4){o2[2 * j].x, o2[2 * j].y, o2[2 * j + 1].x, o2[2 * j + 1].y} * isv;
              s2 += (xr[j].x * xr[j].x + xr[j].y * xr[j].y) + (xr[j].z * xr[j].z + xr[j].w * xr[j].w); }
          const float rf = __builtin_amdgcn_rsqf(wave_sum(s2) * (1.f / DM) + EPS);
          const float* fi_ = fing; asm volatile("" : "+s"(fi_));
          const unsigned char* fp = (const unsigned char*)fi_; unsigned char* op = (unsigned char*)outp; const unsigned fo = 16u * (unsigned)lane;
          if (!dry || rf == 1.2345e30f)
#pragma unroll
          for (int j = 0; j < 8; ++j) *(GAS f32x4*)(op + (xo + 1024u * j)) = xr[j] * rf * *(const GAS f32x4*)(fp + (fo + 1024u * j)); }
    }
#endif
#undef U_ISSUE
#undef X_ISSUE
#undef U_ACT
#undef U_CONSUME
#undef V_ISSUE
#undef V_CONSUME
    __syncthreads();
}

__global__ void __launch_bounds__(NWAVES * 64, 2) hybrid_fwd(Args args) {
    extern __shared__ __attribute__((aligned(16))) unsigned char lds[];
    Frame F;
    F.lds = (LAS unsigned char*)lds;
    F.MISC = (volatile LAS unsigned*)(F.lds + MISC_OFF);
    F.tid = threadIdx.x; F.lane = F.tid & 63; F.wave = __builtin_amdgcn_readfirstlane(F.tid >> 6); F.G = gridDim.x;
    for (int u = F.tid; u < (LDS_BYTES - LDSCTL_OFF) / 4; u += NWAVES * 64) ((LAS unsigned*)(F.lds + LDSCTL_OFF))[u] = 0u;
    __syncthreads();
    (void)args;
    XcdBarrier bar = xcd_barrier_post(F.ctl() + CW_BAR, F.MISC + 8);

#ifndef NO_P0
#ifdef PROBE_P0X2
    { int reps = 2; asm volatile("" : "+s"(reps)); for (int rep = 0; rep < reps; ++rep) p0_prologue(F); }
#else
    p0_prologue(F);
#endif
#endif
    xcd_barrier(bar);
#ifndef NO_P1
#ifdef PROBE_GX2
    { int reps = 2; asm volatile("" : "+s"(reps)); for (int rep = 0; rep < reps; ++rep) {
#else
    { { const int rep = 0, reps = 1;
#endif
      pg8::Gemm gm{F.HN(), F.WinT(), MTOK, NPAD, DM}; pg8::StaticOrder S; S.init(MTOK, NPAD, F.G, (int)blockIdx.x);
      EpiProj E{F.PROJ(), F.dtraw(), (rep + 1 < reps) ? nullptr : F.kmean()};
      pg8::gemm_phase<EpiProj, pg8::StaticOrder, PG8_ALIGN, PG8_SP2>(F.lds + RING_OFF, gm, S, E); } }
    { const int nun = (MTOK / 256) * (NPAD / 256), rem = nun % F.G;
      if (rem && (int)blockIdx.x >= rem) tables_convert(F, tab_split(F.G), TAB_ITEMS, (size_t)((int)blockIdx.x - rem) * (NWAVES * 64) + fresh_tid(), (size_t)(F.G - rem) * (NWAVES * 64)); }
#endif
    xcd_barrier(bar);
#ifdef PROBE_P15X2
    conv_phase(F);
#endif
    conv_phase(F);
    xcd_barrier(bar);
#ifdef PROBE_P2X2
    { int reps = 2; asm volatile("" : "+s"(reps)); for (int rep = 0; rep < reps; ++rep) {
#else
    { { const int rep = 0, reps = 1;
#endif
    const bool doatom = rep + 1 == reps;
    for (;;) {
        if (F.tid == 0) F.MISC[0] = xb_add(F.ctl() + CW_Q2 + 64 * rep, 1u);
        __syncthreads();
        const int ui = (int)F.MISC[0];
        __syncthreads();
        if (ui >= 128 + 512) break;
#ifdef PROBE_P2_SSD
        if (ui < 128 || doatom)
#endif
#ifdef PROBE_P2_ATT
        if (ui >= 128 || doatom)
#endif
        {
        if (ui < 128) ssd_unit(F, ui >> 4, ui & 15, doatom);
        else { const int a = ui - 128; attn_unit(F, (a & 63) >> 3, a & 7, 7 - (a >> 6), doatom); }
        }
    } } }
    xcd_barrier(bar);
#ifndef NO_P3
#ifdef PROBE_GX2
    { int reps = 2; asm volatile("" : "+s"(reps)); for (int rep = 0; rep < reps; ++rep) {
#else
    { { const int rep = 0, reps = 1;
#endif
      pg8::Gemm gm{F.HN(), F.WoutT(), MTOK, DM, DM}; pg8::StaticOrder S; S.init(MTOK, DM, F.G, (int)blockIdx.x);
      {
        const int t_ = fresh_tid(); pg8::Unit uu; const float* const sq = F.ssq();
        if (S.next(t_ >> 8, uu)) { const int row = uu.pm * 256 + (t_ & 255);
            const float q1 = __hip_atomic_load(sq + (size_t)row * 4 + 1, RLX_AGENT), q2 = __hip_atomic_load(sq + (size_t)row * 4 + 2, RLX_AGENT), q3 = __hip_atomic_load(sq + (size_t)row * 4 + 3, RLX_AGENT);
            const float sa = __builtin_amdgcn_rsqf(q1 * (1.f / 1024.f) + EPS), s0 = __builtin_amdgcn_rsqf(q2 * (1.f / 512.f) + EPS), s1 = __builtin_amdgcn_rsqf(q3 * (1.f / 512.f) + EPS);
            *(LAS f32x4*)(F.lds + SEGTAB_OFF + t_ * 16) = (f32x4){sa / s0, s0 / s1, s1, 0.f}; }
        __syncthreads(); }
      EpiOut E{F.x(), F.X1B(), F.ssq(), rep + 1 == reps, (const LAS f32x4*)(F.lds + SEGTAB_OFF)};
      pg8::gemm_phase<EpiOut, pg8::StaticOrder, PG8_ALIGN, PG8_SP2>(F.lds + RING_OFF, gm, S, E); } }
#endif
    xcd_barrier(bar);
#ifndef NO_P4
#ifdef PROBE_GX2
    { int reps = 2; asm volatile("" : "+s"(reps)); for (int rep = 0; rep < reps; ++rep) {
#else
    { { const int rep = 0, reps = 1; (void)rep; (void)reps;
#endif
      pg8::Gemm gm{F.X1B(), F.WqT(), MTOK, DM, DM}; pg8::StaticOrder S; S.init(MTOK, DM, F.G, (int)blockIdx.x);
      EpiQ E{F.QP(), F.ssq()};
      pg8::gemm_phase<EpiQ, pg8::StaticOrder, PG8_ALIGN, PG8_SP2>(F.lds + RING_OFF, gm, S, E); } }
#endif
    xcd_barrier(bar);
#ifndef NO_P5
#ifdef PROBE_P5X2
    { int reps = 2; asm volatile("" : "+s"(reps));
      for (int rep = 0; rep < reps; ++rep) for (int u = blockIdx.x; u < MTOK / 32; u += F.G) peer_unit(F, u, rep + 1 < reps); }
#else
    for (int u = blockIdx.x; u < MTOK / 32; u += F.G) peer_unit(F, u);
#endif
#endif
}

extern "C" void kernel_launch(void* const* d_in, const int* in_sizes, int n_in, void* d_out, int out_size, void* d_ws, size_t ws_size, hipStream_t stream) {
    static int grid = 0;
    if (grid == 0) {
        if (n_in != 18 || out_size != MTOK * DM || ws_size < WS_END) { fprintf(stderr, "kernel_launch: unexpected shapes (n_in %d, out %d, ws %zu)\n", n_in, out_size, ws_size); grid = -1; return; }
        int dev = 0, cus = 0, per_cu = 0;
        if (hipGetDevice(&dev) != hipSuccess || hipDeviceGetAttribute(&cus, hipDeviceAttributeMultiprocessorCount, dev) != hipSuccess) { grid = -1; return; }
        if (hipFuncSetAttribute((const void*)hybrid_fwd, hipFuncAttributeMaxDynamicSharedMemorySize, LDS_BYTES) != hipSuccess) { fprintf(stderr, "kernel_launch: hipFuncSetAttribute failed\n"); grid = -1; return; }
        if (hipOccupancyMaxActiveBlocksPerMultiprocessor(&per_cu, (const void*)hybrid_fwd, NWAVES * 64, LDS_BYTES) != hipSuccess || per_cu < 1)
            fprintf(stderr, "kernel_launch: note: occupancy query reports %d workgroups per CU\n", per_cu);
        (void)hipGetLastError();
        grid = cus;
    }
    if (grid < 0) return;
    if (hipMemsetAsync((char*)d_ws + WS_CTL, 0, CTL_ZERO_BYTES, stream) != hipSuccess) return;
    Args a{};
    for (int i = 0; i < 18; ++i) a.in[i] = (const float*)d_in[i];
    a.out = (float*)d_out; a.ws = (unsigned char*)d_ws;
    hipLaunchKernelGGL(hybrid_fwd, dim3(grid), dim3(NWAVES * 64), LDS_BYTES, stream, a);
}
```

```cpp
#include <hip/hip_runtime.h>
#include <cstdio>
#include <cstdint>
namespace pg8 {
#define PG8_LAS __attribute__((address_space(3)))
typedef unsigned short bf16_t;
typedef short bf16x8 __attribute__((ext_vector_type(8)));
typedef float f32x4 __attribute__((ext_vector_type(4)));
typedef unsigned u32x4 __attribute__((ext_vector_type(4)));
constexpr int BM = 256, BK = 64, HALF = 128, HTB = HALF * BK * 2  , STAGE_BYTES = 8 * HTB, NXCD = 8, WGM = 8;

__host__ __device__ __forceinline__ int lds_byte(int r, int c) { const int st = (r >> 4) * 2 + (c >> 5), rr = r & 15, cc = c & 31, ob = rr * 64 + cc * 2; return st * 1024 + (ob ^ (((ob >> 9) & 1) << 5)); }
__host__ __device__ __forceinline__ void stage_rc(int b, int& R, int& C) { const int st = b / 1024, sb = b % 1024, swz = sb ^ (((sb >> 9) & 1) << 5); R = (st >> 1) * 16 + swz / 64; C = (st & 1) * 32 + (swz % 64) / 2; }
__host__ __device__ __forceinline__ int perm32(int rho) { const int n = rho >> 4, i = rho & 15; return 8 * (i >> 2) + 4 * n + (i & 3); }

struct Unit { int pm, pn; };
struct Gemm { const bf16_t* A; const bf16_t* Bt; int M, N, K; };

struct StaticOrder {
    int nM, nN, nwg, G, c;
    __host__ __device__ void init(int M, int N, int G_, int c_) { nM = M / BM; nN = N / BM; nwg = nM * nN; G = G_; c = c_; }
    __host__ __device__ bool next(int i, Unit& u) const {
        const long L = (long)i * G + c; if (L >= nwg) return false;
        int wgid = (int)L; { const int q = nwg / NXCD, r = nwg % NXCD, xcd = wgid % NXCD, off = wgid / NXCD; wgid = (xcd < r ? xcd * (q + 1) : r * (q + 1) + (xcd - r) * q) + off; }
        const int nig = WGM * nN, gid = wgid / nig, fm = gid * WGM, gsz = (nM - fm) < WGM ? (nM - fm) : WGM;
        u.pm = fm + ((wgid % nig) % gsz); u.pn = (wgid % nig) / gsz; return true;
    }
    __device__ __forceinline__ void a_ready(const Unit&) const {}
    __device__ __forceinline__ void done(const Unit&) const {}
};

__device__ __forceinline__ unsigned cvt_pk_bf16(float lo, float hi) { unsigned r; asm volatile("v_cvt_pk_bf16_f32 %0, %1, %2" : "=v"(r) : "v"(lo), "v"(hi)); return r; }
typedef float f32x2 __attribute__((ext_vector_type(2)));
__device__ __forceinline__ f32x2 gelu_pk(f32x2 v) {
    const f32x2 av = __builtin_elementwise_abs(v), d = av * 0.2316418882f + 1.0f;
    f32x2 t; t.x = __builtin_amdgcn_rcpf(d.x); t.y = __builtin_amdgcn_rcpf(d.y);
    f32x2 q = t * 0.5307027145f + (-0.7265760135f); q = q * t + 0.7107068705f; q = q * t + (-0.142248368f); q = q * t + 0.127414796f; q = q * t;
    const f32x2 s = (v * v) * (-0.72134752044f);
    f32x2 e; e.x = __builtin_amdgcn_exp2f(s.x); e.y = __builtin_amdgcn_exp2f(s.y);
    const f32x2 m = v * (q * e), r = v - m;
    f32x2 o; o.x = v.x < 0.f ? m.x : r.x; o.y = v.y < 0.f ? m.y : r.y; return o;
}

template <int ACT  > struct EpiBf16 {
    static constexpr bool PERM = true, AFTER_DRAIN = false, SEG = false; static_assert(ACT == 0 || ACT == 1, "EpiBf16: ACT is 0 (none) or 1 (gelu_pk)");
    bf16_t* O; int ldc; const float* bias; int split_cols; size_t split_stride; float scale0;
    __device__ __forceinline__ void operator()(const f32x4 (&acc)[2][2][4][2], const Unit& u, int wr, int wc, int fr, int fq) const {
        const int row0 = u.pm * BM + wr * 64 + fr; int colt = u.pn * BM; bf16_t* base = O;
        float sc = 1.f; if (split_cols) { const int t = colt / split_cols; base += (size_t)t * split_stride; colt -= t * split_cols; if (t == 0) sc = scale0; }
        const int col0 = colt + wc * 32 + 8 * fq, bcol0 = u.pn * BM + wc * 32 + 8 * fq;
        f32x4 bv[2][2];
#pragma unroll
        for (int bj = 0; bj < 2; ++bj)
#pragma unroll
            for (int n = 0; n < 2; ++n) bv[bj][n] = bias ? *(const f32x4*)(bias + bcol0 + bj * HALF + 4 * n) : (f32x4){0.f, 0.f, 0.f, 0.f};
#pragma unroll
        for (int ai = 0; ai < 2; ++ai)
#pragma unroll
            for (int m = 0; m < 4; ++m) { bf16_t* rowp = base + (size_t)(row0 + ai * HALF + m * 16) * ldc + col0;
#pragma unroll
                for (int bj = 0; bj < 2; ++bj) { f32x4 v0 = acc[ai][bj][m][0] + bv[bj][0], v1 = acc[ai][bj][m][1] + bv[bj][1];
                    if (ACT == 1) { f32x2 a = gelu_pk((f32x2){v0[0], v0[1]}), b = gelu_pk((f32x2){v0[2], v0[3]}), c = gelu_pk((f32x2){v1[0], v1[1]}), d = gelu_pk((f32x2){v1[2], v1[3]});
                        v0 = (f32x4){a.x, a.y, b.x, b.y}; v1 = (f32x4){c.x, c.y, d.x, d.y}; }
                    v0 = v0 * sc; v1 = v1 * sc; u32x4 w; w.x = cvt_pk_bf16(v0[0], v0[1]); w.y = cvt_pk_bf16(v0[2], v0[3]); w.z = cvt_pk_bf16(v1[0], v1[1]); w.w = cvt_pk_bf16(v1[2], v1[3]);
                    *(u32x4*)(rowp + bj * HALF) = w; } }
    }
};
template <class Epi, class Sched, bool ALIGN_EPI = false, bool SP2 = false>
__device__ __forceinline__ void gemm_phase(PG8_LAS unsigned char* lds, const Gemm g, const Sched& S, const Epi& E) {
    const int tid = threadIdx.x, wid = __builtin_amdgcn_readfirstlane(tid >> 6), lane = tid & 63, wr = wid >> 2, wc = wid & 3, fr = lane & 15, fq = lane >> 4;
    const int K = g.K, nt = K / BK;
    unsigned voffA[2], voffB[2];
#pragma unroll
    for (int i = 0; i < 2; ++i) { int R, C; stage_rc(tid * 16 + i * 8192, R, C); const int Rb = Epi::PERM ? ((R & ~31) + perm32(R & 31)) : R;
        voffA[i] = (unsigned)(R * K + C) * 2u; voffB[i] = (unsigned)(Rb * K + C) * 2u; }
    const size_t kstep = (size_t)(BK * 2);
    const size_t hstep = (size_t)HALF * K * 2;
    const size_t tstep = 2 * hstep;
    const unsigned ldsw = (unsigned)wid * 1024u;
    const int aoff = lds_byte(wr * 64 + fr, fq * 8), boff = lds_byte(wc * 32 + fr, fq * 8);
#define PG8_SA(b, h) (((b) * 2 + (h)) * HTB)
#define PG8_SB(b, h) ((4 + (b) * 2 + (h)) * HTB)
#define PG8_STAGE(bufoff, gbase, voff) do { _Pragma("unroll") for (int _i = 0; _i < 2; ++_i) \
        __builtin_amdgcn_global_load_lds((const unsigned*)((const char*)(gbase) + (voff)[_i]), (PG8_LAS unsigned*)(lds + (bufoff) + ldsw + _i * 8192), 16, 0, 0); } while (0)
#define PG8_LDA(dst, b, h) do { _Pragma("unroll") for (int m = 0; m < 4; ++m) _Pragma("unroll") for (int k = 0; k < 2; ++k) dst[m][k] = *(const PG8_LAS bf16x8*)(lds + PG8_SA(b, h) + aoff + m * 2048 + k * 1024); } while (0)
#define PG8_LDB(dst, b, h) do { _Pragma("unroll") for (int n = 0; n < 2; ++n) _Pragma("unroll") for (int k = 0; k < 2; ++k) dst[n][k] = *(const PG8_LAS bf16x8*)(lds + PG8_SB(b, h) + boff + n * 2048 + k * 1024); } while (0)
#define PG8_MMA(ai, bj, At, Bt) do { __builtin_amdgcn_s_setprio(1); _Pragma("unroll") for (int m = 0; m < 4; ++m) _Pragma("unroll") for (int n = 0; n < 2; ++n) _Pragma("unroll") for (int k = 0; k < 2; ++k) \
        acc[ai][bj][m][n] = __builtin_amdgcn_mfma_f32_16x16x32_bf16(Bt[n][k], At[m][k], acc[ai][bj][m][n], 0, 0, 0); __builtin_amdgcn_s_setprio(0); } while (0)
#define PG8_WAIT_V(n) asm volatile("s_waitcnt vmcnt(" #n ")" ::: "memory")
#define PG8_WAIT_L(n) asm volatile("s_waitcnt lgkmcnt(" #n ")" ::: "memory")
#define PG8_BAR __builtin_amdgcn_s_barrier()
#define PG8_SCHED __builtin_amdgcn_sched_barrier(0)
    Unit cur, nxt; int ui = 0;
    if (!S.next(0, cur)) return;
    f32x4 acc[2][2][4][2];
#pragma unroll
    for (int a = 0; a < 2; ++a)
#pragma unroll
        for (int b = 0; b < 2; ++b)
#pragma unroll
            for (int m = 0; m < 4; ++m)
#pragma unroll
                for (int n = 0; n < 2; ++n) acc[a][b][m][n] = (f32x4){0.f, 0.f, 0.f, 0.f};
    bf16x8 At[4][2], B0[2][2], B1[2][2];
    const char* cA = (const char*)g.A + (size_t)cur.pm * tstep; const char* cB = (const char*)g.Bt + (size_t)cur.pn * tstep;
    S.a_ready(cur);
    float segr[16];
    if constexpr (Epi::SEG) E.seg_load(ui, wr, fr, segr);
    if constexpr (SP2) {
        PG8_STAGE(PG8_SB(0, 0), cB, voffB); PG8_STAGE(PG8_SB(0, 1), cB + hstep, voffB); PG8_STAGE(PG8_SA(0, 0), cA, voffA); PG8_STAGE(PG8_SA(0, 1), cA + hstep, voffA);
        if (wr == 1) PG8_BAR;
        PG8_WAIT_V(2); PG8_BAR;
        PG8_STAGE(PG8_SB(1, 0), cB + kstep, voffB); PG8_STAGE(PG8_SA(1, 0), cA + kstep, voffA); PG8_STAGE(PG8_SB(1, 1), cB + hstep + kstep, voffB);
        PG8_WAIT_V(6); PG8_BAR;
    } else {
        PG8_STAGE(PG8_SB(0, 0), cB, voffB); PG8_STAGE(PG8_SA(0, 0), cA, voffA); PG8_STAGE(PG8_SB(0, 1), cB + hstep, voffB); PG8_STAGE(PG8_SA(0, 1), cA + hstep, voffA);
        if (wr == 1) PG8_BAR;
        PG8_WAIT_V(4); PG8_BAR;
        PG8_STAGE(PG8_SB(1, 0), cB + kstep, voffB); PG8_STAGE(PG8_SA(1, 0), cA + kstep, voffA); PG8_STAGE(PG8_SB(1, 1), cB + hstep + kstep, voffB);
        PG8_WAIT_V(6); PG8_BAR;
    }
    for (;;) {
        const bool has_next = S.next(ui + 1, nxt);
        const char* nA = has_next ? (const char*)g.A + (size_t)nxt.pm * tstep : cA; const char* nB = has_next ? (const char*)g.Bt + (size_t)nxt.pn * tstep : cB;
        int t = 0;
#pragma unroll 1
        for (int sgi = 0; sgi < (Epi::SEG ? 3 : 1); ++sgi) {
        int tend = nt; if constexpr (Epi::SEG) tend = (sgi == 0) ? Epi::SEG_T1 : ((sgi == 1) ? Epi::SEG_T2 : nt);
        for (; t < tend; t += 2) {
            const bool last = (t == nt - 2);
            const char* a1 = cA + (size_t)(t + 1) * kstep;
            const char* a2 = last ? nA : cA + (size_t)(t + 2) * kstep; const char* b2 = last ? nB : cB + (size_t)(t + 2) * kstep;
            const char* a3 = a2 + kstep; const char* b3 = b2 + kstep;
            if (last && has_next) S.a_ready(nxt);
            if constexpr (SP2) {
            PG8_LDB(B0, 0, 0); PG8_LDB(B1, 0, 1); PG8_SCHED; PG8_LDA(At, 0, 0); PG8_STAGE(PG8_SA(1, 1), a1 + hstep, voffA);
            PG8_WAIT_V(8); PG8_WAIT_L(0); PG8_BAR; PG8_MMA(0, 0, At, B0); PG8_MMA(0, 1, At, B1); PG8_BAR; PG8_SCHED;
            PG8_LDA(At, 0, 1); PG8_STAGE(PG8_SB(0, 0), b2, voffB); PG8_STAGE(PG8_SB(0, 1), b2 + hstep, voffB); PG8_STAGE(PG8_SA(0, 0), a2, voffA);
            PG8_WAIT_V(8); PG8_WAIT_L(0); PG8_BAR; PG8_MMA(1, 0, At, B0); PG8_MMA(1, 1, At, B1); PG8_BAR; PG8_SCHED;
            PG8_LDB(B0, 1, 0); PG8_LDB(B1, 1, 1); PG8_SCHED; PG8_LDA(At, 1, 0); PG8_STAGE(PG8_SA(0, 1), a2 + hstep, voffA);
            PG8_WAIT_V(8); PG8_WAIT_L(0); PG8_BAR; PG8_MMA(0, 0, At, B0); PG8_MMA(0, 1, At, B1); PG8_BAR; PG8_SCHED;
            PG8_LDA(At, 1, 1); PG8_STAGE(PG8_SB(1, 0), b3, voffB); PG8_STAGE(PG8_SB(1, 1), b3 + hstep, voffB); PG8_STAGE(PG8_SA(1, 0), a3, voffA);
            PG8_WAIT_V(8); PG8_WAIT_L(0); PG8_BAR; PG8_MMA(1, 0, At, B0); PG8_MMA(1, 1, At, B1); PG8_BAR; PG8_SCHED;
            } else {
            PG8_LDB(B0, 0, 0); PG8_SCHED; PG8_LDA(At, 0, 0); PG8_STAGE(PG8_SA(1, 1), a1 + hstep, voffA);
            PG8_WAIT_L(8); PG8_BAR; PG8_WAIT_L(0); PG8_MMA(0, 0, At, B0); PG8_BAR; PG8_SCHED;
            PG8_LDB(B1, 0, 1); PG8_STAGE(PG8_SB(0, 0), b2, voffB);
            PG8_BAR; PG8_WAIT_L(0); PG8_MMA(0, 1, At, B1); PG8_BAR;
            PG8_LDA(At, 0, 1); PG8_STAGE(PG8_SA(0, 0), a2, voffA);
            PG8_BAR; PG8_WAIT_L(0); PG8_MMA(1, 0, At, B0); PG8_BAR; PG8_SCHED;
            PG8_STAGE(PG8_SB(0, 1), b2 + hstep, voffB);
            PG8_WAIT_V(6); PG8_BAR; PG8_MMA(1, 1, At, B1); PG8_BAR;
            PG8_LDB(B0, 1, 0); PG8_SCHED; PG8_LDA(At, 1, 0); PG8_STAGE(PG8_SA(0, 1), a2 + hstep, voffA);
            PG8_WAIT_L(8); PG8_BAR; PG8_WAIT_L(0); PG8_MMA(0, 0, At, B0); PG8_BAR; PG8_SCHED;
            PG8_LDB(B1, 1, 1); PG8_STAGE(PG8_SB(1, 0), b3, voffB);
            PG8_BAR; PG8_WAIT_L(0); PG8_MMA(0, 1, At, B1); PG8_BAR;
            PG8_LDA(At, 1, 1); PG8_STAGE(PG8_SA(1, 0), a3, voffA);
            PG8_BAR; PG8_WAIT_L(0); PG8_MMA(1, 0, At, B0); PG8_BAR; PG8_SCHED;
            PG8_STAGE(PG8_SB(1, 1), b3 + hstep, voffB);
            PG8_WAIT_V(6); PG8_BAR; PG8_MMA(1, 1, At, B1); PG8_BAR;
            }
        }
        if constexpr (Epi::SEG) E.seg_apply(acc, segr, sgi);
        }
        if constexpr (ALIGN_EPI) { if (wr == 0) PG8_BAR; }
        if constexpr (!Epi::AFTER_DRAIN) { if constexpr (Epi::SEG) E(acc, cur, wr, wc, fr, fq, ui); else E(acc, cur, wr, wc, fr, fq); S.done(cur); }
        if (!has_next) break;
#pragma unroll
        for (int a = 0; a < 2; ++a)
#pragma unroll
            for (int b = 0; b < 2; ++b)
#pragma unroll
                for (int m = 0; m < 4; ++m)
#pragma unroll
                    for (int n = 0; n < 2; ++n) acc[a][b][m][n] = (f32x4){0.f, 0.f, 0.f, 0.f};
        cur = nxt; cA = nA; cB = nB; ++ui;
        if constexpr (Epi::SEG) E.seg_load(ui, wr, fr, segr);
        if constexpr (ALIGN_EPI) { if (wr == 1) PG8_BAR; }
    }
    PG8_WAIT_V(0);
    if constexpr (!ALIGN_EPI) { if (wr == 0) PG8_BAR; }
    PG8_BAR;
    if constexpr (Epi::AFTER_DRAIN) { E.fused(acc, cur, wr, wc, fr, fq, lds, wid, lane); S.done(cur); }
#undef PG8_SA
#undef PG8_SB
#undef PG8_STAGE
#undef PG8_LDA
#undef PG8_LDB
#undef PG8_MMA
#undef PG8_WAIT_V
#undef PG8_WAIT_L
#undef PG8_BAR
#undef PG8_SCHED
}
}
#ifndef PG8_SP2
#define PG8_SP2 true
#endif
#ifndef PG8_ALIGN
#define PG8_ALIGN true
#endif

constexpr int BATCH = 8, SEQ = 2048, DM = 2048, MTOK = BATCH * SEQ;
constexpr int ATT_W = 1024, ATT_H = 8, ATT_HD = 128, MOBA_BLK = 256, NBLK = SEQ / MOBA_BLK;
constexpr int SSM_W = 1024, SSM_H = 16, SSM_P = 64, SSM_N = 128, SSM_L = 128, SSM_NC = SEQ / SSM_L, CONV_CH = 1536;
constexpr int IN_PROJ = 5648, NPROJ = 5632  , NPAD = 5888  ;
constexpr int COL_Q = 0, COL_K = 1024, COL_V = 2048, COL_Z = 3072, COL_XBC = 4096;
constexpr int PEER_H = 8, PEER_NK = 128, PEER_K = 16, PEER_HK = 128;
constexpr float EPS = 1e-6f;
constexpr float SU = 64.f, SV = 4.f, SH = 16.f, SLO = 16.f;
constexpr float SH4 = 1.5f, SLO4 = 4.f;
constexpr int ROWB = DM / 2;

constexpr size_t MiB = 1u << 20;
constexpr size_t WS_CTL = 0, CTL_ZERO_BYTES = 1 * MiB;
constexpr size_t WS_DT = 1 * MiB;
constexpr size_t WS_SK = 2 * MiB;
constexpr size_t WS_WIN = 4 * MiB;
constexpr size_t WS_WOUT = 28 * MiB;
constexpr size_t WS_WQ = 36 * MiB;
constexpr size_t WS_HN = 44 * MiB;
constexpr size_t WS_PROJ = 108 * MiB;
constexpr size_t WS_X1B = WS_PROJ, WS_QP = WS_PROJ + 64 * MiB;
constexpr size_t WS_U8 = 284 * MiB, WS_V8 = 316 * MiB;
constexpr size_t WS_XBC = 348 * MiB;
constexpr size_t WS_DT2 = 3 * MiB;
constexpr size_t WS_END = 396 * MiB;
constexpr int CW_BAR = 4096;
constexpr int CW_Q2 = 8192;
constexpr int CW_KMEAN = 32768;
constexpr int CW_SSQ = 131072;
static_assert((CW_SSQ + MTOK * 4) * 4 <= (int)CTL_ZERO_BYTES, "CTL words inside the memset region");

constexpr int RING_OFF = 0, RING_BYTES = 131072;
constexpr int LDSCTL_OFF = RING_BYTES, MISC_OFF = LDSCTL_OFF + 320;
constexpr int SEGTAB_OFF = LDSCTL_OFF + 1024;  static_assert(LDSCTL_OFF + 1024 + 3 * 256 * 16 <= 147456, "segment table inside the LDS allocation");
constexpr int LDS_BYTES = 147456;
constexpr int NWAVES = 8;

#define GAS __attribute__((address_space(1)))
#define LAS __attribute__((address_space(3)))
typedef unsigned short bf16;
typedef unsigned v4u __attribute__((ext_vector_type(4)));
typedef unsigned v2u __attribute__((ext_vector_type(2)));
typedef float f32x4 __attribute__((ext_vector_type(4)));
typedef float f32x2 __attribute__((ext_vector_type(2)));
typedef short bf16x8 __attribute__((ext_vector_type(8)));
typedef short s16x4 __attribute__((ext_vector_type(4)));
typedef GAS unsigned gu32;
#define RLX_AGENT __ATOMIC_RELAXED, __HIP_MEMORY_SCOPE_AGENT
#define LDS_WAIT() asm volatile("s_waitcnt lgkmcnt(0)" ::: "memory")
#define VM_WAIT() asm volatile("s_waitcnt vmcnt(0)" ::: "memory")
__device__ __forceinline__ unsigned f2bf(float f) { unsigned u = __builtin_bit_cast(unsigned, f); return (u + 0x7fffu + ((u >> 16) & 1u)) >> 16; }
typedef __bf16 bf16v2 __attribute__((ext_vector_type(2)));
__device__ __forceinline__ unsigned pk2(float lo, float hi) { bf16v2 v; v.x = (__bf16)lo; v.y = (__bf16)hi; return __builtin_bit_cast(unsigned, v); }
__device__ __forceinline__ float bflo(unsigned w) { return __builtin_bit_cast(float, w << 16); }
__device__ __forceinline__ float bfhi(unsigned w) { return __builtin_bit_cast(float, w & 0xffff0000u); }
__device__ __forceinline__ float wave_sum(float v) {
#pragma unroll
    for (int o = 1; o < 64; o <<= 1) v += __shfl_xor(v, o);
    return v;
}
__device__ __forceinline__ float silu_f(float x) { return x * __builtin_amdgcn_rcpf(1.f + __expf(-x)); }

#define XB_TMO      128
#define XB_XCNT(j)  (256  + 64 * (j))
#define XB_XSUB(j)  (1280 + 64 * (j))
#define XB_XGEN(j)  (2304 + 64 * (j))
#define XB_TOP      3328
#define XB_TOPGEN   3392
#define XCD_BAR_WORDS 3456
#define XB_SPIN_CAP (1u << 18)

__device__ __forceinline__ unsigned xb_ld(unsigned* p)              { return __hip_atomic_load(p, __ATOMIC_RELAXED, __HIP_MEMORY_SCOPE_AGENT); }
__device__ __forceinline__ unsigned xb_add(unsigned* p, unsigned v) { return __hip_atomic_fetch_add(p, v, __ATOMIC_RELAXED, __HIP_MEMORY_SCOPE_AGENT); }
__device__ __forceinline__ unsigned xb_xcc_id() { return (unsigned)__builtin_amdgcn_s_getreg((3 << 11) | 20) & 0xFu; }
#define XB_SPIN(cond, bar) do { unsigned _sp = 0; while (cond) { __builtin_amdgcn_s_sleep(1); \
    if ((++_sp & 255u) == 0u) { if (xb_ld(&(bar)[XB_TMO])) break; if (_sp > XB_SPIN_CAP) { atomicAdd(&(bar)[XB_TMO], 1u); break; } } } } while (0)

struct XcdBarrier {
    unsigned* bar; unsigned x;
    volatile LAS unsigned* st;
};
__device__ __forceinline__ XcdBarrier xcd_barrier_post(unsigned* bar, volatile LAS unsigned* st) {
    XcdBarrier b; b.bar = bar; b.x = xb_xcc_id(); b.st = st;
    if (threadIdx.x == 0) (void)xb_add(&bar[XB_XCNT(b.x)], 1u);
    return b;
}
__device__ __forceinline__ void xcd_barrier_complete(unsigned* bar, unsigned x, unsigned& nloc, unsigned& nx) {
    const unsigned G = gridDim.x * gridDim.y * gridDim.z;
    unsigned sum, cnt, mine, sp = 0u;
    for (;;) {
        sum = 0u; cnt = 0u; mine = 0u;
#pragma unroll
        for (unsigned j = 0; j < 16; ++j) { const unsigned c = xb_ld(&bar[XB_XCNT(j)]); sum += c; cnt += (c > 0u) ? 1u : 0u; mine = (j == x) ? c : mine; }
        if (sum == G) break;
        __builtin_amdgcn_s_sleep(1);
        if ((++sp & 255u) == 0u) { if (xb_ld(&bar[XB_TMO])) break; if (sp > XB_SPIN_CAP) { atomicAdd(&bar[XB_TMO], 1u); break; } }
    }
    nloc = mine > 0u ? mine : 1u; nx = cnt > 0u ? cnt : 1u;
}
__device__ __forceinline__ void xcd_barrier(const XcdBarrier& b) {
    asm volatile("s_waitcnt vmcnt(0)" ::: "memory");
    __syncthreads();
    if (threadIdx.x == 0) {
        unsigned* bar = b.bar;
        __builtin_amdgcn_s_waitcnt(0);
        unsigned nloc = b.st[0], nx = b.st[1];
        if (nloc == 0u) { xcd_barrier_complete(bar, b.x, nloc, nx); b.st[0] = nloc; b.st[1] = nx; }
        const unsigned old = xb_add(&bar[XB_XSUB(b.x)], 1u);
        const unsigned gen = old / nloc;
        if (old + 1u == (gen + 1u) * nloc) {
            __builtin_amdgcn_fence(__ATOMIC_RELEASE, "agent");
            asm volatile("s_waitcnt vmcnt(0)" ::: "memory");
            const unsigned og = xb_add(&bar[XB_TOP], 1u);
            const unsigned tg = og / nx;
            if (og + 1u == (tg + 1u) * nx) xb_add(&bar[XB_TOPGEN], 1u);
            else XB_SPIN(xb_ld(&bar[XB_TOPGEN]) == tg, bar);
            __builtin_amdgcn_fence(__ATOMIC_ACQUIRE, "agent");
            xb_add(&bar[XB_XGEN(b.x)], 1u);
            asm volatile("s_waitcnt vmcnt(0)" ::: "memory");
        } else {
            XB_SPIN(xb_ld(&bar[XB_XGEN(b.x)]) == gen, bar);
            __builtin_amdgcn_fence(__ATOMIC_ACQUIRE, "agent");
            asm volatile("s_waitcnt vmcnt(0)" ::: "memory");
        }
    }
    __syncthreads();
}

#define CAS __attribute__((address_space(4)))
struct Args { const float* in[18]; float* out; unsigned char* ws; };
__device__ __forceinline__ const CAS unsigned char* kargs() { const CAS unsigned char* p = (const CAS unsigned char*)__builtin_amdgcn_kernarg_segment_ptr(); asm volatile("" : "+s"(p)); return p; }
__device__ __forceinline__ const float* kin(int i) { return *(const float* const CAS*)(kargs() + 8 * i); }
__device__ __forceinline__ float* kout() { return *(float* const CAS*)(kargs() + 8 * 18); }
__device__ __forceinline__ unsigned char* kws() { return *(unsigned char* const CAS*)(kargs() + 8 * 19); }
__device__ __forceinline__ int fresh_tid() { int t = threadIdx.x; asm volatile("" : "+v"(t)); return t; }
struct Frame {
    LAS unsigned char* lds;
    volatile LAS unsigned* MISC;
    int tid, lane, wave, G;
    __device__ __forceinline__ const float* x() const { return kin(0); }
    __device__ __forceinline__ const float* attn_norm() const { return kin(1); }
    __device__ __forceinline__ const float* w_in() const { return kin(2); }
    __device__ __forceinline__ const float* conv_w() const { return kin(3); }
    __device__ __forceinline__ const float* conv_b() const { return kin(4); }
    __device__ __forceinline__ const float* dt_bias() const { return kin(5); }
    __device__ __forceinline__ const float* a_log() const { return kin(6); }
    __device__ __forceinline__ const float* d_skip() const { return kin(7); }
    __device__ __forceinline__ const float* rel_bias() const { return kin(8); }
    __device__ __forceinline__ const float* attn_out_norm() const { return kin(9); }
    __device__ __forceinline__ const float* ssm_out_norm() const { return kin(10); }
    __device__ __forceinline__ const float* w_out() const { return kin(11); }
    __device__ __forceinline__ const float* ffn_norm() const { return kin(12); }
    __device__ __forceinline__ const float* peer_wq() const { return kin(13); }
    __device__ __forceinline__ const float* peer_sk() const { return kin(14); }
    __device__ __forceinline__ const float* peer_u() const { return kin(15); }
    __device__ __forceinline__ const float* peer_v() const { return kin(16); }
    __device__ __forceinline__ const float* final_norm() const { return kin(17); }
    __device__ __forceinline__ float* out() const { return kout(); }
    __device__ __forceinline__ unsigned* ctl() const { return (unsigned*)(kws() + WS_CTL); }
    __device__ __forceinline__ float* dtraw() const { return (float*)(kws() + WS_DT); }
    __device__ __forceinline__ bf16* SK() const { return (bf16*)(kws() + WS_SK); }
    __device__ __forceinline__ bf16* WinT() const { return (bf16*)(kws() + WS_WIN); }
    __device__ __forceinline__ bf16* WoutT() const { return (bf16*)(kws() + WS_WOUT); }
    __device__ __forceinline__ bf16* WqT() const { return (bf16*)(kws() + WS_WQ); }
    __device__ __forceinline__ bf16* HN() const { return (bf16*)(kws() + WS_HN); }
    __device__ __forceinline__ bf16* PROJ() const { return (bf16*)(kws() + WS_PROJ); }
    __device__ __forceinline__ bf16* X1B() const { return (bf16*)(kws() + WS_X1B); }
    __device__ __forceinline__ bf16* QP() const { return (bf16*)(kws() + WS_QP); }
    __device__ __forceinline__ unsigned char* U8() const { return kws() + WS_U8; }
    __device__ __forceinline__ unsigned char* V8() const { return kws() + WS_V8; }
    __device__ __forceinline__ bf16* XBC() const { return (bf16*)(kws() + WS_XBC); }
    __device__ __forceinline__ float* DT2() const { return (float*)(kws() + WS_DT2); }
    __device__ __forceinline__ float* kmean() const { return (float*)(kws() + WS_CTL) + CW_KMEAN; }
    __device__ __forceinline__ float* ssq() const { return (float*)(kws() + WS_CTL) + CW_SSQ; }
};

__device__ __forceinline__ void p0_transpose_item(const float* W, int K, int N, bf16* WT, const float* gain, LAS float* scr, int item, int lane) {
    const int nblk = (N + 31) / 32, kb = item / nblk, nb = item % nblk, k0 = 64 * kb, n0 = 32 * nb;
    const int kr = lane >> 3, nc = (lane & 7) * 4; const bool ok = (n0 + nc) < N;
    f32x4 v[8]; float gk[8];
#pragma unroll
    for (int i = 0; i < 8; ++i) { const int kk = 8 * i + kr; v[i] = ok ? *(const GAS f32x4*)(W + (size_t)(k0 + kk) * N + n0 + nc) : (f32x4){0.f, 0.f, 0.f, 0.f}; gk[i] = gain ? gain[k0 + kk] : 1.f; }
#pragma unroll
    for (int i = 0; i < 8; ++i) { const int kk = 8 * i + kr; LAS float* d = scr + kk * 33 + nc; d[0] = v[i].x * gk[i]; d[1] = v[i].y * gk[i]; d[2] = v[i].z * gk[i]; d[3] = v[i].w * gk[i]; }
    LDS_WAIT(); asm volatile("" ::: "memory");
    const int c = lane & 7;
#pragma unroll
    for (int j = 0; j < 4; ++j) { const int n = (lane >> 3) + 8 * j; const LAS float* s = scr + (8 * c) * 33 + n;
        v4u o; o.x = pk2(s[0 * 33], s[1 * 33]); o.y = pk2(s[2 * 33], s[3 * 33]); o.z = pk2(s[4 * 33], s[5 * 33]); o.w = pk2(s[6 * 33], s[7 * 33]);
        *(GAS v4u*)(WT + (size_t)(n0 + n) * K + k0 + 8 * c) = o; }
    LDS_WAIT(); asm volatile("" ::: "memory");
}
__device__ __forceinline__ void rms_2rows_to_bf16(const float* x0, const float* x1, const float* gain, bf16* o0, bf16* o1, int lane) {
    const GAS f32x4* xr0 = (const GAS f32x4*)x0 + lane; const GAS f32x4* xr1 = (const GAS f32x4*)x1 + lane; const GAS f32x4* gr = (const GAS f32x4*)gain + lane;
    f32x4 v[8], u[8]; float s = 0.f, t = 0.f;
#pragma unroll
    for (int j = 0; j < 8; ++j) { v[j] = xr0[64 * j]; u[j] = xr1[64 * j]; }
#pragma unroll
    for (int j = 0; j < 8; ++j) { s += (v[j].x * v[j].x + v[j].y * v[j].y) + (v[j].z * v[j].z + v[j].w * v[j].w); t += (u[j].x * u[j].x + u[j].y * u[j].y) + (u[j].z * u[j].z + u[j].w * u[j].w); }
    const float rs = __builtin_amdgcn_rsqf(wave_sum(s) * (1.f / DM) + EPS), rt = __builtin_amdgcn_rsqf(wave_sum(t) * (1.f / DM) + EPS);
    GAS v2u* p0 = (GAS v2u*)o0 + lane; GAS v2u* p1 = (GAS v2u*)o1 + lane;
#pragma unroll
    for (int j = 0; j < 8; ++j) { const f32x4 g = gr[64 * j]; v2u a, b;
        a.x = pk2(v[j].x * rs * g.x, v[j].y * rs * g.y); a.y = pk2(v[j].z * rs * g.z, v[j].w * rs * g.w); p0[64 * j] = a;
        b.x = pk2(u[j].x * rt * g.x, u[j].y * rt * g.y); b.y = pk2(u[j].z * rt * g.z, u[j].w * rt * g.w); p1[64 * j] = b; }
}
#ifdef PROBE_FP4EMU
__device__ __forceinline__ float fp4grid(float y) { const float a = fabsf(y); float r;
    if (a <= 2.f) r = rintf(a * 2.f) * 0.5f; else if (a <= 4.f) r = rintf(a); else r = (a < 5.f) ? 4.f : 6.f;
    return copysignf(r, y); }
__device__ __forceinline__ float clampf(float v, float lim) { if (lim == 448.5f) return fp4grid(v * (1.f / 16.f)) * 16.f; return fminf(fmaxf(v, -lim), lim); }
#else
__device__ __forceinline__ float clampf(float v, float lim) { return fminf(fmaxf(v, -lim), lim); }
#endif
template <int TAB = 0> __device__ __forceinline__ v4u cvt16_fp8(const f32x4 a, const f32x4 b, const f32x4 c, const f32x4 d, float sc) {
    v4u o; int w; constexpr float LIM = TAB ? 448.5f : 448.f;
    w = __builtin_amdgcn_cvt_pk_fp8_f32(clampf(a.x * sc, LIM), clampf(a.y * sc, LIM), 0, false); w = __builtin_amdgcn_cvt_pk_fp8_f32(clampf(a.z * sc, LIM), clampf(a.w * sc, LIM), w, true); o.x = (unsigned)w;
    w = __builtin_amdgcn_cvt_pk_fp8_f32(clampf(b.x * sc, LIM), clampf(b.y * sc, LIM), 0, false); w = __builtin_amdgcn_cvt_pk_fp8_f32(clampf(b.z * sc, LIM), clampf(b.w * sc, LIM), w, true); o.y = (unsigned)w;
    w = __builtin_amdgcn_cvt_pk_fp8_f32(clampf(c.x * sc, LIM), clampf(c.y * sc, LIM), 0, false); w = __builtin_amdgcn_cvt_pk_fp8_f32(clampf(c.z * sc, LIM), clampf(c.w * sc, LIM), w, true); o.z = (unsigned)w;
    w = __builtin_amdgcn_cvt_pk_fp8_f32(clampf(d.x * sc, LIM), clampf(d.y * sc, LIM), 0, false); w = __builtin_amdgcn_cvt_pk_fp8_f32(clampf(d.z * sc, LIM), clampf(d.w * sc, LIM), w, true); o.w = (unsigned)w;
    return o;
}
__device__ __forceinline__ void tables_convert(Frame& F, size_t lo, size_t hi, size_t tix, size_t ntx) {
      const GAS f32x4* su = (const GAS f32x4*)F.peer_u(); const GAS f32x4* sv = (const GAS f32x4*)F.peer_v(); GAS v4u* du = (GAS v4u*)F.U8(); GAS v4u* dv = (GAS v4u*)F.V8();
#pragma unroll 1
      for (int tab = 0; tab < 2; ++tab) { const GAS f32x4* src = tab ? sv : su; GAS v4u* dst = tab ? dv : du; const float sc = tab ? SV : SU;
        f32x4 nx[8]; const size_t i0 = lo + tix;
        if (i0 < hi) { const GAS f32x4* p = src + (i0 >> 6) * 512 + (i0 & 63);
#pragma unroll
            for (int j = 0; j < 8; ++j) nx[j] = p[64 * j]; }
#pragma unroll 1
        for (size_t i = i0; i < hi; i += ntx) { f32x4 v[8];
#pragma unroll
            for (int j = 0; j < 8; ++j) v[j] = nx[j];
            if (i + ntx < hi) { const size_t i2 = i + ntx; const GAS f32x4* p = src + (i2 >> 6) * 512 + (i2 & 63);
#pragma unroll
                for (int j = 0; j < 8; ++j) nx[j] = p[64 * j]; }
            unsigned wd[4];
#pragma unroll
            for (int q = 0; q < 4; ++q) { const f32x4 a = v[2 * q] * sc, b = v[2 * q + 1] * sc; unsigned w = 0u;
                w = __builtin_amdgcn_cvt_scalef32_pk_fp4_f32(w, clampf(a.x, 6.f), clampf(a.y, 6.f), 1.0f, 0); w = __builtin_amdgcn_cvt_scalef32_pk_fp4_f32(w, clampf(a.z, 6.f), clampf(a.w, 6.f), 1.0f, 1);
                w = __builtin_amdgcn_cvt_scalef32_pk_fp4_f32(w, clampf(b.x, 6.f), clampf(b.y, 6.f), 1.0f, 2); w = __builtin_amdgcn_cvt_scalef32_pk_fp4_f32(w, clampf(b.z, 6.f), clampf(b.w, 6.f), 1.0f, 3); wd[q] = w; }
            dst[i] = (v4u){wd[0], wd[1], wd[2], wd[3]}; } }
}
constexpr size_t TAB_ITEMS = (size_t)16384 * 64;
__device__ __forceinline__ size_t tab_split(int G) { const int rem = ((MTOK / 256) * (NPAD / 256)) % G; return rem ? (TAB_ITEMS / 8) * 5 : TAB_ITEMS; }
__device__ __forceinline__ unsigned fp4_code(float y) { const float a = fabsf(y);
    const unsigned m = (unsigned)(a >= 0.25f) + (unsigned)(a >= 0.75f) + (unsigned)(a >= 1.25f) + (unsigned)(a >= 1.75f) + (unsigned)(a >= 2.5f) + (unsigned)(a >= 3.5f) + (unsigned)(a >= 5.0f);
    return m | ((y < 0.f) ? 8u : 0u); }
__device__ __forceinline__ void p0_prologue(Frame& F) {
    const int tid = fresh_tid(), lane = tid & 63, wave = __builtin_amdgcn_readfirstlane(tid >> 6);
    LAS float* scr = (LAS float*)(F.lds + RING_OFF + wave * 16384);
    const int gw = blockIdx.x * NWAVES + wave, NGW = F.G * NWAVES;
    constexpr int I_IN = (DM / 64) * ((IN_PROJ + 31) / 32), I_SQ = (DM / 64) * (DM / 32);
    constexpr int NITEMS = I_IN + 2 * I_SQ;
    { const float* const w_in = F.w_in(); const float* const w_out = F.w_out(); const float* const wq = F.peer_wq(); const float* const fg = F.ffn_norm(); bf16* const WinT = F.WinT(); bf16* const WoutT = F.WoutT(); bf16* const WqT = F.WqT(); const float* const gatt = F.attn_out_norm(); const float* const gssm = F.ssm_out_norm();
      for (int it = gw; it < NITEMS; it += NGW) {
        int r = it;
        if (r < I_IN) { p0_transpose_item(w_in, DM, IN_PROJ, WinT, nullptr, scr, r, lane); continue; } r -= I_IN;
        if (r < I_SQ) { const int k0_ = 64 * (r / (DM / 32)); p0_transpose_item(w_out, DM, DM, WoutT, (k0_ < ATT_W) ? gatt : (gssm - ATT_W), scr, r, lane); continue; } r -= I_SQ;
        p0_transpose_item(wq, DM, DM, WqT, fg, scr, r, lane);
      } }
    const size_t gt = (size_t)blockIdx.x * (NWAVES * 64) + tid, GT = (size_t)F.G * NWAVES * 64;
    { const size_t z0 = (size_t)5664 * DM / 8, z1 = (size_t)NPAD * DM / 8; GAS v4u* p = (GAS v4u*)F.WinT(); for (size_t i = z0 + gt; i < z1; i += GT) p[i] = (v4u){0u, 0u, 0u, 0u}; }
    { const GAS f32x4* s = (const GAS f32x4*)F.peer_sk(); GAS v2u* d = (GAS v2u*)F.SK(); for (size_t i = gt; i < (size_t)16 * 128 * 128 / 4; i += GT) { const f32x4 v = s[i]; v2u o; o.x = pk2(v.x, v.y); o.y = pk2(v.z, v.w); d[i] = o; } }
    { const float* const xg = F.x(); const float* const gn = F.attn_norm(); bf16* const hn = F.HN();
      for (int m = gw; m < MTOK / 2; m += NGW) rms_2rows_to_bf16(xg + (size_t)(2 * m) * DM, xg + (size_t)(2 * m + 1) * DM, gn, hn + (size_t)(2 * m) * DM, hn + (size_t)(2 * m + 1) * DM, lane); }
    tables_convert(F, 0, tab_split(F.G), gt, GT);
}

struct EpiProj {
    static constexpr bool PERM = true, AFTER_DRAIN = false, SEG = false;
    bf16* O; float* dtraw; float* kmean;
    __device__ __forceinline__ void operator()(const pg8::f32x4 (&acc)[2][2][4][2], const pg8::Unit& u, int wr, int wc, int fr, int fq) const {
        const int row0 = u.pm * 256 + wr * 64 + fr, col0 = u.pn * 256 + wc * 32 + 8 * fq;
        if (u.pn < 22) {
#pragma unroll
            for (int ai = 0; ai < 2; ++ai)
#pragma unroll
                for (int m = 0; m < 4; ++m) { bf16* rowp = O + (size_t)(row0 + ai * 128 + m * 16) * NPROJ + col0;
#pragma unroll
                    for (int bj = 0; bj < 2; ++bj) { const pg8::f32x4 v0 = acc[ai][bj][m][0], v1 = acc[ai][bj][m][1];
                        pg8::u32x4 w; w.x = pg8::cvt_pk_bf16(v0[0], v0[1]); w.y = pg8::cvt_pk_bf16(v0[2], v0[3]); w.z = pg8::cvt_pk_bf16(v1[0], v1[1]); w.w = pg8::cvt_pk_bf16(v1[2], v1[3]);
                        *(pg8::u32x4*)(rowp + bj * 128) = w; } }
        } else if (wc == 0 && fq < 2) {
#pragma unroll
            for (int ai = 0; ai < 2; ++ai)
#pragma unroll
                for (int m = 0; m < 4; ++m) { float* rp = dtraw + (size_t)(row0 + ai * 128 + m * 16) * 16 + 8 * fq;
                    *(pg8::f32x4*)rp = acc[ai][0][m][0]; *(pg8::f32x4*)(rp + 4) = acc[ai][0][m][1]; }
        }
        if (kmean && u.pn >= 4 && u.pn < 8) {
#pragma unroll
            for (int bj = 0; bj < 2; ++bj)
#pragma unroll
                for (int n = 0; n < 2; ++n)
#pragma unroll
                    for (int i = 0; i < 4; ++i) { float s = 0.f;
#pragma unroll
                        for (int ai = 0; ai < 2; ++ai)
#pragma unroll
                            for (int m = 0; m < 4; ++m) s += acc[ai][bj][m][n][i];
                        s += __shfl_xor(s, 1); s += __shfl_xor(s, 2); s += __shfl_xor(s, 4); s += __shfl_xor(s, 8);
                        if (fr == 0) unsafeAtomicAdd(kmean + (size_t)u.pm * 1024 + (col0 - 1024) + bj * 128 + 4 * n + i, s); }
        }
    }
};
struct EpiOut {
    static constexpr bool PERM = true, AFTER_DRAIN = false, SEG = true; static constexpr int SEG_T1 = 16, SEG_T2 = 24;
    const float* x; bf16* x1b; float* ssq; bool doatom; const LAS f32x4* tab;
    __device__ __forceinline__ void seg_load(int ui, int wr, int fr, float (&sr)[16]) const {
#pragma unroll
        for (int i = 0; i < 8; ++i) { const int r = (i >> 2) * 128 + wr * 64 + (i & 3) * 16 + fr; const f32x2 q = *(const LAS f32x2*)(tab + ui * 256 + r); sr[2 * i] = q.x; sr[2 * i + 1] = q.y; }
        asm volatile("s_waitcnt lgkmcnt(0)" ::: "memory");
    }
    __device__ __forceinline__ void seg_apply(pg8::f32x4 (&acc)[2][2][4][2], const float (&sr)[16], int which) const {
#pragma unroll
        for (int ai = 0; ai < 2; ++ai)
#pragma unroll
            for (int m = 0; m < 4; ++m) { const float f = (which == 0) ? sr[2 * (ai * 4 + m)] : ((which == 1) ? sr[2 * (ai * 4 + m) + 1] : 1.0f);
#pragma unroll
                for (int bj = 0; bj < 2; ++bj)
#pragma unroll
                    for (int n = 0; n < 2; ++n) acc[ai][bj][m][n] = acc[ai][bj][m][n] * f; }
    }
    __device__ __forceinline__ void operator()(const pg8::f32x4 (&acc)[2][2][4][2], const pg8::Unit& u, int wr, int wc, int fr, int fq, int ui) const {
        const int row0 = u.pm * 256 + wr * 64 + fr, col0 = u.pn * 256 + wc * 32 + 8 * fq;
#pragma unroll
        for (int ai = 0; ai < 2; ++ai)
#pragma unroll
            for (int m = 0; m < 4; ++m) { const int row = row0 + ai * 128 + m * 16; const size_t off = (size_t)row * DM + col0; float s = 0.f;
                const float s1 = (*(const LAS f32x4*)(tab + ui * 256 + ai * 128 + wr * 64 + m * 16 + fr)).z;
#pragma unroll
                for (int bj = 0; bj < 2; ++bj) {
                    const pg8::f32x4 a0 = *(const pg8::f32x4*)(x + off + bj * 128), a1 = *(const pg8::f32x4*)(x + off + bj * 128 + 4);
                    const pg8::f32x4 v0 = acc[ai][bj][m][0] * s1 + a0, v1 = acc[ai][bj][m][1] * s1 + a1;
                    pg8::u32x4 w; w.x = pg8::cvt_pk_bf16(v0[0], v0[1]); w.y = pg8::cvt_pk_bf16(v0[2], v0[3]); w.z = pg8::cvt_pk_bf16(v1[0], v1[1]); w.w = pg8::cvt_pk_bf16(v1[2], v1[3]);
                    *(pg8::u32x4*)(x1b + off + bj * 128) = w;
                    s += (v0[0] * v0[0] + v0[1] * v0[1]) + (v0[2] * v0[2] + v0[3] * v0[3]) + (v1[0] * v1[0] + v1[1] * v1[1]) + (v1[2] * v1[2] + v1[3] * v1[3]); }
                s += __shfl_xor(s, 16); s += __shfl_xor(s, 32);
                if (fq == 0 && doatom) unsafeAtomicAdd(ssq + (size_t)row * 4, s);
                asm volatile("" ::: "memory"); }
    }
};
struct EpiQ {
    static constexpr bool PERM = true, AFTER_DRAIN = false, SEG = false;
    bf16* O; const float* ssq;
    __device__ __forceinline__ void operator()(const pg8::f32x4 (&acc)[2][2][4][2], const pg8::Unit& u, int wr, int wc, int fr, int fq) const {
        const int row0 = u.pm * 256 + wr * 64 + fr, col0 = u.pn * 256 + wc * 32 + 8 * fq;
#pragma unroll
        for (int ai = 0; ai < 2; ++ai)
#pragma unroll
            for (int m = 0; m < 4; ++m) { const int row = row0 + ai * 128 + m * 16; bf16* rowp = O + (size_t)row * DM + col0;
                const float rs = 1.f / sqrtf(__hip_atomic_load(ssq + (size_t)row * 4, RLX_AGENT) * (1.f / DM) + EPS);
#pragma unroll
                for (int bj = 0; bj < 2; ++bj) { const pg8::f32x4 v0 = acc[ai][bj][m][0] * rs, v1 = acc[ai][bj][m][1] * rs;
                    pg8::u32x4 w; w.x = pg8::cvt_pk_bf16(v0[0], v0[1]); w.y = pg8::cvt_pk_bf16(v0[2], v0[3]); w.z = pg8::cvt_pk_bf16(v1[0], v1[1]); w.w = pg8::cvt_pk_bf16(v1[2], v1[3]);
                    *(pg8::u32x4*)(rowp + bj * 128) = w; } }
    }
};

constexpr int A_KSTR = 272, A_VSTR = 288;
constexpr int A_KB0 = 0, A_KB1 = 64 * A_KSTR, A_VB0 = 2 * 64 * A_KSTR, A_VB1 = A_VB0 + 64 * A_VSTR, A_KM = A_VB1 + 64 * A_VSTR, A_TAB = A_KM + 8 * 128 * 4, A_END = A_TAB + 128 * 4;
static_assert(A_END <= RING_BYTES && (A_KM % 16) == 0, "attention LDS map");
#define PIN16(a, i) asm volatile("" : "+v"(a[i]), "+v"(a[i + 1]), "+v"(a[i + 2]), "+v"(a[i + 3]), "+v"(a[i + 4]), "+v"(a[i + 5]), "+v"(a[i + 6]), "+v"(a[i + 7]), "+v"(a[i + 8]), "+v"(a[i + 9]), "+v"(a[i + 10]), "+v"(a[i + 11]), "+v"(a[i + 12]), "+v"(a[i + 13]), "+v"(a[i + 14]), "+v"(a[i + 15]))
#define TR16(p) __builtin_amdgcn_ds_read_tr16_b64_v4i16((LAS s16x4*)(p))
#define MFMA16(a, b, c) __builtin_amdgcn_mfma_f32_16x16x32_bf16((a), (b), (c), 0, 0, 0)
__device__ __forceinline__ bf16x8 pack8(const float* v) {
    const unsigned a = pk2(v[0], v[1]), b = pk2(v[2], v[3]), c = pk2(v[4], v[5]), d = pk2(v[6], v[7]);
    const v4u u = {a, b, c, d}; return __builtin_bit_cast(bf16x8, u);
}
__device__ __forceinline__ void attn_unit(Frame& F, int b, int h, int blk, const bool doatom = true) {
    LAS unsigned char* lds = F.lds + RING_OFF;
    const int tid = fresh_tid(), lane = tid & 63, w = __builtin_amdgcn_readfirstlane(tid >> 6), g = lane >> 4, c16 = lane & 15, q4 = c16 >> 2, p4 = lane & 3;
    const int own = blk, t0 = blk * 256, tq0 = t0 + 32 * w + c16;
    const size_t rowbase = (size_t)b * SEQ;
    const float NEG_INF = -__builtin_inff();
    constexpr float LOG2E = 1.4426950408889634f, SCL2 = 0.08838834764831845f * 1.4426950408889634f;
    LAS float* km = (LAS float*)(lds + A_KM); LAS float* tab = (LAS float*)(lds + A_TAB);
    const bf16* const PROJ = F.PROJ(); const float* const kmg = F.kmean(); const float* const relb = F.rel_bias();
    for (int i = tid; i < own * 128; i += NWAVES * 64) { const int n = i >> 7, d = i & 127; km[i] = kmg[(size_t)(b * 8 + n) * 1024 + h * 128 + d] * (1.f / 256.f); }
    if (tid < 128) { const int rel = tid; int bucket = rel; if (rel >= 16) { bucket = 16 + (int)(log2f((float)rel * (1.f / 16.f)) * (16.f / 3.f)); bucket = bucket > 31 ? 31 : bucket; }
        tab[tid] = relb[bucket * 8 + h] * LOG2E; }
    bf16x8 qf[2][4];
#pragma unroll
    for (int gi = 0; gi < 2; ++gi) { const bf16* qrow = PROJ + (rowbase + tq0 + 16 * gi) * NPROJ + COL_Q + h * 128 + 8 * g;
#pragma unroll
      for (int ks = 0; ks < 4; ++ks) qf[gi][ks] = *(const GAS bf16x8*)(qrow + 32 * ks); }
    __syncthreads();
    unsigned selmask[2];
    if (own <= 3) { selmask[0] = (1u << own) - 1u; selmask[1] = selmask[0]; }
    else {
#pragma unroll
      for (int gi = 0; gi < 2; ++gi) {
        float gate[7];
#pragma unroll
        for (int n = 0; n < 7; ++n) {
            float s = NEG_INF;
            if (n < own) { s = 0.f;
#pragma unroll
                for (int ks = 0; ks < 4; ++ks) { const LAS f32x4* kp = (const LAS f32x4*)(km + n * 128 + 32 * ks + 8 * g); const f32x4 k0 = kp[0], k1 = kp[1]; const v4u qu = __builtin_bit_cast(v4u, qf[gi][ks]);
                    s += bflo(qu.x) * k0.x + bfhi(qu.x) * k0.y + bflo(qu.y) * k0.z + bfhi(qu.y) * k0.w + bflo(qu.z) * k1.x + bfhi(qu.z) * k1.y + bflo(qu.w) * k1.z + bfhi(qu.w) * k1.w; }
                s += __shfl_xor(s, 16); s += __shfl_xor(s, 32); }
            gate[n] = s;
        }
        unsigned sm = 0u;
#pragma unroll
        for (int r = 0; r < 3; ++r) { float best = NEG_INF; int bi = 0;
#pragma unroll
            for (int n = 0; n < 7; ++n) { const bool cand = (n < own) && !((sm >> n) & 1u) && (gate[n] > best); best = cand ? gate[n] : best; bi = cand ? n : bi; }
            sm |= 1u << bi; }
        selmask[gi] = sm; }
    }
    const int nT = 4 + 4 * own;
    const int sr = tid >> 3, sc = (tid & 7) * 16;
#define A_KEY0(i) ((i) < 4 ? own * 256 + 64 * (i) : (((i) - 4) >> 2) * 256 + (((i) - 4) & 3) * 64)
    v4u kr0, kr1, vr0, vr1;
#define A_LOAD(i) do { const bf16* kp_ = PROJ + (rowbase + A_KEY0(i) + sr) * NPROJ + COL_K + h * 128 + sc; \
        kr0 = *(const GAS v4u*)kp_; kr1 = *(const GAS v4u*)(kp_ + 8); vr0 = *(const GAS v4u*)(kp_ + (COL_V - COL_K)); vr1 = *(const GAS v4u*)(kp_ + (COL_V - COL_K) + 8); } while (0)
#define A_STORE(bufi) do { LAS unsigned char* kd_ = lds + ((bufi) ? A_KB1 : A_KB0) + sr * A_KSTR + sc * 2; LAS unsigned char* vd_ = lds + ((bufi) ? A_VB1 : A_VB0) + sr * A_VSTR + sc * 2; \
        *(LAS v4u*)kd_ = kr0; *(LAS v4u*)(kd_ + 16) = kr1; *(LAS v4u*)vd_ = vr0; *(LAS v4u*)(vd_ + 16) = vr1; } while (0)
    A_LOAD(0); A_STORE(0);
    __syncthreads();
    float m_run[2] = {NEG_INF, NEG_INF}, l_run[2] = {0.f, 0.f};
    f32x4 oacc[2][8];
#pragma unroll
    for (int gi = 0; gi < 2; ++gi)
#pragma unroll
        for (int db = 0; db < 8; ++db) oacc[gi][db] = (f32x4){0.f, 0.f, 0.f, 0.f};
    for (int i = 0; i < nT; ++i) {
        if (i + 1 < nT) A_LOAD(i + 1);
        const int buf = i & 1, key0 = A_KEY0(i); const bool isown = i < 4; const int pblk = isown ? own : ((i - 4) >> 2);
        const bool skipw = isown && (64 * i > 32 * w + 31);
        if (!skipw) {
        LAS unsigned char* Kb = lds + (buf ? A_KB1 : A_KB0); LAS unsigned char* Vb = lds + (buf ? A_VB1 : A_VB0);
        f32x4 sacc[2][4];
#pragma unroll
        for (int hf = 0; hf < 2; ++hf) { bf16x8 kf[8];
#pragma unroll
            for (int n2 = 0; n2 < 2; ++n2)
#pragma unroll
                for (int ks = 0; ks < 4; ++ks) kf[n2 * 4 + ks] = *(const LAS bf16x8*)(Kb + (16 * (2 * hf + n2) + c16) * A_KSTR + (32 * ks + 8 * g) * 2);
            __builtin_amdgcn_sched_barrier(0);
#pragma unroll
            for (int gi = 0; gi < 2; ++gi)
#pragma unroll
                for (int n2 = 0; n2 < 2; ++n2) { f32x4 a = (f32x4){0.f, 0.f, 0.f, 0.f};
#pragma unroll
                    for (int ks = 0; ks < 4; ++ks) a = MFMA16(kf[n2 * 4 + ks], qf[gi][ks], a);
                    sacc[gi][2 * hf + n2] = a; }
            __builtin_amdgcn_sched_barrier(0); }
        const bool far = (key0 + 63 + 128 <= t0 + 32 * w);
        const bool diag = isown && (64 * i + 63 > 32 * w);
        bf16x8 pf[2][2];
#pragma unroll
        for (int gi = 0; gi < 2; ++gi) {
            const int tq = tq0 + 16 * gi; const bool sel = isown || ((selmask[gi] >> pblk) & 1u);
            float sv[16]; float mloc, m_new, alpha;
            if (far) {
                const float bfar = tab[127];
                float mx = fmaxf(fmaxf(sacc[gi][0][0], sacc[gi][0][1]), fmaxf(sacc[gi][0][2], sacc[gi][0][3]));
#pragma unroll
                for (int nb = 1; nb < 4; ++nb) mx = fmaxf(mx, fmaxf(fmaxf(sacc[gi][nb][0], sacc[gi][nb][1]), fmaxf(sacc[gi][nb][2], sacc[gi][nb][3])));
                mloc = sel ? (mx * SCL2 + bfar) : NEG_INF;
                mloc = fmaxf(mloc, __shfl_xor(mloc, 16)); mloc = fmaxf(mloc, __shfl_xor(mloc, 32));
                m_new = fmaxf(m_run[gi], mloc); alpha = __builtin_amdgcn_exp2f(m_run[gi] - m_new);
                const float cadd = sel ? (bfar - m_new) : NEG_INF;
#pragma unroll
                for (int nb = 0; nb < 4; ++nb)
#pragma unroll
                    for (int r = 0; r < 4; ++r) sv[nb * 4 + r] = __builtin_amdgcn_exp2f(sacc[gi][nb][r] * SCL2 + cadd);
            } else {
                const int relb = tq - key0 - 4 * g; float bias[16];
#pragma unroll
                for (int nb = 0; nb < 4; ++nb)
#pragma unroll
                    for (int r = 0; r < 4; ++r) { const int rel = relb - 16 * nb - r; int ri = rel < 0 ? 0 : rel; ri = ri > 127 ? 127 : ri; bias[nb * 4 + r] = tab[ri]; }
                PIN16(bias, 0);
                mloc = NEG_INF;
#pragma unroll
                for (int nb = 0; nb < 4; ++nb)
#pragma unroll
                    for (int r = 0; r < 4; ++r) { const int rel = relb - 16 * nb - r;
                        float s = sacc[gi][nb][r] * SCL2 + bias[nb * 4 + r]; s = (!sel || (diag && rel < 0)) ? NEG_INF : s; sv[nb * 4 + r] = s; mloc = fmaxf(mloc, s); }
                mloc = fmaxf(mloc, __shfl_xor(mloc, 16)); mloc = fmaxf(mloc, __shfl_xor(mloc, 32));
                m_new = fmaxf(m_run[gi], mloc); alpha = __builtin_amdgcn_exp2f(m_run[gi] - m_new);
#pragma unroll
                for (int e = 0; e < 16; ++e) sv[e] = __builtin_amdgcn_exp2f(sv[e] - m_new);
            }
            float psum = 0.f;
#pragma unroll
            for (int e = 0; e < 16; ++e) psum += sv[e];
            l_run[gi] = l_run[gi] * alpha + psum; m_run[gi] = m_new;
#pragma unroll
            for (int db = 0; db < 8; ++db) oacc[gi][db] = oacc[gi][db] * alpha;
            pf[gi][0] = pack8(sv); pf[gi][1] = pack8(sv + 8);
        }
        __builtin_amdgcn_sched_barrier(0);
#pragma unroll
        for (int s = 0; s < 2; ++s) { s16x4 vlo[8], vhi[8];
#pragma unroll
            for (int db = 0; db < 8; ++db) { LAS unsigned char* va = Vb + (32 * s + 4 * g + q4) * A_VSTR + (16 * db + 4 * p4) * 2; vlo[db] = TR16(va); vhi[db] = TR16(va + 16 * A_VSTR); }
            __builtin_amdgcn_sched_barrier(0);
#pragma unroll
            for (int db = 0; db < 8; ++db) { const bf16x8 vf = __builtin_shufflevector(vlo[db], vhi[db], 0, 1, 2, 3, 4, 5, 6, 7);
                oacc[0][db] = MFMA16(vf, pf[0][s], oacc[0][db]); oacc[1][db] = MFMA16(vf, pf[1][s], oacc[1][db]); }
            __builtin_amdgcn_sched_barrier(0); }
        }
        if (i + 1 < nT) A_STORE((i + 1) & 1);
        __syncthreads();
    }
    bf16* const MIXp = F.HN(); float* const ssqp = F.ssq();
#pragma unroll
    for (int gi = 0; gi < 2; ++gi) {
        const int tq = tq0 + 16 * gi;
        float l_tot = l_run[gi]; l_tot += __shfl_xor(l_tot, 16); l_tot += __shfl_xor(l_tot, 32);
        const float inv = 1.f / l_tot; float ssq = 0.f;
        bf16* orow = MIXp + (rowbase + tq) * DM + h * 128 + 4 * g;
#pragma unroll
        for (int db = 0; db < 8; ++db) { const f32x4 o = oacc[gi][db] * inv; ssq += (o.x * o.x + o.y * o.y) + (o.z * o.z + o.w * o.w); v2u wv; wv.x = pk2(o.x, o.y); wv.y = pk2(o.z, o.w); *(GAS v2u*)(orow + 16 * db) = wv; }
        ssq += __shfl_xor(ssq, 16); ssq += __shfl_xor(ssq, 32);
        if (g == 0 && doatom) unsafeAtomicAdd(ssqp + (rowbase + tq) * 4 + 1, ssq);
    }
#undef A_KEY0
#undef A_LOAD
#undef A_STORE
}

constexpr int XBC_W = CONV_CH;
__device__ __forceinline__ void conv_phase(Frame& F) {
    const bf16* const PROJ = F.PROJ(); bf16* const XBC = F.XBC(); const float* const cw = F.conv_w(); const float* const cb = F.conv_b();
    const int gt = blockIdx.x * (NWAVES * 64) + fresh_tid(), GT = F.G * NWAVES * 64;
    for (int task = gt; task < (MTOK / 32) * (CONV_CH / 8); task += GT) {
        const int r = task / (CONV_CH / 8), k = task % (CONV_CH / 8), ch = 8 * k, tok0 = 32 * r;
        float wv[4][8], bias[8];
#pragma unroll
        for (int t = 0; t < 4; ++t) { const f32x4 w0 = *(const GAS f32x4*)(cw + t * CONV_CH + ch), w1 = *(const GAS f32x4*)(cw + t * CONV_CH + ch + 4);
            wv[t][0] = w0.x; wv[t][1] = w0.y; wv[t][2] = w0.z; wv[t][3] = w0.w; wv[t][4] = w1.x; wv[t][5] = w1.y; wv[t][6] = w1.z; wv[t][7] = w1.w; }
        { const f32x4 b0 = *(const GAS f32x4*)(cb + ch), b1 = *(const GAS f32x4*)(cb + ch + 4); bias[0] = b0.x; bias[1] = b0.y; bias[2] = b0.z; bias[3] = b0.w; bias[4] = b1.x; bias[5] = b1.y; bias[6] = b1.z; bias[7] = b1.w; }
        const bf16* src = PROJ + (size_t)tok0 * NPROJ + COL_XBC + ch; bf16* dst = XBC + (size_t)tok0 * XBC_W + ch;
        v4u p0 = (v4u){0u, 0u, 0u, 0u}, p1 = p0, p2 = p0;
        if ((tok0 & (SEQ - 1)) != 0) { p0 = *(const GAS v4u*)(src - 3 * (ptrdiff_t)NPROJ); p1 = *(const GAS v4u*)(src - 2 * (ptrdiff_t)NPROJ); p2 = *(const GAS v4u*)(src - (ptrdiff_t)NPROJ); }
#pragma unroll 1
        for (int i0 = 0; i0 < 32; i0 += 8) {
            v4u cur[8];
#pragma unroll
            for (int i = 0; i < 8; ++i) cur[i] = *(const GAS v4u*)(src + (size_t)(i0 + i) * NPROJ);
#pragma unroll
            for (int i = 0; i < 8; ++i) {
                const v4u c = cur[i]; float acc[8];
                const unsigned a0[4] = {p0.x, p0.y, p0.z, p0.w}, a1[4] = {p1.x, p1.y, p1.z, p1.w}, a2[4] = {p2.x, p2.y, p2.z, p2.w}, a3[4] = {c.x, c.y, c.z, c.w};
#pragma unroll
                for (int j = 0; j < 4; ++j) {
                    acc[2 * j] = bias[2 * j] + wv[0][2 * j] * bflo(a0[j]) + wv[1][2 * j] * bflo(a1[j]) + wv[2][2 * j] * bflo(a2[j]) + wv[3][2 * j] * bflo(a3[j]);
                    acc[2 * j + 1] = bias[2 * j + 1] + wv[0][2 * j + 1] * bfhi(a0[j]) + wv[1][2 * j + 1] * bfhi(a1[j]) + wv[2][2 * j + 1] * bfhi(a2[j]) + wv[3][2 * j + 1] * bfhi(a3[j]); }
#pragma unroll
                for (int j = 0; j < 8; ++j) acc[j] = silu_f(acc[j]);
                v4u o; o.x = pk2(acc[0], acc[1]); o.y = pk2(acc[2], acc[3]); o.z = pk2(acc[4], acc[5]); o.w = pk2(acc[6], acc[7]);
                *(GAS v4u*)(dst + (size_t)(i0 + i) * XBC_W) = o;
                p0 = p1; p1 = p2; p2 = c; }
        }
    }
    { const float* const dtraw = F.dtraw(); float* const dt2 = F.DT2(); const float* const dtb = F.dt_bias();
      for (int i = gt; i < MTOK * 16; i += GT) { const float xr = dtraw[i] + dtb[i & 15]; dt2[i] = xr > 20.f ? xr : log1pf(__expf(xr)); } }
}

constexpr int S_BSTR = 272, S_XSTR = 144;
constexpr int S_BM = 0, S_CM = 128 * S_BSTR, S_X = 2 * 128 * S_BSTR, S_XW = S_X + 128 * S_XSTR, S_HB = S_XW + 128 * S_XSTR, S_DT = S_HB + 64 * S_BSTR, S_CS = S_DT + 512, S_DA = S_CS + 512, S_END = S_DA + 512;
static_assert(S_END <= RING_BYTES, "ssd LDS map");
__device__ __forceinline__ void ssd_unit(Frame& F, int b, int h, const bool doatom = true) {
    LAS unsigned char* lds = F.lds + RING_OFF;
    const int tid = fresh_tid(), lane = tid & 63, w = __builtin_amdgcn_readfirstlane(tid >> 6), g = lane >> 4, c16 = lane & 15, q4 = c16 >> 2, p4 = lane & 3;
    const int g8 = h >> 3, pbw = w & 3, nhw = w >> 2;
    const float a_h = -__expf(F.a_log()[h]), dsk = F.d_skip()[h];
    const bf16* const PROJ = F.PROJ(); bf16* const MIX = F.HN(); const float* const dt2 = F.DT2(); const bf16* const XBC = F.XBC(); float* const ssqp = F.ssq();
    LAS float* dtl = (LAS float*)(lds + S_DT); LAS float* csl = (LAS float*)(lds + S_CS); LAS float* dal = (LAS float*)(lds + S_DA);
    for (int i = tid; i < 64 * S_BSTR / 16; i += NWAVES * 64) ((LAS v4u*)(lds + S_HB))[i] = (v4u){0u, 0u, 0u, 0u};
    f32x4 hacc[4];
#pragma unroll
    for (int i = 0; i < 4; ++i) hacc[i] = (f32x4){0.f, 0.f, 0.f, 0.f};
    const int xl = tid >> 3, xc = tid & 7, bl = tid >> 4, bc = tid & 15;
    v4u xr[2], br[4], cr[4]; float dtv = 0.f;
#define S_PREFETCH(cc) do { const size_t t0_ = (size_t)b * SEQ + (size_t)(cc) * SSM_L; \
        _Pragma("unroll") for (int i_ = 0; i_ < 2; ++i_) xr[i_] = *(const GAS v4u*)(XBC + (t0_ + xl + 64 * i_) * XBC_W + h * 64 + 8 * xc); \
        _Pragma("unroll") for (int i_ = 0; i_ < 4; ++i_) { const bf16* p_ = XBC + (t0_ + bl + 32 * i_) * XBC_W + 1024 + g8 * 128 + 8 * bc; br[i_] = *(const GAS v4u*)p_; cr[i_] = *(const GAS v4u*)(p_ + 256); } \
        if (tid < 128) dtv = dt2[(t0_ + tid) * 16 + h]; } while (0)
    S_PREFETCH(0);
    for (int c = 0; c < SSM_NC; ++c) {
        const size_t tok0 = (size_t)b * SEQ + (size_t)c * SSM_L;
        if (tid < 128) { dtl[tid] = dtv; dal[tid] = dtv * a_h; }
        __syncthreads();
        if (w == 0) { const float v0 = dal[2 * lane], v1 = dal[2 * lane + 1]; float s = v0 + v1;
#pragma unroll
            for (int o = 1; o < 64; o <<= 1) { const float t = __shfl_up(s, o); s += (lane >= o) ? t : 0.f; }
            csl[2 * lane] = s - v1; csl[2 * lane + 1] = s; }
        __syncthreads();
        const float cs_last = csl[127];
#pragma unroll
        for (int i = 0; i < 2; ++i) { const int l = xl + 64 * i; const v4u v = xr[i]; *(LAS v4u*)(lds + S_X + l * S_XSTR + xc * 16) = v; const float wl = dtl[l] * __expf(cs_last - csl[l]);
            v4u o2; o2.x = pk2(bflo(v.x) * wl, bfhi(v.x) * wl); o2.y = pk2(bflo(v.y) * wl, bfhi(v.y) * wl); o2.z = pk2(bflo(v.z) * wl, bfhi(v.z) * wl); o2.w = pk2(bflo(v.w) * wl, bfhi(v.w) * wl);
            *(LAS v4u*)(lds + S_XW + l * S_XSTR + xc * 16) = o2; }
#pragma unroll
        for (int i = 0; i < 4; ++i) { const int l = bl + 32 * i; *(LAS v4u*)(lds + S_BM + l * S_BSTR + bc * 16) = br[i]; *(LAS v4u*)(lds + S_CM + l * S_BSTR + bc * 16) = cr[i]; }
        const int lrow = 16 * w + c16;
        v2u zr[4];
#pragma unroll
        for (int pb = 0; pb < 4; ++pb) zr[pb] = *(const GAS v2u*)(PROJ + (tok0 + lrow) * NPROJ + COL_Z + h * 64 + 16 * pb + 4 * g);
        if (c + 1 < SSM_NC) S_PREFETCH(c + 1);
        __syncthreads();
        bf16x8 cf[4];
#pragma unroll
        for (int ks = 0; ks < 4; ++ks) cf[ks] = *(const LAS bf16x8*)(lds + S_CM + lrow * S_BSTR + (32 * ks + 8 * g) * 2);
        f32x4 yacc[4];
        const float cs_l = csl[lrow]; const float el = __expf(cs_l);
#pragma unroll
        for (int pb = 0; pb < 4; ++pb) { yacc[pb] = (f32x4){0.f, 0.f, 0.f, 0.f};
#pragma unroll
            for (int ks = 0; ks < 4; ++ks) { const bf16x8 hf = *(const LAS bf16x8*)(lds + S_HB + (16 * pb + c16) * S_BSTR + (32 * ks + 8 * g) * 2); yacc[pb] = MFMA16(hf, cf[ks], yacc[pb]); }
            yacc[pb] = yacc[pb] * el; }
        for (int s2 = 0; s2 <= (w >> 1); ++s2) {
            const int sb0 = 2 * s2, sb1 = 2 * s2 + 1; const bool has1 = sb1 <= w;
            f32x4 cb0 = (f32x4){0.f, 0.f, 0.f, 0.f}, cb1 = (f32x4){0.f, 0.f, 0.f, 0.f};
#pragma unroll
            for (int ks = 0; ks < 4; ++ks) { const bf16x8 bf0 = *(const LAS bf16x8*)(lds + S_BM + (16 * sb0 + c16) * S_BSTR + (32 * ks + 8 * g) * 2); cb0 = MFMA16(bf0, cf[ks], cb0); }
            if (has1) {
#pragma unroll
                for (int ks = 0; ks < 4; ++ks) { const bf16x8 bf1 = *(const LAS bf16x8*)(lds + S_BM + (16 * sb1 + c16) * S_BSTR + (32 * ks + 8 * g) * 2); cb1 = MFMA16(bf1, cf[ks], cb1); } }
            float mv[8];
#pragma unroll
            for (int r = 0; r < 4; ++r) { const int s = 16 * sb0 + 4 * g + r; const float e = __expf(fminf(cs_l - csl[s], 0.f)) * dtl[s]; mv[r] = (s <= lrow) ? cb0[r] * e : 0.f; }
#pragma unroll
            for (int r = 0; r < 4; ++r) { const int s = 16 * sb1 + 4 * g + r; const int sc_ = s > 127 ? 127 : s; const float e = __expf(fminf(cs_l - csl[sc_], 0.f)) * dtl[sc_]; mv[4 + r] = (has1 && s <= lrow) ? cb1[r] * e : 0.f; }
            const bf16x8 pf = pack8(mv);
#pragma unroll
            for (int pb = 0; pb < 4; ++pb) { LAS unsigned char* xa = lds + S_X + (32 * s2 + 4 * g + q4) * S_XSTR + (16 * pb + 4 * p4) * 2;
                const s16x4 lo = TR16(xa), hi = TR16(xa + 16 * S_XSTR); const bf16x8 xf = __builtin_shufflevector(lo, hi, 0, 1, 2, 3, 4, 5, 6, 7);
                yacc[pb] = MFMA16(xf, pf, yacc[pb]); }
        }
        { const size_t tok = tok0 + lrow; float ssq = 0.f;
#pragma unroll
          for (int pb = 0; pb < 4; ++pb) { const int p0 = 16 * pb + 4 * g;
              const v2u xs_ = *(const LAS v2u*)(lds + S_X + lrow * S_XSTR + p0 * 2);
              const v2u zr_ = zr[pb];
              const float o0 = (yacc[pb].x + bflo(xs_.x) * dsk) * silu_f(bflo(zr_.x)), o1 = (yacc[pb].y + bfhi(xs_.x) * dsk) * silu_f(bfhi(zr_.x));
              const float o2 = (yacc[pb].z + bflo(xs_.y) * dsk) * silu_f(bflo(zr_.y)), o3 = (yacc[pb].w + bfhi(xs_.y) * dsk) * silu_f(bfhi(zr_.y));
              ssq += (o0 * o0 + o1 * o1) + (o2 * o2 + o3 * o3);
              v2u wv; wv.x = pk2(o0, o1); wv.y = pk2(o2, o3); *(GAS v2u*)(MIX + tok * DM + ATT_W + h * 64 + p0) = wv; }
          ssq += __shfl_xor(ssq, 16); ssq += __shfl_xor(ssq, 32);
          if (g == 0 && doatom) unsafeAtomicAdd(ssqp + tok * 4 + 2 + g8, ssq); }
        { const float cdec = __expf(cs_last);
#pragma unroll
          for (int i = 0; i < 4; ++i) hacc[i] = hacc[i] * cdec;
#pragma unroll
          for (int ks = 0; ks < 4; ++ks) {
              LAS unsigned char* xa = lds + S_XW + (32 * ks + 8 * g + q4) * S_XSTR + (16 * pbw + 4 * p4) * 2;
              const s16x4 xlo = TR16(xa), xhi = TR16(xa + 4 * S_XSTR); const bf16x8 xf = __builtin_shufflevector(xlo, xhi, 0, 1, 2, 3, 4, 5, 6, 7);
#pragma unroll
              for (int i = 0; i < 4; ++i) { const int nb = 4 * nhw + i; LAS unsigned char* ba = lds + S_BM + (32 * ks + 8 * g + q4) * S_BSTR + (16 * nb + 4 * p4) * 2;
                  const s16x4 blo = TR16(ba), bhi = TR16(ba + 4 * S_BSTR); const bf16x8 bfr = __builtin_shufflevector(blo, bhi, 0, 1, 2, 3, 4, 5, 6, 7);
                  hacc[i] = MFMA16(bfr, xf, hacc[i]); } } }
        __syncthreads();
#pragma unroll
        for (int i = 0; i < 4; ++i) { const int nb = 4 * nhw + i; v2u o; o.x = pk2(hacc[i].x, hacc[i].y); o.y = pk2(hacc[i].z, hacc[i].w);
            *(LAS v2u*)(lds + S_HB + (16 * pbw + c16) * S_BSTR + (16 * nb + 4 * g) * 2) = o; }
    }
#undef S_PREFETCH
    __syncthreads();
}

__device__ __forceinline__ void mix_normalize(Frame& F) {
    const int tid_ = fresh_tid(), lane = tid_ & 63; const int gw = blockIdx.x * NWAVES + __builtin_amdgcn_readfirstlane(tid_ >> 6), NGW = F.G * NWAVES;
    const float* const ssqp = F.ssq(); bf16* const MIX = F.HN(); const float* const gatt = F.attn_out_norm(); const float* const gssm = F.ssm_out_norm();
    for (int m = gw; m < MTOK; m += NGW) {
        const float* sq = ssqp + (size_t)m * 4;
        const float s1 = __hip_atomic_load(sq + 1, RLX_AGENT), s2 = __hip_atomic_load(sq + 2, RLX_AGENT), s3 = __hip_atomic_load(sq + 3, RLX_AGENT);
        const float ra = 1.f / sqrtf(s1 * (1.f / 1024.f) + EPS), r0 = 1.f / sqrtf(s2 * (1.f / 512.f) + EPS), r1 = 1.f / sqrtf(s3 * (1.f / 512.f) + EPS);
        GAS v4u* row = (GAS v4u*)(MIX + (size_t)m * DM);
#pragma unroll
        for (int j = 0; j < 4; ++j) { const int idx = lane + 64 * j, col = 8 * idx; const float rs = (j < 2) ? ra : ((j == 2) ? r0 : r1);
            const float* gp = (j < 2) ? (gatt + col) : (gssm + (col - ATT_W));
            const f32x4 g0 = *(const GAS f32x4*)gp, g1 = *(const GAS f32x4*)(gp + 4); const v4u v = row[idx]; v4u o;
            o.x = pk2(bflo(v.x) * rs * g0.x, bfhi(v.x) * rs * g0.y); o.y = pk2(bflo(v.y) * rs * g0.z, bfhi(v.y) * rs * g0.w);
            o.z = pk2(bflo(v.z) * rs * g1.x, bfhi(v.z) * rs * g1.y); o.w = pk2(bflo(v.w) * rs * g1.z, bfhi(v.w) * rs * g1.w); row[idx] = o; }
    }
}

constexpr int P_EIDX = 0, P_GATE = 16384, P_LST = 32768, P_HN = 65536, P_ACT = 98304, P_END = 102400;
static_assert(P_END <= RING_BYTES, "peer LDS map");
__constant__ unsigned char PEER_CAND[52] = {0, 1, 2, 3, 4, 5, 6, 7, 8, 9, 10, 11, 12, 13, 14, 15, 16, 17, 18, 19, 20, 21, 22, 23, 32, 33, 34, 35, 36, 48, 49, 50, 51, 64, 65, 66, 80, 81, 96, 97, 112, 113, 128, 144, 160, 176, 192, 208, 224, 240, 255, 255};
__device__ __forceinline__ unsigned f2ord(float f) { const unsigned u = __builtin_bit_cast(unsigned, f); return u ^ ((u >> 31) ? 0xFFFFFFFFu : 0x80000000u); }
__device__ __forceinline__ float ord2f(unsigned u) { return __builtin_bit_cast(float, u ^ ((u >> 31) ? 0x80000000u : 0xFFFFFFFFu)); }
#define CSWAPD(a, b) do { const unsigned hi_ = (a) > (b) ? (a) : (b), lo_ = (a) > (b) ? (b) : (a); (a) = hi_; (b) = lo_; } while (0)
template <int N> __device__ __forceinline__ void bitonic_sort_desc(unsigned (&v)[N]) {
#pragma unroll
    for (int k = 2; k <= N; k <<= 1)
#pragma unroll
        for (int j = k >> 1; j > 0; j >>= 1)
#pragma unroll
            for (int i = 0; i < N; ++i) { const int l = i ^ j; if (l > i) { if ((i & k) == 0) CSWAPD(v[i], v[l]); else CSWAPD(v[l], v[i]); } }
}
__device__ __forceinline__ void merge16_xor(unsigned (&v)[16], int dist) {
    unsigned o[16];
#pragma unroll
    for (int i = 0; i < 16; ++i) o[i] = (unsigned)__shfl_xor((int)v[i], dist);
#pragma unroll
    for (int i = 0; i < 16; ++i) v[i] = v[i] > o[15 - i] ? v[i] : o[15 - i];
#pragma unroll
    for (int j = 8; j > 0; j >>= 1)
#pragma unroll
        for (int i = 0; i < 16; ++i) { const int l = i ^ j; if (l > i) CSWAPD(v[i], v[l]); }
}
__device__ __forceinline__ float gelu_erf(float x) { return 0.5f * x * (1.f + erff(x * 0.70710678118654752f)); }
__device__ __forceinline__ float fp4_dec1(unsigned n) { const unsigned m = n & 7u; unsigned bits = (m >= 2u) ? (((126u + (m >> 1)) << 23) | ((m & 1u) << 22)) : (m ? 0x3F000000u : 0u); bits |= (n & 8u) << 28; return __builtin_bit_cast(float, bits); }
__device__ __forceinline__ f32x2 fp4_dec2(unsigned x) { f32x2 r; r.x = fp4_dec1(x & 15u); r.y = fp4_dec1((x >> 4) & 15u); return r; }
typedef long i64;
typedef int v8i __attribute__((ext_vector_type(8)));
__device__ __forceinline__ void peer_unit(Frame& F, int u, const bool dry = false) {
    LAS unsigned char* lds = F.lds + RING_OFF;
    const int tid_ = fresh_tid(), lane = tid_ & 63, w = __builtin_amdgcn_readfirstlane(tid_ >> 6), g = lane >> 4, c16 = lane & 15;
    const int T0 = 32 * u;
    LAS int* eidx = (LAS int*)(lds + P_EIDX); LAS float* gate = (LAS float*)(lds + P_GATE);
    LAS unsigned* lst = (LAS unsigned*)(lds + P_LST) + w * 1024;
    const bf16* const QP = F.QP(); const bf16* const SK = F.SK(); float* const outp = F.out(); const bf16* const X1B = F.X1B(); const float* const fgain = F.ffn_norm(); const float* const fing = F.final_norm(); const unsigned char* const U8 = F.U8(); const unsigned char* const V8 = F.V8();
#ifndef NO_ROUTE
    for (int tb = 0; tb < 2; ++tb) {
        for (int c = 0; c < 2; ++c) {
            const int p = 2 * w + c;
            bf16x8 qf[4];
            { const unsigned qo = ((unsigned)(T0 + 16 * tb + c16) * (unsigned)DM + (unsigned)(p * 128 + 8 * g)) * 2u;
#pragma unroll
              for (int ks = 0; ks < 4; ++ks) qf[ks] = __builtin_nontemporal_load((const GAS bf16x8*)((const unsigned char*)QP + (qo + 64u * ks))); }
            unsigned key[32];
#pragma unroll
            for (int kb = 0; kb < 8; ++kb) { f32x4 acc = (f32x4){0.f, 0.f, 0.f, 0.f};
                const unsigned so = ((unsigned)(p * 128 + 16 * kb + c16) * 128u + 8u * (unsigned)g) * 2u;
#pragma unroll
                for (int ks = 0; ks < 4; ++ks) { const bf16x8 sf = *(const GAS bf16x8*)((const unsigned char*)SK + (so + 64u * ks)); acc = MFMA16(sf, qf[ks], acc); }
#pragma unroll
                for (int r = 0; r < 4; ++r) key[kb * 4 + r] = (f2ord(acc[r]) & ~0x7Fu) | (unsigned)(16 * kb + 4 * g + r);
                __builtin_amdgcn_sched_barrier(0); }
            bitonic_sort_desc<32>(key);
            unsigned top[16];
#pragma unroll
            for (int i = 0; i < 16; ++i) top[i] = key[i];
            merge16_xor(top, 16); merge16_xor(top, 32);
            if (g == 0) { LAS v4u* d = (LAS v4u*)(lst + (c * 32 + 16 * tb + c16) * 16);
                d[0] = (v4u){top[0], top[1], top[2], top[3]}; d[1] = (v4u){top[4], top[5], top[6], top[7]}; d[2] = (v4u){top[8], top[9], top[10], top[11]}; d[3] = (v4u){top[12], top[13], top[14], top[15]}; }
        }
        LDS_WAIT();
        const LAS unsigned* l1 = lst + (16 * tb + c16) * 16; const LAS unsigned* l2 = lst + (32 + 16 * tb + c16) * 16;
        unsigned ck[16];
#pragma unroll
        for (int k = 0; k < 13; ++k) { const unsigned ab = PEER_CAND[4 * k + g]; const unsigned a = ab >> 4, bq = ab & 15u;
            const float s = ord2f(l1[a] & ~0x7Fu) + ord2f(l2[bq] & ~0x7Fu); ck[k] = (ab == 255u) ? 0u : ((f2ord(s) & ~0xFFu) | ab); }
        ck[13] = 0u; ck[14] = 0u; ck[15] = 0u;
        bitonic_sort_desc<16>(ck);
        merge16_xor(ck, 16); merge16_xor(ck, 32);
        if (g == 0) { const int tl = 16 * tb + c16; const float m = ord2f(ck[0] & ~0xFFu); float e[16]; float sum = 0.f;
#pragma unroll
            for (int k = 0; k < 16; ++k) { e[k] = __expf(ord2f(ck[k] & ~0xFFu) - m); sum += e[k]; }
            const float inv = 1.f / sum;
#pragma unroll
            for (int k = 0; k < 16; ++k) { const unsigned a = (ck[k] >> 4) & 15u, bq = ck[k] & 15u; const int ex = (int)((l1[a] & 0x7Fu) * 128u + (l2[bq] & 0x7Fu));
                eidx[tl * 128 + w * 16 + k] = ex; gate[tl * 128 + w * 16 + k] = e[k] * inv; } }
    }
#endif
    __syncthreads();
    LAS unsigned char* hnb = lds + P_HN + w * 4096; LAS float* actl = (LAS float*)(lds + P_ACT) + w * 128;
    const LAS unsigned char* hb = hnb + 16 * g + ((c16 == 1) ? 1024 : 0);
    v4u bA[8], bB[8];
#define U_ISSUE(buf, e_, jb) do { const unsigned uo_ = (unsigned)(e_) * (unsigned)ROWB + 16u * (unsigned)g + 512u * (unsigned)(jb); \
        _Pragma("unroll") for (int jj = 0; jj < 8; ++jj) buf[jj] = *(const GAS v4u*)(U8 + (uo_ + 64u * jj)); __builtin_amdgcn_sched_barrier(0); } while (0)
#define U_CONSUME(buf, jb) do { v4u bq_[8]; _Pragma("unroll") for (int jj = 0; jj < 8; ++jj) bq_[jj] = *(const LAS v4u*)(hb + 64 * (8 * (jb) + jj)); \
        __builtin_amdgcn_sched_barrier(0); \
        _Pragma("unroll") for (int jj = 0; jj < 8; ++jj) { const v4u a_ = buf[jj]; \
            const v8i av_ = {(int)a_.x, (int)a_.y, (int)a_.z, (int)a_.w, 0, 0, 0, 0}; const v8i bv_ = {(int)bq_[jj].x, (int)bq_[jj].y, (int)bq_[jj].z, (int)bq_[jj].w, 0, 0, 0, 0}; \
            acc = __builtin_amdgcn_mfma_scale_f32_16x16x128_f8f6f4(av_, bv_, acc, 4, 4, 0, 0x7f7f7f7f, 0, 0x7f7f7f7f); } __builtin_amdgcn_sched_barrier(0); } while (0)
#define U_ACT(grp_) do { const float l0_ = __shfl_down(acc.x, 1), l1_ = __shfl_down(acc.y, 1), l2_ = __shfl_down(acc.z, 1), l3_ = __shfl_down(acc.w, 1); \
        if (c16 == 0) { const int k0 = 16 * (grp_) + 4 * g; constexpr float isc = 1.f / (SU * SH4), ilo = 1.f / SLO4; const f32x4 gt = *(const LAS f32x4*)(gate + tl * 128 + k0); \
        f32x4 a4; a4.x = gelu_erf((acc.x + l0_ * ilo) * isc) * gt.x; a4.y = gelu_erf((acc.y + l1_ * ilo) * isc) * gt.y; a4.z = gelu_erf((acc.z + l2_ * ilo) * isc) * gt.z; a4.w = gelu_erf((acc.w + l3_ * ilo) * isc) * gt.w; *(LAS f32x4*)(actl + k0) = a4; } } while (0)
#define V_ISSUE(buf, kb_) do { _Pragma("unroll") for (int kk = 0; kk < 8; ++kk) { const int e_ = eidx[tl * 128 + 8 * (kb_) + kk]; const unsigned vo_ = (unsigned)e_ * (unsigned)ROWB + 16u * (unsigned)lane; \
        buf[kk] = *(const GAS v4u*)(V8 + vo_); } __builtin_amdgcn_sched_barrier(0); } while (0)
#ifdef FP4_SOFT_DEC
#define FP4_DEC(x) fp4_dec2(x)
#else
#define FP4_DEC(x) __builtin_amdgcn_cvt_scalef32_pk_f32_fp4((x), 1.0f, 0)
#endif
#ifdef FP4_SWAP_DEC
#define FP4_ACC(oa, ob, d) do { oa += a_ * d.y; ob += a_ * d.x; } while (0)
#else
#define FP4_ACC(oa, ob, d) do { oa += a_ * d.x; ob += a_ * d.y; } while (0)
#endif
#define PIN8x2(a, i) asm volatile("" : "+v"(a[i]), "+v"(a[i + 1]), "+v"(a[i + 2]), "+v"(a[i + 3]), "+v"(a[i + 4]), "+v"(a[i + 5]), "+v"(a[i + 6]), "+v"(a[i + 7]))
#define V_CONSUME(buf, kb_) do { _Pragma("unroll") for (int kk = 0; kk < 8; ++kk) { const float as_ = actl[8 * (kb_) + kk]; const f32x2 a2_ = {as_, as_}; \
        const unsigned vw[4] = {buf[kk].x, buf[kk].y, buf[kk].z, buf[kk].w}; \
        _Pragma("unroll") for (int q = 0; q < 4; ++q) { \
            o2[4 * q]     = __builtin_elementwise_fma(__builtin_amdgcn_cvt_scalef32_pk_f32_fp4(vw[q], 1.0f, 0), a2_, o2[4 * q]); \
            o2[4 * q + 1] = __builtin_elementwise_fma(__builtin_amdgcn_cvt_scalef32_pk_f32_fp4(vw[q], 1.0f, 1), a2_, o2[4 * q + 1]); \
            o2[4 * q + 2] = __builtin_elementwise_fma(__builtin_amdgcn_cvt_scalef32_pk_f32_fp4(vw[q], 1.0f, 2), a2_, o2[4 * q + 2]); \
            o2[4 * q + 3] = __builtin_elementwise_fma(__builtin_amdgcn_cvt_scalef32_pk_f32_fp4(vw[q], 1.0f, 3), a2_, o2[4 * q + 3]); } \
        PIN8x2(o2, 0); PIN8x2(o2, 8); } } while (0)
#ifndef NO_GATHER
    int e_cur = eidx[w * 128 + c16];
    v2u xn[8];
#define X_ISSUE(tok_) do { const unsigned xb_ = (unsigned)(tok_) * (unsigned)(DM * 2) + 8u * (unsigned)lane; _Pragma("unroll") for (int j = 0; j < 8; ++j) xn[j] = __builtin_nontemporal_load((const GAS v2u*)((const unsigned char*)X1B + (xb_ + 512u * j))); } while (0)
    X_ISSUE(T0 + w);
    U_ISSUE(bA, e_cur, 0);
    for (int ti = 0; ti < 4; ++ti) {
        const int tl = w + 8 * ti; const size_t token = (size_t)T0 + tl;
        f32x4 xr[8]; float ss = 0.f;
        const unsigned xo = (unsigned)token * (unsigned)(DM * 4) + 16u * (unsigned)lane;
        {
#pragma unroll
          for (int j = 0; j < 8; ++j) { const v2u r = xn[j]; xr[j] = (f32x4){bflo(r.x), bfhi(r.x), bflo(r.y), bfhi(r.y)}; }
#pragma unroll
          for (int j = 0; j < 8; ++j) ss += (xr[j].x * xr[j].x + xr[j].y * xr[j].y) + (xr[j].z * xr[j].z + xr[j].w * xr[j].w); }
        const float rs2 = __builtin_amdgcn_rsqf(wave_sum(ss) * (1.f / DM) + EPS);
        {
          const float* fg_ = fgain; asm volatile("" : "+s"(fg_));
          const unsigned char* gp = (const unsigned char*)fg_; const unsigned go = 16u * (unsigned)lane;
          unsigned hw[4], lw[4];
#pragma unroll
          for (int q = 0; q < 4; ++q) { unsigned wh = 0u, wl = 0u;
#pragma unroll
              for (int t = 0; t < 2; ++t) { const int j = 2 * q + t; const f32x4 gg = *(const GAS f32x4*)(gp + (go + 1024u * j)); const f32x4 hv = xr[j] * gg * (rs2 * SH4);
                  const float h0 = clampf(hv.x, 6.f), h1 = clampf(hv.y, 6.f), h2 = clampf(hv.z, 6.f), h3 = clampf(hv.w, 6.f);
                  const unsigned p0 = __builtin_amdgcn_cvt_scalef32_pk_fp4_f32(0u, h0, h1, 1.0f, 0), p1 = __builtin_amdgcn_cvt_scalef32_pk_fp4_f32(0u, h2, h3, 1.0f, 0);
                  const f32x2 d0 = __builtin_amdgcn_cvt_scalef32_pk_f32_fp4(p0, 1.0f, 0), d1 = __builtin_amdgcn_cvt_scalef32_pk_f32_fp4(p1, 1.0f, 0);
                  const unsigned r0 = __builtin_amdgcn_cvt_scalef32_pk_fp4_f32(0u, clampf((h0 - d0.x) * SLO4, 6.f), clampf((h1 - d0.y) * SLO4, 6.f), 1.0f, 0), r1 = __builtin_amdgcn_cvt_scalef32_pk_fp4_f32(0u, clampf((h2 - d1.x) * SLO4, 6.f), clampf((h3 - d1.y) * SLO4, 6.f), 1.0f, 0);
                  wh |= ((p0 & 0xFFu) | ((p1 & 0xFFu) << 8)) << (16 * t); wl |= ((r0 & 0xFFu) | ((r1 & 0xFFu) << 8)) << (16 * t); }
              hw[q] = wh; lw[q] = wl; }
          *(LAS v4u*)(hnb + 16 * lane) = (v4u){hw[0], hw[1], hw[2], hw[3]}; *(LAS v4u*)(hnb + 1024 + 16 * lane) = (v4u){lw[0], lw[1], lw[2], lw[3]}; }
        LDS_WAIT();
#pragma unroll 1
        for (int grp = 0; grp < 8; ++grp) {
            const int gn = grp < 7 ? grp + 1 : 7;
            const int e_nxt = eidx[tl * 128 + 16 * gn + c16];
            f32x4 acc = (f32x4){0.f, 0.f, 0.f, 0.f};
            U_ISSUE(bB, e_cur, 1); U_CONSUME(bA, 0);
            if (grp < 7) U_ISSUE(bA, e_nxt, 0); else V_ISSUE(bA, 0);
            U_CONSUME(bB, 1);
            U_ACT(grp);
            e_cur = e_nxt;
        }
        LDS_WAIT();
        f32x2 o2[16];
#pragma unroll
        for (int i = 0; i < 16; ++i) o2[i] = (f32x2){0.f, 0.f};
#pragma unroll 1
        for (int kb = 0; kb < 16; kb += 2) {
            V_ISSUE(bB, kb + 1); V_CONSUME(bA, kb);
            if (kb + 2 < 16) V_ISSUE(bA, kb + 2);
            else if (ti < 3) { e_cur = eidx[(tl + 8) * 128 + c16]; X_ISSUE(token + 8); U_ISSUE(bA, e_cur, 0); }
            V_CONSUME(bB, kb + 1);
        }
        { constexpr float isv = 1.f / SV; float s2 = 0.f;
#pragma unroll
          for (int j = 0; j < 8; ++j) { xr[j] = xr[j] + (f32x4){o2[2 * j].x, o2[2 * j].y, o2[2 * j + 1].x, o2[2 * j + 1].y} * isv;
              s2 += (xr[j].x * xr[j].x + xr[j].y * xr[j].y) + (xr[j].z * xr[j].z + xr[j].w * xr[j].w); }
          const float rf = __builtin_amdgcn_rsqf(wave_sum(s2) * (1.f / DM) + EPS);
          const float* fi_ = fing; asm volatile("" : "+s"(fi_));
          const unsigned char* fp = (const unsigned char*)fi_; unsigned char* op = (unsigned char*)outp; const unsigned fo = 16u * (unsigned)lane;
          if (!dry || rf == 1.2345e30f)
#pragma unroll
          for (int j = 0; j < 8; ++j) __builtin_nontemporal_store(xr[j] * rf * *(const GAS f32x4*)(fp + (fo + 1024u * j)), (GAS f32x4*)(op + (xo + 1024u * j))); }
    }
#endif
#undef U_ISSUE
#undef X_ISSUE
#undef U_ACT
#undef U_CONSUME
#undef V_ISSUE
#undef V_CONSUME
    __syncthreads();
}

__global__ void __launch_bounds__(NWAVES * 64, 2) hybrid_fwd(Args args) {
    extern __shared__ __attribute__((aligned(16))) unsigned char lds[];
    Frame F;
    F.lds = (LAS unsigned char*)lds;
    F.MISC = (volatile LAS unsigned*)(F.lds + MISC_OFF);
    F.tid = threadIdx.x; F.lane = F.tid & 63; F.wave = __builtin_amdgcn_readfirstlane(F.tid >> 6); F.G = gridDim.x;
    for (int u = F.tid; u < (LDS_BYTES - LDSCTL_OFF) / 4; u += NWAVES * 64) ((LAS unsigned*)(F.lds + LDSCTL_OFF))[u] = 0u;
    __syncthreads();
    (void)args;
    XcdBarrier bar = xcd_barrier_post(F.ctl() + CW_BAR, F.MISC + 8);

#ifndef NO_P0
#ifdef PROBE_P0X2
    { int reps = 2; asm volatile("" : "+s"(reps)); for (int rep = 0; rep < reps; ++rep) p0_prologue(F); }
#else
    p0_prologue(F);
#endif
#endif
    xcd_barrier(bar);
#ifndef NO_P1
#ifdef PROBE_GX2
    { int reps = 2; asm volatile("" : "+s"(reps)); for (int rep = 0; rep < reps; ++rep) {
#else
    { { const int rep = 0, reps = 1;
#endif
      pg8::Gemm gm{F.HN(), F.WinT(), MTOK, NPAD, DM}; pg8::StaticOrder S; S.init(MTOK, NPAD, F.G, (int)blockIdx.x);
      EpiProj E{F.PROJ(), F.dtraw(), (rep + 1 < reps) ? nullptr : F.kmean()};
      pg8::gemm_phase<EpiProj, pg8::StaticOrder, PG8_ALIGN, PG8_SP2>(F.lds + RING_OFF, gm, S, E); } }
    { const int nun = (MTOK / 256) * (NPAD / 256), rem = nun % F.G;
      if (rem && (int)blockIdx.x >= rem) tables_convert(F, tab_split(F.G), TAB_ITEMS, (size_t)((int)blockIdx.x - rem) * (NWAVES * 64) + fresh_tid(), (size_t)(F.G - rem) * (NWAVES * 64)); }
#endif
    xcd_barrier(bar);
#ifdef PROBE_P15X2
    conv_phase(F);
#endif
    conv_phase(F);
    xcd_barrier(bar);
#ifdef PROBE_P2X2
    { int reps = 2; asm volatile("" : "+s"(reps)); for (int rep = 0; rep < reps; ++rep) {
#else
    { { const int rep = 0, reps = 1;
#endif
    const bool doatom = rep + 1 == reps;
    for (;;) {
        if (F.tid == 0) F.MISC[0] = xb_add(F.ctl() + CW_Q2 + 64 * rep, 1u);
        __syncthreads();
        const int ui = (int)F.MISC[0];
        __syncthreads();
        if (ui >= 128 + 512) break;
#ifdef PROBE_P2_SSD
        if (ui < 128 || doatom)
#endif
#ifdef PROBE_P2_ATT
        if (ui >= 128 || doatom)
#endif
        {
        if (ui < 128) ssd_unit(F, ui >> 4, ui & 15, doatom);
        else { const int a = ui - 128; attn_unit(F, (a & 63) >> 3, a & 7, 7 - (a >> 6), doatom); }
        }
    } } }
    xcd_barrier(bar);
#ifndef NO_P3
#ifdef PROBE_GX2
    { int reps = 2; asm volatile("" : "+s"(reps)); for (int rep = 0; rep < reps; ++rep) {
#else
    { { const int rep = 0, reps = 1;
#endif
      pg8::Gemm gm{F.HN(), F.WoutT(), MTOK, DM, DM}; pg8::StaticOrder S; S.init(MTOK, DM, F.G, (int)blockIdx.x);
      {
        const int t_ = fresh_tid(); const float* const sq = F.ssq();
#pragma unroll 1
        for (int ii = t_ >> 8; ii < 3; ii += 2) { pg8::Unit uu;
          if (S.next(ii, uu)) { const int row = uu.pm * 256 + (t_ & 255);
            const float q1 = __hip_atomic_load(sq + (size_t)row * 4 + 1, RLX_AGENT), q2 = __hip_atomic_load(sq + (size_t)row * 4 + 2, RLX_AGENT), q3 = __hip_atomic_load(sq + (size_t)row * 4 + 3, RLX_AGENT);
            const float sa = __builtin_amdgcn_rsqf(q1 * (1.f / 1024.f) + EPS), s0 = __builtin_amdgcn_rsqf(q2 * (1.f / 512.f) + EPS), s1 = __builtin_amdgcn_rsqf(q3 * (1.f / 512.f) + EPS);
            *(LAS f32x4*)(F.lds + SEGTAB_OFF + (ii * 256 + (t_ & 255)) * 16) = (f32x4){sa / s0, s0 / s1, s1, 0.f}; } }
        __syncthreads(); }
      EpiOut E{F.x(), F.X1B(), F.ssq(), rep + 1 == reps, (const LAS f32x4*)(F.lds + SEGTAB_OFF)};
      pg8::gemm_phase<EpiOut, pg8::StaticOrder, PG8_ALIGN, PG8_SP2>(F.lds + RING_OFF, gm, S, E); } }
#endif
    xcd_barrier(bar);
#ifndef NO_P4
#ifdef PROBE_GX2
    { int reps = 2; asm volatile("" : "+s"(reps)); for (int rep = 0; rep < reps; ++rep) {
#else
    { { const int rep = 0, reps = 1; (void)rep; (void)reps;
#endif
      pg8::Gemm gm{F.X1B(), F.WqT(), MTOK, DM, DM}; pg8::StaticOrder S; S.init(MTOK, DM, F.G, (int)blockIdx.x);
      EpiQ E{F.QP(), F.ssq()};
      pg8::gemm_phase<EpiQ, pg8::StaticOrder, PG8_ALIGN, PG8_SP2>(F.lds + RING_OFF, gm, S, E); } }
#endif
    xcd_barrier(bar);
#ifndef NO_P5
#ifdef PROBE_P5X2
    { int reps = 2; asm volatile("" : "+s"(reps));
      for (int rep = 0; rep < reps; ++rep) for (int u = blockIdx.x; u < MTOK / 32; u += F.G) peer_unit(F, u, rep + 1 < reps); }
#else
    for (int u = blockIdx.x; u < MTOK / 32; u += F.G) peer_unit(F, u);
#endif
#endif
}

extern "C" void kernel_launch(void* const* d_in, const int* in_sizes, int n_in, void* d_out, int out_size, void* d_ws, size_t ws_size, hipStream_t stream) {
    static int grid = 0;
    if (grid == 0) {
        if (n_in != 18 || out_size != MTOK * DM || ws_size < WS_END) { fprintf(stderr, "kernel_launch: unexpected shapes (n_in %d, out %d, ws %zu)\n", n_in, out_size, ws_size); grid = -1; return; }
        int dev = 0, cus = 0, per_cu = 0;
        if (hipGetDevice(&dev) != hipSuccess || hipDeviceGetAttribute(&cus, hipDeviceAttributeMultiprocessorCount, dev) != hipSuccess) { grid = -1; return; }
        if (hipFuncSetAttribute((const void*)hybrid_fwd, hipFuncAttributeMaxDynamicSharedMemorySize, LDS_BYTES) != hipSuccess) { fprintf(stderr, "kernel_launch: hipFuncSetAttribute failed\n"); grid = -1; return; }
        if (hipOccupancyMaxActiveBlocksPerMultiprocessor(&per_cu, (const void*)hybrid_fwd, NWAVES * 64, LDS_BYTES) != hipSuccess || per_cu < 1)
            fprintf(stderr, "kernel_launch: note: occupancy query reports %d workgroups per CU\n", per_cu);
        (void)hipGetLastError();
        grid = cus;
    }
    if (grid < 0) return;
    if (hipMemsetAsync((char*)d_ws + WS_CTL, 0, CTL_ZERO_BYTES, stream) != hipSuccess) return;
    Args a{};
    for (int i = 0; i < 18; ++i) a.in[i] = (const float*)d_in[i];
    a.out = (float*)d_out; a.ws = (unsigned char*)d_ws;
    hipLaunchKernelGGL(hybrid_fwd, dim3(grid), dim3(NWAVES * 64), LDS_BYTES, stream, a);
}
```

```cpp
#include <hip/hip_runtime.h>
#include <cstdio>
#include <cstdint>
namespace pg8 {
#define PG8_LAS __attribute__((address_space(3)))
typedef unsigned short bf16_t;
typedef short bf16x8 __attribute__((ext_vector_type(8)));
typedef float f32x4 __attribute__((ext_vector_type(4)));
typedef unsigned u32x4 __attribute__((ext_vector_type(4)));
constexpr int BM = 256, BK = 64, HALF = 128, HTB = HALF * BK * 2  , STAGE_BYTES = 8 * HTB, NXCD = 8, WGM = 8;

__host__ __device__ __forceinline__ int lds_byte(int r, int c) { const int st = (r >> 4) * 2 + (c >> 5), rr = r & 15, cc = c & 31, ob = rr * 64 + cc * 2; return st * 1024 + (ob ^ (((ob >> 9) & 1) << 5)); }
__host__ __device__ __forceinline__ void stage_rc(int b, int& R, int& C) { const int st = b / 1024, sb = b % 1024, swz = sb ^ (((sb >> 9) & 1) << 5); R = (st >> 1) * 16 + swz / 64; C = (st & 1) * 32 + (swz % 64) / 2; }
__host__ __device__ __forceinline__ int perm32(int rho) { const int n = rho >> 4, i = rho & 15; return 8 * (i >> 2) + 4 * n + (i & 3); }

struct Unit { int pm, pn; };
struct Gemm { const bf16_t* A; const bf16_t* Bt; int M, N, K; };

struct StaticOrder {
    int nM, nN, nwg, G, c;
    __host__ __device__ void init(int M, int N, int G_, int c_) { nM = M / BM; nN = N / BM; nwg = nM * nN; G = G_; c = c_; }
    __host__ __device__ bool next(int i, Unit& u) const {
        const long L = (long)i * G + c; if (L >= nwg) return false;
        int wgid = (int)L; { const int q = nwg / NXCD, r = nwg % NXCD, xcd = wgid % NXCD, off = wgid / NXCD; wgid = (xcd < r ? xcd * (q + 1) : r * (q + 1) + (xcd - r) * q) + off; }
        const int nig = WGM * nN, gid = wgid / nig, fm = gid * WGM, gsz = (nM - fm) < WGM ? (nM - fm) : WGM;
        u.pm = fm + ((wgid % nig) % gsz); u.pn = (wgid % nig) / gsz; return true;
    }
    __device__ __forceinline__ void a_ready(const Unit&) const {}
    __device__ __forceinline__ void done(const Unit&) const {}
};

__device__ __forceinline__ unsigned cvt_pk_bf16(float lo, float hi) { unsigned r; asm volatile("v_cvt_pk_bf16_f32 %0, %1, %2" : "=v"(r) : "v"(lo), "v"(hi)); return r; }
typedef float f32x2 __attribute__((ext_vector_type(2)));
__device__ __forceinline__ f32x2 gelu_pk(f32x2 v) {
    const f32x2 av = __builtin_elementwise_abs(v), d = av * 0.2316418882f + 1.0f;
    f32x2 t; t.x = __builtin_amdgcn_rcpf(d.x); t.y = __builtin_amdgcn_rcpf(d.y);
    f32x2 q = t * 0.5307027145f + (-0.7265760135f); q = q * t + 0.7107068705f; q = q * t + (-0.142248368f); q = q * t + 0.127414796f; q = q * t;
    const f32x2 s = (v * v) * (-0.72134752044f);
    f32x2 e; e.x = __builtin_amdgcn_exp2f(s.x); e.y = __builtin_amdgcn_exp2f(s.y);
    const f32x2 m = v * (q * e), r = v - m;
    f32x2 o; o.x = v.x < 0.f ? m.x : r.x; o.y = v.y < 0.f ? m.y : r.y; return o;
}

template <int ACT  > struct EpiBf16 {
    static constexpr bool PERM = true, AFTER_DRAIN = false, SEG = false; static_assert(ACT == 0 || ACT == 1, "EpiBf16: ACT is 0 (none) or 1 (gelu_pk)");
    bf16_t* O; int ldc; const float* bias; int split_cols; size_t split_stride; float scale0;
    __device__ __forceinline__ void operator()(const f32x4 (&acc)[2][2][4][2], const Unit& u, int wr, int wc, int fr, int fq) const {
        const int row0 = u.pm * BM + wr * 64 + fr; int colt = u.pn * BM; bf16_t* base = O;
        float sc = 1.f; if (split_cols) { const int t = colt / split_cols; base += (size_t)t * split_stride; colt -= t * split_cols; if (t == 0) sc = scale0; }
        const int col0 = colt + wc * 32 + 8 * fq, bcol0 = u.pn * BM + wc * 32 + 8 * fq;
        f32x4 bv[2][2];
#pragma unroll
        for (int bj = 0; bj < 2; ++bj)
#pragma unroll
            for (int n = 0; n < 2; ++n) bv[bj][n] = bias ? *(const f32x4*)(bias + bcol0 + bj * HALF + 4 * n) : (f32x4){0.f, 0.f, 0.f, 0.f};
#pragma unroll
        for (int ai = 0; ai < 2; ++ai)
#pragma unroll
            for (int m = 0; m < 4; ++m) { bf16_t* rowp = base + (size_t)(row0 + ai * HALF + m * 16) * ldc + col0;
#pragma unroll
                for (int bj = 0; bj < 2; ++bj) { f32x4 v0 = acc[ai][bj][m][0] + bv[bj][0], v1 = acc[ai][bj][m][1] + bv[bj][1];
                    if (ACT == 1) { f32x2 a = gelu_pk((f32x2){v0[0], v0[1]}), b = gelu_pk((f32x2){v0[2], v0[3]}), c = gelu_pk((f32x2){v1[0], v1[1]}), d = gelu_pk((f32x2){v1[2], v1[3]});
                        v0 = (f32x4){a.x, a.y, b.x, b.y}; v1 = (f32x4){c.x, c.y, d.x, d.y}; }
                    v0 = v0 * sc; v1 = v1 * sc; u32x4 w; w.x = cvt_pk_bf16(v0[0], v0[1]); w.y = cvt_pk_bf16(v0[2], v0[3]); w.z = cvt_pk_bf16(v1[0], v1[1]); w.w = cvt_pk_bf16(v1[2], v1[3]);
                    *(u32x4*)(rowp + bj * HALF) = w; } }
    }
};
template <class Epi, class Sched, bool ALIGN_EPI = false, bool SP2 = false, bool F8 = false>
__device__ __forceinline__ void gemm_phase(PG8_LAS unsigned char* lds, const Gemm g, const Sched& S, const Epi& E) {
    int tid_ = threadIdx.x; asm volatile("" : "+v"(tid_));
    const int tid = tid_, wid = __builtin_amdgcn_readfirstlane(tid >> 6), lane = tid & 63, wr = wid >> 2, wc = wid & 3, fr = lane & 15, fq = lane >> 4;
    const int K = g.K, nt = K / BK;
    unsigned voffA[2], voffB[2];
#pragma unroll
    for (int i = 0; i < 2; ++i) { int R, C; stage_rc(tid * 16 + i * 8192, R, C); const int Rb = Epi::PERM ? ((R & ~31) + perm32(R & 31)) : R;
        voffA[i] = (unsigned)(R * K + C) * 2u; voffB[i] = (unsigned)(Rb * K + C) * 2u; }
    const size_t kstep = (size_t)(BK * 2);
    const size_t hstep = (size_t)HALF * K * 2;
    const size_t tstep = 2 * hstep;
    const unsigned ldsw = (unsigned)wid * 1024u;
    const int aoff = lds_byte(wr * 64 + fr, fq * 8), boff = lds_byte(wc * 32 + fr, fq * 8);
#define PG8_SA(b, h) (((b) * 2 + (h)) * HTB)
#define PG8_SB(b, h) ((4 + (b) * 2 + (h)) * HTB)
#define PG8_STAGE(bufoff, gbase, voff) do { _Pragma("unroll") for (int _i = 0; _i < 2; ++_i) \
        __builtin_amdgcn_global_load_lds((const unsigned*)((const char*)(gbase) + (voff)[_i]), (PG8_LAS unsigned*)(lds + (bufoff) + ldsw + _i * 8192), 16, 0, 0); } while (0)
#define PG8_LDA(dst, b, h) do { _Pragma("unroll") for (int m = 0; m < 4; ++m) _Pragma("unroll") for (int k = 0; k < 2; ++k) dst[m][k] = *(const PG8_LAS bf16x8*)(lds + PG8_SA(b, h) + aoff + m * 2048 + k * 1024); } while (0)
#define PG8_LDB(dst, b, h) do { _Pragma("unroll") for (int n = 0; n < 2; ++n) _Pragma("unroll") for (int k = 0; k < 2; ++k) dst[n][k] = *(const PG8_LAS bf16x8*)(lds + PG8_SB(b, h) + boff + n * 2048 + k * 1024); } while (0)
#define PG8_MMA(ai, bj, At, Bt) do { __builtin_amdgcn_s_setprio(1); _Pragma("unroll") for (int m = 0; m < 4; ++m) _Pragma("unroll") for (int n = 0; n < 2; ++n) { \
        if constexpr (F8) { typedef int v8i_ __attribute__((ext_vector_type(8))); typedef int v4i_ __attribute__((ext_vector_type(4))); \
            const v4i_ b0_ = __builtin_bit_cast(v4i_, Bt[n][0]), b1_ = __builtin_bit_cast(v4i_, Bt[n][1]), a0_ = __builtin_bit_cast(v4i_, At[m][0]), a1_ = __builtin_bit_cast(v4i_, At[m][1]); \
            const v8i_ bb_ = {b0_.x, b0_.y, b0_.z, b0_.w, b1_.x, b1_.y, b1_.z, b1_.w}, aa_ = {a0_.x, a0_.y, a0_.z, a0_.w, a1_.x, a1_.y, a1_.z, a1_.w}; \
            asm volatile("v_mfma_scale_f32_16x16x128_f8f6f4 %0, %1, %2, %0, %3, %3 op_sel_hi:[0,0,0]" : "+v"(acc[ai][bj][m][n]) : "v"(bb_), "v"(aa_), "v"(f8one)); } \
        else { _Pragma("unroll") for (int k = 0; k < 2; ++k) acc[ai][bj][m][n] = __builtin_amdgcn_mfma_f32_16x16x32_bf16(Bt[n][k], At[m][k], acc[ai][bj][m][n], 0, 0, 0); } } \
        __builtin_amdgcn_s_setprio(0); } while (0)
#define PG8_WAIT_V(n) asm volatile("s_waitcnt vmcnt(" #n ")" ::: "memory")
#define PG8_WAIT_L(n) asm volatile("s_waitcnt lgkmcnt(" #n ")" ::: "memory")
#define PG8_BAR __builtin_amdgcn_s_barrier()
#define PG8_SCHED __builtin_amdgcn_sched_barrier(0)
    Unit cur, nxt; int ui = 0;
    if (!S.next(0, cur)) return;
    f32x4 acc[2][2][4][2];
    const int f8one = 0x7f7f7f7f;
#pragma unroll
    for (int a = 0; a < 2; ++a)
#pragma unroll
        for (int b = 0; b < 2; ++b)
#pragma unroll
            for (int m = 0; m < 4; ++m)
#pragma unroll
                for (int n = 0; n < 2; ++n) acc[a][b][m][n] = (f32x4){0.f, 0.f, 0.f, 0.f};
    bf16x8 At[4][2], B0[2][2], B1[2][2];
    const char* cA = (const char*)g.A + (size_t)cur.pm * tstep; const char* cB = (const char*)g.Bt + (size_t)cur.pn * tstep;
    S.a_ready(cur);
    float segr[16];
    if constexpr (Epi::SEG) E.seg_load(ui, wr, fr, segr);
    if constexpr (SP2) {
        PG8_STAGE(PG8_SB(0, 0), cB, voffB); PG8_STAGE(PG8_SB(0, 1), cB + hstep, voffB); PG8_STAGE(PG8_SA(0, 0), cA, voffA); PG8_STAGE(PG8_SA(0, 1), cA + hstep, voffA);
        if (wr == 1) PG8_BAR;
        PG8_WAIT_V(2); PG8_BAR;
        PG8_STAGE(PG8_SB(1, 0), cB + kstep, voffB); PG8_STAGE(PG8_SA(1, 0), cA + kstep, voffA); PG8_STAGE(PG8_SB(1, 1), cB + hstep + kstep, voffB);
        PG8_WAIT_V(6); PG8_BAR;
    } else {
        PG8_STAGE(PG8_SB(0, 0), cB, voffB); PG8_STAGE(PG8_SA(0, 0), cA, voffA); PG8_STAGE(PG8_SB(0, 1), cB + hstep, voffB); PG8_STAGE(PG8_SA(0, 1), cA + hstep, voffA);
        if (wr == 1) PG8_BAR;
        PG8_WAIT_V(4); PG8_BAR;
        PG8_STAGE(PG8_SB(1, 0), cB + kstep, voffB); PG8_STAGE(PG8_SA(1, 0), cA + kstep, voffA); PG8_STAGE(PG8_SB(1, 1), cB + hstep + kstep, voffB);
        PG8_WAIT_V(6); PG8_BAR;
    }
    for (;;) {
        const bool has_next = S.next(ui + 1, nxt);
        const char* nA = has_next ? (const char*)g.A + (size_t)nxt.pm * tstep : cA; const char* nB = has_next ? (const char*)g.Bt + (size_t)nxt.pn * tstep : cB;
        int t = 0;
#pragma unroll 1
        for (int sgi = 0; sgi < (Epi::SEG ? 3 : 1); ++sgi) {
        int tend = nt; if constexpr (Epi::SEG) tend = (sgi == 0) ? Epi::SEG_T1 : ((sgi == 1) ? Epi::SEG_T2 : nt);
        for (; t < tend; t += 2) {
            const bool last = (t == nt - 2);
            const char* a1 = cA + (size_t)(t + 1) * kstep;
            const char* a2 = last ? nA : cA + (size_t)(t + 2) * kstep; const char* b2 = last ? nB : cB + (size_t)(t + 2) * kstep;
            const char* a3 = a2 + kstep; const char* b3 = b2 + kstep;
            if (last && has_next) S.a_ready(nxt);
            if constexpr (SP2) {
            PG8_LDB(B0, 0, 0); PG8_LDB(B1, 0, 1); PG8_SCHED; PG8_LDA(At, 0, 0); PG8_STAGE(PG8_SA(1, 1), a1 + hstep, voffA);
            PG8_WAIT_V(8); PG8_WAIT_L(0); PG8_BAR; PG8_MMA(0, 0, At, B0); PG8_MMA(0, 1, At, B1); PG8_BAR; PG8_SCHED;
            PG8_LDA(At, 0, 1); PG8_STAGE(PG8_SB(0, 0), b2, voffB); PG8_STAGE(PG8_SB(0, 1), b2 + hstep, voffB); PG8_STAGE(PG8_SA(0, 0), a2, voffA);
            PG8_WAIT_V(8); PG8_WAIT_L(0); PG8_BAR; PG8_MMA(1, 0, At, B0); PG8_MMA(1, 1, At, B1); PG8_BAR; PG8_SCHED;
            PG8_LDB(B0, 1, 0); PG8_LDB(B1, 1, 1); PG8_SCHED; PG8_LDA(At, 1, 0); PG8_STAGE(PG8_SA(0, 1), a2 + hstep, voffA);
            PG8_WAIT_V(8); PG8_WAIT_L(0); PG8_BAR; PG8_MMA(0, 0, At, B0); PG8_MMA(0, 1, At, B1); PG8_BAR; PG8_SCHED;
            PG8_LDA(At, 1, 1); PG8_STAGE(PG8_SB(1, 0), b3, voffB); PG8_STAGE(PG8_SB(1, 1), b3 + hstep, voffB); PG8_STAGE(PG8_SA(1, 0), a3, voffA);
            PG8_WAIT_V(8); PG8_WAIT_L(0); PG8_BAR; PG8_MMA(1, 0, At, B0); PG8_MMA(1, 1, At, B1); PG8_BAR; PG8_SCHED;
            } else {
            PG8_LDB(B0, 0, 0); PG8_SCHED; PG8_LDA(At, 0, 0); PG8_STAGE(PG8_SA(1, 1), a1 + hstep, voffA);
            PG8_WAIT_L(8); PG8_BAR; PG8_WAIT_L(0); PG8_MMA(0, 0, At, B0); PG8_BAR; PG8_SCHED;
            PG8_LDB(B1, 0, 1); PG8_STAGE(PG8_SB(0, 0), b2, voffB);
            PG8_BAR; PG8_WAIT_L(0); PG8_MMA(0, 1, At, B1); PG8_BAR;
            PG8_LDA(At, 0, 1); PG8_STAGE(PG8_SA(0, 0), a2, voffA);
            PG8_BAR; PG8_WAIT_L(0); PG8_MMA(1, 0, At, B0); PG8_BAR; PG8_SCHED;
            PG8_STAGE(PG8_SB(0, 1), b2 + hstep, voffB);
            PG8_WAIT_V(6); PG8_BAR; PG8_MMA(1, 1, At, B1); PG8_BAR;
            PG8_LDB(B0, 1, 0); PG8_SCHED; PG8_LDA(At, 1, 0); PG8_STAGE(PG8_SA(0, 1), a2 + hstep, voffA);
            PG8_WAIT_L(8); PG8_BAR; PG8_WAIT_L(0); PG8_MMA(0, 0, At, B0); PG8_BAR; PG8_SCHED;
            PG8_LDB(B1, 1, 1); PG8_STAGE(PG8_SB(1, 0), b3, voffB);
            PG8_BAR; PG8_WAIT_L(0); PG8_MMA(0, 1, At, B1); PG8_BAR;
            PG8_LDA(At, 1, 1); PG8_STAGE(PG8_SA(1, 0), a3, voffA);
            PG8_BAR; PG8_WAIT_L(0); PG8_MMA(1, 0, At, B0); PG8_BAR; PG8_SCHED;
            PG8_STAGE(PG8_SB(1, 1), b3 + hstep, voffB);
            PG8_WAIT_V(6); PG8_BAR; PG8_MMA(1, 1, At, B1); PG8_BAR;
            }
        }
        if constexpr (Epi::SEG) E.seg_apply(acc, segr, sgi);
        }
        if constexpr (ALIGN_EPI) { if (wr == 0) PG8_BAR; }
        if constexpr (!Epi::AFTER_DRAIN) { if constexpr (Epi::SEG) E(acc, cur, wr, wc, fr, fq, ui); else E(acc, cur, wr, wc, fr, fq); S.done(cur); }
        if (!has_next) break;
#pragma unroll
        for (int a = 0; a < 2; ++a)
#pragma unroll
            for (int b = 0; b < 2; ++b)
#pragma unroll
                for (int m = 0; m < 4; ++m)
#pragma unroll
                    for (int n = 0; n < 2; ++n) acc[a][b][m][n] = (f32x4){0.f, 0.f, 0.f, 0.f};
        cur = nxt; cA = nA; cB = nB; ++ui;
        if constexpr (Epi::SEG) E.seg_load(ui, wr, fr, segr);
        if constexpr (ALIGN_EPI) { if (wr == 1) PG8_BAR; }
    }
    PG8_WAIT_V(0);
    if constexpr (!ALIGN_EPI) { if (wr == 0) PG8_BAR; }
    PG8_BAR;
    if constexpr (Epi::AFTER_DRAIN) { E.fused(acc, cur, wr, wc, fr, fq, lds, wid, lane); S.done(cur); }
#undef PG8_SA
#undef PG8_SB
#undef PG8_STAGE
#undef PG8_LDA
#undef PG8_LDB
#undef PG8_MMA
#undef PG8_WAIT_V
#undef PG8_WAIT_L
#undef PG8_BAR
#undef PG8_SCHED
}
}
#ifndef PG8_SP2
#define PG8_SP2 true
#endif
#ifndef PG8_ALIGN
#define PG8_ALIGN true
#endif

constexpr int BATCH = 8, SEQ = 2048, DM = 2048, MTOK = BATCH * SEQ;
constexpr int ATT_W = 1024, ATT_H = 8, ATT_HD = 128, MOBA_BLK = 256, NBLK = SEQ / MOBA_BLK;
constexpr int SSM_W = 1024, SSM_H = 16, SSM_P = 64, SSM_N = 128, SSM_L = 128, SSM_NC = SEQ / SSM_L, CONV_CH = 1536;
constexpr int IN_PROJ = 5648, NPROJ = 5632  , NPAD = 5888  ;
constexpr int COL_Q = 0, COL_K = 1024, COL_V = 2048, COL_Z = 3072, COL_XBC = 4096;
constexpr int PEER_H = 8, PEER_NK = 128, PEER_K = 16, PEER_HK = 128;
constexpr float EPS = 1e-6f;
constexpr float SU = 64.f, SV = 4.f, SH = 16.f, SLO = 16.f;
constexpr float SX8 = 16.f, SW8 = 1024.f;
constexpr float SH4 = 1.5f, SLO4 = 4.f;
constexpr int ROWB = DM / 2;

constexpr size_t MiB = 1u << 20;
constexpr size_t WS_CTL = 0, CTL_ZERO_BYTES = 1 * MiB;
constexpr size_t WS_DT = 1 * MiB;
constexpr size_t WS_SK = 2 * MiB;
constexpr size_t WS_WIN = 4 * MiB;
constexpr size_t WS_WOUT = 28 * MiB;
constexpr size_t WS_WQ = 36 * MiB;
constexpr size_t WS_HN = 44 * MiB;
constexpr size_t WS_PROJ = 108 * MiB;
constexpr size_t WS_X1B = WS_PROJ, WS_QP = WS_PROJ + 64 * MiB;
constexpr size_t WS_U8 = 284 * MiB, WS_V8 = 316 * MiB;
constexpr size_t WS_XBC = 348 * MiB;
constexpr size_t WS_DT2 = 3 * MiB;
constexpr size_t WS_X18 = 396 * MiB;
constexpr size_t WS_END = 428 * MiB;
constexpr int CW_BAR = 4096;
constexpr int CW_Q2 = 8192;
constexpr int CW_KMEAN = 32768;
constexpr int CW_SSQ = 131072;
static_assert((CW_SSQ + MTOK * 4) * 4 <= (int)CTL_ZERO_BYTES, "CTL words inside the memset region");

constexpr int RING_OFF = 0, RING_BYTES = 131072;
constexpr int LDSCTL_OFF = RING_BYTES, MISC_OFF = LDSCTL_OFF + 320;
constexpr int SEGTAB_OFF = LDSCTL_OFF + 1024;  static_assert(LDSCTL_OFF + 1024 + 3 * 256 * 16 <= 147456, "segment table inside the LDS allocation");
constexpr int LDS_BYTES = 147456;
constexpr int NWAVES = 8;

#define GAS __attribute__((address_space(1)))
#define LAS __attribute__((address_space(3)))
typedef unsigned short bf16;
typedef unsigned v4u __attribute__((ext_vector_type(4)));
typedef unsigned v2u __attribute__((ext_vector_type(2)));
typedef float f32x4 __attribute__((ext_vector_type(4)));
typedef float f32x2 __attribute__((ext_vector_type(2)));
typedef short bf16x8 __attribute__((ext_vector_type(8)));
typedef short s16x4 __attribute__((ext_vector_type(4)));
typedef GAS unsigned gu32;
#define RLX_AGENT __ATOMIC_RELAXED, __HIP_MEMORY_SCOPE_AGENT
#define LDS_WAIT() asm volatile("s_waitcnt lgkmcnt(0)" ::: "memory")
#define VM_WAIT() asm volatile("s_waitcnt vmcnt(0)" ::: "memory")
__device__ __forceinline__ unsigned f2bf(float f) { unsigned u = __builtin_bit_cast(unsigned, f); return (u + 0x7fffu + ((u >> 16) & 1u)) >> 16; }
typedef __bf16 bf16v2 __attribute__((ext_vector_type(2)));
__device__ __forceinline__ unsigned pk2(float lo, float hi) { bf16v2 v; v.x = (__bf16)lo; v.y = (__bf16)hi; return __builtin_bit_cast(unsigned, v); }
__device__ __forceinline__ float bflo(unsigned w) { return __builtin_bit_cast(float, w << 16); }
__device__ __forceinline__ float bfhi(unsigned w) { return __builtin_bit_cast(float, w & 0xffff0000u); }
__device__ __forceinline__ float wave_sum(float v) {
#pragma unroll
    for (int o = 1; o < 64; o <<= 1) v += __shfl_xor(v, o);
    return v;
}
__device__ __forceinline__ float silu_f(float x) { return x * __builtin_amdgcn_rcpf(1.f + __expf(-x)); }

#define XB_TMO      128
#define XB_XCNT(j)  (256  + 64 * (j))
#define XB_XSUB(j)  (1280 + 64 * (j))
#define XB_XGEN(j)  (2304 + 64 * (j))
#define XB_TOP      3328
#define XB_TOPGEN   3392
#define XCD_BAR_WORDS 3456
#define XB_SPIN_CAP (1u << 18)

__device__ __forceinline__ unsigned xb_ld(unsigned* p)              { return __hip_atomic_load(p, __ATOMIC_RELAXED, __HIP_MEMORY_SCOPE_AGENT); }
__device__ __forceinline__ unsigned xb_add(unsigned* p, unsigned v) { return __hip_atomic_fetch_add(p, v, __ATOMIC_RELAXED, __HIP_MEMORY_SCOPE_AGENT); }
__device__ __forceinline__ unsigned xb_xcc_id() { return (unsigned)__builtin_amdgcn_s_getreg((3 << 11) | 20) & 0xFu; }
#define XB_SPIN(cond, bar) do { unsigned _sp = 0; while (cond) { __builtin_amdgcn_s_sleep(1); \
    if ((++_sp & 255u) == 0u) { if (xb_ld(&(bar)[XB_TMO])) break; if (_sp > XB_SPIN_CAP) { atomicAdd(&(bar)[XB_TMO], 1u); break; } } } } while (0)

struct XcdBarrier {
    unsigned* bar; unsigned x;
    volatile LAS unsigned* st;
};
__device__ __forceinline__ XcdBarrier xcd_barrier_post(unsigned* bar, volatile LAS unsigned* st) {
    XcdBarrier b; b.bar = bar; b.x = xb_xcc_id(); b.st = st;
    if (threadIdx.x == 0) (void)xb_add(&bar[XB_XCNT(b.x)], 1u);
    return b;
}
__device__ __forceinline__ void xcd_barrier_complete(unsigned* bar, unsigned x, unsigned& nloc, unsigned& nx) {
    const unsigned G = gridDim.x * gridDim.y * gridDim.z;
    unsigned sum, cnt, mine, sp = 0u;
    for (;;) {
        sum = 0u; cnt = 0u; mine = 0u;
#pragma unroll
        for (unsigned j = 0; j < 16; ++j) { const unsigned c = xb_ld(&bar[XB_XCNT(j)]); sum += c; cnt += (c > 0u) ? 1u : 0u; mine = (j == x) ? c : mine; }
        if (sum == G) break;
        __builtin_amdgcn_s_sleep(1);
        if ((++sp & 255u) == 0u) { if (xb_ld(&bar[XB_TMO])) break; if (sp > XB_SPIN_CAP) { atomicAdd(&bar[XB_TMO], 1u); break; } }
    }
    nloc = mine > 0u ? mine : 1u; nx = cnt > 0u ? cnt : 1u;
}
__device__ __forceinline__ void xcd_barrier(const XcdBarrier& b) {
    asm volatile("s_waitcnt vmcnt(0)" ::: "memory");
    __syncthreads();
    if (threadIdx.x == 0) {
        unsigned* bar = b.bar;
        __builtin_amdgcn_s_waitcnt(0);
        unsigned nloc = b.st[0], nx = b.st[1];
        if (nloc == 0u) { xcd_barrier_complete(bar, b.x, nloc, nx); b.st[0] = nloc; b.st[1] = nx; }
        const unsigned old = xb_add(&bar[XB_XSUB(b.x)], 1u);
        const unsigned gen = old / nloc;
        if (old + 1u == (gen + 1u) * nloc) {
            __builtin_amdgcn_fence(__ATOMIC_RELEASE, "agent");
            asm volatile("s_waitcnt vmcnt(0)" ::: "memory");
            const unsigned og = xb_add(&bar[XB_TOP], 1u);
            const unsigned tg = og / nx;
            if (og + 1u == (tg + 1u) * nx) xb_add(&bar[XB_TOPGEN], 1u);
            else XB_SPIN(xb_ld(&bar[XB_TOPGEN]) == tg, bar);
            __builtin_amdgcn_fence(__ATOMIC_ACQUIRE, "agent");
            xb_add(&bar[XB_XGEN(b.x)], 1u);
            asm volatile("s_waitcnt vmcnt(0)" ::: "memory");
        } else {
            XB_SPIN(xb_ld(&bar[XB_XGEN(b.x)]) == gen, bar);
            __builtin_amdgcn_fence(__ATOMIC_ACQUIRE, "agent");
            asm volatile("s_waitcnt vmcnt(0)" ::: "memory");
        }
    }
    __syncthreads();
}

#define CAS __attribute__((address_space(4)))
struct Args { const float* in[18]; float* out; unsigned char* ws; };
__device__ __forceinline__ const CAS unsigned char* kargs() { const CAS unsigned char* p = (const CAS unsigned char*)__builtin_amdgcn_kernarg_segment_ptr(); asm volatile("" : "+s"(p)); return p; }
__device__ __forceinline__ const float* kin(int i) { return *(const float* const CAS*)(kargs() + 8 * i); }
__device__ __forceinline__ float* kout() { return *(float* const CAS*)(kargs() + 8 * 18); }
__device__ __forceinline__ unsigned char* kws() { return *(unsigned char* const CAS*)(kargs() + 8 * 19); }
__device__ __forceinline__ int fresh_tid() { int t = threadIdx.x; asm volatile("" : "+v"(t)); return t; }
struct Frame {
    LAS unsigned char* lds;
    volatile LAS unsigned* MISC;
    int tid, lane, wave, G;
    __device__ __forceinline__ const float* x() const { return kin(0); }
    __device__ __forceinline__ const float* attn_norm() const { return kin(1); }
    __device__ __forceinline__ const float* w_in() const { return kin(2); }
    __device__ __forceinline__ const float* conv_w() const { return kin(3); }
    __device__ __forceinline__ const float* conv_b() const { return kin(4); }
    __device__ __forceinline__ const float* dt_bias() const { return kin(5); }
    __device__ __forceinline__ const float* a_log() const { return kin(6); }
    __device__ __forceinline__ const float* d_skip() const { return kin(7); }
    __device__ __forceinline__ const float* rel_bias() const { return kin(8); }
    __device__ __forceinline__ const float* attn_out_norm() const { return kin(9); }
    __device__ __forceinline__ const float* ssm_out_norm() const { return kin(10); }
    __device__ __forceinline__ const float* w_out() const { return kin(11); }
    __device__ __forceinline__ const float* ffn_norm() const { return kin(12); }
    __device__ __forceinline__ const float* peer_wq() const { return kin(13); }
    __device__ __forceinline__ const float* peer_sk() const { return kin(14); }
    __device__ __forceinline__ const float* peer_u() const { return kin(15); }
    __device__ __forceinline__ const float* peer_v() const { return kin(16); }
    __device__ __forceinline__ const float* final_norm() const { return kin(17); }
    __device__ __forceinline__ float* out() const { return kout(); }
    __device__ __forceinline__ unsigned* ctl() const { return (unsigned*)(kws() + WS_CTL); }
    __device__ __forceinline__ float* dtraw() const { return (float*)(kws() + WS_DT); }
    __device__ __forceinline__ bf16* SK() const { return (bf16*)(kws() + WS_SK); }
    __device__ __forceinline__ bf16* WinT() const { return (bf16*)(kws() + WS_WIN); }
    __device__ __forceinline__ bf16* WoutT() const { return (bf16*)(kws() + WS_WOUT); }
    __device__ __forceinline__ bf16* WqT() const { return (bf16*)(kws() + WS_WQ); }
    __device__ __forceinline__ bf16* HN() const { return (bf16*)(kws() + WS_HN); }
    __device__ __forceinline__ bf16* PROJ() const { return (bf16*)(kws() + WS_PROJ); }
    __device__ __forceinline__ bf16* X1B() const { return (bf16*)(kws() + WS_X1B); }
    __device__ __forceinline__ bf16* QP() const { return (bf16*)(kws() + WS_QP); }
    __device__ __forceinline__ unsigned char* U8() const { return kws() + WS_U8; }
    __device__ __forceinline__ unsigned char* V8() const { return kws() + WS_V8; }
    __device__ __forceinline__ unsigned char* X18() const { return kws() + WS_X18; }
    __device__ __forceinline__ bf16* XBC() const { return (bf16*)(kws() + WS_XBC); }
    __device__ __forceinline__ float* DT2() const { return (float*)(kws() + WS_DT2); }
    __device__ __forceinline__ float* kmean() const { return (float*)(kws() + WS_CTL) + CW_KMEAN; }
    __device__ __forceinline__ float* ssq() const { return (float*)(kws() + WS_CTL) + CW_SSQ; }
};

__device__ __forceinline__ float clampf(float v, float lim);
__device__ __forceinline__ void p0_transpose_item(const float* W, int K, int N, bf16* WT, const float* gain, LAS float* scr, int item, int lane, const float f8scale = 0.f) {
    const int nblk = (N + 31) / 32, kb = item / nblk, nb = item % nblk, k0 = 64 * kb, n0 = 32 * nb;
    const int kr = lane >> 3, nc = (lane & 7) * 4; const bool ok = (n0 + nc) < N;
    f32x4 v[8]; float gk[8];
#pragma unroll
    for (int i = 0; i < 8; ++i) { const int kk = 8 * i + kr; v[i] = ok ? *(const GAS f32x4*)(W + (size_t)(k0 + kk) * N + n0 + nc) : (f32x4){0.f, 0.f, 0.f, 0.f}; gk[i] = gain ? gain[k0 + kk] : 1.f; }
#pragma unroll
    for (int i = 0; i < 8; ++i) { const int kk = 8 * i + kr; LAS float* d = scr + kk * 33 + nc; d[0] = v[i].x * gk[i]; d[1] = v[i].y * gk[i]; d[2] = v[i].z * gk[i]; d[3] = v[i].w * gk[i]; }
    LDS_WAIT(); asm volatile("" ::: "memory");
    const int c = lane & 7;
#pragma unroll
    for (int j = 0; j < 4; ++j) { const int n = (lane >> 3) + 8 * j; const LAS float* s = scr + (8 * c) * 33 + n;
        v4u o; o.x = pk2(s[0 * 33], s[1 * 33]); o.y = pk2(s[2 * 33], s[3 * 33]); o.z = pk2(s[4 * 33], s[5 * 33]); o.w = pk2(s[6 * 33], s[7 * 33]);
        if (f8scale == 0.f) *(GAS v4u*)(WT + (size_t)(n0 + n) * K + k0 + 8 * c) = o;
        else { v2u o8; int w_;
            w_ = __builtin_amdgcn_cvt_pk_fp8_f32(clampf(s[0 * 33] * f8scale, 448.f), clampf(s[1 * 33] * f8scale, 448.f), 0, false); w_ = __builtin_amdgcn_cvt_pk_fp8_f32(clampf(s[2 * 33] * f8scale, 448.f), clampf(s[3 * 33] * f8scale, 448.f), w_, true); o8.x = (unsigned)w_;
            w_ = __builtin_amdgcn_cvt_pk_fp8_f32(clampf(s[4 * 33] * f8scale, 448.f), clampf(s[5 * 33] * f8scale, 448.f), 0, false); w_ = __builtin_amdgcn_cvt_pk_fp8_f32(clampf(s[6 * 33] * f8scale, 448.f), clampf(s[7 * 33] * f8scale, 448.f), w_, true); o8.y = (unsigned)w_;
            *(GAS v2u*)((unsigned char*)WT + (size_t)(n0 + n) * K + k0 + 8 * c) = o8; } }
    LDS_WAIT(); asm volatile("" ::: "memory");
}
__device__ __forceinline__ void rms_2rows_to_bf16(const float* x0, const float* x1, const float* gain, bf16* o0, bf16* o1, int lane) {
    const GAS f32x4* xr0 = (const GAS f32x4*)x0 + lane; const GAS f32x4* xr1 = (const GAS f32x4*)x1 + lane; const GAS f32x4* gr = (const GAS f32x4*)gain + lane;
    f32x4 v[8], u[8]; float s = 0.f, t = 0.f;
#pragma unroll
    for (int j = 0; j < 8; ++j) { v[j] = xr0[64 * j]; u[j] = xr1[64 * j]; }
#pragma unroll
    for (int j = 0; j < 8; ++j) { s += (v[j].x * v[j].x + v[j].y * v[j].y) + (v[j].z * v[j].z + v[j].w * v[j].w); t += (u[j].x * u[j].x + u[j].y * u[j].y) + (u[j].z * u[j].z + u[j].w * u[j].w); }
    const float rs = __builtin_amdgcn_rsqf(wave_sum(s) * (1.f / DM) + EPS), rt = __builtin_amdgcn_rsqf(wave_sum(t) * (1.f / DM) + EPS);
    GAS v2u* p0 = (GAS v2u*)o0 + lane; GAS v2u* p1 = (GAS v2u*)o1 + lane;
#pragma unroll
    for (int j = 0; j < 8; ++j) { const f32x4 g = gr[64 * j]; v2u a, b;
        a.x = pk2(v[j].x * rs * g.x, v[j].y * rs * g.y); a.y = pk2(v[j].z * rs * g.z, v[j].w * rs * g.w); p0[64 * j] = a;
        b.x = pk2(u[j].x * rt * g.x, u[j].y * rt * g.y); b.y = pk2(u[j].z * rt * g.z, u[j].w * rt * g.w); p1[64 * j] = b; }
}
#ifdef PROBE_FP4EMU
__device__ __forceinline__ float fp4grid(float y) { const float a = fabsf(y); float r;
    if (a <= 2.f) r = rintf(a * 2.f) * 0.5f; else if (a <= 4.f) r = rintf(a); else r = (a < 5.f) ? 4.f : 6.f;
    return copysignf(r, y); }
__device__ __forceinline__ float clampf(float v, float lim) { if (lim == 448.5f) return fp4grid(v * (1.f / 16.f)) * 16.f; return fminf(fmaxf(v, -lim), lim); }
#else
__device__ __forceinline__ float clampf(float v, float lim) { return fminf(fmaxf(v, -lim), lim); }
#endif
template <int TAB = 0> __device__ __forceinline__ v4u cvt16_fp8(const f32x4 a, const f32x4 b, const f32x4 c, const f32x4 d, float sc) {
    v4u o; int w; constexpr float LIM = TAB ? 448.5f : 448.f;
    w = __builtin_amdgcn_cvt_pk_fp8_f32(clampf(a.x * sc, LIM), clampf(a.y * sc, LIM), 0, false); w = __builtin_amdgcn_cvt_pk_fp8_f32(clampf(a.z * sc, LIM), clampf(a.w * sc, LIM), w, true); o.x = (unsigned)w;
    w = __builtin_amdgcn_cvt_pk_fp8_f32(clampf(b.x * sc, LIM), clampf(b.y * sc, LIM), 0, false); w = __builtin_amdgcn_cvt_pk_fp8_f32(clampf(b.z * sc, LIM), clampf(b.w * sc, LIM), w, true); o.y = (unsigned)w;
    w = __builtin_amdgcn_cvt_pk_fp8_f32(clampf(c.x * sc, LIM), clampf(c.y * sc, LIM), 0, false); w = __builtin_amdgcn_cvt_pk_fp8_f32(clampf(c.z * sc, LIM), clampf(c.w * sc, LIM), w, true); o.z = (unsigned)w;
    w = __builtin_amdgcn_cvt_pk_fp8_f32(clampf(d.x * sc, LIM), clampf(d.y * sc, LIM), 0, false); w = __builtin_amdgcn_cvt_pk_fp8_f32(clampf(d.z * sc, LIM), clampf(d.w * sc, LIM), w, true); o.w = (unsigned)w;
    return o;
}
__device__ __forceinline__ void tables_convert(Frame& F, size_t lo, size_t hi, size_t tix, size_t ntx) {
      const GAS f32x4* su = (const GAS f32x4*)F.peer_u(); const GAS f32x4* sv = (const GAS f32x4*)F.peer_v(); GAS v4u* du = (GAS v4u*)F.U8(); GAS v4u* dv = (GAS v4u*)F.V8();
#pragma unroll 1
      for (int tab = 0; tab < 2; ++tab) { const GAS f32x4* src = tab ? sv : su; GAS v4u* dst = tab ? dv : du; const float sc = tab ? SV : SU;
        f32x4 nx[8]; const size_t i0 = lo + tix;
        if (i0 < hi) { const GAS f32x4* p = src + (i0 >> 6) * 512 + (i0 & 63);
#pragma unroll
            for (int j = 0; j < 8; ++j) nx[j] = p[64 * j]; }
#pragma unroll 1
        for (size_t i = i0; i < hi; i += ntx) { f32x4 v[8];
#pragma unroll
            for (int j = 0; j < 8; ++j) v[j] = nx[j];
            if (i + ntx < hi) { const size_t i2 = i + ntx; const GAS f32x4* p = src + (i2 >> 6) * 512 + (i2 & 63);
#pragma unroll
                for (int j = 0; j < 8; ++j) nx[j] = p[64 * j]; }
            unsigned wd[4];
#pragma unroll
            for (int q = 0; q < 4; ++q) { const f32x4 a = v[2 * q] * sc, b = v[2 * q + 1] * sc; unsigned w = 0u;
                w = __builtin_amdgcn_cvt_scalef32_pk_fp4_f32(w, clampf(a.x, 6.f), clampf(a.y, 6.f), 1.0f, 0); w = __builtin_amdgcn_cvt_scalef32_pk_fp4_f32(w, clampf(a.z, 6.f), clampf(a.w, 6.f), 1.0f, 1);
                w = __builtin_amdgcn_cvt_scalef32_pk_fp4_f32(w, clampf(b.x, 6.f), clampf(b.y, 6.f), 1.0f, 2); w = __builtin_amdgcn_cvt_scalef32_pk_fp4_f32(w, clampf(b.z, 6.f), clampf(b.w, 6.f), 1.0f, 3); wd[q] = w; }
            dst[i] = (v4u){wd[0], wd[1], wd[2], wd[3]}; } }
}
constexpr size_t TAB_ITEMS = (size_t)16384 * 64;
__device__ __forceinline__ size_t tab_split(int G) { const int rem = ((MTOK / 256) * (NPAD / 256)) % G; return rem ? (TAB_ITEMS / 8) * 5 : TAB_ITEMS; }
__device__ __forceinline__ unsigned fp4_code(float y) { const float a = fabsf(y);
    const unsigned m = (unsigned)(a >= 0.25f) + (unsigned)(a >= 0.75f) + (unsigned)(a >= 1.25f) + (unsigned)(a >= 1.75f) + (unsigned)(a >= 2.5f) + (unsigned)(a >= 3.5f) + (unsigned)(a >= 5.0f);
    return m | ((y < 0.f) ? 8u : 0u); }
__device__ __forceinline__ void p0_prologue(Frame& F) {
    const int tid = fresh_tid(), lane = tid & 63, wave = __builtin_amdgcn_readfirstlane(tid >> 6);
    LAS float* scr = (LAS float*)(F.lds + RING_OFF + wave * 16384);
    const int gw = blockIdx.x * NWAVES + wave, NGW = F.G * NWAVES;
    constexpr int I_IN = (DM / 64) * ((IN_PROJ + 31) / 32), I_SQ = (DM / 64) * (DM / 32);
    constexpr int NITEMS = I_IN + 2 * I_SQ;
    { const float* const w_in = F.w_in(); const float* const w_out = F.w_out(); const float* const wq = F.peer_wq(); const float* const fg = F.ffn_norm(); bf16* const WinT = F.WinT(); bf16* const WoutT = F.WoutT(); bf16* const WqT = F.WqT(); const float* const gatt = F.attn_out_norm(); const float* const gssm = F.ssm_out_norm();
      for (int it = gw; it < NITEMS; it += NGW) {
        int r = it;
        if (r < I_IN) { p0_transpose_item(w_in, DM, IN_PROJ, WinT, nullptr, scr, r, lane); continue; } r -= I_IN;
        if (r < I_SQ) { const int k0_ = 64 * (r / (DM / 32)); p0_transpose_item(w_out, DM, DM, WoutT, (k0_ < ATT_W) ? gatt : (gssm - ATT_W), scr, r, lane); continue; } r -= I_SQ;
        p0_transpose_item(wq, DM, DM, WqT, fg, scr, r, lane, SW8);
      } }
    const size_t gt = (size_t)blockIdx.x * (NWAVES * 64) + tid, GT = (size_t)F.G * NWAVES * 64;
    { const size_t z0 = (size_t)5664 * DM / 8, z1 = (size_t)NPAD * DM / 8; GAS v4u* p = (GAS v4u*)F.WinT(); for (size_t i = z0 + gt; i < z1; i += GT) p[i] = (v4u){0u, 0u, 0u, 0u}; }
    { const GAS f32x4* s = (const GAS f32x4*)F.peer_sk(); GAS v2u* d = (GAS v2u*)F.SK(); for (size_t i = gt; i < (size_t)16 * 128 * 128 / 4; i += GT) { const f32x4 v = s[i]; v2u o; o.x = pk2(v.x, v.y); o.y = pk2(v.z, v.w); d[i] = o; } }
    { const float* const xg = F.x(); const float* const gn = F.attn_norm(); bf16* const hn = F.HN();
      for (int m = gw; m < MTOK / 2; m += NGW) rms_2rows_to_bf16(xg + (size_t)(2 * m) * DM, xg + (size_t)(2 * m + 1) * DM, gn, hn + (size_t)(2 * m) * DM, hn + (size_t)(2 * m + 1) * DM, lane); }
    tables_convert(F, 0, tab_split(F.G), gt, GT);
}

struct EpiProj {
    static constexpr bool PERM = true, AFTER_DRAIN = false, SEG = false;
    bf16* O; float* dtraw; float* kmean;
    __device__ __forceinline__ void operator()(const pg8::f32x4 (&acc)[2][2][4][2], const pg8::Unit& u, int wr, int wc, int fr, int fq) const {
        const int row0 = u.pm * 256 + wr * 64 + fr, col0 = u.pn * 256 + wc * 32 + 8 * fq;
        if (u.pn < 22) {
#pragma unroll
            for (int ai = 0; ai < 2; ++ai)
#pragma unroll
                for (int m = 0; m < 4; ++m) { bf16* rowp = O + (size_t)(row0 + ai * 128 + m * 16) * NPROJ + col0;
#pragma unroll
                    for (int bj = 0; bj < 2; ++bj) { const pg8::f32x4 v0 = acc[ai][bj][m][0], v1 = acc[ai][bj][m][1];
                        pg8::u32x4 w; w.x = pg8::cvt_pk_bf16(v0[0], v0[1]); w.y = pg8::cvt_pk_bf16(v0[2], v0[3]); w.z = pg8::cvt_pk_bf16(v1[0], v1[1]); w.w = pg8::cvt_pk_bf16(v1[2], v1[3]);
                        *(pg8::u32x4*)(rowp + bj * 128) = w; } }
        } else if (wc == 0 && fq < 2) {
#pragma unroll
            for (int ai = 0; ai < 2; ++ai)
#pragma unroll
                for (int m = 0; m < 4; ++m) { float* rp = dtraw + (size_t)(row0 + ai * 128 + m * 16) * 16 + 8 * fq;
                    *(pg8::f32x4*)rp = acc[ai][0][m][0]; *(pg8::f32x4*)(rp + 4) = acc[ai][0][m][1]; }
        }
        if (kmean && u.pn >= 4 && u.pn < 8) {
#pragma unroll
            for (int bj = 0; bj < 2; ++bj)
#pragma unroll
                for (int n = 0; n < 2; ++n)
#pragma unroll
                    for (int i = 0; i < 4; ++i) { float s = 0.f;
#pragma unroll
                        for (int ai = 0; ai < 2; ++ai)
#pragma unroll
                            for (int m = 0; m < 4; ++m) s += acc[ai][bj][m][n][i];
                        s += __shfl_xor(s, 1); s += __shfl_xor(s, 2); s += __shfl_xor(s, 4); s += __shfl_xor(s, 8);
                        if (fr == 0) unsafeAtomicAdd(kmean + (size_t)u.pm * 1024 + (col0 - 1024) + bj * 128 + 4 * n + i, s); }
        }
    }
};
struct EpiOut {
    static constexpr bool PERM = true, AFTER_DRAIN = false, SEG = true; static constexpr int SEG_T1 = 16, SEG_T2 = 24;
    const float* x; bf16* x1b; unsigned char* x18; float* ssq; bool doatom; const LAS f32x4* tab;
    __device__ __forceinline__ void seg_load(int ui, int wr, int fr, float (&sr)[16]) const {
#pragma unroll
        for (int i = 0; i < 8; ++i) { const int r = (i >> 2) * 128 + wr * 64 + (i & 3) * 16 + fr; const f32x2 q = *(const LAS f32x2*)(tab + ui * 256 + r); sr[2 * i] = q.x; sr[2 * i + 1] = q.y; }
        asm volatile("s_waitcnt lgkmcnt(0)" ::: "memory");
    }
    __device__ __forceinline__ void seg_apply(pg8::f32x4 (&acc)[2][2][4][2], const float (&sr)[16], int which) const {
#pragma unroll
        for (int ai = 0; ai < 2; ++ai)
#pragma unroll
            for (int m = 0; m < 4; ++m) { const float f = (which == 0) ? sr[2 * (ai * 4 + m)] : ((which == 1) ? sr[2 * (ai * 4 + m) + 1] : 1.0f);
#pragma unroll
                for (int bj = 0; bj < 2; ++bj)
#pragma unroll
                    for (int n = 0; n < 2; ++n) acc[ai][bj][m][n] = acc[ai][bj][m][n] * f; }
    }
    __device__ __forceinline__ void operator()(const pg8::f32x4 (&acc)[2][2][4][2], const pg8::Unit& u, int wr, int wc, int fr, int fq, int ui) const {
        const int row0 = u.pm * 256 + wr * 64 + fr, col0 = u.pn * 256 + wc * 32 + 8 * fq;
#pragma unroll
        for (int ai = 0; ai < 2; ++ai)
#pragma unroll
            for (int m = 0; m < 4; ++m) { const int row = row0 + ai * 128 + m * 16; const size_t off = (size_t)row * DM + col0; float s = 0.f;
                const float s1 = (*(const LAS f32x4*)(tab + ui * 256 + ai * 128 + wr * 64 + m * 16 + fr)).z;
#pragma unroll
                for (int bj = 0; bj < 2; ++bj) {
                    const pg8::f32x4 a0 = *(const pg8::f32x4*)(x + off + bj * 128), a1 = *(const pg8::f32x4*)(x + off + bj * 128 + 4);
                    const pg8::f32x4 v0 = acc[ai][bj][m][0] * s1 + a0, v1 = acc[ai][bj][m][1] * s1 + a1;
                    pg8::u32x4 w; w.x = pg8::cvt_pk_bf16(v0[0], v0[1]); w.y = pg8::cvt_pk_bf16(v0[2], v0[3]); w.z = pg8::cvt_pk_bf16(v1[0], v1[1]); w.w = pg8::cvt_pk_bf16(v1[2], v1[3]);
                    *(pg8::u32x4*)(x1b + off + bj * 128) = w;
                    { v2u o8; int w_; w_ = __builtin_amdgcn_cvt_pk_fp8_f32(clampf(v0[0] * SX8, 448.f), clampf(v0[1] * SX8, 448.f), 0, false); w_ = __builtin_amdgcn_cvt_pk_fp8_f32(clampf(v0[2] * SX8, 448.f), clampf(v0[3] * SX8, 448.f), w_, true); o8.x = (unsigned)w_;
                      w_ = __builtin_amdgcn_cvt_pk_fp8_f32(clampf(v1[0] * SX8, 448.f), clampf(v1[1] * SX8, 448.f), 0, false); w_ = __builtin_amdgcn_cvt_pk_fp8_f32(clampf(v1[2] * SX8, 448.f), clampf(v1[3] * SX8, 448.f), w_, true); o8.y = (unsigned)w_;
                      *(v2u*)(x18 + off + bj * 128) = o8; }
                    s += (v0[0] * v0[0] + v0[1] * v0[1]) + (v0[2] * v0[2] + v0[3] * v0[3]) + (v1[0] * v1[0] + v1[1] * v1[1]) + (v1[2] * v1[2] + v1[3] * v1[3]); }
                s += __shfl_xor(s, 16); s += __shfl_xor(s, 32);
                if (fq == 0 && doatom) unsafeAtomicAdd(ssq + (size_t)row * 4, s);
                asm volatile("" ::: "memory"); }
    }
};
struct EpiQ {
    static constexpr bool PERM = true, AFTER_DRAIN = false, SEG = false;
    bf16* O; const float* ssq;
    __device__ __forceinline__ void operator()(const pg8::f32x4 (&acc)[2][2][4][2], const pg8::Unit& u, int wr, int wc, int fr, int fq) const {
        const int row0 = u.pm * 256 + wr * 64 + fr, col0 = u.pn * 256 + wc * 32 + 8 * fq;
#pragma unroll
        for (int ai = 0; ai < 2; ++ai)
#pragma unroll
            for (int m = 0; m < 4; ++m) { const int row = row0 + ai * 128 + m * 16; bf16* rowp = O + (size_t)row * DM + col0;
                const float rs = (1.f / (SX8 * SW8)) / sqrtf(__hip_atomic_load(ssq + (size_t)row * 4, RLX_AGENT) * (1.f / DM) + EPS);
#pragma unroll
                for (int bj = 0; bj < 2; ++bj) { const pg8::f32x4 v0 = acc[ai][bj][m][0] * rs, v1 = acc[ai][bj][m][1] * rs;
                    pg8::u32x4 w; w.x = pg8::cvt_pk_bf16(v0[0], v0[1]); w.y = pg8::cvt_pk_bf16(v0[2], v0[3]); w.z = pg8::cvt_pk_bf16(v1[0], v1[1]); w.w = pg8::cvt_pk_bf16(v1[2], v1[3]);
                    *(pg8::u32x4*)(rowp + bj * 128) = w; } }
    }
};

constexpr int A_KSTR = 272, A_VSTR = 288;
constexpr int A_KB0 = 0, A_KB1 = 64 * A_KSTR, A_VB0 = 2 * 64 * A_KSTR, A_VB1 = A_VB0 + 64 * A_VSTR, A_KM = A_VB1 + 64 * A_VSTR, A_TAB = A_KM + 8 * 128 * 4, A_END = A_TAB + 128 * 4;
static_assert(A_END <= RING_BYTES && (A_KM % 16) == 0, "attention LDS map");
#define PIN16(a, i) asm volatile("" : "+v"(a[i]), "+v"(a[i + 1]), "+v"(a[i + 2]), "+v"(a[i + 3]), "+v"(a[i + 4]), "+v"(a[i + 5]), "+v"(a[i + 6]), "+v"(a[i + 7]), "+v"(a[i + 8]), "+v"(a[i + 9]), "+v"(a[i + 10]), "+v"(a[i + 11]), "+v"(a[i + 12]), "+v"(a[i + 13]), "+v"(a[i + 14]), "+v"(a[i + 15]))
#define TR16(p) __builtin_amdgcn_ds_read_tr16_b64_v4i16((LAS s16x4*)(p))
#define MFMA16(a, b, c) __builtin_amdgcn_mfma_f32_16x16x32_bf16((a), (b), (c), 0, 0, 0)
__device__ __forceinline__ bf16x8 pack8(const float* v) {
    const unsigned a = pk2(v[0], v[1]), b = pk2(v[2], v[3]), c = pk2(v[4], v[5]), d = pk2(v[6], v[7]);
    const v4u u = {a, b, c, d}; return __builtin_bit_cast(bf16x8, u);
}
__device__ __forceinline__ void attn_unit(Frame& F, int b, int h, int blk, const bool doatom = true) {
    LAS unsigned char* lds = F.lds + RING_OFF;
    const int tid = fresh_tid(), lane = tid & 63, w = __builtin_amdgcn_readfirstlane(tid >> 6), g = lane >> 4, c16 = lane & 15, q4 = c16 >> 2, p4 = lane & 3;
    const int own = blk, t0 = blk * 256, tq0 = t0 + 32 * w + c16;
    const size_t rowbase = (size_t)b * SEQ;
    const float NEG_INF = -__builtin_inff();
    constexpr float LOG2E = 1.4426950408889634f, SCL2 = 0.08838834764831845f * 1.4426950408889634f;
    LAS float* km = (LAS float*)(lds + A_KM); LAS float* tab = (LAS float*)(lds + A_TAB);
    const bf16* const PROJ = F.PROJ(); const float* const kmg = F.kmean(); const float* const relb = F.rel_bias();
    for (int i = tid; i < own * 128; i += NWAVES * 64) { const int n = i >> 7, d = i & 127; km[i] = kmg[(size_t)(b * 8 + n) * 1024 + h * 128 + d] * (1.f / 256.f); }
    if (tid < 128) { const int rel = tid; int bucket = rel; if (rel >= 16) { bucket = 16 + (int)(log2f((float)rel * (1.f / 16.f)) * (16.f / 3.f)); bucket = bucket > 31 ? 31 : bucket; }
        tab[tid] = relb[bucket * 8 + h] * LOG2E; }
    bf16x8 qf[2][4];
#pragma unroll
    for (int gi = 0; gi < 2; ++gi) { const bf16* qrow = PROJ + (rowbase + tq0 + 16 * gi) * NPROJ + COL_Q + h * 128 + 8 * g;
#pragma unroll
      for (int ks = 0; ks < 4; ++ks) qf[gi][ks] = *(const GAS bf16x8*)(qrow + 32 * ks); }
    __syncthreads();
    unsigned selmask[2];
    if (own <= 3) { selmask[0] = (1u << own) - 1u; selmask[1] = selmask[0]; }
    else {
#pragma unroll
      for (int gi = 0; gi < 2; ++gi) {
        float gate[7];
#pragma unroll
        for (int n = 0; n < 7; ++n) {
            float s = NEG_INF;
            if (n < own) { s = 0.f;
#pragma unroll
                for (int ks = 0; ks < 4; ++ks) { const LAS f32x4* kp = (const LAS f32x4*)(km + n * 128 + 32 * ks + 8 * g); const f32x4 k0 = kp[0], k1 = kp[1]; const v4u qu = __builtin_bit_cast(v4u, qf[gi][ks]);
                    s += bflo(qu.x) * k0.x + bfhi(qu.x) * k0.y + bflo(qu.y) * k0.z + bfhi(qu.y) * k0.w + bflo(qu.z) * k1.x + bfhi(qu.z) * k1.y + bflo(qu.w) * k1.z + bfhi(qu.w) * k1.w; }
                s += __shfl_xor(s, 16); s += __shfl_xor(s, 32); }
            gate[n] = s;
        }
        unsigned sm = 0u;
#pragma unroll
        for (int r = 0; r < 3; ++r) { float best = NEG_INF; int bi = 0;
#pragma unroll
            for (int n = 0; n < 7; ++n) { const bool cand = (n < own) && !((sm >> n) & 1u) && (gate[n] > best); best = cand ? gate[n] : best; bi = cand ? n : bi; }
            sm |= 1u << bi; }
        selmask[gi] = sm; }
    }
    const int nT = 4 + 4 * own;
    const int sr = tid >> 3, sc = (tid & 7) * 16;
#define A_KEY0(i) ((i) < 4 ? own * 256 + 64 * (i) : (((i) - 4) >> 2) * 256 + (((i) - 4) & 3) * 64)
    v4u kr0, kr1, vr0, vr1;
#define A_LOAD(i) do { const bf16* kp_ = PROJ + (rowbase + A_KEY0(i) + sr) * NPROJ + COL_K + h * 128 + sc; \
        kr0 = *(const GAS v4u*)kp_; kr1 = *(const GAS v4u*)(kp_ + 8); vr0 = *(const GAS v4u*)(kp_ + (COL_V - COL_K)); vr1 = *(const GAS v4u*)(kp_ + (COL_V - COL_K) + 8); } while (0)
#define A_STORE(bufi) do { LAS unsigned char* kd_ = lds + ((bufi) ? A_KB1 : A_KB0) + sr * A_KSTR + sc * 2; LAS unsigned char* vd_ = lds + ((bufi) ? A_VB1 : A_VB0) + sr * A_VSTR + sc * 2; \
        *(LAS v4u*)kd_ = kr0; *(LAS v4u*)(kd_ + 16) = kr1; *(LAS v4u*)vd_ = vr0; *(LAS v4u*)(vd_ + 16) = vr1; } while (0)
    A_LOAD(0); A_STORE(0);
    __syncthreads();
    float m_run[2] = {NEG_INF, NEG_INF}, l_run[2] = {0.f, 0.f};
    f32x4 oacc[2][8];
#pragma unroll
    for (int gi = 0; gi < 2; ++gi)
#pragma unroll
        for (int db = 0; db < 8; ++db) oacc[gi][db] = (f32x4){0.f, 0.f, 0.f, 0.f};
    for (int i = 0; i < nT; ++i) {
        if (i + 1 < nT) A_LOAD(i + 1);
        const int buf = i & 1, key0 = A_KEY0(i); const bool isown = i < 4; const int pblk = isown ? own : ((i - 4) >> 2);
        const bool skipw = isown && (64 * i > 32 * w + 31);
        if (!skipw) {
        LAS unsigned char* Kb = lds + (buf ? A_KB1 : A_KB0); LAS unsigned char* Vb = lds + (buf ? A_VB1 : A_VB0);
        f32x4 sacc[2][4];
#pragma unroll
        for (int hf = 0; hf < 2; ++hf) { bf16x8 kf[8];
#pragma unroll
            for (int n2 = 0; n2 < 2; ++n2)
#pragma unroll
                for (int ks = 0; ks < 4; ++ks) kf[n2 * 4 + ks] = *(const LAS bf16x8*)(Kb + (16 * (2 * hf + n2) + c16) * A_KSTR + (32 * ks + 8 * g) * 2);
            __builtin_amdgcn_sched_barrier(0);
#pragma unroll
            for (int gi = 0; gi < 2; ++gi)
#pragma unroll
                for (int n2 = 0; n2 < 2; ++n2) { f32x4 a = (f32x4){0.f, 0.f, 0.f, 0.f};
#pragma unroll
                    for (int ks = 0; ks < 4; ++ks) a = MFMA16(kf[n2 * 4 + ks], qf[gi][ks], a);
                    sacc[gi][2 * hf + n2] = a; }
            __builtin_amdgcn_sched_barrier(0); }
        const bool far = (key0 + 63 + 128 <= t0 + 32 * w);
        const bool diag = isown && (64 * i + 63 > 32 * w);
        bf16x8 pf[2][2];
#pragma unroll
        for (int gi = 0; gi < 2; ++gi) {
            const int tq = tq0 + 16 * gi; const bool sel = isown || ((selmask[gi] >> pblk) & 1u);
            float sv[16]; float mloc, m_new, alpha;
            if (far) {
                const float bfar = tab[127];
                float mx = fmaxf(fmaxf(sacc[gi][0][0], sacc[gi][0][1]), fmaxf(sacc[gi][0][2], sacc[gi][0][3]));
#pragma unroll
                for (int nb = 1; nb < 4; ++nb) mx = fmaxf(mx, fmaxf(fmaxf(sacc[gi][nb][0], sacc[gi][nb][1]), fmaxf(sacc[gi][nb][2], sacc[gi][nb][3])));
                mloc = sel ? (mx * SCL2 + bfar) : NEG_INF;
                mloc = fmaxf(mloc, __shfl_xor(mloc, 16)); mloc = fmaxf(mloc, __shfl_xor(mloc, 32));
                m_new = fmaxf(m_run[gi], mloc); alpha = __builtin_amdgcn_exp2f(m_run[gi] - m_new);
                const float cadd = sel ? (bfar - m_new) : NEG_INF;
#pragma unroll
                for (int nb = 0; nb < 4; ++nb)
#pragma unroll
                    for (int r = 0; r < 4; ++r) sv[nb * 4 + r] = __builtin_amdgcn_exp2f(sacc[gi][nb][r] * SCL2 + cadd);
            } else {
                const int relb = tq - key0 - 4 * g; float bias[16];
#pragma unroll
                for (int nb = 0; nb < 4; ++nb)
#pragma unroll
                    for (int r = 0; r < 4; ++r) { const int rel = relb - 16 * nb - r; int ri = rel < 0 ? 0 : rel; ri = ri > 127 ? 127 : ri; bias[nb * 4 + r] = tab[ri]; }
                PIN16(bias, 0);
                mloc = NEG_INF;
#pragma unroll
                for (int nb = 0; nb < 4; ++nb)
#pragma unroll
                    for (int r = 0; r < 4; ++r) { const int rel = relb - 16 * nb - r;
                        float s = sacc[gi][nb][r] * SCL2 + bias[nb * 4 + r]; s = (!sel || (diag && rel < 0)) ? NEG_INF : s; sv[nb * 4 + r] = s; mloc = fmaxf(mloc, s); }
                mloc = fmaxf(mloc, __shfl_xor(mloc, 16)); mloc = fmaxf(mloc, __shfl_xor(mloc, 32));
                m_new = fmaxf(m_run[gi], mloc); alpha = __builtin_amdgcn_exp2f(m_run[gi] - m_new);
#pragma unroll
                for (int e = 0; e < 16; ++e) sv[e] = __builtin_amdgcn_exp2f(sv[e] - m_new);
            }
            float psum = 0.f;
#pragma unroll
            for (int e = 0; e < 16; ++e) psum += sv[e];
            l_run[gi] = l_run[gi] * alpha + psum; m_run[gi] = m_new;
#pragma unroll
            for (int db = 0; db < 8; ++db) oacc[gi][db] = oacc[gi][db] * alpha;
            pf[gi][0] = pack8(sv); pf[gi][1] = pack8(sv + 8);
        }
        __builtin_amdgcn_sched_barrier(0);
#pragma unroll
        for (int s = 0; s < 2; ++s) { s16x4 vlo[8], vhi[8];
#pragma unroll
            for (int db = 0; db < 8; ++db) { LAS unsigned char* va = Vb + (32 * s + 4 * g + q4) * A_VSTR + (16 * db + 4 * p4) * 2; vlo[db] = TR16(va); vhi[db] = TR16(va + 16 * A_VSTR); }
            __builtin_amdgcn_sched_barrier(0);
#pragma unroll
            for (int db = 0; db < 8; ++db) { const bf16x8 vf = __builtin_shufflevector(vlo[db], vhi[db], 0, 1, 2, 3, 4, 5, 6, 7);
                oacc[0][db] = MFMA16(vf, pf[0][s], oacc[0][db]); oacc[1][db] = MFMA16(vf, pf[1][s], oacc[1][db]); }
            __builtin_amdgcn_sched_barrier(0); }
        }
        if (i + 1 < nT) A_STORE((i + 1) & 1);
        __syncthreads();
    }
    bf16* const MIXp = F.HN(); float* const ssqp = F.ssq();
#pragma unroll
    for (int gi = 0; gi < 2; ++gi) {
        const int tq = tq0 + 16 * gi;
        float l_tot = l_run[gi]; l_tot += __shfl_xor(l_tot, 16); l_tot += __shfl_xor(l_tot, 32);
        const float inv = 1.f / l_tot; float ssq = 0.f;
        bf16* orow = MIXp + (rowbase + tq) * DM + h * 128 + 4 * g;
#pragma unroll
        for (int db = 0; db < 8; ++db) { const f32x4 o = oacc[gi][db] * inv; ssq += (o.x * o.x + o.y * o.y) + (o.z * o.z + o.w * o.w); v2u wv; wv.x = pk2(o.x, o.y); wv.y = pk2(o.z, o.w); *(GAS v2u*)(orow + 16 * db) = wv; }
        ssq += __shfl_xor(ssq, 16); ssq += __shfl_xor(ssq, 32);
        if (g == 0 && doatom) unsafeAtomicAdd(ssqp + (rowbase + tq) * 4 + 1, ssq);
    }
#undef A_KEY0
#undef A_LOAD
#undef A_STORE
}

constexpr int XBC_W = CONV_CH;
__device__ __forceinline__ void conv_phase(Frame& F) {
    const bf16* const PROJ = F.PROJ(); bf16* const XBC = F.XBC(); const float* const cw = F.conv_w(); const float* const cb = F.conv_b();
    const int gt = blockIdx.x * (NWAVES * 64) + fresh_tid(), GT = F.G * NWAVES * 64;
    for (int task = gt; task < (MTOK / 32) * (CONV_CH / 8); task += GT) {
        const int r = task / (CONV_CH / 8), k = task % (CONV_CH / 8), ch = 8 * k, tok0 = 32 * r;
        float wv[4][8], bias[8];
#pragma unroll
        for (int t = 0; t < 4; ++t) { const f32x4 w0 = *(const GAS f32x4*)(cw + t * CONV_CH + ch), w1 = *(const GAS f32x4*)(cw + t * CONV_CH + ch + 4);
            wv[t][0] = w0.x; wv[t][1] = w0.y; wv[t][2] = w0.z; wv[t][3] = w0.w; wv[t][4] = w1.x; wv[t][5] = w1.y; wv[t][6] = w1.z; wv[t][7] = w1.w; }
        { const f32x4 b0 = *(const GAS f32x4*)(cb + ch), b1 = *(const GAS f32x4*)(cb + ch + 4); bias[0] = b0.x; bias[1] = b0.y; bias[2] = b0.z; bias[3] = b0.w; bias[4] = b1.x; bias[5] = b1.y; bias[6] = b1.z; bias[7] = b1.w; }
        const bf16* src = PROJ + (size_t)tok0 * NPROJ + COL_XBC + ch; bf16* dst = XBC + (size_t)tok0 * XBC_W + ch;
        v4u p0 = (v4u){0u, 0u, 0u, 0u}, p1 = p0, p2 = p0;
        if ((tok0 & (SEQ - 1)) != 0) { p0 = *(const GAS v4u*)(src - 3 * (ptrdiff_t)NPROJ); p1 = *(const GAS v4u*)(src - 2 * (ptrdiff_t)NPROJ); p2 = *(const GAS v4u*)(src - (ptrdiff_t)NPROJ); }
#pragma unroll 1
        for (int i0 = 0; i0 < 32; i0 += 8) {
            v4u cur[8];
#pragma unroll
            for (int i = 0; i < 8; ++i) cur[i] = *(const GAS v4u*)(src + (size_t)(i0 + i) * NPROJ);
#pragma unroll
            for (int i = 0; i < 8; ++i) {
                const v4u c = cur[i]; float acc[8];
                const unsigned a0[4] = {p0.x, p0.y, p0.z, p0.w}, a1[4] = {p1.x, p1.y, p1.z, p1.w}, a2[4] = {p2.x, p2.y, p2.z, p2.w}, a3[4] = {c.x, c.y, c.z, c.w};
#pragma unroll
                for (int j = 0; j < 4; ++j) {
                    acc[2 * j] = bias[2 * j] + wv[0][2 * j] * bflo(a0[j]) + wv[1][2 * j] * bflo(a1[j]) + wv[2][2 * j] * bflo(a2[j]) + wv[3][2 * j] * bflo(a3[j]);
                    acc[2 * j + 1] = bias[2 * j + 1] + wv[0][2 * j + 1] * bfhi(a0[j]) + wv[1][2 * j + 1] * bfhi(a1[j]) + wv[2][2 * j + 1] * bfhi(a2[j]) + wv[3][2 * j + 1] * bfhi(a3[j]); }
#pragma unroll
                for (int j = 0; j < 8; ++j) acc[j] = silu_f(acc[j]);
                v4u o; o.x = pk2(acc[0], acc[1]); o.y = pk2(acc[2], acc[3]); o.z = pk2(acc[4], acc[5]); o.w = pk2(acc[6], acc[7]);
                *(GAS v4u*)(dst + (size_t)(i0 + i) * XBC_W) = o;
                p0 = p1; p1 = p2; p2 = c; }
        }
    }
    { const float* const dtraw = F.dtraw(); float* const dt2 = F.DT2(); const float* const dtb = F.dt_bias();
      for (int i = gt; i < MTOK * 16; i += GT) { const float xr = dtraw[i] + dtb[i & 15]; dt2[i] = xr > 20.f ? xr : log1pf(__expf(xr)); } }
}

constexpr int S_BSTR = 272, S_XSTR = 144;
constexpr int S_BM = 0, S_CM = 128 * S_BSTR, S_X = 2 * 128 * S_BSTR, S_XW = S_X + 128 * S_XSTR, S_HB = S_XW + 128 * S_XSTR, S_DT = S_HB + 64 * S_BSTR, S_CS = S_DT + 512, S_DA = S_CS + 512, S_END = S_DA + 512;
static_assert(S_END <= RING_BYTES, "ssd LDS map");
__device__ __forceinline__ void ssd_unit(Frame& F, int b, int h, const bool doatom = true) {
    LAS unsigned char* lds = F.lds + RING_OFF;
    const int tid = fresh_tid(), lane = tid & 63, w = __builtin_amdgcn_readfirstlane(tid >> 6), g = lane >> 4, c16 = lane & 15, q4 = c16 >> 2, p4 = lane & 3;
    const int g8 = h >> 3, pbw = w & 3, nhw = w >> 2;
    const float a_h = -__expf(F.a_log()[h]), dsk = F.d_skip()[h];
    const bf16* const PROJ = F.PROJ(); bf16* const MIX = F.HN(); const float* const dt2 = F.DT2(); const bf16* const XBC = F.XBC(); float* const ssqp = F.ssq();
    LAS float* dtl = (LAS float*)(lds + S_DT); LAS float* csl = (LAS float*)(lds + S_CS); LAS float* dal = (LAS float*)(lds + S_DA);
    for (int i = tid; i < 64 * S_BSTR / 16; i += NWAVES * 64) ((LAS v4u*)(lds + S_HB))[i] = (v4u){0u, 0u, 0u, 0u};
    f32x4 hacc[4];
#pragma unroll
    for (int i = 0; i < 4; ++i) hacc[i] = (f32x4){0.f, 0.f, 0.f, 0.f};
    const int xl = tid >> 3, xc = tid & 7, bl = tid >> 4, bc = tid & 15;
    v4u xr[2], br[4], cr[4]; float dtv = 0.f;
#define S_PREFETCH(cc) do { const size_t t0_ = (size_t)b * SEQ + (size_t)(cc) * SSM_L; \
        _Pragma("unroll") for (int i_ = 0; i_ < 2; ++i_) xr[i_] = *(const GAS v4u*)(XBC + (t0_ + xl + 64 * i_) * XBC_W + h * 64 + 8 * xc); \
        _Pragma("unroll") for (int i_ = 0; i_ < 4; ++i_) { const bf16* p_ = XBC + (t0_ + bl + 32 * i_) * XBC_W + 1024 + g8 * 128 + 8 * bc; br[i_] = *(const GAS v4u*)p_; cr[i_] = *(const GAS v4u*)(p_ + 256); } \
        if (tid < 128) dtv = dt2[(t0_ + tid) * 16 + h]; } while (0)
    S_PREFETCH(0);
    for (int c = 0; c < SSM_NC; ++c) {
        const size_t tok0 = (size_t)b * SEQ + (size_t)c * SSM_L;
        if (tid < 128) { dtl[tid] = dtv; dal[tid] = dtv * a_h; }
        __syncthreads();
        if (w == 0) { const float v0 = dal[2 * lane], v1 = dal[2 * lane + 1]; float s = v0 + v1;
#pragma unroll
            for (int o = 1; o < 64; o <<= 1) { const float t = __shfl_up(s, o); s += (lane >= o) ? t : 0.f; }
            csl[2 * lane] = s - v1; csl[2 * lane + 1] = s; }
        __syncthreads();
        const float cs_last = csl[127];
#pragma unroll
        for (int i = 0; i < 2; ++i) { const int l = xl + 64 * i; const v4u v = xr[i]; *(LAS v4u*)(lds + S_X + l * S_XSTR + xc * 16) = v; const float wl = dtl[l] * __expf(cs_last - csl[l]);
            v4u o2; o2.x = pk2(bflo(v.x) * wl, bfhi(v.x) * wl); o2.y = pk2(bflo(v.y) * wl, bfhi(v.y) * wl); o2.z = pk2(bflo(v.z) * wl, bfhi(v.z) * wl); o2.w = pk2(bflo(v.w) * wl, bfhi(v.w) * wl);
            *(LAS v4u*)(lds + S_XW + l * S_XSTR + xc * 16) = o2; }
#pragma unroll
        for (int i = 0; i < 4; ++i) { const int l = bl + 32 * i; *(LAS v4u*)(lds + S_BM + l * S_BSTR + bc * 16) = br[i]; *(LAS v4u*)(lds + S_CM + l * S_BSTR + bc * 16) = cr[i]; }
        const int lrow = 16 * w + c16;
        v2u zr[4];
#pragma unroll
        for (int pb = 0; pb < 4; ++pb) zr[pb] = *(const GAS v2u*)(PROJ + (tok0 + lrow) * NPROJ + COL_Z + h * 64 + 16 * pb + 4 * g);
        if (c + 1 < SSM_NC) S_PREFETCH(c + 1);
        __syncthreads();
        bf16x8 cf[4];
#pragma unroll
        for (int ks = 0; ks < 4; ++ks) cf[ks] = *(const LAS bf16x8*)(lds + S_CM + lrow * S_BSTR + (32 * ks + 8 * g) * 2);
        f32x4 yacc[4];
        const float cs_l = csl[lrow]; const float el = __expf(cs_l);
#pragma unroll
        for (int pb = 0; pb < 4; ++pb) { yacc[pb] = (f32x4){0.f, 0.f, 0.f, 0.f};
#pragma unroll
            for (int ks = 0; ks < 4; ++ks) { const bf16x8 hf = *(const LAS bf16x8*)(lds + S_HB + (16 * pb + c16) * S_BSTR + (32 * ks + 8 * g) * 2); yacc[pb] = MFMA16(hf, cf[ks], yacc[pb]); }
            yacc[pb] = yacc[pb] * el; }
        for (int s2 = 0; s2 <= (w >> 1); ++s2) {
            const int sb0 = 2 * s2, sb1 = 2 * s2 + 1; const bool has1 = sb1 <= w;
            f32x4 cb0 = (f32x4){0.f, 0.f, 0.f, 0.f}, cb1 = (f32x4){0.f, 0.f, 0.f, 0.f};
#pragma unroll
            for (int ks = 0; ks < 4; ++ks) { const bf16x8 bf0 = *(const LAS bf16x8*)(lds + S_BM + (16 * sb0 + c16) * S_BSTR + (32 * ks + 8 * g) * 2); cb0 = MFMA16(bf0, cf[ks], cb0); }
            if (has1) {
#pragma unroll
                for (int ks = 0; ks < 4; ++ks) { const bf16x8 bf1 = *(const LAS bf16x8*)(lds + S_BM + (16 * sb1 + c16) * S_BSTR + (32 * ks + 8 * g) * 2); cb1 = MFMA16(bf1, cf[ks], cb1); } }
            float mv[8];
#pragma unroll
            for (int r = 0; r < 4; ++r) { const int s = 16 * sb0 + 4 * g + r; const float e = __expf(fminf(cs_l - csl[s], 0.f)) * dtl[s]; mv[r] = (s <= lrow) ? cb0[r] * e : 0.f; }
#pragma unroll
            for (int r = 0; r < 4; ++r) { const int s = 16 * sb1 + 4 * g + r; const int sc_ = s > 127 ? 127 : s; const float e = __expf(fminf(cs_l - csl[sc_], 0.f)) * dtl[sc_]; mv[4 + r] = (has1 && s <= lrow) ? cb1[r] * e : 0.f; }
            const bf16x8 pf = pack8(mv);
#pragma unroll
            for (int pb = 0; pb < 4; ++pb) { LAS unsigned char* xa = lds + S_X + (32 * s2 + 4 * g + q4) * S_XSTR + (16 * pb + 4 * p4) * 2;
                const s16x4 lo = TR16(xa), hi = TR16(xa + 16 * S_XSTR); const bf16x8 xf = __builtin_shufflevector(lo, hi, 0, 1, 2, 3, 4, 5, 6, 7);
                yacc[pb] = MFMA16(xf, pf, yacc[pb]); }
        }
        { const size_t tok = tok0 + lrow; float ssq = 0.f;
#pragma unroll
          for (int pb = 0; pb < 4; ++pb) { const int p0 = 16 * pb + 4 * g;
              const v2u xs_ = *(const LAS v2u*)(lds + S_X + lrow * S_XSTR + p0 * 2);
              const v2u zr_ = zr[pb];
              const float o0 = (yacc[pb].x + bflo(xs_.x) * dsk) * silu_f(bflo(zr_.x)), o1 = (yacc[pb].y + bfhi(xs_.x) * dsk) * silu_f(bfhi(zr_.x));
              const float o2 = (yacc[pb].z + bflo(xs_.y) * dsk) * silu_f(bflo(zr_.y)), o3 = (yacc[pb].w + bfhi(xs_.y) * dsk) * silu_f(bfhi(zr_.y));
              ssq += (o0 * o0 + o1 * o1) + (o2 * o2 + o3 * o3);
              v2u wv; wv.x = pk2(o0, o1); wv.y = pk2(o2, o3); *(GAS v2u*)(MIX + tok * DM + ATT_W + h * 64 + p0) = wv; }
          ssq += __shfl_xor(ssq, 16); ssq += __shfl_xor(ssq, 32);
          if (g == 0 && doatom) unsafeAtomicAdd(ssqp + tok * 4 + 2 + g8, ssq); }
        { const float cdec = __expf(cs_last);
#pragma unroll
          for (int i = 0; i < 4; ++i) hacc[i] = hacc[i] * cdec;
#pragma unroll
          for (int ks = 0; ks < 4; ++ks) {
              LAS unsigned char* xa = lds + S_XW + (32 * ks + 8 * g + q4) * S_XSTR + (16 * pbw + 4 * p4) * 2;
              const s16x4 xlo = TR16(xa), xhi = TR16(xa + 4 * S_XSTR); const bf16x8 xf = __builtin_shufflevector(xlo, xhi, 0, 1, 2, 3, 4, 5, 6, 7);
#pragma unroll
              for (int i = 0; i < 4; ++i) { const int nb = 4 * nhw + i; LAS unsigned char* ba = lds + S_BM + (32 * ks + 8 * g + q4) * S_BSTR + (16 * nb + 4 * p4) * 2;
                  const s16x4 blo = TR16(ba), bhi = TR16(ba + 4 * S_BSTR); const bf16x8 bfr = __builtin_shufflevector(blo, bhi, 0, 1, 2, 3, 4, 5, 6, 7);
                  hacc[i] = MFMA16(bfr, xf, hacc[i]); } } }
        __syncthreads();
#pragma unroll
        for (int i = 0; i < 4; ++i) { const int nb = 4 * nhw + i; v2u o; o.x = pk2(hacc[i].x, hacc[i].y); o.y = pk2(hacc[i].z, hacc[i].w);
            *(LAS v2u*)(lds + S_HB + (16 * pbw + c16) * S_BSTR + (16 * nb + 4 * g) * 2) = o; }
    }
#undef S_PREFETCH
    __syncthreads();
}

__device__ __forceinline__ void mix_normalize(Frame& F) {
    const int tid_ = fresh_tid(), lane = tid_ & 63; const int gw = blockIdx.x * NWAVES + __builtin_amdgcn_readfirstlane(tid_ >> 6), NGW = F.G * NWAVES;
    const float* const ssqp = F.ssq(); bf16* const MIX = F.HN(); const float* const gatt = F.attn_out_norm(); const float* const gssm = F.ssm_out_norm();
    for (int m = gw; m < MTOK; m += NGW) {
        const float* sq = ssqp + (size_t)m * 4;
        const float s1 = __hip_atomic_load(sq + 1, RLX_AGENT), s2 = __hip_atomic_load(sq + 2, RLX_AGENT), s3 = __hip_atomic_load(sq + 3, RLX_AGENT);
        const float ra = 1.f / sqrtf(s1 * (1.f / 1024.f) + EPS), r0 = 1.f / sqrtf(s2 * (1.f / 512.f) + EPS), r1 = 1.f / sqrtf(s3 * (1.f / 512.f) + EPS);
        GAS v4u* row = (GAS v4u*)(MIX + (size_t)m * DM);
#pragma unroll
        for (int j = 0; j < 4; ++j) { const int idx = lane + 64 * j, col = 8 * idx; const float rs = (j < 2) ? ra : ((j == 2) ? r0 : r1);
            const float* gp = (j < 2) ? (gatt + col) : (gssm + (col - ATT_W));
            const f32x4 g0 = *(const GAS f32x4*)gp, g1 = *(const GAS f32x4*)(gp + 4); const v4u v = row[idx]; v4u o;
            o.x = pk2(bflo(v.x) * rs * g0.x, bfhi(v.x) * rs * g0.y); o.y = pk2(bflo(v.y) * rs * g0.z, bfhi(v.y) * rs * g0.w);
            o.z = pk2(bflo(v.z) * rs * g1.x, bfhi(v.z) * rs * g1.y); o.w = pk2(bflo(v.w) * rs * g1.z, bfhi(v.w) * rs * g1.w); row[idx] = o; }
    }
}

constexpr int P_EIDX = 0, P_GATE = 16384, P_LST = 32768, P_HN = 65536, P_ACT = 98304, P_END = 102400;
static_assert(P_END <= RING_BYTES, "peer LDS map");
__constant__ unsigned char PEER_CAND[52] = {0, 1, 2, 3, 4, 5, 6, 7, 8, 9, 10, 11, 12, 13, 14, 15, 16, 17, 18, 19, 20, 21, 22, 23, 32, 33, 34, 35, 36, 48, 49, 50, 51, 64, 65, 66, 80, 81, 96, 97, 112, 113, 128, 144, 160, 176, 192, 208, 224, 240, 255, 255};
__device__ __forceinline__ unsigned f2ord(float f) { const unsigned u = __builtin_bit_cast(unsigned, f); return u ^ ((u >> 31) ? 0xFFFFFFFFu : 0x80000000u); }
__device__ __forceinline__ float ord2f(unsigned u) { return __builtin_bit_cast(float, u ^ ((u >> 31) ? 0x80000000u : 0xFFFFFFFFu)); }
#define CSWAPD(a, b) do { const unsigned hi_ = (a) > (b) ? (a) : (b), lo_ = (a) > (b) ? (b) : (a); (a) = hi_; (b) = lo_; } while (0)
template <int N> __device__ __forceinline__ void bitonic_sort_desc(unsigned (&v)[N]) {
#pragma unroll
    for (int k = 2; k <= N; k <<= 1)
#pragma unroll
        for (int j = k >> 1; j > 0; j >>= 1)
#pragma unroll
            for (int i = 0; i < N; ++i) { const int l = i ^ j; if (l > i) { if ((i & k) == 0) CSWAPD(v[i], v[l]); else CSWAPD(v[l], v[i]); } }
}
__device__ __forceinline__ void merge16_xor(unsigned (&v)[16], int dist) {
    unsigned o[16];
#pragma unroll
    for (int i = 0; i < 16; ++i) o[i] = (unsigned)__shfl_xor((int)v[i], dist);
#pragma unroll
    for (int i = 0; i < 16; ++i) v[i] = v[i] > o[15 - i] ? v[i] : o[15 - i];
#pragma unroll
    for (int j = 8; j > 0; j >>= 1)
#pragma unroll
        for (int i = 0; i < 16; ++i) { const int l = i ^ j; if (l > i) CSWAPD(v[i], v[l]); }
}
__device__ __forceinline__ float gelu_erf(float x) { return 0.5f * x * (1.f + erff(x * 0.70710678118654752f)); }
__device__ __forceinline__ float fp4_dec1(unsigned n) { const unsigned m = n & 7u; unsigned bits = (m >= 2u) ? (((126u + (m >> 1)) << 23) | ((m & 1u) << 22)) : (m ? 0x3F000000u : 0u); bits |= (n & 8u) << 28; return __builtin_bit_cast(float, bits); }
__device__ __forceinline__ f32x2 fp4_dec2(unsigned x) { f32x2 r; r.x = fp4_dec1(x & 15u); r.y = fp4_dec1((x >> 4) & 15u); return r; }
typedef long i64;
typedef int v8i __attribute__((ext_vector_type(8)));
__device__ __forceinline__ void peer_unit(Frame& F, int u, const bool dry = false) {
    LAS unsigned char* lds = F.lds + RING_OFF;
    const int tid_ = fresh_tid(), lane = tid_ & 63, w = __builtin_amdgcn_readfirstlane(tid_ >> 6), g = lane >> 4, c16 = lane & 15;
    const int T0 = 32 * u;
    LAS int* eidx = (LAS int*)(lds + P_EIDX); LAS float* gate = (LAS float*)(lds + P_GATE);
    LAS unsigned* lst = (LAS unsigned*)(lds + P_LST) + w * 1024;
    const bf16* const QP = F.QP(); const bf16* const SK = F.SK(); float* const outp = F.out(); const bf16* const X1B = F.X1B(); const float* const fgain = F.ffn_norm(); const float* const fing = F.final_norm(); const unsigned char* const U8 = F.U8(); const unsigned char* const V8 = F.V8();
#ifndef NO_ROUTE
    for (int tb = 0; tb < 2; ++tb) {
        for (int c = 0; c < 2; ++c) {
            const int p = 2 * w + c;
            bf16x8 qf[4];
            { const unsigned qo = ((unsigned)(T0 + 16 * tb + c16) * (unsigned)DM + (unsigned)(p * 128 + 8 * g)) * 2u;
#pragma unroll
              for (int ks = 0; ks < 4; ++ks) qf[ks] = __builtin_nontemporal_load((const GAS bf16x8*)((const unsigned char*)QP + (qo + 64u * ks))); }
            unsigned key[32];
#pragma unroll
            for (int kb = 0; kb < 8; ++kb) { f32x4 acc = (f32x4){0.f, 0.f, 0.f, 0.f};
                const unsigned so = ((unsigned)(p * 128 + 16 * kb + c16) * 128u + 8u * (unsigned)g) * 2u;
#pragma unroll
                for (int ks = 0; ks < 4; ++ks) { const bf16x8 sf = *(const GAS bf16x8*)((const unsigned char*)SK + (so + 64u * ks)); acc = MFMA16(sf, qf[ks], acc); }
#pragma unroll
                for (int r = 0; r < 4; ++r) key[kb * 4 + r] = (f2ord(acc[r]) & ~0x7Fu) | (unsigned)(16 * kb + 4 * g + r);
                __builtin_amdgcn_sched_barrier(0); }
            bitonic_sort_desc<32>(key);
            unsigned top[16];
#pragma unroll
            for (int i = 0; i < 16; ++i) top[i] = key[i];
            merge16_xor(top, 16); merge16_xor(top, 32);
            if (g == 0) { LAS v4u* d = (LAS v4u*)(lst + (c * 32 + 16 * tb + c16) * 16);
                d[0] = (v4u){top[0], top[1], top[2], top[3]}; d[1] = (v4u){top[4], top[5], top[6], top[7]}; d[2] = (v4u){top[8], top[9], top[10], top[11]}; d[3] = (v4u){top[12], top[13], top[14], top[15]}; }
        }
        LDS_WAIT();
        const LAS unsigned* l1 = lst + (16 * tb + c16) * 16; const LAS unsigned* l2 = lst + (32 + 16 * tb + c16) * 16;
        unsigned ck[16];
#pragma unroll
        for (int k = 0; k < 13; ++k) { const unsigned ab = PEER_CAND[4 * k + g]; const unsigned a = ab >> 4, bq = ab & 15u;
            const float s = ord2f(l1[a] & ~0x7Fu) + ord2f(l2[bq] & ~0x7Fu); ck[k] = (ab == 255u) ? 0u : ((f2ord(s) & ~0xFFu) | ab); }
        ck[13] = 0u; ck[14] = 0u; ck[15] = 0u;
        bitonic_sort_desc<16>(ck);
        merge16_xor(ck, 16); merge16_xor(ck, 32);
        if (g == 0) { const int tl = 16 * tb + c16; const float m = ord2f(ck[0] & ~0xFFu); float e[16]; float sum = 0.f;
#pragma unroll
            for (int k = 0; k < 16; ++k) { e[k] = __expf(ord2f(ck[k] & ~0xFFu) - m); sum += e[k]; }
            const float inv = 1.f / sum;
#pragma unroll
            for (int k = 0; k < 16; ++k) { const unsigned a = (ck[k] >> 4) & 15u, bq = ck[k] & 15u; const int ex = (int)((l1[a] & 0x7Fu) * 128u + (l2[bq] & 0x7Fu));
                eidx[tl * 128 + w * 16 + k] = ex; gate[tl * 128 + w * 16 + k] = e[k] * inv; } }
    }
#endif
    __syncthreads();
    LAS unsigned char* hnb = lds + P_HN + w * 4096; LAS float* actl = (LAS float*)(lds + P_ACT) + w * 128;
    const LAS unsigned char* hb = hnb + 16 * g + ((c16 == 1) ? 1024 : 0);
    v4u bA[8], bB[8];
#define U_ISSUE(buf, e_, jb) do { const unsigned uo_ = (unsigned)(e_) * (unsigned)ROWB + 16u * (unsigned)g + 512u * (unsigned)(jb); \
        _Pragma("unroll") for (int jj = 0; jj < 8; ++jj) buf[jj] = *(const GAS v4u*)(U8 + (uo_ + 64u * jj)); __builtin_amdgcn_sched_barrier(0); } while (0)
#define U_CONSUME(buf, jb) do { v4u bq_[8]; _Pragma("unroll") for (int jj = 0; jj < 8; ++jj) bq_[jj] = *(const LAS v4u*)(hb + 64 * (8 * (jb) + jj)); \
        __builtin_amdgcn_sched_barrier(0); \
        _Pragma("unroll") for (int jj = 0; jj < 8; ++jj) { const v4u a_ = buf[jj]; \
            const v8i av_ = {(int)a_.x, (int)a_.y, (int)a_.z, (int)a_.w, 0, 0, 0, 0}; const v8i bv_ = {(int)bq_[jj].x, (int)bq_[jj].y, (int)bq_[jj].z, (int)bq_[jj].w, 0, 0, 0, 0}; \
            acc = __builtin_amdgcn_mfma_scale_f32_16x16x128_f8f6f4(av_, bv_, acc, 4, 4, 0, 0x7f7f7f7f, 0, 0x7f7f7f7f); } __builtin_amdgcn_sched_barrier(0); } while (0)
#define U_ACT(grp_) do { const float l0_ = __shfl_down(acc.x, 1), l1_ = __shfl_down(acc.y, 1), l2_ = __shfl_down(acc.z, 1), l3_ = __shfl_down(acc.w, 1); \
        if (c16 == 0) { const int k0 = 16 * (grp_) + 4 * g; constexpr float isc = 1.f / (SU * SH4), ilo = 1.f / SLO4; const f32x4 gt = *(const LAS f32x4*)(gate + tl * 128 + k0); \
        f32x4 a4; a4.x = gelu_erf((acc.x + l0_ * ilo) * isc) * gt.x; a4.y = gelu_erf((acc.y + l1_ * ilo) * isc) * gt.y; a4.z = gelu_erf((acc.z + l2_ * ilo) * isc) * gt.z; a4.w = gelu_erf((acc.w + l3_ * ilo) * isc) * gt.w; *(LAS f32x4*)(actl + k0) = a4; } } while (0)
#define V_ISSUE(buf, kb_) do { _Pragma("unroll") for (int kk = 0; kk < 8; ++kk) { const int e_ = eidx[tl * 128 + 8 * (kb_) + kk]; const unsigned vo_ = (unsigned)e_ * (unsigned)ROWB + 16u * (unsigned)lane; \
        buf[kk] = *(const GAS v4u*)(V8 + vo_); } __builtin_amdgcn_sched_barrier(0); } while (0)
#ifdef FP4_SOFT_DEC
#define FP4_DEC(x) fp4_dec2(x)
#else
#define FP4_DEC(x) __builtin_amdgcn_cvt_scalef32_pk_f32_fp4((x), 1.0f, 0)
#endif
#ifdef FP4_SWAP_DEC
#define FP4_ACC(oa, ob, d) do { oa += a_ * d.y; ob += a_ * d.x; } while (0)
#else
#define FP4_ACC(oa, ob, d) do { oa += a_ * d.x; ob += a_ * d.y; } while (0)
#endif
#define PIN8x2(a, i) asm volatile("" : "+v"(a[i]), "+v"(a[i + 1]), "+v"(a[i + 2]), "+v"(a[i + 3]), "+v"(a[i + 4]), "+v"(a[i + 5]), "+v"(a[i + 6]), "+v"(a[i + 7]))
#define V_CONSUME(buf, kb_) do { _Pragma("unroll") for (int kk = 0; kk < 8; ++kk) { const float as_ = actl[8 * (kb_) + kk]; const f32x2 a2_ = {as_, as_}; \
        const unsigned vw[4] = {buf[kk].x, buf[kk].y, buf[kk].z, buf[kk].w}; \
        _Pragma("unroll") for (int q = 0; q < 4; ++q) { \
            o2[4 * q]     = __builtin_elementwise_fma(__builtin_amdgcn_cvt_scalef32_pk_f32_fp4(vw[q], 1.0f, 0), a2_, o2[4 * q]); \
            o2[4 * q + 1] = __builtin_elementwise_fma(__builtin_amdgcn_cvt_scalef32_pk_f32_fp4(vw[q], 1.0f, 1), a2_, o2[4 * q + 1]); \
            o2[4 * q + 2] = __builtin_elementwise_fma(__builtin_amdgcn_cvt_scalef32_pk_f32_fp4(vw[q], 1.0f, 2), a2_, o2[4 * q + 2]); \
            o2[4 * q + 3] = __builtin_elementwise_fma(__builtin_amdgcn_cvt_scalef32_pk_f32_fp4(vw[q], 1.0f, 3), a2_, o2[4 * q + 3]); } \
        PIN8x2(o2, 0); PIN8x2(o2, 8); } } while (0)
#ifndef NO_GATHER
    int e_cur = eidx[w * 128 + c16];
    v2u xn[8];
#define X_ISSUE(tok_) do { const unsigned xb_ = (unsigned)(tok_) * (unsigned)(DM * 2) + 8u * (unsigned)lane; _Pragma("unroll") for (int j = 0; j < 8; ++j) xn[j] = __builtin_nontemporal_load((const GAS v2u*)((const unsigned char*)X1B + (xb_ + 512u * j))); } while (0)
    X_ISSUE(T0 + w);
    U_ISSUE(bA, e_cur, 0);
    for (int ti = 0; ti < 4; ++ti) {
        const int tl = w + 8 * ti; const size_t token = (size_t)T0 + tl;
        f32x4 xr[8]; float ss = 0.f;
        const unsigned xo = (unsigned)token * (unsigned)(DM * 4) + 16u * (unsigned)lane;
        {
#pragma unroll
          for (int j = 0; j < 8; ++j) { const v2u r = xn[j]; xr[j] = (f32x4){bflo(r.x), bfhi(r.x), bflo(r.y), bfhi(r.y)}; }
#pragma unroll
          for (int j = 0; j < 8; ++j) ss += (xr[j].x * xr[j].x + xr[j].y * xr[j].y) + (xr[j].z * xr[j].z + xr[j].w * xr[j].w); }
        const float rs2 = __builtin_amdgcn_rsqf(wave_sum(ss) * (1.f / DM) + EPS);
        {
          const float* fg_ = fgain; asm volatile("" : "+s"(fg_));
          const unsigned char* gp = (const unsigned char*)fg_; const unsigned go = 16u * (unsigned)lane;
          unsigned hw[4], lw[4];
#pragma unroll
          for (int q = 0; q < 4; ++q) { unsigned wh = 0u, wl = 0u;
#pragma unroll
              for (int t = 0; t < 2; ++t) { const int j = 2 * q + t; const f32x4 gg = *(const GAS f32x4*)(gp + (go + 1024u * j)); const f32x4 hv = xr[j] * gg * (rs2 * SH4);
                  const float h0 = clampf(hv.x, 6.f), h1 = clampf(hv.y, 6.f), h2 = clampf(hv.z, 6.f), h3 = clampf(hv.w, 6.f);
                  const unsigned p0 = __builtin_amdgcn_cvt_scalef32_pk_fp4_f32(0u, h0, h1, 1.0f, 0), p1 = __builtin_amdgcn_cvt_scalef32_pk_fp4_f32(0u, h2, h3, 1.0f, 0);
                  const f32x2 d0 = __builtin_amdgcn_cvt_scalef32_pk_f32_fp4(p0, 1.0f, 0), d1 = __builtin_amdgcn_cvt_scalef32_pk_f32_fp4(p1, 1.0f, 0);
                  const unsigned r0 = __builtin_amdgcn_cvt_scalef32_pk_fp4_f32(0u, clampf((h0 - d0.x) * SLO4, 6.f), clampf((h1 - d0.y) * SLO4, 6.f), 1.0f, 0), r1 = __builtin_amdgcn_cvt_scalef32_pk_fp4_f32(0u, clampf((h2 - d1.x) * SLO4, 6.f), clampf((h3 - d1.y) * SLO4, 6.f), 1.0f, 0);
                  wh |= ((p0 & 0xFFu) | ((p1 & 0xFFu) << 8)) << (16 * t); wl |= ((r0 & 0xFFu) | ((r1 & 0xFFu) << 8)) << (16 * t); }
              hw[q] = wh; lw[q] = wl; }
          *(LAS v4u*)(hnb + 16 * lane) = (v4u){hw[0], hw[1], hw[2], hw[3]}; *(LAS v4u*)(hnb + 1024 + 16 * lane) = (v4u){lw[0], lw[1], lw[2], lw[3]}; }
        LDS_WAIT();
#pragma unroll 1
        for (int grp = 0; grp < 8; ++grp) {
            const int gn = grp < 7 ? grp + 1 : 7;
            const int e_nxt = eidx[tl * 128 + 16 * gn + c16];
            f32x4 acc = (f32x4){0.f, 0.f, 0.f, 0.f};
            U_ISSUE(bB, e_cur, 1); U_CONSUME(bA, 0);
            if (grp < 7) U_ISSUE(bA, e_nxt, 0); else V_ISSUE(bA, 0);
            U_CONSUME(bB, 1);
            U_ACT(grp);
            e_cur = e_nxt;
        }
        LDS_WAIT();
        f32x2 o2[16];
#pragma unroll
        for (int i = 0; i < 16; ++i) o2[i] = (f32x2){0.f, 0.f};
#pragma unroll 1
        for (int kb = 0; kb < 16; kb += 2) {
            V_ISSUE(bB, kb + 1); V_CONSUME(bA, kb);
            if (kb + 2 < 16) V_ISSUE(bA, kb + 2);
            else if (ti < 3) { e_cur = eidx[(tl + 8) * 128 + c16]; X_ISSUE(token + 8); U_ISSUE(bA, e_cur, 0); }
            V_CONSUME(bB, kb + 1);
        }
        { constexpr float isv = 1.f / SV; float s2 = 0.f;
#pragma unroll
          for (int j = 0; j < 8; ++j) { xr[j] = xr[j] + (f32x4){o2[2 * j].x, o2[2 * j].y, o2[2 * j + 1].x, o2[2 * j + 1].y} * isv;
              s2 += (xr[j].x * xr[j].x + xr[j].y * xr[j].y) + (xr[j].z * xr[j].z + xr[j].w * xr[j].w); }
          const float rf = __builtin_amdgcn_rsqf(wave_sum(s2) * (1.f / DM) + EPS);
          const float* fi_ = fing; asm volatile("" : "+s"(fi_));
          const unsigned char* fp = (const unsigned char*)fi_; unsigned char* op = (unsigned char*)outp; const unsigned fo = 16u * (unsigned)lane;
          if (!dry || rf == 1.2345e30f)
#pragma unroll
          for (int j = 0; j < 8; ++j) __builtin_nontemporal_store(xr[j] * rf * *(const GAS f32x4*)(fp + (fo + 1024u * j)), (GAS f32x4*)(op + (xo + 1024u * j))); }
    }
#endif
#undef U_ISSUE
#undef X_ISSUE
#undef U_ACT
#undef U_CONSUME
#undef V_ISSUE
#undef V_CONSUME
    __syncthreads();
}

__global__ void __launch_bounds__(NWAVES * 64, 2) hybrid_fwd(Args args) {
    extern __shared__ __attribute__((aligned(16))) unsigned char lds[];
    Frame F;
    F.lds = (LAS unsigned char*)lds;
    F.MISC = (volatile LAS unsigned*)(F.lds + MISC_OFF);
    F.tid = threadIdx.x; F.lane = F.tid & 63; F.wave = __builtin_amdgcn_readfirstlane(F.tid >> 6); F.G = gridDim.x;
    for (int u = F.tid; u < (LDS_BYTES - LDSCTL_OFF) / 4; u += NWAVES * 64) ((LAS unsigned*)(F.lds + LDSCTL_OFF))[u] = 0u;
    __syncthreads();
    (void)args;
    XcdBarrier bar = xcd_barrier_post(F.ctl() + CW_BAR, F.MISC + 8);

#ifndef NO_P0
#ifdef PROBE_P0X2
    { int reps = 2; asm volatile("" : "+s"(reps)); for (int rep = 0; rep < reps; ++rep) p0_prologue(F); }
#else
    p0_prologue(F);
#endif
#endif
    xcd_barrier(bar);
#ifndef NO_P1
#ifdef PROBE_GX2
    { int reps = 2; asm volatile("" : "+s"(reps)); for (int rep = 0; rep < reps; ++rep) {
#else
    { { const int rep = 0, reps = 1;
#endif
      pg8::Gemm gm{F.HN(), F.WinT(), MTOK, NPAD, DM}; pg8::StaticOrder S; S.init(MTOK, NPAD, F.G, (int)blockIdx.x);
      EpiProj E{F.PROJ(), F.dtraw(), (rep + 1 < reps) ? nullptr : F.kmean()};
      pg8::gemm_phase<EpiProj, pg8::StaticOrder, PG8_ALIGN, PG8_SP2>(F.lds + RING_OFF, gm, S, E); } }
    { const int nun = (MTOK / 256) * (NPAD / 256), rem = nun % F.G;
      if (rem && (int)blockIdx.x >= rem) tables_convert(F, tab_split(F.G), TAB_ITEMS, (size_t)((int)blockIdx.x - rem) * (NWAVES * 64) + fresh_tid(), (size_t)(F.G - rem) * (NWAVES * 64)); }
#endif
    xcd_barrier(bar);
#ifdef PROBE_P15X2
    conv_phase(F);
#endif
    conv_phase(F);
    xcd_barrier(bar);
#ifdef PROBE_P2X2
    { int reps = 2; asm volatile("" : "+s"(reps)); for (int rep = 0; rep < reps; ++rep) {
#else
    { { const int rep = 0, reps = 1;
#endif
    const bool doatom = rep + 1 == reps;
    for (;;) {
        if (F.tid == 0) F.MISC[0] = xb_add(F.ctl() + CW_Q2 + 64 * rep, 1u);
        __syncthreads();
        const int ui = (int)F.MISC[0];
        __syncthreads();
        if (ui >= 128 + 512) break;
#ifdef PROBE_P2_SSD
        if (ui < 128 || doatom)
#endif
#ifdef PROBE_P2_ATT
        if (ui >= 128 || doatom)
#endif
        {
        if (ui < 128) ssd_unit(F, ui >> 4, ui & 15, doatom);
        else { const int a = ui - 128; attn_unit(F, (a & 63) >> 3, a & 7, 7 - (a >> 6), doatom); }
        }
    } } }
    xcd_barrier(bar);
#ifndef NO_P3
#ifdef PROBE_GX2
    { int reps = 2; asm volatile("" : "+s"(reps)); for (int rep = 0; rep < reps; ++rep) {
#else
    { { const int rep = 0, reps = 1;
#endif
      pg8::Gemm gm{F.HN(), F.WoutT(), MTOK, DM, DM}; pg8::StaticOrder S; S.init(MTOK, DM, F.G, (int)blockIdx.x);
      {
        const int t_ = fresh_tid(); const float* const sq = F.ssq();
#pragma unroll 1
        for (int ii = t_ >> 8; ii < 3; ii += 2) { pg8::Unit uu;
          if (S.next(ii, uu)) { const int row = uu.pm * 256 + (t_ & 255);
            const float q1 = __hip_atomic_load(sq + (size_t)row * 4 + 1, RLX_AGENT), q2 = __hip_atomic_load(sq + (size_t)row * 4 + 2, RLX_AGENT), q3 = __hip_atomic_load(sq + (size_t)row * 4 + 3, RLX_AGENT);
            const float sa = __builtin_amdgcn_rsqf(q1 * (1.f / 1024.f) + EPS), s0 = __builtin_amdgcn_rsqf(q2 * (1.f / 512.f) + EPS), s1 = __builtin_amdgcn_rsqf(q3 * (1.f / 512.f) + EPS);
            *(LAS f32x4*)(F.lds + SEGTAB_OFF + (ii * 256 + (t_ & 255)) * 16) = (f32x4){sa / s0, s0 / s1, s1, 0.f}; } }
        __syncthreads(); }
      EpiOut E{F.x(), F.X1B(), F.X18(), F.ssq(), rep + 1 == reps, (const LAS f32x4*)(F.lds + SEGTAB_OFF)};
      pg8::gemm_phase<EpiOut, pg8::StaticOrder, PG8_ALIGN, PG8_SP2>(F.lds + RING_OFF, gm, S, E); } }
#endif
    xcd_barrier(bar);
#ifndef NO_P4
#ifdef PROBE_GX2
    { int reps = 2; asm volatile("" : "+s"(reps)); for (int rep = 0; rep < reps; ++rep) {
#else
    { { const int rep = 0, reps = 1; (void)rep; (void)reps;
#endif
      pg8::Gemm gm{(const pg8::bf16_t*)F.X18(), F.WqT(), MTOK, DM, DM / 2}; pg8::StaticOrder S; S.init(MTOK, DM, F.G, (int)blockIdx.x);
      EpiQ E{F.QP(), F.ssq()};
      pg8::gemm_phase<EpiQ, pg8::StaticOrder, PG8_ALIGN, PG8_SP2, true>(F.lds + RING_OFF, gm, S, E); } }
#endif
    xcd_barrier(bar);
#ifndef NO_P5
#ifdef PROBE_P5X2
    { int reps = 2; asm volatile("" : "+s"(reps));
      for (int rep = 0; rep < reps; ++rep) for (int u = blockIdx.x; u < MTOK / 32; u += F.G) peer_unit(F, u, rep + 1 < reps); }
#else
    for (int u = blockIdx.x; u < MTOK / 32; u += F.G) peer_unit(F, u);
#endif
#endif
}

extern "C" void kernel_launch(void* const* d_in, const int* in_sizes, int n_in, void* d_out, int out_size, void* d_ws, size_t ws_size, hipStream_t stream) {
    static int grid = 0;
    if (grid == 0) {
        if (n_in != 18 || out_size != MTOK * DM || ws_size < WS_END) { fprintf(stderr, "kernel_launch: unexpected shapes (n_in %d, out %d, ws %zu)\n", n_in, out_size, ws_size); grid = -1; return; }
        int dev = 0, cus = 0, per_cu = 0;
        if (hipGetDevice(&dev) != hipSuccess || hipDeviceGetAttribute(&cus, hipDeviceAttributeMultiprocessorCount, dev) != hipSuccess) { grid = -1; return; }
        if (hipFuncSetAttribute((const void*)hybrid_fwd, hipFuncAttributeMaxDynamicSharedMemorySize, LDS_BYTES) != hipSuccess) { fprintf(stderr, "kernel_launch: hipFuncSetAttribute failed\n"); grid = -1; return; }
        if (hipOccupancyMaxActiveBlocksPerMultiprocessor(&per_cu, (const void*)hybrid_fwd, NWAVES * 64, LDS_BYTES) != hipSuccess || per_cu < 1)
            fprintf(stderr, "kernel_launch: note: occupancy query reports %d workgroups per CU\n", per_cu);
        (void)hipGetLastError();
        grid = cus;
    }
    if (grid < 0) return;
    if (hipMemsetAsync((char*)d_ws + WS_CTL, 0, CTL_ZERO_BYTES, stream) != hipSuccess) return;
    Args a{};
    for (int i = 0; i < 18; ++i) a.in[i] = (const float*)d_in[i];
    a.out = (float*)d_out; a.ws = (unsigned char*)d_ws;
    hipLaunchKernelGGL(hybrid_fwd, dim3(grid), dim3(NWAVES * 64), LDS_BYTES, stream, a);
}
```

```cpp
#include <hip/hip_runtime.h>
#include <cstdio>
#include <cstdint>
namespace pg8 {
#define PG8_LAS __attribute__((address_space(3)))
typedef unsigned short bf16_t;
typedef short bf16x8 __attribute__((ext_vector_type(8)));
typedef float f32x4 __attribute__((ext_vector_type(4)));
typedef unsigned u32x4 __attribute__((ext_vector_type(4)));
constexpr int BM = 256, BK = 64, HALF = 128, HTB = HALF * BK * 2  , STAGE_BYTES = 8 * HTB, NXCD = 8, WGM = 8;

__host__ __device__ __forceinline__ int lds_byte(int r, int c) { const int st = (r >> 4) * 2 + (c >> 5), rr = r & 15, cc = c & 31, ob = rr * 64 + cc * 2; return st * 1024 + (ob ^ (((ob >> 9) & 1) << 5)); }
__host__ __device__ __forceinline__ void stage_rc(int b, int& R, int& C) { const int st = b / 1024, sb = b % 1024, swz = sb ^ (((sb >> 9) & 1) << 5); R = (st >> 1) * 16 + swz / 64; C = (st & 1) * 32 + (swz % 64) / 2; }
__host__ __device__ __forceinline__ int perm32(int rho) { const int n = rho >> 4, i = rho & 15; return 8 * (i >> 2) + 4 * n + (i & 3); }

struct Unit { int pm, pn; };
struct Gemm { const bf16_t* A; const bf16_t* Bt; int M, N, K; };

struct StaticOrder {
    int nM, nN, nwg, G, c;
    __host__ __device__ void init(int M, int N, int G_, int c_) { nM = M / BM; nN = N / BM; nwg = nM * nN; G = G_; c = c_; }
    __host__ __device__ bool next(int i, Unit& u) const {
        const long L = (long)i * G + c; if (L >= nwg) return false;
        int wgid = (int)L; { const int q = nwg / NXCD, r = nwg % NXCD, xcd = wgid % NXCD, off = wgid / NXCD; wgid = (xcd < r ? xcd * (q + 1) : r * (q + 1) + (xcd - r) * q) + off; }
        const int nig = WGM * nN, gid = wgid / nig, fm = gid * WGM, gsz = (nM - fm) < WGM ? (nM - fm) : WGM;
        u.pm = fm + ((wgid % nig) % gsz); u.pn = (wgid % nig) / gsz; return true;
    }
    __device__ __forceinline__ void a_ready(const Unit&) const {}
    __device__ __forceinline__ void done(const Unit&) const {}
};

__device__ __forceinline__ unsigned cvt_pk_bf16(float lo, float hi) { unsigned r; asm volatile("v_cvt_pk_bf16_f32 %0, %1, %2" : "=v"(r) : "v"(lo), "v"(hi)); return r; }
typedef float f32x2 __attribute__((ext_vector_type(2)));
__device__ __forceinline__ f32x2 gelu_pk(f32x2 v) {
    const f32x2 av = __builtin_elementwise_abs(v), d = av * 0.2316418882f + 1.0f;
    f32x2 t; t.x = __builtin_amdgcn_rcpf(d.x); t.y = __builtin_amdgcn_rcpf(d.y);
    f32x2 q = t * 0.5307027145f + (-0.7265760135f); q = q * t + 0.7107068705f; q = q * t + (-0.142248368f); q = q * t + 0.127414796f; q = q * t;
    const f32x2 s = (v * v) * (-0.72134752044f);
    f32x2 e; e.x = __builtin_amdgcn_exp2f(s.x); e.y = __builtin_amdgcn_exp2f(s.y);
    const f32x2 m = v * (q * e), r = v - m;
    f32x2 o; o.x = v.x < 0.f ? m.x : r.x; o.y = v.y < 0.f ? m.y : r.y; return o;
}

template <int ACT  > struct EpiBf16 {
    static constexpr bool PERM = true, AFTER_DRAIN = false, SEG = false; static_assert(ACT == 0 || ACT == 1, "EpiBf16: ACT is 0 (none) or 1 (gelu_pk)");
    bf16_t* O; int ldc; const float* bias; int split_cols; size_t split_stride; float scale0;
    __device__ __forceinline__ void operator()(const f32x4 (&acc)[2][2][4][2], const Unit& u, int wr, int wc, int fr, int fq) const {
        const int row0 = u.pm * BM + wr * 64 + fr; int colt = u.pn * BM; bf16_t* base = O;
        float sc = 1.f; if (split_cols) { const int t = colt / split_cols; base += (size_t)t * split_stride; colt -= t * split_cols; if (t == 0) sc = scale0; }
        const int col0 = colt + wc * 32 + 8 * fq, bcol0 = u.pn * BM + wc * 32 + 8 * fq;
        f32x4 bv[2][2];
#pragma unroll
        for (int bj = 0; bj < 2; ++bj)
#pragma unroll
            for (int n = 0; n < 2; ++n) bv[bj][n] = bias ? *(const f32x4*)(bias + bcol0 + bj * HALF + 4 * n) : (f32x4){0.f, 0.f, 0.f, 0.f};
#pragma unroll
        for (int ai = 0; ai < 2; ++ai)
#pragma unroll
            for (int m = 0; m < 4; ++m) { bf16_t* rowp = base + (size_t)(row0 + ai * HALF + m * 16) * ldc + col0;
#pragma unroll
                for (int bj = 0; bj < 2; ++bj) { f32x4 v0 = acc[ai][bj][m][0] + bv[bj][0], v1 = acc[ai][bj][m][1] + bv[bj][1];
                    if (ACT == 1) { f32x2 a = gelu_pk((f32x2){v0[0], v0[1]}), b = gelu_pk((f32x2){v0[2], v0[3]}), c = gelu_pk((f32x2){v1[0], v1[1]}), d = gelu_pk((f32x2){v1[2], v1[3]});
                        v0 = (f32x4){a.x, a.y, b.x, b.y}; v1 = (f32x4){c.x, c.y, d.x, d.y}; }
                    v0 = v0 * sc; v1 = v1 * sc; u32x4 w; w.x = cvt_pk_bf16(v0[0], v0[1]); w.y = cvt_pk_bf16(v0[2], v0[3]); w.z = cvt_pk_bf16(v1[0], v1[1]); w.w = cvt_pk_bf16(v1[2], v1[3]);
                    *(u32x4*)(rowp + bj * HALF) = w; } }
    }
};
template <class Epi, class Sched, bool ALIGN_EPI = false, bool SP2 = false, bool F8 = false>
__device__ __forceinline__ void gemm_phase(PG8_LAS unsigned char* lds, const Gemm g, const Sched& S, const Epi& E) {
    int tid_ = threadIdx.x; asm volatile("" : "+v"(tid_));
    const int tid = tid_, wid = __builtin_amdgcn_readfirstlane(tid >> 6), lane = tid & 63, wr = wid >> 2, wc = wid & 3, fr = lane & 15, fq = lane >> 4;
    const int K = g.K, nt = K / BK;
    unsigned voffA[2], voffB[2];
#pragma unroll
    for (int i = 0; i < 2; ++i) { int R, C; stage_rc(tid * 16 + i * 8192, R, C); const int Rb = Epi::PERM ? ((R & ~31) + perm32(R & 31)) : R;
        voffA[i] = (unsigned)(R * K + C) * 2u; voffB[i] = (unsigned)(Rb * K + C) * 2u; }
    const size_t kstep = (size_t)(BK * 2);
    const size_t hstep = (size_t)HALF * K * 2;
    const size_t tstep = 2 * hstep;
    const unsigned ldsw = (unsigned)wid * 1024u;
    const int aoff = lds_byte(wr * 64 + fr, fq * 8), boff = lds_byte(wc * 32 + fr, fq * 8);
#define PG8_SA(b, h) (((b) * 2 + (h)) * HTB)
#define PG8_SB(b, h) ((4 + (b) * 2 + (h)) * HTB)
#define PG8_STAGE(bufoff, gbase, voff) do { _Pragma("unroll") for (int _i = 0; _i < 2; ++_i) \
        __builtin_amdgcn_global_load_lds((const unsigned*)((const char*)(gbase) + (voff)[_i]), (PG8_LAS unsigned*)(lds + (bufoff) + ldsw + _i * 8192), 16, 0, 0); } while (0)
#define PG8_LDA(dst, b, h) do { _Pragma("unroll") for (int m = 0; m < 4; ++m) _Pragma("unroll") for (int k = 0; k < 2; ++k) dst[m][k] = *(const PG8_LAS bf16x8*)(lds + PG8_SA(b, h) + aoff + m * 2048 + k * 1024); } while (0)
#define PG8_LDB(dst, b, h) do { _Pragma("unroll") for (int n = 0; n < 2; ++n) _Pragma("unroll") for (int k = 0; k < 2; ++k) dst[n][k] = *(const PG8_LAS bf16x8*)(lds + PG8_SB(b, h) + boff + n * 2048 + k * 1024); } while (0)
#define PG8_MMA(ai, bj, At, Bt) do { __builtin_amdgcn_s_setprio(1); _Pragma("unroll") for (int m = 0; m < 4; ++m) _Pragma("unroll") for (int n = 0; n < 2; ++n) { \
        if constexpr (F8) { typedef int v8i_ __attribute__((ext_vector_type(8))); typedef int v4i_ __attribute__((ext_vector_type(4))); \
            const v4i_ b0_ = __builtin_bit_cast(v4i_, Bt[n][0]), b1_ = __builtin_bit_cast(v4i_, Bt[n][1]), a0_ = __builtin_bit_cast(v4i_, At[m][0]), a1_ = __builtin_bit_cast(v4i_, At[m][1]); \
            const v8i_ bb_ = {b0_.x, b0_.y, b0_.z, b0_.w, b1_.x, b1_.y, b1_.z, b1_.w}, aa_ = {a0_.x, a0_.y, a0_.z, a0_.w, a1_.x, a1_.y, a1_.z, a1_.w}; \
            asm volatile("v_mfma_scale_f32_16x16x128_f8f6f4 %0, %1, %2, %0, %3, %3 op_sel_hi:[0,0,0]" : "+v"(acc[ai][bj][m][n]) : "v"(bb_), "v"(aa_), "v"(f8one)); } \
        else { _Pragma("unroll") for (int k = 0; k < 2; ++k) acc[ai][bj][m][n] = __builtin_amdgcn_mfma_f32_16x16x32_bf16(Bt[n][k], At[m][k], acc[ai][bj][m][n], 0, 0, 0); } } \
        __builtin_amdgcn_s_setprio(0); } while (0)
#define PG8_WAIT_V(n) asm volatile("s_waitcnt vmcnt(" #n ")" ::: "memory")
#define PG8_WAIT_L(n) asm volatile("s_waitcnt lgkmcnt(" #n ")" ::: "memory")
#define PG8_BAR __builtin_amdgcn_s_barrier()
#define PG8_SCHED __builtin_amdgcn_sched_barrier(0)
    Unit cur, nxt; int ui = 0;
    if (!S.next(0, cur)) return;
    f32x4 acc[2][2][4][2];
    const int f8one = 0x7f7f7f7f;
#pragma unroll
    for (int a = 0; a < 2; ++a)
#pragma unroll
        for (int b = 0; b < 2; ++b)
#pragma unroll
            for (int m = 0; m < 4; ++m)
#pragma unroll
                for (int n = 0; n < 2; ++n) acc[a][b][m][n] = (f32x4){0.f, 0.f, 0.f, 0.f};
    bf16x8 At[4][2], B0[2][2], B1[2][2];
    const char* cA = (const char*)g.A + (size_t)cur.pm * tstep; const char* cB = (const char*)g.Bt + (size_t)cur.pn * tstep;
    S.a_ready(cur);
    float segr[16];
    if constexpr (Epi::SEG) E.seg_load(ui, wr, fr, segr);
    if constexpr (SP2) {
        PG8_STAGE(PG8_SB(0, 0), cB, voffB); PG8_STAGE(PG8_SB(0, 1), cB + hstep, voffB); PG8_STAGE(PG8_SA(0, 0), cA, voffA); PG8_STAGE(PG8_SA(0, 1), cA + hstep, voffA);
        if (wr == 1) PG8_BAR;
        PG8_WAIT_V(2); PG8_BAR;
        PG8_STAGE(PG8_SB(1, 0), cB + kstep, voffB); PG8_STAGE(PG8_SA(1, 0), cA + kstep, voffA); PG8_STAGE(PG8_SB(1, 1), cB + hstep + kstep, voffB);
        PG8_WAIT_V(6); PG8_BAR;
    } else {
        PG8_STAGE(PG8_SB(0, 0), cB, voffB); PG8_STAGE(PG8_SA(0, 0), cA, voffA); PG8_STAGE(PG8_SB(0, 1), cB + hstep, voffB); PG8_STAGE(PG8_SA(0, 1), cA + hstep, voffA);
        if (wr == 1) PG8_BAR;
        PG8_WAIT_V(4); PG8_BAR;
        PG8_STAGE(PG8_SB(1, 0), cB + kstep, voffB); PG8_STAGE(PG8_SA(1, 0), cA + kstep, voffA); PG8_STAGE(PG8_SB(1, 1), cB + hstep + kstep, voffB);
        PG8_WAIT_V(6); PG8_BAR;
    }
    for (;;) {
        const bool has_next = S.next(ui + 1, nxt);
        const char* nA = has_next ? (const char*)g.A + (size_t)nxt.pm * tstep : cA; const char* nB = has_next ? (const char*)g.Bt + (size_t)nxt.pn * tstep : cB;
        int t = 0;
#pragma unroll 1
        for (int sgi = 0; sgi < (Epi::SEG ? 3 : 1); ++sgi) {
        int tend = nt; if constexpr (Epi::SEG) tend = (sgi == 0) ? Epi::SEG_T1 : ((sgi == 1) ? Epi::SEG_T2 : nt);
        for (; t < tend; t += 2) {
            const bool last = (t == nt - 2);
            const char* a1 = cA + (size_t)(t + 1) * kstep;
            const char* a2 = last ? nA : cA + (size_t)(t + 2) * kstep; const char* b2 = last ? nB : cB + (size_t)(t + 2) * kstep;
            const char* a3 = a2 + kstep; const char* b3 = b2 + kstep;
            if (last && has_next) S.a_ready(nxt);
            if constexpr (SP2) {
            PG8_LDB(B0, 0, 0); PG8_LDB(B1, 0, 1); PG8_SCHED; PG8_LDA(At, 0, 0); PG8_STAGE(PG8_SA(1, 1), a1 + hstep, voffA);
            PG8_WAIT_V(8); PG8_WAIT_L(0); PG8_BAR; PG8_MMA(0, 0, At, B0); PG8_MMA(0, 1, At, B1); PG8_BAR; PG8_SCHED;
            PG8_LDA(At, 0, 1); PG8_STAGE(PG8_SB(0, 0), b2, voffB); PG8_STAGE(PG8_SB(0, 1), b2 + hstep, voffB); PG8_STAGE(PG8_SA(0, 0), a2, voffA);
            PG8_WAIT_V(8); PG8_WAIT_L(0); PG8_BAR; PG8_MMA(1, 0, At, B0); PG8_MMA(1, 1, At, B1); PG8_BAR; PG8_SCHED;
            PG8_LDB(B0, 1, 0); PG8_LDB(B1, 1, 1); PG8_SCHED; PG8_LDA(At, 1, 0); PG8_STAGE(PG8_SA(0, 1), a2 + hstep, voffA);
            PG8_WAIT_V(8); PG8_WAIT_L(0); PG8_BAR; PG8_MMA(0, 0, At, B0); PG8_MMA(0, 1, At, B1); PG8_BAR; PG8_SCHED;
            PG8_LDA(At, 1, 1); PG8_STAGE(PG8_SB(1, 0), b3, voffB); PG8_STAGE(PG8_SB(1, 1), b3 + hstep, voffB); PG8_STAGE(PG8_SA(1, 0), a3, voffA);
            PG8_WAIT_V(8); PG8_WAIT_L(0); PG8_BAR; PG8_MMA(1, 0, At, B0); PG8_MMA(1, 1, At, B1); PG8_BAR; PG8_SCHED;
            } else {
            PG8_LDB(B0, 0, 0); PG8_SCHED; PG8_LDA(At, 0, 0); PG8_STAGE(PG8_SA(1, 1), a1 + hstep, voffA);
            PG8_WAIT_L(8); PG8_BAR; PG8_WAIT_L(0); PG8_MMA(0, 0, At, B0); PG8_BAR; PG8_SCHED;
            PG8_LDB(B1, 0, 1); PG8_STAGE(PG8_SB(0, 0), b2, voffB);
            PG8_BAR; PG8_WAIT_L(0); PG8_MMA(0, 1, At, B1); PG8_BAR;
            PG8_LDA(At, 0, 1); PG8_STAGE(PG8_SA(0, 0), a2, voffA);
            PG8_BAR; PG8_WAIT_L(0); PG8_MMA(1, 0, At, B0); PG8_BAR; PG8_SCHED;
            PG8_STAGE(PG8_SB(0, 1), b2 + hstep, voffB);
            PG8_WAIT_V(6); PG8_BAR; PG8_MMA(1, 1, At, B1); PG8_BAR;
            PG8_LDB(B0, 1, 0); PG8_SCHED; PG8_LDA(At, 1, 0); PG8_STAGE(PG8_SA(0, 1), a2 + hstep, voffA);
            PG8_WAIT_L(8); PG8_BAR; PG8_WAIT_L(0); PG8_MMA(0, 0, At, B0); PG8_BAR; PG8_SCHED;
            PG8_LDB(B1, 1, 1); PG8_STAGE(PG8_SB(1, 0), b3, voffB);
            PG8_BAR; PG8_WAIT_L(0); PG8_MMA(0, 1, At, B1); PG8_BAR;
            PG8_LDA(At, 1, 1); PG8_STAGE(PG8_SA(1, 0), a3, voffA);
            PG8_BAR; PG8_WAIT_L(0); PG8_MMA(1, 0, At, B0); PG8_BAR; PG8_SCHED;
            PG8_STAGE(PG8_SB(1, 1), b3 + hstep, voffB);
            PG8_WAIT_V(6); PG8_BAR; PG8_MMA(1, 1, At, B1); PG8_BAR;
            }
        }
        if constexpr (Epi::SEG) E.seg_apply(acc, segr, sgi);
        }
        if constexpr (ALIGN_EPI) { if (wr == 0) PG8_BAR; }
        if constexpr (!Epi::AFTER_DRAIN) { if constexpr (Epi::SEG) E(acc, cur, wr, wc, fr, fq, ui); else E(acc, cur, wr, wc, fr, fq); S.done(cur); }
        if (!has_next) break;
#pragma unroll
        for (int a = 0; a < 2; ++a)
#pragma unroll
            for (int b = 0; b < 2; ++b)
#pragma unroll
                for (int m = 0; m < 4; ++m)
#pragma unroll
                    for (int n = 0; n < 2; ++n) acc[a][b][m][n] = (f32x4){0.f, 0.f, 0.f, 0.f};
        cur = nxt; cA = nA; cB = nB; ++ui;
        if constexpr (Epi::SEG) E.seg_load(ui, wr, fr, segr);
        if constexpr (ALIGN_EPI) { if (wr == 1) PG8_BAR; }
    }
    PG8_WAIT_V(0);
    if constexpr (!ALIGN_EPI) { if (wr == 0) PG8_BAR; }
    PG8_BAR;
    if constexpr (Epi::AFTER_DRAIN) { E.fused(acc, cur, wr, wc, fr, fq, lds, wid, lane); S.done(cur); }
#undef PG8_SA
#undef PG8_SB
#undef PG8_STAGE
#undef PG8_LDA
#undef PG8_LDB
#undef PG8_MMA
#undef PG8_WAIT_V
#undef PG8_WAIT_L
#undef PG8_BAR
#undef PG8_SCHED
}
}
#ifndef PG8_SP2
#define PG8_SP2 true
#endif
#ifndef PG8_ALIGN
#define PG8_ALIGN true
#endif

constexpr int BATCH = 8, SEQ = 2048, DM = 2048, MTOK = BATCH * SEQ;
constexpr int ATT_W = 1024, ATT_H = 8, ATT_HD = 128, MOBA_BLK = 256, NBLK = SEQ / MOBA_BLK;
constexpr int SSM_W = 1024, SSM_H = 16, SSM_P = 64, SSM_N = 128, SSM_L = 128, SSM_NC = SEQ / SSM_L, CONV_CH = 1536;
constexpr int IN_PROJ = 5648, NPROJ = 5632  , NPAD = 5888  ;
constexpr int F8_LO = 2048, F8_HI = 3072, NB16 = NPAD - (F8_HI - F8_LO)  ;
constexpr float SH8 = 16.f;
constexpr int COL_Q = 0, COL_K = 1024, COL_V = 2048, COL_Z = 3072, COL_XBC = 4096;
constexpr int PEER_H = 8, PEER_NK = 128, PEER_K = 16, PEER_HK = 128;
constexpr float EPS = 1e-6f;
constexpr float SU = 64.f, SV = 4.f, SH = 16.f, SLO = 16.f;
constexpr float SX8 = 16.f, SW8 = 1024.f;
constexpr float SH4 = 1.5f, SLO4 = 4.f;
constexpr int ROWB = DM / 2;

constexpr size_t MiB = 1u << 20;
constexpr size_t WS_CTL = 0, CTL_ZERO_BYTES = 1 * MiB;
constexpr size_t WS_DT = 1 * MiB;
constexpr size_t WS_SK = 2 * MiB;
constexpr size_t WS_WIN = 4 * MiB;
constexpr size_t WS_WIN8 = 24 * MiB;
constexpr size_t WS_HN8 = 396 * MiB;
constexpr size_t WS_WOUT = 28 * MiB;
constexpr size_t WS_WQ = 36 * MiB;
constexpr size_t WS_HN = 44 * MiB;
constexpr size_t WS_PROJ = 108 * MiB;
constexpr size_t WS_X1B = WS_PROJ, WS_QP = WS_PROJ + 64 * MiB;
constexpr size_t WS_U8 = 284 * MiB, WS_V8 = 316 * MiB;
constexpr size_t WS_XBC = 348 * MiB;
constexpr size_t WS_DT2 = 3 * MiB;
constexpr size_t WS_X18 = 396 * MiB;
constexpr size_t WS_END = 428 * MiB;
constexpr int CW_BAR = 4096;
constexpr int CW_Q2 = 8192;
constexpr int CW_KMEAN = 32768;
constexpr int CW_SSQ = 131072;
static_assert((CW_SSQ + MTOK * 4) * 4 <= (int)CTL_ZERO_BYTES, "CTL words inside the memset region");

constexpr int RING_OFF = 0, RING_BYTES = 131072;
constexpr int LDSCTL_OFF = RING_BYTES, MISC_OFF = LDSCTL_OFF + 320;
constexpr int SEGTAB_OFF = LDSCTL_OFF + 1024;  static_assert(LDSCTL_OFF + 1024 + 3 * 256 * 16 <= 147456, "segment table inside the LDS allocation");
constexpr int LDS_BYTES = 147456;
constexpr int NWAVES = 8;

#define GAS __attribute__((address_space(1)))
#define LAS __attribute__((address_space(3)))
typedef unsigned short bf16;
typedef unsigned v4u __attribute__((ext_vector_type(4)));
typedef unsigned v2u __attribute__((ext_vector_type(2)));
typedef float f32x4 __attribute__((ext_vector_type(4)));
typedef float f32x2 __attribute__((ext_vector_type(2)));
typedef short bf16x8 __attribute__((ext_vector_type(8)));
typedef short s16x4 __attribute__((ext_vector_type(4)));
typedef GAS unsigned gu32;
#define RLX_AGENT __ATOMIC_RELAXED, __HIP_MEMORY_SCOPE_AGENT
#define LDS_WAIT() asm volatile("s_waitcnt lgkmcnt(0)" ::: "memory")
#define VM_WAIT() asm volatile("s_waitcnt vmcnt(0)" ::: "memory")
__device__ __forceinline__ unsigned f2bf(float f) { unsigned u = __builtin_bit_cast(unsigned, f); return (u + 0x7fffu + ((u >> 16) & 1u)) >> 16; }
typedef __bf16 bf16v2 __attribute__((ext_vector_type(2)));
__device__ __forceinline__ unsigned pk2(float lo, float hi) { bf16v2 v; v.x = (__bf16)lo; v.y = (__bf16)hi; return __builtin_bit_cast(unsigned, v); }
__device__ __forceinline__ float bflo(unsigned w) { return __builtin_bit_cast(float, w << 16); }
__device__ __forceinline__ float bfhi(unsigned w) { return __builtin_bit_cast(float, w & 0xffff0000u); }
__device__ __forceinline__ float wave_sum(float v) {
#pragma unroll
    for (int o = 1; o < 64; o <<= 1) v += __shfl_xor(v, o);
    return v;
}
__device__ __forceinline__ float silu_f(float x) { return x * __builtin_amdgcn_rcpf(1.f + __expf(-x)); }

#define XB_TMO      128
#define XB_XCNT(j)  (256  + 64 * (j))
#define XB_XSUB(j)  (1280 + 64 * (j))
#define XB_XGEN(j)  (2304 + 64 * (j))
#define XB_TOP      3328
#define XB_TOPGEN   3392
#define XCD_BAR_WORDS 3456
#define XB_SPIN_CAP (1u << 18)

__device__ __forceinline__ unsigned xb_ld(unsigned* p)              { return __hip_atomic_load(p, __ATOMIC_RELAXED, __HIP_MEMORY_SCOPE_AGENT); }
__device__ __forceinline__ unsigned xb_add(unsigned* p, unsigned v) { return __hip_atomic_fetch_add(p, v, __ATOMIC_RELAXED, __HIP_MEMORY_SCOPE_AGENT); }
__device__ __forceinline__ unsigned xb_xcc_id() { return (unsigned)__builtin_amdgcn_s_getreg((3 << 11) | 20) & 0xFu; }
#define XB_SPIN(cond, bar) do { unsigned _sp = 0; while (cond) { __builtin_amdgcn_s_sleep(1); \
    if ((++_sp & 255u) == 0u) { if (xb_ld(&(bar)[XB_TMO])) break; if (_sp > XB_SPIN_CAP) { atomicAdd(&(bar)[XB_TMO], 1u); break; } } } } while (0)

struct XcdBarrier {
    unsigned* bar; unsigned x;
    volatile LAS unsigned* st;
};
__device__ __forceinline__ XcdBarrier xcd_barrier_post(unsigned* bar, volatile LAS unsigned* st) {
    XcdBarrier b; b.bar = bar; b.x = xb_xcc_id(); b.st = st;
    if (threadIdx.x == 0) (void)xb_add(&bar[XB_XCNT(b.x)], 1u);
    return b;
}
__device__ __forceinline__ void xcd_barrier_complete(unsigned* bar, unsigned x, unsigned& nloc, unsigned& nx) {
    const unsigned G = gridDim.x * gridDim.y * gridDim.z;
    unsigned sum, cnt, mine, sp = 0u;
    for (;;) {
        sum = 0u; cnt = 0u; mine = 0u;
#pragma unroll
        for (unsigned j = 0; j < 16; ++j) { const unsigned c = xb_ld(&bar[XB_XCNT(j)]); sum += c; cnt += (c > 0u) ? 1u : 0u; mine = (j == x) ? c : mine; }
        if (sum == G) break;
        __builtin_amdgcn_s_sleep(1);
        if ((++sp & 255u) == 0u) { if (xb_ld(&bar[XB_TMO])) break; if (sp > XB_SPIN_CAP) { atomicAdd(&bar[XB_TMO], 1u); break; } }
    }
    nloc = mine > 0u ? mine : 1u; nx = cnt > 0u ? cnt : 1u;
}
__device__ __forceinline__ void xcd_barrier(const XcdBarrier& b) {
    asm volatile("s_waitcnt vmcnt(0)" ::: "memory");
    __syncthreads();
    if (threadIdx.x == 0) {
        unsigned* bar = b.bar;
        __builtin_amdgcn_s_waitcnt(0);
        unsigned nloc = b.st[0], nx = b.st[1];
        if (nloc == 0u) { xcd_barrier_complete(bar, b.x, nloc, nx); b.st[0] = nloc; b.st[1] = nx; }
        const unsigned old = xb_add(&bar[XB_XSUB(b.x)], 1u);
        const unsigned gen = old / nloc;
        if (old + 1u == (gen + 1u) * nloc) {
            __builtin_amdgcn_fence(__ATOMIC_RELEASE, "agent");
            asm volatile("s_waitcnt vmcnt(0)" ::: "memory");
            const unsigned og = xb_add(&bar[XB_TOP], 1u);
            const unsigned tg = og / nx;
            if (og + 1u == (tg + 1u) * nx) xb_add(&bar[XB_TOPGEN], 1u);
            else XB_SPIN(xb_ld(&bar[XB_TOPGEN]) == tg, bar);
            __builtin_amdgcn_fence(__ATOMIC_ACQUIRE, "agent");
            xb_add(&bar[XB_XGEN(b.x)], 1u);
            asm volatile("s_waitcnt vmcnt(0)" ::: "memory");
        } else {
            XB_SPIN(xb_ld(&bar[XB_XGEN(b.x)]) == gen, bar);
            __builtin_amdgcn_fence(__ATOMIC_ACQUIRE, "agent");
            asm volatile("s_waitcnt vmcnt(0)" ::: "memory");
        }
    }
    __syncthreads();
}

#define CAS __attribute__((address_space(4)))
struct Args { const float* in[18]; float* out; unsigned char* ws; };
__device__ __forceinline__ const CAS unsigned char* kargs() { const CAS unsigned char* p = (const CAS unsigned char*)__builtin_amdgcn_kernarg_segment_ptr(); asm volatile("" : "+s"(p)); return p; }
__device__ __forceinline__ const float* kin(int i) { return *(const float* const CAS*)(kargs() + 8 * i); }
__device__ __forceinline__ float* kout() { return *(float* const CAS*)(kargs() + 8 * 18); }
__device__ __forceinline__ unsigned char* kws() { return *(unsigned char* const CAS*)(kargs() + 8 * 19); }
__device__ __forceinline__ int fresh_tid() { int t = threadIdx.x; asm volatile("" : "+v"(t)); return t; }
struct Frame {
    LAS unsigned char* lds;
    volatile LAS unsigned* MISC;
    int tid, lane, wave, G;
    __device__ __forceinline__ const float* x() const { return kin(0); }
    __device__ __forceinline__ const float* attn_norm() const { return kin(1); }
    __device__ __forceinline__ const float* w_in() const { return kin(2); }
    __device__ __forceinline__ const float* conv_w() const { return kin(3); }
    __device__ __forceinline__ const float* conv_b() const { return kin(4); }
    __device__ __forceinline__ const float* dt_bias() const { return kin(5); }
    __device__ __forceinline__ const float* a_log() const { return kin(6); }
    __device__ __forceinline__ const float* d_skip() const { return kin(7); }
    __device__ __forceinline__ const float* rel_bias() const { return kin(8); }
    __device__ __forceinline__ const float* attn_out_norm() const { return kin(9); }
    __device__ __forceinline__ const float* ssm_out_norm() const { return kin(10); }
    __device__ __forceinline__ const float* w_out() const { return kin(11); }
    __device__ __forceinline__ const float* ffn_norm() const { return kin(12); }
    __device__ __forceinline__ const float* peer_wq() const { return kin(13); }
    __device__ __forceinline__ const float* peer_sk() const { return kin(14); }
    __device__ __forceinline__ const float* peer_u() const { return kin(15); }
    __device__ __forceinline__ const float* peer_v() const { return kin(16); }
    __device__ __forceinline__ const float* final_norm() const { return kin(17); }
    __device__ __forceinline__ float* out() const { return kout(); }
    __device__ __forceinline__ unsigned* ctl() const { return (unsigned*)(kws() + WS_CTL); }
    __device__ __forceinline__ float* dtraw() const { return (float*)(kws() + WS_DT); }
    __device__ __forceinline__ bf16* SK() const { return (bf16*)(kws() + WS_SK); }
    __device__ __forceinline__ bf16* WinT() const { return (bf16*)(kws() + WS_WIN); }
    __device__ __forceinline__ bf16* WoutT() const { return (bf16*)(kws() + WS_WOUT); }
    __device__ __forceinline__ bf16* WqT() const { return (bf16*)(kws() + WS_WQ); }
    __device__ __forceinline__ bf16* HN() const { return (bf16*)(kws() + WS_HN); }
    __device__ __forceinline__ bf16* PROJ() const { return (bf16*)(kws() + WS_PROJ); }
    __device__ __forceinline__ bf16* X1B() const { return (bf16*)(kws() + WS_X1B); }
    __device__ __forceinline__ bf16* QP() const { return (bf16*)(kws() + WS_QP); }
    __device__ __forceinline__ unsigned char* U8() const { return kws() + WS_U8; }
    __device__ __forceinline__ unsigned char* V8() const { return kws() + WS_V8; }
    __device__ __forceinline__ unsigned char* X18() const { return kws() + WS_X18; }
    __device__ __forceinline__ unsigned char* HN8() const { return kws() + WS_HN8; }
    __device__ __forceinline__ unsigned char* WinT8() const { return kws() + WS_WIN8; }
    __device__ __forceinline__ bf16* XBC() const { return (bf16*)(kws() + WS_XBC); }
    __device__ __forceinline__ float* DT2() const { return (float*)(kws() + WS_DT2); }
    __device__ __forceinline__ float* kmean() const { return (float*)(kws() + WS_CTL) + CW_KMEAN; }
    __device__ __forceinline__ float* ssq() const { return (float*)(kws() + WS_CTL) + CW_SSQ; }
};

__device__ __forceinline__ float clampf(float v, float lim);
__device__ __forceinline__ void p0_transpose_item(const float* W, int K, int N, bf16* WT, const float* gain, LAS float* scr, int item, int lane, const float f8scale = 0.f, const int nshift = 0) {
    const int nblk = (N + 31) / 32, kb = item / nblk, nb = item % nblk, k0 = 64 * kb, n0 = 32 * nb;
    const int kr = lane >> 3, nc = (lane & 7) * 4; const bool ok = (n0 + nc) < N;
    f32x4 v[8]; float gk[8];
#pragma unroll
    for (int i = 0; i < 8; ++i) { const int kk = 8 * i + kr; v[i] = ok ? *(const GAS f32x4*)(W + (size_t)(k0 + kk) * N + n0 + nc) : (f32x4){0.f, 0.f, 0.f, 0.f}; gk[i] = gain ? gain[k0 + kk] : 1.f; }
#pragma unroll
    for (int i = 0; i < 8; ++i) { const int kk = 8 * i + kr; LAS float* d = scr + kk * 33 + nc; d[0] = v[i].x * gk[i]; d[1] = v[i].y * gk[i]; d[2] = v[i].z * gk[i]; d[3] = v[i].w * gk[i]; }
    LDS_WAIT(); asm volatile("" ::: "memory");
    const int c = lane & 7;
#pragma unroll
    for (int j = 0; j < 4; ++j) { const int n = (lane >> 3) + 8 * j; const LAS float* s = scr + (8 * c) * 33 + n;
        v4u o; o.x = pk2(s[0 * 33], s[1 * 33]); o.y = pk2(s[2 * 33], s[3 * 33]); o.z = pk2(s[4 * 33], s[5 * 33]); o.w = pk2(s[6 * 33], s[7 * 33]);
        if (f8scale == 0.f) *(GAS v4u*)(WT + (size_t)(n0 + n - nshift) * K + k0 + 8 * c) = o;
        else { v2u o8; int w_;
            w_ = __builtin_amdgcn_cvt_pk_fp8_f32(clampf(s[0 * 33] * f8scale, 448.f), clampf(s[1 * 33] * f8scale, 448.f), 0, false); w_ = __builtin_amdgcn_cvt_pk_fp8_f32(clampf(s[2 * 33] * f8scale, 448.f), clampf(s[3 * 33] * f8scale, 448.f), w_, true); o8.x = (unsigned)w_;
            w_ = __builtin_amdgcn_cvt_pk_fp8_f32(clampf(s[4 * 33] * f8scale, 448.f), clampf(s[5 * 33] * f8scale, 448.f), 0, false); w_ = __builtin_amdgcn_cvt_pk_fp8_f32(clampf(s[6 * 33] * f8scale, 448.f), clampf(s[7 * 33] * f8scale, 448.f), w_, true); o8.y = (unsigned)w_;
            *(GAS v2u*)((unsigned char*)WT + (size_t)(n0 + n - nshift) * K + k0 + 8 * c) = o8; } }
    LDS_WAIT(); asm volatile("" ::: "memory");
}
__device__ __forceinline__ unsigned pk4_fp8(float a, float b, float c, float d) { int w = __builtin_amdgcn_cvt_pk_fp8_f32(clampf(a, 448.f), clampf(b, 448.f), 0, false); w = __builtin_amdgcn_cvt_pk_fp8_f32(clampf(c, 448.f), clampf(d, 448.f), w, true); return (unsigned)w; }
__device__ __forceinline__ void rms_2rows_to_bf16(const float* x0, const float* x1, const float* gain, bf16* o0, bf16* o1, unsigned char* q0, unsigned char* q1, int lane) {
    const GAS f32x4* xr0 = (const GAS f32x4*)x0 + lane; const GAS f32x4* xr1 = (const GAS f32x4*)x1 + lane; const GAS f32x4* gr = (const GAS f32x4*)gain + lane;
    f32x4 v[8], u[8]; float s = 0.f, t = 0.f;
#pragma unroll
    for (int j = 0; j < 8; ++j) { v[j] = xr0[64 * j]; u[j] = xr1[64 * j]; }
#pragma unroll
    for (int j = 0; j < 8; ++j) { s += (v[j].x * v[j].x + v[j].y * v[j].y) + (v[j].z * v[j].z + v[j].w * v[j].w); t += (u[j].x * u[j].x + u[j].y * u[j].y) + (u[j].z * u[j].z + u[j].w * u[j].w); }
    const float rs = __builtin_amdgcn_rsqf(wave_sum(s) * (1.f / DM) + EPS), rt = __builtin_amdgcn_rsqf(wave_sum(t) * (1.f / DM) + EPS);
    GAS v2u* p0 = (GAS v2u*)o0 + lane; GAS v2u* p1 = (GAS v2u*)o1 + lane; GAS unsigned* r0 = (GAS unsigned*)q0 + lane; GAS unsigned* r1 = (GAS unsigned*)q1 + lane;
#pragma unroll
    for (int j = 0; j < 8; ++j) { const f32x4 g = gr[64 * j]; v2u a, b;
        const f32x4 h0 = v[j] * g * rs, h1 = u[j] * g * rt;
        a.x = pk2(h0.x, h0.y); a.y = pk2(h0.z, h0.w); p0[64 * j] = a; r0[64 * j] = pk4_fp8(h0.x * SH8, h0.y * SH8, h0.z * SH8, h0.w * SH8);
        b.x = pk2(h1.x, h1.y); b.y = pk2(h1.z, h1.w); p1[64 * j] = b; r1[64 * j] = pk4_fp8(h1.x * SH8, h1.y * SH8, h1.z * SH8, h1.w * SH8); }
}
#ifdef PROBE_FP4EMU
__device__ __forceinline__ float fp4grid(float y) { const float a = fabsf(y); float r;
    if (a <= 2.f) r = rintf(a * 2.f) * 0.5f; else if (a <= 4.f) r = rintf(a); else r = (a < 5.f) ? 4.f : 6.f;
    return copysignf(r, y); }
__device__ __forceinline__ float clampf(float v, float lim) { if (lim == 448.5f) return fp4grid(v * (1.f / 16.f)) * 16.f; return fminf(fmaxf(v, -lim), lim); }
#else
__device__ __forceinline__ float clampf(float v, float lim) { return fminf(fmaxf(v, -lim), lim); }
#endif
template <int TAB = 0> __device__ __forceinline__ v4u cvt16_fp8(const f32x4 a, const f32x4 b, const f32x4 c, const f32x4 d, float sc) {
    v4u o; int w; constexpr float LIM = TAB ? 448.5f : 448.f;
    w = __builtin_amdgcn_cvt_pk_fp8_f32(clampf(a.x * sc, LIM), clampf(a.y * sc, LIM), 0, false); w = __builtin_amdgcn_cvt_pk_fp8_f32(clampf(a.z * sc, LIM), clampf(a.w * sc, LIM), w, true); o.x = (unsigned)w;
    w = __builtin_amdgcn_cvt_pk_fp8_f32(clampf(b.x * sc, LIM), clampf(b.y * sc, LIM), 0, false); w = __builtin_amdgcn_cvt_pk_fp8_f32(clampf(b.z * sc, LIM), clampf(b.w * sc, LIM), w, true); o.y = (unsigned)w;
    w = __builtin_amdgcn_cvt_pk_fp8_f32(clampf(c.x * sc, LIM), clampf(c.y * sc, LIM), 0, false); w = __builtin_amdgcn_cvt_pk_fp8_f32(clampf(c.z * sc, LIM), clampf(c.w * sc, LIM), w, true); o.z = (unsigned)w;
    w = __builtin_amdgcn_cvt_pk_fp8_f32(clampf(d.x * sc, LIM), clampf(d.y * sc, LIM), 0, false); w = __builtin_amdgcn_cvt_pk_fp8_f32(clampf(d.z * sc, LIM), clampf(d.w * sc, LIM), w, true); o.w = (unsigned)w;
    return o;
}
__device__ __forceinline__ void tables_convert(Frame& F, size_t lo, size_t hi, size_t tix, size_t ntx) {
      const GAS f32x4* su = (const GAS f32x4*)F.peer_u(); const GAS f32x4* sv = (const GAS f32x4*)F.peer_v(); GAS v4u* du = (GAS v4u*)F.U8(); GAS v4u* dv = (GAS v4u*)F.V8();
#pragma unroll 1
      for (int tab = 0; tab < 2; ++tab) { const GAS f32x4* src = tab ? sv : su; GAS v4u* dst = tab ? dv : du; const float sc = tab ? SV : SU;
        f32x4 nx[8]; const size_t i0 = lo + tix;
        if (i0 < hi) { const GAS f32x4* p = src + (i0 >> 6) * 512 + (i0 & 63);
#pragma unroll
            for (int j = 0; j < 8; ++j) nx[j] = p[64 * j]; }
#pragma unroll 1
        for (size_t i = i0; i < hi; i += ntx) { f32x4 v[8];
#pragma unroll
            for (int j = 0; j < 8; ++j) v[j] = nx[j];
            if (i + ntx < hi) { const size_t i2 = i + ntx; const GAS f32x4* p = src + (i2 >> 6) * 512 + (i2 & 63);
#pragma unroll
                for (int j = 0; j < 8; ++j) nx[j] = p[64 * j]; }
            unsigned wd[4];
#pragma unroll
            for (int q = 0; q < 4; ++q) { const f32x4 a = v[2 * q] * sc, b = v[2 * q + 1] * sc; unsigned w = 0u;
                w = __builtin_amdgcn_cvt_scalef32_pk_fp4_f32(w, clampf(a.x, 6.f), clampf(a.y, 6.f), 1.0f, 0); w = __builtin_amdgcn_cvt_scalef32_pk_fp4_f32(w, clampf(a.z, 6.f), clampf(a.w, 6.f), 1.0f, 1);
                w = __builtin_amdgcn_cvt_scalef32_pk_fp4_f32(w, clampf(b.x, 6.f), clampf(b.y, 6.f), 1.0f, 2); w = __builtin_amdgcn_cvt_scalef32_pk_fp4_f32(w, clampf(b.z, 6.f), clampf(b.w, 6.f), 1.0f, 3); wd[q] = w; }
            dst[i] = (v4u){wd[0], wd[1], wd[2], wd[3]}; } }
}
constexpr size_t TAB_ITEMS = (size_t)16384 * 64;
__device__ __forceinline__ size_t tab_split(int G) { const int rem = ((MTOK / 256) * (NB16 / 256)) % G; return rem ? (TAB_ITEMS / 8) * 5 : TAB_ITEMS; }
__device__ __forceinline__ unsigned fp4_code(float y) { const float a = fabsf(y);
    const unsigned m = (unsigned)(a >= 0.25f) + (unsigned)(a >= 0.75f) + (unsigned)(a >= 1.25f) + (unsigned)(a >= 1.75f) + (unsigned)(a >= 2.5f) + (unsigned)(a >= 3.5f) + (unsigned)(a >= 5.0f);
    return m | ((y < 0.f) ? 8u : 0u); }
__device__ __forceinline__ void p0_prologue(Frame& F) {
    const int tid = fresh_tid(), lane = tid & 63, wave = __builtin_amdgcn_readfirstlane(tid >> 6);
    LAS float* scr = (LAS float*)(F.lds + RING_OFF + wave * 16384);
    const int gw = blockIdx.x * NWAVES + wave, NGW = F.G * NWAVES;
    constexpr int I_IN = (DM / 64) * ((IN_PROJ + 31) / 32), I_SQ = (DM / 64) * (DM / 32);
    constexpr int NITEMS = I_IN + 2 * I_SQ;
    { const float* const w_in = F.w_in(); const float* const w_out = F.w_out(); const float* const wq = F.peer_wq(); const float* const fg = F.ffn_norm(); bf16* const WinT = F.WinT(); unsigned char* const WinT8 = F.WinT8(); bf16* const WoutT = F.WoutT(); bf16* const WqT = F.WqT(); const float* const gatt = F.attn_out_norm(); const float* const gssm = F.ssm_out_norm();
      for (int it = gw; it < NITEMS; it += NGW) {
        int r = it;
        if (r < I_IN) { const int n0_ = 32 * (r % ((IN_PROJ + 31) / 32));
            if (n0_ >= F8_LO && n0_ < F8_HI) p0_transpose_item(w_in, DM, IN_PROJ, (bf16*)WinT8, nullptr, scr, r, lane, SW8, F8_LO);
            else p0_transpose_item(w_in, DM, IN_PROJ, WinT, nullptr, scr, r, lane, 0.f, (n0_ >= F8_HI) ? (F8_HI - F8_LO) : 0);
            continue; } r -= I_IN;
        if (r < I_SQ) { const int k0_ = 64 * (r / (DM / 32)); p0_transpose_item(w_out, DM, DM, WoutT, (k0_ < ATT_W) ? gatt : (gssm - ATT_W), scr, r, lane); continue; } r -= I_SQ;
        p0_transpose_item(wq, DM, DM, WqT, fg, scr, r, lane, SW8);
      } }
    const size_t gt = (size_t)blockIdx.x * (NWAVES * 64) + tid, GT = (size_t)F.G * NWAVES * 64;
    { const size_t z0 = (size_t)(5664 - (F8_HI - F8_LO)) * DM / 8, z1 = (size_t)NB16 * DM / 8; GAS v4u* p = (GAS v4u*)F.WinT(); for (size_t i = z0 + gt; i < z1; i += GT) p[i] = (v4u){0u, 0u, 0u, 0u}; }
    { const GAS f32x4* s = (const GAS f32x4*)F.peer_sk(); GAS v2u* d = (GAS v2u*)F.SK(); for (size_t i = gt; i < (size_t)16 * 128 * 128 / 4; i += GT) { const f32x4 v = s[i]; v2u o; o.x = pk2(v.x, v.y); o.y = pk2(v.z, v.w); d[i] = o; } }
    { const float* const xg = F.x(); const float* const gn = F.attn_norm(); bf16* const hn = F.HN(); unsigned char* const hn8 = F.HN8();
      for (int m = gw; m < MTOK / 2; m += NGW) rms_2rows_to_bf16(xg + (size_t)(2 * m) * DM, xg + (size_t)(2 * m + 1) * DM, gn, hn + (size_t)(2 * m) * DM, hn + (size_t)(2 * m + 1) * DM, hn8 + (size_t)(2 * m) * DM, hn8 + (size_t)(2 * m + 1) * DM, lane); }
    tables_convert(F, 0, tab_split(F.G), gt, GT);
}

struct EpiProj {
    static constexpr bool PERM = true, AFTER_DRAIN = false, SEG = false;
    bf16* O; float* dtraw; float* kmean;
    __device__ __forceinline__ void operator()(const pg8::f32x4 (&acc)[2][2][4][2], const pg8::Unit& u, int wr, int wc, int fr, int fq) const {
        const int rpn = (u.pn < F8_LO / 256) ? u.pn : u.pn + (F8_HI - F8_LO) / 256;
        const int row0 = u.pm * 256 + wr * 64 + fr, col0 = rpn * 256 + wc * 32 + 8 * fq;
        if (rpn < 22) {
#pragma unroll
            for (int ai = 0; ai < 2; ++ai)
#pragma unroll
                for (int m = 0; m < 4; ++m) { bf16* rowp = O + (size_t)(row0 + ai * 128 + m * 16) * NPROJ + col0;
#pragma unroll
                    for (int bj = 0; bj < 2; ++bj) { const pg8::f32x4 v0 = acc[ai][bj][m][0], v1 = acc[ai][bj][m][1];
                        pg8::u32x4 w; w.x = pg8::cvt_pk_bf16(v0[0], v0[1]); w.y = pg8::cvt_pk_bf16(v0[2], v0[3]); w.z = pg8::cvt_pk_bf16(v1[0], v1[1]); w.w = pg8::cvt_pk_bf16(v1[2], v1[3]);
                        *(pg8::u32x4*)(rowp + bj * 128) = w; } }
        } else if (wc == 0 && fq < 2) {
#pragma unroll
            for (int ai = 0; ai < 2; ++ai)
#pragma unroll
                for (int m = 0; m < 4; ++m) { float* rp = dtraw + (size_t)(row0 + ai * 128 + m * 16) * 16 + 8 * fq;
                    *(pg8::f32x4*)rp = acc[ai][0][m][0]; *(pg8::f32x4*)(rp + 4) = acc[ai][0][m][1]; }
        }
        if (kmean && u.pn >= 4 && u.pn < 8) {
#pragma unroll
            for (int bj = 0; bj < 2; ++bj)
#pragma unroll
                for (int n = 0; n < 2; ++n)
#pragma unroll
                    for (int i = 0; i < 4; ++i) { float s = 0.f;
#pragma unroll
                        for (int ai = 0; ai < 2; ++ai)
#pragma unroll
                            for (int m = 0; m < 4; ++m) s += acc[ai][bj][m][n][i];
                        s += __shfl_xor(s, 1); s += __shfl_xor(s, 2); s += __shfl_xor(s, 4); s += __shfl_xor(s, 8);
                        if (fr == 0) unsafeAtomicAdd(kmean + (size_t)u.pm * 1024 + (col0 - 1024) + bj * 128 + 4 * n + i, s); }
        }
    }
};
struct EpiProj8 {
    static constexpr bool PERM = true, AFTER_DRAIN = false, SEG = false;
    bf16* O;
    __device__ __forceinline__ void operator()(const pg8::f32x4 (&acc)[2][2][4][2], const pg8::Unit& u, int wr, int wc, int fr, int fq) const {
        const int row0 = u.pm * 256 + wr * 64 + fr, col0 = F8_LO + u.pn * 256 + wc * 32 + 8 * fq; constexpr float sc = 1.f / (SH8 * SW8);
#pragma unroll
        for (int ai = 0; ai < 2; ++ai)
#pragma unroll
            for (int m = 0; m < 4; ++m) { bf16* rowp = O + (size_t)(row0 + ai * 128 + m * 16) * NPROJ + col0;
#pragma unroll
                for (int bj = 0; bj < 2; ++bj) { const pg8::f32x4 v0 = acc[ai][bj][m][0] * sc, v1 = acc[ai][bj][m][1] * sc;
                    pg8::u32x4 w; w.x = pg8::cvt_pk_bf16(v0[0], v0[1]); w.y = pg8::cvt_pk_bf16(v0[2], v0[3]); w.z = pg8::cvt_pk_bf16(v1[0], v1[1]); w.w = pg8::cvt_pk_bf16(v1[2], v1[3]);
                    *(pg8::u32x4*)(rowp + bj * 128) = w; } }
    }
};
struct EpiOut {
    static constexpr bool PERM = true, AFTER_DRAIN = false, SEG = true; static constexpr int SEG_T1 = 16, SEG_T2 = 24;
    const float* x; bf16* x1b; unsigned char* x18; float* ssq; bool doatom; const LAS f32x4* tab;
    __device__ __forceinline__ void seg_load(int ui, int wr, int fr, float (&sr)[16]) const {
#pragma unroll
        for (int i = 0; i < 8; ++i) { const int r = (i >> 2) * 128 + wr * 64 + (i & 3) * 16 + fr; const f32x2 q = *(const LAS f32x2*)(tab + ui * 256 + r); sr[2 * i] = q.x; sr[2 * i + 1] = q.y; }
        asm volatile("s_waitcnt lgkmcnt(0)" ::: "memory");
    }
    __device__ __forceinline__ void seg_apply(pg8::f32x4 (&acc)[2][2][4][2], const float (&sr)[16], int which) const {
#pragma unroll
        for (int ai = 0; ai < 2; ++ai)
#pragma unroll
            for (int m = 0; m < 4; ++m) { const float f = (which == 0) ? sr[2 * (ai * 4 + m)] : ((which == 1) ? sr[2 * (ai * 4 + m) + 1] : 1.0f);
#pragma unroll
                for (int bj = 0; bj < 2; ++bj)
#pragma unroll
                    for (int n = 0; n < 2; ++n) acc[ai][bj][m][n] = acc[ai][bj][m][n] * f; }
    }
    __device__ __forceinline__ void operator()(const pg8::f32x4 (&acc)[2][2][4][2], const pg8::Unit& u, int wr, int wc, int fr, int fq, int ui) const {
        const int row0 = u.pm * 256 + wr * 64 + fr, col0 = u.pn * 256 + wc * 32 + 8 * fq;
#pragma unroll
        for (int ai = 0; ai < 2; ++ai)
#pragma unroll
            for (int m = 0; m < 4; ++m) { const int row = row0 + ai * 128 + m * 16; const size_t off = (size_t)row * DM + col0; float s = 0.f;
                const float s1 = (*(const LAS f32x4*)(tab + ui * 256 + ai * 128 + wr * 64 + m * 16 + fr)).z;
#pragma unroll
                for (int bj = 0; bj < 2; ++bj) {
                    const pg8::f32x4 a0 = *(const pg8::f32x4*)(x + off + bj * 128), a1 = *(const pg8::f32x4*)(x + off + bj * 128 + 4);
                    const pg8::f32x4 v0 = acc[ai][bj][m][0] * s1 + a0, v1 = acc[ai][bj][m][1] * s1 + a1;
                    pg8::u32x4 w; w.x = pg8::cvt_pk_bf16(v0[0], v0[1]); w.y = pg8::cvt_pk_bf16(v0[2], v0[3]); w.z = pg8::cvt_pk_bf16(v1[0], v1[1]); w.w = pg8::cvt_pk_bf16(v1[2], v1[3]);
                    *(pg8::u32x4*)(x1b + off + bj * 128) = w;
                    { v2u o8; int w_; w_ = __builtin_amdgcn_cvt_pk_fp8_f32(clampf(v0[0] * SX8, 448.f), clampf(v0[1] * SX8, 448.f), 0, false); w_ = __builtin_amdgcn_cvt_pk_fp8_f32(clampf(v0[2] * SX8, 448.f), clampf(v0[3] * SX8, 448.f), w_, true); o8.x = (unsigned)w_;
                      w_ = __builtin_amdgcn_cvt_pk_fp8_f32(clampf(v1[0] * SX8, 448.f), clampf(v1[1] * SX8, 448.f), 0, false); w_ = __builtin_amdgcn_cvt_pk_fp8_f32(clampf(v1[2] * SX8, 448.f), clampf(v1[3] * SX8, 448.f), w_, true); o8.y = (unsigned)w_;
                      *(v2u*)(x18 + off + bj * 128) = o8; }
                    s += (v0[0] * v0[0] + v0[1] * v0[1]) + (v0[2] * v0[2] + v0[3] * v0[3]) + (v1[0] * v1[0] + v1[1] * v1[1]) + (v1[2] * v1[2] + v1[3] * v1[3]); }
                s += __shfl_xor(s, 16); s += __shfl_xor(s, 32);
                if (fq == 0 && doatom) unsafeAtomicAdd(ssq + (size_t)row * 4, s);
                asm volatile("" ::: "memory"); }
    }
};
struct EpiQ {
    static constexpr bool PERM = true, AFTER_DRAIN = false, SEG = false;
    bf16* O; const float* ssq;
    __device__ __forceinline__ void operator()(const pg8::f32x4 (&acc)[2][2][4][2], const pg8::Unit& u, int wr, int wc, int fr, int fq) const {
        const int row0 = u.pm * 256 + wr * 64 + fr, col0 = u.pn * 256 + wc * 32 + 8 * fq;
#pragma unroll
        for (int ai = 0; ai < 2; ++ai)
#pragma unroll
            for (int m = 0; m < 4; ++m) { const int row = row0 + ai * 128 + m * 16; bf16* rowp = O + (size_t)row * DM + col0;
                const float rs = (1.f / (SX8 * SW8)) / sqrtf(__hip_atomic_load(ssq + (size_t)row * 4, RLX_AGENT) * (1.f / DM) + EPS);
#pragma unroll
                for (int bj = 0; bj < 2; ++bj) { const pg8::f32x4 v0 = acc[ai][bj][m][0] * rs, v1 = acc[ai][bj][m][1] * rs;
                    pg8::u32x4 w; w.x = pg8::cvt_pk_bf16(v0[0], v0[1]); w.y = pg8::cvt_pk_bf16(v0[2], v0[3]); w.z = pg8::cvt_pk_bf16(v1[0], v1[1]); w.w = pg8::cvt_pk_bf16(v1[2], v1[3]);
                    *(pg8::u32x4*)(rowp + bj * 128) = w; } }
    }
};

constexpr int A_KSTR = 272, A_VSTR = 288;
constexpr int A_KB0 = 0, A_KB1 = 64 * A_KSTR, A_VB0 = 2 * 64 * A_KSTR, A_VB1 = A_VB0 + 64 * A_VSTR, A_KM = A_VB1 + 64 * A_VSTR, A_TAB = A_KM + 8 * 128 * 4, A_END = A_TAB + 128 * 4;
static_assert(A_END <= RING_BYTES && (A_KM % 16) == 0, "attention LDS map");
#define PIN16(a, i) asm volatile("" : "+v"(a[i]), "+v"(a[i + 1]), "+v"(a[i + 2]), "+v"(a[i + 3]), "+v"(a[i + 4]), "+v"(a[i + 5]), "+v"(a[i + 6]), "+v"(a[i + 7]), "+v"(a[i + 8]), "+v"(a[i + 9]), "+v"(a[i + 10]), "+v"(a[i + 11]), "+v"(a[i + 12]), "+v"(a[i + 13]), "+v"(a[i + 14]), "+v"(a[i + 15]))
#define TR16(p) __builtin_amdgcn_ds_read_tr16_b64_v4i16((LAS s16x4*)(p))
#define MFMA16(a, b, c) __builtin_amdgcn_mfma_f32_16x16x32_bf16((a), (b), (c), 0, 0, 0)
__device__ __forceinline__ bf16x8 pack8(const float* v) {
    const unsigned a = pk2(v[0], v[1]), b = pk2(v[2], v[3]), c = pk2(v[4], v[5]), d = pk2(v[6], v[7]);
    const v4u u = {a, b, c, d}; return __builtin_bit_cast(bf16x8, u);
}
__device__ __forceinline__ void attn_unit(Frame& F, int b, int h, int blk, const bool doatom = true) {
    LAS unsigned char* lds = F.lds + RING_OFF;
    const int tid = fresh_tid(), lane = tid & 63, w = __builtin_amdgcn_readfirstlane(tid >> 6), g = lane >> 4, c16 = lane & 15, q4 = c16 >> 2, p4 = lane & 3;
    const int own = blk, t0 = blk * 256, tq0 = t0 + 32 * w + c16;
    const size_t rowbase = (size_t)b * SEQ;
    const float NEG_INF = -__builtin_inff();
    constexpr float LOG2E = 1.4426950408889634f, SCL2 = 0.08838834764831845f * 1.4426950408889634f;
    LAS float* km = (LAS float*)(lds + A_KM); LAS float* tab = (LAS float*)(lds + A_TAB);
    const bf16* const PROJ = F.PROJ(); const float* const kmg = F.kmean(); const float* const relb = F.rel_bias();
    for (int i = tid; i < own * 128; i += NWAVES * 64) { const int n = i >> 7, d = i & 127; km[i] = kmg[(size_t)(b * 8 + n) * 1024 + h * 128 + d] * (1.f / 256.f); }
    if (tid < 128) { const int rel = tid; int bucket = rel; if (rel >= 16) { bucket = 16 + (int)(log2f((float)rel * (1.f / 16.f)) * (16.f / 3.f)); bucket = bucket > 31 ? 31 : bucket; }
        tab[tid] = relb[bucket * 8 + h] * LOG2E; }
    bf16x8 qf[2][4];
#pragma unroll
    for (int gi = 0; gi < 2; ++gi) { const bf16* qrow = PROJ + (rowbase + tq0 + 16 * gi) * NPROJ + COL_Q + h * 128 + 8 * g;
#pragma unroll
      for (int ks = 0; ks < 4; ++ks) qf[gi][ks] = *(const GAS bf16x8*)(qrow + 32 * ks); }
    __syncthreads();
    unsigned selmask[2];
    if (own <= 3) { selmask[0] = (1u << own) - 1u; selmask[1] = selmask[0]; }
    else {
#pragma unroll
      for (int gi = 0; gi < 2; ++gi) {
        float gate[7];
#pragma unroll
        for (int n = 0; n < 7; ++n) {
            float s = NEG_INF;
            if (n < own) { s = 0.f;
#pragma unroll
                for (int ks = 0; ks < 4; ++ks) { const LAS f32x4* kp = (const LAS f32x4*)(km + n * 128 + 32 * ks + 8 * g); const f32x4 k0 = kp[0], k1 = kp[1]; const v4u qu = __builtin_bit_cast(v4u, qf[gi][ks]);
                    s += bflo(qu.x) * k0.x + bfhi(qu.x) * k0.y + bflo(qu.y) * k0.z + bfhi(qu.y) * k0.w + bflo(qu.z) * k1.x + bfhi(qu.z) * k1.y + bflo(qu.w) * k1.z + bfhi(qu.w) * k1.w; }
                s += __shfl_xor(s, 16); s += __shfl_xor(s, 32); }
            gate[n] = s;
        }
        unsigned sm = 0u;
#pragma unroll
        for (int r = 0; r < 3; ++r) { float best = NEG_INF; int bi = 0;
#pragma unroll
            for (int n = 0; n < 7; ++n) { const bool cand = (n < own) && !((sm >> n) & 1u) && (gate[n] > best); best = cand ? gate[n] : best; bi = cand ? n : bi; }
            sm |= 1u << bi; }
        selmask[gi] = sm; }
    }
    const int nT = 4 + 4 * own;
    const int sr = tid >> 3, sc = (tid & 7) * 16;
#define A_KEY0(i) ((i) < 4 ? own * 256 + 64 * (i) : (((i) - 4) >> 2) * 256 + (((i) - 4) & 3) * 64)
    v4u kr0, kr1, vr0, vr1;
#define A_LOAD(i) do { const bf16* kp_ = PROJ + (rowbase + A_KEY0(i) + sr) * NPROJ + COL_K + h * 128 + sc; \
        kr0 = *(const GAS v4u*)kp_; kr1 = *(const GAS v4u*)(kp_ + 8); vr0 = *(const GAS v4u*)(kp_ + (COL_V - COL_K)); vr1 = *(const GAS v4u*)(kp_ + (COL_V - COL_K) + 8); } while (0)
#define A_STORE(bufi) do { LAS unsigned char* kd_ = lds + ((bufi) ? A_KB1 : A_KB0) + sr * A_KSTR + sc * 2; LAS unsigned char* vd_ = lds + ((bufi) ? A_VB1 : A_VB0) + sr * A_VSTR + sc * 2; \
        *(LAS v4u*)kd_ = kr0; *(LAS v4u*)(kd_ + 16) = kr1; *(LAS v4u*)vd_ = vr0; *(LAS v4u*)(vd_ + 16) = vr1; } while (0)
    A_LOAD(0); A_STORE(0);
    __syncthreads();
    float m_run[2] = {NEG_INF, NEG_INF}, l_run[2] = {0.f, 0.f};
    f32x4 oacc[2][8];
#pragma unroll
    for (int gi = 0; gi < 2; ++gi)
#pragma unroll
        for (int db = 0; db < 8; ++db) oacc[gi][db] = (f32x4){0.f, 0.f, 0.f, 0.f};
    for (int i = 0; i < nT; ++i) {
        if (i + 1 < nT) A_LOAD(i + 1);
        const int buf = i & 1, key0 = A_KEY0(i); const bool isown = i < 4; const int pblk = isown ? own : ((i - 4) >> 2);
        const bool skipw = isown && (64 * i > 32 * w + 31);
        if (!skipw) {
        LAS unsigned char* Kb = lds + (buf ? A_KB1 : A_KB0); LAS unsigned char* Vb = lds + (buf ? A_VB1 : A_VB0);
        f32x4 sacc[2][4];
#pragma unroll
        for (int hf = 0; hf < 2; ++hf) { bf16x8 kf[8];
#pragma unroll
            for (int n2 = 0; n2 < 2; ++n2)
#pragma unroll
                for (int ks = 0; ks < 4; ++ks) kf[n2 * 4 + ks] = *(const LAS bf16x8*)(Kb + (16 * (2 * hf + n2) + c16) * A_KSTR + (32 * ks + 8 * g) * 2);
            __builtin_amdgcn_sched_barrier(0);
#pragma unroll
            for (int gi = 0; gi < 2; ++gi)
#pragma unroll
                for (int n2 = 0; n2 < 2; ++n2) { f32x4 a = (f32x4){0.f, 0.f, 0.f, 0.f};
#pragma unroll
                    for (int ks = 0; ks < 4; ++ks) a = MFMA16(kf[n2 * 4 + ks], qf[gi][ks], a);
                    sacc[gi][2 * hf + n2] = a; }
            __builtin_amdgcn_sched_barrier(0); }
        const bool far = (key0 + 63 + 128 <= t0 + 32 * w);
        const bool diag = isown && (64 * i + 63 > 32 * w);
        bf16x8 pf[2][2];
#pragma unroll
        for (int gi = 0; gi < 2; ++gi) {
            const int tq = tq0 + 16 * gi; const bool sel = isown || ((selmask[gi] >> pblk) & 1u);
            float sv[16]; float mloc, m_new, alpha;
            if (far) {
                const float bfar = tab[127];
                float mx = fmaxf(fmaxf(sacc[gi][0][0], sacc[gi][0][1]), fmaxf(sacc[gi][0][2], sacc[gi][0][3]));
#pragma unroll
                for (int nb = 1; nb < 4; ++nb) mx = fmaxf(mx, fmaxf(fmaxf(sacc[gi][nb][0], sacc[gi][nb][1]), fmaxf(sacc[gi][nb][2], sacc[gi][nb][3])));
                mloc = sel ? (mx * SCL2 + bfar) : NEG_INF;
                mloc = fmaxf(mloc, __shfl_xor(mloc, 16)); mloc = fmaxf(mloc, __shfl_xor(mloc, 32));
                m_new = fmaxf(m_run[gi], mloc); alpha = __builtin_amdgcn_exp2f(m_run[gi] - m_new);
                const float cadd = sel ? (bfar - m_new) : NEG_INF;
#pragma unroll
                for (int nb = 0; nb < 4; ++nb)
#pragma unroll
                    for (int r = 0; r < 4; ++r) sv[nb * 4 + r] = __builtin_amdgcn_exp2f(sacc[gi][nb][r] * SCL2 + cadd);
            } else {
                const int relb = tq - key0 - 4 * g; float bias[16];
#pragma unroll
                for (int nb = 0; nb < 4; ++nb)
#pragma unroll
                    for (int r = 0; r < 4; ++r) { const int rel = relb - 16 * nb - r; int ri = rel < 0 ? 0 : rel; ri = ri > 127 ? 127 : ri; bias[nb * 4 + r] = tab[ri]; }
                PIN16(bias, 0);
                mloc = NEG_INF;
#pragma unroll
                for (int nb = 0; nb < 4; ++nb)
#pragma unroll
                    for (int r = 0; r < 4; ++r) { const int rel = relb - 16 * nb - r;
                        float s = sacc[gi][nb][r] * SCL2 + bias[nb * 4 + r]; s = (!sel || (diag && rel < 0)) ? NEG_INF : s; sv[nb * 4 + r] = s; mloc = fmaxf(mloc, s); }
                mloc = fmaxf(mloc, __shfl_xor(mloc, 16)); mloc = fmaxf(mloc, __shfl_xor(mloc, 32));
                m_new = fmaxf(m_run[gi], mloc); alpha = __builtin_amdgcn_exp2f(m_run[gi] - m_new);
#pragma unroll
                for (int e = 0; e < 16; ++e) sv[e] = __builtin_amdgcn_exp2f(sv[e] - m_new);
            }
            float psum = 0.f;
#pragma unroll
            for (int e = 0; e < 16; ++e) psum += sv[e];
            l_run[gi] = l_run[gi] * alpha + psum; m_run[gi] = m_new;
#pragma unroll
            for (int db = 0; db < 8; ++db) oacc[gi][db] = oacc[gi][db] * alpha;
            pf[gi][0] = pack8(sv); pf[gi][1] = pack8(sv + 8);
        }
        __builtin_amdgcn_sched_barrier(0);
#pragma unroll
        for (int s = 0; s < 2; ++s) { s16x4 vlo[8], vhi[8];
#pragma unroll
            for (int db = 0; db < 8; ++db) { LAS unsigned char* va = Vb + (32 * s + 4 * g + q4) * A_VSTR + (16 * db + 4 * p4) * 2; vlo[db] = TR16(va); vhi[db] = TR16(va + 16 * A_VSTR); }
            __builtin_amdgcn_sched_barrier(0);
#pragma unroll
            for (int db = 0; db < 8; ++db) { const bf16x8 vf = __builtin_shufflevector(vlo[db], vhi[db], 0, 1, 2, 3, 4, 5, 6, 7);
                oacc[0][db] = MFMA16(vf, pf[0][s], oacc[0][db]); oacc[1][db] = MFMA16(vf, pf[1][s], oacc[1][db]); }
            __builtin_amdgcn_sched_barrier(0); }
        }
        if (i + 1 < nT) A_STORE((i + 1) & 1);
        __syncthreads();
    }
    bf16* const MIXp = F.HN(); float* const ssqp = F.ssq();
#pragma unroll
    for (int gi = 0; gi < 2; ++gi) {
        const int tq = tq0 + 16 * gi;
        float l_tot = l_run[gi]; l_tot += __shfl_xor(l_tot, 16); l_tot += __shfl_xor(l_tot, 32);
        const float inv = 1.f / l_tot; float ssq = 0.f;
        bf16* orow = MIXp + (rowbase + tq) * DM + h * 128 + 4 * g;
#pragma unroll
        for (int db = 0; db < 8; ++db) { const f32x4 o = oacc[gi][db] * inv; ssq += (o.x * o.x + o.y * o.y) + (o.z * o.z + o.w * o.w); v2u wv; wv.x = pk2(o.x, o.y); wv.y = pk2(o.z, o.w); *(GAS v2u*)(orow + 16 * db) = wv; }
        ssq += __shfl_xor(ssq, 16); ssq += __shfl_xor(ssq, 32);
        if (g == 0 && doatom) unsafeAtomicAdd(ssqp + (rowbase + tq) * 4 + 1, ssq);
    }
#undef A_KEY0
#undef A_LOAD
#undef A_STORE
}

constexpr int XBC_W = CONV_CH;
__device__ __forceinline__ void conv_phase(Frame& F) {
    const bf16* const PROJ = F.PROJ(); bf16* const XBC = F.XBC(); const float* const cw = F.conv_w(); const float* const cb = F.conv_b();
    const int gt = blockIdx.x * (NWAVES * 64) + fresh_tid(), GT = F.G * NWAVES * 64;
    for (int task = gt; task < (MTOK / 32) * (CONV_CH / 8); task += GT) {
        const int r = task / (CONV_CH / 8), k = task % (CONV_CH / 8), ch = 8 * k, tok0 = 32 * r;
        float wv[4][8], bias[8];
#pragma unroll
        for (int t = 0; t < 4; ++t) { const f32x4 w0 = *(const GAS f32x4*)(cw + t * CONV_CH + ch), w1 = *(const GAS f32x4*)(cw + t * CONV_CH + ch + 4);
            wv[t][0] = w0.x; wv[t][1] = w0.y; wv[t][2] = w0.z; wv[t][3] = w0.w; wv[t][4] = w1.x; wv[t][5] = w1.y; wv[t][6] = w1.z; wv[t][7] = w1.w; }
        { const f32x4 b0 = *(const GAS f32x4*)(cb + ch), b1 = *(const GAS f32x4*)(cb + ch + 4); bias[0] = b0.x; bias[1] = b0.y; bias[2] = b0.z; bias[3] = b0.w; bias[4] = b1.x; bias[5] = b1.y; bias[6] = b1.z; bias[7] = b1.w; }
        const bf16* src = PROJ + (size_t)tok0 * NPROJ + COL_XBC + ch; bf16* dst = XBC + (size_t)tok0 * XBC_W + ch;
        v4u p0 = (v4u){0u, 0u, 0u, 0u}, p1 = p0, p2 = p0;
        if ((tok0 & (SEQ - 1)) != 0) { p0 = *(const GAS v4u*)(src - 3 * (ptrdiff_t)NPROJ); p1 = *(const GAS v4u*)(src - 2 * (ptrdiff_t)NPROJ); p2 = *(const GAS v4u*)(src - (ptrdiff_t)NPROJ); }
#pragma unroll 1
        for (int i0 = 0; i0 < 32; i0 += 8) {
            v4u cur[8];
#pragma unroll
            for (int i = 0; i < 8; ++i) cur[i] = *(const GAS v4u*)(src + (size_t)(i0 + i) * NPROJ);
#pragma unroll
            for (int i = 0; i < 8; ++i) {
                const v4u c = cur[i]; float acc[8];
                const unsigned a0[4] = {p0.x, p0.y, p0.z, p0.w}, a1[4] = {p1.x, p1.y, p1.z, p1.w}, a2[4] = {p2.x, p2.y, p2.z, p2.w}, a3[4] = {c.x, c.y, c.z, c.w};
#pragma unroll
                for (int j = 0; j < 4; ++j) {
                    acc[2 * j] = bias[2 * j] + wv[0][2 * j] * bflo(a0[j]) + wv[1][2 * j] * bflo(a1[j]) + wv[2][2 * j] * bflo(a2[j]) + wv[3][2 * j] * bflo(a3[j]);
                    acc[2 * j + 1] = bias[2 * j + 1] + wv[0][2 * j + 1] * bfhi(a0[j]) + wv[1][2 * j + 1] * bfhi(a1[j]) + wv[2][2 * j + 1] * bfhi(a2[j]) + wv[3][2 * j + 1] * bfhi(a3[j]); }
#pragma unroll
                for (int j = 0; j < 8; ++j) acc[j] = silu_f(acc[j]);
                v4u o; o.x = pk2(acc[0], acc[1]); o.y = pk2(acc[2], acc[3]); o.z = pk2(acc[4], acc[5]); o.w = pk2(acc[6], acc[7]);
                *(GAS v4u*)(dst + (size_t)(i0 + i) * XBC_W) = o;
                p0 = p1; p1 = p2; p2 = c; }
        }
    }
    { const float* const dtraw = F.dtraw(); float* const dt2 = F.DT2(); const float* const dtb = F.dt_bias();
      for (int i = gt; i < MTOK * 16; i += GT) { const float xr = dtraw[i] + dtb[i & 15]; dt2[i] = xr > 20.f ? xr : log1pf(__expf(xr)); } }
}

constexpr int S_BSTR = 272, S_XSTR = 144;
constexpr int S_BM = 0, S_CM = 128 * S_BSTR, S_X = 2 * 128 * S_BSTR, S_XW = S_X + 128 * S_XSTR, S_HB = S_XW + 128 * S_XSTR, S_DT = S_HB + 64 * S_BSTR, S_CS = S_DT + 512, S_DA = S_CS + 512, S_END = S_DA + 512;
static_assert(S_END <= RING_BYTES, "ssd LDS map");
__device__ __forceinline__ void ssd_unit(Frame& F, int b, int h, const bool doatom = true) {
    LAS unsigned char* lds = F.lds + RING_OFF;
    const int tid = fresh_tid(), lane = tid & 63, w = __builtin_amdgcn_readfirstlane(tid >> 6), g = lane >> 4, c16 = lane & 15, q4 = c16 >> 2, p4 = lane & 3;
    const int g8 = h >> 3, pbw = w & 3, nhw = w >> 2;
    const float a_h = -__expf(F.a_log()[h]), dsk = F.d_skip()[h];
    const bf16* const PROJ = F.PROJ(); bf16* const MIX = F.HN(); const float* const dt2 = F.DT2(); const bf16* const XBC = F.XBC(); float* const ssqp = F.ssq();
    LAS float* dtl = (LAS float*)(lds + S_DT); LAS float* csl = (LAS float*)(lds + S_CS); LAS float* dal = (LAS float*)(lds + S_DA);
    for (int i = tid; i < 64 * S_BSTR / 16; i += NWAVES * 64) ((LAS v4u*)(lds + S_HB))[i] = (v4u){0u, 0u, 0u, 0u};
    f32x4 hacc[4];
#pragma unroll
    for (int i = 0; i < 4; ++i) hacc[i] = (f32x4){0.f, 0.f, 0.f, 0.f};
    const int xl = tid >> 3, xc = tid & 7, bl = tid >> 4, bc = tid & 15;
    v4u xr[2], br[4], cr[4]; float dtv = 0.f;
#define S_PREFETCH(cc) do { const size_t t0_ = (size_t)b * SEQ + (size_t)(cc) * SSM_L; \
        _Pragma("unroll") for (int i_ = 0; i_ < 2; ++i_) xr[i_] = *(const GAS v4u*)(XBC + (t0_ + xl + 64 * i_) * XBC_W + h * 64 + 8 * xc); \
        _Pragma("unroll") for (int i_ = 0; i_ < 4; ++i_) { const bf16* p_ = XBC + (t0_ + bl + 32 * i_) * XBC_W + 1024 + g8 * 128 + 8 * bc; br[i_] = *(const GAS v4u*)p_; cr[i_] = *(const GAS v4u*)(p_ + 256); } \
        if (tid < 128) dtv = dt2[(t0_ + tid) * 16 + h]; } while (0)
    S_PREFETCH(0);
    for (int c = 0; c < SSM_NC; ++c) {
        const size_t tok0 = (size_t)b * SEQ + (size_t)c * SSM_L;
        if (tid < 128) { dtl[tid] = dtv; dal[tid] = dtv * a_h; }
        __syncthreads();
        if (w == 0) { const float v0 = dal[2 * lane], v1 = dal[2 * lane + 1]; float s = v0 + v1;
#pragma unroll
            for (int o = 1; o < 64; o <<= 1) { const float t = __shfl_up(s, o); s += (lane >= o) ? t : 0.f; }
            csl[2 * lane] = s - v1; csl[2 * lane + 1] = s; }
        __syncthreads();
        const float cs_last = csl[127];
#pragma unroll
        for (int i = 0; i < 2; ++i) { const int l = xl + 64 * i; const v4u v = xr[i]; *(LAS v4u*)(lds + S_X + l * S_XSTR + xc * 16) = v; const float wl = dtl[l] * __expf(cs_last - csl[l]);
            v4u o2; o2.x = pk2(bflo(v.x) * wl, bfhi(v.x) * wl); o2.y = pk2(bflo(v.y) * wl, bfhi(v.y) * wl); o2.z = pk2(bflo(v.z) * wl, bfhi(v.z) * wl); o2.w = pk2(bflo(v.w) * wl, bfhi(v.w) * wl);
            *(LAS v4u*)(lds + S_XW + l * S_XSTR + xc * 16) = o2; }
#pragma unroll
        for (int i = 0; i < 4; ++i) { const int l = bl + 32 * i; *(LAS v4u*)(lds + S_BM + l * S_BSTR + bc * 16) = br[i]; *(LAS v4u*)(lds + S_CM + l * S_BSTR + bc * 16) = cr[i]; }
        const int lrow = 16 * w + c16;
        v2u zr[4];
#pragma unroll
        for (int pb = 0; pb < 4; ++pb) zr[pb] = *(const GAS v2u*)(PROJ + (tok0 + lrow) * NPROJ + COL_Z + h * 64 + 16 * pb + 4 * g);
        if (c + 1 < SSM_NC) S_PREFETCH(c + 1);
        __syncthreads();
        bf16x8 cf[4];
#pragma unroll
        for (int ks = 0; ks < 4; ++ks) cf[ks] = *(const LAS bf16x8*)(lds + S_CM + lrow * S_BSTR + (32 * ks + 8 * g) * 2);
        f32x4 yacc[4];
        const float cs_l = csl[lrow]; const float el = __expf(cs_l);
#pragma unroll
        for (int pb = 0; pb < 4; ++pb) { yacc[pb] = (f32x4){0.f, 0.f, 0.f, 0.f};
#pragma unroll
            for (int ks = 0; ks < 4; ++ks) { const bf16x8 hf = *(const LAS bf16x8*)(lds + S_HB + (16 * pb + c16) * S_BSTR + (32 * ks + 8 * g) * 2); yacc[pb] = MFMA16(hf, cf[ks], yacc[pb]); }
            yacc[pb] = yacc[pb] * el; }
        for (int s2 = 0; s2 <= (w >> 1); ++s2) {
            const int sb0 = 2 * s2, sb1 = 2 * s2 + 1; const bool has1 = sb1 <= w;
            f32x4 cb0 = (f32x4){0.f, 0.f, 0.f, 0.f}, cb1 = (f32x4){0.f, 0.f, 0.f, 0.f};
#pragma unroll
            for (int ks = 0; ks < 4; ++ks) { const bf16x8 bf0 = *(const LAS bf16x8*)(lds + S_BM + (16 * sb0 + c16) * S_BSTR + (32 * ks + 8 * g) * 2); cb0 = MFMA16(bf0, cf[ks], cb0); }
            if (has1) {
#pragma unroll
                for (int ks = 0; ks < 4; ++ks) { const bf16x8 bf1 = *(const LAS bf16x8*)(lds + S_BM + (16 * sb1 + c16) * S_BSTR + (32 * ks + 8 * g) * 2); cb1 = MFMA16(bf1, cf[ks], cb1); } }
            float mv[8];
#pragma unroll
            for (int r = 0; r < 4; ++r) { const int s = 16 * sb0 + 4 * g + r; const float e = __expf(fminf(cs_l - csl[s], 0.f)) * dtl[s]; mv[r] = (s <= lrow) ? cb0[r] * e : 0.f; }
#pragma unroll
            for (int r = 0; r < 4; ++r) { const int s = 16 * sb1 + 4 * g + r; const int sc_ = s > 127 ? 127 : s; const float e = __expf(fminf(cs_l - csl[sc_], 0.f)) * dtl[sc_]; mv[4 + r] = (has1 && s <= lrow) ? cb1[r] * e : 0.f; }
            const bf16x8 pf = pack8(mv);
#pragma unroll
            for (int pb = 0; pb < 4; ++pb) { LAS unsigned char* xa = lds + S_X + (32 * s2 + 4 * g + q4) * S_XSTR + (16 * pb + 4 * p4) * 2;
                const s16x4 lo = TR16(xa), hi = TR16(xa + 16 * S_XSTR); const bf16x8 xf = __builtin_shufflevector(lo, hi, 0, 1, 2, 3, 4, 5, 6, 7);
                yacc[pb] = MFMA16(xf, pf, yacc[pb]); }
        }
        { const size_t tok = tok0 + lrow; float ssq = 0.f;
#pragma unroll
          for (int pb = 0; pb < 4; ++pb) { const int p0 = 16 * pb + 4 * g;
              const v2u xs_ = *(const LAS v2u*)(lds + S_X + lrow * S_XSTR + p0 * 2);
              const v2u zr_ = zr[pb];
              const float o0 = (yacc[pb].x + bflo(xs_.x) * dsk) * silu_f(bflo(zr_.x)), o1 = (yacc[pb].y + bfhi(xs_.x) * dsk) * silu_f(bfhi(zr_.x));
              const float o2 = (yacc[pb].z + bflo(xs_.y) * dsk) * silu_f(bflo(zr_.y)), o3 = (yacc[pb].w + bfhi(xs_.y) * dsk) * silu_f(bfhi(zr_.y));
              ssq += (o0 * o0 + o1 * o1) + (o2 * o2 + o3 * o3);
              v2u wv; wv.x = pk2(o0, o1); wv.y = pk2(o2, o3); *(GAS v2u*)(MIX + tok * DM + ATT_W + h * 64 + p0) = wv; }
          ssq += __shfl_xor(ssq, 16); ssq += __shfl_xor(ssq, 32);
          if (g == 0 && doatom) unsafeAtomicAdd(ssqp + tok * 4 + 2 + g8, ssq); }
        { const float cdec = __expf(cs_last);
#pragma unroll
          for (int i = 0; i < 4; ++i) hacc[i] = hacc[i] * cdec;
#pragma unroll
          for (int ks = 0; ks < 4; ++ks) {
              LAS unsigned char* xa = lds + S_XW + (32 * ks + 8 * g + q4) * S_XSTR + (16 * pbw + 4 * p4) * 2;
              const s16x4 xlo = TR16(xa), xhi = TR16(xa + 4 * S_XSTR); const bf16x8 xf = __builtin_shufflevector(xlo, xhi, 0, 1, 2, 3, 4, 5, 6, 7);
#pragma unroll
              for (int i = 0; i < 4; ++i) { const int nb = 4 * nhw + i; LAS unsigned char* ba = lds + S_BM + (32 * ks + 8 * g + q4) * S_BSTR + (16 * nb + 4 * p4) * 2;
                  const s16x4 blo = TR16(ba), bhi = TR16(ba + 4 * S_BSTR); const bf16x8 bfr = __builtin_shufflevector(blo, bhi, 0, 1, 2, 3, 4, 5, 6, 7);
                  hacc[i] = MFMA16(bfr, xf, hacc[i]); } } }
        __syncthreads();
#pragma unroll
        for (int i = 0; i < 4; ++i) { const int nb = 4 * nhw + i; v2u o; o.x = pk2(hacc[i].x, hacc[i].y); o.y = pk2(hacc[i].z, hacc[i].w);
            *(LAS v2u*)(lds + S_HB + (16 * pbw + c16) * S_BSTR + (16 * nb + 4 * g) * 2) = o; }
    }
#undef S_PREFETCH
    __syncthreads();
}

__device__ __forceinline__ void mix_normalize(Frame& F) {
    const int tid_ = fresh_tid(), lane = tid_ & 63; const int gw = blockIdx.x * NWAVES + __builtin_amdgcn_readfirstlane(tid_ >> 6), NGW = F.G * NWAVES;
    const float* const ssqp = F.ssq(); bf16* const MIX = F.HN(); const float* const gatt = F.attn_out_norm(); const float* const gssm = F.ssm_out_norm();
    for (int m = gw; m < MTOK; m += NGW) {
        const float* sq = ssqp + (size_t)m * 4;
        const float s1 = __hip_atomic_load(sq + 1, RLX_AGENT), s2 = __hip_atomic_load(sq + 2, RLX_AGENT), s3 = __hip_atomic_load(sq + 3, RLX_AGENT);
        const float ra = 1.f / sqrtf(s1 * (1.f / 1024.f) + EPS), r0 = 1.f / sqrtf(s2 * (1.f / 512.f) + EPS), r1 = 1.f / sqrtf(s3 * (1.f / 512.f) + EPS);
        GAS v4u* row = (GAS v4u*)(MIX + (size_t)m * DM);
#pragma unroll
        for (int j = 0; j < 4; ++j) { const int idx = lane + 64 * j, col = 8 * idx; const float rs = (j < 2) ? ra : ((j == 2) ? r0 : r1);
            const float* gp = (j < 2) ? (gatt + col) : (gssm + (col - ATT_W));
            const f32x4 g0 = *(const GAS f32x4*)gp, g1 = *(const GAS f32x4*)(gp + 4); const v4u v = row[idx]; v4u o;
            o.x = pk2(bflo(v.x) * rs * g0.x, bfhi(v.x) * rs * g0.y); o.y = pk2(bflo(v.y) * rs * g0.z, bfhi(v.y) * rs * g0.w);
            o.z = pk2(bflo(v.z) * rs * g1.x, bfhi(v.z) * rs * g1.y); o.w = pk2(bflo(v.w) * rs * g1.z, bfhi(v.w) * rs * g1.w); row[idx] = o; }
    }
}

constexpr int P_EIDX = 0, P_GATE = 16384, P_LST = 32768, P_HN = 65536, P_ACT = 98304, P_END = 102400;
static_assert(P_END <= RING_BYTES, "peer LDS map");
__constant__ unsigned char PEER_CAND[52] = {0, 1, 2, 3, 4, 5, 6, 7, 8, 9, 10, 11, 12, 13, 14, 15, 16, 17, 18, 19, 20, 21, 22, 23, 32, 33, 34, 35, 36, 48, 49, 50, 51, 64, 65, 66, 80, 81, 96, 97, 112, 113, 128, 144, 160, 176, 192, 208, 224, 240, 255, 255};
__device__ __forceinline__ unsigned f2ord(float f) { const unsigned u = __builtin_bit_cast(unsigned, f); return u ^ ((u >> 31) ? 0xFFFFFFFFu : 0x80000000u); }
__device__ __forceinline__ float ord2f(unsigned u) { return __builtin_bit_cast(float, u ^ ((u >> 31) ? 0x80000000u : 0xFFFFFFFFu)); }
#define CSWAPD(a, b) do { const unsigned hi_ = (a) > (b) ? (a) : (b), lo_ = (a) > (b) ? (b) : (a); (a) = hi_; (b) = lo_; } while (0)
template <int N> __device__ __forceinline__ void bitonic_sort_desc(unsigned (&v)[N]) {
#pragma unroll
    for (int k = 2; k <= N; k <<= 1)
#pragma unroll
        for (int j = k >> 1; j > 0; j >>= 1)
#pragma unroll
            for (int i = 0; i < N; ++i) { const int l = i ^ j; if (l > i) { if ((i & k) == 0) CSWAPD(v[i], v[l]); else CSWAPD(v[l], v[i]); } }
}
__device__ __forceinline__ void merge16_xor(unsigned (&v)[16], int dist) {
    unsigned o[16];
#pragma unroll
    for (int i = 0; i < 16; ++i) o[i] = (unsigned)__shfl_xor((int)v[i], dist);
#pragma unroll
    for (int i = 0; i < 16; ++i) v[i] = v[i] > o[15 - i] ? v[i] : o[15 - i];
#pragma unroll
    for (int j = 8; j > 0; j >>= 1)
#pragma unroll
        for (int i = 0; i < 16; ++i) { const int l = i ^ j; if (l > i) CSWAPD(v[i], v[l]); }
}
__device__ __forceinline__ float gelu_erf(float x) { return 0.5f * x * (1.f + erff(x * 0.70710678118654752f)); }
__device__ __forceinline__ float fp4_dec1(unsigned n) { const unsigned m = n & 7u; unsigned bits = (m >= 2u) ? (((126u + (m >> 1)) << 23) | ((m & 1u) << 22)) : (m ? 0x3F000000u : 0u); bits |= (n & 8u) << 28; return __builtin_bit_cast(float, bits); }
__device__ __forceinline__ f32x2 fp4_dec2(unsigned x) { f32x2 r; r.x = fp4_dec1(x & 15u); r.y = fp4_dec1((x >> 4) & 15u); return r; }
typedef long i64;
typedef int v8i __attribute__((ext_vector_type(8)));
__device__ __forceinline__ void peer_unit(Frame& F, int u, const bool dry = false) {
    LAS unsigned char* lds = F.lds + RING_OFF;
    const int tid_ = fresh_tid(), lane = tid_ & 63, w = __builtin_amdgcn_readfirstlane(tid_ >> 6), g = lane >> 4, c16 = lane & 15;
    const int T0 = 32 * u;
    LAS int* eidx = (LAS int*)(lds + P_EIDX); LAS float* gate = (LAS float*)(lds + P_GATE);
    LAS unsigned* lst = (LAS unsigned*)(lds + P_LST) + w * 1024;
    const bf16* const QP = F.QP(); const bf16* const SK = F.SK(); float* const outp = F.out(); const bf16* const X1B = F.X1B(); const float* const fgain = F.ffn_norm(); const float* const fing = F.final_norm(); const unsigned char* const U8 = F.U8(); const unsigned char* const V8 = F.V8();
#ifndef NO_ROUTE
    for (int tb = 0; tb < 2; ++tb) {
        for (int c = 0; c < 2; ++c) {
            const int p = 2 * w + c;
            bf16x8 qf[4];
            { const unsigned qo = ((unsigned)(T0 + 16 * tb + c16) * (unsigned)DM + (unsigned)(p * 128 + 8 * g)) * 2u;
#pragma unroll
              for (int ks = 0; ks < 4; ++ks) qf[ks] = __builtin_nontemporal_load((const GAS bf16x8*)((const unsigned char*)QP + (qo + 64u * ks))); }
            unsigned key[32];
#pragma unroll
            for (int kb = 0; kb < 8; ++kb) { f32x4 acc = (f32x4){0.f, 0.f, 0.f, 0.f};
                const unsigned so = ((unsigned)(p * 128 + 16 * kb + c16) * 128u + 8u * (unsigned)g) * 2u;
#pragma unroll
                for (int ks = 0; ks < 4; ++ks) { const bf16x8 sf = *(const GAS bf16x8*)((const unsigned char*)SK + (so + 64u * ks)); acc = MFMA16(sf, qf[ks], acc); }
#pragma unroll
                for (int r = 0; r < 4; ++r) key[kb * 4 + r] = (f2ord(acc[r]) & ~0x7Fu) | (unsigned)(16 * kb + 4 * g + r);
                __builtin_amdgcn_sched_barrier(0); }
            bitonic_sort_desc<32>(key);
            unsigned top[16];
#pragma unroll
            for (int i = 0; i < 16; ++i) top[i] = key[i];
            merge16_xor(top, 16); merge16_xor(top, 32);
            if (g == 0) { LAS v4u* d = (LAS v4u*)(lst + (c * 32 + 16 * tb + c16) * 16);
                d[0] = (v4u){top[0], top[1], top[2], top[3]}; d[1] = (v4u){top[4], top[5], top[6], top[7]}; d[2] = (v4u){top[8], top[9], top[10], top[11]}; d[3] = (v4u){top[12], top[13], top[14], top[15]}; }
        }
        LDS_WAIT();
        const LAS unsigned* l1 = lst + (16 * tb + c16) * 16; const LAS unsigned* l2 = lst + (32 + 16 * tb + c16) * 16;
        unsigned ck[16];
#pragma unroll
        for (int k = 0; k < 13; ++k) { const unsigned ab = PEER_CAND[4 * k + g]; const unsigned a = ab >> 4, bq = ab & 15u;
            const float s = ord2f(l1[a] & ~0x7Fu) + ord2f(l2[bq] & ~0x7Fu); ck[k] = (ab == 255u) ? 0u : ((f2ord(s) & ~0xFFu) | ab); }
        ck[13] = 0u; ck[14] = 0u; ck[15] = 0u;
        bitonic_sort_desc<16>(ck);
        merge16_xor(ck, 16); merge16_xor(ck, 32);
        if (g == 0) { const int tl = 16 * tb + c16; const float m = ord2f(ck[0] & ~0xFFu); float e[16]; float sum = 0.f;
#pragma unroll
            for (int k = 0; k < 16; ++k) { e[k] = __expf(ord2f(ck[k] & ~0xFFu) - m); sum += e[k]; }
            const float inv = 1.f / sum;
#pragma unroll
            for (int k = 0; k < 16; ++k) { const unsigned a = (ck[k] >> 4) & 15u, bq = ck[k] & 15u; const int ex = (int)((l1[a] & 0x7Fu) * 128u + (l2[bq] & 0x7Fu));
                eidx[tl * 128 + w * 16 + k] = ex; gate[tl * 128 + w * 16 + k] = e[k] * inv; } }
    }
#endif
    __syncthreads();
    LAS unsigned char* hnb = lds + P_HN + w * 4096; LAS float* actl = (LAS float*)(lds + P_ACT) + w * 128;
    const LAS unsigned char* hb = hnb + 16 * g + ((c16 == 1) ? 1024 : 0);
    v4u bA[8], bB[8];
#define U_ISSUE(buf, e_, jb) do { const unsigned uo_ = (unsigned)(e_) * (unsigned)ROWB + 16u * (unsigned)g + 512u * (unsigned)(jb); \
        _Pragma("unroll") for (int jj = 0; jj < 8; ++jj) buf[jj] = *(const GAS v4u*)(U8 + (uo_ + 64u * jj)); __builtin_amdgcn_sched_barrier(0); } while (0)
#define U_CONSUME(buf, jb) do { v4u bq_[8]; _Pragma("unroll") for (int jj = 0; jj < 8; ++jj) bq_[jj] = *(const LAS v4u*)(hb + 64 * (8 * (jb) + jj)); \
        __builtin_amdgcn_sched_barrier(0); \
        _Pragma("unroll") for (int jj = 0; jj < 8; ++jj) { const v4u a_ = buf[jj]; \
            const v8i av_ = {(int)a_.x, (int)a_.y, (int)a_.z, (int)a_.w, 0, 0, 0, 0}; const v8i bv_ = {(int)bq_[jj].x, (int)bq_[jj].y, (int)bq_[jj].z, (int)bq_[jj].w, 0, 0, 0, 0}; \
            acc = __builtin_amdgcn_mfma_scale_f32_16x16x128_f8f6f4(av_, bv_, acc, 4, 4, 0, 0x7f7f7f7f, 0, 0x7f7f7f7f); } __builtin_amdgcn_sched_barrier(0); } while (0)
#define U_ACT(grp_) do { const float l0_ = __shfl_down(acc.x, 1), l1_ = __shfl_down(acc.y, 1), l2_ = __shfl_down(acc.z, 1), l3_ = __shfl_down(acc.w, 1); \
        if (c16 == 0) { const int k0 = 16 * (grp_) + 4 * g; constexpr float isc = 1.f / (SU * SH4), ilo = 1.f / SLO4; const f32x4 gt = *(const LAS f32x4*)(gate + tl * 128 + k0); \
        f32x4 a4; a4.x = gelu_erf((acc.x + l0_ * ilo) * isc) * gt.x; a4.y = gelu_erf((acc.y + l1_ * ilo) * isc) * gt.y; a4.z = gelu_erf((acc.z + l2_ * ilo) * isc) * gt.z; a4.w = gelu_erf((acc.w + l3_ * ilo) * isc) * gt.w; *(LAS f32x4*)(actl + k0) = a4; } } while (0)
#define V_ISSUE(buf, kb_) do { _Pragma("unroll") for (int kk = 0; kk < 8; ++kk) { const int e_ = eidx[tl * 128 + 8 * (kb_) + kk]; const unsigned vo_ = (unsigned)e_ * (unsigned)ROWB + 16u * (unsigned)lane; \
        buf[kk] = *(const GAS v4u*)(V8 + vo_); } __builtin_amdgcn_sched_barrier(0); } while (0)
#ifdef FP4_SOFT_DEC
#define FP4_DEC(x) fp4_dec2(x)
#else
#define FP4_DEC(x) __builtin_amdgcn_cvt_scalef32_pk_f32_fp4((x), 1.0f, 0)
#endif
#ifdef FP4_SWAP_DEC
#define FP4_ACC(oa, ob, d) do { oa += a_ * d.y; ob += a_ * d.x; } while (0)
#else
#define FP4_ACC(oa, ob, d) do { oa += a_ * d.x; ob += a_ * d.y; } while (0)
#endif
#define PIN8x2(a, i) asm volatile("" : "+v"(a[i]), "+v"(a[i + 1]), "+v"(a[i + 2]), "+v"(a[i + 3]), "+v"(a[i + 4]), "+v"(a[i + 5]), "+v"(a[i + 6]), "+v"(a[i + 7]))
#define V_CONSUME(buf, kb_) do { _Pragma("unroll") for (int kk = 0; kk < 8; ++kk) { const float as_ = actl[8 * (kb_) + kk]; const f32x2 a2_ = {as_, as_}; \
        const unsigned vw[4] = {buf[kk].x, buf[kk].y, buf[kk].z, buf[kk].w}; \
        _Pragma("unroll") for (int q = 0; q < 4; ++q) { \
            o2[4 * q]     = __builtin_elementwise_fma(__builtin_amdgcn_cvt_scalef32_pk_f32_fp4(vw[q], 1.0f, 0), a2_, o2[4 * q]); \
            o2[4 * q + 1] = __builtin_elementwise_fma(__builtin_amdgcn_cvt_scalef32_pk_f32_fp4(vw[q], 1.0f, 1), a2_, o2[4 * q + 1]); \
            o2[4 * q + 2] = __builtin_elementwise_fma(__builtin_amdgcn_cvt_scalef32_pk_f32_fp4(vw[q], 1.0f, 2), a2_, o2[4 * q + 2]); \
            o2[4 * q + 3] = __builtin_elementwise_fma(__builtin_amdgcn_cvt_scalef32_pk_f32_fp4(vw[q], 1.0f, 3), a2_, o2[4 * q + 3]); } \
        PIN8x2(o2, 0); PIN8x2(o2, 8); } } while (0)
#ifndef NO_GATHER
    int e_cur = eidx[w * 128 + c16];
    v2u xn[8];
#define X_ISSUE(tok_) do { const unsigned xb_ = (unsigned)(tok_) * (unsigned)(DM * 2) + 8u * (unsigned)lane; _Pragma("unroll") for (int j = 0; j < 8; ++j) xn[j] = __builtin_nontemporal_load((const GAS v2u*)((const unsigned char*)X1B + (xb_ + 512u * j))); } while (0)
    X_ISSUE(T0 + w);
    U_ISSUE(bA, e_cur, 0);
    for (int ti = 0; ti < 4; ++ti) {
        const int tl = w + 8 * ti; const size_t token = (size_t)T0 + tl;
        f32x4 xr[8]; float ss = 0.f;
        const unsigned xo = (unsigned)token * (unsigned)(DM * 4) + 16u * (unsigned)lane;
        {
#pragma unroll
          for (int j = 0; j < 8; ++j) { const v2u r = xn[j]; xr[j] = (f32x4){bflo(r.x), bfhi(r.x), bflo(r.y), bfhi(r.y)}; }
#pragma unroll
          for (int j = 0; j < 8; ++j) ss += (xr[j].x * xr[j].x + xr[j].y * xr[j].y) + (xr[j].z * xr[j].z + xr[j].w * xr[j].w); }
        const float rs2 = __builtin_amdgcn_rsqf(wave_sum(ss) * (1.f / DM) + EPS);
        {
          const float* fg_ = fgain; asm volatile("" : "+s"(fg_));
          const unsigned char* gp = (const unsigned char*)fg_; const unsigned go = 16u * (unsigned)lane;
          unsigned hw[4], lw[4];
#pragma unroll
          for (int q = 0; q < 4; ++q) { unsigned wh = 0u, wl = 0u;
#pragma unroll
              for (int t = 0; t < 2; ++t) { const int j = 2 * q + t; const f32x4 gg = *(const GAS f32x4*)(gp + (go + 1024u * j)); const f32x4 hv = xr[j] * gg * (rs2 * SH4);
                  const float h0 = clampf(hv.x, 6.f), h1 = clampf(hv.y, 6.f), h2 = clampf(hv.z, 6.f), h3 = clampf(hv.w, 6.f);
                  const unsigned p0 = __builtin_amdgcn_cvt_scalef32_pk_fp4_f32(0u, h0, h1, 1.0f, 0), p1 = __builtin_amdgcn_cvt_scalef32_pk_fp4_f32(0u, h2, h3, 1.0f, 0);
                  const f32x2 d0 = __builtin_amdgcn_cvt_scalef32_pk_f32_fp4(p0, 1.0f, 0), d1 = __builtin_amdgcn_cvt_scalef32_pk_f32_fp4(p1, 1.0f, 0);
                  const unsigned r0 = __builtin_amdgcn_cvt_scalef32_pk_fp4_f32(0u, clampf((h0 - d0.x) * SLO4, 6.f), clampf((h1 - d0.y) * SLO4, 6.f), 1.0f, 0), r1 = __builtin_amdgcn_cvt_scalef32_pk_fp4_f32(0u, clampf((h2 - d1.x) * SLO4, 6.f), clampf((h3 - d1.y) * SLO4, 6.f), 1.0f, 0);
                  wh |= ((p0 & 0xFFu) | ((p1 & 0xFFu) << 8)) << (16 * t); wl |= ((r0 & 0xFFu) | ((r1 & 0xFFu) << 8)) << (16 * t); }
              hw[q] = wh; lw[q] = wl; }
          *(LAS v4u*)(hnb + 16 * lane) = (v4u){hw[0], hw[1], hw[2], hw[3]}; *(LAS v4u*)(hnb + 1024 + 16 * lane) = (v4u){lw[0], lw[1], lw[2], lw[3]}; }
        LDS_WAIT();
#pragma unroll 1
        for (int grp = 0; grp < 8; ++grp) {
            const int gn = grp < 7 ? grp + 1 : 7;
            const int e_nxt = eidx[tl * 128 + 16 * gn + c16];
            f32x4 acc = (f32x4){0.f, 0.f, 0.f, 0.f};
            U_ISSUE(bB, e_cur, 1); U_CONSUME(bA, 0);
            if (grp < 7) U_ISSUE(bA, e_nxt, 0); else V_ISSUE(bA, 0);
            U_CONSUME(bB, 1);
            U_ACT(grp);
            e_cur = e_nxt;
        }
        LDS_WAIT();
        f32x2 o2[16];
#pragma unroll
        for (int i = 0; i < 16; ++i) o2[i] = (f32x2){0.f, 0.f};
#pragma unroll 1
        for (int kb = 0; kb < 16; kb += 2) {
            V_ISSUE(bB, kb + 1); V_CONSUME(bA, kb);
            if (kb + 2 < 16) V_ISSUE(bA, kb + 2);
            else if (ti < 3) { e_cur = eidx[(tl + 8) * 128 + c16]; X_ISSUE(token + 8); U_ISSUE(bA, e_cur, 0); }
            V_CONSUME(bB, kb + 1);
        }
        { constexpr float isv = 1.f / SV; float s2 = 0.f;
#pragma unroll
          for (int j = 0; j < 8; ++j) { xr[j] = xr[j] + (f32x4){o2[2 * j].x, o2[2 * j].y, o2[2 * j + 1].x, o2[2 * j + 1].y} * isv;
              s2 += (xr[j].x * xr[j].x + xr[j].y * xr[j].y) + (xr[j].z * xr[j].z + xr[j].w * xr[j].w); }
          const float rf = __builtin_amdgcn_rsqf(wave_sum(s2) * (1.f / DM) + EPS);
          const float* fi_ = fing; asm volatile("" : "+s"(fi_));
          const unsigned char* fp = (const unsigned char*)fi_; unsigned char* op = (unsigned char*)outp; const unsigned fo = 16u * (unsigned)lane;
          if (!dry || rf == 1.2345e30f)
#pragma unroll
          for (int j = 0; j < 8; ++j) __builtin_nontemporal_store(xr[j] * rf * *(const GAS f32x4*)(fp + (fo + 1024u * j)), (GAS f32x4*)(op + (xo + 1024u * j))); }
    }
#endif
#undef U_ISSUE
#undef X_ISSUE
#undef U_ACT
#undef U_CONSUME
#undef V_ISSUE
#undef V_CONSUME
    __syncthreads();
}

__global__ void __launch_bounds__(NWAVES * 64, 2) hybrid_fwd(Args args) {
    extern __shared__ __attribute__((aligned(16))) unsigned char lds[];
    Frame F;
    F.lds = (LAS unsigned char*)lds;
    F.MISC = (volatile LAS unsigned*)(F.lds + MISC_OFF);
    F.tid = threadIdx.x; F.lane = F.tid & 63; F.wave = __builtin_amdgcn_readfirstlane(F.tid >> 6); F.G = gridDim.x;
    for (int u = F.tid; u < (LDS_BYTES - LDSCTL_OFF) / 4; u += NWAVES * 64) ((LAS unsigned*)(F.lds + LDSCTL_OFF))[u] = 0u;
    __syncthreads();
    (void)args;
    XcdBarrier bar = xcd_barrier_post(F.ctl() + CW_BAR, F.MISC + 8);

#ifndef NO_P0
#ifdef PROBE_P0X2
    { int reps = 2; asm volatile("" : "+s"(reps)); for (int rep = 0; rep < reps; ++rep) p0_prologue(F); }
#else
    p0_prologue(F);
#endif
#endif
    xcd_barrier(bar);
#ifndef NO_P1
#ifdef PROBE_GX2
    { int reps = 2; asm volatile("" : "+s"(reps)); for (int rep = 0; rep < reps; ++rep) {
#else
    { { const int rep = 0, reps = 1;
#endif
      pg8::Gemm gm{F.HN(), F.WinT(), MTOK, NB16, DM}; pg8::StaticOrder S; S.init(MTOK, NB16, F.G, (int)blockIdx.x);
      EpiProj E{F.PROJ(), F.dtraw(), (rep + 1 < reps) ? nullptr : F.kmean()};
      pg8::gemm_phase<EpiProj, pg8::StaticOrder, PG8_ALIGN, PG8_SP2>(F.lds + RING_OFF, gm, S, E); } }
    { const int nun = (MTOK / 256) * (NB16 / 256), rem = nun % F.G;
      if (rem && (int)blockIdx.x >= rem) tables_convert(F, tab_split(F.G), TAB_ITEMS, (size_t)((int)blockIdx.x - rem) * (NWAVES * 64) + fresh_tid(), (size_t)(F.G - rem) * (NWAVES * 64)); }
    __syncthreads();
    {
      pg8::Gemm gm{(const pg8::bf16_t*)F.HN8(), (const pg8::bf16_t*)F.WinT8(), MTOK, F8_HI - F8_LO, DM / 2}; pg8::StaticOrder S; S.init(MTOK, F8_HI - F8_LO, F.G, (int)blockIdx.x);
      EpiProj8 E{F.PROJ()};
      pg8::gemm_phase<EpiProj8, pg8::StaticOrder, PG8_ALIGN, PG8_SP2, true>(F.lds + RING_OFF, gm, S, E); }
#endif
    xcd_barrier(bar);
#ifdef PROBE_P15X2
    conv_phase(F);
#endif
    conv_phase(F);
    xcd_barrier(bar);
#ifdef PROBE_P2X2
    { int reps = 2; asm volatile("" : "+s"(reps)); for (int rep = 0; rep < reps; ++rep) {
#else
    { { const int rep = 0, reps = 1;
#endif
    const bool doatom = rep + 1 == reps;
    for (;;) {
        if (F.tid == 0) F.MISC[0] = xb_add(F.ctl() + CW_Q2 + 64 * rep, 1u);
        __syncthreads();
        const int ui = (int)F.MISC[0];
        __syncthreads();
        if (ui >= 128 + 512) break;
#ifdef PROBE_P2_SSD
        if (ui < 128 || doatom)
#endif
#ifdef PROBE_P2_ATT
        if (ui >= 128 || doatom)
#endif
        {
        if (ui < 128) ssd_unit(F, ui >> 4, ui & 15, doatom);
        else { const int a = ui - 128; attn_unit(F, (a & 63) >> 3, a & 7, 7 - (a >> 6), doatom); }
        }
    } } }
    xcd_barrier(bar);
#ifndef NO_P3
#ifdef PROBE_GX2
    { int reps = 2; asm volatile("" : "+s"(reps)); for (int rep = 0; rep < reps; ++rep) {
#else
    { { const int rep = 0, reps = 1;
#endif
      pg8::Gemm gm{F.HN(), F.WoutT(), MTOK, DM, DM}; pg8::StaticOrder S; S.init(MTOK, DM, F.G, (int)blockIdx.x);
      {
        const int t_ = fresh_tid(); const float* const sq = F.ssq();
#pragma unroll 1
        for (int ii = t_ >> 8; ii < 3; ii += 2) { pg8::Unit uu;
          if (S.next(ii, uu)) { const int row = uu.pm * 256 + (t_ & 255);
            const float q1 = __hip_atomic_load(sq + (size_t)row * 4 + 1, RLX_AGENT), q2 = __hip_atomic_load(sq + (size_t)row * 4 + 2, RLX_AGENT), q3 = __hip_atomic_load(sq + (size_t)row * 4 + 3, RLX_AGENT);
            const float sa = __builtin_amdgcn_rsqf(q1 * (1.f / 1024.f) + EPS), s0 = __builtin_amdgcn_rsqf(q2 * (1.f / 512.f) + EPS), s1 = __builtin_amdgcn_rsqf(q3 * (1.f / 512.f) + EPS);
            *(LAS f32x4*)(F.lds + SEGTAB_OFF + (ii * 256 + (t_ & 255)) * 16) = (f32x4){sa / s0, s0 / s1, s1, 0.f}; } }
        __syncthreads(); }
      EpiOut E{F.x(), F.X1B(), F.X18(), F.ssq(), rep + 1 == reps, (const LAS f32x4*)(F.lds + SEGTAB_OFF)};
      pg8::gemm_phase<EpiOut, pg8::StaticOrder, PG8_ALIGN, PG8_SP2>(F.lds + RING_OFF, gm, S, E); } }
#endif
    xcd_barrier(bar);
#ifndef NO_P4
#ifdef PROBE_GX2
    { int reps = 2; asm volatile("" : "+s"(reps)); for (int rep = 0; rep < reps; ++rep) {
#else
    { { const int rep = 0, reps = 1; (void)rep; (void)reps;
#endif
      pg8::Gemm gm{(const pg8::bf16_t*)F.X18(), F.WqT(), MTOK, DM, DM / 2}; pg8::StaticOrder S; S.init(MTOK, DM, F.G, (int)blockIdx.x);
      EpiQ E{F.QP(), F.ssq()};
      pg8::gemm_phase<EpiQ, pg8::StaticOrder, PG8_ALIGN, PG8_SP2, true>(F.lds + RING_OFF, gm, S, E); } }
#endif
    xcd_barrier(bar);
#ifndef NO_P5
#ifdef PROBE_P5X2
    { int reps = 2; asm volatile("" : "+s"(reps));
      for (int rep = 0; rep < reps; ++rep) for (int u = blockIdx.x; u < MTOK / 32; u += F.G) peer_unit(F, u, rep + 1 < reps); }
#else
    for (int u = blockIdx.x; u < MTOK / 32; u += F.G) peer_unit(F, u);
#endif
#endif
}

extern "C" void kernel_launch(void* const* d_in, const int* in_sizes, int n_in, void* d_out, int out_size, void* d_ws, size_t ws_size, hipStream_t stream) {
    static int grid = 0;
    if (grid == 0) {
        if (n_in != 18 || out_size != MTOK * DM || ws_size < WS_END) { fprintf(stderr, "kernel_launch: unexpected shapes (n_in %d, out %d, ws %zu)\n", n_in, out_size, ws_size); grid = -1; return; }
        int dev = 0, cus = 0, per_cu = 0;
        if (hipGetDevice(&dev) != hipSuccess || hipDeviceGetAttribute(&cus, hipDeviceAttributeMultiprocessorCount, dev) != hipSuccess) { grid = -1; return; }
        if (hipFuncSetAttribute((const void*)hybrid_fwd, hipFuncAttributeMaxDynamicSharedMemorySize, LDS_BYTES) != hipSuccess) { fprintf(stderr, "kernel_launch: hipFuncSetAttribute failed\n"); grid = -1; return; }
        if (hipOccupancyMaxActiveBlocksPerMultiprocessor(&per_cu, (const void*)hybrid_fwd, NWAVES * 64, LDS_BYTES) != hipSuccess || per_cu < 1)
            fprintf(stderr, "kernel_launch: note: occupancy query reports %d workgroups per CU\n", per_cu);
        (void)hipGetLastError();
        grid = cus;
    }
    if (grid < 0) return;
    if (hipMemsetAsync((char*)d_ws + WS_CTL, 0, CTL_ZERO_BYTES, stream) != hipSuccess) return;
    Args a{};
    for (int i = 0; i < 18; ++i) a.in[i] = (const float*)d_in[i];
    a.out = (float*)d_out; a.ws = (unsigned char*)d_ws;
    hipLaunchKernelGGL(hybrid_fwd, dim3(grid), dim3(NWAVES * 64), LDS_BYTES, stream, a);
}
```

```cpp
#include <hip/hip_runtime.h>
#include <cstdio>
#include <cstdint>
namespace pg8 {
#define PG8_LAS __attribute__((address_space(3)))
typedef unsigned short bf16_t;
typedef short bf16x8 __attribute__((ext_vector_type(8)));
typedef float f32x4 __attribute__((ext_vector_type(4)));
typedef unsigned u32x4 __attribute__((ext_vector_type(4)));
constexpr int BM = 256, BK = 64, HALF = 128, HTB = HALF * BK * 2  , STAGE_BYTES = 8 * HTB, NXCD = 8, WGM = 8;

__host__ __device__ __forceinline__ int lds_byte(int r, int c) { const int st = (r >> 4) * 2 + (c >> 5), rr = r & 15, cc = c & 31, ob = rr * 64 + cc * 2; return st * 1024 + (ob ^ (((ob >> 9) & 1) << 5)); }
__host__ __device__ __forceinline__ void stage_rc(int b, int& R, int& C) { const int st = b / 1024, sb = b % 1024, swz = sb ^ (((sb >> 9) & 1) << 5); R = (st >> 1) * 16 + swz / 64; C = (st & 1) * 32 + (swz % 64) / 2; }
__host__ __device__ __forceinline__ int perm32(int rho) { const int n = rho >> 4, i = rho & 15; return 8 * (i >> 2) + 4 * n + (i & 3); }

struct Unit { int pm, pn; };
struct Gemm { const bf16_t* A; const bf16_t* Bt; int M, N, K; };

struct StaticOrder {
    int nM, nN, nwg, G, c;
    __host__ __device__ void init(int M, int N, int G_, int c_) { nM = M / BM; nN = N / BM; nwg = nM * nN; G = G_; c = c_; }
    __host__ __device__ bool next(int i, Unit& u) const {
        const long L = (long)i * G + c; if (L >= nwg) return false;
        int wgid = (int)L; { const int q = nwg / NXCD, r = nwg % NXCD, xcd = wgid % NXCD, off = wgid / NXCD; wgid = (xcd < r ? xcd * (q + 1) : r * (q + 1) + (xcd - r) * q) + off; }
        const int nig = WGM * nN, gid = wgid / nig, fm = gid * WGM, gsz = (nM - fm) < WGM ? (nM - fm) : WGM;
        u.pm = fm + ((wgid % nig) % gsz); u.pn = (wgid % nig) / gsz; return true;
    }
    __device__ __forceinline__ void a_ready(const Unit&) const {}
    __device__ __forceinline__ void done(const Unit&) const {}
};

__device__ __forceinline__ unsigned cvt_pk_bf16(float lo, float hi) { unsigned r; asm volatile("v_cvt_pk_bf16_f32 %0, %1, %2" : "=v"(r) : "v"(lo), "v"(hi)); return r; }
typedef float f32x2 __attribute__((ext_vector_type(2)));
__device__ __forceinline__ f32x2 gelu_pk(f32x2 v) {
    const f32x2 av = __builtin_elementwise_abs(v), d = av * 0.2316418882f + 1.0f;
    f32x2 t; t.x = __builtin_amdgcn_rcpf(d.x); t.y = __builtin_amdgcn_rcpf(d.y);
    f32x2 q = t * 0.5307027145f + (-0.7265760135f); q = q * t + 0.7107068705f; q = q * t + (-0.142248368f); q = q * t + 0.127414796f; q = q * t;
    const f32x2 s = (v * v) * (-0.72134752044f);
    f32x2 e; e.x = __builtin_amdgcn_exp2f(s.x); e.y = __builtin_amdgcn_exp2f(s.y);
    const f32x2 m = v * (q * e), r = v - m;
    f32x2 o; o.x = v.x < 0.f ? m.x : r.x; o.y = v.y < 0.f ? m.y : r.y; return o;
}

template <int ACT  > struct EpiBf16 {
    static constexpr bool PERM = true, AFTER_DRAIN = false, SEG = false; static_assert(ACT == 0 || ACT == 1, "EpiBf16: ACT is 0 (none) or 1 (gelu_pk)");
    bf16_t* O; int ldc; const float* bias; int split_cols; size_t split_stride; float scale0;
    __device__ __forceinline__ void operator()(const f32x4 (&acc)[2][2][4][2], const Unit& u, int wr, int wc, int fr, int fq) const {
        const int row0 = u.pm * BM + wr * 64 + fr; int colt = u.pn * BM; bf16_t* base = O;
        float sc = 1.f; if (split_cols) { const int t = colt / split_cols; base += (size_t)t * split_stride; colt -= t * split_cols; if (t == 0) sc = scale0; }
        const int col0 = colt + wc * 32 + 8 * fq, bcol0 = u.pn * BM + wc * 32 + 8 * fq;
        f32x4 bv[2][2];
#pragma unroll
        for (int bj = 0; bj < 2; ++bj)
#pragma unroll
            for (int n = 0; n < 2; ++n) bv[bj][n] = bias ? *(const f32x4*)(bias + bcol0 + bj * HALF + 4 * n) : (f32x4){0.f, 0.f, 0.f, 0.f};
#pragma unroll
        for (int ai = 0; ai < 2; ++ai)
#pragma unroll
            for (int m = 0; m < 4; ++m) { bf16_t* rowp = base + (size_t)(row0 + ai * HALF + m * 16) * ldc + col0;
#pragma unroll
                for (int bj = 0; bj < 2; ++bj) { f32x4 v0 = acc[ai][bj][m][0] + bv[bj][0], v1 = acc[ai][bj][m][1] + bv[bj][1];
                    if (ACT == 1) { f32x2 a = gelu_pk((f32x2){v0[0], v0[1]}), b = gelu_pk((f32x2){v0[2], v0[3]}), c = gelu_pk((f32x2){v1[0], v1[1]}), d = gelu_pk((f32x2){v1[2], v1[3]});
                        v0 = (f32x4){a.x, a.y, b.x, b.y}; v1 = (f32x4){c.x, c.y, d.x, d.y}; }
                    v0 = v0 * sc; v1 = v1 * sc; u32x4 w; w.x = cvt_pk_bf16(v0[0], v0[1]); w.y = cvt_pk_bf16(v0[2], v0[3]); w.z = cvt_pk_bf16(v1[0], v1[1]); w.w = cvt_pk_bf16(v1[2], v1[3]);
                    *(u32x4*)(rowp + bj * HALF) = w; } }
    }
};
template <class Epi, class Sched, bool ALIGN_EPI = false, bool SP2 = false, bool F8 = false>
__device__ __forceinline__ void gemm_phase(PG8_LAS unsigned char* lds, const Gemm g, const Sched& S, const Epi& E) {
    int tid_ = threadIdx.x; asm volatile("" : "+v"(tid_));
    const int tid = tid_, wid = __builtin_amdgcn_readfirstlane(tid >> 6), lane = tid & 63, wr = wid >> 2, wc = wid & 3, fr = lane & 15, fq = lane >> 4;
    const int K = g.K, nt = K / BK;
    unsigned voffA[2], voffB[2];
#pragma unroll
    for (int i = 0; i < 2; ++i) { int R, C; stage_rc(tid * 16 + i * 8192, R, C); const int Rb = Epi::PERM ? ((R & ~31) + perm32(R & 31)) : R;
        voffA[i] = (unsigned)(R * K + C) * 2u; voffB[i] = (unsigned)(Rb * K + C) * 2u; }
    const size_t kstep = (size_t)(BK * 2);
    const size_t hstep = (size_t)HALF * K * 2;
    const size_t tstep = 2 * hstep;
    const unsigned ldsw = (unsigned)wid * 1024u;
    const int aoff = lds_byte(wr * 64 + fr, fq * 8), boff = lds_byte(wc * 32 + fr, fq * 8);
#define PG8_SA(b, h) (((b) * 2 + (h)) * HTB)
#define PG8_SB(b, h) ((4 + (b) * 2 + (h)) * HTB)
#define PG8_STAGE(bufoff, gbase, voff) do { _Pragma("unroll") for (int _i = 0; _i < 2; ++_i) \
        __builtin_amdgcn_global_load_lds((const unsigned*)((const char*)(gbase) + (voff)[_i]), (PG8_LAS unsigned*)(lds + (bufoff) + ldsw + _i * 8192), 16, 0, 0); } while (0)
#define PG8_LDA(dst, b, h) do { _Pragma("unroll") for (int m = 0; m < 4; ++m) _Pragma("unroll") for (int k = 0; k < 2; ++k) dst[m][k] = *(const PG8_LAS bf16x8*)(lds + PG8_SA(b, h) + aoff + m * 2048 + k * 1024); } while (0)
#define PG8_LDB(dst, b, h) do { _Pragma("unroll") for (int n = 0; n < 2; ++n) _Pragma("unroll") for (int k = 0; k < 2; ++k) dst[n][k] = *(const PG8_LAS bf16x8*)(lds + PG8_SB(b, h) + boff + n * 2048 + k * 1024); } while (0)
#define PG8_MMA(ai, bj, At, Bt) do { __builtin_amdgcn_s_setprio(1); _Pragma("unroll") for (int m = 0; m < 4; ++m) _Pragma("unroll") for (int n = 0; n < 2; ++n) { \
        if constexpr (F8) { typedef int v8i_ __attribute__((ext_vector_type(8))); typedef int v4i_ __attribute__((ext_vector_type(4))); \
            const v4i_ b0_ = __builtin_bit_cast(v4i_, Bt[n][0]), b1_ = __builtin_bit_cast(v4i_, Bt[n][1]), a0_ = __builtin_bit_cast(v4i_, At[m][0]), a1_ = __builtin_bit_cast(v4i_, At[m][1]); \
            const v8i_ bb_ = {b0_.x, b0_.y, b0_.z, b0_.w, b1_.x, b1_.y, b1_.z, b1_.w}, aa_ = {a0_.x, a0_.y, a0_.z, a0_.w, a1_.x, a1_.y, a1_.z, a1_.w}; \
            asm volatile("v_mfma_scale_f32_16x16x128_f8f6f4 %0, %1, %2, %0, %3, %3 op_sel_hi:[0,0,0]" : "+v"(acc[ai][bj][m][n]) : "v"(bb_), "v"(aa_), "v"(f8one)); } \
        else { _Pragma("unroll") for (int k = 0; k < 2; ++k) acc[ai][bj][m][n] = __builtin_amdgcn_mfma_f32_16x16x32_bf16(Bt[n][k], At[m][k], acc[ai][bj][m][n], 0, 0, 0); } } \
        __builtin_amdgcn_s_setprio(0); } while (0)
#define PG8_WAIT_V(n) asm volatile("s_waitcnt vmcnt(" #n ")" ::: "memory")
#define PG8_WAIT_L(n) asm volatile("s_waitcnt lgkmcnt(" #n ")" ::: "memory")
#define PG8_BAR __builtin_amdgcn_s_barrier()
#define PG8_SCHED __builtin_amdgcn_sched_barrier(0)
    Unit cur, nxt; int ui = 0;
    if (!S.next(0, cur)) return;
    f32x4 acc[2][2][4][2];
    const int f8one = 0x7f7f7f7f;
#pragma unroll
    for (int a = 0; a < 2; ++a)
#pragma unroll
        for (int b = 0; b < 2; ++b)
#pragma unroll
            for (int m = 0; m < 4; ++m)
#pragma unroll
                for (int n = 0; n < 2; ++n) acc[a][b][m][n] = (f32x4){0.f, 0.f, 0.f, 0.f};
    bf16x8 At[4][2], B0[2][2], B1[2][2];
    const char* cA = (const char*)g.A + (size_t)cur.pm * tstep; const char* cB = (const char*)g.Bt + (size_t)cur.pn * tstep;
    S.a_ready(cur);
    float segr[16];
    if constexpr (Epi::SEG) E.seg_load(ui, wr, fr, segr);
    if constexpr (SP2) {
        PG8_STAGE(PG8_SB(0, 0), cB, voffB); PG8_STAGE(PG8_SB(0, 1), cB + hstep, voffB); PG8_STAGE(PG8_SA(0, 0), cA, voffA); PG8_STAGE(PG8_SA(0, 1), cA + hstep, voffA);
        if (wr == 1) PG8_BAR;
        PG8_WAIT_V(2); PG8_BAR;
        PG8_STAGE(PG8_SB(1, 0), cB + kstep, voffB); PG8_STAGE(PG8_SA(1, 0), cA + kstep, voffA); PG8_STAGE(PG8_SB(1, 1), cB + hstep + kstep, voffB);
        PG8_WAIT_V(6); PG8_BAR;
    } else {
        PG8_STAGE(PG8_SB(0, 0), cB, voffB); PG8_STAGE(PG8_SA(0, 0), cA, voffA); PG8_STAGE(PG8_SB(0, 1), cB + hstep, voffB); PG8_STAGE(PG8_SA(0, 1), cA + hstep, voffA);
        if (wr == 1) PG8_BAR;
        PG8_WAIT_V(4); PG8_BAR;
        PG8_STAGE(PG8_SB(1, 0), cB + kstep, voffB); PG8_STAGE(PG8_SA(1, 0), cA + kstep, voffA); PG8_STAGE(PG8_SB(1, 1), cB + hstep + kstep, voffB);
        PG8_WAIT_V(6); PG8_BAR;
    }
    for (;;) {
        const bool has_next = S.next(ui + 1, nxt);
        const char* nA = has_next ? (const char*)g.A + (size_t)nxt.pm * tstep : cA; const char* nB = has_next ? (const char*)g.Bt + (size_t)nxt.pn * tstep : cB;
        int t = 0;
#pragma unroll 1
        for (int sgi = 0; sgi < (Epi::SEG ? 3 : 1); ++sgi) {
        int tend = nt; if constexpr (Epi::SEG) tend = (sgi == 0) ? Epi::SEG_T1 : ((sgi == 1) ? Epi::SEG_T2 : nt);
        for (; t < tend; t += 2) {
            const bool last = (t == nt - 2);
            const char* a1 = cA + (size_t)(t + 1) * kstep;
            const char* a2 = last ? nA : cA + (size_t)(t + 2) * kstep; const char* b2 = last ? nB : cB + (size_t)(t + 2) * kstep;
            const char* a3 = a2 + kstep; const char* b3 = b2 + kstep;
            if (last && has_next) S.a_ready(nxt);
            if constexpr (SP2) {
            PG8_LDB(B0, 0, 0); PG8_LDB(B1, 0, 1); PG8_SCHED; PG8_LDA(At, 0, 0); PG8_STAGE(PG8_SA(1, 1), a1 + hstep, voffA);
            PG8_WAIT_V(8); PG8_WAIT_L(0); PG8_BAR; PG8_MMA(0, 0, At, B0); PG8_MMA(0, 1, At, B1); PG8_BAR; PG8_SCHED;
            PG8_LDA(At, 0, 1); PG8_STAGE(PG8_SB(0, 0), b2, voffB); PG8_STAGE(PG8_SB(0, 1), b2 + hstep, voffB); PG8_STAGE(PG8_SA(0, 0), a2, voffA);
            PG8_WAIT_V(8); PG8_WAIT_L(0); PG8_BAR; PG8_MMA(1, 0, At, B0); PG8_MMA(1, 1, At, B1); PG8_BAR; PG8_SCHED;
            PG8_LDB(B0, 1, 0); PG8_LDB(B1, 1, 1); PG8_SCHED; PG8_LDA(At, 1, 0); PG8_STAGE(PG8_SA(0, 1), a2 + hstep, voffA);
            PG8_WAIT_V(8); PG8_WAIT_L(0); PG8_BAR; PG8_MMA(0, 0, At, B0); PG8_MMA(0, 1, At, B1); PG8_BAR; PG8_SCHED;
            PG8_LDA(At, 1, 1); PG8_STAGE(PG8_SB(1, 0), b3, voffB); PG8_STAGE(PG8_SB(1, 1), b3 + hstep, voffB); PG8_STAGE(PG8_SA(1, 0), a3, voffA);
            PG8_WAIT_V(8); PG8_WAIT_L(0); PG8_BAR; PG8_MMA(1, 0, At, B0); PG8_MMA(1, 1, At, B1); PG8_BAR; PG8_SCHED;
            } else {
            PG8_LDB(B0, 0, 0); PG8_SCHED; PG8_LDA(At, 0, 0); PG8_STAGE(PG8_SA(1, 1), a1 + hstep, voffA);
            PG8_WAIT_L(8); PG8_BAR; PG8_WAIT_L(0); PG8_MMA(0, 0, At, B0); PG8_BAR; PG8_SCHED;
            PG8_LDB(B1, 0, 1); PG8_STAGE(PG8_SB(0, 0), b2, voffB);
            PG8_BAR; PG8_WAIT_L(0); PG8_MMA(0, 1, At, B1); PG8_BAR;
            PG8_LDA(At, 0, 1); PG8_STAGE(PG8_SA(0, 0), a2, voffA);
            PG8_BAR; PG8_WAIT_L(0); PG8_MMA(1, 0, At, B0); PG8_BAR; PG8_SCHED;
            PG8_STAGE(PG8_SB(0, 1), b2 + hstep, voffB);
            PG8_WAIT_V(6); PG8_BAR; PG8_MMA(1, 1, At, B1); PG8_BAR;
            PG8_LDB(B0, 1, 0); PG8_SCHED; PG8_LDA(At, 1, 0); PG8_STAGE(PG8_SA(0, 1), a2 + hstep, voffA);
            PG8_WAIT_L(8); PG8_BAR; PG8_WAIT_L(0); PG8_MMA(0, 0, At, B0); PG8_BAR; PG8_SCHED;
            PG8_LDB(B1, 1, 1); PG8_STAGE(PG8_SB(1, 0), b3, voffB);
            PG8_BAR; PG8_WAIT_L(0); PG8_MMA(0, 1, At, B1); PG8_BAR;
            PG8_LDA(At, 1, 1); PG8_STAGE(PG8_SA(1, 0), a3, voffA);
            PG8_BAR; PG8_WAIT_L(0); PG8_MMA(1, 0, At, B0); PG8_BAR; PG8_SCHED;
            PG8_STAGE(PG8_SB(1, 1), b3 + hstep, voffB);
            PG8_WAIT_V(6); PG8_BAR; PG8_MMA(1, 1, At, B1); PG8_BAR;
            }
        }
        if constexpr (Epi::SEG) E.seg_apply(acc, segr, sgi);
        }
        if constexpr (ALIGN_EPI) { if (wr == 0) PG8_BAR; }
        if constexpr (!Epi::AFTER_DRAIN) { if constexpr (Epi::SEG) E(acc, cur, wr, wc, fr, fq, ui); else E(acc, cur, wr, wc, fr, fq); S.done(cur); }
        if (!has_next) break;
#pragma unroll
        for (int a = 0; a < 2; ++a)
#pragma unroll
            for (int b = 0; b < 2; ++b)
#pragma unroll
                for (int m = 0; m < 4; ++m)
#pragma unroll
                    for (int n = 0; n < 2; ++n) acc[a][b][m][n] = (f32x4){0.f, 0.f, 0.f, 0.f};
        cur = nxt; cA = nA; cB = nB; ++ui;
        if constexpr (Epi::SEG) E.seg_load(ui, wr, fr, segr);
        if constexpr (ALIGN_EPI) { if (wr == 1) PG8_BAR; }
    }
    PG8_WAIT_V(0);
    if constexpr (!ALIGN_EPI) { if (wr == 0) PG8_BAR; }
    PG8_BAR;
    if constexpr (Epi::AFTER_DRAIN) { E.fused(acc, cur, wr, wc, fr, fq, lds, wid, lane); S.done(cur); }
#undef PG8_SA
#undef PG8_SB
#undef PG8_STAGE
#undef PG8_LDA
#undef PG8_LDB
#undef PG8_MMA
#undef PG8_WAIT_V
#undef PG8_WAIT_L
#undef PG8_BAR
#undef PG8_SCHED
}
}
#ifndef PG8_SP2
#define PG8_SP2 true
#endif
#ifndef PG8_ALIGN
#define PG8_ALIGN true
#endif

constexpr int BATCH = 8, SEQ = 2048, DM = 2048, MTOK = BATCH * SEQ;
constexpr int ATT_W = 1024, ATT_H = 8, ATT_HD = 128, MOBA_BLK = 256, NBLK = SEQ / MOBA_BLK;
constexpr int SSM_W = 1024, SSM_H = 16, SSM_P = 64, SSM_N = 128, SSM_L = 128, SSM_NC = SEQ / SSM_L, CONV_CH = 1536;
constexpr int IN_PROJ = 5648, NPROJ = 5632  , NPAD = 5888  ;
constexpr int F8_LO = 2048, F8_HI = 3072, NB16 = NPAD - (F8_HI - F8_LO)  ;
constexpr float SH8 = 16.f;
constexpr int COL_Q = 0, COL_K = 1024, COL_V = 2048, COL_Z = 3072, COL_XBC = 4096;
constexpr int PEER_H = 8, PEER_NK = 128, PEER_K = 16, PEER_HK = 128;
constexpr float EPS = 1e-6f;
constexpr float SU = 64.f, SV = 4.f, SH = 16.f, SLO = 16.f;
constexpr float SX8 = 16.f, SW8 = 1024.f;
constexpr float SH4 = 1.5f, SLO4 = 4.f;
constexpr int ROWB = DM / 2;

constexpr size_t MiB = 1u << 20;
constexpr size_t WS_CTL = 0, CTL_ZERO_BYTES = 1 * MiB;
constexpr size_t WS_DT = 1 * MiB;
constexpr size_t WS_SK = 2 * MiB;
constexpr size_t WS_WIN = 4 * MiB;
constexpr size_t WS_WIN8 = 24 * MiB;
constexpr size_t WS_HN8 = 396 * MiB;
constexpr size_t WS_WOUT = 28 * MiB;
constexpr size_t WS_WQ = 36 * MiB;
constexpr size_t WS_HN = 44 * MiB;
constexpr size_t WS_PROJ = 108 * MiB;
constexpr size_t WS_X1B = WS_PROJ, WS_QP = WS_PROJ + 64 * MiB;
constexpr size_t WS_U8 = 284 * MiB, WS_V8 = 316 * MiB;
constexpr size_t WS_XBC = 348 * MiB;
constexpr size_t WS_DT2 = 3 * MiB;
constexpr size_t WS_X18 = 396 * MiB;
constexpr size_t WS_END = 428 * MiB;
constexpr int CW_BAR = 4096;
constexpr int CW_Q2 = 8192;
constexpr int CW_KMEAN = 32768;
constexpr int CW_SSQ = 131072;
static_assert((CW_SSQ + MTOK * 4) * 4 <= (int)CTL_ZERO_BYTES, "CTL words inside the memset region");

constexpr int RING_OFF = 0, RING_BYTES = 131072;
constexpr int LDSCTL_OFF = RING_BYTES, MISC_OFF = LDSCTL_OFF + 320;
constexpr int SEGTAB_OFF = LDSCTL_OFF + 1024;  static_assert(LDSCTL_OFF + 1024 + 3 * 256 * 16 <= 147456, "segment table inside the LDS allocation");
constexpr int LDS_BYTES = 147456;
constexpr int NWAVES = 8;

#define GAS __attribute__((address_space(1)))
#define LAS __attribute__((address_space(3)))
typedef unsigned short bf16;
typedef unsigned v4u __attribute__((ext_vector_type(4)));
typedef unsigned v2u __attribute__((ext_vector_type(2)));
typedef float f32x4 __attribute__((ext_vector_type(4)));
typedef float f32x2 __attribute__((ext_vector_type(2)));
typedef short bf16x8 __attribute__((ext_vector_type(8)));
typedef short s16x4 __attribute__((ext_vector_type(4)));
typedef GAS unsigned gu32;
#define RLX_AGENT __ATOMIC_RELAXED, __HIP_MEMORY_SCOPE_AGENT
#define LDS_WAIT() asm volatile("s_waitcnt lgkmcnt(0)" ::: "memory")
#define VM_WAIT() asm volatile("s_waitcnt vmcnt(0)" ::: "memory")
__device__ __forceinline__ unsigned f2bf(float f) { unsigned u = __builtin_bit_cast(unsigned, f); return (u + 0x7fffu + ((u >> 16) & 1u)) >> 16; }
typedef __bf16 bf16v2 __attribute__((ext_vector_type(2)));
__device__ __forceinline__ unsigned pk2(float lo, float hi) { bf16v2 v; v.x = (__bf16)lo; v.y = (__bf16)hi; return __builtin_bit_cast(unsigned, v); }
__device__ __forceinline__ float bflo(unsigned w) { return __builtin_bit_cast(float, w << 16); }
__device__ __forceinline__ float bfhi(unsigned w) { return __builtin_bit_cast(float, w & 0xffff0000u); }
__device__ __forceinline__ float wave_sum(float v) {
#pragma unroll
    for (int o = 1; o < 64; o <<= 1) v += __shfl_xor(v, o);
    return v;
}
__device__ __forceinline__ float silu_f(float x) { return x * __builtin_amdgcn_rcpf(1.f + __expf(-x)); }

#define XB_TMO      128
#define XB_XCNT(j)  (256  + 64 * (j))
#define XB_XSUB(j)  (1280 + 64 * (j))
#define XB_XGEN(j)  (2304 + 64 * (j))
#define XB_TOP      3328
#define XB_TOPGEN   3392
#define XCD_BAR_WORDS 3456
#define XB_SPIN_CAP (1u << 18)

__device__ __forceinline__ unsigned xb_ld(unsigned* p)              { return __hip_atomic_load(p, __ATOMIC_RELAXED, __HIP_MEMORY_SCOPE_AGENT); }
__device__ __forceinline__ unsigned xb_add(unsigned* p, unsigned v) { return __hip_atomic_fetch_add(p, v, __ATOMIC_RELAXED, __HIP_MEMORY_SCOPE_AGENT); }
__device__ __forceinline__ unsigned xb_xcc_id() { return (unsigned)__builtin_amdgcn_s_getreg((3 << 11) | 20) & 0xFu; }
#define XB_SPIN(cond, bar) do { unsigned _sp = 0; while (cond) { __builtin_amdgcn_s_sleep(1); \
    if ((++_sp & 255u) == 0u) { if (xb_ld(&(bar)[XB_TMO])) break; if (_sp > XB_SPIN_CAP) { atomicAdd(&(bar)[XB_TMO], 1u); break; } } } } while (0)

struct XcdBarrier {
    unsigned* bar; unsigned x;
    volatile LAS unsigned* st;
};
__device__ __forceinline__ XcdBarrier xcd_barrier_post(unsigned* bar, volatile LAS unsigned* st) {
    XcdBarrier b; b.bar = bar; b.x = xb_xcc_id(); b.st = st;
    if (threadIdx.x == 0) (void)xb_add(&bar[XB_XCNT(b.x)], 1u);
    return b;
}
__device__ __forceinline__ void xcd_barrier_complete(unsigned* bar, unsigned x, unsigned& nloc, unsigned& nx) {
    const unsigned G = gridDim.x * gridDim.y * gridDim.z;
    unsigned sum, cnt, mine, sp = 0u;
    for (;;) {
        sum = 0u; cnt = 0u; mine = 0u;
#pragma unroll
        for (unsigned j = 0; j < 16; ++j) { const unsigned c = xb_ld(&bar[XB_XCNT(j)]); sum += c; cnt += (c > 0u) ? 1u : 0u; mine = (j == x) ? c : mine; }
        if (sum == G) break;
        __builtin_amdgcn_s_sleep(1);
        if ((++sp & 255u) == 0u) { if (xb_ld(&bar[XB_TMO])) break; if (sp > XB_SPIN_CAP) { atomicAdd(&bar[XB_TMO], 1u); break; } }
    }
    nloc = mine > 0u ? mine : 1u; nx = cnt > 0u ? cnt : 1u;
}
__device__ __forceinline__ void xcd_barrier(const XcdBarrier& b) {
    asm volatile("s_waitcnt vmcnt(0)" ::: "memory");
    __syncthreads();
    if (threadIdx.x == 0) {
        unsigned* bar = b.bar;
        __builtin_amdgcn_s_waitcnt(0);
        unsigned nloc = b.st[0], nx = b.st[1];
        if (nloc == 0u) { xcd_barrier_complete(bar, b.x, nloc, nx); b.st[0] = nloc; b.st[1] = nx; }
        const unsigned old = xb_add(&bar[XB_XSUB(b.x)], 1u);
        const unsigned gen = old / nloc;
        if (old + 1u == (gen + 1u) * nloc) {
            __builtin_amdgcn_fence(__ATOMIC_RELEASE, "agent");
            asm volatile("s_waitcnt vmcnt(0)" ::: "memory");
            const unsigned og = xb_add(&bar[XB_TOP], 1u);
            const unsigned tg = og / nx;
            if (og + 1u == (tg + 1u) * nx) xb_add(&bar[XB_TOPGEN], 1u);
            else XB_SPIN(xb_ld(&bar[XB_TOPGEN]) == tg, bar);
            __builtin_amdgcn_fence(__ATOMIC_ACQUIRE, "agent");
            xb_add(&bar[XB_XGEN(b.x)], 1u);
            asm volatile("s_waitcnt vmcnt(0)" ::: "memory");
        } else {
            XB_SPIN(xb_ld(&bar[XB_XGEN(b.x)]) == gen, bar);
            __builtin_amdgcn_fence(__ATOMIC_ACQUIRE, "agent");
            asm volatile("s_waitcnt vmcnt(0)" ::: "memory");
        }
    }
    __syncthreads();
}

#define CAS __attribute__((address_space(4)))
struct Args { const float* in[18]; float* out; unsigned char* ws; };
__device__ __forceinline__ const CAS unsigned char* kargs() { const CAS unsigned char* p = (const CAS unsigned char*)__builtin_amdgcn_kernarg_segment_ptr(); asm volatile("" : "+s"(p)); return p; }
__device__ __forceinline__ const float* kin(int i) { return *(const float* const CAS*)(kargs() + 8 * i); }
__device__ __forceinline__ float* kout() { return *(float* const CAS*)(kargs() + 8 * 18); }
__device__ __forceinline__ unsigned char* kws() { return *(unsigned char* const CAS*)(kargs() + 8 * 19); }
__device__ __forceinline__ int fresh_tid() { int t = threadIdx.x; asm volatile("" : "+v"(t)); return t; }
struct Frame {
    LAS unsigned char* lds;
    volatile LAS unsigned* MISC;
    int tid, lane, wave, G;
    __device__ __forceinline__ const float* x() const { return kin(0); }
    __device__ __forceinline__ const float* attn_norm() const { return kin(1); }
    __device__ __forceinline__ const float* w_in() const { return kin(2); }
    __device__ __forceinline__ const float* conv_w() const { return kin(3); }
    __device__ __forceinline__ const float* conv_b() const { return kin(4); }
    __device__ __forceinline__ const float* dt_bias() const { return kin(5); }
    __device__ __forceinline__ const float* a_log() const { return kin(6); }
    __device__ __forceinline__ const float* d_skip() const { return kin(7); }
    __device__ __forceinline__ const float* rel_bias() const { return kin(8); }
    __device__ __forceinline__ const float* attn_out_norm() const { return kin(9); }
    __device__ __forceinline__ const float* ssm_out_norm() const { return kin(10); }
    __device__ __forceinline__ const float* w_out() const { return kin(11); }
    __device__ __forceinline__ const float* ffn_norm() const { return kin(12); }
    __device__ __forceinline__ const float* peer_wq() const { return kin(13); }
    __device__ __forceinline__ const float* peer_sk() const { return kin(14); }
    __device__ __forceinline__ const float* peer_u() const { return kin(15); }
    __device__ __forceinline__ const float* peer_v() const { return kin(16); }
    __device__ __forceinline__ const float* final_norm() const { return kin(17); }
    __device__ __forceinline__ float* out() const { return kout(); }
    __device__ __forceinline__ unsigned* ctl() const { return (unsigned*)(kws() + WS_CTL); }
    __device__ __forceinline__ float* dtraw() const { return (float*)(kws() + WS_DT); }
    __device__ __forceinline__ bf16* SK() const { return (bf16*)(kws() + WS_SK); }
    __device__ __forceinline__ bf16* WinT() const { return (bf16*)(kws() + WS_WIN); }
    __device__ __forceinline__ bf16* WoutT() const { return (bf16*)(kws() + WS_WOUT); }
    __device__ __forceinline__ bf16* WqT() const { return (bf16*)(kws() + WS_WQ); }
    __device__ __forceinline__ bf16* HN() const { return (bf16*)(kws() + WS_HN); }
    __device__ __forceinline__ bf16* PROJ() const { return (bf16*)(kws() + WS_PROJ); }
    __device__ __forceinline__ bf16* X1B() const { return (bf16*)(kws() + WS_X1B); }
    __device__ __forceinline__ bf16* QP() const { return (bf16*)(kws() + WS_QP); }
    __device__ __forceinline__ unsigned char* U8() const { return kws() + WS_U8; }
    __device__ __forceinline__ unsigned char* V8() const { return kws() + WS_V8; }
    __device__ __forceinline__ unsigned char* X18() const { return kws() + WS_X18; }
    __device__ __forceinline__ unsigned char* HN8() const { return kws() + WS_HN8; }
    __device__ __forceinline__ unsigned char* WinT8() const { return kws() + WS_WIN8; }
    __device__ __forceinline__ bf16* XBC() const { return (bf16*)(kws() + WS_XBC); }
    __device__ __forceinline__ float* DT2() const { return (float*)(kws() + WS_DT2); }
    __device__ __forceinline__ float* kmean() const { return (float*)(kws() + WS_CTL) + CW_KMEAN; }
    __device__ __forceinline__ float* ssq() const { return (float*)(kws() + WS_CTL) + CW_SSQ; }
};

__device__ __forceinline__ float clampf(float v, float lim);
__device__ __forceinline__ void p0_transpose_item(const float* W, int K, int N, bf16* WT, const float* gain, LAS float* scr, int item, int lane, const float f8scale = 0.f, const int nshift = 0) {
    const int nblk = (N + 31) / 32, kb = item / nblk, nb = item % nblk, k0 = 64 * kb, n0 = 32 * nb;
    const int kr = lane >> 3, nc = (lane & 7) * 4; const bool ok = (n0 + nc) < N;
    f32x4 v[8]; float gk[8];
#pragma unroll
    for (int i = 0; i < 8; ++i) { const int kk = 8 * i + kr; v[i] = ok ? *(const GAS f32x4*)(W + (size_t)(k0 + kk) * N + n0 + nc) : (f32x4){0.f, 0.f, 0.f, 0.f}; gk[i] = gain ? gain[k0 + kk] : 1.f; }
#pragma unroll
    for (int i = 0; i < 8; ++i) { const int kk = 8 * i + kr; LAS float* d = scr + kk * 33 + nc; d[0] = v[i].x * gk[i]; d[1] = v[i].y * gk[i]; d[2] = v[i].z * gk[i]; d[3] = v[i].w * gk[i]; }
    LDS_WAIT(); asm volatile("" ::: "memory");
    const int c = lane & 7;
#pragma unroll
    for (int j = 0; j < 4; ++j) { const int n = (lane >> 3) + 8 * j; const LAS float* s = scr + (8 * c) * 33 + n;
        v4u o; o.x = pk2(s[0 * 33], s[1 * 33]); o.y = pk2(s[2 * 33], s[3 * 33]); o.z = pk2(s[4 * 33], s[5 * 33]); o.w = pk2(s[6 * 33], s[7 * 33]);
        if (f8scale == 0.f) *(GAS v4u*)(WT + (size_t)(n0 + n - nshift) * K + k0 + 8 * c) = o;
        else { v2u o8; int w_;
            w_ = __builtin_amdgcn_cvt_pk_fp8_f32(clampf(s[0 * 33] * f8scale, 448.f), clampf(s[1 * 33] * f8scale, 448.f), 0, false); w_ = __builtin_amdgcn_cvt_pk_fp8_f32(clampf(s[2 * 33] * f8scale, 448.f), clampf(s[3 * 33] * f8scale, 448.f), w_, true); o8.x = (unsigned)w_;
            w_ = __builtin_amdgcn_cvt_pk_fp8_f32(clampf(s[4 * 33] * f8scale, 448.f), clampf(s[5 * 33] * f8scale, 448.f), 0, false); w_ = __builtin_amdgcn_cvt_pk_fp8_f32(clampf(s[6 * 33] * f8scale, 448.f), clampf(s[7 * 33] * f8scale, 448.f), w_, true); o8.y = (unsigned)w_;
            *(GAS v2u*)((unsigned char*)WT + (size_t)(n0 + n - nshift) * K + k0 + 8 * c) = o8; } }
    LDS_WAIT(); asm volatile("" ::: "memory");
}
__device__ __forceinline__ unsigned pk4_fp8(float a, float b, float c, float d) { int w = __builtin_amdgcn_cvt_pk_fp8_f32(clampf(a, 448.f), clampf(b, 448.f), 0, false); w = __builtin_amdgcn_cvt_pk_fp8_f32(clampf(c, 448.f), clampf(d, 448.f), w, true); return (unsigned)w; }
__device__ __forceinline__ void rms_2rows_to_bf16(const float* x0, const float* x1, const float* gain, bf16* o0, bf16* o1, unsigned char* q0, unsigned char* q1, int lane) {
    const GAS f32x4* xr0 = (const GAS f32x4*)x0 + lane; const GAS f32x4* xr1 = (const GAS f32x4*)x1 + lane; const GAS f32x4* gr = (const GAS f32x4*)gain + lane;
    f32x4 v[8], u[8]; float s = 0.f, t = 0.f;
#pragma unroll
    for (int j = 0; j < 8; ++j) { v[j] = xr0[64 * j]; u[j] = xr1[64 * j]; }
#pragma unroll
    for (int j = 0; j < 8; ++j) { s += (v[j].x * v[j].x + v[j].y * v[j].y) + (v[j].z * v[j].z + v[j].w * v[j].w); t += (u[j].x * u[j].x + u[j].y * u[j].y) + (u[j].z * u[j].z + u[j].w * u[j].w); }
    const float rs = __builtin_amdgcn_rsqf(wave_sum(s) * (1.f / DM) + EPS), rt = __builtin_amdgcn_rsqf(wave_sum(t) * (1.f / DM) + EPS);
    GAS v2u* p0 = (GAS v2u*)o0 + lane; GAS v2u* p1 = (GAS v2u*)o1 + lane; GAS unsigned* r0 = (GAS unsigned*)q0 + lane; GAS unsigned* r1 = (GAS unsigned*)q1 + lane;
#pragma unroll
    for (int j = 0; j < 8; ++j) { const f32x4 g = gr[64 * j]; v2u a, b;
        const f32x4 h0 = v[j] * g * rs, h1 = u[j] * g * rt;
        a.x = pk2(h0.x, h0.y); a.y = pk2(h0.z, h0.w); p0[64 * j] = a; r0[64 * j] = pk4_fp8(h0.x * SH8, h0.y * SH8, h0.z * SH8, h0.w * SH8);
        b.x = pk2(h1.x, h1.y); b.y = pk2(h1.z, h1.w); p1[64 * j] = b; r1[64 * j] = pk4_fp8(h1.x * SH8, h1.y * SH8, h1.z * SH8, h1.w * SH8); }
}
#ifdef PROBE_FP4EMU
__device__ __forceinline__ float fp4grid(float y) { const float a = fabsf(y); float r;
    if (a <= 2.f) r = rintf(a * 2.f) * 0.5f; else if (a <= 4.f) r = rintf(a); else r = (a < 5.f) ? 4.f : 6.f;
    return copysignf(r, y); }
__device__ __forceinline__ float clampf(float v, float lim) { if (lim == 448.5f) return fp4grid(v * (1.f / 16.f)) * 16.f; return fminf(fmaxf(v, -lim), lim); }
#else
__device__ __forceinline__ float clampf(float v, float lim) { return fminf(fmaxf(v, -lim), lim); }
#endif
template <int TAB = 0> __device__ __forceinline__ v4u cvt16_fp8(const f32x4 a, const f32x4 b, const f32x4 c, const f32x4 d, float sc) {
    v4u o; int w; constexpr float LIM = TAB ? 448.5f : 448.f;
    w = __builtin_amdgcn_cvt_pk_fp8_f32(clampf(a.x * sc, LIM), clampf(a.y * sc, LIM), 0, false); w = __builtin_amdgcn_cvt_pk_fp8_f32(clampf(a.z * sc, LIM), clampf(a.w * sc, LIM), w, true); o.x = (unsigned)w;
    w = __builtin_amdgcn_cvt_pk_fp8_f32(clampf(b.x * sc, LIM), clampf(b.y * sc, LIM), 0, false); w = __builtin_amdgcn_cvt_pk_fp8_f32(clampf(b.z * sc, LIM), clampf(b.w * sc, LIM), w, true); o.y = (unsigned)w;
    w = __builtin_amdgcn_cvt_pk_fp8_f32(clampf(c.x * sc, LIM), clampf(c.y * sc, LIM), 0, false); w = __builtin_amdgcn_cvt_pk_fp8_f32(clampf(c.z * sc, LIM), clampf(c.w * sc, LIM), w, true); o.z = (unsigned)w;
    w = __builtin_amdgcn_cvt_pk_fp8_f32(clampf(d.x * sc, LIM), clampf(d.y * sc, LIM), 0, false); w = __builtin_amdgcn_cvt_pk_fp8_f32(clampf(d.z * sc, LIM), clampf(d.w * sc, LIM), w, true); o.w = (unsigned)w;
    return o;
}
__device__ __forceinline__ void tables_convert(Frame& F, size_t lo, size_t hi, size_t tix, size_t ntx) {
      const GAS f32x4* su = (const GAS f32x4*)F.peer_u(); const GAS f32x4* sv = (const GAS f32x4*)F.peer_v(); GAS v4u* du = (GAS v4u*)F.U8(); GAS v4u* dv = (GAS v4u*)F.V8();
#pragma unroll 1
      for (int tab = 0; tab < 2; ++tab) { const GAS f32x4* src = tab ? sv : su; GAS v4u* dst = tab ? dv : du; const float sc = tab ? SV : SU;
        f32x4 nx[8]; const size_t i0 = lo + tix;
        if (i0 < hi) { const GAS f32x4* p = src + (i0 >> 6) * 512 + (i0 & 63);
#pragma unroll
            for (int j = 0; j < 8; ++j) nx[j] = p[64 * j]; }
#pragma unroll 1
        for (size_t i = i0; i < hi; i += ntx) { f32x4 v[8];
#pragma unroll
            for (int j = 0; j < 8; ++j) v[j] = nx[j];
            if (i + ntx < hi) { const size_t i2 = i + ntx; const GAS f32x4* p = src + (i2 >> 6) * 512 + (i2 & 63);
#pragma unroll
                for (int j = 0; j < 8; ++j) nx[j] = p[64 * j]; }
            unsigned wd[4];
#pragma unroll
            for (int q = 0; q < 4; ++q) { const f32x4 a = v[2 * q] * sc, b = v[2 * q + 1] * sc; unsigned w = 0u;
                w = __builtin_amdgcn_cvt_scalef32_pk_fp4_f32(w, clampf(a.x, 6.f), clampf(a.y, 6.f), 1.0f, 0); w = __builtin_amdgcn_cvt_scalef32_pk_fp4_f32(w, clampf(a.z, 6.f), clampf(a.w, 6.f), 1.0f, 1);
                w = __builtin_amdgcn_cvt_scalef32_pk_fp4_f32(w, clampf(b.x, 6.f), clampf(b.y, 6.f), 1.0f, 2); w = __builtin_amdgcn_cvt_scalef32_pk_fp4_f32(w, clampf(b.z, 6.f), clampf(b.w, 6.f), 1.0f, 3); wd[q] = w; }
            dst[i] = (v4u){wd[0], wd[1], wd[2], wd[3]}; } }
}
constexpr size_t TAB_ITEMS = (size_t)16384 * 64;
__device__ __forceinline__ size_t tab_split(int G) { const int rem = ((MTOK / 256) * (NB16 / 256)) % G; return rem ? (TAB_ITEMS / 8) * 5 : TAB_ITEMS; }
__device__ __forceinline__ unsigned fp4_code(float y) { const float a = fabsf(y);
    const unsigned m = (unsigned)(a >= 0.25f) + (unsigned)(a >= 0.75f) + (unsigned)(a >= 1.25f) + (unsigned)(a >= 1.75f) + (unsigned)(a >= 2.5f) + (unsigned)(a >= 3.5f) + (unsigned)(a >= 5.0f);
    return m | ((y < 0.f) ? 8u : 0u); }
__device__ __forceinline__ void p0_prologue(Frame& F) {
    const int tid = fresh_tid(), lane = tid & 63, wave = __builtin_amdgcn_readfirstlane(tid >> 6);
    LAS float* scr = (LAS float*)(F.lds + RING_OFF + wave * 16384);
    const int gw = blockIdx.x * NWAVES + wave, NGW = F.G * NWAVES;
    constexpr int I_IN = (DM / 64) * ((IN_PROJ + 31) / 32), I_SQ = (DM / 64) * (DM / 32);
    constexpr int NITEMS = I_IN + 2 * I_SQ;
    { const float* const w_in = F.w_in(); const float* const w_out = F.w_out(); const float* const wq = F.peer_wq(); const float* const fg = F.ffn_norm(); bf16* const WinT = F.WinT(); unsigned char* const WinT8 = F.WinT8(); bf16* const WoutT = F.WoutT(); bf16* const WqT = F.WqT(); const float* const gatt = F.attn_out_norm(); const float* const gssm = F.ssm_out_norm();
      for (int it = gw; it < NITEMS; it += NGW) {
        int r = it;
        if (r < I_IN) { const int n0_ = 32 * (r % ((IN_PROJ + 31) / 32));
            if (n0_ >= F8_LO && n0_ < F8_HI) p0_transpose_item(w_in, DM, IN_PROJ, (bf16*)WinT8, nullptr, scr, r, lane, SW8, F8_LO);
            else p0_transpose_item(w_in, DM, IN_PROJ, WinT, nullptr, scr, r, lane, 0.f, (n0_ >= F8_HI) ? (F8_HI - F8_LO) : 0);
            continue; } r -= I_IN;
        if (r < I_SQ) { const int k0_ = 64 * (r / (DM / 32)); p0_transpose_item(w_out, DM, DM, WoutT, (k0_ < ATT_W) ? gatt : (gssm - ATT_W), scr, r, lane); continue; } r -= I_SQ;
        p0_transpose_item(wq, DM, DM, WqT, fg, scr, r, lane, SW8);
      } }
    const size_t gt = (size_t)blockIdx.x * (NWAVES * 64) + tid, GT = (size_t)F.G * NWAVES * 64;
    { const size_t z0 = (size_t)(5664 - (F8_HI - F8_LO)) * DM / 8, z1 = (size_t)NB16 * DM / 8; GAS v4u* p = (GAS v4u*)F.WinT(); for (size_t i = z0 + gt; i < z1; i += GT) p[i] = (v4u){0u, 0u, 0u, 0u}; }
    { const GAS f32x4* s = (const GAS f32x4*)F.peer_sk(); GAS v2u* d = (GAS v2u*)F.SK(); for (size_t i = gt; i < (size_t)16 * 128 * 128 / 4; i += GT) { const f32x4 v = s[i]; v2u o; o.x = pk2(v.x, v.y); o.y = pk2(v.z, v.w); d[i] = o; } }
    { const float* const xg = F.x(); const float* const gn = F.attn_norm(); bf16* const hn = F.HN(); unsigned char* const hn8 = F.HN8();
      for (int m = gw; m < MTOK / 2; m += NGW) rms_2rows_to_bf16(xg + (size_t)(2 * m) * DM, xg + (size_t)(2 * m + 1) * DM, gn, hn + (size_t)(2 * m) * DM, hn + (size_t)(2 * m + 1) * DM, hn8 + (size_t)(2 * m) * DM, hn8 + (size_t)(2 * m + 1) * DM, lane); }
    tables_convert(F, 0, tab_split(F.G), gt, GT);
}

struct EpiProj {
    static constexpr bool PERM = true, AFTER_DRAIN = false, SEG = false;
    bf16* O; float* dtraw; float* kmean;
    __device__ __forceinline__ void operator()(const pg8::f32x4 (&acc)[2][2][4][2], const pg8::Unit& u, int wr, int wc, int fr, int fq) const {
        const int rpn = (u.pn < F8_LO / 256) ? u.pn : u.pn + (F8_HI - F8_LO) / 256;
        const int row0 = u.pm * 256 + wr * 64 + fr, col0 = rpn * 256 + wc * 32 + 8 * fq;
        if (rpn < 22) {
#pragma unroll
            for (int ai = 0; ai < 2; ++ai)
#pragma unroll
                for (int m = 0; m < 4; ++m) { bf16* rowp = O + (size_t)(row0 + ai * 128 + m * 16) * NPROJ + col0;
#pragma unroll
                    for (int bj = 0; bj < 2; ++bj) { const pg8::f32x4 v0 = acc[ai][bj][m][0], v1 = acc[ai][bj][m][1];
                        pg8::u32x4 w; w.x = pg8::cvt_pk_bf16(v0[0], v0[1]); w.y = pg8::cvt_pk_bf16(v0[2], v0[3]); w.z = pg8::cvt_pk_bf16(v1[0], v1[1]); w.w = pg8::cvt_pk_bf16(v1[2], v1[3]);
                        *(pg8::u32x4*)(rowp + bj * 128) = w; } }
        } else if (wc == 0 && fq < 2) {
#pragma unroll
            for (int ai = 0; ai < 2; ++ai)
#pragma unroll
                for (int m = 0; m < 4; ++m) { float* rp = dtraw + (size_t)(row0 + ai * 128 + m * 16) * 16 + 8 * fq;
                    *(pg8::f32x4*)rp = acc[ai][0][m][0]; *(pg8::f32x4*)(rp + 4) = acc[ai][0][m][1]; }
        }
        if (kmean && u.pn >= 4 && u.pn < 8) {
#pragma unroll
            for (int bj = 0; bj < 2; ++bj)
#pragma unroll
                for (int n = 0; n < 2; ++n)
#pragma unroll
                    for (int i = 0; i < 4; ++i) { float s = 0.f;
#pragma unroll
                        for (int ai = 0; ai < 2; ++ai)
#pragma unroll
                            for (int m = 0; m < 4; ++m) s += acc[ai][bj][m][n][i];
                        s += __shfl_xor(s, 1); s += __shfl_xor(s, 2); s += __shfl_xor(s, 4); s += __shfl_xor(s, 8);
                        if (fr == 0) unsafeAtomicAdd(kmean + (size_t)u.pm * 1024 + (col0 - 1024) + bj * 128 + 4 * n + i, s); }
        }
    }
};
struct EpiProj8 {
    static constexpr bool PERM = true, AFTER_DRAIN = false, SEG = false;
    bf16* O;
    __device__ __forceinline__ void operator()(const pg8::f32x4 (&acc)[2][2][4][2], const pg8::Unit& u, int wr, int wc, int fr, int fq) const {
        const int row0 = u.pm * 256 + wr * 64 + fr, col0 = F8_LO + u.pn * 256 + wc * 32 + 8 * fq; constexpr float sc = 1.f / (SH8 * SW8);
#pragma unroll
        for (int ai = 0; ai < 2; ++ai)
#pragma unroll
            for (int m = 0; m < 4; ++m) { bf16* rowp = O + (size_t)(row0 + ai * 128 + m * 16) * NPROJ + col0;
#pragma unroll
                for (int bj = 0; bj < 2; ++bj) { const pg8::f32x4 v0 = acc[ai][bj][m][0] * sc, v1 = acc[ai][bj][m][1] * sc;
                    pg8::u32x4 w; w.x = pg8::cvt_pk_bf16(v0[0], v0[1]); w.y = pg8::cvt_pk_bf16(v0[2], v0[3]); w.z = pg8::cvt_pk_bf16(v1[0], v1[1]); w.w = pg8::cvt_pk_bf16(v1[2], v1[3]);
                    *(pg8::u32x4*)(rowp + bj * 128) = w; } }
    }
};
struct EpiOut {
    static constexpr bool PERM = true, AFTER_DRAIN = false, SEG = true; static constexpr int SEG_T1 = 16, SEG_T2 = 24;
    const float* x; bf16* x1b; unsigned char* x18; float* ssq; bool doatom; const LAS f32x4* tab;
    __device__ __forceinline__ void seg_load(int ui, int wr, int fr, float (&sr)[16]) const {
#pragma unroll
        for (int i = 0; i < 8; ++i) { const int r = (i >> 2) * 128 + wr * 64 + (i & 3) * 16 + fr; const f32x2 q = *(const LAS f32x2*)(tab + ui * 256 + r); sr[2 * i] = q.x; sr[2 * i + 1] = q.y; }
        asm volatile("s_waitcnt lgkmcnt(0)" ::: "memory");
    }
    __device__ __forceinline__ void seg_apply(pg8::f32x4 (&acc)[2][2][4][2], const float (&sr)[16], int which) const {
#pragma unroll
        for (int ai = 0; ai < 2; ++ai)
#pragma unroll
            for (int m = 0; m < 4; ++m) { const float f = (which == 0) ? sr[2 * (ai * 4 + m)] : ((which == 1) ? sr[2 * (ai * 4 + m) + 1] : 1.0f);
#pragma unroll
                for (int bj = 0; bj < 2; ++bj)
#pragma unroll
                    for (int n = 0; n < 2; ++n) acc[ai][bj][m][n] = acc[ai][bj][m][n] * f; }
    }
    __device__ __forceinline__ void operator()(const pg8::f32x4 (&acc)[2][2][4][2], const pg8::Unit& u, int wr, int wc, int fr, int fq, int ui) const {
        const int row0 = u.pm * 256 + wr * 64 + fr, col0 = u.pn * 256 + wc * 32 + 8 * fq;
#pragma unroll
        for (int ai = 0; ai < 2; ++ai)
#pragma unroll
            for (int m = 0; m < 4; ++m) { const int row = row0 + ai * 128 + m * 16; const size_t off = (size_t)row * DM + col0; float s = 0.f;
                const float s1 = (*(const LAS f32x4*)(tab + ui * 256 + ai * 128 + wr * 64 + m * 16 + fr)).z;
#pragma unroll
                for (int bj = 0; bj < 2; ++bj) {
                    const pg8::f32x4 a0 = *(const pg8::f32x4*)(x + off + bj * 128), a1 = *(const pg8::f32x4*)(x + off + bj * 128 + 4);
                    const pg8::f32x4 v0 = acc[ai][bj][m][0] * s1 + a0, v1 = acc[ai][bj][m][1] * s1 + a1;
                    pg8::u32x4 w; w.x = pg8::cvt_pk_bf16(v0[0], v0[1]); w.y = pg8::cvt_pk_bf16(v0[2], v0[3]); w.z = pg8::cvt_pk_bf16(v1[0], v1[1]); w.w = pg8::cvt_pk_bf16(v1[2], v1[3]);
                    *(pg8::u32x4*)(x1b + off + bj * 128) = w;
                    { v2u o8; int w_; w_ = __builtin_amdgcn_cvt_pk_fp8_f32(clampf(v0[0] * SX8, 448.f), clampf(v0[1] * SX8, 448.f), 0, false); w_ = __builtin_amdgcn_cvt_pk_fp8_f32(clampf(v0[2] * SX8, 448.f), clampf(v0[3] * SX8, 448.f), w_, true); o8.x = (unsigned)w_;
                      w_ = __builtin_amdgcn_cvt_pk_fp8_f32(clampf(v1[0] * SX8, 448.f), clampf(v1[1] * SX8, 448.f), 0, false); w_ = __builtin_amdgcn_cvt_pk_fp8_f32(clampf(v1[2] * SX8, 448.f), clampf(v1[3] * SX8, 448.f), w_, true); o8.y = (unsigned)w_;
                      *(v2u*)(x18 + off + bj * 128) = o8; }
                    s += (v0[0] * v0[0] + v0[1] * v0[1]) + (v0[2] * v0[2] + v0[3] * v0[3]) + (v1[0] * v1[0] + v1[1] * v1[1]) + (v1[2] * v1[2] + v1[3] * v1[3]); }
                s += __shfl_xor(s, 16); s += __shfl_xor(s, 32);
                if (fq == 0 && doatom) unsafeAtomicAdd(ssq + (size_t)row * 4, s);
                asm volatile("" ::: "memory"); }
    }
};
struct EpiQ {
    static constexpr bool PERM = true, AFTER_DRAIN = false, SEG = false;
    bf16* O; const float* ssq;
    __device__ __forceinline__ void operator()(const pg8::f32x4 (&acc)[2][2][4][2], const pg8::Unit& u, int wr, int wc, int fr, int fq) const {
        const int row0 = u.pm * 256 + wr * 64 + fr, col0 = u.pn * 256 + wc * 32 + 8 * fq;
#pragma unroll
        for (int ai = 0; ai < 2; ++ai)
#pragma unroll
            for (int m = 0; m < 4; ++m) { const int row = row0 + ai * 128 + m * 16; bf16* rowp = O + (size_t)row * DM + col0;
                const float rs = (1.f / (SX8 * SW8)) / sqrtf(__hip_atomic_load(ssq + (size_t)row * 4, RLX_AGENT) * (1.f / DM) + EPS);
#pragma unroll
                for (int bj = 0; bj < 2; ++bj) { const pg8::f32x4 v0 = acc[ai][bj][m][0] * rs, v1 = acc[ai][bj][m][1] * rs;
                    pg8::u32x4 w; w.x = pg8::cvt_pk_bf16(v0[0], v0[1]); w.y = pg8::cvt_pk_bf16(v0[2], v0[3]); w.z = pg8::cvt_pk_bf16(v1[0], v1[1]); w.w = pg8::cvt_pk_bf16(v1[2], v1[3]);
                    *(pg8::u32x4*)(rowp + bj * 128) = w; } }
    }
};

constexpr int A_KSTR = 272, A_VSTR = 288;
constexpr int A_KB0 = 0, A_KB1 = 64 * A_KSTR, A_VB0 = 2 * 64 * A_KSTR, A_VBS = 64 * A_VSTR  , A_KM = A_VB0 + 3 * A_VBS, A_TAB = A_KM + 8 * 128 * 4, A_END = A_TAB + 128 * 4;
static_assert(A_END <= RING_BYTES && (A_KM % 16) == 0, "attention LDS map");
#define PIN16(a, i) asm volatile("" : "+v"(a[i]), "+v"(a[i + 1]), "+v"(a[i + 2]), "+v"(a[i + 3]), "+v"(a[i + 4]), "+v"(a[i + 5]), "+v"(a[i + 6]), "+v"(a[i + 7]), "+v"(a[i + 8]), "+v"(a[i + 9]), "+v"(a[i + 10]), "+v"(a[i + 11]), "+v"(a[i + 12]), "+v"(a[i + 13]), "+v"(a[i + 14]), "+v"(a[i + 15]))
#define TR16(p) __builtin_amdgcn_ds_read_tr16_b64_v4i16((LAS s16x4*)(p))
#define MFMA16(a, b, c) __builtin_amdgcn_mfma_f32_16x16x32_bf16((a), (b), (c), 0, 0, 0)
__device__ __forceinline__ bf16x8 pack8(const float* v) {
    const unsigned a = pk2(v[0], v[1]), b = pk2(v[2], v[3]), c = pk2(v[4], v[5]), d = pk2(v[6], v[7]);
    const v4u u = {a, b, c, d}; return __builtin_bit_cast(bf16x8, u);
}
__device__ __forceinline__ void attn_unit(Frame& F, int b, int h, int blk, const bool doatom = true) {
    LAS unsigned char* lds = F.lds + RING_OFF;
    const int tid = fresh_tid(), lane = tid & 63, w = __builtin_amdgcn_readfirstlane(tid >> 6), g = lane >> 4, c16 = lane & 15, q4 = c16 >> 2, p4 = lane & 3;
    const int own = blk, t0 = blk * 256, tq0 = t0 + 32 * w + c16;
    const size_t rowbase = (size_t)b * SEQ;
    const float NEG_INF = -__builtin_inff();
    constexpr float LOG2E = 1.4426950408889634f, SCL2 = 0.08838834764831845f * 1.4426950408889634f;
    LAS float* km = (LAS float*)(lds + A_KM); LAS float* tab = (LAS float*)(lds + A_TAB);
    const bf16* const PROJ = F.PROJ(); const float* const kmg = F.kmean(); const float* const relb = F.rel_bias();
    for (int i = tid; i < own * 128; i += NWAVES * 64) { const int n = i >> 7, d = i & 127; km[i] = kmg[(size_t)(b * 8 + n) * 1024 + h * 128 + d] * (1.f / 256.f); }
    if (tid < 128) { const int rel = tid; int bucket = rel; if (rel >= 16) { bucket = 16 + (int)(log2f((float)rel * (1.f / 16.f)) * (16.f / 3.f)); bucket = bucket > 31 ? 31 : bucket; }
        tab[tid] = relb[bucket * 8 + h] * LOG2E; }
    bf16x8 qf[2][4];
#pragma unroll
    for (int gi = 0; gi < 2; ++gi) { const bf16* qrow = PROJ + (rowbase + tq0 + 16 * gi) * NPROJ + COL_Q + h * 128 + 8 * g;
#pragma unroll
      for (int ks = 0; ks < 4; ++ks) qf[gi][ks] = *(const GAS bf16x8*)(qrow + 32 * ks); }
    __syncthreads();
    unsigned selmask[2];
    if (own <= 3) { selmask[0] = (1u << own) - 1u; selmask[1] = selmask[0]; }
    else {
#pragma unroll
      for (int gi = 0; gi < 2; ++gi) {
        float gate[7];
#pragma unroll
        for (int n = 0; n < 7; ++n) {
            float s = NEG_INF;
            if (n < own) { s = 0.f;
#pragma unroll
                for (int ks = 0; ks < 4; ++ks) { const LAS f32x4* kp = (const LAS f32x4*)(km + n * 128 + 32 * ks + 8 * g); const f32x4 k0 = kp[0], k1 = kp[1]; const v4u qu = __builtin_bit_cast(v4u, qf[gi][ks]);
                    s += bflo(qu.x) * k0.x + bfhi(qu.x) * k0.y + bflo(qu.y) * k0.z + bfhi(qu.y) * k0.w + bflo(qu.z) * k1.x + bfhi(qu.z) * k1.y + bflo(qu.w) * k1.z + bfhi(qu.w) * k1.w; }
                s += __shfl_xor(s, 16); s += __shfl_xor(s, 32); }
            gate[n] = s;
        }
        unsigned sm = 0u;
#pragma unroll
        for (int r = 0; r < 3; ++r) { float best = NEG_INF; int bi = 0;
#pragma unroll
            for (int n = 0; n < 7; ++n) { const bool cand = (n < own) && !((sm >> n) & 1u) && (gate[n] > best); best = cand ? gate[n] : best; bi = cand ? n : bi; }
            sm |= 1u << bi; }
        selmask[gi] = sm; }
    }
    const int nT = 4 + 4 * own;
    const int sr = tid >> 3, sc = (tid & 7) * 16;
#define A_KEY0(i) ((i) < 4 ? own * 256 + 64 * (i) : (((i) - 4) >> 2) * 256 + (((i) - 4) & 3) * 64)
    v4u kr0, kr1, vr0, vr1;
#define A_LOAD(i) do { const bf16* kp_ = PROJ + (rowbase + A_KEY0(i) + sr) * NPROJ + COL_K + h * 128 + sc; \
        kr0 = *(const GAS v4u*)kp_; kr1 = *(const GAS v4u*)(kp_ + 8); vr0 = *(const GAS v4u*)(kp_ + (COL_V - COL_K)); vr1 = *(const GAS v4u*)(kp_ + (COL_V - COL_K) + 8); } while (0)
#define A_STORE(bufi) do { LAS unsigned char* kd_ = lds + ((bufi) ? A_KB1 : A_KB0) + sr * A_KSTR + sc * 2; LAS unsigned char* vd_ = lds + A_VB0 + vnx * A_VBS + sr * A_VSTR + sc * 2; \
        *(LAS v4u*)kd_ = kr0; *(LAS v4u*)(kd_ + 16) = kr1; *(LAS v4u*)vd_ = vr0; *(LAS v4u*)(vd_ + 16) = vr1; } while (0)
    int vcur = 0, vnx = 0, vprev = 0;
#define A_PV(PF, Vb_) do { _Pragma("unroll") for (int s = 0; s < 2; ++s) { s16x4 vlo[8], vhi[8]; \
            _Pragma("unroll") for (int db = 0; db < 8; ++db) { LAS unsigned char* va = (Vb_) + (32 * s + 4 * g + q4) * A_VSTR + (16 * db + 4 * p4) * 2; vlo[db] = TR16(va); vhi[db] = TR16(va + 16 * A_VSTR); } \
            __builtin_amdgcn_sched_barrier(0); \
            _Pragma("unroll") for (int db = 0; db < 8; ++db) { const bf16x8 vf = __builtin_shufflevector(vlo[db], vhi[db], 0, 1, 2, 3, 4, 5, 6, 7); \
                oacc[0][db] = MFMA16(vf, PF[0][s], oacc[0][db]); oacc[1][db] = MFMA16(vf, PF[1][s], oacc[1][db]); } \
            __builtin_amdgcn_sched_barrier(0); } } while (0)
    A_LOAD(0); A_STORE(0);
    __syncthreads();
    const bool late = w >= 4;
    bf16x8 pfp[2][2]; bool skipp = true;
#pragma unroll
    for (int gi = 0; gi < 2; ++gi) { pfp[gi][0] = (bf16x8){0, 0, 0, 0, 0, 0, 0, 0}; pfp[gi][1] = pfp[gi][0]; }
    float m_run[2] = {NEG_INF, NEG_INF}, l_run[2] = {0.f, 0.f};
    f32x4 oacc[2][8];
#pragma unroll
    for (int gi = 0; gi < 2; ++gi)
#pragma unroll
        for (int db = 0; db < 8; ++db) oacc[gi][db] = (f32x4){0.f, 0.f, 0.f, 0.f};
    for (int i = 0; i < nT; ++i) {
        if (i + 1 < nT) A_LOAD(i + 1);
        vnx = (vcur == 2) ? 0 : vcur + 1;
        const int buf = i & 1, key0 = A_KEY0(i); const bool isown = i < 4; const int pblk = isown ? own : ((i - 4) >> 2);
        const bool skipw = isown && (64 * i > 32 * w + 31);
        if (late && !skipp) A_PV(pfp, lds + A_VB0 + vprev * A_VBS);
        bf16x8 pf[2][2];
        if (!skipw) {
        LAS unsigned char* Kb = lds + (buf ? A_KB1 : A_KB0);
        f32x4 sacc[2][4];
#pragma unroll
        for (int hf = 0; hf < 2; ++hf) { bf16x8 kf[8];
#pragma unroll
            for (int n2 = 0; n2 < 2; ++n2)
#pragma unroll
                for (int ks = 0; ks < 4; ++ks) kf[n2 * 4 + ks] = *(const LAS bf16x8*)(Kb + (16 * (2 * hf + n2) + c16) * A_KSTR + (32 * ks + 8 * g) * 2);
            __builtin_amdgcn_sched_barrier(0);
#pragma unroll
            for (int gi = 0; gi < 2; ++gi)
#pragma unroll
                for (int n2 = 0; n2 < 2; ++n2) { f32x4 a = (f32x4){0.f, 0.f, 0.f, 0.f};
#pragma unroll
                    for (int ks = 0; ks < 4; ++ks) a = MFMA16(kf[n2 * 4 + ks], qf[gi][ks], a);
                    sacc[gi][2 * hf + n2] = a; }
            __builtin_amdgcn_sched_barrier(0); }
        const bool far = (key0 + 63 + 128 <= t0 + 32 * w);
        const bool diag = isown && (64 * i + 63 > 32 * w);
#pragma unroll
        for (int gi = 0; gi < 2; ++gi) {
            const int tq = tq0 + 16 * gi; const bool sel = isown || ((selmask[gi] >> pblk) & 1u);
            float sv[16]; float mloc, m_new, alpha;
            if (far) {
                const float bfar = tab[127];
                float mx = fmaxf(fmaxf(sacc[gi][0][0], sacc[gi][0][1]), fmaxf(sacc[gi][0][2], sacc[gi][0][3]));
#pragma unroll
                for (int nb = 1; nb < 4; ++nb) mx = fmaxf(mx, fmaxf(fmaxf(sacc[gi][nb][0], sacc[gi][nb][1]), fmaxf(sacc[gi][nb][2], sacc[gi][nb][3])));
                mloc = sel ? (mx * SCL2 + bfar) : NEG_INF;
                mloc = fmaxf(mloc, __shfl_xor(mloc, 16)); mloc = fmaxf(mloc, __shfl_xor(mloc, 32));
                m_new = fmaxf(m_run[gi], mloc); alpha = __builtin_amdgcn_exp2f(m_run[gi] - m_new);
                const float cadd = sel ? (bfar - m_new) : NEG_INF;
#pragma unroll
                for (int nb = 0; nb < 4; ++nb)
#pragma unroll
                    for (int r = 0; r < 4; ++r) sv[nb * 4 + r] = __builtin_amdgcn_exp2f(sacc[gi][nb][r] * SCL2 + cadd);
            } else {
                const int relb = tq - key0 - 4 * g; float bias[16];
#pragma unroll
                for (int nb = 0; nb < 4; ++nb)
#pragma unroll
                    for (int r = 0; r < 4; ++r) { const int rel = relb - 16 * nb - r; int ri = rel < 0 ? 0 : rel; ri = ri > 127 ? 127 : ri; bias[nb * 4 + r] = tab[ri]; }
                PIN16(bias, 0);
                mloc = NEG_INF;
#pragma unroll
                for (int nb = 0; nb < 4; ++nb)
#pragma unroll
                    for (int r = 0; r < 4; ++r) { const int rel = relb - 16 * nb - r;
                        float s = sacc[gi][nb][r] * SCL2 + bias[nb * 4 + r]; s = (!sel || (diag && rel < 0)) ? NEG_INF : s; sv[nb * 4 + r] = s; mloc = fmaxf(mloc, s); }
                mloc = fmaxf(mloc, __shfl_xor(mloc, 16)); mloc = fmaxf(mloc, __shfl_xor(mloc, 32));
                m_new = fmaxf(m_run[gi], mloc); alpha = __builtin_amdgcn_exp2f(m_run[gi] - m_new);
#pragma unroll
                for (int e = 0; e < 16; ++e) sv[e] = __builtin_amdgcn_exp2f(sv[e] - m_new);
            }
            float psum = 0.f;
#pragma unroll
            for (int e = 0; e < 16; ++e) psum += sv[e];
            l_run[gi] = l_run[gi] * alpha + psum; m_run[gi] = m_new;
#pragma unroll
            for (int db = 0; db < 8; ++db) oacc[gi][db] = oacc[gi][db] * alpha;
            pf[gi][0] = pack8(sv); pf[gi][1] = pack8(sv + 8);
        }
        __builtin_amdgcn_sched_barrier(0);
        if (!late) A_PV(pf, lds + A_VB0 + vcur * A_VBS);
        }
        if (late) { skipp = skipw;
#pragma unroll
            for (int gi = 0; gi < 2; ++gi) { pfp[gi][0] = pf[gi][0]; pfp[gi][1] = pf[gi][1]; } }
        if (i + 1 < nT) A_STORE((i + 1) & 1);
        vprev = vcur; vcur = vnx;
        __syncthreads();
    }
    if (late && !skipp) A_PV(pfp, lds + A_VB0 + vprev * A_VBS);
#undef A_PV
    bf16* const MIXp = F.HN(); float* const ssqp = F.ssq();
#pragma unroll
    for (int gi = 0; gi < 2; ++gi) {
        const int tq = tq0 + 16 * gi;
        float l_tot = l_run[gi]; l_tot += __shfl_xor(l_tot, 16); l_tot += __shfl_xor(l_tot, 32);
        const float inv = 1.f / l_tot; float ssq = 0.f;
        bf16* orow = MIXp + (rowbase + tq) * DM + h * 128 + 4 * g;
#pragma unroll
        for (int db = 0; db < 8; ++db) { const f32x4 o = oacc[gi][db] * inv; ssq += (o.x * o.x + o.y * o.y) + (o.z * o.z + o.w * o.w); v2u wv; wv.x = pk2(o.x, o.y); wv.y = pk2(o.z, o.w); *(GAS v2u*)(orow + 16 * db) = wv; }
        ssq += __shfl_xor(ssq, 16); ssq += __shfl_xor(ssq, 32);
        if (g == 0 && doatom) unsafeAtomicAdd(ssqp + (rowbase + tq) * 4 + 1, ssq);
    }
#undef A_KEY0
#undef A_LOAD
#undef A_STORE
}

constexpr int XBC_W = CONV_CH;
__device__ __forceinline__ void conv_phase(Frame& F) {
    const bf16* const PROJ = F.PROJ(); bf16* const XBC = F.XBC(); const float* const cw = F.conv_w(); const float* const cb = F.conv_b();
    const int gt = blockIdx.x * (NWAVES * 64) + fresh_tid(), GT = F.G * NWAVES * 64;
    for (int task = gt; task < (MTOK / 32) * (CONV_CH / 8); task += GT) {
        const int r = task / (CONV_CH / 8), k = task % (CONV_CH / 8), ch = 8 * k, tok0 = 32 * r;
        float wv[4][8], bias[8];
#pragma unroll
        for (int t = 0; t < 4; ++t) { const f32x4 w0 = *(const GAS f32x4*)(cw + t * CONV_CH + ch), w1 = *(const GAS f32x4*)(cw + t * CONV_CH + ch + 4);
            wv[t][0] = w0.x; wv[t][1] = w0.y; wv[t][2] = w0.z; wv[t][3] = w0.w; wv[t][4] = w1.x; wv[t][5] = w1.y; wv[t][6] = w1.z; wv[t][7] = w1.w; }
        { const f32x4 b0 = *(const GAS f32x4*)(cb + ch), b1 = *(const GAS f32x4*)(cb + ch + 4); bias[0] = b0.x; bias[1] = b0.y; bias[2] = b0.z; bias[3] = b0.w; bias[4] = b1.x; bias[5] = b1.y; bias[6] = b1.z; bias[7] = b1.w; }
        const bf16* src = PROJ + (size_t)tok0 * NPROJ + COL_XBC + ch; bf16* dst = XBC + (size_t)tok0 * XBC_W + ch;
        v4u p0 = (v4u){0u, 0u, 0u, 0u}, p1 = p0, p2 = p0;
        if ((tok0 & (SEQ - 1)) != 0) { p0 = *(const GAS v4u*)(src - 3 * (ptrdiff_t)NPROJ); p1 = *(const GAS v4u*)(src - 2 * (ptrdiff_t)NPROJ); p2 = *(const GAS v4u*)(src - (ptrdiff_t)NPROJ); }
#pragma unroll 1
        for (int i0 = 0; i0 < 32; i0 += 8) {
            v4u cur[8];
#pragma unroll
            for (int i = 0; i < 8; ++i) cur[i] = *(const GAS v4u*)(src + (size_t)(i0 + i) * NPROJ);
#pragma unroll
            for (int i = 0; i < 8; ++i) {
                const v4u c = cur[i]; float acc[8];
                const unsigned a0[4] = {p0.x, p0.y, p0.z, p0.w}, a1[4] = {p1.x, p1.y, p1.z, p1.w}, a2[4] = {p2.x, p2.y, p2.z, p2.w}, a3[4] = {c.x, c.y, c.z, c.w};
#pragma unroll
                for (int j = 0; j < 4; ++j) {
                    acc[2 * j] = bias[2 * j] + wv[0][2 * j] * bflo(a0[j]) + wv[1][2 * j] * bflo(a1[j]) + wv[2][2 * j] * bflo(a2[j]) + wv[3][2 * j] * bflo(a3[j]);
                    acc[2 * j + 1] = bias[2 * j + 1] + wv[0][2 * j + 1] * bfhi(a0[j]) + wv[1][2 * j + 1] * bfhi(a1[j]) + wv[2][2 * j + 1] * bfhi(a2[j]) + wv[3][2 * j + 1] * bfhi(a3[j]); }
#pragma unroll
                for (int j = 0; j < 8; ++j) acc[j] = silu_f(acc[j]);
                v4u o; o.x = pk2(acc[0], acc[1]); o.y = pk2(acc[2], acc[3]); o.z = pk2(acc[4], acc[5]); o.w = pk2(acc[6], acc[7]);
                *(GAS v4u*)(dst + (size_t)(i0 + i) * XBC_W) = o;
                p0 = p1; p1 = p2; p2 = c; }
        }
    }
    { const float* const dtraw = F.dtraw(); float* const dt2 = F.DT2(); const float* const dtb = F.dt_bias();
      for (int i = gt; i < MTOK * 16; i += GT) { const float xr = dtraw[i] + dtb[i & 15]; dt2[i] = xr > 20.f ? xr : log1pf(__expf(xr)); } }
}

constexpr int S_BSTR = 272, S_XSTR = 144;
constexpr int S_BM = 0, S_CM = 128 * S_BSTR, S_X = 2 * 128 * S_BSTR, S_XW = S_X + 128 * S_XSTR, S_HB = S_XW + 128 * S_XSTR, S_DT = S_HB + 64 * S_BSTR, S_CS = S_DT + 512, S_DA = S_CS + 512, S_END = S_DA + 512;
static_assert(S_END <= RING_BYTES, "ssd LDS map");
__device__ __forceinline__ void ssd_unit(Frame& F, int b, int h, const bool doatom = true) {
    LAS unsigned char* lds = F.lds + RING_OFF;
    const int tid = fresh_tid(), lane = tid & 63, w = __builtin_amdgcn_readfirstlane(tid >> 6), g = lane >> 4, c16 = lane & 15, q4 = c16 >> 2, p4 = lane & 3;
    const int g8 = h >> 3, pbw = w & 3, nhw = w >> 2;
    const float a_h = -__expf(F.a_log()[h]), dsk = F.d_skip()[h];
    const bf16* const PROJ = F.PROJ(); bf16* const MIX = F.HN(); const float* const dt2 = F.DT2(); const bf16* const XBC = F.XBC(); float* const ssqp = F.ssq();
    LAS float* dtl = (LAS float*)(lds + S_DT); LAS float* csl = (LAS float*)(lds + S_CS); LAS float* dal = (LAS float*)(lds + S_DA);
    for (int i = tid; i < 64 * S_BSTR / 16; i += NWAVES * 64) ((LAS v4u*)(lds + S_HB))[i] = (v4u){0u, 0u, 0u, 0u};
    f32x4 hacc[4];
#pragma unroll
    for (int i = 0; i < 4; ++i) hacc[i] = (f32x4){0.f, 0.f, 0.f, 0.f};
    const int xl = tid >> 3, xc = tid & 7, bl = tid >> 4, bc = tid & 15;
    v4u xr[2], br[4], cr[4]; float dtv = 0.f;
#define S_PREFETCH(cc) do { const size_t t0_ = (size_t)b * SEQ + (size_t)(cc) * SSM_L; \
        _Pragma("unroll") for (int i_ = 0; i_ < 2; ++i_) xr[i_] = *(const GAS v4u*)(XBC + (t0_ + xl + 64 * i_) * XBC_W + h * 64 + 8 * xc); \
        _Pragma("unroll") for (int i_ = 0; i_ < 4; ++i_) { const bf16* p_ = XBC + (t0_ + bl + 32 * i_) * XBC_W + 1024 + g8 * 128 + 8 * bc; br[i_] = *(const GAS v4u*)p_; cr[i_] = *(const GAS v4u*)(p_ + 256); } \
        if (tid < 128) dtv = dt2[(t0_ + tid) * 16 + h]; } while (0)
    S_PREFETCH(0);
    for (int c = 0; c < SSM_NC; ++c) {
        const size_t tok0 = (size_t)b * SEQ + (size_t)c * SSM_L;
        if (tid < 128) { dtl[tid] = dtv; dal[tid] = dtv * a_h; }
        __syncthreads();
        if (w == 0) { const float v0 = dal[2 * lane], v1 = dal[2 * lane + 1]; float s = v0 + v1;
#pragma unroll
            for (int o = 1; o < 64; o <<= 1) { const float t = __shfl_up(s, o); s += (lane >= o) ? t : 0.f; }
            csl[2 * lane] = s - v1; csl[2 * lane + 1] = s; }
        __syncthreads();
        const float cs_last = csl[127];
#pragma unroll
        for (int i = 0; i < 2; ++i) { const int l = xl + 64 * i; const v4u v = xr[i]; *(LAS v4u*)(lds + S_X + l * S_XSTR + xc * 16) = v; const float wl = dtl[l] * __expf(cs_last - csl[l]);
            v4u o2; o2.x = pk2(bflo(v.x) * wl, bfhi(v.x) * wl); o2.y = pk2(bflo(v.y) * wl, bfhi(v.y) * wl); o2.z = pk2(bflo(v.z) * wl, bfhi(v.z) * wl); o2.w = pk2(bflo(v.w) * wl, bfhi(v.w) * wl);
            *(LAS v4u*)(lds + S_XW + l * S_XSTR + xc * 16) = o2; }
#pragma unroll
        for (int i = 0; i < 4; ++i) { const int l = bl + 32 * i; *(LAS v4u*)(lds + S_BM + l * S_BSTR + bc * 16) = br[i]; *(LAS v4u*)(lds + S_CM + l * S_BSTR + bc * 16) = cr[i]; }
        const int lrow = 16 * w + c16;
        v2u zr[4];
#pragma unroll
        for (int pb = 0; pb < 4; ++pb) zr[pb] = *(const GAS v2u*)(PROJ + (tok0 + lrow) * NPROJ + COL_Z + h * 64 + 16 * pb + 4 * g);
        if (c + 1 < SSM_NC) S_PREFETCH(c + 1);
        __syncthreads();
        bf16x8 cf[4];
#pragma unroll
        for (int ks = 0; ks < 4; ++ks) cf[ks] = *(const LAS bf16x8*)(lds + S_CM + lrow * S_BSTR + (32 * ks + 8 * g) * 2);
        f32x4 yacc[4];
        const float cs_l = csl[lrow]; const float el = __expf(cs_l);
#pragma unroll
        for (int pb = 0; pb < 4; ++pb) { yacc[pb] = (f32x4){0.f, 0.f, 0.f, 0.f};
#pragma unroll
            for (int ks = 0; ks < 4; ++ks) { const bf16x8 hf = *(const LAS bf16x8*)(lds + S_HB + (16 * pb + c16) * S_BSTR + (32 * ks + 8 * g) * 2); yacc[pb] = MFMA16(hf, cf[ks], yacc[pb]); }
            yacc[pb] = yacc[pb] * el; }
        for (int s2 = 0; s2 <= (w >> 1); ++s2) {
            const int sb0 = 2 * s2, sb1 = 2 * s2 + 1; const bool has1 = sb1 <= w;
            f32x4 cb0 = (f32x4){0.f, 0.f, 0.f, 0.f}, cb1 = (f32x4){0.f, 0.f, 0.f, 0.f};
#pragma unroll
            for (int ks = 0; ks < 4; ++ks) { const bf16x8 bf0 = *(const LAS bf16x8*)(lds + S_BM + (16 * sb0 + c16) * S_BSTR + (32 * ks + 8 * g) * 2); cb0 = MFMA16(bf0, cf[ks], cb0); }
            if (has1) {
#pragma unroll
                for (int ks = 0; ks < 4; ++ks) { const bf16x8 bf1 = *(const LAS bf16x8*)(lds + S_BM + (16 * sb1 + c16) * S_BSTR + (32 * ks + 8 * g) * 2); cb1 = MFMA16(bf1, cf[ks], cb1); } }
            float mv[8];
#pragma unroll
            for (int r = 0; r < 4; ++r) { const int s = 16 * sb0 + 4 * g + r; const float e = __expf(fminf(cs_l - csl[s], 0.f)) * dtl[s]; mv[r] = (s <= lrow) ? cb0[r] * e : 0.f; }
#pragma unroll
            for (int r = 0; r < 4; ++r) { const int s = 16 * sb1 + 4 * g + r; const int sc_ = s > 127 ? 127 : s; const float e = __expf(fminf(cs_l - csl[sc_], 0.f)) * dtl[sc_]; mv[4 + r] = (has1 && s <= lrow) ? cb1[r] * e : 0.f; }
            const bf16x8 pf = pack8(mv);
#pragma unroll
            for (int pb = 0; pb < 4; ++pb) { LAS unsigned char* xa = lds + S_X + (32 * s2 + 4 * g + q4) * S_XSTR + (16 * pb + 4 * p4) * 2;
                const s16x4 lo = TR16(xa), hi = TR16(xa + 16 * S_XSTR); const bf16x8 xf = __builtin_shufflevector(lo, hi, 0, 1, 2, 3, 4, 5, 6, 7);
                yacc[pb] = MFMA16(xf, pf, yacc[pb]); }
        }
        { const size_t tok = tok0 + lrow; float ssq = 0.f;
#pragma unroll
          for (int pb = 0; pb < 4; ++pb) { const int p0 = 16 * pb + 4 * g;
              const v2u xs_ = *(const LAS v2u*)(lds + S_X + lrow * S_XSTR + p0 * 2);
              const v2u zr_ = zr[pb];
              const float o0 = (yacc[pb].x + bflo(xs_.x) * dsk) * silu_f(bflo(zr_.x)), o1 = (yacc[pb].y + bfhi(xs_.x) * dsk) * silu_f(bfhi(zr_.x));
              const float o2 = (yacc[pb].z + bflo(xs_.y) * dsk) * silu_f(bflo(zr_.y)), o3 = (yacc[pb].w + bfhi(xs_.y) * dsk) * silu_f(bfhi(zr_.y));
              ssq += (o0 * o0 + o1 * o1) + (o2 * o2 + o3 * o3);
              v2u wv; wv.x = pk2(o0, o1); wv.y = pk2(o2, o3); *(GAS v2u*)(MIX + tok * DM + ATT_W + h * 64 + p0) = wv; }
          ssq += __shfl_xor(ssq, 16); ssq += __shfl_xor(ssq, 32);
          if (g == 0 && doatom) unsafeAtomicAdd(ssqp + tok * 4 + 2 + g8, ssq); }
        { const float cdec = __expf(cs_last);
#pragma unroll
          for (int i = 0; i < 4; ++i) hacc[i] = hacc[i] * cdec;
#pragma unroll
          for (int ks = 0; ks < 4; ++ks) {
              LAS unsigned char* xa = lds + S_XW + (32 * ks + 8 * g + q4) * S_XSTR + (16 * pbw + 4 * p4) * 2;
              const s16x4 xlo = TR16(xa), xhi = TR16(xa + 4 * S_XSTR); const bf16x8 xf = __builtin_shufflevector(xlo, xhi, 0, 1, 2, 3, 4, 5, 6, 7);
#pragma unroll
              for (int i = 0; i < 4; ++i) { const int nb = 4 * nhw + i; LAS unsigned char* ba = lds + S_BM + (32 * ks + 8 * g + q4) * S_BSTR + (16 * nb + 4 * p4) * 2;
                  const s16x4 blo = TR16(ba), bhi = TR16(ba + 4 * S_BSTR); const bf16x8 bfr = __builtin_shufflevector(blo, bhi, 0, 1, 2, 3, 4, 5, 6, 7);
                  hacc[i] = MFMA16(bfr, xf, hacc[i]); } } }
        __syncthreads();
#pragma unroll
        for (int i = 0; i < 4; ++i) { const int nb = 4 * nhw + i; v2u o; o.x = pk2(hacc[i].x, hacc[i].y); o.y = pk2(hacc[i].z, hacc[i].w);
            *(LAS v2u*)(lds + S_HB + (16 * pbw + c16) * S_BSTR + (16 * nb + 4 * g) * 2) = o; }
    }
#undef S_PREFETCH
    __syncthreads();
}

__device__ __forceinline__ void mix_normalize(Frame& F) {
    const int tid_ = fresh_tid(), lane = tid_ & 63; const int gw = blockIdx.x * NWAVES + __builtin_amdgcn_readfirstlane(tid_ >> 6), NGW = F.G * NWAVES;
    const float* const ssqp = F.ssq(); bf16* const MIX = F.HN(); const float* const gatt = F.attn_out_norm(); const float* const gssm = F.ssm_out_norm();
    for (int m = gw; m < MTOK; m += NGW) {
        const float* sq = ssqp + (size_t)m * 4;
        const float s1 = __hip_atomic_load(sq + 1, RLX_AGENT), s2 = __hip_atomic_load(sq + 2, RLX_AGENT), s3 = __hip_atomic_load(sq + 3, RLX_AGENT);
        const float ra = 1.f / sqrtf(s1 * (1.f / 1024.f) + EPS), r0 = 1.f / sqrtf(s2 * (1.f / 512.f) + EPS), r1 = 1.f / sqrtf(s3 * (1.f / 512.f) + EPS);
        GAS v4u* row = (GAS v4u*)(MIX + (size_t)m * DM);
#pragma unroll
        for (int j = 0; j < 4; ++j) { const int idx = lane + 64 * j, col = 8 * idx; const float rs = (j < 2) ? ra : ((j == 2) ? r0 : r1);
            const float* gp = (j < 2) ? (gatt + col) : (gssm + (col - ATT_W));
            const f32x4 g0 = *(const GAS f32x4*)gp, g1 = *(const GAS f32x4*)(gp + 4); const v4u v = row[idx]; v4u o;
            o.x = pk2(bflo(v.x) * rs * g0.x, bfhi(v.x) * rs * g0.y); o.y = pk2(bflo(v.y) * rs * g0.z, bfhi(v.y) * rs * g0.w);
            o.z = pk2(bflo(v.z) * rs * g1.x, bfhi(v.z) * rs * g1.y); o.w = pk2(bflo(v.w) * rs * g1.z, bfhi(v.w) * rs * g1.w); row[idx] = o; }
    }
}

constexpr int P_EIDX = 0, P_GATE = 16384, P_LST = 32768, P_HN = 65536, P_ACT = 98304, P_END = 102400;
static_assert(P_END <= RING_BYTES, "peer LDS map");
__constant__ unsigned char PEER_CAND[52] = {0, 1, 2, 3, 4, 5, 6, 7, 8, 9, 10, 11, 12, 13, 14, 15, 16, 17, 18, 19, 20, 21, 22, 23, 32, 33, 34, 35, 36, 48, 49, 50, 51, 64, 65, 66, 80, 81, 96, 97, 112, 113, 128, 144, 160, 176, 192, 208, 224, 240, 255, 255};
__device__ __forceinline__ unsigned f2ord(float f) { const unsigned u = __builtin_bit_cast(unsigned, f); return u ^ ((u >> 31) ? 0xFFFFFFFFu : 0x80000000u); }
__device__ __forceinline__ float ord2f(unsigned u) { return __builtin_bit_cast(float, u ^ ((u >> 31) ? 0x80000000u : 0xFFFFFFFFu)); }
#define CSWAPD(a, b) do { const unsigned hi_ = (a) > (b) ? (a) : (b), lo_ = (a) > (b) ? (b) : (a); (a) = hi_; (b) = lo_; } while (0)
template <int N> __device__ __forceinline__ void bitonic_sort_desc(unsigned (&v)[N]) {
#pragma unroll
    for (int k = 2; k <= N; k <<= 1)
#pragma unroll
        for (int j = k >> 1; j > 0; j >>= 1)
#pragma unroll
            for (int i = 0; i < N; ++i) { const int l = i ^ j; if (l > i) { if ((i & k) == 0) CSWAPD(v[i], v[l]); else CSWAPD(v[l], v[i]); } }
}
__device__ __forceinline__ void merge16_xor(unsigned (&v)[16], int dist) {
    unsigned o[16];
#pragma unroll
    for (int i = 0; i < 16; ++i) o[i] = (unsigned)__shfl_xor((int)v[i], dist);
#pragma unroll
    for (int i = 0; i < 16; ++i) v[i] = v[i] > o[15 - i] ? v[i] : o[15 - i];
#pragma unroll
    for (int j = 8; j > 0; j >>= 1)
#pragma unroll
        for (int i = 0; i < 16; ++i) { const int l = i ^ j; if (l > i) CSWAPD(v[i], v[l]); }
}
__device__ __forceinline__ float gelu_erf(float x) { return 0.5f * x * (1.f + erff(x * 0.70710678118654752f)); }
__device__ __forceinline__ float fp4_dec1(unsigned n) { const unsigned m = n & 7u; unsigned bits = (m >= 2u) ? (((126u + (m >> 1)) << 23) | ((m & 1u) << 22)) : (m ? 0x3F000000u : 0u); bits |= (n & 8u) << 28; return __builtin_bit_cast(float, bits); }
__device__ __forceinline__ f32x2 fp4_dec2(unsigned x) { f32x2 r; r.x = fp4_dec1(x & 15u); r.y = fp4_dec1((x >> 4) & 15u); return r; }
typedef long i64;
typedef int v8i __attribute__((ext_vector_type(8)));
__device__ __forceinline__ void peer_unit(Frame& F, int u, const bool dry = false) {
    LAS unsigned char* lds = F.lds + RING_OFF;
    const int tid_ = fresh_tid(), lane = tid_ & 63, w = __builtin_amdgcn_readfirstlane(tid_ >> 6), g = lane >> 4, c16 = lane & 15;
    const int T0 = 32 * u;
    LAS int* eidx = (LAS int*)(lds + P_EIDX); LAS float* gate = (LAS float*)(lds + P_GATE);
    LAS unsigned* lst = (LAS unsigned*)(lds + P_LST) + w * 1024;
    const bf16* const QP = F.QP(); const bf16* const SK = F.SK(); float* const outp = F.out(); const bf16* const X1B = F.X1B(); const float* const fgain = F.ffn_norm(); const float* const fing = F.final_norm(); const unsigned char* const U8 = F.U8(); const unsigned char* const V8 = F.V8();
#ifndef NO_ROUTE
    for (int tb = 0; tb < 2; ++tb) {
        for (int c = 0; c < 2; ++c) {
            const int p = 2 * w + c;
            bf16x8 qf[4];
            { const unsigned qo = ((unsigned)(T0 + 16 * tb + c16) * (unsigned)DM + (unsigned)(p * 128 + 8 * g)) * 2u;
#pragma unroll
              for (int ks = 0; ks < 4; ++ks) qf[ks] = __builtin_nontemporal_load((const GAS bf16x8*)((const unsigned char*)QP + (qo + 64u * ks))); }
            unsigned key[32];
#pragma unroll
            for (int kb = 0; kb < 8; ++kb) { f32x4 acc = (f32x4){0.f, 0.f, 0.f, 0.f};
                const unsigned so = ((unsigned)(p * 128 + 16 * kb + c16) * 128u + 8u * (unsigned)g) * 2u;
#pragma unroll
                for (int ks = 0; ks < 4; ++ks) { const bf16x8 sf = *(const GAS bf16x8*)((const unsigned char*)SK + (so + 64u * ks)); acc = MFMA16(sf, qf[ks], acc); }
#pragma unroll
                for (int r = 0; r < 4; ++r) key[kb * 4 + r] = (f2ord(acc[r]) & ~0x7Fu) | (unsigned)(16 * kb + 4 * g + r);
                __builtin_amdgcn_sched_barrier(0); }
            bitonic_sort_desc<32>(key);
            unsigned top[16];
#pragma unroll
            for (int i = 0; i < 16; ++i) top[i] = key[i];
            merge16_xor(top, 16); merge16_xor(top, 32);
            if (g == 0) { LAS v4u* d = (LAS v4u*)(lst + (c * 32 + 16 * tb + c16) * 16);
                d[0] = (v4u){top[0], top[1], top[2], top[3]}; d[1] = (v4u){top[4], top[5], top[6], top[7]}; d[2] = (v4u){top[8], top[9], top[10], top[11]}; d[3] = (v4u){top[12], top[13], top[14], top[15]}; }
        }
        LDS_WAIT();
        const LAS unsigned* l1 = lst + (16 * tb + c16) * 16; const LAS unsigned* l2 = lst + (32 + 16 * tb + c16) * 16;
        unsigned ck[16];
#pragma unroll
        for (int k = 0; k < 13; ++k) { const unsigned ab = PEER_CAND[4 * k + g]; const unsigned a = ab >> 4, bq = ab & 15u;
            const float s = ord2f(l1[a] & ~0x7Fu) + ord2f(l2[bq] & ~0x7Fu); ck[k] = (ab == 255u) ? 0u : ((f2ord(s) & ~0xFFu) | ab); }
        ck[13] = 0u; ck[14] = 0u; ck[15] = 0u;
        bitonic_sort_desc<16>(ck);
        merge16_xor(ck, 16); merge16_xor(ck, 32);
        if (g == 0) { const int tl = 16 * tb + c16; const float m = ord2f(ck[0] & ~0xFFu); float e[16]; float sum = 0.f;
#pragma unroll
            for (int k = 0; k < 16; ++k) { e[k] = __expf(ord2f(ck[k] & ~0xFFu) - m); sum += e[k]; }
            const float inv = 1.f / sum;
#pragma unroll
            for (int k = 0; k < 16; ++k) { const unsigned a = (ck[k] >> 4) & 15u, bq = ck[k] & 15u; const int ex = (int)((l1[a] & 0x7Fu) * 128u + (l2[bq] & 0x7Fu));
                eidx[tl * 128 + w * 16 + k] = ex; gate[tl * 128 + w * 16 + k] = e[k] * inv; } }
    }
#endif
    __syncthreads();
    LAS unsigned char* hnb = lds + P_HN + w * 4096; LAS float* actl = (LAS float*)(lds + P_ACT) + w * 128;
    const LAS unsigned char* hb = hnb + 16 * g + ((c16 == 1) ? 1024 : 0);
    v4u bA[8], bB[8];
#define U_ISSUE(buf, e_, jb) do { const unsigned uo_ = (unsigned)(e_) * (unsigned)ROWB + 16u * (unsigned)g + 512u * (unsigned)(jb); \
        _Pragma("unroll") for (int jj = 0; jj < 8; ++jj) buf[jj] = *(const GAS v4u*)(U8 + (uo_ + 64u * jj)); __builtin_amdgcn_sched_barrier(0); } while (0)
#define U_CONSUME(buf, jb) do { v4u bq_[8]; _Pragma("unroll") for (int jj = 0; jj < 8; ++jj) bq_[jj] = *(const LAS v4u*)(hb + 64 * (8 * (jb) + jj)); \
        __builtin_amdgcn_sched_barrier(0); \
        _Pragma("unroll") for (int jj = 0; jj < 8; ++jj) { const v4u a_ = buf[jj]; \
            const v8i av_ = {(int)a_.x, (int)a_.y, (int)a_.z, (int)a_.w, 0, 0, 0, 0}; const v8i bv_ = {(int)bq_[jj].x, (int)bq_[jj].y, (int)bq_[jj].z, (int)bq_[jj].w, 0, 0, 0, 0}; \
            acc = __builtin_amdgcn_mfma_scale_f32_16x16x128_f8f6f4(av_, bv_, acc, 4, 4, 0, 0x7f7f7f7f, 0, 0x7f7f7f7f); } __builtin_amdgcn_sched_barrier(0); } while (0)
#define U_ACT(grp_) do { const float l0_ = __shfl_down(acc.x, 1), l1_ = __shfl_down(acc.y, 1), l2_ = __shfl_down(acc.z, 1), l3_ = __shfl_down(acc.w, 1); \
        if (c16 == 0) { const int k0 = 16 * (grp_) + 4 * g; constexpr float isc = 1.f / (SU * SH4), ilo = 1.f / SLO4; const f32x4 gt = *(const LAS f32x4*)(gate + tl * 128 + k0); \
        f32x4 a4; a4.x = gelu_erf((acc.x + l0_ * ilo) * isc) * gt.x; a4.y = gelu_erf((acc.y + l1_ * ilo) * isc) * gt.y; a4.z = gelu_erf((acc.z + l2_ * ilo) * isc) * gt.z; a4.w = gelu_erf((acc.w + l3_ * ilo) * isc) * gt.w; *(LAS f32x4*)(actl + k0) = a4; } } while (0)
#define V_ISSUE(buf, kb_) do { _Pragma("unroll") for (int kk = 0; kk < 8; ++kk) { const int e_ = eidx[tl * 128 + 8 * (kb_) + kk]; const unsigned vo_ = (unsigned)e_ * (unsigned)ROWB + 16u * (unsigned)lane; \
        buf[kk] = *(const GAS v4u*)(V8 + vo_); } __builtin_amdgcn_sched_barrier(0); } while (0)
#ifdef FP4_SOFT_DEC
#define FP4_DEC(x) fp4_dec2(x)
#else
#define FP4_DEC(x) __builtin_amdgcn_cvt_scalef32_pk_f32_fp4((x), 1.0f, 0)
#endif
#ifdef FP4_SWAP_DEC
#define FP4_ACC(oa, ob, d) do { oa += a_ * d.y; ob += a_ * d.x; } while (0)
#else
#define FP4_ACC(oa, ob, d) do { oa += a_ * d.x; ob += a_ * d.y; } while (0)
#endif
#define PIN8x2(a, i) asm volatile("" : "+v"(a[i]), "+v"(a[i + 1]), "+v"(a[i + 2]), "+v"(a[i + 3]), "+v"(a[i + 4]), "+v"(a[i + 5]), "+v"(a[i + 6]), "+v"(a[i + 7]))
#define V_CONSUME(buf, kb_) do { _Pragma("unroll") for (int kk = 0; kk < 8; ++kk) { const float as_ = actl[8 * (kb_) + kk]; const f32x2 a2_ = {as_, as_}; \
        const unsigned vw[4] = {buf[kk].x, buf[kk].y, buf[kk].z, buf[kk].w}; \
        _Pragma("unroll") for (int q = 0; q < 4; ++q) { \
            o2[4 * q]     = __builtin_elementwise_fma(__builtin_amdgcn_cvt_scalef32_pk_f32_fp4(vw[q], 1.0f, 0), a2_, o2[4 * q]); \
            o2[4 * q + 1] = __builtin_elementwise_fma(__builtin_amdgcn_cvt_scalef32_pk_f32_fp4(vw[q], 1.0f, 1), a2_, o2[4 * q + 1]); \
            o2[4 * q + 2] = __builtin_elementwise_fma(__builtin_amdgcn_cvt_scalef32_pk_f32_fp4(vw[q], 1.0f, 2), a2_, o2[4 * q + 2]); \
            o2[4 * q + 3] = __builtin_elementwise_fma(__builtin_amdgcn_cvt_scalef32_pk_f32_fp4(vw[q], 1.0f, 3), a2_, o2[4 * q + 3]); } \
        PIN8x2(o2, 0); PIN8x2(o2, 8); } } while (0)
#ifndef NO_GATHER
    int e_cur = eidx[w * 128 + c16];
    v2u xn[8];
#define X_ISSUE(tok_) do { const unsigned xb_ = (unsigned)(tok_) * (unsigned)(DM * 2) + 8u * (unsigned)lane; _Pragma("unroll") for (int j = 0; j < 8; ++j) xn[j] = __builtin_nontemporal_load((const GAS v2u*)((const unsigned char*)X1B + (xb_ + 512u * j))); } while (0)
    X_ISSUE(T0 + w);
    U_ISSUE(bA, e_cur, 0);
    for (int ti = 0; ti < 4; ++ti) {
        const int tl = w + 8 * ti; const size_t token = (size_t)T0 + tl;
        f32x4 xr[8]; float ss = 0.f;
        const unsigned xo = (unsigned)token * (unsigned)(DM * 4) + 16u * (unsigned)lane;
        {
#pragma unroll
          for (int j = 0; j < 8; ++j) { const v2u r = xn[j]; xr[j] = (f32x4){bflo(r.x), bfhi(r.x), bflo(r.y), bfhi(r.y)}; }
#pragma unroll
          for (int j = 0; j < 8; ++j) ss += (xr[j].x * xr[j].x + xr[j].y * xr[j].y) + (xr[j].z * xr[j].z + xr[j].w * xr[j].w); }
        const float rs2 = __builtin_amdgcn_rsqf(wave_sum(ss) * (1.f / DM) + EPS);
        {
          const float* fg_ = fgain; asm volatile("" : "+s"(fg_));
          const unsigned char* gp = (const unsigned char*)fg_; const unsigned go = 16u * (unsigned)lane;
          unsigned hw[4], lw[4];
#pragma unroll
          for (int q = 0; q < 4; ++q) { unsigned wh = 0u, wl = 0u;
#pragma unroll
              for (int t = 0; t < 2; ++t) { const int j = 2 * q + t; const f32x4 gg = *(const GAS f32x4*)(gp + (go + 1024u * j)); const f32x4 hv = xr[j] * gg * (rs2 * SH4);
                  const float h0 = clampf(hv.x, 6.f), h1 = clampf(hv.y, 6.f), h2 = clampf(hv.z, 6.f), h3 = clampf(hv.w, 6.f);
                  const unsigned p0 = __builtin_amdgcn_cvt_scalef32_pk_fp4_f32(0u, h0, h1, 1.0f, 0), p1 = __builtin_amdgcn_cvt_scalef32_pk_fp4_f32(0u, h2, h3, 1.0f, 0);
                  const f32x2 d0 = __builtin_amdgcn_cvt_scalef32_pk_f32_fp4(p0, 1.0f, 0), d1 = __builtin_amdgcn_cvt_scalef32_pk_f32_fp4(p1, 1.0f, 0);
                  const unsigned r0 = __builtin_amdgcn_cvt_scalef32_pk_fp4_f32(0u, clampf((h0 - d0.x) * SLO4, 6.f), clampf((h1 - d0.y) * SLO4, 6.f), 1.0f, 0), r1 = __builtin_amdgcn_cvt_scalef32_pk_fp4_f32(0u, clampf((h2 - d1.x) * SLO4, 6.f), clampf((h3 - d1.y) * SLO4, 6.f), 1.0f, 0);
                  wh |= ((p0 & 0xFFu) | ((p1 & 0xFFu) << 8)) << (16 * t); wl |= ((r0 & 0xFFu) | ((r1 & 0xFFu) << 8)) << (16 * t); }
              hw[q] = wh; lw[q] = wl; }
          *(LAS v4u*)(hnb + 16 * lane) = (v4u){hw[0], hw[1], hw[2], hw[3]}; *(LAS v4u*)(hnb + 1024 + 16 * lane) = (v4u){lw[0], lw[1], lw[2], lw[3]}; }
        LDS_WAIT();
#pragma unroll 1
        for (int grp = 0; grp < 8; ++grp) {
            const int gn = grp < 7 ? grp + 1 : 7;
            const int e_nxt = eidx[tl * 128 + 16 * gn + c16];
            f32x4 acc = (f32x4){0.f, 0.f, 0.f, 0.f};
            U_ISSUE(bB, e_cur, 1); U_CONSUME(bA, 0);
            if (grp < 7) U_ISSUE(bA, e_nxt, 0); else V_ISSUE(bA, 0);
            U_CONSUME(bB, 1);
            U_ACT(grp);
            e_cur = e_nxt;
        }
        LDS_WAIT();
        f32x2 o2[16];
#pragma unroll
        for (int i = 0; i < 16; ++i) o2[i] = (f32x2){0.f, 0.f};
#pragma unroll 1
        for (int kb = 0; kb < 16; kb += 2) {
            V_ISSUE(bB, kb + 1); V_CONSUME(bA, kb);
            if (kb + 2 < 16) V_ISSUE(bA, kb + 2);
            else if (ti < 3) { e_cur = eidx[(tl + 8) * 128 + c16]; X_ISSUE(token + 8); U_ISSUE(bA, e_cur, 0); }
            V_CONSUME(bB, kb + 1);
        }
        { constexpr float isv = 1.f / SV; float s2 = 0.f;
#pragma unroll
          for (int j = 0; j < 8; ++j) { xr[j] = xr[j] + (f32x4){o2[2 * j].x, o2[2 * j].y, o2[2 * j + 1].x, o2[2 * j + 1].y} * isv;
              s2 += (xr[j].x * xr[j].x + xr[j].y * xr[j].y) + (xr[j].z * xr[j].z + xr[j].w * xr[j].w); }
          const float rf = __builtin_amdgcn_rsqf(wave_sum(s2) * (1.f / DM) + EPS);
          const float* fi_ = fing; asm volatile("" : "+s"(fi_));
          const unsigned char* fp = (const unsigned char*)fi_; unsigned char* op = (unsigned char*)outp; const unsigned fo = 16u * (unsigned)lane;
          if (!dry || rf == 1.2345e30f)
#pragma unroll
          for (int j = 0; j < 8; ++j) __builtin_nontemporal_store(xr[j] * rf * *(const GAS f32x4*)(fp + (fo + 1024u * j)), (GAS f32x4*)(op + (xo + 1024u * j))); }
    }
#endif
#undef U_ISSUE
#undef X_ISSUE
#undef U_ACT
#undef U_CONSUME
#undef V_ISSUE
#undef V_CONSUME
    __syncthreads();
}

__global__ void __launch_bounds__(NWAVES * 64, 2) hybrid_fwd(Args args) {
    extern __shared__ __attribute__((aligned(16))) unsigned char lds[];
    Frame F;
    F.lds = (LAS unsigned char*)lds;
    F.MISC = (volatile LAS unsigned*)(F.lds + MISC_OFF);
    F.tid = threadIdx.x; F.lane = F.tid & 63; F.wave = __builtin_amdgcn_readfirstlane(F.tid >> 6); F.G = gridDim.x;
    for (int u = F.tid; u < (LDS_BYTES - LDSCTL_OFF) / 4; u += NWAVES * 64) ((LAS unsigned*)(F.lds + LDSCTL_OFF))[u] = 0u;
    __syncthreads();
    (void)args;
    XcdBarrier bar = xcd_barrier_post(F.ctl() + CW_BAR, F.MISC + 8);

#ifndef NO_P0
#ifdef PROBE_P0X2
    { int reps = 2; asm volatile("" : "+s"(reps)); for (int rep = 0; rep < reps; ++rep) p0_prologue(F); }
#else
    p0_prologue(F);
#endif
#endif
    xcd_barrier(bar);
#ifndef NO_P1
#ifdef PROBE_GX2
    { int reps = 2; asm volatile("" : "+s"(reps)); for (int rep = 0; rep < reps; ++rep) {
#else
    { { const int rep = 0, reps = 1;
#endif
      pg8::Gemm gm{F.HN(), F.WinT(), MTOK, NB16, DM}; pg8::StaticOrder S; S.init(MTOK, NB16, F.G, (int)blockIdx.x);
      EpiProj E{F.PROJ(), F.dtraw(), (rep + 1 < reps) ? nullptr : F.kmean()};
      pg8::gemm_phase<EpiProj, pg8::StaticOrder, PG8_ALIGN, PG8_SP2>(F.lds + RING_OFF, gm, S, E); } }
    { const int nun = (MTOK / 256) * (NB16 / 256), rem = nun % F.G;
      if (rem && (int)blockIdx.x >= rem) tables_convert(F, tab_split(F.G), TAB_ITEMS, (size_t)((int)blockIdx.x - rem) * (NWAVES * 64) + fresh_tid(), (size_t)(F.G - rem) * (NWAVES * 64)); }
    __syncthreads();
    {
      pg8::Gemm gm{(const pg8::bf16_t*)F.HN8(), (const pg8::bf16_t*)F.WinT8(), MTOK, F8_HI - F8_LO, DM / 2}; pg8::StaticOrder S; S.init(MTOK, F8_HI - F8_LO, F.G, (int)blockIdx.x);
      EpiProj8 E{F.PROJ()};
      pg8::gemm_phase<EpiProj8, pg8::StaticOrder, PG8_ALIGN, PG8_SP2, true>(F.lds + RING_OFF, gm, S, E); }
#endif
    xcd_barrier(bar);
#ifdef PROBE_P15X2
    conv_phase(F);
#endif
    conv_phase(F);
    xcd_barrier(bar);
#ifdef PROBE_P2X2
    { int reps = 2; asm volatile("" : "+s"(reps)); for (int rep = 0; rep < reps; ++rep) {
#else
    { { const int rep = 0, reps = 1;
#endif
    const bool doatom = rep + 1 == reps;
    for (;;) {
        if (F.tid == 0) F.MISC[0] = xb_add(F.ctl() + CW_Q2 + 64 * rep, 1u);
        __syncthreads();
        const int ui = (int)F.MISC[0];
        __syncthreads();
        if (ui >= 128 + 512) break;
#ifdef PROBE_P2_SSD
        if (ui < 128 || doatom)
#endif
#ifdef PROBE_P2_ATT
        if (ui >= 128 || doatom)
#endif
        {
        if (ui < 128) ssd_unit(F, ui >> 4, ui & 15, doatom);
        else { const int a = ui - 128; attn_unit(F, (a & 63) >> 3, a & 7, 7 - (a >> 6), doatom); }
        }
    } } }
    xcd_barrier(bar);
#ifndef NO_P3
#ifdef PROBE_GX2
    { int reps = 2; asm volatile("" : "+s"(reps)); for (int rep = 0; rep < reps; ++rep) {
#else
    { { const int rep = 0, reps = 1;
#endif
      pg8::Gemm gm{F.HN(), F.WoutT(), MTOK, DM, DM}; pg8::StaticOrder S; S.init(MTOK, DM, F.G, (int)blockIdx.x);
      {
        const int t_ = fresh_tid(); const float* const sq = F.ssq();
#pragma unroll 1
        for (int ii = t_ >> 8; ii < 3; ii += 2) { pg8::Unit uu;
          if (S.next(ii, uu)) { const int row = uu.pm * 256 + (t_ & 255);
            const float q1 = __hip_atomic_load(sq + (size_t)row * 4 + 1, RLX_AGENT), q2 = __hip_atomic_load(sq + (size_t)row * 4 + 2, RLX_AGENT), q3 = __hip_atomic_load(sq + (size_t)row * 4 + 3, RLX_AGENT);
            const float sa = __builtin_amdgcn_rsqf(q1 * (1.f / 1024.f) + EPS), s0 = __builtin_amdgcn_rsqf(q2 * (1.f / 512.f) + EPS), s1 = __builtin_amdgcn_rsqf(q3 * (1.f / 512.f) + EPS);
            *(LAS f32x4*)(F.lds + SEGTAB_OFF + (ii * 256 + (t_ & 255)) * 16) = (f32x4){sa / s0, s0 / s1, s1, 0.f}; } }
        __syncthreads(); }
      EpiOut E{F.x(), F.X1B(), F.X18(), F.ssq(), rep + 1 == reps, (const LAS f32x4*)(F.lds + SEGTAB_OFF)};
      pg8::gemm_phase<EpiOut, pg8::StaticOrder, PG8_ALIGN, PG8_SP2>(F.lds + RING_OFF, gm, S, E); } }
#endif
    xcd_barrier(bar);
#ifndef NO_P4
#ifdef PROBE_GX2
    { int reps = 2; asm volatile("" : "+s"(reps)); for (int rep = 0; rep < reps; ++rep) {
#else
    { { const int rep = 0, reps = 1; (void)rep; (void)reps;
#endif
      pg8::Gemm gm{(const pg8::bf16_t*)F.X18(), F.WqT(), MTOK, DM, DM / 2}; pg8::StaticOrder S; S.init(MTOK, DM, F.G, (int)blockIdx.x);
      EpiQ E{F.QP(), F.ssq()};
      pg8::gemm_phase<EpiQ, pg8::StaticOrder, PG8_ALIGN, PG8_SP2, true>(F.lds + RING_OFF, gm, S, E); } }
#endif
    xcd_barrier(bar);
#ifndef NO_P5
#ifdef PROBE_P5X2
    { int reps = 2; asm volatile("" : "+s"(reps));
      for (int rep = 0; rep < reps; ++rep) for (int u = blockIdx.x; u < MTOK / 32; u += F.G) peer_unit(F, u, rep + 1 < reps); }
#else
    for (int u = blockIdx.x; u < MTOK / 32; u += F.G) peer_unit(F, u);
#endif
#endif
}

extern "C" void kernel_launch(void* const* d_in, const int* in_sizes, int n_in, void* d_out, int out_size, void* d_ws, size_t ws_size, hipStream_t stream) {
    static int grid = 0;
    if (grid == 0) {
        if (n_in != 18 || out_size != MTOK * DM || ws_size < WS_END) { fprintf(stderr, "kernel_launch: unexpected shapes (n_in %d, out %d, ws %zu)\n", n_in, out_size, ws_size); grid = -1; return; }
        int dev = 0, cus = 0, per_cu = 0;
        if (hipGetDevice(&dev) != hipSuccess || hipDeviceGetAttribute(&cus, hipDeviceAttributeMultiprocessorCount, dev) != hipSuccess) { grid = -1; return; }
        if (hipFuncSetAttribute((const void*)hybrid_fwd, hipFuncAttributeMaxDynamicSharedMemorySize, LDS_BYTES) != hipSuccess) { fprintf(stderr, "kernel_launch: hipFuncSetAttribute failed\n"); grid = -1; return; }
        if (hipOccupancyMaxActiveBlocksPerMultiprocessor(&per_cu, (const void*)hybrid_fwd, NWAVES * 64, LDS_BYTES) != hipSuccess || per_cu < 1)
            fprintf(stderr, "kernel_launch: note: occupancy query reports %d workgroups per CU\n", per_cu);
        (void)hipGetLastError();
        grid = cus;
    }
    if (grid < 0) return;
    if (hipMemsetAsync((char*)d_ws + WS_CTL, 0, CTL_ZERO_BYTES, stream) != hipSuccess) return;
    Args a{};
    for (int i = 0; i < 18; ++i) a.in[i] = (const float*)d_in[i];
    a.out = (float*)d_out; a.ws = (unsigned char*)d_ws;
    hipLaunchKernelGGL(hybrid_fwd, dim3(grid), dim3(NWAVES * 64), LDS_BYTES, stream, a);
}
```

```cpp
#include <hip/hip_runtime.h>
#include <cstdio>
#include <cstdint>
namespace pg8 {
#define PG8_LAS __attribute__((address_space(3)))
typedef unsigned short bf16_t;
typedef short bf16x8 __attribute__((ext_vector_type(8)));
typedef float f32x4 __attribute__((ext_vector_type(4)));
typedef unsigned u32x4 __attribute__((ext_vector_type(4)));
constexpr int BM = 256, BK = 64, HALF = 128, HTB = HALF * BK * 2  , STAGE_BYTES = 8 * HTB, NXCD = 8, WGM = 8;

__host__ __device__ __forceinline__ int lds_byte(int r, int c) { const int st = (r >> 4) * 2 + (c >> 5), rr = r & 15, cc = c & 31, ob = rr * 64 + cc * 2; return st * 1024 + (ob ^ (((ob >> 9) & 1) << 5)); }
__host__ __device__ __forceinline__ void stage_rc(int b, int& R, int& C) { const int st = b / 1024, sb = b % 1024, swz = sb ^ (((sb >> 9) & 1) << 5); R = (st >> 1) * 16 + swz / 64; C = (st & 1) * 32 + (swz % 64) / 2; }
__host__ __device__ __forceinline__ int perm32(int rho) { const int n = rho >> 4, i = rho & 15; return 8 * (i >> 2) + 4 * n + (i & 3); }

struct Unit { int pm, pn; };
struct Gemm { const bf16_t* A; const bf16_t* Bt; int M, N, K; };

struct StaticOrder {
    int nM, nN, nwg, G, c;
    __host__ __device__ void init(int M, int N, int G_, int c_) { nM = M / BM; nN = N / BM; nwg = nM * nN; G = G_; c = c_; }
    __host__ __device__ bool next(int i, Unit& u) const {
        const long L = (long)i * G + c; if (L >= nwg) return false;
        int wgid = (int)L; { const int q = nwg / NXCD, r = nwg % NXCD, xcd = wgid % NXCD, off = wgid / NXCD; wgid = (xcd < r ? xcd * (q + 1) : r * (q + 1) + (xcd - r) * q) + off; }
        const int nig = WGM * nN, gid = wgid / nig, fm = gid * WGM, gsz = (nM - fm) < WGM ? (nM - fm) : WGM;
        u.pm = fm + ((wgid % nig) % gsz); u.pn = (wgid % nig) / gsz; return true;
    }
    __device__ __forceinline__ void a_ready(const Unit&) const {}
    __device__ __forceinline__ void done(const Unit&) const {}
};

__device__ __forceinline__ unsigned cvt_pk_bf16(float lo, float hi) { unsigned r; asm volatile("v_cvt_pk_bf16_f32 %0, %1, %2" : "=v"(r) : "v"(lo), "v"(hi)); return r; }
typedef float f32x2 __attribute__((ext_vector_type(2)));
__device__ __forceinline__ f32x2 gelu_pk(f32x2 v) {
    const f32x2 av = __builtin_elementwise_abs(v), d = av * 0.2316418882f + 1.0f;
    f32x2 t; t.x = __builtin_amdgcn_rcpf(d.x); t.y = __builtin_amdgcn_rcpf(d.y);
    f32x2 q = t * 0.5307027145f + (-0.7265760135f); q = q * t + 0.7107068705f; q = q * t + (-0.142248368f); q = q * t + 0.127414796f; q = q * t;
    const f32x2 s = (v * v) * (-0.72134752044f);
    f32x2 e; e.x = __builtin_amdgcn_exp2f(s.x); e.y = __builtin_amdgcn_exp2f(s.y);
    const f32x2 m = v * (q * e), r = v - m;
    f32x2 o; o.x = v.x < 0.f ? m.x : r.x; o.y = v.y < 0.f ? m.y : r.y; return o;
}

template <int ACT  > struct EpiBf16 {
    static constexpr bool PERM = true, AFTER_DRAIN = false, SEG = false; static_assert(ACT == 0 || ACT == 1, "EpiBf16: ACT is 0 (none) or 1 (gelu_pk)");
    bf16_t* O; int ldc; const float* bias; int split_cols; size_t split_stride; float scale0;
    __device__ __forceinline__ void operator()(const f32x4 (&acc)[2][2][4][2], const Unit& u, int wr, int wc, int fr, int fq) const {
        const int row0 = u.pm * BM + wr * 64 + fr; int colt = u.pn * BM; bf16_t* base = O;
        float sc = 1.f; if (split_cols) { const int t = colt / split_cols; base += (size_t)t * split_stride; colt -= t * split_cols; if (t == 0) sc = scale0; }
        const int col0 = colt + wc * 32 + 8 * fq, bcol0 = u.pn * BM + wc * 32 + 8 * fq;
        f32x4 bv[2][2];
#pragma unroll
        for (int bj = 0; bj < 2; ++bj)
#pragma unroll
            for (int n = 0; n < 2; ++n) bv[bj][n] = bias ? *(const f32x4*)(bias + bcol0 + bj * HALF + 4 * n) : (f32x4){0.f, 0.f, 0.f, 0.f};
#pragma unroll
        for (int ai = 0; ai < 2; ++ai)
#pragma unroll
            for (int m = 0; m < 4; ++m) { bf16_t* rowp = base + (size_t)(row0 + ai * HALF + m * 16) * ldc + col0;
#pragma unroll
                for (int bj = 0; bj < 2; ++bj) { f32x4 v0 = acc[ai][bj][m][0] + bv[bj][0], v1 = acc[ai][bj][m][1] + bv[bj][1];
                    if (ACT == 1) { f32x2 a = gelu_pk((f32x2){v0[0], v0[1]}), b = gelu_pk((f32x2){v0[2], v0[3]}), c = gelu_pk((f32x2){v1[0], v1[1]}), d = gelu_pk((f32x2){v1[2], v1[3]});
                        v0 = (f32x4){a.x, a.y, b.x, b.y}; v1 = (f32x4){c.x, c.y, d.x, d.y}; }
                    v0 = v0 * sc; v1 = v1 * sc; u32x4 w; w.x = cvt_pk_bf16(v0[0], v0[1]); w.y = cvt_pk_bf16(v0[2], v0[3]); w.z = cvt_pk_bf16(v1[0], v1[1]); w.w = cvt_pk_bf16(v1[2], v1[3]);
                    *(u32x4*)(rowp + bj * HALF) = w; } }
    }
};
template <class Epi, class Sched, bool ALIGN_EPI = false, bool SP2 = false, bool F8 = false>
__device__ __forceinline__ void gemm_phase(PG8_LAS unsigned char* lds, const Gemm g, const Sched& S, const Epi& E) {
    int tid_ = threadIdx.x; asm volatile("" : "+v"(tid_));
    const int tid = tid_, wid = __builtin_amdgcn_readfirstlane(tid >> 6), lane = tid & 63, wr = wid >> 2, wc = wid & 3, fr = lane & 15, fq = lane >> 4;
    const int K = g.K, nt = K / BK;
    unsigned voffA[2], voffB[2];
#pragma unroll
    for (int i = 0; i < 2; ++i) { int R, C; stage_rc(tid * 16 + i * 8192, R, C); const int Rb = Epi::PERM ? ((R & ~31) + perm32(R & 31)) : R;
        voffA[i] = (unsigned)(R * K + C) * 2u; voffB[i] = (unsigned)(Rb * K + C) * 2u; }
    const size_t kstep = (size_t)(BK * 2);
    const size_t hstep = (size_t)HALF * K * 2;
    const size_t tstep = 2 * hstep;
    const unsigned ldsw = (unsigned)wid * 1024u;
    const int aoff = lds_byte(wr * 64 + fr, fq * 8), boff = lds_byte(wc * 32 + fr, fq * 8);
#define PG8_SA(b, h) (((b) * 2 + (h)) * HTB)
#define PG8_SB(b, h) ((4 + (b) * 2 + (h)) * HTB)
#define PG8_STAGE(bufoff, gbase, voff) do { _Pragma("unroll") for (int _i = 0; _i < 2; ++_i) \
        __builtin_amdgcn_global_load_lds((const unsigned*)((const char*)(gbase) + (voff)[_i]), (PG8_LAS unsigned*)(lds + (bufoff) + ldsw + _i * 8192), 16, 0, 0); } while (0)
#define PG8_LDA(dst, b, h) do { _Pragma("unroll") for (int m = 0; m < 4; ++m) _Pragma("unroll") for (int k = 0; k < 2; ++k) dst[m][k] = *(const PG8_LAS bf16x8*)(lds + PG8_SA(b, h) + aoff + m * 2048 + k * 1024); } while (0)
#define PG8_LDB(dst, b, h) do { _Pragma("unroll") for (int n = 0; n < 2; ++n) _Pragma("unroll") for (int k = 0; k < 2; ++k) dst[n][k] = *(const PG8_LAS bf16x8*)(lds + PG8_SB(b, h) + boff + n * 2048 + k * 1024); } while (0)
#define PG8_MMA(ai, bj, At, Bt) do { __builtin_amdgcn_s_setprio(1); _Pragma("unroll") for (int m = 0; m < 4; ++m) _Pragma("unroll") for (int n = 0; n < 2; ++n) { \
        if constexpr (F8) { typedef int v8i_ __attribute__((ext_vector_type(8))); typedef int v4i_ __attribute__((ext_vector_type(4))); \
            const v4i_ b0_ = __builtin_bit_cast(v4i_, Bt[n][0]), b1_ = __builtin_bit_cast(v4i_, Bt[n][1]), a0_ = __builtin_bit_cast(v4i_, At[m][0]), a1_ = __builtin_bit_cast(v4i_, At[m][1]); \
            const v8i_ bb_ = {b0_.x, b0_.y, b0_.z, b0_.w, b1_.x, b1_.y, b1_.z, b1_.w}, aa_ = {a0_.x, a0_.y, a0_.z, a0_.w, a1_.x, a1_.y, a1_.z, a1_.w}; \
            asm volatile("v_mfma_scale_f32_16x16x128_f8f6f4 %0, %1, %2, %0, %3, %3 op_sel_hi:[0,0,0]" : "+v"(acc[ai][bj][m][n]) : "v"(bb_), "v"(aa_), "v"(f8one)); } \
        else { _Pragma("unroll") for (int k = 0; k < 2; ++k) acc[ai][bj][m][n] = __builtin_amdgcn_mfma_f32_16x16x32_bf16(Bt[n][k], At[m][k], acc[ai][bj][m][n], 0, 0, 0); } } \
        __builtin_amdgcn_s_setprio(0); } while (0)
#define PG8_WAIT_V(n) asm volatile("s_waitcnt vmcnt(" #n ")" ::: "memory")
#define PG8_WAIT_L(n) asm volatile("s_waitcnt lgkmcnt(" #n ")" ::: "memory")
#define PG8_BAR __builtin_amdgcn_s_barrier()
#define PG8_SCHED __builtin_amdgcn_sched_barrier(0)
    Unit cur, nxt; int ui = 0;
    if (!S.next(0, cur)) return;
    f32x4 acc[2][2][4][2];
    const int f8one = 0x7f7f7f7f;
#pragma unroll
    for (int a = 0; a < 2; ++a)
#pragma unroll
        for (int b = 0; b < 2; ++b)
#pragma unroll
            for (int m = 0; m < 4; ++m)
#pragma unroll
                for (int n = 0; n < 2; ++n) acc[a][b][m][n] = (f32x4){0.f, 0.f, 0.f, 0.f};
    bf16x8 At[4][2], B0[2][2], B1[2][2];
    const char* cA = (const char*)g.A + (size_t)cur.pm * tstep; const char* cB = (const char*)g.Bt + (size_t)cur.pn * tstep;
    S.a_ready(cur);
    float segr[16];
    if constexpr (Epi::SEG) E.seg_load(ui, wr, fr, segr);
    if constexpr (SP2) {
        PG8_STAGE(PG8_SB(0, 0), cB, voffB); PG8_STAGE(PG8_SB(0, 1), cB + hstep, voffB); PG8_STAGE(PG8_SA(0, 0), cA, voffA); PG8_STAGE(PG8_SA(0, 1), cA + hstep, voffA);
        if (wr == 1) PG8_BAR;
        PG8_WAIT_V(2); PG8_BAR;
        PG8_STAGE(PG8_SB(1, 0), cB + kstep, voffB); PG8_STAGE(PG8_SA(1, 0), cA + kstep, voffA); PG8_STAGE(PG8_SB(1, 1), cB + hstep + kstep, voffB);
        PG8_WAIT_V(6); PG8_BAR;
    } else {
        PG8_STAGE(PG8_SB(0, 0), cB, voffB); PG8_STAGE(PG8_SA(0, 0), cA, voffA); PG8_STAGE(PG8_SB(0, 1), cB + hstep, voffB); PG8_STAGE(PG8_SA(0, 1), cA + hstep, voffA);
        if (wr == 1) PG8_BAR;
        PG8_WAIT_V(4); PG8_BAR;
        PG8_STAGE(PG8_SB(1, 0), cB + kstep, voffB); PG8_STAGE(PG8_SA(1, 0), cA + kstep, voffA); PG8_STAGE(PG8_SB(1, 1), cB + hstep + kstep, voffB);
        PG8_WAIT_V(6); PG8_BAR;
    }
    for (;;) {
        const bool has_next = S.next(ui + 1, nxt);
        const char* nA = has_next ? (const char*)g.A + (size_t)nxt.pm * tstep : cA; const char* nB = has_next ? (const char*)g.Bt + (size_t)nxt.pn * tstep : cB;
        int t = 0;
#pragma unroll 1
        for (int sgi = 0; sgi < (Epi::SEG ? 3 : 1); ++sgi) {
        int tend = nt; if constexpr (Epi::SEG) tend = (sgi == 0) ? Epi::SEG_T1 : ((sgi == 1) ? Epi::SEG_T2 : nt);
        for (; t < tend; t += 2) {
            const bool last = (t == nt - 2);
            const char* a1 = cA + (size_t)(t + 1) * kstep;
            const char* a2 = last ? nA : cA + (size_t)(t + 2) * kstep; const char* b2 = last ? nB : cB + (size_t)(t + 2) * kstep;
            const char* a3 = a2 + kstep; const char* b3 = b2 + kstep;
            if (last && has_next) S.a_ready(nxt);
            if constexpr (SP2) {
            PG8_LDB(B0, 0, 0); PG8_LDB(B1, 0, 1); PG8_SCHED; PG8_LDA(At, 0, 0); PG8_STAGE(PG8_SA(1, 1), a1 + hstep, voffA);
            PG8_WAIT_V(8); PG8_WAIT_L(0); PG8_BAR; PG8_MMA(0, 0, At, B0); PG8_MMA(0, 1, At, B1); PG8_BAR; PG8_SCHED;
            PG8_LDA(At, 0, 1); PG8_STAGE(PG8_SB(0, 0), b2, voffB); PG8_STAGE(PG8_SB(0, 1), b2 + hstep, voffB); PG8_STAGE(PG8_SA(0, 0), a2, voffA);
            PG8_WAIT_V(8); PG8_WAIT_L(0); PG8_BAR; PG8_MMA(1, 0, At, B0); PG8_MMA(1, 1, At, B1); PG8_BAR; PG8_SCHED;
            PG8_LDB(B0, 1, 0); PG8_LDB(B1, 1, 1); PG8_SCHED; PG8_LDA(At, 1, 0); PG8_STAGE(PG8_SA(0, 1), a2 + hstep, voffA);
            PG8_WAIT_V(8); PG8_WAIT_L(0); PG8_BAR; PG8_MMA(0, 0, At, B0); PG8_MMA(0, 1, At, B1); PG8_BAR; PG8_SCHED;
            PG8_LDA(At, 1, 1); PG8_STAGE(PG8_SB(1, 0), b3, voffB); PG8_STAGE(PG8_SB(1, 1), b3 + hstep, voffB); PG8_STAGE(PG8_SA(1, 0), a3, voffA);
            PG8_WAIT_V(8); PG8_WAIT_L(0); PG8_BAR; PG8_MMA(1, 0, At, B0); PG8_MMA(1, 1, At, B1); PG8_BAR; PG8_SCHED;
            } else {
            PG8_LDB(B0, 0, 0); PG8_SCHED; PG8_LDA(At, 0, 0); PG8_STAGE(PG8_SA(1, 1), a1 + hstep, voffA);
            PG8_WAIT_L(8); PG8_BAR; PG8_WAIT_L(0); PG8_MMA(0, 0, At, B0); PG8_BAR; PG8_SCHED;
            PG8_LDB(B1, 0, 1); PG8_STAGE(PG8_SB(0, 0), b2, voffB);
            PG8_BAR; PG8_WAIT_L(0); PG8_MMA(0, 1, At, B1); PG8_BAR;
            PG8_LDA(At, 0, 1); PG8_STAGE(PG8_SA(0, 0), a2, voffA);
            PG8_BAR; PG8_WAIT_L(0); PG8_MMA(1, 0, At, B0); PG8_BAR; PG8_SCHED;
            PG8_STAGE(PG8_SB(0, 1), b2 + hstep, voffB);
            PG8_WAIT_V(6); PG8_BAR; PG8_MMA(1, 1, At, B1); PG8_BAR;
            PG8_LDB(B0, 1, 0); PG8_SCHED; PG8_LDA(At, 1, 0); PG8_STAGE(PG8_SA(0, 1), a2 + hstep, voffA);
            PG8_WAIT_L(8); PG8_BAR; PG8_WAIT_L(0); PG8_MMA(0, 0, At, B0); PG8_BAR; PG8_SCHED;
            PG8_LDB(B1, 1, 1); PG8_STAGE(PG8_SB(1, 0), b3, voffB);
            PG8_BAR; PG8_WAIT_L(0); PG8_MMA(0, 1, At, B1); PG8_BAR;
            PG8_LDA(At, 1, 1); PG8_STAGE(PG8_SA(1, 0), a3, voffA);
            PG8_BAR; PG8_WAIT_L(0); PG8_MMA(1, 0, At, B0); PG8_BAR; PG8_SCHED;
            PG8_STAGE(PG8_SB(1, 1), b3 + hstep, voffB);
            PG8_WAIT_V(6); PG8_BAR; PG8_MMA(1, 1, At, B1); PG8_BAR;
            }
        }
        if constexpr (Epi::SEG) E.seg_apply(acc, segr, sgi);
        }
        if constexpr (ALIGN_EPI) { if (wr == 0) PG8_BAR; }
        if constexpr (!Epi::AFTER_DRAIN) { if constexpr (Epi::SEG) E(acc, cur, wr, wc, fr, fq, ui); else E(acc, cur, wr, wc, fr, fq); S.done(cur); }
        if (!has_next) break;
#pragma unroll
        for (int a = 0; a < 2; ++a)
#pragma unroll
            for (int b = 0; b < 2; ++b)
#pragma unroll
                for (int m = 0; m < 4; ++m)
#pragma unroll
                    for (int n = 0; n < 2; ++n) acc[a][b][m][n] = (f32x4){0.f, 0.f, 0.f, 0.f};
        cur = nxt; cA = nA; cB = nB; ++ui;
        if constexpr (Epi::SEG) E.seg_load(ui, wr, fr, segr);
        if constexpr (ALIGN_EPI) { if (wr == 1) PG8_BAR; }
    }
    PG8_WAIT_V(0);
    if constexpr (!ALIGN_EPI) { if (wr == 0) PG8_BAR; }
    PG8_BAR;
    if constexpr (Epi::AFTER_DRAIN) { E.fused(acc, cur, wr, wc, fr, fq, lds, wid, lane); S.done(cur); }
#undef PG8_SA
#undef PG8_SB
#undef PG8_STAGE
#undef PG8_LDA
#undef PG8_LDB
#undef PG8_MMA
#undef PG8_WAIT_V
#undef PG8_WAIT_L
#undef PG8_BAR
#undef PG8_SCHED
}
}
#ifndef PG8_SP2
#define PG8_SP2 true
#endif
#ifndef PG8_ALIGN
#define PG8_ALIGN true
#endif

constexpr int BATCH = 8, SEQ = 2048, DM = 2048, MTOK = BATCH * SEQ;
constexpr int ATT_W = 1024, ATT_H = 8, ATT_HD = 128, MOBA_BLK = 256, NBLK = SEQ / MOBA_BLK;
constexpr int SSM_W = 1024, SSM_H = 16, SSM_P = 64, SSM_N = 128, SSM_L = 128, SSM_NC = SEQ / SSM_L, CONV_CH = 1536;
constexpr int IN_PROJ = 5648, NPROJ = 5632  , NPAD = 5888  ;
constexpr int F8_LO = 2048, F8_HI = 3072, NB16 = NPAD - (F8_HI - F8_LO)  ;
constexpr float SH8 = 16.f;
constexpr int COL_Q = 0, COL_K = 1024, COL_V = 2048, COL_Z = 3072, COL_XBC = 4096;
constexpr int PEER_H = 8, PEER_NK = 128, PEER_K = 16, PEER_HK = 128;
constexpr float EPS = 1e-6f;
constexpr float SU = 64.f, SV = 4.f, SH = 16.f, SLO = 16.f;
constexpr float SX8 = 16.f, SW8 = 1024.f;
constexpr float SA8 = 32.f, SS8 = 8.f;
constexpr float SH4 = 1.5f, SLO4 = 4.f;
constexpr int ROWB = DM / 2;

constexpr size_t MiB = 1u << 20;
constexpr size_t WS_CTL = 0, CTL_ZERO_BYTES = 1 * MiB;
constexpr size_t WS_DT = 1 * MiB;
constexpr size_t WS_SK = 2 * MiB;
constexpr size_t WS_WIN = 4 * MiB;
constexpr size_t WS_WIN8 = 24 * MiB;
constexpr size_t WS_HN8 = 396 * MiB;
constexpr size_t WS_WOUT = 28 * MiB;
constexpr size_t WS_WQ = 36 * MiB;
constexpr size_t WS_HN = 44 * MiB;
constexpr size_t WS_PROJ = 108 * MiB;
constexpr size_t WS_X1B = WS_PROJ, WS_QP = WS_PROJ + 64 * MiB;
constexpr size_t WS_U8 = 284 * MiB, WS_V8 = 316 * MiB;
constexpr size_t WS_XBC = 348 * MiB;
constexpr size_t WS_DT2 = 3 * MiB;
constexpr size_t WS_X18 = 396 * MiB;
constexpr size_t WS_END = 428 * MiB;
constexpr int CW_BAR = 4096;
constexpr int CW_Q2 = 8192;
constexpr int CW_KMEAN = 32768;
constexpr int CW_SSQ = 131072;
static_assert((CW_SSQ + MTOK * 4) * 4 <= (int)CTL_ZERO_BYTES, "CTL words inside the memset region");

constexpr int RING_OFF = 0, RING_BYTES = 131072;
constexpr int LDSCTL_OFF = RING_BYTES, MISC_OFF = LDSCTL_OFF + 320;
constexpr int SEGTAB_OFF = LDSCTL_OFF + 1024;  static_assert(LDSCTL_OFF + 1024 + 3 * 256 * 16 <= 147456, "segment table inside the LDS allocation");
constexpr int LDS_BYTES = 147456;
constexpr int NWAVES = 8;

#define GAS __attribute__((address_space(1)))
#define LAS __attribute__((address_space(3)))
typedef unsigned short bf16;
typedef unsigned v4u __attribute__((ext_vector_type(4)));
typedef unsigned v2u __attribute__((ext_vector_type(2)));
typedef float f32x4 __attribute__((ext_vector_type(4)));
typedef float f32x2 __attribute__((ext_vector_type(2)));
typedef short bf16x8 __attribute__((ext_vector_type(8)));
typedef short s16x4 __attribute__((ext_vector_type(4)));
typedef GAS unsigned gu32;
#define RLX_AGENT __ATOMIC_RELAXED, __HIP_MEMORY_SCOPE_AGENT
#define LDS_WAIT() asm volatile("s_waitcnt lgkmcnt(0)" ::: "memory")
#define VM_WAIT() asm volatile("s_waitcnt vmcnt(0)" ::: "memory")
__device__ __forceinline__ unsigned f2bf(float f) { unsigned u = __builtin_bit_cast(unsigned, f); return (u + 0x7fffu + ((u >> 16) & 1u)) >> 16; }
typedef __bf16 bf16v2 __attribute__((ext_vector_type(2)));
__device__ __forceinline__ unsigned pk2(float lo, float hi) { bf16v2 v; v.x = (__bf16)lo; v.y = (__bf16)hi; return __builtin_bit_cast(unsigned, v); }
__device__ __forceinline__ float bflo(unsigned w) { return __builtin_bit_cast(float, w << 16); }
__device__ __forceinline__ float bfhi(unsigned w) { return __builtin_bit_cast(float, w & 0xffff0000u); }
__device__ __forceinline__ float wave_sum(float v) {
#pragma unroll
    for (int o = 1; o < 64; o <<= 1) v += __shfl_xor(v, o);
    return v;
}
__device__ __forceinline__ float silu_f(float x) { return x * __builtin_amdgcn_rcpf(1.f + __expf(-x)); }

#define XB_TMO      128
#define XB_XCNT(j)  (256  + 64 * (j))
#define XB_XSUB(j)  (1280 + 64 * (j))
#define XB_XGEN(j)  (2304 + 64 * (j))
#define XB_TOP      3328
#define XB_TOPGEN   3392
#define XCD_BAR_WORDS 3456
#define XB_SPIN_CAP (1u << 18)

__device__ __forceinline__ unsigned xb_ld(unsigned* p)              { return __hip_atomic_load(p, __ATOMIC_RELAXED, __HIP_MEMORY_SCOPE_AGENT); }
__device__ __forceinline__ unsigned xb_add(unsigned* p, unsigned v) { return __hip_atomic_fetch_add(p, v, __ATOMIC_RELAXED, __HIP_MEMORY_SCOPE_AGENT); }
__device__ __forceinline__ unsigned xb_xcc_id() { return (unsigned)__builtin_amdgcn_s_getreg((3 << 11) | 20) & 0xFu; }
#define XB_SPIN(cond, bar) do { unsigned _sp = 0; while (cond) { __builtin_amdgcn_s_sleep(1); \
    if ((++_sp & 255u) == 0u) { if (xb_ld(&(bar)[XB_TMO])) break; if (_sp > XB_SPIN_CAP) { atomicAdd(&(bar)[XB_TMO], 1u); break; } } } } while (0)

struct XcdBarrier {
    unsigned* bar; unsigned x;
    volatile LAS unsigned* st;
};
__device__ __forceinline__ XcdBarrier xcd_barrier_post(unsigned* bar, volatile LAS unsigned* st) {
    XcdBarrier b; b.bar = bar; b.x = xb_xcc_id(); b.st = st;
    if (threadIdx.x == 0) (void)xb_add(&bar[XB_XCNT(b.x)], 1u);
    return b;
}
__device__ __forceinline__ void xcd_barrier_complete(unsigned* bar, unsigned x, unsigned& nloc, unsigned& nx) {
    const unsigned G = gridDim.x * gridDim.y * gridDim.z;
    unsigned sum, cnt, mine, sp = 0u;
    for (;;) {
        sum = 0u; cnt = 0u; mine = 0u;
#pragma unroll
        for (unsigned j = 0; j < 16; ++j) { const unsigned c = xb_ld(&bar[XB_XCNT(j)]); sum += c; cnt += (c > 0u) ? 1u : 0u; mine = (j == x) ? c : mine; }
        if (sum == G) break;
        __builtin_amdgcn_s_sleep(1);
        if ((++sp & 255u) == 0u) { if (xb_ld(&bar[XB_TMO])) break; if (sp > XB_SPIN_CAP) { atomicAdd(&bar[XB_TMO], 1u); break; } }
    }
    nloc = mine > 0u ? mine : 1u; nx = cnt > 0u ? cnt : 1u;
}
__device__ __forceinline__ void xcd_barrier(const XcdBarrier& b) {
    asm volatile("s_waitcnt vmcnt(0)" ::: "memory");
    __syncthreads();
    if (threadIdx.x == 0) {
        unsigned* bar = b.bar;
        __builtin_amdgcn_s_waitcnt(0);
        unsigned nloc = b.st[0], nx = b.st[1];
        if (nloc == 0u) { xcd_barrier_complete(bar, b.x, nloc, nx); b.st[0] = nloc; b.st[1] = nx; }
        const unsigned old = xb_add(&bar[XB_XSUB(b.x)], 1u);
        const unsigned gen = old / nloc;
        if (old + 1u == (gen + 1u) * nloc) {
            __builtin_amdgcn_fence(__ATOMIC_RELEASE, "agent");
            asm volatile("s_waitcnt vmcnt(0)" ::: "memory");
            const unsigned og = xb_add(&bar[XB_TOP], 1u);
            const unsigned tg = og / nx;
            if (og + 1u == (tg + 1u) * nx) xb_add(&bar[XB_TOPGEN], 1u);
            else XB_SPIN(xb_ld(&bar[XB_TOPGEN]) == tg, bar);
            __builtin_amdgcn_fence(__ATOMIC_ACQUIRE, "agent");
            xb_add(&bar[XB_XGEN(b.x)], 1u);
            asm volatile("s_waitcnt vmcnt(0)" ::: "memory");
        } else {
            XB_SPIN(xb_ld(&bar[XB_XGEN(b.x)]) == gen, bar);
            __builtin_amdgcn_fence(__ATOMIC_ACQUIRE, "agent");
            asm volatile("s_waitcnt vmcnt(0)" ::: "memory");
        }
    }
    __syncthreads();
}

#define CAS __attribute__((address_space(4)))
struct Args { const float* in[18]; float* out; unsigned char* ws; };
__device__ __forceinline__ const CAS unsigned char* kargs() { const CAS unsigned char* p = (const CAS unsigned char*)__builtin_amdgcn_kernarg_segment_ptr(); asm volatile("" : "+s"(p)); return p; }
__device__ __forceinline__ const float* kin(int i) { return *(const float* const CAS*)(kargs() + 8 * i); }
__device__ __forceinline__ float* kout() { return *(float* const CAS*)(kargs() + 8 * 18); }
__device__ __forceinline__ unsigned char* kws() { return *(unsigned char* const CAS*)(kargs() + 8 * 19); }
__device__ __forceinline__ int fresh_tid() { int t = threadIdx.x; asm volatile("" : "+v"(t)); return t; }
struct Frame {
    LAS unsigned char* lds;
    volatile LAS unsigned* MISC;
    int tid, lane, wave, G;
    __device__ __forceinline__ const float* x() const { return kin(0); }
    __device__ __forceinline__ const float* attn_norm() const { return kin(1); }
    __device__ __forceinline__ const float* w_in() const { return kin(2); }
    __device__ __forceinline__ const float* conv_w() const { return kin(3); }
    __device__ __forceinline__ const float* conv_b() const { return kin(4); }
    __device__ __forceinline__ const float* dt_bias() const { return kin(5); }
    __device__ __forceinline__ const float* a_log() const { return kin(6); }
    __device__ __forceinline__ const float* d_skip() const { return kin(7); }
    __device__ __forceinline__ const float* rel_bias() const { return kin(8); }
    __device__ __forceinline__ const float* attn_out_norm() const { return kin(9); }
    __device__ __forceinline__ const float* ssm_out_norm() const { return kin(10); }
    __device__ __forceinline__ const float* w_out() const { return kin(11); }
    __device__ __forceinline__ const float* ffn_norm() const { return kin(12); }
    __device__ __forceinline__ const float* peer_wq() const { return kin(13); }
    __device__ __forceinline__ const float* peer_sk() const { return kin(14); }
    __device__ __forceinline__ const float* peer_u() const { return kin(15); }
    __device__ __forceinline__ const float* peer_v() const { return kin(16); }
    __device__ __forceinline__ const float* final_norm() const { return kin(17); }
    __device__ __forceinline__ float* out() const { return kout(); }
    __device__ __forceinline__ unsigned* ctl() const { return (unsigned*)(kws() + WS_CTL); }
    __device__ __forceinline__ float* dtraw() const { return (float*)(kws() + WS_DT); }
    __device__ __forceinline__ bf16* SK() const { return (bf16*)(kws() + WS_SK); }
    __device__ __forceinline__ bf16* WinT() const { return (bf16*)(kws() + WS_WIN); }
    __device__ __forceinline__ bf16* WoutT() const { return (bf16*)(kws() + WS_WOUT); }
    __device__ __forceinline__ bf16* WqT() const { return (bf16*)(kws() + WS_WQ); }
    __device__ __forceinline__ bf16* HN() const { return (bf16*)(kws() + WS_HN); }
    __device__ __forceinline__ bf16* PROJ() const { return (bf16*)(kws() + WS_PROJ); }
    __device__ __forceinline__ bf16* X1B() const { return (bf16*)(kws() + WS_X1B); }
    __device__ __forceinline__ bf16* QP() const { return (bf16*)(kws() + WS_QP); }
    __device__ __forceinline__ unsigned char* U8() const { return kws() + WS_U8; }
    __device__ __forceinline__ unsigned char* V8() const { return kws() + WS_V8; }
    __device__ __forceinline__ unsigned char* X18() const { return kws() + WS_X18; }
    __device__ __forceinline__ unsigned char* HN8() const { return kws() + WS_HN8; }
    __device__ __forceinline__ unsigned char* WinT8() const { return kws() + WS_WIN8; }
    __device__ __forceinline__ bf16* XBC() const { return (bf16*)(kws() + WS_XBC); }
    __device__ __forceinline__ float* DT2() const { return (float*)(kws() + WS_DT2); }
    __device__ __forceinline__ float* kmean() const { return (float*)(kws() + WS_CTL) + CW_KMEAN; }
    __device__ __forceinline__ float* ssq() const { return (float*)(kws() + WS_CTL) + CW_SSQ; }
};

__device__ __forceinline__ float clampf(float v, float lim);
__device__ __forceinline__ void p0_transpose_item(const float* W, int K, int N, bf16* WT, const float* gain, LAS float* scr, int item, int lane, const float f8scale = 0.f, const int nshift = 0) {
    const int nblk = (N + 31) / 32, kb = item / nblk, nb = item % nblk, k0 = 64 * kb, n0 = 32 * nb;
    const int kr = lane >> 3, nc = (lane & 7) * 4; const bool ok = (n0 + nc) < N;
    f32x4 v[8]; float gk[8];
#pragma unroll
    for (int i = 0; i < 8; ++i) { const int kk = 8 * i + kr; v[i] = ok ? *(const GAS f32x4*)(W + (size_t)(k0 + kk) * N + n0 + nc) : (f32x4){0.f, 0.f, 0.f, 0.f}; gk[i] = gain ? gain[k0 + kk] : 1.f; }
#pragma unroll
    for (int i = 0; i < 8; ++i) { const int kk = 8 * i + kr; LAS float* d = scr + kk * 33 + nc; d[0] = v[i].x * gk[i]; d[1] = v[i].y * gk[i]; d[2] = v[i].z * gk[i]; d[3] = v[i].w * gk[i]; }
    LDS_WAIT(); asm volatile("" ::: "memory");
    const int c = lane & 7;
#pragma unroll
    for (int j = 0; j < 4; ++j) { const int n = (lane >> 3) + 8 * j; const LAS float* s = scr + (8 * c) * 33 + n;
        v4u o; o.x = pk2(s[0 * 33], s[1 * 33]); o.y = pk2(s[2 * 33], s[3 * 33]); o.z = pk2(s[4 * 33], s[5 * 33]); o.w = pk2(s[6 * 33], s[7 * 33]);
        if (f8scale == 0.f) *(GAS v4u*)(WT + (size_t)(n0 + n - nshift) * K + k0 + 8 * c) = o;
        else { v2u o8; int w_;
            w_ = __builtin_amdgcn_cvt_pk_fp8_f32(clampf(s[0 * 33] * f8scale, 448.f), clampf(s[1 * 33] * f8scale, 448.f), 0, false); w_ = __builtin_amdgcn_cvt_pk_fp8_f32(clampf(s[2 * 33] * f8scale, 448.f), clampf(s[3 * 33] * f8scale, 448.f), w_, true); o8.x = (unsigned)w_;
            w_ = __builtin_amdgcn_cvt_pk_fp8_f32(clampf(s[4 * 33] * f8scale, 448.f), clampf(s[5 * 33] * f8scale, 448.f), 0, false); w_ = __builtin_amdgcn_cvt_pk_fp8_f32(clampf(s[6 * 33] * f8scale, 448.f), clampf(s[7 * 33] * f8scale, 448.f), w_, true); o8.y = (unsigned)w_;
            *(GAS v2u*)((unsigned char*)WT + (size_t)(n0 + n - nshift) * K + k0 + 8 * c) = o8; } }
    LDS_WAIT(); asm volatile("" ::: "memory");
}
__device__ __forceinline__ unsigned pk4_fp8(float a, float b, float c, float d) { int w = __builtin_amdgcn_cvt_pk_fp8_f32(clampf(a, 448.f), clampf(b, 448.f), 0, false); w = __builtin_amdgcn_cvt_pk_fp8_f32(clampf(c, 448.f), clampf(d, 448.f), w, true); return (unsigned)w; }
__device__ __forceinline__ void rms_2rows_to_bf16(const float* x0, const float* x1, const float* gain, bf16* o0, bf16* o1, unsigned char* q0, unsigned char* q1, int lane) {
    const GAS f32x4* xr0 = (const GAS f32x4*)x0 + lane; const GAS f32x4* xr1 = (const GAS f32x4*)x1 + lane; const GAS f32x4* gr = (const GAS f32x4*)gain + lane;
    f32x4 v[8], u[8]; float s = 0.f, t = 0.f;
#pragma unroll
    for (int j = 0; j < 8; ++j) { v[j] = xr0[64 * j]; u[j] = xr1[64 * j]; }
#pragma unroll
    for (int j = 0; j < 8; ++j) { s += (v[j].x * v[j].x + v[j].y * v[j].y) + (v[j].z * v[j].z + v[j].w * v[j].w); t += (u[j].x * u[j].x + u[j].y * u[j].y) + (u[j].z * u[j].z + u[j].w * u[j].w); }
    const float rs = __builtin_amdgcn_rsqf(wave_sum(s) * (1.f / DM) + EPS), rt = __builtin_amdgcn_rsqf(wave_sum(t) * (1.f / DM) + EPS);
    GAS v2u* p0 = (GAS v2u*)o0 + lane; GAS v2u* p1 = (GAS v2u*)o1 + lane; GAS unsigned* r0 = (GAS unsigned*)q0 + lane; GAS unsigned* r1 = (GAS unsigned*)q1 + lane;
#pragma unroll
    for (int j = 0; j < 8; ++j) { const f32x4 g = gr[64 * j]; v2u a, b;
        const f32x4 h0 = v[j] * g * rs, h1 = u[j] * g * rt;
        a.x = pk2(h0.x, h0.y); a.y = pk2(h0.z, h0.w); p0[64 * j] = a; r0[64 * j] = pk4_fp8(h0.x * SH8, h0.y * SH8, h0.z * SH8, h0.w * SH8);
        b.x = pk2(h1.x, h1.y); b.y = pk2(h1.z, h1.w); p1[64 * j] = b; r1[64 * j] = pk4_fp8(h1.x * SH8, h1.y * SH8, h1.z * SH8, h1.w * SH8); }
}
#ifdef PROBE_FP4EMU
__device__ __forceinline__ float fp4grid(float y) { const float a = fabsf(y); float r;
    if (a <= 2.f) r = rintf(a * 2.f) * 0.5f; else if (a <= 4.f) r = rintf(a); else r = (a < 5.f) ? 4.f : 6.f;
    return copysignf(r, y); }
__device__ __forceinline__ float clampf(float v, float lim) { if (lim == 448.5f) return fp4grid(v * (1.f / 16.f)) * 16.f; return fminf(fmaxf(v, -lim), lim); }
#else
__device__ __forceinline__ float clampf(float v, float lim) { return fminf(fmaxf(v, -lim), lim); }
#endif
template <int TAB = 0> __device__ __forceinline__ v4u cvt16_fp8(const f32x4 a, const f32x4 b, const f32x4 c, const f32x4 d, float sc) {
    v4u o; int w; constexpr float LIM = TAB ? 448.5f : 448.f;
    w = __builtin_amdgcn_cvt_pk_fp8_f32(clampf(a.x * sc, LIM), clampf(a.y * sc, LIM), 0, false); w = __builtin_amdgcn_cvt_pk_fp8_f32(clampf(a.z * sc, LIM), clampf(a.w * sc, LIM), w, true); o.x = (unsigned)w;
    w = __builtin_amdgcn_cvt_pk_fp8_f32(clampf(b.x * sc, LIM), clampf(b.y * sc, LIM), 0, false); w = __builtin_amdgcn_cvt_pk_fp8_f32(clampf(b.z * sc, LIM), clampf(b.w * sc, LIM), w, true); o.y = (unsigned)w;
    w = __builtin_amdgcn_cvt_pk_fp8_f32(clampf(c.x * sc, LIM), clampf(c.y * sc, LIM), 0, false); w = __builtin_amdgcn_cvt_pk_fp8_f32(clampf(c.z * sc, LIM), clampf(c.w * sc, LIM), w, true); o.z = (unsigned)w;
    w = __builtin_amdgcn_cvt_pk_fp8_f32(clampf(d.x * sc, LIM), clampf(d.y * sc, LIM), 0, false); w = __builtin_amdgcn_cvt_pk_fp8_f32(clampf(d.z * sc, LIM), clampf(d.w * sc, LIM), w, true); o.w = (unsigned)w;
    return o;
}
__device__ __forceinline__ void tables_convert(Frame& F, size_t lo, size_t hi, size_t tix, size_t ntx) {
      const GAS f32x4* su = (const GAS f32x4*)F.peer_u(); const GAS f32x4* sv = (const GAS f32x4*)F.peer_v(); GAS v4u* du = (GAS v4u*)F.U8(); GAS v4u* dv = (GAS v4u*)F.V8();
#pragma unroll 1
      for (int tab = 0; tab < 2; ++tab) { const GAS f32x4* src = tab ? sv : su; GAS v4u* dst = tab ? dv : du; const float sc = tab ? SV : SU;
        f32x4 nx[8]; const size_t i0 = lo + tix;
        if (i0 < hi) { const GAS f32x4* p = src + (i0 >> 6) * 512 + (i0 & 63);
#pragma unroll
            for (int j = 0; j < 8; ++j) nx[j] = p[64 * j]; }
#pragma unroll 1
        for (size_t i = i0; i < hi; i += ntx) { f32x4 v[8];
#pragma unroll
            for (int j = 0; j < 8; ++j) v[j] = nx[j];
            if (i + ntx < hi) { const size_t i2 = i + ntx; const GAS f32x4* p = src + (i2 >> 6) * 512 + (i2 & 63);
#pragma unroll
                for (int j = 0; j < 8; ++j) nx[j] = p[64 * j]; }
            unsigned wd[4];
#pragma unroll
            for (int q = 0; q < 4; ++q) { const f32x4 a = v[2 * q] * sc, b = v[2 * q + 1] * sc; unsigned w = 0u;
                w = __builtin_amdgcn_cvt_scalef32_pk_fp4_f32(w, clampf(a.x, 6.f), clampf(a.y, 6.f), 1.0f, 0); w = __builtin_amdgcn_cvt_scalef32_pk_fp4_f32(w, clampf(a.z, 6.f), clampf(a.w, 6.f), 1.0f, 1);
                w = __builtin_amdgcn_cvt_scalef32_pk_fp4_f32(w, clampf(b.x, 6.f), clampf(b.y, 6.f), 1.0f, 2); w = __builtin_amdgcn_cvt_scalef32_pk_fp4_f32(w, clampf(b.z, 6.f), clampf(b.w, 6.f), 1.0f, 3); wd[q] = w; }
            dst[i] = (v4u){wd[0], wd[1], wd[2], wd[3]}; } }
}
constexpr size_t TAB_ITEMS = (size_t)16384 * 64;
__device__ __forceinline__ size_t tab_split(int G) { const int rem = ((MTOK / 256) * (NB16 / 256)) % G; return rem ? (TAB_ITEMS / 8) * 5 : TAB_ITEMS; }
__device__ __forceinline__ unsigned fp4_code(float y) { const float a = fabsf(y);
    const unsigned m = (unsigned)(a >= 0.25f) + (unsigned)(a >= 0.75f) + (unsigned)(a >= 1.25f) + (unsigned)(a >= 1.75f) + (unsigned)(a >= 2.5f) + (unsigned)(a >= 3.5f) + (unsigned)(a >= 5.0f);
    return m | ((y < 0.f) ? 8u : 0u); }
__device__ __forceinline__ void p0_prologue(Frame& F) {
    const int tid = fresh_tid(), lane = tid & 63, wave = __builtin_amdgcn_readfirstlane(tid >> 6);
    LAS float* scr = (LAS float*)(F.lds + RING_OFF + wave * 16384);
    const int gw = blockIdx.x * NWAVES + wave, NGW = F.G * NWAVES;
    constexpr int I_IN = (DM / 64) * ((IN_PROJ + 31) / 32), I_SQ = (DM / 64) * (DM / 32);
    constexpr int NITEMS = I_IN + 2 * I_SQ;
    { const float* const w_in = F.w_in(); const float* const w_out = F.w_out(); const float* const wq = F.peer_wq(); const float* const fg = F.ffn_norm(); bf16* const WinT = F.WinT(); unsigned char* const WinT8 = F.WinT8(); bf16* const WoutT = F.WoutT(); bf16* const WqT = F.WqT(); const float* const gatt = F.attn_out_norm(); const float* const gssm = F.ssm_out_norm();
      for (int it = gw; it < NITEMS; it += NGW) {
        int r = it;
        if (r < I_IN) { const int n0_ = 32 * (r % ((IN_PROJ + 31) / 32));
            if (n0_ >= F8_LO && n0_ < F8_HI) p0_transpose_item(w_in, DM, IN_PROJ, (bf16*)WinT8, nullptr, scr, r, lane, SW8, F8_LO);
            else p0_transpose_item(w_in, DM, IN_PROJ, WinT, nullptr, scr, r, lane, 0.f, (n0_ >= F8_HI) ? (F8_HI - F8_LO) : 0);
            continue; } r -= I_IN;
        if (r < I_SQ) { const int k0_ = 64 * (r / (DM / 32)); p0_transpose_item(w_out, DM, DM, WoutT, (k0_ < ATT_W) ? gatt : (gssm - ATT_W), scr, r, lane, SW8); continue; } r -= I_SQ;
        p0_transpose_item(wq, DM, DM, WqT, fg, scr, r, lane, SW8);
      } }
    const size_t gt = (size_t)blockIdx.x * (NWAVES * 64) + tid, GT = (size_t)F.G * NWAVES * 64;
    { const size_t z0 = (size_t)(5664 - (F8_HI - F8_LO)) * DM / 8, z1 = (size_t)NB16 * DM / 8; GAS v4u* p = (GAS v4u*)F.WinT(); for (size_t i = z0 + gt; i < z1; i += GT) p[i] = (v4u){0u, 0u, 0u, 0u}; }
    { const GAS f32x4* s = (const GAS f32x4*)F.peer_sk(); GAS v2u* d = (GAS v2u*)F.SK(); for (size_t i = gt; i < (size_t)16 * 128 * 128 / 4; i += GT) { const f32x4 v = s[i]; v2u o; o.x = pk2(v.x, v.y); o.y = pk2(v.z, v.w); d[i] = o; } }
    { const float* const xg = F.x(); const float* const gn = F.attn_norm(); bf16* const hn = F.HN(); unsigned char* const hn8 = F.HN8();
      for (int m = gw; m < MTOK / 2; m += NGW) rms_2rows_to_bf16(xg + (size_t)(2 * m) * DM, xg + (size_t)(2 * m + 1) * DM, gn, hn + (size_t)(2 * m) * DM, hn + (size_t)(2 * m + 1) * DM, hn8 + (size_t)(2 * m) * DM, hn8 + (size_t)(2 * m + 1) * DM, lane); }
    tables_convert(F, 0, tab_split(F.G), gt, GT);
}

struct EpiProj {
    static constexpr bool PERM = true, AFTER_DRAIN = false, SEG = false;
    bf16* O; float* dtraw; float* kmean;
    __device__ __forceinline__ void operator()(const pg8::f32x4 (&acc)[2][2][4][2], const pg8::Unit& u, int wr, int wc, int fr, int fq) const {
        const int rpn = (u.pn < F8_LO / 256) ? u.pn : u.pn + (F8_HI - F8_LO) / 256;
        const int row0 = u.pm * 256 + wr * 64 + fr, col0 = rpn * 256 + wc * 32 + 8 * fq;
        if (rpn < 22) {
#pragma unroll
            for (int ai = 0; ai < 2; ++ai)
#pragma unroll
                for (int m = 0; m < 4; ++m) { bf16* rowp = O + (size_t)(row0 + ai * 128 + m * 16) * NPROJ + col0;
#pragma unroll
                    for (int bj = 0; bj < 2; ++bj) { const pg8::f32x4 v0 = acc[ai][bj][m][0], v1 = acc[ai][bj][m][1];
                        pg8::u32x4 w; w.x = pg8::cvt_pk_bf16(v0[0], v0[1]); w.y = pg8::cvt_pk_bf16(v0[2], v0[3]); w.z = pg8::cvt_pk_bf16(v1[0], v1[1]); w.w = pg8::cvt_pk_bf16(v1[2], v1[3]);
                        *(pg8::u32x4*)(rowp + bj * 128) = w; } }
        } else if (wc == 0 && fq < 2) {
#pragma unroll
            for (int ai = 0; ai < 2; ++ai)
#pragma unroll
                for (int m = 0; m < 4; ++m) { float* rp = dtraw + (size_t)(row0 + ai * 128 + m * 16) * 16 + 8 * fq;
                    *(pg8::f32x4*)rp = acc[ai][0][m][0]; *(pg8::f32x4*)(rp + 4) = acc[ai][0][m][1]; }
        }
        if (kmean && u.pn >= 4 && u.pn < 8) {
#pragma unroll
            for (int bj = 0; bj < 2; ++bj)
#pragma unroll
                for (int n = 0; n < 2; ++n)
#pragma unroll
                    for (int i = 0; i < 4; ++i) { float s = 0.f;
#pragma unroll
                        for (int ai = 0; ai < 2; ++ai)
#pragma unroll
                            for (int m = 0; m < 4; ++m) s += acc[ai][bj][m][n][i];
                        s += __shfl_xor(s, 1); s += __shfl_xor(s, 2); s += __shfl_xor(s, 4); s += __shfl_xor(s, 8);
                        if (fr == 0) unsafeAtomicAdd(kmean + (size_t)u.pm * 1024 + (col0 - 1024) + bj * 128 + 4 * n + i, s); }
        }
    }
};
struct EpiProj8 {
    static constexpr bool PERM = true, AFTER_DRAIN = false, SEG = false;
    bf16* O;
    __device__ __forceinline__ void operator()(const pg8::f32x4 (&acc)[2][2][4][2], const pg8::Unit& u, int wr, int wc, int fr, int fq) const {
        const int row0 = u.pm * 256 + wr * 64 + fr, col0 = F8_LO + u.pn * 256 + wc * 32 + 8 * fq; constexpr float sc = 1.f / (SH8 * SW8);
#pragma unroll
        for (int ai = 0; ai < 2; ++ai)
#pragma unroll
            for (int m = 0; m < 4; ++m) { bf16* rowp = O + (size_t)(row0 + ai * 128 + m * 16) * NPROJ + col0;
#pragma unroll
                for (int bj = 0; bj < 2; ++bj) { const pg8::f32x4 v0 = acc[ai][bj][m][0] * sc, v1 = acc[ai][bj][m][1] * sc;
                    pg8::u32x4 w; w.x = pg8::cvt_pk_bf16(v0[0], v0[1]); w.y = pg8::cvt_pk_bf16(v0[2], v0[3]); w.z = pg8::cvt_pk_bf16(v1[0], v1[1]); w.w = pg8::cvt_pk_bf16(v1[2], v1[3]);
                    *(pg8::u32x4*)(rowp + bj * 128) = w; } }
    }
};
struct EpiOut {
    static constexpr bool PERM = true, AFTER_DRAIN = false, SEG = true; static constexpr int SEG_T1 = 8, SEG_T2 = 12;
    const float* x; bf16* x1b; unsigned char* x18; float* ssq; bool doatom; const LAS f32x4* tab;
    __device__ __forceinline__ void seg_load(int ui, int wr, int fr, float (&sr)[16]) const {
#pragma unroll
        for (int i = 0; i < 8; ++i) { const int r = (i >> 2) * 128 + wr * 64 + (i & 3) * 16 + fr; const f32x2 q = *(const LAS f32x2*)(tab + ui * 256 + r); sr[2 * i] = q.x; sr[2 * i + 1] = q.y; }
        asm volatile("s_waitcnt lgkmcnt(0)" ::: "memory");
    }
    __device__ __forceinline__ void seg_apply(pg8::f32x4 (&acc)[2][2][4][2], const float (&sr)[16], int which) const {
#pragma unroll
        for (int ai = 0; ai < 2; ++ai)
#pragma unroll
            for (int m = 0; m < 4; ++m) { const float f = (which == 0) ? sr[2 * (ai * 4 + m)] : ((which == 1) ? sr[2 * (ai * 4 + m) + 1] : 1.0f);
#pragma unroll
                for (int bj = 0; bj < 2; ++bj)
#pragma unroll
                    for (int n = 0; n < 2; ++n) acc[ai][bj][m][n] = acc[ai][bj][m][n] * f; }
    }
    __device__ __forceinline__ void operator()(const pg8::f32x4 (&acc)[2][2][4][2], const pg8::Unit& u, int wr, int wc, int fr, int fq, int ui) const {
        const int row0 = u.pm * 256 + wr * 64 + fr, col0 = u.pn * 256 + wc * 32 + 8 * fq;
#pragma unroll
        for (int ai = 0; ai < 2; ++ai)
#pragma unroll
            for (int m = 0; m < 4; ++m) { const int row = row0 + ai * 128 + m * 16; const size_t off = (size_t)row * DM + col0; float s = 0.f;
                const float s1 = (*(const LAS f32x4*)(tab + ui * 256 + ai * 128 + wr * 64 + m * 16 + fr)).z;
#pragma unroll
                for (int bj = 0; bj < 2; ++bj) {
                    const pg8::f32x4 a0 = *(const pg8::f32x4*)(x + off + bj * 128), a1 = *(const pg8::f32x4*)(x + off + bj * 128 + 4);
                    const pg8::f32x4 v0 = acc[ai][bj][m][0] * s1 + a0, v1 = acc[ai][bj][m][1] * s1 + a1;
                    pg8::u32x4 w; w.x = pg8::cvt_pk_bf16(v0[0], v0[1]); w.y = pg8::cvt_pk_bf16(v0[2], v0[3]); w.z = pg8::cvt_pk_bf16(v1[0], v1[1]); w.w = pg8::cvt_pk_bf16(v1[2], v1[3]);
                    *(pg8::u32x4*)(x1b + off + bj * 128) = w;
                    { v2u o8; int w_; w_ = __builtin_amdgcn_cvt_pk_fp8_f32(clampf(v0[0] * SX8, 448.f), clampf(v0[1] * SX8, 448.f), 0, false); w_ = __builtin_amdgcn_cvt_pk_fp8_f32(clampf(v0[2] * SX8, 448.f), clampf(v0[3] * SX8, 448.f), w_, true); o8.x = (unsigned)w_;
                      w_ = __builtin_amdgcn_cvt_pk_fp8_f32(clampf(v1[0] * SX8, 448.f), clampf(v1[1] * SX8, 448.f), 0, false); w_ = __builtin_amdgcn_cvt_pk_fp8_f32(clampf(v1[2] * SX8, 448.f), clampf(v1[3] * SX8, 448.f), w_, true); o8.y = (unsigned)w_;
                      *(v2u*)(x18 + off + bj * 128) = o8; }
                    s += (v0[0] * v0[0] + v0[1] * v0[1]) + (v0[2] * v0[2] + v0[3] * v0[3]) + (v1[0] * v1[0] + v1[1] * v1[1]) + (v1[2] * v1[2] + v1[3] * v1[3]); }
                s += __shfl_xor(s, 16); s += __shfl_xor(s, 32);
                if (fq == 0 && doatom) unsafeAtomicAdd(ssq + (size_t)row * 4, s);
                asm volatile("" ::: "memory"); }
    }
};
struct EpiQ {
    static constexpr bool PERM = true, AFTER_DRAIN = false, SEG = false;
    bf16* O; const float* ssq;
    __device__ __forceinline__ void operator()(const pg8::f32x4 (&acc)[2][2][4][2], const pg8::Unit& u, int wr, int wc, int fr, int fq) const {
        const int row0 = u.pm * 256 + wr * 64 + fr, col0 = u.pn * 256 + wc * 32 + 8 * fq;
#pragma unroll
        for (int ai = 0; ai < 2; ++ai)
#pragma unroll
            for (int m = 0; m < 4; ++m) { const int row = row0 + ai * 128 + m * 16; bf16* rowp = O + (size_t)row * DM + col0;
                const float rs = (1.f / (SX8 * SW8)) / sqrtf(__hip_atomic_load(ssq + (size_t)row * 4, RLX_AGENT) * (1.f / DM) + EPS);
#pragma unroll
                for (int bj = 0; bj < 2; ++bj) { const pg8::f32x4 v0 = acc[ai][bj][m][0] * rs, v1 = acc[ai][bj][m][1] * rs;
                    pg8::u32x4 w; w.x = pg8::cvt_pk_bf16(v0[0], v0[1]); w.y = pg8::cvt_pk_bf16(v0[2], v0[3]); w.z = pg8::cvt_pk_bf16(v1[0], v1[1]); w.w = pg8::cvt_pk_bf16(v1[2], v1[3]);
                    *(pg8::u32x4*)(rowp + bj * 128) = w; } }
    }
};

constexpr int A_KSTR = 272, A_VSTR = 288;
constexpr int A_KB0 = 0, A_KB1 = 64 * A_KSTR, A_VB0 = 2 * 64 * A_KSTR, A_VBS = 64 * A_VSTR  , A_KM = A_VB0 + 3 * A_VBS, A_TAB = A_KM + 8 * 128 * 4, A_END = A_TAB + 128 * 4;
static_assert(A_END <= RING_BYTES && (A_KM % 16) == 0, "attention LDS map");
#define PIN16(a, i) asm volatile("" : "+v"(a[i]), "+v"(a[i + 1]), "+v"(a[i + 2]), "+v"(a[i + 3]), "+v"(a[i + 4]), "+v"(a[i + 5]), "+v"(a[i + 6]), "+v"(a[i + 7]), "+v"(a[i + 8]), "+v"(a[i + 9]), "+v"(a[i + 10]), "+v"(a[i + 11]), "+v"(a[i + 12]), "+v"(a[i + 13]), "+v"(a[i + 14]), "+v"(a[i + 15]))
#define TR16(p) __builtin_amdgcn_ds_read_tr16_b64_v4i16((LAS s16x4*)(p))
#define MFMA16(a, b, c) __builtin_amdgcn_mfma_f32_16x16x32_bf16((a), (b), (c), 0, 0, 0)
__device__ __forceinline__ bf16x8 pack8(const float* v) {
    const unsigned a = pk2(v[0], v[1]), b = pk2(v[2], v[3]), c = pk2(v[4], v[5]), d = pk2(v[6], v[7]);
    const v4u u = {a, b, c, d}; return __builtin_bit_cast(bf16x8, u);
}
__device__ __forceinline__ void attn_unit(Frame& F, int b, int h, int blk, const bool doatom = true) {
    LAS unsigned char* lds = F.lds + RING_OFF;
    const int tid = fresh_tid(), lane = tid & 63, w = __builtin_amdgcn_readfirstlane(tid >> 6), g = lane >> 4, c16 = lane & 15, q4 = c16 >> 2, p4 = lane & 3;
    const int own = blk, t0 = blk * 256, tq0 = t0 + 32 * w + c16;
    const size_t rowbase = (size_t)b * SEQ;
    const float NEG_INF = -__builtin_inff();
    constexpr float LOG2E = 1.4426950408889634f, SCL2 = 0.08838834764831845f * 1.4426950408889634f;
    LAS float* km = (LAS float*)(lds + A_KM); LAS float* tab = (LAS float*)(lds + A_TAB);
    const bf16* const PROJ = F.PROJ(); const float* const kmg = F.kmean(); const float* const relb = F.rel_bias();
    for (int i = tid; i < own * 128; i += NWAVES * 64) { const int n = i >> 7, d = i & 127; km[i] = kmg[(size_t)(b * 8 + n) * 1024 + h * 128 + d] * (1.f / 256.f); }
    if (tid < 128) { const int rel = tid; int bucket = rel; if (rel >= 16) { bucket = 16 + (int)(log2f((float)rel * (1.f / 16.f)) * (16.f / 3.f)); bucket = bucket > 31 ? 31 : bucket; }
        tab[tid] = relb[bucket * 8 + h] * LOG2E; }
    bf16x8 qf[2][4];
#pragma unroll
    for (int gi = 0; gi < 2; ++gi) { const bf16* qrow = PROJ + (rowbase + tq0 + 16 * gi) * NPROJ + COL_Q + h * 128 + 8 * g;
#pragma unroll
      for (int ks = 0; ks < 4; ++ks) qf[gi][ks] = *(const GAS bf16x8*)(qrow + 32 * ks); }
    __syncthreads();
    unsigned selmask[2];
    if (own <= 3) { selmask[0] = (1u << own) - 1u; selmask[1] = selmask[0]; }
    else {
#pragma unroll
      for (int gi = 0; gi < 2; ++gi) {
        float gate[7];
#pragma unroll
        for (int n = 0; n < 7; ++n) {
            float s = NEG_INF;
            if (n < own) { s = 0.f;
#pragma unroll
                for (int ks = 0; ks < 4; ++ks) { const LAS f32x4* kp = (const LAS f32x4*)(km + n * 128 + 32 * ks + 8 * g); const f32x4 k0 = kp[0], k1 = kp[1]; const v4u qu = __builtin_bit_cast(v4u, qf[gi][ks]);
                    s += bflo(qu.x) * k0.x + bfhi(qu.x) * k0.y + bflo(qu.y) * k0.z + bfhi(qu.y) * k0.w + bflo(qu.z) * k1.x + bfhi(qu.z) * k1.y + bflo(qu.w) * k1.z + bfhi(qu.w) * k1.w; }
                s += __shfl_xor(s, 16); s += __shfl_xor(s, 32); }
            gate[n] = s;
        }
        unsigned sm = 0u;
#pragma unroll
        for (int r = 0; r < 3; ++r) { float best = NEG_INF; int bi = 0;
#pragma unroll
            for (int n = 0; n < 7; ++n) { const bool cand = (n < own) && !((sm >> n) & 1u) && (gate[n] > best); best = cand ? gate[n] : best; bi = cand ? n : bi; }
            sm |= 1u << bi; }
        selmask[gi] = sm; }
    }
    const int nT = 4 + 4 * own;
    const int sr = tid >> 3, sc = (tid & 7) * 16;
#define A_KEY0(i) ((i) < 4 ? own * 256 + 64 * (i) : (((i) - 4) >> 2) * 256 + (((i) - 4) & 3) * 64)
    v4u kr0, kr1, vr0, vr1;
#define A_LOAD(i) do { const bf16* kp_ = PROJ + (rowbase + A_KEY0(i) + sr) * NPROJ + COL_K + h * 128 + sc; \
        kr0 = *(const GAS v4u*)kp_; kr1 = *(const GAS v4u*)(kp_ + 8); vr0 = *(const GAS v4u*)(kp_ + (COL_V - COL_K)); vr1 = *(const GAS v4u*)(kp_ + (COL_V - COL_K) + 8); } while (0)
#define A_STORE(bufi) do { LAS unsigned char* kd_ = lds + ((bufi) ? A_KB1 : A_KB0) + sr * A_KSTR + sc * 2; LAS unsigned char* vd_ = lds + A_VB0 + vnx * A_VBS + sr * A_VSTR + sc * 2; \
        *(LAS v4u*)kd_ = kr0; *(LAS v4u*)(kd_ + 16) = kr1; *(LAS v4u*)vd_ = vr0; *(LAS v4u*)(vd_ + 16) = vr1; } while (0)
    int vcur = 0, vnx = 0, vprev = 0;
#define A_PV(PF, Vb_) do { _Pragma("unroll") for (int s = 0; s < 2; ++s) { s16x4 vlo[8], vhi[8]; \
            _Pragma("unroll") for (int db = 0; db < 8; ++db) { LAS unsigned char* va = (Vb_) + (32 * s + 4 * g + q4) * A_VSTR + (16 * db + 4 * p4) * 2; vlo[db] = TR16(va); vhi[db] = TR16(va + 16 * A_VSTR); } \
            __builtin_amdgcn_sched_barrier(0); \
            _Pragma("unroll") for (int db = 0; db < 8; ++db) { const bf16x8 vf = __builtin_shufflevector(vlo[db], vhi[db], 0, 1, 2, 3, 4, 5, 6, 7); \
                oacc[0][db] = MFMA16(vf, PF[0][s], oacc[0][db]); oacc[1][db] = MFMA16(vf, PF[1][s], oacc[1][db]); } \
            __builtin_amdgcn_sched_barrier(0); } } while (0)
    A_LOAD(0); A_STORE(0);
    __syncthreads();
    const bool late = w >= 4;
    bf16x8 pfp[2][2]; bool skipp = true;
#pragma unroll
    for (int gi = 0; gi < 2; ++gi) { pfp[gi][0] = (bf16x8){0, 0, 0, 0, 0, 0, 0, 0}; pfp[gi][1] = pfp[gi][0]; }
    float m_run[2] = {NEG_INF, NEG_INF}, l_run[2] = {0.f, 0.f};
    f32x4 oacc[2][8];
#pragma unroll
    for (int gi = 0; gi < 2; ++gi)
#pragma unroll
        for (int db = 0; db < 8; ++db) oacc[gi][db] = (f32x4){0.f, 0.f, 0.f, 0.f};
    for (int i = 0; i < nT; ++i) {
        if (i + 1 < nT) A_LOAD(i + 1);
        vnx = (vcur == 2) ? 0 : vcur + 1;
        const int buf = i & 1, key0 = A_KEY0(i); const bool isown = i < 4; const int pblk = isown ? own : ((i - 4) >> 2);
        const bool skipw = isown && (64 * i > 32 * w + 31);
        if (late && !skipp) A_PV(pfp, lds + A_VB0 + vprev * A_VBS);
        bf16x8 pf[2][2];
        if (!skipw) {
        LAS unsigned char* Kb = lds + (buf ? A_KB1 : A_KB0);
        f32x4 sacc[2][4];
#pragma unroll
        for (int hf = 0; hf < 2; ++hf) { bf16x8 kf[8];
#pragma unroll
            for (int n2 = 0; n2 < 2; ++n2)
#pragma unroll
                for (int ks = 0; ks < 4; ++ks) kf[n2 * 4 + ks] = *(const LAS bf16x8*)(Kb + (16 * (2 * hf + n2) + c16) * A_KSTR + (32 * ks + 8 * g) * 2);
            __builtin_amdgcn_sched_barrier(0);
#pragma unroll
            for (int gi = 0; gi < 2; ++gi)
#pragma unroll
                for (int n2 = 0; n2 < 2; ++n2) { f32x4 a = (f32x4){0.f, 0.f, 0.f, 0.f};
#pragma unroll
                    for (int ks = 0; ks < 4; ++ks) a = MFMA16(kf[n2 * 4 + ks], qf[gi][ks], a);
                    sacc[gi][2 * hf + n2] = a; }
            __builtin_amdgcn_sched_barrier(0); }
        const bool far = (key0 + 63 + 128 <= t0 + 32 * w);
        const bool diag = isown && (64 * i + 63 > 32 * w);
#pragma unroll
        for (int gi = 0; gi < 2; ++gi) {
            const int tq = tq0 + 16 * gi; const bool sel = isown || ((selmask[gi] >> pblk) & 1u);
            float sv[16]; float mloc, m_new, alpha;
            if (far) {
                const float bfar = tab[127];
                float mx = fmaxf(fmaxf(sacc[gi][0][0], sacc[gi][0][1]), fmaxf(sacc[gi][0][2], sacc[gi][0][3]));
#pragma unroll
                for (int nb = 1; nb < 4; ++nb) mx = fmaxf(mx, fmaxf(fmaxf(sacc[gi][nb][0], sacc[gi][nb][1]), fmaxf(sacc[gi][nb][2], sacc[gi][nb][3])));
                mloc = sel ? (mx * SCL2 + bfar) : NEG_INF;
                mloc = fmaxf(mloc, __shfl_xor(mloc, 16)); mloc = fmaxf(mloc, __shfl_xor(mloc, 32));
                m_new = fmaxf(m_run[gi], mloc); alpha = __builtin_amdgcn_exp2f(m_run[gi] - m_new);
                const float cadd = sel ? (bfar - m_new) : NEG_INF;
#pragma unroll
                for (int nb = 0; nb < 4; ++nb)
#pragma unroll
                    for (int r = 0; r < 4; ++r) sv[nb * 4 + r] = __builtin_amdgcn_exp2f(sacc[gi][nb][r] * SCL2 + cadd);
            } else {
                const int relb = tq - key0 - 4 * g; float bias[16];
#pragma unroll
                for (int nb = 0; nb < 4; ++nb)
#pragma unroll
                    for (int r = 0; r < 4; ++r) { const int rel = relb - 16 * nb - r; int ri = rel < 0 ? 0 : rel; ri = ri > 127 ? 127 : ri; bias[nb * 4 + r] = tab[ri]; }
                PIN16(bias, 0);
                mloc = NEG_INF;
#pragma unroll
                for (int nb = 0; nb < 4; ++nb)
#pragma unroll
                    for (int r = 0; r < 4; ++r) { const int rel = relb - 16 * nb - r;
                        float s = sacc[gi][nb][r] * SCL2 + bias[nb * 4 + r]; s = (!sel || (diag && rel < 0)) ? NEG_INF : s; sv[nb * 4 + r] = s; mloc = fmaxf(mloc, s); }
                mloc = fmaxf(mloc, __shfl_xor(mloc, 16)); mloc = fmaxf(mloc, __shfl_xor(mloc, 32));
                m_new = fmaxf(m_run[gi], mloc); alpha = __builtin_amdgcn_exp2f(m_run[gi] - m_new);
#pragma unroll
                for (int e = 0; e < 16; ++e) sv[e] = __builtin_amdgcn_exp2f(sv[e] - m_new);
            }
            float psum = 0.f;
#pragma unroll
            for (int e = 0; e < 16; ++e) psum += sv[e];
            l_run[gi] = l_run[gi] * alpha + psum; m_run[gi] = m_new;
#pragma unroll
            for (int db = 0; db < 8; ++db) oacc[gi][db] = oacc[gi][db] * alpha;
            pf[gi][0] = pack8(sv); pf[gi][1] = pack8(sv + 8);
        }
        __builtin_amdgcn_sched_barrier(0);
        if (!late) A_PV(pf, lds + A_VB0 + vcur * A_VBS);
        }
        if (late) { skipp = skipw;
#pragma unroll
            for (int gi = 0; gi < 2; ++gi) { pfp[gi][0] = pf[gi][0]; pfp[gi][1] = pf[gi][1]; } }
        if (i + 1 < nT) A_STORE((i + 1) & 1);
        vprev = vcur; vcur = vnx;
        __syncthreads();
    }
    if (late && !skipp) A_PV(pfp, lds + A_VB0 + vprev * A_VBS);
#undef A_PV
    bf16* const MIXp = F.HN(); float* const ssqp = F.ssq();
#pragma unroll
    for (int gi = 0; gi < 2; ++gi) {
        const int tq = tq0 + 16 * gi;
        float l_tot = l_run[gi]; l_tot += __shfl_xor(l_tot, 16); l_tot += __shfl_xor(l_tot, 32);
        const float inv = 1.f / l_tot; float ssq = 0.f;
        unsigned char* orow = (unsigned char*)MIXp + (rowbase + tq) * DM + h * 128 + 4 * g;
#pragma unroll
        for (int db = 0; db < 8; ++db) { const f32x4 o = oacc[gi][db] * inv; ssq += (o.x * o.x + o.y * o.y) + (o.z * o.z + o.w * o.w); *(GAS unsigned*)(orow + 16 * db) = pk4_fp8(o.x * SA8, o.y * SA8, o.z * SA8, o.w * SA8); }
        ssq += __shfl_xor(ssq, 16); ssq += __shfl_xor(ssq, 32);
        if (g == 0 && doatom) unsafeAtomicAdd(ssqp + (rowbase + tq) * 4 + 1, ssq);
    }
#undef A_KEY0
#undef A_LOAD
#undef A_STORE
}

constexpr int XBC_W = CONV_CH;
__device__ __forceinline__ void conv_phase(Frame& F) {
    const bf16* const PROJ = F.PROJ(); bf16* const XBC = F.XBC(); const float* const cw = F.conv_w(); const float* const cb = F.conv_b();
    const int gt = blockIdx.x * (NWAVES * 64) + fresh_tid(), GT = F.G * NWAVES * 64;
    for (int task = gt; task < (MTOK / 32) * (CONV_CH / 8); task += GT) {
        const int r = task / (CONV_CH / 8), k = task % (CONV_CH / 8), ch = 8 * k, tok0 = 32 * r;
        float wv[4][8], bias[8];
#pragma unroll
        for (int t = 0; t < 4; ++t) { const f32x4 w0 = *(const GAS f32x4*)(cw + t * CONV_CH + ch), w1 = *(const GAS f32x4*)(cw + t * CONV_CH + ch + 4);
            wv[t][0] = w0.x; wv[t][1] = w0.y; wv[t][2] = w0.z; wv[t][3] = w0.w; wv[t][4] = w1.x; wv[t][5] = w1.y; wv[t][6] = w1.z; wv[t][7] = w1.w; }
        { const f32x4 b0 = *(const GAS f32x4*)(cb + ch), b1 = *(const GAS f32x4*)(cb + ch + 4); bias[0] = b0.x; bias[1] = b0.y; bias[2] = b0.z; bias[3] = b0.w; bias[4] = b1.x; bias[5] = b1.y; bias[6] = b1.z; bias[7] = b1.w; }
        const bf16* src = PROJ + (size_t)tok0 * NPROJ + COL_XBC + ch; bf16* dst = XBC + (size_t)tok0 * XBC_W + ch;
        v4u p0 = (v4u){0u, 0u, 0u, 0u}, p1 = p0, p2 = p0;
        if ((tok0 & (SEQ - 1)) != 0) { p0 = *(const GAS v4u*)(src - 3 * (ptrdiff_t)NPROJ); p1 = *(const GAS v4u*)(src - 2 * (ptrdiff_t)NPROJ); p2 = *(const GAS v4u*)(src - (ptrdiff_t)NPROJ); }
#pragma unroll 1
        for (int i0 = 0; i0 < 32; i0 += 8) {
            v4u cur[8];
#pragma unroll
            for (int i = 0; i < 8; ++i) cur[i] = *(const GAS v4u*)(src + (size_t)(i0 + i) * NPROJ);
#pragma unroll
            for (int i = 0; i < 8; ++i) {
                const v4u c = cur[i]; float acc[8];
                const unsigned a0[4] = {p0.x, p0.y, p0.z, p0.w}, a1[4] = {p1.x, p1.y, p1.z, p1.w}, a2[4] = {p2.x, p2.y, p2.z, p2.w}, a3[4] = {c.x, c.y, c.z, c.w};
#pragma unroll
                for (int j = 0; j < 4; ++j) {
                    acc[2 * j] = bias[2 * j] + wv[0][2 * j] * bflo(a0[j]) + wv[1][2 * j] * bflo(a1[j]) + wv[2][2 * j] * bflo(a2[j]) + wv[3][2 * j] * bflo(a3[j]);
                    acc[2 * j + 1] = bias[2 * j + 1] + wv[0][2 * j + 1] * bfhi(a0[j]) + wv[1][2 * j + 1] * bfhi(a1[j]) + wv[2][2 * j + 1] * bfhi(a2[j]) + wv[3][2 * j + 1] * bfhi(a3[j]); }
#pragma unroll
                for (int j = 0; j < 8; ++j) acc[j] = silu_f(acc[j]);
                v4u o; o.x = pk2(acc[0], acc[1]); o.y = pk2(acc[2], acc[3]); o.z = pk2(acc[4], acc[5]); o.w = pk2(acc[6], acc[7]);
                *(GAS v4u*)(dst + (size_t)(i0 + i) * XBC_W) = o;
                p0 = p1; p1 = p2; p2 = c; }
        }
    }
    { const float* const dtraw = F.dtraw(); float* const dt2 = F.DT2(); const float* const dtb = F.dt_bias();
      for (int i = gt; i < MTOK * 16; i += GT) { const float xr = dtraw[i] + dtb[i & 15]; dt2[i] = xr > 20.f ? xr : log1pf(__expf(xr)); } }
}

constexpr int S_BSTR = 272, S_XSTR = 144;
constexpr int S_BM = 0, S_CM = 128 * S_BSTR, S_X = 2 * 128 * S_BSTR, S_XW = S_X + 128 * S_XSTR, S_HB = S_XW + 128 * S_XSTR, S_DT = S_HB + 64 * S_BSTR, S_CS = S_DT + 512, S_DA = S_CS + 512, S_END = S_DA + 512;
static_assert(S_END <= RING_BYTES, "ssd LDS map");
__device__ __forceinline__ void ssd_unit(Frame& F, int b, int h, const bool doatom = true) {
    LAS unsigned char* lds = F.lds + RING_OFF;
    const int tid = fresh_tid(), lane = tid & 63, w = __builtin_amdgcn_readfirstlane(tid >> 6), g = lane >> 4, c16 = lane & 15, q4 = c16 >> 2, p4 = lane & 3;
    const int g8 = h >> 3, pbw = w & 3, nhw = w >> 2;
    const float a_h = -__expf(F.a_log()[h]), dsk = F.d_skip()[h];
    const bf16* const PROJ = F.PROJ(); bf16* const MIX = F.HN(); const float* const dt2 = F.DT2(); const bf16* const XBC = F.XBC(); float* const ssqp = F.ssq();
    LAS float* dtl = (LAS float*)(lds + S_DT); LAS float* csl = (LAS float*)(lds + S_CS); LAS float* dal = (LAS float*)(lds + S_DA);
    for (int i = tid; i < 64 * S_BSTR / 16; i += NWAVES * 64) ((LAS v4u*)(lds + S_HB))[i] = (v4u){0u, 0u, 0u, 0u};
    f32x4 hacc[4];
#pragma unroll
    for (int i = 0; i < 4; ++i) hacc[i] = (f32x4){0.f, 0.f, 0.f, 0.f};
    const int xl = tid >> 3, xc = tid & 7, bl = tid >> 4, bc = tid & 15;
    v4u xr[2], br[4], cr[4]; float dtv = 0.f;
#define S_PREFETCH(cc) do { const size_t t0_ = (size_t)b * SEQ + (size_t)(cc) * SSM_L; \
        _Pragma("unroll") for (int i_ = 0; i_ < 2; ++i_) xr[i_] = *(const GAS v4u*)(XBC + (t0_ + xl + 64 * i_) * XBC_W + h * 64 + 8 * xc); \
        _Pragma("unroll") for (int i_ = 0; i_ < 4; ++i_) { const bf16* p_ = XBC + (t0_ + bl + 32 * i_) * XBC_W + 1024 + g8 * 128 + 8 * bc; br[i_] = *(const GAS v4u*)p_; cr[i_] = *(const GAS v4u*)(p_ + 256); } \
        if (tid < 128) dtv = dt2[(t0_ + tid) * 16 + h]; } while (0)
    S_PREFETCH(0);
    for (int c = 0; c < SSM_NC; ++c) {
        const size_t tok0 = (size_t)b * SEQ + (size_t)c * SSM_L;
        if (tid < 128) { dtl[tid] = dtv; dal[tid] = dtv * a_h; }
        __syncthreads();
        if (w == 0) { const float v0 = dal[2 * lane], v1 = dal[2 * lane + 1]; float s = v0 + v1;
#pragma unroll
            for (int o = 1; o < 64; o <<= 1) { const float t = __shfl_up(s, o); s += (lane >= o) ? t : 0.f; }
            csl[2 * lane] = s - v1; csl[2 * lane + 1] = s; }
        __syncthreads();
        const float cs_last = csl[127];
#pragma unroll
        for (int i = 0; i < 2; ++i) { const int l = xl + 64 * i; const v4u v = xr[i]; *(LAS v4u*)(lds + S_X + l * S_XSTR + xc * 16) = v; const float wl = dtl[l] * __expf(cs_last - csl[l]);
            v4u o2; o2.x = pk2(bflo(v.x) * wl, bfhi(v.x) * wl); o2.y = pk2(bflo(v.y) * wl, bfhi(v.y) * wl); o2.z = pk2(bflo(v.z) * wl, bfhi(v.z) * wl); o2.w = pk2(bflo(v.w) * wl, bfhi(v.w) * wl);
            *(LAS v4u*)(lds + S_XW + l * S_XSTR + xc * 16) = o2; }
#pragma unroll
        for (int i = 0; i < 4; ++i) { const int l = bl + 32 * i; *(LAS v4u*)(lds + S_BM + l * S_BSTR + bc * 16) = br[i]; *(LAS v4u*)(lds + S_CM + l * S_BSTR + bc * 16) = cr[i]; }
        const int lrow = 16 * w + c16;
        v2u zr[4];
#pragma unroll
        for (int pb = 0; pb < 4; ++pb) zr[pb] = *(const GAS v2u*)(PROJ + (tok0 + lrow) * NPROJ + COL_Z + h * 64 + 16 * pb + 4 * g);
        if (c + 1 < SSM_NC) S_PREFETCH(c + 1);
        __syncthreads();
        bf16x8 cf[4];
#pragma unroll
        for (int ks = 0; ks < 4; ++ks) cf[ks] = *(const LAS bf16x8*)(lds + S_CM + lrow * S_BSTR + (32 * ks + 8 * g) * 2);
        f32x4 yacc[4];
        const float cs_l = csl[lrow]; const float el = __expf(cs_l);
#pragma unroll
        for (int pb = 0; pb < 4; ++pb) { yacc[pb] = (f32x4){0.f, 0.f, 0.f, 0.f};
#pragma unroll
            for (int ks = 0; ks < 4; ++ks) { const bf16x8 hf = *(const LAS bf16x8*)(lds + S_HB + (16 * pb + c16) * S_BSTR + (32 * ks + 8 * g) * 2); yacc[pb] = MFMA16(hf, cf[ks], yacc[pb]); }
            yacc[pb] = yacc[pb] * el; }
        for (int s2 = 0; s2 <= (w >> 1); ++s2) {
            const int sb0 = 2 * s2, sb1 = 2 * s2 + 1; const bool has1 = sb1 <= w;
            f32x4 cb0 = (f32x4){0.f, 0.f, 0.f, 0.f}, cb1 = (f32x4){0.f, 0.f, 0.f, 0.f};
#pragma unroll
            for (int ks = 0; ks < 4; ++ks) { const bf16x8 bf0 = *(const LAS bf16x8*)(lds + S_BM + (16 * sb0 + c16) * S_BSTR + (32 * ks + 8 * g) * 2); cb0 = MFMA16(bf0, cf[ks], cb0); }
            if (has1) {
#pragma unroll
                for (int ks = 0; ks < 4; ++ks) { const bf16x8 bf1 = *(const LAS bf16x8*)(lds + S_BM + (16 * sb1 + c16) * S_BSTR + (32 * ks + 8 * g) * 2); cb1 = MFMA16(bf1, cf[ks], cb1); } }
            float mv[8];
#pragma unroll
            for (int r = 0; r < 4; ++r) { const int s = 16 * sb0 + 4 * g + r; const float e = __expf(fminf(cs_l - csl[s], 0.f)) * dtl[s]; mv[r] = (s <= lrow) ? cb0[r] * e : 0.f; }
#pragma unroll
            for (int r = 0; r < 4; ++r) { const int s = 16 * sb1 + 4 * g + r; const int sc_ = s > 127 ? 127 : s; const float e = __expf(fminf(cs_l - csl[sc_], 0.f)) * dtl[sc_]; mv[4 + r] = (has1 && s <= lrow) ? cb1[r] * e : 0.f; }
            const bf16x8 pf = pack8(mv);
#pragma unroll
            for (int pb = 0; pb < 4; ++pb) { LAS unsigned char* xa = lds + S_X + (32 * s2 + 4 * g + q4) * S_XSTR + (16 * pb + 4 * p4) * 2;
                const s16x4 lo = TR16(xa), hi = TR16(xa + 16 * S_XSTR); const bf16x8 xf = __builtin_shufflevector(lo, hi, 0, 1, 2, 3, 4, 5, 6, 7);
                yacc[pb] = MFMA16(xf, pf, yacc[pb]); }
        }
        { const size_t tok = tok0 + lrow; float ssq = 0.f;
#pragma unroll
          for (int pb = 0; pb < 4; ++pb) { const int p0 = 16 * pb + 4 * g;
              const v2u xs_ = *(const LAS v2u*)(lds + S_X + lrow * S_XSTR + p0 * 2);
              const v2u zr_ = zr[pb];
              const float o0 = (yacc[pb].x + bflo(xs_.x) * dsk) * silu_f(bflo(zr_.x)), o1 = (yacc[pb].y + bfhi(xs_.x) * dsk) * silu_f(bfhi(zr_.x));
              const float o2 = (yacc[pb].z + bflo(xs_.y) * dsk) * silu_f(bflo(zr_.y)), o3 = (yacc[pb].w + bfhi(xs_.y) * dsk) * silu_f(bfhi(zr_.y));
              ssq += (o0 * o0 + o1 * o1) + (o2 * o2 + o3 * o3);
              *(GAS unsigned*)((unsigned char*)MIX + tok * DM + ATT_W + h * 64 + p0) = pk4_fp8(o0 * SS8, o1 * SS8, o2 * SS8, o3 * SS8); }
          ssq += __shfl_xor(ssq, 16); ssq += __shfl_xor(ssq, 32);
          if (g == 0 && doatom) unsafeAtomicAdd(ssqp + tok * 4 + 2 + g8, ssq); }
        { const float cdec = __expf(cs_last);
#pragma unroll
          for (int i = 0; i < 4; ++i) hacc[i] = hacc[i] * cdec;
#pragma unroll
          for (int ks = 0; ks < 4; ++ks) {
              LAS unsigned char* xa = lds + S_XW + (32 * ks + 8 * g + q4) * S_XSTR + (16 * pbw + 4 * p4) * 2;
              const s16x4 xlo = TR16(xa), xhi = TR16(xa + 4 * S_XSTR); const bf16x8 xf = __builtin_shufflevector(xlo, xhi, 0, 1, 2, 3, 4, 5, 6, 7);
#pragma unroll
              for (int i = 0; i < 4; ++i) { const int nb = 4 * nhw + i; LAS unsigned char* ba = lds + S_BM + (32 * ks + 8 * g + q4) * S_BSTR + (16 * nb + 4 * p4) * 2;
                  const s16x4 blo = TR16(ba), bhi = TR16(ba + 4 * S_BSTR); const bf16x8 bfr = __builtin_shufflevector(blo, bhi, 0, 1, 2, 3, 4, 5, 6, 7);
                  hacc[i] = MFMA16(bfr, xf, hacc[i]); } } }
        __syncthreads();
#pragma unroll
        for (int i = 0; i < 4; ++i) { const int nb = 4 * nhw + i; v2u o; o.x = pk2(hacc[i].x, hacc[i].y); o.y = pk2(hacc[i].z, hacc[i].w);
            *(LAS v2u*)(lds + S_HB + (16 * pbw + c16) * S_BSTR + (16 * nb + 4 * g) * 2) = o; }
    }
#undef S_PREFETCH
    __syncthreads();
}

__device__ __forceinline__ void mix_normalize(Frame& F) {
    const int tid_ = fresh_tid(), lane = tid_ & 63; const int gw = blockIdx.x * NWAVES + __builtin_amdgcn_readfirstlane(tid_ >> 6), NGW = F.G * NWAVES;
    const float* const ssqp = F.ssq(); bf16* const MIX = F.HN(); const float* const gatt = F.attn_out_norm(); const float* const gssm = F.ssm_out_norm();
    for (int m = gw; m < MTOK; m += NGW) {
        const float* sq = ssqp + (size_t)m * 4;
        const float s1 = __hip_atomic_load(sq + 1, RLX_AGENT), s2 = __hip_atomic_load(sq + 2, RLX_AGENT), s3 = __hip_atomic_load(sq + 3, RLX_AGENT);
        const float ra = 1.f / sqrtf(s1 * (1.f / 1024.f) + EPS), r0 = 1.f / sqrtf(s2 * (1.f / 512.f) + EPS), r1 = 1.f / sqrtf(s3 * (1.f / 512.f) + EPS);
        GAS v4u* row = (GAS v4u*)(MIX + (size_t)m * DM);
#pragma unroll
        for (int j = 0; j < 4; ++j) { const int idx = lane + 64 * j, col = 8 * idx; const float rs = (j < 2) ? ra : ((j == 2) ? r0 : r1);
            const float* gp = (j < 2) ? (gatt + col) : (gssm + (col - ATT_W));
            const f32x4 g0 = *(const GAS f32x4*)gp, g1 = *(const GAS f32x4*)(gp + 4); const v4u v = row[idx]; v4u o;
            o.x = pk2(bflo(v.x) * rs * g0.x, bfhi(v.x) * rs * g0.y); o.y = pk2(bflo(v.y) * rs * g0.z, bfhi(v.y) * rs * g0.w);
            o.z = pk2(bflo(v.z) * rs * g1.x, bfhi(v.z) * rs * g1.y); o.w = pk2(bflo(v.w) * rs * g1.z, bfhi(v.w) * rs * g1.w); row[idx] = o; }
    }
}

constexpr int P_EIDX = 0, P_GATE = 16384, P_LST = 32768, P_HN = 65536, P_ACT = 98304, P_END = 102400;
static_assert(P_END <= RING_BYTES, "peer LDS map");
__constant__ unsigned char PEER_CAND[52] = {0, 1, 2, 3, 4, 5, 6, 7, 8, 9, 10, 11, 12, 13, 14, 15, 16, 17, 18, 19, 20, 21, 22, 23, 32, 33, 34, 35, 36, 48, 49, 50, 51, 64, 65, 66, 80, 81, 96, 97, 112, 113, 128, 144, 160, 176, 192, 208, 224, 240, 255, 255};
__device__ __forceinline__ unsigned f2ord(float f) { const unsigned u = __builtin_bit_cast(unsigned, f); return u ^ ((u >> 31) ? 0xFFFFFFFFu : 0x80000000u); }
__device__ __forceinline__ float ord2f(unsigned u) { return __builtin_bit_cast(float, u ^ ((u >> 31) ? 0x80000000u : 0xFFFFFFFFu)); }
#define CSWAPD(a, b) do { const unsigned hi_ = (a) > (b) ? (a) : (b), lo_ = (a) > (b) ? (b) : (a); (a) = hi_; (b) = lo_; } while (0)
template <int N> __device__ __forceinline__ void bitonic_sort_desc(unsigned (&v)[N]) {
#pragma unroll
    for (int k = 2; k <= N; k <<= 1)
#pragma unroll
        for (int j = k >> 1; j > 0; j >>= 1)
#pragma unroll
            for (int i = 0; i < N; ++i) { const int l = i ^ j; if (l > i) { if ((i & k) == 0) CSWAPD(v[i], v[l]); else CSWAPD(v[l], v[i]); } }
}
__device__ __forceinline__ void merge16_xor(unsigned (&v)[16], int dist) {
    unsigned o[16];
#pragma unroll
    for (int i = 0; i < 16; ++i) o[i] = (unsigned)__shfl_xor((int)v[i], dist);
#pragma unroll
    for (int i = 0; i < 16; ++i) v[i] = v[i] > o[15 - i] ? v[i] : o[15 - i];
#pragma unroll
    for (int j = 8; j > 0; j >>= 1)
#pragma unroll
        for (int i = 0; i < 16; ++i) { const int l = i ^ j; if (l > i) CSWAPD(v[i], v[l]); }
}
__device__ __forceinline__ float gelu_erf(float x) { return 0.5f * x * (1.f + erff(x * 0.70710678118654752f)); }
__device__ __forceinline__ float fp4_dec1(unsigned n) { const unsigned m = n & 7u; unsigned bits = (m >= 2u) ? (((126u + (m >> 1)) << 23) | ((m & 1u) << 22)) : (m ? 0x3F000000u : 0u); bits |= (n & 8u) << 28; return __builtin_bit_cast(float, bits); }
__device__ __forceinline__ f32x2 fp4_dec2(unsigned x) { f32x2 r; r.x = fp4_dec1(x & 15u); r.y = fp4_dec1((x >> 4) & 15u); return r; }
typedef long i64;
typedef int v8i __attribute__((ext_vector_type(8)));
template <bool dry = false> __device__ __forceinline__ void peer_unit(Frame& F, int u) {
    LAS unsigned char* lds = F.lds + RING_OFF;
    const int tid_ = fresh_tid(), lane = tid_ & 63, w = __builtin_amdgcn_readfirstlane(tid_ >> 6), g = lane >> 4, c16 = lane & 15;
    const int T0 = 32 * u;
    LAS int* eidx = (LAS int*)(lds + P_EIDX); LAS float* gate = (LAS float*)(lds + P_GATE);
    LAS unsigned* lst = (LAS unsigned*)(lds + P_LST) + w * 1024;
    const bf16* const QP = F.QP(); const bf16* const SK = F.SK(); float* const outp = F.out(); const bf16* const X1B = F.X1B(); const float* const fgain = F.ffn_norm(); const float* const fing = F.final_norm(); const unsigned char* const U8 = F.U8(); const unsigned char* const V8 = F.V8();
#ifndef NO_ROUTE
    for (int tb = 0; tb < 2; ++tb) {
        for (int c = 0; c < 2; ++c) {
            const int p = 2 * w + c;
            bf16x8 qf[4];
            { const unsigned qo = ((unsigned)(T0 + 16 * tb + c16) * (unsigned)DM + (unsigned)(p * 128 + 8 * g)) * 2u;
#pragma unroll
              for (int ks = 0; ks < 4; ++ks) qf[ks] = __builtin_nontemporal_load((const GAS bf16x8*)((const unsigned char*)QP + (qo + 64u * ks))); }
            unsigned key[32];
#pragma unroll
            for (int kb = 0; kb < 8; ++kb) { f32x4 acc = (f32x4){0.f, 0.f, 0.f, 0.f};
                const unsigned so = ((unsigned)(p * 128 + 16 * kb + c16) * 128u + 8u * (unsigned)g) * 2u;
#pragma unroll
                for (int ks = 0; ks < 4; ++ks) { const bf16x8 sf = *(const GAS bf16x8*)((const unsigned char*)SK + (so + 64u * ks)); acc = MFMA16(sf, qf[ks], acc); }
#pragma unroll
                for (int r = 0; r < 4; ++r) key[kb * 4 + r] = (f2ord(acc[r]) & ~0x7Fu) | (unsigned)(16 * kb + 4 * g + r);
                __builtin_amdgcn_sched_barrier(0); }
            bitonic_sort_desc<32>(key);
            unsigned top[16];
#pragma unroll
            for (int i = 0; i < 16; ++i) top[i] = key[i];
            merge16_xor(top, 16); merge16_xor(top, 32);
            if (g == 0) { LAS v4u* d = (LAS v4u*)(lst + (c * 32 + 16 * tb + c16) * 16);
                d[0] = (v4u){top[0], top[1], top[2], top[3]}; d[1] = (v4u){top[4], top[5], top[6], top[7]}; d[2] = (v4u){top[8], top[9], top[10], top[11]}; d[3] = (v4u){top[12], top[13], top[14], top[15]}; }
        }
        LDS_WAIT();
        const LAS unsigned* l1 = lst + (16 * tb + c16) * 16; const LAS unsigned* l2 = lst + (32 + 16 * tb + c16) * 16;
        unsigned ck[16];
#pragma unroll
        for (int k = 0; k < 13; ++k) { const unsigned ab = PEER_CAND[4 * k + g]; const unsigned a = ab >> 4, bq = ab & 15u;
            const float s = ord2f(l1[a] & ~0x7Fu) + ord2f(l2[bq] & ~0x7Fu); ck[k] = (ab == 255u) ? 0u : ((f2ord(s) & ~0xFFu) | ab); }
        ck[13] = 0u; ck[14] = 0u; ck[15] = 0u;
        bitonic_sort_desc<16>(ck);
        merge16_xor(ck, 16); merge16_xor(ck, 32);
        if (g == 0) { const int tl = 16 * tb + c16; const float m = ord2f(ck[0] & ~0xFFu); float e[16]; float sum = 0.f;
#pragma unroll
            for (int k = 0; k < 16; ++k) { e[k] = __expf(ord2f(ck[k] & ~0xFFu) - m); sum += e[k]; }
            const float inv = 1.f / sum;
#pragma unroll
            for (int k = 0; k < 16; ++k) { const unsigned a = (ck[k] >> 4) & 15u, bq = ck[k] & 15u; const int ex = (int)((l1[a] & 0x7Fu) * 128u + (l2[bq] & 0x7Fu));
                eidx[tl * 128 + w * 16 + k] = ex; gate[tl * 128 + w * 16 + k] = e[k] * inv; } }
    }
#endif
    __syncthreads();
    LAS unsigned char* hnb = lds + P_HN + w * 4096; LAS float* actl = (LAS float*)(lds + P_ACT) + w * 128;
    const LAS unsigned char* hb = hnb + 16 * g + ((c16 == 1) ? 1024 : 0);
    v4u bA[8], bB[8];
#ifdef PROBE_UROW
#define U_ISSUE(buf, e_, jb) do { if (dry) { _Pragma("unroll") for (int jj = 0; jj < 8; ++jj) { const unsigned uo_ = (unsigned)__shfl((int)(e_), 8 * (jb) + jj) * (unsigned)ROWB + 16u * (unsigned)lane; buf[jj] = *(const GAS v4u*)(U8 + uo_); } } else { \
        const unsigned uo_ = (unsigned)(e_) * (unsigned)ROWB + 16u * (unsigned)g + 512u * (unsigned)(jb); \
        _Pragma("unroll") for (int jj = 0; jj < 8; ++jj) buf[jj] = *(const GAS v4u*)(U8 + (uo_ + 64u * jj)); } __builtin_amdgcn_sched_barrier(0); } while (0)
#else
#define U_ISSUE(buf, e_, jb) do { const unsigned uo_ = (unsigned)(e_) * (unsigned)ROWB + 16u * (unsigned)g + 512u * (unsigned)(jb); \
        _Pragma("unroll") for (int jj = 0; jj < 8; ++jj) buf[jj] = *(const GAS v4u*)(U8 + (uo_ + 64u * jj)); __builtin_amdgcn_sched_barrier(0); } while (0)
#endif
#define U_CONSUME(buf, jb) do { v4u bq_[8]; _Pragma("unroll") for (int jj = 0; jj < 8; ++jj) bq_[jj] = *(const LAS v4u*)(hb + 64 * (8 * (jb) + jj)); \
        __builtin_amdgcn_sched_barrier(0); \
        _Pragma("unroll") for (int jj = 0; jj < 8; ++jj) { const v4u a_ = buf[jj]; \
            const v8i av_ = {(int)a_.x, (int)a_.y, (int)a_.z, (int)a_.w, 0, 0, 0, 0}; const v8i bv_ = {(int)bq_[jj].x, (int)bq_[jj].y, (int)bq_[jj].z, (int)bq_[jj].w, 0, 0, 0, 0}; \
            acc = __builtin_amdgcn_mfma_scale_f32_16x16x128_f8f6f4(av_, bv_, acc, 4, 4, 0, 0x7f7f7f7f, 0, 0x7f7f7f7f); } __builtin_amdgcn_sched_barrier(0); } while (0)
#define U_ACT(grp_) do { const float l0_ = __shfl_down(acc.x, 1), l1_ = __shfl_down(acc.y, 1), l2_ = __shfl_down(acc.z, 1), l3_ = __shfl_down(acc.w, 1); \
        if (c16 == 0) { const int k0 = 16 * (grp_) + 4 * g; constexpr float isc = 1.f / (SU * SH4), ilo = 1.f / SLO4; const f32x4 gt = *(const LAS f32x4*)(gate + tl * 128 + k0); \
        f32x4 a4; a4.x = gelu_erf((acc.x + l0_ * ilo) * isc) * gt.x; a4.y = gelu_erf((acc.y + l1_ * ilo) * isc) * gt.y; a4.z = gelu_erf((acc.z + l2_ * ilo) * isc) * gt.z; a4.w = gelu_erf((acc.w + l3_ * ilo) * isc) * gt.w; *(LAS f32x4*)(actl + k0) = a4; } } while (0)
#define V_ISSUE(buf, kb_) do { _Pragma("unroll") for (int kk = 0; kk < 8; ++kk) { const int e_ = eidx[tl * 128 + 8 * (kb_) + kk] & emask; const unsigned vo_ = (unsigned)e_ * (unsigned)ROWB + 16u * (unsigned)lane; \
        buf[kk] = *(const GAS v4u*)(V8 + vo_); } __builtin_amdgcn_sched_barrier(0); } while (0)
#ifdef FP4_SOFT_DEC
#define FP4_DEC(x) fp4_dec2(x)
#else
#define FP4_DEC(x) __builtin_amdgcn_cvt_scalef32_pk_f32_fp4((x), 1.0f, 0)
#endif
#ifdef FP4_SWAP_DEC
#define FP4_ACC(oa, ob, d) do { oa += a_ * d.y; ob += a_ * d.x; } while (0)
#else
#define FP4_ACC(oa, ob, d) do { oa += a_ * d.x; ob += a_ * d.y; } while (0)
#endif
#define PIN8x2(a, i) asm volatile("" : "+v"(a[i]), "+v"(a[i + 1]), "+v"(a[i + 2]), "+v"(a[i + 3]), "+v"(a[i + 4]), "+v"(a[i + 5]), "+v"(a[i + 6]), "+v"(a[i + 7]))
#define V_CONSUME(buf, kb_) do { _Pragma("unroll") for (int kk = 0; kk < 8; ++kk) { const float as_ = actl[8 * (kb_) + kk]; const f32x2 a2_ = {as_, as_}; \
        const unsigned vw[4] = {buf[kk].x, buf[kk].y, buf[kk].z, buf[kk].w}; \
        _Pragma("unroll") for (int q = 0; q < 4; ++q) { \
            o2[4 * q]     = __builtin_elementwise_fma(__builtin_amdgcn_cvt_scalef32_pk_f32_fp4(vw[q], 1.0f, 0), a2_, o2[4 * q]); \
            o2[4 * q + 1] = __builtin_elementwise_fma(__builtin_amdgcn_cvt_scalef32_pk_f32_fp4(vw[q], 1.0f, 1), a2_, o2[4 * q + 1]); \
            o2[4 * q + 2] = __builtin_elementwise_fma(__builtin_amdgcn_cvt_scalef32_pk_f32_fp4(vw[q], 1.0f, 2), a2_, o2[4 * q + 2]); \
            o2[4 * q + 3] = __builtin_elementwise_fma(__builtin_amdgcn_cvt_scalef32_pk_f32_fp4(vw[q], 1.0f, 3), a2_, o2[4 * q + 3]); } \
        PIN8x2(o2, 0); PIN8x2(o2, 8); } } while (0)
#define V_KEEP(buf) do { _Pragma("unroll") for (int kk = 0; kk < 8; ++kk) asm volatile("" :: "v"(buf[kk])); } while (0)
#ifndef NO_GATHER
#ifdef PROBE_L2RES
    constexpr int emask = dry ? PROBE_L2RES : 16383;
#else
    constexpr int emask = 16383;
#endif
    int e_cur = eidx[w * 128 + c16] & emask;
    v2u xn[8];
#define X_ISSUE(tok_) do { const unsigned xb_ = (unsigned)(tok_) * (unsigned)(DM * 2) + 8u * (unsigned)lane; _Pragma("unroll") for (int j = 0; j < 8; ++j) xn[j] = __builtin_nontemporal_load((const GAS v2u*)((const unsigned char*)X1B + (xb_ + 512u * j))); } while (0)
    X_ISSUE(T0 + w);
    U_ISSUE(bA, e_cur, 0);
    for (int ti = 0; ti < 4; ++ti) {
        const int tl = w + 8 * ti; const size_t token = (size_t)T0 + tl;
        f32x4 xr[8]; float ss = 0.f;
        const unsigned xo = (unsigned)token * (unsigned)(DM * 4) + 16u * (unsigned)lane;
        {
#pragma unroll
          for (int j = 0; j < 8; ++j) { const v2u r = xn[j]; xr[j] = (f32x4){bflo(r.x), bfhi(r.x), bflo(r.y), bfhi(r.y)}; }
#pragma unroll
          for (int j = 0; j < 8; ++j) ss += (xr[j].x * xr[j].x + xr[j].y * xr[j].y) + (xr[j].z * xr[j].z + xr[j].w * xr[j].w); }
        const float rs2 = __builtin_amdgcn_rsqf(wave_sum(ss) * (1.f / DM) + EPS);
        {
          const float* fg_ = fgain; asm volatile("" : "+s"(fg_));
          const unsigned char* gp = (const unsigned char*)fg_; const unsigned go = 16u * (unsigned)lane;
          unsigned hw[4], lw[4];
#pragma unroll
          for (int q = 0; q < 4; ++q) { unsigned wh = 0u, wl = 0u;
#pragma unroll
              for (int t = 0; t < 2; ++t) { const int j = 2 * q + t; const f32x4 gg = *(const GAS f32x4*)(gp + (go + 1024u * j)); const f32x4 hv = xr[j] * gg * (rs2 * SH4);
                  const float h0 = clampf(hv.x, 6.f), h1 = clampf(hv.y, 6.f), h2 = clampf(hv.z, 6.f), h3 = clampf(hv.w, 6.f);
                  const unsigned p0 = __builtin_amdgcn_cvt_scalef32_pk_fp4_f32(0u, h0, h1, 1.0f, 0), p1 = __builtin_amdgcn_cvt_scalef32_pk_fp4_f32(0u, h2, h3, 1.0f, 0);
                  const f32x2 d0 = __builtin_amdgcn_cvt_scalef32_pk_f32_fp4(p0, 1.0f, 0), d1 = __builtin_amdgcn_cvt_scalef32_pk_f32_fp4(p1, 1.0f, 0);
                  const unsigned r0 = __builtin_amdgcn_cvt_scalef32_pk_fp4_f32(0u, clampf((h0 - d0.x) * SLO4, 6.f), clampf((h1 - d0.y) * SLO4, 6.f), 1.0f, 0), r1 = __builtin_amdgcn_cvt_scalef32_pk_fp4_f32(0u, clampf((h2 - d1.x) * SLO4, 6.f), clampf((h3 - d1.y) * SLO4, 6.f), 1.0f, 0);
                  wh |= ((p0 & 0xFFu) | ((p1 & 0xFFu) << 8)) << (16 * t); wl |= ((r0 & 0xFFu) | ((r1 & 0xFFu) << 8)) << (16 * t); }
              hw[q] = wh; lw[q] = wl; }
          *(LAS v4u*)(hnb + 16 * lane) = (v4u){hw[0], hw[1], hw[2], hw[3]}; *(LAS v4u*)(hnb + 1024 + 16 * lane) = (v4u){lw[0], lw[1], lw[2], lw[3]}; }
        LDS_WAIT();
#pragma unroll 1
        for (int grp = 0; grp < 8; ++grp) {
            const int gn = grp < 7 ? grp + 1 : 7;
            const int e_nxt = eidx[tl * 128 + 16 * gn + c16] & emask;
            f32x4 acc = (f32x4){0.f, 0.f, 0.f, 0.f};
#ifdef PROBE_NOUMATH
            U_ISSUE(bB, e_cur, 1); if (dry) { V_KEEP(bA); } else { U_CONSUME(bA, 0); }
            if (grp < 7) U_ISSUE(bA, e_nxt, 0); else V_ISSUE(bA, 0);
            if (dry) { V_KEEP(bB); } else { U_CONSUME(bB, 1); U_ACT(grp); }
#else
            U_ISSUE(bB, e_cur, 1); U_CONSUME(bA, 0);
            if (grp < 7) U_ISSUE(bA, e_nxt, 0); else V_ISSUE(bA, 0);
            U_CONSUME(bB, 1);
            U_ACT(grp);
#endif
            e_cur = e_nxt;
        }
        LDS_WAIT();
        f32x2 o2[16];
#pragma unroll
        for (int i = 0; i < 16; ++i) o2[i] = (f32x2){0.f, 0.f};
#pragma unroll 1
        for (int kb = 0; kb < 16; kb += 2) {
#ifdef PROBE_NOVMATH
            V_ISSUE(bB, kb + 1); if (dry) V_KEEP(bA); else V_CONSUME(bA, kb);
            if (kb + 2 < 16) V_ISSUE(bA, kb + 2);
            else if (ti < 3) { e_cur = eidx[(tl + 8) * 128 + c16] & emask; X_ISSUE(token + 8); U_ISSUE(bA, e_cur, 0); }
            if (dry) V_KEEP(bB); else V_CONSUME(bB, kb + 1);
#else
            V_ISSUE(bB, kb + 1); V_CONSUME(bA, kb);
            if (kb + 2 < 16) V_ISSUE(bA, kb + 2);
            else if (ti < 3) { e_cur = eidx[(tl + 8) * 128 + c16] & emask; X_ISSUE(token + 8); U_ISSUE(bA, e_cur, 0); }
            V_CONSUME(bB, kb + 1);
#endif
        }
        { constexpr float isv = 1.f / SV; float s2 = 0.f;
#pragma unroll
          for (int j = 0; j < 8; ++j) { xr[j] = xr[j] + (f32x4){o2[2 * j].x, o2[2 * j].y, o2[2 * j + 1].x, o2[2 * j + 1].y} * isv;
              s2 += (xr[j].x * xr[j].x + xr[j].y * xr[j].y) + (xr[j].z * xr[j].z + xr[j].w * xr[j].w); }
          const float rf = __builtin_amdgcn_rsqf(wave_sum(s2) * (1.f / DM) + EPS);
          const float* fi_ = fing; asm volatile("" : "+s"(fi_));
          const unsigned char* fp = (const unsigned char*)fi_; unsigned char* op = (unsigned char*)outp; const unsigned fo = 16u * (unsigned)lane;
          if (!dry || rf == 1.2345e30f)
#pragma unroll
          for (int j = 0; j < 8; ++j) __builtin_nontemporal_store(xr[j] * rf * *(const GAS f32x4*)(fp + (fo + 1024u * j)), (GAS f32x4*)(op + (xo + 1024u * j))); }
    }
#endif
#undef U_ISSUE
#undef X_ISSUE
#undef U_ACT
#undef U_CONSUME
#undef V_ISSUE
#undef V_CONSUME
    __syncthreads();
}

__global__ void __launch_bounds__(NWAVES * 64, 2) hybrid_fwd(Args args) {
    extern __shared__ __attribute__((aligned(16))) unsigned char lds[];
    Frame F;
    F.lds = (LAS unsigned char*)lds;
    F.MISC = (volatile LAS unsigned*)(F.lds + MISC_OFF);
    F.tid = threadIdx.x; F.lane = F.tid & 63; F.wave = __builtin_amdgcn_readfirstlane(F.tid >> 6); F.G = gridDim.x;
    for (int u = F.tid; u < (LDS_BYTES - LDSCTL_OFF) / 4; u += NWAVES * 64) ((LAS unsigned*)(F.lds + LDSCTL_OFF))[u] = 0u;
    __syncthreads();
    (void)args;
    XcdBarrier bar = xcd_barrier_post(F.ctl() + CW_BAR, F.MISC + 8);

#ifndef NO_P0
#ifdef PROBE_P0X2
    { int reps = 2; asm volatile("" : "+s"(reps)); for (int rep = 0; rep < reps; ++rep) p0_prologue(F); }
#else
    p0_prologue(F);
#endif
#endif
    xcd_barrier(bar);
#ifndef NO_P1
#ifdef PROBE_GX2
    { int reps = 2; asm volatile("" : "+s"(reps)); for (int rep = 0; rep < reps; ++rep) {
#else
    { { const int rep = 0, reps = 1;
#endif
      pg8::Gemm gm{F.HN(), F.WinT(), MTOK, NB16, DM}; pg8::StaticOrder S; S.init(MTOK, NB16, F.G, (int)blockIdx.x);
      EpiProj E{F.PROJ(), F.dtraw(), (rep + 1 < reps) ? nullptr : F.kmean()};
      pg8::gemm_phase<EpiProj, pg8::StaticOrder, PG8_ALIGN, PG8_SP2>(F.lds + RING_OFF, gm, S, E); } }
    { const int nun = (MTOK / 256) * (NB16 / 256), rem = nun % F.G;
      if (rem && (int)blockIdx.x >= rem) tables_convert(F, tab_split(F.G), TAB_ITEMS, (size_t)((int)blockIdx.x - rem) * (NWAVES * 64) + fresh_tid(), (size_t)(F.G - rem) * (NWAVES * 64)); }
    __syncthreads();
    {
      pg8::Gemm gm{(const pg8::bf16_t*)F.HN8(), (const pg8::bf16_t*)F.WinT8(), MTOK, F8_HI - F8_LO, DM / 2}; pg8::StaticOrder S; S.init(MTOK, F8_HI - F8_LO, F.G, (int)blockIdx.x);
      EpiProj8 E{F.PROJ()};
      pg8::gemm_phase<EpiProj8, pg8::StaticOrder, PG8_ALIGN, PG8_SP2, true>(F.lds + RING_OFF, gm, S, E); }
#endif
    xcd_barrier(bar);
#ifdef PROBE_P15X2
    conv_phase(F);
#endif
    conv_phase(F);
    xcd_barrier(bar);
#ifdef PROBE_P2X2
    { int reps = 2; asm volatile("" : "+s"(reps)); for (int rep = 0; rep < reps; ++rep) {
#else
    { { const int rep = 0, reps = 1;
#endif
    const bool doatom = rep + 1 == reps;
    for (;;) {
        if (F.tid == 0) F.MISC[0] = xb_add(F.ctl() + CW_Q2 + 64 * rep, 1u);
        __syncthreads();
        const int ui = (int)F.MISC[0];
        __syncthreads();
        if (ui >= 128 + 512) break;
#ifdef PROBE_P2_SSD
        if (ui < 128 || doatom)
#endif
#ifdef PROBE_P2_ATT
        if (ui >= 128 || doatom)
#endif
        {
        if (ui < 128) ssd_unit(F, ui >> 4, ui & 15, doatom);
        else { const int a = ui - 128; attn_unit(F, (a & 63) >> 3, a & 7, 7 - (a >> 6), doatom); }
        }
    } } }
    xcd_barrier(bar);
#ifndef NO_P3
#ifdef PROBE_GX2
    { int reps = 2; asm volatile("" : "+s"(reps)); for (int rep = 0; rep < reps; ++rep) {
#else
    { { const int rep = 0, reps = 1;
#endif
      pg8::Gemm gm{F.HN(), F.WoutT(), MTOK, DM, DM / 2}; pg8::StaticOrder S; S.init(MTOK, DM, F.G, (int)blockIdx.x);
      {
        const int t_ = fresh_tid(); const float* const sq = F.ssq();
#pragma unroll 1
        for (int ii = t_ >> 8; ii < 3; ii += 2) { pg8::Unit uu;
          if (S.next(ii, uu)) { const int row = uu.pm * 256 + (t_ & 255);
            const float q1 = __hip_atomic_load(sq + (size_t)row * 4 + 1, RLX_AGENT), q2 = __hip_atomic_load(sq + (size_t)row * 4 + 2, RLX_AGENT), q3 = __hip_atomic_load(sq + (size_t)row * 4 + 3, RLX_AGENT);
            const float sa = __builtin_amdgcn_rsqf(q1 * (1.f / 1024.f) + EPS), s0 = __builtin_amdgcn_rsqf(q2 * (1.f / 512.f) + EPS), s1 = __builtin_amdgcn_rsqf(q3 * (1.f / 512.f) + EPS);
            *(LAS f32x4*)(F.lds + SEGTAB_OFF + (ii * 256 + (t_ & 255)) * 16) = (f32x4){sa / s0 * (SS8 / SA8), s0 / s1, s1 * (1.f / (SS8 * SW8)), 0.f}; } }
        __syncthreads(); }
      EpiOut E{F.x(), F.X1B(), F.X18(), F.ssq(), rep + 1 == reps, (const LAS f32x4*)(F.lds + SEGTAB_OFF)};
      pg8::gemm_phase<EpiOut, pg8::StaticOrder, PG8_ALIGN, PG8_SP2, true>(F.lds + RING_OFF, gm, S, E); } }
#endif
    xcd_barrier(bar);
#ifndef NO_P4
#ifdef PROBE_GX2
    { int reps = 2; asm volatile("" : "+s"(reps)); for (int rep = 0; rep < reps; ++rep) {
#else
    { { const int rep = 0, reps = 1; (void)rep; (void)reps;
#endif
      pg8::Gemm gm{(const pg8::bf16_t*)F.X18(), F.WqT(), MTOK, DM, DM / 2}; pg8::StaticOrder S; S.init(MTOK, DM, F.G, (int)blockIdx.x);
      EpiQ E{F.QP(), F.ssq()};
      pg8::gemm_phase<EpiQ, pg8::StaticOrder, PG8_ALIGN, PG8_SP2, true>(F.lds + RING_OFF, gm, S, E); } }
#endif
    xcd_barrier(bar);
#ifndef NO_P5
#ifdef PROBE_P5X2
    { for (int u = blockIdx.x; u < MTOK / 32; u += F.G) peer_unit<true>(F, u);
      for (int u = blockIdx.x; u < MTOK / 32; u += F.G) peer_unit<false>(F, u); }
#else
    for (int u = blockIdx.x; u < MTOK / 32; u += F.G) peer_unit(F, u);
#endif
#endif
}

extern "C" void kernel_launch(void* const* d_in, const int* in_sizes, int n_in, void* d_out, int out_size, void* d_ws, size_t ws_size, hipStream_t stream) {
    static int grid = 0;
    if (grid == 0) {
        if (n_in != 18 || out_size != MTOK * DM || ws_size < WS_END) { fprintf(stderr, "kernel_launch: unexpected shapes (n_in %d, out %d, ws %zu)\n", n_in, out_size, ws_size); grid = -1; return; }
        int dev = 0, cus = 0, per_cu = 0;
        if (hipGetDevice(&dev) != hipSuccess || hipDeviceGetAttribute(&cus, hipDeviceAttributeMultiprocessorCount, dev) != hipSuccess) { grid = -1; return; }
        if (hipFuncSetAttribute((const void*)hybrid_fwd, hipFuncAttributeMaxDynamicSharedMemorySize, LDS_BYTES) != hipSuccess) { fprintf(stderr, "kernel_launch: hipFuncSetAttribute failed\n"); grid = -1; return; }
        if (hipOccupancyMaxActiveBlocksPerMultiprocessor(&per_cu, (const void*)hybrid_fwd, NWAVES * 64, LDS_BYTES) != hipSuccess || per_cu < 1)
            fprintf(stderr, "kernel_launch: note: occupancy query reports %d workgroups per CU\n", per_cu);
        (void)hipGetLastError();
        grid = cus;
    }
    if (grid < 0) return;
    if (hipMemsetAsync((char*)d_ws + WS_CTL, 0, CTL_ZERO_BYTES, stream) != hipSuccess) return;
    Args a{};
    for (int i = 0; i < 18; ++i) a.in[i] = (const float*)d_in[i];
    a.out = (float*)d_out; a.ws = (unsigned char*)d_ws;
    hipLaunchKernelGGL(hybrid_fwd, dim3(grid), dim3(NWAVES * 64), LDS_BYTES, stream, a);
}
```

```cpp
#include <hip/hip_runtime.h>
#include <cstdio>
#include <cstdint>
namespace pg8 {
#define PG8_LAS __attribute__((address_space(3)))
typedef unsigned short bf16_t;
typedef short bf16x8 __attribute__((ext_vector_type(8)));
typedef float f32x4 __attribute__((ext_vector_type(4)));
typedef unsigned u32x4 __attribute__((ext_vector_type(4)));
constexpr int BM = 256, BK = 64, HALF = 128, HTB = HALF * BK * 2  , STAGE_BYTES = 8 * HTB, NXCD = 8, WGM = 8;

__host__ __device__ __forceinline__ int lds_byte(int r, int c) { const int st = (r >> 4) * 2 + (c >> 5), rr = r & 15, cc = c & 31, ob = rr * 64 + cc * 2; return st * 1024 + (ob ^ (((ob >> 9) & 1) << 5)); }
__host__ __device__ __forceinline__ void stage_rc(int b, int& R, int& C) { const int st = b / 1024, sb = b % 1024, swz = sb ^ (((sb >> 9) & 1) << 5); R = (st >> 1) * 16 + swz / 64; C = (st & 1) * 32 + (swz % 64) / 2; }
__host__ __device__ __forceinline__ int perm32(int rho) { const int n = rho >> 4, i = rho & 15; return 8 * (i >> 2) + 4 * n + (i & 3); }

struct Unit { int pm, pn; };
struct Gemm { const bf16_t* A; const bf16_t* Bt; int M, N, K; };

struct StaticOrder {
    int nM, nN, nwg, G, c;
    __host__ __device__ void init(int M, int N, int G_, int c_) { nM = M / BM; nN = N / BM; nwg = nM * nN; G = G_; c = c_; }
    __host__ __device__ bool next(int i, Unit& u) const {
        const long L = (long)i * G + c; if (L >= nwg) return false;
        int wgid = (int)L; { const int q = nwg / NXCD, r = nwg % NXCD, xcd = wgid % NXCD, off = wgid / NXCD; wgid = (xcd < r ? xcd * (q + 1) : r * (q + 1) + (xcd - r) * q) + off; }
        const int nig = WGM * nN, gid = wgid / nig, fm = gid * WGM, gsz = (nM - fm) < WGM ? (nM - fm) : WGM;
        u.pm = fm + ((wgid % nig) % gsz); u.pn = (wgid % nig) / gsz; return true;
    }
    __device__ __forceinline__ void a_ready(const Unit&) const {}
    __device__ __forceinline__ void done(const Unit&) const {}
};

__device__ __forceinline__ unsigned cvt_pk_bf16(float lo, float hi) { unsigned r; asm volatile("v_cvt_pk_bf16_f32 %0, %1, %2" : "=v"(r) : "v"(lo), "v"(hi)); return r; }
typedef float f32x2 __attribute__((ext_vector_type(2)));
__device__ __forceinline__ f32x2 gelu_pk(f32x2 v) {
    const f32x2 av = __builtin_elementwise_abs(v), d = av * 0.2316418882f + 1.0f;
    f32x2 t; t.x = __builtin_amdgcn_rcpf(d.x); t.y = __builtin_amdgcn_rcpf(d.y);
    f32x2 q = t * 0.5307027145f + (-0.7265760135f); q = q * t + 0.7107068705f; q = q * t + (-0.142248368f); q = q * t + 0.127414796f; q = q * t;
    const f32x2 s = (v * v) * (-0.72134752044f);
    f32x2 e; e.x = __builtin_amdgcn_exp2f(s.x); e.y = __builtin_amdgcn_exp2f(s.y);
    const f32x2 m = v * (q * e), r = v - m;
    f32x2 o; o.x = v.x < 0.f ? m.x : r.x; o.y = v.y < 0.f ? m.y : r.y; return o;
}

template <int ACT  > struct EpiBf16 {
    static constexpr bool PERM = true, AFTER_DRAIN = false, SEG = false; static_assert(ACT == 0 || ACT == 1, "EpiBf16: ACT is 0 (none) or 1 (gelu_pk)");
    bf16_t* O; int ldc; const float* bias; int split_cols; size_t split_stride; float scale0;
    __device__ __forceinline__ void operator()(const f32x4 (&acc)[2][2][4][2], const Unit& u, int wr, int wc, int fr, int fq) const {
        const int row0 = u.pm * BM + wr * 64 + fr; int colt = u.pn * BM; bf16_t* base = O;
        float sc = 1.f; if (split_cols) { const int t = colt / split_cols; base += (size_t)t * split_stride; colt -= t * split_cols; if (t == 0) sc = scale0; }
        const int col0 = colt + wc * 32 + 8 * fq, bcol0 = u.pn * BM + wc * 32 + 8 * fq;
        f32x4 bv[2][2];
#pragma unroll
        for (int bj = 0; bj < 2; ++bj)
#pragma unroll
            for (int n = 0; n < 2; ++n) bv[bj][n] = bias ? *(const f32x4*)(bias + bcol0 + bj * HALF + 4 * n) : (f32x4){0.f, 0.f, 0.f, 0.f};
#pragma unroll
        for (int ai = 0; ai < 2; ++ai)
#pragma unroll
            for (int m = 0; m < 4; ++m) { bf16_t* rowp = base + (size_t)(row0 + ai * HALF + m * 16) * ldc + col0;
#pragma unroll
                for (int bj = 0; bj < 2; ++bj) { f32x4 v0 = acc[ai][bj][m][0] + bv[bj][0], v1 = acc[ai][bj][m][1] + bv[bj][1];
                    if (ACT == 1) { f32x2 a = gelu_pk((f32x2){v0[0], v0[1]}), b = gelu_pk((f32x2){v0[2], v0[3]}), c = gelu_pk((f32x2){v1[0], v1[1]}), d = gelu_pk((f32x2){v1[2], v1[3]});
                        v0 = (f32x4){a.x, a.y, b.x, b.y}; v1 = (f32x4){c.x, c.y, d.x, d.y}; }
                    v0 = v0 * sc; v1 = v1 * sc; u32x4 w; w.x = cvt_pk_bf16(v0[0], v0[1]); w.y = cvt_pk_bf16(v0[2], v0[3]); w.z = cvt_pk_bf16(v1[0], v1[1]); w.w = cvt_pk_bf16(v1[2], v1[3]);
                    *(u32x4*)(rowp + bj * HALF) = w; } }
    }
};
template <class Epi, class Sched, bool ALIGN_EPI = false, bool SP2 = false, bool F8 = false>
__device__ __forceinline__ void gemm_phase(PG8_LAS unsigned char* lds, const Gemm g, const Sched& S, const Epi& E) {
    int tid_ = threadIdx.x; asm volatile("" : "+v"(tid_));
    const int tid = tid_, wid = __builtin_amdgcn_readfirstlane(tid >> 6), lane = tid & 63, wr = wid >> 2, wc = wid & 3, fr = lane & 15, fq = lane >> 4;
    const int K = g.K, nt = K / BK;
    unsigned voffA[2], voffB[2];
#pragma unroll
    for (int i = 0; i < 2; ++i) { int R, C; stage_rc(tid * 16 + i * 8192, R, C); const int Rb = Epi::PERM ? ((R & ~31) + perm32(R & 31)) : R;
        voffA[i] = (unsigned)(R * K + C) * 2u; voffB[i] = (unsigned)(Rb * K + C) * 2u; }
    const size_t kstep = (size_t)(BK * 2);
    const size_t hstep = (size_t)HALF * K * 2;
    const size_t tstep = 2 * hstep;
    const unsigned ldsw = (unsigned)wid * 1024u;
    const int aoff = lds_byte(wr * 64 + fr, fq * 8), boff = lds_byte(wc * 32 + fr, fq * 8);
#define PG8_SA(b, h) (((b) * 2 + (h)) * HTB)
#define PG8_SB(b, h) ((4 + (b) * 2 + (h)) * HTB)
#define PG8_STAGE(bufoff, gbase, voff) do { _Pragma("unroll") for (int _i = 0; _i < 2; ++_i) \
        __builtin_amdgcn_global_load_lds((const unsigned*)((const char*)(gbase) + (voff)[_i]), (PG8_LAS unsigned*)(lds + (bufoff) + ldsw + _i * 8192), 16, 0, 0); } while (0)
#define PG8_LDA(dst, b, h) do { _Pragma("unroll") for (int m = 0; m < 4; ++m) _Pragma("unroll") for (int k = 0; k < 2; ++k) dst[m][k] = *(const PG8_LAS bf16x8*)(lds + PG8_SA(b, h) + aoff + m * 2048 + k * 1024); } while (0)
#define PG8_LDB(dst, b, h) do { _Pragma("unroll") for (int n = 0; n < 2; ++n) _Pragma("unroll") for (int k = 0; k < 2; ++k) dst[n][k] = *(const PG8_LAS bf16x8*)(lds + PG8_SB(b, h) + boff + n * 2048 + k * 1024); } while (0)
#define PG8_MMA(ai, bj, At, Bt) do { __builtin_amdgcn_s_setprio(1); _Pragma("unroll") for (int m = 0; m < 4; ++m) _Pragma("unroll") for (int n = 0; n < 2; ++n) { \
        if constexpr (F8) { typedef int v8i_ __attribute__((ext_vector_type(8))); typedef int v4i_ __attribute__((ext_vector_type(4))); \
            const v4i_ b0_ = __builtin_bit_cast(v4i_, Bt[n][0]), b1_ = __builtin_bit_cast(v4i_, Bt[n][1]), a0_ = __builtin_bit_cast(v4i_, At[m][0]), a1_ = __builtin_bit_cast(v4i_, At[m][1]); \
            const v8i_ bb_ = {b0_.x, b0_.y, b0_.z, b0_.w, b1_.x, b1_.y, b1_.z, b1_.w}, aa_ = {a0_.x, a0_.y, a0_.z, a0_.w, a1_.x, a1_.y, a1_.z, a1_.w}; \
            asm volatile("v_mfma_scale_f32_16x16x128_f8f6f4 %0, %1, %2, %0, %3, %3 op_sel_hi:[0,0,0]" : "+v"(acc[ai][bj][m][n]) : "v"(bb_), "v"(aa_), "v"(f8one)); } \
        else { _Pragma("unroll") for (int k = 0; k < 2; ++k) acc[ai][bj][m][n] = __builtin_amdgcn_mfma_f32_16x16x32_bf16(Bt[n][k], At[m][k], acc[ai][bj][m][n], 0, 0, 0); } } \
        __builtin_amdgcn_s_setprio(0); } while (0)
#define PG8_WAIT_V(n) asm volatile("s_waitcnt vmcnt(" #n ")" ::: "memory")
#define PG8_WAIT_L(n) asm volatile("s_waitcnt lgkmcnt(" #n ")" ::: "memory")
#define PG8_BAR __builtin_amdgcn_s_barrier()
#define PG8_SCHED __builtin_amdgcn_sched_barrier(0)
    Unit cur, nxt; int ui = 0;
    if (!S.next(0, cur)) return;
    f32x4 acc[2][2][4][2];
    const int f8one = 0x7f7f7f7f;
#pragma unroll
    for (int a = 0; a < 2; ++a)
#pragma unroll
        for (int b = 0; b < 2; ++b)
#pragma unroll
            for (int m = 0; m < 4; ++m)
#pragma unroll
                for (int n = 0; n < 2; ++n) acc[a][b][m][n] = (f32x4){0.f, 0.f, 0.f, 0.f};
    bf16x8 At[4][2], B0[2][2], B1[2][2];
    const char* cA = (const char*)g.A + (size_t)cur.pm * tstep; const char* cB = (const char*)g.Bt + (size_t)cur.pn * tstep;
    S.a_ready(cur);
    float segr[16];
    if constexpr (Epi::SEG) E.seg_load(ui, wr, fr, segr);
    if constexpr (SP2) {
        PG8_STAGE(PG8_SB(0, 0), cB, voffB); PG8_STAGE(PG8_SB(0, 1), cB + hstep, voffB); PG8_STAGE(PG8_SA(0, 0), cA, voffA); PG8_STAGE(PG8_SA(0, 1), cA + hstep, voffA);
        if (wr == 1) PG8_BAR;
        PG8_WAIT_V(2); PG8_BAR;
        PG8_STAGE(PG8_SB(1, 0), cB + kstep, voffB); PG8_STAGE(PG8_SA(1, 0), cA + kstep, voffA); PG8_STAGE(PG8_SB(1, 1), cB + hstep + kstep, voffB);
        PG8_WAIT_V(6); PG8_BAR;
    } else {
        PG8_STAGE(PG8_SB(0, 0), cB, voffB); PG8_STAGE(PG8_SA(0, 0), cA, voffA); PG8_STAGE(PG8_SB(0, 1), cB + hstep, voffB); PG8_STAGE(PG8_SA(0, 1), cA + hstep, voffA);
        if (wr == 1) PG8_BAR;
        PG8_WAIT_V(4); PG8_BAR;
        PG8_STAGE(PG8_SB(1, 0), cB + kstep, voffB); PG8_STAGE(PG8_SA(1, 0), cA + kstep, voffA); PG8_STAGE(PG8_SB(1, 1), cB + hstep + kstep, voffB);
        PG8_WAIT_V(6); PG8_BAR;
    }
    for (;;) {
        const bool has_next = S.next(ui + 1, nxt);
        const char* nA = has_next ? (const char*)g.A + (size_t)nxt.pm * tstep : cA; const char* nB = has_next ? (const char*)g.Bt + (size_t)nxt.pn * tstep : cB;
        int t = 0;
#pragma unroll 1
        for (int sgi = 0; sgi < (Epi::SEG ? 3 : 1); ++sgi) {
        int tend = nt; if constexpr (Epi::SEG) tend = (sgi == 0) ? Epi::SEG_T1 : ((sgi == 1) ? Epi::SEG_T2 : nt);
        for (; t < tend; t += 2) {
            const bool last = (t == nt - 2);
            const char* a1 = cA + (size_t)(t + 1) * kstep;
            const char* a2 = last ? nA : cA + (size_t)(t + 2) * kstep; const char* b2 = last ? nB : cB + (size_t)(t + 2) * kstep;
            const char* a3 = a2 + kstep; const char* b3 = b2 + kstep;
            if (last && has_next) S.a_ready(nxt);
            if constexpr (SP2) {
            PG8_LDB(B0, 0, 0); PG8_LDB(B1, 0, 1); PG8_SCHED; PG8_LDA(At, 0, 0); PG8_STAGE(PG8_SA(1, 1), a1 + hstep, voffA);
            PG8_WAIT_V(8); PG8_WAIT_L(0); PG8_BAR; PG8_MMA(0, 0, At, B0); PG8_MMA(0, 1, At, B1); PG8_BAR; PG8_SCHED;
            PG8_LDA(At, 0, 1); PG8_STAGE(PG8_SB(0, 0), b2, voffB); PG8_STAGE(PG8_SB(0, 1), b2 + hstep, voffB); PG8_STAGE(PG8_SA(0, 0), a2, voffA);
            PG8_WAIT_V(8); PG8_WAIT_L(0); PG8_BAR; PG8_MMA(1, 0, At, B0); PG8_MMA(1, 1, At, B1); PG8_BAR; PG8_SCHED;
            PG8_LDB(B0, 1, 0); PG8_LDB(B1, 1, 1); PG8_SCHED; PG8_LDA(At, 1, 0); PG8_STAGE(PG8_SA(0, 1), a2 + hstep, voffA);
            PG8_WAIT_V(8); PG8_WAIT_L(0); PG8_BAR; PG8_MMA(0, 0, At, B0); PG8_MMA(0, 1, At, B1); PG8_BAR; PG8_SCHED;
            PG8_LDA(At, 1, 1); PG8_STAGE(PG8_SB(1, 0), b3, voffB); PG8_STAGE(PG8_SB(1, 1), b3 + hstep, voffB); PG8_STAGE(PG8_SA(1, 0), a3, voffA);
            PG8_WAIT_V(8); PG8_WAIT_L(0); PG8_BAR; PG8_MMA(1, 0, At, B0); PG8_MMA(1, 1, At, B1); PG8_BAR; PG8_SCHED;
            } else {
            PG8_LDB(B0, 0, 0); PG8_SCHED; PG8_LDA(At, 0, 0); PG8_STAGE(PG8_SA(1, 1), a1 + hstep, voffA);
            PG8_WAIT_L(8); PG8_BAR; PG8_WAIT_L(0); PG8_MMA(0, 0, At, B0); PG8_BAR; PG8_SCHED;
            PG8_LDB(B1, 0, 1); PG8_STAGE(PG8_SB(0, 0), b2, voffB);
            PG8_BAR; PG8_WAIT_L(0); PG8_MMA(0, 1, At, B1); PG8_BAR;
            PG8_LDA(At, 0, 1); PG8_STAGE(PG8_SA(0, 0), a2, voffA);
            PG8_BAR; PG8_WAIT_L(0); PG8_MMA(1, 0, At, B0); PG8_BAR; PG8_SCHED;
            PG8_STAGE(PG8_SB(0, 1), b2 + hstep, voffB);
            PG8_WAIT_V(6); PG8_BAR; PG8_MMA(1, 1, At, B1); PG8_BAR;
            PG8_LDB(B0, 1, 0); PG8_SCHED; PG8_LDA(At, 1, 0); PG8_STAGE(PG8_SA(0, 1), a2 + hstep, voffA);
            PG8_WAIT_L(8); PG8_BAR; PG8_WAIT_L(0); PG8_MMA(0, 0, At, B0); PG8_BAR; PG8_SCHED;
            PG8_LDB(B1, 1, 1); PG8_STAGE(PG8_SB(1, 0), b3, voffB);
            PG8_BAR; PG8_WAIT_L(0); PG8_MMA(0, 1, At, B1); PG8_BAR;
            PG8_LDA(At, 1, 1); PG8_STAGE(PG8_SA(1, 0), a3, voffA);
            PG8_BAR; PG8_WAIT_L(0); PG8_MMA(1, 0, At, B0); PG8_BAR; PG8_SCHED;
            PG8_STAGE(PG8_SB(1, 1), b3 + hstep, voffB);
            PG8_WAIT_V(6); PG8_BAR; PG8_MMA(1, 1, At, B1); PG8_BAR;
            }
        }
        if constexpr (Epi::SEG) E.seg_apply(acc, segr, sgi);
        }
        if constexpr (ALIGN_EPI) { if (wr == 0) PG8_BAR; }
        if constexpr (!Epi::AFTER_DRAIN) { if constexpr (Epi::SEG) E(acc, cur, wr, wc, fr, fq, ui); else E(acc, cur, wr, wc, fr, fq); S.done(cur); }
        if (!has_next) break;
#pragma unroll
        for (int a = 0; a < 2; ++a)
#pragma unroll
            for (int b = 0; b < 2; ++b)
#pragma unroll
                for (int m = 0; m < 4; ++m)
#pragma unroll
                    for (int n = 0; n < 2; ++n) acc[a][b][m][n] = (f32x4){0.f, 0.f, 0.f, 0.f};
        cur = nxt; cA = nA; cB = nB; ++ui;
        if constexpr (Epi::SEG) E.seg_load(ui, wr, fr, segr);
        if constexpr (ALIGN_EPI) { if (wr == 1) PG8_BAR; }
    }
    PG8_WAIT_V(0);
    if constexpr (!ALIGN_EPI) { if (wr == 0) PG8_BAR; }
    PG8_BAR;
    if constexpr (Epi::AFTER_DRAIN) { E.fused(acc, cur, wr, wc, fr, fq, lds, wid, lane); S.done(cur); }
#undef PG8_SA
#undef PG8_SB
#undef PG8_STAGE
#undef PG8_LDA
#undef PG8_LDB
#undef PG8_MMA
#undef PG8_WAIT_V
#undef PG8_WAIT_L
#undef PG8_BAR
#undef PG8_SCHED
}
}
#ifndef PG8_SP2
#define PG8_SP2 true
#endif
#ifndef PG8_ALIGN
#define PG8_ALIGN true
#endif

constexpr int BATCH = 8, SEQ = 2048, DM = 2048, MTOK = BATCH * SEQ;
constexpr int ATT_W = 1024, ATT_H = 8, ATT_HD = 128, MOBA_BLK = 256, NBLK = SEQ / MOBA_BLK;
constexpr int SSM_W = 1024, SSM_H = 16, SSM_P = 64, SSM_N = 128, SSM_L = 128, SSM_NC = SEQ / SSM_L, CONV_CH = 1536;
constexpr int IN_PROJ = 5648, NPROJ = 5632  , NPAD = 5888  ;
constexpr int F8_LO = 2048, F8_HI = 3072, NB16 = NPAD - (F8_HI - F8_LO)  ;
constexpr float SH8 = 16.f;
constexpr int COL_Q = 0, COL_K = 1024, COL_V = 2048, COL_Z = 3072, COL_XBC = 4096;
constexpr int PEER_H = 8, PEER_NK = 128, PEER_K = 16, PEER_HK = 128;
constexpr float EPS = 1e-6f;
constexpr float SU = 64.f, SV = 4.f, SH = 16.f, SLO = 16.f;
constexpr float SX8 = 16.f, SW8 = 1024.f;
constexpr float SA8 = 32.f, SS8 = 8.f;
constexpr float SH4 = 1.5f, SLO4 = 4.f;
constexpr int ROWB = DM / 2;

constexpr size_t MiB = 1u << 20;
constexpr size_t WS_CTL = 0, CTL_ZERO_BYTES = 1 * MiB;
constexpr size_t WS_DT = 1 * MiB;
constexpr size_t WS_SK = 2 * MiB;
constexpr size_t WS_WIN = 4 * MiB;
constexpr size_t WS_WIN8 = 24 * MiB;
constexpr size_t WS_HN8 = 396 * MiB;
constexpr size_t WS_WOUT = 28 * MiB;
constexpr size_t WS_WQ = 36 * MiB;
constexpr size_t WS_HN = 44 * MiB;
constexpr size_t WS_PROJ = 108 * MiB;
constexpr size_t WS_X1B = WS_PROJ, WS_QP = WS_PROJ + 64 * MiB;
constexpr size_t WS_U8 = 284 * MiB, WS_V8 = 316 * MiB;
constexpr size_t WS_XBC = 348 * MiB;
constexpr size_t WS_DT2 = 3 * MiB;
constexpr size_t WS_X18 = 396 * MiB;
constexpr size_t WS_END = 428 * MiB;
constexpr int CW_BAR = 4096;
constexpr int CW_Q2 = 8192;
constexpr int CW_KMEAN = 32768;
constexpr int CW_SSQ = 131072;
static_assert((CW_SSQ + MTOK * 4) * 4 <= (int)CTL_ZERO_BYTES, "CTL words inside the memset region");

constexpr int RING_OFF = 0, RING_BYTES = 131072;
constexpr int LDSCTL_OFF = RING_BYTES, MISC_OFF = LDSCTL_OFF + 320;
constexpr int SEGTAB_OFF = LDSCTL_OFF + 1024;  static_assert(LDSCTL_OFF + 1024 + 3 * 256 * 16 <= 147456, "segment table inside the LDS allocation");
constexpr int LDS_BYTES = 147456;
constexpr int NWAVES = 8;

#define GAS __attribute__((address_space(1)))
#define LAS __attribute__((address_space(3)))
typedef unsigned short bf16;
typedef unsigned v4u __attribute__((ext_vector_type(4)));
typedef unsigned v2u __attribute__((ext_vector_type(2)));
typedef float f32x4 __attribute__((ext_vector_type(4)));
typedef float f32x2 __attribute__((ext_vector_type(2)));
typedef short bf16x8 __attribute__((ext_vector_type(8)));
typedef short s16x4 __attribute__((ext_vector_type(4)));
typedef GAS unsigned gu32;
#define RLX_AGENT __ATOMIC_RELAXED, __HIP_MEMORY_SCOPE_AGENT
#define LDS_WAIT() asm volatile("s_waitcnt lgkmcnt(0)" ::: "memory")
#define VM_WAIT() asm volatile("s_waitcnt vmcnt(0)" ::: "memory")
__device__ __forceinline__ unsigned f2bf(float f) { unsigned u = __builtin_bit_cast(unsigned, f); return (u + 0x7fffu + ((u >> 16) & 1u)) >> 16; }
typedef __bf16 bf16v2 __attribute__((ext_vector_type(2)));
__device__ __forceinline__ unsigned pk2(float lo, float hi) { bf16v2 v; v.x = (__bf16)lo; v.y = (__bf16)hi; return __builtin_bit_cast(unsigned, v); }
__device__ __forceinline__ float bflo(unsigned w) { return __builtin_bit_cast(float, w << 16); }
__device__ __forceinline__ float bfhi(unsigned w) { return __builtin_bit_cast(float, w & 0xffff0000u); }
__device__ __forceinline__ float wave_sum(float v) {
#pragma unroll
    for (int o = 1; o < 64; o <<= 1) v += __shfl_xor(v, o);
    return v;
}
__device__ __forceinline__ float silu_f(float x) { return x * __builtin_amdgcn_rcpf(1.f + __expf(-x)); }

#define XB_TMO      128
#define XB_XCNT(j)  (256  + 64 * (j))
#define XB_XSUB(j)  (1280 + 64 * (j))
#define XB_XGEN(j)  (2304 + 64 * (j))
#define XB_TOP      3328
#define XB_TOPGEN   3392
#define XCD_BAR_WORDS 3456
#define XB_SPIN_CAP (1u << 18)

__device__ __forceinline__ unsigned xb_ld(unsigned* p)              { return __hip_atomic_load(p, __ATOMIC_RELAXED, __HIP_MEMORY_SCOPE_AGENT); }
__device__ __forceinline__ unsigned xb_add(unsigned* p, unsigned v) { return __hip_atomic_fetch_add(p, v, __ATOMIC_RELAXED, __HIP_MEMORY_SCOPE_AGENT); }
__device__ __forceinline__ unsigned xb_xcc_id() { return (unsigned)__builtin_amdgcn_s_getreg((3 << 11) | 20) & 0xFu; }
#define XB_SPIN(cond, bar) do { unsigned _sp = 0; while (cond) { __builtin_amdgcn_s_sleep(1); \
    if ((++_sp & 255u) == 0u) { if (xb_ld(&(bar)[XB_TMO])) break; if (_sp > XB_SPIN_CAP) { atomicAdd(&(bar)[XB_TMO], 1u); break; } } } } while (0)

struct XcdBarrier {
    unsigned* bar; unsigned x;
    volatile LAS unsigned* st;
};
__device__ __forceinline__ XcdBarrier xcd_barrier_post(unsigned* bar, volatile LAS unsigned* st) {
    XcdBarrier b; b.bar = bar; b.x = xb_xcc_id(); b.st = st;
    if (threadIdx.x == 0) (void)xb_add(&bar[XB_XCNT(b.x)], 1u);
    return b;
}
__device__ __forceinline__ void xcd_barrier_complete(unsigned* bar, unsigned x, unsigned& nloc, unsigned& nx) {
    const unsigned G = gridDim.x * gridDim.y * gridDim.z;
    unsigned sum, cnt, mine, sp = 0u;
    for (;;) {
        sum = 0u; cnt = 0u; mine = 0u;
#pragma unroll
        for (unsigned j = 0; j < 16; ++j) { const unsigned c = xb_ld(&bar[XB_XCNT(j)]); sum += c; cnt += (c > 0u) ? 1u : 0u; mine = (j == x) ? c : mine; }
        if (sum == G) break;
        __builtin_amdgcn_s_sleep(1);
        if ((++sp & 255u) == 0u) { if (xb_ld(&bar[XB_TMO])) break; if (sp > XB_SPIN_CAP) { atomicAdd(&bar[XB_TMO], 1u); break; } }
    }
    nloc = mine > 0u ? mine : 1u; nx = cnt > 0u ? cnt : 1u;
}
__device__ __forceinline__ void xcd_barrier(const XcdBarrier& b) {
    asm volatile("s_waitcnt vmcnt(0)" ::: "memory");
    __syncthreads();
    if (threadIdx.x == 0) {
        unsigned* bar = b.bar;
        __builtin_amdgcn_s_waitcnt(0);
        unsigned nloc = b.st[0], nx = b.st[1];
        if (nloc == 0u) { xcd_barrier_complete(bar, b.x, nloc, nx); b.st[0] = nloc; b.st[1] = nx; }
        const unsigned old = xb_add(&bar[XB_XSUB(b.x)], 1u);
        const unsigned gen = old / nloc;
        if (old + 1u == (gen + 1u) * nloc) {
            __builtin_amdgcn_fence(__ATOMIC_RELEASE, "agent");
            asm volatile("s_waitcnt vmcnt(0)" ::: "memory");
            const unsigned og = xb_add(&bar[XB_TOP], 1u);
            const unsigned tg = og / nx;
            if (og + 1u == (tg + 1u) * nx) xb_add(&bar[XB_TOPGEN], 1u);
            else XB_SPIN(xb_ld(&bar[XB_TOPGEN]) == tg, bar);
            __builtin_amdgcn_fence(__ATOMIC_ACQUIRE, "agent");
            xb_add(&bar[XB_XGEN(b.x)], 1u);
            asm volatile("s_waitcnt vmcnt(0)" ::: "memory");
        } else {
            XB_SPIN(xb_ld(&bar[XB_XGEN(b.x)]) == gen, bar);
            __builtin_amdgcn_fence(__ATOMIC_ACQUIRE, "agent");
            asm volatile("s_waitcnt vmcnt(0)" ::: "memory");
        }
    }
    __syncthreads();
}

#define CAS __attribute__((address_space(4)))
struct Args { const float* in[18]; float* out; unsigned char* ws; };
__device__ __forceinline__ const CAS unsigned char* kargs() { const CAS unsigned char* p = (const CAS unsigned char*)__builtin_amdgcn_kernarg_segment_ptr(); asm volatile("" : "+s"(p)); return p; }
__device__ __forceinline__ const float* kin(int i) { return *(const float* const CAS*)(kargs() + 8 * i); }
__device__ __forceinline__ float* kout() { return *(float* const CAS*)(kargs() + 8 * 18); }
__device__ __forceinline__ unsigned char* kws() { return *(unsigned char* const CAS*)(kargs() + 8 * 19); }
__device__ __forceinline__ int fresh_tid() { int t = threadIdx.x; asm volatile("" : "+v"(t)); return t; }
struct Frame {
    LAS unsigned char* lds;
    volatile LAS unsigned* MISC;
    int tid, lane, wave, G;
    __device__ __forceinline__ const float* x() const { return kin(0); }
    __device__ __forceinline__ const float* attn_norm() const { return kin(1); }
    __device__ __forceinline__ const float* w_in() const { return kin(2); }
    __device__ __forceinline__ const float* conv_w() const { return kin(3); }
    __device__ __forceinline__ const float* conv_b() const { return kin(4); }
    __device__ __forceinline__ const float* dt_bias() const { return kin(5); }
    __device__ __forceinline__ const float* a_log() const { return kin(6); }
    __device__ __forceinline__ const float* d_skip() const { return kin(7); }
    __device__ __forceinline__ const float* rel_bias() const { return kin(8); }
    __device__ __forceinline__ const float* attn_out_norm() const { return kin(9); }
    __device__ __forceinline__ const float* ssm_out_norm() const { return kin(10); }
    __device__ __forceinline__ const float* w_out() const { return kin(11); }
    __device__ __forceinline__ const float* ffn_norm() const { return kin(12); }
    __device__ __forceinline__ const float* peer_wq() const { return kin(13); }
    __device__ __forceinline__ const float* peer_sk() const { return kin(14); }
    __device__ __forceinline__ const float* peer_u() const { return kin(15); }
    __device__ __forceinline__ const float* peer_v() const { return kin(16); }
    __device__ __forceinline__ const float* final_norm() const { return kin(17); }
    __device__ __forceinline__ float* out() const { return kout(); }
    __device__ __forceinline__ unsigned* ctl() const { return (unsigned*)(kws() + WS_CTL); }
    __device__ __forceinline__ float* dtraw() const { return (float*)(kws() + WS_DT); }
    __device__ __forceinline__ bf16* SK() const { return (bf16*)(kws() + WS_SK); }
    __device__ __forceinline__ bf16* WinT() const { return (bf16*)(kws() + WS_WIN); }
    __device__ __forceinline__ bf16* WoutT() const { return (bf16*)(kws() + WS_WOUT); }
    __device__ __forceinline__ bf16* WqT() const { return (bf16*)(kws() + WS_WQ); }
    __device__ __forceinline__ bf16* HN() const { return (bf16*)(kws() + WS_HN); }
    __device__ __forceinline__ bf16* PROJ() const { return (bf16*)(kws() + WS_PROJ); }
    __device__ __forceinline__ bf16* X1B() const { return (bf16*)(kws() + WS_X1B); }
    __device__ __forceinline__ bf16* QP() const { return (bf16*)(kws() + WS_QP); }
    __device__ __forceinline__ unsigned char* U8() const { return kws() + WS_U8; }
    __device__ __forceinline__ unsigned char* V8() const { return kws() + WS_V8; }
    __device__ __forceinline__ unsigned char* X18() const { return kws() + WS_X18; }
    __device__ __forceinline__ unsigned char* HN8() const { return kws() + WS_HN8; }
    __device__ __forceinline__ unsigned char* WinT8() const { return kws() + WS_WIN8; }
    __device__ __forceinline__ bf16* XBC() const { return (bf16*)(kws() + WS_XBC); }
    __device__ __forceinline__ float* DT2() const { return (float*)(kws() + WS_DT2); }
    __device__ __forceinline__ float* kmean() const { return (float*)(kws() + WS_CTL) + CW_KMEAN; }
    __device__ __forceinline__ float* ssq() const { return (float*)(kws() + WS_CTL) + CW_SSQ; }
};

__device__ __forceinline__ float clampf(float v, float lim);
__device__ __forceinline__ void p0_transpose_item(const float* W, int K, int N, bf16* WT, const float* gain, LAS float* scr, int item, int lane, const float f8scale = 0.f, const int nshift = 0) {
    const int nblk = (N + 31) / 32, kb = item / nblk, nb = item % nblk, k0 = 64 * kb, n0 = 32 * nb;
    const int kr = lane >> 3, nc = (lane & 7) * 4; const bool ok = (n0 + nc) < N;
    f32x4 v[8]; float gk[8];
#pragma unroll
    for (int i = 0; i < 8; ++i) { const int kk = 8 * i + kr; v[i] = ok ? *(const GAS f32x4*)(W + (size_t)(k0 + kk) * N + n0 + nc) : (f32x4){0.f, 0.f, 0.f, 0.f}; gk[i] = gain ? gain[k0 + kk] : 1.f; }
#pragma unroll
    for (int i = 0; i < 8; ++i) { const int kk = 8 * i + kr; LAS float* d = scr + kk * 33 + nc; d[0] = v[i].x * gk[i]; d[1] = v[i].y * gk[i]; d[2] = v[i].z * gk[i]; d[3] = v[i].w * gk[i]; }
    LDS_WAIT(); asm volatile("" ::: "memory");
    const int c = lane & 7;
#pragma unroll
    for (int j = 0; j < 4; ++j) { const int n = (lane >> 3) + 8 * j; const LAS float* s = scr + (8 * c) * 33 + n;
        v4u o; o.x = pk2(s[0 * 33], s[1 * 33]); o.y = pk2(s[2 * 33], s[3 * 33]); o.z = pk2(s[4 * 33], s[5 * 33]); o.w = pk2(s[6 * 33], s[7 * 33]);
        if (f8scale == 0.f) *(GAS v4u*)(WT + (size_t)(n0 + n - nshift) * K + k0 + 8 * c) = o;
        else { v2u o8; int w_;
            w_ = __builtin_amdgcn_cvt_pk_fp8_f32(clampf(s[0 * 33] * f8scale, 448.f), clampf(s[1 * 33] * f8scale, 448.f), 0, false); w_ = __builtin_amdgcn_cvt_pk_fp8_f32(clampf(s[2 * 33] * f8scale, 448.f), clampf(s[3 * 33] * f8scale, 448.f), w_, true); o8.x = (unsigned)w_;
            w_ = __builtin_amdgcn_cvt_pk_fp8_f32(clampf(s[4 * 33] * f8scale, 448.f), clampf(s[5 * 33] * f8scale, 448.f), 0, false); w_ = __builtin_amdgcn_cvt_pk_fp8_f32(clampf(s[6 * 33] * f8scale, 448.f), clampf(s[7 * 33] * f8scale, 448.f), w_, true); o8.y = (unsigned)w_;
            *(GAS v2u*)((unsigned char*)WT + (size_t)(n0 + n - nshift) * K + k0 + 8 * c) = o8; } }
    LDS_WAIT(); asm volatile("" ::: "memory");
}
__device__ __forceinline__ unsigned pk4_fp8(float a, float b, float c, float d) { int w = __builtin_amdgcn_cvt_pk_fp8_f32(clampf(a, 448.f), clampf(b, 448.f), 0, false); w = __builtin_amdgcn_cvt_pk_fp8_f32(clampf(c, 448.f), clampf(d, 448.f), w, true); return (unsigned)w; }
__device__ __forceinline__ void rms_2rows_to_bf16(const float* x0, const float* x1, const float* gain, bf16* o0, bf16* o1, unsigned char* q0, unsigned char* q1, int lane) {
    const GAS f32x4* xr0 = (const GAS f32x4*)x0 + lane; const GAS f32x4* xr1 = (const GAS f32x4*)x1 + lane; const GAS f32x4* gr = (const GAS f32x4*)gain + lane;
    f32x4 v[8], u[8]; float s = 0.f, t = 0.f;
#pragma unroll
    for (int j = 0; j < 8; ++j) { v[j] = xr0[64 * j]; u[j] = xr1[64 * j]; }
#pragma unroll
    for (int j = 0; j < 8; ++j) { s += (v[j].x * v[j].x + v[j].y * v[j].y) + (v[j].z * v[j].z + v[j].w * v[j].w); t += (u[j].x * u[j].x + u[j].y * u[j].y) + (u[j].z * u[j].z + u[j].w * u[j].w); }
    const float rs = __builtin_amdgcn_rsqf(wave_sum(s) * (1.f / DM) + EPS), rt = __builtin_amdgcn_rsqf(wave_sum(t) * (1.f / DM) + EPS);
    GAS v2u* p0 = (GAS v2u*)o0 + lane; GAS v2u* p1 = (GAS v2u*)o1 + lane; GAS unsigned* r0 = (GAS unsigned*)q0 + lane; GAS unsigned* r1 = (GAS unsigned*)q1 + lane;
#pragma unroll
    for (int j = 0; j < 8; ++j) { const f32x4 g = gr[64 * j]; v2u a, b;
        const f32x4 h0 = v[j] * g * rs, h1 = u[j] * g * rt;
        a.x = pk2(h0.x, h0.y); a.y = pk2(h0.z, h0.w); p0[64 * j] = a; r0[64 * j] = pk4_fp8(h0.x * SH8, h0.y * SH8, h0.z * SH8, h0.w * SH8);
        b.x = pk2(h1.x, h1.y); b.y = pk2(h1.z, h1.w); p1[64 * j] = b; r1[64 * j] = pk4_fp8(h1.x * SH8, h1.y * SH8, h1.z * SH8, h1.w * SH8); }
}
#ifdef PROBE_FP4EMU
__device__ __forceinline__ float fp4grid(float y) { const float a = fabsf(y); float r;
    if (a <= 2.f) r = rintf(a * 2.f) * 0.5f; else if (a <= 4.f) r = rintf(a); else r = (a < 5.f) ? 4.f : 6.f;
    return copysignf(r, y); }
__device__ __forceinline__ float clampf(float v, float lim) { if (lim == 448.5f) return fp4grid(v * (1.f / 16.f)) * 16.f; return fminf(fmaxf(v, -lim), lim); }
#else
__device__ __forceinline__ float clampf(float v, float lim) { return fminf(fmaxf(v, -lim), lim); }
#endif
template <int TAB = 0> __device__ __forceinline__ v4u cvt16_fp8(const f32x4 a, const f32x4 b, const f32x4 c, const f32x4 d, float sc) {
    v4u o; int w; constexpr float LIM = TAB ? 448.5f : 448.f;
    w = __builtin_amdgcn_cvt_pk_fp8_f32(clampf(a.x * sc, LIM), clampf(a.y * sc, LIM), 0, false); w = __builtin_amdgcn_cvt_pk_fp8_f32(clampf(a.z * sc, LIM), clampf(a.w * sc, LIM), w, true); o.x = (unsigned)w;
    w = __builtin_amdgcn_cvt_pk_fp8_f32(clampf(b.x * sc, LIM), clampf(b.y * sc, LIM), 0, false); w = __builtin_amdgcn_cvt_pk_fp8_f32(clampf(b.z * sc, LIM), clampf(b.w * sc, LIM), w, true); o.y = (unsigned)w;
    w = __builtin_amdgcn_cvt_pk_fp8_f32(clampf(c.x * sc, LIM), clampf(c.y * sc, LIM), 0, false); w = __builtin_amdgcn_cvt_pk_fp8_f32(clampf(c.z * sc, LIM), clampf(c.w * sc, LIM), w, true); o.z = (unsigned)w;
    w = __builtin_amdgcn_cvt_pk_fp8_f32(clampf(d.x * sc, LIM), clampf(d.y * sc, LIM), 0, false); w = __builtin_amdgcn_cvt_pk_fp8_f32(clampf(d.z * sc, LIM), clampf(d.w * sc, LIM), w, true); o.w = (unsigned)w;
    return o;
}
__device__ __forceinline__ void tables_convert(Frame& F, size_t lo, size_t hi, size_t tix, size_t ntx) {
      const GAS f32x4* su = (const GAS f32x4*)F.peer_u(); const GAS f32x4* sv = (const GAS f32x4*)F.peer_v(); GAS v4u* du = (GAS v4u*)F.U8(); GAS v4u* dv = (GAS v4u*)F.V8();
#pragma unroll 1
      for (int tab = 0; tab < 2; ++tab) { const GAS f32x4* src = tab ? sv : su; GAS v4u* dst = tab ? dv : du; const float sc = tab ? SV : SU;
        f32x4 nx[8]; const size_t i0 = lo + tix;
        if (i0 < hi) { const GAS f32x4* p = src + (i0 >> 6) * 512 + (i0 & 63);
#pragma unroll
            for (int j = 0; j < 8; ++j) nx[j] = p[64 * j]; }
#pragma unroll 1
        for (size_t i = i0; i < hi; i += ntx) { f32x4 v[8];
#pragma unroll
            for (int j = 0; j < 8; ++j) v[j] = nx[j];
            if (i + ntx < hi) { const size_t i2 = i + ntx; const GAS f32x4* p = src + (i2 >> 6) * 512 + (i2 & 63);
#pragma unroll
                for (int j = 0; j < 8; ++j) nx[j] = p[64 * j]; }
            unsigned wd[4];
#pragma unroll
            for (int q = 0; q < 4; ++q) { const f32x4 a = v[2 * q] * sc, b = v[2 * q + 1] * sc; unsigned w = 0u;
                w = __builtin_amdgcn_cvt_scalef32_pk_fp4_f32(w, clampf(a.x, 6.f), clampf(a.y, 6.f), 1.0f, 0); w = __builtin_amdgcn_cvt_scalef32_pk_fp4_f32(w, clampf(a.z, 6.f), clampf(a.w, 6.f), 1.0f, 1);
                w = __builtin_amdgcn_cvt_scalef32_pk_fp4_f32(w, clampf(b.x, 6.f), clampf(b.y, 6.f), 1.0f, 2); w = __builtin_amdgcn_cvt_scalef32_pk_fp4_f32(w, clampf(b.z, 6.f), clampf(b.w, 6.f), 1.0f, 3); wd[q] = w; }
            dst[i] = (v4u){wd[0], wd[1], wd[2], wd[3]}; } }
}
constexpr size_t TAB_ITEMS = (size_t)16384 * 64;
__device__ __forceinline__ size_t tab_split(int G) { const int rem = ((MTOK / 256) * (NB16 / 256)) % G; return rem ? (TAB_ITEMS / 8) * 5 : TAB_ITEMS; }
__device__ __forceinline__ unsigned fp4_code(float y) { const float a = fabsf(y);
    const unsigned m = (unsigned)(a >= 0.25f) + (unsigned)(a >= 0.75f) + (unsigned)(a >= 1.25f) + (unsigned)(a >= 1.75f) + (unsigned)(a >= 2.5f) + (unsigned)(a >= 3.5f) + (unsigned)(a >= 5.0f);
    return m | ((y < 0.f) ? 8u : 0u); }
__device__ __forceinline__ void p0_prologue(Frame& F) {
    const int tid = fresh_tid(), lane = tid & 63, wave = __builtin_amdgcn_readfirstlane(tid >> 6);
    LAS float* scr = (LAS float*)(F.lds + RING_OFF + wave * 16384);
    const int gw = blockIdx.x * NWAVES + wave, NGW = F.G * NWAVES;
    constexpr int I_IN = (DM / 64) * ((IN_PROJ + 31) / 32), I_SQ = (DM / 64) * (DM / 32);
    constexpr int NITEMS = I_IN + 2 * I_SQ;
    { const float* const w_in = F.w_in(); const float* const w_out = F.w_out(); const float* const wq = F.peer_wq(); const float* const fg = F.ffn_norm(); bf16* const WinT = F.WinT(); unsigned char* const WinT8 = F.WinT8(); bf16* const WoutT = F.WoutT(); bf16* const WqT = F.WqT(); const float* const gatt = F.attn_out_norm(); const float* const gssm = F.ssm_out_norm();
      for (int it = gw; it < NITEMS; it += NGW) {
        int r = it;
        if (r < I_IN) { const int n0_ = 32 * (r % ((IN_PROJ + 31) / 32));
            if (n0_ >= F8_LO && n0_ < F8_HI) p0_transpose_item(w_in, DM, IN_PROJ, (bf16*)WinT8, nullptr, scr, r, lane, SW8, F8_LO);
            else p0_transpose_item(w_in, DM, IN_PROJ, WinT, nullptr, scr, r, lane, 0.f, (n0_ >= F8_HI) ? (F8_HI - F8_LO) : 0);
            continue; } r -= I_IN;
        if (r < I_SQ) { const int k0_ = 64 * (r / (DM / 32)); p0_transpose_item(w_out, DM, DM, WoutT, (k0_ < ATT_W) ? gatt : (gssm - ATT_W), scr, r, lane, SW8); continue; } r -= I_SQ;
        p0_transpose_item(wq, DM, DM, WqT, fg, scr, r, lane, SW8);
      } }
    const size_t gt = (size_t)blockIdx.x * (NWAVES * 64) + tid, GT = (size_t)F.G * NWAVES * 64;
    { const size_t z0 = (size_t)(5664 - (F8_HI - F8_LO)) * DM / 8, z1 = (size_t)NB16 * DM / 8; GAS v4u* p = (GAS v4u*)F.WinT(); for (size_t i = z0 + gt; i < z1; i += GT) p[i] = (v4u){0u, 0u, 0u, 0u}; }
    { const GAS f32x4* s = (const GAS f32x4*)F.peer_sk(); GAS v2u* d = (GAS v2u*)F.SK(); for (size_t i = gt; i < (size_t)16 * 128 * 128 / 4; i += GT) { const f32x4 v = s[i]; v2u o; o.x = pk2(v.x, v.y); o.y = pk2(v.z, v.w); d[i] = o; } }
    { const float* const xg = F.x(); const float* const gn = F.attn_norm(); bf16* const hn = F.HN(); unsigned char* const hn8 = F.HN8();
      for (int m = gw; m < MTOK / 2; m += NGW) rms_2rows_to_bf16(xg + (size_t)(2 * m) * DM, xg + (size_t)(2 * m + 1) * DM, gn, hn + (size_t)(2 * m) * DM, hn + (size_t)(2 * m + 1) * DM, hn8 + (size_t)(2 * m) * DM, hn8 + (size_t)(2 * m + 1) * DM, lane); }
    tables_convert(F, 0, tab_split(F.G), gt, GT);
}

struct EpiProj {
    static constexpr bool PERM = true, AFTER_DRAIN = false, SEG = false;
    bf16* O; float* dtraw; float* kmean;
    __device__ __forceinline__ void operator()(const pg8::f32x4 (&acc)[2][2][4][2], const pg8::Unit& u, int wr, int wc, int fr, int fq) const {
        const int rpn = (u.pn < F8_LO / 256) ? u.pn : u.pn + (F8_HI - F8_LO) / 256;
        const int row0 = u.pm * 256 + wr * 64 + fr, col0 = rpn * 256 + wc * 32 + 8 * fq;
        if (rpn < 22) {
#pragma unroll
            for (int ai = 0; ai < 2; ++ai)
#pragma unroll
                for (int m = 0; m < 4; ++m) { bf16* rowp = O + (size_t)(row0 + ai * 128 + m * 16) * NPROJ + col0;
#pragma unroll
                    for (int bj = 0; bj < 2; ++bj) { const pg8::f32x4 v0 = acc[ai][bj][m][0], v1 = acc[ai][bj][m][1];
                        pg8::u32x4 w; w.x = pg8::cvt_pk_bf16(v0[0], v0[1]); w.y = pg8::cvt_pk_bf16(v0[2], v0[3]); w.z = pg8::cvt_pk_bf16(v1[0], v1[1]); w.w = pg8::cvt_pk_bf16(v1[2], v1[3]);
                        *(pg8::u32x4*)(rowp + bj * 128) = w; } }
        } else if (wc == 0 && fq < 2) {
#pragma unroll
            for (int ai = 0; ai < 2; ++ai)
#pragma unroll
                for (int m = 0; m < 4; ++m) { float* rp = dtraw + (size_t)(row0 + ai * 128 + m * 16) * 16 + 8 * fq;
                    *(pg8::f32x4*)rp = acc[ai][0][m][0]; *(pg8::f32x4*)(rp + 4) = acc[ai][0][m][1]; }
        }
        if (kmean && u.pn >= 4 && u.pn < 8) {
#pragma unroll
            for (int bj = 0; bj < 2; ++bj)
#pragma unroll
                for (int n = 0; n < 2; ++n)
#pragma unroll
                    for (int i = 0; i < 4; ++i) { float s = 0.f;
#pragma unroll
                        for (int ai = 0; ai < 2; ++ai)
#pragma unroll
                            for (int m = 0; m < 4; ++m) s += acc[ai][bj][m][n][i];
                        s += __shfl_xor(s, 1); s += __shfl_xor(s, 2); s += __shfl_xor(s, 4); s += __shfl_xor(s, 8);
                        if (fr == 0) unsafeAtomicAdd(kmean + (size_t)u.pm * 1024 + (col0 - 1024) + bj * 128 + 4 * n + i, s); }
        }
    }
};
struct EpiProj8 {
    static constexpr bool PERM = true, AFTER_DRAIN = false, SEG = false;
    bf16* O;
    __device__ __forceinline__ void operator()(const pg8::f32x4 (&acc)[2][2][4][2], const pg8::Unit& u, int wr, int wc, int fr, int fq) const {
        const int row0 = u.pm * 256 + wr * 64 + fr, col0 = F8_LO + u.pn * 256 + wc * 32 + 8 * fq; constexpr float sc = 1.f / (SH8 * SW8);
#pragma unroll
        for (int ai = 0; ai < 2; ++ai)
#pragma unroll
            for (int m = 0; m < 4; ++m) { bf16* rowp = O + (size_t)(row0 + ai * 128 + m * 16) * NPROJ + col0;
#pragma unroll
                for (int bj = 0; bj < 2; ++bj) { const pg8::f32x4 v0 = acc[ai][bj][m][0] * sc, v1 = acc[ai][bj][m][1] * sc;
                    pg8::u32x4 w; w.x = pg8::cvt_pk_bf16(v0[0], v0[1]); w.y = pg8::cvt_pk_bf16(v0[2], v0[3]); w.z = pg8::cvt_pk_bf16(v1[0], v1[1]); w.w = pg8::cvt_pk_bf16(v1[2], v1[3]);
                    *(pg8::u32x4*)(rowp + bj * 128) = w; } }
    }
};
struct EpiOut {
    static constexpr bool PERM = true, AFTER_DRAIN = false, SEG = true; static constexpr int SEG_T1 = 8, SEG_T2 = 12;
    const float* x; bf16* x1b; unsigned char* x18; float* ssq; bool doatom; const LAS f32x4* tab;
    __device__ __forceinline__ void seg_load(int ui, int wr, int fr, float (&sr)[16]) const {
#pragma unroll
        for (int i = 0; i < 8; ++i) { const int r = (i >> 2) * 128 + wr * 64 + (i & 3) * 16 + fr; const f32x2 q = *(const LAS f32x2*)(tab + ui * 256 + r); sr[2 * i] = q.x; sr[2 * i + 1] = q.y; }
        asm volatile("s_waitcnt lgkmcnt(0)" ::: "memory");
    }
    __device__ __forceinline__ void seg_apply(pg8::f32x4 (&acc)[2][2][4][2], const float (&sr)[16], int which) const {
#pragma unroll
        for (int ai = 0; ai < 2; ++ai)
#pragma unroll
            for (int m = 0; m < 4; ++m) { const float f = (which == 0) ? sr[2 * (ai * 4 + m)] : ((which == 1) ? sr[2 * (ai * 4 + m) + 1] : 1.0f);
#pragma unroll
                for (int bj = 0; bj < 2; ++bj)
#pragma unroll
                    for (int n = 0; n < 2; ++n) acc[ai][bj][m][n] = acc[ai][bj][m][n] * f; }
    }
    __device__ __forceinline__ void operator()(const pg8::f32x4 (&acc)[2][2][4][2], const pg8::Unit& u, int wr, int wc, int fr, int fq, int ui) const {
        const int row0 = u.pm * 256 + wr * 64 + fr, col0 = u.pn * 256 + wc * 32 + 8 * fq;
#pragma unroll
        for (int ai = 0; ai < 2; ++ai)
#pragma unroll
            for (int m = 0; m < 4; ++m) { const int row = row0 + ai * 128 + m * 16; const size_t off = (size_t)row * DM + col0; float s = 0.f;
                const float s1 = (*(const LAS f32x4*)(tab + ui * 256 + ai * 128 + wr * 64 + m * 16 + fr)).z;
#pragma unroll
                for (int bj = 0; bj < 2; ++bj) {
                    const pg8::f32x4 a0 = *(const pg8::f32x4*)(x + off + bj * 128), a1 = *(const pg8::f32x4*)(x + off + bj * 128 + 4);
                    const pg8::f32x4 v0 = acc[ai][bj][m][0] * s1 + a0, v1 = acc[ai][bj][m][1] * s1 + a1;
                    pg8::u32x4 w; w.x = pg8::cvt_pk_bf16(v0[0], v0[1]); w.y = pg8::cvt_pk_bf16(v0[2], v0[3]); w.z = pg8::cvt_pk_bf16(v1[0], v1[1]); w.w = pg8::cvt_pk_bf16(v1[2], v1[3]);
                    *(pg8::u32x4*)(x1b + off + bj * 128) = w;
                    { v2u o8; int w_; w_ = __builtin_amdgcn_cvt_pk_fp8_f32(clampf(v0[0] * SX8, 448.f), clampf(v0[1] * SX8, 448.f), 0, false); w_ = __builtin_amdgcn_cvt_pk_fp8_f32(clampf(v0[2] * SX8, 448.f), clampf(v0[3] * SX8, 448.f), w_, true); o8.x = (unsigned)w_;
                      w_ = __builtin_amdgcn_cvt_pk_fp8_f32(clampf(v1[0] * SX8, 448.f), clampf(v1[1] * SX8, 448.f), 0, false); w_ = __builtin_amdgcn_cvt_pk_fp8_f32(clampf(v1[2] * SX8, 448.f), clampf(v1[3] * SX8, 448.f), w_, true); o8.y = (unsigned)w_;
                      *(v2u*)(x18 + off + bj * 128) = o8; }
                    s += (v0[0] * v0[0] + v0[1] * v0[1]) + (v0[2] * v0[2] + v0[3] * v0[3]) + (v1[0] * v1[0] + v1[1] * v1[1]) + (v1[2] * v1[2] + v1[3] * v1[3]); }
                s += __shfl_xor(s, 16); s += __shfl_xor(s, 32);
                if (fq == 0 && doatom) unsafeAtomicAdd(ssq + (size_t)row * 4, s);
                asm volatile("" ::: "memory"); }
    }
};
struct EpiQ {
    static constexpr bool PERM = true, AFTER_DRAIN = false, SEG = false;
    bf16* O; const float* ssq;
    __device__ __forceinline__ void operator()(const pg8::f32x4 (&acc)[2][2][4][2], const pg8::Unit& u, int wr, int wc, int fr, int fq) const {
        const int row0 = u.pm * 256 + wr * 64 + fr, col0 = u.pn * 256 + wc * 32 + 8 * fq;
#pragma unroll
        for (int ai = 0; ai < 2; ++ai)
#pragma unroll
            for (int m = 0; m < 4; ++m) { const int row = row0 + ai * 128 + m * 16; bf16* rowp = O + (size_t)row * DM + col0;
                const float rs = (1.f / (SX8 * SW8)) / sqrtf(__hip_atomic_load(ssq + (size_t)row * 4, RLX_AGENT) * (1.f / DM) + EPS);
#pragma unroll
                for (int bj = 0; bj < 2; ++bj) { const pg8::f32x4 v0 = acc[ai][bj][m][0] * rs, v1 = acc[ai][bj][m][1] * rs;
                    pg8::u32x4 w; w.x = pg8::cvt_pk_bf16(v0[0], v0[1]); w.y = pg8::cvt_pk_bf16(v0[2], v0[3]); w.z = pg8::cvt_pk_bf16(v1[0], v1[1]); w.w = pg8::cvt_pk_bf16(v1[2], v1[3]);
                    *(pg8::u32x4*)(rowp + bj * 128) = w; } }
    }
};

constexpr int A_KSTR = 272, A_VSTR = 288;
constexpr int A_KB0 = 0, A_KB1 = 64 * A_KSTR, A_VB0 = 2 * 64 * A_KSTR, A_VBS = 64 * A_VSTR  , A_KM = A_VB0 + 3 * A_VBS, A_TAB = A_KM + 8 * 128 * 4, A_END = A_TAB + 128 * 4;
static_assert(A_END <= RING_BYTES && (A_KM % 16) == 0, "attention LDS map");
#define PIN16(a, i) asm volatile("" : "+v"(a[i]), "+v"(a[i + 1]), "+v"(a[i + 2]), "+v"(a[i + 3]), "+v"(a[i + 4]), "+v"(a[i + 5]), "+v"(a[i + 6]), "+v"(a[i + 7]), "+v"(a[i + 8]), "+v"(a[i + 9]), "+v"(a[i + 10]), "+v"(a[i + 11]), "+v"(a[i + 12]), "+v"(a[i + 13]), "+v"(a[i + 14]), "+v"(a[i + 15]))
#define TR16(p) __builtin_amdgcn_ds_read_tr16_b64_v4i16((LAS s16x4*)(p))
#define MFMA16(a, b, c) __builtin_amdgcn_mfma_f32_16x16x32_bf16((a), (b), (c), 0, 0, 0)
__device__ __forceinline__ bf16x8 pack8(const float* v) {
    const unsigned a = pk2(v[0], v[1]), b = pk2(v[2], v[3]), c = pk2(v[4], v[5]), d = pk2(v[6], v[7]);
    const v4u u = {a, b, c, d}; return __builtin_bit_cast(bf16x8, u);
}
__device__ __forceinline__ void attn_unit(Frame& F, int b, int h, int blk, const bool doatom = true) {
    LAS unsigned char* lds = F.lds + RING_OFF;
    const int tid = fresh_tid(), lane = tid & 63, w = __builtin_amdgcn_readfirstlane(tid >> 6), g = lane >> 4, c16 = lane & 15, q4 = c16 >> 2, p4 = lane & 3;
    const int own = blk, t0 = blk * 256, tq0 = t0 + 32 * w + c16;
    const size_t rowbase = (size_t)b * SEQ;
    const float NEG_INF = -__builtin_inff();
    constexpr float LOG2E = 1.4426950408889634f, SCL2 = 0.08838834764831845f * 1.4426950408889634f;
    LAS float* km = (LAS float*)(lds + A_KM); LAS float* tab = (LAS float*)(lds + A_TAB);
    const bf16* const PROJ = F.PROJ(); const float* const kmg = F.kmean(); const float* const relb = F.rel_bias();
    for (int i = tid; i < own * 128; i += NWAVES * 64) { const int n = i >> 7, d = i & 127; km[i] = kmg[(size_t)(b * 8 + n) * 1024 + h * 128 + d] * (1.f / 256.f); }
    if (tid < 128) { const int rel = tid; int bucket = rel; if (rel >= 16) { bucket = 16 + (int)(log2f((float)rel * (1.f / 16.f)) * (16.f / 3.f)); bucket = bucket > 31 ? 31 : bucket; }
        tab[tid] = relb[bucket * 8 + h] * LOG2E; }
    bf16x8 qf[2][4];
#pragma unroll
    for (int gi = 0; gi < 2; ++gi) { const bf16* qrow = PROJ + (rowbase + tq0 + 16 * gi) * NPROJ + COL_Q + h * 128 + 8 * g;
#pragma unroll
      for (int ks = 0; ks < 4; ++ks) qf[gi][ks] = *(const GAS bf16x8*)(qrow + 32 * ks); }
    __syncthreads();
    unsigned selmask[2];
    if (own <= 3) { selmask[0] = (1u << own) - 1u; selmask[1] = selmask[0]; }
    else {
#pragma unroll
      for (int gi = 0; gi < 2; ++gi) {
        float gate[7];
#pragma unroll
        for (int n = 0; n < 7; ++n) {
            float s = NEG_INF;
            if (n < own) { s = 0.f;
#pragma unroll
                for (int ks = 0; ks < 4; ++ks) { const LAS f32x4* kp = (const LAS f32x4*)(km + n * 128 + 32 * ks + 8 * g); const f32x4 k0 = kp[0], k1 = kp[1]; const v4u qu = __builtin_bit_cast(v4u, qf[gi][ks]);
                    s += bflo(qu.x) * k0.x + bfhi(qu.x) * k0.y + bflo(qu.y) * k0.z + bfhi(qu.y) * k0.w + bflo(qu.z) * k1.x + bfhi(qu.z) * k1.y + bflo(qu.w) * k1.z + bfhi(qu.w) * k1.w; }
                s += __shfl_xor(s, 16); s += __shfl_xor(s, 32); }
            gate[n] = s;
        }
        unsigned sm = 0u;
#pragma unroll
        for (int r = 0; r < 3; ++r) { float best = NEG_INF; int bi = 0;
#pragma unroll
            for (int n = 0; n < 7; ++n) { const bool cand = (n < own) && !((sm >> n) & 1u) && (gate[n] > best); best = cand ? gate[n] : best; bi = cand ? n : bi; }
            sm |= 1u << bi; }
        selmask[gi] = sm; }
    }
    const int nT = 4 + 4 * own;
    const int sr = tid >> 3, sc = (tid & 7) * 16;
#define A_KEY0(i) ((i) < 4 ? own * 256 + 64 * (i) : (((i) - 4) >> 2) * 256 + (((i) - 4) & 3) * 64)
    v4u kr0, kr1, vr0, vr1;
#define A_LOAD(i) do { const bf16* kp_ = PROJ + (rowbase + A_KEY0(i) + sr) * NPROJ + COL_K + h * 128 + sc; \
        kr0 = *(const GAS v4u*)kp_; kr1 = *(const GAS v4u*)(kp_ + 8); vr0 = *(const GAS v4u*)(kp_ + (COL_V - COL_K)); vr1 = *(const GAS v4u*)(kp_ + (COL_V - COL_K) + 8); } while (0)
#define A_STORE(bufi) do { LAS unsigned char* kd_ = lds + ((bufi) ? A_KB1 : A_KB0) + sr * A_KSTR + sc * 2; LAS unsigned char* vd_ = lds + A_VB0 + vnx * A_VBS + sr * A_VSTR + sc * 2; \
        *(LAS v4u*)kd_ = kr0; *(LAS v4u*)(kd_ + 16) = kr1; *(LAS v4u*)vd_ = vr0; *(LAS v4u*)(vd_ + 16) = vr1; } while (0)
    int vcur = 0, vnx = 0, vprev = 0;
#define A_PV(PF, Vb_) do { _Pragma("unroll") for (int s = 0; s < 2; ++s) { s16x4 vlo[8], vhi[8]; \
            _Pragma("unroll") for (int db = 0; db < 8; ++db) { LAS unsigned char* va = (Vb_) + (32 * s + 4 * g + q4) * A_VSTR + (16 * db + 4 * p4) * 2; vlo[db] = TR16(va); vhi[db] = TR16(va + 16 * A_VSTR); } \
            __builtin_amdgcn_sched_barrier(0); \
            _Pragma("unroll") for (int db = 0; db < 8; ++db) { const bf16x8 vf = __builtin_shufflevector(vlo[db], vhi[db], 0, 1, 2, 3, 4, 5, 6, 7); \
                oacc[0][db] = MFMA16(vf, PF[0][s], oacc[0][db]); oacc[1][db] = MFMA16(vf, PF[1][s], oacc[1][db]); } \
            __builtin_amdgcn_sched_barrier(0); } } while (0)
    A_LOAD(0); A_STORE(0);
    __syncthreads();
    const bool late = w >= 4;
    bf16x8 pfp[2][2]; bool skipp = true;
#pragma unroll
    for (int gi = 0; gi < 2; ++gi) { pfp[gi][0] = (bf16x8){0, 0, 0, 0, 0, 0, 0, 0}; pfp[gi][1] = pfp[gi][0]; }
    float m_run[2] = {NEG_INF, NEG_INF}, l_run[2] = {0.f, 0.f};
    f32x4 oacc[2][8];
#pragma unroll
    for (int gi = 0; gi < 2; ++gi)
#pragma unroll
        for (int db = 0; db < 8; ++db) oacc[gi][db] = (f32x4){0.f, 0.f, 0.f, 0.f};
    for (int i = 0; i < nT; ++i) {
        if (i + 1 < nT) A_LOAD(i + 1);
        vnx = (vcur == 2) ? 0 : vcur + 1;
        const int buf = i & 1, key0 = A_KEY0(i); const bool isown = i < 4; const int pblk = isown ? own : ((i - 4) >> 2);
        const bool skipw = isown && (64 * i > 32 * w + 31);
        if (late && !skipp) A_PV(pfp, lds + A_VB0 + vprev * A_VBS);
        bf16x8 pf[2][2];
        if (!skipw) {
        LAS unsigned char* Kb = lds + (buf ? A_KB1 : A_KB0);
        f32x4 sacc[2][4];
#pragma unroll
        for (int hf = 0; hf < 2; ++hf) { bf16x8 kf[8];
#pragma unroll
            for (int n2 = 0; n2 < 2; ++n2)
#pragma unroll
                for (int ks = 0; ks < 4; ++ks) kf[n2 * 4 + ks] = *(const LAS bf16x8*)(Kb + (16 * (2 * hf + n2) + c16) * A_KSTR + (32 * ks + 8 * g) * 2);
            __builtin_amdgcn_sched_barrier(0);
#pragma unroll
            for (int gi = 0; gi < 2; ++gi)
#pragma unroll
                for (int n2 = 0; n2 < 2; ++n2) { f32x4 a = (f32x4){0.f, 0.f, 0.f, 0.f};
#pragma unroll
                    for (int ks = 0; ks < 4; ++ks) a = MFMA16(kf[n2 * 4 + ks], qf[gi][ks], a);
                    sacc[gi][2 * hf + n2] = a; }
            __builtin_amdgcn_sched_barrier(0); }
        const bool far = (key0 + 63 + 128 <= t0 + 32 * w);
        const bool diag = isown && (64 * i + 63 > 32 * w);
#pragma unroll
        for (int gi = 0; gi < 2; ++gi) {
            const int tq = tq0 + 16 * gi; const bool sel = isown || ((selmask[gi] >> pblk) & 1u);
            float sv[16]; float mloc, m_new, alpha;
            if (far) {
                const float bfar = tab[127];
                float mx = fmaxf(fmaxf(sacc[gi][0][0], sacc[gi][0][1]), fmaxf(sacc[gi][0][2], sacc[gi][0][3]));
#pragma unroll
                for (int nb = 1; nb < 4; ++nb) mx = fmaxf(mx, fmaxf(fmaxf(sacc[gi][nb][0], sacc[gi][nb][1]), fmaxf(sacc[gi][nb][2], sacc[gi][nb][3])));
                mloc = sel ? (mx * SCL2 + bfar) : NEG_INF;
                mloc = fmaxf(mloc, __shfl_xor(mloc, 16)); mloc = fmaxf(mloc, __shfl_xor(mloc, 32));
                m_new = fmaxf(m_run[gi], mloc); alpha = __builtin_amdgcn_exp2f(m_run[gi] - m_new);
                const float cadd = sel ? (bfar - m_new) : NEG_INF;
#pragma unroll
                for (int nb = 0; nb < 4; ++nb)
#pragma unroll
                    for (int r = 0; r < 4; ++r) sv[nb * 4 + r] = __builtin_amdgcn_exp2f(sacc[gi][nb][r] * SCL2 + cadd);
            } else {
                const int relb = tq - key0 - 4 * g; float bias[16];
#pragma unroll
                for (int nb = 0; nb < 4; ++nb)
#pragma unroll
                    for (int r = 0; r < 4; ++r) { const int rel = relb - 16 * nb - r; int ri = rel < 0 ? 0 : rel; ri = ri > 127 ? 127 : ri; bias[nb * 4 + r] = tab[ri]; }
                PIN16(bias, 0);
                mloc = NEG_INF;
#pragma unroll
                for (int nb = 0; nb < 4; ++nb)
#pragma unroll
                    for (int r = 0; r < 4; ++r) { const int rel = relb - 16 * nb - r;
                        float s = sacc[gi][nb][r] * SCL2 + bias[nb * 4 + r]; s = (!sel || (diag && rel < 0)) ? NEG_INF : s; sv[nb * 4 + r] = s; mloc = fmaxf(mloc, s); }
                mloc = fmaxf(mloc, __shfl_xor(mloc, 16)); mloc = fmaxf(mloc, __shfl_xor(mloc, 32));
                m_new = fmaxf(m_run[gi], mloc); alpha = __builtin_amdgcn_exp2f(m_run[gi] - m_new);
#pragma unroll
                for (int e = 0; e < 16; ++e) sv[e] = __builtin_amdgcn_exp2f(sv[e] - m_new);
            }
            float psum = 0.f;
#pragma unroll
            for (int e = 0; e < 16; ++e) psum += sv[e];
            l_run[gi] = l_run[gi] * alpha + psum; m_run[gi] = m_new;
#pragma unroll
            for (int db = 0; db < 8; ++db) oacc[gi][db] = oacc[gi][db] * alpha;
            pf[gi][0] = pack8(sv); pf[gi][1] = pack8(sv + 8);
        }
        __builtin_amdgcn_sched_barrier(0);
        if (!late) A_PV(pf, lds + A_VB0 + vcur * A_VBS);
        }
        if (late) { skipp = skipw;
#pragma unroll
            for (int gi = 0; gi < 2; ++gi) { pfp[gi][0] = pf[gi][0]; pfp[gi][1] = pf[gi][1]; } }
        if (i + 1 < nT) A_STORE((i + 1) & 1);
        vprev = vcur; vcur = vnx;
        __syncthreads();
    }
    if (late && !skipp) A_PV(pfp, lds + A_VB0 + vprev * A_VBS);
#undef A_PV
    bf16* const MIXp = F.HN(); float* const ssqp = F.ssq();
#pragma unroll
    for (int gi = 0; gi < 2; ++gi) {
        const int tq = tq0 + 16 * gi;
        float l_tot = l_run[gi]; l_tot += __shfl_xor(l_tot, 16); l_tot += __shfl_xor(l_tot, 32);
        const float inv = 1.f / l_tot; float ssq = 0.f;
        unsigned char* orow = (unsigned char*)MIXp + (rowbase + tq) * DM + h * 128 + 4 * g;
#pragma unroll
        for (int db = 0; db < 8; ++db) { const f32x4 o = oacc[gi][db] * inv; ssq += (o.x * o.x + o.y * o.y) + (o.z * o.z + o.w * o.w); *(GAS unsigned*)(orow + 16 * db) = pk4_fp8(o.x * SA8, o.y * SA8, o.z * SA8, o.w * SA8); }
        ssq += __shfl_xor(ssq, 16); ssq += __shfl_xor(ssq, 32);
        if (g == 0 && doatom) unsafeAtomicAdd(ssqp + (rowbase + tq) * 4 + 1, ssq);
    }
#undef A_KEY0
#undef A_LOAD
#undef A_STORE
}

constexpr int XBC_W = CONV_CH;
__device__ __forceinline__ void conv_phase(Frame& F) {
    const bf16* const PROJ = F.PROJ(); bf16* const XBC = F.XBC(); const float* const cw = F.conv_w(); const float* const cb = F.conv_b();
    const int gt = blockIdx.x * (NWAVES * 64) + fresh_tid(), GT = F.G * NWAVES * 64;
    for (int task = gt; task < (MTOK / 32) * (CONV_CH / 8); task += GT) {
        const int r = task / (CONV_CH / 8), k = task % (CONV_CH / 8), ch = 8 * k, tok0 = 32 * r;
        float wv[4][8], bias[8];
#pragma unroll
        for (int t = 0; t < 4; ++t) { const f32x4 w0 = *(const GAS f32x4*)(cw + t * CONV_CH + ch), w1 = *(const GAS f32x4*)(cw + t * CONV_CH + ch + 4);
            wv[t][0] = w0.x; wv[t][1] = w0.y; wv[t][2] = w0.z; wv[t][3] = w0.w; wv[t][4] = w1.x; wv[t][5] = w1.y; wv[t][6] = w1.z; wv[t][7] = w1.w; }
        { const f32x4 b0 = *(const GAS f32x4*)(cb + ch), b1 = *(const GAS f32x4*)(cb + ch + 4); bias[0] = b0.x; bias[1] = b0.y; bias[2] = b0.z; bias[3] = b0.w; bias[4] = b1.x; bias[5] = b1.y; bias[6] = b1.z; bias[7] = b1.w; }
        const bf16* src = PROJ + (size_t)tok0 * NPROJ + COL_XBC + ch; bf16* dst = XBC + (size_t)tok0 * XBC_W + ch;
        v4u p0 = (v4u){0u, 0u, 0u, 0u}, p1 = p0, p2 = p0;
        if ((tok0 & (SEQ - 1)) != 0) { p0 = *(const GAS v4u*)(src - 3 * (ptrdiff_t)NPROJ); p1 = *(const GAS v4u*)(src - 2 * (ptrdiff_t)NPROJ); p2 = *(const GAS v4u*)(src - (ptrdiff_t)NPROJ); }
#pragma unroll 1
        for (int i0 = 0; i0 < 32; i0 += 8) {
            v4u cur[8];
#pragma unroll
            for (int i = 0; i < 8; ++i) cur[i] = *(const GAS v4u*)(src + (size_t)(i0 + i) * NPROJ);
#pragma unroll
            for (int i = 0; i < 8; ++i) {
                const v4u c = cur[i]; float acc[8];
                const unsigned a0[4] = {p0.x, p0.y, p0.z, p0.w}, a1[4] = {p1.x, p1.y, p1.z, p1.w}, a2[4] = {p2.x, p2.y, p2.z, p2.w}, a3[4] = {c.x, c.y, c.z, c.w};
#pragma unroll
                for (int j = 0; j < 4; ++j) {
                    acc[2 * j] = bias[2 * j] + wv[0][2 * j] * bflo(a0[j]) + wv[1][2 * j] * bflo(a1[j]) + wv[2][2 * j] * bflo(a2[j]) + wv[3][2 * j] * bflo(a3[j]);
                    acc[2 * j + 1] = bias[2 * j + 1] + wv[0][2 * j + 1] * bfhi(a0[j]) + wv[1][2 * j + 1] * bfhi(a1[j]) + wv[2][2 * j + 1] * bfhi(a2[j]) + wv[3][2 * j + 1] * bfhi(a3[j]); }
#pragma unroll
                for (int j = 0; j < 8; ++j) acc[j] = silu_f(acc[j]);
                v4u o; o.x = pk2(acc[0], acc[1]); o.y = pk2(acc[2], acc[3]); o.z = pk2(acc[4], acc[5]); o.w = pk2(acc[6], acc[7]);
                *(GAS v4u*)(dst + (size_t)(i0 + i) * XBC_W) = o;
                p0 = p1; p1 = p2; p2 = c; }
        }
    }
    { const float* const dtraw = F.dtraw(); float* const dt2 = F.DT2(); const float* const dtb = F.dt_bias();
      for (int i = gt; i < MTOK * 16; i += GT) { const float xr = dtraw[i] + dtb[i & 15]; dt2[i] = xr > 20.f ? xr : log1pf(__expf(xr)); } }
}

constexpr int S_BSTR = 272, S_XSTR = 144;
constexpr int S_BM = 0, S_CM = 128 * S_BSTR, S_X = 2 * 128 * S_BSTR, S_XW = S_X + 128 * S_XSTR, S_HB = S_XW + 128 * S_XSTR, S_DT = S_HB + 64 * S_BSTR, S_CS = S_DT + 512, S_DA = S_CS + 512, S_END = S_DA + 512;
static_assert(S_END <= RING_BYTES, "ssd LDS map");
__device__ __forceinline__ void ssd_unit(Frame& F, int b, int h, const bool doatom = true) {
    LAS unsigned char* lds = F.lds + RING_OFF;
    const int tid = fresh_tid(), lane = tid & 63, w = __builtin_amdgcn_readfirstlane(tid >> 6), g = lane >> 4, c16 = lane & 15, q4 = c16 >> 2, p4 = lane & 3;
    const int g8 = h >> 3, pbw = w & 3, nhw = w >> 2;
    const float a_h = -__expf(F.a_log()[h]), dsk = F.d_skip()[h];
    const bf16* const PROJ = F.PROJ(); bf16* const MIX = F.HN(); const float* const dt2 = F.DT2(); const bf16* const XBC = F.XBC(); float* const ssqp = F.ssq();
    LAS float* dtl = (LAS float*)(lds + S_DT); LAS float* csl = (LAS float*)(lds + S_CS); LAS float* dal = (LAS float*)(lds + S_DA);
    for (int i = tid; i < 64 * S_BSTR / 16; i += NWAVES * 64) ((LAS v4u*)(lds + S_HB))[i] = (v4u){0u, 0u, 0u, 0u};
    f32x4 hacc[4];
#pragma unroll
    for (int i = 0; i < 4; ++i) hacc[i] = (f32x4){0.f, 0.f, 0.f, 0.f};
    const int xl = tid >> 3, xc = tid & 7, bl = tid >> 4, bc = tid & 15;
    v4u xr[2], br[4], cr[4]; float dtv = 0.f;
#define S_PREFETCH(cc) do { const size_t t0_ = (size_t)b * SEQ + (size_t)(cc) * SSM_L; \
        _Pragma("unroll") for (int i_ = 0; i_ < 2; ++i_) xr[i_] = *(const GAS v4u*)(XBC + (t0_ + xl + 64 * i_) * XBC_W + h * 64 + 8 * xc); \
        _Pragma("unroll") for (int i_ = 0; i_ < 4; ++i_) { const bf16* p_ = XBC + (t0_ + bl + 32 * i_) * XBC_W + 1024 + g8 * 128 + 8 * bc; br[i_] = *(const GAS v4u*)p_; cr[i_] = *(const GAS v4u*)(p_ + 256); } \
        if (tid < 128) dtv = dt2[(t0_ + tid) * 16 + h]; } while (0)
    S_PREFETCH(0);
    for (int c = 0; c < SSM_NC; ++c) {
        const size_t tok0 = (size_t)b * SEQ + (size_t)c * SSM_L;
        if (tid < 128) { dtl[tid] = dtv; dal[tid] = dtv * a_h; }
        __syncthreads();
        if (w == 0) { const float v0 = dal[2 * lane], v1 = dal[2 * lane + 1]; float s = v0 + v1;
#pragma unroll
            for (int o = 1; o < 64; o <<= 1) { const float t = __shfl_up(s, o); s += (lane >= o) ? t : 0.f; }
            csl[2 * lane] = s - v1; csl[2 * lane + 1] = s; }
        __syncthreads();
        const float cs_last = csl[127];
#pragma unroll
        for (int i = 0; i < 2; ++i) { const int l = xl + 64 * i; const v4u v = xr[i]; *(LAS v4u*)(lds + S_X + l * S_XSTR + xc * 16) = v; const float wl = dtl[l] * __expf(cs_last - csl[l]);
            v4u o2; o2.x = pk2(bflo(v.x) * wl, bfhi(v.x) * wl); o2.y = pk2(bflo(v.y) * wl, bfhi(v.y) * wl); o2.z = pk2(bflo(v.z) * wl, bfhi(v.z) * wl); o2.w = pk2(bflo(v.w) * wl, bfhi(v.w) * wl);
            *(LAS v4u*)(lds + S_XW + l * S_XSTR + xc * 16) = o2; }
#pragma unroll
        for (int i = 0; i < 4; ++i) { const int l = bl + 32 * i; *(LAS v4u*)(lds + S_BM + l * S_BSTR + bc * 16) = br[i]; *(LAS v4u*)(lds + S_CM + l * S_BSTR + bc * 16) = cr[i]; }
        const int lrow = 16 * w + c16;
        v2u zr[4];
#pragma unroll
        for (int pb = 0; pb < 4; ++pb) zr[pb] = *(const GAS v2u*)(PROJ + (tok0 + lrow) * NPROJ + COL_Z + h * 64 + 16 * pb + 4 * g);
        if (c + 1 < SSM_NC) S_PREFETCH(c + 1);
        __syncthreads();
        bf16x8 cf[4];
#pragma unroll
        for (int ks = 0; ks < 4; ++ks) cf[ks] = *(const LAS bf16x8*)(lds + S_CM + lrow * S_BSTR + (32 * ks + 8 * g) * 2);
        f32x4 yacc[4];
        const float cs_l = csl[lrow]; const float el = __expf(cs_l);
#pragma unroll
        for (int pb = 0; pb < 4; ++pb) { yacc[pb] = (f32x4){0.f, 0.f, 0.f, 0.f};
#pragma unroll
            for (int ks = 0; ks < 4; ++ks) { const bf16x8 hf = *(const LAS bf16x8*)(lds + S_HB + (16 * pb + c16) * S_BSTR + (32 * ks + 8 * g) * 2); yacc[pb] = MFMA16(hf, cf[ks], yacc[pb]); }
            yacc[pb] = yacc[pb] * el; }
        for (int s2 = 0; s2 <= (w >> 1); ++s2) {
            const int sb0 = 2 * s2, sb1 = 2 * s2 + 1; const bool has1 = sb1 <= w;
            f32x4 cb0 = (f32x4){0.f, 0.f, 0.f, 0.f}, cb1 = (f32x4){0.f, 0.f, 0.f, 0.f};
#pragma unroll
            for (int ks = 0; ks < 4; ++ks) { const bf16x8 bf0 = *(const LAS bf16x8*)(lds + S_BM + (16 * sb0 + c16) * S_BSTR + (32 * ks + 8 * g) * 2); cb0 = MFMA16(bf0, cf[ks], cb0); }
            if (has1) {
#pragma unroll
                for (int ks = 0; ks < 4; ++ks) { const bf16x8 bf1 = *(const LAS bf16x8*)(lds + S_BM + (16 * sb1 + c16) * S_BSTR + (32 * ks + 8 * g) * 2); cb1 = MFMA16(bf1, cf[ks], cb1); } }
            float mv[8];
#pragma unroll
            for (int r = 0; r < 4; ++r) { const int s = 16 * sb0 + 4 * g + r; const float e = __expf(fminf(cs_l - csl[s], 0.f)) * dtl[s]; mv[r] = (s <= lrow) ? cb0[r] * e : 0.f; }
#pragma unroll
            for (int r = 0; r < 4; ++r) { const int s = 16 * sb1 + 4 * g + r; const int sc_ = s > 127 ? 127 : s; const float e = __expf(fminf(cs_l - csl[sc_], 0.f)) * dtl[sc_]; mv[4 + r] = (has1 && s <= lrow) ? cb1[r] * e : 0.f; }
            const bf16x8 pf = pack8(mv);
#pragma unroll
            for (int pb = 0; pb < 4; ++pb) { LAS unsigned char* xa = lds + S_X + (32 * s2 + 4 * g + q4) * S_XSTR + (16 * pb + 4 * p4) * 2;
                const s16x4 lo = TR16(xa), hi = TR16(xa + 16 * S_XSTR); const bf16x8 xf = __builtin_shufflevector(lo, hi, 0, 1, 2, 3, 4, 5, 6, 7);
                yacc[pb] = MFMA16(xf, pf, yacc[pb]); }
        }
        { const size_t tok = tok0 + lrow; float ssq = 0.f;
#pragma unroll
          for (int pb = 0; pb < 4; ++pb) { const int p0 = 16 * pb + 4 * g;
              const v2u xs_ = *(const LAS v2u*)(lds + S_X + lrow * S_XSTR + p0 * 2);
              const v2u zr_ = zr[pb];
              const float o0 = (yacc[pb].x + bflo(xs_.x) * dsk) * silu_f(bflo(zr_.x)), o1 = (yacc[pb].y + bfhi(xs_.x) * dsk) * silu_f(bfhi(zr_.x));
              const float o2 = (yacc[pb].z + bflo(xs_.y) * dsk) * silu_f(bflo(zr_.y)), o3 = (yacc[pb].w + bfhi(xs_.y) * dsk) * silu_f(bfhi(zr_.y));
              ssq += (o0 * o0 + o1 * o1) + (o2 * o2 + o3 * o3);
              *(GAS unsigned*)((unsigned char*)MIX + tok * DM + ATT_W + h * 64 + p0) = pk4_fp8(o0 * SS8, o1 * SS8, o2 * SS8, o3 * SS8); }
          ssq += __shfl_xor(ssq, 16); ssq += __shfl_xor(ssq, 32);
          if (g == 0 && doatom) unsafeAtomicAdd(ssqp + tok * 4 + 2 + g8, ssq); }
        { const float cdec = __expf(cs_last);
#pragma unroll
          for (int i = 0; i < 4; ++i) hacc[i] = hacc[i] * cdec;
#pragma unroll
          for (int ks = 0; ks < 4; ++ks) {
              LAS unsigned char* xa = lds + S_XW + (32 * ks + 8 * g + q4) * S_XSTR + (16 * pbw + 4 * p4) * 2;
              const s16x4 xlo = TR16(xa), xhi = TR16(xa + 4 * S_XSTR); const bf16x8 xf = __builtin_shufflevector(xlo, xhi, 0, 1, 2, 3, 4, 5, 6, 7);
#pragma unroll
              for (int i = 0; i < 4; ++i) { const int nb = 4 * nhw + i; LAS unsigned char* ba = lds + S_BM + (32 * ks + 8 * g + q4) * S_BSTR + (16 * nb + 4 * p4) * 2;
                  const s16x4 blo = TR16(ba), bhi = TR16(ba + 4 * S_BSTR); const bf16x8 bfr = __builtin_shufflevector(blo, bhi, 0, 1, 2, 3, 4, 5, 6, 7);
                  hacc[i] = MFMA16(bfr, xf, hacc[i]); } } }
        __syncthreads();
#pragma unroll
        for (int i = 0; i < 4; ++i) { const int nb = 4 * nhw + i; v2u o; o.x = pk2(hacc[i].x, hacc[i].y); o.y = pk2(hacc[i].z, hacc[i].w);
            *(LAS v2u*)(lds + S_HB + (16 * pbw + c16) * S_BSTR + (16 * nb + 4 * g) * 2) = o; }
    }
#undef S_PREFETCH
    __syncthreads();
}

__device__ __forceinline__ void mix_normalize(Frame& F) {
    const int tid_ = fresh_tid(), lane = tid_ & 63; const int gw = blockIdx.x * NWAVES + __builtin_amdgcn_readfirstlane(tid_ >> 6), NGW = F.G * NWAVES;
    const float* const ssqp = F.ssq(); bf16* const MIX = F.HN(); const float* const gatt = F.attn_out_norm(); const float* const gssm = F.ssm_out_norm();
    for (int m = gw; m < MTOK; m += NGW) {
        const float* sq = ssqp + (size_t)m * 4;
        const float s1 = __hip_atomic_load(sq + 1, RLX_AGENT), s2 = __hip_atomic_load(sq + 2, RLX_AGENT), s3 = __hip_atomic_load(sq + 3, RLX_AGENT);
        const float ra = 1.f / sqrtf(s1 * (1.f / 1024.f) + EPS), r0 = 1.f / sqrtf(s2 * (1.f / 512.f) + EPS), r1 = 1.f / sqrtf(s3 * (1.f / 512.f) + EPS);
        GAS v4u* row = (GAS v4u*)(MIX + (size_t)m * DM);
#pragma unroll
        for (int j = 0; j < 4; ++j) { const int idx = lane + 64 * j, col = 8 * idx; const float rs = (j < 2) ? ra : ((j == 2) ? r0 : r1);
            const float* gp = (j < 2) ? (gatt + col) : (gssm + (col - ATT_W));
            const f32x4 g0 = *(const GAS f32x4*)gp, g1 = *(const GAS f32x4*)(gp + 4); const v4u v = row[idx]; v4u o;
            o.x = pk2(bflo(v.x) * rs * g0.x, bfhi(v.x) * rs * g0.y); o.y = pk2(bflo(v.y) * rs * g0.z, bfhi(v.y) * rs * g0.w);
            o.z = pk2(bflo(v.z) * rs * g1.x, bfhi(v.z) * rs * g1.y); o.w = pk2(bflo(v.w) * rs * g1.z, bfhi(v.w) * rs * g1.w); row[idx] = o; }
    }
}

constexpr int P_EIDX = 0, P_GATE = 16384, P_LST = 32768, P_HN = 65536, P_ACT = 98304, P_END = 102400;
static_assert(P_END <= RING_BYTES, "peer LDS map");
__constant__ unsigned char PEER_CAND[52] = {0, 1, 2, 3, 4, 5, 6, 7, 8, 9, 10, 11, 12, 13, 14, 15, 16, 17, 18, 19, 20, 21, 22, 23, 32, 33, 34, 35, 36, 48, 49, 50, 51, 64, 65, 66, 80, 81, 96, 97, 112, 113, 128, 144, 160, 176, 192, 208, 224, 240, 255, 255};
__device__ __forceinline__ unsigned f2ord(float f) { const unsigned u = __builtin_bit_cast(unsigned, f); return u ^ ((u >> 31) ? 0xFFFFFFFFu : 0x80000000u); }
__device__ __forceinline__ float ord2f(unsigned u) { return __builtin_bit_cast(float, u ^ ((u >> 31) ? 0x80000000u : 0xFFFFFFFFu)); }
#define CSWAPD(a, b) do { const unsigned hi_ = (a) > (b) ? (a) : (b), lo_ = (a) > (b) ? (b) : (a); (a) = hi_; (b) = lo_; } while (0)
template <int N> __device__ __forceinline__ void bitonic_sort_desc(unsigned (&v)[N]) {
#pragma unroll
    for (int k = 2; k <= N; k <<= 1)
#pragma unroll
        for (int j = k >> 1; j > 0; j >>= 1)
#pragma unroll
            for (int i = 0; i < N; ++i) { const int l = i ^ j; if (l > i) { if ((i & k) == 0) CSWAPD(v[i], v[l]); else CSWAPD(v[l], v[i]); } }
}
__device__ __forceinline__ void merge16_xor(unsigned (&v)[16], int dist) {
    unsigned o[16];
#pragma unroll
    for (int i = 0; i < 16; ++i) o[i] = (unsigned)__shfl_xor((int)v[i], dist);
#pragma unroll
    for (int i = 0; i < 16; ++i) v[i] = v[i] > o[15 - i] ? v[i] : o[15 - i];
#pragma unroll
    for (int j = 8; j > 0; j >>= 1)
#pragma unroll
        for (int i = 0; i < 16; ++i) { const int l = i ^ j; if (l > i) CSWAPD(v[i], v[l]); }
}
__device__ __forceinline__ float gelu_erf(float x) { return 0.5f * x * (1.f + erff(x * 0.70710678118654752f)); }
__device__ __forceinline__ float fp4_dec1(unsigned n) { const unsigned m = n & 7u; unsigned bits = (m >= 2u) ? (((126u + (m >> 1)) << 23) | ((m & 1u) << 22)) : (m ? 0x3F000000u : 0u); bits |= (n & 8u) << 28; return __builtin_bit_cast(float, bits); }
__device__ __forceinline__ f32x2 fp4_dec2(unsigned x) { f32x2 r; r.x = fp4_dec1(x & 15u); r.y = fp4_dec1((x >> 4) & 15u); return r; }
typedef long i64;
typedef int v8i __attribute__((ext_vector_type(8)));
template <bool dry = false> __device__ __forceinline__ void peer_unit(Frame& F, int u) {
    LAS unsigned char* lds = F.lds + RING_OFF;
    const int tid_ = fresh_tid(), lane = tid_ & 63, w = __builtin_amdgcn_readfirstlane(tid_ >> 6), g = lane >> 4, c16 = lane & 15;
    const int T0 = 32 * u;
    LAS int* eidx = (LAS int*)(lds + P_EIDX); LAS float* gate = (LAS float*)(lds + P_GATE);
    LAS unsigned* lst = (LAS unsigned*)(lds + P_LST) + w * 1024;
    const bf16* const QP = F.QP(); const bf16* const SK = F.SK(); float* const outp = F.out(); const bf16* const X1B = F.X1B(); const float* const fgain = F.ffn_norm(); const float* const fing = F.final_norm(); const unsigned char* const U8 = F.U8(); const unsigned char* const V8 = F.V8();
#ifndef NO_ROUTE
    for (int tb = 0; tb < 2; ++tb) {
        for (int c = 0; c < 2; ++c) {
            const int p = 2 * w + c;
            bf16x8 qf[4];
            { const unsigned qo = ((unsigned)(T0 + 16 * tb + c16) * (unsigned)DM + (unsigned)(p * 128 + 8 * g)) * 2u;
#pragma unroll
              for (int ks = 0; ks < 4; ++ks) qf[ks] = __builtin_nontemporal_load((const GAS bf16x8*)((const unsigned char*)QP + (qo + 64u * ks))); }
            unsigned key[32];
#pragma unroll
            for (int kb = 0; kb < 8; ++kb) { f32x4 acc = (f32x4){0.f, 0.f, 0.f, 0.f};
                const unsigned so = ((unsigned)(p * 128 + 16 * kb + c16) * 128u + 8u * (unsigned)g) * 2u;
#pragma unroll
                for (int ks = 0; ks < 4; ++ks) { const bf16x8 sf = *(const GAS bf16x8*)((const unsigned char*)SK + (so + 64u * ks)); acc = MFMA16(sf, qf[ks], acc); }
#pragma unroll
                for (int r = 0; r < 4; ++r) key[kb * 4 + r] = (f2ord(acc[r]) & ~0x7Fu) | (unsigned)(16 * kb + 4 * g + r);
                __builtin_amdgcn_sched_barrier(0); }
            bitonic_sort_desc<32>(key);
            unsigned top[16];
#pragma unroll
            for (int i = 0; i < 16; ++i) top[i] = key[i];
            merge16_xor(top, 16); merge16_xor(top, 32);
            if (g == 0) { LAS v4u* d = (LAS v4u*)(lst + (c * 32 + 16 * tb + c16) * 16);
                d[0] = (v4u){top[0], top[1], top[2], top[3]}; d[1] = (v4u){top[4], top[5], top[6], top[7]}; d[2] = (v4u){top[8], top[9], top[10], top[11]}; d[3] = (v4u){top[12], top[13], top[14], top[15]}; }
        }
        LDS_WAIT();
        const LAS unsigned* l1 = lst + (16 * tb + c16) * 16; const LAS unsigned* l2 = lst + (32 + 16 * tb + c16) * 16;
        unsigned ck[16];
#pragma unroll
        for (int k = 0; k < 13; ++k) { const unsigned ab = PEER_CAND[4 * k + g]; const unsigned a = ab >> 4, bq = ab & 15u;
            const float s = ord2f(l1[a] & ~0x7Fu) + ord2f(l2[bq] & ~0x7Fu); ck[k] = (ab == 255u) ? 0u : ((f2ord(s) & ~0xFFu) | ab); }
        ck[13] = 0u; ck[14] = 0u; ck[15] = 0u;
        bitonic_sort_desc<16>(ck);
        merge16_xor(ck, 16); merge16_xor(ck, 32);
        if (g == 0) { const int tl = 16 * tb + c16; const float m = ord2f(ck[0] & ~0xFFu); float e[16]; float sum = 0.f;
#pragma unroll
            for (int k = 0; k < 16; ++k) { e[k] = __expf(ord2f(ck[k] & ~0xFFu) - m); sum += e[k]; }
            const float inv = 1.f / sum;
#pragma unroll
            for (int k = 0; k < 16; ++k) { const unsigned a = (ck[k] >> 4) & 15u, bq = ck[k] & 15u; const int ex = (int)((l1[a] & 0x7Fu) * 128u + (l2[bq] & 0x7Fu));
                eidx[tl * 128 + w * 16 + k] = ex; gate[tl * 128 + w * 16 + k] = e[k] * inv; } }
    }
#endif
    __syncthreads();
    LAS unsigned char* hnb = lds + P_HN + w * 4096; LAS float* actl = (LAS float*)(lds + P_ACT) + w * 128;
    const LAS unsigned char* hb = hnb + 16 * g + ((c16 == 1) ? 1024 : 0);
    v4u bA[8], bB[8];
#ifdef PROBE_UROW
#define U_ISSUE(buf, e_, jb) do { if (dry) { _Pragma("unroll") for (int jj = 0; jj < 8; ++jj) { const unsigned uo_ = (unsigned)__shfl((int)(e_), 8 * (jb) + jj) * (unsigned)ROWB + 16u * (unsigned)lane; buf[jj] = *(const GAS v4u*)(U8 + uo_); } } else { \
        const unsigned uo_ = (unsigned)(e_) * (unsigned)ROWB + 16u * (unsigned)g + 512u * (unsigned)(jb); \
        _Pragma("unroll") for (int jj = 0; jj < 8; ++jj) buf[jj] = *(const GAS v4u*)(U8 + (uo_ + 64u * jj)); } __builtin_amdgcn_sched_barrier(0); } while (0)
#else
#define U_ISSUE(buf, e_, jb) do { const unsigned uo_ = (unsigned)(e_) * (unsigned)ROWB + 16u * (unsigned)g + 512u * (unsigned)(jb); \
        _Pragma("unroll") for (int jj = 0; jj < 8; ++jj) buf[jj] = *(const GAS v4u*)(U8 + (uo_ + 64u * jj)); __builtin_amdgcn_sched_barrier(0); } while (0)
#endif
#define U_CONSUME(buf, jb) do { v4u bq_[8]; _Pragma("unroll") for (int jj = 0; jj < 8; ++jj) bq_[jj] = *(const LAS v4u*)(hb + 64 * (8 * (jb) + jj)); \
        __builtin_amdgcn_sched_barrier(0); \
        _Pragma("unroll") for (int jj = 0; jj < 8; ++jj) { const v4u a_ = buf[jj]; \
            const v8i av_ = {(int)a_.x, (int)a_.y, (int)a_.z, (int)a_.w, 0, 0, 0, 0}; const v8i bv_ = {(int)bq_[jj].x, (int)bq_[jj].y, (int)bq_[jj].z, (int)bq_[jj].w, 0, 0, 0, 0}; \
            acc = __builtin_amdgcn_mfma_scale_f32_16x16x128_f8f6f4(av_, bv_, acc, 4, 4, 0, 0x7f7f7f7f, 0, 0x7f7f7f7f); } __builtin_amdgcn_sched_barrier(0); } while (0)
#define U_ACT(grp_) do { const float l0_ = __shfl_down(acc.x, 1), l1_ = __shfl_down(acc.y, 1), l2_ = __shfl_down(acc.z, 1), l3_ = __shfl_down(acc.w, 1); \
        if (c16 == 0) { const int k0 = 16 * (grp_) + 4 * g; constexpr float isc = 1.f / (SU * SH4), ilo = 1.f / SLO4; const f32x4 gt = *(const LAS f32x4*)(gate + tl * 128 + k0); \
        f32x4 a4; a4.x = gelu_erf((acc.x + l0_ * ilo) * isc) * gt.x; a4.y = gelu_erf((acc.y + l1_ * ilo) * isc) * gt.y; a4.z = gelu_erf((acc.z + l2_ * ilo) * isc) * gt.z; a4.w = gelu_erf((acc.w + l3_ * ilo) * isc) * gt.w; *(LAS f32x4*)(actl + k0) = a4; } } while (0)
#define V_ISSUE(buf, kb_) do { _Pragma("unroll") for (int kk = 0; kk < 8; ++kk) { const int e_ = eidx[tl * 128 + 8 * (kb_) + kk] & emask; const unsigned vo_ = (unsigned)e_ * (unsigned)ROWB + 16u * (unsigned)lane; \
        buf[kk] = *(const GAS v4u*)(V8 + vo_); } __builtin_amdgcn_sched_barrier(0); } while (0)
#ifdef FP4_SOFT_DEC
#define FP4_DEC(x) fp4_dec2(x)
#else
#define FP4_DEC(x) __builtin_amdgcn_cvt_scalef32_pk_f32_fp4((x), 1.0f, 0)
#endif
#ifdef FP4_SWAP_DEC
#define FP4_ACC(oa, ob, d) do { oa += a_ * d.y; ob += a_ * d.x; } while (0)
#else
#define FP4_ACC(oa, ob, d) do { oa += a_ * d.x; ob += a_ * d.y; } while (0)
#endif
#define PIN8x2(a, i) asm volatile("" : "+v"(a[i]), "+v"(a[i + 1]), "+v"(a[i + 2]), "+v"(a[i + 3]), "+v"(a[i + 4]), "+v"(a[i + 5]), "+v"(a[i + 6]), "+v"(a[i + 7]))
#define V_CONSUME(buf, kb_) do { _Pragma("unroll") for (int kk = 0; kk < 8; ++kk) { const float as_ = actl[8 * (kb_) + kk]; const f32x2 a2_ = {as_, as_}; \
        const unsigned vw[4] = {buf[kk].x, buf[kk].y, buf[kk].z, buf[kk].w}; \
        _Pragma("unroll") for (int q = 0; q < 4; ++q) { \
            o2[4 * q]     = __builtin_elementwise_fma(__builtin_amdgcn_cvt_scalef32_pk_f32_fp4(vw[q], 1.0f, 0), a2_, o2[4 * q]); \
            o2[4 * q + 1] = __builtin_elementwise_fma(__builtin_amdgcn_cvt_scalef32_pk_f32_fp4(vw[q], 1.0f, 1), a2_, o2[4 * q + 1]); \
            o2[4 * q + 2] = __builtin_elementwise_fma(__builtin_amdgcn_cvt_scalef32_pk_f32_fp4(vw[q], 1.0f, 2), a2_, o2[4 * q + 2]); \
            o2[4 * q + 3] = __builtin_elementwise_fma(__builtin_amdgcn_cvt_scalef32_pk_f32_fp4(vw[q], 1.0f, 3), a2_, o2[4 * q + 3]); } \
        PIN8x2(o2, 0); PIN8x2(o2, 8); } } while (0)
#define V_KEEP(buf) do { _Pragma("unroll") for (int kk = 0; kk < 8; ++kk) asm volatile("" :: "v"(buf[kk])); } while (0)
#ifndef NO_GATHER
#ifdef PROBE_L2RES
    constexpr int emask = dry ? PROBE_L2RES : 16383;
#else
    constexpr int emask = 16383;
#endif
    int e_cur = eidx[w * 128 + c16] & emask;
    v2u xn[8];
#define X_ISSUE(tok_) do { const unsigned xb_ = (unsigned)(tok_) * (unsigned)(DM * 2) + 8u * (unsigned)lane; _Pragma("unroll") for (int j = 0; j < 8; ++j) xn[j] = __builtin_nontemporal_load((const GAS v2u*)((const unsigned char*)X1B + (xb_ + 512u * j))); } while (0)
    X_ISSUE(T0 + w);
    U_ISSUE(bA, e_cur, 0);
    for (int ti = 0; ti < 4; ++ti) {
        const int tl = w + 8 * ti; const size_t token = (size_t)T0 + tl;
        f32x4 xr[8]; float ss = 0.f;
        const unsigned xo = (unsigned)token * (unsigned)(DM * 4) + 16u * (unsigned)lane;
        {
#pragma unroll
          for (int j = 0; j < 8; ++j) { const v2u r = xn[j]; xr[j] = (f32x4){bflo(r.x), bfhi(r.x), bflo(r.y), bfhi(r.y)}; }
#pragma unroll
          for (int j = 0; j < 8; ++j) ss += (xr[j].x * xr[j].x + xr[j].y * xr[j].y) + (xr[j].z * xr[j].z + xr[j].w * xr[j].w); }
        const float rs2 = __builtin_amdgcn_rsqf(wave_sum(ss) * (1.f / DM) + EPS);
        {
          const float* fg_ = fgain; asm volatile("" : "+s"(fg_));
          const unsigned char* gp = (const unsigned char*)fg_; const unsigned go = 16u * (unsigned)lane;
          unsigned hw[4], lw[4];
#pragma unroll
          for (int q = 0; q < 4; ++q) { unsigned wh = 0u, wl = 0u;
#pragma unroll
              for (int t = 0; t < 2; ++t) { const int j = 2 * q + t; const f32x4 gg = *(const GAS f32x4*)(gp + (go + 1024u * j)); const f32x4 hv = xr[j] * gg * (rs2 * SH4);
                  const float h0 = clampf(hv.x, 6.f), h1 = clampf(hv.y, 6.f), h2 = clampf(hv.z, 6.f), h3 = clampf(hv.w, 6.f);
                  const unsigned p0 = __builtin_amdgcn_cvt_scalef32_pk_fp4_f32(0u, h0, h1, 1.0f, 0), p1 = __builtin_amdgcn_cvt_scalef32_pk_fp4_f32(0u, h2, h3, 1.0f, 0);
                  const f32x2 d0 = __builtin_amdgcn_cvt_scalef32_pk_f32_fp4(p0, 1.0f, 0), d1 = __builtin_amdgcn_cvt_scalef32_pk_f32_fp4(p1, 1.0f, 0);
                  const unsigned r0 = __builtin_amdgcn_cvt_scalef32_pk_fp4_f32(0u, clampf((h0 - d0.x) * SLO4, 6.f), clampf((h1 - d0.y) * SLO4, 6.f), 1.0f, 0), r1 = __builtin_amdgcn_cvt_scalef32_pk_fp4_f32(0u, clampf((h2 - d1.x) * SLO4, 6.f), clampf((h3 - d1.y) * SLO4, 6.f), 1.0f, 0);
                  wh |= ((p0 & 0xFFu) | ((p1 & 0xFFu) << 8)) << (16 * t); wl |= ((r0 & 0xFFu) | ((r1 & 0xFFu) << 8)) << (16 * t); }
              hw[q] = wh; lw[q] = wl; }
          *(LAS v4u*)(hnb + 16 * lane) = (v4u){hw[0], hw[1], hw[2], hw[3]}; *(LAS v4u*)(hnb + 1024 + 16 * lane) = (v4u){lw[0], lw[1], lw[2], lw[3]}; }
        LDS_WAIT();
#pragma unroll 1
        for (int grp = 0; grp < 7; ++grp) {
            const int e_nxt = eidx[tl * 128 + 16 * (grp + 1) + c16] & emask;
            f32x4 acc = (f32x4){0.f, 0.f, 0.f, 0.f};
            U_ISSUE(bB, e_cur, 1); U_CONSUME(bA, 0);
            U_ISSUE(bA, e_nxt, 0);
            U_CONSUME(bB, 1);
            U_ACT(grp);
            e_cur = e_nxt;
        }
        { f32x4 acc = (f32x4){0.f, 0.f, 0.f, 0.f};
          U_ISSUE(bB, e_cur, 1); U_CONSUME(bA, 0);
          V_ISSUE(bA, 0);
          U_CONSUME(bB, 1);
          U_ACT(7); }
        LDS_WAIT();
        f32x2 o2[16];
#pragma unroll
        for (int i = 0; i < 16; ++i) o2[i] = (f32x2){0.f, 0.f};
#pragma unroll 1
        for (int kb = 0; kb < 14; kb += 2) {
            V_ISSUE(bB, kb + 1); V_CONSUME(bA, kb);
            V_ISSUE(bA, kb + 2);
            V_CONSUME(bB, kb + 1);
        }
        { V_ISSUE(bB, 15); V_CONSUME(bA, 14);
          const int tn = (ti < 3) ? tl + 8 : tl;
          e_cur = eidx[tn * 128 + c16] & emask; X_ISSUE(T0 + tn); U_ISSUE(bA, e_cur, 0);
          V_CONSUME(bB, 15); }
        { constexpr float isv = 1.f / SV; float s2 = 0.f;
#pragma unroll
          for (int j = 0; j < 8; ++j) { xr[j] = xr[j] + (f32x4){o2[2 * j].x, o2[2 * j].y, o2[2 * j + 1].x, o2[2 * j + 1].y} * isv;
              s2 += (xr[j].x * xr[j].x + xr[j].y * xr[j].y) + (xr[j].z * xr[j].z + xr[j].w * xr[j].w); }
          const float rf = __builtin_amdgcn_rsqf(wave_sum(s2) * (1.f / DM) + EPS);
          const float* fi_ = fing; asm volatile("" : "+s"(fi_));
          const unsigned char* fp = (const unsigned char*)fi_; unsigned char* op = (unsigned char*)outp; const unsigned fo = 16u * (unsigned)lane;
          if (!dry || rf == 1.2345e30f)
#pragma unroll
          for (int j = 0; j < 8; ++j) __builtin_nontemporal_store(xr[j] * rf * *(const GAS f32x4*)(fp + (fo + 1024u * j)), (GAS f32x4*)(op + (xo + 1024u * j))); }
    }
#endif
#undef U_ISSUE
#undef X_ISSUE
#undef U_ACT
#undef U_CONSUME
#undef V_ISSUE
#undef V_CONSUME
    __syncthreads();
}

__global__ void __launch_bounds__(NWAVES * 64, 2) hybrid_fwd(Args args) {
    extern __shared__ __attribute__((aligned(16))) unsigned char lds[];
    Frame F;
    F.lds = (LAS unsigned char*)lds;
    F.MISC = (volatile LAS unsigned*)(F.lds + MISC_OFF);
    F.tid = threadIdx.x; F.lane = F.tid & 63; F.wave = __builtin_amdgcn_readfirstlane(F.tid >> 6); F.G = gridDim.x;
    for (int u = F.tid; u < (LDS_BYTES - LDSCTL_OFF) / 4; u += NWAVES * 64) ((LAS unsigned*)(F.lds + LDSCTL_OFF))[u] = 0u;
    __syncthreads();
    (void)args;
    XcdBarrier bar = xcd_barrier_post(F.ctl() + CW_BAR, F.MISC + 8);

#ifndef NO_P0
#ifdef PROBE_P0X2
    { int reps = 2; asm volatile("" : "+s"(reps)); for (int rep = 0; rep < reps; ++rep) p0_prologue(F); }
#else
    p0_prologue(F);
#endif
#endif
    xcd_barrier(bar);
#ifndef NO_P1
#ifdef PROBE_GX2
    { int reps = 2; asm volatile("" : "+s"(reps)); for (int rep = 0; rep < reps; ++rep) {
#else
    { { const int rep = 0, reps = 1;
#endif
      pg8::Gemm gm{F.HN(), F.WinT(), MTOK, NB16, DM}; pg8::StaticOrder S; S.init(MTOK, NB16, F.G, (int)blockIdx.x);
      EpiProj E{F.PROJ(), F.dtraw(), (rep + 1 < reps) ? nullptr : F.kmean()};
      pg8::gemm_phase<EpiProj, pg8::StaticOrder, PG8_ALIGN, PG8_SP2>(F.lds + RING_OFF, gm, S, E); } }
    { const int nun = (MTOK / 256) * (NB16 / 256), rem = nun % F.G;
      if (rem && (int)blockIdx.x >= rem) tables_convert(F, tab_split(F.G), TAB_ITEMS, (size_t)((int)blockIdx.x - rem) * (NWAVES * 64) + fresh_tid(), (size_t)(F.G - rem) * (NWAVES * 64)); }
    __syncthreads();
    {
      pg8::Gemm gm{(const pg8::bf16_t*)F.HN8(), (const pg8::bf16_t*)F.WinT8(), MTOK, F8_HI - F8_LO, DM / 2}; pg8::StaticOrder S; S.init(MTOK, F8_HI - F8_LO, F.G, (int)blockIdx.x);
      EpiProj8 E{F.PROJ()};
      pg8::gemm_phase<EpiProj8, pg8::StaticOrder, PG8_ALIGN, PG8_SP2, true>(F.lds + RING_OFF, gm, S, E); }
#endif
    xcd_barrier(bar);
#ifdef PROBE_P15X2
    conv_phase(F);
#endif
    conv_phase(F);
    xcd_barrier(bar);
#ifdef PROBE_P2X2
    { int reps = 2; asm volatile("" : "+s"(reps)); for (int rep = 0; rep < reps; ++rep) {
#else
    { { const int rep = 0, reps = 1;
#endif
    const bool doatom = rep + 1 == reps;
    for (;;) {
        if (F.tid == 0) F.MISC[0] = xb_add(F.ctl() + CW_Q2 + 64 * rep, 1u);
        __syncthreads();
        const int ui = (int)F.MISC[0];
        __syncthreads();
        if (ui >= 128 + 512) break;
#ifdef PROBE_P2_SSD
        if (ui < 128 || doatom)
#endif
#ifdef PROBE_P2_ATT
        if (ui >= 128 || doatom)
#endif
        {
        if (ui < 128) ssd_unit(F, ui >> 4, ui & 15, doatom);
        else { const int a = ui - 128; attn_unit(F, (a & 63) >> 3, a & 7, 7 - (a >> 6), doatom); }
        }
    } } }
    xcd_barrier(bar);
#ifndef NO_P3
#ifdef PROBE_GX2
    { int reps = 2; asm volatile("" : "+s"(reps)); for (int rep = 0; rep < reps; ++rep) {
#else
    { { const int rep = 0, reps = 1;
#endif
      pg8::Gemm gm{F.HN(), F.WoutT(), MTOK, DM, DM / 2}; pg8::StaticOrder S; S.init(MTOK, DM, F.G, (int)blockIdx.x);
      {
        const int t_ = fresh_tid(); const float* const sq = F.ssq();
#pragma unroll 1
        for (int ii = t_ >> 8; ii < 3; ii += 2) { pg8::Unit uu;
          if (S.next(ii, uu)) { const int row = uu.pm * 256 + (t_ & 255);
            const float q1 = __hip_atomic_load(sq + (size_t)row * 4 + 1, RLX_AGENT), q2 = __hip_atomic_load(sq + (size_t)row * 4 + 2, RLX_AGENT), q3 = __hip_atomic_load(sq + (size_t)row * 4 + 3, RLX_AGENT);
            const float sa = __builtin_amdgcn_rsqf(q1 * (1.f / 1024.f) + EPS), s0 = __builtin_amdgcn_rsqf(q2 * (1.f / 512.f) + EPS), s1 = __builtin_amdgcn_rsqf(q3 * (1.f / 512.f) + EPS);
            *(LAS f32x4*)(F.lds + SEGTAB_OFF + (ii * 256 + (t_ & 255)) * 16) = (f32x4){sa / s0 * (SS8 / SA8), s0 / s1, s1 * (1.f / (SS8 * SW8)), 0.f}; } }
        __syncthreads(); }
      EpiOut E{F.x(), F.X1B(), F.X18(), F.ssq(), rep + 1 == reps, (const LAS f32x4*)(F.lds + SEGTAB_OFF)};
      pg8::gemm_phase<EpiOut, pg8::StaticOrder, PG8_ALIGN, PG8_SP2, true>(F.lds + RING_OFF, gm, S, E); } }
#endif
    xcd_barrier(bar);
#ifndef NO_P4
#ifdef PROBE_GX2
    { int reps = 2; asm volatile("" : "+s"(reps)); for (int rep = 0; rep < reps; ++rep) {
#else
    { { const int rep = 0, reps = 1; (void)rep; (void)reps;
#endif
      pg8::Gemm gm{(const pg8::bf16_t*)F.X18(), F.WqT(), MTOK, DM, DM / 2}; pg8::StaticOrder S; S.init(MTOK, DM, F.G, (int)blockIdx.x);
      EpiQ E{F.QP(), F.ssq()};
      pg8::gemm_phase<EpiQ, pg8::StaticOrder, PG8_ALIGN, PG8_SP2, true>(F.lds + RING_OFF, gm, S, E); } }
#endif
    xcd_barrier(bar);
#ifndef NO_P5
#ifdef PROBE_P5X2
    { for (int u = blockIdx.x; u < MTOK / 32; u += F.G) peer_unit<true>(F, u);
      for (int u = blockIdx.x; u < MTOK / 32; u += F.G) peer_unit<false>(F, u); }
#else
    for (int u = blockIdx.x; u < MTOK / 32; u += F.G) peer_unit(F, u);
#endif
#endif
}

extern "C" void kernel_launch(void* const* d_in, const int* in_sizes, int n_in, void* d_out, int out_size, void* d_ws, size_t ws_size, hipStream_t stream) {
    static int grid = 0;
    if (grid == 0) {
        if (n_in != 18 || out_size != MTOK * DM || ws_size < WS_END) { fprintf(stderr, "kernel_launch: unexpected shapes (n_in %d, out %d, ws %zu)\n", n_in, out_size, ws_size); grid = -1; return; }
        int dev = 0, cus = 0, per_cu = 0;
        if (hipGetDevice(&dev) != hipSuccess || hipDeviceGetAttribute(&cus, hipDeviceAttributeMultiprocessorCount, dev) != hipSuccess) { grid = -1; return; }
        if (hipFuncSetAttribute((const void*)hybrid_fwd, hipFuncAttributeMaxDynamicSharedMemorySize, LDS_BYTES) != hipSuccess) { fprintf(stderr, "kernel_launch: hipFuncSetAttribute failed\n"); grid = -1; return; }
        if (hipOccupancyMaxActiveBlocksPerMultiprocessor(&per_cu, (const void*)hybrid_fwd, NWAVES * 64, LDS_BYTES) != hipSuccess || per_cu < 1)
            fprintf(stderr, "kernel_launch: note: occupancy query reports %d workgroups per CU\n", per_cu);
        (void)hipGetLastError();
        grid = cus;
    }
    if (grid < 0) return;
    if (hipMemsetAsync((char*)d_ws + WS_CTL, 0, CTL_ZERO_BYTES, stream) != hipSuccess) return;
    Args a{};
    for (int i = 0; i < 18; ++i) a.in[i] = (const float*)d_in[i];
    a.out = (float*)d_out; a.ws = (unsigned char*)d_ws;
    hipLaunchKernelGGL(hybrid_fwd, dim3(grid), dim3(NWAVES * 64), LDS_BYTES, stream, a);
}
```

```cpp
#include <hip/hip_runtime.h>
#include <cstdio>
#include <cstdint>
namespace pg8 {
#define PG8_LAS __attribute__((address_space(3)))
typedef unsigned short bf16_t;
typedef short bf16x8 __attribute__((ext_vector_type(8)));
typedef float f32x4 __attribute__((ext_vector_type(4)));
typedef unsigned u32x4 __attribute__((ext_vector_type(4)));
constexpr int BM = 256, BK = 64, HALF = 128, HTB = HALF * BK * 2  , STAGE_BYTES = 8 * HTB, NXCD = 8, WGM = 8;

__host__ __device__ __forceinline__ int lds_byte(int r, int c) { const int st = (r >> 4) * 2 + (c >> 5), rr = r & 15, cc = c & 31, ob = rr * 64 + cc * 2; return st * 1024 + (ob ^ (((ob >> 9) & 1) << 5)); }
__host__ __device__ __forceinline__ void stage_rc(int b, int& R, int& C) { const int st = b / 1024, sb = b % 1024, swz = sb ^ (((sb >> 9) & 1) << 5); R = (st >> 1) * 16 + swz / 64; C = (st & 1) * 32 + (swz % 64) / 2; }
__host__ __device__ __forceinline__ int perm32(int rho) { const int n = rho >> 4, i = rho & 15; return 8 * (i >> 2) + 4 * n + (i & 3); }

struct Unit { int pm, pn; };
struct Gemm { const bf16_t* A; const bf16_t* Bt; int M, N, K; };

struct StaticOrder {
    int nM, nN, nwg, G, c;
    __host__ __device__ void init(int M, int N, int G_, int c_) { nM = M / BM; nN = N / BM; nwg = nM * nN; G = G_; c = c_; }
    __host__ __device__ bool next(int i, Unit& u) const {
        const long L = (long)i * G + c; if (L >= nwg) return false;
        int wgid = (int)L; { const int q = nwg / NXCD, r = nwg % NXCD, xcd = wgid % NXCD, off = wgid / NXCD; wgid = (xcd < r ? xcd * (q + 1) : r * (q + 1) + (xcd - r) * q) + off; }
        const int nig = WGM * nN, gid = wgid / nig, fm = gid * WGM, gsz = (nM - fm) < WGM ? (nM - fm) : WGM;
        u.pm = fm + ((wgid % nig) % gsz); u.pn = (wgid % nig) / gsz; return true;
    }
    __device__ __forceinline__ void a_ready(const Unit&) const {}
    __device__ __forceinline__ void done(const Unit&) const {}
};

__device__ __forceinline__ unsigned cvt_pk_bf16(float lo, float hi) { unsigned r; asm volatile("v_cvt_pk_bf16_f32 %0, %1, %2" : "=v"(r) : "v"(lo), "v"(hi)); return r; }
typedef float f32x2 __attribute__((ext_vector_type(2)));
__device__ __forceinline__ f32x2 gelu_pk(f32x2 v) {
    const f32x2 av = __builtin_elementwise_abs(v), d = av * 0.2316418882f + 1.0f;
    f32x2 t; t.x = __builtin_amdgcn_rcpf(d.x); t.y = __builtin_amdgcn_rcpf(d.y);
    f32x2 q = t * 0.5307027145f + (-0.7265760135f); q = q * t + 0.7107068705f; q = q * t + (-0.142248368f); q = q * t + 0.127414796f; q = q * t;
    const f32x2 s = (v * v) * (-0.72134752044f);
    f32x2 e; e.x = __builtin_amdgcn_exp2f(s.x); e.y = __builtin_amdgcn_exp2f(s.y);
    const f32x2 m = v * (q * e), r = v - m;
    f32x2 o; o.x = v.x < 0.f ? m.x : r.x; o.y = v.y < 0.f ? m.y : r.y; return o;
}

template <int ACT  > struct EpiBf16 {
    static constexpr bool PERM = true, AFTER_DRAIN = false, SEG = false; static_assert(ACT == 0 || ACT == 1, "EpiBf16: ACT is 0 (none) or 1 (gelu_pk)");
    bf16_t* O; int ldc; const float* bias; int split_cols; size_t split_stride; float scale0;
    __device__ __forceinline__ void operator()(const f32x4 (&acc)[2][2][4][2], const Unit& u, int wr, int wc, int fr, int fq) const {
        const int row0 = u.pm * BM + wr * 64 + fr; int colt = u.pn * BM; bf16_t* base = O;
        float sc = 1.f; if (split_cols) { const int t = colt / split_cols; base += (size_t)t * split_stride; colt -= t * split_cols; if (t == 0) sc = scale0; }
        const int col0 = colt + wc * 32 + 8 * fq, bcol0 = u.pn * BM + wc * 32 + 8 * fq;
        f32x4 bv[2][2];
#pragma unroll
        for (int bj = 0; bj < 2; ++bj)
#pragma unroll
            for (int n = 0; n < 2; ++n) bv[bj][n] = bias ? *(const f32x4*)(bias + bcol0 + bj * HALF + 4 * n) : (f32x4){0.f, 0.f, 0.f, 0.f};
#pragma unroll
        for (int ai = 0; ai < 2; ++ai)
#pragma unroll
            for (int m = 0; m < 4; ++m) { bf16_t* rowp = base + (size_t)(row0 + ai * HALF + m * 16) * ldc + col0;
#pragma unroll
                for (int bj = 0; bj < 2; ++bj) { f32x4 v0 = acc[ai][bj][m][0] + bv[bj][0], v1 = acc[ai][bj][m][1] + bv[bj][1];
                    if (ACT == 1) { f32x2 a = gelu_pk((f32x2){v0[0], v0[1]}), b = gelu_pk((f32x2){v0[2], v0[3]}), c = gelu_pk((f32x2){v1[0], v1[1]}), d = gelu_pk((f32x2){v1[2], v1[3]});
                        v0 = (f32x4){a.x, a.y, b.x, b.y}; v1 = (f32x4){c.x, c.y, d.x, d.y}; }
                    v0 = v0 * sc; v1 = v1 * sc; u32x4 w; w.x = cvt_pk_bf16(v0[0], v0[1]); w.y = cvt_pk_bf16(v0[2], v0[3]); w.z = cvt_pk_bf16(v1[0], v1[1]); w.w = cvt_pk_bf16(v1[2], v1[3]);
                    *(u32x4*)(rowp + bj * HALF) = w; } }
    }
};
template <class Epi, class Sched, bool ALIGN_EPI = false, bool SP2 = false, bool F8 = false>
__device__ __forceinline__ void gemm_phase(PG8_LAS unsigned char* lds, const Gemm g, const Sched& S, const Epi& E) {
    int tid_ = threadIdx.x; asm volatile("" : "+v"(tid_));
    const int tid = tid_, wid = __builtin_amdgcn_readfirstlane(tid >> 6), lane = tid & 63, wr = wid >> 2, wc = wid & 3, fr = lane & 15, fq = lane >> 4;
    const int K = g.K, nt = K / BK;
    unsigned voffA[2], voffB[2];
#pragma unroll
    for (int i = 0; i < 2; ++i) { int R, C; stage_rc(tid * 16 + i * 8192, R, C); const int Rb = Epi::PERM ? ((R & ~31) + perm32(R & 31)) : R;
        voffA[i] = (unsigned)(R * K + C) * 2u; voffB[i] = (unsigned)(Rb * K + C) * 2u; }
    const size_t kstep = (size_t)(BK * 2);
    const size_t hstep = (size_t)HALF * K * 2;
    const size_t tstep = 2 * hstep;
    const unsigned ldsw = (unsigned)wid * 1024u;
    const int aoff = lds_byte(wr * 64 + fr, fq * 8), boff = lds_byte(wc * 32 + fr, fq * 8);
#define PG8_SA(b, h) (((b) * 2 + (h)) * HTB)
#define PG8_SB(b, h) ((4 + (b) * 2 + (h)) * HTB)
#define PG8_STAGE(bufoff, gbase, voff) do { _Pragma("unroll") for (int _i = 0; _i < 2; ++_i) \
        __builtin_amdgcn_global_load_lds((const unsigned*)((const char*)(gbase) + (voff)[_i]), (PG8_LAS unsigned*)(lds + (bufoff) + ldsw + _i * 8192), 16, 0, 0); } while (0)
#define PG8_LDA(dst, b, h) do { _Pragma("unroll") for (int m = 0; m < 4; ++m) _Pragma("unroll") for (int k = 0; k < 2; ++k) dst[m][k] = *(const PG8_LAS bf16x8*)(lds + PG8_SA(b, h) + aoff + m * 2048 + k * 1024); } while (0)
#define PG8_LDB(dst, b, h) do { _Pragma("unroll") for (int n = 0; n < 2; ++n) _Pragma("unroll") for (int k = 0; k < 2; ++k) dst[n][k] = *(const PG8_LAS bf16x8*)(lds + PG8_SB(b, h) + boff + n * 2048 + k * 1024); } while (0)
#define PG8_MMA(ai, bj, At, Bt) do { __builtin_amdgcn_s_setprio(1); _Pragma("unroll") for (int m = 0; m < 4; ++m) _Pragma("unroll") for (int n = 0; n < 2; ++n) { \
        if constexpr (F8) { typedef int v8i_ __attribute__((ext_vector_type(8))); typedef int v4i_ __attribute__((ext_vector_type(4))); \
            const v4i_ b0_ = __builtin_bit_cast(v4i_, Bt[n][0]), b1_ = __builtin_bit_cast(v4i_, Bt[n][1]), a0_ = __builtin_bit_cast(v4i_, At[m][0]), a1_ = __builtin_bit_cast(v4i_, At[m][1]); \
            const v8i_ bb_ = {b0_.x, b0_.y, b0_.z, b0_.w, b1_.x, b1_.y, b1_.z, b1_.w}, aa_ = {a0_.x, a0_.y, a0_.z, a0_.w, a1_.x, a1_.y, a1_.z, a1_.w}; \
            asm volatile("v_mfma_scale_f32_16x16x128_f8f6f4 %0, %1, %2, %0, %3, %3 op_sel_hi:[0,0,0]" : "+v"(acc[ai][bj][m][n]) : "v"(bb_), "v"(aa_), "v"(f8one)); } \
        else { _Pragma("unroll") for (int k = 0; k < 2; ++k) acc[ai][bj][m][n] = __builtin_amdgcn_mfma_f32_16x16x32_bf16(Bt[n][k], At[m][k], acc[ai][bj][m][n], 0, 0, 0); } } \
        __builtin_amdgcn_s_setprio(0); } while (0)
#define PG8_WAIT_V(n) asm volatile("s_waitcnt vmcnt(" #n ")" ::: "memory")
#define PG8_WAIT_L(n) asm volatile("s_waitcnt lgkmcnt(" #n ")" ::: "memory")
#define PG8_BAR __builtin_amdgcn_s_barrier()
#define PG8_SCHED __builtin_amdgcn_sched_barrier(0)
    Unit cur, nxt; int ui = 0;
    if (!S.next(0, cur)) return;
    f32x4 acc[2][2][4][2];
    const int f8one = 0x7f7f7f7f;
#pragma unroll
    for (int a = 0; a < 2; ++a)
#pragma unroll
        for (int b = 0; b < 2; ++b)
#pragma unroll
            for (int m = 0; m < 4; ++m)
#pragma unroll
                for (int n = 0; n < 2; ++n) acc[a][b][m][n] = (f32x4){0.f, 0.f, 0.f, 0.f};
    bf16x8 At[4][2], B0[2][2], B1[2][2];
    const char* cA = (const char*)g.A + (size_t)cur.pm * tstep; const char* cB = (const char*)g.Bt + (size_t)cur.pn * tstep;
    S.a_ready(cur);
    float segr[16];
    if constexpr (Epi::SEG) E.seg_load(ui, wr, fr, segr);
    if constexpr (SP2) {
        PG8_STAGE(PG8_SB(0, 0), cB, voffB); PG8_STAGE(PG8_SB(0, 1), cB + hstep, voffB); PG8_STAGE(PG8_SA(0, 0), cA, voffA); PG8_STAGE(PG8_SA(0, 1), cA + hstep, voffA);
        if (wr == 1) PG8_BAR;
        PG8_WAIT_V(2); PG8_BAR;
        PG8_STAGE(PG8_SB(1, 0), cB + kstep, voffB); PG8_STAGE(PG8_SA(1, 0), cA + kstep, voffA); PG8_STAGE(PG8_SB(1, 1), cB + hstep + kstep, voffB);
        PG8_WAIT_V(6); PG8_BAR;
    } else {
        PG8_STAGE(PG8_SB(0, 0), cB, voffB); PG8_STAGE(PG8_SA(0, 0), cA, voffA); PG8_STAGE(PG8_SB(0, 1), cB + hstep, voffB); PG8_STAGE(PG8_SA(0, 1), cA + hstep, voffA);
        if (wr == 1) PG8_BAR;
        PG8_WAIT_V(4); PG8_BAR;
        PG8_STAGE(PG8_SB(1, 0), cB + kstep, voffB); PG8_STAGE(PG8_SA(1, 0), cA + kstep, voffA); PG8_STAGE(PG8_SB(1, 1), cB + hstep + kstep, voffB);
        PG8_WAIT_V(6); PG8_BAR;
    }
    for (;;) {
        const bool has_next = S.next(ui + 1, nxt);
        const char* nA = has_next ? (const char*)g.A + (size_t)nxt.pm * tstep : cA; const char* nB = has_next ? (const char*)g.Bt + (size_t)nxt.pn * tstep : cB;
        int t = 0;
#pragma unroll 1
        for (int sgi = 0; sgi < (Epi::SEG ? 3 : 1); ++sgi) {
        int tend = nt; if constexpr (Epi::SEG) tend = (sgi == 0) ? Epi::SEG_T1 : ((sgi == 1) ? Epi::SEG_T2 : nt);
        for (; t < tend; t += 2) {
            const bool last = (t == nt - 2);
            const char* a1 = cA + (size_t)(t + 1) * kstep;
            const char* a2 = last ? nA : cA + (size_t)(t + 2) * kstep; const char* b2 = last ? nB : cB + (size_t)(t + 2) * kstep;
            const char* a3 = a2 + kstep; const char* b3 = b2 + kstep;
            if (last && has_next) S.a_ready(nxt);
            if constexpr (SP2) {
            PG8_LDB(B0, 0, 0); PG8_LDB(B1, 0, 1); PG8_SCHED; PG8_LDA(At, 0, 0); PG8_STAGE(PG8_SA(1, 1), a1 + hstep, voffA);
            PG8_WAIT_V(8); PG8_WAIT_L(0); PG8_BAR; PG8_MMA(0, 0, At, B0); PG8_MMA(0, 1, At, B1); PG8_BAR; PG8_SCHED;
            PG8_LDA(At, 0, 1); PG8_STAGE(PG8_SB(0, 0), b2, voffB); PG8_STAGE(PG8_SB(0, 1), b2 + hstep, voffB); PG8_STAGE(PG8_SA(0, 0), a2, voffA);
            PG8_WAIT_V(8); PG8_WAIT_L(0); PG8_BAR; PG8_MMA(1, 0, At, B0); PG8_MMA(1, 1, At, B1); PG8_BAR; PG8_SCHED;
            PG8_LDB(B0, 1, 0); PG8_LDB(B1, 1, 1); PG8_SCHED; PG8_LDA(At, 1, 0); PG8_STAGE(PG8_SA(0, 1), a2 + hstep, voffA);
            PG8_WAIT_V(8); PG8_WAIT_L(0); PG8_BAR; PG8_MMA(0, 0, At, B0); PG8_MMA(0, 1, At, B1); PG8_BAR; PG8_SCHED;
            PG8_LDA(At, 1, 1); PG8_STAGE(PG8_SB(1, 0), b3, voffB); PG8_STAGE(PG8_SB(1, 1), b3 + hstep, voffB); PG8_STAGE(PG8_SA(1, 0), a3, voffA);
            PG8_WAIT_V(8); PG8_WAIT_L(0); PG8_BAR; PG8_MMA(1, 0, At, B0); PG8_MMA(1, 1, At, B1); PG8_BAR; PG8_SCHED;
            } else {
            PG8_LDB(B0, 0, 0); PG8_SCHED; PG8_LDA(At, 0, 0); PG8_STAGE(PG8_SA(1, 1), a1 + hstep, voffA);
            PG8_WAIT_L(8); PG8_BAR; PG8_WAIT_L(0); PG8_MMA(0, 0, At, B0); PG8_BAR; PG8_SCHED;
            PG8_LDB(B1, 0, 1); PG8_STAGE(PG8_SB(0, 0), b2, voffB);
            PG8_BAR; PG8_WAIT_L(0); PG8_MMA(0, 1, At, B1); PG8_BAR;
            PG8_LDA(At, 0, 1); PG8_STAGE(PG8_SA(0, 0), a2, voffA);
            PG8_BAR; PG8_WAIT_L(0); PG8_MMA(1, 0, At, B0); PG8_BAR; PG8_SCHED;
            PG8_STAGE(PG8_SB(0, 1), b2 + hstep, voffB);
            PG8_WAIT_V(6); PG8_BAR; PG8_MMA(1, 1, At, B1); PG8_BAR;
            PG8_LDB(B0, 1, 0); PG8_SCHED; PG8_LDA(At, 1, 0); PG8_STAGE(PG8_SA(0, 1), a2 + hstep, voffA);
            PG8_WAIT_L(8); PG8_BAR; PG8_WAIT_L(0); PG8_MMA(0, 0, At, B0); PG8_BAR; PG8_SCHED;
            PG8_LDB(B1, 1, 1); PG8_STAGE(PG8_SB(1, 0), b3, voffB);
            PG8_BAR; PG8_WAIT_L(0); PG8_MMA(0, 1, At, B1); PG8_BAR;
            PG8_LDA(At, 1, 1); PG8_STAGE(PG8_SA(1, 0), a3, voffA);
            PG8_BAR; PG8_WAIT_L(0); PG8_MMA(1, 0, At, B0); PG8_BAR; PG8_SCHED;
            PG8_STAGE(PG8_SB(1, 1), b3 + hstep, voffB);
            PG8_WAIT_V(6); PG8_BAR; PG8_MMA(1, 1, At, B1); PG8_BAR;
            }
        }
        if constexpr (Epi::SEG) E.seg_apply(acc, segr, sgi);
        }
        if constexpr (ALIGN_EPI) { if (wr == 0) PG8_BAR; }
        if constexpr (!Epi::AFTER_DRAIN) { if constexpr (Epi::SEG) E(acc, cur, wr, wc, fr, fq, ui); else E(acc, cur, wr, wc, fr, fq); S.done(cur); }
        if (!has_next) break;
#pragma unroll
        for (int a = 0; a < 2; ++a)
#pragma unroll
            for (int b = 0; b < 2; ++b)
#pragma unroll
                for (int m = 0; m < 4; ++m)
#pragma unroll
                    for (int n = 0; n < 2; ++n) acc[a][b][m][n] = (f32x4){0.f, 0.f, 0.f, 0.f};
        cur = nxt; cA = nA; cB = nB; ++ui;
        if constexpr (Epi::SEG) E.seg_load(ui, wr, fr, segr);
        if constexpr (ALIGN_EPI) { if (wr == 1) PG8_BAR; }
    }
    PG8_WAIT_V(0);
    if constexpr (!ALIGN_EPI) { if (wr == 0) PG8_BAR; }
    PG8_BAR;
    if constexpr (Epi::AFTER_DRAIN) { E.fused(acc, cur, wr, wc, fr, fq, lds, wid, lane); S.done(cur); }
#undef PG8_SA
#undef PG8_SB
#undef PG8_STAGE
#undef PG8_LDA
#undef PG8_LDB
#undef PG8_MMA
#undef PG8_WAIT_V
#undef PG8_WAIT_L
#undef PG8_BAR
#undef PG8_SCHED
}
}
#ifndef PG8_SP2
#define PG8_SP2 true
#endif
#ifndef PG8_ALIGN
#define PG8_ALIGN true
#endif

constexpr int BATCH = 8, SEQ = 2048, DM = 2048, MTOK = BATCH * SEQ;
constexpr int ATT_W = 1024, ATT_H = 8, ATT_HD = 128, MOBA_BLK = 256, NBLK = SEQ / MOBA_BLK;
constexpr int SSM_W = 1024, SSM_H = 16, SSM_P = 64, SSM_N = 128, SSM_L = 128, SSM_NC = SEQ / SSM_L, CONV_CH = 1536;
constexpr int IN_PROJ = 5648, NPROJ = 5632  , NPAD = 5888  ;
constexpr int F8_LO = 2048, F8_HI = 3072, NB16 = NPAD - (F8_HI - F8_LO)  ;
constexpr float SH8 = 16.f;
constexpr int COL_Q = 0, COL_K = 1024, COL_V = 2048, COL_Z = 3072, COL_XBC = 4096;
constexpr int PEER_H = 8, PEER_NK = 128, PEER_K = 16, PEER_HK = 128;
constexpr float EPS = 1e-6f;
constexpr float SU = 64.f, SV = 4.f, SH = 16.f, SLO = 16.f;
constexpr float SX8 = 16.f, SW8 = 1024.f;
constexpr float SA8 = 32.f, SS8 = 8.f;
constexpr float SH4 = 1.5f, SLO4 = 4.f;
constexpr int ROWB = DM / 2;

constexpr size_t MiB = 1u << 20;
constexpr size_t WS_CTL = 0, CTL_ZERO_BYTES = 1 * MiB;
constexpr size_t WS_DT = 1 * MiB;
constexpr size_t WS_SK = 2 * MiB;
constexpr size_t WS_WIN = 4 * MiB;
constexpr size_t WS_WIN8 = 24 * MiB;
constexpr size_t WS_HN8 = 396 * MiB;
constexpr size_t WS_WOUT = 28 * MiB;
constexpr size_t WS_WQ = 36 * MiB;
constexpr size_t WS_HN = 44 * MiB;
constexpr size_t WS_PROJ = 108 * MiB;
constexpr size_t WS_X1B = WS_PROJ, WS_QP = WS_PROJ + 64 * MiB;
constexpr size_t WS_U8 = 284 * MiB, WS_V8 = 316 * MiB;
constexpr size_t WS_XBC = 348 * MiB;
constexpr size_t WS_DT2 = 3 * MiB;
constexpr size_t WS_X18 = 396 * MiB;
constexpr size_t WS_END = 428 * MiB;
constexpr int CW_BAR = 4096;
constexpr int CW_Q2 = 8192;
constexpr int CW_KMEAN = 32768;
constexpr int CW_SSQ = 131072;
static_assert((CW_SSQ + MTOK * 4) * 4 <= (int)CTL_ZERO_BYTES, "CTL words inside the memset region");

constexpr int RING_OFF = 0, RING_BYTES = 131072;
constexpr int LDSCTL_OFF = RING_BYTES, MISC_OFF = LDSCTL_OFF + 320;
constexpr int SEGTAB_OFF = LDSCTL_OFF + 1024;  static_assert(LDSCTL_OFF + 1024 + 3 * 256 * 16 <= 147456, "segment table inside the LDS allocation");
constexpr int LDS_BYTES = 147456;
constexpr int NWAVES = 8;

#define GAS __attribute__((address_space(1)))
#define LAS __attribute__((address_space(3)))
typedef unsigned short bf16;
typedef unsigned v4u __attribute__((ext_vector_type(4)));
typedef unsigned v2u __attribute__((ext_vector_type(2)));
typedef float f32x4 __attribute__((ext_vector_type(4)));
typedef float f32x2 __attribute__((ext_vector_type(2)));
typedef short bf16x8 __attribute__((ext_vector_type(8)));
typedef short s16x4 __attribute__((ext_vector_type(4)));
typedef GAS unsigned gu32;
#define RLX_AGENT __ATOMIC_RELAXED, __HIP_MEMORY_SCOPE_AGENT
#define LDS_WAIT() asm volatile("s_waitcnt lgkmcnt(0)" ::: "memory")
#define VM_WAIT() asm volatile("s_waitcnt vmcnt(0)" ::: "memory")
__device__ __forceinline__ unsigned f2bf(float f) { unsigned u = __builtin_bit_cast(unsigned, f); return (u + 0x7fffu + ((u >> 16) & 1u)) >> 16; }
typedef __bf16 bf16v2 __attribute__((ext_vector_type(2)));
__device__ __forceinline__ unsigned pk2(float lo, float hi) { bf16v2 v; v.x = (__bf16)lo; v.y = (__bf16)hi; return __builtin_bit_cast(unsigned, v); }
__device__ __forceinline__ float bflo(unsigned w) { return __builtin_bit_cast(float, w << 16); }
__device__ __forceinline__ float bfhi(unsigned w) { return __builtin_bit_cast(float, w & 0xffff0000u); }
__device__ __forceinline__ float wave_sum(float v) {
#pragma unroll
    for (int o = 1; o < 64; o <<= 1) v += __shfl_xor(v, o);
    return v;
}
__device__ __forceinline__ float silu_f(float x) { return x * __builtin_amdgcn_rcpf(1.f + __expf(-x)); }

#define XB_TMO      128
#define XB_XCNT(j)  (256  + 64 * (j))
#define XB_XSUB(j)  (1280 + 64 * (j))
#define XB_XGEN(j)  (2304 + 64 * (j))
#define XB_TOP      3328
#define XB_TOPGEN   3392
#define XCD_BAR_WORDS 3456
#define XB_SPIN_CAP (1u << 18)

__device__ __forceinline__ unsigned xb_ld(unsigned* p)              { return __hip_atomic_load(p, __ATOMIC_RELAXED, __HIP_MEMORY_SCOPE_AGENT); }
__device__ __forceinline__ unsigned xb_add(unsigned* p, unsigned v) { return __hip_atomic_fetch_add(p, v, __ATOMIC_RELAXED, __HIP_MEMORY_SCOPE_AGENT); }
__device__ __forceinline__ unsigned xb_xcc_id() { return (unsigned)__builtin_amdgcn_s_getreg((3 << 11) | 20) & 0xFu; }
#define XB_SPIN(cond, bar) do { unsigned _sp = 0; while (cond) { __builtin_amdgcn_s_sleep(1); \
    if ((++_sp & 255u) == 0u) { if (xb_ld(&(bar)[XB_TMO])) break; if (_sp > XB_SPIN_CAP) { atomicAdd(&(bar)[XB_TMO], 1u); break; } } } } while (0)

struct XcdBarrier {
    unsigned* bar; unsigned x;
    volatile LAS unsigned* st;
};
__device__ __forceinline__ XcdBarrier xcd_barrier_post(unsigned* bar, volatile LAS unsigned* st) {
    XcdBarrier b; b.bar = bar; b.x = xb_xcc_id(); b.st = st;
    if (threadIdx.x == 0) (void)xb_add(&bar[XB_XCNT(b.x)], 1u);
    return b;
}
__device__ __forceinline__ void xcd_barrier_complete(unsigned* bar, unsigned x, unsigned& nloc, unsigned& nx) {
    const unsigned G = gridDim.x * gridDim.y * gridDim.z;
    unsigned sum, cnt, mine, sp = 0u;
    for (;;) {
        sum = 0u; cnt = 0u; mine = 0u;
#pragma unroll
        for (unsigned j = 0; j < 16; ++j) { const unsigned c = xb_ld(&bar[XB_XCNT(j)]); sum += c; cnt += (c > 0u) ? 1u : 0u; mine = (j == x) ? c : mine; }
        if (sum == G) break;
        __builtin_amdgcn_s_sleep(1);
        if ((++sp & 255u) == 0u) { if (xb_ld(&bar[XB_TMO])) break; if (sp > XB_SPIN_CAP) { atomicAdd(&bar[XB_TMO], 1u); break; } }
    }
    nloc = mine > 0u ? mine : 1u; nx = cnt > 0u ? cnt : 1u;
}
__device__ __forceinline__ void xcd_barrier(const XcdBarrier& b) {
    asm volatile("s_waitcnt vmcnt(0)" ::: "memory");
    __syncthreads();
    if (threadIdx.x == 0) {
        unsigned* bar = b.bar;
        __builtin_amdgcn_s_waitcnt(0);
        unsigned nloc = b.st[0], nx = b.st[1];
        if (nloc == 0u) { xcd_barrier_complete(bar, b.x, nloc, nx); b.st[0] = nloc; b.st[1] = nx; }
        const unsigned old = xb_add(&bar[XB_XSUB(b.x)], 1u);
        const unsigned gen = old / nloc;
        if (old + 1u == (gen + 1u) * nloc) {
            __builtin_amdgcn_fence(__ATOMIC_RELEASE, "agent");
            asm volatile("s_waitcnt vmcnt(0)" ::: "memory");
            const unsigned og = xb_add(&bar[XB_TOP], 1u);
            const unsigned tg = og / nx;
            if (og + 1u == (tg + 1u) * nx) xb_add(&bar[XB_TOPGEN], 1u);
            else XB_SPIN(xb_ld(&bar[XB_TOPGEN]) == tg, bar);
            __builtin_amdgcn_fence(__ATOMIC_ACQUIRE, "agent");
            xb_add(&bar[XB_XGEN(b.x)], 1u);
            asm volatile("s_waitcnt vmcnt(0)" ::: "memory");
        } else {
            XB_SPIN(xb_ld(&bar[XB_XGEN(b.x)]) == gen, bar);
            __builtin_amdgcn_fence(__ATOMIC_ACQUIRE, "agent");
            asm volatile("s_waitcnt vmcnt(0)" ::: "memory");
        }
    }
    __syncthreads();
}

#define CAS __attribute__((address_space(4)))
struct Args { const float* in[18]; float* out; unsigned char* ws; };
__device__ __forceinline__ const CAS unsigned char* kargs() { const CAS unsigned char* p = (const CAS unsigned char*)__builtin_amdgcn_kernarg_segment_ptr(); asm volatile("" : "+s"(p)); return p; }
__device__ __forceinline__ const float* kin(int i) { return *(const float* const CAS*)(kargs() + 8 * i); }
__device__ __forceinline__ float* kout() { return *(float* const CAS*)(kargs() + 8 * 18); }
__device__ __forceinline__ unsigned char* kws() { return *(unsigned char* const CAS*)(kargs() + 8 * 19); }
__device__ __forceinline__ int fresh_tid() { int t = threadIdx.x; asm volatile("" : "+v"(t)); return t; }
struct Frame {
    LAS unsigned char* lds;
    volatile LAS unsigned* MISC;
    int tid, lane, wave, G;
    __device__ __forceinline__ const float* x() const { return kin(0); }
    __device__ __forceinline__ const float* attn_norm() const { return kin(1); }
    __device__ __forceinline__ const float* w_in() const { return kin(2); }
    __device__ __forceinline__ const float* conv_w() const { return kin(3); }
    __device__ __forceinline__ const float* conv_b() const { return kin(4); }
    __device__ __forceinline__ const float* dt_bias() const { return kin(5); }
    __device__ __forceinline__ const float* a_log() const { return kin(6); }
    __device__ __forceinline__ const float* d_skip() const { return kin(7); }
    __device__ __forceinline__ const float* rel_bias() const { return kin(8); }
    __device__ __forceinline__ const float* attn_out_norm() const { return kin(9); }
    __device__ __forceinline__ const float* ssm_out_norm() const { return kin(10); }
    __device__ __forceinline__ const float* w_out() const { return kin(11); }
    __device__ __forceinline__ const float* ffn_norm() const { return kin(12); }
    __device__ __forceinline__ const float* peer_wq() const { return kin(13); }
    __device__ __forceinline__ const float* peer_sk() const { return kin(14); }
    __device__ __forceinline__ const float* peer_u() const { return kin(15); }
    __device__ __forceinline__ const float* peer_v() const { return kin(16); }
    __device__ __forceinline__ const float* final_norm() const { return kin(17); }
    __device__ __forceinline__ float* out() const { return kout(); }
    __device__ __forceinline__ unsigned* ctl() const { return (unsigned*)(kws() + WS_CTL); }
    __device__ __forceinline__ float* dtraw() const { return (float*)(kws() + WS_DT); }
    __device__ __forceinline__ bf16* SK() const { return (bf16*)(kws() + WS_SK); }
    __device__ __forceinline__ bf16* WinT() const { return (bf16*)(kws() + WS_WIN); }
    __device__ __forceinline__ bf16* WoutT() const { return (bf16*)(kws() + WS_WOUT); }
    __device__ __forceinline__ bf16* WqT() const { return (bf16*)(kws() + WS_WQ); }
    __device__ __forceinline__ bf16* HN() const { return (bf16*)(kws() + WS_HN); }
    __device__ __forceinline__ bf16* PROJ() const { return (bf16*)(kws() + WS_PROJ); }
    __device__ __forceinline__ bf16* X1B() const { return (bf16*)(kws() + WS_X1B); }
    __device__ __forceinline__ bf16* QP() const { return (bf16*)(kws() + WS_QP); }
    __device__ __forceinline__ unsigned char* U8() const { return kws() + WS_U8; }
    __device__ __forceinline__ unsigned char* V8() const { return kws() + WS_V8; }
    __device__ __forceinline__ unsigned char* X18() const { return kws() + WS_X18; }
    __device__ __forceinline__ unsigned char* HN8() const { return kws() + WS_HN8; }
    __device__ __forceinline__ unsigned char* WinT8() const { return kws() + WS_WIN8; }
    __device__ __forceinline__ bf16* XBC() const { return (bf16*)(kws() + WS_XBC); }
    __device__ __forceinline__ float* DT2() const { return (float*)(kws() + WS_DT2); }
    __device__ __forceinline__ float* kmean() const { return (float*)(kws() + WS_CTL) + CW_KMEAN; }
    __device__ __forceinline__ float* ssq() const { return (float*)(kws() + WS_CTL) + CW_SSQ; }
};

__device__ __forceinline__ float clampf(float v, float lim);
__device__ __forceinline__ void p0_transpose_item(const float* W, int K, int N, bf16* WT, const float* gain, LAS float* scr, int item, int lane, const float f8scale = 0.f, const int nshift = 0) {
    const int nblk = (N + 31) / 32, kb = item / nblk, nb = item % nblk, k0 = 64 * kb, n0 = 32 * nb;
    const int kr = lane >> 3, nc = (lane & 7) * 4; const bool ok = (n0 + nc) < N;
    f32x4 v[8]; float gk[8];
#pragma unroll
    for (int i = 0; i < 8; ++i) { const int kk = 8 * i + kr; v[i] = ok ? *(const GAS f32x4*)(W + (size_t)(k0 + kk) * N + n0 + nc) : (f32x4){0.f, 0.f, 0.f, 0.f}; gk[i] = gain ? gain[k0 + kk] : 1.f; }
#pragma unroll
    for (int i = 0; i < 8; ++i) { const int kk = 8 * i + kr; LAS float* d = scr + kk * 33 + nc; d[0] = v[i].x * gk[i]; d[1] = v[i].y * gk[i]; d[2] = v[i].z * gk[i]; d[3] = v[i].w * gk[i]; }
    LDS_WAIT(); asm volatile("" ::: "memory");
    const int c = lane & 7;
#pragma unroll
    for (int j = 0; j < 4; ++j) { const int n = (lane >> 3) + 8 * j; const LAS float* s = scr + (8 * c) * 33 + n;
        v4u o; o.x = pk2(s[0 * 33], s[1 * 33]); o.y = pk2(s[2 * 33], s[3 * 33]); o.z = pk2(s[4 * 33], s[5 * 33]); o.w = pk2(s[6 * 33], s[7 * 33]);
        if (f8scale == 0.f) *(GAS v4u*)(WT + (size_t)(n0 + n - nshift) * K + k0 + 8 * c) = o;
        else { v2u o8; int w_;
            w_ = __builtin_amdgcn_cvt_pk_fp8_f32(clampf(s[0 * 33] * f8scale, 448.f), clampf(s[1 * 33] * f8scale, 448.f), 0, false); w_ = __builtin_amdgcn_cvt_pk_fp8_f32(clampf(s[2 * 33] * f8scale, 448.f), clampf(s[3 * 33] * f8scale, 448.f), w_, true); o8.x = (unsigned)w_;
            w_ = __builtin_amdgcn_cvt_pk_fp8_f32(clampf(s[4 * 33] * f8scale, 448.f), clampf(s[5 * 33] * f8scale, 448.f), 0, false); w_ = __builtin_amdgcn_cvt_pk_fp8_f32(clampf(s[6 * 33] * f8scale, 448.f), clampf(s[7 * 33] * f8scale, 448.f), w_, true); o8.y = (unsigned)w_;
            *(GAS v2u*)((unsigned char*)WT + (size_t)(n0 + n - nshift) * K + k0 + 8 * c) = o8; } }
    LDS_WAIT(); asm volatile("" ::: "memory");
}
__device__ __forceinline__ unsigned pk4_fp8(float a, float b, float c, float d) { int w = __builtin_amdgcn_cvt_pk_fp8_f32(clampf(a, 448.f), clampf(b, 448.f), 0, false); w = __builtin_amdgcn_cvt_pk_fp8_f32(clampf(c, 448.f), clampf(d, 448.f), w, true); return (unsigned)w; }
__device__ __forceinline__ void rms_2rows_to_bf16(const float* x0, const float* x1, const float* gain, bf16* o0, bf16* o1, unsigned char* q0, unsigned char* q1, int lane) {
    const GAS f32x4* xr0 = (const GAS f32x4*)x0 + lane; const GAS f32x4* xr1 = (const GAS f32x4*)x1 + lane; const GAS f32x4* gr = (const GAS f32x4*)gain + lane;
    f32x4 v[8], u[8]; float s = 0.f, t = 0.f;
#pragma unroll
    for (int j = 0; j < 8; ++j) { v[j] = xr0[64 * j]; u[j] = xr1[64 * j]; }
#pragma unroll
    for (int j = 0; j < 8; ++j) { s += (v[j].x * v[j].x + v[j].y * v[j].y) + (v[j].z * v[j].z + v[j].w * v[j].w); t += (u[j].x * u[j].x + u[j].y * u[j].y) + (u[j].z * u[j].z + u[j].w * u[j].w); }
    const float rs = __builtin_amdgcn_rsqf(wave_sum(s) * (1.f / DM) + EPS), rt = __builtin_amdgcn_rsqf(wave_sum(t) * (1.f / DM) + EPS);
    GAS v2u* p0 = (GAS v2u*)o0 + lane; GAS v2u* p1 = (GAS v2u*)o1 + lane; GAS unsigned* r0 = (GAS unsigned*)q0 + lane; GAS unsigned* r1 = (GAS unsigned*)q1 + lane;
#pragma unroll
    for (int j = 0; j < 8; ++j) { const f32x4 g = gr[64 * j]; v2u a, b;
        const f32x4 h0 = v[j] * g * rs, h1 = u[j] * g * rt;
        a.x = pk2(h0.x, h0.y); a.y = pk2(h0.z, h0.w); p0[64 * j] = a; r0[64 * j] = pk4_fp8(h0.x * SH8, h0.y * SH8, h0.z * SH8, h0.w * SH8);
        b.x = pk2(h1.x, h1.y); b.y = pk2(h1.z, h1.w); p1[64 * j] = b; r1[64 * j] = pk4_fp8(h1.x * SH8, h1.y * SH8, h1.z * SH8, h1.w * SH8); }
}
#ifdef PROBE_FP4EMU
__device__ __forceinline__ float fp4grid(float y) { const float a = fabsf(y); float r;
    if (a <= 2.f) r = rintf(a * 2.f) * 0.5f; else if (a <= 4.f) r = rintf(a); else r = (a < 5.f) ? 4.f : 6.f;
    return copysignf(r, y); }
__device__ __forceinline__ float clampf(float v, float lim) { if (lim == 448.5f) return fp4grid(v * (1.f / 16.f)) * 16.f; return fminf(fmaxf(v, -lim), lim); }
#else
__device__ __forceinline__ float clampf(float v, float lim) { return fminf(fmaxf(v, -lim), lim); }
#endif
template <int TAB = 0> __device__ __forceinline__ v4u cvt16_fp8(const f32x4 a, const f32x4 b, const f32x4 c, const f32x4 d, float sc) {
    v4u o; int w; constexpr float LIM = TAB ? 448.5f : 448.f;
    w = __builtin_amdgcn_cvt_pk_fp8_f32(clampf(a.x * sc, LIM), clampf(a.y * sc, LIM), 0, false); w = __builtin_amdgcn_cvt_pk_fp8_f32(clampf(a.z * sc, LIM), clampf(a.w * sc, LIM), w, true); o.x = (unsigned)w;
    w = __builtin_amdgcn_cvt_pk_fp8_f32(clampf(b.x * sc, LIM), clampf(b.y * sc, LIM), 0, false); w = __builtin_amdgcn_cvt_pk_fp8_f32(clampf(b.z * sc, LIM), clampf(b.w * sc, LIM), w, true); o.y = (unsigned)w;
    w = __builtin_amdgcn_cvt_pk_fp8_f32(clampf(c.x * sc, LIM), clampf(c.y * sc, LIM), 0, false); w = __builtin_amdgcn_cvt_pk_fp8_f32(clampf(c.z * sc, LIM), clampf(c.w * sc, LIM), w, true); o.z = (unsigned)w;
    w = __builtin_amdgcn_cvt_pk_fp8_f32(clampf(d.x * sc, LIM), clampf(d.y * sc, LIM), 0, false); w = __builtin_amdgcn_cvt_pk_fp8_f32(clampf(d.z * sc, LIM), clampf(d.w * sc, LIM), w, true); o.w = (unsigned)w;
    return o;
}
__device__ __forceinline__ void tables_convert(Frame& F, size_t lo, size_t hi, size_t tix, size_t ntx) {
      const GAS f32x4* su = (const GAS f32x4*)F.peer_u(); const GAS f32x4* sv = (const GAS f32x4*)F.peer_v(); GAS v4u* du = (GAS v4u*)F.U8(); GAS v4u* dv = (GAS v4u*)F.V8();
#pragma unroll 1
      for (int tab = 0; tab < 2; ++tab) { const GAS f32x4* src = tab ? sv : su; GAS v4u* dst = tab ? dv : du; const float sc = tab ? SV : SU;
        f32x4 nx[8]; const size_t i0 = lo + tix;
        if (i0 < hi) { const GAS f32x4* p = src + (i0 >> 6) * 512 + (i0 & 63);
#pragma unroll
            for (int j = 0; j < 8; ++j) nx[j] = p[64 * j]; }
#pragma unroll 1
        for (size_t i = i0; i < hi; i += ntx) { f32x4 v[8];
#pragma unroll
            for (int j = 0; j < 8; ++j) v[j] = nx[j];
            if (i + ntx < hi) { const size_t i2 = i + ntx; const GAS f32x4* p = src + (i2 >> 6) * 512 + (i2 & 63);
#pragma unroll
                for (int j = 0; j < 8; ++j) nx[j] = p[64 * j]; }
            unsigned wd[4];
#pragma unroll
            for (int q = 0; q < 4; ++q) { const f32x4 a = v[2 * q] * sc, b = v[2 * q + 1] * sc; unsigned w = 0u;
                w = __builtin_amdgcn_cvt_scalef32_pk_fp4_f32(w, clampf(a.x, 6.f), clampf(a.y, 6.f), 1.0f, 0); w = __builtin_amdgcn_cvt_scalef32_pk_fp4_f32(w, clampf(a.z, 6.f), clampf(a.w, 6.f), 1.0f, 1);
                w = __builtin_amdgcn_cvt_scalef32_pk_fp4_f32(w, clampf(b.x, 6.f), clampf(b.y, 6.f), 1.0f, 2); w = __builtin_amdgcn_cvt_scalef32_pk_fp4_f32(w, clampf(b.z, 6.f), clampf(b.w, 6.f), 1.0f, 3); wd[q] = w; }
            dst[i] = (v4u){wd[0], wd[1], wd[2], wd[3]}; } }
}
constexpr size_t TAB_ITEMS = (size_t)16384 * 64;
__device__ __forceinline__ size_t tab_split(int G) { const int rem = ((MTOK / 256) * (NB16 / 256)) % G; return rem ? (TAB_ITEMS / 8) * 5 : TAB_ITEMS; }
__device__ __forceinline__ unsigned fp4_code(float y) { const float a = fabsf(y);
    const unsigned m = (unsigned)(a >= 0.25f) + (unsigned)(a >= 0.75f) + (unsigned)(a >= 1.25f) + (unsigned)(a >= 1.75f) + (unsigned)(a >= 2.5f) + (unsigned)(a >= 3.5f) + (unsigned)(a >= 5.0f);
    return m | ((y < 0.f) ? 8u : 0u); }
__device__ __forceinline__ void p0_prologue(Frame& F) {
    const int tid = fresh_tid(), lane = tid & 63, wave = __builtin_amdgcn_readfirstlane(tid >> 6);
    LAS float* scr = (LAS float*)(F.lds + RING_OFF + wave * 16384);
    const int gw = blockIdx.x * NWAVES + wave, NGW = F.G * NWAVES;
    constexpr int I_IN = (DM / 64) * ((IN_PROJ + 31) / 32), I_SQ = (DM / 64) * (DM / 32);
    constexpr int NITEMS = I_IN + 2 * I_SQ;
    { const float* const w_in = F.w_in(); const float* const w_out = F.w_out(); const float* const wq = F.peer_wq(); const float* const fg = F.ffn_norm(); bf16* const WinT = F.WinT(); unsigned char* const WinT8 = F.WinT8(); bf16* const WoutT = F.WoutT(); bf16* const WqT = F.WqT(); const float* const gatt = F.attn_out_norm(); const float* const gssm = F.ssm_out_norm();
      for (int it = gw; it < NITEMS; it += NGW) {
        int r = it;
        if (r < I_IN) { const int n0_ = 32 * (r % ((IN_PROJ + 31) / 32));
            if (n0_ >= F8_LO && n0_ < F8_HI) p0_transpose_item(w_in, DM, IN_PROJ, (bf16*)WinT8, nullptr, scr, r, lane, SW8, F8_LO);
            else p0_transpose_item(w_in, DM, IN_PROJ, WinT, nullptr, scr, r, lane, 0.f, (n0_ >= F8_HI) ? (F8_HI - F8_LO) : 0);
            continue; } r -= I_IN;
        if (r < I_SQ) { const int k0_ = 64 * (r / (DM / 32)); p0_transpose_item(w_out, DM, DM, WoutT, (k0_ < ATT_W) ? gatt : (gssm - ATT_W), scr, r, lane, SW8); continue; } r -= I_SQ;
        p0_transpose_item(wq, DM, DM, WqT, fg, scr, r, lane, SW8);
      } }
    const size_t gt = (size_t)blockIdx.x * (NWAVES * 64) + tid, GT = (size_t)F.G * NWAVES * 64;
    { const size_t z0 = (size_t)(5664 - (F8_HI - F8_LO)) * DM / 8, z1 = (size_t)NB16 * DM / 8; GAS v4u* p = (GAS v4u*)F.WinT(); for (size_t i = z0 + gt; i < z1; i += GT) p[i] = (v4u){0u, 0u, 0u, 0u}; }
    { const GAS f32x4* s = (const GAS f32x4*)F.peer_sk(); GAS v2u* d = (GAS v2u*)F.SK(); for (size_t i = gt; i < (size_t)16 * 128 * 128 / 4; i += GT) { const f32x4 v = s[i]; v2u o; o.x = pk2(v.x, v.y); o.y = pk2(v.z, v.w); d[i] = o; } }
    { const float* const xg = F.x(); const float* const gn = F.attn_norm(); bf16* const hn = F.HN(); unsigned char* const hn8 = F.HN8();
      for (int m = gw; m < MTOK / 2; m += NGW) rms_2rows_to_bf16(xg + (size_t)(2 * m) * DM, xg + (size_t)(2 * m + 1) * DM, gn, hn + (size_t)(2 * m) * DM, hn + (size_t)(2 * m + 1) * DM, hn8 + (size_t)(2 * m) * DM, hn8 + (size_t)(2 * m + 1) * DM, lane); }
    tables_convert(F, 0, tab_split(F.G), gt, GT);
}

struct EpiProj {
    static constexpr bool PERM = true, AFTER_DRAIN = false, SEG = false;
    bf16* O; float* dtraw; float* kmean;
    __device__ __forceinline__ void operator()(const pg8::f32x4 (&acc)[2][2][4][2], const pg8::Unit& u, int wr, int wc, int fr, int fq) const {
        const int rpn = (u.pn < F8_LO / 256) ? u.pn : u.pn + (F8_HI - F8_LO) / 256;
        const int row0 = u.pm * 256 + wr * 64 + fr, col0 = rpn * 256 + wc * 32 + 8 * fq;
        if (rpn < 22) {
#pragma unroll
            for (int ai = 0; ai < 2; ++ai)
#pragma unroll
                for (int m = 0; m < 4; ++m) { bf16* rowp = O + (size_t)(row0 + ai * 128 + m * 16) * NPROJ + col0;
#pragma unroll
                    for (int bj = 0; bj < 2; ++bj) { const pg8::f32x4 v0 = acc[ai][bj][m][0], v1 = acc[ai][bj][m][1];
                        pg8::u32x4 w; w.x = pg8::cvt_pk_bf16(v0[0], v0[1]); w.y = pg8::cvt_pk_bf16(v0[2], v0[3]); w.z = pg8::cvt_pk_bf16(v1[0], v1[1]); w.w = pg8::cvt_pk_bf16(v1[2], v1[3]);
                        *(pg8::u32x4*)(rowp + bj * 128) = w; } }
        } else if (wc == 0 && fq < 2) {
#pragma unroll
            for (int ai = 0; ai < 2; ++ai)
#pragma unroll
                for (int m = 0; m < 4; ++m) { float* rp = dtraw + (size_t)(row0 + ai * 128 + m * 16) * 16 + 8 * fq;
                    *(pg8::f32x4*)rp = acc[ai][0][m][0]; *(pg8::f32x4*)(rp + 4) = acc[ai][0][m][1]; }
        }
        if (kmean && u.pn >= 4 && u.pn < 8) {
#pragma unroll
            for (int bj = 0; bj < 2; ++bj)
#pragma unroll
                for (int n = 0; n < 2; ++n)
#pragma unroll
                    for (int i = 0; i < 4; ++i) { float s = 0.f;
#pragma unroll
                        for (int ai = 0; ai < 2; ++ai)
#pragma unroll
                            for (int m = 0; m < 4; ++m) s += acc[ai][bj][m][n][i];
                        s += __shfl_xor(s, 1); s += __shfl_xor(s, 2); s += __shfl_xor(s, 4); s += __shfl_xor(s, 8);
                        if (fr == 0) unsafeAtomicAdd(kmean + (size_t)u.pm * 1024 + (col0 - 1024) + bj * 128 + 4 * n + i, s); }
        }
    }
};
struct EpiProj8 {
    static constexpr bool PERM = true, AFTER_DRAIN = false, SEG = false;
    bf16* O;
    __device__ __forceinline__ void operator()(const pg8::f32x4 (&acc)[2][2][4][2], const pg8::Unit& u, int wr, int wc, int fr, int fq) const {
        const int row0 = u.pm * 256 + wr * 64 + fr, col0 = F8_LO + u.pn * 256 + wc * 32 + 8 * fq; constexpr float sc = 1.f / (SH8 * SW8);
#pragma unroll
        for (int ai = 0; ai < 2; ++ai)
#pragma unroll
            for (int m = 0; m < 4; ++m) { bf16* rowp = O + (size_t)(row0 + ai * 128 + m * 16) * NPROJ + col0;
#pragma unroll
                for (int bj = 0; bj < 2; ++bj) { const pg8::f32x4 v0 = acc[ai][bj][m][0] * sc, v1 = acc[ai][bj][m][1] * sc;
                    pg8::u32x4 w; w.x = pg8::cvt_pk_bf16(v0[0], v0[1]); w.y = pg8::cvt_pk_bf16(v0[2], v0[3]); w.z = pg8::cvt_pk_bf16(v1[0], v1[1]); w.w = pg8::cvt_pk_bf16(v1[2], v1[3]);
                    *(pg8::u32x4*)(rowp + bj * 128) = w; } }
    }
};
struct EpiOut {
    static constexpr bool PERM = true, AFTER_DRAIN = false, SEG = true; static constexpr int SEG_T1 = 8, SEG_T2 = 12;
    const float* x; bf16* x1b; unsigned char* x18; float* ssq; bool doatom; const LAS f32x4* tab;
    __device__ __forceinline__ void seg_load(int ui, int wr, int fr, float (&sr)[16]) const {
#pragma unroll
        for (int i = 0; i < 8; ++i) { const int r = (i >> 2) * 128 + wr * 64 + (i & 3) * 16 + fr; const f32x2 q = *(const LAS f32x2*)(tab + ui * 256 + r); sr[2 * i] = q.x; sr[2 * i + 1] = q.y; }
        asm volatile("s_waitcnt lgkmcnt(0)" ::: "memory");
    }
    __device__ __forceinline__ void seg_apply(pg8::f32x4 (&acc)[2][2][4][2], const float (&sr)[16], int which) const {
#pragma unroll
        for (int ai = 0; ai < 2; ++ai)
#pragma unroll
            for (int m = 0; m < 4; ++m) { const float f = (which == 0) ? sr[2 * (ai * 4 + m)] : ((which == 1) ? sr[2 * (ai * 4 + m) + 1] : 1.0f);
#pragma unroll
                for (int bj = 0; bj < 2; ++bj)
#pragma unroll
                    for (int n = 0; n < 2; ++n) acc[ai][bj][m][n] = acc[ai][bj][m][n] * f; }
    }
    __device__ __forceinline__ void operator()(const pg8::f32x4 (&acc)[2][2][4][2], const pg8::Unit& u, int wr, int wc, int fr, int fq, int ui) const {
        const int row0 = u.pm * 256 + wr * 64 + fr, col0 = u.pn * 256 + wc * 32 + 8 * fq;
#pragma unroll
        for (int ai = 0; ai < 2; ++ai)
#pragma unroll
            for (int m = 0; m < 4; ++m) { const int row = row0 + ai * 128 + m * 16; const size_t off = (size_t)row * DM + col0; float s = 0.f;
                const float s1 = (*(const LAS f32x4*)(tab + ui * 256 + ai * 128 + wr * 64 + m * 16 + fr)).z;
#pragma unroll
                for (int bj = 0; bj < 2; ++bj) {
                    const pg8::f32x4 a0 = *(const pg8::f32x4*)(x + off + bj * 128), a1 = *(const pg8::f32x4*)(x + off + bj * 128 + 4);
                    const pg8::f32x4 v0 = acc[ai][bj][m][0] * s1 + a0, v1 = acc[ai][bj][m][1] * s1 + a1;
                    pg8::u32x4 w; w.x = pg8::cvt_pk_bf16(v0[0], v0[1]); w.y = pg8::cvt_pk_bf16(v0[2], v0[3]); w.z = pg8::cvt_pk_bf16(v1[0], v1[1]); w.w = pg8::cvt_pk_bf16(v1[2], v1[3]);
                    *(pg8::u32x4*)(x1b + off + bj * 128) = w;
                    { v2u o8; int w_; w_ = __builtin_amdgcn_cvt_pk_fp8_f32(clampf(v0[0] * SX8, 448.f), clampf(v0[1] * SX8, 448.f), 0, false); w_ = __builtin_amdgcn_cvt_pk_fp8_f32(clampf(v0[2] * SX8, 448.f), clampf(v0[3] * SX8, 448.f), w_, true); o8.x = (unsigned)w_;
                      w_ = __builtin_amdgcn_cvt_pk_fp8_f32(clampf(v1[0] * SX8, 448.f), clampf(v1[1] * SX8, 448.f), 0, false); w_ = __builtin_amdgcn_cvt_pk_fp8_f32(clampf(v1[2] * SX8, 448.f), clampf(v1[3] * SX8, 448.f), w_, true); o8.y = (unsigned)w_;
                      *(v2u*)(x18 + off + bj * 128) = o8; }
                    s += (v0[0] * v0[0] + v0[1] * v0[1]) + (v0[2] * v0[2] + v0[3] * v0[3]) + (v1[0] * v1[0] + v1[1] * v1[1]) + (v1[2] * v1[2] + v1[3] * v1[3]); }
                s += __shfl_xor(s, 16); s += __shfl_xor(s, 32);
                if (fq == 0 && doatom) unsafeAtomicAdd(ssq + (size_t)row * 4, s);
                asm volatile("" ::: "memory"); }
    }
};
struct EpiQ {
    static constexpr bool PERM = true, AFTER_DRAIN = false, SEG = false;
    bf16* O; const float* ssq;
    __device__ __forceinline__ void operator()(const pg8::f32x4 (&acc)[2][2][4][2], const pg8::Unit& u, int wr, int wc, int fr, int fq) const {
        const int row0 = u.pm * 256 + wr * 64 + fr, col0 = u.pn * 256 + wc * 32 + 8 * fq;
#pragma unroll
        for (int ai = 0; ai < 2; ++ai)
#pragma unroll
            for (int m = 0; m < 4; ++m) { const int row = row0 + ai * 128 + m * 16; bf16* rowp = O + (size_t)row * DM + col0;
                const float rs = (1.f / (SX8 * SW8)) / sqrtf(__hip_atomic_load(ssq + (size_t)row * 4, RLX_AGENT) * (1.f / DM) + EPS);
#pragma unroll
                for (int bj = 0; bj < 2; ++bj) { const pg8::f32x4 v0 = acc[ai][bj][m][0] * rs, v1 = acc[ai][bj][m][1] * rs;
                    pg8::u32x4 w; w.x = pg8::cvt_pk_bf16(v0[0], v0[1]); w.y = pg8::cvt_pk_bf16(v0[2], v0[3]); w.z = pg8::cvt_pk_bf16(v1[0], v1[1]); w.w = pg8::cvt_pk_bf16(v1[2], v1[3]);
                    *(pg8::u32x4*)(rowp + bj * 128) = w; } }
    }
};

constexpr int A_KSTR = 272, A_VSTR = 288;
constexpr int A_KB0 = 0, A_KB1 = 64 * A_KSTR, A_VB0 = 2 * 64 * A_KSTR, A_VBS = 64 * A_VSTR  , A_KM = A_VB0 + 3 * A_VBS, A_TAB = A_KM + 8 * 128 * 4, A_END = A_TAB + 128 * 4;
static_assert(A_END <= RING_BYTES && (A_KM % 16) == 0, "attention LDS map");
#define PIN16(a, i) asm volatile("" : "+v"(a[i]), "+v"(a[i + 1]), "+v"(a[i + 2]), "+v"(a[i + 3]), "+v"(a[i + 4]), "+v"(a[i + 5]), "+v"(a[i + 6]), "+v"(a[i + 7]), "+v"(a[i + 8]), "+v"(a[i + 9]), "+v"(a[i + 10]), "+v"(a[i + 11]), "+v"(a[i + 12]), "+v"(a[i + 13]), "+v"(a[i + 14]), "+v"(a[i + 15]))
#define TR16(p) __builtin_amdgcn_ds_read_tr16_b64_v4i16((LAS s16x4*)(p))
#define MFMA16(a, b, c) __builtin_amdgcn_mfma_f32_16x16x32_bf16((a), (b), (c), 0, 0, 0)
__device__ __forceinline__ bf16x8 pack8(const float* v) {
    const unsigned a = pk2(v[0], v[1]), b = pk2(v[2], v[3]), c = pk2(v[4], v[5]), d = pk2(v[6], v[7]);
    const v4u u = {a, b, c, d}; return __builtin_bit_cast(bf16x8, u);
}
__device__ __forceinline__ void attn_unit(Frame& F, int b, int h, int blk, const bool doatom = true) {
    LAS unsigned char* lds = F.lds + RING_OFF;
    const int tid = fresh_tid(), lane = tid & 63, w = __builtin_amdgcn_readfirstlane(tid >> 6), g = lane >> 4, c16 = lane & 15, q4 = c16 >> 2, p4 = lane & 3;
    const int own = blk, t0 = blk * 256, tq0 = t0 + 32 * w + c16;
    const size_t rowbase = (size_t)b * SEQ;
    const float NEG_INF = -__builtin_inff();
    constexpr float LOG2E = 1.4426950408889634f, SCL2 = 0.08838834764831845f * 1.4426950408889634f;
    LAS float* km = (LAS float*)(lds + A_KM); LAS float* tab = (LAS float*)(lds + A_TAB);
    const bf16* const PROJ = F.PROJ(); const float* const kmg = F.kmean(); const float* const relb = F.rel_bias();
    for (int i = tid; i < own * 128; i += NWAVES * 64) { const int n = i >> 7, d = i & 127; km[i] = kmg[(size_t)(b * 8 + n) * 1024 + h * 128 + d] * (1.f / 256.f); }
    if (tid < 128) { const int rel = tid; int bucket = rel; if (rel >= 16) { bucket = 16 + (int)(log2f((float)rel * (1.f / 16.f)) * (16.f / 3.f)); bucket = bucket > 31 ? 31 : bucket; }
        tab[tid] = relb[bucket * 8 + h] * LOG2E; }
    bf16x8 qf[2][4];
#pragma unroll
    for (int gi = 0; gi < 2; ++gi) { const bf16* qrow = PROJ + (rowbase + tq0 + 16 * gi) * NPROJ + COL_Q + h * 128 + 8 * g;
#pragma unroll
      for (int ks = 0; ks < 4; ++ks) qf[gi][ks] = *(const GAS bf16x8*)(qrow + 32 * ks); }
    __syncthreads();
    unsigned selmask[2];
    if (own <= 3) { selmask[0] = (1u << own) - 1u; selmask[1] = selmask[0]; }
    else {
#pragma unroll
      for (int gi = 0; gi < 2; ++gi) {
        float gate[7];
#pragma unroll
        for (int n = 0; n < 7; ++n) {
            float s = NEG_INF;
            if (n < own) { s = 0.f;
#pragma unroll
                for (int ks = 0; ks < 4; ++ks) { const LAS f32x4* kp = (const LAS f32x4*)(km + n * 128 + 32 * ks + 8 * g); const f32x4 k0 = kp[0], k1 = kp[1]; const v4u qu = __builtin_bit_cast(v4u, qf[gi][ks]);
                    s += bflo(qu.x) * k0.x + bfhi(qu.x) * k0.y + bflo(qu.y) * k0.z + bfhi(qu.y) * k0.w + bflo(qu.z) * k1.x + bfhi(qu.z) * k1.y + bflo(qu.w) * k1.z + bfhi(qu.w) * k1.w; }
                s += __shfl_xor(s, 16); s += __shfl_xor(s, 32); }
            gate[n] = s;
        }
        unsigned sm = 0u;
#pragma unroll
        for (int r = 0; r < 3; ++r) { float best = NEG_INF; int bi = 0;
#pragma unroll
            for (int n = 0; n < 7; ++n) { const bool cand = (n < own) && !((sm >> n) & 1u) && (gate[n] > best); best = cand ? gate[n] : best; bi = cand ? n : bi; }
            sm |= 1u << bi; }
        selmask[gi] = sm; }
    }
    const int nT = 4 + 4 * own;
    const int sr = tid >> 3, sc = (tid & 7) * 16;
#define A_KEY0(i) ((i) < 4 ? own * 256 + 64 * (i) : (((i) - 4) >> 2) * 256 + (((i) - 4) & 3) * 64)
    v4u kr0, kr1, vr0, vr1;
#define A_LOAD(i) do { const bf16* kp_ = PROJ + (rowbase + A_KEY0(i) + sr) * NPROJ + COL_K + h * 128 + sc; \
        kr0 = *(const GAS v4u*)kp_; kr1 = *(const GAS v4u*)(kp_ + 8); vr0 = *(const GAS v4u*)(kp_ + (COL_V - COL_K)); vr1 = *(const GAS v4u*)(kp_ + (COL_V - COL_K) + 8); } while (0)
#define A_STORE(bufi) do { LAS unsigned char* kd_ = lds + ((bufi) ? A_KB1 : A_KB0) + sr * A_KSTR + sc * 2; LAS unsigned char* vd_ = lds + A_VB0 + vnx * A_VBS + sr * A_VSTR + sc * 2; \
        *(LAS v4u*)kd_ = kr0; *(LAS v4u*)(kd_ + 16) = kr1; *(LAS v4u*)vd_ = vr0; *(LAS v4u*)(vd_ + 16) = vr1; } while (0)
    int vcur = 0, vnx = 0, vprev = 0;
#define A_PV(PF, Vb_) do { _Pragma("unroll") for (int s = 0; s < 2; ++s) { s16x4 vlo[8], vhi[8]; \
            _Pragma("unroll") for (int db = 0; db < 8; ++db) { LAS unsigned char* va = (Vb_) + (32 * s + 4 * g + q4) * A_VSTR + (16 * db + 4 * p4) * 2; vlo[db] = TR16(va); vhi[db] = TR16(va + 16 * A_VSTR); } \
            __builtin_amdgcn_sched_barrier(0); \
            _Pragma("unroll") for (int db = 0; db < 8; ++db) { const bf16x8 vf = __builtin_shufflevector(vlo[db], vhi[db], 0, 1, 2, 3, 4, 5, 6, 7); \
                oacc[0][db] = MFMA16(vf, PF[0][s], oacc[0][db]); oacc[1][db] = MFMA16(vf, PF[1][s], oacc[1][db]); } \
            __builtin_amdgcn_sched_barrier(0); } } while (0)
    A_LOAD(0); A_STORE(0);
    __syncthreads();
    const bool late = w >= 4;
    bf16x8 pfp[2][2]; bool skipp = true;
#pragma unroll
    for (int gi = 0; gi < 2; ++gi) { pfp[gi][0] = (bf16x8){0, 0, 0, 0, 0, 0, 0, 0}; pfp[gi][1] = pfp[gi][0]; }
    float m_run[2] = {NEG_INF, NEG_INF}, l_run[2] = {0.f, 0.f};
    f32x4 oacc[2][8];
#pragma unroll
    for (int gi = 0; gi < 2; ++gi)
#pragma unroll
        for (int db = 0; db < 8; ++db) oacc[gi][db] = (f32x4){0.f, 0.f, 0.f, 0.f};
    for (int i = 0; i < nT; ++i) {
        if (i + 1 < nT) A_LOAD(i + 1);
        vnx = (vcur == 2) ? 0 : vcur + 1;
        const int buf = i & 1, key0 = A_KEY0(i); const bool isown = i < 4; const int pblk = isown ? own : ((i - 4) >> 2);
        const bool skipw = isown && (64 * i > 32 * w + 31);
        if (late && !skipp) A_PV(pfp, lds + A_VB0 + vprev * A_VBS);
        bf16x8 pf[2][2];
        if (!skipw) {
        LAS unsigned char* Kb = lds + (buf ? A_KB1 : A_KB0);
        f32x4 sacc[2][4];
#pragma unroll
        for (int hf = 0; hf < 2; ++hf) { bf16x8 kf[8];
#pragma unroll
            for (int n2 = 0; n2 < 2; ++n2)
#pragma unroll
                for (int ks = 0; ks < 4; ++ks) kf[n2 * 4 + ks] = *(const LAS bf16x8*)(Kb + (16 * (2 * hf + n2) + c16) * A_KSTR + (32 * ks + 8 * g) * 2);
            __builtin_amdgcn_sched_barrier(0);
#pragma unroll
            for (int gi = 0; gi < 2; ++gi)
#pragma unroll
                for (int n2 = 0; n2 < 2; ++n2) { f32x4 a = (f32x4){0.f, 0.f, 0.f, 0.f};
#pragma unroll
                    for (int ks = 0; ks < 4; ++ks) a = MFMA16(kf[n2 * 4 + ks], qf[gi][ks], a);
                    sacc[gi][2 * hf + n2] = a; }
            __builtin_amdgcn_sched_barrier(0); }
        const bool far = (key0 + 63 + 128 <= t0 + 32 * w);
        const bool diag = isown && (64 * i + 63 > 32 * w);
#pragma unroll
        for (int gi = 0; gi < 2; ++gi) {
            const int tq = tq0 + 16 * gi; const bool sel = isown || ((selmask[gi] >> pblk) & 1u);
            float sv[16]; float mloc, m_new, alpha;
            if (far) {
                const float bfar = tab[127];
                float mx = fmaxf(fmaxf(sacc[gi][0][0], sacc[gi][0][1]), fmaxf(sacc[gi][0][2], sacc[gi][0][3]));
#pragma unroll
                for (int nb = 1; nb < 4; ++nb) mx = fmaxf(mx, fmaxf(fmaxf(sacc[gi][nb][0], sacc[gi][nb][1]), fmaxf(sacc[gi][nb][2], sacc[gi][nb][3])));
                mloc = sel ? (mx * SCL2 + bfar) : NEG_INF;
                mloc = fmaxf(mloc, __shfl_xor(mloc, 16)); mloc = fmaxf(mloc, __shfl_xor(mloc, 32));
                m_new = fmaxf(m_run[gi], mloc); alpha = __builtin_amdgcn_exp2f(m_run[gi] - m_new);
                const float cadd = sel ? (bfar - m_new) : NEG_INF;
#pragma unroll
                for (int nb = 0; nb < 4; ++nb)
#pragma unroll
                    for (int r = 0; r < 4; ++r) sv[nb * 4 + r] = __builtin_amdgcn_exp2f(sacc[gi][nb][r] * SCL2 + cadd);
            } else {
                const int relb = tq - key0 - 4 * g; float bias[16];
#pragma unroll
                for (int nb = 0; nb < 4; ++nb)
#pragma unroll
                    for (int r = 0; r < 4; ++r) { const int rel = relb - 16 * nb - r; int ri = rel < 0 ? 0 : rel; ri = ri > 127 ? 127 : ri; bias[nb * 4 + r] = tab[ri]; }
                PIN16(bias, 0);
                mloc = NEG_INF;
#pragma unroll
                for (int nb = 0; nb < 4; ++nb)
#pragma unroll
                    for (int r = 0; r < 4; ++r) { const int rel = relb - 16 * nb - r;
                        float s = sacc[gi][nb][r] * SCL2 + bias[nb * 4 + r]; s = (!sel || (diag && rel < 0)) ? NEG_INF : s; sv[nb * 4 + r] = s; mloc = fmaxf(mloc, s); }
                mloc = fmaxf(mloc, __shfl_xor(mloc, 16)); mloc = fmaxf(mloc, __shfl_xor(mloc, 32));
                m_new = fmaxf(m_run[gi], mloc); alpha = __builtin_amdgcn_exp2f(m_run[gi] - m_new);
#pragma unroll
                for (int e = 0; e < 16; ++e) sv[e] = __builtin_amdgcn_exp2f(sv[e] - m_new);
            }
            float psum = 0.f;
#pragma unroll
            for (int e = 0; e < 16; ++e) psum += sv[e];
            l_run[gi] = l_run[gi] * alpha + psum; m_run[gi] = m_new;
#pragma unroll
            for (int db = 0; db < 8; ++db) oacc[gi][db] = oacc[gi][db] * alpha;
            pf[gi][0] = pack8(sv); pf[gi][1] = pack8(sv + 8);
        }
        __builtin_amdgcn_sched_barrier(0);
        if (!late) A_PV(pf, lds + A_VB0 + vcur * A_VBS);
        }
        if (late) { skipp = skipw;
#pragma unroll
            for (int gi = 0; gi < 2; ++gi) { pfp[gi][0] = pf[gi][0]; pfp[gi][1] = pf[gi][1]; } }
        if (i + 1 < nT) A_STORE((i + 1) & 1);
        vprev = vcur; vcur = vnx;
        __syncthreads();
    }
    if (late && !skipp) A_PV(pfp, lds + A_VB0 + vprev * A_VBS);
#undef A_PV
    bf16* const MIXp = F.HN(); float* const ssqp = F.ssq();
#pragma unroll
    for (int gi = 0; gi < 2; ++gi) {
        const int tq = tq0 + 16 * gi;
        float l_tot = l_run[gi]; l_tot += __shfl_xor(l_tot, 16); l_tot += __shfl_xor(l_tot, 32);
        const float inv = 1.f / l_tot; float ssq = 0.f;
        unsigned char* orow = (unsigned char*)MIXp + (rowbase + tq) * DM + h * 128 + 4 * g;
#pragma unroll
        for (int db = 0; db < 8; ++db) { const f32x4 o = oacc[gi][db] * inv; ssq += (o.x * o.x + o.y * o.y) + (o.z * o.z + o.w * o.w); *(GAS unsigned*)(orow + 16 * db) = pk4_fp8(o.x * SA8, o.y * SA8, o.z * SA8, o.w * SA8); }
        ssq += __shfl_xor(ssq, 16); ssq += __shfl_xor(ssq, 32);
        if (g == 0 && doatom) unsafeAtomicAdd(ssqp + (rowbase + tq) * 4 + 1, ssq);
    }
#undef A_KEY0
#undef A_LOAD
#undef A_STORE
}

constexpr int XBC_W = CONV_CH;
__device__ __forceinline__ void conv_phase(Frame& F) {
    const bf16* const PROJ = F.PROJ(); bf16* const XBC = F.XBC(); const float* const cw = F.conv_w(); const float* const cb = F.conv_b();
    const int gt = blockIdx.x * (NWAVES * 64) + fresh_tid(), GT = F.G * NWAVES * 64;
    for (int task = gt; task < (MTOK / 32) * (CONV_CH / 8); task += GT) {
        const int r = task / (CONV_CH / 8), k = task % (CONV_CH / 8), ch = 8 * k, tok0 = 32 * r;
        float wv[4][8], bias[8];
#pragma unroll
        for (int t = 0; t < 4; ++t) { const f32x4 w0 = *(const GAS f32x4*)(cw + t * CONV_CH + ch), w1 = *(const GAS f32x4*)(cw + t * CONV_CH + ch + 4);
            wv[t][0] = w0.x; wv[t][1] = w0.y; wv[t][2] = w0.z; wv[t][3] = w0.w; wv[t][4] = w1.x; wv[t][5] = w1.y; wv[t][6] = w1.z; wv[t][7] = w1.w; }
        { const f32x4 b0 = *(const GAS f32x4*)(cb + ch), b1 = *(const GAS f32x4*)(cb + ch + 4); bias[0] = b0.x; bias[1] = b0.y; bias[2] = b0.z; bias[3] = b0.w; bias[4] = b1.x; bias[5] = b1.y; bias[6] = b1.z; bias[7] = b1.w; }
        const bf16* src = PROJ + (size_t)tok0 * NPROJ + COL_XBC + ch; bf16* dst = XBC + (size_t)tok0 * XBC_W + ch;
        v4u p0 = (v4u){0u, 0u, 0u, 0u}, p1 = p0, p2 = p0;
        if ((tok0 & (SEQ - 1)) != 0) { p0 = *(const GAS v4u*)(src - 3 * (ptrdiff_t)NPROJ); p1 = *(const GAS v4u*)(src - 2 * (ptrdiff_t)NPROJ); p2 = *(const GAS v4u*)(src - (ptrdiff_t)NPROJ); }
#pragma unroll 1
        for (int i0 = 0; i0 < 32; i0 += 8) {
            v4u cur[8];
#pragma unroll
            for (int i = 0; i < 8; ++i) cur[i] = *(const GAS v4u*)(src + (size_t)(i0 + i) * NPROJ);
#pragma unroll
            for (int i = 0; i < 8; ++i) {
                const v4u c = cur[i]; float acc[8];
                const unsigned a0[4] = {p0.x, p0.y, p0.z, p0.w}, a1[4] = {p1.x, p1.y, p1.z, p1.w}, a2[4] = {p2.x, p2.y, p2.z, p2.w}, a3[4] = {c.x, c.y, c.z, c.w};
#pragma unroll
                for (int j = 0; j < 4; ++j) {
                    acc[2 * j] = bias[2 * j] + wv[0][2 * j] * bflo(a0[j]) + wv[1][2 * j] * bflo(a1[j]) + wv[2][2 * j] * bflo(a2[j]) + wv[3][2 * j] * bflo(a3[j]);
                    acc[2 * j + 1] = bias[2 * j + 1] + wv[0][2 * j + 1] * bfhi(a0[j]) + wv[1][2 * j + 1] * bfhi(a1[j]) + wv[2][2 * j + 1] * bfhi(a2[j]) + wv[3][2 * j + 1] * bfhi(a3[j]); }
#pragma unroll
                for (int j = 0; j < 8; ++j) acc[j] = silu_f(acc[j]);
                v4u o; o.x = pk2(acc[0], acc[1]); o.y = pk2(acc[2], acc[3]); o.z = pk2(acc[4], acc[5]); o.w = pk2(acc[6], acc[7]);
                *(GAS v4u*)(dst + (size_t)(i0 + i) * XBC_W) = o;
                p0 = p1; p1 = p2; p2 = c; }
        }
    }
    { const float* const dtraw = F.dtraw(); float* const dt2 = F.DT2(); const float* const dtb = F.dt_bias();
      for (int i = gt; i < MTOK * 16; i += GT) { const float xr = dtraw[i] + dtb[i & 15]; dt2[i] = xr > 20.f ? xr : log1pf(__expf(xr)); } }
}

constexpr int S_BSTR = 272, S_XSTR = 144;
constexpr int S_BM = 0, S_CM = 128 * S_BSTR, S_X = 2 * 128 * S_BSTR, S_XW = S_X + 128 * S_XSTR, S_HB = S_XW + 128 * S_XSTR, S_DT = S_HB + 64 * S_BSTR, S_CS = S_DT + 512, S_DA = S_CS + 512, S_END = S_DA + 512;
static_assert(S_END <= RING_BYTES, "ssd LDS map");
__device__ __forceinline__ void ssd_unit(Frame& F, int b, int h, const bool doatom = true) {
    LAS unsigned char* lds = F.lds + RING_OFF;
    const int tid = fresh_tid(), lane = tid & 63, w = __builtin_amdgcn_readfirstlane(tid >> 6), g = lane >> 4, c16 = lane & 15, q4 = c16 >> 2, p4 = lane & 3;
    const int g8 = h >> 3, pbw = w & 3, nhw = w >> 2;
    const float a_h = -__expf(F.a_log()[h]), dsk = F.d_skip()[h];
    const bf16* const PROJ = F.PROJ(); bf16* const MIX = F.HN(); const float* const dt2 = F.DT2(); const bf16* const XBC = F.XBC(); float* const ssqp = F.ssq();
    LAS float* dtl = (LAS float*)(lds + S_DT); LAS float* csl = (LAS float*)(lds + S_CS); LAS float* dal = (LAS float*)(lds + S_DA);
    for (int i = tid; i < 64 * S_BSTR / 16; i += NWAVES * 64) ((LAS v4u*)(lds + S_HB))[i] = (v4u){0u, 0u, 0u, 0u};
    f32x4 hacc[4];
#pragma unroll
    for (int i = 0; i < 4; ++i) hacc[i] = (f32x4){0.f, 0.f, 0.f, 0.f};
    const int xl = tid >> 3, xc = tid & 7, bl = tid >> 4, bc = tid & 15;
    v4u xr[2], br[4], cr[4]; float dtv = 0.f;
#define S_PREFETCH(cc) do { const size_t t0_ = (size_t)b * SEQ + (size_t)(cc) * SSM_L; \
        _Pragma("unroll") for (int i_ = 0; i_ < 2; ++i_) xr[i_] = *(const GAS v4u*)(XBC + (t0_ + xl + 64 * i_) * XBC_W + h * 64 + 8 * xc); \
        _Pragma("unroll") for (int i_ = 0; i_ < 4; ++i_) { const bf16* p_ = XBC + (t0_ + bl + 32 * i_) * XBC_W + 1024 + g8 * 128 + 8 * bc; br[i_] = *(const GAS v4u*)p_; cr[i_] = *(const GAS v4u*)(p_ + 256); } \
        if (tid < 128) dtv = dt2[(t0_ + tid) * 16 + h]; } while (0)
    S_PREFETCH(0);
    for (int c = 0; c < SSM_NC; ++c) {
        const size_t tok0 = (size_t)b * SEQ + (size_t)c * SSM_L;
        if (tid < 128) { dtl[tid] = dtv; dal[tid] = dtv * a_h; }
        __syncthreads();
        if (w == 0) { const float v0 = dal[2 * lane], v1 = dal[2 * lane + 1]; float s = v0 + v1;
#pragma unroll
            for (int o = 1; o < 64; o <<= 1) { const float t = __shfl_up(s, o); s += (lane >= o) ? t : 0.f; }
            csl[2 * lane] = s - v1; csl[2 * lane + 1] = s; }
        __syncthreads();
        const float cs_last = csl[127];
#pragma unroll
        for (int i = 0; i < 2; ++i) { const int l = xl + 64 * i; const v4u v = xr[i]; *(LAS v4u*)(lds + S_X + l * S_XSTR + xc * 16) = v; const float wl = dtl[l] * __expf(cs_last - csl[l]);
            v4u o2; o2.x = pk2(bflo(v.x) * wl, bfhi(v.x) * wl); o2.y = pk2(bflo(v.y) * wl, bfhi(v.y) * wl); o2.z = pk2(bflo(v.z) * wl, bfhi(v.z) * wl); o2.w = pk2(bflo(v.w) * wl, bfhi(v.w) * wl);
            *(LAS v4u*)(lds + S_XW + l * S_XSTR + xc * 16) = o2; }
#pragma unroll
        for (int i = 0; i < 4; ++i) { const int l = bl + 32 * i; *(LAS v4u*)(lds + S_BM + l * S_BSTR + bc * 16) = br[i]; *(LAS v4u*)(lds + S_CM + l * S_BSTR + bc * 16) = cr[i]; }
        const int lrow = 16 * w + c16;
        v2u zr[4];
#pragma unroll
        for (int pb = 0; pb < 4; ++pb) zr[pb] = *(const GAS v2u*)(PROJ + (tok0 + lrow) * NPROJ + COL_Z + h * 64 + 16 * pb + 4 * g);
        if (c + 1 < SSM_NC) S_PREFETCH(c + 1);
        __syncthreads();
        bf16x8 cf[4];
#pragma unroll
        for (int ks = 0; ks < 4; ++ks) cf[ks] = *(const LAS bf16x8*)(lds + S_CM + lrow * S_BSTR + (32 * ks + 8 * g) * 2);
        f32x4 yacc[4];
        const float cs_l = csl[lrow]; const float el = __expf(cs_l);
#pragma unroll
        for (int pb = 0; pb < 4; ++pb) { yacc[pb] = (f32x4){0.f, 0.f, 0.f, 0.f};
#pragma unroll
            for (int ks = 0; ks < 4; ++ks) { const bf16x8 hf = *(const LAS bf16x8*)(lds + S_HB + (16 * pb + c16) * S_BSTR + (32 * ks + 8 * g) * 2); yacc[pb] = MFMA16(hf, cf[ks], yacc[pb]); }
            yacc[pb] = yacc[pb] * el; }
        for (int s2 = 0; s2 <= (w >> 1); ++s2) {
            const int sb0 = 2 * s2, sb1 = 2 * s2 + 1; const bool has1 = sb1 <= w;
            f32x4 cb0 = (f32x4){0.f, 0.f, 0.f, 0.f}, cb1 = (f32x4){0.f, 0.f, 0.f, 0.f};
#pragma unroll
            for (int ks = 0; ks < 4; ++ks) { const bf16x8 bf0 = *(const LAS bf16x8*)(lds + S_BM + (16 * sb0 + c16) * S_BSTR + (32 * ks + 8 * g) * 2); cb0 = MFMA16(bf0, cf[ks], cb0); }
            if (has1) {
#pragma unroll
                for (int ks = 0; ks < 4; ++ks) { const bf16x8 bf1 = *(const LAS bf16x8*)(lds + S_BM + (16 * sb1 + c16) * S_BSTR + (32 * ks + 8 * g) * 2); cb1 = MFMA16(bf1, cf[ks], cb1); } }
            float mv[8];
#pragma unroll
            for (int r = 0; r < 4; ++r) { const int s = 16 * sb0 + 4 * g + r; const float e = __expf(fminf(cs_l - csl[s], 0.f)) * dtl[s]; mv[r] = (s <= lrow) ? cb0[r] * e : 0.f; }
#pragma unroll
            for (int r = 0; r < 4; ++r) { const int s = 16 * sb1 + 4 * g + r; const int sc_ = s > 127 ? 127 : s; const float e = __expf(fminf(cs_l - csl[sc_], 0.f)) * dtl[sc_]; mv[4 + r] = (has1 && s <= lrow) ? cb1[r] * e : 0.f; }
            const bf16x8 pf = pack8(mv);
#pragma unroll
            for (int pb = 0; pb < 4; ++pb) { LAS unsigned char* xa = lds + S_X + (32 * s2 + 4 * g + q4) * S_XSTR + (16 * pb + 4 * p4) * 2;
                const s16x4 lo = TR16(xa), hi = TR16(xa + 16 * S_XSTR); const bf16x8 xf = __builtin_shufflevector(lo, hi, 0, 1, 2, 3, 4, 5, 6, 7);
                yacc[pb] = MFMA16(xf, pf, yacc[pb]); }
        }
        { const size_t tok = tok0 + lrow; float ssq = 0.f;
#pragma unroll
          for (int pb = 0; pb < 4; ++pb) { const int p0 = 16 * pb + 4 * g;
              const v2u xs_ = *(const LAS v2u*)(lds + S_X + lrow * S_XSTR + p0 * 2);
              const v2u zr_ = zr[pb];
              const float o0 = (yacc[pb].x + bflo(xs_.x) * dsk) * silu_f(bflo(zr_.x)), o1 = (yacc[pb].y + bfhi(xs_.x) * dsk) * silu_f(bfhi(zr_.x));
              const float o2 = (yacc[pb].z + bflo(xs_.y) * dsk) * silu_f(bflo(zr_.y)), o3 = (yacc[pb].w + bfhi(xs_.y) * dsk) * silu_f(bfhi(zr_.y));
              ssq += (o0 * o0 + o1 * o1) + (o2 * o2 + o3 * o3);
              *(GAS unsigned*)((unsigned char*)MIX + tok * DM + ATT_W + h * 64 + p0) = pk4_fp8(o0 * SS8, o1 * SS8, o2 * SS8, o3 * SS8); }
          ssq += __shfl_xor(ssq, 16); ssq += __shfl_xor(ssq, 32);
          if (g == 0 && doatom) unsafeAtomicAdd(ssqp + tok * 4 + 2 + g8, ssq); }
        { const float cdec = __expf(cs_last);
#pragma unroll
          for (int i = 0; i < 4; ++i) hacc[i] = hacc[i] * cdec;
#pragma unroll
          for (int ks = 0; ks < 4; ++ks) {
              LAS unsigned char* xa = lds + S_XW + (32 * ks + 8 * g + q4) * S_XSTR + (16 * pbw + 4 * p4) * 2;
              const s16x4 xlo = TR16(xa), xhi = TR16(xa + 4 * S_XSTR); const bf16x8 xf = __builtin_shufflevector(xlo, xhi, 0, 1, 2, 3, 4, 5, 6, 7);
#pragma unroll
              for (int i = 0; i < 4; ++i) { const int nb = 4 * nhw + i; LAS unsigned char* ba = lds + S_BM + (32 * ks + 8 * g + q4) * S_BSTR + (16 * nb + 4 * p4) * 2;
                  const s16x4 blo = TR16(ba), bhi = TR16(ba + 4 * S_BSTR); const bf16x8 bfr = __builtin_shufflevector(blo, bhi, 0, 1, 2, 3, 4, 5, 6, 7);
                  hacc[i] = MFMA16(bfr, xf, hacc[i]); } } }
        __syncthreads();
#pragma unroll
        for (int i = 0; i < 4; ++i) { const int nb = 4 * nhw + i; v2u o; o.x = pk2(hacc[i].x, hacc[i].y); o.y = pk2(hacc[i].z, hacc[i].w);
            *(LAS v2u*)(lds + S_HB + (16 * pbw + c16) * S_BSTR + (16 * nb + 4 * g) * 2) = o; }
    }
#undef S_PREFETCH
    __syncthreads();
}

__device__ __forceinline__ void mix_normalize(Frame& F) {
    const int tid_ = fresh_tid(), lane = tid_ & 63; const int gw = blockIdx.x * NWAVES + __builtin_amdgcn_readfirstlane(tid_ >> 6), NGW = F.G * NWAVES;
    const float* const ssqp = F.ssq(); bf16* const MIX = F.HN(); const float* const gatt = F.attn_out_norm(); const float* const gssm = F.ssm_out_norm();
    for (int m = gw; m < MTOK; m += NGW) {
        const float* sq = ssqp + (size_t)m * 4;
        const float s1 = __hip_atomic_load(sq + 1, RLX_AGENT), s2 = __hip_atomic_load(sq + 2, RLX_AGENT), s3 = __hip_atomic_load(sq + 3, RLX_AGENT);
        const float ra = 1.f / sqrtf(s1 * (1.f / 1024.f) + EPS), r0 = 1.f / sqrtf(s2 * (1.f / 512.f) + EPS), r1 = 1.f / sqrtf(s3 * (1.f / 512.f) + EPS);
        GAS v4u* row = (GAS v4u*)(MIX + (size_t)m * DM);
#pragma unroll
        for (int j = 0; j < 4; ++j) { const int idx = lane + 64 * j, col = 8 * idx; const float rs = (j < 2) ? ra : ((j == 2) ? r0 : r1);
            const float* gp = (j < 2) ? (gatt + col) : (gssm + (col - ATT_W));
            const f32x4 g0 = *(const GAS f32x4*)gp, g1 = *(const GAS f32x4*)(gp + 4); const v4u v = row[idx]; v4u o;
            o.x = pk2(bflo(v.x) * rs * g0.x, bfhi(v.x) * rs * g0.y); o.y = pk2(bflo(v.y) * rs * g0.z, bfhi(v.y) * rs * g0.w);
            o.z = pk2(bflo(v.z) * rs * g1.x, bfhi(v.z) * rs * g1.y); o.w = pk2(bflo(v.w) * rs * g1.z, bfhi(v.w) * rs * g1.w); row[idx] = o; }
    }
}

constexpr int P_EIDX = 0, P_GATE = 16384, P_LST = 32768, P_HN = 65536, P_ACT = 98304, P_END = 102400;
static_assert(P_END <= RING_BYTES, "peer LDS map");
__constant__ unsigned char PEER_CAND[52] = {0, 1, 2, 3, 4, 5, 6, 7, 8, 9, 10, 11, 12, 13, 14, 15, 16, 17, 18, 19, 20, 21, 22, 23, 32, 33, 34, 35, 36, 48, 49, 50, 51, 64, 65, 66, 80, 81, 96, 97, 112, 113, 128, 144, 160, 176, 192, 208, 224, 240, 255, 255};
__device__ __forceinline__ unsigned f2ord(float f) { const unsigned u = __builtin_bit_cast(unsigned, f); return u ^ ((u >> 31) ? 0xFFFFFFFFu : 0x80000000u); }
__device__ __forceinline__ float ord2f(unsigned u) { return __builtin_bit_cast(float, u ^ ((u >> 31) ? 0x80000000u : 0xFFFFFFFFu)); }
#define CSWAPD(a, b) do { const unsigned hi_ = (a) > (b) ? (a) : (b), lo_ = (a) > (b) ? (b) : (a); (a) = hi_; (b) = lo_; } while (0)
template <int N> __device__ __forceinline__ void bitonic_sort_desc(unsigned (&v)[N]) {
#pragma unroll
    for (int k = 2; k <= N; k <<= 1)
#pragma unroll
        for (int j = k >> 1; j > 0; j >>= 1)
#pragma unroll
            for (int i = 0; i < N; ++i) { const int l = i ^ j; if (l > i) { if ((i & k) == 0) CSWAPD(v[i], v[l]); else CSWAPD(v[l], v[i]); } }
}
__device__ __forceinline__ void merge16_xor(unsigned (&v)[16], int dist) {
    unsigned o[16];
#pragma unroll
    for (int i = 0; i < 16; ++i) o[i] = (unsigned)__shfl_xor((int)v[i], dist);
#pragma unroll
    for (int i = 0; i < 16; ++i) v[i] = v[i] > o[15 - i] ? v[i] : o[15 - i];
#pragma unroll
    for (int j = 8; j > 0; j >>= 1)
#pragma unroll
        for (int i = 0; i < 16; ++i) { const int l = i ^ j; if (l > i) CSWAPD(v[i], v[l]); }
}
__device__ __forceinline__ float gelu_erf(float x) { return 0.5f * x * (1.f + erff(x * 0.70710678118654752f)); }
__device__ __forceinline__ float fp4_dec1(unsigned n) { const unsigned m = n & 7u; unsigned bits = (m >= 2u) ? (((126u + (m >> 1)) << 23) | ((m & 1u) << 22)) : (m ? 0x3F000000u : 0u); bits |= (n & 8u) << 28; return __builtin_bit_cast(float, bits); }
__device__ __forceinline__ f32x2 fp4_dec2(unsigned x) { f32x2 r; r.x = fp4_dec1(x & 15u); r.y = fp4_dec1((x >> 4) & 15u); return r; }
typedef long i64;
typedef int v8i __attribute__((ext_vector_type(8)));
template <bool dry = false> __device__ __forceinline__ void peer_unit(Frame& F, int u) {
    LAS unsigned char* lds = F.lds + RING_OFF;
    const int tid_ = fresh_tid(), lane = tid_ & 63, w = __builtin_amdgcn_readfirstlane(tid_ >> 6), g = lane >> 4, c16 = lane & 15;
    const int T0 = 32 * u;
    LAS int* eidx = (LAS int*)(lds + P_EIDX); LAS float* gate = (LAS float*)(lds + P_GATE);
    LAS unsigned* lst = (LAS unsigned*)(lds + P_LST) + w * 1024;
    const bf16* const QP = F.QP(); const bf16* const SK = F.SK(); float* const outp = F.out(); const bf16* const X1B = F.X1B(); const float* const fgain = F.ffn_norm(); const float* const fing = F.final_norm(); const unsigned char* const U8 = F.U8(); const unsigned char* const V8 = F.V8();
#ifndef NO_ROUTE
#pragma unroll 1
    for (int c = 0; c < 2; ++c) {
        const int p = 2 * w + c;
        bf16x8 qf[2][4];
#pragma unroll
        for (int tb = 0; tb < 2; ++tb) { const unsigned qo = ((unsigned)(T0 + 16 * tb + c16) * (unsigned)DM + (unsigned)(p * 128 + 8 * g)) * 2u;
#pragma unroll
            for (int ks = 0; ks < 4; ++ks) qf[tb][ks] = __builtin_nontemporal_load((const GAS bf16x8*)((const unsigned char*)QP + (qo + 64u * ks))); }
        unsigned key[2][32];
        bf16x8 sf[2][4];
        const unsigned so0 = ((unsigned)(p * 128 + c16) * 128u + 8u * (unsigned)g) * 2u;
#define SK_LOAD(buf, kb_) do { _Pragma("unroll") for (int ks = 0; ks < 4; ++ks) sf[buf][ks] = *(const GAS bf16x8*)((const unsigned char*)SK + (so0 + (unsigned)(kb_) * 4096u + 64u * ks)); } while (0)
        SK_LOAD(0, 0);
#pragma unroll
        for (int kb = 0; kb < 8; ++kb) {
            if (kb < 7) SK_LOAD((kb + 1) & 1, kb + 1);
            __builtin_amdgcn_sched_barrier(0);
#pragma unroll
            for (int tb = 0; tb < 2; ++tb) { f32x4 acc = (f32x4){0.f, 0.f, 0.f, 0.f};
#pragma unroll
                for (int ks = 0; ks < 4; ++ks) acc = MFMA16(sf[kb & 1][ks], qf[tb][ks], acc);
#pragma unroll
                for (int r = 0; r < 4; ++r) key[tb][kb * 4 + r] = (f2ord(acc[r]) & ~0x7Fu) | (unsigned)(16 * kb + 4 * g + r); }
            __builtin_amdgcn_sched_barrier(0); }
#undef SK_LOAD
#pragma unroll
        for (int tb = 0; tb < 2; ++tb) {
            bitonic_sort_desc<32>(key[tb]);
            unsigned top[16];
#pragma unroll
            for (int i = 0; i < 16; ++i) top[i] = key[tb][i];
            merge16_xor(top, 16); merge16_xor(top, 32);
            if (g == 0) { LAS v4u* d = (LAS v4u*)(lst + (c * 32 + 16 * tb + c16) * 16);
                d[0] = (v4u){top[0], top[1], top[2], top[3]}; d[1] = (v4u){top[4], top[5], top[6], top[7]}; d[2] = (v4u){top[8], top[9], top[10], top[11]}; d[3] = (v4u){top[12], top[13], top[14], top[15]}; } }
    }
    for (int tb = 0; tb < 2; ++tb) {
        LDS_WAIT();
        const LAS unsigned* l1 = lst + (16 * tb + c16) * 16; const LAS unsigned* l2 = lst + (32 + 16 * tb + c16) * 16;
        unsigned ck[16];
#pragma unroll
        for (int k = 0; k < 13; ++k) { const unsigned ab = PEER_CAND[4 * k + g]; const unsigned a = ab >> 4, bq = ab & 15u;
            const float s = ord2f(l1[a] & ~0x7Fu) + ord2f(l2[bq] & ~0x7Fu); ck[k] = (ab == 255u) ? 0u : ((f2ord(s) & ~0xFFu) | ab); }
        ck[13] = 0u; ck[14] = 0u; ck[15] = 0u;
        bitonic_sort_desc<16>(ck);
        merge16_xor(ck, 16); merge16_xor(ck, 32);
        if (g == 0) { const int tl = 16 * tb + c16; const float m = ord2f(ck[0] & ~0xFFu); float e[16]; float sum = 0.f;
#pragma unroll
            for (int k = 0; k < 16; ++k) { e[k] = __expf(ord2f(ck[k] & ~0xFFu) - m); sum += e[k]; }
            const float inv = 1.f / sum;
#pragma unroll
            for (int k = 0; k < 16; ++k) { const unsigned a = (ck[k] >> 4) & 15u, bq = ck[k] & 15u; const int ex = (int)((l1[a] & 0x7Fu) * 128u + (l2[bq] & 0x7Fu));
                eidx[tl * 128 + w * 16 + k] = ex; gate[tl * 128 + w * 16 + k] = e[k] * inv; } }
    }
#endif
    __syncthreads();
    LAS unsigned char* hnb = lds + P_HN + w * 4096; LAS float* actl = (LAS float*)(lds + P_ACT) + w * 128;
    const LAS unsigned char* hb = hnb + 16 * g + ((c16 == 1) ? 1024 : 0);
    v4u bA[8], bB[8];
#ifdef PROBE_UROW
#define U_ISSUE(buf, e_, jb) do { if (dry) { _Pragma("unroll") for (int jj = 0; jj < 8; ++jj) { const unsigned uo_ = (unsigned)__shfl((int)(e_), 8 * (jb) + jj) * (unsigned)ROWB + 16u * (unsigned)lane; buf[jj] = *(const GAS v4u*)(U8 + uo_); } } else { \
        const unsigned uo_ = (unsigned)(e_) * (unsigned)ROWB + 16u * (unsigned)g + 512u * (unsigned)(jb); \
        _Pragma("unroll") for (int jj = 0; jj < 8; ++jj) buf[jj] = *(const GAS v4u*)(U8 + (uo_ + 64u * jj)); } __builtin_amdgcn_sched_barrier(0); } while (0)
#else
#define U_ISSUE(buf, e_, jb) do { const unsigned uo_ = (unsigned)(e_) * (unsigned)ROWB + 16u * (unsigned)g + 512u * (unsigned)(jb); \
        _Pragma("unroll") for (int jj = 0; jj < 8; ++jj) buf[jj] = *(const GAS v4u*)(U8 + (uo_ + 64u * jj)); __builtin_amdgcn_sched_barrier(0); } while (0)
#endif
#define U_CONSUME(buf, jb) do { v4u bq_[8]; _Pragma("unroll") for (int jj = 0; jj < 8; ++jj) bq_[jj] = *(const LAS v4u*)(hb + 64 * (8 * (jb) + jj)); \
        __builtin_amdgcn_sched_barrier(0); \
        _Pragma("unroll") for (int jj = 0; jj < 8; ++jj) { const v4u a_ = buf[jj]; \
            const v8i av_ = {(int)a_.x, (int)a_.y, (int)a_.z, (int)a_.w, 0, 0, 0, 0}; const v8i bv_ = {(int)bq_[jj].x, (int)bq_[jj].y, (int)bq_[jj].z, (int)bq_[jj].w, 0, 0, 0, 0}; \
            acc = __builtin_amdgcn_mfma_scale_f32_16x16x128_f8f6f4(av_, bv_, acc, 4, 4, 0, 0x7f7f7f7f, 0, 0x7f7f7f7f); } __builtin_amdgcn_sched_barrier(0); } while (0)
#define U_ACT(grp_) do { const float l0_ = __shfl_down(acc.x, 1), l1_ = __shfl_down(acc.y, 1), l2_ = __shfl_down(acc.z, 1), l3_ = __shfl_down(acc.w, 1); \
        if (c16 == 0) { const int k0 = 16 * (grp_) + 4 * g; constexpr float isc = 1.f / (SU * SH4), ilo = 1.f / SLO4; const f32x4 gt = *(const LAS f32x4*)(gate + tl * 128 + k0); \
        f32x4 a4; a4.x = gelu_erf((acc.x + l0_ * ilo) * isc) * gt.x; a4.y = gelu_erf((acc.y + l1_ * ilo) * isc) * gt.y; a4.z = gelu_erf((acc.z + l2_ * ilo) * isc) * gt.z; a4.w = gelu_erf((acc.w + l3_ * ilo) * isc) * gt.w; *(LAS f32x4*)(actl + k0) = a4; } } while (0)
#define V_ISSUE(buf, kb_) do { _Pragma("unroll") for (int kk = 0; kk < 8; ++kk) { const int e_ = eidx[tl * 128 + 8 * (kb_) + kk] & emask; const unsigned vo_ = (unsigned)e_ * (unsigned)ROWB + 16u * (unsigned)lane; \
        buf[kk] = *(const GAS v4u*)(V8 + vo_); } __builtin_amdgcn_sched_barrier(0); } while (0)
#ifdef FP4_SOFT_DEC
#define FP4_DEC(x) fp4_dec2(x)
#else
#define FP4_DEC(x) __builtin_amdgcn_cvt_scalef32_pk_f32_fp4((x), 1.0f, 0)
#endif
#ifdef FP4_SWAP_DEC
#define FP4_ACC(oa, ob, d) do { oa += a_ * d.y; ob += a_ * d.x; } while (0)
#else
#define FP4_ACC(oa, ob, d) do { oa += a_ * d.x; ob += a_ * d.y; } while (0)
#endif
#define PIN8x2(a, i) asm volatile("" : "+v"(a[i]), "+v"(a[i + 1]), "+v"(a[i + 2]), "+v"(a[i + 3]), "+v"(a[i + 4]), "+v"(a[i + 5]), "+v"(a[i + 6]), "+v"(a[i + 7]))
#define V_CONSUME(buf, kb_) do { _Pragma("unroll") for (int kk = 0; kk < 8; ++kk) { const float as_ = actl[8 * (kb_) + kk]; const f32x2 a2_ = {as_, as_}; \
        const unsigned vw[4] = {buf[kk].x, buf[kk].y, buf[kk].z, buf[kk].w}; \
        _Pragma("unroll") for (int q = 0; q < 4; ++q) { \
            o2[4 * q]     = __builtin_elementwise_fma(__builtin_amdgcn_cvt_scalef32_pk_f32_fp4(vw[q], 1.0f, 0), a2_, o2[4 * q]); \
            o2[4 * q + 1] = __builtin_elementwise_fma(__builtin_amdgcn_cvt_scalef32_pk_f32_fp4(vw[q], 1.0f, 1), a2_, o2[4 * q + 1]); \
            o2[4 * q + 2] = __builtin_elementwise_fma(__builtin_amdgcn_cvt_scalef32_pk_f32_fp4(vw[q], 1.0f, 2), a2_, o2[4 * q + 2]); \
            o2[4 * q + 3] = __builtin_elementwise_fma(__builtin_amdgcn_cvt_scalef32_pk_f32_fp4(vw[q], 1.0f, 3), a2_, o2[4 * q + 3]); } \
        PIN8x2(o2, 0); PIN8x2(o2, 8); } } while (0)
#define V_KEEP(buf) do { _Pragma("unroll") for (int kk = 0; kk < 8; ++kk) asm volatile("" :: "v"(buf[kk])); } while (0)
#ifndef NO_GATHER
#ifdef PROBE_L2RES
    constexpr int emask = dry ? PROBE_L2RES : 16383;
#else
    constexpr int emask = 16383;
#endif
    int e_cur = eidx[w * 128 + c16] & emask;
    v2u xn[8];
#define X_ISSUE(tok_) do { const unsigned xb_ = (unsigned)(tok_) * (unsigned)(DM * 2) + 8u * (unsigned)lane; _Pragma("unroll") for (int j = 0; j < 8; ++j) xn[j] = __builtin_nontemporal_load((const GAS v2u*)((const unsigned char*)X1B + (xb_ + 512u * j))); } while (0)
    X_ISSUE(T0 + w);
    U_ISSUE(bA, e_cur, 0);
    for (int ti = 0; ti < 4; ++ti) {
        const int tl = w + 8 * ti; const size_t token = (size_t)T0 + tl;
        f32x4 xr[8]; float ss = 0.f;
        const unsigned xo = (unsigned)token * (unsigned)(DM * 4) + 16u * (unsigned)lane;
        {
#pragma unroll
          for (int j = 0; j < 8; ++j) { const v2u r = xn[j]; xr[j] = (f32x4){bflo(r.x), bfhi(r.x), bflo(r.y), bfhi(r.y)}; }
#pragma unroll
          for (int j = 0; j < 8; ++j) ss += (xr[j].x * xr[j].x + xr[j].y * xr[j].y) + (xr[j].z * xr[j].z + xr[j].w * xr[j].w); }
        const float rs2 = __builtin_amdgcn_rsqf(wave_sum(ss) * (1.f / DM) + EPS);
        {
          const float* fg_ = fgain; asm volatile("" : "+s"(fg_));
          const unsigned char* gp = (const unsigned char*)fg_; const unsigned go = 16u * (unsigned)lane;
          unsigned hw[4], lw[4];
#pragma unroll
          for (int q = 0; q < 4; ++q) { unsigned wh = 0u, wl = 0u;
#pragma unroll
              for (int t = 0; t < 2; ++t) { const int j = 2 * q + t; const f32x4 gg = *(const GAS f32x4*)(gp + (go + 1024u * j)); const f32x4 hv = xr[j] * gg * (rs2 * SH4);
                  const float h0 = clampf(hv.x, 6.f), h1 = clampf(hv.y, 6.f), h2 = clampf(hv.z, 6.f), h3 = clampf(hv.w, 6.f);
                  const unsigned p0 = __builtin_amdgcn_cvt_scalef32_pk_fp4_f32(0u, h0, h1, 1.0f, 0), p1 = __builtin_amdgcn_cvt_scalef32_pk_fp4_f32(0u, h2, h3, 1.0f, 0);
                  const f32x2 d0 = __builtin_amdgcn_cvt_scalef32_pk_f32_fp4(p0, 1.0f, 0), d1 = __builtin_amdgcn_cvt_scalef32_pk_f32_fp4(p1, 1.0f, 0);
                  const unsigned r0 = __builtin_amdgcn_cvt_scalef32_pk_fp4_f32(0u, clampf((h0 - d0.x) * SLO4, 6.f), clampf((h1 - d0.y) * SLO4, 6.f), 1.0f, 0), r1 = __builtin_amdgcn_cvt_scalef32_pk_fp4_f32(0u, clampf((h2 - d1.x) * SLO4, 6.f), clampf((h3 - d1.y) * SLO4, 6.f), 1.0f, 0);
                  wh |= ((p0 & 0xFFu) | ((p1 & 0xFFu) << 8)) << (16 * t); wl |= ((r0 & 0xFFu) | ((r1 & 0xFFu) << 8)) << (16 * t); }
              hw[q] = wh; lw[q] = wl; }
          *(LAS v4u*)(hnb + 16 * lane) = (v4u){hw[0], hw[1], hw[2], hw[3]}; *(LAS v4u*)(hnb + 1024 + 16 * lane) = (v4u){lw[0], lw[1], lw[2], lw[3]}; }
        LDS_WAIT();
#pragma unroll 1
        for (int grp = 0; grp < 7; ++grp) {
            const int e_nxt = eidx[tl * 128 + 16 * (grp + 1) + c16] & emask;
            f32x4 acc = (f32x4){0.f, 0.f, 0.f, 0.f};
            U_ISSUE(bB, e_cur, 1); U_CONSUME(bA, 0);
            U_ISSUE(bA, e_nxt, 0);
            U_CONSUME(bB, 1);
            U_ACT(grp);
            e_cur = e_nxt;
        }
        { f32x4 acc = (f32x4){0.f, 0.f, 0.f, 0.f};
          U_ISSUE(bB, e_cur, 1); U_CONSUME(bA, 0);
          V_ISSUE(bA, 0);
          U_CONSUME(bB, 1);
          U_ACT(7); }
        LDS_WAIT();
        f32x2 o2[16];
#pragma unroll
        for (int i = 0; i < 16; ++i) o2[i] = (f32x2){0.f, 0.f};
#pragma unroll 1
        for (int kb = 0; kb < 14; kb += 2) {
            V_ISSUE(bB, kb + 1); V_CONSUME(bA, kb);
            V_ISSUE(bA, kb + 2);
            V_CONSUME(bB, kb + 1);
        }
        { V_ISSUE(bB, 15); V_CONSUME(bA, 14);
          const int tn = (ti < 3) ? tl + 8 : tl;
          e_cur = eidx[tn * 128 + c16] & emask; X_ISSUE(T0 + tn); U_ISSUE(bA, e_cur, 0);
          V_CONSUME(bB, 15); }
        { constexpr float isv = 1.f / SV; float s2 = 0.f;
#pragma unroll
          for (int j = 0; j < 8; ++j) { xr[j] = xr[j] + (f32x4){o2[2 * j].x, o2[2 * j].y, o2[2 * j + 1].x, o2[2 * j + 1].y} * isv;
              s2 += (xr[j].x * xr[j].x + xr[j].y * xr[j].y) + (xr[j].z * xr[j].z + xr[j].w * xr[j].w); }
          const float rf = __builtin_amdgcn_rsqf(wave_sum(s2) * (1.f / DM) + EPS);
          const float* fi_ = fing; asm volatile("" : "+s"(fi_));
          const unsigned char* fp = (const unsigned char*)fi_; unsigned char* op = (unsigned char*)outp; const unsigned fo = 16u * (unsigned)lane;
          if (!dry || rf == 1.2345e30f)
#pragma unroll
          for (int j = 0; j < 8; ++j) __builtin_nontemporal_store(xr[j] * rf * *(const GAS f32x4*)(fp + (fo + 1024u * j)), (GAS f32x4*)(op + (xo + 1024u * j))); }
    }
#endif
#undef U_ISSUE
#undef X_ISSUE
#undef U_ACT
#undef U_CONSUME
#undef V_ISSUE
#undef V_CONSUME
    __syncthreads();
}

__global__ void __launch_bounds__(NWAVES * 64, 2) hybrid_fwd(Args args) {
    extern __shared__ __attribute__((aligned(16))) unsigned char lds[];
    Frame F;
    F.lds = (LAS unsigned char*)lds;
    F.MISC = (volatile LAS unsigned*)(F.lds + MISC_OFF);
    F.tid = threadIdx.x; F.lane = F.tid & 63; F.wave = __builtin_amdgcn_readfirstlane(F.tid >> 6); F.G = gridDim.x;
    for (int u = F.tid; u < (LDS_BYTES - LDSCTL_OFF) / 4; u += NWAVES * 64) ((LAS unsigned*)(F.lds + LDSCTL_OFF))[u] = 0u;
    __syncthreads();
    (void)args;
    XcdBarrier bar = xcd_barrier_post(F.ctl() + CW_BAR, F.MISC + 8);

#ifndef NO_P0
#ifdef PROBE_P0X2
    { int reps = 2; asm volatile("" : "+s"(reps)); for (int rep = 0; rep < reps; ++rep) p0_prologue(F); }
#else
    p0_prologue(F);
#endif
#endif
    xcd_barrier(bar);
#ifndef NO_P1
#ifdef PROBE_GX2
    { int reps = 2; asm volatile("" : "+s"(reps)); for (int rep = 0; rep < reps; ++rep) {
#else
    { { const int rep = 0, reps = 1;
#endif
      pg8::Gemm gm{F.HN(), F.WinT(), MTOK, NB16, DM}; pg8::StaticOrder S; S.init(MTOK, NB16, F.G, (int)blockIdx.x);
      EpiProj E{F.PROJ(), F.dtraw(), (rep + 1 < reps) ? nullptr : F.kmean()};
      pg8::gemm_phase<EpiProj, pg8::StaticOrder, PG8_ALIGN, PG8_SP2>(F.lds + RING_OFF, gm, S, E); } }
    { const int nun = (MTOK / 256) * (NB16 / 256), rem = nun % F.G;
      if (rem && (int)blockIdx.x >= rem) tables_convert(F, tab_split(F.G), TAB_ITEMS, (size_t)((int)blockIdx.x - rem) * (NWAVES * 64) + fresh_tid(), (size_t)(F.G - rem) * (NWAVES * 64)); }
    __syncthreads();
    {
      pg8::Gemm gm{(const pg8::bf16_t*)F.HN8(), (const pg8::bf16_t*)F.WinT8(), MTOK, F8_HI - F8_LO, DM / 2}; pg8::StaticOrder S; S.init(MTOK, F8_HI - F8_LO, F.G, (int)blockIdx.x);
      EpiProj8 E{F.PROJ()};
      pg8::gemm_phase<EpiProj8, pg8::StaticOrder, PG8_ALIGN, PG8_SP2, true>(F.lds + RING_OFF, gm, S, E); }
#endif
    xcd_barrier(bar);
#ifdef PROBE_P15X2
    conv_phase(F);
#endif
    conv_phase(F);
    xcd_barrier(bar);
#ifdef PROBE_P2X2
    { int reps = 2; asm volatile("" : "+s"(reps)); for (int rep = 0; rep < reps; ++rep) {
#else
    { { const int rep = 0, reps = 1;
#endif
    const bool doatom = rep + 1 == reps;
    for (;;) {
        if (F.tid == 0) F.MISC[0] = xb_add(F.ctl() + CW_Q2 + 64 * rep, 1u);
        __syncthreads();
        const int ui = (int)F.MISC[0];
        __syncthreads();
        if (ui >= 128 + 512) break;
#ifdef PROBE_P2_SSD
        if (ui < 128 || doatom)
#endif
#ifdef PROBE_P2_ATT
        if (ui >= 128 || doatom)
#endif
        {
        if (ui < 128) ssd_unit(F, ui >> 4, ui & 15, doatom);
        else { const int a = ui - 128; attn_unit(F, (a & 63) >> 3, a & 7, 7 - (a >> 6), doatom); }
        }
    } } }
    xcd_barrier(bar);
#ifndef NO_P3
#ifdef PROBE_GX2
    { int reps = 2; asm volatile("" : "+s"(reps)); for (int rep = 0; rep < reps; ++rep) {
#else
    { { const int rep = 0, reps = 1;
#endif
      pg8::Gemm gm{F.HN(), F.WoutT(), MTOK, DM, DM / 2}; pg8::StaticOrder S; S.init(MTOK, DM, F.G, (int)blockIdx.x);
      {
        const int t_ = fresh_tid(); const float* const sq = F.ssq();
#pragma unroll 1
        for (int ii = t_ >> 8; ii < 3; ii += 2) { pg8::Unit uu;
          if (S.next(ii, uu)) { const int row = uu.pm * 256 + (t_ & 255);
            const float q1 = __hip_atomic_load(sq + (size_t)row * 4 + 1, RLX_AGENT), q2 = __hip_atomic_load(sq + (size_t)row * 4 + 2, RLX_AGENT), q3 = __hip_atomic_load(sq + (size_t)row * 4 + 3, RLX_AGENT);
            const float sa = __builtin_amdgcn_rsqf(q1 * (1.f / 1024.f) + EPS), s0 = __builtin_amdgcn_rsqf(q2 * (1.f / 512.f) + EPS), s1 = __builtin_amdgcn_rsqf(q3 * (1.f / 512.f) + EPS);
            *(LAS f32x4*)(F.lds + SEGTAB_OFF + (ii * 256 + (t_ & 255)) * 16) = (f32x4){sa / s0 * (SS8 / SA8), s0 / s1, s1 * (1.f / (SS8 * SW8)), 0.f}; } }
        __syncthreads(); }
      EpiOut E{F.x(), F.X1B(), F.X18(), F.ssq(), rep + 1 == reps, (const LAS f32x4*)(F.lds + SEGTAB_OFF)};
      pg8::gemm_phase<EpiOut, pg8::StaticOrder, PG8_ALIGN, PG8_SP2, true>(F.lds + RING_OFF, gm, S, E); } }
#endif
    xcd_barrier(bar);
#ifndef NO_P4
#ifdef PROBE_GX2
    { int reps = 2; asm volatile("" : "+s"(reps)); for (int rep = 0; rep < reps; ++rep) {
#else
    { { const int rep = 0, reps = 1; (void)rep; (void)reps;
#endif
      pg8::Gemm gm{(const pg8::bf16_t*)F.X18(), F.WqT(), MTOK, DM, DM / 2}; pg8::StaticOrder S; S.init(MTOK, DM, F.G, (int)blockIdx.x);
      EpiQ E{F.QP(), F.ssq()};
      pg8::gemm_phase<EpiQ, pg8::StaticOrder, PG8_ALIGN, PG8_SP2, true>(F.lds + RING_OFF, gm, S, E); } }
#endif
    xcd_barrier(bar);
#ifndef NO_P5
#ifdef PROBE_P5X2
    { for (int u = blockIdx.x; u < MTOK / 32; u += F.G) peer_unit<true>(F, u);
      for (int u = blockIdx.x; u < MTOK / 32; u += F.G) peer_unit<false>(F, u); }
#else
    for (int u = blockIdx.x; u < MTOK / 32; u += F.G) peer_unit(F, u);
#endif
#endif
}

extern "C" void kernel_launch(void* const* d_in, const int* in_sizes, int n_in, void* d_out, int out_size, void* d_ws, size_t ws_size, hipStream_t stream) {
    static int grid = 0;
    if (grid == 0) {
        if (n_in != 18 || out_size != MTOK * DM || ws_size < WS_END) { fprintf(stderr, "kernel_launch: unexpected shapes (n_in %d, out %d, ws %zu)\n", n_in, out_size, ws_size); grid = -1; return; }
        int dev = 0, cus = 0, per_cu = 0;
        if (hipGetDevice(&dev) != hipSuccess || hipDeviceGetAttribute(&cus, hipDeviceAttributeMultiprocessorCount, dev) != hipSuccess) { grid = -1; return; }
        if (hipFuncSetAttribute((const void*)hybrid_fwd, hipFuncAttributeMaxDynamicSharedMemorySize, LDS_BYTES) != hipSuccess) { fprintf(stderr, "kernel_launch: hipFuncSetAttribute failed\n"); grid = -1; return; }
        if (hipOccupancyMaxActiveBlocksPerMultiprocessor(&per_cu, (const void*)hybrid_fwd, NWAVES * 64, LDS_BYTES) != hipSuccess || per_cu < 1)
            fprintf(stderr, "kernel_launch: note: occupancy query reports %d workgroups per CU\n", per_cu);
        (void)hipGetLastError();
        grid = cus;
    }
    if (grid < 0) return;
    if (hipMemsetAsync((char*)d_ws + WS_CTL, 0, CTL_ZERO_BYTES, stream) != hipSuccess) return;
    Args a{};
    for (int i = 0; i < 18; ++i) a.in[i] = (const float*)d_in[i];
    a.out = (float*)d_out; a.ws = (unsigned char*)d_ws;
    hipLaunchKernelGGL(hybrid_fwd, dim3(grid), dim3(NWAVES * 64), LDS_BYTES, stream, a);
}
```

```cpp
#include <hip/hip_runtime.h>
#include <cstdio>
#include <cstdint>
namespace pg8 {
#define PG8_LAS __attribute__((address_space(3)))
typedef unsigned short bf16_t;
typedef short bf16x8 __attribute__((ext_vector_type(8)));
typedef float f32x4 __attribute__((ext_vector_type(4)));
typedef unsigned u32x4 __attribute__((ext_vector_type(4)));
constexpr int BM = 256, BK = 64, HALF = 128, HTB = HALF * BK * 2  , STAGE_BYTES = 8 * HTB, NXCD = 8, WGM = 8;

__host__ __device__ __forceinline__ int lds_byte(int r, int c) { const int st = (r >> 4) * 2 + (c >> 5), rr = r & 15, cc = c & 31, ob = rr * 64 + cc * 2; return st * 1024 + (ob ^ (((ob >> 9) & 1) << 5)); }
__host__ __device__ __forceinline__ void stage_rc(int b, int& R, int& C) { const int st = b / 1024, sb = b % 1024, swz = sb ^ (((sb >> 9) & 1) << 5); R = (st >> 1) * 16 + swz / 64; C = (st & 1) * 32 + (swz % 64) / 2; }
__host__ __device__ __forceinline__ int perm32(int rho) { const int n = rho >> 4, i = rho & 15; return 8 * (i >> 2) + 4 * n + (i & 3); }

struct Unit { int pm, pn; };
struct Gemm { const bf16_t* A; const bf16_t* Bt; int M, N, K; };

struct StaticOrder {
    int nM, nN, nwg, G, c;
    __host__ __device__ void init(int M, int N, int G_, int c_) { nM = M / BM; nN = N / BM; nwg = nM * nN; G = G_; c = c_; }
    __host__ __device__ bool next(int i, Unit& u) const {
        const long L = (long)i * G + c; if (L >= nwg) return false;
        int wgid = (int)L; { const int q = nwg / NXCD, r = nwg % NXCD, xcd = wgid % NXCD, off = wgid / NXCD; wgid = (xcd < r ? xcd * (q + 1) : r * (q + 1) + (xcd - r) * q) + off; }
        const int nig = WGM * nN, gid = wgid / nig, fm = gid * WGM, gsz = (nM - fm) < WGM ? (nM - fm) : WGM;
        u.pm = fm + ((wgid % nig) % gsz); u.pn = (wgid % nig) / gsz; return true;
    }
    __device__ __forceinline__ void a_ready(const Unit&) const {}
    __device__ __forceinline__ void done(const Unit&) const {}
};

__device__ __forceinline__ unsigned cvt_pk_bf16(float lo, float hi) { unsigned r; asm volatile("v_cvt_pk_bf16_f32 %0, %1, %2" : "=v"(r) : "v"(lo), "v"(hi)); return r; }
typedef float f32x2 __attribute__((ext_vector_type(2)));
__device__ __forceinline__ f32x2 gelu_pk(f32x2 v) {
    const f32x2 av = __builtin_elementwise_abs(v), d = av * 0.2316418882f + 1.0f;
    f32x2 t; t.x = __builtin_amdgcn_rcpf(d.x); t.y = __builtin_amdgcn_rcpf(d.y);
    f32x2 q = t * 0.5307027145f + (-0.7265760135f); q = q * t + 0.7107068705f; q = q * t + (-0.142248368f); q = q * t + 0.127414796f; q = q * t;
    const f32x2 s = (v * v) * (-0.72134752044f);
    f32x2 e; e.x = __builtin_amdgcn_exp2f(s.x); e.y = __builtin_amdgcn_exp2f(s.y);
    const f32x2 m = v * (q * e), r = v - m;
    f32x2 o; o.x = v.x < 0.f ? m.x : r.x; o.y = v.y < 0.f ? m.y : r.y; return o;
}

template <int ACT  > struct EpiBf16 {
    static constexpr bool PERM = true, AFTER_DRAIN = false, SEG = false; static_assert(ACT == 0 || ACT == 1, "EpiBf16: ACT is 0 (none) or 1 (gelu_pk)");
    bf16_t* O; int ldc; const float* bias; int split_cols; size_t split_stride; float scale0;
    __device__ __forceinline__ void operator()(const f32x4 (&acc)[2][2][4][2], const Unit& u, int wr, int wc, int fr, int fq) const {
        const int row0 = u.pm * BM + wr * 64 + fr; int colt = u.pn * BM; bf16_t* base = O;
        float sc = 1.f; if (split_cols) { const int t = colt / split_cols; base += (size_t)t * split_stride; colt -= t * split_cols; if (t == 0) sc = scale0; }
        const int col0 = colt + wc * 32 + 8 * fq, bcol0 = u.pn * BM + wc * 32 + 8 * fq;
        f32x4 bv[2][2];
#pragma unroll
        for (int bj = 0; bj < 2; ++bj)
#pragma unroll
            for (int n = 0; n < 2; ++n) bv[bj][n] = bias ? *(const f32x4*)(bias + bcol0 + bj * HALF + 4 * n) : (f32x4){0.f, 0.f, 0.f, 0.f};
#pragma unroll
        for (int ai = 0; ai < 2; ++ai)
#pragma unroll
            for (int m = 0; m < 4; ++m) { bf16_t* rowp = base + (size_t)(row0 + ai * HALF + m * 16) * ldc + col0;
#pragma unroll
                for (int bj = 0; bj < 2; ++bj) { f32x4 v0 = acc[ai][bj][m][0] + bv[bj][0], v1 = acc[ai][bj][m][1] + bv[bj][1];
                    if (ACT == 1) { f32x2 a = gelu_pk((f32x2){v0[0], v0[1]}), b = gelu_pk((f32x2){v0[2], v0[3]}), c = gelu_pk((f32x2){v1[0], v1[1]}), d = gelu_pk((f32x2){v1[2], v1[3]});
                        v0 = (f32x4){a.x, a.y, b.x, b.y}; v1 = (f32x4){c.x, c.y, d.x, d.y}; }
                    v0 = v0 * sc; v1 = v1 * sc; u32x4 w; w.x = cvt_pk_bf16(v0[0], v0[1]); w.y = cvt_pk_bf16(v0[2], v0[3]); w.z = cvt_pk_bf16(v1[0], v1[1]); w.w = cvt_pk_bf16(v1[2], v1[3]);
                    *(u32x4*)(rowp + bj * HALF) = w; } }
    }
};
template <class Epi, class Sched, bool ALIGN_EPI = false, bool SP2 = false, bool F8 = false>
__device__ __forceinline__ void gemm_phase(PG8_LAS unsigned char* lds, const Gemm g, const Sched& S, const Epi& E) {
    int tid_ = threadIdx.x; asm volatile("" : "+v"(tid_));
    const int tid = tid_, wid = __builtin_amdgcn_readfirstlane(tid >> 6), lane = tid & 63, wr = wid >> 2, wc = wid & 3, fr = lane & 15, fq = lane >> 4;
    const int K = g.K, nt = K / BK;
    unsigned voffA[2], voffB[2];
#pragma unroll
    for (int i = 0; i < 2; ++i) { int R, C; stage_rc(tid * 16 + i * 8192, R, C); const int Rb = Epi::PERM ? ((R & ~31) + perm32(R & 31)) : R;
        voffA[i] = (unsigned)(R * K + C) * 2u; voffB[i] = (unsigned)(Rb * K + C) * 2u; }
    const size_t kstep = (size_t)(BK * 2);
    const size_t hstep = (size_t)HALF * K * 2;
    const size_t tstep = 2 * hstep;
    const unsigned ldsw = (unsigned)wid * 1024u;
    const int aoff = lds_byte(wr * 64 + fr, fq * 8), boff = lds_byte(wc * 32 + fr, fq * 8);
#define PG8_SA(b, h) (((b) * 2 + (h)) * HTB)
#define PG8_SB(b, h) ((4 + (b) * 2 + (h)) * HTB)
#define PG8_STAGE(bufoff, gbase, voff) do { _Pragma("unroll") for (int _i = 0; _i < 2; ++_i) \
        __builtin_amdgcn_global_load_lds((const unsigned*)((const char*)(gbase) + (voff)[_i]), (PG8_LAS unsigned*)(lds + (bufoff) + ldsw + _i * 8192), 16, 0, 0); } while (0)
#define PG8_LDA(dst, b, h) do { _Pragma("unroll") for (int m = 0; m < 4; ++m) _Pragma("unroll") for (int k = 0; k < 2; ++k) dst[m][k] = *(const PG8_LAS bf16x8*)(lds + PG8_SA(b, h) + aoff + m * 2048 + k * 1024); } while (0)
#define PG8_LDB(dst, b, h) do { _Pragma("unroll") for (int n = 0; n < 2; ++n) _Pragma("unroll") for (int k = 0; k < 2; ++k) dst[n][k] = *(const PG8_LAS bf16x8*)(lds + PG8_SB(b, h) + boff + n * 2048 + k * 1024); } while (0)
#define PG8_MMA(ai, bj, At, Bt) do { __builtin_amdgcn_s_setprio(1); _Pragma("unroll") for (int m = 0; m < 4; ++m) _Pragma("unroll") for (int n = 0; n < 2; ++n) { \
        if constexpr (F8) { typedef int v8i_ __attribute__((ext_vector_type(8))); typedef int v4i_ __attribute__((ext_vector_type(4))); \
            const v4i_ b0_ = __builtin_bit_cast(v4i_, Bt[n][0]), b1_ = __builtin_bit_cast(v4i_, Bt[n][1]), a0_ = __builtin_bit_cast(v4i_, At[m][0]), a1_ = __builtin_bit_cast(v4i_, At[m][1]); \
            const v8i_ bb_ = {b0_.x, b0_.y, b0_.z, b0_.w, b1_.x, b1_.y, b1_.z, b1_.w}, aa_ = {a0_.x, a0_.y, a0_.z, a0_.w, a1_.x, a1_.y, a1_.z, a1_.w}; \
            asm volatile("v_mfma_scale_f32_16x16x128_f8f6f4 %0, %1, %2, %0, %3, %3 op_sel_hi:[0,0,0]" : "+v"(acc[ai][bj][m][n]) : "v"(bb_), "v"(aa_), "v"(f8one)); } \
        else { _Pragma("unroll") for (int k = 0; k < 2; ++k) acc[ai][bj][m][n] = __builtin_amdgcn_mfma_f32_16x16x32_bf16(Bt[n][k], At[m][k], acc[ai][bj][m][n], 0, 0, 0); } } \
        __builtin_amdgcn_s_setprio(0); } while (0)
#define PG8_WAIT_V(n) asm volatile("s_waitcnt vmcnt(" #n ")" ::: "memory")
#define PG8_WAIT_L(n) asm volatile("s_waitcnt lgkmcnt(" #n ")" ::: "memory")
#define PG8_BAR __builtin_amdgcn_s_barrier()
#define PG8_SCHED __builtin_amdgcn_sched_barrier(0)
    Unit cur, nxt; int ui = 0;
    if (!S.next(0, cur)) return;
    f32x4 acc[2][2][4][2];
    const int f8one = 0x7f7f7f7f;
#pragma unroll
    for (int a = 0; a < 2; ++a)
#pragma unroll
        for (int b = 0; b < 2; ++b)
#pragma unroll
            for (int m = 0; m < 4; ++m)
#pragma unroll
                for (int n = 0; n < 2; ++n) acc[a][b][m][n] = (f32x4){0.f, 0.f, 0.f, 0.f};
    bf16x8 At[4][2], B0[2][2], B1[2][2];
    const char* cA = (const char*)g.A + (size_t)cur.pm * tstep; const char* cB = (const char*)g.Bt + (size_t)cur.pn * tstep;
    S.a_ready(cur);
    float segr[16];
    if constexpr (Epi::SEG) E.seg_load(ui, wr, fr, segr);
    if constexpr (SP2) {
        PG8_STAGE(PG8_SB(0, 0), cB, voffB); PG8_STAGE(PG8_SB(0, 1), cB + hstep, voffB); PG8_STAGE(PG8_SA(0, 0), cA, voffA); PG8_STAGE(PG8_SA(0, 1), cA + hstep, voffA);
        if (wr == 1) PG8_BAR;
        PG8_WAIT_V(2); PG8_BAR;
        PG8_STAGE(PG8_SB(1, 0), cB + kstep, voffB); PG8_STAGE(PG8_SA(1, 0), cA + kstep, voffA); PG8_STAGE(PG8_SB(1, 1), cB + hstep + kstep, voffB);
        PG8_WAIT_V(6); PG8_BAR;
    } else {
        PG8_STAGE(PG8_SB(0, 0), cB, voffB); PG8_STAGE(PG8_SA(0, 0), cA, voffA); PG8_STAGE(PG8_SB(0, 1), cB + hstep, voffB); PG8_STAGE(PG8_SA(0, 1), cA + hstep, voffA);
        if (wr == 1) PG8_BAR;
        PG8_WAIT_V(4); PG8_BAR;
        PG8_STAGE(PG8_SB(1, 0), cB + kstep, voffB); PG8_STAGE(PG8_SA(1, 0), cA + kstep, voffA); PG8_STAGE(PG8_SB(1, 1), cB + hstep + kstep, voffB);
        PG8_WAIT_V(6); PG8_BAR;
    }
    for (;;) {
        const bool has_next = S.next(ui + 1, nxt);
        const char* nA = has_next ? (const char*)g.A + (size_t)nxt.pm * tstep : cA; const char* nB = has_next ? (const char*)g.Bt + (size_t)nxt.pn * tstep : cB;
        int t = 0;
#pragma unroll 1
        for (int sgi = 0; sgi < (Epi::SEG ? 3 : 1); ++sgi) {
        int tend = nt; if constexpr (Epi::SEG) tend = (sgi == 0) ? Epi::SEG_T1 : ((sgi == 1) ? Epi::SEG_T2 : nt);
        for (; t < tend; t += 2) {
            const bool last = (t == nt - 2);
            const char* a1 = cA + (size_t)(t + 1) * kstep;
            const char* a2 = last ? nA : cA + (size_t)(t + 2) * kstep; const char* b2 = last ? nB : cB + (size_t)(t + 2) * kstep;
            const char* a3 = a2 + kstep; const char* b3 = b2 + kstep;
            if (last && has_next) S.a_ready(nxt);
            if constexpr (SP2) {
            PG8_LDB(B0, 0, 0); PG8_LDB(B1, 0, 1); PG8_SCHED; PG8_LDA(At, 0, 0); PG8_STAGE(PG8_SA(1, 1), a1 + hstep, voffA);
            PG8_WAIT_V(8); PG8_WAIT_L(0); PG8_BAR; PG8_MMA(0, 0, At, B0); PG8_MMA(0, 1, At, B1); PG8_BAR; PG8_SCHED;
            PG8_LDA(At, 0, 1); PG8_STAGE(PG8_SB(0, 0), b2, voffB); PG8_STAGE(PG8_SB(0, 1), b2 + hstep, voffB); PG8_STAGE(PG8_SA(0, 0), a2, voffA);
            PG8_WAIT_V(8); PG8_WAIT_L(0); PG8_BAR; PG8_MMA(1, 0, At, B0); PG8_MMA(1, 1, At, B1); PG8_BAR; PG8_SCHED;
            PG8_LDB(B0, 1, 0); PG8_LDB(B1, 1, 1); PG8_SCHED; PG8_LDA(At, 1, 0); PG8_STAGE(PG8_SA(0, 1), a2 + hstep, voffA);
            PG8_WAIT_V(8); PG8_WAIT_L(0); PG8_BAR; PG8_MMA(0, 0, At, B0); PG8_MMA(0, 1, At, B1); PG8_BAR; PG8_SCHED;
            PG8_LDA(At, 1, 1); PG8_STAGE(PG8_SB(1, 0), b3, voffB); PG8_STAGE(PG8_SB(1, 1), b3 + hstep, voffB); PG8_STAGE(PG8_SA(1, 0), a3, voffA);
            PG8_WAIT_V(8); PG8_WAIT_L(0); PG8_BAR; PG8_MMA(1, 0, At, B0); PG8_MMA(1, 1, At, B1); PG8_BAR; PG8_SCHED;
            } else {
            PG8_LDB(B0, 0, 0); PG8_SCHED; PG8_LDA(At, 0, 0); PG8_STAGE(PG8_SA(1, 1), a1 + hstep, voffA);
            PG8_WAIT_L(8); PG8_BAR; PG8_WAIT_L(0); PG8_MMA(0, 0, At, B0); PG8_BAR; PG8_SCHED;
            PG8_LDB(B1, 0, 1); PG8_STAGE(PG8_SB(0, 0), b2, voffB);
            PG8_BAR; PG8_WAIT_L(0); PG8_MMA(0, 1, At, B1); PG8_BAR;
            PG8_LDA(At, 0, 1); PG8_STAGE(PG8_SA(0, 0), a2, voffA);
            PG8_BAR; PG8_WAIT_L(0); PG8_MMA(1, 0, At, B0); PG8_BAR; PG8_SCHED;
            PG8_STAGE(PG8_SB(0, 1), b2 + hstep, voffB);
            PG8_WAIT_V(6); PG8_BAR; PG8_MMA(1, 1, At, B1); PG8_BAR;
            PG8_LDB(B0, 1, 0); PG8_SCHED; PG8_LDA(At, 1, 0); PG8_STAGE(PG8_SA(0, 1), a2 + hstep, voffA);
            PG8_WAIT_L(8); PG8_BAR; PG8_WAIT_L(0); PG8_MMA(0, 0, At, B0); PG8_BAR; PG8_SCHED;
            PG8_LDB(B1, 1, 1); PG8_STAGE(PG8_SB(1, 0), b3, voffB);
            PG8_BAR; PG8_WAIT_L(0); PG8_MMA(0, 1, At, B1); PG8_BAR;
            PG8_LDA(At, 1, 1); PG8_STAGE(PG8_SA(1, 0), a3, voffA);
            PG8_BAR; PG8_WAIT_L(0); PG8_MMA(1, 0, At, B0); PG8_BAR; PG8_SCHED;
            PG8_STAGE(PG8_SB(1, 1), b3 + hstep, voffB);
            PG8_WAIT_V(6); PG8_BAR; PG8_MMA(1, 1, At, B1); PG8_BAR;
            }
        }
        if constexpr (Epi::SEG) E.seg_apply(acc, segr, sgi);
        }
        if constexpr (ALIGN_EPI) { if (wr == 0) PG8_BAR; }
        if constexpr (!Epi::AFTER_DRAIN) { if constexpr (Epi::SEG) E(acc, cur, wr, wc, fr, fq, ui); else E(acc, cur, wr, wc, fr, fq); S.done(cur); }
        if (!has_next) break;
#pragma unroll
        for (int a = 0; a < 2; ++a)
#pragma unroll
            for (int b = 0; b < 2; ++b)
#pragma unroll
                for (int m = 0; m < 4; ++m)
#pragma unroll
                    for (int n = 0; n < 2; ++n) acc[a][b][m][n] = (f32x4){0.f, 0.f, 0.f, 0.f};
        cur = nxt; cA = nA; cB = nB; ++ui;
        if constexpr (Epi::SEG) E.seg_load(ui, wr, fr, segr);
        if constexpr (ALIGN_EPI) { if (wr == 1) PG8_BAR; }
    }
    PG8_WAIT_V(0);
    if constexpr (!ALIGN_EPI) { if (wr == 0) PG8_BAR; }
    PG8_BAR;
    if constexpr (Epi::AFTER_DRAIN) { E.fused(acc, cur, wr, wc, fr, fq, lds, wid, lane); S.done(cur); }
#undef PG8_SA
#undef PG8_SB
#undef PG8_STAGE
#undef PG8_LDA
#undef PG8_LDB
#undef PG8_MMA
#undef PG8_WAIT_V
#undef PG8_WAIT_L
#undef PG8_BAR
#undef PG8_SCHED
}
}
#ifndef PG8_SP2
#define PG8_SP2 true
#endif
#ifndef PG8_ALIGN
#define PG8_ALIGN true
#endif

constexpr int BATCH = 8, SEQ = 2048, DM = 2048, MTOK = BATCH * SEQ;
constexpr int ATT_W = 1024, ATT_H = 8, ATT_HD = 128, MOBA_BLK = 256, NBLK = SEQ / MOBA_BLK;
constexpr int SSM_W = 1024, SSM_H = 16, SSM_P = 64, SSM_N = 128, SSM_L = 128, SSM_NC = SEQ / SSM_L, CONV_CH = 1536;
constexpr int IN_PROJ = 5648, NPROJ = 5632  , NPAD = 5888  ;
constexpr int F8_LO = 2048, F8_HI = 3072, NB16 = NPAD - (F8_HI - F8_LO)  ;
constexpr float SH8 = 16.f;
constexpr int COL_Q = 0, COL_K = 1024, COL_V = 2048, COL_Z = 3072, COL_XBC = 4096;
constexpr int PEER_H = 8, PEER_NK = 128, PEER_K = 16, PEER_HK = 128;
constexpr float EPS = 1e-6f;
constexpr float SU = 64.f, SV = 4.f, SH = 16.f, SLO = 16.f;
constexpr float SX8 = 16.f, SW8 = 1024.f;
constexpr float SA8 = 32.f, SS8 = 8.f;
constexpr float SH4 = 1.5f, SLO4 = 4.f;
constexpr int ROWB = DM / 2;

constexpr size_t MiB = 1u << 20;
constexpr size_t WS_CTL = 0, CTL_ZERO_BYTES = 1 * MiB;
constexpr size_t WS_DT = 1 * MiB;
constexpr size_t WS_SK = 2 * MiB;
constexpr size_t WS_WIN = 4 * MiB;
constexpr size_t WS_WIN8 = 24 * MiB;
constexpr size_t WS_HN8 = 396 * MiB;
constexpr size_t WS_WOUT = 28 * MiB;
constexpr size_t WS_WQ = 36 * MiB;
constexpr size_t WS_HN = 44 * MiB;
constexpr size_t WS_PROJ = 108 * MiB;
constexpr size_t WS_X1B = WS_PROJ, WS_QP = WS_PROJ + 64 * MiB;
constexpr size_t WS_U8 = 284 * MiB, WS_V8 = 316 * MiB;
constexpr size_t WS_XBC = 348 * MiB;
constexpr size_t WS_DT2 = 3 * MiB;
constexpr size_t WS_X18 = 396 * MiB;
constexpr size_t WS_END = 428 * MiB;
constexpr int CW_BAR = 4096;
constexpr int CW_Q2 = 8192;
constexpr int CW_KMEAN = 32768;
constexpr int CW_SSQ = 131072;
static_assert((CW_SSQ + MTOK * 4) * 4 <= (int)CTL_ZERO_BYTES, "CTL words inside the memset region");

constexpr int RING_OFF = 0, RING_BYTES = 131072;
constexpr int LDSCTL_OFF = RING_BYTES, MISC_OFF = LDSCTL_OFF + 320;
constexpr int SEGTAB_OFF = LDSCTL_OFF + 1024;  static_assert(LDSCTL_OFF + 1024 + 3 * 256 * 16 <= 147456, "segment table inside the LDS allocation");
constexpr int LDS_BYTES = 147456;
constexpr int NWAVES = 8;

#define GAS __attribute__((address_space(1)))
#define LAS __attribute__((address_space(3)))
typedef unsigned short bf16;
typedef unsigned v4u __attribute__((ext_vector_type(4)));
typedef unsigned v2u __attribute__((ext_vector_type(2)));
typedef float f32x4 __attribute__((ext_vector_type(4)));
typedef float f32x2 __attribute__((ext_vector_type(2)));
typedef short bf16x8 __attribute__((ext_vector_type(8)));
typedef short s16x4 __attribute__((ext_vector_type(4)));
typedef GAS unsigned gu32;
#define RLX_AGENT __ATOMIC_RELAXED, __HIP_MEMORY_SCOPE_AGENT
#define LDS_WAIT() asm volatile("s_waitcnt lgkmcnt(0)" ::: "memory")
#define VM_WAIT() asm volatile("s_waitcnt vmcnt(0)" ::: "memory")
__device__ __forceinline__ unsigned f2bf(float f) { unsigned u = __builtin_bit_cast(unsigned, f); return (u + 0x7fffu + ((u >> 16) & 1u)) >> 16; }
typedef __bf16 bf16v2 __attribute__((ext_vector_type(2)));
__device__ __forceinline__ unsigned pk2(float lo, float hi) { bf16v2 v; v.x = (__bf16)lo; v.y = (__bf16)hi; return __builtin_bit_cast(unsigned, v); }
__device__ __forceinline__ float bflo(unsigned w) { return __builtin_bit_cast(float, w << 16); }
__device__ __forceinline__ float bfhi(unsigned w) { return __builtin_bit_cast(float, w & 0xffff0000u); }
__device__ __forceinline__ float wave_sum(float v) {
#pragma unroll
    for (int o = 1; o < 64; o <<= 1) v += __shfl_xor(v, o);
    return v;
}
__device__ __forceinline__ float silu_f(float x) { return x * __builtin_amdgcn_rcpf(1.f + __expf(-x)); }

#define XB_TMO      128
#define XB_XCNT(j)  (256  + 64 * (j))
#define XB_XSUB(j)  (1280 + 64 * (j))
#define XB_XGEN(j)  (2304 + 64 * (j))
#define XB_TOP      3328
#define XB_TOPGEN   3392
#define XCD_BAR_WORDS 3456
#define XB_SPIN_CAP (1u << 18)

__device__ __forceinline__ unsigned xb_ld(unsigned* p)              { return __hip_atomic_load(p, __ATOMIC_RELAXED, __HIP_MEMORY_SCOPE_AGENT); }
__device__ __forceinline__ unsigned xb_add(unsigned* p, unsigned v) { return __hip_atomic_fetch_add(p, v, __ATOMIC_RELAXED, __HIP_MEMORY_SCOPE_AGENT); }
__device__ __forceinline__ unsigned xb_xcc_id() { return (unsigned)__builtin_amdgcn_s_getreg((3 << 11) | 20) & 0xFu; }
#define XB_SPIN(cond, bar) do { unsigned _sp = 0; while (cond) { __builtin_amdgcn_s_sleep(1); \
    if ((++_sp & 255u) == 0u) { if (xb_ld(&(bar)[XB_TMO])) break; if (_sp > XB_SPIN_CAP) { atomicAdd(&(bar)[XB_TMO], 1u); break; } } } } while (0)

struct XcdBarrier {
    unsigned* bar; unsigned x;
    volatile LAS unsigned* st;
};
__device__ __forceinline__ XcdBarrier xcd_barrier_post(unsigned* bar, volatile LAS unsigned* st) {
    XcdBarrier b; b.bar = bar; b.x = xb_xcc_id(); b.st = st;
    if (threadIdx.x == 0) (void)xb_add(&bar[XB_XCNT(b.x)], 1u);
    return b;
}
__device__ __forceinline__ void xcd_barrier_complete(unsigned* bar, unsigned x, unsigned& nloc, unsigned& nx) {
    const unsigned G = gridDim.x * gridDim.y * gridDim.z;
    unsigned sum, cnt, mine, sp = 0u;
    for (;;) {
        sum = 0u; cnt = 0u; mine = 0u;
#pragma unroll
        for (unsigned j = 0; j < 16; ++j) { const unsigned c = xb_ld(&bar[XB_XCNT(j)]); sum += c; cnt += (c > 0u) ? 1u : 0u; mine = (j == x) ? c : mine; }
        if (sum == G) break;
        __builtin_amdgcn_s_sleep(1);
        if ((++sp & 255u) == 0u) { if (xb_ld(&bar[XB_TMO])) break; if (sp > XB_SPIN_CAP) { atomicAdd(&bar[XB_TMO], 1u); break; } }
    }
    nloc = mine > 0u ? mine : 1u; nx = cnt > 0u ? cnt : 1u;
}
__device__ __forceinline__ void xcd_barrier(const XcdBarrier& b) {
    asm volatile("s_waitcnt vmcnt(0)" ::: "memory");
    __syncthreads();
    if (threadIdx.x == 0) {
        unsigned* bar = b.bar;
        __builtin_amdgcn_s_waitcnt(0);
        unsigned nloc = b.st[0], nx = b.st[1];
        if (nloc == 0u) { xcd_barrier_complete(bar, b.x, nloc, nx); b.st[0] = nloc; b.st[1] = nx; }
        const unsigned old = xb_add(&bar[XB_XSUB(b.x)], 1u);
        const unsigned gen = old / nloc;
        if (old + 1u == (gen + 1u) * nloc) {
            __builtin_amdgcn_fence(__ATOMIC_RELEASE, "agent");
            asm volatile("s_waitcnt vmcnt(0)" ::: "memory");
            const unsigned og = xb_add(&bar[XB_TOP], 1u);
            const unsigned tg = og / nx;
            if (og + 1u == (tg + 1u) * nx) xb_add(&bar[XB_TOPGEN], 1u);
            else XB_SPIN(xb_ld(&bar[XB_TOPGEN]) == tg, bar);
            __builtin_amdgcn_fence(__ATOMIC_ACQUIRE, "agent");
            xb_add(&bar[XB_XGEN(b.x)], 1u);
            asm volatile("s_waitcnt vmcnt(0)" ::: "memory");
        } else {
            XB_SPIN(xb_ld(&bar[XB_XGEN(b.x)]) == gen, bar);
            __builtin_amdgcn_fence(__ATOMIC_ACQUIRE, "agent");
            asm volatile("s_waitcnt vmcnt(0)" ::: "memory");
        }
    }
    __syncthreads();
}

#define CAS __attribute__((address_space(4)))
struct Args { const float* in[18]; float* out; unsigned char* ws; };
__device__ __forceinline__ const CAS unsigned char* kargs() { const CAS unsigned char* p = (const CAS unsigned char*)__builtin_amdgcn_kernarg_segment_ptr(); asm volatile("" : "+s"(p)); return p; }
__device__ __forceinline__ const float* kin(int i) { return *(const float* const CAS*)(kargs() + 8 * i); }
__device__ __forceinline__ float* kout() { return *(float* const CAS*)(kargs() + 8 * 18); }
__device__ __forceinline__ unsigned char* kws() { return *(unsigned char* const CAS*)(kargs() + 8 * 19); }
__device__ __forceinline__ int fresh_tid() { int t = threadIdx.x; asm volatile("" : "+v"(t)); return t; }
struct Frame {
    LAS unsigned char* lds;
    volatile LAS unsigned* MISC;
    int tid, lane, wave, G;
    __device__ __forceinline__ const float* x() const { return kin(0); }
    __device__ __forceinline__ const float* attn_norm() const { return kin(1); }
    __device__ __forceinline__ const float* w_in() const { return kin(2); }
    __device__ __forceinline__ const float* conv_w() const { return kin(3); }
    __device__ __forceinline__ const float* conv_b() const { return kin(4); }
    __device__ __forceinline__ const float* dt_bias() const { return kin(5); }
    __device__ __forceinline__ const float* a_log() const { return kin(6); }
    __device__ __forceinline__ const float* d_skip() const { return kin(7); }
    __device__ __forceinline__ const float* rel_bias() const { return kin(8); }
    __device__ __forceinline__ const float* attn_out_norm() const { return kin(9); }
    __device__ __forceinline__ const float* ssm_out_norm() const { return kin(10); }
    __device__ __forceinline__ const float* w_out() const { return kin(11); }
    __device__ __forceinline__ const float* ffn_norm() const { return kin(12); }
    __device__ __forceinline__ const float* peer_wq() const { return kin(13); }
    __device__ __forceinline__ const float* peer_sk() const { return kin(14); }
    __device__ __forceinline__ const float* peer_u() const { return kin(15); }
    __device__ __forceinline__ const float* peer_v() const { return kin(16); }
    __device__ __forceinline__ const float* final_norm() const { return kin(17); }
    __device__ __forceinline__ float* out() const { return kout(); }
    __device__ __forceinline__ unsigned* ctl() const { return (unsigned*)(kws() + WS_CTL); }
    __device__ __forceinline__ float* dtraw() const { return (float*)(kws() + WS_DT); }
    __device__ __forceinline__ bf16* SK() const { return (bf16*)(kws() + WS_SK); }
    __device__ __forceinline__ bf16* WinT() const { return (bf16*)(kws() + WS_WIN); }
    __device__ __forceinline__ bf16* WoutT() const { return (bf16*)(kws() + WS_WOUT); }
    __device__ __forceinline__ bf16* WqT() const { return (bf16*)(kws() + WS_WQ); }
    __device__ __forceinline__ bf16* HN() const { return (bf16*)(kws() + WS_HN); }
    __device__ __forceinline__ bf16* PROJ() const { return (bf16*)(kws() + WS_PROJ); }
    __device__ __forceinline__ bf16* X1B() const { return (bf16*)(kws() + WS_X1B); }
    __device__ __forceinline__ bf16* QP() const { return (bf16*)(kws() + WS_QP); }
    __device__ __forceinline__ unsigned char* U8() const { return kws() + WS_U8; }
    __device__ __forceinline__ unsigned char* V8() const { return kws() + WS_V8; }
    __device__ __forceinline__ unsigned char* X18() const { return kws() + WS_X18; }
    __device__ __forceinline__ unsigned char* HN8() const { return kws() + WS_HN8; }
    __device__ __forceinline__ unsigned char* WinT8() const { return kws() + WS_WIN8; }
    __device__ __forceinline__ bf16* XBC() const { return (bf16*)(kws() + WS_XBC); }
    __device__ __forceinline__ float* DT2() const { return (float*)(kws() + WS_DT2); }
    __device__ __forceinline__ float* kmean() const { return (float*)(kws() + WS_CTL) + CW_KMEAN; }
    __device__ __forceinline__ float* ssq() const { return (float*)(kws() + WS_CTL) + CW_SSQ; }
};

__device__ __forceinline__ float clampf(float v, float lim);
__device__ __forceinline__ void p0_transpose_item(const float* W, int K, int N, bf16* WT, const float* gain, LAS float* scr, int item, int lane, const float f8scale = 0.f, const int nshift = 0) {
    const int nblk = (N + 31) / 32, kb = item / nblk, nb = item % nblk, k0 = 64 * kb, n0 = 32 * nb;
    const int kr = lane >> 3, nc = (lane & 7) * 4; const bool ok = (n0 + nc) < N;
    f32x4 v[8]; float gk[8];
#pragma unroll
    for (int i = 0; i < 8; ++i) { const int kk = 8 * i + kr; v[i] = ok ? *(const GAS f32x4*)(W + (size_t)(k0 + kk) * N + n0 + nc) : (f32x4){0.f, 0.f, 0.f, 0.f}; gk[i] = gain ? gain[k0 + kk] : 1.f; }
#pragma unroll
    for (int i = 0; i < 8; ++i) { const int kk = 8 * i + kr; LAS float* d = scr + kk * 33 + nc; d[0] = v[i].x * gk[i]; d[1] = v[i].y * gk[i]; d[2] = v[i].z * gk[i]; d[3] = v[i].w * gk[i]; }
    LDS_WAIT(); asm volatile("" ::: "memory");
    const int c = lane & 7;
#pragma unroll
    for (int j = 0; j < 4; ++j) { const int n = (lane >> 3) + 8 * j; const LAS float* s = scr + (8 * c) * 33 + n;
        v4u o; o.x = pk2(s[0 * 33], s[1 * 33]); o.y = pk2(s[2 * 33], s[3 * 33]); o.z = pk2(s[4 * 33], s[5 * 33]); o.w = pk2(s[6 * 33], s[7 * 33]);
        if (f8scale == 0.f) *(GAS v4u*)(WT + (size_t)(n0 + n - nshift) * K + k0 + 8 * c) = o;
        else { v2u o8; int w_;
            w_ = __builtin_amdgcn_cvt_pk_fp8_f32(clampf(s[0 * 33] * f8scale, 448.f), clampf(s[1 * 33] * f8scale, 448.f), 0, false); w_ = __builtin_amdgcn_cvt_pk_fp8_f32(clampf(s[2 * 33] * f8scale, 448.f), clampf(s[3 * 33] * f8scale, 448.f), w_, true); o8.x = (unsigned)w_;
            w_ = __builtin_amdgcn_cvt_pk_fp8_f32(clampf(s[4 * 33] * f8scale, 448.f), clampf(s[5 * 33] * f8scale, 448.f), 0, false); w_ = __builtin_amdgcn_cvt_pk_fp8_f32(clampf(s[6 * 33] * f8scale, 448.f), clampf(s[7 * 33] * f8scale, 448.f), w_, true); o8.y = (unsigned)w_;
            *(GAS v2u*)((unsigned char*)WT + (size_t)(n0 + n - nshift) * K + k0 + 8 * c) = o8; } }
    LDS_WAIT(); asm volatile("" ::: "memory");
}
__device__ __forceinline__ unsigned pk4_fp8(float a, float b, float c, float d) { int w = __builtin_amdgcn_cvt_pk_fp8_f32(clampf(a, 448.f), clampf(b, 448.f), 0, false); w = __builtin_amdgcn_cvt_pk_fp8_f32(clampf(c, 448.f), clampf(d, 448.f), w, true); return (unsigned)w; }
__device__ __forceinline__ void rms_2rows_to_bf16(const float* x0, const float* x1, const float* gain, bf16* o0, bf16* o1, unsigned char* q0, unsigned char* q1, int lane) {
    const GAS f32x4* xr0 = (const GAS f32x4*)x0 + lane; const GAS f32x4* xr1 = (const GAS f32x4*)x1 + lane; const GAS f32x4* gr = (const GAS f32x4*)gain + lane;
    f32x4 v[8], u[8]; float s = 0.f, t = 0.f;
#pragma unroll
    for (int j = 0; j < 8; ++j) { v[j] = xr0[64 * j]; u[j] = xr1[64 * j]; }
#pragma unroll
    for (int j = 0; j < 8; ++j) { s += (v[j].x * v[j].x + v[j].y * v[j].y) + (v[j].z * v[j].z + v[j].w * v[j].w); t += (u[j].x * u[j].x + u[j].y * u[j].y) + (u[j].z * u[j].z + u[j].w * u[j].w); }
    const float rs = __builtin_amdgcn_rsqf(wave_sum(s) * (1.f / DM) + EPS), rt = __builtin_amdgcn_rsqf(wave_sum(t) * (1.f / DM) + EPS);
    GAS v2u* p0 = (GAS v2u*)o0 + lane; GAS v2u* p1 = (GAS v2u*)o1 + lane; GAS unsigned* r0 = (GAS unsigned*)q0 + lane; GAS unsigned* r1 = (GAS unsigned*)q1 + lane;
#pragma unroll
    for (int j = 0; j < 8; ++j) { const f32x4 g = gr[64 * j]; v2u a, b;
        const f32x4 h0 = v[j] * g * rs, h1 = u[j] * g * rt;
        a.x = pk2(h0.x, h0.y); a.y = pk2(h0.z, h0.w); p0[64 * j] = a; r0[64 * j] = pk4_fp8(h0.x * SH8, h0.y * SH8, h0.z * SH8, h0.w * SH8);
        b.x = pk2(h1.x, h1.y); b.y = pk2(h1.z, h1.w); p1[64 * j] = b; r1[64 * j] = pk4_fp8(h1.x * SH8, h1.y * SH8, h1.z * SH8, h1.w * SH8); }
}
#ifdef PROBE_FP4EMU
__device__ __forceinline__ float fp4grid(float y) { const float a = fabsf(y); float r;
    if (a <= 2.f) r = rintf(a * 2.f) * 0.5f; else if (a <= 4.f) r = rintf(a); else r = (a < 5.f) ? 4.f : 6.f;
    return copysignf(r, y); }
__device__ __forceinline__ float clampf(float v, float lim) { if (lim == 448.5f) return fp4grid(v * (1.f / 16.f)) * 16.f; return fminf(fmaxf(v, -lim), lim); }
#else
__device__ __forceinline__ float clampf(float v, float lim) { return fminf(fmaxf(v, -lim), lim); }
#endif
template <int TAB = 0> __device__ __forceinline__ v4u cvt16_fp8(const f32x4 a, const f32x4 b, const f32x4 c, const f32x4 d, float sc) {
    v4u o; int w; constexpr float LIM = TAB ? 448.5f : 448.f;
    w = __builtin_amdgcn_cvt_pk_fp8_f32(clampf(a.x * sc, LIM), clampf(a.y * sc, LIM), 0, false); w = __builtin_amdgcn_cvt_pk_fp8_f32(clampf(a.z * sc, LIM), clampf(a.w * sc, LIM), w, true); o.x = (unsigned)w;
    w = __builtin_amdgcn_cvt_pk_fp8_f32(clampf(b.x * sc, LIM), clampf(b.y * sc, LIM), 0, false); w = __builtin_amdgcn_cvt_pk_fp8_f32(clampf(b.z * sc, LIM), clampf(b.w * sc, LIM), w, true); o.y = (unsigned)w;
    w = __builtin_amdgcn_cvt_pk_fp8_f32(clampf(c.x * sc, LIM), clampf(c.y * sc, LIM), 0, false); w = __builtin_amdgcn_cvt_pk_fp8_f32(clampf(c.z * sc, LIM), clampf(c.w * sc, LIM), w, true); o.z = (unsigned)w;
    w = __builtin_amdgcn_cvt_pk_fp8_f32(clampf(d.x * sc, LIM), clampf(d.y * sc, LIM), 0, false); w = __builtin_amdgcn_cvt_pk_fp8_f32(clampf(d.z * sc, LIM), clampf(d.w * sc, LIM), w, true); o.w = (unsigned)w;
    return o;
}
__device__ __forceinline__ void tables_convert(Frame& F, size_t lo, size_t hi, size_t tix, size_t ntx) {
      const GAS f32x4* su = (const GAS f32x4*)F.peer_u(); const GAS f32x4* sv = (const GAS f32x4*)F.peer_v(); GAS v4u* du = (GAS v4u*)F.U8(); GAS v4u* dv = (GAS v4u*)F.V8();
#pragma unroll 1
      for (int tab = 0; tab < 2; ++tab) { const GAS f32x4* src = tab ? sv : su; GAS v4u* dst = tab ? dv : du; const float sc = tab ? SV : SU;
        f32x4 nx[8]; const size_t i0 = lo + tix;
        if (i0 < hi) { const GAS f32x4* p = src + (i0 >> 6) * 512 + (i0 & 63);
#pragma unroll
            for (int j = 0; j < 8; ++j) nx[j] = p[64 * j]; }
#pragma unroll 1
        for (size_t i = i0; i < hi; i += ntx) { f32x4 v[8];
#pragma unroll
            for (int j = 0; j < 8; ++j) v[j] = nx[j];
            if (i + ntx < hi) { const size_t i2 = i + ntx; const GAS f32x4* p = src + (i2 >> 6) * 512 + (i2 & 63);
#pragma unroll
                for (int j = 0; j < 8; ++j) nx[j] = p[64 * j]; }
            unsigned wd[4];
#pragma unroll
            for (int q = 0; q < 4; ++q) { const f32x4 a = v[2 * q] * sc, b = v[2 * q + 1] * sc; unsigned w = 0u;
                w = __builtin_amdgcn_cvt_scalef32_pk_fp4_f32(w, clampf(a.x, 6.f), clampf(a.y, 6.f), 1.0f, 0); w = __builtin_amdgcn_cvt_scalef32_pk_fp4_f32(w, clampf(a.z, 6.f), clampf(a.w, 6.f), 1.0f, 1);
                w = __builtin_amdgcn_cvt_scalef32_pk_fp4_f32(w, clampf(b.x, 6.f), clampf(b.y, 6.f), 1.0f, 2); w = __builtin_amdgcn_cvt_scalef32_pk_fp4_f32(w, clampf(b.z, 6.f), clampf(b.w, 6.f), 1.0f, 3); wd[q] = w; }
            dst[i] = (v4u){wd[0], wd[1], wd[2], wd[3]}; } }
}
constexpr size_t TAB_ITEMS = (size_t)16384 * 64;
__device__ __forceinline__ size_t tab_split(int G) { const int rem = ((MTOK / 256) * (NB16 / 256)) % G; return rem ? (TAB_ITEMS / 8) * 5 : TAB_ITEMS; }
__device__ __forceinline__ unsigned fp4_code(float y) { const float a = fabsf(y);
    const unsigned m = (unsigned)(a >= 0.25f) + (unsigned)(a >= 0.75f) + (unsigned)(a >= 1.25f) + (unsigned)(a >= 1.75f) + (unsigned)(a >= 2.5f) + (unsigned)(a >= 3.5f) + (unsigned)(a >= 5.0f);
    return m | ((y < 0.f) ? 8u : 0u); }
__device__ __forceinline__ void p0_prologue(Frame& F) {
    const int tid = fresh_tid(), lane = tid & 63, wave = __builtin_amdgcn_readfirstlane(tid >> 6);
    LAS float* scr = (LAS float*)(F.lds + RING_OFF + wave * 16384);
    const int gw = blockIdx.x * NWAVES + wave, NGW = F.G * NWAVES;
    constexpr int I_IN = (DM / 64) * ((IN_PROJ + 31) / 32), I_SQ = (DM / 64) * (DM / 32);
    constexpr int NITEMS = I_IN + 2 * I_SQ;
    { const float* const w_in = F.w_in(); const float* const w_out = F.w_out(); const float* const wq = F.peer_wq(); const float* const fg = F.ffn_norm(); bf16* const WinT = F.WinT(); unsigned char* const WinT8 = F.WinT8(); bf16* const WoutT = F.WoutT(); bf16* const WqT = F.WqT(); const float* const gatt = F.attn_out_norm(); const float* const gssm = F.ssm_out_norm();
      for (int it = gw; it < NITEMS; it += NGW) {
        int r = it;
        if (r < I_IN) { const int n0_ = 32 * (r % ((IN_PROJ + 31) / 32));
            if (n0_ >= F8_LO && n0_ < F8_HI) p0_transpose_item(w_in, DM, IN_PROJ, (bf16*)WinT8, nullptr, scr, r, lane, SW8, F8_LO);
            else p0_transpose_item(w_in, DM, IN_PROJ, WinT, nullptr, scr, r, lane, 0.f, (n0_ >= F8_HI) ? (F8_HI - F8_LO) : 0);
            continue; } r -= I_IN;
        if (r < I_SQ) { const int k0_ = 64 * (r / (DM / 32)); p0_transpose_item(w_out, DM, DM, WoutT, (k0_ < ATT_W) ? gatt : (gssm - ATT_W), scr, r, lane, SW8); continue; } r -= I_SQ;
        p0_transpose_item(wq, DM, DM, WqT, fg, scr, r, lane, SW8);
      } }
    const size_t gt = (size_t)blockIdx.x * (NWAVES * 64) + tid, GT = (size_t)F.G * NWAVES * 64;
    { const size_t z0 = (size_t)(5664 - (F8_HI - F8_LO)) * DM / 8, z1 = (size_t)NB16 * DM / 8; GAS v4u* p = (GAS v4u*)F.WinT(); for (size_t i = z0 + gt; i < z1; i += GT) p[i] = (v4u){0u, 0u, 0u, 0u}; }
    { const GAS f32x4* s = (const GAS f32x4*)F.peer_sk(); GAS v2u* d = (GAS v2u*)F.SK(); for (size_t i = gt; i < (size_t)16 * 128 * 128 / 4; i += GT) { const f32x4 v = s[i]; v2u o; o.x = pk2(v.x, v.y); o.y = pk2(v.z, v.w); d[i] = o; } }
    { const float* const xg = F.x(); const float* const gn = F.attn_norm(); bf16* const hn = F.HN(); unsigned char* const hn8 = F.HN8();
      for (int m = gw; m < MTOK / 2; m += NGW) rms_2rows_to_bf16(xg + (size_t)(2 * m) * DM, xg + (size_t)(2 * m + 1) * DM, gn, hn + (size_t)(2 * m) * DM, hn + (size_t)(2 * m + 1) * DM, hn8 + (size_t)(2 * m) * DM, hn8 + (size_t)(2 * m + 1) * DM, lane); }
    tables_convert(F, 0, tab_split(F.G), gt, GT);
}

struct EpiProj {
    static constexpr bool PERM = true, AFTER_DRAIN = false, SEG = false;
    bf16* O; float* dtraw; float* kmean;
    __device__ __forceinline__ void operator()(const pg8::f32x4 (&acc)[2][2][4][2], const pg8::Unit& u, int wr, int wc, int fr, int fq) const {
        const int rpn = (u.pn < F8_LO / 256) ? u.pn : u.pn + (F8_HI - F8_LO) / 256;
        const int row0 = u.pm * 256 + wr * 64 + fr, col0 = rpn * 256 + wc * 32 + 8 * fq;
        if (rpn < 22) {
#pragma unroll
            for (int ai = 0; ai < 2; ++ai)
#pragma unroll
                for (int m = 0; m < 4; ++m) { bf16* rowp = O + (size_t)(row0 + ai * 128 + m * 16) * NPROJ + col0;
#pragma unroll
                    for (int bj = 0; bj < 2; ++bj) { const pg8::f32x4 v0 = acc[ai][bj][m][0], v1 = acc[ai][bj][m][1];
                        pg8::u32x4 w; w.x = pg8::cvt_pk_bf16(v0[0], v0[1]); w.y = pg8::cvt_pk_bf16(v0[2], v0[3]); w.z = pg8::cvt_pk_bf16(v1[0], v1[1]); w.w = pg8::cvt_pk_bf16(v1[2], v1[3]);
                        *(pg8::u32x4*)(rowp + bj * 128) = w; } }
        } else if (wc == 0 && fq < 2) {
#pragma unroll
            for (int ai = 0; ai < 2; ++ai)
#pragma unroll
                for (int m = 0; m < 4; ++m) { float* rp = dtraw + (size_t)(row0 + ai * 128 + m * 16) * 16 + 8 * fq;
                    *(pg8::f32x4*)rp = acc[ai][0][m][0]; *(pg8::f32x4*)(rp + 4) = acc[ai][0][m][1]; }
        }
        if (kmean && u.pn >= 4 && u.pn < 8) {
#pragma unroll
            for (int bj = 0; bj < 2; ++bj)
#pragma unroll
                for (int n = 0; n < 2; ++n)
#pragma unroll
                    for (int i = 0; i < 4; ++i) { float s = 0.f;
#pragma unroll
                        for (int ai = 0; ai < 2; ++ai)
#pragma unroll
                            for (int m = 0; m < 4; ++m) s += acc[ai][bj][m][n][i];
                        s += __shfl_xor(s, 1); s += __shfl_xor(s, 2); s += __shfl_xor(s, 4); s += __shfl_xor(s, 8);
                        if (fr == 0) unsafeAtomicAdd(kmean + (size_t)u.pm * 1024 + (col0 - 1024) + bj * 128 + 4 * n + i, s); }
        }
    }
};
struct EpiProj8 {
    static constexpr bool PERM = true, AFTER_DRAIN = false, SEG = false;
    bf16* O;
    __device__ __forceinline__ void operator()(const pg8::f32x4 (&acc)[2][2][4][2], const pg8::Unit& u, int wr, int wc, int fr, int fq) const {
        const int row0 = u.pm * 256 + wr * 64 + fr, col0 = F8_LO + u.pn * 256 + wc * 32 + 8 * fq; constexpr float sc = 1.f / (SH8 * SW8);
#pragma unroll
        for (int ai = 0; ai < 2; ++ai)
#pragma unroll
            for (int m = 0; m < 4; ++m) { bf16* rowp = O + (size_t)(row0 + ai * 128 + m * 16) * NPROJ + col0;
#pragma unroll
                for (int bj = 0; bj < 2; ++bj) { const pg8::f32x4 v0 = acc[ai][bj][m][0] * sc, v1 = acc[ai][bj][m][1] * sc;
                    pg8::u32x4 w; w.x = pg8::cvt_pk_bf16(v0[0], v0[1]); w.y = pg8::cvt_pk_bf16(v0[2], v0[3]); w.z = pg8::cvt_pk_bf16(v1[0], v1[1]); w.w = pg8::cvt_pk_bf16(v1[2], v1[3]);
                    *(pg8::u32x4*)(rowp + bj * 128) = w; } }
    }
};
struct EpiOut {
    static constexpr bool PERM = true, AFTER_DRAIN = false, SEG = true; static constexpr int SEG_T1 = 8, SEG_T2 = 12;
    const float* x; bf16* x1b; unsigned char* x18; float* ssq; bool doatom; const LAS f32x4* tab;
    __device__ __forceinline__ void seg_load(int ui, int wr, int fr, float (&sr)[16]) const {
#pragma unroll
        for (int i = 0; i < 8; ++i) { const int r = (i >> 2) * 128 + wr * 64 + (i & 3) * 16 + fr; const f32x2 q = *(const LAS f32x2*)(tab + ui * 256 + r); sr[2 * i] = q.x; sr[2 * i + 1] = q.y; }
        asm volatile("s_waitcnt lgkmcnt(0)" ::: "memory");
    }
    __device__ __forceinline__ void seg_apply(pg8::f32x4 (&acc)[2][2][4][2], const float (&sr)[16], int which) const {
#pragma unroll
        for (int ai = 0; ai < 2; ++ai)
#pragma unroll
            for (int m = 0; m < 4; ++m) { const float f = (which == 0) ? sr[2 * (ai * 4 + m)] : ((which == 1) ? sr[2 * (ai * 4 + m) + 1] : 1.0f);
#pragma unroll
                for (int bj = 0; bj < 2; ++bj)
#pragma unroll
                    for (int n = 0; n < 2; ++n) acc[ai][bj][m][n] = acc[ai][bj][m][n] * f; }
    }
    __device__ __forceinline__ void operator()(const pg8::f32x4 (&acc)[2][2][4][2], const pg8::Unit& u, int wr, int wc, int fr, int fq, int ui) const {
        const int row0 = u.pm * 256 + wr * 64 + fr, col0 = u.pn * 256 + wc * 32 + 8 * fq;
#pragma unroll
        for (int ai = 0; ai < 2; ++ai)
#pragma unroll
            for (int m = 0; m < 4; ++m) { const int row = row0 + ai * 128 + m * 16; const size_t off = (size_t)row * DM + col0; float s = 0.f;
                const float s1 = (*(const LAS f32x4*)(tab + ui * 256 + ai * 128 + wr * 64 + m * 16 + fr)).z;
#pragma unroll
                for (int bj = 0; bj < 2; ++bj) {
                    const pg8::f32x4 a0 = *(const pg8::f32x4*)(x + off + bj * 128), a1 = *(const pg8::f32x4*)(x + off + bj * 128 + 4);
                    const pg8::f32x4 v0 = acc[ai][bj][m][0] * s1 + a0, v1 = acc[ai][bj][m][1] * s1 + a1;
                    pg8::u32x4 w; w.x = pg8::cvt_pk_bf16(v0[0], v0[1]); w.y = pg8::cvt_pk_bf16(v0[2], v0[3]); w.z = pg8::cvt_pk_bf16(v1[0], v1[1]); w.w = pg8::cvt_pk_bf16(v1[2], v1[3]);
                    *(pg8::u32x4*)(x1b + off + bj * 128) = w;
                    { v2u o8; int w_; w_ = __builtin_amdgcn_cvt_pk_fp8_f32(clampf(v0[0] * SX8, 448.f), clampf(v0[1] * SX8, 448.f), 0, false); w_ = __builtin_amdgcn_cvt_pk_fp8_f32(clampf(v0[2] * SX8, 448.f), clampf(v0[3] * SX8, 448.f), w_, true); o8.x = (unsigned)w_;
                      w_ = __builtin_amdgcn_cvt_pk_fp8_f32(clampf(v1[0] * SX8, 448.f), clampf(v1[1] * SX8, 448.f), 0, false); w_ = __builtin_amdgcn_cvt_pk_fp8_f32(clampf(v1[2] * SX8, 448.f), clampf(v1[3] * SX8, 448.f), w_, true); o8.y = (unsigned)w_;
                      *(v2u*)(x18 + off + bj * 128) = o8; }
                    s += (v0[0] * v0[0] + v0[1] * v0[1]) + (v0[2] * v0[2] + v0[3] * v0[3]) + (v1[0] * v1[0] + v1[1] * v1[1]) + (v1[2] * v1[2] + v1[3] * v1[3]); }
                s += __shfl_xor(s, 16); s += __shfl_xor(s, 32);
                if (fq == 0 && doatom) unsafeAtomicAdd(ssq + (size_t)row * 4, s);
                asm volatile("" ::: "memory"); }
    }
};
struct EpiQ {
    static constexpr bool PERM = true, AFTER_DRAIN = false, SEG = false;
    bf16* O; const float* ssq;
    __device__ __forceinline__ void operator()(const pg8::f32x4 (&acc)[2][2][4][2], const pg8::Unit& u, int wr, int wc, int fr, int fq) const {
        const int row0 = u.pm * 256 + wr * 64 + fr, col0 = u.pn * 256 + wc * 32 + 8 * fq;
#pragma unroll
        for (int ai = 0; ai < 2; ++ai)
#pragma unroll
            for (int m = 0; m < 4; ++m) { const int row = row0 + ai * 128 + m * 16; bf16* rowp = O + (size_t)row * DM + col0;
                const float rs = (1.f / (SX8 * SW8)) / sqrtf(__hip_atomic_load(ssq + (size_t)row * 4, RLX_AGENT) * (1.f / DM) + EPS);
#pragma unroll
                for (int bj = 0; bj < 2; ++bj) { const pg8::f32x4 v0 = acc[ai][bj][m][0] * rs, v1 = acc[ai][bj][m][1] * rs;
                    pg8::u32x4 w; w.x = pg8::cvt_pk_bf16(v0[0], v0[1]); w.y = pg8::cvt_pk_bf16(v0[2], v0[3]); w.z = pg8::cvt_pk_bf16(v1[0], v1[1]); w.w = pg8::cvt_pk_bf16(v1[2], v1[3]);
                    *(pg8::u32x4*)(rowp + bj * 128) = w; } }
    }
};

constexpr int A_KSTR = 272, A_VSTR = 288;
constexpr int A_KB0 = 0, A_KB1 = 64 * A_KSTR, A_VB0 = 2 * 64 * A_KSTR, A_VBS = 64 * A_VSTR  , A_KM = A_VB0 + 3 * A_VBS, A_TAB = A_KM + 8 * 128 * 4, A_END = A_TAB + 128 * 4;
static_assert(A_END <= RING_BYTES && (A_KM % 16) == 0, "attention LDS map");
#define PIN16(a, i) asm volatile("" : "+v"(a[i]), "+v"(a[i + 1]), "+v"(a[i + 2]), "+v"(a[i + 3]), "+v"(a[i + 4]), "+v"(a[i + 5]), "+v"(a[i + 6]), "+v"(a[i + 7]), "+v"(a[i + 8]), "+v"(a[i + 9]), "+v"(a[i + 10]), "+v"(a[i + 11]), "+v"(a[i + 12]), "+v"(a[i + 13]), "+v"(a[i + 14]), "+v"(a[i + 15]))
#define TR16(p) __builtin_amdgcn_ds_read_tr16_b64_v4i16((LAS s16x4*)(p))
#define MFMA16(a, b, c) __builtin_amdgcn_mfma_f32_16x16x32_bf16((a), (b), (c), 0, 0, 0)
__device__ __forceinline__ bf16x8 pack8(const float* v) {
    const unsigned a = pk2(v[0], v[1]), b = pk2(v[2], v[3]), c = pk2(v[4], v[5]), d = pk2(v[6], v[7]);
    const v4u u = {a, b, c, d}; return __builtin_bit_cast(bf16x8, u);
}
__device__ __forceinline__ void attn_unit(Frame& F, int b, int h, int blk, const bool doatom = true) {
    LAS unsigned char* lds = F.lds + RING_OFF;
    const int tid = fresh_tid(), lane = tid & 63, w = __builtin_amdgcn_readfirstlane(tid >> 6), g = lane >> 4, c16 = lane & 15, q4 = c16 >> 2, p4 = lane & 3;
    const int own = blk, t0 = blk * 256, tq0 = t0 + 32 * w + c16;
    const size_t rowbase = (size_t)b * SEQ;
    const float NEG_INF = -__builtin_inff();
    constexpr float LOG2E = 1.4426950408889634f, SCL2 = 0.08838834764831845f * 1.4426950408889634f;
    LAS float* km = (LAS float*)(lds + A_KM); LAS float* tab = (LAS float*)(lds + A_TAB);
    const bf16* const PROJ = F.PROJ(); const float* const kmg = F.kmean(); const float* const relb = F.rel_bias();
    for (int i = tid; i < own * 128; i += NWAVES * 64) { const int n = i >> 7, d = i & 127; km[i] = kmg[(size_t)(b * 8 + n) * 1024 + h * 128 + d] * (1.f / 256.f); }
    if (tid < 128) { const int rel = tid; int bucket = rel; if (rel >= 16) { bucket = 16 + (int)(log2f((float)rel * (1.f / 16.f)) * (16.f / 3.f)); bucket = bucket > 31 ? 31 : bucket; }
        tab[tid] = relb[bucket * 8 + h] * LOG2E; }
    bf16x8 qf[2][4];
#pragma unroll
    for (int gi = 0; gi < 2; ++gi) { const bf16* qrow = PROJ + (rowbase + tq0 + 16 * gi) * NPROJ + COL_Q + h * 128 + 8 * g;
#pragma unroll
      for (int ks = 0; ks < 4; ++ks) qf[gi][ks] = *(const GAS bf16x8*)(qrow + 32 * ks); }
    __syncthreads();
    unsigned selmask[2];
    if (own <= 3) { selmask[0] = (1u << own) - 1u; selmask[1] = selmask[0]; }
    else {
#pragma unroll
      for (int gi = 0; gi < 2; ++gi) {
        float gate[7];
#pragma unroll
        for (int n = 0; n < 7; ++n) {
            float s = NEG_INF;
            if (n < own) { s = 0.f;
#pragma unroll
                for (int ks = 0; ks < 4; ++ks) { const LAS f32x4* kp = (const LAS f32x4*)(km + n * 128 + 32 * ks + 8 * g); const f32x4 k0 = kp[0], k1 = kp[1]; const v4u qu = __builtin_bit_cast(v4u, qf[gi][ks]);
                    s += bflo(qu.x) * k0.x + bfhi(qu.x) * k0.y + bflo(qu.y) * k0.z + bfhi(qu.y) * k0.w + bflo(qu.z) * k1.x + bfhi(qu.z) * k1.y + bflo(qu.w) * k1.z + bfhi(qu.w) * k1.w; }
                s += __shfl_xor(s, 16); s += __shfl_xor(s, 32); }
            gate[n] = s;
        }
        unsigned sm = 0u;
#pragma unroll
        for (int r = 0; r < 3; ++r) { float best = NEG_INF; int bi = 0;
#pragma unroll
            for (int n = 0; n < 7; ++n) { const bool cand = (n < own) && !((sm >> n) & 1u) && (gate[n] > best); best = cand ? gate[n] : best; bi = cand ? n : bi; }
            sm |= 1u << bi; }
        selmask[gi] = sm; }
    }
    const int nT = 4 + 4 * own;
    const int sr = tid >> 3, sc = (tid & 7) * 16;
#define A_KEY0(i) ((i) < 4 ? own * 256 + 64 * (i) : (((i) - 4) >> 2) * 256 + (((i) - 4) & 3) * 64)
    v4u kr0, kr1, vr0, vr1;
#define A_LOAD(i) do { const bf16* kp_ = PROJ + (rowbase + A_KEY0(i) + sr) * NPROJ + COL_K + h * 128 + sc; \
        kr0 = *(const GAS v4u*)kp_; kr1 = *(const GAS v4u*)(kp_ + 8); vr0 = *(const GAS v4u*)(kp_ + (COL_V - COL_K)); vr1 = *(const GAS v4u*)(kp_ + (COL_V - COL_K) + 8); } while (0)
#define A_STORE(bufi) do { LAS unsigned char* kd_ = lds + ((bufi) ? A_KB1 : A_KB0) + sr * A_KSTR + sc * 2; LAS unsigned char* vd_ = lds + A_VB0 + vnx * A_VBS + sr * A_VSTR + sc * 2; \
        *(LAS v4u*)kd_ = kr0; *(LAS v4u*)(kd_ + 16) = kr1; *(LAS v4u*)vd_ = vr0; *(LAS v4u*)(vd_ + 16) = vr1; } while (0)
    int vcur = 0, vnx = 0, vprev = 0;
#define A_PV(PF, Vb_) do { _Pragma("unroll") for (int s = 0; s < 2; ++s) { s16x4 vlo[8], vhi[8]; \
            _Pragma("unroll") for (int db = 0; db < 8; ++db) { LAS unsigned char* va = (Vb_) + (32 * s + 4 * g + q4) * A_VSTR + (16 * db + 4 * p4) * 2; vlo[db] = TR16(va); vhi[db] = TR16(va + 16 * A_VSTR); } \
            __builtin_amdgcn_sched_barrier(0); \
            _Pragma("unroll") for (int db = 0; db < 8; ++db) { const bf16x8 vf = __builtin_shufflevector(vlo[db], vhi[db], 0, 1, 2, 3, 4, 5, 6, 7); \
                oacc[0][db] = MFMA16(vf, PF[0][s], oacc[0][db]); oacc[1][db] = MFMA16(vf, PF[1][s], oacc[1][db]); } \
            __builtin_amdgcn_sched_barrier(0); } } while (0)
    A_LOAD(0); A_STORE(0);
    __syncthreads();
    const bool late = w >= 4;
    bf16x8 pfp[2][2]; bool skipp = true;
#pragma unroll
    for (int gi = 0; gi < 2; ++gi) { pfp[gi][0] = (bf16x8){0, 0, 0, 0, 0, 0, 0, 0}; pfp[gi][1] = pfp[gi][0]; }
    float m_run[2] = {NEG_INF, NEG_INF}, l_run[2] = {0.f, 0.f};
    f32x4 oacc[2][8];
#pragma unroll
    for (int gi = 0; gi < 2; ++gi)
#pragma unroll
        for (int db = 0; db < 8; ++db) oacc[gi][db] = (f32x4){0.f, 0.f, 0.f, 0.f};
    for (int i = 0; i < nT; ++i) {
        if (i + 1 < nT) A_LOAD(i + 1);
        vnx = (vcur == 2) ? 0 : vcur + 1;
        const int buf = i & 1, key0 = A_KEY0(i); const bool isown = i < 4; const int pblk = isown ? own : ((i - 4) >> 2);
        const bool skipw = isown && (64 * i > 32 * w + 31);
        if (late && !skipp) A_PV(pfp, lds + A_VB0 + vprev * A_VBS);
        bf16x8 pf[2][2];
        if (!skipw) {
        LAS unsigned char* Kb = lds + (buf ? A_KB1 : A_KB0);
        f32x4 sacc[2][4];
#pragma unroll
        for (int hf = 0; hf < 2; ++hf) { bf16x8 kf[8];
#pragma unroll
            for (int n2 = 0; n2 < 2; ++n2)
#pragma unroll
                for (int ks = 0; ks < 4; ++ks) kf[n2 * 4 + ks] = *(const LAS bf16x8*)(Kb + (16 * (2 * hf + n2) + c16) * A_KSTR + (32 * ks + 8 * g) * 2);
            __builtin_amdgcn_sched_barrier(0);
#pragma unroll
            for (int gi = 0; gi < 2; ++gi)
#pragma unroll
                for (int n2 = 0; n2 < 2; ++n2) { f32x4 a = (f32x4){0.f, 0.f, 0.f, 0.f};
#pragma unroll
                    for (int ks = 0; ks < 4; ++ks) a = MFMA16(kf[n2 * 4 + ks], qf[gi][ks], a);
                    sacc[gi][2 * hf + n2] = a; }
            __builtin_amdgcn_sched_barrier(0); }
        const bool far = (key0 + 63 + 128 <= t0 + 32 * w);
        const bool diag = isown && (64 * i + 63 > 32 * w);
#pragma unroll
        for (int gi = 0; gi < 2; ++gi) {
            const int tq = tq0 + 16 * gi; const bool sel = isown || ((selmask[gi] >> pblk) & 1u);
            float sv[16]; float mloc, m_new, alpha;
            if (far) {
                const float bfar = tab[127];
                float mx = fmaxf(fmaxf(sacc[gi][0][0], sacc[gi][0][1]), fmaxf(sacc[gi][0][2], sacc[gi][0][3]));
#pragma unroll
                for (int nb = 1; nb < 4; ++nb) mx = fmaxf(mx, fmaxf(fmaxf(sacc[gi][nb][0], sacc[gi][nb][1]), fmaxf(sacc[gi][nb][2], sacc[gi][nb][3])));
                mloc = sel ? (mx * SCL2 + bfar) : NEG_INF;
                mloc = fmaxf(mloc, __shfl_xor(mloc, 16)); mloc = fmaxf(mloc, __shfl_xor(mloc, 32));
                m_new = fmaxf(m_run[gi], mloc); alpha = __builtin_amdgcn_exp2f(m_run[gi] - m_new);
                const float cadd = sel ? (bfar - m_new) : NEG_INF;
#pragma unroll
                for (int nb = 0; nb < 4; ++nb)
#pragma unroll
                    for (int r = 0; r < 4; ++r) sv[nb * 4 + r] = __builtin_amdgcn_exp2f(sacc[gi][nb][r] * SCL2 + cadd);
            } else {
                const int relb = tq - key0 - 4 * g; float bias[16];
#pragma unroll
                for (int nb = 0; nb < 4; ++nb)
#pragma unroll
                    for (int r = 0; r < 4; ++r) { const int rel = relb - 16 * nb - r; int ri = rel < 0 ? 0 : rel; ri = ri > 127 ? 127 : ri; bias[nb * 4 + r] = tab[ri]; }
                PIN16(bias, 0);
                mloc = NEG_INF;
#pragma unroll
                for (int nb = 0; nb < 4; ++nb)
#pragma unroll
                    for (int r = 0; r < 4; ++r) { const int rel = relb - 16 * nb - r;
                        float s = sacc[gi][nb][r] * SCL2 + bias[nb * 4 + r]; s = (!sel || (diag && rel < 0)) ? NEG_INF : s; sv[nb * 4 + r] = s; mloc = fmaxf(mloc, s); }
                mloc = fmaxf(mloc, __shfl_xor(mloc, 16)); mloc = fmaxf(mloc, __shfl_xor(mloc, 32));
                m_new = fmaxf(m_run[gi], mloc); alpha = __builtin_amdgcn_exp2f(m_run[gi] - m_new);
#pragma unroll
                for (int e = 0; e < 16; ++e) sv[e] = __builtin_amdgcn_exp2f(sv[e] - m_new);
            }
            float psum = 0.f;
#pragma unroll
            for (int e = 0; e < 16; ++e) psum += sv[e];
            l_run[gi] = l_run[gi] * alpha + psum; m_run[gi] = m_new;
#pragma unroll
            for (int db = 0; db < 8; ++db) oacc[gi][db] = oacc[gi][db] * alpha;
            pf[gi][0] = pack8(sv); pf[gi][1] = pack8(sv + 8);
        }
        __builtin_amdgcn_sched_barrier(0);
        if (!late) A_PV(pf, lds + A_VB0 + vcur * A_VBS);
        }
        if (late) { skipp = skipw;
#pragma unroll
            for (int gi = 0; gi < 2; ++gi) { pfp[gi][0] = pf[gi][0]; pfp[gi][1] = pf[gi][1]; } }
        if (i + 1 < nT) A_STORE((i + 1) & 1);
        vprev = vcur; vcur = vnx;
        __syncthreads();
    }
    if (late && !skipp) A_PV(pfp, lds + A_VB0 + vprev * A_VBS);
#undef A_PV
    bf16* const MIXp = F.HN(); float* const ssqp = F.ssq();
#pragma unroll
    for (int gi = 0; gi < 2; ++gi) {
        const int tq = tq0 + 16 * gi;
        float l_tot = l_run[gi]; l_tot += __shfl_xor(l_tot, 16); l_tot += __shfl_xor(l_tot, 32);
        const float inv = 1.f / l_tot; float ssq = 0.f;
        unsigned char* orow = (unsigned char*)MIXp + (rowbase + tq) * DM + h * 128 + 4 * g;
#pragma unroll
        for (int db = 0; db < 8; ++db) { const f32x4 o = oacc[gi][db] * inv; ssq += (o.x * o.x + o.y * o.y) + (o.z * o.z + o.w * o.w); *(GAS unsigned*)(orow + 16 * db) = pk4_fp8(o.x * SA8, o.y * SA8, o.z * SA8, o.w * SA8); }
        ssq += __shfl_xor(ssq, 16); ssq += __shfl_xor(ssq, 32);
        if (g == 0 && doatom) unsafeAtomicAdd(ssqp + (rowbase + tq) * 4 + 1, ssq);
    }
#undef A_KEY0
#undef A_LOAD
#undef A_STORE
}

constexpr int XBC_W = CONV_CH;
__device__ __forceinline__ void conv_phase(Frame& F) {
    const bf16* const PROJ = F.PROJ(); bf16* const XBC = F.XBC(); const float* const cw = F.conv_w(); const float* const cb = F.conv_b();
    const int gt = blockIdx.x * (NWAVES * 64) + fresh_tid(), GT = F.G * NWAVES * 64;
    for (int task = gt; task < (MTOK / 32) * (CONV_CH / 8); task += GT) {
        const int r = task / (CONV_CH / 8), k = task % (CONV_CH / 8), ch = 8 * k, tok0 = 32 * r;
        float wv[4][8], bias[8];
#pragma unroll
        for (int t = 0; t < 4; ++t) { const f32x4 w0 = *(const GAS f32x4*)(cw + t * CONV_CH + ch), w1 = *(const GAS f32x4*)(cw + t * CONV_CH + ch + 4);
            wv[t][0] = w0.x; wv[t][1] = w0.y; wv[t][2] = w0.z; wv[t][3] = w0.w; wv[t][4] = w1.x; wv[t][5] = w1.y; wv[t][6] = w1.z; wv[t][7] = w1.w; }
        { const f32x4 b0 = *(const GAS f32x4*)(cb + ch), b1 = *(const GAS f32x4*)(cb + ch + 4); bias[0] = b0.x; bias[1] = b0.y; bias[2] = b0.z; bias[3] = b0.w; bias[4] = b1.x; bias[5] = b1.y; bias[6] = b1.z; bias[7] = b1.w; }
        const bf16* src = PROJ + (size_t)tok0 * NPROJ + COL_XBC + ch; bf16* dst = XBC + (size_t)tok0 * XBC_W + ch;
        v4u p0 = (v4u){0u, 0u, 0u, 0u}, p1 = p0, p2 = p0;
        if ((tok0 & (SEQ - 1)) != 0) { p0 = *(const GAS v4u*)(src - 3 * (ptrdiff_t)NPROJ); p1 = *(const GAS v4u*)(src - 2 * (ptrdiff_t)NPROJ); p2 = *(const GAS v4u*)(src - (ptrdiff_t)NPROJ); }
#pragma unroll 1
        for (int i0 = 0; i0 < 32; i0 += 8) {
            v4u cur[8];
#pragma unroll
            for (int i = 0; i < 8; ++i) cur[i] = *(const GAS v4u*)(src + (size_t)(i0 + i) * NPROJ);
#pragma unroll
            for (int i = 0; i < 8; ++i) {
                const v4u c = cur[i]; float acc[8];
                const unsigned a0[4] = {p0.x, p0.y, p0.z, p0.w}, a1[4] = {p1.x, p1.y, p1.z, p1.w}, a2[4] = {p2.x, p2.y, p2.z, p2.w}, a3[4] = {c.x, c.y, c.z, c.w};
#pragma unroll
                for (int j = 0; j < 4; ++j) {
                    acc[2 * j] = bias[2 * j] + wv[0][2 * j] * bflo(a0[j]) + wv[1][2 * j] * bflo(a1[j]) + wv[2][2 * j] * bflo(a2[j]) + wv[3][2 * j] * bflo(a3[j]);
                    acc[2 * j + 1] = bias[2 * j + 1] + wv[0][2 * j + 1] * bfhi(a0[j]) + wv[1][2 * j + 1] * bfhi(a1[j]) + wv[2][2 * j + 1] * bfhi(a2[j]) + wv[3][2 * j + 1] * bfhi(a3[j]); }
#pragma unroll
                for (int j = 0; j < 8; ++j) acc[j] = silu_f(acc[j]);
                v4u o; o.x = pk2(acc[0], acc[1]); o.y = pk2(acc[2], acc[3]); o.z = pk2(acc[4], acc[5]); o.w = pk2(acc[6], acc[7]);
                *(GAS v4u*)(dst + (size_t)(i0 + i) * XBC_W) = o;
                p0 = p1; p1 = p2; p2 = c; }
        }
    }
    { const float* const dtraw = F.dtraw(); float* const dt2 = F.DT2(); const float* const dtb = F.dt_bias();
      for (int i = gt; i < MTOK * 16; i += GT) { const float xr = dtraw[i] + dtb[i & 15]; dt2[i] = xr > 20.f ? xr : log1pf(__expf(xr)); } }
}

constexpr int S_BSTR = 272, S_XSTR = 144;
constexpr int S_BM = 0, S_CM = 128 * S_BSTR, S_X = 2 * 128 * S_BSTR, S_XW = S_X + 128 * S_XSTR, S_HB = S_XW + 128 * S_XSTR, S_DT = S_HB + 64 * S_BSTR, S_CS = S_DT + 512, S_DA = S_CS + 512, S_END = S_DA + 512;
static_assert(S_END <= RING_BYTES, "ssd LDS map");
__device__ __forceinline__ void ssd_unit(Frame& F, int b, int h, const bool doatom = true) {
    LAS unsigned char* lds = F.lds + RING_OFF;
    const int tid = fresh_tid(), lane = tid & 63, w = __builtin_amdgcn_readfirstlane(tid >> 6), g = lane >> 4, c16 = lane & 15, q4 = c16 >> 2, p4 = lane & 3;
    const int g8 = h >> 3, pbw = w & 3, nhw = w >> 2;
    const float a_h = -__expf(F.a_log()[h]), dsk = F.d_skip()[h];
    const bf16* const PROJ = F.PROJ(); bf16* const MIX = F.HN(); const float* const dt2 = F.DT2(); const bf16* const XBC = F.XBC(); float* const ssqp = F.ssq();
    LAS float* dtl = (LAS float*)(lds + S_DT); LAS float* csl = (LAS float*)(lds + S_CS); LAS float* dal = (LAS float*)(lds + S_DA);
    for (int i = tid; i < 64 * S_BSTR / 16; i += NWAVES * 64) ((LAS v4u*)(lds + S_HB))[i] = (v4u){0u, 0u, 0u, 0u};
    f32x4 hacc[4];
#pragma unroll
    for (int i = 0; i < 4; ++i) hacc[i] = (f32x4){0.f, 0.f, 0.f, 0.f};
    const int xl = tid >> 3, xc = tid & 7, bl = tid >> 4, bc = tid & 15;
    v4u xr[2], br[4], cr[4]; float dtv = 0.f;
#define S_PREFETCH(cc) do { const size_t t0_ = (size_t)b * SEQ + (size_t)(cc) * SSM_L; \
        _Pragma("unroll") for (int i_ = 0; i_ < 2; ++i_) xr[i_] = *(const GAS v4u*)(XBC + (t0_ + xl + 64 * i_) * XBC_W + h * 64 + 8 * xc); \
        _Pragma("unroll") for (int i_ = 0; i_ < 4; ++i_) { const bf16* p_ = XBC + (t0_ + bl + 32 * i_) * XBC_W + 1024 + g8 * 128 + 8 * bc; br[i_] = *(const GAS v4u*)p_; cr[i_] = *(const GAS v4u*)(p_ + 256); } \
        if (tid < 128) dtv = dt2[(t0_ + tid) * 16 + h]; } while (0)
    S_PREFETCH(0);
    for (int c = 0; c < SSM_NC; ++c) {
        const size_t tok0 = (size_t)b * SEQ + (size_t)c * SSM_L;
        if (tid < 128) { dtl[tid] = dtv; dal[tid] = dtv * a_h; }
        __syncthreads();
        if (w == 0) { const float v0 = dal[2 * lane], v1 = dal[2 * lane + 1]; float s = v0 + v1;
#pragma unroll
            for (int o = 1; o < 64; o <<= 1) { const float t = __shfl_up(s, o); s += (lane >= o) ? t : 0.f; }
            csl[2 * lane] = s - v1; csl[2 * lane + 1] = s; }
        __syncthreads();
        const float cs_last = csl[127];
#pragma unroll
        for (int i = 0; i < 2; ++i) { const int l = xl + 64 * i; const v4u v = xr[i]; *(LAS v4u*)(lds + S_X + l * S_XSTR + xc * 16) = v; const float wl = dtl[l] * __expf(cs_last - csl[l]);
            v4u o2; o2.x = pk2(bflo(v.x) * wl, bfhi(v.x) * wl); o2.y = pk2(bflo(v.y) * wl, bfhi(v.y) * wl); o2.z = pk2(bflo(v.z) * wl, bfhi(v.z) * wl); o2.w = pk2(bflo(v.w) * wl, bfhi(v.w) * wl);
            *(LAS v4u*)(lds + S_XW + l * S_XSTR + xc * 16) = o2; }
#pragma unroll
        for (int i = 0; i < 4; ++i) { const int l = bl + 32 * i; *(LAS v4u*)(lds + S_BM + l * S_BSTR + bc * 16) = br[i]; *(LAS v4u*)(lds + S_CM + l * S_BSTR + bc * 16) = cr[i]; }
        const int lrow = 16 * w + c16;
        v2u zr[4];
#pragma unroll
        for (int pb = 0; pb < 4; ++pb) zr[pb] = *(const GAS v2u*)(PROJ + (tok0 + lrow) * NPROJ + COL_Z + h * 64 + 16 * pb + 4 * g);
        if (c + 1 < SSM_NC) S_PREFETCH(c + 1);
        __syncthreads();
        bf16x8 cf[4];
#pragma unroll
        for (int ks = 0; ks < 4; ++ks) cf[ks] = *(const LAS bf16x8*)(lds + S_CM + lrow * S_BSTR + (32 * ks + 8 * g) * 2);
        f32x4 yacc[4];
        const float cs_l = csl[lrow]; const float el = __expf(cs_l);
#pragma unroll
        for (int pb = 0; pb < 4; ++pb) { yacc[pb] = (f32x4){0.f, 0.f, 0.f, 0.f};
#pragma unroll
            for (int ks = 0; ks < 4; ++ks) { const bf16x8 hf = *(const LAS bf16x8*)(lds + S_HB + (16 * pb + c16) * S_BSTR + (32 * ks + 8 * g) * 2); yacc[pb] = MFMA16(hf, cf[ks], yacc[pb]); }
            yacc[pb] = yacc[pb] * el; }
        for (int s2 = 0; s2 <= (w >> 1); ++s2) {
            const int sb0 = 2 * s2, sb1 = 2 * s2 + 1; const bool has1 = sb1 <= w;
            f32x4 cb0 = (f32x4){0.f, 0.f, 0.f, 0.f}, cb1 = (f32x4){0.f, 0.f, 0.f, 0.f};
#pragma unroll
            for (int ks = 0; ks < 4; ++ks) { const bf16x8 bf0 = *(const LAS bf16x8*)(lds + S_BM + (16 * sb0 + c16) * S_BSTR + (32 * ks + 8 * g) * 2); cb0 = MFMA16(bf0, cf[ks], cb0); }
            if (has1) {
#pragma unroll
                for (int ks = 0; ks < 4; ++ks) { const bf16x8 bf1 = *(const LAS bf16x8*)(lds + S_BM + (16 * sb1 + c16) * S_BSTR + (32 * ks + 8 * g) * 2); cb1 = MFMA16(bf1, cf[ks], cb1); } }
            float mv[8];
#pragma unroll
            for (int r = 0; r < 4; ++r) { const int s = 16 * sb0 + 4 * g + r; const float e = __expf(fminf(cs_l - csl[s], 0.f)) * dtl[s]; mv[r] = (s <= lrow) ? cb0[r] * e : 0.f; }
#pragma unroll
            for (int r = 0; r < 4; ++r) { const int s = 16 * sb1 + 4 * g + r; const int sc_ = s > 127 ? 127 : s; const float e = __expf(fminf(cs_l - csl[sc_], 0.f)) * dtl[sc_]; mv[4 + r] = (has1 && s <= lrow) ? cb1[r] * e : 0.f; }
            const bf16x8 pf = pack8(mv);
#pragma unroll
            for (int pb = 0; pb < 4; ++pb) { LAS unsigned char* xa = lds + S_X + (32 * s2 + 4 * g + q4) * S_XSTR + (16 * pb + 4 * p4) * 2;
                const s16x4 lo = TR16(xa), hi = TR16(xa + 16 * S_XSTR); const bf16x8 xf = __builtin_shufflevector(lo, hi, 0, 1, 2, 3, 4, 5, 6, 7);
                yacc[pb] = MFMA16(xf, pf, yacc[pb]); }
        }
        { const size_t tok = tok0 + lrow; float ssq = 0.f;
#pragma unroll
          for (int pb = 0; pb < 4; ++pb) { const int p0 = 16 * pb + 4 * g;
              const v2u xs_ = *(const LAS v2u*)(lds + S_X + lrow * S_XSTR + p0 * 2);
              const v2u zr_ = zr[pb];
              const float o0 = (yacc[pb].x + bflo(xs_.x) * dsk) * silu_f(bflo(zr_.x)), o1 = (yacc[pb].y + bfhi(xs_.x) * dsk) * silu_f(bfhi(zr_.x));
              const float o2 = (yacc[pb].z + bflo(xs_.y) * dsk) * silu_f(bflo(zr_.y)), o3 = (yacc[pb].w + bfhi(xs_.y) * dsk) * silu_f(bfhi(zr_.y));
              ssq += (o0 * o0 + o1 * o1) + (o2 * o2 + o3 * o3);
              *(GAS unsigned*)((unsigned char*)MIX + tok * DM + ATT_W + h * 64 + p0) = pk4_fp8(o0 * SS8, o1 * SS8, o2 * SS8, o3 * SS8); }
          ssq += __shfl_xor(ssq, 16); ssq += __shfl_xor(ssq, 32);
          if (g == 0 && doatom) unsafeAtomicAdd(ssqp + tok * 4 + 2 + g8, ssq); }
        { const float cdec = __expf(cs_last);
#pragma unroll
          for (int i = 0; i < 4; ++i) hacc[i] = hacc[i] * cdec;
#pragma unroll
          for (int ks = 0; ks < 4; ++ks) {
              LAS unsigned char* xa = lds + S_XW + (32 * ks + 8 * g + q4) * S_XSTR + (16 * pbw + 4 * p4) * 2;
              const s16x4 xlo = TR16(xa), xhi = TR16(xa + 4 * S_XSTR); const bf16x8 xf = __builtin_shufflevector(xlo, xhi, 0, 1, 2, 3, 4, 5, 6, 7);
#pragma unroll
              for (int i = 0; i < 4; ++i) { const int nb = 4 * nhw + i; LAS unsigned char* ba = lds + S_BM + (32 * ks + 8 * g + q4) * S_BSTR + (16 * nb + 4 * p4) * 2;
                  const s16x4 blo = TR16(ba), bhi = TR16(ba + 4 * S_BSTR); const bf16x8 bfr = __builtin_shufflevector(blo, bhi, 0, 1, 2, 3, 4, 5, 6, 7);
                  hacc[i] = MFMA16(bfr, xf, hacc[i]); } } }
        __syncthreads();
#pragma unroll
        for (int i = 0; i < 4; ++i) { const int nb = 4 * nhw + i; v2u o; o.x = pk2(hacc[i].x, hacc[i].y); o.y = pk2(hacc[i].z, hacc[i].w);
            *(LAS v2u*)(lds + S_HB + (16 * pbw + c16) * S_BSTR + (16 * nb + 4 * g) * 2) = o; }
    }
#undef S_PREFETCH
    __syncthreads();
}

__device__ __forceinline__ void mix_normalize(Frame& F) {
    const int tid_ = fresh_tid(), lane = tid_ & 63; const int gw = blockIdx.x * NWAVES + __builtin_amdgcn_readfirstlane(tid_ >> 6), NGW = F.G * NWAVES;
    const float* const ssqp = F.ssq(); bf16* const MIX = F.HN(); const float* const gatt = F.attn_out_norm(); const float* const gssm = F.ssm_out_norm();
    for (int m = gw; m < MTOK; m += NGW) {
        const float* sq = ssqp + (size_t)m * 4;
        const float s1 = __hip_atomic_load(sq + 1, RLX_AGENT), s2 = __hip_atomic_load(sq + 2, RLX_AGENT), s3 = __hip_atomic_load(sq + 3, RLX_AGENT);
        const float ra = 1.f / sqrtf(s1 * (1.f / 1024.f) + EPS), r0 = 1.f / sqrtf(s2 * (1.f / 512.f) + EPS), r1 = 1.f / sqrtf(s3 * (1.f / 512.f) + EPS);
        GAS v4u* row = (GAS v4u*)(MIX + (size_t)m * DM);
#pragma unroll
        for (int j = 0; j < 4; ++j) { const int idx = lane + 64 * j, col = 8 * idx; const float rs = (j < 2) ? ra : ((j == 2) ? r0 : r1);
            const float* gp = (j < 2) ? (gatt + col) : (gssm + (col - ATT_W));
            const f32x4 g0 = *(const GAS f32x4*)gp, g1 = *(const GAS f32x4*)(gp + 4); const v4u v = row[idx]; v4u o;
            o.x = pk2(bflo(v.x) * rs * g0.x, bfhi(v.x) * rs * g0.y); o.y = pk2(bflo(v.y) * rs * g0.z, bfhi(v.y) * rs * g0.w);
            o.z = pk2(bflo(v.z) * rs * g1.x, bfhi(v.z) * rs * g1.y); o.w = pk2(bflo(v.w) * rs * g1.z, bfhi(v.w) * rs * g1.w); row[idx] = o; }
    }
}

constexpr int P_EIDX = 0, P_GATE = 16384, P_LST = 32768  , P_HN4 = 32768  , P_ACT = 98304  , P_END = 114688;
static_assert(P_END <= RING_BYTES, "peer LDS map");
__constant__ unsigned char PEER_CAND[52] = {0, 1, 2, 3, 4, 5, 6, 7, 8, 9, 10, 11, 12, 13, 14, 15, 16, 17, 18, 19, 20, 21, 22, 23, 32, 33, 34, 35, 36, 48, 49, 50, 51, 64, 65, 66, 80, 81, 96, 97, 112, 113, 128, 144, 160, 176, 192, 208, 224, 240, 255, 255};
__device__ __forceinline__ unsigned f2ord(float f) { const unsigned u = __builtin_bit_cast(unsigned, f); return u ^ ((u >> 31) ? 0xFFFFFFFFu : 0x80000000u); }
__device__ __forceinline__ float ord2f(unsigned u) { return __builtin_bit_cast(float, u ^ ((u >> 31) ? 0x80000000u : 0xFFFFFFFFu)); }
#define CSWAPD(a, b) do { const unsigned hi_ = (a) > (b) ? (a) : (b), lo_ = (a) > (b) ? (b) : (a); (a) = hi_; (b) = lo_; } while (0)
template <int N> __device__ __forceinline__ void bitonic_sort_desc(unsigned (&v)[N]) {
#pragma unroll
    for (int k = 2; k <= N; k <<= 1)
#pragma unroll
        for (int j = k >> 1; j > 0; j >>= 1)
#pragma unroll
            for (int i = 0; i < N; ++i) { const int l = i ^ j; if (l > i) { if ((i & k) == 0) CSWAPD(v[i], v[l]); else CSWAPD(v[l], v[i]); } }
}
__device__ __forceinline__ void merge16_xor(unsigned (&v)[16], int dist) {
    unsigned o[16];
#pragma unroll
    for (int i = 0; i < 16; ++i) o[i] = (unsigned)__shfl_xor((int)v[i], dist);
#pragma unroll
    for (int i = 0; i < 16; ++i) v[i] = v[i] > o[15 - i] ? v[i] : o[15 - i];
#pragma unroll
    for (int j = 8; j > 0; j >>= 1)
#pragma unroll
        for (int i = 0; i < 16; ++i) { const int l = i ^ j; if (l > i) CSWAPD(v[i], v[l]); }
}
__device__ __forceinline__ float gelu_erf(float x) { return 0.5f * x * (1.f + erff(x * 0.70710678118654752f)); }
__device__ __forceinline__ float fp4_dec1(unsigned n) { const unsigned m = n & 7u; unsigned bits = (m >= 2u) ? (((126u + (m >> 1)) << 23) | ((m & 1u) << 22)) : (m ? 0x3F000000u : 0u); bits |= (n & 8u) << 28; return __builtin_bit_cast(float, bits); }
__device__ __forceinline__ f32x2 fp4_dec2(unsigned x) { f32x2 r; r.x = fp4_dec1(x & 15u); r.y = fp4_dec1((x >> 4) & 15u); return r; }
typedef long i64;
typedef int v8i __attribute__((ext_vector_type(8)));
typedef int v4i __attribute__((ext_vector_type(4)));
template <bool dry = false> __device__ __forceinline__ void peer_unit(Frame& F, int u) {
    LAS unsigned char* lds = F.lds + RING_OFF;
    const int tid_ = fresh_tid(), lane = tid_ & 63, w = __builtin_amdgcn_readfirstlane(tid_ >> 6), g = lane >> 4, c16 = lane & 15;
    const int T0 = 32 * u;
    LAS int* eidx = (LAS int*)(lds + P_EIDX); LAS float* gate = (LAS float*)(lds + P_GATE);
    LAS unsigned* lst = (LAS unsigned*)(lds + P_LST) + w * 1024;
    const bf16* const QP = F.QP(); const bf16* const SK = F.SK(); float* const outp = F.out(); const bf16* const X1B = F.X1B(); const float* const fgain = F.ffn_norm(); const float* const fing = F.final_norm(); const unsigned char* const U8 = F.U8(); const unsigned char* const V8 = F.V8();
#ifndef NO_ROUTE
    unsigned cpk[4];
    { unsigned cb[16];
#pragma unroll
      for (int k = 0; k < 13; ++k) cb[k] = PEER_CAND[4 * k + g];
      cb[13] = 255u; cb[14] = 255u; cb[15] = 255u;
#pragma unroll
      for (int q = 0; q < 4; ++q) cpk[q] = cb[4 * q] | (cb[4 * q + 1] << 8) | (cb[4 * q + 2] << 16) | (cb[4 * q + 3] << 24); }
    {
    bf16x8 qf[2][4];
#define QP_LOAD(dst, c_) do { _Pragma("unroll") for (int tb = 0; tb < 2; ++tb) { const unsigned qo = ((unsigned)(T0 + 16 * tb + c16) * (unsigned)DM + (unsigned)((2 * w + (c_)) * 128 + 8 * g)) * 2u; \
        _Pragma("unroll") for (int ks = 0; ks < 4; ++ks) dst[tb][ks] = __builtin_nontemporal_load((const GAS bf16x8*)((const unsigned char*)QP + (qo + 64u * ks))); } } while (0)
    QP_LOAD(qf, 0);
#pragma unroll
    for (int c = 0; c < 2; ++c) {
        const int p = 2 * w + c;
        unsigned key[2][32];
        bf16x8 sf[3][8];
        const unsigned so0 = ((unsigned)(p * 128 + c16) * 128u + 8u * (unsigned)g) * 2u;
#define SK_LOAD(buf, j_) do { _Pragma("unroll") for (int q = 0; q < 8; ++q) sf[buf][q] = *(const GAS bf16x8*)((const unsigned char*)SK + (so0 + (unsigned)(2 * (j_) + (q >> 2)) * 4096u + 64u * (q & 3))); } while (0)
        SK_LOAD(0, 0); SK_LOAD(1, 1);
#pragma unroll
        for (int j = 0; j < 4; ++j) {
            if (j + 2 < 4) SK_LOAD((j + 2) % 3, j + 2);
            __builtin_amdgcn_sched_barrier(0);
#pragma unroll
            for (int h2 = 0; h2 < 2; ++h2)
#pragma unroll
            for (int tb = 0; tb < 2; ++tb) { const int kb = 2 * j + h2; f32x4 acc = (f32x4){0.f, 0.f, 0.f, 0.f};
#pragma unroll
                for (int ks = 0; ks < 4; ++ks) acc = MFMA16(sf[j % 3][4 * h2 + ks], qf[tb][ks], acc);
#pragma unroll
                for (int r = 0; r < 4; ++r) key[tb][kb * 4 + r] = (f2ord(acc[r]) & ~0x7Fu) | (unsigned)(16 * kb + 4 * g + r); }
            __builtin_amdgcn_sched_barrier(0); }
#undef SK_LOAD
        if (c == 0) { QP_LOAD(qf, 1); __builtin_amdgcn_sched_barrier(0); }
#pragma unroll
        for (int tb = 0; tb < 2; ++tb) {
            bitonic_sort_desc<32>(key[tb]);
            unsigned top[16];
#pragma unroll
            for (int i = 0; i < 16; ++i) top[i] = key[tb][i];
            merge16_xor(top, 16); merge16_xor(top, 32);
            if (g == 0) { LAS v4u* d = (LAS v4u*)(lst + (c * 32 + 16 * tb + c16) * 16);
                d[0] = (v4u){top[0], top[1], top[2], top[3]}; d[1] = (v4u){top[4], top[5], top[6], top[7]}; d[2] = (v4u){top[8], top[9], top[10], top[11]}; d[3] = (v4u){top[12], top[13], top[14], top[15]}; } }
    }
#undef QP_LOAD
    }
    for (int tb = 0; tb < 2; ++tb) {
        LDS_WAIT();
        const LAS unsigned* l1 = lst + (16 * tb + c16) * 16; const LAS unsigned* l2 = lst + (32 + 16 * tb + c16) * 16;
        unsigned ck[16];
#pragma unroll
        for (int k = 0; k < 13; ++k) { const unsigned ab = (cpk[k >> 2] >> (8 * (k & 3))) & 255u; const unsigned a = ab >> 4, bq = ab & 15u;
            const float s = ord2f(l1[a] & ~0x7Fu) + ord2f(l2[bq] & ~0x7Fu); ck[k] = (ab == 255u) ? 0u : ((f2ord(s) & ~0xFFu) | ab); }
        ck[13] = 0u; ck[14] = 0u; ck[15] = 0u;
        bitonic_sort_desc<16>(ck);
        merge16_xor(ck, 16); merge16_xor(ck, 32);
        if (g == 0) { const int tl = 16 * tb + c16; const float m = ord2f(ck[0] & ~0xFFu); float e[16]; float sum = 0.f;
#pragma unroll
            for (int k = 0; k < 16; ++k) { e[k] = __expf(ord2f(ck[k] & ~0xFFu) - m); sum += e[k]; }
            const float inv = 1.f / sum;
#pragma unroll
            for (int k = 0; k < 16; ++k) { const unsigned a = (ck[k] >> 4) & 15u, bq = ck[k] & 15u; const int ex = (int)((l1[a] & 0x7Fu) * 128u + (l2[bq] & 0x7Fu));
                eidx[tl * 128 + w * 16 + k] = ex; gate[tl * 128 + w * 16 + k] = e[k] * inv; } }
    }
#endif
    __syncthreads();
    LAS unsigned char* hnb = lds + P_HN4 + w * 8192; LAS float* actl = (LAS float*)(lds + P_ACT) + w * 512;
    const LAS unsigned char* hb = hnb + 16 * g + ((c16 == 1) ? 1024 : 0);
    v4u bA[8], bB[8];
#define U_ISSUE(buf, e_, jb) do { const unsigned uo_ = (unsigned)(e_) * (unsigned)ROWB + 16u * (unsigned)g + 512u * (unsigned)(jb); \
        _Pragma("unroll") for (int jj = 0; jj < 8; ++jj) buf[jj] = *(const GAS v4u*)(U8 + (uo_ + 64u * jj)); __builtin_amdgcn_sched_barrier(0); } while (0)
#define U_CONSUME(buf, jb, HB) do { v4u bq_[8]; _Pragma("unroll") for (int jj = 0; jj < 8; ++jj) bq_[jj] = *(const LAS v4u*)((HB) + 64 * (8 * (jb) + jj)); \
        __builtin_amdgcn_sched_barrier(0); \
        _Pragma("unroll") for (int jj = 0; jj < 8; ++jj) { const v4u a_ = buf[jj]; \
            const v8i av_ = {(int)a_.x, (int)a_.y, (int)a_.z, (int)a_.w, 0, 0, 0, 0}; const v8i bv_ = {(int)bq_[jj].x, (int)bq_[jj].y, (int)bq_[jj].z, (int)bq_[jj].w, 0, 0, 0, 0}; \
            acc = __builtin_amdgcn_mfma_scale_f32_16x16x128_f8f6f4(av_, bv_, acc, 4, 4, 0, 0x7f7f7f7f, 0, 0x7f7f7f7f); } __builtin_amdgcn_sched_barrier(0); } while (0)
#define U_ACT(grp_, TL, ACT) do { const float l0_ = __shfl_down(acc.x, 1), l1_ = __shfl_down(acc.y, 1), l2_ = __shfl_down(acc.z, 1), l3_ = __shfl_down(acc.w, 1); \
        if (c16 == 0) { const int k0 = 16 * (grp_) + 4 * g; constexpr float isc = 1.f / (SU * SH4), ilo = 1.f / SLO4; const f32x4 gt = *(const LAS f32x4*)(gate + (TL) * 128 + k0); \
        f32x4 a4; a4.x = gelu_erf((acc.x + l0_ * ilo) * isc) * gt.x; a4.y = gelu_erf((acc.y + l1_ * ilo) * isc) * gt.y; a4.z = gelu_erf((acc.z + l2_ * ilo) * isc) * gt.z; a4.w = gelu_erf((acc.w + l3_ * ilo) * isc) * gt.w; *(LAS f32x4*)((ACT) + k0) = a4; } } while (0)
#define V_ISSUE(buf, TL, kb_) do { _Pragma("unroll") for (int kh = 0; kh < 2; ++kh) { const LAS v4i* ep_ = (const LAS v4i*)(eidx + (TL) * 128 + 8 * (kb_) + 4 * kh); const v4i e4_ = *ep_; const int ee_[4] = {e4_.x, e4_.y, e4_.z, e4_.w}; \
        _Pragma("unroll") for (int kk = 0; kk < 4; ++kk) { const unsigned vo_ = (unsigned)(ee_[kk] & emask) * (unsigned)ROWB + 16u * (unsigned)lane; buf[4 * kh + kk] = *(const GAS v4u*)(V8 + vo_); } \
        __builtin_amdgcn_sched_barrier(0); } } while (0)
#define PIN8x2(a, i) asm volatile("" : "+v"(a[i]), "+v"(a[i + 1]), "+v"(a[i + 2]), "+v"(a[i + 3]), "+v"(a[i + 4]), "+v"(a[i + 5]), "+v"(a[i + 6]), "+v"(a[i + 7]))
#define V_CONSUME(buf, kb_, O, ACT) do { _Pragma("unroll") for (int kk = 0; kk < 8; ++kk) { const float as_ = (ACT)[8 * (kb_) + kk]; const f32x2 a2_ = {as_, as_}; \
        const unsigned vw[4] = {buf[kk].x, buf[kk].y, buf[kk].z, buf[kk].w}; \
        _Pragma("unroll") for (int q = 0; q < 4; ++q) { \
            O[4 * q]     = __builtin_elementwise_fma(__builtin_amdgcn_cvt_scalef32_pk_f32_fp4(vw[q], 1.0f, 0), a2_, O[4 * q]); \
            O[4 * q + 1] = __builtin_elementwise_fma(__builtin_amdgcn_cvt_scalef32_pk_f32_fp4(vw[q], 1.0f, 1), a2_, O[4 * q + 1]); \
            O[4 * q + 2] = __builtin_elementwise_fma(__builtin_amdgcn_cvt_scalef32_pk_f32_fp4(vw[q], 1.0f, 2), a2_, O[4 * q + 2]); \
            O[4 * q + 3] = __builtin_elementwise_fma(__builtin_amdgcn_cvt_scalef32_pk_f32_fp4(vw[q], 1.0f, 3), a2_, O[4 * q + 3]); } \
        PIN8x2(O, 0); PIN8x2(O, 8); } } while (0)
#ifndef NO_GATHER
#ifdef PROBE_L2RES
    constexpr int emask = dry ? PROBE_L2RES : 16383;
#else
    constexpr int emask = 16383;
#endif
    {
    { unsigned k0[4], k1[4];
#pragma unroll
      for (int ti = 0; ti < 4; ++ti) { const int tl = w + 8 * ti; k0[ti] = ((unsigned)eidx[tl * 128 + lane] << 7) | (unsigned)lane; k1[ti] = ((unsigned)eidx[tl * 128 + 64 + lane] << 7) | (unsigned)(64 + lane); }
#pragma unroll
      for (int k = 2; k <= 128; k <<= 1)
#pragma unroll
        for (int j = k >> 1; j > 0; j >>= 1) {
            if (j == 64) {
#pragma unroll
                for (int ti = 0; ti < 4; ++ti) { const unsigned lo_ = k0[ti] < k1[ti] ? k0[ti] : k1[ti], hi_ = k0[ti] < k1[ti] ? k1[ti] : k0[ti]; k0[ti] = lo_; k1[ti] = hi_; }
            } else {
                const bool lower = (lane & j) == 0;
                const bool desc0 = (k == 64) ? false : ((k == 128) ? false : ((lane & k) != 0)), desc1 = (k == 64) ? true : desc0;
                const bool min0 = lower != desc0, min1 = lower != desc1;
#pragma unroll
                for (int ti = 0; ti < 4; ++ti) { const unsigned p0 = (unsigned)__shfl_xor((int)k0[ti], j), p1 = (unsigned)__shfl_xor((int)k1[ti], j);
                    const unsigned mn0 = k0[ti] < p0 ? k0[ti] : p0, mx0 = k0[ti] < p0 ? p0 : k0[ti], mn1 = k1[ti] < p1 ? k1[ti] : p1, mx1 = k1[ti] < p1 ? p1 : k1[ti];
                    k0[ti] = min0 ? mn0 : mx0; k1[ti] = min1 ? mn1 : mx1; }
            }
        }
      float g0[4], g1[4];
#pragma unroll
      for (int ti = 0; ti < 4; ++ti) { const int tl = w + 8 * ti; g0[ti] = gate[tl * 128 + (int)(k0[ti] & 127u)]; g1[ti] = gate[tl * 128 + (int)(k1[ti] & 127u)]; }
      LDS_WAIT(); asm volatile("" ::: "memory");
#pragma unroll
      for (int ti = 0; ti < 4; ++ti) { const int tl = w + 8 * ti; eidx[tl * 128 + lane] = (int)(k0[ti] >> 7); eidx[tl * 128 + 64 + lane] = (int)(k1[ti] >> 7); gate[tl * 128 + lane] = g0[ti]; gate[tl * 128 + 64 + lane] = g1[ti]; }
      LDS_WAIT(); asm volatile("" ::: "memory"); }
    v2u xn[8];
#define X_ISSUE(tok_) do { const unsigned xb_ = (unsigned)(tok_) * (unsigned)(DM * 2) + 8u * (unsigned)lane; _Pragma("unroll") for (int j = 0; j < 8; ++j) xn[j] = __builtin_nontemporal_load((const GAS v2u*)((const unsigned char*)X1B + (xb_ + 512u * j))); } while (0)
    X_ISSUE(T0 + w);
#pragma unroll 1
    for (int ti = 0; ti < 4; ++ti) {
        f32x4 xr[8]; float ss = 0.f;
#pragma unroll
        for (int j = 0; j < 8; ++j) { const v2u r = xn[j]; xr[j] = (f32x4){bflo(r.x), bfhi(r.x), bflo(r.y), bfhi(r.y)}; }
        X_ISSUE(T0 + w + 8 * (ti < 3 ? ti + 1 : 3));
#pragma unroll
        for (int j = 0; j < 8; ++j) ss += (xr[j].x * xr[j].x + xr[j].y * xr[j].y) + (xr[j].z * xr[j].z + xr[j].w * xr[j].w);
        const float rs2 = __builtin_amdgcn_rsqf(wave_sum(ss) * (1.f / DM) + EPS);
        const float* fg_ = fgain; asm volatile("" : "+s"(fg_));
        const unsigned char* gp = (const unsigned char*)fg_; const unsigned go = 16u * (unsigned)lane;
        unsigned hw[4], lw[4];
#pragma unroll
        for (int q = 0; q < 4; ++q) { unsigned wh = 0u, wl = 0u;
#pragma unroll
            for (int t = 0; t < 2; ++t) { const int j = 2 * q + t; const f32x4 gg = *(const GAS f32x4*)(gp + (go + 1024u * j)); const f32x4 hv = xr[j] * gg * (rs2 * SH4);
                const float h0 = clampf(hv.x, 6.f), h1 = clampf(hv.y, 6.f), h2 = clampf(hv.z, 6.f), h3 = clampf(hv.w, 6.f);
                const unsigned p0 = __builtin_amdgcn_cvt_scalef32_pk_fp4_f32(0u, h0, h1, 1.0f, 0), p1 = __builtin_amdgcn_cvt_scalef32_pk_fp4_f32(0u, h2, h3, 1.0f, 0);
                const f32x2 d0 = __builtin_amdgcn_cvt_scalef32_pk_f32_fp4(p0, 1.0f, 0), d1 = __builtin_amdgcn_cvt_scalef32_pk_f32_fp4(p1, 1.0f, 0);
                const unsigned r0 = __builtin_amdgcn_cvt_scalef32_pk_fp4_f32(0u, clampf((h0 - d0.x) * SLO4, 6.f), clampf((h1 - d0.y) * SLO4, 6.f), 1.0f, 0), r1 = __builtin_amdgcn_cvt_scalef32_pk_fp4_f32(0u, clampf((h2 - d1.x) * SLO4, 6.f), clampf((h3 - d1.y) * SLO4, 6.f), 1.0f, 0);
                wh |= ((p0 & 0xFFu) | ((p1 & 0xFFu) << 8)) << (16 * t); wl |= ((r0 & 0xFFu) | ((r1 & 0xFFu) << 8)) << (16 * t); }
            hw[q] = wh; lw[q] = wl; }
        *(LAS v4u*)(hnb + 2048 * ti + 16 * lane) = (v4u){hw[0], hw[1], hw[2], hw[3]}; *(LAS v4u*)(hnb + 2048 * ti + 1024 + 16 * lane) = (v4u){lw[0], lw[1], lw[2], lw[3]};
    }
    LDS_WAIT();
    { int e_cur = eidx[w * 128 + c16] & emask;
      U_ISSUE(bA, e_cur, 0);
#pragma unroll 1
      for (int s_ = 0; s_ < 31; ++s_) {
          const int ti = s_ & 3, grp = s_ >> 2, tl = w + 8 * ti, sn = s_ + 1;
          const int e_nxt = eidx[(w + 8 * (sn & 3)) * 128 + 16 * (sn >> 2) + c16] & emask;
          const LAS unsigned char* hbt = hb + 2048 * ti; LAS float* actt = actl + 128 * ti;
          f32x4 acc = (f32x4){0.f, 0.f, 0.f, 0.f};
          U_ISSUE(bB, e_cur, 1); U_CONSUME(bA, 0, hbt);
          U_ISSUE(bA, e_nxt, 0);
          U_CONSUME(bB, 1, hbt);
          U_ACT(grp, tl, actt);
          e_cur = e_nxt;
      }
      { const LAS unsigned char* hbt = hb + 2048 * 3; LAS float* actt = actl + 128 * 3;
        f32x4 acc = (f32x4){0.f, 0.f, 0.f, 0.f};
        U_ISSUE(bB, e_cur, 1); U_CONSUME(bA, 0, hbt);
        V_ISSUE(bA, w, 0);
        U_CONSUME(bB, 1, hbt);
        U_ACT(7, w + 24, actt); } }
    LDS_WAIT();
    f32x2 o2[4][16];
#pragma unroll
    for (int ti = 0; ti < 4; ++ti)
#pragma unroll
        for (int i = 0; i < 16; ++i) o2[ti][i] = (f32x2){0.f, 0.f};
#pragma unroll 1
    for (int grp = 0; grp < 8; ++grp) {
        const int gn = grp < 7 ? grp + 1 : 7;
        V_ISSUE(bB, w, 2 * grp + 1);      V_CONSUME(bA, 2 * grp, o2[0], actl);       V_ISSUE(bA, w + 8, 2 * grp);  V_CONSUME(bB, 2 * grp + 1, o2[0], actl);
        V_ISSUE(bB, w + 8, 2 * grp + 1);  V_CONSUME(bA, 2 * grp, o2[1], actl + 128); V_ISSUE(bA, w + 16, 2 * grp); V_CONSUME(bB, 2 * grp + 1, o2[1], actl + 128);
        V_ISSUE(bB, w + 16, 2 * grp + 1); V_CONSUME(bA, 2 * grp, o2[2], actl + 256); V_ISSUE(bA, w + 24, 2 * grp); V_CONSUME(bB, 2 * grp + 1, o2[2], actl + 256);
        V_ISSUE(bB, w + 24, 2 * grp + 1); V_CONSUME(bA, 2 * grp, o2[3], actl + 384); V_ISSUE(bA, w, 2 * gn);       V_CONSUME(bB, 2 * grp + 1, o2[3], actl + 384);
    }
    X_ISSUE(T0 + w);
#pragma unroll
    for (int ti = 0; ti < 4; ++ti) {
        const size_t token = (size_t)T0 + w + 8 * ti;
        const unsigned xo = (unsigned)token * (unsigned)(DM * 4) + 16u * (unsigned)lane;
        f32x4 xr[8];
#pragma unroll
        for (int j = 0; j < 8; ++j) { const v2u r = xn[j]; xr[j] = (f32x4){bflo(r.x), bfhi(r.x), bflo(r.y), bfhi(r.y)}; }
        if (ti < 3) X_ISSUE(T0 + w + 8 * (ti + 1));
        constexpr float isv = 1.f / SV; float s2 = 0.f;
#pragma unroll
        for (int j = 0; j < 8; ++j) { xr[j] = xr[j] + (f32x4){o2[ti][2 * j].x, o2[ti][2 * j].y, o2[ti][2 * j + 1].x, o2[ti][2 * j + 1].y} * isv;
            s2 += (xr[j].x * xr[j].x + xr[j].y * xr[j].y) + (xr[j].z * xr[j].z + xr[j].w * xr[j].w); }
        const float rf = __builtin_amdgcn_rsqf(wave_sum(s2) * (1.f / DM) + EPS);
        const float* fi_ = fing; asm volatile("" : "+s"(fi_));
        const unsigned char* fp = (const unsigned char*)fi_; unsigned char* op = (unsigned char*)outp; const unsigned fo = 16u * (unsigned)lane;
        if (!dry || rf == 1.2345e30f)
#pragma unroll
        for (int j = 0; j < 8; ++j) __builtin_nontemporal_store(xr[j] * rf * *(const GAS f32x4*)(fp + (fo + 1024u * j)), (GAS f32x4*)(op + (xo + 1024u * j)));
    }
    }
#endif
#undef U_ISSUE
#undef X_ISSUE
#undef U_ACT
#undef U_CONSUME
#undef V_ISSUE
#undef V_CONSUME
    __syncthreads();
}

__global__ void __launch_bounds__(NWAVES * 64, 2) hybrid_fwd(Args args) {
    extern __shared__ __attribute__((aligned(16))) unsigned char lds[];
    Frame F;
    F.lds = (LAS unsigned char*)lds;
    F.MISC = (volatile LAS unsigned*)(F.lds + MISC_OFF);
    F.tid = threadIdx.x; F.lane = F.tid & 63; F.wave = __builtin_amdgcn_readfirstlane(F.tid >> 6); F.G = gridDim.x;
    for (int u = F.tid; u < (LDS_BYTES - LDSCTL_OFF) / 4; u += NWAVES * 64) ((LAS unsigned*)(F.lds + LDSCTL_OFF))[u] = 0u;
    __syncthreads();
    (void)args;
    XcdBarrier bar = xcd_barrier_post(F.ctl() + CW_BAR, F.MISC + 8);

#ifndef NO_P0
#ifdef PROBE_P0X2
    { int reps = 2; asm volatile("" : "+s"(reps)); for (int rep = 0; rep < reps; ++rep) p0_prologue(F); }
#else
    p0_prologue(F);
#endif
#endif
    xcd_barrier(bar);
#ifndef NO_P1
#ifdef PROBE_GX2
    { int reps = 2; asm volatile("" : "+s"(reps)); for (int rep = 0; rep < reps; ++rep) {
#else
    { { const int rep = 0, reps = 1;
#endif
      pg8::Gemm gm{F.HN(), F.WinT(), MTOK, NB16, DM}; pg8::StaticOrder S; S.init(MTOK, NB16, F.G, (int)blockIdx.x);
      EpiProj E{F.PROJ(), F.dtraw(), (rep + 1 < reps) ? nullptr : F.kmean()};
      pg8::gemm_phase<EpiProj, pg8::StaticOrder, PG8_ALIGN, PG8_SP2>(F.lds + RING_OFF, gm, S, E); } }
    { const int nun = (MTOK / 256) * (NB16 / 256), rem = nun % F.G;
      if (rem && (int)blockIdx.x >= rem) tables_convert(F, tab_split(F.G), TAB_ITEMS, (size_t)((int)blockIdx.x - rem) * (NWAVES * 64) + fresh_tid(), (size_t)(F.G - rem) * (NWAVES * 64)); }
    __syncthreads();
    {
      pg8::Gemm gm{(const pg8::bf16_t*)F.HN8(), (const pg8::bf16_t*)F.WinT8(), MTOK, F8_HI - F8_LO, DM / 2}; pg8::StaticOrder S; S.init(MTOK, F8_HI - F8_LO, F.G, (int)blockIdx.x);
      EpiProj8 E{F.PROJ()};
      pg8::gemm_phase<EpiProj8, pg8::StaticOrder, PG8_ALIGN, PG8_SP2, true>(F.lds + RING_OFF, gm, S, E); }
#endif
    xcd_barrier(bar);
#ifdef PROBE_P15X2
    conv_phase(F);
#endif
    conv_phase(F);
    xcd_barrier(bar);
#ifdef PROBE_P2X2
    { int reps = 2; asm volatile("" : "+s"(reps)); for (int rep = 0; rep < reps; ++rep) {
#else
    { { const int rep = 0, reps = 1;
#endif
    const bool doatom = rep + 1 == reps;
    for (;;) {
        if (F.tid == 0) F.MISC[0] = xb_add(F.ctl() + CW_Q2 + 64 * rep, 1u);
        __syncthreads();
        const int ui = (int)F.MISC[0];
        __syncthreads();
        if (ui >= 128 + 512) break;
#ifdef PROBE_P2_SSD
        if (ui < 128 || doatom)
#endif
#ifdef PROBE_P2_ATT
        if (ui >= 128 || doatom)
#endif
        {
        if (ui < 128) ssd_unit(F, ui >> 4, ui & 15, doatom);
        else { const int a = ui - 128; attn_unit(F, (a & 63) >> 3, a & 7, 7 - (a >> 6), doatom); }
        }
    } } }
    xcd_barrier(bar);
#ifndef NO_P3
#ifdef PROBE_GX2
    { int reps = 2; asm volatile("" : "+s"(reps)); for (int rep = 0; rep < reps; ++rep) {
#else
    { { const int rep = 0, reps = 1;
#endif
      pg8::Gemm gm{F.HN(), F.WoutT(), MTOK, DM, DM / 2}; pg8::StaticOrder S; S.init(MTOK, DM, F.G, (int)blockIdx.x);
      {
        const int t_ = fresh_tid(); const float* const sq = F.ssq();
#pragma unroll 1
        for (int ii = t_ >> 8; ii < 3; ii += 2) { pg8::Unit uu;
          if (S.next(ii, uu)) { const int row = uu.pm * 256 + (t_ & 255);
            const float q1 = __hip_atomic_load(sq + (size_t)row * 4 + 1, RLX_AGENT), q2 = __hip_atomic_load(sq + (size_t)row * 4 + 2, RLX_AGENT), q3 = __hip_atomic_load(sq + (size_t)row * 4 + 3, RLX_AGENT);
            const float sa = __builtin_amdgcn_rsqf(q1 * (1.f / 1024.f) + EPS), s0 = __builtin_amdgcn_rsqf(q2 * (1.f / 512.f) + EPS), s1 = __builtin_amdgcn_rsqf(q3 * (1.f / 512.f) + EPS);
            *(LAS f32x4*)(F.lds + SEGTAB_OFF + (ii * 256 + (t_ & 255)) * 16) = (f32x4){sa / s0 * (SS8 / SA8), s0 / s1, s1 * (1.f / (SS8 * SW8)), 0.f}; } }
        __syncthreads(); }
      EpiOut E{F.x(), F.X1B(), F.X18(), F.ssq(), rep + 1 == reps, (const LAS f32x4*)(F.lds + SEGTAB_OFF)};
      pg8::gemm_phase<EpiOut, pg8::StaticOrder, PG8_ALIGN, PG8_SP2, true>(F.lds + RING_OFF, gm, S, E); } }
#endif
    xcd_barrier(bar);
#ifndef NO_P4
#ifdef PROBE_GX2
    { int reps = 2; asm volatile("" : "+s"(reps)); for (int rep = 0; rep < reps; ++rep) {
#else
    { { const int rep = 0, reps = 1; (void)rep; (void)reps;
#endif
      pg8::Gemm gm{(const pg8::bf16_t*)F.X18(), F.WqT(), MTOK, DM, DM / 2}; pg8::StaticOrder S; S.init(MTOK, DM, F.G, (int)blockIdx.x);
      EpiQ E{F.QP(), F.ssq()};
      pg8::gemm_phase<EpiQ, pg8::StaticOrder, PG8_ALIGN, PG8_SP2, true>(F.lds + RING_OFF, gm, S, E); } }
#endif
    xcd_barrier(bar);
#ifndef NO_P5
#ifdef PROBE_P5X2
    { for (int u = blockIdx.x; u < MTOK / 32; u += F.G) peer_unit<true>(F, u);
      for (int u = blockIdx.x; u < MTOK / 32; u += F.G) peer_unit<false>(F, u); }
#else
    for (int u = blockIdx.x; u < MTOK / 32; u += F.G) peer_unit(F, u);
#endif
#endif
}

extern "C" void kernel_launch(void* const* d_in, const int* in_sizes, int n_in, void* d_out, int out_size, void* d_ws, size_t ws_size, hipStream_t stream) {
    static int grid = 0;
    if (grid == 0) {
        if (n_in != 18 || out_size != MTOK * DM || ws_size < WS_END) { fprintf(stderr, "kernel_launch: unexpected shapes (n_in %d, out %d, ws %zu)\n", n_in, out_size, ws_size); grid = -1; return; }
        int dev = 0, cus = 0, per_cu = 0;
        if (hipGetDevice(&dev) != hipSuccess || hipDeviceGetAttribute(&cus, hipDeviceAttributeMultiprocessorCount, dev) != hipSuccess) { grid = -1; return; }
        if (hipFuncSetAttribute((const void*)hybrid_fwd, hipFuncAttributeMaxDynamicSharedMemorySize, LDS_BYTES) != hipSuccess) { fprintf(stderr, "kernel_launch: hipFuncSetAttribute failed\n"); grid = -1; return; }
        if (hipOccupancyMaxActiveBlocksPerMultiprocessor(&per_cu, (const void*)hybrid_fwd, NWAVES * 64, LDS_BYTES) != hipSuccess || per_cu < 1)
            fprintf(stderr, "kernel_launch: note: occupancy query reports %d workgroups per CU\n", per_cu);
        (void)hipGetLastError();
        grid = cus;
    }
    if (grid < 0) return;
    if (hipMemsetAsync((char*)d_ws + WS_CTL, 0, CTL_ZERO_BYTES, stream) != hipSuccess) return;
    Args a{};
    for (int i = 0; i < 18; ++i) a.in[i] = (const float*)d_in[i];
    a.out = (float*)d_out; a.ws = (unsigned char*)d_ws;
    hipLaunchKernelGGL(hybrid_fwd, dim3(grid), dim3(NWAVES * 64), LDS_BYTES, stream, a);
}
```

```cpp
#include <hip/hip_runtime.h>
#include <cstdio>
#include <cstdint>
namespace pg8 {
#define PG8_LAS __attribute__((address_space(3)))
typedef unsigned short bf16_t;
typedef short bf16x8 __attribute__((ext_vector_type(8)));
typedef float f32x4 __attribute__((ext_vector_type(4)));
typedef unsigned u32x4 __attribute__((ext_vector_type(4)));
constexpr int BM = 256, BK = 64, HALF = 128, HTB = HALF * BK * 2  , STAGE_BYTES = 8 * HTB, NXCD = 8, WGM = 8;

__host__ __device__ __forceinline__ int lds_byte(int r, int c) { const int st = (r >> 4) * 2 + (c >> 5), rr = r & 15, cc = c & 31, ob = rr * 64 + cc * 2; return st * 1024 + (ob ^ (((ob >> 9) & 1) << 5)); }
__host__ __device__ __forceinline__ void stage_rc(int b, int& R, int& C) { const int st = b / 1024, sb = b % 1024, swz = sb ^ (((sb >> 9) & 1) << 5); R = (st >> 1) * 16 + swz / 64; C = (st & 1) * 32 + (swz % 64) / 2; }
__host__ __device__ __forceinline__ int perm32(int rho) { const int n = rho >> 4, i = rho & 15; return 8 * (i >> 2) + 4 * n + (i & 3); }

struct Unit { int pm, pn; };
struct Gemm { const bf16_t* A; const bf16_t* Bt; int M, N, K; };

struct StaticOrder {
    int nM, nN, nwg, G, c;
    __host__ __device__ void init(int M, int N, int G_, int c_) { nM = M / BM; nN = N / BM; nwg = nM * nN; G = G_; c = c_; }
    __host__ __device__ bool next(int i, Unit& u) const {
        const long L = (long)i * G + c; if (L >= nwg) return false;
        int wgid = (int)L; { const int q = nwg / NXCD, r = nwg % NXCD, xcd = wgid % NXCD, off = wgid / NXCD; wgid = (xcd < r ? xcd * (q + 1) : r * (q + 1) + (xcd - r) * q) + off; }
        const int nig = WGM * nN, gid = wgid / nig, fm = gid * WGM, gsz = (nM - fm) < WGM ? (nM - fm) : WGM;
        u.pm = fm + ((wgid % nig) % gsz); u.pn = (wgid % nig) / gsz; return true;
    }
    __device__ __forceinline__ void a_ready(const Unit&) const {}
    __device__ __forceinline__ void done(const Unit&) const {}
};

__device__ __forceinline__ unsigned cvt_pk_bf16(float lo, float hi) { unsigned r; asm volatile("v_cvt_pk_bf16_f32 %0, %1, %2" : "=v"(r) : "v"(lo), "v"(hi)); return r; }
typedef float f32x2 __attribute__((ext_vector_type(2)));
__device__ __forceinline__ f32x2 gelu_pk(f32x2 v) {
    const f32x2 av = __builtin_elementwise_abs(v), d = av * 0.2316418882f + 1.0f;
    f32x2 t; t.x = __builtin_amdgcn_rcpf(d.x); t.y = __builtin_amdgcn_rcpf(d.y);
    f32x2 q = t * 0.5307027145f + (-0.7265760135f); q = q * t + 0.7107068705f; q = q * t + (-0.142248368f); q = q * t + 0.127414796f; q = q * t;
    const f32x2 s = (v * v) * (-0.72134752044f);
    f32x2 e; e.x = __builtin_amdgcn_exp2f(s.x); e.y = __builtin_amdgcn_exp2f(s.y);
    const f32x2 m = v * (q * e), r = v - m;
    f32x2 o; o.x = v.x < 0.f ? m.x : r.x; o.y = v.y < 0.f ? m.y : r.y; return o;
}

template <int ACT  > struct EpiBf16 {
    static constexpr bool PERM = true, AFTER_DRAIN = false, SEG = false; static_assert(ACT == 0 || ACT == 1, "EpiBf16: ACT is 0 (none) or 1 (gelu_pk)");
    bf16_t* O; int ldc; const float* bias; int split_cols; size_t split_stride; float scale0;
    __device__ __forceinline__ void operator()(const f32x4 (&acc)[2][2][4][2], const Unit& u, int wr, int wc, int fr, int fq) const {
        const int row0 = u.pm * BM + wr * 64 + fr; int colt = u.pn * BM; bf16_t* base = O;
        float sc = 1.f; if (split_cols) { const int t = colt / split_cols; base += (size_t)t * split_stride; colt -= t * split_cols; if (t == 0) sc = scale0; }
        const int col0 = colt + wc * 32 + 8 * fq, bcol0 = u.pn * BM + wc * 32 + 8 * fq;
        f32x4 bv[2][2];
#pragma unroll
        for (int bj = 0; bj < 2; ++bj)
#pragma unroll
            for (int n = 0; n < 2; ++n) bv[bj][n] = bias ? *(const f32x4*)(bias + bcol0 + bj * HALF + 4 * n) : (f32x4){0.f, 0.f, 0.f, 0.f};
#pragma unroll
        for (int ai = 0; ai < 2; ++ai)
#pragma unroll
            for (int m = 0; m < 4; ++m) { bf16_t* rowp = base + (size_t)(row0 + ai * HALF + m * 16) * ldc + col0;
#pragma unroll
                for (int bj = 0; bj < 2; ++bj) { f32x4 v0 = acc[ai][bj][m][0] + bv[bj][0], v1 = acc[ai][bj][m][1] + bv[bj][1];
                    if (ACT == 1) { f32x2 a = gelu_pk((f32x2){v0[0], v0[1]}), b = gelu_pk((f32x2){v0[2], v0[3]}), c = gelu_pk((f32x2){v1[0], v1[1]}), d = gelu_pk((f32x2){v1[2], v1[3]});
                        v0 = (f32x4){a.x, a.y, b.x, b.y}; v1 = (f32x4){c.x, c.y, d.x, d.y}; }
                    v0 = v0 * sc; v1 = v1 * sc; u32x4 w; w.x = cvt_pk_bf16(v0[0], v0[1]); w.y = cvt_pk_bf16(v0[2], v0[3]); w.z = cvt_pk_bf16(v1[0], v1[1]); w.w = cvt_pk_bf16(v1[2], v1[3]);
                    *(u32x4*)(rowp + bj * HALF) = w; } }
    }
};
template <class Epi, class Sched, bool ALIGN_EPI = false, bool SP2 = false, bool F8 = false>
__device__ __forceinline__ void gemm_phase(PG8_LAS unsigned char* lds, const Gemm g, const Sched& S, const Epi& E) {
    int tid_ = threadIdx.x; asm volatile("" : "+v"(tid_));
    const int tid = tid_, wid = __builtin_amdgcn_readfirstlane(tid >> 6), lane = tid & 63, wr = wid >> 2, wc = wid & 3, fr = lane & 15, fq = lane >> 4;
    const int K = g.K, nt = K / BK;
    unsigned voffA[2], voffB[2];
#pragma unroll
    for (int i = 0; i < 2; ++i) { int R, C; stage_rc(tid * 16 + i * 8192, R, C); const int Rb = Epi::PERM ? ((R & ~31) + perm32(R & 31)) : R;
        voffA[i] = (unsigned)(R * K + C) * 2u; voffB[i] = (unsigned)(Rb * K + C) * 2u; }
    const size_t kstep = (size_t)(BK * 2);
    const size_t hstep = (size_t)HALF * K * 2;
    const size_t tstep = 2 * hstep;
    const unsigned ldsw = (unsigned)wid * 1024u;
    const int aoff = lds_byte(wr * 64 + fr, fq * 8), boff = lds_byte(wc * 32 + fr, fq * 8);
#define PG8_SA(b, h) (((b) * 2 + (h)) * HTB)
#define PG8_SB(b, h) ((4 + (b) * 2 + (h)) * HTB)
#define PG8_STAGE(bufoff, gbase, voff) do { _Pragma("unroll") for (int _i = 0; _i < 2; ++_i) \
        __builtin_amdgcn_global_load_lds((const unsigned*)((const char*)(gbase) + (voff)[_i]), (PG8_LAS unsigned*)(lds + (bufoff) + ldsw + _i * 8192), 16, 0, 0); } while (0)
#define PG8_LDA(dst, b, h) do { _Pragma("unroll") for (int m = 0; m < 4; ++m) _Pragma("unroll") for (int k = 0; k < 2; ++k) dst[m][k] = *(const PG8_LAS bf16x8*)(lds + PG8_SA(b, h) + aoff + m * 2048 + k * 1024); } while (0)
#define PG8_LDB(dst, b, h) do { _Pragma("unroll") for (int n = 0; n < 2; ++n) _Pragma("unroll") for (int k = 0; k < 2; ++k) dst[n][k] = *(const PG8_LAS bf16x8*)(lds + PG8_SB(b, h) + boff + n * 2048 + k * 1024); } while (0)
#define PG8_MMA(ai, bj, At, Bt) do { __builtin_amdgcn_s_setprio(1); _Pragma("unroll") for (int m = 0; m < 4; ++m) _Pragma("unroll") for (int n = 0; n < 2; ++n) { \
        if constexpr (F8) { typedef int v8i_ __attribute__((ext_vector_type(8))); typedef int v4i_ __attribute__((ext_vector_type(4))); \
            const v4i_ b0_ = __builtin_bit_cast(v4i_, Bt[n][0]), b1_ = __builtin_bit_cast(v4i_, Bt[n][1]), a0_ = __builtin_bit_cast(v4i_, At[m][0]), a1_ = __builtin_bit_cast(v4i_, At[m][1]); \
            const v8i_ bb_ = {b0_.x, b0_.y, b0_.z, b0_.w, b1_.x, b1_.y, b1_.z, b1_.w}, aa_ = {a0_.x, a0_.y, a0_.z, a0_.w, a1_.x, a1_.y, a1_.z, a1_.w}; \
            asm volatile("v_mfma_scale_f32_16x16x128_f8f6f4 %0, %1, %2, %0, %3, %3 op_sel_hi:[0,0,0]" : "+v"(acc[ai][bj][m][n]) : "v"(bb_), "v"(aa_), "v"(f8one)); } \
        else { _Pragma("unroll") for (int k = 0; k < 2; ++k) acc[ai][bj][m][n] = __builtin_amdgcn_mfma_f32_16x16x32_bf16(Bt[n][k], At[m][k], acc[ai][bj][m][n], 0, 0, 0); } } \
        __builtin_amdgcn_s_setprio(0); } while (0)
#define PG8_WAIT_V(n) asm volatile("s_waitcnt vmcnt(" #n ")" ::: "memory")
#define PG8_WAIT_L(n) asm volatile("s_waitcnt lgkmcnt(" #n ")" ::: "memory")
#define PG8_BAR __builtin_amdgcn_s_barrier()
#define PG8_SCHED __builtin_amdgcn_sched_barrier(0)
    Unit cur, nxt; int ui = 0;
    if (!S.next(0, cur)) return;
    f32x4 acc[2][2][4][2];
    const int f8one = 0x7f7f7f7f;
#pragma unroll
    for (int a = 0; a < 2; ++a)
#pragma unroll
        for (int b = 0; b < 2; ++b)
#pragma unroll
            for (int m = 0; m < 4; ++m)
#pragma unroll
                for (int n = 0; n < 2; ++n) acc[a][b][m][n] = (f32x4){0.f, 0.f, 0.f, 0.f};
    bf16x8 At[4][2], B0[2][2], B1[2][2];
    const char* cA = (const char*)g.A + (size_t)cur.pm * tstep; const char* cB = (const char*)g.Bt + (size_t)cur.pn * tstep;
    S.a_ready(cur);
    float segr[16];
    if constexpr (Epi::SEG) E.seg_load(ui, wr, fr, segr);
    if constexpr (SP2) {
        PG8_STAGE(PG8_SB(0, 0), cB, voffB); PG8_STAGE(PG8_SB(0, 1), cB + hstep, voffB); PG8_STAGE(PG8_SA(0, 0), cA, voffA); PG8_STAGE(PG8_SA(0, 1), cA + hstep, voffA);
        if (wr == 1) PG8_BAR;
        PG8_WAIT_V(2); PG8_BAR;
        PG8_STAGE(PG8_SB(1, 0), cB + kstep, voffB); PG8_STAGE(PG8_SA(1, 0), cA + kstep, voffA); PG8_STAGE(PG8_SB(1, 1), cB + hstep + kstep, voffB);
        PG8_WAIT_V(6); PG8_BAR;
    } else {
        PG8_STAGE(PG8_SB(0, 0), cB, voffB); PG8_STAGE(PG8_SA(0, 0), cA, voffA); PG8_STAGE(PG8_SB(0, 1), cB + hstep, voffB); PG8_STAGE(PG8_SA(0, 1), cA + hstep, voffA);
        if (wr == 1) PG8_BAR;
        PG8_WAIT_V(4); PG8_BAR;
        PG8_STAGE(PG8_SB(1, 0), cB + kstep, voffB); PG8_STAGE(PG8_SA(1, 0), cA + kstep, voffA); PG8_STAGE(PG8_SB(1, 1), cB + hstep + kstep, voffB);
        PG8_WAIT_V(6); PG8_BAR;
    }
    for (;;) {
        const bool has_next = S.next(ui + 1, nxt);
        const char* nA = has_next ? (const char*)g.A + (size_t)nxt.pm * tstep : cA; const char* nB = has_next ? (const char*)g.Bt + (size_t)nxt.pn * tstep : cB;
        int t = 0;
#pragma unroll 1
        for (int sgi = 0; sgi < (Epi::SEG ? 3 : 1); ++sgi) {
        int tend = nt; if constexpr (Epi::SEG) tend = (sgi == 0) ? Epi::SEG_T1 : ((sgi == 1) ? Epi::SEG_T2 : nt);
        for (; t < tend; t += 2) {
            const bool last = (t == nt - 2);
            const char* a1 = cA + (size_t)(t + 1) * kstep;
            const char* a2 = last ? nA : cA + (size_t)(t + 2) * kstep; const char* b2 = last ? nB : cB + (size_t)(t + 2) * kstep;
            const char* a3 = a2 + kstep; const char* b3 = b2 + kstep;
            if (last && has_next) S.a_ready(nxt);
            if constexpr (SP2) {
            PG8_LDB(B0, 0, 0); PG8_LDB(B1, 0, 1); PG8_SCHED; PG8_LDA(At, 0, 0); PG8_STAGE(PG8_SA(1, 1), a1 + hstep, voffA);
            PG8_WAIT_V(8); PG8_WAIT_L(0); PG8_BAR; PG8_MMA(0, 0, At, B0); PG8_MMA(0, 1, At, B1); PG8_BAR; PG8_SCHED;
            PG8_LDA(At, 0, 1); PG8_STAGE(PG8_SB(0, 0), b2, voffB); PG8_STAGE(PG8_SB(0, 1), b2 + hstep, voffB); PG8_STAGE(PG8_SA(0, 0), a2, voffA);
            PG8_WAIT_V(8); PG8_WAIT_L(0); PG8_BAR; PG8_MMA(1, 0, At, B0); PG8_MMA(1, 1, At, B1); PG8_BAR; PG8_SCHED;
            PG8_LDB(B0, 1, 0); PG8_LDB(B1, 1, 1); PG8_SCHED; PG8_LDA(At, 1, 0); PG8_STAGE(PG8_SA(0, 1), a2 + hstep, voffA);
            PG8_WAIT_V(8); PG8_WAIT_L(0); PG8_BAR; PG8_MMA(0, 0, At, B0); PG8_MMA(0, 1, At, B1); PG8_BAR; PG8_SCHED;
            PG8_LDA(At, 1, 1); PG8_STAGE(PG8_SB(1, 0), b3, voffB); PG8_STAGE(PG8_SB(1, 1), b3 + hstep, voffB); PG8_STAGE(PG8_SA(1, 0), a3, voffA);
            PG8_WAIT_V(8); PG8_WAIT_L(0); PG8_BAR; PG8_MMA(1, 0, At, B0); PG8_MMA(1, 1, At, B1); PG8_BAR; PG8_SCHED;
            } else {
            PG8_LDB(B0, 0, 0); PG8_SCHED; PG8_LDA(At, 0, 0); PG8_STAGE(PG8_SA(1, 1), a1 + hstep, voffA);
            PG8_WAIT_L(8); PG8_BAR; PG8_WAIT_L(0); PG8_MMA(0, 0, At, B0); PG8_BAR; PG8_SCHED;
            PG8_LDB(B1, 0, 1); PG8_STAGE(PG8_SB(0, 0), b2, voffB);
            PG8_BAR; PG8_WAIT_L(0); PG8_MMA(0, 1, At, B1); PG8_BAR;
            PG8_LDA(At, 0, 1); PG8_STAGE(PG8_SA(0, 0), a2, voffA);
            PG8_BAR; PG8_WAIT_L(0); PG8_MMA(1, 0, At, B0); PG8_BAR; PG8_SCHED;
            PG8_STAGE(PG8_SB(0, 1), b2 + hstep, voffB);
            PG8_WAIT_V(6); PG8_BAR; PG8_MMA(1, 1, At, B1); PG8_BAR;
            PG8_LDB(B0, 1, 0); PG8_SCHED; PG8_LDA(At, 1, 0); PG8_STAGE(PG8_SA(0, 1), a2 + hstep, voffA);
            PG8_WAIT_L(8); PG8_BAR; PG8_WAIT_L(0); PG8_MMA(0, 0, At, B0); PG8_BAR; PG8_SCHED;
            PG8_LDB(B1, 1, 1); PG8_STAGE(PG8_SB(1, 0), b3, voffB);
            PG8_BAR; PG8_WAIT_L(0); PG8_MMA(0, 1, At, B1); PG8_BAR;
            PG8_LDA(At, 1, 1); PG8_STAGE(PG8_SA(1, 0), a3, voffA);
            PG8_BAR; PG8_WAIT_L(0); PG8_MMA(1, 0, At, B0); PG8_BAR; PG8_SCHED;
            PG8_STAGE(PG8_SB(1, 1), b3 + hstep, voffB);
            PG8_WAIT_V(6); PG8_BAR; PG8_MMA(1, 1, At, B1); PG8_BAR;
            }
        }
        if constexpr (Epi::SEG) E.seg_apply(acc, segr, sgi);
        }
        if constexpr (ALIGN_EPI) { if (wr == 0) PG8_BAR; }
        if constexpr (!Epi::AFTER_DRAIN) { if constexpr (Epi::SEG) E(acc, cur, wr, wc, fr, fq, ui); else E(acc, cur, wr, wc, fr, fq); S.done(cur); }
        if (!has_next) break;
#pragma unroll
        for (int a = 0; a < 2; ++a)
#pragma unroll
            for (int b = 0; b < 2; ++b)
#pragma unroll
                for (int m = 0; m < 4; ++m)
#pragma unroll
                    for (int n = 0; n < 2; ++n) acc[a][b][m][n] = (f32x4){0.f, 0.f, 0.f, 0.f};
        cur = nxt; cA = nA; cB = nB; ++ui;
        if constexpr (Epi::SEG) E.seg_load(ui, wr, fr, segr);
        if constexpr (ALIGN_EPI) { if (wr == 1) PG8_BAR; }
    }
    PG8_WAIT_V(0);
    if constexpr (!ALIGN_EPI) { if (wr == 0) PG8_BAR; }
    PG8_BAR;
    if constexpr (Epi::AFTER_DRAIN) { E.fused(acc, cur, wr, wc, fr, fq, lds, wid, lane); S.done(cur); }
#undef PG8_SA
#undef PG8_SB
#undef PG8_STAGE
#undef PG8_LDA
#undef PG8_LDB
#undef PG8_MMA
#undef PG8_WAIT_V
#undef PG8_WAIT_L
#undef PG8_BAR
#undef PG8_SCHED
}
}
#ifndef PG8_SP2
#define PG8_SP2 true
#endif
#ifndef PG8_ALIGN
#define PG8_ALIGN true
#endif

constexpr int BATCH = 8, SEQ = 2048, DM = 2048, MTOK = BATCH * SEQ;
constexpr int ATT_W = 1024, ATT_H = 8, ATT_HD = 128, MOBA_BLK = 256, NBLK = SEQ / MOBA_BLK;
constexpr int SSM_W = 1024, SSM_H = 16, SSM_P = 64, SSM_N = 128, SSM_L = 128, SSM_NC = SEQ / SSM_L, CONV_CH = 1536;
constexpr int IN_PROJ = 5648, NPROJ = 5632  , NPAD = 5888  ;
constexpr int F8_LO = 2048, F8_HI = 4096, NB16 = NPAD - (F8_HI - F8_LO)  ;
constexpr float SH8 = 16.f;
constexpr int COL_Q = 0, COL_K = 1024, COL_V = 2048, COL_Z = 3072, COL_XBC = 4096;
constexpr int PEER_H = 8, PEER_NK = 128, PEER_K = 16, PEER_HK = 128;
constexpr float EPS = 1e-6f;
constexpr float SU = 64.f, SV = 4.f, SH = 16.f, SLO = 16.f;
constexpr float SX8 = 16.f, SW8 = 1024.f;
constexpr float SA8 = 32.f, SS8 = 8.f;
constexpr float SH4 = 1.5f, SLO4 = 4.f;
constexpr int ROWB = DM / 2;

constexpr size_t MiB = 1u << 20;
constexpr size_t WS_CTL = 0, CTL_ZERO_BYTES = 1 * MiB;
constexpr size_t WS_DT = 1 * MiB;
constexpr size_t WS_SK = 2 * MiB;
constexpr size_t WS_WIN = 4 * MiB;
constexpr size_t WS_WIN8 = 24 * MiB;
constexpr size_t WS_HN8 = 396 * MiB;
constexpr size_t WS_WOUT = 28 * MiB;
constexpr size_t WS_WQ = 36 * MiB;
constexpr size_t WS_HN = 44 * MiB;
constexpr size_t WS_PROJ = 108 * MiB;
constexpr size_t WS_X1B = WS_PROJ, WS_QP = WS_PROJ + 64 * MiB;
constexpr size_t WS_U8 = 284 * MiB, WS_V8 = 316 * MiB;
constexpr size_t WS_XBC = 348 * MiB;
constexpr size_t WS_DT2 = 3 * MiB;
constexpr size_t WS_X18 = 396 * MiB;
constexpr size_t WS_END = 428 * MiB;
constexpr int CW_BAR = 4096;
constexpr int CW_Q2 = 8192;
constexpr int CW_KMEAN = 32768;
constexpr int CW_SSQ = 131072;
static_assert((CW_SSQ + MTOK * 4) * 4 <= (int)CTL_ZERO_BYTES, "CTL words inside the memset region");

constexpr int RING_OFF = 0, RING_BYTES = 131072;
constexpr int LDSCTL_OFF = RING_BYTES, MISC_OFF = LDSCTL_OFF + 320;
constexpr int SEGTAB_OFF = LDSCTL_OFF + 1024;  static_assert(LDSCTL_OFF + 1024 + 3 * 256 * 16 <= 147456, "segment table inside the LDS allocation");
constexpr int LDS_BYTES = 147456;
constexpr int NWAVES = 8;

#define GAS __attribute__((address_space(1)))
#define LAS __attribute__((address_space(3)))
typedef unsigned short bf16;
typedef unsigned v4u __attribute__((ext_vector_type(4)));
typedef unsigned v2u __attribute__((ext_vector_type(2)));
typedef float f32x4 __attribute__((ext_vector_type(4)));
typedef float f32x2 __attribute__((ext_vector_type(2)));
typedef short bf16x8 __attribute__((ext_vector_type(8)));
typedef short s16x4 __attribute__((ext_vector_type(4)));
typedef GAS unsigned gu32;
#define RLX_AGENT __ATOMIC_RELAXED, __HIP_MEMORY_SCOPE_AGENT
#define LDS_WAIT() asm volatile("s_waitcnt lgkmcnt(0)" ::: "memory")
#define VM_WAIT() asm volatile("s_waitcnt vmcnt(0)" ::: "memory")
__device__ __forceinline__ unsigned f2bf(float f) { unsigned u = __builtin_bit_cast(unsigned, f); return (u + 0x7fffu + ((u >> 16) & 1u)) >> 16; }
typedef __bf16 bf16v2 __attribute__((ext_vector_type(2)));
__device__ __forceinline__ unsigned pk2(float lo, float hi) { bf16v2 v; v.x = (__bf16)lo; v.y = (__bf16)hi; return __builtin_bit_cast(unsigned, v); }
__device__ __forceinline__ float bflo(unsigned w) { return __builtin_bit_cast(float, w << 16); }
__device__ __forceinline__ float bfhi(unsigned w) { return __builtin_bit_cast(float, w & 0xffff0000u); }
__device__ __forceinline__ float wave_sum(float v) {
#pragma unroll
    for (int o = 1; o < 64; o <<= 1) v += __shfl_xor(v, o);
    return v;
}
__device__ __forceinline__ float silu_f(float x) { return x * __builtin_amdgcn_rcpf(1.f + __expf(-x)); }

#define XB_TMO      128
#define XB_XCNT(j)  (256  + 64 * (j))
#define XB_XSUB(j)  (1280 + 64 * (j))
#define XB_XGEN(j)  (2304 + 64 * (j))
#define XB_TOP      3328
#define XB_TOPGEN   3392
#define XCD_BAR_WORDS 3456
#define XB_SPIN_CAP (1u << 18)

__device__ __forceinline__ unsigned xb_ld(unsigned* p)              { return __hip_atomic_load(p, __ATOMIC_RELAXED, __HIP_MEMORY_SCOPE_AGENT); }
__device__ __forceinline__ unsigned xb_add(unsigned* p, unsigned v) { return __hip_atomic_fetch_add(p, v, __ATOMIC_RELAXED, __HIP_MEMORY_SCOPE_AGENT); }
__device__ __forceinline__ unsigned xb_xcc_id() { return (unsigned)__builtin_amdgcn_s_getreg((3 << 11) | 20) & 0xFu; }
#define XB_SPIN(cond, bar) do { unsigned _sp = 0; while (cond) { __builtin_amdgcn_s_sleep(1); \
    if ((++_sp & 255u) == 0u) { if (xb_ld(&(bar)[XB_TMO])) break; if (_sp > XB_SPIN_CAP) { atomicAdd(&(bar)[XB_TMO], 1u); break; } } } } while (0)

struct XcdBarrier {
    unsigned* bar; unsigned x;
    volatile LAS unsigned* st;
};
__device__ __forceinline__ XcdBarrier xcd_barrier_post(unsigned* bar, volatile LAS unsigned* st) {
    XcdBarrier b; b.bar = bar; b.x = xb_xcc_id(); b.st = st;
    if (threadIdx.x == 0) (void)xb_add(&bar[XB_XCNT(b.x)], 1u);
    return b;
}
__device__ __forceinline__ void xcd_barrier_complete(unsigned* bar, unsigned x, unsigned& nloc, unsigned& nx) {
    const unsigned G = gridDim.x * gridDim.y * gridDim.z;
    unsigned sum, cnt, mine, sp = 0u;
    for (;;) {
        sum = 0u; cnt = 0u; mine = 0u;
#pragma unroll
        for (unsigned j = 0; j < 16; ++j) { const unsigned c = xb_ld(&bar[XB_XCNT(j)]); sum += c; cnt += (c > 0u) ? 1u : 0u; mine = (j == x) ? c : mine; }
        if (sum == G) break;
        __builtin_amdgcn_s_sleep(1);
        if ((++sp & 255u) == 0u) { if (xb_ld(&bar[XB_TMO])) break; if (sp > XB_SPIN_CAP) { atomicAdd(&bar[XB_TMO], 1u); break; } }
    }
    nloc = mine > 0u ? mine : 1u; nx = cnt > 0u ? cnt : 1u;
}
__device__ __forceinline__ void xcd_barrier(const XcdBarrier& b) {
    asm volatile("s_waitcnt vmcnt(0)" ::: "memory");
    __syncthreads();
    if (threadIdx.x == 0) {
        unsigned* bar = b.bar;
        __builtin_amdgcn_s_waitcnt(0);
        unsigned nloc = b.st[0], nx = b.st[1];
        if (nloc == 0u) { xcd_barrier_complete(bar, b.x, nloc, nx); b.st[0] = nloc; b.st[1] = nx; }
        const unsigned old = xb_add(&bar[XB_XSUB(b.x)], 1u);
        const unsigned gen = old / nloc;
        if (old + 1u == (gen + 1u) * nloc) {
            __builtin_amdgcn_fence(__ATOMIC_RELEASE, "agent");
            asm volatile("s_waitcnt vmcnt(0)" ::: "memory");
            const unsigned og = xb_add(&bar[XB_TOP], 1u);
            const unsigned tg = og / nx;
            if (og + 1u == (tg + 1u) * nx) xb_add(&bar[XB_TOPGEN], 1u);
            else XB_SPIN(xb_ld(&bar[XB_TOPGEN]) == tg, bar);
            __builtin_amdgcn_fence(__ATOMIC_ACQUIRE, "agent");
            xb_add(&bar[XB_XGEN(b.x)], 1u);
            asm volatile("s_waitcnt vmcnt(0)" ::: "memory");
        } else {
            XB_SPIN(xb_ld(&bar[XB_XGEN(b.x)]) == gen, bar);
            __builtin_amdgcn_fence(__ATOMIC_ACQUIRE, "agent");
            asm volatile("s_waitcnt vmcnt(0)" ::: "memory");
        }
    }
    __syncthreads();
}

#define CAS __attribute__((address_space(4)))
struct Args { const float* in[18]; float* out; unsigned char* ws; };
__device__ __forceinline__ const CAS unsigned char* kargs() { const CAS unsigned char* p = (const CAS unsigned char*)__builtin_amdgcn_kernarg_segment_ptr(); asm volatile("" : "+s"(p)); return p; }
__device__ __forceinline__ const float* kin(int i) { return *(const float* const CAS*)(kargs() + 8 * i); }
__device__ __forceinline__ float* kout() { return *(float* const CAS*)(kargs() + 8 * 18); }
__device__ __forceinline__ unsigned char* kws() { return *(unsigned char* const CAS*)(kargs() + 8 * 19); }
__device__ __forceinline__ int fresh_tid() { int t = threadIdx.x; asm volatile("" : "+v"(t)); return t; }
struct Frame {
    LAS unsigned char* lds;
    volatile LAS unsigned* MISC;
    int tid, lane, wave, G;
    __device__ __forceinline__ const float* x() const { return kin(0); }
    __device__ __forceinline__ const float* attn_norm() const { return kin(1); }
    __device__ __forceinline__ const float* w_in() const { return kin(2); }
    __device__ __forceinline__ const float* conv_w() const { return kin(3); }
    __device__ __forceinline__ const float* conv_b() const { return kin(4); }
    __device__ __forceinline__ const float* dt_bias() const { return kin(5); }
    __device__ __forceinline__ const float* a_log() const { return kin(6); }
    __device__ __forceinline__ const float* d_skip() const { return kin(7); }
    __device__ __forceinline__ const float* rel_bias() const { return kin(8); }
    __device__ __forceinline__ const float* attn_out_norm() const { return kin(9); }
    __device__ __forceinline__ const float* ssm_out_norm() const { return kin(10); }
    __device__ __forceinline__ const float* w_out() const { return kin(11); }
    __device__ __forceinline__ const float* ffn_norm() const { return kin(12); }
    __device__ __forceinline__ const float* peer_wq() const { return kin(13); }
    __device__ __forceinline__ const float* peer_sk() const { return kin(14); }
    __device__ __forceinline__ const float* peer_u() const { return kin(15); }
    __device__ __forceinline__ const float* peer_v() const { return kin(16); }
    __device__ __forceinline__ const float* final_norm() const { return kin(17); }
    __device__ __forceinline__ float* out() const { return kout(); }
    __device__ __forceinline__ unsigned* ctl() const { return (unsigned*)(kws() + WS_CTL); }
    __device__ __forceinline__ float* dtraw() const { return (float*)(kws() + WS_DT); }
    __device__ __forceinline__ bf16* SK() const { return (bf16*)(kws() + WS_SK); }
    __device__ __forceinline__ bf16* WinT() const { return (bf16*)(kws() + WS_WIN); }
    __device__ __forceinline__ bf16* WoutT() const { return (bf16*)(kws() + WS_WOUT); }
    __device__ __forceinline__ bf16* WqT() const { return (bf16*)(kws() + WS_WQ); }
    __device__ __forceinline__ bf16* HN() const { return (bf16*)(kws() + WS_HN); }
    __device__ __forceinline__ bf16* PROJ() const { return (bf16*)(kws() + WS_PROJ); }
    __device__ __forceinline__ bf16* X1B() const { return (bf16*)(kws() + WS_X1B); }
    __device__ __forceinline__ bf16* QP() const { return (bf16*)(kws() + WS_QP); }
    __device__ __forceinline__ unsigned char* U8() const { return kws() + WS_U8; }
    __device__ __forceinline__ unsigned char* V8() const { return kws() + WS_V8; }
    __device__ __forceinline__ unsigned char* X18() const { return kws() + WS_X18; }
    __device__ __forceinline__ unsigned char* HN8() const { return kws() + WS_HN8; }
    __device__ __forceinline__ unsigned char* WinT8() const { return kws() + WS_WIN8; }
    __device__ __forceinline__ bf16* XBC() const { return (bf16*)(kws() + WS_XBC); }
    __device__ __forceinline__ float* DT2() const { return (float*)(kws() + WS_DT2); }
    __device__ __forceinline__ float* kmean() const { return (float*)(kws() + WS_CTL) + CW_KMEAN; }
    __device__ __forceinline__ float* ssq() const { return (float*)(kws() + WS_CTL) + CW_SSQ; }
};

__device__ __forceinline__ float clampf(float v, float lim);
__device__ __forceinline__ void p0_transpose_item(const float* W, int K, int N, bf16* WT, const float* gain, LAS float* scr, int item, int lane, const float f8scale = 0.f, const int nshift = 0) {
    const int nblk = (N + 31) / 32, kb = item / nblk, nb = item % nblk, k0 = 64 * kb, n0 = 32 * nb;
    const int kr = lane >> 3, nc = (lane & 7) * 4; const bool ok = (n0 + nc) < N;
    f32x4 v[8]; float gk[8];
#pragma unroll
    for (int i = 0; i < 8; ++i) { const int kk = 8 * i + kr; v[i] = ok ? *(const GAS f32x4*)(W + (size_t)(k0 + kk) * N + n0 + nc) : (f32x4){0.f, 0.f, 0.f, 0.f}; gk[i] = gain ? gain[k0 + kk] : 1.f; }
#pragma unroll
    for (int i = 0; i < 8; ++i) { const int kk = 8 * i + kr; LAS float* d = scr + kk * 33 + nc; d[0] = v[i].x * gk[i]; d[1] = v[i].y * gk[i]; d[2] = v[i].z * gk[i]; d[3] = v[i].w * gk[i]; }
    LDS_WAIT(); asm volatile("" ::: "memory");
    const int c = lane & 7;
#pragma unroll
    for (int j = 0; j < 4; ++j) { const int n = (lane >> 3) + 8 * j; const LAS float* s = scr + (8 * c) * 33 + n;
        v4u o; o.x = pk2(s[0 * 33], s[1 * 33]); o.y = pk2(s[2 * 33], s[3 * 33]); o.z = pk2(s[4 * 33], s[5 * 33]); o.w = pk2(s[6 * 33], s[7 * 33]);
        if (f8scale == 0.f) *(GAS v4u*)(WT + (size_t)(n0 + n - nshift) * K + k0 + 8 * c) = o;
        else { v2u o8; int w_;
            w_ = __builtin_amdgcn_cvt_pk_fp8_f32(clampf(s[0 * 33] * f8scale, 448.f), clampf(s[1 * 33] * f8scale, 448.f), 0, false); w_ = __builtin_amdgcn_cvt_pk_fp8_f32(clampf(s[2 * 33] * f8scale, 448.f), clampf(s[3 * 33] * f8scale, 448.f), w_, true); o8.x = (unsigned)w_;
            w_ = __builtin_amdgcn_cvt_pk_fp8_f32(clampf(s[4 * 33] * f8scale, 448.f), clampf(s[5 * 33] * f8scale, 448.f), 0, false); w_ = __builtin_amdgcn_cvt_pk_fp8_f32(clampf(s[6 * 33] * f8scale, 448.f), clampf(s[7 * 33] * f8scale, 448.f), w_, true); o8.y = (unsigned)w_;
            *(GAS v2u*)((unsigned char*)WT + (size_t)(n0 + n - nshift) * K + k0 + 8 * c) = o8; } }
    LDS_WAIT(); asm volatile("" ::: "memory");
}
__device__ __forceinline__ unsigned pk4_fp8(float a, float b, float c, float d) { int w = __builtin_amdgcn_cvt_pk_fp8_f32(clampf(a, 448.f), clampf(b, 448.f), 0, false); w = __builtin_amdgcn_cvt_pk_fp8_f32(clampf(c, 448.f), clampf(d, 448.f), w, true); return (unsigned)w; }
__device__ __forceinline__ void rms_2rows_to_bf16(const float* x0, const float* x1, const float* gain, bf16* o0, bf16* o1, unsigned char* q0, unsigned char* q1, int lane) {
    const GAS f32x4* xr0 = (const GAS f32x4*)x0 + lane; const GAS f32x4* xr1 = (const GAS f32x4*)x1 + lane; const GAS f32x4* gr = (const GAS f32x4*)gain + lane;
    f32x4 v[8], u[8]; float s = 0.f, t = 0.f;
#pragma unroll
    for (int j = 0; j < 8; ++j) { v[j] = xr0[64 * j]; u[j] = xr1[64 * j]; }
#pragma unroll
    for (int j = 0; j < 8; ++j) { s += (v[j].x * v[j].x + v[j].y * v[j].y) + (v[j].z * v[j].z + v[j].w * v[j].w); t += (u[j].x * u[j].x + u[j].y * u[j].y) + (u[j].z * u[j].z + u[j].w * u[j].w); }
    const float rs = __builtin_amdgcn_rsqf(wave_sum(s) * (1.f / DM) + EPS), rt = __builtin_amdgcn_rsqf(wave_sum(t) * (1.f / DM) + EPS);
    GAS v2u* p0 = (GAS v2u*)o0 + lane; GAS v2u* p1 = (GAS v2u*)o1 + lane; GAS unsigned* r0 = (GAS unsigned*)q0 + lane; GAS unsigned* r1 = (GAS unsigned*)q1 + lane;
#pragma unroll
    for (int j = 0; j < 8; ++j) { const f32x4 g = gr[64 * j]; v2u a, b;
        const f32x4 h0 = v[j] * g * rs, h1 = u[j] * g * rt;
        a.x = pk2(h0.x, h0.y); a.y = pk2(h0.z, h0.w); p0[64 * j] = a; r0[64 * j] = pk4_fp8(h0.x * SH8, h0.y * SH8, h0.z * SH8, h0.w * SH8);
        b.x = pk2(h1.x, h1.y); b.y = pk2(h1.z, h1.w); p1[64 * j] = b; r1[64 * j] = pk4_fp8(h1.x * SH8, h1.y * SH8, h1.z * SH8, h1.w * SH8); }
}
#ifdef PROBE_FP4EMU
__device__ __forceinline__ float fp4grid(float y) { const float a = fabsf(y); float r;
    if (a <= 2.f) r = rintf(a * 2.f) * 0.5f; else if (a <= 4.f) r = rintf(a); else r = (a < 5.f) ? 4.f : 6.f;
    return copysignf(r, y); }
__device__ __forceinline__ float clampf(float v, float lim) { if (lim == 448.5f) return fp4grid(v * (1.f / 16.f)) * 16.f; return fminf(fmaxf(v, -lim), lim); }
#else
__device__ __forceinline__ float clampf(float v, float lim) { return fminf(fmaxf(v, -lim), lim); }
#endif
template <int TAB = 0> __device__ __forceinline__ v4u cvt16_fp8(const f32x4 a, const f32x4 b, const f32x4 c, const f32x4 d, float sc) {
    v4u o; int w; constexpr float LIM = TAB ? 448.5f : 448.f;
    w = __builtin_amdgcn_cvt_pk_fp8_f32(clampf(a.x * sc, LIM), clampf(a.y * sc, LIM), 0, false); w = __builtin_amdgcn_cvt_pk_fp8_f32(clampf(a.z * sc, LIM), clampf(a.w * sc, LIM), w, true); o.x = (unsigned)w;
    w = __builtin_amdgcn_cvt_pk_fp8_f32(clampf(b.x * sc, LIM), clampf(b.y * sc, LIM), 0, false); w = __builtin_amdgcn_cvt_pk_fp8_f32(clampf(b.z * sc, LIM), clampf(b.w * sc, LIM), w, true); o.y = (unsigned)w;
    w = __builtin_amdgcn_cvt_pk_fp8_f32(clampf(c.x * sc, LIM), clampf(c.y * sc, LIM), 0, false); w = __builtin_amdgcn_cvt_pk_fp8_f32(clampf(c.z * sc, LIM), clampf(c.w * sc, LIM), w, true); o.z = (unsigned)w;
    w = __builtin_amdgcn_cvt_pk_fp8_f32(clampf(d.x * sc, LIM), clampf(d.y * sc, LIM), 0, false); w = __builtin_amdgcn_cvt_pk_fp8_f32(clampf(d.z * sc, LIM), clampf(d.w * sc, LIM), w, true); o.w = (unsigned)w;
    return o;
}
__device__ __forceinline__ void tables_convert(Frame& F, size_t lo, size_t hi, size_t tix, size_t ntx) {
      const GAS f32x4* su = (const GAS f32x4*)F.peer_u(); const GAS f32x4* sv = (const GAS f32x4*)F.peer_v(); GAS v4u* du = (GAS v4u*)F.U8(); GAS v4u* dv = (GAS v4u*)F.V8();
#pragma unroll 1
      for (int tab = 0; tab < 2; ++tab) { const GAS f32x4* src = tab ? sv : su; GAS v4u* dst = tab ? dv : du; const float sc = tab ? SV : SU;
        f32x4 nx[8]; const size_t i0 = lo + tix;
        if (i0 < hi) { const GAS f32x4* p = src + (i0 >> 6) * 512 + (i0 & 63);
#pragma unroll
            for (int j = 0; j < 8; ++j) nx[j] = p[64 * j]; }
#pragma unroll 1
        for (size_t i = i0; i < hi; i += ntx) { f32x4 v[8];
#pragma unroll
            for (int j = 0; j < 8; ++j) v[j] = nx[j];
            if (i + ntx < hi) { const size_t i2 = i + ntx; const GAS f32x4* p = src + (i2 >> 6) * 512 + (i2 & 63);
#pragma unroll
                for (int j = 0; j < 8; ++j) nx[j] = p[64 * j]; }
            unsigned wd[4];
#pragma unroll
            for (int q = 0; q < 4; ++q) { const f32x4 a = v[2 * q] * sc, b = v[2 * q + 1] * sc; unsigned w = 0u;
                w = __builtin_amdgcn_cvt_scalef32_pk_fp4_f32(w, clampf(a.x, 6.f), clampf(a.y, 6.f), 1.0f, 0); w = __builtin_amdgcn_cvt_scalef32_pk_fp4_f32(w, clampf(a.z, 6.f), clampf(a.w, 6.f), 1.0f, 1);
                w = __builtin_amdgcn_cvt_scalef32_pk_fp4_f32(w, clampf(b.x, 6.f), clampf(b.y, 6.f), 1.0f, 2); w = __builtin_amdgcn_cvt_scalef32_pk_fp4_f32(w, clampf(b.z, 6.f), clampf(b.w, 6.f), 1.0f, 3); wd[q] = w; }
            dst[i] = (v4u){wd[0], wd[1], wd[2], wd[3]}; } }
}
constexpr size_t TAB_ITEMS = (size_t)16384 * 64;
__device__ __forceinline__ size_t tab_split(int G) { const int rem = ((MTOK / 256) * (NB16 / 256)) % G; return rem ? (TAB_ITEMS / 8) * 5 : TAB_ITEMS; }
__device__ __forceinline__ unsigned fp4_code(float y) { const float a = fabsf(y);
    const unsigned m = (unsigned)(a >= 0.25f) + (unsigned)(a >= 0.75f) + (unsigned)(a >= 1.25f) + (unsigned)(a >= 1.75f) + (unsigned)(a >= 2.5f) + (unsigned)(a >= 3.5f) + (unsigned)(a >= 5.0f);
    return m | ((y < 0.f) ? 8u : 0u); }
__device__ __forceinline__ void p0_prologue(Frame& F) {
    const int tid = fresh_tid(), lane = tid & 63, wave = __builtin_amdgcn_readfirstlane(tid >> 6);
    LAS float* scr = (LAS float*)(F.lds + RING_OFF + wave * 16384);
    const int gw = blockIdx.x * NWAVES + wave, NGW = F.G * NWAVES;
    constexpr int I_IN = (DM / 64) * ((IN_PROJ + 31) / 32), I_SQ = (DM / 64) * (DM / 32);
    constexpr int NITEMS = I_IN + 2 * I_SQ;
    { const float* const w_in = F.w_in(); const float* const w_out = F.w_out(); const float* const wq = F.peer_wq(); const float* const fg = F.ffn_norm(); bf16* const WinT = F.WinT(); unsigned char* const WinT8 = F.WinT8(); bf16* const WoutT = F.WoutT(); bf16* const WqT = F.WqT(); const float* const gatt = F.attn_out_norm(); const float* const gssm = F.ssm_out_norm();
      for (int it = gw; it < NITEMS; it += NGW) {
        int r = it;
        if (r < I_IN) { const int n0_ = 32 * (r % ((IN_PROJ + 31) / 32));
            if (n0_ >= F8_LO && n0_ < F8_HI) p0_transpose_item(w_in, DM, IN_PROJ, (bf16*)WinT8, nullptr, scr, r, lane, SW8, F8_LO);
            else p0_transpose_item(w_in, DM, IN_PROJ, WinT, nullptr, scr, r, lane, 0.f, (n0_ >= F8_HI) ? (F8_HI - F8_LO) : 0);
            continue; } r -= I_IN;
        if (r < I_SQ) { const int k0_ = 64 * (r / (DM / 32)); p0_transpose_item(w_out, DM, DM, WoutT, (k0_ < ATT_W) ? gatt : (gssm - ATT_W), scr, r, lane, SW8); continue; } r -= I_SQ;
        p0_transpose_item(wq, DM, DM, WqT, fg, scr, r, lane, SW8);
      } }
    const size_t gt = (size_t)blockIdx.x * (NWAVES * 64) + tid, GT = (size_t)F.G * NWAVES * 64;
    { const size_t z0 = (size_t)(5664 - (F8_HI - F8_LO)) * DM / 8, z1 = (size_t)NB16 * DM / 8; GAS v4u* p = (GAS v4u*)F.WinT(); for (size_t i = z0 + gt; i < z1; i += GT) p[i] = (v4u){0u, 0u, 0u, 0u}; }
    { const GAS f32x4* s = (const GAS f32x4*)F.peer_sk(); GAS v2u* d = (GAS v2u*)F.SK(); for (size_t i = gt; i < (size_t)16 * 128 * 128 / 4; i += GT) { const f32x4 v = s[i]; v2u o; o.x = pk2(v.x, v.y); o.y = pk2(v.z, v.w); d[i] = o; } }
    { const float* const xg = F.x(); const float* const gn = F.attn_norm(); bf16* const hn = F.HN(); unsigned char* const hn8 = F.HN8();
      for (int m = gw; m < MTOK / 2; m += NGW) rms_2rows_to_bf16(xg + (size_t)(2 * m) * DM, xg + (size_t)(2 * m + 1) * DM, gn, hn + (size_t)(2 * m) * DM, hn + (size_t)(2 * m + 1) * DM, hn8 + (size_t)(2 * m) * DM, hn8 + (size_t)(2 * m + 1) * DM, lane); }
    tables_convert(F, 0, tab_split(F.G), gt, GT);
}

struct EpiProj {
    static constexpr bool PERM = true, AFTER_DRAIN = false, SEG = false;
    bf16* O; float* dtraw; float* kmean;
    __device__ __forceinline__ void operator()(const pg8::f32x4 (&acc)[2][2][4][2], const pg8::Unit& u, int wr, int wc, int fr, int fq) const {
        const int rpn = (u.pn < F8_LO / 256) ? u.pn : u.pn + (F8_HI - F8_LO) / 256;
        const int row0 = u.pm * 256 + wr * 64 + fr, col0 = rpn * 256 + wc * 32 + 8 * fq;
        if (rpn < 22) {
#pragma unroll
            for (int ai = 0; ai < 2; ++ai)
#pragma unroll
                for (int m = 0; m < 4; ++m) { bf16* rowp = O + (size_t)(row0 + ai * 128 + m * 16) * NPROJ + col0;
#pragma unroll
                    for (int bj = 0; bj < 2; ++bj) { const pg8::f32x4 v0 = acc[ai][bj][m][0], v1 = acc[ai][bj][m][1];
                        pg8::u32x4 w; w.x = pg8::cvt_pk_bf16(v0[0], v0[1]); w.y = pg8::cvt_pk_bf16(v0[2], v0[3]); w.z = pg8::cvt_pk_bf16(v1[0], v1[1]); w.w = pg8::cvt_pk_bf16(v1[2], v1[3]);
                        *(pg8::u32x4*)(rowp + bj * 128) = w; } }
        } else if (wc == 0 && fq < 2) {
#pragma unroll
            for (int ai = 0; ai < 2; ++ai)
#pragma unroll
                for (int m = 0; m < 4; ++m) { float* rp = dtraw + (size_t)(row0 + ai * 128 + m * 16) * 16 + 8 * fq;
                    *(pg8::f32x4*)rp = acc[ai][0][m][0]; *(pg8::f32x4*)(rp + 4) = acc[ai][0][m][1]; }
        }
        if (kmean && u.pn >= 4 && u.pn < 8) {
#pragma unroll
            for (int bj = 0; bj < 2; ++bj)
#pragma unroll
                for (int n = 0; n < 2; ++n)
#pragma unroll
                    for (int i = 0; i < 4; ++i) { float s = 0.f;
#pragma unroll
                        for (int ai = 0; ai < 2; ++ai)
#pragma unroll
                            for (int m = 0; m < 4; ++m) s += acc[ai][bj][m][n][i];
                        s += __shfl_xor(s, 1); s += __shfl_xor(s, 2); s += __shfl_xor(s, 4); s += __shfl_xor(s, 8);
                        if (fr == 0) unsafeAtomicAdd(kmean + (size_t)u.pm * 1024 + (col0 - 1024) + bj * 128 + 4 * n + i, s); }
        }
    }
};
struct EpiProj8 {
    static constexpr bool PERM = true, AFTER_DRAIN = false, SEG = false;
    bf16* O;
    __device__ __forceinline__ void operator()(const pg8::f32x4 (&acc)[2][2][4][2], const pg8::Unit& u, int wr, int wc, int fr, int fq) const {
        const int row0 = u.pm * 256 + wr * 64 + fr, col0 = F8_LO + u.pn * 256 + wc * 32 + 8 * fq; constexpr float sc = 1.f / (SH8 * SW8);
#pragma unroll
        for (int ai = 0; ai < 2; ++ai)
#pragma unroll
            for (int m = 0; m < 4; ++m) { bf16* rowp = O + (size_t)(row0 + ai * 128 + m * 16) * NPROJ + col0;
#pragma unroll
                for (int bj = 0; bj < 2; ++bj) { const pg8::f32x4 v0 = acc[ai][bj][m][0] * sc, v1 = acc[ai][bj][m][1] * sc;
                    pg8::u32x4 w; w.x = pg8::cvt_pk_bf16(v0[0], v0[1]); w.y = pg8::cvt_pk_bf16(v0[2], v0[3]); w.z = pg8::cvt_pk_bf16(v1[0], v1[1]); w.w = pg8::cvt_pk_bf16(v1[2], v1[3]);
                    *(pg8::u32x4*)(rowp + bj * 128) = w; } }
    }
};
struct EpiOut {
    static constexpr bool PERM = true, AFTER_DRAIN = false, SEG = true; static constexpr int SEG_T1 = 8, SEG_T2 = 12;
    const float* x; bf16* x1b; unsigned char* x18; float* ssq; bool doatom; const LAS f32x4* tab;
    __device__ __forceinline__ void seg_load(int ui, int wr, int fr, float (&sr)[16]) const {
#pragma unroll
        for (int i = 0; i < 8; ++i) { const int r = (i >> 2) * 128 + wr * 64 + (i & 3) * 16 + fr; const f32x2 q = *(const LAS f32x2*)(tab + ui * 256 + r); sr[2 * i] = q.x; sr[2 * i + 1] = q.y; }
        asm volatile("s_waitcnt lgkmcnt(0)" ::: "memory");
    }
    __device__ __forceinline__ void seg_apply(pg8::f32x4 (&acc)[2][2][4][2], const float (&sr)[16], int which) const {
#pragma unroll
        for (int ai = 0; ai < 2; ++ai)
#pragma unroll
            for (int m = 0; m < 4; ++m) { const float f = (which == 0) ? sr[2 * (ai * 4 + m)] : ((which == 1) ? sr[2 * (ai * 4 + m) + 1] : 1.0f);
#pragma unroll
                for (int bj = 0; bj < 2; ++bj)
#pragma unroll
                    for (int n = 0; n < 2; ++n) acc[ai][bj][m][n] = acc[ai][bj][m][n] * f; }
    }
    __device__ __forceinline__ void operator()(const pg8::f32x4 (&acc)[2][2][4][2], const pg8::Unit& u, int wr, int wc, int fr, int fq, int ui) const {
        const int row0 = u.pm * 256 + wr * 64 + fr, col0 = u.pn * 256 + wc * 32 + 8 * fq;
#pragma unroll
        for (int ai = 0; ai < 2; ++ai)
#pragma unroll
            for (int m = 0; m < 4; ++m) { const int row = row0 + ai * 128 + m * 16; const size_t off = (size_t)row * DM + col0; float s = 0.f;
                const float s1 = (*(const LAS f32x4*)(tab + ui * 256 + ai * 128 + wr * 64 + m * 16 + fr)).z;
#pragma unroll
                for (int bj = 0; bj < 2; ++bj) {
                    const pg8::f32x4 a0 = *(const pg8::f32x4*)(x + off + bj * 128), a1 = *(const pg8::f32x4*)(x + off + bj * 128 + 4);
                    const pg8::f32x4 v0 = acc[ai][bj][m][0] * s1 + a0, v1 = acc[ai][bj][m][1] * s1 + a1;
                    pg8::u32x4 w; w.x = pg8::cvt_pk_bf16(v0[0], v0[1]); w.y = pg8::cvt_pk_bf16(v0[2], v0[3]); w.z = pg8::cvt_pk_bf16(v1[0], v1[1]); w.w = pg8::cvt_pk_bf16(v1[2], v1[3]);
                    *(pg8::u32x4*)(x1b + off + bj * 128) = w;
                    { v2u o8; int w_; w_ = __builtin_amdgcn_cvt_pk_fp8_f32(clampf(v0[0] * SX8, 448.f), clampf(v0[1] * SX8, 448.f), 0, false); w_ = __builtin_amdgcn_cvt_pk_fp8_f32(clampf(v0[2] * SX8, 448.f), clampf(v0[3] * SX8, 448.f), w_, true); o8.x = (unsigned)w_;
                      w_ = __builtin_amdgcn_cvt_pk_fp8_f32(clampf(v1[0] * SX8, 448.f), clampf(v1[1] * SX8, 448.f), 0, false); w_ = __builtin_amdgcn_cvt_pk_fp8_f32(clampf(v1[2] * SX8, 448.f), clampf(v1[3] * SX8, 448.f), w_, true); o8.y = (unsigned)w_;
                      *(v2u*)(x18 + off + bj * 128) = o8; }
                    s += (v0[0] * v0[0] + v0[1] * v0[1]) + (v0[2] * v0[2] + v0[3] * v0[3]) + (v1[0] * v1[0] + v1[1] * v1[1]) + (v1[2] * v1[2] + v1[3] * v1[3]); }
                s += __shfl_xor(s, 16); s += __shfl_xor(s, 32);
                if (fq == 0 && doatom) unsafeAtomicAdd(ssq + (size_t)row * 4, s);
                asm volatile("" ::: "memory"); }
    }
};
struct EpiQ {
    static constexpr bool PERM = true, AFTER_DRAIN = false, SEG = false;
    bf16* O; const float* ssq;
    __device__ __forceinline__ void operator()(const pg8::f32x4 (&acc)[2][2][4][2], const pg8::Unit& u, int wr, int wc, int fr, int fq) const {
        const int row0 = u.pm * 256 + wr * 64 + fr, col0 = u.pn * 256 + wc * 32 + 8 * fq;
#pragma unroll
        for (int ai = 0; ai < 2; ++ai)
#pragma unroll
            for (int m = 0; m < 4; ++m) { const int row = row0 + ai * 128 + m * 16; bf16* rowp = O + (size_t)row * DM + col0;
                const float rs = (1.f / (SX8 * SW8)) / sqrtf(__hip_atomic_load(ssq + (size_t)row * 4, RLX_AGENT) * (1.f / DM) + EPS);
#pragma unroll
                for (int bj = 0; bj < 2; ++bj) { const pg8::f32x4 v0 = acc[ai][bj][m][0] * rs, v1 = acc[ai][bj][m][1] * rs;
                    pg8::u32x4 w; w.x = pg8::cvt_pk_bf16(v0[0], v0[1]); w.y = pg8::cvt_pk_bf16(v0[2], v0[3]); w.z = pg8::cvt_pk_bf16(v1[0], v1[1]); w.w = pg8::cvt_pk_bf16(v1[2], v1[3]);
                    *(pg8::u32x4*)(rowp + bj * 128) = w; } }
    }
};

constexpr int A_KSTR = 272, A_VSTR = 288;
constexpr int A_KB0 = 0, A_KB1 = 64 * A_KSTR, A_VB0 = 2 * 64 * A_KSTR, A_VBS = 64 * A_VSTR  , A_KM = A_VB0 + 3 * A_VBS, A_TAB = A_KM + 8 * 128 * 4, A_END = A_TAB + 128 * 4;
static_assert(A_END <= RING_BYTES && (A_KM % 16) == 0, "attention LDS map");
#define PIN16(a, i) asm volatile("" : "+v"(a[i]), "+v"(a[i + 1]), "+v"(a[i + 2]), "+v"(a[i + 3]), "+v"(a[i + 4]), "+v"(a[i + 5]), "+v"(a[i + 6]), "+v"(a[i + 7]), "+v"(a[i + 8]), "+v"(a[i + 9]), "+v"(a[i + 10]), "+v"(a[i + 11]), "+v"(a[i + 12]), "+v"(a[i + 13]), "+v"(a[i + 14]), "+v"(a[i + 15]))
#define TR16(p) __builtin_amdgcn_ds_read_tr16_b64_v4i16((LAS s16x4*)(p))
#define MFMA16(a, b, c) __builtin_amdgcn_mfma_f32_16x16x32_bf16((a), (b), (c), 0, 0, 0)
__device__ __forceinline__ bf16x8 pack8(const float* v) {
    const unsigned a = pk2(v[0], v[1]), b = pk2(v[2], v[3]), c = pk2(v[4], v[5]), d = pk2(v[6], v[7]);
    const v4u u = {a, b, c, d}; return __builtin_bit_cast(bf16x8, u);
}
__device__ __forceinline__ void attn_unit(Frame& F, int b, int h, int blk, const bool doatom = true) {
    LAS unsigned char* lds = F.lds + RING_OFF;
    const int tid = fresh_tid(), lane = tid & 63, w = __builtin_amdgcn_readfirstlane(tid >> 6), g = lane >> 4, c16 = lane & 15, q4 = c16 >> 2, p4 = lane & 3;
    const int own = blk, t0 = blk * 256, tq0 = t0 + 32 * w + c16;
    const size_t rowbase = (size_t)b * SEQ;
    const float NEG_INF = -__builtin_inff();
    constexpr float LOG2E = 1.4426950408889634f, SCL2 = 0.08838834764831845f * 1.4426950408889634f;
    LAS float* km = (LAS float*)(lds + A_KM); LAS float* tab = (LAS float*)(lds + A_TAB);
    const bf16* const PROJ = F.PROJ(); const float* const kmg = F.kmean(); const float* const relb = F.rel_bias();
    for (int i = tid; i < own * 128; i += NWAVES * 64) { const int n = i >> 7, d = i & 127; km[i] = kmg[(size_t)(b * 8 + n) * 1024 + h * 128 + d] * (1.f / 256.f); }
    if (tid < 128) { const int rel = tid; int bucket = rel; if (rel >= 16) { bucket = 16 + (int)(log2f((float)rel * (1.f / 16.f)) * (16.f / 3.f)); bucket = bucket > 31 ? 31 : bucket; }
        tab[tid] = relb[bucket * 8 + h] * LOG2E; }
    bf16x8 qf[2][4];
#pragma unroll
    for (int gi = 0; gi < 2; ++gi) { const bf16* qrow = PROJ + (rowbase + tq0 + 16 * gi) * NPROJ + COL_Q + h * 128 + 8 * g;
#pragma unroll
      for (int ks = 0; ks < 4; ++ks) qf[gi][ks] = *(const GAS bf16x8*)(qrow + 32 * ks); }
    __syncthreads();
    unsigned selmask[2];
    if (own <= 3) { selmask[0] = (1u << own) - 1u; selmask[1] = selmask[0]; }
    else {
#pragma unroll
      for (int gi = 0; gi < 2; ++gi) {
        float gate[7];
#pragma unroll
        for (int n = 0; n < 7; ++n) {
            float s = NEG_INF;
            if (n < own) { s = 0.f;
#pragma unroll
                for (int ks = 0; ks < 4; ++ks) { const LAS f32x4* kp = (const LAS f32x4*)(km + n * 128 + 32 * ks + 8 * g); const f32x4 k0 = kp[0], k1 = kp[1]; const v4u qu = __builtin_bit_cast(v4u, qf[gi][ks]);
                    s += bflo(qu.x) * k0.x + bfhi(qu.x) * k0.y + bflo(qu.y) * k0.z + bfhi(qu.y) * k0.w + bflo(qu.z) * k1.x + bfhi(qu.z) * k1.y + bflo(qu.w) * k1.z + bfhi(qu.w) * k1.w; }
                s += __shfl_xor(s, 16); s += __shfl_xor(s, 32); }
            gate[n] = s;
        }
        unsigned sm = 0u;
#pragma unroll
        for (int r = 0; r < 3; ++r) { float best = NEG_INF; int bi = 0;
#pragma unroll
            for (int n = 0; n < 7; ++n) { const bool cand = (n < own) && !((sm >> n) & 1u) && (gate[n] > best); best = cand ? gate[n] : best; bi = cand ? n : bi; }
            sm |= 1u << bi; }
        selmask[gi] = sm; }
    }
    const int nT = 4 + 4 * own;
    const int sr = tid >> 3, sc = (tid & 7) * 16;
#define A_KEY0(i) ((i) < 4 ? own * 256 + 64 * (i) : (((i) - 4) >> 2) * 256 + (((i) - 4) & 3) * 64)
    v4u kr0, kr1, vr0, vr1;
#define A_LOAD(i) do { const bf16* kp_ = PROJ + (rowbase + A_KEY0(i) + sr) * NPROJ + COL_K + h * 128 + sc; \
        kr0 = *(const GAS v4u*)kp_; kr1 = *(const GAS v4u*)(kp_ + 8); vr0 = *(const GAS v4u*)(kp_ + (COL_V - COL_K)); vr1 = *(const GAS v4u*)(kp_ + (COL_V - COL_K) + 8); } while (0)
#define A_STORE(bufi) do { LAS unsigned char* kd_ = lds + ((bufi) ? A_KB1 : A_KB0) + sr * A_KSTR + sc * 2; LAS unsigned char* vd_ = lds + A_VB0 + vnx * A_VBS + sr * A_VSTR + sc * 2; \
        *(LAS v4u*)kd_ = kr0; *(LAS v4u*)(kd_ + 16) = kr1; *(LAS v4u*)vd_ = vr0; *(LAS v4u*)(vd_ + 16) = vr1; } while (0)
    int vcur = 0, vnx = 0, vprev = 0;
#define A_PV(PF, Vb_) do { _Pragma("unroll") for (int s = 0; s < 2; ++s) { s16x4 vlo[8], vhi[8]; \
            _Pragma("unroll") for (int db = 0; db < 8; ++db) { LAS unsigned char* va = (Vb_) + (32 * s + 4 * g + q4) * A_VSTR + (16 * db + 4 * p4) * 2; vlo[db] = TR16(va); vhi[db] = TR16(va + 16 * A_VSTR); } \
            __builtin_amdgcn_sched_barrier(0); \
            _Pragma("unroll") for (int db = 0; db < 8; ++db) { const bf16x8 vf = __builtin_shufflevector(vlo[db], vhi[db], 0, 1, 2, 3, 4, 5, 6, 7); \
                oacc[0][db] = MFMA16(vf, PF[0][s], oacc[0][db]); oacc[1][db] = MFMA16(vf, PF[1][s], oacc[1][db]); } \
            __builtin_amdgcn_sched_barrier(0); } } while (0)
    A_LOAD(0); A_STORE(0);
    __syncthreads();
    const bool late = w >= 4;
    bf16x8 pfp[2][2]; bool skipp = true;
#pragma unroll
    for (int gi = 0; gi < 2; ++gi) { pfp[gi][0] = (bf16x8){0, 0, 0, 0, 0, 0, 0, 0}; pfp[gi][1] = pfp[gi][0]; }
    float m_run[2] = {NEG_INF, NEG_INF}, l_run[2] = {0.f, 0.f};
    f32x4 oacc[2][8];
#pragma unroll
    for (int gi = 0; gi < 2; ++gi)
#pragma unroll
        for (int db = 0; db < 8; ++db) oacc[gi][db] = (f32x4){0.f, 0.f, 0.f, 0.f};
    for (int i = 0; i < nT; ++i) {
        if (i + 1 < nT) A_LOAD(i + 1);
        vnx = (vcur == 2) ? 0 : vcur + 1;
        const int buf = i & 1, key0 = A_KEY0(i); const bool isown = i < 4; const int pblk = isown ? own : ((i - 4) >> 2);
        const bool skipw = isown && (64 * i > 32 * w + 31);
        if (late && !skipp) A_PV(pfp, lds + A_VB0 + vprev * A_VBS);
        bf16x8 pf[2][2];
        if (!skipw) {
        LAS unsigned char* Kb = lds + (buf ? A_KB1 : A_KB0);
        f32x4 sacc[2][4];
#pragma unroll
        for (int hf = 0; hf < 2; ++hf) { bf16x8 kf[8];
#pragma unroll
            for (int n2 = 0; n2 < 2; ++n2)
#pragma unroll
                for (int ks = 0; ks < 4; ++ks) kf[n2 * 4 + ks] = *(const LAS bf16x8*)(Kb + (16 * (2 * hf + n2) + c16) * A_KSTR + (32 * ks + 8 * g) * 2);
            __builtin_amdgcn_sched_barrier(0);
#pragma unroll
            for (int gi = 0; gi < 2; ++gi)
#pragma unroll
                for (int n2 = 0; n2 < 2; ++n2) { f32x4 a = (f32x4){0.f, 0.f, 0.f, 0.f};
#pragma unroll
                    for (int ks = 0; ks < 4; ++ks) a = MFMA16(kf[n2 * 4 + ks], qf[gi][ks], a);
                    sacc[gi][2 * hf + n2] = a; }
            __builtin_amdgcn_sched_barrier(0); }
        const bool far = (key0 + 63 + 128 <= t0 + 32 * w);
        const bool diag = isown && (64 * i + 63 > 32 * w);
#pragma unroll
        for (int gi = 0; gi < 2; ++gi) {
            const int tq = tq0 + 16 * gi; const bool sel = isown || ((selmask[gi] >> pblk) & 1u);
            float sv[16]; float mloc, m_new, alpha;
            if (far) {
                const float bfar = tab[127];
                float mx = fmaxf(fmaxf(sacc[gi][0][0], sacc[gi][0][1]), fmaxf(sacc[gi][0][2], sacc[gi][0][3]));
#pragma unroll
                for (int nb = 1; nb < 4; ++nb) mx = fmaxf(mx, fmaxf(fmaxf(sacc[gi][nb][0], sacc[gi][nb][1]), fmaxf(sacc[gi][nb][2], sacc[gi][nb][3])));
                mloc = sel ? (mx * SCL2 + bfar) : NEG_INF;
                mloc = fmaxf(mloc, __shfl_xor(mloc, 16)); mloc = fmaxf(mloc, __shfl_xor(mloc, 32));
                m_new = fmaxf(m_run[gi], mloc); alpha = __builtin_amdgcn_exp2f(m_run[gi] - m_new);
                const float cadd = sel ? (bfar - m_new) : NEG_INF;
#pragma unroll
                for (int nb = 0; nb < 4; ++nb)
#pragma unroll
                    for (int r = 0; r < 4; ++r) sv[nb * 4 + r] = __builtin_amdgcn_exp2f(sacc[gi][nb][r] * SCL2 + cadd);
            } else {
                const int relb = tq - key0 - 4 * g; float bias[16];
#pragma unroll
                for (int nb = 0; nb < 4; ++nb)
#pragma unroll
                    for (int r = 0; r < 4; ++r) { const int rel = relb - 16 * nb - r; int ri = rel < 0 ? 0 : rel; ri = ri > 127 ? 127 : ri; bias[nb * 4 + r] = tab[ri]; }
                PIN16(bias, 0);
                mloc = NEG_INF;
#pragma unroll
                for (int nb = 0; nb < 4; ++nb)
#pragma unroll
                    for (int r = 0; r < 4; ++r) { const int rel = relb - 16 * nb - r;
                        float s = sacc[gi][nb][r] * SCL2 + bias[nb * 4 + r]; s = (!sel || (diag && rel < 0)) ? NEG_INF : s; sv[nb * 4 + r] = s; mloc = fmaxf(mloc, s); }
                mloc = fmaxf(mloc, __shfl_xor(mloc, 16)); mloc = fmaxf(mloc, __shfl_xor(mloc, 32));
                m_new = fmaxf(m_run[gi], mloc); alpha = __builtin_amdgcn_exp2f(m_run[gi] - m_new);
#pragma unroll
                for (int e = 0; e < 16; ++e) sv[e] = __builtin_amdgcn_exp2f(sv[e] - m_new);
            }
            float psum = 0.f;
#pragma unroll
            for (int e = 0; e < 16; ++e) psum += sv[e];
            l_run[gi] = l_run[gi] * alpha + psum; m_run[gi] = m_new;
#pragma unroll
            for (int db = 0; db < 8; ++db) oacc[gi][db] = oacc[gi][db] * alpha;
            pf[gi][0] = pack8(sv); pf[gi][1] = pack8(sv + 8);
        }
        __builtin_amdgcn_sched_barrier(0);
        if (!late) A_PV(pf, lds + A_VB0 + vcur * A_VBS);
        }
        if (late) { skipp = skipw;
#pragma unroll
            for (int gi = 0; gi < 2; ++gi) { pfp[gi][0] = pf[gi][0]; pfp[gi][1] = pf[gi][1]; } }
        if (i + 1 < nT) A_STORE((i + 1) & 1);
        vprev = vcur; vcur = vnx;
        __syncthreads();
    }
    if (late && !skipp) A_PV(pfp, lds + A_VB0 + vprev * A_VBS);
#undef A_PV
    bf16* const MIXp = F.HN(); float* const ssqp = F.ssq();
#pragma unroll
    for (int gi = 0; gi < 2; ++gi) {
        const int tq = tq0 + 16 * gi;
        float l_tot = l_run[gi]; l_tot += __shfl_xor(l_tot, 16); l_tot += __shfl_xor(l_tot, 32);
        const float inv = 1.f / l_tot; float ssq = 0.f;
        unsigned char* orow = (unsigned char*)MIXp + (rowbase + tq) * DM + h * 128 + 4 * g;
#pragma unroll
        for (int db = 0; db < 8; ++db) { const f32x4 o = oacc[gi][db] * inv; ssq += (o.x * o.x + o.y * o.y) + (o.z * o.z + o.w * o.w); *(GAS unsigned*)(orow + 16 * db) = pk4_fp8(o.x * SA8, o.y * SA8, o.z * SA8, o.w * SA8); }
        ssq += __shfl_xor(ssq, 16); ssq += __shfl_xor(ssq, 32);
        if (g == 0 && doatom) unsafeAtomicAdd(ssqp + (rowbase + tq) * 4 + 1, ssq);
    }
#undef A_KEY0
#undef A_LOAD
#undef A_STORE
}

constexpr int XBC_W = CONV_CH;
__device__ __forceinline__ void conv_phase(Frame& F) {
    const bf16* const PROJ = F.PROJ(); bf16* const XBC = F.XBC(); const float* const cw = F.conv_w(); const float* const cb = F.conv_b();
    const int gt = blockIdx.x * (NWAVES * 64) + fresh_tid(), GT = F.G * NWAVES * 64;
    for (int task = gt; task < (MTOK / 32) * (CONV_CH / 8); task += GT) {
        const int r = task / (CONV_CH / 8), k = task % (CONV_CH / 8), ch = 8 * k, tok0 = 32 * r;
        float wv[4][8], bias[8];
#pragma unroll
        for (int t = 0; t < 4; ++t) { const f32x4 w0 = *(const GAS f32x4*)(cw + t * CONV_CH + ch), w1 = *(const GAS f32x4*)(cw + t * CONV_CH + ch + 4);
            wv[t][0] = w0.x; wv[t][1] = w0.y; wv[t][2] = w0.z; wv[t][3] = w0.w; wv[t][4] = w1.x; wv[t][5] = w1.y; wv[t][6] = w1.z; wv[t][7] = w1.w; }
        { const f32x4 b0 = *(const GAS f32x4*)(cb + ch), b1 = *(const GAS f32x4*)(cb + ch + 4); bias[0] = b0.x; bias[1] = b0.y; bias[2] = b0.z; bias[3] = b0.w; bias[4] = b1.x; bias[5] = b1.y; bias[6] = b1.z; bias[7] = b1.w; }
        const bf16* src = PROJ + (size_t)tok0 * NPROJ + COL_XBC + ch; bf16* dst = XBC + (size_t)tok0 * XBC_W + ch;
        v4u p0 = (v4u){0u, 0u, 0u, 0u}, p1 = p0, p2 = p0;
        if ((tok0 & (SEQ - 1)) != 0) { p0 = *(const GAS v4u*)(src - 3 * (ptrdiff_t)NPROJ); p1 = *(const GAS v4u*)(src - 2 * (ptrdiff_t)NPROJ); p2 = *(const GAS v4u*)(src - (ptrdiff_t)NPROJ); }
#pragma unroll 1
        for (int i0 = 0; i0 < 32; i0 += 8) {
            v4u cur[8];
#pragma unroll
            for (int i = 0; i < 8; ++i) cur[i] = *(const GAS v4u*)(src + (size_t)(i0 + i) * NPROJ);
#pragma unroll
            for (int i = 0; i < 8; ++i) {
                const v4u c = cur[i]; float acc[8];
                const unsigned a0[4] = {p0.x, p0.y, p0.z, p0.w}, a1[4] = {p1.x, p1.y, p1.z, p1.w}, a2[4] = {p2.x, p2.y, p2.z, p2.w}, a3[4] = {c.x, c.y, c.z, c.w};
#pragma unroll
                for (int j = 0; j < 4; ++j) {
                    acc[2 * j] = bias[2 * j] + wv[0][2 * j] * bflo(a0[j]) + wv[1][2 * j] * bflo(a1[j]) + wv[2][2 * j] * bflo(a2[j]) + wv[3][2 * j] * bflo(a3[j]);
                    acc[2 * j + 1] = bias[2 * j + 1] + wv[0][2 * j + 1] * bfhi(a0[j]) + wv[1][2 * j + 1] * bfhi(a1[j]) + wv[2][2 * j + 1] * bfhi(a2[j]) + wv[3][2 * j + 1] * bfhi(a3[j]); }
#pragma unroll
                for (int j = 0; j < 8; ++j) acc[j] = silu_f(acc[j]);
                v4u o; o.x = pk2(acc[0], acc[1]); o.y = pk2(acc[2], acc[3]); o.z = pk2(acc[4], acc[5]); o.w = pk2(acc[6], acc[7]);
                *(GAS v4u*)(dst + (size_t)(i0 + i) * XBC_W) = o;
                p0 = p1; p1 = p2; p2 = c; }
        }
    }
    { const float* const dtraw = F.dtraw(); float* const dt2 = F.DT2(); const float* const dtb = F.dt_bias();
      for (int i = gt; i < MTOK * 16; i += GT) { const float xr = dtraw[i] + dtb[i & 15]; dt2[i] = xr > 20.f ? xr : log1pf(__expf(xr)); } }
}

constexpr int S_BSTR = 272, S_XSTR = 144;
constexpr int S_BM = 0, S_CM = 128 * S_BSTR, S_X = 2 * 128 * S_BSTR, S_XW = S_X + 128 * S_XSTR, S_HB = S_XW + 128 * S_XSTR, S_DT = S_HB + 64 * S_BSTR, S_CS = S_DT + 512, S_DA = S_CS + 512, S_END = S_DA + 512;
static_assert(S_END <= RING_BYTES, "ssd LDS map");
__device__ __forceinline__ void ssd_unit(Frame& F, int b, int h, const bool doatom = true) {
    LAS unsigned char* lds = F.lds + RING_OFF;
    const int tid = fresh_tid(), lane = tid & 63, w = __builtin_amdgcn_readfirstlane(tid >> 6), g = lane >> 4, c16 = lane & 15, q4 = c16 >> 2, p4 = lane & 3;
    const int g8 = h >> 3, pbw = w & 3, nhw = w >> 2;
    const float a_h = -__expf(F.a_log()[h]), dsk = F.d_skip()[h];
    const bf16* const PROJ = F.PROJ(); bf16* const MIX = F.HN(); const float* const dt2 = F.DT2(); const bf16* const XBC = F.XBC(); float* const ssqp = F.ssq();
    LAS float* dtl = (LAS float*)(lds + S_DT); LAS float* csl = (LAS float*)(lds + S_CS); LAS float* dal = (LAS float*)(lds + S_DA);
    for (int i = tid; i < 64 * S_BSTR / 16; i += NWAVES * 64) ((LAS v4u*)(lds + S_HB))[i] = (v4u){0u, 0u, 0u, 0u};
    f32x4 hacc[4];
#pragma unroll
    for (int i = 0; i < 4; ++i) hacc[i] = (f32x4){0.f, 0.f, 0.f, 0.f};
    const int xl = tid >> 3, xc = tid & 7, bl = tid >> 4, bc = tid & 15;
    v4u xr[2], br[4], cr[4]; float dtv = 0.f;
#define S_PREFETCH(cc) do { const size_t t0_ = (size_t)b * SEQ + (size_t)(cc) * SSM_L; \
        _Pragma("unroll") for (int i_ = 0; i_ < 2; ++i_) xr[i_] = *(const GAS v4u*)(XBC + (t0_ + xl + 64 * i_) * XBC_W + h * 64 + 8 * xc); \
        _Pragma("unroll") for (int i_ = 0; i_ < 4; ++i_) { const bf16* p_ = XBC + (t0_ + bl + 32 * i_) * XBC_W + 1024 + g8 * 128 + 8 * bc; br[i_] = *(const GAS v4u*)p_; cr[i_] = *(const GAS v4u*)(p_ + 256); } \
        if (tid < 128) dtv = dt2[(t0_ + tid) * 16 + h]; } while (0)
    S_PREFETCH(0);
    for (int c = 0; c < SSM_NC; ++c) {
        const size_t tok0 = (size_t)b * SEQ + (size_t)c * SSM_L;
        if (tid < 128) { dtl[tid] = dtv; dal[tid] = dtv * a_h; }
        __syncthreads();
        if (w == 0) { const float v0 = dal[2 * lane], v1 = dal[2 * lane + 1]; float s = v0 + v1;
#pragma unroll
            for (int o = 1; o < 64; o <<= 1) { const float t = __shfl_up(s, o); s += (lane >= o) ? t : 0.f; }
            csl[2 * lane] = s - v1; csl[2 * lane + 1] = s; }
        __syncthreads();
        const float cs_last = csl[127];
#pragma unroll
        for (int i = 0; i < 2; ++i) { const int l = xl + 64 * i; const v4u v = xr[i]; *(LAS v4u*)(lds + S_X + l * S_XSTR + xc * 16) = v; const float wl = dtl[l] * __expf(cs_last - csl[l]);
            v4u o2; o2.x = pk2(bflo(v.x) * wl, bfhi(v.x) * wl); o2.y = pk2(bflo(v.y) * wl, bfhi(v.y) * wl); o2.z = pk2(bflo(v.z) * wl, bfhi(v.z) * wl); o2.w = pk2(bflo(v.w) * wl, bfhi(v.w) * wl);
            *(LAS v4u*)(lds + S_XW + l * S_XSTR + xc * 16) = o2; }
#pragma unroll
        for (int i = 0; i < 4; ++i) { const int l = bl + 32 * i; *(LAS v4u*)(lds + S_BM + l * S_BSTR + bc * 16) = br[i]; *(LAS v4u*)(lds + S_CM + l * S_BSTR + bc * 16) = cr[i]; }
        const int lrow = 16 * w + c16;
        v2u zr[4];
#pragma unroll
        for (int pb = 0; pb < 4; ++pb) zr[pb] = *(const GAS v2u*)(PROJ + (tok0 + lrow) * NPROJ + COL_Z + h * 64 + 16 * pb + 4 * g);
        if (c + 1 < SSM_NC) S_PREFETCH(c + 1);
        __syncthreads();
        bf16x8 cf[4];
#pragma unroll
        for (int ks = 0; ks < 4; ++ks) cf[ks] = *(const LAS bf16x8*)(lds + S_CM + lrow * S_BSTR + (32 * ks + 8 * g) * 2);
        f32x4 yacc[4];
        const float cs_l = csl[lrow]; const float el = __expf(cs_l);
#pragma unroll
        for (int pb = 0; pb < 4; ++pb) { yacc[pb] = (f32x4){0.f, 0.f, 0.f, 0.f};
#pragma unroll
            for (int ks = 0; ks < 4; ++ks) { const bf16x8 hf = *(const LAS bf16x8*)(lds + S_HB + (16 * pb + c16) * S_BSTR + (32 * ks + 8 * g) * 2); yacc[pb] = MFMA16(hf, cf[ks], yacc[pb]); }
            yacc[pb] = yacc[pb] * el; }
        for (int s2 = 0; s2 <= (w >> 1); ++s2) {
            const int sb0 = 2 * s2, sb1 = 2 * s2 + 1; const bool has1 = sb1 <= w;
            f32x4 cb0 = (f32x4){0.f, 0.f, 0.f, 0.f}, cb1 = (f32x4){0.f, 0.f, 0.f, 0.f};
#pragma unroll
            for (int ks = 0; ks < 4; ++ks) { const bf16x8 bf0 = *(const LAS bf16x8*)(lds + S_BM + (16 * sb0 + c16) * S_BSTR + (32 * ks + 8 * g) * 2); cb0 = MFMA16(bf0, cf[ks], cb0); }
            if (has1) {
#pragma unroll
                for (int ks = 0; ks < 4; ++ks) { const bf16x8 bf1 = *(const LAS bf16x8*)(lds + S_BM + (16 * sb1 + c16) * S_BSTR + (32 * ks + 8 * g) * 2); cb1 = MFMA16(bf1, cf[ks], cb1); } }
            float mv[8];
#pragma unroll
            for (int r = 0; r < 4; ++r) { const int s = 16 * sb0 + 4 * g + r; const float e = __expf(fminf(cs_l - csl[s], 0.f)) * dtl[s]; mv[r] = (s <= lrow) ? cb0[r] * e : 0.f; }
#pragma unroll
            for (int r = 0; r < 4; ++r) { const int s = 16 * sb1 + 4 * g + r; const int sc_ = s > 127 ? 127 : s; const float e = __expf(fminf(cs_l - csl[sc_], 0.f)) * dtl[sc_]; mv[4 + r] = (has1 && s <= lrow) ? cb1[r] * e : 0.f; }
            const bf16x8 pf = pack8(mv);
#pragma unroll
            for (int pb = 0; pb < 4; ++pb) { LAS unsigned char* xa = lds + S_X + (32 * s2 + 4 * g + q4) * S_XSTR + (16 * pb + 4 * p4) * 2;
                const s16x4 lo = TR16(xa), hi = TR16(xa + 16 * S_XSTR); const bf16x8 xf = __builtin_shufflevector(lo, hi, 0, 1, 2, 3, 4, 5, 6, 7);
                yacc[pb] = MFMA16(xf, pf, yacc[pb]); }
        }
        { const size_t tok = tok0 + lrow; float ssq = 0.f;
#pragma unroll
          for (int pb = 0; pb < 4; ++pb) { const int p0 = 16 * pb + 4 * g;
              const v2u xs_ = *(const LAS v2u*)(lds + S_X + lrow * S_XSTR + p0 * 2);
              const v2u zr_ = zr[pb];
              const float o0 = (yacc[pb].x + bflo(xs_.x) * dsk) * silu_f(bflo(zr_.x)), o1 = (yacc[pb].y + bfhi(xs_.x) * dsk) * silu_f(bfhi(zr_.x));
              const float o2 = (yacc[pb].z + bflo(xs_.y) * dsk) * silu_f(bflo(zr_.y)), o3 = (yacc[pb].w + bfhi(xs_.y) * dsk) * silu_f(bfhi(zr_.y));
              ssq += (o0 * o0 + o1 * o1) + (o2 * o2 + o3 * o3);
              *(GAS unsigned*)((unsigned char*)MIX + tok * DM + ATT_W + h * 64 + p0) = pk4_fp8(o0 * SS8, o1 * SS8, o2 * SS8, o3 * SS8); }
          ssq += __shfl_xor(ssq, 16); ssq += __shfl_xor(ssq, 32);
          if (g == 0 && doatom) unsafeAtomicAdd(ssqp + tok * 4 + 2 + g8, ssq); }
        { const float cdec = __expf(cs_last);
#pragma unroll
          for (int i = 0; i < 4; ++i) hacc[i] = hacc[i] * cdec;
#pragma unroll
          for (int ks = 0; ks < 4; ++ks) {
              LAS unsigned char* xa = lds + S_XW + (32 * ks + 8 * g + q4) * S_XSTR + (16 * pbw + 4 * p4) * 2;
              const s16x4 xlo = TR16(xa), xhi = TR16(xa + 4 * S_XSTR); const bf16x8 xf = __builtin_shufflevector(xlo, xhi, 0, 1, 2, 3, 4, 5, 6, 7);
#pragma unroll
              for (int i = 0; i < 4; ++i) { const int nb = 4 * nhw + i; LAS unsigned char* ba = lds + S_BM + (32 * ks + 8 * g + q4) * S_BSTR + (16 * nb + 4 * p4) * 2;
                  const s16x4 blo = TR16(ba), bhi = TR16(ba + 4 * S_BSTR); const bf16x8 bfr = __builtin_shufflevector(blo, bhi, 0, 1, 2, 3, 4, 5, 6, 7);
                  hacc[i] = MFMA16(bfr, xf, hacc[i]); } } }
        __syncthreads();
#pragma unroll
        for (int i = 0; i < 4; ++i) { const int nb = 4 * nhw + i; v2u o; o.x = pk2(hacc[i].x, hacc[i].y); o.y = pk2(hacc[i].z, hacc[i].w);
            *(LAS v2u*)(lds + S_HB + (16 * pbw + c16) * S_BSTR + (16 * nb + 4 * g) * 2) = o; }
    }
#undef S_PREFETCH
    __syncthreads();
}

__device__ __forceinline__ void mix_normalize(Frame& F) {
    const int tid_ = fresh_tid(), lane = tid_ & 63; const int gw = blockIdx.x * NWAVES + __builtin_amdgcn_readfirstlane(tid_ >> 6), NGW = F.G * NWAVES;
    const float* const ssqp = F.ssq(); bf16* const MIX = F.HN(); const float* const gatt = F.attn_out_norm(); const float* const gssm = F.ssm_out_norm();
    for (int m = gw; m < MTOK; m += NGW) {
        const float* sq = ssqp + (size_t)m * 4;
        const float s1 = __hip_atomic_load(sq + 1, RLX_AGENT), s2 = __hip_atomic_load(sq + 2, RLX_AGENT), s3 = __hip_atomic_load(sq + 3, RLX_AGENT);
        const float ra = 1.f / sqrtf(s1 * (1.f / 1024.f) + EPS), r0 = 1.f / sqrtf(s2 * (1.f / 512.f) + EPS), r1 = 1.f / sqrtf(s3 * (1.f / 512.f) + EPS);
        GAS v4u* row = (GAS v4u*)(MIX + (size_t)m * DM);
#pragma unroll
        for (int j = 0; j < 4; ++j) { const int idx = lane + 64 * j, col = 8 * idx; const float rs = (j < 2) ? ra : ((j == 2) ? r0 : r1);
            const float* gp = (j < 2) ? (gatt + col) : (gssm + (col - ATT_W));
            const f32x4 g0 = *(const GAS f32x4*)gp, g1 = *(const GAS f32x4*)(gp + 4); const v4u v = row[idx]; v4u o;
            o.x = pk2(bflo(v.x) * rs * g0.x, bfhi(v.x) * rs * g0.y); o.y = pk2(bflo(v.y) * rs * g0.z, bfhi(v.y) * rs * g0.w);
            o.z = pk2(bflo(v.z) * rs * g1.x, bfhi(v.z) * rs * g1.y); o.w = pk2(bflo(v.w) * rs * g1.z, bfhi(v.w) * rs * g1.w); row[idx] = o; }
    }
}

constexpr int P_EIDX = 0, P_GATE = 16384, P_LST = 32768  , P_HN4 = 32768  , P_ACT = 98304  , P_END = 114688;
static_assert(P_END <= RING_BYTES, "peer LDS map");
__constant__ unsigned char PEER_CAND[52] = {0, 1, 2, 3, 4, 5, 6, 7, 8, 9, 10, 11, 12, 13, 14, 15, 16, 17, 18, 19, 20, 21, 22, 23, 32, 33, 34, 35, 36, 48, 49, 50, 51, 64, 65, 66, 80, 81, 96, 97, 112, 113, 128, 144, 160, 176, 192, 208, 224, 240, 255, 255};
__device__ __forceinline__ unsigned f2ord(float f) { const unsigned u = __builtin_bit_cast(unsigned, f); return u ^ ((u >> 31) ? 0xFFFFFFFFu : 0x80000000u); }
__device__ __forceinline__ float ord2f(unsigned u) { return __builtin_bit_cast(float, u ^ ((u >> 31) ? 0x80000000u : 0xFFFFFFFFu)); }
#define CSWAPD(a, b) do { const unsigned hi_ = (a) > (b) ? (a) : (b), lo_ = (a) > (b) ? (b) : (a); (a) = hi_; (b) = lo_; } while (0)
template <int N> __device__ __forceinline__ void bitonic_sort_desc(unsigned (&v)[N]) {
#pragma unroll
    for (int k = 2; k <= N; k <<= 1)
#pragma unroll
        for (int j = k >> 1; j > 0; j >>= 1)
#pragma unroll
            for (int i = 0; i < N; ++i) { const int l = i ^ j; if (l > i) { if ((i & k) == 0) CSWAPD(v[i], v[l]); else CSWAPD(v[l], v[i]); } }
}
__device__ __forceinline__ void merge16_xor(unsigned (&v)[16], int dist) {
    unsigned o[16];
#pragma unroll
    for (int i = 0; i < 16; ++i) o[i] = (unsigned)__shfl_xor((int)v[i], dist);
#pragma unroll
    for (int i = 0; i < 16; ++i) v[i] = v[i] > o[15 - i] ? v[i] : o[15 - i];
#pragma unroll
    for (int j = 8; j > 0; j >>= 1)
#pragma unroll
        for (int i = 0; i < 16; ++i) { const int l = i ^ j; if (l > i) CSWAPD(v[i], v[l]); }
}
__device__ __forceinline__ float gelu_erf(float x) { return 0.5f * x * (1.f + erff(x * 0.70710678118654752f)); }
__device__ __forceinline__ float fp4_dec1(unsigned n) { const unsigned m = n & 7u; unsigned bits = (m >= 2u) ? (((126u + (m >> 1)) << 23) | ((m & 1u) << 22)) : (m ? 0x3F000000u : 0u); bits |= (n & 8u) << 28; return __builtin_bit_cast(float, bits); }
__device__ __forceinline__ f32x2 fp4_dec2(unsigned x) { f32x2 r; r.x = fp4_dec1(x & 15u); r.y = fp4_dec1((x >> 4) & 15u); return r; }
typedef long i64;
typedef int v8i __attribute__((ext_vector_type(8)));
typedef int v4i __attribute__((ext_vector_type(4)));
template <bool dry = false> __device__ __forceinline__ void peer_unit(Frame& F, int u) {
    LAS unsigned char* lds = F.lds + RING_OFF;
    const int tid_ = fresh_tid(), lane = tid_ & 63, w = __builtin_amdgcn_readfirstlane(tid_ >> 6), g = lane >> 4, c16 = lane & 15;
    const int T0 = 32 * u;
    LAS int* eidx = (LAS int*)(lds + P_EIDX); LAS float* gate = (LAS float*)(lds + P_GATE);
    LAS unsigned* lst = (LAS unsigned*)(lds + P_LST) + w * 1024;
    const bf16* const QP = F.QP(); const bf16* const SK = F.SK(); float* const outp = F.out(); const bf16* const X1B = F.X1B(); const float* const fgain = F.ffn_norm(); const float* const fing = F.final_norm(); const unsigned char* const U8 = F.U8(); const unsigned char* const V8 = F.V8();
#ifndef NO_ROUTE
    unsigned cpk[4];
    { unsigned cb[16];
#pragma unroll
      for (int k = 0; k < 13; ++k) cb[k] = PEER_CAND[4 * k + g];
      cb[13] = 255u; cb[14] = 255u; cb[15] = 255u;
#pragma unroll
      for (int q = 0; q < 4; ++q) cpk[q] = cb[4 * q] | (cb[4 * q + 1] << 8) | (cb[4 * q + 2] << 16) | (cb[4 * q + 3] << 24); }
    {
    bf16x8 qf[2][4];
#define QP_LOAD(dst, c_) do { _Pragma("unroll") for (int tb = 0; tb < 2; ++tb) { const unsigned qo = ((unsigned)(T0 + 16 * tb + c16) * (unsigned)DM + (unsigned)((2 * w + (c_)) * 128 + 8 * g)) * 2u; \
        _Pragma("unroll") for (int ks = 0; ks < 4; ++ks) dst[tb][ks] = __builtin_nontemporal_load((const GAS bf16x8*)((const unsigned char*)QP + (qo + 64u * ks))); } } while (0)
    QP_LOAD(qf, 0);
#pragma unroll
    for (int c = 0; c < 2; ++c) {
        const int p = 2 * w + c;
        unsigned key[2][32];
        bf16x8 sf[3][8];
        const unsigned so0 = ((unsigned)(p * 128 + c16) * 128u + 8u * (unsigned)g) * 2u;
#define SK_LOAD(buf, j_) do { _Pragma("unroll") for (int q = 0; q < 8; ++q) sf[buf][q] = *(const GAS bf16x8*)((const unsigned char*)SK + (so0 + (unsigned)(2 * (j_) + (q >> 2)) * 4096u + 64u * (q & 3))); } while (0)
        SK_LOAD(0, 0); SK_LOAD(1, 1);
#pragma unroll
        for (int j = 0; j < 4; ++j) {
            if (j + 2 < 4) SK_LOAD((j + 2) % 3, j + 2);
            __builtin_amdgcn_sched_barrier(0);
#pragma unroll
            for (int h2 = 0; h2 < 2; ++h2)
#pragma unroll
            for (int tb = 0; tb < 2; ++tb) { const int kb = 2 * j + h2; f32x4 acc = (f32x4){0.f, 0.f, 0.f, 0.f};
#pragma unroll
                for (int ks = 0; ks < 4; ++ks) acc = MFMA16(sf[j % 3][4 * h2 + ks], qf[tb][ks], acc);
#pragma unroll
                for (int r = 0; r < 4; ++r) key[tb][kb * 4 + r] = (f2ord(acc[r]) & ~0x7Fu) | (unsigned)(16 * kb + 4 * g + r); }
            __builtin_amdgcn_sched_barrier(0); }
#undef SK_LOAD
        if (c == 0) { QP_LOAD(qf, 1); __builtin_amdgcn_sched_barrier(0); }
#pragma unroll
        for (int tb = 0; tb < 2; ++tb) {
            bitonic_sort_desc<32>(key[tb]);
            unsigned top[16];
#pragma unroll
            for (int i = 0; i < 16; ++i) top[i] = key[tb][i];
            merge16_xor(top, 16); merge16_xor(top, 32);
            if (g == 0) { LAS v4u* d = (LAS v4u*)(lst + (c * 32 + 16 * tb + c16) * 16);
                d[0] = (v4u){top[0], top[1], top[2], top[3]}; d[1] = (v4u){top[4], top[5], top[6], top[7]}; d[2] = (v4u){top[8], top[9], top[10], top[11]}; d[3] = (v4u){top[12], top[13], top[14], top[15]}; } }
    }
#undef QP_LOAD
    }
    for (int tb = 0; tb < 2; ++tb) {
        LDS_WAIT();
        const LAS unsigned* l1 = lst + (16 * tb + c16) * 16; const LAS unsigned* l2 = lst + (32 + 16 * tb + c16) * 16;
        unsigned ck[16];
#pragma unroll
        for (int k = 0; k < 13; ++k) { const unsigned ab = (cpk[k >> 2] >> (8 * (k & 3))) & 255u; const unsigned a = ab >> 4, bq = ab & 15u;
            const float s = ord2f(l1[a] & ~0x7Fu) + ord2f(l2[bq] & ~0x7Fu); ck[k] = (ab == 255u) ? 0u : ((f2ord(s) & ~0xFFu) | ab); }
        ck[13] = 0u; ck[14] = 0u; ck[15] = 0u;
        bitonic_sort_desc<16>(ck);
        merge16_xor(ck, 16); merge16_xor(ck, 32);
        if (g == 0) { const int tl = 16 * tb + c16; const float m = ord2f(ck[0] & ~0xFFu); float e[16]; float sum = 0.f;
#pragma unroll
            for (int k = 0; k < 16; ++k) { e[k] = __expf(ord2f(ck[k] & ~0xFFu) - m); sum += e[k]; }
            const float inv = 1.f / sum;
#pragma unroll
            for (int k = 0; k < 16; ++k) { const unsigned a = (ck[k] >> 4) & 15u, bq = ck[k] & 15u; const int ex = (int)((l1[a] & 0x7Fu) * 128u + (l2[bq] & 0x7Fu));
                eidx[tl * 128 + w * 16 + k] = ex; gate[tl * 128 + w * 16 + k] = e[k] * inv; } }
    }
#endif
    __syncthreads();
    LAS unsigned char* hnb = lds + P_HN4 + w * 8192; LAS float* actl = (LAS float*)(lds + P_ACT) + w * 512;
    const LAS unsigned char* hb = hnb + 16 * g + ((c16 == 1) ? 1024 : 0);
    v4u bA[8], bB[8];
#define U_ISSUE(buf, e_, jb) do { const unsigned uo_ = (unsigned)(e_) * (unsigned)ROWB + 16u * (unsigned)g + 512u * (unsigned)(jb); \
        _Pragma("unroll") for (int jj = 0; jj < 8; ++jj) buf[jj] = *(const GAS v4u*)(U8 + (uo_ + 64u * jj)); __builtin_amdgcn_sched_barrier(0); } while (0)
#define U_CONSUME(buf, jb, HB) do { v4u bq_[8]; _Pragma("unroll") for (int jj = 0; jj < 8; ++jj) bq_[jj] = *(const LAS v4u*)((HB) + 64 * (8 * (jb) + jj)); \
        __builtin_amdgcn_sched_barrier(0); \
        _Pragma("unroll") for (int jj = 0; jj < 8; ++jj) { const v4u a_ = buf[jj]; \
            const v8i av_ = {(int)a_.x, (int)a_.y, (int)a_.z, (int)a_.w, 0, 0, 0, 0}; const v8i bv_ = {(int)bq_[jj].x, (int)bq_[jj].y, (int)bq_[jj].z, (int)bq_[jj].w, 0, 0, 0, 0}; \
            acc = __builtin_amdgcn_mfma_scale_f32_16x16x128_f8f6f4(av_, bv_, acc, 4, 4, 0, 0x7f7f7f7f, 0, 0x7f7f7f7f); } __builtin_amdgcn_sched_barrier(0); } while (0)
#define U_ACT(grp_, TL, ACT) do { const float l0_ = __shfl_down(acc.x, 1), l1_ = __shfl_down(acc.y, 1), l2_ = __shfl_down(acc.z, 1), l3_ = __shfl_down(acc.w, 1); \
        if (c16 == 0) { const int k0 = 16 * (grp_) + 4 * g; constexpr float isc = 1.f / (SU * SH4), ilo = 1.f / SLO4; const f32x4 gt = *(const LAS f32x4*)(gate + (TL) * 128 + k0); \
        f32x4 a4; a4.x = gelu_erf((acc.x + l0_ * ilo) * isc) * gt.x; a4.y = gelu_erf((acc.y + l1_ * ilo) * isc) * gt.y; a4.z = gelu_erf((acc.z + l2_ * ilo) * isc) * gt.z; a4.w = gelu_erf((acc.w + l3_ * ilo) * isc) * gt.w; *(LAS f32x4*)((ACT) + k0) = a4; } } while (0)
#define V_ISSUE(buf, TL, kb_) do { _Pragma("unroll") for (int kh = 0; kh < 2; ++kh) { const LAS v4i* ep_ = (const LAS v4i*)(eidx + (TL) * 128 + 8 * (kb_) + 4 * kh); const v4i e4_ = *ep_; const int ee_[4] = {e4_.x, e4_.y, e4_.z, e4_.w}; \
        _Pragma("unroll") for (int kk = 0; kk < 4; ++kk) { const unsigned vo_ = (unsigned)(ee_[kk] & emask) * (unsigned)ROWB + 16u * (unsigned)lane; buf[4 * kh + kk] = *(const GAS v4u*)(V8 + vo_); } \
        __builtin_amdgcn_sched_barrier(0); } } while (0)
#define PIN8x2(a, i) asm volatile("" : "+v"(a[i]), "+v"(a[i + 1]), "+v"(a[i + 2]), "+v"(a[i + 3]), "+v"(a[i + 4]), "+v"(a[i + 5]), "+v"(a[i + 6]), "+v"(a[i + 7]))
#define V_CONSUME(buf, kb_, O, ACT) do { _Pragma("unroll") for (int kk = 0; kk < 8; ++kk) { const float as_ = (ACT)[8 * (kb_) + kk]; const f32x2 a2_ = {as_, as_}; \
        const unsigned vw[4] = {buf[kk].x, buf[kk].y, buf[kk].z, buf[kk].w}; \
        _Pragma("unroll") for (int q = 0; q < 4; ++q) { \
            O[4 * q]     = __builtin_elementwise_fma(__builtin_amdgcn_cvt_scalef32_pk_f32_fp4(vw[q], 1.0f, 0), a2_, O[4 * q]); \
            O[4 * q + 1] = __builtin_elementwise_fma(__builtin_amdgcn_cvt_scalef32_pk_f32_fp4(vw[q], 1.0f, 1), a2_, O[4 * q + 1]); \
            O[4 * q + 2] = __builtin_elementwise_fma(__builtin_amdgcn_cvt_scalef32_pk_f32_fp4(vw[q], 1.0f, 2), a2_, O[4 * q + 2]); \
            O[4 * q + 3] = __builtin_elementwise_fma(__builtin_amdgcn_cvt_scalef32_pk_f32_fp4(vw[q], 1.0f, 3), a2_, O[4 * q + 3]); } \
        PIN8x2(O, 0); PIN8x2(O, 8); } } while (0)
#ifndef NO_GATHER
#ifdef PROBE_L2RES
    constexpr int emask = dry ? PROBE_L2RES : 16383;
#else
    constexpr int emask = 16383;
#endif
    {
    { unsigned k0[4], k1[4];
#pragma unroll
      for (int ti = 0; ti < 4; ++ti) { const int tl = w + 8 * ti; k0[ti] = ((unsigned)eidx[tl * 128 + lane] << 7) | (unsigned)lane; k1[ti] = ((unsigned)eidx[tl * 128 + 64 + lane] << 7) | (unsigned)(64 + lane); }
#pragma unroll
      for (int k = 2; k <= 128; k <<= 1)
#pragma unroll
        for (int j = k >> 1; j > 0; j >>= 1) {
            if (j == 64) {
#pragma unroll
                for (int ti = 0; ti < 4; ++ti) { const unsigned lo_ = k0[ti] < k1[ti] ? k0[ti] : k1[ti], hi_ = k0[ti] < k1[ti] ? k1[ti] : k0[ti]; k0[ti] = lo_; k1[ti] = hi_; }
            } else {
                const bool lower = (lane & j) == 0;
                const bool desc0 = (k == 64) ? false : ((k == 128) ? false : ((lane & k) != 0)), desc1 = (k == 64) ? true : desc0;
                const bool min0 = lower != desc0, min1 = lower != desc1;
#pragma unroll
                for (int ti = 0; ti < 4; ++ti) { const unsigned p0 = (unsigned)__shfl_xor((int)k0[ti], j), p1 = (unsigned)__shfl_xor((int)k1[ti], j);
                    const unsigned mn0 = k0[ti] < p0 ? k0[ti] : p0, mx0 = k0[ti] < p0 ? p0 : k0[ti], mn1 = k1[ti] < p1 ? k1[ti] : p1, mx1 = k1[ti] < p1 ? p1 : k1[ti];
                    k0[ti] = min0 ? mn0 : mx0; k1[ti] = min1 ? mn1 : mx1; }
            }
        }
      float g0[4], g1[4];
#pragma unroll
      for (int ti = 0; ti < 4; ++ti) { const int tl = w + 8 * ti; g0[ti] = gate[tl * 128 + (int)(k0[ti] & 127u)]; g1[ti] = gate[tl * 128 + (int)(k1[ti] & 127u)]; }
      LDS_WAIT(); asm volatile("" ::: "memory");
#pragma unroll
      for (int ti = 0; ti < 4; ++ti) { const int tl = w + 8 * ti; eidx[tl * 128 + lane] = (int)(k0[ti] >> 7); eidx[tl * 128 + 64 + lane] = (int)(k1[ti] >> 7); gate[tl * 128 + lane] = g0[ti]; gate[tl * 128 + 64 + lane] = g1[ti]; }
      LDS_WAIT(); asm volatile("" ::: "memory"); }
    v2u xn[8];
#define X_ISSUE(tok_) do { const unsigned xb_ = (unsigned)(tok_) * (unsigned)(DM * 2) + 8u * (unsigned)lane; _Pragma("unroll") for (int j = 0; j < 8; ++j) xn[j] = __builtin_nontemporal_load((const GAS v2u*)((const unsigned char*)X1B + (xb_ + 512u * j))); } while (0)
    X_ISSUE(T0 + w);
#pragma unroll 1
    for (int ti = 0; ti < 4; ++ti) {
        f32x4 xr[8]; float ss = 0.f;
#pragma unroll
        for (int j = 0; j < 8; ++j) { const v2u r = xn[j]; xr[j] = (f32x4){bflo(r.x), bfhi(r.x), bflo(r.y), bfhi(r.y)}; }
        X_ISSUE(T0 + w + 8 * (ti < 3 ? ti + 1 : 3));
#pragma unroll
        for (int j = 0; j < 8; ++j) ss += (xr[j].x * xr[j].x + xr[j].y * xr[j].y) + (xr[j].z * xr[j].z + xr[j].w * xr[j].w);
        const float rs2 = __builtin_amdgcn_rsqf(wave_sum(ss) * (1.f / DM) + EPS);
        const float* fg_ = fgain; asm volatile("" : "+s"(fg_));
        const unsigned char* gp = (const unsigned char*)fg_; const unsigned go = 16u * (unsigned)lane;
        unsigned hw[4], lw[4];
#pragma unroll
        for (int q = 0; q < 4; ++q) { unsigned wh = 0u, wl = 0u;
#pragma unroll
            for (int t = 0; t < 2; ++t) { const int j = 2 * q + t; const f32x4 gg = *(const GAS f32x4*)(gp + (go + 1024u * j)); const f32x4 hv = xr[j] * gg * (rs2 * SH4);
                const float h0 = clampf(hv.x, 6.f), h1 = clampf(hv.y, 6.f), h2 = clampf(hv.z, 6.f), h3 = clampf(hv.w, 6.f);
                const unsigned p0 = __builtin_amdgcn_cvt_scalef32_pk_fp4_f32(0u, h0, h1, 1.0f, 0), p1 = __builtin_amdgcn_cvt_scalef32_pk_fp4_f32(0u, h2, h3, 1.0f, 0);
                const f32x2 d0 = __builtin_amdgcn_cvt_scalef32_pk_f32_fp4(p0, 1.0f, 0), d1 = __builtin_amdgcn_cvt_scalef32_pk_f32_fp4(p1, 1.0f, 0);
                const unsigned r0 = __builtin_amdgcn_cvt_scalef32_pk_fp4_f32(0u, clampf((h0 - d0.x) * SLO4, 6.f), clampf((h1 - d0.y) * SLO4, 6.f), 1.0f, 0), r1 = __builtin_amdgcn_cvt_scalef32_pk_fp4_f32(0u, clampf((h2 - d1.x) * SLO4, 6.f), clampf((h3 - d1.y) * SLO4, 6.f), 1.0f, 0);
                wh |= ((p0 & 0xFFu) | ((p1 & 0xFFu) << 8)) << (16 * t); wl |= ((r0 & 0xFFu) | ((r1 & 0xFFu) << 8)) << (16 * t); }
            hw[q] = wh; lw[q] = wl; }
        *(LAS v4u*)(hnb + 2048 * ti + 16 * lane) = (v4u){hw[0], hw[1], hw[2], hw[3]}; *(LAS v4u*)(hnb + 2048 * ti + 1024 + 16 * lane) = (v4u){lw[0], lw[1], lw[2], lw[3]};
    }
    LDS_WAIT();
    { int e_cur = eidx[w * 128 + c16] & emask;
      U_ISSUE(bA, e_cur, 0);
#pragma unroll 1
      for (int s_ = 0; s_ < 31; ++s_) {
          const int ti = s_ & 3, grp = s_ >> 2, tl = w + 8 * ti, sn = s_ + 1;
          const int e_nxt = eidx[(w + 8 * (sn & 3)) * 128 + 16 * (sn >> 2) + c16] & emask;
          const LAS unsigned char* hbt = hb + 2048 * ti; LAS float* actt = actl + 128 * ti;
          f32x4 acc = (f32x4){0.f, 0.f, 0.f, 0.f};
          U_ISSUE(bB, e_cur, 1); U_CONSUME(bA, 0, hbt);
          U_ISSUE(bA, e_nxt, 0);
          U_CONSUME(bB, 1, hbt);
          U_ACT(grp, tl, actt);
          e_cur = e_nxt;
      }
      { const LAS unsigned char* hbt = hb + 2048 * 3; LAS float* actt = actl + 128 * 3;
        f32x4 acc = (f32x4){0.f, 0.f, 0.f, 0.f};
        U_ISSUE(bB, e_cur, 1); U_CONSUME(bA, 0, hbt);
        V_ISSUE(bA, w, 0);
        U_CONSUME(bB, 1, hbt);
        U_ACT(7, w + 24, actt); } }
    LDS_WAIT();
    f32x2 o2[4][16];
#pragma unroll
    for (int ti = 0; ti < 4; ++ti)
#pragma unroll
        for (int i = 0; i < 16; ++i) o2[ti][i] = (f32x2){0.f, 0.f};
#pragma unroll 1
    for (int grp = 0; grp < 8; ++grp) {
        const int gn = grp < 7 ? grp + 1 : 7;
        V_ISSUE(bB, w, 2 * grp + 1);      V_CONSUME(bA, 2 * grp, o2[0], actl);       V_ISSUE(bA, w + 8, 2 * grp);  V_CONSUME(bB, 2 * grp + 1, o2[0], actl);
        V_ISSUE(bB, w + 8, 2 * grp + 1);  V_CONSUME(bA, 2 * grp, o2[1], actl + 128); V_ISSUE(bA, w + 16, 2 * grp); V_CONSUME(bB, 2 * grp + 1, o2[1], actl + 128);
        V_ISSUE(bB, w + 16, 2 * grp + 1); V_CONSUME(bA, 2 * grp, o2[2], actl + 256); V_ISSUE(bA, w + 24, 2 * grp); V_CONSUME(bB, 2 * grp + 1, o2[2], actl + 256);
        V_ISSUE(bB, w + 24, 2 * grp + 1); V_CONSUME(bA, 2 * grp, o2[3], actl + 384); V_ISSUE(bA, w, 2 * gn);       V_CONSUME(bB, 2 * grp + 1, o2[3], actl + 384);
    }
    X_ISSUE(T0 + w);
#pragma unroll
    for (int ti = 0; ti < 4; ++ti) {
        const size_t token = (size_t)T0 + w + 8 * ti;
        const unsigned xo = (unsigned)token * (unsigned)(DM * 4) + 16u * (unsigned)lane;
        f32x4 xr[8];
#pragma unroll
        for (int j = 0; j < 8; ++j) { const v2u r = xn[j]; xr[j] = (f32x4){bflo(r.x), bfhi(r.x), bflo(r.y), bfhi(r.y)}; }
        if (ti < 3) X_ISSUE(T0 + w + 8 * (ti + 1));
        constexpr float isv = 1.f / SV; float s2 = 0.f;
#pragma unroll
        for (int j = 0; j < 8; ++j) { xr[j] = xr[j] + (f32x4){o2[ti][2 * j].x, o2[ti][2 * j].y, o2[ti][2 * j + 1].x, o2[ti][2 * j + 1].y} * isv;
            s2 += (xr[j].x * xr[j].x + xr[j].y * xr[j].y) + (xr[j].z * xr[j].z + xr[j].w * xr[j].w); }
        const float rf = __builtin_amdgcn_rsqf(wave_sum(s2) * (1.f / DM) + EPS);
        const float* fi_ = fing; asm volatile("" : "+s"(fi_));
        const unsigned char* fp = (const unsigned char*)fi_; unsigned char* op = (unsigned char*)outp; const unsigned fo = 16u * (unsigned)lane;
        if (!dry || rf == 1.2345e30f)
#pragma unroll
        for (int j = 0; j < 8; ++j) __builtin_nontemporal_store(xr[j] * rf * *(const GAS f32x4*)(fp + (fo + 1024u * j)), (GAS f32x4*)(op + (xo + 1024u * j)));
    }
    }
#endif
#undef U_ISSUE
#undef X_ISSUE
#undef U_ACT
#undef U_CONSUME
#undef V_ISSUE
#undef V_CONSUME
    __syncthreads();
}

__global__ void __launch_bounds__(NWAVES * 64, 2) hybrid_fwd(Args args) {
    extern __shared__ __attribute__((aligned(16))) unsigned char lds[];
    Frame F;
    F.lds = (LAS unsigned char*)lds;
    F.MISC = (volatile LAS unsigned*)(F.lds + MISC_OFF);
    F.tid = threadIdx.x; F.lane = F.tid & 63; F.wave = __builtin_amdgcn_readfirstlane(F.tid >> 6); F.G = gridDim.x;
    for (int u = F.tid; u < (LDS_BYTES - LDSCTL_OFF) / 4; u += NWAVES * 64) ((LAS unsigned*)(F.lds + LDSCTL_OFF))[u] = 0u;
    __syncthreads();
    (void)args;
    XcdBarrier bar = xcd_barrier_post(F.ctl() + CW_BAR, F.MISC + 8);

#ifndef NO_P0
#ifdef PROBE_P0X2
    { int reps = 2; asm volatile("" : "+s"(reps)); for (int rep = 0; rep < reps; ++rep) p0_prologue(F); }
#else
    p0_prologue(F);
#endif
#endif
    xcd_barrier(bar);
#ifndef NO_P1
#ifdef PROBE_GX2
    { int reps = 2; asm volatile("" : "+s"(reps)); for (int rep = 0; rep < reps; ++rep) {
#else
    { { const int rep = 0, reps = 1;
#endif
      pg8::Gemm gm{F.HN(), F.WinT(), MTOK, NB16, DM}; pg8::StaticOrder S; S.init(MTOK, NB16, F.G, (int)blockIdx.x);
      EpiProj E{F.PROJ(), F.dtraw(), (rep + 1 < reps) ? nullptr : F.kmean()};
      pg8::gemm_phase<EpiProj, pg8::StaticOrder, PG8_ALIGN, PG8_SP2>(F.lds + RING_OFF, gm, S, E); } }
    { const int nun = (MTOK / 256) * (NB16 / 256), rem = nun % F.G;
      if (rem && (int)blockIdx.x >= rem) tables_convert(F, tab_split(F.G), TAB_ITEMS, (size_t)((int)blockIdx.x - rem) * (NWAVES * 64) + fresh_tid(), (size_t)(F.G - rem) * (NWAVES * 64)); }
    __syncthreads();
    {
      pg8::Gemm gm{(const pg8::bf16_t*)F.HN8(), (const pg8::bf16_t*)F.WinT8(), MTOK, F8_HI - F8_LO, DM / 2}; pg8::StaticOrder S; S.init(MTOK, F8_HI - F8_LO, F.G, (int)blockIdx.x);
      EpiProj8 E{F.PROJ()};
      pg8::gemm_phase<EpiProj8, pg8::StaticOrder, PG8_ALIGN, PG8_SP2, true>(F.lds + RING_OFF, gm, S, E); }
#endif
    xcd_barrier(bar);
#ifdef PROBE_P15X2
    conv_phase(F);
#endif
    conv_phase(F);
    xcd_barrier(bar);
#ifdef PROBE_P2X2
    { int reps = 2; asm volatile("" : "+s"(reps)); for (int rep = 0; rep < reps; ++rep) {
#else
    { { const int rep = 0, reps = 1;
#endif
    const bool doatom = rep + 1 == reps;
    for (;;) {
        if (F.tid == 0) F.MISC[0] = xb_add(F.ctl() + CW_Q2 + 64 * rep, 1u);
        __syncthreads();
        const int ui = (int)F.MISC[0];
        __syncthreads();
        if (ui >= 128 + 512) break;
#ifdef PROBE_P2_SSD
        if (ui < 128 || doatom)
#endif
#ifdef PROBE_P2_ATT
        if (ui >= 128 || doatom)
#endif
        {
        if (ui < 128) ssd_unit(F, ui >> 4, ui & 15, doatom);
        else { const int a = ui - 128; attn_unit(F, (a & 63) >> 3, a & 7, 7 - (a >> 6), doatom); }
        }
    } } }
    xcd_barrier(bar);
#ifndef NO_P3
#ifdef PROBE_GX2
    { int reps = 2; asm volatile("" : "+s"(reps)); for (int rep = 0; rep < reps; ++rep) {
#else
    { { const int rep = 0, reps = 1;
#endif
      pg8::Gemm gm{F.HN(), F.WoutT(), MTOK, DM, DM / 2}; pg8::StaticOrder S; S.init(MTOK, DM, F.G, (int)blockIdx.x);
      {
        const int t_ = fresh_tid(); const float* const sq = F.ssq();
#pragma unroll 1
        for (int ii = t_ >> 8; ii < 3; ii += 2) { pg8::Unit uu;
          if (S.next(ii, uu)) { const int row = uu.pm * 256 + (t_ & 255);
            const float q1 = __hip_atomic_load(sq + (size_t)row * 4 + 1, RLX_AGENT), q2 = __hip_atomic_load(sq + (size_t)row * 4 + 2, RLX_AGENT), q3 = __hip_atomic_load(sq + (size_t)row * 4 + 3, RLX_AGENT);
            const float sa = __builtin_amdgcn_rsqf(q1 * (1.f / 1024.f) + EPS), s0 = __builtin_amdgcn_rsqf(q2 * (1.f / 512.f) + EPS), s1 = __builtin_amdgcn_rsqf(q3 * (1.f / 512.f) + EPS);
            *(LAS f32x4*)(F.lds + SEGTAB_OFF + (ii * 256 + (t_ & 255)) * 16) = (f32x4){sa / s0 * (SS8 / SA8), s0 / s1, s1 * (1.f / (SS8 * SW8)), 0.f}; } }
        __syncthreads(); }
      EpiOut E{F.x(), F.X1B(), F.X18(), F.ssq(), rep + 1 == reps, (const LAS f32x4*)(F.lds + SEGTAB_OFF)};
      pg8::gemm_phase<EpiOut, pg8::StaticOrder, PG8_ALIGN, PG8_SP2, true>(F.lds + RING_OFF, gm, S, E); } }
#endif
    xcd_barrier(bar);
#ifndef NO_P4
#ifdef PROBE_GX2
    { int reps = 2; asm volatile("" : "+s"(reps)); for (int rep = 0; rep < reps; ++rep) {
#else
    { { const int rep = 0, reps = 1; (void)rep; (void)reps;
#endif
      pg8::Gemm gm{(const pg8::bf16_t*)F.X18(), F.WqT(), MTOK, DM, DM / 2}; pg8::StaticOrder S; S.init(MTOK, DM, F.G, (int)blockIdx.x);
      EpiQ E{F.QP(), F.ssq()};
      pg8::gemm_phase<EpiQ, pg8::StaticOrder, PG8_ALIGN, PG8_SP2, true>(F.lds + RING_OFF, gm, S, E); } }
#endif
    xcd_barrier(bar);
#ifndef NO_P5
#ifdef PROBE_P5X2
    { for (int u = blockIdx.x; u < MTOK / 32; u += F.G) peer_unit<true>(F, u);
      for (int u = blockIdx.x; u < MTOK / 32; u += F.G) peer_unit<false>(F, u); }
#else
    for (int u = blockIdx.x; u < MTOK / 32; u += F.G) peer_unit(F, u);
#endif
#endif
}

extern "C" void kernel_launch(void* const* d_in, const int* in_sizes, int n_in, void* d_out, int out_size, void* d_ws, size_t ws_size, hipStream_t stream) {
    static int grid = 0;
    if (grid == 0) {
        if (n_in != 18 || out_size != MTOK * DM || ws_size < WS_END) { fprintf(stderr, "kernel_launch: unexpected shapes (n_in %d, out %d, ws %zu)\n", n_in, out_size, ws_size); grid = -1; return; }
        int dev = 0, cus = 0, per_cu = 0;
        if (hipGetDevice(&dev) != hipSuccess || hipDeviceGetAttribute(&cus, hipDeviceAttributeMultiprocessorCount, dev) != hipSuccess) { grid = -1; return; }
        if (hipFuncSetAttribute((const void*)hybrid_fwd, hipFuncAttributeMaxDynamicSharedMemorySize, LDS_BYTES) != hipSuccess) { fprintf(stderr, "kernel_launch: hipFuncSetAttribute failed\n"); grid = -1; return; }
        if (hipOccupancyMaxActiveBlocksPerMultiprocessor(&per_cu, (const void*)hybrid_fwd, NWAVES * 64, LDS_BYTES) != hipSuccess || per_cu < 1)
            fprintf(stderr, "kernel_launch: note: occupancy query reports %d workgroups per CU\n", per_cu);
        (void)hipGetLastError();
        grid = cus;
    }
    if (grid < 0) return;
    if (hipMemsetAsync((char*)d_ws + WS_CTL, 0, CTL_ZERO_BYTES, stream) != hipSuccess) return;
    Args a{};
    for (int i = 0; i < 18; ++i) a.in[i] = (const float*)d_in[i];
    a.out = (float*)d_out; a.ws = (unsigned char*)d_ws;
    hipLaunchKernelGGL(hybrid_fwd, dim3(grid), dim3(NWAVES * 64), LDS_BYTES, stream, a);
}
```

```cpp
#include <hip/hip_runtime.h>
#include <cstdio>
#include <cstdint>
namespace pg8 {
#define PG8_LAS __attribute__((address_space(3)))
typedef unsigned short bf16_t;
typedef short bf16x8 __attribute__((ext_vector_type(8)));
typedef float f32x4 __attribute__((ext_vector_type(4)));
typedef unsigned u32x4 __attribute__((ext_vector_type(4)));
constexpr int BM = 256, BK = 64, HALF = 128, HTB = HALF * BK * 2  , STAGE_BYTES = 8 * HTB, NXCD = 8, WGM = 8;

__host__ __device__ __forceinline__ int lds_byte(int r, int c) { const int st = (r >> 4) * 2 + (c >> 5), rr = r & 15, cc = c & 31, ob = rr * 64 + cc * 2; return st * 1024 + (ob ^ (((ob >> 9) & 1) << 5)); }
__host__ __device__ __forceinline__ void stage_rc(int b, int& R, int& C) { const int st = b / 1024, sb = b % 1024, swz = sb ^ (((sb >> 9) & 1) << 5); R = (st >> 1) * 16 + swz / 64; C = (st & 1) * 32 + (swz % 64) / 2; }
__host__ __device__ __forceinline__ int perm32(int rho) { const int n = rho >> 4, i = rho & 15; return 8 * (i >> 2) + 4 * n + (i & 3); }

struct Unit { int pm, pn; };
struct Gemm { const bf16_t* A; const bf16_t* Bt; int M, N, K; };

struct StaticOrder {
    int nM, nN, nwg, G, c;
    __host__ __device__ void init(int M, int N, int G_, int c_) { nM = M / BM; nN = N / BM; nwg = nM * nN; G = G_; c = c_; }
    __host__ __device__ bool next(int i, Unit& u) const {
        const long L = (long)i * G + c; if (L >= nwg) return false;
        int wgid = (int)L; { const int q = nwg / NXCD, r = nwg % NXCD, xcd = wgid % NXCD, off = wgid / NXCD; wgid = (xcd < r ? xcd * (q + 1) : r * (q + 1) + (xcd - r) * q) + off; }
        const int nig = WGM * nN, gid = wgid / nig, fm = gid * WGM, gsz = (nM - fm) < WGM ? (nM - fm) : WGM;
        u.pm = fm + ((wgid % nig) % gsz); u.pn = (wgid % nig) / gsz; return true;
    }
    __device__ __forceinline__ void a_ready(const Unit&) const {}
    __device__ __forceinline__ void done(const Unit&) const {}
};

__device__ __forceinline__ unsigned cvt_pk_bf16(float lo, float hi) { unsigned r; asm volatile("v_cvt_pk_bf16_f32 %0, %1, %2" : "=v"(r) : "v"(lo), "v"(hi)); return r; }
typedef float f32x2 __attribute__((ext_vector_type(2)));
__device__ __forceinline__ f32x2 gelu_pk(f32x2 v) {
    const f32x2 av = __builtin_elementwise_abs(v), d = av * 0.2316418882f + 1.0f;
    f32x2 t; t.x = __builtin_amdgcn_rcpf(d.x); t.y = __builtin_amdgcn_rcpf(d.y);
    f32x2 q = t * 0.5307027145f + (-0.7265760135f); q = q * t + 0.7107068705f; q = q * t + (-0.142248368f); q = q * t + 0.127414796f; q = q * t;
    const f32x2 s = (v * v) * (-0.72134752044f);
    f32x2 e; e.x = __builtin_amdgcn_exp2f(s.x); e.y = __builtin_amdgcn_exp2f(s.y);
    const f32x2 m = v * (q * e), r = v - m;
    f32x2 o; o.x = v.x < 0.f ? m.x : r.x; o.y = v.y < 0.f ? m.y : r.y; return o;
}

template <int ACT  > struct EpiBf16 {
    static constexpr bool PERM = true, AFTER_DRAIN = false, SEG = false; static_assert(ACT == 0 || ACT == 1, "EpiBf16: ACT is 0 (none) or 1 (gelu_pk)");
    bf16_t* O; int ldc; const float* bias; int split_cols; size_t split_stride; float scale0;
    __device__ __forceinline__ void operator()(const f32x4 (&acc)[2][2][4][2], const Unit& u, int wr, int wc, int fr, int fq) const {
        const int row0 = u.pm * BM + wr * 64 + fr; int colt = u.pn * BM; bf16_t* base = O;
        float sc = 1.f; if (split_cols) { const int t = colt / split_cols; base += (size_t)t * split_stride; colt -= t * split_cols; if (t == 0) sc = scale0; }
        const int col0 = colt + wc * 32 + 8 * fq, bcol0 = u.pn * BM + wc * 32 + 8 * fq;
        f32x4 bv[2][2];
#pragma unroll
        for (int bj = 0; bj < 2; ++bj)
#pragma unroll
            for (int n = 0; n < 2; ++n) bv[bj][n] = bias ? *(const f32x4*)(bias + bcol0 + bj * HALF + 4 * n) : (f32x4){0.f, 0.f, 0.f, 0.f};
#pragma unroll
        for (int ai = 0; ai < 2; ++ai)
#pragma unroll
            for (int m = 0; m < 4; ++m) { bf16_t* rowp = base + (size_t)(row0 + ai * HALF + m * 16) * ldc + col0;
#pragma unroll
                for (int bj = 0; bj < 2; ++bj) { f32x4 v0 = acc[ai][bj][m][0] + bv[bj][0], v1 = acc[ai][bj][m][1] + bv[bj][1];
                    if (ACT == 1) { f32x2 a = gelu_pk((f32x2){v0[0], v0[1]}), b = gelu_pk((f32x2){v0[2], v0[3]}), c = gelu_pk((f32x2){v1[0], v1[1]}), d = gelu_pk((f32x2){v1[2], v1[3]});
                        v0 = (f32x4){a.x, a.y, b.x, b.y}; v1 = (f32x4){c.x, c.y, d.x, d.y}; }
                    v0 = v0 * sc; v1 = v1 * sc; u32x4 w; w.x = cvt_pk_bf16(v0[0], v0[1]); w.y = cvt_pk_bf16(v0[2], v0[3]); w.z = cvt_pk_bf16(v1[0], v1[1]); w.w = cvt_pk_bf16(v1[2], v1[3]);
                    *(u32x4*)(rowp + bj * HALF) = w; } }
    }
};
template <class Epi, class Sched, bool ALIGN_EPI = false, bool SP2 = false, bool F8 = false>
__device__ __forceinline__ void gemm_phase(PG8_LAS unsigned char* lds, const Gemm g, const Sched& S, const Epi& E) {
    int tid_ = threadIdx.x; asm volatile("" : "+v"(tid_));
    const int tid = tid_, wid = __builtin_amdgcn_readfirstlane(tid >> 6), lane = tid & 63, wr = wid >> 2, wc = wid & 3, fr = lane & 15, fq = lane >> 4;
    const int K = g.K, nt = K / BK;
    unsigned voffA[2], voffB[2];
#pragma unroll
    for (int i = 0; i < 2; ++i) { int R, C; stage_rc(tid * 16 + i * 8192, R, C); const int Rb = Epi::PERM ? ((R & ~31) + perm32(R & 31)) : R;
        voffA[i] = (unsigned)(R * K + C) * 2u; voffB[i] = (unsigned)(Rb * K + C) * 2u; }
    const size_t kstep = (size_t)(BK * 2);
    const size_t hstep = (size_t)HALF * K * 2;
    const size_t tstep = 2 * hstep;
    const unsigned ldsw = (unsigned)wid * 1024u;
    const int aoff = lds_byte(wr * 64 + fr, fq * 8), boff = lds_byte(wc * 32 + fr, fq * 8);
#define PG8_SA(b, h) (((b) * 2 + (h)) * HTB)
#define PG8_SB(b, h) ((4 + (b) * 2 + (h)) * HTB)
#define PG8_STAGE(bufoff, gbase, voff) do { _Pragma("unroll") for (int _i = 0; _i < 2; ++_i) \
        __builtin_amdgcn_global_load_lds((const unsigned*)((const char*)(gbase) + (voff)[_i]), (PG8_LAS unsigned*)(lds + (bufoff) + ldsw + _i * 8192), 16, 0, 0); } while (0)
#define PG8_LDA(dst, b, h) do { _Pragma("unroll") for (int m = 0; m < 4; ++m) _Pragma("unroll") for (int k = 0; k < 2; ++k) dst[m][k] = *(const PG8_LAS bf16x8*)(lds + PG8_SA(b, h) + aoff + m * 2048 + k * 1024); } while (0)
#define PG8_LDB(dst, b, h) do { _Pragma("unroll") for (int n = 0; n < 2; ++n) _Pragma("unroll") for (int k = 0; k < 2; ++k) dst[n][k] = *(const PG8_LAS bf16x8*)(lds + PG8_SB(b, h) + boff + n * 2048 + k * 1024); } while (0)
#define PG8_MMA(ai, bj, At, Bt) do { __builtin_amdgcn_s_setprio(1); _Pragma("unroll") for (int m = 0; m < 4; ++m) _Pragma("unroll") for (int n = 0; n < 2; ++n) { \
        if constexpr (F8) { typedef int v8i_ __attribute__((ext_vector_type(8))); typedef int v4i_ __attribute__((ext_vector_type(4))); \
            const v4i_ b0_ = __builtin_bit_cast(v4i_, Bt[n][0]), b1_ = __builtin_bit_cast(v4i_, Bt[n][1]), a0_ = __builtin_bit_cast(v4i_, At[m][0]), a1_ = __builtin_bit_cast(v4i_, At[m][1]); \
            const v8i_ bb_ = {b0_.x, b0_.y, b0_.z, b0_.w, b1_.x, b1_.y, b1_.z, b1_.w}, aa_ = {a0_.x, a0_.y, a0_.z, a0_.w, a1_.x, a1_.y, a1_.z, a1_.w}; \
            asm volatile("v_mfma_scale_f32_16x16x128_f8f6f4 %0, %1, %2, %0, %3, %3 op_sel_hi:[0,0,0]" : "+v"(acc[ai][bj][m][n]) : "v"(bb_), "v"(aa_), "v"(f8one)); } \
        else { _Pragma("unroll") for (int k = 0; k < 2; ++k) acc[ai][bj][m][n] = __builtin_amdgcn_mfma_f32_16x16x32_bf16(Bt[n][k], At[m][k], acc[ai][bj][m][n], 0, 0, 0); } } \
        __builtin_amdgcn_s_setprio(0); } while (0)
#define PG8_WAIT_V(n) asm volatile("s_waitcnt vmcnt(" #n ")" ::: "memory")
#define PG8_WAIT_L(n) asm volatile("s_waitcnt lgkmcnt(" #n ")" ::: "memory")
#define PG8_BAR __builtin_amdgcn_s_barrier()
#define PG8_SCHED __builtin_amdgcn_sched_barrier(0)
    Unit cur, nxt; int ui = 0;
    if (!S.next(0, cur)) return;
    f32x4 acc[2][2][4][2];
    const int f8one = 0x7f7f7f7f;
#pragma unroll
    for (int a = 0; a < 2; ++a)
#pragma unroll
        for (int b = 0; b < 2; ++b)
#pragma unroll
            for (int m = 0; m < 4; ++m)
#pragma unroll
                for (int n = 0; n < 2; ++n) acc[a][b][m][n] = (f32x4){0.f, 0.f, 0.f, 0.f};
    bf16x8 At[4][2], B0[2][2], B1[2][2];
    const char* cA = (const char*)g.A + (size_t)cur.pm * tstep; const char* cB = (const char*)g.Bt + (size_t)cur.pn * tstep;
    S.a_ready(cur);
    float segr[16];
    if constexpr (Epi::SEG) E.seg_load(ui, wr, fr, segr);
    if constexpr (SP2) {
        PG8_STAGE(PG8_SB(0, 0), cB, voffB); PG8_STAGE(PG8_SB(0, 1), cB + hstep, voffB); PG8_STAGE(PG8_SA(0, 0), cA, voffA); PG8_STAGE(PG8_SA(0, 1), cA + hstep, voffA);
        if (wr == 1) PG8_BAR;
        PG8_WAIT_V(2); PG8_BAR;
        PG8_STAGE(PG8_SB(1, 0), cB + kstep, voffB); PG8_STAGE(PG8_SA(1, 0), cA + kstep, voffA); PG8_STAGE(PG8_SB(1, 1), cB + hstep + kstep, voffB);
        PG8_WAIT_V(6); PG8_BAR;
    } else {
        PG8_STAGE(PG8_SB(0, 0), cB, voffB); PG8_STAGE(PG8_SA(0, 0), cA, voffA); PG8_STAGE(PG8_SB(0, 1), cB + hstep, voffB); PG8_STAGE(PG8_SA(0, 1), cA + hstep, voffA);
        if (wr == 1) PG8_BAR;
        PG8_WAIT_V(4); PG8_BAR;
        PG8_STAGE(PG8_SB(1, 0), cB + kstep, voffB); PG8_STAGE(PG8_SA(1, 0), cA + kstep, voffA); PG8_STAGE(PG8_SB(1, 1), cB + hstep + kstep, voffB);
        PG8_WAIT_V(6); PG8_BAR;
    }
    for (;;) {
        const bool has_next = S.next(ui + 1, nxt);
        const char* nA = has_next ? (const char*)g.A + (size_t)nxt.pm * tstep : cA; const char* nB = has_next ? (const char*)g.Bt + (size_t)nxt.pn * tstep : cB;
        int t = 0;
#pragma unroll 1
        for (int sgi = 0; sgi < (Epi::SEG ? 3 : 1); ++sgi) {
        int tend = nt; if constexpr (Epi::SEG) tend = (sgi == 0) ? Epi::SEG_T1 : ((sgi == 1) ? Epi::SEG_T2 : nt);
        for (; t < tend; t += 2) {
            const bool last = (t == nt - 2);
            const char* a1 = cA + (size_t)(t + 1) * kstep;
            const char* a2 = last ? nA : cA + (size_t)(t + 2) * kstep; const char* b2 = last ? nB : cB + (size_t)(t + 2) * kstep;
            const char* a3 = a2 + kstep; const char* b3 = b2 + kstep;
            if (last && has_next) S.a_ready(nxt);
            if constexpr (SP2) {
            PG8_LDB(B0, 0, 0); PG8_LDB(B1, 0, 1); PG8_SCHED; PG8_LDA(At, 0, 0); PG8_STAGE(PG8_SA(1, 1), a1 + hstep, voffA);
            PG8_WAIT_V(8); PG8_WAIT_L(0); PG8_BAR; PG8_MMA(0, 0, At, B0); PG8_MMA(0, 1, At, B1); PG8_BAR; PG8_SCHED;
            PG8_LDA(At, 0, 1); PG8_STAGE(PG8_SB(0, 0), b2, voffB); PG8_STAGE(PG8_SB(0, 1), b2 + hstep, voffB); PG8_STAGE(PG8_SA(0, 0), a2, voffA);
            PG8_WAIT_V(8); PG8_WAIT_L(0); PG8_BAR; PG8_MMA(1, 0, At, B0); PG8_MMA(1, 1, At, B1); PG8_BAR; PG8_SCHED;
            PG8_LDB(B0, 1, 0); PG8_LDB(B1, 1, 1); PG8_SCHED; PG8_LDA(At, 1, 0); PG8_STAGE(PG8_SA(0, 1), a2 + hstep, voffA);
            PG8_WAIT_V(8); PG8_WAIT_L(0); PG8_BAR; PG8_MMA(0, 0, At, B0); PG8_MMA(0, 1, At, B1); PG8_BAR; PG8_SCHED;
            PG8_LDA(At, 1, 1); PG8_STAGE(PG8_SB(1, 0), b3, voffB); PG8_STAGE(PG8_SB(1, 1), b3 + hstep, voffB); PG8_STAGE(PG8_SA(1, 0), a3, voffA);
            PG8_WAIT_V(8); PG8_WAIT_L(0); PG8_BAR; PG8_MMA(1, 0, At, B0); PG8_MMA(1, 1, At, B1); PG8_BAR; PG8_SCHED;
            } else {
            PG8_LDB(B0, 0, 0); PG8_SCHED; PG8_LDA(At, 0, 0); PG8_STAGE(PG8_SA(1, 1), a1 + hstep, voffA);
            PG8_WAIT_L(8); PG8_BAR; PG8_WAIT_L(0); PG8_MMA(0, 0, At, B0); PG8_BAR; PG8_SCHED;
            PG8_LDB(B1, 0, 1); PG8_STAGE(PG8_SB(0, 0), b2, voffB);
            PG8_BAR; PG8_WAIT_L(0); PG8_MMA(0, 1, At, B1); PG8_BAR;
            PG8_LDA(At, 0, 1); PG8_STAGE(PG8_SA(0, 0), a2, voffA);
            PG8_BAR; PG8_WAIT_L(0); PG8_MMA(1, 0, At, B0); PG8_BAR; PG8_SCHED;
            PG8_STAGE(PG8_SB(0, 1), b2 + hstep, voffB);
            PG8_WAIT_V(6); PG8_BAR; PG8_MMA(1, 1, At, B1); PG8_BAR;
            PG8_LDB(B0, 1, 0); PG8_SCHED; PG8_LDA(At, 1, 0); PG8_STAGE(PG8_SA(0, 1), a2 + hstep, voffA);
            PG8_WAIT_L(8); PG8_BAR; PG8_WAIT_L(0); PG8_MMA(0, 0, At, B0); PG8_BAR; PG8_SCHED;
            PG8_LDB(B1, 1, 1); PG8_STAGE(PG8_SB(1, 0), b3, voffB);
            PG8_BAR; PG8_WAIT_L(0); PG8_MMA(0, 1, At, B1); PG8_BAR;
            PG8_LDA(At, 1, 1); PG8_STAGE(PG8_SA(1, 0), a3, voffA);
            PG8_BAR; PG8_WAIT_L(0); PG8_MMA(1, 0, At, B0); PG8_BAR; PG8_SCHED;
            PG8_STAGE(PG8_SB(1, 1), b3 + hstep, voffB);
            PG8_WAIT_V(6); PG8_BAR; PG8_MMA(1, 1, At, B1); PG8_BAR;
            }
        }
        if constexpr (Epi::SEG) E.seg_apply(acc, segr, sgi);
        }
        if constexpr (ALIGN_EPI) { if (wr == 0) PG8_BAR; }
        if constexpr (!Epi::AFTER_DRAIN) { if constexpr (Epi::SEG) E(acc, cur, wr, wc, fr, fq, ui); else E(acc, cur, wr, wc, fr, fq); S.done(cur); }
        if (!has_next) break;
#pragma unroll
        for (int a = 0; a < 2; ++a)
#pragma unroll
            for (int b = 0; b < 2; ++b)
#pragma unroll
                for (int m = 0; m < 4; ++m)
#pragma unroll
                    for (int n = 0; n < 2; ++n) acc[a][b][m][n] = (f32x4){0.f, 0.f, 0.f, 0.f};
        cur = nxt; cA = nA; cB = nB; ++ui;
        if constexpr (Epi::SEG) E.seg_load(ui, wr, fr, segr);
        if constexpr (ALIGN_EPI) { if (wr == 1) PG8_BAR; }
    }
    PG8_WAIT_V(0);
    if constexpr (!ALIGN_EPI) { if (wr == 0) PG8_BAR; }
    PG8_BAR;
    if constexpr (Epi::AFTER_DRAIN) { E.fused(acc, cur, wr, wc, fr, fq, lds, wid, lane); S.done(cur); }
#undef PG8_SA
#undef PG8_SB
#undef PG8_STAGE
#undef PG8_LDA
#undef PG8_LDB
#undef PG8_MMA
#undef PG8_WAIT_V
#undef PG8_WAIT_L
#undef PG8_BAR
#undef PG8_SCHED
}
}
#ifndef PG8_SP2
#define PG8_SP2 true
#endif
#ifndef PG8_ALIGN
#define PG8_ALIGN true
#endif

constexpr int BATCH = 8, SEQ = 2048, DM = 2048, MTOK = BATCH * SEQ;
constexpr int ATT_W = 1024, ATT_H = 8, ATT_HD = 128, MOBA_BLK = 256, NBLK = SEQ / MOBA_BLK;
constexpr int SSM_W = 1024, SSM_H = 16, SSM_P = 64, SSM_N = 128, SSM_L = 128, SSM_NC = SEQ / SSM_L, CONV_CH = 1536;
constexpr int IN_PROJ = 5648, NPROJ = 5632  , NPAD = 5888  ;
constexpr int F8_LO = 2048, F8_HI = 4096, NB16 = NPAD - (F8_HI - F8_LO)  ;
constexpr float SH8 = 16.f;
constexpr int COL_Q = 0, COL_K = 1024, COL_V = 2048, COL_Z = 3072, COL_XBC = 4096;
constexpr int PEER_H = 8, PEER_NK = 128, PEER_K = 16, PEER_HK = 128;
constexpr float EPS = 1e-6f;
constexpr float SU = 64.f, SV = 4.f, SH = 16.f, SLO = 16.f;
constexpr float SX8 = 16.f, SW8 = 1024.f;
constexpr float SA8 = 32.f, SS8 = 8.f;
constexpr float SH4 = 1.5f, SLO4 = 4.f;
constexpr int ROWB = DM / 2;

constexpr size_t MiB = 1u << 20;
constexpr size_t WS_CTL = 0, CTL_ZERO_BYTES = 1 * MiB;
constexpr size_t WS_DT = 1 * MiB;
constexpr size_t WS_SK = 2 * MiB;
constexpr size_t WS_WIN = 4 * MiB;
constexpr size_t WS_WIN8 = 24 * MiB;
constexpr size_t WS_HN8 = 396 * MiB;
constexpr size_t WS_WOUT = 28 * MiB;
constexpr size_t WS_WQ = 36 * MiB;
constexpr size_t WS_HN = 44 * MiB;
constexpr size_t WS_PROJ = 108 * MiB;
constexpr size_t WS_X1B = WS_PROJ, WS_QP = WS_PROJ + 64 * MiB;
constexpr size_t WS_U8 = 284 * MiB, WS_V8 = 316 * MiB;
constexpr size_t WS_XBC = 348 * MiB;
constexpr size_t WS_DT2 = 3 * MiB;
constexpr size_t WS_X18 = 396 * MiB;
constexpr size_t WS_END = 428 * MiB;
constexpr int CW_BAR = 4096;
constexpr int CW_Q2 = 8192;
constexpr int CW_KMEAN = 32768;
constexpr int CW_SSQ = 131072;
static_assert((CW_SSQ + MTOK * 4) * 4 <= (int)CTL_ZERO_BYTES, "CTL words inside the memset region");

constexpr int RING_OFF = 0, RING_BYTES = 131072;
constexpr int LDSCTL_OFF = RING_BYTES, MISC_OFF = LDSCTL_OFF + 320;
constexpr int SEGTAB_OFF = LDSCTL_OFF + 1024;  static_assert(LDSCTL_OFF + 1024 + 3 * 256 * 16 <= 147456, "segment table inside the LDS allocation");
constexpr int LDS_BYTES = 147456;
constexpr int NWAVES = 8;

#define GAS __attribute__((address_space(1)))
#define LAS __attribute__((address_space(3)))
typedef unsigned short bf16;
typedef unsigned v4u __attribute__((ext_vector_type(4)));
typedef unsigned v2u __attribute__((ext_vector_type(2)));
typedef float f32x4 __attribute__((ext_vector_type(4)));
typedef float f32x2 __attribute__((ext_vector_type(2)));
typedef short bf16x8 __attribute__((ext_vector_type(8)));
typedef short s16x4 __attribute__((ext_vector_type(4)));
typedef GAS unsigned gu32;
#define RLX_AGENT __ATOMIC_RELAXED, __HIP_MEMORY_SCOPE_AGENT
#define LDS_WAIT() asm volatile("s_waitcnt lgkmcnt(0)" ::: "memory")
#define VM_WAIT() asm volatile("s_waitcnt vmcnt(0)" ::: "memory")
__device__ __forceinline__ unsigned f2bf(float f) { unsigned u = __builtin_bit_cast(unsigned, f); return (u + 0x7fffu + ((u >> 16) & 1u)) >> 16; }
typedef __bf16 bf16v2 __attribute__((ext_vector_type(2)));
__device__ __forceinline__ unsigned pk2(float lo, float hi) { bf16v2 v; v.x = (__bf16)lo; v.y = (__bf16)hi; return __builtin_bit_cast(unsigned, v); }
__device__ __forceinline__ float bflo(unsigned w) { return __builtin_bit_cast(float, w << 16); }
__device__ __forceinline__ float bfhi(unsigned w) { return __builtin_bit_cast(float, w & 0xffff0000u); }
__device__ __forceinline__ float wave_sum(float v) {
#pragma unroll
    for (int o = 1; o < 64; o <<= 1) v += __shfl_xor(v, o);
    return v;
}
__device__ __forceinline__ float silu_f(float x) { return x * __builtin_amdgcn_rcpf(1.f + __expf(-x)); }

#define XB_TMO      128
#define XB_XCNT(j)  (256  + 64 * (j))
#define XB_XSUB(j)  (1280 + 64 * (j))
#define XB_XGEN(j)  (2304 + 64 * (j))
#define XB_TOP      3328
#define XB_TOPGEN   3392
#define XCD_BAR_WORDS 3456
#define XB_SPIN_CAP (1u << 18)

__device__ __forceinline__ unsigned xb_ld(unsigned* p)              { return __hip_atomic_load(p, __ATOMIC_RELAXED, __HIP_MEMORY_SCOPE_AGENT); }
__device__ __forceinline__ unsigned xb_add(unsigned* p, unsigned v) { return __hip_atomic_fetch_add(p, v, __ATOMIC_RELAXED, __HIP_MEMORY_SCOPE_AGENT); }
__device__ __forceinline__ unsigned xb_xcc_id() { return (unsigned)__builtin_amdgcn_s_getreg((3 << 11) | 20) & 0xFu; }
#define XB_SPIN(cond, bar) do { unsigned _sp = 0; while (cond) { __builtin_amdgcn_s_sleep(1); \
    if ((++_sp & 255u) == 0u) { if (xb_ld(&(bar)[XB_TMO])) break; if (_sp > XB_SPIN_CAP) { atomicAdd(&(bar)[XB_TMO], 1u); break; } } } } while (0)

struct XcdBarrier {
    unsigned* bar; unsigned x;
    volatile LAS unsigned* st;
};
__device__ __forceinline__ XcdBarrier xcd_barrier_post(unsigned* bar, volatile LAS unsigned* st) {
    XcdBarrier b; b.bar = bar; b.x = xb_xcc_id(); b.st = st;
    if (threadIdx.x == 0) (void)xb_add(&bar[XB_XCNT(b.x)], 1u);
    return b;
}
__device__ __forceinline__ void xcd_barrier_complete(unsigned* bar, unsigned x, unsigned& nloc, unsigned& nx) {
    const unsigned G = gridDim.x * gridDim.y * gridDim.z;
    unsigned sum, cnt, mine, sp = 0u;
    for (;;) {
        sum = 0u; cnt = 0u; mine = 0u;
#pragma unroll
        for (unsigned j = 0; j < 16; ++j) { const unsigned c = xb_ld(&bar[XB_XCNT(j)]); sum += c; cnt += (c > 0u) ? 1u : 0u; mine = (j == x) ? c : mine; }
        if (sum == G) break;
        __builtin_amdgcn_s_sleep(1);
        if ((++sp & 255u) == 0u) { if (xb_ld(&bar[XB_TMO])) break; if (sp > XB_SPIN_CAP) { atomicAdd(&bar[XB_TMO], 1u); break; } }
    }
    nloc = mine > 0u ? mine : 1u; nx = cnt > 0u ? cnt : 1u;
}
__device__ __forceinline__ void xcd_barrier(const XcdBarrier& b) {
    asm volatile("s_waitcnt vmcnt(0)" ::: "memory");
    __syncthreads();
    if (threadIdx.x == 0) {
        unsigned* bar = b.bar;
        __builtin_amdgcn_s_waitcnt(0);
        unsigned nloc = b.st[0], nx = b.st[1];
        if (nloc == 0u) { xcd_barrier_complete(bar, b.x, nloc, nx); b.st[0] = nloc; b.st[1] = nx; }
        const unsigned old = xb_add(&bar[XB_XSUB(b.x)], 1u);
        const unsigned gen = old / nloc;
        if (old + 1u == (gen + 1u) * nloc) {
            __builtin_amdgcn_fence(__ATOMIC_RELEASE, "agent");
            asm volatile("s_waitcnt vmcnt(0)" ::: "memory");
            const unsigned og = xb_add(&bar[XB_TOP], 1u);
            const unsigned tg = og / nx;
            if (og + 1u == (tg + 1u) * nx) xb_add(&bar[XB_TOPGEN], 1u);
            else XB_SPIN(xb_ld(&bar[XB_TOPGEN]) == tg, bar);
            __builtin_amdgcn_fence(__ATOMIC_ACQUIRE, "agent");
            xb_add(&bar[XB_XGEN(b.x)], 1u);
            asm volatile("s_waitcnt vmcnt(0)" ::: "memory");
        } else {
            XB_SPIN(xb_ld(&bar[XB_XGEN(b.x)]) == gen, bar);
            __builtin_amdgcn_fence(__ATOMIC_ACQUIRE, "agent");
            asm volatile("s_waitcnt vmcnt(0)" ::: "memory");
        }
    }
    __syncthreads();
}

#define CAS __attribute__((address_space(4)))
struct Args { const float* in[18]; float* out; unsigned char* ws; };
__device__ __forceinline__ const CAS unsigned char* kargs() { const CAS unsigned char* p = (const CAS unsigned char*)__builtin_amdgcn_kernarg_segment_ptr(); asm volatile("" : "+s"(p)); return p; }
__device__ __forceinline__ const float* kin(int i) { return *(const float* const CAS*)(kargs() + 8 * i); }
__device__ __forceinline__ float* kout() { return *(float* const CAS*)(kargs() + 8 * 18); }
__device__ __forceinline__ unsigned char* kws() { return *(unsigned char* const CAS*)(kargs() + 8 * 19); }
__device__ __forceinline__ int fresh_tid() { int t = threadIdx.x; asm volatile("" : "+v"(t)); return t; }
struct Frame {
    LAS unsigned char* lds;
    volatile LAS unsigned* MISC;
    int tid, lane, wave, G;
    __device__ __forceinline__ const float* x() const { return kin(0); }
    __device__ __forceinline__ const float* attn_norm() const { return kin(1); }
    __device__ __forceinline__ const float* w_in() const { return kin(2); }
    __device__ __forceinline__ const float* conv_w() const { return kin(3); }
    __device__ __forceinline__ const float* conv_b() const { return kin(4); }
    __device__ __forceinline__ const float* dt_bias() const { return kin(5); }
    __device__ __forceinline__ const float* a_log() const { return kin(6); }
    __device__ __forceinline__ const float* d_skip() const { return kin(7); }
    __device__ __forceinline__ const float* rel_bias() const { return kin(8); }
    __device__ __forceinline__ const float* attn_out_norm() const { return kin(9); }
    __device__ __forceinline__ const float* ssm_out_norm() const { return kin(10); }
    __device__ __forceinline__ const float* w_out() const { return kin(11); }
    __device__ __forceinline__ const float* ffn_norm() const { return kin(12); }
    __device__ __forceinline__ const float* peer_wq() const { return kin(13); }
    __device__ __forceinline__ const float* peer_sk() const { return kin(14); }
    __device__ __forceinline__ const float* peer_u() const { return kin(15); }
    __device__ __forceinline__ const float* peer_v() const { return kin(16); }
    __device__ __forceinline__ const float* final_norm() const { return kin(17); }
    __device__ __forceinline__ float* out() const { return kout(); }
    __device__ __forceinline__ unsigned* ctl() const { return (unsigned*)(kws() + WS_CTL); }
    __device__ __forceinline__ float* dtraw() const { return (float*)(kws() + WS_DT); }
    __device__ __forceinline__ bf16* SK() const { return (bf16*)(kws() + WS_SK); }
    __device__ __forceinline__ bf16* WinT() const { return (bf16*)(kws() + WS_WIN); }
    __device__ __forceinline__ bf16* WoutT() const { return (bf16*)(kws() + WS_WOUT); }
    __device__ __forceinline__ bf16* WqT() const { return (bf16*)(kws() + WS_WQ); }
    __device__ __forceinline__ bf16* HN() const { return (bf16*)(kws() + WS_HN); }
    __device__ __forceinline__ bf16* PROJ() const { return (bf16*)(kws() + WS_PROJ); }
    __device__ __forceinline__ bf16* X1B() const { return (bf16*)(kws() + WS_X1B); }
    __device__ __forceinline__ bf16* QP() const { return (bf16*)(kws() + WS_QP); }
    __device__ __forceinline__ unsigned char* U8() const { return kws() + WS_U8; }
    __device__ __forceinline__ unsigned char* V8() const { return kws() + WS_V8; }
    __device__ __forceinline__ unsigned char* X18() const { return kws() + WS_X18; }
    __device__ __forceinline__ unsigned char* HN8() const { return kws() + WS_HN8; }
    __device__ __forceinline__ unsigned char* WinT8() const { return kws() + WS_WIN8; }
    __device__ __forceinline__ bf16* XBC() const { return (bf16*)(kws() + WS_XBC); }
    __device__ __forceinline__ float* DT2() const { return (float*)(kws() + WS_DT2); }
    __device__ __forceinline__ float* kmean() const { return (float*)(kws() + WS_CTL) + CW_KMEAN; }
    __device__ __forceinline__ float* ssq() const { return (float*)(kws() + WS_CTL) + CW_SSQ; }
};

__device__ __forceinline__ float clampf(float v, float lim);
__device__ __forceinline__ void p0_transpose_item(const float* W, int K, int N, bf16* WT, const float* gain, LAS float* scr, int item, int lane, const float f8scale = 0.f, const int nshift = 0) {
    const int nblk = (N + 31) / 32, kb = item / nblk, nb = item % nblk, k0 = 64 * kb, n0 = 32 * nb;
    const int kr = lane >> 3, nc = (lane & 7) * 4; const bool ok = (n0 + nc) < N;
    f32x4 v[8]; float gk[8];
#pragma unroll
    for (int i = 0; i < 8; ++i) { const int kk = 8 * i + kr; v[i] = ok ? *(const GAS f32x4*)(W + (size_t)(k0 + kk) * N + n0 + nc) : (f32x4){0.f, 0.f, 0.f, 0.f}; gk[i] = gain ? gain[k0 + kk] : 1.f; }
#pragma unroll
    for (int i = 0; i < 8; ++i) { const int kk = 8 * i + kr; LAS float* d = scr + kk * 33 + nc; d[0] = v[i].x * gk[i]; d[1] = v[i].y * gk[i]; d[2] = v[i].z * gk[i]; d[3] = v[i].w * gk[i]; }
    LDS_WAIT(); asm volatile("" ::: "memory");
    const int c = lane & 7;
#pragma unroll
    for (int j = 0; j < 4; ++j) { const int n = (lane >> 3) + 8 * j; const LAS float* s = scr + (8 * c) * 33 + n;
        v4u o; o.x = pk2(s[0 * 33], s[1 * 33]); o.y = pk2(s[2 * 33], s[3 * 33]); o.z = pk2(s[4 * 33], s[5 * 33]); o.w = pk2(s[6 * 33], s[7 * 33]);
        if (f8scale == 0.f) *(GAS v4u*)(WT + (size_t)(n0 + n - nshift) * K + k0 + 8 * c) = o;
        else { v2u o8; int w_;
            w_ = __builtin_amdgcn_cvt_pk_fp8_f32(clampf(s[0 * 33] * f8scale, 448.f), clampf(s[1 * 33] * f8scale, 448.f), 0, false); w_ = __builtin_amdgcn_cvt_pk_fp8_f32(clampf(s[2 * 33] * f8scale, 448.f), clampf(s[3 * 33] * f8scale, 448.f), w_, true); o8.x = (unsigned)w_;
            w_ = __builtin_amdgcn_cvt_pk_fp8_f32(clampf(s[4 * 33] * f8scale, 448.f), clampf(s[5 * 33] * f8scale, 448.f), 0, false); w_ = __builtin_amdgcn_cvt_pk_fp8_f32(clampf(s[6 * 33] * f8scale, 448.f), clampf(s[7 * 33] * f8scale, 448.f), w_, true); o8.y = (unsigned)w_;
            *(GAS v2u*)((unsigned char*)WT + (size_t)(n0 + n - nshift) * K + k0 + 8 * c) = o8; } }
    LDS_WAIT(); asm volatile("" ::: "memory");
}
__device__ __forceinline__ unsigned pk4_fp8(float a, float b, float c, float d) { int w = __builtin_amdgcn_cvt_pk_fp8_f32(clampf(a, 448.f), clampf(b, 448.f), 0, false); w = __builtin_amdgcn_cvt_pk_fp8_f32(clampf(c, 448.f), clampf(d, 448.f), w, true); return (unsigned)w; }
__device__ __forceinline__ void rms_2rows_to_bf16(const float* x0, const float* x1, const float* gain, bf16* o0, bf16* o1, unsigned char* q0, unsigned char* q1, int lane) {
    const GAS f32x4* xr0 = (const GAS f32x4*)x0 + lane; const GAS f32x4* xr1 = (const GAS f32x4*)x1 + lane; const GAS f32x4* gr = (const GAS f32x4*)gain + lane;
    f32x4 v[8], u[8]; float s = 0.f, t = 0.f;
#pragma unroll
    for (int j = 0; j < 8; ++j) { v[j] = xr0[64 * j]; u[j] = xr1[64 * j]; }
#pragma unroll
    for (int j = 0; j < 8; ++j) { s += (v[j].x * v[j].x + v[j].y * v[j].y) + (v[j].z * v[j].z + v[j].w * v[j].w); t += (u[j].x * u[j].x + u[j].y * u[j].y) + (u[j].z * u[j].z + u[j].w * u[j].w); }
    const float rs = __builtin_amdgcn_rsqf(wave_sum(s) * (1.f / DM) + EPS), rt = __builtin_amdgcn_rsqf(wave_sum(t) * (1.f / DM) + EPS);
    GAS v2u* p0 = (GAS v2u*)o0 + lane; GAS v2u* p1 = (GAS v2u*)o1 + lane; GAS unsigned* r0 = (GAS unsigned*)q0 + lane; GAS unsigned* r1 = (GAS unsigned*)q1 + lane;
#pragma unroll
    for (int j = 0; j < 8; ++j) { const f32x4 g = gr[64 * j]; v2u a, b;
        const f32x4 h0 = v[j] * g * rs, h1 = u[j] * g * rt;
        a.x = pk2(h0.x, h0.y); a.y = pk2(h0.z, h0.w); p0[64 * j] = a; r0[64 * j] = pk4_fp8(h0.x * SH8, h0.y * SH8, h0.z * SH8, h0.w * SH8);
        b.x = pk2(h1.x, h1.y); b.y = pk2(h1.z, h1.w); p1[64 * j] = b; r1[64 * j] = pk4_fp8(h1.x * SH8, h1.y * SH8, h1.z * SH8, h1.w * SH8); }
}
#ifdef PROBE_FP4EMU
__device__ __forceinline__ float fp4grid(float y) { const float a = fabsf(y); float r;
    if (a <= 2.f) r = rintf(a * 2.f) * 0.5f; else if (a <= 4.f) r = rintf(a); else r = (a < 5.f) ? 4.f : 6.f;
    return copysignf(r, y); }
__device__ __forceinline__ float clampf(float v, float lim) { if (lim == 448.5f) return fp4grid(v * (1.f / 16.f)) * 16.f; return fminf(fmaxf(v, -lim), lim); }
#else
__device__ __forceinline__ float clampf(float v, float lim) { return fminf(fmaxf(v, -lim), lim); }
#endif
template <int TAB = 0> __device__ __forceinline__ v4u cvt16_fp8(const f32x4 a, const f32x4 b, const f32x4 c, const f32x4 d, float sc) {
    v4u o; int w; constexpr float LIM = TAB ? 448.5f : 448.f;
    w = __builtin_amdgcn_cvt_pk_fp8_f32(clampf(a.x * sc, LIM), clampf(a.y * sc, LIM), 0, false); w = __builtin_amdgcn_cvt_pk_fp8_f32(clampf(a.z * sc, LIM), clampf(a.w * sc, LIM), w, true); o.x = (unsigned)w;
    w = __builtin_amdgcn_cvt_pk_fp8_f32(clampf(b.x * sc, LIM), clampf(b.y * sc, LIM), 0, false); w = __builtin_amdgcn_cvt_pk_fp8_f32(clampf(b.z * sc, LIM), clampf(b.w * sc, LIM), w, true); o.y = (unsigned)w;
    w = __builtin_amdgcn_cvt_pk_fp8_f32(clampf(c.x * sc, LIM), clampf(c.y * sc, LIM), 0, false); w = __builtin_amdgcn_cvt_pk_fp8_f32(clampf(c.z * sc, LIM), clampf(c.w * sc, LIM), w, true); o.z = (unsigned)w;
    w = __builtin_amdgcn_cvt_pk_fp8_f32(clampf(d.x * sc, LIM), clampf(d.y * sc, LIM), 0, false); w = __builtin_amdgcn_cvt_pk_fp8_f32(clampf(d.z * sc, LIM), clampf(d.w * sc, LIM), w, true); o.w = (unsigned)w;
    return o;
}
__device__ __forceinline__ void tables_convert(Frame& F, size_t lo, size_t hi, size_t tix, size_t ntx) {
      const GAS f32x4* su = (const GAS f32x4*)F.peer_u(); const GAS f32x4* sv = (const GAS f32x4*)F.peer_v(); GAS v4u* du = (GAS v4u*)F.U8(); GAS v4u* dv = (GAS v4u*)F.V8();
#pragma unroll 1
      for (int tab = 0; tab < 2; ++tab) { const GAS f32x4* src = tab ? sv : su; GAS v4u* dst = tab ? dv : du; const float sc = tab ? SV : SU;
        f32x4 nx[8]; const size_t i0 = lo + tix;
        if (i0 < hi) { const GAS f32x4* p = src + (i0 >> 6) * 512 + (i0 & 63);
#pragma unroll
            for (int j = 0; j < 8; ++j) nx[j] = p[64 * j]; }
#pragma unroll 1
        for (size_t i = i0; i < hi; i += ntx) { f32x4 v[8];
#pragma unroll
            for (int j = 0; j < 8; ++j) v[j] = nx[j];
            if (i + ntx < hi) { const size_t i2 = i + ntx; const GAS f32x4* p = src + (i2 >> 6) * 512 + (i2 & 63);
#pragma unroll
                for (int j = 0; j < 8; ++j) nx[j] = p[64 * j]; }
            unsigned wd[4];
#pragma unroll
            for (int q = 0; q < 4; ++q) { const f32x4 a = v[2 * q] * sc, b = v[2 * q + 1] * sc; unsigned w = 0u;
                w = __builtin_amdgcn_cvt_scalef32_pk_fp4_f32(w, clampf(a.x, 6.f), clampf(a.y, 6.f), 1.0f, 0); w = __builtin_amdgcn_cvt_scalef32_pk_fp4_f32(w, clampf(a.z, 6.f), clampf(a.w, 6.f), 1.0f, 1);
                w = __builtin_amdgcn_cvt_scalef32_pk_fp4_f32(w, clampf(b.x, 6.f), clampf(b.y, 6.f), 1.0f, 2); w = __builtin_amdgcn_cvt_scalef32_pk_fp4_f32(w, clampf(b.z, 6.f), clampf(b.w, 6.f), 1.0f, 3); wd[q] = w; }
            dst[i] = (v4u){wd[0], wd[1], wd[2], wd[3]}; } }
}
constexpr size_t TAB_ITEMS = (size_t)16384 * 64;
__device__ __forceinline__ size_t tab_split(int G) { const int rem = ((MTOK / 256) * (NB16 / 256)) % G; return rem ? (TAB_ITEMS / 8) * 5 : TAB_ITEMS; }
__device__ __forceinline__ unsigned fp4_code(float y) { const float a = fabsf(y);
    const unsigned m = (unsigned)(a >= 0.25f) + (unsigned)(a >= 0.75f) + (unsigned)(a >= 1.25f) + (unsigned)(a >= 1.75f) + (unsigned)(a >= 2.5f) + (unsigned)(a >= 3.5f) + (unsigned)(a >= 5.0f);
    return m | ((y < 0.f) ? 8u : 0u); }
__device__ __forceinline__ void p0_prologue(Frame& F) {
    const int tid = fresh_tid(), lane = tid & 63, wave = __builtin_amdgcn_readfirstlane(tid >> 6);
    LAS float* scr = (LAS float*)(F.lds + RING_OFF + wave * 16384);
    const int gw = blockIdx.x * NWAVES + wave, NGW = F.G * NWAVES;
    constexpr int I_IN = (DM / 64) * ((IN_PROJ + 31) / 32), I_SQ = (DM / 64) * (DM / 32);
    constexpr int NITEMS = I_IN + 2 * I_SQ;
    { const float* const w_in = F.w_in(); const float* const w_out = F.w_out(); const float* const wq = F.peer_wq(); const float* const fg = F.ffn_norm(); bf16* const WinT = F.WinT(); unsigned char* const WinT8 = F.WinT8(); bf16* const WoutT = F.WoutT(); bf16* const WqT = F.WqT(); const float* const gatt = F.attn_out_norm(); const float* const gssm = F.ssm_out_norm();
      for (int it = gw; it < NITEMS; it += NGW) {
        int r = it;
        if (r < I_IN) { const int n0_ = 32 * (r % ((IN_PROJ + 31) / 32));
            if (n0_ >= F8_LO && n0_ < F8_HI) p0_transpose_item(w_in, DM, IN_PROJ, (bf16*)WinT8, nullptr, scr, r, lane, SW8, F8_LO);
            else p0_transpose_item(w_in, DM, IN_PROJ, WinT, nullptr, scr, r, lane, 0.f, (n0_ >= F8_HI) ? (F8_HI - F8_LO) : 0);
            continue; } r -= I_IN;
        if (r < I_SQ) { const int k0_ = 64 * (r / (DM / 32)); p0_transpose_item(w_out, DM, DM, WoutT, (k0_ < ATT_W) ? gatt : (gssm - ATT_W), scr, r, lane, SW8); continue; } r -= I_SQ;
        p0_transpose_item(wq, DM, DM, WqT, fg, scr, r, lane, SW8);
      } }
    const size_t gt = (size_t)blockIdx.x * (NWAVES * 64) + tid, GT = (size_t)F.G * NWAVES * 64;
    { const size_t z0 = (size_t)(5664 - (F8_HI - F8_LO)) * DM / 8, z1 = (size_t)NB16 * DM / 8; GAS v4u* p = (GAS v4u*)F.WinT(); for (size_t i = z0 + gt; i < z1; i += GT) p[i] = (v4u){0u, 0u, 0u, 0u}; }
    { const GAS f32x4* s = (const GAS f32x4*)F.peer_sk(); GAS v2u* d = (GAS v2u*)F.SK(); for (size_t i = gt; i < (size_t)16 * 128 * 128 / 4; i += GT) { const f32x4 v = s[i]; v2u o; o.x = pk2(v.x, v.y); o.y = pk2(v.z, v.w); d[i] = o; } }
    { const float* const xg = F.x(); const float* const gn = F.attn_norm(); bf16* const hn = F.HN(); unsigned char* const hn8 = F.HN8();
      for (int m = gw; m < MTOK / 2; m += NGW) rms_2rows_to_bf16(xg + (size_t)(2 * m) * DM, xg + (size_t)(2 * m + 1) * DM, gn, hn + (size_t)(2 * m) * DM, hn + (size_t)(2 * m + 1) * DM, hn8 + (size_t)(2 * m) * DM, hn8 + (size_t)(2 * m + 1) * DM, lane); }
}

struct EpiProj {
    static constexpr bool PERM = true, AFTER_DRAIN = false, SEG = false;
    bf16* O; float* dtraw; float* kmean;
    __device__ __forceinline__ void operator()(const pg8::f32x4 (&acc)[2][2][4][2], const pg8::Unit& u, int wr, int wc, int fr, int fq) const {
        const int rpn = (u.pn < F8_LO / 256) ? u.pn : u.pn + (F8_HI - F8_LO) / 256;
        const int row0 = u.pm * 256 + wr * 64 + fr, col0 = rpn * 256 + wc * 32 + 8 * fq;
        if (rpn < 22) {
#pragma unroll
            for (int ai = 0; ai < 2; ++ai)
#pragma unroll
                for (int m = 0; m < 4; ++m) { bf16* rowp = O + (size_t)(row0 + ai * 128 + m * 16) * NPROJ + col0;
#pragma unroll
                    for (int bj = 0; bj < 2; ++bj) { const pg8::f32x4 v0 = acc[ai][bj][m][0], v1 = acc[ai][bj][m][1];
                        pg8::u32x4 w; w.x = pg8::cvt_pk_bf16(v0[0], v0[1]); w.y = pg8::cvt_pk_bf16(v0[2], v0[3]); w.z = pg8::cvt_pk_bf16(v1[0], v1[1]); w.w = pg8::cvt_pk_bf16(v1[2], v1[3]);
                        *(pg8::u32x4*)(rowp + bj * 128) = w; } }
        } else if (wc == 0 && fq < 2) {
#pragma unroll
            for (int ai = 0; ai < 2; ++ai)
#pragma unroll
                for (int m = 0; m < 4; ++m) { float* rp = dtraw + (size_t)(row0 + ai * 128 + m * 16) * 16 + 8 * fq;
                    *(pg8::f32x4*)rp = acc[ai][0][m][0]; *(pg8::f32x4*)(rp + 4) = acc[ai][0][m][1]; }
        }
        if (kmean && u.pn >= 4 && u.pn < 8) {
#pragma unroll
            for (int bj = 0; bj < 2; ++bj)
#pragma unroll
                for (int n = 0; n < 2; ++n)
#pragma unroll
                    for (int i = 0; i < 4; ++i) { float s = 0.f;
#pragma unroll
                        for (int ai = 0; ai < 2; ++ai)
#pragma unroll
                            for (int m = 0; m < 4; ++m) s += acc[ai][bj][m][n][i];
                        s += __shfl_xor(s, 1); s += __shfl_xor(s, 2); s += __shfl_xor(s, 4); s += __shfl_xor(s, 8);
                        if (fr == 0) unsafeAtomicAdd(kmean + (size_t)u.pm * 1024 + (col0 - 1024) + bj * 128 + 4 * n + i, s); }
        }
    }
};
struct EpiProj8 {
    static constexpr bool PERM = true, AFTER_DRAIN = false, SEG = false;
    bf16* O;
    __device__ __forceinline__ void operator()(const pg8::f32x4 (&acc)[2][2][4][2], const pg8::Unit& u, int wr, int wc, int fr, int fq) const {
        const int row0 = u.pm * 256 + wr * 64 + fr, col0 = F8_LO + u.pn * 256 + wc * 32 + 8 * fq; constexpr float sc = 1.f / (SH8 * SW8);
#pragma unroll
        for (int ai = 0; ai < 2; ++ai)
#pragma unroll
            for (int m = 0; m < 4; ++m) { bf16* rowp = O + (size_t)(row0 + ai * 128 + m * 16) * NPROJ + col0;
#pragma unroll
                for (int bj = 0; bj < 2; ++bj) { const pg8::f32x4 v0 = acc[ai][bj][m][0] * sc, v1 = acc[ai][bj][m][1] * sc;
                    pg8::u32x4 w; w.x = pg8::cvt_pk_bf16(v0[0], v0[1]); w.y = pg8::cvt_pk_bf16(v0[2], v0[3]); w.z = pg8::cvt_pk_bf16(v1[0], v1[1]); w.w = pg8::cvt_pk_bf16(v1[2], v1[3]);
                    *(pg8::u32x4*)(rowp + bj * 128) = w; } }
    }
};
struct EpiOut {
    static constexpr bool PERM = true, AFTER_DRAIN = false, SEG = true; static constexpr int SEG_T1 = 8, SEG_T2 = 12;
    const float* x; bf16* x1b; unsigned char* x18; float* ssq; bool doatom; const LAS f32x4* tab;
    __device__ __forceinline__ void seg_load(int ui, int wr, int fr, float (&sr)[16]) const {
#pragma unroll
        for (int i = 0; i < 8; ++i) { const int r = (i >> 2) * 128 + wr * 64 + (i & 3) * 16 + fr; const f32x2 q = *(const LAS f32x2*)(tab + ui * 256 + r); sr[2 * i] = q.x; sr[2 * i + 1] = q.y; }
        asm volatile("s_waitcnt lgkmcnt(0)" ::: "memory");
    }
    __device__ __forceinline__ void seg_apply(pg8::f32x4 (&acc)[2][2][4][2], const float (&sr)[16], int which) const {
#pragma unroll
        for (int ai = 0; ai < 2; ++ai)
#pragma unroll
            for (int m = 0; m < 4; ++m) { const float f = (which == 0) ? sr[2 * (ai * 4 + m)] : ((which == 1) ? sr[2 * (ai * 4 + m) + 1] : 1.0f);
#pragma unroll
                for (int bj = 0; bj < 2; ++bj)
#pragma unroll
                    for (int n = 0; n < 2; ++n) acc[ai][bj][m][n] = acc[ai][bj][m][n] * f; }
    }
    __device__ __forceinline__ void operator()(const pg8::f32x4 (&acc)[2][2][4][2], const pg8::Unit& u, int wr, int wc, int fr, int fq, int ui) const {
        const int row0 = u.pm * 256 + wr * 64 + fr, col0 = u.pn * 256 + wc * 32 + 8 * fq;
#pragma unroll
        for (int ai = 0; ai < 2; ++ai)
#pragma unroll
            for (int m = 0; m < 4; ++m) { const int row = row0 + ai * 128 + m * 16; const size_t off = (size_t)row * DM + col0; float s = 0.f;
                const float s1 = (*(const LAS f32x4*)(tab + ui * 256 + ai * 128 + wr * 64 + m * 16 + fr)).z;
#pragma unroll
                for (int bj = 0; bj < 2; ++bj) {
                    const pg8::f32x4 a0 = *(const pg8::f32x4*)(x + off + bj * 128), a1 = *(const pg8::f32x4*)(x + off + bj * 128 + 4);
                    const pg8::f32x4 v0 = acc[ai][bj][m][0] * s1 + a0, v1 = acc[ai][bj][m][1] * s1 + a1;
                    pg8::u32x4 w; w.x = pg8::cvt_pk_bf16(v0[0], v0[1]); w.y = pg8::cvt_pk_bf16(v0[2], v0[3]); w.z = pg8::cvt_pk_bf16(v1[0], v1[1]); w.w = pg8::cvt_pk_bf16(v1[2], v1[3]);
                    *(pg8::u32x4*)(x1b + off + bj * 128) = w;
                    { v2u o8; int w_; w_ = __builtin_amdgcn_cvt_pk_fp8_f32(clampf(v0[0] * SX8, 448.f), clampf(v0[1] * SX8, 448.f), 0, false); w_ = __builtin_amdgcn_cvt_pk_fp8_f32(clampf(v0[2] * SX8, 448.f), clampf(v0[3] * SX8, 448.f), w_, true); o8.x = (unsigned)w_;
                      w_ = __builtin_amdgcn_cvt_pk_fp8_f32(clampf(v1[0] * SX8, 448.f), clampf(v1[1] * SX8, 448.f), 0, false); w_ = __builtin_amdgcn_cvt_pk_fp8_f32(clampf(v1[2] * SX8, 448.f), clampf(v1[3] * SX8, 448.f), w_, true); o8.y = (unsigned)w_;
                      *(v2u*)(x18 + off + bj * 128) = o8; }
                    s += (v0[0] * v0[0] + v0[1] * v0[1]) + (v0[2] * v0[2] + v0[3] * v0[3]) + (v1[0] * v1[0] + v1[1] * v1[1]) + (v1[2] * v1[2] + v1[3] * v1[3]); }
                s += __shfl_xor(s, 16); s += __shfl_xor(s, 32);
                if (fq == 0 && doatom) unsafeAtomicAdd(ssq + (size_t)row * 4, s);
                asm volatile("" ::: "memory"); }
    }
};
struct EpiQ {
    static constexpr bool PERM = true, AFTER_DRAIN = false, SEG = false;
    bf16* O; const float* ssq;
    __device__ __forceinline__ void operator()(const pg8::f32x4 (&acc)[2][2][4][2], const pg8::Unit& u, int wr, int wc, int fr, int fq) const {
        const int row0 = u.pm * 256 + wr * 64 + fr, col0 = u.pn * 256 + wc * 32 + 8 * fq;
#pragma unroll
        for (int ai = 0; ai < 2; ++ai)
#pragma unroll
            for (int m = 0; m < 4; ++m) { const int row = row0 + ai * 128 + m * 16; bf16* rowp = O + (size_t)row * DM + col0;
                const float rs = (1.f / (SX8 * SW8)) / sqrtf(__hip_atomic_load(ssq + (size_t)row * 4, RLX_AGENT) * (1.f / DM) + EPS);
#pragma unroll
                for (int bj = 0; bj < 2; ++bj) { const pg8::f32x4 v0 = acc[ai][bj][m][0] * rs, v1 = acc[ai][bj][m][1] * rs;
                    pg8::u32x4 w; w.x = pg8::cvt_pk_bf16(v0[0], v0[1]); w.y = pg8::cvt_pk_bf16(v0[2], v0[3]); w.z = pg8::cvt_pk_bf16(v1[0], v1[1]); w.w = pg8::cvt_pk_bf16(v1[2], v1[3]);
                    *(pg8::u32x4*)(rowp + bj * 128) = w; } }
    }
};

constexpr int A_KSTR = 272, A_VSTR = 288;
constexpr int A_KB0 = 0, A_KB1 = 64 * A_KSTR, A_VB0 = 2 * 64 * A_KSTR, A_VBS = 64 * A_VSTR  , A_KM = A_VB0 + 3 * A_VBS, A_TAB = A_KM + 8 * 128 * 4, A_END = A_TAB + 128 * 4;
static_assert(A_END <= RING_BYTES && (A_KM % 16) == 0, "attention LDS map");
#define PIN16(a, i) asm volatile("" : "+v"(a[i]), "+v"(a[i + 1]), "+v"(a[i + 2]), "+v"(a[i + 3]), "+v"(a[i + 4]), "+v"(a[i + 5]), "+v"(a[i + 6]), "+v"(a[i + 7]), "+v"(a[i + 8]), "+v"(a[i + 9]), "+v"(a[i + 10]), "+v"(a[i + 11]), "+v"(a[i + 12]), "+v"(a[i + 13]), "+v"(a[i + 14]), "+v"(a[i + 15]))
#define TR16(p) __builtin_amdgcn_ds_read_tr16_b64_v4i16((LAS s16x4*)(p))
#define MFMA16(a, b, c) __builtin_amdgcn_mfma_f32_16x16x32_bf16((a), (b), (c), 0, 0, 0)
__device__ __forceinline__ bf16x8 pack8(const float* v) {
    const unsigned a = pk2(v[0], v[1]), b = pk2(v[2], v[3]), c = pk2(v[4], v[5]), d = pk2(v[6], v[7]);
    const v4u u = {a, b, c, d}; return __builtin_bit_cast(bf16x8, u);
}
__device__ __forceinline__ void attn_unit(Frame& F, int b, int h, int blk, const bool doatom = true) {
    LAS unsigned char* lds = F.lds + RING_OFF;
    const int tid = fresh_tid(), lane = tid & 63, w = __builtin_amdgcn_readfirstlane(tid >> 6), g = lane >> 4, c16 = lane & 15, q4 = c16 >> 2, p4 = lane & 3;
    const int own = blk, t0 = blk * 256, tq0 = t0 + 32 * w + c16;
    const size_t rowbase = (size_t)b * SEQ;
    const float NEG_INF = -__builtin_inff();
    constexpr float LOG2E = 1.4426950408889634f, SCL2 = 0.08838834764831845f * 1.4426950408889634f;
    LAS float* km = (LAS float*)(lds + A_KM); LAS float* tab = (LAS float*)(lds + A_TAB);
    const bf16* const PROJ = F.PROJ(); const float* const kmg = F.kmean(); const float* const relb = F.rel_bias();
    for (int i = tid; i < own * 128; i += NWAVES * 64) { const int n = i >> 7, d = i & 127; km[i] = kmg[(size_t)(b * 8 + n) * 1024 + h * 128 + d] * (1.f / 256.f); }
    if (tid < 128) { const int rel = tid; int bucket = rel; if (rel >= 16) { bucket = 16 + (int)(log2f((float)rel * (1.f / 16.f)) * (16.f / 3.f)); bucket = bucket > 31 ? 31 : bucket; }
        tab[tid] = relb[bucket * 8 + h] * LOG2E; }
    bf16x8 qf[2][4];
#pragma unroll
    for (int gi = 0; gi < 2; ++gi) { const bf16* qrow = PROJ + (rowbase + tq0 + 16 * gi) * NPROJ + COL_Q + h * 128 + 8 * g;
#pragma unroll
      for (int ks = 0; ks < 4; ++ks) qf[gi][ks] = *(const GAS bf16x8*)(qrow + 32 * ks); }
    __syncthreads();
    unsigned selmask[2];
    if (own <= 3) { selmask[0] = (1u << own) - 1u; selmask[1] = selmask[0]; }
    else {
#pragma unroll
      for (int gi = 0; gi < 2; ++gi) {
        float gate[7];
#pragma unroll
        for (int n = 0; n < 7; ++n) {
            float s = NEG_INF;
            if (n < own) { s = 0.f;
#pragma unroll
                for (int ks = 0; ks < 4; ++ks) { const LAS f32x4* kp = (const LAS f32x4*)(km + n * 128 + 32 * ks + 8 * g); const f32x4 k0 = kp[0], k1 = kp[1]; const v4u qu = __builtin_bit_cast(v4u, qf[gi][ks]);
                    s += bflo(qu.x) * k0.x + bfhi(qu.x) * k0.y + bflo(qu.y) * k0.z + bfhi(qu.y) * k0.w + bflo(qu.z) * k1.x + bfhi(qu.z) * k1.y + bflo(qu.w) * k1.z + bfhi(qu.w) * k1.w; }
                s += __shfl_xor(s, 16); s += __shfl_xor(s, 32); }
            gate[n] = s;
        }
        unsigned sm = 0u;
#pragma unroll
        for (int r = 0; r < 3; ++r) { float best = NEG_INF; int bi = 0;
#pragma unroll
            for (int n = 0; n < 7; ++n) { const bool cand = (n < own) && !((sm >> n) & 1u) && (gate[n] > best); best = cand ? gate[n] : best; bi = cand ? n : bi; }
            sm |= 1u << bi; }
        selmask[gi] = sm; }
    }
    const int nT = 4 + 4 * own;
    const int sr = tid >> 3, sc = (tid & 7) * 16;
#define A_KEY0(i) ((i) < 4 ? own * 256 + 64 * (i) : (((i) - 4) >> 2) * 256 + (((i) - 4) & 3) * 64)
    v4u kr0, kr1, vr0, vr1;
#define A_LOAD(i) do { const bf16* kp_ = PROJ + (rowbase + A_KEY0(i) + sr) * NPROJ + COL_K + h * 128 + sc; \
        kr0 = *(const GAS v4u*)kp_; kr1 = *(const GAS v4u*)(kp_ + 8); vr0 = *(const GAS v4u*)(kp_ + (COL_V - COL_K)); vr1 = *(const GAS v4u*)(kp_ + (COL_V - COL_K) + 8); } while (0)
#define A_STORE(bufi) do { LAS unsigned char* kd_ = lds + ((bufi) ? A_KB1 : A_KB0) + sr * A_KSTR + sc * 2; LAS unsigned char* vd_ = lds + A_VB0 + vnx * A_VBS + sr * A_VSTR + sc * 2; \
        *(LAS v4u*)kd_ = kr0; *(LAS v4u*)(kd_ + 16) = kr1; *(LAS v4u*)vd_ = vr0; *(LAS v4u*)(vd_ + 16) = vr1; } while (0)
    int vcur = 0, vnx = 0, vprev = 0;
#define A_PV(PF, Vb_) do { _Pragma("unroll") for (int s = 0; s < 2; ++s) { s16x4 vlo[8], vhi[8]; \
            _Pragma("unroll") for (int db = 0; db < 8; ++db) { LAS unsigned char* va = (Vb_) + (32 * s + 4 * g + q4) * A_VSTR + (16 * db + 4 * p4) * 2; vlo[db] = TR16(va); vhi[db] = TR16(va + 16 * A_VSTR); } \
            __builtin_amdgcn_sched_barrier(0); \
            _Pragma("unroll") for (int db = 0; db < 8; ++db) { const bf16x8 vf = __builtin_shufflevector(vlo[db], vhi[db], 0, 1, 2, 3, 4, 5, 6, 7); \
                oacc[0][db] = MFMA16(vf, PF[0][s], oacc[0][db]); oacc[1][db] = MFMA16(vf, PF[1][s], oacc[1][db]); } \
            __builtin_amdgcn_sched_barrier(0); } } while (0)
    A_LOAD(0); A_STORE(0);
    __syncthreads();
    const bool late = w >= 4;
    bf16x8 pfp[2][2]; bool skipp = true;
#pragma unroll
    for (int gi = 0; gi < 2; ++gi) { pfp[gi][0] = (bf16x8){0, 0, 0, 0, 0, 0, 0, 0}; pfp[gi][1] = pfp[gi][0]; }
    float m_run[2] = {NEG_INF, NEG_INF}, l_run[2] = {0.f, 0.f};
    f32x4 oacc[2][8];
#pragma unroll
    for (int gi = 0; gi < 2; ++gi)
#pragma unroll
        for (int db = 0; db < 8; ++db) oacc[gi][db] = (f32x4){0.f, 0.f, 0.f, 0.f};
    for (int i = 0; i < nT; ++i) {
        if (i + 1 < nT) A_LOAD(i + 1);
        vnx = (vcur == 2) ? 0 : vcur + 1;
        const int buf = i & 1, key0 = A_KEY0(i); const bool isown = i < 4; const int pblk = isown ? own : ((i - 4) >> 2);
        const bool skipw = isown && (64 * i > 32 * w + 31);
        if (late && !skipp) A_PV(pfp, lds + A_VB0 + vprev * A_VBS);
        bf16x8 pf[2][2];
        if (!skipw) {
        LAS unsigned char* Kb = lds + (buf ? A_KB1 : A_KB0);
        f32x4 sacc[2][4];
#pragma unroll
        for (int hf = 0; hf < 2; ++hf) { bf16x8 kf[8];
#pragma unroll
            for (int n2 = 0; n2 < 2; ++n2)
#pragma unroll
                for (int ks = 0; ks < 4; ++ks) kf[n2 * 4 + ks] = *(const LAS bf16x8*)(Kb + (16 * (2 * hf + n2) + c16) * A_KSTR + (32 * ks + 8 * g) * 2);
            __builtin_amdgcn_sched_barrier(0);
#pragma unroll
            for (int gi = 0; gi < 2; ++gi)
#pragma unroll
                for (int n2 = 0; n2 < 2; ++n2) { f32x4 a = (f32x4){0.f, 0.f, 0.f, 0.f};
#pragma unroll
                    for (int ks = 0; ks < 4; ++ks) a = MFMA16(kf[n2 * 4 + ks], qf[gi][ks], a);
                    sacc[gi][2 * hf + n2] = a; }
            __builtin_amdgcn_sched_barrier(0); }
        const bool far = (key0 + 63 + 128 <= t0 + 32 * w);
        const bool diag = isown && (64 * i + 63 > 32 * w);
#pragma unroll
        for (int gi = 0; gi < 2; ++gi) {
            const int tq = tq0 + 16 * gi; const bool sel = isown || ((selmask[gi] >> pblk) & 1u);
            float sv[16]; float mloc, m_new, alpha;
            if (far) {
                const float bfar = tab[127];
                float mx = fmaxf(fmaxf(sacc[gi][0][0], sacc[gi][0][1]), fmaxf(sacc[gi][0][2], sacc[gi][0][3]));
#pragma unroll
                for (int nb = 1; nb < 4; ++nb) mx = fmaxf(mx, fmaxf(fmaxf(sacc[gi][nb][0], sacc[gi][nb][1]), fmaxf(sacc[gi][nb][2], sacc[gi][nb][3])));
                mloc = sel ? (mx * SCL2 + bfar) : NEG_INF;
                mloc = fmaxf(mloc, __shfl_xor(mloc, 16)); mloc = fmaxf(mloc, __shfl_xor(mloc, 32));
                m_new = fmaxf(m_run[gi], mloc); alpha = __builtin_amdgcn_exp2f(m_run[gi] - m_new);
                const float cadd = sel ? (bfar - m_new) : NEG_INF;
#pragma unroll
                for (int nb = 0; nb < 4; ++nb)
#pragma unroll
                    for (int r = 0; r < 4; ++r) sv[nb * 4 + r] = __builtin_amdgcn_exp2f(sacc[gi][nb][r] * SCL2 + cadd);
            } else {
                const int relb = tq - key0 - 4 * g; float bias[16];
#pragma unroll
                for (int nb = 0; nb < 4; ++nb)
#pragma unroll
                    for (int r = 0; r < 4; ++r) { const int rel = relb - 16 * nb - r; int ri = rel < 0 ? 0 : rel; ri = ri > 127 ? 127 : ri; bias[nb * 4 + r] = tab[ri]; }
                PIN16(bias, 0);
                mloc = NEG_INF;
#pragma unroll
                for (int nb = 0; nb < 4; ++nb)
#pragma unroll
                    for (int r = 0; r < 4; ++r) { const int rel = relb - 16 * nb - r;
                        float s = sacc[gi][nb][r] * SCL2 + bias[nb * 4 + r]; s = (!sel || (diag && rel < 0)) ? NEG_INF : s; sv[nb * 4 + r] = s; mloc = fmaxf(mloc, s); }
                mloc = fmaxf(mloc, __shfl_xor(mloc, 16)); mloc = fmaxf(mloc, __shfl_xor(mloc, 32));
                m_new = fmaxf(m_run[gi], mloc); alpha = __builtin_amdgcn_exp2f(m_run[gi] - m_new);
#pragma unroll
                for (int e = 0; e < 16; ++e) sv[e] = __builtin_amdgcn_exp2f(sv[e] - m_new);
            }
            float psum = 0.f;
#pragma unroll
            for (int e = 0; e < 16; ++e) psum += sv[e];
            l_run[gi] = l_run[gi] * alpha + psum; m_run[gi] = m_new;
#pragma unroll
            for (int db = 0; db < 8; ++db) oacc[gi][db] = oacc[gi][db] * alpha;
            pf[gi][0] = pack8(sv); pf[gi][1] = pack8(sv + 8);
        }
        __builtin_amdgcn_sched_barrier(0);
        if (!late) A_PV(pf, lds + A_VB0 + vcur * A_VBS);
        }
        if (late) { skipp = skipw;
#pragma unroll
            for (int gi = 0; gi < 2; ++gi) { pfp[gi][0] = pf[gi][0]; pfp[gi][1] = pf[gi][1]; } }
        if (i + 1 < nT) A_STORE((i + 1) & 1);
        vprev = vcur; vcur = vnx;
        __syncthreads();
    }
    if (late && !skipp) A_PV(pfp, lds + A_VB0 + vprev * A_VBS);
#undef A_PV
    bf16* const MIXp = F.HN(); float* const ssqp = F.ssq();
#pragma unroll
    for (int gi = 0; gi < 2; ++gi) {
        const int tq = tq0 + 16 * gi;
        float l_tot = l_run[gi]; l_tot += __shfl_xor(l_tot, 16); l_tot += __shfl_xor(l_tot, 32);
        const float inv = 1.f / l_tot; float ssq = 0.f;
        unsigned char* orow = (unsigned char*)MIXp + (rowbase + tq) * DM + h * 128 + 4 * g;
#pragma unroll
        for (int db = 0; db < 8; ++db) { const f32x4 o = oacc[gi][db] * inv; ssq += (o.x * o.x + o.y * o.y) + (o.z * o.z + o.w * o.w); *(GAS unsigned*)(orow + 16 * db) = pk4_fp8(o.x * SA8, o.y * SA8, o.z * SA8, o.w * SA8); }
        ssq += __shfl_xor(ssq, 16); ssq += __shfl_xor(ssq, 32);
        if (g == 0 && doatom) unsafeAtomicAdd(ssqp + (rowbase + tq) * 4 + 1, ssq);
    }
#undef A_KEY0
#undef A_LOAD
#undef A_STORE
}

constexpr int XBC_W = CONV_CH;
__device__ __forceinline__ void conv_phase(Frame& F) {
    const bf16* const PROJ = F.PROJ(); bf16* const XBC = F.XBC(); const float* const cw = F.conv_w(); const float* const cb = F.conv_b();
    const int gt = blockIdx.x * (NWAVES * 64) + fresh_tid(), GT = F.G * NWAVES * 64;
    for (int task = gt; task < (MTOK / 32) * (CONV_CH / 8); task += GT) {
        const int r = task / (CONV_CH / 8), k = task % (CONV_CH / 8), ch = 8 * k, tok0 = 32 * r;
        float wv[4][8], bias[8];
#pragma unroll
        for (int t = 0; t < 4; ++t) { const f32x4 w0 = *(const GAS f32x4*)(cw + t * CONV_CH + ch), w1 = *(const GAS f32x4*)(cw + t * CONV_CH + ch + 4);
            wv[t][0] = w0.x; wv[t][1] = w0.y; wv[t][2] = w0.z; wv[t][3] = w0.w; wv[t][4] = w1.x; wv[t][5] = w1.y; wv[t][6] = w1.z; wv[t][7] = w1.w; }
        { const f32x4 b0 = *(const GAS f32x4*)(cb + ch), b1 = *(const GAS f32x4*)(cb + ch + 4); bias[0] = b0.x; bias[1] = b0.y; bias[2] = b0.z; bias[3] = b0.w; bias[4] = b1.x; bias[5] = b1.y; bias[6] = b1.z; bias[7] = b1.w; }
        const bf16* src = PROJ + (size_t)tok0 * NPROJ + COL_XBC + ch; bf16* dst = XBC + (size_t)tok0 * XBC_W + ch;
        v4u p0 = (v4u){0u, 0u, 0u, 0u}, p1 = p0, p2 = p0;
        if ((tok0 & (SEQ - 1)) != 0) { p0 = *(const GAS v4u*)(src - 3 * (ptrdiff_t)NPROJ); p1 = *(const GAS v4u*)(src - 2 * (ptrdiff_t)NPROJ); p2 = *(const GAS v4u*)(src - (ptrdiff_t)NPROJ); }
#pragma unroll 1
        for (int i0 = 0; i0 < 32; i0 += 8) {
            v4u cur[8];
#pragma unroll
            for (int i = 0; i < 8; ++i) cur[i] = *(const GAS v4u*)(src + (size_t)(i0 + i) * NPROJ);
#pragma unroll
            for (int i = 0; i < 8; ++i) {
                const v4u c = cur[i]; float acc[8];
                const unsigned a0[4] = {p0.x, p0.y, p0.z, p0.w}, a1[4] = {p1.x, p1.y, p1.z, p1.w}, a2[4] = {p2.x, p2.y, p2.z, p2.w}, a3[4] = {c.x, c.y, c.z, c.w};
#pragma unroll
                for (int j = 0; j < 4; ++j) {
                    acc[2 * j] = bias[2 * j] + wv[0][2 * j] * bflo(a0[j]) + wv[1][2 * j] * bflo(a1[j]) + wv[2][2 * j] * bflo(a2[j]) + wv[3][2 * j] * bflo(a3[j]);
                    acc[2 * j + 1] = bias[2 * j + 1] + wv[0][2 * j + 1] * bfhi(a0[j]) + wv[1][2 * j + 1] * bfhi(a1[j]) + wv[2][2 * j + 1] * bfhi(a2[j]) + wv[3][2 * j + 1] * bfhi(a3[j]); }
#pragma unroll
                for (int j = 0; j < 8; ++j) acc[j] = silu_f(acc[j]);
                v4u o; o.x = pk2(acc[0], acc[1]); o.y = pk2(acc[2], acc[3]); o.z = pk2(acc[4], acc[5]); o.w = pk2(acc[6], acc[7]);
                *(GAS v4u*)(dst + (size_t)(i0 + i) * XBC_W) = o;
                p0 = p1; p1 = p2; p2 = c; }
        }
    }
    { const float* const dtraw = F.dtraw(); float* const dt2 = F.DT2(); const float* const dtb = F.dt_bias();
      for (int i = gt; i < MTOK * 16; i += GT) { const float xr = dtraw[i] + dtb[i & 15]; dt2[i] = xr > 20.f ? xr : log1pf(__expf(xr)); } }
}

constexpr int S_BSTR = 272, S_XSTR = 144;
constexpr int S_BM = 0, S_CM = 128 * S_BSTR, S_X = 2 * 128 * S_BSTR, S_XW = S_X + 128 * S_XSTR, S_HB = S_XW + 128 * S_XSTR, S_DT = S_HB + 64 * S_BSTR, S_CS = S_DT + 512, S_DA = S_CS + 512, S_END = S_DA + 512;
static_assert(S_END <= RING_BYTES, "ssd LDS map");
__device__ __forceinline__ void ssd_unit(Frame& F, int b, int h, const bool doatom = true) {
    LAS unsigned char* lds = F.lds + RING_OFF;
    const int tid = fresh_tid(), lane = tid & 63, w = __builtin_amdgcn_readfirstlane(tid >> 6), g = lane >> 4, c16 = lane & 15, q4 = c16 >> 2, p4 = lane & 3;
    const int g8 = h >> 3, pbw = w & 3, nhw = w >> 2;
    const float a_h = -__expf(F.a_log()[h]), dsk = F.d_skip()[h];
    const bf16* const PROJ = F.PROJ(); bf16* const MIX = F.HN(); const float* const dt2 = F.DT2(); const bf16* const XBC = F.XBC(); float* const ssqp = F.ssq();
    LAS float* dtl = (LAS float*)(lds + S_DT); LAS float* csl = (LAS float*)(lds + S_CS); LAS float* dal = (LAS float*)(lds + S_DA);
    for (int i = tid; i < 64 * S_BSTR / 16; i += NWAVES * 64) ((LAS v4u*)(lds + S_HB))[i] = (v4u){0u, 0u, 0u, 0u};
    f32x4 hacc[4];
#pragma unroll
    for (int i = 0; i < 4; ++i) hacc[i] = (f32x4){0.f, 0.f, 0.f, 0.f};
    const int xl = tid >> 3, xc = tid & 7, bl = tid >> 4, bc = tid & 15;
    v4u xr[2], br[4], cr[4]; float dtv = 0.f;
#define S_PREFETCH(cc) do { const size_t t0_ = (size_t)b * SEQ + (size_t)(cc) * SSM_L; \
        _Pragma("unroll") for (int i_ = 0; i_ < 2; ++i_) xr[i_] = *(const GAS v4u*)(XBC + (t0_ + xl + 64 * i_) * XBC_W + h * 64 + 8 * xc); \
        _Pragma("unroll") for (int i_ = 0; i_ < 4; ++i_) { const bf16* p_ = XBC + (t0_ + bl + 32 * i_) * XBC_W + 1024 + g8 * 128 + 8 * bc; br[i_] = *(const GAS v4u*)p_; cr[i_] = *(const GAS v4u*)(p_ + 256); } \
        if (tid < 128) dtv = dt2[(t0_ + tid) * 16 + h]; } while (0)
    S_PREFETCH(0);
    for (int c = 0; c < SSM_NC; ++c) {
        const size_t tok0 = (size_t)b * SEQ + (size_t)c * SSM_L;
        if (tid < 128) { dtl[tid] = dtv; dal[tid] = dtv * a_h; }
        __syncthreads();
        { const float v0 = dal[2 * lane], v1 = dal[2 * lane + 1]; float s = v0 + v1;
#pragma unroll
            for (int o = 1; o < 64; o <<= 1) { const float t = __shfl_up(s, o); s += (lane >= o) ? t : 0.f; }
            csl[2 * lane] = s - v1; csl[2 * lane + 1] = s; }
        LDS_WAIT(); asm volatile("" ::: "memory");
        const float cs_last = csl[127];
#pragma unroll
        for (int i = 0; i < 2; ++i) { const int l = xl + 64 * i; const v4u v = xr[i]; *(LAS v4u*)(lds + S_X + l * S_XSTR + xc * 16) = v; const float wl = dtl[l] * __expf(cs_last - csl[l]);
            v4u o2; o2.x = pk2(bflo(v.x) * wl, bfhi(v.x) * wl); o2.y = pk2(bflo(v.y) * wl, bfhi(v.y) * wl); o2.z = pk2(bflo(v.z) * wl, bfhi(v.z) * wl); o2.w = pk2(bflo(v.w) * wl, bfhi(v.w) * wl);
            *(LAS v4u*)(lds + S_XW + l * S_XSTR + xc * 16) = o2; }
#pragma unroll
        for (int i = 0; i < 4; ++i) { const int l = bl + 32 * i; *(LAS v4u*)(lds + S_BM + l * S_BSTR + bc * 16) = br[i]; *(LAS v4u*)(lds + S_CM + l * S_BSTR + bc * 16) = cr[i]; }
        const int lrow = 16 * w + c16;
        v2u zr[4];
#pragma unroll
        for (int pb = 0; pb < 4; ++pb) zr[pb] = *(const GAS v2u*)(PROJ + (tok0 + lrow) * NPROJ + COL_Z + h * 64 + 16 * pb + 4 * g);
        if (c + 1 < SSM_NC) S_PREFETCH(c + 1);
        __syncthreads();
        bf16x8 cf[4];
#pragma unroll
        for (int ks = 0; ks < 4; ++ks) cf[ks] = *(const LAS bf16x8*)(lds + S_CM + lrow * S_BSTR + (32 * ks + 8 * g) * 2);
        f32x4 yacc[4];
        const float cs_l = csl[lrow]; const float el = __expf(cs_l);
#pragma unroll
        for (int pb = 0; pb < 4; ++pb) { yacc[pb] = (f32x4){0.f, 0.f, 0.f, 0.f};
#pragma unroll
            for (int ks = 0; ks < 4; ++ks) { const bf16x8 hf = *(const LAS bf16x8*)(lds + S_HB + (16 * pb + c16) * S_BSTR + (32 * ks + 8 * g) * 2); yacc[pb] = MFMA16(hf, cf[ks], yacc[pb]); }
            yacc[pb] = yacc[pb] * el; }
        for (int s2 = 0; s2 <= (w >> 1); ++s2) {
            const int sb0 = 2 * s2, sb1 = 2 * s2 + 1; const bool has1 = sb1 <= w;
            f32x4 cb0 = (f32x4){0.f, 0.f, 0.f, 0.f}, cb1 = (f32x4){0.f, 0.f, 0.f, 0.f};
#pragma unroll
            for (int ks = 0; ks < 4; ++ks) { const bf16x8 bf0 = *(const LAS bf16x8*)(lds + S_BM + (16 * sb0 + c16) * S_BSTR + (32 * ks + 8 * g) * 2); cb0 = MFMA16(bf0, cf[ks], cb0); }
            if (has1) {
#pragma unroll
                for (int ks = 0; ks < 4; ++ks) { const bf16x8 bf1 = *(const LAS bf16x8*)(lds + S_BM + (16 * sb1 + c16) * S_BSTR + (32 * ks + 8 * g) * 2); cb1 = MFMA16(bf1, cf[ks], cb1); } }
            float mv[8];
#pragma unroll
            for (int r = 0; r < 4; ++r) { const int s = 16 * sb0 + 4 * g + r; const float e = __expf(fminf(cs_l - csl[s], 0.f)) * dtl[s]; mv[r] = (s <= lrow) ? cb0[r] * e : 0.f; }
#pragma unroll
            for (int r = 0; r < 4; ++r) { const int s = 16 * sb1 + 4 * g + r; const int sc_ = s > 127 ? 127 : s; const float e = __expf(fminf(cs_l - csl[sc_], 0.f)) * dtl[sc_]; mv[4 + r] = (has1 && s <= lrow) ? cb1[r] * e : 0.f; }
            const bf16x8 pf = pack8(mv);
#pragma unroll
            for (int pb = 0; pb < 4; ++pb) { LAS unsigned char* xa = lds + S_X + (32 * s2 + 4 * g + q4) * S_XSTR + (16 * pb + 4 * p4) * 2;
                const s16x4 lo = TR16(xa), hi = TR16(xa + 16 * S_XSTR); const bf16x8 xf = __builtin_shufflevector(lo, hi, 0, 1, 2, 3, 4, 5, 6, 7);
                yacc[pb] = MFMA16(xf, pf, yacc[pb]); }
        }
        { const size_t tok = tok0 + lrow; float ssq = 0.f;
#pragma unroll
          for (int pb = 0; pb < 4; ++pb) { const int p0 = 16 * pb + 4 * g;
              const v2u xs_ = *(const LAS v2u*)(lds + S_X + lrow * S_XSTR + p0 * 2);
              const v2u zr_ = zr[pb];
              const float o0 = (yacc[pb].x + bflo(xs_.x) * dsk) * silu_f(bflo(zr_.x)), o1 = (yacc[pb].y + bfhi(xs_.x) * dsk) * silu_f(bfhi(zr_.x));
              const float o2 = (yacc[pb].z + bflo(xs_.y) * dsk) * silu_f(bflo(zr_.y)), o3 = (yacc[pb].w + bfhi(xs_.y) * dsk) * silu_f(bfhi(zr_.y));
              ssq += (o0 * o0 + o1 * o1) + (o2 * o2 + o3 * o3);
              *(GAS unsigned*)((unsigned char*)MIX + tok * DM + ATT_W + h * 64 + p0) = pk4_fp8(o0 * SS8, o1 * SS8, o2 * SS8, o3 * SS8); }
          ssq += __shfl_xor(ssq, 16); ssq += __shfl_xor(ssq, 32);
          if (g == 0 && doatom) unsafeAtomicAdd(ssqp + tok * 4 + 2 + g8, ssq); }
        { const float cdec = __expf(cs_last);
#pragma unroll
          for (int i = 0; i < 4; ++i) hacc[i] = hacc[i] * cdec;
#pragma unroll
          for (int ks = 0; ks < 4; ++ks) {
              LAS unsigned char* xa = lds + S_XW + (32 * ks + 8 * g + q4) * S_XSTR + (16 * pbw + 4 * p4) * 2;
              const s16x4 xlo = TR16(xa), xhi = TR16(xa + 4 * S_XSTR); const bf16x8 xf = __builtin_shufflevector(xlo, xhi, 0, 1, 2, 3, 4, 5, 6, 7);
#pragma unroll
              for (int i = 0; i < 4; ++i) { const int nb = 4 * nhw + i; LAS unsigned char* ba = lds + S_BM + (32 * ks + 8 * g + q4) * S_BSTR + (16 * nb + 4 * p4) * 2;
                  const s16x4 blo = TR16(ba), bhi = TR16(ba + 4 * S_BSTR); const bf16x8 bfr = __builtin_shufflevector(blo, bhi, 0, 1, 2, 3, 4, 5, 6, 7);
                  hacc[i] = MFMA16(bfr, xf, hacc[i]); } } }
        __syncthreads();
#pragma unroll
        for (int i = 0; i < 4; ++i) { const int nb = 4 * nhw + i; v2u o; o.x = pk2(hacc[i].x, hacc[i].y); o.y = pk2(hacc[i].z, hacc[i].w);
            *(LAS v2u*)(lds + S_HB + (16 * pbw + c16) * S_BSTR + (16 * nb + 4 * g) * 2) = o; }
    }
#undef S_PREFETCH
    __syncthreads();
}

__device__ __forceinline__ void mix_normalize(Frame& F) {
    const int tid_ = fresh_tid(), lane = tid_ & 63; const int gw = blockIdx.x * NWAVES + __builtin_amdgcn_readfirstlane(tid_ >> 6), NGW = F.G * NWAVES;
    const float* const ssqp = F.ssq(); bf16* const MIX = F.HN(); const float* const gatt = F.attn_out_norm(); const float* const gssm = F.ssm_out_norm();
    for (int m = gw; m < MTOK; m += NGW) {
        const float* sq = ssqp + (size_t)m * 4;
        const float s1 = __hip_atomic_load(sq + 1, RLX_AGENT), s2 = __hip_atomic_load(sq + 2, RLX_AGENT), s3 = __hip_atomic_load(sq + 3, RLX_AGENT);
        const float ra = 1.f / sqrtf(s1 * (1.f / 1024.f) + EPS), r0 = 1.f / sqrtf(s2 * (1.f / 512.f) + EPS), r1 = 1.f / sqrtf(s3 * (1.f / 512.f) + EPS);
        GAS v4u* row = (GAS v4u*)(MIX + (size_t)m * DM);
#pragma unroll
        for (int j = 0; j < 4; ++j) { const int idx = lane + 64 * j, col = 8 * idx; const float rs = (j < 2) ? ra : ((j == 2) ? r0 : r1);
            const float* gp = (j < 2) ? (gatt + col) : (gssm + (col - ATT_W));
            const f32x4 g0 = *(const GAS f32x4*)gp, g1 = *(const GAS f32x4*)(gp + 4); const v4u v = row[idx]; v4u o;
            o.x = pk2(bflo(v.x) * rs * g0.x, bfhi(v.x) * rs * g0.y); o.y = pk2(bflo(v.y) * rs * g0.z, bfhi(v.y) * rs * g0.w);
            o.z = pk2(bflo(v.z) * rs * g1.x, bfhi(v.z) * rs * g1.y); o.w = pk2(bflo(v.w) * rs * g1.z, bfhi(v.w) * rs * g1.w); row[idx] = o; }
    }
}

constexpr size_t TAB_UNIT = 1024;
static_assert((TAB_ITEMS / 8) * 5 % TAB_UNIT == 0 && TAB_ITEMS % TAB_UNIT == 0, "table filler units");
constexpr int P_EIDX = 0, P_GATE = 16384, P_LST = 32768  , P_HN4 = 32768  , P_ACT = 98304  , P_END = 114688;
static_assert(P_END <= RING_BYTES, "peer LDS map");
__constant__ unsigned char PEER_CAND[52] = {0, 1, 2, 3, 4, 5, 6, 7, 8, 9, 10, 11, 12, 13, 14, 15, 16, 17, 18, 19, 20, 21, 22, 23, 32, 33, 34, 35, 36, 48, 49, 50, 51, 64, 65, 66, 80, 81, 96, 97, 112, 113, 128, 144, 160, 176, 192, 208, 224, 240, 255, 255};
__device__ __forceinline__ unsigned f2ord(float f) { const unsigned u = __builtin_bit_cast(unsigned, f); return u ^ ((u >> 31) ? 0xFFFFFFFFu : 0x80000000u); }
__device__ __forceinline__ float ord2f(unsigned u) { return __builtin_bit_cast(float, u ^ ((u >> 31) ? 0x80000000u : 0xFFFFFFFFu)); }
#define CSWAPD(a, b) do { const unsigned hi_ = (a) > (b) ? (a) : (b), lo_ = (a) > (b) ? (b) : (a); (a) = hi_; (b) = lo_; } while (0)
template <int N> __device__ __forceinline__ void bitonic_sort_desc(unsigned (&v)[N]) {
#pragma unroll
    for (int k = 2; k <= N; k <<= 1)
#pragma unroll
        for (int j = k >> 1; j > 0; j >>= 1)
#pragma unroll
            for (int i = 0; i < N; ++i) { const int l = i ^ j; if (l > i) { if ((i & k) == 0) CSWAPD(v[i], v[l]); else CSWAPD(v[l], v[i]); } }
}
__device__ __forceinline__ void merge16_xor(unsigned (&v)[16], int dist) {
    unsigned o[16];
#pragma unroll
    for (int i = 0; i < 16; ++i) o[i] = (unsigned)__shfl_xor((int)v[i], dist);
#pragma unroll
    for (int i = 0; i < 16; ++i) v[i] = v[i] > o[15 - i] ? v[i] : o[15 - i];
#pragma unroll
    for (int j = 8; j > 0; j >>= 1)
#pragma unroll
        for (int i = 0; i < 16; ++i) { const int l = i ^ j; if (l > i) CSWAPD(v[i], v[l]); }
}
__device__ __forceinline__ float gelu_erf(float x) { return 0.5f * x * (1.f + erff(x * 0.70710678118654752f)); }
__device__ __forceinline__ float fp4_dec1(unsigned n) { const unsigned m = n & 7u; unsigned bits = (m >= 2u) ? (((126u + (m >> 1)) << 23) | ((m & 1u) << 22)) : (m ? 0x3F000000u : 0u); bits |= (n & 8u) << 28; return __builtin_bit_cast(float, bits); }
__device__ __forceinline__ f32x2 fp4_dec2(unsigned x) { f32x2 r; r.x = fp4_dec1(x & 15u); r.y = fp4_dec1((x >> 4) & 15u); return r; }
typedef long i64;
typedef int v8i __attribute__((ext_vector_type(8)));
typedef int v4i __attribute__((ext_vector_type(4)));
template <bool dry = false> __device__ __forceinline__ void peer_unit(Frame& F, int u) {
    LAS unsigned char* lds = F.lds + RING_OFF;
    const int tid_ = fresh_tid(), lane = tid_ & 63, w = __builtin_amdgcn_readfirstlane(tid_ >> 6), g = lane >> 4, c16 = lane & 15;
    const int T0 = 32 * u;
    LAS int* eidx = (LAS int*)(lds + P_EIDX); LAS float* gate = (LAS float*)(lds + P_GATE);
    LAS unsigned* lst = (LAS unsigned*)(lds + P_LST) + w * 1024;
    const bf16* const QP = F.QP(); const bf16* const SK = F.SK(); float* const outp = F.out(); const bf16* const X1B = F.X1B(); const float* const fgain = F.ffn_norm(); const float* const fing = F.final_norm(); const unsigned char* const U8 = F.U8(); const unsigned char* const V8 = F.V8();
#ifndef NO_ROUTE
    unsigned cpk[4];
    { unsigned cb[16];
#pragma unroll
      for (int k = 0; k < 13; ++k) cb[k] = PEER_CAND[4 * k + g];
      cb[13] = 255u; cb[14] = 255u; cb[15] = 255u;
#pragma unroll
      for (int q = 0; q < 4; ++q) cpk[q] = cb[4 * q] | (cb[4 * q + 1] << 8) | (cb[4 * q + 2] << 16) | (cb[4 * q + 3] << 24); }
    {
    bf16x8 qf[2][4];
#define QP_LOAD(dst, c_) do { _Pragma("unroll") for (int tb = 0; tb < 2; ++tb) { const unsigned qo = ((unsigned)(T0 + 16 * tb + c16) * (unsigned)DM + (unsigned)((2 * w + (c_)) * 128 + 8 * g)) * 2u; \
        _Pragma("unroll") for (int ks = 0; ks < 4; ++ks) dst[tb][ks] = __builtin_nontemporal_load((const GAS bf16x8*)((const unsigned char*)QP + (qo + 64u * ks))); } } while (0)
    QP_LOAD(qf, 0);
#pragma unroll
    for (int c = 0; c < 2; ++c) {
        const int p = 2 * w + c;
        unsigned key[2][32];
        bf16x8 sf[3][8];
        const unsigned so0 = ((unsigned)(p * 128 + c16) * 128u + 8u * (unsigned)g) * 2u;
#define SK_LOAD(buf, j_) do { _Pragma("unroll") for (int q = 0; q < 8; ++q) sf[buf][q] = *(const GAS bf16x8*)((const unsigned char*)SK + (so0 + (unsigned)(2 * (j_) + (q >> 2)) * 4096u + 64u * (q & 3))); } while (0)
        SK_LOAD(0, 0); SK_LOAD(1, 1);
#pragma unroll
        for (int j = 0; j < 4; ++j) {
            if (j + 2 < 4) SK_LOAD((j + 2) % 3, j + 2);
            __builtin_amdgcn_sched_barrier(0);
#pragma unroll
            for (int h2 = 0; h2 < 2; ++h2)
#pragma unroll
            for (int tb = 0; tb < 2; ++tb) { const int kb = 2 * j + h2; f32x4 acc = (f32x4){0.f, 0.f, 0.f, 0.f};
#pragma unroll
                for (int ks = 0; ks < 4; ++ks) acc = MFMA16(sf[j % 3][4 * h2 + ks], qf[tb][ks], acc);
#pragma unroll
                for (int r = 0; r < 4; ++r) key[tb][kb * 4 + r] = (f2ord(acc[r]) & ~0x7Fu) | (unsigned)(16 * kb + 4 * g + r); }
            __builtin_amdgcn_sched_barrier(0); }
#undef SK_LOAD
        if (c == 0) { QP_LOAD(qf, 1); __builtin_amdgcn_sched_barrier(0); }
#pragma unroll
        for (int tb = 0; tb < 2; ++tb) {
            bitonic_sort_desc<32>(key[tb]);
            unsigned top[16];
#pragma unroll
            for (int i = 0; i < 16; ++i) top[i] = key[tb][i];
            merge16_xor(top, 16); merge16_xor(top, 32);
            if (g == 0) { LAS v4u* d = (LAS v4u*)(lst + (c * 32 + 16 * tb + c16) * 16);
                d[0] = (v4u){top[0], top[1], top[2], top[3]}; d[1] = (v4u){top[4], top[5], top[6], top[7]}; d[2] = (v4u){top[8], top[9], top[10], top[11]}; d[3] = (v4u){top[12], top[13], top[14], top[15]}; } }
    }
#undef QP_LOAD
    }
    for (int tb = 0; tb < 2; ++tb) {
        LDS_WAIT();
        const LAS unsigned* l1 = lst + (16 * tb + c16) * 16; const LAS unsigned* l2 = lst + (32 + 16 * tb + c16) * 16;
        unsigned ck[16];
#pragma unroll
        for (int k = 0; k < 13; ++k) { const unsigned ab = (cpk[k >> 2] >> (8 * (k & 3))) & 255u; const unsigned a = ab >> 4, bq = ab & 15u;
            const float s = ord2f(l1[a] & ~0x7Fu) + ord2f(l2[bq] & ~0x7Fu); ck[k] = (ab == 255u) ? 0u : ((f2ord(s) & ~0xFFu) | ab); }
        ck[13] = 0u; ck[14] = 0u; ck[15] = 0u;
        bitonic_sort_desc<16>(ck);
        merge16_xor(ck, 16); merge16_xor(ck, 32);
        if (g == 0) { const int tl = 16 * tb + c16; const float m = ord2f(ck[0] & ~0xFFu); float e[16]; float sum = 0.f;
#pragma unroll
            for (int k = 0; k < 16; ++k) { e[k] = __expf(ord2f(ck[k] & ~0xFFu) - m); sum += e[k]; }
            const float inv = 1.f / sum;
#pragma unroll
            for (int k = 0; k < 16; ++k) { const unsigned a = (ck[k] >> 4) & 15u, bq = ck[k] & 15u; const int ex = (int)((l1[a] & 0x7Fu) * 128u + (l2[bq] & 0x7Fu));
                eidx[tl * 128 + w * 16 + k] = ex; gate[tl * 128 + w * 16 + k] = e[k] * inv; } }
    }
#endif
    __syncthreads();
    LAS unsigned char* hnb = lds + P_HN4 + w * 8192; LAS float* actl = (LAS float*)(lds + P_ACT) + w * 512;
    const LAS unsigned char* hb = hnb + 16 * g + ((c16 == 1) ? 1024 : 0);
    v4u bA[8], bB[8];
#define U_ISSUE(buf, e_, jb) do { const unsigned uo_ = (unsigned)(e_) * (unsigned)ROWB + 16u * (unsigned)g + 512u * (unsigned)(jb); \
        _Pragma("unroll") for (int jj = 0; jj < 8; ++jj) buf[jj] = *(const GAS v4u*)(U8 + (uo_ + 64u * jj)); __builtin_amdgcn_sched_barrier(0); } while (0)
#define U_CONSUME(buf, jb, HB) do { v4u bq_[8]; _Pragma("unroll") for (int jj = 0; jj < 8; ++jj) bq_[jj] = *(const LAS v4u*)((HB) + 64 * (8 * (jb) + jj)); \
        __builtin_amdgcn_sched_barrier(0); \
        _Pragma("unroll") for (int jj = 0; jj < 8; ++jj) { const v4u a_ = buf[jj]; \
            const v8i av_ = {(int)a_.x, (int)a_.y, (int)a_.z, (int)a_.w, 0, 0, 0, 0}; const v8i bv_ = {(int)bq_[jj].x, (int)bq_[jj].y, (int)bq_[jj].z, (int)bq_[jj].w, 0, 0, 0, 0}; \
            acc = __builtin_amdgcn_mfma_scale_f32_16x16x128_f8f6f4(av_, bv_, acc, 4, 4, 0, 0x7f7f7f7f, 0, 0x7f7f7f7f); } __builtin_amdgcn_sched_barrier(0); } while (0)
#define U_ACT(grp_, TL, ACT) do { const float l0_ = __shfl_down(acc.x, 1), l1_ = __shfl_down(acc.y, 1), l2_ = __shfl_down(acc.z, 1), l3_ = __shfl_down(acc.w, 1); \
        if (c16 == 0) { const int k0 = 16 * (grp_) + 4 * g; constexpr float isc = 1.f / (SU * SH4), ilo = 1.f / SLO4; const f32x4 gt = *(const LAS f32x4*)(gate + (TL) * 128 + k0); \
        f32x4 a4; a4.x = gelu_erf((acc.x + l0_ * ilo) * isc) * gt.x; a4.y = gelu_erf((acc.y + l1_ * ilo) * isc) * gt.y; a4.z = gelu_erf((acc.z + l2_ * ilo) * isc) * gt.z; a4.w = gelu_erf((acc.w + l3_ * ilo) * isc) * gt.w; *(LAS f32x4*)((ACT) + k0) = a4; } } while (0)
#define V_ISSUE(buf, TL, kb_) do { _Pragma("unroll") for (int kh = 0; kh < 2; ++kh) { const LAS v4i* ep_ = (const LAS v4i*)(eidx + (TL) * 128 + 8 * (kb_) + 4 * kh); const v4i e4_ = *ep_; const int ee_[4] = {e4_.x, e4_.y, e4_.z, e4_.w}; \
        _Pragma("unroll") for (int kk = 0; kk < 4; ++kk) { const unsigned vo_ = (unsigned)(ee_[kk] & emask) * (unsigned)ROWB + 16u * (unsigned)lane; buf[4 * kh + kk] = *(const GAS v4u*)(V8 + vo_); } \
        __builtin_amdgcn_sched_barrier(0); } } while (0)
#define PIN8x2(a, i) asm volatile("" : "+v"(a[i]), "+v"(a[i + 1]), "+v"(a[i + 2]), "+v"(a[i + 3]), "+v"(a[i + 4]), "+v"(a[i + 5]), "+v"(a[i + 6]), "+v"(a[i + 7]))
#define V_CONSUME(buf, kb_, O, ACT) do { _Pragma("unroll") for (int kk = 0; kk < 8; ++kk) { const float as_ = (ACT)[8 * (kb_) + kk]; const f32x2 a2_ = {as_, as_}; \
        const unsigned vw[4] = {buf[kk].x, buf[kk].y, buf[kk].z, buf[kk].w}; \
        _Pragma("unroll") for (int q = 0; q < 4; ++q) { \
            O[4 * q]     = __builtin_elementwise_fma(__builtin_amdgcn_cvt_scalef32_pk_f32_fp4(vw[q], 1.0f, 0), a2_, O[4 * q]); \
            O[4 * q + 1] = __builtin_elementwise_fma(__builtin_amdgcn_cvt_scalef32_pk_f32_fp4(vw[q], 1.0f, 1), a2_, O[4 * q + 1]); \
            O[4 * q + 2] = __builtin_elementwise_fma(__builtin_amdgcn_cvt_scalef32_pk_f32_fp4(vw[q], 1.0f, 2), a2_, O[4 * q + 2]); \
            O[4 * q + 3] = __builtin_elementwise_fma(__builtin_amdgcn_cvt_scalef32_pk_f32_fp4(vw[q], 1.0f, 3), a2_, O[4 * q + 3]); } \
        PIN8x2(O, 0); PIN8x2(O, 8); } } while (0)
#ifndef NO_GATHER
#ifdef PROBE_L2RES
    constexpr int emask = dry ? PROBE_L2RES : 16383;
#else
    constexpr int emask = 16383;
#endif
    {
    { unsigned k0[4], k1[4];
#pragma unroll
      for (int ti = 0; ti < 4; ++ti) { const int tl = w + 8 * ti; k0[ti] = ((unsigned)eidx[tl * 128 + lane] << 7) | (unsigned)lane; k1[ti] = ((unsigned)eidx[tl * 128 + 64 + lane] << 7) | (unsigned)(64 + lane); }
#pragma unroll
      for (int k = 2; k <= 128; k <<= 1)
#pragma unroll
        for (int j = k >> 1; j > 0; j >>= 1) {
            if (j == 64) {
#pragma unroll
                for (int ti = 0; ti < 4; ++ti) { const unsigned lo_ = k0[ti] < k1[ti] ? k0[ti] : k1[ti], hi_ = k0[ti] < k1[ti] ? k1[ti] : k0[ti]; k0[ti] = lo_; k1[ti] = hi_; }
            } else {
                const bool lower = (lane & j) == 0;
                const bool desc0 = (k == 64) ? false : ((k == 128) ? false : ((lane & k) != 0)), desc1 = (k == 64) ? true : desc0;
                const bool min0 = lower != desc0, min1 = lower != desc1;
#pragma unroll
                for (int ti = 0; ti < 4; ++ti) { const unsigned p0 = (unsigned)__shfl_xor((int)k0[ti], j), p1 = (unsigned)__shfl_xor((int)k1[ti], j);
                    const unsigned mn0 = k0[ti] < p0 ? k0[ti] : p0, mx0 = k0[ti] < p0 ? p0 : k0[ti], mn1 = k1[ti] < p1 ? k1[ti] : p1, mx1 = k1[ti] < p1 ? p1 : k1[ti];
                    k0[ti] = min0 ? mn0 : mx0; k1[ti] = min1 ? mn1 : mx1; }
            }
        }
      float g0[4], g1[4];
#pragma unroll
      for (int ti = 0; ti < 4; ++ti) { const int tl = w + 8 * ti; g0[ti] = gate[tl * 128 + (int)(k0[ti] & 127u)]; g1[ti] = gate[tl * 128 + (int)(k1[ti] & 127u)]; }
      LDS_WAIT(); asm volatile("" ::: "memory");
#pragma unroll
      for (int ti = 0; ti < 4; ++ti) { const int tl = w + 8 * ti; eidx[tl * 128 + lane] = (int)(k0[ti] >> 7); eidx[tl * 128 + 64 + lane] = (int)(k1[ti] >> 7); gate[tl * 128 + lane] = g0[ti]; gate[tl * 128 + 64 + lane] = g1[ti]; }
      LDS_WAIT(); asm volatile("" ::: "memory"); }
    v2u xn[8];
#define X_ISSUE(tok_) do { const unsigned xb_ = (unsigned)(tok_) * (unsigned)(DM * 2) + 8u * (unsigned)lane; _Pragma("unroll") for (int j = 0; j < 8; ++j) xn[j] = __builtin_nontemporal_load((const GAS v2u*)((const unsigned char*)X1B + (xb_ + 512u * j))); } while (0)
    X_ISSUE(T0 + w);
#pragma unroll 1
    for (int ti = 0; ti < 4; ++ti) {
        f32x4 xr[8]; float ss = 0.f;
#pragma unroll
        for (int j = 0; j < 8; ++j) { const v2u r = xn[j]; xr[j] = (f32x4){bflo(r.x), bfhi(r.x), bflo(r.y), bfhi(r.y)}; }
        X_ISSUE(T0 + w + 8 * (ti < 3 ? ti + 1 : 3));
#pragma unroll
        for (int j = 0; j < 8; ++j) ss += (xr[j].x * xr[j].x + xr[j].y * xr[j].y) + (xr[j].z * xr[j].z + xr[j].w * xr[j].w);
        const float rs2 = __builtin_amdgcn_rsqf(wave_sum(ss) * (1.f / DM) + EPS);
        const float* fg_ = fgain; asm volatile("" : "+s"(fg_));
        const unsigned char* gp = (const unsigned char*)fg_; const unsigned go = 16u * (unsigned)lane;
        unsigned hw[4], lw[4];
#pragma unroll
        for (int q = 0; q < 4; ++q) { unsigned wh = 0u, wl = 0u;
#pragma unroll
            for (int t = 0; t < 2; ++t) { const int j = 2 * q + t; const f32x4 gg = *(const GAS f32x4*)(gp + (go + 1024u * j)); const f32x4 hv = xr[j] * gg * (rs2 * SH4);
                const float h0 = clampf(hv.x, 6.f), h1 = clampf(hv.y, 6.f), h2 = clampf(hv.z, 6.f), h3 = clampf(hv.w, 6.f);
                const unsigned p0 = __builtin_amdgcn_cvt_scalef32_pk_fp4_f32(0u, h0, h1, 1.0f, 0), p1 = __builtin_amdgcn_cvt_scalef32_pk_fp4_f32(0u, h2, h3, 1.0f, 0);
                const f32x2 d0 = __builtin_amdgcn_cvt_scalef32_pk_f32_fp4(p0, 1.0f, 0), d1 = __builtin_amdgcn_cvt_scalef32_pk_f32_fp4(p1, 1.0f, 0);
                const unsigned r0 = __builtin_amdgcn_cvt_scalef32_pk_fp4_f32(0u, clampf((h0 - d0.x) * SLO4, 6.f), clampf((h1 - d0.y) * SLO4, 6.f), 1.0f, 0), r1 = __builtin_amdgcn_cvt_scalef32_pk_fp4_f32(0u, clampf((h2 - d1.x) * SLO4, 6.f), clampf((h3 - d1.y) * SLO4, 6.f), 1.0f, 0);
                wh |= ((p0 & 0xFFu) | ((p1 & 0xFFu) << 8)) << (16 * t); wl |= ((r0 & 0xFFu) | ((r1 & 0xFFu) << 8)) << (16 * t); }
            hw[q] = wh; lw[q] = wl; }
        *(LAS v4u*)(hnb + 2048 * ti + 16 * lane) = (v4u){hw[0], hw[1], hw[2], hw[3]}; *(LAS v4u*)(hnb + 2048 * ti + 1024 + 16 * lane) = (v4u){lw[0], lw[1], lw[2], lw[3]};
    }
    LDS_WAIT();
    { int e_cur = eidx[w * 128 + c16] & emask;
      U_ISSUE(bA, e_cur, 0);
#pragma unroll 1
      for (int s_ = 0; s_ < 31; ++s_) {
          const int ti = s_ & 3, grp = s_ >> 2, tl = w + 8 * ti, sn = s_ + 1;
          const int e_nxt = eidx[(w + 8 * (sn & 3)) * 128 + 16 * (sn >> 2) + c16] & emask;
          const LAS unsigned char* hbt = hb + 2048 * ti; LAS float* actt = actl + 128 * ti;
          f32x4 acc = (f32x4){0.f, 0.f, 0.f, 0.f};
          U_ISSUE(bB, e_cur, 1); U_CONSUME(bA, 0, hbt);
          U_ISSUE(bA, e_nxt, 0);
          U_CONSUME(bB, 1, hbt);
          U_ACT(grp, tl, actt);
          e_cur = e_nxt;
      }
      { const LAS unsigned char* hbt = hb + 2048 * 3; LAS float* actt = actl + 128 * 3;
        f32x4 acc = (f32x4){0.f, 0.f, 0.f, 0.f};
        U_ISSUE(bB, e_cur, 1); U_CONSUME(bA, 0, hbt);
        V_ISSUE(bA, w, 0);
        U_CONSUME(bB, 1, hbt);
        U_ACT(7, w + 24, actt); } }
    LDS_WAIT();
    f32x2 o2[4][16];
#pragma unroll
    for (int ti = 0; ti < 4; ++ti)
#pragma unroll
        for (int i = 0; i < 16; ++i) o2[ti][i] = (f32x2){0.f, 0.f};
#pragma unroll 1
    for (int kb = 0; kb < 16; ++kb) {
        const int kn = kb < 15 ? kb + 1 : 15;
        V_ISSUE(bB, w + 8, kb);  V_CONSUME(bA, kb, o2[0], actl);
        V_ISSUE(bA, w + 16, kb); V_CONSUME(bB, kb, o2[1], actl + 128);
        V_ISSUE(bB, w + 24, kb); V_CONSUME(bA, kb, o2[2], actl + 256);
        V_ISSUE(bA, w, kn);      V_CONSUME(bB, kb, o2[3], actl + 384);
    }
    X_ISSUE(T0 + w);
#pragma unroll
    for (int ti = 0; ti < 4; ++ti) {
        const size_t token = (size_t)T0 + w + 8 * ti;
        const unsigned xo = (unsigned)token * (unsigned)(DM * 4) + 16u * (unsigned)lane;
        f32x4 xr[8];
#pragma unroll
        for (int j = 0; j < 8; ++j) { const v2u r = xn[j]; xr[j] = (f32x4){bflo(r.x), bfhi(r.x), bflo(r.y), bfhi(r.y)}; }
        if (ti < 3) X_ISSUE(T0 + w + 8 * (ti + 1));
        constexpr float isv = 1.f / SV; float s2 = 0.f;
#pragma unroll
        for (int j = 0; j < 8; ++j) { xr[j] = xr[j] + (f32x4){o2[ti][2 * j].x, o2[ti][2 * j].y, o2[ti][2 * j + 1].x, o2[ti][2 * j + 1].y} * isv;
            s2 += (xr[j].x * xr[j].x + xr[j].y * xr[j].y) + (xr[j].z * xr[j].z + xr[j].w * xr[j].w); }
        const float rf = __builtin_amdgcn_rsqf(wave_sum(s2) * (1.f / DM) + EPS);
        const float* fi_ = fing; asm volatile("" : "+s"(fi_));
        const unsigned char* fp = (const unsigned char*)fi_; unsigned char* op = (unsigned char*)outp; const unsigned fo = 16u * (unsigned)lane;
        if (!dry || rf == 1.2345e30f)
#pragma unroll
        for (int j = 0; j < 8; ++j) __builtin_nontemporal_store(xr[j] * rf * *(const GAS f32x4*)(fp + (fo + 1024u * j)), (GAS f32x4*)(op + (xo + 1024u * j)));
    }
    }
#endif
#undef U_ISSUE
#undef X_ISSUE
#undef U_ACT
#undef U_CONSUME
#undef V_ISSUE
#undef V_CONSUME
    __syncthreads();
}

__global__ void __launch_bounds__(NWAVES * 64, 2) hybrid_fwd(Args args) {
    extern __shared__ __attribute__((aligned(16))) unsigned char lds[];
    Frame F;
    F.lds = (LAS unsigned char*)lds;
    F.MISC = (volatile LAS unsigned*)(F.lds + MISC_OFF);
    F.tid = threadIdx.x; F.lane = F.tid & 63; F.wave = __builtin_amdgcn_readfirstlane(F.tid >> 6); F.G = gridDim.x;
    for (int u = F.tid; u < (LDS_BYTES - LDSCTL_OFF) / 4; u += NWAVES * 64) ((LAS unsigned*)(F.lds + LDSCTL_OFF))[u] = 0u;
    __syncthreads();
    (void)args;
    XcdBarrier bar = xcd_barrier_post(F.ctl() + CW_BAR, F.MISC + 8);

#ifndef NO_P0
#ifdef PROBE_P0X2
    { int reps = 2; asm volatile("" : "+s"(reps)); for (int rep = 0; rep < reps; ++rep) p0_prologue(F); }
#else
    p0_prologue(F);
#endif
#endif
    xcd_barrier(bar);
#ifndef NO_P1
#ifdef PROBE_GX2
    { int reps = 2; asm volatile("" : "+s"(reps)); for (int rep = 0; rep < reps; ++rep) {
#else
    { { const int rep = 0, reps = 1;
#endif
      pg8::Gemm gm{F.HN(), F.WinT(), MTOK, NB16, DM}; pg8::StaticOrder S; S.init(MTOK, NB16, F.G, (int)blockIdx.x);
      EpiProj E{F.PROJ(), F.dtraw(), (rep + 1 < reps) ? nullptr : F.kmean()};
      pg8::gemm_phase<EpiProj, pg8::StaticOrder, PG8_ALIGN, PG8_SP2>(F.lds + RING_OFF, gm, S, E); } }
    { const int nun = (MTOK / 256) * (NB16 / 256), rem = nun % F.G;
      if (rem && (int)blockIdx.x >= rem) tables_convert(F, tab_split(F.G), TAB_ITEMS, (size_t)((int)blockIdx.x - rem) * (NWAVES * 64) + fresh_tid(), (size_t)(F.G - rem) * (NWAVES * 64)); }
    __syncthreads();
    {
      pg8::Gemm gm{(const pg8::bf16_t*)F.HN8(), (const pg8::bf16_t*)F.WinT8(), MTOK, F8_HI - F8_LO, DM / 2}; pg8::StaticOrder S; S.init(MTOK, F8_HI - F8_LO, F.G, (int)blockIdx.x);
      EpiProj8 E{F.PROJ()};
      pg8::gemm_phase<EpiProj8, pg8::StaticOrder, PG8_ALIGN, PG8_SP2, true>(F.lds + RING_OFF, gm, S, E); }
#endif
    xcd_barrier(bar);
#ifdef PROBE_P15X2
    conv_phase(F);
#endif
    conv_phase(F);
    xcd_barrier(bar);
#ifdef PROBE_P2X2
    { int reps = 2; asm volatile("" : "+s"(reps)); for (int rep = 0; rep < reps; ++rep) {
#else
    { { const int rep = 0, reps = 1;
#endif
    const bool doatom = rep + 1 == reps;
    const int ntab = (int)(tab_split(F.G) / TAB_UNIT);
    for (;;) {
        if (F.tid == 0) F.MISC[0] = xb_add(F.ctl() + CW_Q2 + 64 * rep, 1u);
        __syncthreads();
        const int ui = (int)F.MISC[0];
        __syncthreads();
        if (ui >= 128 + 512 + ntab) break;
        if (ui >= 128 + 512) { const size_t lo = (size_t)(ui - 640) * TAB_UNIT; tables_convert(F, lo, lo + TAB_UNIT, (size_t)fresh_tid(), (size_t)(NWAVES * 64)); continue; }
#ifdef PROBE_P2_SSD
        if (ui < 128 || doatom)
#endif
#ifdef PROBE_P2_ATT
        if (ui >= 128 || doatom)
#endif
        {
        if (ui < 128) ssd_unit(F, ui >> 4, ui & 15, doatom);
        else { const int a = ui - 128; attn_unit(F, (a & 63) >> 3, a & 7, 7 - (a >> 6), doatom); }
        }
    } } }
    xcd_barrier(bar);
#ifndef NO_P3
#ifdef PROBE_GX2
    { int reps = 2; asm volatile("" : "+s"(reps)); for (int rep = 0; rep < reps; ++rep) {
#else
    { { const int rep = 0, reps = 1;
#endif
      pg8::Gemm gm{F.HN(), F.WoutT(), MTOK, DM, DM / 2}; pg8::StaticOrder S; S.init(MTOK, DM, F.G, (int)blockIdx.x);
      {
        const int t_ = fresh_tid(); const float* const sq = F.ssq();
#pragma unroll 1
        for (int ii = t_ >> 8; ii < 3; ii += 2) { pg8::Unit uu;
          if (S.next(ii, uu)) { const int row = uu.pm * 256 + (t_ & 255);
            const float q1 = __hip_atomic_load(sq + (size_t)row * 4 + 1, RLX_AGENT), q2 = __hip_atomic_load(sq + (size_t)row * 4 + 2, RLX_AGENT), q3 = __hip_atomic_load(sq + (size_t)row * 4 + 3, RLX_AGENT);
            const float sa = __builtin_amdgcn_rsqf(q1 * (1.f / 1024.f) + EPS), s0 = __builtin_amdgcn_rsqf(q2 * (1.f / 512.f) + EPS), s1 = __builtin_amdgcn_rsqf(q3 * (1.f / 512.f) + EPS);
            *(LAS f32x4*)(F.lds + SEGTAB_OFF + (ii * 256 + (t_ & 255)) * 16) = (f32x4){sa / s0 * (SS8 / SA8), s0 / s1, s1 * (1.f / (SS8 * SW8)), 0.f}; } }
        __syncthreads(); }
      EpiOut E{F.x(), F.X1B(), F.X18(), F.ssq(), rep + 1 == reps, (const LAS f32x4*)(F.lds + SEGTAB_OFF)};
      pg8::gemm_phase<EpiOut, pg8::StaticOrder, PG8_ALIGN, PG8_SP2, true>(F.lds + RING_OFF, gm, S, E); } }
#endif
    xcd_barrier(bar);
#ifndef NO_P4
#ifdef PROBE_GX2
    { int reps = 2; asm volatile("" : "+s"(reps)); for (int rep = 0; rep < reps; ++rep) {
#else
    { { const int rep = 0, reps = 1; (void)rep; (void)reps;
#endif
      pg8::Gemm gm{(const pg8::bf16_t*)F.X18(), F.WqT(), MTOK, DM, DM / 2}; pg8::StaticOrder S; S.init(MTOK, DM, F.G, (int)blockIdx.x);
      EpiQ E{F.QP(), F.ssq()};
      pg8::gemm_phase<EpiQ, pg8::StaticOrder, PG8_ALIGN, PG8_SP2, true>(F.lds + RING_OFF, gm, S, E); } }
#endif
    xcd_barrier(bar);
#ifndef NO_P5
#ifdef PROBE_P5X2
    { for (int u = blockIdx.x; u < MTOK / 32; u += F.G) peer_unit<true>(F, u);
      for (int u = blockIdx.x; u < MTOK / 32; u += F.G) peer_unit<false>(F, u); }
#else
    for (int u = blockIdx.x; u < MTOK / 32; u += F.G) peer_unit(F, u);
#endif
#endif
}

extern "C" void kernel_launch(void* const* d_in, const int* in_sizes, int n_in, void* d_out, int out_size, void* d_ws, size_t ws_size, hipStream_t stream) {
    static int grid = 0;
    if (grid == 0) {
        if (n_in != 18 || out_size != MTOK * DM || ws_size < WS_END) { fprintf(stderr, "kernel_launch: unexpected shapes (n_in %d, out %d, ws %zu)\n", n_in, out_size, ws_size); grid = -1; return; }
        int dev = 0, cus = 0, per_cu = 0;
        if (hipGetDevice(&dev) != hipSuccess || hipDeviceGetAttribute(&cus, hipDeviceAttributeMultiprocessorCount, dev) != hipSuccess) { grid = -1; return; }
        if (hipFuncSetAttribute((const void*)hybrid_fwd, hipFuncAttributeMaxDynamicSharedMemorySize, LDS_BYTES) != hipSuccess) { fprintf(stderr, "kernel_launch: hipFuncSetAttribute failed\n"); grid = -1; return; }
        if (hipOccupancyMaxActiveBlocksPerMultiprocessor(&per_cu, (const void*)hybrid_fwd, NWAVES * 64, LDS_BYTES) != hipSuccess || per_cu < 1)
            fprintf(stderr, "kernel_launch: note: occupancy query reports %d workgroups per CU\n", per_cu);
        (void)hipGetLastError();
        grid = cus;
    }
    if (grid < 0) return;
    if (hipMemsetAsync((char*)d_ws + WS_CTL, 0, CTL_ZERO_BYTES, stream) != hipSuccess) return;
    Args a{};
    for (int i = 0; i < 18; ++i) a.in[i] = (const float*)d_in[i];
    a.out = (float*)d_out; a.ws = (unsigned char*)d_ws;
    hipLaunchKernelGGL(hybrid_fwd, dim3(grid), dim3(NWAVES * 64), LDS_BYTES, stream, a);
}
```

```cpp
#include <hip/hip_runtime.h>
#include <cstdio>
#include <cstdint>
namespace pg8 {
#define PG8_LAS __attribute__((address_space(3)))
typedef unsigned short bf16_t;
typedef short bf16x8 __attribute__((ext_vector_type(8)));
typedef float f32x4 __attribute__((ext_vector_type(4)));
typedef unsigned u32x4 __attribute__((ext_vector_type(4)));
constexpr int BM = 256, BK = 64, HALF = 128, HTB = HALF * BK * 2  , STAGE_BYTES = 8 * HTB, NXCD = 8, WGM = 8;

__host__ __device__ __forceinline__ int lds_byte(int r, int c) { const int st = (r >> 4) * 2 + (c >> 5), rr = r & 15, cc = c & 31, ob = rr * 64 + cc * 2; return st * 1024 + (ob ^ (((ob >> 9) & 1) << 5)); }
__host__ __device__ __forceinline__ void stage_rc(int b, int& R, int& C) { const int st = b / 1024, sb = b % 1024, swz = sb ^ (((sb >> 9) & 1) << 5); R = (st >> 1) * 16 + swz / 64; C = (st & 1) * 32 + (swz % 64) / 2; }
__host__ __device__ __forceinline__ int perm32(int rho) { const int n = rho >> 4, i = rho & 15; return 8 * (i >> 2) + 4 * n + (i & 3); }

struct Unit { int pm, pn; };
struct Gemm { const bf16_t* A; const bf16_t* Bt; int M, N, K; };

struct StaticOrder {
    int nM, nN, nwg, G, c;
    __host__ __device__ void init(int M, int N, int G_, int c_) { nM = M / BM; nN = N / BM; nwg = nM * nN; G = G_; c = c_; }
    __host__ __device__ bool next(int i, Unit& u) const {
        const long L = (long)i * G + c; if (L >= nwg) return false;
        int wgid = (int)L; { const int q = nwg / NXCD, r = nwg % NXCD, xcd = wgid % NXCD, off = wgid / NXCD; wgid = (xcd < r ? xcd * (q + 1) : r * (q + 1) + (xcd - r) * q) + off; }
        const int nig = WGM * nN, gid = wgid / nig, fm = gid * WGM, gsz = (nM - fm) < WGM ? (nM - fm) : WGM;
        u.pm = fm + ((wgid % nig) % gsz); u.pn = (wgid % nig) / gsz; return true;
    }
    __device__ __forceinline__ void a_ready(const Unit&) const {}
    __device__ __forceinline__ void done(const Unit&) const {}
};

__device__ __forceinline__ unsigned cvt_pk_bf16(float lo, float hi) { unsigned r; asm volatile("v_cvt_pk_bf16_f32 %0, %1, %2" : "=v"(r) : "v"(lo), "v"(hi)); return r; }
typedef float f32x2 __attribute__((ext_vector_type(2)));
__device__ __forceinline__ f32x2 gelu_pk(f32x2 v) {
    const f32x2 av = __builtin_elementwise_abs(v), d = av * 0.2316418882f + 1.0f;
    f32x2 t; t.x = __builtin_amdgcn_rcpf(d.x); t.y = __builtin_amdgcn_rcpf(d.y);
    f32x2 q = t * 0.5307027145f + (-0.7265760135f); q = q * t + 0.7107068705f; q = q * t + (-0.142248368f); q = q * t + 0.127414796f; q = q * t;
    const f32x2 s = (v * v) * (-0.72134752044f);
    f32x2 e; e.x = __builtin_amdgcn_exp2f(s.x); e.y = __builtin_amdgcn_exp2f(s.y);
    const f32x2 m = v * (q * e), r = v - m;
    f32x2 o; o.x = v.x < 0.f ? m.x : r.x; o.y = v.y < 0.f ? m.y : r.y; return o;
}

template <int ACT  > struct EpiBf16 {
    static constexpr bool PERM = true, AFTER_DRAIN = false, SEG = false; static_assert(ACT == 0 || ACT == 1, "EpiBf16: ACT is 0 (none) or 1 (gelu_pk)");
    bf16_t* O; int ldc; const float* bias; int split_cols; size_t split_stride; float scale0;
    __device__ __forceinline__ void operator()(const f32x4 (&acc)[2][2][4][2], const Unit& u, int wr, int wc, int fr, int fq) const {
        const int row0 = u.pm * BM + wr * 64 + fr; int colt = u.pn * BM; bf16_t* base = O;
        float sc = 1.f; if (split_cols) { const int t = colt / split_cols; base += (size_t)t * split_stride; colt -= t * split_cols; if (t == 0) sc = scale0; }
        const int col0 = colt + wc * 32 + 8 * fq, bcol0 = u.pn * BM + wc * 32 + 8 * fq;
        f32x4 bv[2][2];
#pragma unroll
        for (int bj = 0; bj < 2; ++bj)
#pragma unroll
            for (int n = 0; n < 2; ++n) bv[bj][n] = bias ? *(const f32x4*)(bias + bcol0 + bj * HALF + 4 * n) : (f32x4){0.f, 0.f, 0.f, 0.f};
#pragma unroll
        for (int ai = 0; ai < 2; ++ai)
#pragma unroll
            for (int m = 0; m < 4; ++m) { bf16_t* rowp = base + (size_t)(row0 + ai * HALF + m * 16) * ldc + col0;
#pragma unroll
                for (int bj = 0; bj < 2; ++bj) { f32x4 v0 = acc[ai][bj][m][0] + bv[bj][0], v1 = acc[ai][bj][m][1] + bv[bj][1];
                    if (ACT == 1) { f32x2 a = gelu_pk((f32x2){v0[0], v0[1]}), b = gelu_pk((f32x2){v0[2], v0[3]}), c = gelu_pk((f32x2){v1[0], v1[1]}), d = gelu_pk((f32x2){v1[2], v1[3]});
                        v0 = (f32x4){a.x, a.y, b.x, b.y}; v1 = (f32x4){c.x, c.y, d.x, d.y}; }
                    v0 = v0 * sc; v1 = v1 * sc; u32x4 w; w.x = cvt_pk_bf16(v0[0], v0[1]); w.y = cvt_pk_bf16(v0[2], v0[3]); w.z = cvt_pk_bf16(v1[0], v1[1]); w.w = cvt_pk_bf16(v1[2], v1[3]);
                    *(u32x4*)(rowp + bj * HALF) = w; } }
    }
};
template <class Epi, class Sched, bool ALIGN_EPI = false, bool SP2 = false, bool F8 = false>
__device__ __forceinline__ void gemm_phase(PG8_LAS unsigned char* lds, const Gemm g, const Sched& S, const Epi& E) {
    int tid_ = threadIdx.x; asm volatile("" : "+v"(tid_));
    const int tid = tid_, wid = __builtin_amdgcn_readfirstlane(tid >> 6), lane = tid & 63, wr = wid >> 2, wc = wid & 3, fr = lane & 15, fq = lane >> 4;
    const int K = g.K, nt = K / BK;
    unsigned voffA[2], voffB[2];
#pragma unroll
    for (int i = 0; i < 2; ++i) { int R, C; stage_rc(tid * 16 + i * 8192, R, C); const int Rb = Epi::PERM ? ((R & ~31) + perm32(R & 31)) : R;
        voffA[i] = (unsigned)(R * K + C) * 2u; voffB[i] = (unsigned)(Rb * K + C) * 2u; }
    const size_t kstep = (size_t)(BK * 2);
    const size_t hstep = (size_t)HALF * K * 2;
    const size_t tstep = 2 * hstep;
    const unsigned ldsw = (unsigned)wid * 1024u;
    const int aoff = lds_byte(wr * 64 + fr, fq * 8), boff = lds_byte(wc * 32 + fr, fq * 8);
#define PG8_SA(b, h) (((b) * 2 + (h)) * HTB)
#define PG8_SB(b, h) ((4 + (b) * 2 + (h)) * HTB)
#define PG8_STAGE(bufoff, gbase, voff) do { _Pragma("unroll") for (int _i = 0; _i < 2; ++_i) \
        __builtin_amdgcn_global_load_lds((const unsigned*)((const char*)(gbase) + (voff)[_i]), (PG8_LAS unsigned*)(lds + (bufoff) + ldsw + _i * 8192), 16, 0, 0); } while (0)
#define PG8_LDA(dst, b, h) do { _Pragma("unroll") for (int m = 0; m < 4; ++m) _Pragma("unroll") for (int k = 0; k < 2; ++k) dst[m][k] = *(const PG8_LAS bf16x8*)(lds + PG8_SA(b, h) + aoff + m * 2048 + k * 1024); } while (0)
#define PG8_LDB(dst, b, h) do { _Pragma("unroll") for (int n = 0; n < 2; ++n) _Pragma("unroll") for (int k = 0; k < 2; ++k) dst[n][k] = *(const PG8_LAS bf16x8*)(lds + PG8_SB(b, h) + boff + n * 2048 + k * 1024); } while (0)
#define PG8_MMA(ai, bj, At, Bt) do { __builtin_amdgcn_s_setprio(1); _Pragma("unroll") for (int m = 0; m < 4; ++m) _Pragma("unroll") for (int n = 0; n < 2; ++n) { \
        if constexpr (F8) { typedef int v8i_ __attribute__((ext_vector_type(8))); typedef int v4i_ __attribute__((ext_vector_type(4))); \
            const v4i_ b0_ = __builtin_bit_cast(v4i_, Bt[n][0]), b1_ = __builtin_bit_cast(v4i_, Bt[n][1]), a0_ = __builtin_bit_cast(v4i_, At[m][0]), a1_ = __builtin_bit_cast(v4i_, At[m][1]); \
            const v8i_ bb_ = {b0_.x, b0_.y, b0_.z, b0_.w, b1_.x, b1_.y, b1_.z, b1_.w}, aa_ = {a0_.x, a0_.y, a0_.z, a0_.w, a1_.x, a1_.y, a1_.z, a1_.w}; \
            asm volatile("v_mfma_scale_f32_16x16x128_f8f6f4 %0, %1, %2, %0, %3, %3 op_sel_hi:[0,0,0]" : "+v"(acc[ai][bj][m][n]) : "v"(bb_), "v"(aa_), "v"(f8one)); } \
        else { _Pragma("unroll") for (int k = 0; k < 2; ++k) acc[ai][bj][m][n] = __builtin_amdgcn_mfma_f32_16x16x32_bf16(Bt[n][k], At[m][k], acc[ai][bj][m][n], 0, 0, 0); } } \
        __builtin_amdgcn_s_setprio(0); } while (0)
#define PG8_WAIT_V(n) asm volatile("s_waitcnt vmcnt(" #n ")" ::: "memory")
#define PG8_WAIT_L(n) asm volatile("s_waitcnt lgkmcnt(" #n ")" ::: "memory")
#define PG8_BAR __builtin_amdgcn_s_barrier()
#define PG8_SCHED __builtin_amdgcn_sched_barrier(0)
    Unit cur, nxt; int ui = 0;
    if (!S.next(0, cur)) return;
    f32x4 acc[2][2][4][2];
    const int f8one = 0x7f7f7f7f;
#pragma unroll
    for (int a = 0; a < 2; ++a)
#pragma unroll
        for (int b = 0; b < 2; ++b)
#pragma unroll
            for (int m = 0; m < 4; ++m)
#pragma unroll
                for (int n = 0; n < 2; ++n) acc[a][b][m][n] = (f32x4){0.f, 0.f, 0.f, 0.f};
    bf16x8 At[4][2], B0[2][2], B1[2][2];
    const char* cA = (const char*)g.A + (size_t)cur.pm * tstep; const char* cB = (const char*)g.Bt + (size_t)cur.pn * tstep;
    S.a_ready(cur);
    float segr[16];
    if constexpr (Epi::SEG) E.seg_load(ui, wr, fr, segr);
    if constexpr (SP2) {
        PG8_STAGE(PG8_SB(0, 0), cB, voffB); PG8_STAGE(PG8_SB(0, 1), cB + hstep, voffB); PG8_STAGE(PG8_SA(0, 0), cA, voffA); PG8_STAGE(PG8_SA(0, 1), cA + hstep, voffA);
        if (wr == 1) PG8_BAR;
        PG8_WAIT_V(2); PG8_BAR;
        PG8_STAGE(PG8_SB(1, 0), cB + kstep, voffB); PG8_STAGE(PG8_SA(1, 0), cA + kstep, voffA); PG8_STAGE(PG8_SB(1, 1), cB + hstep + kstep, voffB);
        PG8_WAIT_V(6); PG8_BAR;
    } else {
        PG8_STAGE(PG8_SB(0, 0), cB, voffB); PG8_STAGE(PG8_SA(0, 0), cA, voffA); PG8_STAGE(PG8_SB(0, 1), cB + hstep, voffB); PG8_STAGE(PG8_SA(0, 1), cA + hstep, voffA);
        if (wr == 1) PG8_BAR;
        PG8_WAIT_V(4); PG8_BAR;
        PG8_STAGE(PG8_SB(1, 0), cB + kstep, voffB); PG8_STAGE(PG8_SA(1, 0), cA + kstep, voffA); PG8_STAGE(PG8_SB(1, 1), cB + hstep + kstep, voffB);
        PG8_WAIT_V(6); PG8_BAR;
    }
    for (;;) {
        const bool has_next = S.next(ui + 1, nxt);
        const char* nA = has_next ? (const char*)g.A + (size_t)nxt.pm * tstep : cA; const char* nB = has_next ? (const char*)g.Bt + (size_t)nxt.pn * tstep : cB;
        int t = 0;
#pragma unroll 1
        for (int sgi = 0; sgi < (Epi::SEG ? 3 : 1); ++sgi) {
        int tend = nt; if constexpr (Epi::SEG) tend = (sgi == 0) ? Epi::SEG_T1 : ((sgi == 1) ? Epi::SEG_T2 : nt);
        for (; t < tend; t += 2) {
            const bool last = (t == nt - 2);
            const char* a1 = cA + (size_t)(t + 1) * kstep;
            const char* a2 = last ? nA : cA + (size_t)(t + 2) * kstep; const char* b2 = last ? nB : cB + (size_t)(t + 2) * kstep;
            const char* a3 = a2 + kstep; const char* b3 = b2 + kstep;
            if (last && has_next) S.a_ready(nxt);
            if constexpr (SP2) {
            PG8_LDB(B0, 0, 0); PG8_LDB(B1, 0, 1); PG8_SCHED; PG8_LDA(At, 0, 0); PG8_STAGE(PG8_SA(1, 1), a1 + hstep, voffA);
            PG8_WAIT_V(8); PG8_WAIT_L(0); PG8_BAR; PG8_MMA(0, 0, At, B0); PG8_MMA(0, 1, At, B1); PG8_BAR; PG8_SCHED;
            PG8_LDA(At, 0, 1); PG8_STAGE(PG8_SB(0, 0), b2, voffB); PG8_STAGE(PG8_SB(0, 1), b2 + hstep, voffB); PG8_STAGE(PG8_SA(0, 0), a2, voffA);
            PG8_WAIT_V(8); PG8_WAIT_L(0); PG8_BAR; PG8_MMA(1, 0, At, B0); PG8_MMA(1, 1, At, B1); PG8_BAR; PG8_SCHED;
            PG8_LDB(B0, 1, 0); PG8_LDB(B1, 1, 1); PG8_SCHED; PG8_LDA(At, 1, 0); PG8_STAGE(PG8_SA(0, 1), a2 + hstep, voffA);
            PG8_WAIT_V(8); PG8_WAIT_L(0); PG8_BAR; PG8_MMA(0, 0, At, B0); PG8_MMA(0, 1, At, B1); PG8_BAR; PG8_SCHED;
            PG8_LDA(At, 1, 1); PG8_STAGE(PG8_SB(1, 0), b3, voffB); PG8_STAGE(PG8_SB(1, 1), b3 + hstep, voffB); PG8_STAGE(PG8_SA(1, 0), a3, voffA);
            PG8_WAIT_V(8); PG8_WAIT_L(0); PG8_BAR; PG8_MMA(1, 0, At, B0); PG8_MMA(1, 1, At, B1); PG8_BAR; PG8_SCHED;
            } else {
            PG8_LDB(B0, 0, 0); PG8_SCHED; PG8_LDA(At, 0, 0); PG8_STAGE(PG8_SA(1, 1), a1 + hstep, voffA);
            PG8_WAIT_L(8); PG8_BAR; PG8_WAIT_L(0); PG8_MMA(0, 0, At, B0); PG8_BAR; PG8_SCHED;
            PG8_LDB(B1, 0, 1); PG8_STAGE(PG8_SB(0, 0), b2, voffB);
            PG8_BAR; PG8_WAIT_L(0); PG8_MMA(0, 1, At, B1); PG8_BAR;
            PG8_LDA(At, 0, 1); PG8_STAGE(PG8_SA(0, 0), a2, voffA);
            PG8_BAR; PG8_WAIT_L(0); PG8_MMA(1, 0, At, B0); PG8_BAR; PG8_SCHED;
            PG8_STAGE(PG8_SB(0, 1), b2 + hstep, voffB);
            PG8_WAIT_V(6); PG8_BAR; PG8_MMA(1, 1, At, B1); PG8_BAR;
            PG8_LDB(B0, 1, 0); PG8_SCHED; PG8_LDA(At, 1, 0); PG8_STAGE(PG8_SA(0, 1), a2 + hstep, voffA);
            PG8_WAIT_L(8); PG8_BAR; PG8_WAIT_L(0); PG8_MMA(0, 0, At, B0); PG8_BAR; PG8_SCHED;
            PG8_LDB(B1, 1, 1); PG8_STAGE(PG8_SB(1, 0), b3, voffB);
            PG8_BAR; PG8_WAIT_L(0); PG8_MMA(0, 1, At, B1); PG8_BAR;
            PG8_LDA(At, 1, 1); PG8_STAGE(PG8_SA(1, 0), a3, voffA);
            PG8_BAR; PG8_WAIT_L(0); PG8_MMA(1, 0, At, B0); PG8_BAR; PG8_SCHED;
            PG8_STAGE(PG8_SB(1, 1), b3 + hstep, voffB);
            PG8_WAIT_V(6); PG8_BAR; PG8_MMA(1, 1, At, B1); PG8_BAR;
            }
        }
        if constexpr (Epi::SEG) E.seg_apply(acc, segr, sgi);
        }
        if constexpr (ALIGN_EPI) { if (wr == 0) PG8_BAR; }
        if constexpr (!Epi::AFTER_DRAIN) { if constexpr (Epi::SEG) E(acc, cur, wr, wc, fr, fq, ui); else E(acc, cur, wr, wc, fr, fq); S.done(cur); }
        if (!has_next) break;
#pragma unroll
        for (int a = 0; a < 2; ++a)
#pragma unroll
            for (int b = 0; b < 2; ++b)
#pragma unroll
                for (int m = 0; m < 4; ++m)
#pragma unroll
                    for (int n = 0; n < 2; ++n) acc[a][b][m][n] = (f32x4){0.f, 0.f, 0.f, 0.f};
        cur = nxt; cA = nA; cB = nB; ++ui;
        if constexpr (Epi::SEG) E.seg_load(ui, wr, fr, segr);
        if constexpr (ALIGN_EPI) { if (wr == 1) PG8_BAR; }
    }
    PG8_WAIT_V(0);
    if constexpr (!ALIGN_EPI) { if (wr == 0) PG8_BAR; }
    PG8_BAR;
    if constexpr (Epi::AFTER_DRAIN) { E.fused(acc, cur, wr, wc, fr, fq, lds, wid, lane); S.done(cur); }
#undef PG8_SA
#undef PG8_SB
#undef PG8_STAGE
#undef PG8_LDA
#undef PG8_LDB
#undef PG8_MMA
#undef PG8_WAIT_V
#undef PG8_WAIT_L
#undef PG8_BAR
#undef PG8_SCHED
}
}
#ifndef PG8_SP2
#define PG8_SP2 true
#endif
#ifndef PG8_ALIGN
#define PG8_ALIGN true
#endif

constexpr int BATCH = 8, SEQ = 2048, DM = 2048, MTOK = BATCH * SEQ;
constexpr int ATT_W = 1024, ATT_H = 8, ATT_HD = 128, MOBA_BLK = 256, NBLK = SEQ / MOBA_BLK;
constexpr int SSM_W = 1024, SSM_H = 16, SSM_P = 64, SSM_N = 128, SSM_L = 128, SSM_NC = SEQ / SSM_L, CONV_CH = 1536;
constexpr int IN_PROJ = 5648, NPROJ = 5632  , NPAD = 5888  ;
constexpr int F8_LO = 2048, F8_HI = 4096, NB16 = NPAD - (F8_HI - F8_LO)  ;
constexpr float SH8 = 16.f;
constexpr int COL_Q = 0, COL_K = 1024, COL_V = 2048, COL_Z = 3072, COL_XBC = 4096;
constexpr int PEER_H = 8, PEER_NK = 128, PEER_K = 16, PEER_HK = 128;
constexpr float EPS = 1e-6f;
constexpr float SU = 64.f, SV = 4.f, SH = 16.f, SLO = 16.f;
constexpr float SX8 = 16.f, SW8 = 1024.f;
constexpr float SA8 = 32.f, SS8 = 8.f;
constexpr float SH4 = 1.5f, SLO4 = 4.f;
constexpr int ROWB = DM / 2;

constexpr size_t MiB = 1u << 20;
constexpr size_t WS_CTL = 0, CTL_ZERO_BYTES = 1 * MiB;
constexpr size_t WS_DT = 1 * MiB;
constexpr size_t WS_SK = 2 * MiB;
constexpr size_t WS_WIN = 4 * MiB;
constexpr size_t WS_WIN8 = 24 * MiB;
constexpr size_t WS_HN8 = 396 * MiB;
constexpr size_t WS_WOUT = 28 * MiB;
constexpr size_t WS_WQ = 36 * MiB;
constexpr size_t WS_HN = 44 * MiB;
constexpr size_t WS_PROJ = 108 * MiB;
constexpr size_t WS_X1B = WS_PROJ, WS_QP = WS_PROJ + 64 * MiB;
constexpr size_t WS_U8 = 284 * MiB, WS_V8 = 316 * MiB;
constexpr size_t WS_XBC = 348 * MiB;
constexpr size_t WS_DT2 = 3 * MiB;
constexpr size_t WS_X18 = 396 * MiB;
constexpr size_t WS_END = 428 * MiB;
constexpr int CW_BAR = 4096;
constexpr int CW_Q2 = 8192;
constexpr int CW_KMEAN = 32768;
constexpr int CW_SSQ = 131072;
static_assert((CW_SSQ + MTOK * 4) * 4 <= (int)CTL_ZERO_BYTES, "CTL words inside the memset region");

constexpr int RING_OFF = 0, RING_BYTES = 131072;
constexpr int LDSCTL_OFF = RING_BYTES, MISC_OFF = LDSCTL_OFF + 320;
constexpr int SEGTAB_OFF = LDSCTL_OFF + 1024;  static_assert(LDSCTL_OFF + 1024 + 3 * 256 * 16 <= 147456, "segment table inside the LDS allocation");
constexpr int LDS_BYTES = 147456;
constexpr int NWAVES = 8;

#define GAS __attribute__((address_space(1)))
#define LAS __attribute__((address_space(3)))
typedef unsigned short bf16;
typedef unsigned v4u __attribute__((ext_vector_type(4)));
typedef unsigned v2u __attribute__((ext_vector_type(2)));
typedef float f32x4 __attribute__((ext_vector_type(4)));
typedef float f32x2 __attribute__((ext_vector_type(2)));
typedef short bf16x8 __attribute__((ext_vector_type(8)));
typedef short s16x4 __attribute__((ext_vector_type(4)));
typedef GAS unsigned gu32;
#define RLX_AGENT __ATOMIC_RELAXED, __HIP_MEMORY_SCOPE_AGENT
#define LDS_WAIT() asm volatile("s_waitcnt lgkmcnt(0)" ::: "memory")
#define VM_WAIT() asm volatile("s_waitcnt vmcnt(0)" ::: "memory")
__device__ __forceinline__ unsigned f2bf(float f) { unsigned u = __builtin_bit_cast(unsigned, f); return (u + 0x7fffu + ((u >> 16) & 1u)) >> 16; }
typedef __bf16 bf16v2 __attribute__((ext_vector_type(2)));
__device__ __forceinline__ unsigned pk2(float lo, float hi) { bf16v2 v; v.x = (__bf16)lo; v.y = (__bf16)hi; return __builtin_bit_cast(unsigned, v); }
__device__ __forceinline__ float bflo(unsigned w) { return __builtin_bit_cast(float, w << 16); }
__device__ __forceinline__ float bfhi(unsigned w) { return __builtin_bit_cast(float, w & 0xffff0000u); }
__device__ __forceinline__ float wave_sum(float v) {
#pragma unroll
    for (int o = 1; o < 64; o <<= 1) v += __shfl_xor(v, o);
    return v;
}
__device__ __forceinline__ float silu_f(float x) { return x * __builtin_amdgcn_rcpf(1.f + __expf(-x)); }

#define XB_TMO      128
#define XB_XCNT(j)  (256  + 64 * (j))
#define XB_XSUB(j)  (1280 + 64 * (j))
#define XB_XGEN(j)  (2304 + 64 * (j))
#define XB_TOP      3328
#define XB_TOPGEN   3392
#define XCD_BAR_WORDS 3456
#define XB_SPIN_CAP (1u << 18)

__device__ __forceinline__ unsigned xb_ld(unsigned* p)              { return __hip_atomic_load(p, __ATOMIC_RELAXED, __HIP_MEMORY_SCOPE_AGENT); }
__device__ __forceinline__ unsigned xb_add(unsigned* p, unsigned v) { return __hip_atomic_fetch_add(p, v, __ATOMIC_RELAXED, __HIP_MEMORY_SCOPE_AGENT); }
__device__ __forceinline__ unsigned xb_xcc_id() { return (unsigned)__builtin_amdgcn_s_getreg((3 << 11) | 20) & 0xFu; }
#define XB_SPIN(cond, bar) do { unsigned _sp = 0; while (cond) { __builtin_amdgcn_s_sleep(1); \
    if ((++_sp & 255u) == 0u) { if (xb_ld(&(bar)[XB_TMO])) break; if (_sp > XB_SPIN_CAP) { atomicAdd(&(bar)[XB_TMO], 1u); break; } } } } while (0)

struct XcdBarrier {
    unsigned* bar; unsigned x;
    volatile LAS unsigned* st;
};
__device__ __forceinline__ XcdBarrier xcd_barrier_post(unsigned* bar, volatile LAS unsigned* st) {
    XcdBarrier b; b.bar = bar; b.x = xb_xcc_id(); b.st = st;
    if (threadIdx.x == 0) (void)xb_add(&bar[XB_XCNT(b.x)], 1u);
    return b;
}
__device__ __forceinline__ void xcd_barrier_complete(unsigned* bar, unsigned x, unsigned& nloc, unsigned& nx) {
    const unsigned G = gridDim.x * gridDim.y * gridDim.z;
    unsigned sum, cnt, mine, sp = 0u;
    for (;;) {
        sum = 0u; cnt = 0u; mine = 0u;
#pragma unroll
        for (unsigned j = 0; j < 16; ++j) { const unsigned c = xb_ld(&bar[XB_XCNT(j)]); sum += c; cnt += (c > 0u) ? 1u : 0u; mine = (j == x) ? c : mine; }
        if (sum == G) break;
        __builtin_amdgcn_s_sleep(1);
        if ((++sp & 255u) == 0u) { if (xb_ld(&bar[XB_TMO])) break; if (sp > XB_SPIN_CAP) { atomicAdd(&bar[XB_TMO], 1u); break; } }
    }
    nloc = mine > 0u ? mine : 1u; nx = cnt > 0u ? cnt : 1u;
}
__device__ __forceinline__ void xcd_barrier(const XcdBarrier& b) {
    asm volatile("s_waitcnt vmcnt(0)" ::: "memory");
    __syncthreads();
    if (threadIdx.x == 0) {
        unsigned* bar = b.bar;
        __builtin_amdgcn_s_waitcnt(0);
        unsigned nloc = b.st[0], nx = b.st[1];
        if (nloc == 0u) { xcd_barrier_complete(bar, b.x, nloc, nx); b.st[0] = nloc; b.st[1] = nx; }
        const unsigned old = xb_add(&bar[XB_XSUB(b.x)], 1u);
        const unsigned gen = old / nloc;
        if (old + 1u == (gen + 1u) * nloc) {
            __builtin_amdgcn_fence(__ATOMIC_RELEASE, "agent");
            asm volatile("s_waitcnt vmcnt(0)" ::: "memory");
            const unsigned og = xb_add(&bar[XB_TOP], 1u);
            const unsigned tg = og / nx;
            if (og + 1u == (tg + 1u) * nx) xb_add(&bar[XB_TOPGEN], 1u);
            else XB_SPIN(xb_ld(&bar[XB_TOPGEN]) == tg, bar);
            __builtin_amdgcn_fence(__ATOMIC_ACQUIRE, "agent");
            xb_add(&bar[XB_XGEN(b.x)], 1u);
            asm volatile("s_waitcnt vmcnt(0)" ::: "memory");
        } else {
            XB_SPIN(xb_ld(&bar[XB_XGEN(b.x)]) == gen, bar);
            __builtin_amdgcn_fence(__ATOMIC_ACQUIRE, "agent");
            asm volatile("s_waitcnt vmcnt(0)" ::: "memory");
        }
    }
    __syncthreads();
}

#define CAS __attribute__((address_space(4)))
struct Args { const float* in[18]; float* out; unsigned char* ws; };
__device__ __forceinline__ const CAS unsigned char* kargs() { const CAS unsigned char* p = (const CAS unsigned char*)__builtin_amdgcn_kernarg_segment_ptr(); asm volatile("" : "+s"(p)); return p; }
__device__ __forceinline__ const float* kin(int i) { return *(const float* const CAS*)(kargs() + 8 * i); }
__device__ __forceinline__ float* kout() { return *(float* const CAS*)(kargs() + 8 * 18); }
__device__ __forceinline__ unsigned char* kws() { return *(unsigned char* const CAS*)(kargs() + 8 * 19); }
__device__ __forceinline__ int fresh_tid() { int t = threadIdx.x; asm volatile("" : "+v"(t)); return t; }
struct Frame {
    LAS unsigned char* lds;
    volatile LAS unsigned* MISC;
    int tid, lane, wave, G;
    __device__ __forceinline__ const float* x() const { return kin(0); }
    __device__ __forceinline__ const float* attn_norm() const { return kin(1); }
    __device__ __forceinline__ const float* w_in() const { return kin(2); }
    __device__ __forceinline__ const float* conv_w() const { return kin(3); }
    __device__ __forceinline__ const float* conv_b() const { return kin(4); }
    __device__ __forceinline__ const float* dt_bias() const { return kin(5); }
    __device__ __forceinline__ const float* a_log() const { return kin(6); }
    __device__ __forceinline__ const float* d_skip() const { return kin(7); }
    __device__ __forceinline__ const float* rel_bias() const { return kin(8); }
    __device__ __forceinline__ const float* attn_out_norm() const { return kin(9); }
    __device__ __forceinline__ const float* ssm_out_norm() const { return kin(10); }
    __device__ __forceinline__ const float* w_out() const { return kin(11); }
    __device__ __forceinline__ const float* ffn_norm() const { return kin(12); }
    __device__ __forceinline__ const float* peer_wq() const { return kin(13); }
    __device__ __forceinline__ const float* peer_sk() const { return kin(14); }
    __device__ __forceinline__ const float* peer_u() const { return kin(15); }
    __device__ __forceinline__ const float* peer_v() const { return kin(16); }
    __device__ __forceinline__ const float* final_norm() const { return kin(17); }
    __device__ __forceinline__ float* out() const { return kout(); }
    __device__ __forceinline__ unsigned* ctl() const { return (unsigned*)(kws() + WS_CTL); }
    __device__ __forceinline__ float* dtraw() const { return (float*)(kws() + WS_DT); }
    __device__ __forceinline__ bf16* SK() const { return (bf16*)(kws() + WS_SK); }
    __device__ __forceinline__ bf16* WinT() const { return (bf16*)(kws() + WS_WIN); }
    __device__ __forceinline__ bf16* WoutT() const { return (bf16*)(kws() + WS_WOUT); }
    __device__ __forceinline__ bf16* WqT() const { return (bf16*)(kws() + WS_WQ); }
    __device__ __forceinline__ bf16* HN() const { return (bf16*)(kws() + WS_HN); }
    __device__ __forceinline__ bf16* PROJ() const { return (bf16*)(kws() + WS_PROJ); }
    __device__ __forceinline__ bf16* X1B() const { return (bf16*)(kws() + WS_X1B); }
    __device__ __forceinline__ bf16* QP() const { return (bf16*)(kws() + WS_QP); }
    __device__ __forceinline__ unsigned char* U8() const { return kws() + WS_U8; }
    __device__ __forceinline__ unsigned char* V8() const { return kws() + WS_V8; }
    __device__ __forceinline__ unsigned char* X18() const { return kws() + WS_X18; }
    __device__ __forceinline__ unsigned char* HN8() const { return kws() + WS_HN8; }
    __device__ __forceinline__ unsigned char* WinT8() const { return kws() + WS_WIN8; }
    __device__ __forceinline__ bf16* XBC() const { return (bf16*)(kws() + WS_XBC); }
    __device__ __forceinline__ float* DT2() const { return (float*)(kws() + WS_DT2); }
    __device__ __forceinline__ float* kmean() const { return (float*)(kws() + WS_CTL) + CW_KMEAN; }
    __device__ __forceinline__ float* ssq() const { return (float*)(kws() + WS_CTL) + CW_SSQ; }
};

__device__ __forceinline__ float clampf(float v, float lim);
__device__ __forceinline__ void p0_transpose_item(const float* W, int K, int N, bf16* WT, const float* gain, LAS float* scr, int item, int lane, const float f8scale = 0.f, const int nshift = 0) {
    const int nblk = (N + 31) / 32, kb = item / nblk, nb = item % nblk, k0 = 64 * kb, n0 = 32 * nb;
    const int kr = lane >> 3, nc = (lane & 7) * 4; const bool ok = (n0 + nc) < N;
    f32x4 v[8]; float gk[8];
#pragma unroll
    for (int i = 0; i < 8; ++i) { const int kk = 8 * i + kr; v[i] = ok ? *(const GAS f32x4*)(W + (size_t)(k0 + kk) * N + n0 + nc) : (f32x4){0.f, 0.f, 0.f, 0.f}; gk[i] = gain ? gain[k0 + kk] : 1.f; }
#pragma unroll
    for (int i = 0; i < 8; ++i) { const int kk = 8 * i + kr; LAS float* d = scr + kk * 33 + nc; d[0] = v[i].x * gk[i]; d[1] = v[i].y * gk[i]; d[2] = v[i].z * gk[i]; d[3] = v[i].w * gk[i]; }
    LDS_WAIT(); asm volatile("" ::: "memory");
    const int c = lane & 7;
#pragma unroll
    for (int j = 0; j < 4; ++j) { const int n = (lane >> 3) + 8 * j; const LAS float* s = scr + (8 * c) * 33 + n;
        v4u o; o.x = pk2(s[0 * 33], s[1 * 33]); o.y = pk2(s[2 * 33], s[3 * 33]); o.z = pk2(s[4 * 33], s[5 * 33]); o.w = pk2(s[6 * 33], s[7 * 33]);
        if (f8scale == 0.f) *(GAS v4u*)(WT + (size_t)(n0 + n - nshift) * K + k0 + 8 * c) = o;
        else { v2u o8; int w_;
            w_ = __builtin_amdgcn_cvt_pk_fp8_f32(clampf(s[0 * 33] * f8scale, 448.f), clampf(s[1 * 33] * f8scale, 448.f), 0, false); w_ = __builtin_amdgcn_cvt_pk_fp8_f32(clampf(s[2 * 33] * f8scale, 448.f), clampf(s[3 * 33] * f8scale, 448.f), w_, true); o8.x = (unsigned)w_;
            w_ = __builtin_amdgcn_cvt_pk_fp8_f32(clampf(s[4 * 33] * f8scale, 448.f), clampf(s[5 * 33] * f8scale, 448.f), 0, false); w_ = __builtin_amdgcn_cvt_pk_fp8_f32(clampf(s[6 * 33] * f8scale, 448.f), clampf(s[7 * 33] * f8scale, 448.f), w_, true); o8.y = (unsigned)w_;
            *(GAS v2u*)((unsigned char*)WT + (size_t)(n0 + n - nshift) * K + k0 + 8 * c) = o8; } }
    LDS_WAIT(); asm volatile("" ::: "memory");
}
__device__ __forceinline__ unsigned pk4_fp8(float a, float b, float c, float d) { int w = __builtin_amdgcn_cvt_pk_fp8_f32(clampf(a, 448.f), clampf(b, 448.f), 0, false); w = __builtin_amdgcn_cvt_pk_fp8_f32(clampf(c, 448.f), clampf(d, 448.f), w, true); return (unsigned)w; }
__device__ __forceinline__ void rms_2rows_to_bf16(const float* x0, const float* x1, const float* gain, bf16* o0, bf16* o1, unsigned char* q0, unsigned char* q1, int lane) {
    const GAS f32x4* xr0 = (const GAS f32x4*)x0 + lane; const GAS f32x4* xr1 = (const GAS f32x4*)x1 + lane; const GAS f32x4* gr = (const GAS f32x4*)gain + lane;
    f32x4 v[8], u[8]; float s = 0.f, t = 0.f;
#pragma unroll
    for (int j = 0; j < 8; ++j) { v[j] = xr0[64 * j]; u[j] = xr1[64 * j]; }
#pragma unroll
    for (int j = 0; j < 8; ++j) { s += (v[j].x * v[j].x + v[j].y * v[j].y) + (v[j].z * v[j].z + v[j].w * v[j].w); t += (u[j].x * u[j].x + u[j].y * u[j].y) + (u[j].z * u[j].z + u[j].w * u[j].w); }
    const float rs = __builtin_amdgcn_rsqf(wave_sum(s) * (1.f / DM) + EPS), rt = __builtin_amdgcn_rsqf(wave_sum(t) * (1.f / DM) + EPS);
    GAS v2u* p0 = (GAS v2u*)o0 + lane; GAS v2u* p1 = (GAS v2u*)o1 + lane; GAS unsigned* r0 = (GAS unsigned*)q0 + lane; GAS unsigned* r1 = (GAS unsigned*)q1 + lane;
#pragma unroll
    for (int j = 0; j < 8; ++j) { const f32x4 g = gr[64 * j]; v2u a, b;
        const f32x4 h0 = v[j] * g * rs, h1 = u[j] * g * rt;
        a.x = pk2(h0.x, h0.y); a.y = pk2(h0.z, h0.w); p0[64 * j] = a; r0[64 * j] = pk4_fp8(h0.x * SH8, h0.y * SH8, h0.z * SH8, h0.w * SH8);
        b.x = pk2(h1.x, h1.y); b.y = pk2(h1.z, h1.w); p1[64 * j] = b; r1[64 * j] = pk4_fp8(h1.x * SH8, h1.y * SH8, h1.z * SH8, h1.w * SH8); }
}
#ifdef PROBE_FP4EMU
__device__ __forceinline__ float fp4grid(float y) { const float a = fabsf(y); float r;
    if (a <= 2.f) r = rintf(a * 2.f) * 0.5f; else if (a <= 4.f) r = rintf(a); else r = (a < 5.f) ? 4.f : 6.f;
    return copysignf(r, y); }
__device__ __forceinline__ float clampf(float v, float lim) { if (lim == 448.5f) return fp4grid(v * (1.f / 16.f)) * 16.f; return fminf(fmaxf(v, -lim), lim); }
#else
__device__ __forceinline__ float clampf(float v, float lim) { return fminf(fmaxf(v, -lim), lim); }
#endif
template <int TAB = 0> __device__ __forceinline__ v4u cvt16_fp8(const f32x4 a, const f32x4 b, const f32x4 c, const f32x4 d, float sc) {
    v4u o; int w; constexpr float LIM = TAB ? 448.5f : 448.f;
    w = __builtin_amdgcn_cvt_pk_fp8_f32(clampf(a.x * sc, LIM), clampf(a.y * sc, LIM), 0, false); w = __builtin_amdgcn_cvt_pk_fp8_f32(clampf(a.z * sc, LIM), clampf(a.w * sc, LIM), w, true); o.x = (unsigned)w;
    w = __builtin_amdgcn_cvt_pk_fp8_f32(clampf(b.x * sc, LIM), clampf(b.y * sc, LIM), 0, false); w = __builtin_amdgcn_cvt_pk_fp8_f32(clampf(b.z * sc, LIM), clampf(b.w * sc, LIM), w, true); o.y = (unsigned)w;
    w = __builtin_amdgcn_cvt_pk_fp8_f32(clampf(c.x * sc, LIM), clampf(c.y * sc, LIM), 0, false); w = __builtin_amdgcn_cvt_pk_fp8_f32(clampf(c.z * sc, LIM), clampf(c.w * sc, LIM), w, true); o.z = (unsigned)w;
    w = __builtin_amdgcn_cvt_pk_fp8_f32(clampf(d.x * sc, LIM), clampf(d.y * sc, LIM), 0, false); w = __builtin_amdgcn_cvt_pk_fp8_f32(clampf(d.z * sc, LIM), clampf(d.w * sc, LIM), w, true); o.w = (unsigned)w;
    return o;
}
__device__ __forceinline__ void tables_convert(Frame& F, size_t lo, size_t hi, size_t tix, size_t ntx) {
      const GAS f32x4* su = (const GAS f32x4*)F.peer_u(); const GAS f32x4* sv = (const GAS f32x4*)F.peer_v(); GAS v4u* du = (GAS v4u*)F.U8(); GAS v4u* dv = (GAS v4u*)F.V8();
#pragma unroll 1
      for (int tab = 0; tab < 2; ++tab) { const GAS f32x4* src = tab ? sv : su; GAS v4u* dst = tab ? dv : du; const float sc = tab ? SV : SU;
        f32x4 nx[8]; const size_t i0 = lo + tix;
        if (i0 < hi) { const GAS f32x4* p = src + (i0 >> 6) * 512 + (i0 & 63);
#pragma unroll
            for (int j = 0; j < 8; ++j) nx[j] = p[64 * j]; }
#pragma unroll 1
        for (size_t i = i0; i < hi; i += ntx) { f32x4 v[8];
#pragma unroll
            for (int j = 0; j < 8; ++j) v[j] = nx[j];
            if (i + ntx < hi) { const size_t i2 = i + ntx; const GAS f32x4* p = src + (i2 >> 6) * 512 + (i2 & 63);
#pragma unroll
                for (int j = 0; j < 8; ++j) nx[j] = p[64 * j]; }
            unsigned wd[4];
#pragma unroll
            for (int q = 0; q < 4; ++q) { const f32x4 a = v[2 * q] * sc, b = v[2 * q + 1] * sc; unsigned w = 0u;
                w = __builtin_amdgcn_cvt_scalef32_pk_fp4_f32(w, clampf(a.x, 6.f), clampf(a.y, 6.f), 1.0f, 0); w = __builtin_amdgcn_cvt_scalef32_pk_fp4_f32(w, clampf(a.z, 6.f), clampf(a.w, 6.f), 1.0f, 1);
                w = __builtin_amdgcn_cvt_scalef32_pk_fp4_f32(w, clampf(b.x, 6.f), clampf(b.y, 6.f), 1.0f, 2); w = __builtin_amdgcn_cvt_scalef32_pk_fp4_f32(w, clampf(b.z, 6.f), clampf(b.w, 6.f), 1.0f, 3); wd[q] = w; }
            dst[i] = (v4u){wd[0], wd[1], wd[2], wd[3]}; } }
}
constexpr size_t TAB_ITEMS = (size_t)16384 * 64;
#ifndef TAB_HEAD8
#define TAB_HEAD8 4
#endif
__device__ __forceinline__ size_t tab_split(int G) { const int rem = ((MTOK / 256) * (NB16 / 256)) % G; return rem ? (TAB_ITEMS / 8) * TAB_HEAD8 : TAB_ITEMS; }
__device__ __forceinline__ unsigned fp4_code(float y) { const float a = fabsf(y);
    const unsigned m = (unsigned)(a >= 0.25f) + (unsigned)(a >= 0.75f) + (unsigned)(a >= 1.25f) + (unsigned)(a >= 1.75f) + (unsigned)(a >= 2.5f) + (unsigned)(a >= 3.5f) + (unsigned)(a >= 5.0f);
    return m | ((y < 0.f) ? 8u : 0u); }
constexpr int W_SQ_ITEMS = (DM / 64) * (DM / 32), W_SQ_PER_UNIT = 64, W_SQ_UNITS = 2 * W_SQ_ITEMS / W_SQ_PER_UNIT;
__device__ __forceinline__ void sq_weight_items(Frame& F, int unit) {
    const int tid = fresh_tid(), lane = tid & 63, wave = __builtin_amdgcn_readfirstlane(tid >> 6);
    LAS float* scr = (LAS float*)(F.lds + RING_OFF + wave * 16384);
    const float* const w_out = F.w_out(); const float* const wq = F.peer_wq(); const float* const fg = F.ffn_norm(); bf16* const WoutT = F.WoutT(); bf16* const WqT = F.WqT(); const float* const gatt = F.attn_out_norm(); const float* const gssm = F.ssm_out_norm();
#pragma unroll 1
    for (int k = 0; k < W_SQ_PER_UNIT / NWAVES; ++k) {
        int r = unit * W_SQ_PER_UNIT + k * NWAVES + wave;
        if (r < W_SQ_ITEMS) { const int k0_ = 64 * (r / (DM / 32)); p0_transpose_item(w_out, DM, DM, WoutT, (k0_ < ATT_W) ? gatt : (gssm - ATT_W), scr, r, lane, SW8); }
        else { r -= W_SQ_ITEMS; p0_transpose_item(wq, DM, DM, WqT, fg, scr, r, lane, SW8); }
    }
}
__device__ __forceinline__ void p0_prologue(Frame& F) {
    const int tid = fresh_tid(), lane = tid & 63, wave = __builtin_amdgcn_readfirstlane(tid >> 6);
    LAS float* scr = (LAS float*)(F.lds + RING_OFF + wave * 16384);
    const int gw = blockIdx.x * NWAVES + wave, NGW = F.G * NWAVES;
    constexpr int I_IN = (DM / 64) * ((IN_PROJ + 31) / 32), I_SQ = (DM / 64) * (DM / 32);
    constexpr int NITEMS = I_IN;
    { const float* const w_in = F.w_in(); const float* const w_out = F.w_out(); const float* const wq = F.peer_wq(); const float* const fg = F.ffn_norm(); bf16* const WinT = F.WinT(); unsigned char* const WinT8 = F.WinT8(); bf16* const WoutT = F.WoutT(); bf16* const WqT = F.WqT(); const float* const gatt = F.attn_out_norm(); const float* const gssm = F.ssm_out_norm();
      for (int it = gw; it < NITEMS; it += NGW) {
        int r = it;
        if (r < I_IN) { const int n0_ = 32 * (r % ((IN_PROJ + 31) / 32));
            if (n0_ >= F8_LO && n0_ < F8_HI) p0_transpose_item(w_in, DM, IN_PROJ, (bf16*)WinT8, nullptr, scr, r, lane, SW8, F8_LO);
            else p0_transpose_item(w_in, DM, IN_PROJ, WinT, nullptr, scr, r, lane, 0.f, (n0_ >= F8_HI) ? (F8_HI - F8_LO) : 0);
            continue; } r -= I_IN;
      } }
    const size_t gt = (size_t)blockIdx.x * (NWAVES * 64) + tid, GT = (size_t)F.G * NWAVES * 64;
    { const size_t z0 = (size_t)(5664 - (F8_HI - F8_LO)) * DM / 8, z1 = (size_t)NB16 * DM / 8; GAS v4u* p = (GAS v4u*)F.WinT(); for (size_t i = z0 + gt; i < z1; i += GT) p[i] = (v4u){0u, 0u, 0u, 0u}; }
    { const GAS f32x4* s = (const GAS f32x4*)F.peer_sk(); GAS v2u* d = (GAS v2u*)F.SK(); for (size_t i = gt; i < (size_t)16 * 128 * 128 / 4; i += GT) { const f32x4 v = s[i]; v2u o; o.x = pk2(v.x, v.y); o.y = pk2(v.z, v.w); d[i] = o; } }
    { const float* const xg = F.x(); const float* const gn = F.attn_norm(); bf16* const hn = F.HN(); unsigned char* const hn8 = F.HN8();
      for (int m = gw; m < MTOK / 2; m += NGW) rms_2rows_to_bf16(xg + (size_t)(2 * m) * DM, xg + (size_t)(2 * m + 1) * DM, gn, hn + (size_t)(2 * m) * DM, hn + (size_t)(2 * m + 1) * DM, hn8 + (size_t)(2 * m) * DM, hn8 + (size_t)(2 * m + 1) * DM, lane); }
}

struct EpiProj {
    static constexpr bool PERM = true, AFTER_DRAIN = false, SEG = false;
    bf16* O; float* dtraw; float* kmean;
    __device__ __forceinline__ void operator()(const pg8::f32x4 (&acc)[2][2][4][2], const pg8::Unit& u, int wr, int wc, int fr, int fq) const {
        const int rpn = (u.pn < F8_LO / 256) ? u.pn : u.pn + (F8_HI - F8_LO) / 256;
        const int row0 = u.pm * 256 + wr * 64 + fr, col0 = rpn * 256 + wc * 32 + 8 * fq;
        if (rpn < 22) {
#pragma unroll
            for (int ai = 0; ai < 2; ++ai)
#pragma unroll
                for (int m = 0; m < 4; ++m) { bf16* rowp = O + (size_t)(row0 + ai * 128 + m * 16) * NPROJ + col0;
#pragma unroll
                    for (int bj = 0; bj < 2; ++bj) { const pg8::f32x4 v0 = acc[ai][bj][m][0], v1 = acc[ai][bj][m][1];
                        pg8::u32x4 w; w.x = pg8::cvt_pk_bf16(v0[0], v0[1]); w.y = pg8::cvt_pk_bf16(v0[2], v0[3]); w.z = pg8::cvt_pk_bf16(v1[0], v1[1]); w.w = pg8::cvt_pk_bf16(v1[2], v1[3]);
                        *(pg8::u32x4*)(rowp + bj * 128) = w; } }
        } else if (wc == 0 && fq < 2) {
#pragma unroll
            for (int ai = 0; ai < 2; ++ai)
#pragma unroll
                for (int m = 0; m < 4; ++m) { float* rp = dtraw + (size_t)(row0 + ai * 128 + m * 16) * 16 + 8 * fq;
                    *(pg8::f32x4*)rp = acc[ai][0][m][0]; *(pg8::f32x4*)(rp + 4) = acc[ai][0][m][1]; }
        }
        if (kmean && u.pn >= 4 && u.pn < 8) {
#pragma unroll
            for (int bj = 0; bj < 2; ++bj)
#pragma unroll
                for (int n = 0; n < 2; ++n)
#pragma unroll
                    for (int i = 0; i < 4; ++i) { float s = 0.f;
#pragma unroll
                        for (int ai = 0; ai < 2; ++ai)
#pragma unroll
                            for (int m = 0; m < 4; ++m) s += acc[ai][bj][m][n][i];
                        s += __shfl_xor(s, 1); s += __shfl_xor(s, 2); s += __shfl_xor(s, 4); s += __shfl_xor(s, 8);
                        if (fr == 0) unsafeAtomicAdd(kmean + (size_t)u.pm * 1024 + (col0 - 1024) + bj * 128 + 4 * n + i, s); }
        }
    }
};
struct EpiProj8 {
    static constexpr bool PERM = true, AFTER_DRAIN = false, SEG = false;
    bf16* O;
    __device__ __forceinline__ void operator()(const pg8::f32x4 (&acc)[2][2][4][2], const pg8::Unit& u, int wr, int wc, int fr, int fq) const {
        const int row0 = u.pm * 256 + wr * 64 + fr, col0 = F8_LO + u.pn * 256 + wc * 32 + 8 * fq; constexpr float sc = 1.f / (SH8 * SW8);
#pragma unroll
        for (int ai = 0; ai < 2; ++ai)
#pragma unroll
            for (int m = 0; m < 4; ++m) { bf16* rowp = O + (size_t)(row0 + ai * 128 + m * 16) * NPROJ + col0;
#pragma unroll
                for (int bj = 0; bj < 2; ++bj) { const pg8::f32x4 v0 = acc[ai][bj][m][0] * sc, v1 = acc[ai][bj][m][1] * sc;
                    pg8::u32x4 w; w.x = pg8::cvt_pk_bf16(v0[0], v0[1]); w.y = pg8::cvt_pk_bf16(v0[2], v0[3]); w.z = pg8::cvt_pk_bf16(v1[0], v1[1]); w.w = pg8::cvt_pk_bf16(v1[2], v1[3]);
                    *(pg8::u32x4*)(rowp + bj * 128) = w; } }
    }
};
struct EpiOut {
    static constexpr bool PERM = true, AFTER_DRAIN = false, SEG = true; static constexpr int SEG_T1 = 8, SEG_T2 = 12;
    const float* x; bf16* x1b; unsigned char* x18; float* ssq; bool doatom; const LAS f32x4* tab;
    __device__ __forceinline__ void seg_load(int ui, int wr, int fr, float (&sr)[16]) const {
#pragma unroll
        for (int i = 0; i < 8; ++i) { const int r = (i >> 2) * 128 + wr * 64 + (i & 3) * 16 + fr; const f32x2 q = *(const LAS f32x2*)(tab + ui * 256 + r); sr[2 * i] = q.x; sr[2 * i + 1] = q.y; }
        asm volatile("s_waitcnt lgkmcnt(0)" ::: "memory");
    }
    __device__ __forceinline__ void seg_apply(pg8::f32x4 (&acc)[2][2][4][2], const float (&sr)[16], int which) const {
#pragma unroll
        for (int ai = 0; ai < 2; ++ai)
#pragma unroll
            for (int m = 0; m < 4; ++m) { const float f = (which == 0) ? sr[2 * (ai * 4 + m)] : ((which == 1) ? sr[2 * (ai * 4 + m) + 1] : 1.0f);
#pragma unroll
                for (int bj = 0; bj < 2; ++bj)
#pragma unroll
                    for (int n = 0; n < 2; ++n) acc[ai][bj][m][n] = acc[ai][bj][m][n] * f; }
    }
    __device__ __forceinline__ void operator()(const pg8::f32x4 (&acc)[2][2][4][2], const pg8::Unit& u, int wr, int wc, int fr, int fq, int ui) const {
        const int row0 = u.pm * 256 + wr * 64 + fr, col0 = u.pn * 256 + wc * 32 + 8 * fq;
#pragma unroll
        for (int ai = 0; ai < 2; ++ai)
#pragma unroll
            for (int m = 0; m < 4; ++m) { const int row = row0 + ai * 128 + m * 16; const size_t off = (size_t)row * DM + col0; float s = 0.f;
                const float s1 = (*(const LAS f32x4*)(tab + ui * 256 + ai * 128 + wr * 64 + m * 16 + fr)).z;
#pragma unroll
                for (int bj = 0; bj < 2; ++bj) {
                    const pg8::f32x4 a0 = *(const pg8::f32x4*)(x + off + bj * 128), a1 = *(const pg8::f32x4*)(x + off + bj * 128 + 4);
                    const pg8::f32x4 v0 = acc[ai][bj][m][0] * s1 + a0, v1 = acc[ai][bj][m][1] * s1 + a1;
                    pg8::u32x4 w; w.x = pg8::cvt_pk_bf16(v0[0], v0[1]); w.y = pg8::cvt_pk_bf16(v0[2], v0[3]); w.z = pg8::cvt_pk_bf16(v1[0], v1[1]); w.w = pg8::cvt_pk_bf16(v1[2], v1[3]);
                    *(pg8::u32x4*)(x1b + off + bj * 128) = w;
                    { v2u o8; int w_; w_ = __builtin_amdgcn_cvt_pk_fp8_f32(clampf(v0[0] * SX8, 448.f), clampf(v0[1] * SX8, 448.f), 0, false); w_ = __builtin_amdgcn_cvt_pk_fp8_f32(clampf(v0[2] * SX8, 448.f), clampf(v0[3] * SX8, 448.f), w_, true); o8.x = (unsigned)w_;
                      w_ = __builtin_amdgcn_cvt_pk_fp8_f32(clampf(v1[0] * SX8, 448.f), clampf(v1[1] * SX8, 448.f), 0, false); w_ = __builtin_amdgcn_cvt_pk_fp8_f32(clampf(v1[2] * SX8, 448.f), clampf(v1[3] * SX8, 448.f), w_, true); o8.y = (unsigned)w_;
                      *(v2u*)(x18 + off + bj * 128) = o8; }
                    s += (v0[0] * v0[0] + v0[1] * v0[1]) + (v0[2] * v0[2] + v0[3] * v0[3]) + (v1[0] * v1[0] + v1[1] * v1[1]) + (v1[2] * v1[2] + v1[3] * v1[3]); }
                s += __shfl_xor(s, 16); s += __shfl_xor(s, 32);
                if (fq == 0 && doatom) unsafeAtomicAdd(ssq + (size_t)row * 4, s);
                asm volatile("" ::: "memory"); }
    }
};
struct EpiQ {
    static constexpr bool PERM = true, AFTER_DRAIN = false, SEG = false;
    bf16* O; const float* ssq;
    __device__ __forceinline__ void operator()(const pg8::f32x4 (&acc)[2][2][4][2], const pg8::Unit& u, int wr, int wc, int fr, int fq) const {
        const int row0 = u.pm * 256 + wr * 64 + fr, col0 = u.pn * 256 + wc * 32 + 8 * fq;
#pragma unroll
        for (int ai = 0; ai < 2; ++ai)
#pragma unroll
            for (int m = 0; m < 4; ++m) { const int row = row0 + ai * 128 + m * 16; bf16* rowp = O + (size_t)row * DM + col0;
                const float rs = (1.f / (SX8 * SW8)) / sqrtf(__hip_atomic_load(ssq + (size_t)row * 4, RLX_AGENT) * (1.f / DM) + EPS);
#pragma unroll
                for (int bj = 0; bj < 2; ++bj) { const pg8::f32x4 v0 = acc[ai][bj][m][0] * rs, v1 = acc[ai][bj][m][1] * rs;
                    pg8::u32x4 w; w.x = pg8::cvt_pk_bf16(v0[0], v0[1]); w.y = pg8::cvt_pk_bf16(v0[2], v0[3]); w.z = pg8::cvt_pk_bf16(v1[0], v1[1]); w.w = pg8::cvt_pk_bf16(v1[2], v1[3]);
                    *(pg8::u32x4*)(rowp + bj * 128) = w; } }
    }
};

constexpr int A_KSTR = 272, A_VSTR = 288;
constexpr int A_KB0 = 0, A_KB1 = 64 * A_KSTR, A_VB0 = 2 * 64 * A_KSTR, A_VBS = 64 * A_VSTR  , A_KM = A_VB0 + 3 * A_VBS, A_TAB = A_KM + 8 * 128 * 4, A_END = A_TAB + 128 * 4;
static_assert(A_END <= RING_BYTES && (A_KM % 16) == 0, "attention LDS map");
#define PIN16(a, i) asm volatile("" : "+v"(a[i]), "+v"(a[i + 1]), "+v"(a[i + 2]), "+v"(a[i + 3]), "+v"(a[i + 4]), "+v"(a[i + 5]), "+v"(a[i + 6]), "+v"(a[i + 7]), "+v"(a[i + 8]), "+v"(a[i + 9]), "+v"(a[i + 10]), "+v"(a[i + 11]), "+v"(a[i + 12]), "+v"(a[i + 13]), "+v"(a[i + 14]), "+v"(a[i + 15]))
#define TR16(p) __builtin_amdgcn_ds_read_tr16_b64_v4i16((LAS s16x4*)(p))
#define MFMA16(a, b, c) __builtin_amdgcn_mfma_f32_16x16x32_bf16((a), (b), (c), 0, 0, 0)
__device__ __forceinline__ bf16x8 pack8(const float* v) {
    const unsigned a = pk2(v[0], v[1]), b = pk2(v[2], v[3]), c = pk2(v[4], v[5]), d = pk2(v[6], v[7]);
    const v4u u = {a, b, c, d}; return __builtin_bit_cast(bf16x8, u);
}
__device__ __forceinline__ void attn_unit(Frame& F, int b, int h, int blk, const bool doatom = true) {
    LAS unsigned char* lds = F.lds + RING_OFF;
    const int tid = fresh_tid(), lane = tid & 63, w = __builtin_amdgcn_readfirstlane(tid >> 6), g = lane >> 4, c16 = lane & 15, q4 = c16 >> 2, p4 = lane & 3;
    const int own = blk, t0 = blk * 256, tq0 = t0 + 32 * w + c16;
    const size_t rowbase = (size_t)b * SEQ;
    const float NEG_INF = -__builtin_inff();
    constexpr float LOG2E = 1.4426950408889634f, SCL2 = 0.08838834764831845f * 1.4426950408889634f;
    LAS float* km = (LAS float*)(lds + A_KM); LAS float* tab = (LAS float*)(lds + A_TAB);
    const bf16* const PROJ = F.PROJ(); const float* const kmg = F.kmean(); const float* const relb = F.rel_bias();
    for (int i = tid; i < own * 128; i += NWAVES * 64) { const int n = i >> 7, d = i & 127; km[i] = kmg[(size_t)(b * 8 + n) * 1024 + h * 128 + d] * (1.f / 256.f); }
    if (tid < 128) { const int rel = tid; int bucket = rel; if (rel >= 16) { bucket = 16 + (int)(log2f((float)rel * (1.f / 16.f)) * (16.f / 3.f)); bucket = bucket > 31 ? 31 : bucket; }
        tab[tid] = relb[bucket * 8 + h] * LOG2E; }
    bf16x8 qf[2][4];
#pragma unroll
    for (int gi = 0; gi < 2; ++gi) { const bf16* qrow = PROJ + (rowbase + tq0 + 16 * gi) * NPROJ + COL_Q + h * 128 + 8 * g;
#pragma unroll
      for (int ks = 0; ks < 4; ++ks) qf[gi][ks] = *(const GAS bf16x8*)(qrow + 32 * ks); }
    __syncthreads();
    unsigned selmask[2];
    if (own <= 3) { selmask[0] = (1u << own) - 1u; selmask[1] = selmask[0]; }
    else {
#pragma unroll
      for (int gi = 0; gi < 2; ++gi) {
        float gate[7];
#pragma unroll
        for (int n = 0; n < 7; ++n) {
            float s = NEG_INF;
            if (n < own) { s = 0.f;
#pragma unroll
                for (int ks = 0; ks < 4; ++ks) { const LAS f32x4* kp = (const LAS f32x4*)(km + n * 128 + 32 * ks + 8 * g); const f32x4 k0 = kp[0], k1 = kp[1]; const v4u qu = __builtin_bit_cast(v4u, qf[gi][ks]);
                    s += bflo(qu.x) * k0.x + bfhi(qu.x) * k0.y + bflo(qu.y) * k0.z + bfhi(qu.y) * k0.w + bflo(qu.z) * k1.x + bfhi(qu.z) * k1.y + bflo(qu.w) * k1.z + bfhi(qu.w) * k1.w; }
                s += __shfl_xor(s, 16); s += __shfl_xor(s, 32); }
            gate[n] = s;
        }
        unsigned sm = 0u;
#pragma unroll
        for (int r = 0; r < 3; ++r) { float best = NEG_INF; int bi = 0;
#pragma unroll
            for (int n = 0; n < 7; ++n) { const bool cand = (n < own) && !((sm >> n) & 1u) && (gate[n] > best); best = cand ? gate[n] : best; bi = cand ? n : bi; }
            sm |= 1u << bi; }
        selmask[gi] = sm; }
    }
    const int nT = 4 + 4 * own;
    const int sr = tid >> 3, sc = (tid & 7) * 16;
#define A_KEY0(i) ((i) < 4 ? own * 256 + 64 * (i) : (((i) - 4) >> 2) * 256 + (((i) - 4) & 3) * 64)
    v4u kr0, kr1, vr0, vr1;
#define A_LOAD(i) do { const bf16* kp_ = PROJ + (rowbase + A_KEY0(i) + sr) * NPROJ + COL_K + h * 128 + sc; \
        kr0 = *(const GAS v4u*)kp_; kr1 = *(const GAS v4u*)(kp_ + 8); vr0 = *(const GAS v4u*)(kp_ + (COL_V - COL_K)); vr1 = *(const GAS v4u*)(kp_ + (COL_V - COL_K) + 8); } while (0)
#define A_STORE(bufi) do { LAS unsigned char* kd_ = lds + ((bufi) ? A_KB1 : A_KB0) + sr * A_KSTR + sc * 2; LAS unsigned char* vd_ = lds + A_VB0 + vnx * A_VBS + sr * A_VSTR + sc * 2; \
        *(LAS v4u*)kd_ = kr0; *(LAS v4u*)(kd_ + 16) = kr1; *(LAS v4u*)vd_ = vr0; *(LAS v4u*)(vd_ + 16) = vr1; } while (0)
    int vcur = 0, vnx = 0, vprev = 0;
#define A_PV(PF, Vb_) do { _Pragma("unroll") for (int s = 0; s < 2; ++s) { s16x4 vlo[8], vhi[8]; \
            _Pragma("unroll") for (int db = 0; db < 8; ++db) { LAS unsigned char* va = (Vb_) + (32 * s + 4 * g + q4) * A_VSTR + (16 * db + 4 * p4) * 2; vlo[db] = TR16(va); vhi[db] = TR16(va + 16 * A_VSTR); } \
            __builtin_amdgcn_sched_barrier(0); \
            _Pragma("unroll") for (int db = 0; db < 8; ++db) { const bf16x8 vf = __builtin_shufflevector(vlo[db], vhi[db], 0, 1, 2, 3, 4, 5, 6, 7); \
                oacc[0][db] = MFMA16(vf, PF[0][s], oacc[0][db]); oacc[1][db] = MFMA16(vf, PF[1][s], oacc[1][db]); } \
            __builtin_amdgcn_sched_barrier(0); } } while (0)
    A_LOAD(0); A_STORE(0);
    __syncthreads();
    const bool late = w >= 4;
    bf16x8 pfp[2][2]; bool skipp = true;
#pragma unroll
    for (int gi = 0; gi < 2; ++gi) { pfp[gi][0] = (bf16x8){0, 0, 0, 0, 0, 0, 0, 0}; pfp[gi][1] = pfp[gi][0]; }
    float m_run[2] = {NEG_INF, NEG_INF}, l_run[2] = {0.f, 0.f};
    f32x4 oacc[2][8];
#pragma unroll
    for (int gi = 0; gi < 2; ++gi)
#pragma unroll
        for (int db = 0; db < 8; ++db) oacc[gi][db] = (f32x4){0.f, 0.f, 0.f, 0.f};
    for (int i = 0; i < nT; ++i) {
        if (i + 1 < nT) A_LOAD(i + 1);
        vnx = (vcur == 2) ? 0 : vcur + 1;
        const int buf = i & 1, key0 = A_KEY0(i); const bool isown = i < 4; const int pblk = isown ? own : ((i - 4) >> 2);
        const bool skipw = isown && (64 * i > 32 * w + 31);
        if (late && !skipp) A_PV(pfp, lds + A_VB0 + vprev * A_VBS);
        bf16x8 pf[2][2];
        if (!skipw) {
        LAS unsigned char* Kb = lds + (buf ? A_KB1 : A_KB0);
        f32x4 sacc[2][4];
#pragma unroll
        for (int hf = 0; hf < 2; ++hf) { bf16x8 kf[8];
#pragma unroll
            for (int n2 = 0; n2 < 2; ++n2)
#pragma unroll
                for (int ks = 0; ks < 4; ++ks) kf[n2 * 4 + ks] = *(const LAS bf16x8*)(Kb + (16 * (2 * hf + n2) + c16) * A_KSTR + (32 * ks + 8 * g) * 2);
            __builtin_amdgcn_sched_barrier(0);
#pragma unroll
            for (int gi = 0; gi < 2; ++gi)
#pragma unroll
                for (int n2 = 0; n2 < 2; ++n2) { f32x4 a = (f32x4){0.f, 0.f, 0.f, 0.f};
#pragma unroll
                    for (int ks = 0; ks < 4; ++ks) a = MFMA16(kf[n2 * 4 + ks], qf[gi][ks], a);
                    sacc[gi][2 * hf + n2] = a; }
            __builtin_amdgcn_sched_barrier(0); }
        const bool far = (key0 + 63 + 128 <= t0 + 32 * w);
        const bool diag = isown && (64 * i + 63 > 32 * w);
#pragma unroll
        for (int gi = 0; gi < 2; ++gi) {
            const int tq = tq0 + 16 * gi; const bool sel = isown || ((selmask[gi] >> pblk) & 1u);
            float sv[16]; float mloc, m_new, alpha;
            if (far) {
                const float bfar = tab[127];
                float mx = fmaxf(fmaxf(sacc[gi][0][0], sacc[gi][0][1]), fmaxf(sacc[gi][0][2], sacc[gi][0][3]));
#pragma unroll
                for (int nb = 1; nb < 4; ++nb) mx = fmaxf(mx, fmaxf(fmaxf(sacc[gi][nb][0], sacc[gi][nb][1]), fmaxf(sacc[gi][nb][2], sacc[gi][nb][3])));
                mloc = sel ? (mx * SCL2 + bfar) : NEG_INF;
                mloc = fmaxf(mloc, __shfl_xor(mloc, 16)); mloc = fmaxf(mloc, __shfl_xor(mloc, 32));
                m_new = fmaxf(m_run[gi], mloc); alpha = __builtin_amdgcn_exp2f(m_run[gi] - m_new);
                const float cadd = sel ? (bfar - m_new) : NEG_INF;
#pragma unroll
                for (int nb = 0; nb < 4; ++nb)
#pragma unroll
                    for (int r = 0; r < 4; ++r) sv[nb * 4 + r] = __builtin_amdgcn_exp2f(sacc[gi][nb][r] * SCL2 + cadd);
            } else {
                const int relb = tq - key0 - 4 * g; float bias[16];
#pragma unroll
                for (int nb = 0; nb < 4; ++nb)
#pragma unroll
                    for (int r = 0; r < 4; ++r) { const int rel = relb - 16 * nb - r; int ri = rel < 0 ? 0 : rel; ri = ri > 127 ? 127 : ri; bias[nb * 4 + r] = tab[ri]; }
                PIN16(bias, 0);
                mloc = NEG_INF;
#pragma unroll
                for (int nb = 0; nb < 4; ++nb)
#pragma unroll
                    for (int r = 0; r < 4; ++r) { const int rel = relb - 16 * nb - r;
                        float s = sacc[gi][nb][r] * SCL2 + bias[nb * 4 + r]; s = (!sel || (diag && rel < 0)) ? NEG_INF : s; sv[nb * 4 + r] = s; mloc = fmaxf(mloc, s); }
                mloc = fmaxf(mloc, __shfl_xor(mloc, 16)); mloc = fmaxf(mloc, __shfl_xor(mloc, 32));
                m_new = fmaxf(m_run[gi], mloc); alpha = __builtin_amdgcn_exp2f(m_run[gi] - m_new);
#pragma unroll
                for (int e = 0; e < 16; ++e) sv[e] = __builtin_amdgcn_exp2f(sv[e] - m_new);
            }
            float psum = 0.f;
#pragma unroll
            for (int e = 0; e < 16; ++e) psum += sv[e];
            l_run[gi] = l_run[gi] * alpha + psum; m_run[gi] = m_new;
#pragma unroll
            for (int db = 0; db < 8; ++db) oacc[gi][db] = oacc[gi][db] * alpha;
            pf[gi][0] = pack8(sv); pf[gi][1] = pack8(sv + 8);
        }
        __builtin_amdgcn_sched_barrier(0);
        if (!late) A_PV(pf, lds + A_VB0 + vcur * A_VBS);
        }
        if (late) { skipp = skipw;
#pragma unroll
            for (int gi = 0; gi < 2; ++gi) { pfp[gi][0] = pf[gi][0]; pfp[gi][1] = pf[gi][1]; } }
        if (i + 1 < nT) A_STORE((i + 1) & 1);
        vprev = vcur; vcur = vnx;
        __syncthreads();
    }
    if (late && !skipp) A_PV(pfp, lds + A_VB0 + vprev * A_VBS);
#undef A_PV
    bf16* const MIXp = F.HN(); float* const ssqp = F.ssq();
#pragma unroll
    for (int gi = 0; gi < 2; ++gi) {
        const int tq = tq0 + 16 * gi;
        float l_tot = l_run[gi]; l_tot += __shfl_xor(l_tot, 16); l_tot += __shfl_xor(l_tot, 32);
        const float inv = 1.f / l_tot; float ssq = 0.f;
        unsigned char* orow = (unsigned char*)MIXp + (rowbase + tq) * DM + h * 128 + 4 * g;
#pragma unroll
        for (int db = 0; db < 8; ++db) { const f32x4 o = oacc[gi][db] * inv; ssq += (o.x * o.x + o.y * o.y) + (o.z * o.z + o.w * o.w); *(GAS unsigned*)(orow + 16 * db) = pk4_fp8(o.x * SA8, o.y * SA8, o.z * SA8, o.w * SA8); }
        ssq += __shfl_xor(ssq, 16); ssq += __shfl_xor(ssq, 32);
        if (g == 0 && doatom) unsafeAtomicAdd(ssqp + (rowbase + tq) * 4 + 1, ssq);
    }
#undef A_KEY0
#undef A_LOAD
#undef A_STORE
}

constexpr int XBC_W = CONV_CH;
__device__ __forceinline__ void conv_phase(Frame& F) {
    const bf16* const PROJ = F.PROJ(); bf16* const XBC = F.XBC(); const float* const cw = F.conv_w(); const float* const cb = F.conv_b();
    const int gt = blockIdx.x * (NWAVES * 64) + fresh_tid(), GT = F.G * NWAVES * 64;
    for (int task = gt; task < (MTOK / 32) * (CONV_CH / 8); task += GT) {
        const int r = task / (CONV_CH / 8), k = task % (CONV_CH / 8), ch = 8 * k, tok0 = 32 * r;
        float wv[4][8], bias[8];
#pragma unroll
        for (int t = 0; t < 4; ++t) { const f32x4 w0 = *(const GAS f32x4*)(cw + t * CONV_CH + ch), w1 = *(const GAS f32x4*)(cw + t * CONV_CH + ch + 4);
            wv[t][0] = w0.x; wv[t][1] = w0.y; wv[t][2] = w0.z; wv[t][3] = w0.w; wv[t][4] = w1.x; wv[t][5] = w1.y; wv[t][6] = w1.z; wv[t][7] = w1.w; }
        { const f32x4 b0 = *(const GAS f32x4*)(cb + ch), b1 = *(const GAS f32x4*)(cb + ch + 4); bias[0] = b0.x; bias[1] = b0.y; bias[2] = b0.z; bias[3] = b0.w; bias[4] = b1.x; bias[5] = b1.y; bias[6] = b1.z; bias[7] = b1.w; }
        const bf16* src = PROJ + (size_t)tok0 * NPROJ + COL_XBC + ch; bf16* dst = XBC + (size_t)tok0 * XBC_W + ch;
        v4u p0 = (v4u){0u, 0u, 0u, 0u}, p1 = p0, p2 = p0;
        if ((tok0 & (SEQ - 1)) != 0) { p0 = *(const GAS v4u*)(src - 3 * (ptrdiff_t)NPROJ); p1 = *(const GAS v4u*)(src - 2 * (ptrdiff_t)NPROJ); p2 = *(const GAS v4u*)(src - (ptrdiff_t)NPROJ); }
#pragma unroll 1
        for (int i0 = 0; i0 < 32; i0 += 8) {
            v4u cur[8];
#pragma unroll
            for (int i = 0; i < 8; ++i) cur[i] = *(const GAS v4u*)(src + (size_t)(i0 + i) * NPROJ);
#pragma unroll
            for (int i = 0; i < 8; ++i) {
                const v4u c = cur[i]; float acc[8];
                const unsigned a0[4] = {p0.x, p0.y, p0.z, p0.w}, a1[4] = {p1.x, p1.y, p1.z, p1.w}, a2[4] = {p2.x, p2.y, p2.z, p2.w}, a3[4] = {c.x, c.y, c.z, c.w};
#pragma unroll
                for (int j = 0; j < 4; ++j) {
                    acc[2 * j] = bias[2 * j] + wv[0][2 * j] * bflo(a0[j]) + wv[1][2 * j] * bflo(a1[j]) + wv[2][2 * j] * bflo(a2[j]) + wv[3][2 * j] * bflo(a3[j]);
                    acc[2 * j + 1] = bias[2 * j + 1] + wv[0][2 * j + 1] * bfhi(a0[j]) + wv[1][2 * j + 1] * bfhi(a1[j]) + wv[2][2 * j + 1] * bfhi(a2[j]) + wv[3][2 * j + 1] * bfhi(a3[j]); }
#pragma unroll
                for (int j = 0; j < 8; ++j) acc[j] = silu_f(acc[j]);
                v4u o; o.x = pk2(acc[0], acc[1]); o.y = pk2(acc[2], acc[3]); o.z = pk2(acc[4], acc[5]); o.w = pk2(acc[6], acc[7]);
                *(GAS v4u*)(dst + (size_t)(i0 + i) * XBC_W) = o;
                p0 = p1; p1 = p2; p2 = c; }
        }
    }
    { const float* const dtraw = F.dtraw(); float* const dt2 = F.DT2(); const float* const dtb = F.dt_bias();
      for (int i = gt; i < MTOK * 16; i += GT) { const float xr = dtraw[i] + dtb[i & 15]; dt2[i] = xr > 20.f ? xr : log1pf(__expf(xr)); } }
}

constexpr int S_BSTR = 272, S_XSTR = 144;
constexpr int S_BM = 0, S_CM = 128 * S_BSTR, S_X = 2 * 128 * S_BSTR, S_XW = S_X + 128 * S_XSTR, S_HB = S_XW + 128 * S_XSTR, S_DT = S_HB + 64 * S_BSTR, S_CS = S_DT + 512, S_DA = S_CS + 512, S_END = S_DA + 512;
static_assert(S_END <= RING_BYTES, "ssd LDS map");
__device__ __forceinline__ void ssd_unit(Frame& F, int b, int h, const bool doatom = true) {
    LAS unsigned char* lds = F.lds + RING_OFF;
    const int tid = fresh_tid(), lane = tid & 63, w = __builtin_amdgcn_readfirstlane(tid >> 6), g = lane >> 4, c16 = lane & 15, q4 = c16 >> 2, p4 = lane & 3;
    const int g8 = h >> 3, pbw = w & 3, nhw = w >> 2;
    const float a_h = -__expf(F.a_log()[h]), dsk = F.d_skip()[h];
    const bf16* const PROJ = F.PROJ(); bf16* const MIX = F.HN(); const float* const dt2 = F.DT2(); const bf16* const XBC = F.XBC(); float* const ssqp = F.ssq();
    LAS float* dtl = (LAS float*)(lds + S_DT); LAS float* csl = (LAS float*)(lds + S_CS); LAS float* dal = (LAS float*)(lds + S_DA);
    for (int i = tid; i < 64 * S_BSTR / 16; i += NWAVES * 64) ((LAS v4u*)(lds + S_HB))[i] = (v4u){0u, 0u, 0u, 0u};
    f32x4 hacc[4];
#pragma unroll
    for (int i = 0; i < 4; ++i) hacc[i] = (f32x4){0.f, 0.f, 0.f, 0.f};
    const int xl = tid >> 3, xc = tid & 7, bl = tid >> 4, bc = tid & 15;
    v4u xr[2], br[4], cr[4]; float dtv = 0.f;
#define S_PREFETCH(cc) do { const size_t t0_ = (size_t)b * SEQ + (size_t)(cc) * SSM_L; \
        _Pragma("unroll") for (int i_ = 0; i_ < 2; ++i_) xr[i_] = *(const GAS v4u*)(XBC + (t0_ + xl + 64 * i_) * XBC_W + h * 64 + 8 * xc); \
        _Pragma("unroll") for (int i_ = 0; i_ < 4; ++i_) { const bf16* p_ = XBC + (t0_ + bl + 32 * i_) * XBC_W + 1024 + g8 * 128 + 8 * bc; br[i_] = *(const GAS v4u*)p_; cr[i_] = *(const GAS v4u*)(p_ + 256); } \
        if (tid < 128) dtv = dt2[(t0_ + tid) * 16 + h]; } while (0)
    S_PREFETCH(0);
    for (int c = 0; c < SSM_NC; ++c) {
        const size_t tok0 = (size_t)b * SEQ + (size_t)c * SSM_L;
        if (tid < 128) { dtl[tid] = dtv; dal[tid] = dtv * a_h; }
        __syncthreads();
        { const float v0 = dal[2 * lane], v1 = dal[2 * lane + 1]; float s = v0 + v1;
#pragma unroll
            for (int o = 1; o < 64; o <<= 1) { const float t = __shfl_up(s, o); s += (lane >= o) ? t : 0.f; }
            csl[2 * lane] = s - v1; csl[2 * lane + 1] = s; }
        LDS_WAIT(); asm volatile("" ::: "memory");
        const float cs_last = csl[127];
#pragma unroll
        for (int i = 0; i < 2; ++i) { const int l = xl + 64 * i; const v4u v = xr[i]; *(LAS v4u*)(lds + S_X + l * S_XSTR + xc * 16) = v; const float wl = dtl[l] * __expf(cs_last - csl[l]);
            v4u o2; o2.x = pk2(bflo(v.x) * wl, bfhi(v.x) * wl); o2.y = pk2(bflo(v.y) * wl, bfhi(v.y) * wl); o2.z = pk2(bflo(v.z) * wl, bfhi(v.z) * wl); o2.w = pk2(bflo(v.w) * wl, bfhi(v.w) * wl);
            *(LAS v4u*)(lds + S_XW + l * S_XSTR + xc * 16) = o2; }
#pragma unroll
        for (int i = 0; i < 4; ++i) { const int l = bl + 32 * i; *(LAS v4u*)(lds + S_BM + l * S_BSTR + bc * 16) = br[i]; *(LAS v4u*)(lds + S_CM + l * S_BSTR + bc * 16) = cr[i]; }
        const int lrow = 16 * w + c16;
        v2u zr[4];
#pragma unroll
        for (int pb = 0; pb < 4; ++pb) zr[pb] = *(const GAS v2u*)(PROJ + (tok0 + lrow) * NPROJ + COL_Z + h * 64 + 16 * pb + 4 * g);
        if (c + 1 < SSM_NC) S_PREFETCH(c + 1);
        __syncthreads();
        bf16x8 cf[4];
#pragma unroll
        for (int ks = 0; ks < 4; ++ks) cf[ks] = *(const LAS bf16x8*)(lds + S_CM + lrow * S_BSTR + (32 * ks + 8 * g) * 2);
        f32x4 yacc[4];
        const float cs_l = csl[lrow]; const float el = __expf(cs_l);
#pragma unroll
        for (int pb = 0; pb < 4; ++pb) { yacc[pb] = (f32x4){0.f, 0.f, 0.f, 0.f};
#pragma unroll
            for (int ks = 0; ks < 4; ++ks) { const bf16x8 hf = *(const LAS bf16x8*)(lds + S_HB + (16 * pb + c16) * S_BSTR + (32 * ks + 8 * g) * 2); yacc[pb] = MFMA16(hf, cf[ks], yacc[pb]); }
            yacc[pb] = yacc[pb] * el; }
        for (int s2 = 0; s2 <= (w >> 1); ++s2) {
            const int sb0 = 2 * s2, sb1 = 2 * s2 + 1; const bool has1 = sb1 <= w;
            f32x4 cb0 = (f32x4){0.f, 0.f, 0.f, 0.f}, cb1 = (f32x4){0.f, 0.f, 0.f, 0.f};
#pragma unroll
            for (int ks = 0; ks < 4; ++ks) { const bf16x8 bf0 = *(const LAS bf16x8*)(lds + S_BM + (16 * sb0 + c16) * S_BSTR + (32 * ks + 8 * g) * 2); cb0 = MFMA16(bf0, cf[ks], cb0); }
            if (has1) {
#pragma unroll
                for (int ks = 0; ks < 4; ++ks) { const bf16x8 bf1 = *(const LAS bf16x8*)(lds + S_BM + (16 * sb1 + c16) * S_BSTR + (32 * ks + 8 * g) * 2); cb1 = MFMA16(bf1, cf[ks], cb1); } }
            float mv[8];
#pragma unroll
            for (int r = 0; r < 4; ++r) { const int s = 16 * sb0 + 4 * g + r; const float e = __expf(fminf(cs_l - csl[s], 0.f)) * dtl[s]; mv[r] = (s <= lrow) ? cb0[r] * e : 0.f; }
#pragma unroll
            for (int r = 0; r < 4; ++r) { const int s = 16 * sb1 + 4 * g + r; const int sc_ = s > 127 ? 127 : s; const float e = __expf(fminf(cs_l - csl[sc_], 0.f)) * dtl[sc_]; mv[4 + r] = (has1 && s <= lrow) ? cb1[r] * e : 0.f; }
            const bf16x8 pf = pack8(mv);
#pragma unroll
            for (int pb = 0; pb < 4; ++pb) { LAS unsigned char* xa = lds + S_X + (32 * s2 + 4 * g + q4) * S_XSTR + (16 * pb + 4 * p4) * 2;
                const s16x4 lo = TR16(xa), hi = TR16(xa + 16 * S_XSTR); const bf16x8 xf = __builtin_shufflevector(lo, hi, 0, 1, 2, 3, 4, 5, 6, 7);
                yacc[pb] = MFMA16(xf, pf, yacc[pb]); }
        }
        { const size_t tok = tok0 + lrow; float ssq = 0.f;
#pragma unroll
          for (int pb = 0; pb < 4; ++pb) { const int p0 = 16 * pb + 4 * g;
              const v2u xs_ = *(const LAS v2u*)(lds + S_X + lrow * S_XSTR + p0 * 2);
              const v2u zr_ = zr[pb];
              const float o0 = (yacc[pb].x + bflo(xs_.x) * dsk) * silu_f(bflo(zr_.x)), o1 = (yacc[pb].y + bfhi(xs_.x) * dsk) * silu_f(bfhi(zr_.x));
              const float o2 = (yacc[pb].z + bflo(xs_.y) * dsk) * silu_f(bflo(zr_.y)), o3 = (yacc[pb].w + bfhi(xs_.y) * dsk) * silu_f(bfhi(zr_.y));
              ssq += (o0 * o0 + o1 * o1) + (o2 * o2 + o3 * o3);
              *(GAS unsigned*)((unsigned char*)MIX + tok * DM + ATT_W + h * 64 + p0) = pk4_fp8(o0 * SS8, o1 * SS8, o2 * SS8, o3 * SS8); }
          ssq += __shfl_xor(ssq, 16); ssq += __shfl_xor(ssq, 32);
          if (g == 0 && doatom) unsafeAtomicAdd(ssqp + tok * 4 + 2 + g8, ssq); }
        { const float cdec = __expf(cs_last);
#pragma unroll
          for (int i = 0; i < 4; ++i) hacc[i] = hacc[i] * cdec;
#pragma unroll
          for (int ks = 0; ks < 4; ++ks) {
              LAS unsigned char* xa = lds + S_XW + (32 * ks + 8 * g + q4) * S_XSTR + (16 * pbw + 4 * p4) * 2;
              const s16x4 xlo = TR16(xa), xhi = TR16(xa + 4 * S_XSTR); const bf16x8 xf = __builtin_shufflevector(xlo, xhi, 0, 1, 2, 3, 4, 5, 6, 7);
#pragma unroll
              for (int i = 0; i < 4; ++i) { const int nb = 4 * nhw + i; LAS unsigned char* ba = lds + S_BM + (32 * ks + 8 * g + q4) * S_BSTR + (16 * nb + 4 * p4) * 2;
                  const s16x4 blo = TR16(ba), bhi = TR16(ba + 4 * S_BSTR); const bf16x8 bfr = __builtin_shufflevector(blo, bhi, 0, 1, 2, 3, 4, 5, 6, 7);
                  hacc[i] = MFMA16(bfr, xf, hacc[i]); } } }
        __syncthreads();
#pragma unroll
        for (int i = 0; i < 4; ++i) { const int nb = 4 * nhw + i; v2u o; o.x = pk2(hacc[i].x, hacc[i].y); o.y = pk2(hacc[i].z, hacc[i].w);
            *(LAS v2u*)(lds + S_HB + (16 * pbw + c16) * S_BSTR + (16 * nb + 4 * g) * 2) = o; }
    }
#undef S_PREFETCH
    __syncthreads();
}

__device__ __forceinline__ void mix_normalize(Frame& F) {
    const int tid_ = fresh_tid(), lane = tid_ & 63; const int gw = blockIdx.x * NWAVES + __builtin_amdgcn_readfirstlane(tid_ >> 6), NGW = F.G * NWAVES;
    const float* const ssqp = F.ssq(); bf16* const MIX = F.HN(); const float* const gatt = F.attn_out_norm(); const float* const gssm = F.ssm_out_norm();
    for (int m = gw; m < MTOK; m += NGW) {
        const float* sq = ssqp + (size_t)m * 4;
        const float s1 = __hip_atomic_load(sq + 1, RLX_AGENT), s2 = __hip_atomic_load(sq + 2, RLX_AGENT), s3 = __hip_atomic_load(sq + 3, RLX_AGENT);
        const float ra = 1.f / sqrtf(s1 * (1.f / 1024.f) + EPS), r0 = 1.f / sqrtf(s2 * (1.f / 512.f) + EPS), r1 = 1.f / sqrtf(s3 * (1.f / 512.f) + EPS);
        GAS v4u* row = (GAS v4u*)(MIX + (size_t)m * DM);
#pragma unroll
        for (int j = 0; j < 4; ++j) { const int idx = lane + 64 * j, col = 8 * idx; const float rs = (j < 2) ? ra : ((j == 2) ? r0 : r1);
            const float* gp = (j < 2) ? (gatt + col) : (gssm + (col - ATT_W));
            const f32x4 g0 = *(const GAS f32x4*)gp, g1 = *(const GAS f32x4*)(gp + 4); const v4u v = row[idx]; v4u o;
            o.x = pk2(bflo(v.x) * rs * g0.x, bfhi(v.x) * rs * g0.y); o.y = pk2(bflo(v.y) * rs * g0.z, bfhi(v.y) * rs * g0.w);
            o.z = pk2(bflo(v.z) * rs * g1.x, bfhi(v.z) * rs * g1.y); o.w = pk2(bflo(v.w) * rs * g1.z, bfhi(v.w) * rs * g1.w); row[idx] = o; }
    }
}

constexpr size_t TAB_UNIT = 1024;
static_assert((TAB_ITEMS / 8) % TAB_UNIT == 0 && TAB_ITEMS % TAB_UNIT == 0, "table filler units");
constexpr int P_EIDX = 0, P_GATE = 16384, P_LST = 32768  , P_HN4 = 32768  , P_ACT = 98304  , P_END = 114688;
static_assert(P_END <= RING_BYTES, "peer LDS map");
__constant__ unsigned char PEER_CAND[52] = {0, 1, 2, 3, 4, 5, 6, 7, 8, 9, 10, 11, 12, 13, 14, 15, 16, 17, 18, 19, 20, 21, 22, 23, 32, 33, 34, 35, 36, 48, 49, 50, 51, 64, 65, 66, 80, 81, 96, 97, 112, 113, 128, 144, 160, 176, 192, 208, 224, 240, 255, 255};
__device__ __forceinline__ unsigned f2ord(float f) { const unsigned u = __builtin_bit_cast(unsigned, f); return u ^ ((u >> 31) ? 0xFFFFFFFFu : 0x80000000u); }
__device__ __forceinline__ float ord2f(unsigned u) { return __builtin_bit_cast(float, u ^ ((u >> 31) ? 0x80000000u : 0xFFFFFFFFu)); }
#define CSWAPD(a, b) do { const unsigned hi_ = (a) > (b) ? (a) : (b), lo_ = (a) > (b) ? (b) : (a); (a) = hi_; (b) = lo_; } while (0)
template <int N> __device__ __forceinline__ void bitonic_sort_desc(unsigned (&v)[N]) {
#pragma unroll
    for (int k = 2; k <= N; k <<= 1)
#pragma unroll
        for (int j = k >> 1; j > 0; j >>= 1)
#pragma unroll
            for (int i = 0; i < N; ++i) { const int l = i ^ j; if (l > i) { if ((i & k) == 0) CSWAPD(v[i], v[l]); else CSWAPD(v[l], v[i]); } }
}
__device__ __forceinline__ void merge16_xor(unsigned (&v)[16], int dist) {
    unsigned o[16];
#pragma unroll
    for (int i = 0; i < 16; ++i) o[i] = (unsigned)__shfl_xor((int)v[i], dist);
#pragma unroll
    for (int i = 0; i < 16; ++i) v[i] = v[i] > o[15 - i] ? v[i] : o[15 - i];
#pragma unroll
    for (int j = 8; j > 0; j >>= 1)
#pragma unroll
        for (int i = 0; i < 16; ++i) { const int l = i ^ j; if (l > i) CSWAPD(v[i], v[l]); }
}
__device__ __forceinline__ float gelu_erf(float x) { return 0.5f * x * (1.f + erff(x * 0.70710678118654752f)); }
__device__ __forceinline__ float fp4_dec1(unsigned n) { const unsigned m = n & 7u; unsigned bits = (m >= 2u) ? (((126u + (m >> 1)) << 23) | ((m & 1u) << 22)) : (m ? 0x3F000000u : 0u); bits |= (n & 8u) << 28; return __builtin_bit_cast(float, bits); }
__device__ __forceinline__ f32x2 fp4_dec2(unsigned x) { f32x2 r; r.x = fp4_dec1(x & 15u); r.y = fp4_dec1((x >> 4) & 15u); return r; }
typedef long i64;
typedef int v8i __attribute__((ext_vector_type(8)));
typedef int v4i __attribute__((ext_vector_type(4)));
template <bool dry = false> __device__ __forceinline__ void peer_unit(Frame& F, int u) {
    LAS unsigned char* lds = F.lds + RING_OFF;
    const int tid_ = fresh_tid(), lane = tid_ & 63, w = __builtin_amdgcn_readfirstlane(tid_ >> 6), g = lane >> 4, c16 = lane & 15;
    const int T0 = 32 * u;
    LAS int* eidx = (LAS int*)(lds + P_EIDX); LAS float* gate = (LAS float*)(lds + P_GATE);
    LAS unsigned* lst = (LAS unsigned*)(lds + P_LST) + w * 1024;
    const bf16* const QP = F.QP(); const bf16* const SK = F.SK(); float* const outp = F.out(); const bf16* const X1B = F.X1B(); const float* const fgain = F.ffn_norm(); const float* const fing = F.final_norm(); const unsigned char* const U8 = F.U8(); const unsigned char* const V8 = F.V8();
#ifndef NO_ROUTE
    unsigned cpk[4];
    { unsigned cb[16];
#pragma unroll
      for (int k = 0; k < 13; ++k) cb[k] = PEER_CAND[4 * k + g];
      cb[13] = 255u; cb[14] = 255u; cb[15] = 255u;
#pragma unroll
      for (int q = 0; q < 4; ++q) cpk[q] = cb[4 * q] | (cb[4 * q + 1] << 8) | (cb[4 * q + 2] << 16) | (cb[4 * q + 3] << 24); }
    {
    bf16x8 qf[2][4];
#define QP_LOAD(dst, c_) do { _Pragma("unroll") for (int tb = 0; tb < 2; ++tb) { const unsigned qo = ((unsigned)(T0 + 16 * tb + c16) * (unsigned)DM + (unsigned)((2 * w + (c_)) * 128 + 8 * g)) * 2u; \
        _Pragma("unroll") for (int ks = 0; ks < 4; ++ks) dst[tb][ks] = __builtin_nontemporal_load((const GAS bf16x8*)((const unsigned char*)QP + (qo + 64u * ks))); } } while (0)
    QP_LOAD(qf, 0);
#pragma unroll
    for (int c = 0; c < 2; ++c) {
        const int p = 2 * w + c;
        unsigned key[2][32];
        bf16x8 sf[3][8];
        const unsigned so0 = ((unsigned)(p * 128 + c16) * 128u + 8u * (unsigned)g) * 2u;
#define SK_LOAD(buf, j_) do { _Pragma("unroll") for (int q = 0; q < 8; ++q) sf[buf][q] = *(const GAS bf16x8*)((const unsigned char*)SK + (so0 + (unsigned)(2 * (j_) + (q >> 2)) * 4096u + 64u * (q & 3))); } while (0)
        SK_LOAD(0, 0); SK_LOAD(1, 1);
#pragma unroll
        for (int j = 0; j < 4; ++j) {
            if (j + 2 < 4) SK_LOAD((j + 2) % 3, j + 2);
            __builtin_amdgcn_sched_barrier(0);
#pragma unroll
            for (int h2 = 0; h2 < 2; ++h2)
#pragma unroll
            for (int tb = 0; tb < 2; ++tb) { const int kb = 2 * j + h2; f32x4 acc = (f32x4){0.f, 0.f, 0.f, 0.f};
#pragma unroll
                for (int ks = 0; ks < 4; ++ks) acc = MFMA16(sf[j % 3][4 * h2 + ks], qf[tb][ks], acc);
#pragma unroll
                for (int r = 0; r < 4; ++r) key[tb][kb * 4 + r] = (f2ord(acc[r]) & ~0x7Fu) | (unsigned)(16 * kb + 4 * g + r); }
            __builtin_amdgcn_sched_barrier(0); }
#undef SK_LOAD
        if (c == 0) { QP_LOAD(qf, 1); __builtin_amdgcn_sched_barrier(0); }
#pragma unroll
        for (int tb = 0; tb < 2; ++tb) {
            bitonic_sort_desc<32>(key[tb]);
            unsigned top[16];
#pragma unroll
            for (int i = 0; i < 16; ++i) top[i] = key[tb][i];
            merge16_xor(top, 16); merge16_xor(top, 32);
            if (g == 0) { LAS v4u* d = (LAS v4u*)(lst + (c * 32 + 16 * tb + c16) * 16);
                d[0] = (v4u){top[0], top[1], top[2], top[3]}; d[1] = (v4u){top[4], top[5], top[6], top[7]}; d[2] = (v4u){top[8], top[9], top[10], top[11]}; d[3] = (v4u){top[12], top[13], top[14], top[15]}; } }
    }
#undef QP_LOAD
    }
    for (int tb = 0; tb < 2; ++tb) {
        LDS_WAIT();
        const LAS unsigned* l1 = lst + (16 * tb + c16) * 16; const LAS unsigned* l2 = lst + (32 + 16 * tb + c16) * 16;
        unsigned ck[16];
#pragma unroll
        for (int k = 0; k < 13; ++k) { const unsigned ab = (cpk[k >> 2] >> (8 * (k & 3))) & 255u; const unsigned a = ab >> 4, bq = ab & 15u;
            const float s = ord2f(l1[a] & ~0x7Fu) + ord2f(l2[bq] & ~0x7Fu); ck[k] = (ab == 255u) ? 0u : ((f2ord(s) & ~0xFFu) | ab); }
        ck[13] = 0u; ck[14] = 0u; ck[15] = 0u;
        bitonic_sort_desc<16>(ck);
        merge16_xor(ck, 16); merge16_xor(ck, 32);
        if (g == 0) { const int tl = 16 * tb + c16; const float m = ord2f(ck[0] & ~0xFFu); float e[16]; float sum = 0.f;
#pragma unroll
            for (int k = 0; k < 16; ++k) { e[k] = __expf(ord2f(ck[k] & ~0xFFu) - m); sum += e[k]; }
            const float inv = 1.f / sum;
#pragma unroll
            for (int k = 0; k < 16; ++k) { const unsigned a = (ck[k] >> 4) & 15u, bq = ck[k] & 15u; const int ex = (int)((l1[a] & 0x7Fu) * 128u + (l2[bq] & 0x7Fu));
                eidx[tl * 128 + w * 16 + k] = ex; gate[tl * 128 + w * 16 + k] = e[k] * inv; } }
    }
#endif
    __syncthreads();
    LAS unsigned char* hnb = lds + P_HN4 + w * 8192; LAS float* actl = (LAS float*)(lds + P_ACT) + w * 512;
    const LAS unsigned char* hb = hnb + 16 * g + ((c16 == 1) ? 1024 : 0);
    v4u bA[8], bB[8];
#define U_ISSUE(buf, e_, jb) do { const unsigned uo_ = (unsigned)(e_) * (unsigned)ROWB + 16u * (unsigned)g + 512u * (unsigned)(jb); \
        _Pragma("unroll") for (int jj = 0; jj < 8; ++jj) buf[jj] = *(const GAS v4u*)(U8 + (uo_ + 64u * jj)); __builtin_amdgcn_sched_barrier(0); } while (0)
#define U_CONSUME(buf, jb, HB) do { v4u bq_[8]; _Pragma("unroll") for (int jj = 0; jj < 8; ++jj) bq_[jj] = *(const LAS v4u*)((HB) + 64 * (8 * (jb) + jj)); \
        __builtin_amdgcn_sched_barrier(0); \
        _Pragma("unroll") for (int jj = 0; jj < 8; ++jj) { const v4u a_ = buf[jj]; \
            const v8i av_ = {(int)a_.x, (int)a_.y, (int)a_.z, (int)a_.w, 0, 0, 0, 0}; const v8i bv_ = {(int)bq_[jj].x, (int)bq_[jj].y, (int)bq_[jj].z, (int)bq_[jj].w, 0, 0, 0, 0}; \
            acc = __builtin_amdgcn_mfma_scale_f32_16x16x128_f8f6f4(av_, bv_, acc, 4, 4, 0, 0x7f7f7f7f, 0, 0x7f7f7f7f); } __builtin_amdgcn_sched_barrier(0); } while (0)
#define U_ACT(grp_, TL, ACT) do { const float l0_ = __shfl_down(acc.x, 1), l1_ = __shfl_down(acc.y, 1), l2_ = __shfl_down(acc.z, 1), l3_ = __shfl_down(acc.w, 1); \
        if (c16 == 0) { const int k0 = 16 * (grp_) + 4 * g; constexpr float isc = 1.f / (SU * SH4), ilo = 1.f / SLO4; const f32x4 gt = *(const LAS f32x4*)(gate + (TL) * 128 + k0); \
        f32x4 a4; a4.x = gelu_erf((acc.x + l0_ * ilo) * isc) * gt.x; a4.y = gelu_erf((acc.y + l1_ * ilo) * isc) * gt.y; a4.z = gelu_erf((acc.z + l2_ * ilo) * isc) * gt.z; a4.w = gelu_erf((acc.w + l3_ * ilo) * isc) * gt.w; *(LAS f32x4*)((ACT) + k0) = a4; } } while (0)
#define V_ISSUE(buf, TL, kb_) do { _Pragma("unroll") for (int kh = 0; kh < 2; ++kh) { const LAS v4i* ep_ = (const LAS v4i*)(eidx + (TL) * 128 + 8 * (kb_) + 4 * kh); const v4i e4_ = *ep_; const int ee_[4] = {e4_.x, e4_.y, e4_.z, e4_.w}; \
        _Pragma("unroll") for (int kk = 0; kk < 4; ++kk) { const unsigned vo_ = (unsigned)(ee_[kk] & emask) * (unsigned)ROWB + 16u * (unsigned)lane; buf[4 * kh + kk] = *(const GAS v4u*)(V8 + vo_); } \
        __builtin_amdgcn_sched_barrier(0); } } while (0)
#define PIN8x2(a, i) asm volatile("" : "+v"(a[i]), "+v"(a[i + 1]), "+v"(a[i + 2]), "+v"(a[i + 3]), "+v"(a[i + 4]), "+v"(a[i + 5]), "+v"(a[i + 6]), "+v"(a[i + 7]))
#define V_CONSUME(buf, kb_, O, ACT) do { _Pragma("unroll") for (int kk = 0; kk < 8; ++kk) { const float as_ = (ACT)[8 * (kb_) + kk]; const f32x2 a2_ = {as_, as_}; \
        const unsigned vw[4] = {buf[kk].x, buf[kk].y, buf[kk].z, buf[kk].w}; \
        _Pragma("unroll") for (int q = 0; q < 4; ++q) { \
            O[4 * q]     = __builtin_elementwise_fma(__builtin_amdgcn_cvt_scalef32_pk_f32_fp4(vw[q], 1.0f, 0), a2_, O[4 * q]); \
            O[4 * q + 1] = __builtin_elementwise_fma(__builtin_amdgcn_cvt_scalef32_pk_f32_fp4(vw[q], 1.0f, 1), a2_, O[4 * q + 1]); \
            O[4 * q + 2] = __builtin_elementwise_fma(__builtin_amdgcn_cvt_scalef32_pk_f32_fp4(vw[q], 1.0f, 2), a2_, O[4 * q + 2]); \
            O[4 * q + 3] = __builtin_elementwise_fma(__builtin_amdgcn_cvt_scalef32_pk_f32_fp4(vw[q], 1.0f, 3), a2_, O[4 * q + 3]); } \
        PIN8x2(O, 0); PIN8x2(O, 8); } } while (0)
#ifndef NO_GATHER
#ifdef PROBE_L2RES
    constexpr int emask = dry ? PROBE_L2RES : 16383;
#else
    constexpr int emask = 16383;
#endif
    {
    { unsigned k0[4], k1[4];
#pragma unroll
      for (int ti = 0; ti < 4; ++ti) { const int tl = w + 8 * ti; k0[ti] = ((unsigned)eidx[tl * 128 + lane] << 7) | (unsigned)lane; k1[ti] = ((unsigned)eidx[tl * 128 + 64 + lane] << 7) | (unsigned)(64 + lane); }
#pragma unroll
      for (int k = 2; k <= 128; k <<= 1)
#pragma unroll
        for (int j = k >> 1; j > 0; j >>= 1) {
            if (j == 64) {
#pragma unroll
                for (int ti = 0; ti < 4; ++ti) { const unsigned lo_ = k0[ti] < k1[ti] ? k0[ti] : k1[ti], hi_ = k0[ti] < k1[ti] ? k1[ti] : k0[ti]; k0[ti] = lo_; k1[ti] = hi_; }
            } else {
                const bool lower = (lane & j) == 0;
                const bool desc0 = (k == 64) ? false : ((k == 128) ? false : ((lane & k) != 0)), desc1 = (k == 64) ? true : desc0;
                const bool min0 = lower != desc0, min1 = lower != desc1;
#pragma unroll
                for (int ti = 0; ti < 4; ++ti) { const unsigned p0 = (unsigned)__shfl_xor((int)k0[ti], j), p1 = (unsigned)__shfl_xor((int)k1[ti], j);
                    const unsigned mn0 = k0[ti] < p0 ? k0[ti] : p0, mx0 = k0[ti] < p0 ? p0 : k0[ti], mn1 = k1[ti] < p1 ? k1[ti] : p1, mx1 = k1[ti] < p1 ? p1 : k1[ti];
                    k0[ti] = min0 ? mn0 : mx0; k1[ti] = min1 ? mn1 : mx1; }
            }
        }
      float g0[4], g1[4];
#pragma unroll
      for (int ti = 0; ti < 4; ++ti) { const int tl = w + 8 * ti; g0[ti] = gate[tl * 128 + (int)(k0[ti] & 127u)]; g1[ti] = gate[tl * 128 + (int)(k1[ti] & 127u)]; }
      LDS_WAIT(); asm volatile("" ::: "memory");
#pragma unroll
      for (int ti = 0; ti < 4; ++ti) { const int tl = w + 8 * ti; eidx[tl * 128 + lane] = (int)(k0[ti] >> 7); eidx[tl * 128 + 64 + lane] = (int)(k1[ti] >> 7); gate[tl * 128 + lane] = g0[ti]; gate[tl * 128 + 64 + lane] = g1[ti]; }
      LDS_WAIT(); asm volatile("" ::: "memory"); }
    v2u xn[8];
#define X_ISSUE(tok_) do { const unsigned xb_ = (unsigned)(tok_) * (unsigned)(DM * 2) + 8u * (unsigned)lane; _Pragma("unroll") for (int j = 0; j < 8; ++j) xn[j] = __builtin_nontemporal_load((const GAS v2u*)((const unsigned char*)X1B + (xb_ + 512u * j))); } while (0)
    X_ISSUE(T0 + w);
#pragma unroll 1
    for (int ti = 0; ti < 4; ++ti) {
        f32x4 xr[8]; float ss = 0.f;
#pragma unroll
        for (int j = 0; j < 8; ++j) { const v2u r = xn[j]; xr[j] = (f32x4){bflo(r.x), bfhi(r.x), bflo(r.y), bfhi(r.y)}; }
        X_ISSUE(T0 + w + 8 * (ti < 3 ? ti + 1 : 3));
#pragma unroll
        for (int j = 0; j < 8; ++j) ss += (xr[j].x * xr[j].x + xr[j].y * xr[j].y) + (xr[j].z * xr[j].z + xr[j].w * xr[j].w);
        const float rs2 = __builtin_amdgcn_rsqf(wave_sum(ss) * (1.f / DM) + EPS);
        const float* fg_ = fgain; asm volatile("" : "+s"(fg_));
        const unsigned char* gp = (const unsigned char*)fg_; const unsigned go = 16u * (unsigned)lane;
        unsigned hw[4], lw[4];
#pragma unroll
        for (int q = 0; q < 4; ++q) { unsigned wh = 0u, wl = 0u;
#pragma unroll
            for (int t = 0; t < 2; ++t) { const int j = 2 * q + t; const f32x4 gg = *(const GAS f32x4*)(gp + (go + 1024u * j)); const f32x4 hv = xr[j] * gg * (rs2 * SH4);
                const float h0 = clampf(hv.x, 6.f), h1 = clampf(hv.y, 6.f), h2 = clampf(hv.z, 6.f), h3 = clampf(hv.w, 6.f);
                const unsigned p0 = __builtin_amdgcn_cvt_scalef32_pk_fp4_f32(0u, h0, h1, 1.0f, 0), p1 = __builtin_amdgcn_cvt_scalef32_pk_fp4_f32(0u, h2, h3, 1.0f, 0);
                const f32x2 d0 = __builtin_amdgcn_cvt_scalef32_pk_f32_fp4(p0, 1.0f, 0), d1 = __builtin_amdgcn_cvt_scalef32_pk_f32_fp4(p1, 1.0f, 0);
                const unsigned r0 = __builtin_amdgcn_cvt_scalef32_pk_fp4_f32(0u, clampf((h0 - d0.x) * SLO4, 6.f), clampf((h1 - d0.y) * SLO4, 6.f), 1.0f, 0), r1 = __builtin_amdgcn_cvt_scalef32_pk_fp4_f32(0u, clampf((h2 - d1.x) * SLO4, 6.f), clampf((h3 - d1.y) * SLO4, 6.f), 1.0f, 0);
                wh |= ((p0 & 0xFFu) | ((p1 & 0xFFu) << 8)) << (16 * t); wl |= ((r0 & 0xFFu) | ((r1 & 0xFFu) << 8)) << (16 * t); }
            hw[q] = wh; lw[q] = wl; }
        *(LAS v4u*)(hnb + 2048 * ti + 16 * lane) = (v4u){hw[0], hw[1], hw[2], hw[3]}; *(LAS v4u*)(hnb + 2048 * ti + 1024 + 16 * lane) = (v4u){lw[0], lw[1], lw[2], lw[3]};
    }
    LDS_WAIT();
    { int e_cur = eidx[w * 128 + c16] & emask;
      U_ISSUE(bA, e_cur, 0);
#pragma unroll 1
      for (int s_ = 0; s_ < 31; ++s_) {
          const int ti = s_ & 3, grp = s_ >> 2, tl = w + 8 * ti, sn = s_ + 1;
          const int e_nxt = eidx[(w + 8 * (sn & 3)) * 128 + 16 * (sn >> 2) + c16] & emask;
          const LAS unsigned char* hbt = hb + 2048 * ti; LAS float* actt = actl + 128 * ti;
          f32x4 acc = (f32x4){0.f, 0.f, 0.f, 0.f};
          U_ISSUE(bB, e_cur, 1); U_CONSUME(bA, 0, hbt);
          U_ISSUE(bA, e_nxt, 0);
          U_CONSUME(bB, 1, hbt);
          U_ACT(grp, tl, actt);
          e_cur = e_nxt;
      }
      { const LAS unsigned char* hbt = hb + 2048 * 3; LAS float* actt = actl + 128 * 3;
        f32x4 acc = (f32x4){0.f, 0.f, 0.f, 0.f};
        U_ISSUE(bB, e_cur, 1); U_CONSUME(bA, 0, hbt);
        V_ISSUE(bA, w, 0);
        U_CONSUME(bB, 1, hbt);
        U_ACT(7, w + 24, actt); } }
    LDS_WAIT();
    f32x2 o2[4][16];
#pragma unroll
    for (int ti = 0; ti < 4; ++ti)
#pragma unroll
        for (int i = 0; i < 16; ++i) o2[ti][i] = (f32x2){0.f, 0.f};
#pragma unroll 1
    for (int kb = 0; kb < 16; ++kb) {
        const int kn = kb < 15 ? kb + 1 : 15;
        V_ISSUE(bB, w + 8, kb);  V_CONSUME(bA, kb, o2[0], actl);
        V_ISSUE(bA, w + 16, kb); V_CONSUME(bB, kb, o2[1], actl + 128);
        V_ISSUE(bB, w + 24, kb); V_CONSUME(bA, kb, o2[2], actl + 256);
        V_ISSUE(bA, w, kn);      V_CONSUME(bB, kb, o2[3], actl + 384);
    }
    X_ISSUE(T0 + w);
#pragma unroll
    for (int ti = 0; ti < 4; ++ti) {
        const size_t token = (size_t)T0 + w + 8 * ti;
        const unsigned xo = (unsigned)token * (unsigned)(DM * 4) + 16u * (unsigned)lane;
        f32x4 xr[8];
#pragma unroll
        for (int j = 0; j < 8; ++j) { const v2u r = xn[j]; xr[j] = (f32x4){bflo(r.x), bfhi(r.x), bflo(r.y), bfhi(r.y)}; }
        if (ti < 3) X_ISSUE(T0 + w + 8 * (ti + 1));
        constexpr float isv = 1.f / SV; float s2 = 0.f;
#pragma unroll
        for (int j = 0; j < 8; ++j) { xr[j] = xr[j] + (f32x4){o2[ti][2 * j].x, o2[ti][2 * j].y, o2[ti][2 * j + 1].x, o2[ti][2 * j + 1].y} * isv;
            s2 += (xr[j].x * xr[j].x + xr[j].y * xr[j].y) + (xr[j].z * xr[j].z + xr[j].w * xr[j].w); }
        const float rf = __builtin_amdgcn_rsqf(wave_sum(s2) * (1.f / DM) + EPS);
        const float* fi_ = fing; asm volatile("" : "+s"(fi_));
        const unsigned char* fp = (const unsigned char*)fi_; unsigned char* op = (unsigned char*)outp; const unsigned fo = 16u * (unsigned)lane;
        if (!dry || rf == 1.2345e30f)
#pragma unroll
        for (int j = 0; j < 8; ++j) __builtin_nontemporal_store(xr[j] * rf * *(const GAS f32x4*)(fp + (fo + 1024u * j)), (GAS f32x4*)(op + (xo + 1024u * j)));
    }
    }
#endif
#undef U_ISSUE
#undef X_ISSUE
#undef U_ACT
#undef U_CONSUME
#undef V_ISSUE
#undef V_CONSUME
    __syncthreads();
}

__global__ void __launch_bounds__(NWAVES * 64, 2) hybrid_fwd(Args args) {
    extern __shared__ __attribute__((aligned(16))) unsigned char lds[];
    Frame F;
    F.lds = (LAS unsigned char*)lds;
    F.MISC = (volatile LAS unsigned*)(F.lds + MISC_OFF);
    F.tid = threadIdx.x; F.lane = F.tid & 63; F.wave = __builtin_amdgcn_readfirstlane(F.tid >> 6); F.G = gridDim.x;
    for (int u = F.tid; u < (LDS_BYTES - LDSCTL_OFF) / 4; u += NWAVES * 64) ((LAS unsigned*)(F.lds + LDSCTL_OFF))[u] = 0u;
    __syncthreads();
    (void)args;
    XcdBarrier bar = xcd_barrier_post(F.ctl() + CW_BAR, F.MISC + 8);

#ifndef NO_P0
#ifdef PROBE_P0X2
    { int reps = 2; asm volatile("" : "+s"(reps)); for (int rep = 0; rep < reps; ++rep) p0_prologue(F); }
#else
    p0_prologue(F);
#endif
#endif
    xcd_barrier(bar);
#ifndef NO_P1
#ifdef PROBE_GX2
    { int reps = 2; asm volatile("" : "+s"(reps)); for (int rep = 0; rep < reps; ++rep) {
#else
    { { const int rep = 0, reps = 1;
#endif
      pg8::Gemm gm{F.HN(), F.WinT(), MTOK, NB16, DM}; pg8::StaticOrder S; S.init(MTOK, NB16, F.G, (int)blockIdx.x);
      EpiProj E{F.PROJ(), F.dtraw(), (rep + 1 < reps) ? nullptr : F.kmean()};
      pg8::gemm_phase<EpiProj, pg8::StaticOrder, PG8_ALIGN, PG8_SP2>(F.lds + RING_OFF, gm, S, E); } }
    { const int nun = (MTOK / 256) * (NB16 / 256), rem = nun % F.G;
      if (rem && (int)blockIdx.x >= rem) tables_convert(F, tab_split(F.G), TAB_ITEMS, (size_t)((int)blockIdx.x - rem) * (NWAVES * 64) + fresh_tid(), (size_t)(F.G - rem) * (NWAVES * 64)); }
    __syncthreads();
    {
      pg8::Gemm gm{(const pg8::bf16_t*)F.HN8(), (const pg8::bf16_t*)F.WinT8(), MTOK, F8_HI - F8_LO, DM / 2}; pg8::StaticOrder S; S.init(MTOK, F8_HI - F8_LO, F.G, (int)blockIdx.x);
      EpiProj8 E{F.PROJ()};
      pg8::gemm_phase<EpiProj8, pg8::StaticOrder, PG8_ALIGN, PG8_SP2, true>(F.lds + RING_OFF, gm, S, E); }
#endif
    xcd_barrier(bar);
#ifdef PROBE_P15X2
    conv_phase(F);
#endif
    conv_phase(F);
    xcd_barrier(bar);
#ifdef PROBE_P2X2
    { int reps = 2; asm volatile("" : "+s"(reps)); for (int rep = 0; rep < reps; ++rep) {
#else
    { { const int rep = 0, reps = 1;
#endif
    const bool doatom = rep + 1 == reps;
    const int ntab = (int)(tab_split(F.G) / TAB_UNIT);
    for (;;) {
        if (F.tid == 0) F.MISC[0] = xb_add(F.ctl() + CW_Q2 + 64 * rep, 1u);
        __syncthreads();
        const int ui = (int)F.MISC[0];
        __syncthreads();
        if (ui >= 128 + 512 + W_SQ_UNITS + ntab) break;
        if (ui >= 128 + 512 && ui < 128 + 512 + W_SQ_UNITS) { sq_weight_items(F, ui - 640); __syncthreads(); continue; }
        if (ui >= 128 + 512 + W_SQ_UNITS) { const size_t lo = (size_t)(ui - 640 - W_SQ_UNITS) * TAB_UNIT; tables_convert(F, lo, lo + TAB_UNIT, (size_t)fresh_tid(), (size_t)(NWAVES * 64)); continue; }
#ifdef PROBE_P2_SSD
        if (ui < 128 || doatom)
#endif
#ifdef PROBE_P2_ATT
        if (ui >= 128 || doatom)
#endif
        {
        if (ui < 128) ssd_unit(F, ui >> 4, ui & 15, doatom);
        else { const int a = ui - 128; attn_unit(F, (a & 63) >> 3, a & 7, 7 - (a >> 6), doatom); }
        }
    } } }
    xcd_barrier(bar);
#ifndef NO_P3
#ifdef PROBE_GX2
    { int reps = 2; asm volatile("" : "+s"(reps)); for (int rep = 0; rep < reps; ++rep) {
#else
    { { const int rep = 0, reps = 1;
#endif
      pg8::Gemm gm{F.HN(), F.WoutT(), MTOK, DM, DM / 2}; pg8::StaticOrder S; S.init(MTOK, DM, F.G, (int)blockIdx.x);
      {
        const int t_ = fresh_tid(); const float* const sq = F.ssq();
#pragma unroll 1
        for (int ii = t_ >> 8; ii < 3; ii += 2) { pg8::Unit uu;
          if (S.next(ii, uu)) { const int row = uu.pm * 256 + (t_ & 255);
            const float q1 = __hip_atomic_load(sq + (size_t)row * 4 + 1, RLX_AGENT), q2 = __hip_atomic_load(sq + (size_t)row * 4 + 2, RLX_AGENT), q3 = __hip_atomic_load(sq + (size_t)row * 4 + 3, RLX_AGENT);
            const float sa = __builtin_amdgcn_rsqf(q1 * (1.f / 1024.f) + EPS), s0 = __builtin_amdgcn_rsqf(q2 * (1.f / 512.f) + EPS), s1 = __builtin_amdgcn_rsqf(q3 * (1.f / 512.f) + EPS);
            *(LAS f32x4*)(F.lds + SEGTAB_OFF + (ii * 256 + (t_ & 255)) * 16) = (f32x4){sa / s0 * (SS8 / SA8), s0 / s1, s1 * (1.f / (SS8 * SW8)), 0.f}; } }
        __syncthreads(); }
      EpiOut E{F.x(), F.X1B(), F.X18(), F.ssq(), rep + 1 == reps, (const LAS f32x4*)(F.lds + SEGTAB_OFF)};
      pg8::gemm_phase<EpiOut, pg8::StaticOrder, PG8_ALIGN, PG8_SP2, true>(F.lds + RING_OFF, gm, S, E); } }
#endif
    xcd_barrier(bar);
#ifndef NO_P4
#ifdef PROBE_GX2
    { int reps = 2; asm volatile("" : "+s"(reps)); for (int rep = 0; rep < reps; ++rep) {
#else
    { { const int rep = 0, reps = 1; (void)rep; (void)reps;
#endif
      pg8::Gemm gm{(const pg8::bf16_t*)F.X18(), F.WqT(), MTOK, DM, DM / 2}; pg8::StaticOrder S; S.init(MTOK, DM, F.G, (int)blockIdx.x);
      EpiQ E{F.QP(), F.ssq()};
      pg8::gemm_phase<EpiQ, pg8::StaticOrder, PG8_ALIGN, PG8_SP2, true>(F.lds + RING_OFF, gm, S, E); } }
#endif
    xcd_barrier(bar);
#ifndef NO_P5
#ifdef PROBE_P5X2
    { for (int u = blockIdx.x; u < MTOK / 32; u += F.G) peer_unit<true>(F, u);
      for (int u = blockIdx.x; u < MTOK / 32; u += F.G) peer_unit<false>(F, u); }
#else
    for (int u = blockIdx.x; u < MTOK / 32; u += F.G) peer_unit(F, u);
#endif
#endif
}

extern "C" void kernel_launch(void* const* d_in, const int* in_sizes, int n_in, void* d_out, int out_size, void* d_ws, size_t ws_size, hipStream_t stream) {
    static int grid = 0;
    if (grid == 0) {
        if (n_in != 18 || out_size != MTOK * DM || ws_size < WS_END) { fprintf(stderr, "kernel_launch: unexpected shapes (n_in %d, out %d, ws %zu)\n", n_in, out_size, ws_size); grid = -1; return; }
        int dev = 0, cus = 0, per_cu = 0;
        if (hipGetDevice(&dev) != hipSuccess || hipDeviceGetAttribute(&cus, hipDeviceAttributeMultiprocessorCount, dev) != hipSuccess) { grid = -1; return; }
        if (hipFuncSetAttribute((const void*)hybrid_fwd, hipFuncAttributeMaxDynamicSharedMemorySize, LDS_BYTES) != hipSuccess) { fprintf(stderr, "kernel_launch: hipFuncSetAttribute failed\n"); grid = -1; return; }
        if (hipOccupancyMaxActiveBlocksPerMultiprocessor(&per_cu, (const void*)hybrid_fwd, NWAVES * 64, LDS_BYTES) != hipSuccess || per_cu < 1)
            fprintf(stderr, "kernel_launch: note: occupancy query reports %d workgroups per CU\n", per_cu);
        (void)hipGetLastError();
        grid = cus;
    }
    if (grid < 0) return;
    if (hipMemsetAsync((char*)d_ws + WS_CTL, 0, CTL_ZERO_BYTES, stream) != hipSuccess) return;
    Args a{};
    for (int i = 0; i < 18; ++i) a.in[i] = (const float*)d_in[i];
    a.out = (float*)d_out; a.ws = (unsigned char*)d_ws;
    hipLaunchKernelGGL(hybrid_fwd, dim3(grid), dim3(NWAVES * 64), LDS_BYTES, stream, a);
}
```

```cpp
#include <hip/hip_runtime.h>
#include <cstdio>
#include <cstdint>
namespace pg8 {
#define PG8_LAS __attribute__((address_space(3)))
typedef unsigned short bf16_t;
typedef short bf16x8 __attribute__((ext_vector_type(8)));
typedef float f32x4 __attribute__((ext_vector_type(4)));
typedef unsigned u32x4 __attribute__((ext_vector_type(4)));
constexpr int BM = 256, BK = 64, HALF = 128, HTB = HALF * BK * 2  , STAGE_BYTES = 8 * HTB, NXCD = 8, WGM = 8;

__host__ __device__ __forceinline__ int lds_byte(int r, int c) { const int st = (r >> 4) * 2 + (c >> 5), rr = r & 15, cc = c & 31, ob = rr * 64 + cc * 2; return st * 1024 + (ob ^ (((ob >> 9) & 1) << 5)); }
__host__ __device__ __forceinline__ void stage_rc(int b, int& R, int& C) { const int st = b / 1024, sb = b % 1024, swz = sb ^ (((sb >> 9) & 1) << 5); R = (st >> 1) * 16 + swz / 64; C = (st & 1) * 32 + (swz % 64) / 2; }
__host__ __device__ __forceinline__ int perm32(int rho) { const int n = rho >> 4, i = rho & 15; return 8 * (i >> 2) + 4 * n + (i & 3); }

struct Unit { int pm, pn; };
struct Gemm { const bf16_t* A; const bf16_t* Bt; int M, N, K; };

struct StaticOrder {
    int nM, nN, nwg, G, c;
    __host__ __device__ void init(int M, int N, int G_, int c_) { nM = M / BM; nN = N / BM; nwg = nM * nN; G = G_; c = c_; }
    __host__ __device__ bool next(int i, Unit& u) const {
        const long L = (long)i * G + c; if (L >= nwg) return false;
        int wgid = (int)L; { const int q = nwg / NXCD, r = nwg % NXCD, xcd = wgid % NXCD, off = wgid / NXCD; wgid = (xcd < r ? xcd * (q + 1) : r * (q + 1) + (xcd - r) * q) + off; }
        const int nig = WGM * nN, gid = wgid / nig, fm = gid * WGM, gsz = (nM - fm) < WGM ? (nM - fm) : WGM;
        u.pm = fm + ((wgid % nig) % gsz); u.pn = (wgid % nig) / gsz; return true;
    }
    __device__ __forceinline__ void a_ready(const Unit&) const {}
    __device__ __forceinline__ void done(const Unit&) const {}
};

__device__ __forceinline__ unsigned cvt_pk_bf16(float lo, float hi) { unsigned r; asm volatile("v_cvt_pk_bf16_f32 %0, %1, %2" : "=v"(r) : "v"(lo), "v"(hi)); return r; }
typedef float f32x2 __attribute__((ext_vector_type(2)));
__device__ __forceinline__ f32x2 gelu_pk(f32x2 v) {
    const f32x2 av = __builtin_elementwise_abs(v), d = av * 0.2316418882f + 1.0f;
    f32x2 t; t.x = __builtin_amdgcn_rcpf(d.x); t.y = __builtin_amdgcn_rcpf(d.y);
    f32x2 q = t * 0.5307027145f + (-0.7265760135f); q = q * t + 0.7107068705f; q = q * t + (-0.142248368f); q = q * t + 0.127414796f; q = q * t;
    const f32x2 s = (v * v) * (-0.72134752044f);
    f32x2 e; e.x = __builtin_amdgcn_exp2f(s.x); e.y = __builtin_amdgcn_exp2f(s.y);
    const f32x2 m = v * (q * e), r = v - m;
    f32x2 o; o.x = v.x < 0.f ? m.x : r.x; o.y = v.y < 0.f ? m.y : r.y; return o;
}

template <int ACT  > struct EpiBf16 {
    static constexpr bool PERM = true, AFTER_DRAIN = false, SEG = false; static_assert(ACT == 0 || ACT == 1, "EpiBf16: ACT is 0 (none) or 1 (gelu_pk)");
    bf16_t* O; int ldc; const float* bias; int split_cols; size_t split_stride; float scale0;
    __device__ __forceinline__ void operator()(const f32x4 (&acc)[2][2][4][2], const Unit& u, int wr, int wc, int fr, int fq) const {
        const int row0 = u.pm * BM + wr * 64 + fr; int colt = u.pn * BM; bf16_t* base = O;
        float sc = 1.f; if (split_cols) { const int t = colt / split_cols; base += (size_t)t * split_stride; colt -= t * split_cols; if (t == 0) sc = scale0; }
        const int col0 = colt + wc * 32 + 8 * fq, bcol0 = u.pn * BM + wc * 32 + 8 * fq;
        f32x4 bv[2][2];
#pragma unroll
        for (int bj = 0; bj < 2; ++bj)
#pragma unroll
            for (int n = 0; n < 2; ++n) bv[bj][n] = bias ? *(const f32x4*)(bias + bcol0 + bj * HALF + 4 * n) : (f32x4){0.f, 0.f, 0.f, 0.f};
#pragma unroll
        for (int ai = 0; ai < 2; ++ai)
#pragma unroll
            for (int m = 0; m < 4; ++m) { bf16_t* rowp = base + (size_t)(row0 + ai * HALF + m * 16) * ldc + col0;
#pragma unroll
                for (int bj = 0; bj < 2; ++bj) { f32x4 v0 = acc[ai][bj][m][0] + bv[bj][0], v1 = acc[ai][bj][m][1] + bv[bj][1];
                    if (ACT == 1) { f32x2 a = gelu_pk((f32x2){v0[0], v0[1]}), b = gelu_pk((f32x2){v0[2], v0[3]}), c = gelu_pk((f32x2){v1[0], v1[1]}), d = gelu_pk((f32x2){v1[2], v1[3]});
                        v0 = (f32x4){a.x, a.y, b.x, b.y}; v1 = (f32x4){c.x, c.y, d.x, d.y}; }
                    v0 = v0 * sc; v1 = v1 * sc; u32x4 w; w.x = cvt_pk_bf16(v0[0], v0[1]); w.y = cvt_pk_bf16(v0[2], v0[3]); w.z = cvt_pk_bf16(v1[0], v1[1]); w.w = cvt_pk_bf16(v1[2], v1[3]);
                    *(u32x4*)(rowp + bj * HALF) = w; } }
    }
};
template <class Epi, class Sched, bool ALIGN_EPI = false, bool SP2 = false, bool F8 = false>
__device__ __forceinline__ void gemm_phase(PG8_LAS unsigned char* lds, const Gemm g, const Sched& S, const Epi& E) {
    int tid_ = threadIdx.x; asm volatile("" : "+v"(tid_));
    const int tid = tid_, wid = __builtin_amdgcn_readfirstlane(tid >> 6), lane = tid & 63, wr = wid >> 2, wc = wid & 3, fr = lane & 15, fq = lane >> 4;
    const int K = g.K, nt = K / BK;
    unsigned voffA[2], voffB[2];
#pragma unroll
    for (int i = 0; i < 2; ++i) { int R, C; stage_rc(tid * 16 + i * 8192, R, C); const int Rb = Epi::PERM ? ((R & ~31) + perm32(R & 31)) : R;
        voffA[i] = (unsigned)(R * K + C) * 2u; voffB[i] = (unsigned)(Rb * K + C) * 2u; }
    const size_t kstep = (size_t)(BK * 2);
    const size_t hstep = (size_t)HALF * K * 2;
    const size_t tstep = 2 * hstep;
    const unsigned ldsw = (unsigned)wid * 1024u;
    const int aoff = lds_byte(wr * 64 + fr, fq * 8), boff = lds_byte(wc * 32 + fr, fq * 8);
#define PG8_SA(b, h) (((b) * 2 + (h)) * HTB)
#define PG8_SB(b, h) ((4 + (b) * 2 + (h)) * HTB)
#define PG8_STAGE(bufoff, gbase, voff) do { _Pragma("unroll") for (int _i = 0; _i < 2; ++_i) \
        __builtin_amdgcn_global_load_lds((const unsigned*)((const char*)(gbase) + (voff)[_i]), (PG8_LAS unsigned*)(lds + (bufoff) + ldsw + _i * 8192), 16, 0, 0); } while (0)
#define PG8_LDA(dst, b, h) do { _Pragma("unroll") for (int m = 0; m < 4; ++m) _Pragma("unroll") for (int k = 0; k < 2; ++k) dst[m][k] = *(const PG8_LAS bf16x8*)(lds + PG8_SA(b, h) + aoff + m * 2048 + k * 1024); } while (0)
#define PG8_LDB(dst, b, h) do { _Pragma("unroll") for (int n = 0; n < 2; ++n) _Pragma("unroll") for (int k = 0; k < 2; ++k) dst[n][k] = *(const PG8_LAS bf16x8*)(lds + PG8_SB(b, h) + boff + n * 2048 + k * 1024); } while (0)
#define PG8_MMA(ai, bj, At, Bt) do { __builtin_amdgcn_s_setprio(1); _Pragma("unroll") for (int m = 0; m < 4; ++m) _Pragma("unroll") for (int n = 0; n < 2; ++n) { \
        if constexpr (F8) { typedef int v8i_ __attribute__((ext_vector_type(8))); typedef int v4i_ __attribute__((ext_vector_type(4))); \
            const v4i_ b0_ = __builtin_bit_cast(v4i_, Bt[n][0]), b1_ = __builtin_bit_cast(v4i_, Bt[n][1]), a0_ = __builtin_bit_cast(v4i_, At[m][0]), a1_ = __builtin_bit_cast(v4i_, At[m][1]); \
            const v8i_ bb_ = {b0_.x, b0_.y, b0_.z, b0_.w, b1_.x, b1_.y, b1_.z, b1_.w}, aa_ = {a0_.x, a0_.y, a0_.z, a0_.w, a1_.x, a1_.y, a1_.z, a1_.w}; \
            asm volatile("v_mfma_scale_f32_16x16x128_f8f6f4 %0, %1, %2, %0, %3, %3 op_sel_hi:[0,0,0]" : "+v"(acc[ai][bj][m][n]) : "v"(bb_), "v"(aa_), "v"(f8one)); } \
        else { _Pragma("unroll") for (int k = 0; k < 2; ++k) acc[ai][bj][m][n] = __builtin_amdgcn_mfma_f32_16x16x32_bf16(Bt[n][k], At[m][k], acc[ai][bj][m][n], 0, 0, 0); } } \
        __builtin_amdgcn_s_setprio(0); } while (0)
#define PG8_WAIT_V(n) asm volatile("s_waitcnt vmcnt(" #n ")" ::: "memory")
#define PG8_WAIT_L(n) asm volatile("s_waitcnt lgkmcnt(" #n ")" ::: "memory")
#define PG8_BAR __builtin_amdgcn_s_barrier()
#define PG8_SCHED __builtin_amdgcn_sched_barrier(0)
    Unit cur, nxt; int ui = 0;
    if (!S.next(0, cur)) return;
    f32x4 acc[2][2][4][2];
    const int f8one = 0x7f7f7f7f;
#pragma unroll
    for (int a = 0; a < 2; ++a)
#pragma unroll
        for (int b = 0; b < 2; ++b)
#pragma unroll
            for (int m = 0; m < 4; ++m)
#pragma unroll
                for (int n = 0; n < 2; ++n) acc[a][b][m][n] = (f32x4){0.f, 0.f, 0.f, 0.f};
    bf16x8 At[4][2], B0[2][2], B1[2][2];
    const char* cA = (const char*)g.A + (size_t)cur.pm * tstep; const char* cB = (const char*)g.Bt + (size_t)cur.pn * tstep;
    S.a_ready(cur);
    float segr[16];
    if constexpr (Epi::SEG) E.seg_load(ui, wr, fr, segr);
    if constexpr (SP2) {
        PG8_STAGE(PG8_SB(0, 0), cB, voffB); PG8_STAGE(PG8_SB(0, 1), cB + hstep, voffB); PG8_STAGE(PG8_SA(0, 0), cA, voffA); PG8_STAGE(PG8_SA(0, 1), cA + hstep, voffA);
        if (wr == 1) PG8_BAR;
        PG8_WAIT_V(2); PG8_BAR;
        PG8_STAGE(PG8_SB(1, 0), cB + kstep, voffB); PG8_STAGE(PG8_SA(1, 0), cA + kstep, voffA); PG8_STAGE(PG8_SB(1, 1), cB + hstep + kstep, voffB);
        PG8_WAIT_V(6); PG8_BAR;
    } else {
        PG8_STAGE(PG8_SB(0, 0), cB, voffB); PG8_STAGE(PG8_SA(0, 0), cA, voffA); PG8_STAGE(PG8_SB(0, 1), cB + hstep, voffB); PG8_STAGE(PG8_SA(0, 1), cA + hstep, voffA);
        if (wr == 1) PG8_BAR;
        PG8_WAIT_V(4); PG8_BAR;
        PG8_STAGE(PG8_SB(1, 0), cB + kstep, voffB); PG8_STAGE(PG8_SA(1, 0), cA + kstep, voffA); PG8_STAGE(PG8_SB(1, 1), cB + hstep + kstep, voffB);
        PG8_WAIT_V(6); PG8_BAR;
    }
    for (;;) {
        const bool has_next = S.next(ui + 1, nxt);
        const char* nA = has_next ? (const char*)g.A + (size_t)nxt.pm * tstep : cA; const char* nB = has_next ? (const char*)g.Bt + (size_t)nxt.pn * tstep : cB;
        int t = 0;
#pragma unroll 1
        for (int sgi = 0; sgi < (Epi::SEG ? 3 : 1); ++sgi) {
        int tend = nt; if constexpr (Epi::SEG) tend = (sgi == 0) ? Epi::SEG_T1 : ((sgi == 1) ? Epi::SEG_T2 : nt);
        for (; t < tend; t += 2) {
            const bool last = (t == nt - 2);
            const char* a1 = cA + (size_t)(t + 1) * kstep;
            const char* a2 = last ? nA : cA + (size_t)(t + 2) * kstep; const char* b2 = last ? nB : cB + (size_t)(t + 2) * kstep;
            const char* a3 = a2 + kstep; const char* b3 = b2 + kstep;
            if (last && has_next) S.a_ready(nxt);
            if constexpr (SP2) {
            PG8_LDB(B0, 0, 0); PG8_LDB(B1, 0, 1); PG8_SCHED; PG8_LDA(At, 0, 0); PG8_STAGE(PG8_SA(1, 1), a1 + hstep, voffA);
            PG8_WAIT_V(8); PG8_WAIT_L(0); PG8_BAR; PG8_MMA(0, 0, At, B0); PG8_MMA(0, 1, At, B1); PG8_BAR; PG8_SCHED;
            PG8_LDA(At, 0, 1); PG8_STAGE(PG8_SB(0, 0), b2, voffB); PG8_STAGE(PG8_SB(0, 1), b2 + hstep, voffB); PG8_STAGE(PG8_SA(0, 0), a2, voffA);
            PG8_WAIT_V(8); PG8_WAIT_L(0); PG8_BAR; PG8_MMA(1, 0, At, B0); PG8_MMA(1, 1, At, B1); PG8_BAR; PG8_SCHED;
            PG8_LDB(B0, 1, 0); PG8_LDB(B1, 1, 1); PG8_SCHED; PG8_LDA(At, 1, 0); PG8_STAGE(PG8_SA(0, 1), a2 + hstep, voffA);
            PG8_WAIT_V(8); PG8_WAIT_L(0); PG8_BAR; PG8_MMA(0, 0, At, B0); PG8_MMA(0, 1, At, B1); PG8_BAR; PG8_SCHED;
            PG8_LDA(At, 1, 1); PG8_STAGE(PG8_SB(1, 0), b3, voffB); PG8_STAGE(PG8_SB(1, 1), b3 + hstep, voffB); PG8_STAGE(PG8_SA(1, 0), a3, voffA);
            PG8_WAIT_V(8); PG8_WAIT_L(0); PG8_BAR; PG8_MMA(1, 0, At, B0); PG8_MMA(1, 1, At, B1); PG8_BAR; PG8_SCHED;
            } else {
            PG8_LDB(B0, 0, 0); PG8_SCHED; PG8_LDA(At, 0, 0); PG8_STAGE(PG8_SA(1, 1), a1 + hstep, voffA);
            PG8_WAIT_L(8); PG8_BAR; PG8_WAIT_L(0); PG8_MMA(0, 0, At, B0); PG8_BAR; PG8_SCHED;
            PG8_LDB(B1, 0, 1); PG8_STAGE(PG8_SB(0, 0), b2, voffB);
            PG8_BAR; PG8_WAIT_L(0); PG8_MMA(0, 1, At, B1); PG8_BAR;
            PG8_LDA(At, 0, 1); PG8_STAGE(PG8_SA(0, 0), a2, voffA);
            PG8_BAR; PG8_WAIT_L(0); PG8_MMA(1, 0, At, B0); PG8_BAR; PG8_SCHED;
            PG8_STAGE(PG8_SB(0, 1), b2 + hstep, voffB);
            PG8_WAIT_V(6); PG8_BAR; PG8_MMA(1, 1, At, B1); PG8_BAR;
            PG8_LDB(B0, 1, 0); PG8_SCHED; PG8_LDA(At, 1, 0); PG8_STAGE(PG8_SA(0, 1), a2 + hstep, voffA);
            PG8_WAIT_L(8); PG8_BAR; PG8_WAIT_L(0); PG8_MMA(0, 0, At, B0); PG8_BAR; PG8_SCHED;
            PG8_LDB(B1, 1, 1); PG8_STAGE(PG8_SB(1, 0), b3, voffB);
            PG8_BAR; PG8_WAIT_L(0); PG8_MMA(0, 1, At, B1); PG8_BAR;
            PG8_LDA(At, 1, 1); PG8_STAGE(PG8_SA(1, 0), a3, voffA);
            PG8_BAR; PG8_WAIT_L(0); PG8_MMA(1, 0, At, B0); PG8_BAR; PG8_SCHED;
            PG8_STAGE(PG8_SB(1, 1), b3 + hstep, voffB);
            PG8_WAIT_V(6); PG8_BAR; PG8_MMA(1, 1, At, B1); PG8_BAR;
            }
        }
        if constexpr (Epi::SEG) E.seg_apply(acc, segr, sgi);
        }
        if constexpr (ALIGN_EPI) { if (wr == 0) PG8_BAR; }
        if constexpr (!Epi::AFTER_DRAIN) { if constexpr (Epi::SEG) E(acc, cur, wr, wc, fr, fq, ui); else E(acc, cur, wr, wc, fr, fq); S.done(cur); }
        if (!has_next) break;
#pragma unroll
        for (int a = 0; a < 2; ++a)
#pragma unroll
            for (int b = 0; b < 2; ++b)
#pragma unroll
                for (int m = 0; m < 4; ++m)
#pragma unroll
                    for (int n = 0; n < 2; ++n) acc[a][b][m][n] = (f32x4){0.f, 0.f, 0.f, 0.f};
        cur = nxt; cA = nA; cB = nB; ++ui;
        if constexpr (Epi::SEG) E.seg_load(ui, wr, fr, segr);
        if constexpr (ALIGN_EPI) { if (wr == 1) PG8_BAR; }
    }
    PG8_WAIT_V(0);
    if constexpr (!ALIGN_EPI) { if (wr == 0) PG8_BAR; }
    PG8_BAR;
    if constexpr (Epi::AFTER_DRAIN) { E.fused(acc, cur, wr, wc, fr, fq, lds, wid, lane); S.done(cur); }
#undef PG8_SA
#undef PG8_SB
#undef PG8_STAGE
#undef PG8_LDA
#undef PG8_LDB
#undef PG8_MMA
#undef PG8_WAIT_V
#undef PG8_WAIT_L
#undef PG8_BAR
#undef PG8_SCHED
}
}
#ifndef PG8_SP2
#define PG8_SP2 true
#endif
#ifndef PG8_ALIGN
#define PG8_ALIGN true
#endif

constexpr int BATCH = 8, SEQ = 2048, DM = 2048, MTOK = BATCH * SEQ;
constexpr int ATT_W = 1024, ATT_H = 8, ATT_HD = 128, MOBA_BLK = 256, NBLK = SEQ / MOBA_BLK;
constexpr int SSM_W = 1024, SSM_H = 16, SSM_P = 64, SSM_N = 128, SSM_L = 128, SSM_NC = SEQ / SSM_L, CONV_CH = 1536;
constexpr int IN_PROJ = 5648, NPROJ = 5632  , NPAD = 5888  ;
constexpr int F8_LO = 2048, F8_HI = 4096, NB16 = NPAD - (F8_HI - F8_LO)  ;
constexpr float SH8 = 16.f;
constexpr int COL_Q = 0, COL_K = 1024, COL_V = 2048, COL_Z = 3072, COL_XBC = 4096;
constexpr int PEER_H = 8, PEER_NK = 128, PEER_K = 16, PEER_HK = 128;
constexpr float EPS = 1e-6f;
constexpr float SU = 64.f, SV = 4.f, SH = 16.f, SLO = 16.f;
constexpr float SX8 = 16.f, SW8 = 1024.f;
constexpr float SA8 = 32.f, SS8 = 8.f;
constexpr float SH4 = 1.5f, SLO4 = 4.f;
constexpr int ROWB = DM / 2;

constexpr size_t MiB = 1u << 20;
constexpr size_t WS_CTL = 0, CTL_ZERO_BYTES = 1 * MiB;
constexpr size_t WS_DT = 1 * MiB;
constexpr size_t WS_SK = 2 * MiB;
constexpr size_t WS_WIN = 4 * MiB;
constexpr size_t WS_WIN8 = 24 * MiB;
constexpr size_t WS_HN8 = 396 * MiB;
constexpr size_t WS_WOUT = 28 * MiB;
constexpr size_t WS_WQ = 36 * MiB;
constexpr size_t WS_HN = 44 * MiB;
constexpr size_t WS_PROJ = 108 * MiB;
constexpr size_t WS_X1B = WS_PROJ, WS_QP = WS_PROJ + 64 * MiB;
constexpr size_t WS_U8 = 284 * MiB, WS_V8 = 316 * MiB;
constexpr size_t WS_XBC = 348 * MiB;
constexpr size_t WS_DT2 = 3 * MiB;
constexpr size_t WS_X18 = 396 * MiB;
constexpr size_t WS_END = 428 * MiB;
constexpr int CW_BAR = 4096;
constexpr int CW_Q2 = 8192;
constexpr int CW_KMEAN = 32768;
constexpr int CW_SSQ = 131072;
static_assert((CW_SSQ + MTOK * 4) * 4 <= (int)CTL_ZERO_BYTES, "CTL words inside the memset region");

constexpr int RING_OFF = 0, RING_BYTES = 131072;
constexpr int LDSCTL_OFF = RING_BYTES, MISC_OFF = LDSCTL_OFF + 320;
constexpr int SEGTAB_OFF = LDSCTL_OFF + 1024;  static_assert(LDSCTL_OFF + 1024 + 3 * 256 * 16 <= 147456, "segment table inside the LDS allocation");
constexpr int LDS_BYTES = 147456;
constexpr int NWAVES = 8;

#define GAS __attribute__((address_space(1)))
#define LAS __attribute__((address_space(3)))
typedef unsigned short bf16;
typedef unsigned v4u __attribute__((ext_vector_type(4)));
typedef unsigned v2u __attribute__((ext_vector_type(2)));
typedef float f32x4 __attribute__((ext_vector_type(4)));
typedef float f32x2 __attribute__((ext_vector_type(2)));
typedef short bf16x8 __attribute__((ext_vector_type(8)));
typedef short s16x4 __attribute__((ext_vector_type(4)));
typedef GAS unsigned gu32;
#define RLX_AGENT __ATOMIC_RELAXED, __HIP_MEMORY_SCOPE_AGENT
#define LDS_WAIT() asm volatile("s_waitcnt lgkmcnt(0)" ::: "memory")
#define VM_WAIT() asm volatile("s_waitcnt vmcnt(0)" ::: "memory")
__device__ __forceinline__ unsigned f2bf(float f) { unsigned u = __builtin_bit_cast(unsigned, f); return (u + 0x7fffu + ((u >> 16) & 1u)) >> 16; }
typedef __bf16 bf16v2 __attribute__((ext_vector_type(2)));
__device__ __forceinline__ unsigned pk2(float lo, float hi) { bf16v2 v; v.x = (__bf16)lo; v.y = (__bf16)hi; return __builtin_bit_cast(unsigned, v); }
__device__ __forceinline__ float bflo(unsigned w) { return __builtin_bit_cast(float, w << 16); }
__device__ __forceinline__ float bfhi(unsigned w) { return __builtin_bit_cast(float, w & 0xffff0000u); }
__device__ __forceinline__ float wave_sum(float v) {
#pragma unroll
    for (int o = 1; o < 64; o <<= 1) v += __shfl_xor(v, o);
    return v;
}
__device__ __forceinline__ float silu_f(float x) { return x * __builtin_amdgcn_rcpf(1.f + __expf(-x)); }

#define XB_TMO      128
#define XB_XCNT(j)  (256  + 64 * (j))
#define XB_XSUB(j)  (1280 + 64 * (j))
#define XB_XGEN(j)  (2304 + 64 * (j))
#define XB_TOP      3328
#define XB_TOPGEN   3392
#define XCD_BAR_WORDS 3456
#define XB_SPIN_CAP (1u << 18)

__device__ __forceinline__ unsigned xb_ld(unsigned* p)              { return __hip_atomic_load(p, __ATOMIC_RELAXED, __HIP_MEMORY_SCOPE_AGENT); }
__device__ __forceinline__ unsigned xb_add(unsigned* p, unsigned v) { return __hip_atomic_fetch_add(p, v, __ATOMIC_RELAXED, __HIP_MEMORY_SCOPE_AGENT); }
__device__ __forceinline__ unsigned xb_xcc_id() { return (unsigned)__builtin_amdgcn_s_getreg((3 << 11) | 20) & 0xFu; }
#define XB_SPIN(cond, bar) do { unsigned _sp = 0; while (cond) { __builtin_amdgcn_s_sleep(1); \
    if ((++_sp & 255u) == 0u) { if (xb_ld(&(bar)[XB_TMO])) break; if (_sp > XB_SPIN_CAP) { atomicAdd(&(bar)[XB_TMO], 1u); break; } } } } while (0)

struct XcdBarrier {
    unsigned* bar; unsigned x;
    volatile LAS unsigned* st;
};
__device__ __forceinline__ XcdBarrier xcd_barrier_post(unsigned* bar, volatile LAS unsigned* st) {
    XcdBarrier b; b.bar = bar; b.x = xb_xcc_id(); b.st = st;
    if (threadIdx.x == 0) (void)xb_add(&bar[XB_XCNT(b.x)], 1u);
    return b;
}
__device__ __forceinline__ void xcd_barrier_complete(unsigned* bar, unsigned x, unsigned& nloc, unsigned& nx) {
    const unsigned G = gridDim.x * gridDim.y * gridDim.z;
    unsigned sum, cnt, mine, sp = 0u;
    for (;;) {
        sum = 0u; cnt = 0u; mine = 0u;
#pragma unroll
        for (unsigned j = 0; j < 16; ++j) { const unsigned c = xb_ld(&bar[XB_XCNT(j)]); sum += c; cnt += (c > 0u) ? 1u : 0u; mine = (j == x) ? c : mine; }
        if (sum == G) break;
        __builtin_amdgcn_s_sleep(1);
        if ((++sp & 255u) == 0u) { if (xb_ld(&bar[XB_TMO])) break; if (sp > XB_SPIN_CAP) { atomicAdd(&bar[XB_TMO], 1u); break; } }
    }
    nloc = mine > 0u ? mine : 1u; nx = cnt > 0u ? cnt : 1u;
}
__device__ __forceinline__ void xcd_barrier(const XcdBarrier& b) {
    asm volatile("s_waitcnt vmcnt(0)" ::: "memory");
    __syncthreads();
    if (threadIdx.x == 0) {
        unsigned* bar = b.bar;
        __builtin_amdgcn_s_waitcnt(0);
        unsigned nloc = b.st[0], nx = b.st[1];
        if (nloc == 0u) { xcd_barrier_complete(bar, b.x, nloc, nx); b.st[0] = nloc; b.st[1] = nx; }
        const unsigned old = xb_add(&bar[XB_XSUB(b.x)], 1u);
        const unsigned gen = old / nloc;
        if (old + 1u == (gen + 1u) * nloc) {
            __builtin_amdgcn_fence(__ATOMIC_RELEASE, "agent");
            asm volatile("s_waitcnt vmcnt(0)" ::: "memory");
            const unsigned og = xb_add(&bar[XB_TOP], 1u);
            const unsigned tg = og / nx;
            if (og + 1u == (tg + 1u) * nx) xb_add(&bar[XB_TOPGEN], 1u);
            else XB_SPIN(xb_ld(&bar[XB_TOPGEN]) == tg, bar);
            __builtin_amdgcn_fence(__ATOMIC_ACQUIRE, "agent");
            xb_add(&bar[XB_XGEN(b.x)], 1u);
            asm volatile("s_waitcnt vmcnt(0)" ::: "memory");
        } else {
            XB_SPIN(xb_ld(&bar[XB_XGEN(b.x)]) == gen, bar);
            __builtin_amdgcn_fence(__ATOMIC_ACQUIRE, "agent");
            asm volatile("s_waitcnt vmcnt(0)" ::: "memory");
        }
    }
    __syncthreads();
}

#define CAS __attribute__((address_space(4)))
struct Args { const float* in[18]; float* out; unsigned char* ws; };
__device__ __forceinline__ const CAS unsigned char* kargs() { const CAS unsigned char* p = (const CAS unsigned char*)__builtin_amdgcn_kernarg_segment_ptr(); asm volatile("" : "+s"(p)); return p; }
__device__ __forceinline__ const float* kin(int i) { return *(const float* const CAS*)(kargs() + 8 * i); }
__device__ __forceinline__ float* kout() { return *(float* const CAS*)(kargs() + 8 * 18); }
__device__ __forceinline__ unsigned char* kws() { return *(unsigned char* const CAS*)(kargs() + 8 * 19); }
__device__ __forceinline__ int fresh_tid() { int t = threadIdx.x; asm volatile("" : "+v"(t)); return t; }
struct Frame {
    LAS unsigned char* lds;
    volatile LAS unsigned* MISC;
    int tid, lane, wave, G;
    __device__ __forceinline__ const float* x() const { return kin(0); }
    __device__ __forceinline__ const float* attn_norm() const { return kin(1); }
    __device__ __forceinline__ const float* w_in() const { return kin(2); }
    __device__ __forceinline__ const float* conv_w() const { return kin(3); }
    __device__ __forceinline__ const float* conv_b() const { return kin(4); }
    __device__ __forceinline__ const float* dt_bias() const { return kin(5); }
    __device__ __forceinline__ const float* a_log() const { return kin(6); }
    __device__ __forceinline__ const float* d_skip() const { return kin(7); }
    __device__ __forceinline__ const float* rel_bias() const { return kin(8); }
    __device__ __forceinline__ const float* attn_out_norm() const { return kin(9); }
    __device__ __forceinline__ const float* ssm_out_norm() const { return kin(10); }
    __device__ __forceinline__ const float* w_out() const { return kin(11); }
    __device__ __forceinline__ const float* ffn_norm() const { return kin(12); }
    __device__ __forceinline__ const float* peer_wq() const { return kin(13); }
    __device__ __forceinline__ const float* peer_sk() const { return kin(14); }
    __device__ __forceinline__ const float* peer_u() const { return kin(15); }
    __device__ __forceinline__ const float* peer_v() const { return kin(16); }
    __device__ __forceinline__ const float* final_norm() const { return kin(17); }
    __device__ __forceinline__ float* out() const { return kout(); }
    __device__ __forceinline__ unsigned* ctl() const { return (unsigned*)(kws() + WS_CTL); }
    __device__ __forceinline__ float* dtraw() const { return (float*)(kws() + WS_DT); }
    __device__ __forceinline__ bf16* SK() const { return (bf16*)(kws() + WS_SK); }
    __device__ __forceinline__ bf16* WinT() const { return (bf16*)(kws() + WS_WIN); }
    __device__ __forceinline__ bf16* WoutT() const { return (bf16*)(kws() + WS_WOUT); }
    __device__ __forceinline__ bf16* WqT() const { return (bf16*)(kws() + WS_WQ); }
    __device__ __forceinline__ bf16* HN() const { return (bf16*)(kws() + WS_HN); }
    __device__ __forceinline__ bf16* PROJ() const { return (bf16*)(kws() + WS_PROJ); }
    __device__ __forceinline__ bf16* X1B() const { return (bf16*)(kws() + WS_X1B); }
    __device__ __forceinline__ bf16* QP() const { return (bf16*)(kws() + WS_QP); }
    __device__ __forceinline__ unsigned char* U8() const { return kws() + WS_U8; }
    __device__ __forceinline__ unsigned char* V8() const { return kws() + WS_V8; }
    __device__ __forceinline__ unsigned char* X18() const { return kws() + WS_X18; }
    __device__ __forceinline__ unsigned char* HN8() const { return kws() + WS_HN8; }
    __device__ __forceinline__ unsigned char* WinT8() const { return kws() + WS_WIN8; }
    __device__ __forceinline__ bf16* XBC() const { return (bf16*)(kws() + WS_XBC); }
    __device__ __forceinline__ float* DT2() const { return (float*)(kws() + WS_DT2); }
    __device__ __forceinline__ float* kmean() const { return (float*)(kws() + WS_CTL) + CW_KMEAN; }
    __device__ __forceinline__ float* ssq() const { return (float*)(kws() + WS_CTL) + CW_SSQ; }
};

__device__ __forceinline__ float clampf(float v, float lim);
__device__ __forceinline__ void p0_transpose_item(const float* W, int K, int N, bf16* WT, const float* gain, LAS float* scr, int item, int lane, const float f8scale = 0.f, const int nshift = 0) {
    const int nblk = (N + 31) / 32, kb = item / nblk, nb = item % nblk, k0 = 64 * kb, n0 = 32 * nb;
    const int kr = lane >> 3, nc = (lane & 7) * 4; const bool ok = (n0 + nc) < N;
    f32x4 v[8]; float gk[8];
#pragma unroll
    for (int i = 0; i < 8; ++i) { const int kk = 8 * i + kr; v[i] = ok ? *(const GAS f32x4*)(W + (size_t)(k0 + kk) * N + n0 + nc) : (f32x4){0.f, 0.f, 0.f, 0.f}; gk[i] = gain ? gain[k0 + kk] : 1.f; }
#pragma unroll
    for (int i = 0; i < 8; ++i) { const int kk = 8 * i + kr; LAS float* d = scr + kk * 33 + nc; d[0] = v[i].x * gk[i]; d[1] = v[i].y * gk[i]; d[2] = v[i].z * gk[i]; d[3] = v[i].w * gk[i]; }
    LDS_WAIT(); asm volatile("" ::: "memory");
    const int c = lane & 7;
#pragma unroll
    for (int j = 0; j < 4; ++j) { const int n = (lane >> 3) + 8 * j; const LAS float* s = scr + (8 * c) * 33 + n;
        v4u o; o.x = pk2(s[0 * 33], s[1 * 33]); o.y = pk2(s[2 * 33], s[3 * 33]); o.z = pk2(s[4 * 33], s[5 * 33]); o.w = pk2(s[6 * 33], s[7 * 33]);
        if (f8scale == 0.f) *(GAS v4u*)(WT + (size_t)(n0 + n - nshift) * K + k0 + 8 * c) = o;
        else { v2u o8; int w_;
            w_ = __builtin_amdgcn_cvt_pk_fp8_f32(clampf(s[0 * 33] * f8scale, 448.f), clampf(s[1 * 33] * f8scale, 448.f), 0, false); w_ = __builtin_amdgcn_cvt_pk_fp8_f32(clampf(s[2 * 33] * f8scale, 448.f), clampf(s[3 * 33] * f8scale, 448.f), w_, true); o8.x = (unsigned)w_;
            w_ = __builtin_amdgcn_cvt_pk_fp8_f32(clampf(s[4 * 33] * f8scale, 448.f), clampf(s[5 * 33] * f8scale, 448.f), 0, false); w_ = __builtin_amdgcn_cvt_pk_fp8_f32(clampf(s[6 * 33] * f8scale, 448.f), clampf(s[7 * 33] * f8scale, 448.f), w_, true); o8.y = (unsigned)w_;
            *(GAS v2u*)((unsigned char*)WT + (size_t)(n0 + n - nshift) * K + k0 + 8 * c) = o8; } }
    LDS_WAIT(); asm volatile("" ::: "memory");
}
__device__ __forceinline__ unsigned pk4_fp8(float a, float b, float c, float d) { int w = __builtin_amdgcn_cvt_pk_fp8_f32(clampf(a, 448.f), clampf(b, 448.f), 0, false); w = __builtin_amdgcn_cvt_pk_fp8_f32(clampf(c, 448.f), clampf(d, 448.f), w, true); return (unsigned)w; }
__device__ __forceinline__ void rms_2rows_to_bf16(const float* x0, const float* x1, const float* gain, bf16* o0, bf16* o1, unsigned char* q0, unsigned char* q1, int lane) {
    const GAS f32x4* xr0 = (const GAS f32x4*)x0 + lane; const GAS f32x4* xr1 = (const GAS f32x4*)x1 + lane; const GAS f32x4* gr = (const GAS f32x4*)gain + lane;
    f32x4 v[8], u[8]; float s = 0.f, t = 0.f;
#pragma unroll
    for (int j = 0; j < 8; ++j) { v[j] = xr0[64 * j]; u[j] = xr1[64 * j]; }
#pragma unroll
    for (int j = 0; j < 8; ++j) { s += (v[j].x * v[j].x + v[j].y * v[j].y) + (v[j].z * v[j].z + v[j].w * v[j].w); t += (u[j].x * u[j].x + u[j].y * u[j].y) + (u[j].z * u[j].z + u[j].w * u[j].w); }
    const float rs = __builtin_amdgcn_rsqf(wave_sum(s) * (1.f / DM) + EPS), rt = __builtin_amdgcn_rsqf(wave_sum(t) * (1.f / DM) + EPS);
    GAS v2u* p0 = (GAS v2u*)o0 + lane; GAS v2u* p1 = (GAS v2u*)o1 + lane; GAS unsigned* r0 = (GAS unsigned*)q0 + lane; GAS unsigned* r1 = (GAS unsigned*)q1 + lane;
#pragma unroll
    for (int j = 0; j < 8; ++j) { const f32x4 g = gr[64 * j]; v2u a, b;
        const f32x4 h0 = v[j] * g * rs, h1 = u[j] * g * rt;
        a.x = pk2(h0.x, h0.y); a.y = pk2(h0.z, h0.w); p0[64 * j] = a; r0[64 * j] = pk4_fp8(h0.x * SH8, h0.y * SH8, h0.z * SH8, h0.w * SH8);
        b.x = pk2(h1.x, h1.y); b.y = pk2(h1.z, h1.w); p1[64 * j] = b; r1[64 * j] = pk4_fp8(h1.x * SH8, h1.y * SH8, h1.z * SH8, h1.w * SH8); }
}
#ifdef PROBE_FP4EMU
__device__ __forceinline__ float fp4grid(float y) { const float a = fabsf(y); float r;
    if (a <= 2.f) r = rintf(a * 2.f) * 0.5f; else if (a <= 4.f) r = rintf(a); else r = (a < 5.f) ? 4.f : 6.f;
    return copysignf(r, y); }
__device__ __forceinline__ float clampf(float v, float lim) { if (lim == 448.5f) return fp4grid(v * (1.f / 16.f)) * 16.f; return fminf(fmaxf(v, -lim), lim); }
#else
__device__ __forceinline__ float clampf(float v, float lim) { return fminf(fmaxf(v, -lim), lim); }
#endif
template <int TAB = 0> __device__ __forceinline__ v4u cvt16_fp8(const f32x4 a, const f32x4 b, const f32x4 c, const f32x4 d, float sc) {
    v4u o; int w; constexpr float LIM = TAB ? 448.5f : 448.f;
    w = __builtin_amdgcn_cvt_pk_fp8_f32(clampf(a.x * sc, LIM), clampf(a.y * sc, LIM), 0, false); w = __builtin_amdgcn_cvt_pk_fp8_f32(clampf(a.z * sc, LIM), clampf(a.w * sc, LIM), w, true); o.x = (unsigned)w;
    w = __builtin_amdgcn_cvt_pk_fp8_f32(clampf(b.x * sc, LIM), clampf(b.y * sc, LIM), 0, false); w = __builtin_amdgcn_cvt_pk_fp8_f32(clampf(b.z * sc, LIM), clampf(b.w * sc, LIM), w, true); o.y = (unsigned)w;
    w = __builtin_amdgcn_cvt_pk_fp8_f32(clampf(c.x * sc, LIM), clampf(c.y * sc, LIM), 0, false); w = __builtin_amdgcn_cvt_pk_fp8_f32(clampf(c.z * sc, LIM), clampf(c.w * sc, LIM), w, true); o.z = (unsigned)w;
    w = __builtin_amdgcn_cvt_pk_fp8_f32(clampf(d.x * sc, LIM), clampf(d.y * sc, LIM), 0, false); w = __builtin_amdgcn_cvt_pk_fp8_f32(clampf(d.z * sc, LIM), clampf(d.w * sc, LIM), w, true); o.w = (unsigned)w;
    return o;
}
__device__ __forceinline__ void tables_convert(Frame& F, size_t lo, size_t hi, size_t tix, size_t ntx) {
      const GAS f32x4* su = (const GAS f32x4*)F.peer_u(); const GAS f32x4* sv = (const GAS f32x4*)F.peer_v(); GAS v4u* du = (GAS v4u*)F.U8(); GAS v4u* dv = (GAS v4u*)F.V8();
#pragma unroll 1
      for (int tab = 0; tab < 2; ++tab) { const GAS f32x4* src = tab ? sv : su; GAS v4u* dst = tab ? dv : du; const float sc = tab ? SV : SU;
        f32x4 nx[8]; const size_t i0 = lo + tix;
        if (i0 < hi) { const GAS f32x4* p = src + (i0 >> 6) * 512 + (i0 & 63);
#pragma unroll
            for (int j = 0; j < 8; ++j) nx[j] = p[64 * j]; }
#pragma unroll 1
        for (size_t i = i0; i < hi; i += ntx) { f32x4 v[8];
#pragma unroll
            for (int j = 0; j < 8; ++j) v[j] = nx[j];
            if (i + ntx < hi) { const size_t i2 = i + ntx; const GAS f32x4* p = src + (i2 >> 6) * 512 + (i2 & 63);
#pragma unroll
                for (int j = 0; j < 8; ++j) nx[j] = p[64 * j]; }
            unsigned wd[4];
#pragma unroll
            for (int q = 0; q < 4; ++q) { const f32x4 a = v[2 * q] * sc, b = v[2 * q + 1] * sc; unsigned w = 0u;
                w = __builtin_amdgcn_cvt_scalef32_pk_fp4_f32(w, clampf(a.x, 6.f), clampf(a.y, 6.f), 1.0f, 0); w = __builtin_amdgcn_cvt_scalef32_pk_fp4_f32(w, clampf(a.z, 6.f), clampf(a.w, 6.f), 1.0f, 1);
                w = __builtin_amdgcn_cvt_scalef32_pk_fp4_f32(w, clampf(b.x, 6.f), clampf(b.y, 6.f), 1.0f, 2); w = __builtin_amdgcn_cvt_scalef32_pk_fp4_f32(w, clampf(b.z, 6.f), clampf(b.w, 6.f), 1.0f, 3); wd[q] = w; }
            dst[i] = (v4u){wd[0], wd[1], wd[2], wd[3]}; } }
}
constexpr size_t TAB_ITEMS = (size_t)16384 * 64;
#ifndef TAB_HEAD8
#define TAB_HEAD8 4
#endif
__device__ __forceinline__ size_t tab_split(int G) { const int rem = ((MTOK / 256) * (NB16 / 256)) % G; return rem ? (TAB_ITEMS / 8) * TAB_HEAD8 : TAB_ITEMS; }
__device__ __forceinline__ unsigned fp4_code(float y) { const float a = fabsf(y);
    const unsigned m = (unsigned)(a >= 0.25f) + (unsigned)(a >= 0.75f) + (unsigned)(a >= 1.25f) + (unsigned)(a >= 1.75f) + (unsigned)(a >= 2.5f) + (unsigned)(a >= 3.5f) + (unsigned)(a >= 5.0f);
    return m | ((y < 0.f) ? 8u : 0u); }
constexpr int W_SQ_ITEMS = (DM / 64) * (DM / 32), W_SQ_PER_UNIT = 64, W_SQ_UNITS = 2 * W_SQ_ITEMS / W_SQ_PER_UNIT;
__device__ __forceinline__ void sq_weight_items(Frame& F, int unit) {
    const int tid = fresh_tid(), lane = tid & 63, wave = __builtin_amdgcn_readfirstlane(tid >> 6);
    LAS float* scr = (LAS float*)(F.lds + RING_OFF + wave * 16384);
    const float* const w_out = F.w_out(); const float* const wq = F.peer_wq(); const float* const fg = F.ffn_norm(); bf16* const WoutT = F.WoutT(); bf16* const WqT = F.WqT(); const float* const gatt = F.attn_out_norm(); const float* const gssm = F.ssm_out_norm();
#pragma unroll 1
    for (int k = 0; k < W_SQ_PER_UNIT / NWAVES; ++k) {
        int r = unit * W_SQ_PER_UNIT + k * NWAVES + wave;
        if (r < W_SQ_ITEMS) { const int k0_ = 64 * (r / (DM / 32)); p0_transpose_item(w_out, DM, DM, WoutT, (k0_ < ATT_W) ? gatt : (gssm - ATT_W), scr, r, lane, SW8); }
        else { r -= W_SQ_ITEMS; p0_transpose_item(wq, DM, DM, WqT, fg, scr, r, lane, SW8); }
    }
}
__device__ __forceinline__ void p0_prologue(Frame& F) {
    const int tid = fresh_tid(), lane = tid & 63, wave = __builtin_amdgcn_readfirstlane(tid >> 6);
    LAS float* scr = (LAS float*)(F.lds + RING_OFF + wave * 16384);
    const int gw = blockIdx.x * NWAVES + wave, NGW = F.G * NWAVES;
    constexpr int I_IN = (DM / 64) * ((IN_PROJ + 31) / 32), I_SQ = (DM / 64) * (DM / 32);
    constexpr int NITEMS = I_IN;
    { const float* const w_in = F.w_in(); const float* const w_out = F.w_out(); const float* const wq = F.peer_wq(); const float* const fg = F.ffn_norm(); bf16* const WinT = F.WinT(); unsigned char* const WinT8 = F.WinT8(); bf16* const WoutT = F.WoutT(); bf16* const WqT = F.WqT(); const float* const gatt = F.attn_out_norm(); const float* const gssm = F.ssm_out_norm();
      for (int it = gw; it < NITEMS; it += NGW) {
        int r = it;
        if (r < I_IN) { const int n0_ = 32 * (r % ((IN_PROJ + 31) / 32));
            if (n0_ >= F8_LO && n0_ < F8_HI) p0_transpose_item(w_in, DM, IN_PROJ, (bf16*)WinT8, nullptr, scr, r, lane, SW8, F8_LO);
            else p0_transpose_item(w_in, DM, IN_PROJ, WinT, nullptr, scr, r, lane, 0.f, (n0_ >= F8_HI) ? (F8_HI - F8_LO) : 0);
            continue; } r -= I_IN;
      } }
    const size_t gt = (size_t)blockIdx.x * (NWAVES * 64) + tid, GT = (size_t)F.G * NWAVES * 64;
    { const size_t z0 = (size_t)(5664 - (F8_HI - F8_LO)) * DM / 8, z1 = (size_t)NB16 * DM / 8; GAS v4u* p = (GAS v4u*)F.WinT(); for (size_t i = z0 + gt; i < z1; i += GT) p[i] = (v4u){0u, 0u, 0u, 0u}; }
    { const GAS f32x4* s = (const GAS f32x4*)F.peer_sk(); GAS v2u* d = (GAS v2u*)F.SK(); for (size_t i = gt; i < (size_t)16 * 128 * 128 / 4; i += GT) { const f32x4 v = s[i]; v2u o; o.x = pk2(v.x, v.y); o.y = pk2(v.z, v.w); d[i] = o; } }
    { const float* const xg = F.x(); const float* const gn = F.attn_norm(); bf16* const hn = F.HN(); unsigned char* const hn8 = F.HN8();
      for (int m = gw; m < MTOK / 2; m += NGW) rms_2rows_to_bf16(xg + (size_t)(2 * m) * DM, xg + (size_t)(2 * m + 1) * DM, gn, hn + (size_t)(2 * m) * DM, hn + (size_t)(2 * m + 1) * DM, hn8 + (size_t)(2 * m) * DM, hn8 + (size_t)(2 * m + 1) * DM, lane); }
}

struct EpiProj {
    static constexpr bool PERM = true, AFTER_DRAIN = false, SEG = false;
    bf16* O; float* dtraw; float* kmean;
    __device__ __forceinline__ void operator()(const pg8::f32x4 (&acc)[2][2][4][2], const pg8::Unit& u, int wr, int wc, int fr, int fq) const {
        const int rpn = (u.pn < F8_LO / 256) ? u.pn : u.pn + (F8_HI - F8_LO) / 256;
        const int row0 = u.pm * 256 + wr * 64 + fr, col0 = rpn * 256 + wc * 32 + 8 * fq;
        if (rpn < 22) {
#pragma unroll
            for (int ai = 0; ai < 2; ++ai)
#pragma unroll
                for (int m = 0; m < 4; ++m) { bf16* rowp = O + (size_t)(row0 + ai * 128 + m * 16) * NPROJ + col0;
#pragma unroll
                    for (int bj = 0; bj < 2; ++bj) { const pg8::f32x4 v0 = acc[ai][bj][m][0], v1 = acc[ai][bj][m][1];
                        pg8::u32x4 w; w.x = pg8::cvt_pk_bf16(v0[0], v0[1]); w.y = pg8::cvt_pk_bf16(v0[2], v0[3]); w.z = pg8::cvt_pk_bf16(v1[0], v1[1]); w.w = pg8::cvt_pk_bf16(v1[2], v1[3]);
                        *(pg8::u32x4*)(rowp + bj * 128) = w; } }
        } else if (wc == 0 && fq < 2) {
#pragma unroll
            for (int ai = 0; ai < 2; ++ai)
#pragma unroll
                for (int m = 0; m < 4; ++m) { float* rp = dtraw + (size_t)(row0 + ai * 128 + m * 16) * 16 + 8 * fq;
                    *(pg8::f32x4*)rp = acc[ai][0][m][0]; *(pg8::f32x4*)(rp + 4) = acc[ai][0][m][1]; }
        }
        if (kmean && u.pn >= 4 && u.pn < 8) {
#pragma unroll
            for (int bj = 0; bj < 2; ++bj)
#pragma unroll
                for (int n = 0; n < 2; ++n)
#pragma unroll
                    for (int i = 0; i < 4; ++i) { float s = 0.f;
#pragma unroll
                        for (int ai = 0; ai < 2; ++ai)
#pragma unroll
                            for (int m = 0; m < 4; ++m) s += acc[ai][bj][m][n][i];
                        s += __shfl_xor(s, 1); s += __shfl_xor(s, 2); s += __shfl_xor(s, 4); s += __shfl_xor(s, 8);
                        if (fr == 0) unsafeAtomicAdd(kmean + (size_t)u.pm * 1024 + (col0 - 1024) + bj * 128 + 4 * n + i, s); }
        }
    }
};
struct EpiProj8 {
    static constexpr bool PERM = true, AFTER_DRAIN = false, SEG = false;
    bf16* O;
    __device__ __forceinline__ void operator()(const pg8::f32x4 (&acc)[2][2][4][2], const pg8::Unit& u, int wr, int wc, int fr, int fq) const {
        const int row0 = u.pm * 256 + wr * 64 + fr, col0 = F8_LO + u.pn * 256 + wc * 32 + 8 * fq; constexpr float sc = 1.f / (SH8 * SW8);
#pragma unroll
        for (int ai = 0; ai < 2; ++ai)
#pragma unroll
            for (int m = 0; m < 4; ++m) { bf16* rowp = O + (size_t)(row0 + ai * 128 + m * 16) * NPROJ + col0;
#pragma unroll
                for (int bj = 0; bj < 2; ++bj) { const pg8::f32x4 v0 = acc[ai][bj][m][0] * sc, v1 = acc[ai][bj][m][1] * sc;
                    pg8::u32x4 w; w.x = pg8::cvt_pk_bf16(v0[0], v0[1]); w.y = pg8::cvt_pk_bf16(v0[2], v0[3]); w.z = pg8::cvt_pk_bf16(v1[0], v1[1]); w.w = pg8::cvt_pk_bf16(v1[2], v1[3]);
                    *(pg8::u32x4*)(rowp + bj * 128) = w; } }
    }
};
struct EpiOut {
    static constexpr bool PERM = true, AFTER_DRAIN = false, SEG = true; static constexpr int SEG_T1 = 8, SEG_T2 = 12;
    const float* x; bf16* x1b; unsigned char* x18; float* ssq; bool doatom; const LAS f32x4* tab;
    __device__ __forceinline__ void seg_load(int ui, int wr, int fr, float (&sr)[16]) const {
#pragma unroll
        for (int i = 0; i < 8; ++i) { const int r = (i >> 2) * 128 + wr * 64 + (i & 3) * 16 + fr; const f32x2 q = *(const LAS f32x2*)(tab + ui * 256 + r); sr[2 * i] = q.x; sr[2 * i + 1] = q.y; }
        asm volatile("s_waitcnt lgkmcnt(0)" ::: "memory");
    }
    __device__ __forceinline__ void seg_apply(pg8::f32x4 (&acc)[2][2][4][2], const float (&sr)[16], int which) const {
#pragma unroll
        for (int ai = 0; ai < 2; ++ai)
#pragma unroll
            for (int m = 0; m < 4; ++m) { const float f = (which == 0) ? sr[2 * (ai * 4 + m)] : ((which == 1) ? sr[2 * (ai * 4 + m) + 1] : 1.0f);
#pragma unroll
                for (int bj = 0; bj < 2; ++bj)
#pragma unroll
                    for (int n = 0; n < 2; ++n) acc[ai][bj][m][n] = acc[ai][bj][m][n] * f; }
    }
    __device__ __forceinline__ void operator()(const pg8::f32x4 (&acc)[2][2][4][2], const pg8::Unit& u, int wr, int wc, int fr, int fq, int ui) const {
        const int row0 = u.pm * 256 + wr * 64 + fr, col0 = u.pn * 256 + wc * 32 + 8 * fq;
#pragma unroll
        for (int ai = 0; ai < 2; ++ai)
#pragma unroll
            for (int m = 0; m < 4; ++m) { const int row = row0 + ai * 128 + m * 16; const size_t off = (size_t)row * DM + col0; float s = 0.f;
                const float s1 = (*(const LAS f32x4*)(tab + ui * 256 + ai * 128 + wr * 64 + m * 16 + fr)).z;
#pragma unroll
                for (int bj = 0; bj < 2; ++bj) {
                    const pg8::f32x4 a0 = *(const pg8::f32x4*)(x + off + bj * 128), a1 = *(const pg8::f32x4*)(x + off + bj * 128 + 4);
                    const pg8::f32x4 v0 = acc[ai][bj][m][0] * s1 + a0, v1 = acc[ai][bj][m][1] * s1 + a1;
                    pg8::u32x4 w; w.x = pg8::cvt_pk_bf16(v0[0], v0[1]); w.y = pg8::cvt_pk_bf16(v0[2], v0[3]); w.z = pg8::cvt_pk_bf16(v1[0], v1[1]); w.w = pg8::cvt_pk_bf16(v1[2], v1[3]);
                    *(pg8::u32x4*)(x1b + off + bj * 128) = w;
                    { v2u o8; int w_; w_ = __builtin_amdgcn_cvt_pk_fp8_f32(clampf(v0[0] * SX8, 448.f), clampf(v0[1] * SX8, 448.f), 0, false); w_ = __builtin_amdgcn_cvt_pk_fp8_f32(clampf(v0[2] * SX8, 448.f), clampf(v0[3] * SX8, 448.f), w_, true); o8.x = (unsigned)w_;
                      w_ = __builtin_amdgcn_cvt_pk_fp8_f32(clampf(v1[0] * SX8, 448.f), clampf(v1[1] * SX8, 448.f), 0, false); w_ = __builtin_amdgcn_cvt_pk_fp8_f32(clampf(v1[2] * SX8, 448.f), clampf(v1[3] * SX8, 448.f), w_, true); o8.y = (unsigned)w_;
                      *(v2u*)(x18 + off + bj * 128) = o8; }
                    s += (v0[0] * v0[0] + v0[1] * v0[1]) + (v0[2] * v0[2] + v0[3] * v0[3]) + (v1[0] * v1[0] + v1[1] * v1[1]) + (v1[2] * v1[2] + v1[3] * v1[3]); }
                s += __shfl_xor(s, 16); s += __shfl_xor(s, 32);
                if (fq == 0 && doatom) unsafeAtomicAdd(ssq + (size_t)row * 4, s);
                asm volatile("" ::: "memory"); }
    }
};
struct EpiQ {
    static constexpr bool PERM = true, AFTER_DRAIN = false, SEG = false;
    bf16* O; const float* ssq;
    __device__ __forceinline__ void operator()(const pg8::f32x4 (&acc)[2][2][4][2], const pg8::Unit& u, int wr, int wc, int fr, int fq) const {
        const int row0 = u.pm * 256 + wr * 64 + fr, col0 = u.pn * 256 + wc * 32 + 8 * fq;
#pragma unroll
        for (int ai = 0; ai < 2; ++ai)
#pragma unroll
            for (int m = 0; m < 4; ++m) { const int row = row0 + ai * 128 + m * 16; bf16* rowp = O + (size_t)row * DM + col0;
                const float rs = (1.f / (SX8 * SW8)) / sqrtf(__hip_atomic_load(ssq + (size_t)row * 4, RLX_AGENT) * (1.f / DM) + EPS);
#pragma unroll
                for (int bj = 0; bj < 2; ++bj) { const pg8::f32x4 v0 = acc[ai][bj][m][0] * rs, v1 = acc[ai][bj][m][1] * rs;
                    pg8::u32x4 w; w.x = pg8::cvt_pk_bf16(v0[0], v0[1]); w.y = pg8::cvt_pk_bf16(v0[2], v0[3]); w.z = pg8::cvt_pk_bf16(v1[0], v1[1]); w.w = pg8::cvt_pk_bf16(v1[2], v1[3]);
                    *(pg8::u32x4*)(rowp + bj * 128) = w; } }
    }
};

constexpr int A_KSTR = 272, A_VSTR = 288;
constexpr int A_KB0 = 0, A_KB1 = 64 * A_KSTR, A_VB0 = 2 * 64 * A_KSTR, A_VBS = 64 * A_VSTR  , A_KM = A_VB0 + 3 * A_VBS, A_TAB = A_KM + 8 * 128 * 4, A_END = A_TAB + 128 * 4;
static_assert(A_END <= RING_BYTES && (A_KM % 16) == 0, "attention LDS map");
#define PIN16(a, i) asm volatile("" : "+v"(a[i]), "+v"(a[i + 1]), "+v"(a[i + 2]), "+v"(a[i + 3]), "+v"(a[i + 4]), "+v"(a[i + 5]), "+v"(a[i + 6]), "+v"(a[i + 7]), "+v"(a[i + 8]), "+v"(a[i + 9]), "+v"(a[i + 10]), "+v"(a[i + 11]), "+v"(a[i + 12]), "+v"(a[i + 13]), "+v"(a[i + 14]), "+v"(a[i + 15]))
#define TR16(p) __builtin_amdgcn_ds_read_tr16_b64_v4i16((LAS s16x4*)(p))
#define MFMA16(a, b, c) __builtin_amdgcn_mfma_f32_16x16x32_bf16((a), (b), (c), 0, 0, 0)
__device__ __forceinline__ bf16x8 pack8(const float* v) {
    const unsigned a = pk2(v[0], v[1]), b = pk2(v[2], v[3]), c = pk2(v[4], v[5]), d = pk2(v[6], v[7]);
    const v4u u = {a, b, c, d}; return __builtin_bit_cast(bf16x8, u);
}
__device__ __forceinline__ void attn_unit(Frame& F, int b, int h, int blk, const bool doatom = true) {
    LAS unsigned char* lds = F.lds + RING_OFF;
    const int tid = fresh_tid(), lane = tid & 63, w = __builtin_amdgcn_readfirstlane(tid >> 6), g = lane >> 4, c16 = lane & 15, q4 = c16 >> 2, p4 = lane & 3;
    const int own = blk, t0 = blk * 256, tq0 = t0 + 32 * w + c16;
    const size_t rowbase = (size_t)b * SEQ;
    const float NEG_INF = -__builtin_inff();
    constexpr float LOG2E = 1.4426950408889634f, SCL2 = 0.08838834764831845f * 1.4426950408889634f;
    LAS float* km = (LAS float*)(lds + A_KM); LAS float* tab = (LAS float*)(lds + A_TAB);
    const bf16* const PROJ = F.PROJ(); const float* const kmg = F.kmean(); const float* const relb = F.rel_bias();
    for (int i = tid; i < own * 128; i += NWAVES * 64) { const int n = i >> 7, d = i & 127; km[i] = kmg[(size_t)(b * 8 + n) * 1024 + h * 128 + d] * (1.f / 256.f); }
    if (tid < 128) { const int rel = tid; int bucket = rel; if (rel >= 16) { bucket = 16 + (int)(log2f((float)rel * (1.f / 16.f)) * (16.f / 3.f)); bucket = bucket > 31 ? 31 : bucket; }
        tab[tid] = relb[bucket * 8 + h] * LOG2E; }
    bf16x8 qf[2][4];
#pragma unroll
    for (int gi = 0; gi < 2; ++gi) { const bf16* qrow = PROJ + (rowbase + tq0 + 16 * gi) * NPROJ + COL_Q + h * 128 + 8 * g;
#pragma unroll
      for (int ks = 0; ks < 4; ++ks) qf[gi][ks] = *(const GAS bf16x8*)(qrow + 32 * ks); }
    __syncthreads();
    unsigned selmask[2];
    if (own <= 3) { selmask[0] = (1u << own) - 1u; selmask[1] = selmask[0]; }
    else {
#pragma unroll
      for (int gi = 0; gi < 2; ++gi) {
        float gate[7];
#pragma unroll
        for (int n = 0; n < 7; ++n) {
            float s = NEG_INF;
            if (n < own) { s = 0.f;
#pragma unroll
                for (int ks = 0; ks < 4; ++ks) { const LAS f32x4* kp = (const LAS f32x4*)(km + n * 128 + 32 * ks + 8 * g); const f32x4 k0 = kp[0], k1 = kp[1]; const v4u qu = __builtin_bit_cast(v4u, qf[gi][ks]);
                    s += bflo(qu.x) * k0.x + bfhi(qu.x) * k0.y + bflo(qu.y) * k0.z + bfhi(qu.y) * k0.w + bflo(qu.z) * k1.x + bfhi(qu.z) * k1.y + bflo(qu.w) * k1.z + bfhi(qu.w) * k1.w; }
                s += __shfl_xor(s, 16); s += __shfl_xor(s, 32); }
            gate[n] = s;
        }
        unsigned sm = 0u;
#pragma unroll
        for (int r = 0; r < 3; ++r) { float best = NEG_INF; int bi = 0;
#pragma unroll
            for (int n = 0; n < 7; ++n) { const bool cand = (n < own) && !((sm >> n) & 1u) && (gate[n] > best); best = cand ? gate[n] : best; bi = cand ? n : bi; }
            sm |= 1u << bi; }
        selmask[gi] = sm; }
    }
    const int nT = 4 + 4 * own;
    const int sr = tid >> 3, sc = (tid & 7) * 16;
#define A_KEY0(i) ((i) < 4 ? own * 256 + 64 * (i) : (((i) - 4) >> 2) * 256 + (((i) - 4) & 3) * 64)
    v4u kr0, kr1, vr0, vr1;
#define A_LOAD(i) do { const bf16* kp_ = PROJ + (rowbase + A_KEY0(i) + sr) * NPROJ + COL_K + h * 128 + sc; \
        kr0 = *(const GAS v4u*)kp_; kr1 = *(const GAS v4u*)(kp_ + 8); vr0 = *(const GAS v4u*)(kp_ + (COL_V - COL_K)); vr1 = *(const GAS v4u*)(kp_ + (COL_V - COL_K) + 8); } while (0)
#define A_STORE(bufi) do { LAS unsigned char* kd_ = lds + ((bufi) ? A_KB1 : A_KB0) + sr * A_KSTR + sc * 2; LAS unsigned char* vd_ = lds + A_VB0 + vnx * A_VBS + sr * A_VSTR + sc * 2; \
        *(LAS v4u*)kd_ = kr0; *(LAS v4u*)(kd_ + 16) = kr1; *(LAS v4u*)vd_ = vr0; *(LAS v4u*)(vd_ + 16) = vr1; } while (0)
    int vcur = 0, vnx = 0, vprev = 0;
#define A_PV(PF, Vb_) do { _Pragma("unroll") for (int s = 0; s < 2; ++s) { s16x4 vlo[8], vhi[8]; \
            _Pragma("unroll") for (int db = 0; db < 8; ++db) { LAS unsigned char* va = (Vb_) + (32 * s + 4 * g + q4) * A_VSTR + (16 * db + 4 * p4) * 2; vlo[db] = TR16(va); vhi[db] = TR16(va + 16 * A_VSTR); } \
            __builtin_amdgcn_sched_barrier(0); \
            _Pragma("unroll") for (int db = 0; db < 8; ++db) { const bf16x8 vf = __builtin_shufflevector(vlo[db], vhi[db], 0, 1, 2, 3, 4, 5, 6, 7); \
                oacc[0][db] = MFMA16(vf, PF[0][s], oacc[0][db]); oacc[1][db] = MFMA16(vf, PF[1][s], oacc[1][db]); } \
            __builtin_amdgcn_sched_barrier(0); } } while (0)
    A_LOAD(0); A_STORE(0);
    __syncthreads();
    const bool late = w >= 4;
    bf16x8 pfp[2][2]; bool skipp = true;
#pragma unroll
    for (int gi = 0; gi < 2; ++gi) { pfp[gi][0] = (bf16x8){0, 0, 0, 0, 0, 0, 0, 0}; pfp[gi][1] = pfp[gi][0]; }
    float m_run[2] = {NEG_INF, NEG_INF}, l_run[2] = {0.f, 0.f};
    f32x4 oacc[2][8];
#pragma unroll
    for (int gi = 0; gi < 2; ++gi)
#pragma unroll
        for (int db = 0; db < 8; ++db) oacc[gi][db] = (f32x4){0.f, 0.f, 0.f, 0.f};
    for (int i = 0; i < nT; ++i) {
        if (i + 1 < nT) A_LOAD(i + 1);
        vnx = (vcur == 2) ? 0 : vcur + 1;
        const int buf = i & 1, key0 = A_KEY0(i); const bool isown = i < 4; const int pblk = isown ? own : ((i - 4) >> 2);
        const bool skipw = isown && (64 * i > 32 * w + 31);
        if (late && !skipp) A_PV(pfp, lds + A_VB0 + vprev * A_VBS);
        bf16x8 pf[2][2];
        if (!skipw) {
        LAS unsigned char* Kb = lds + (buf ? A_KB1 : A_KB0);
        f32x4 sacc[2][4];
#pragma unroll
        for (int hf = 0; hf < 2; ++hf) { bf16x8 kf[8];
#pragma unroll
            for (int n2 = 0; n2 < 2; ++n2)
#pragma unroll
                for (int ks = 0; ks < 4; ++ks) kf[n2 * 4 + ks] = *(const LAS bf16x8*)(Kb + (16 * (2 * hf + n2) + c16) * A_KSTR + (32 * ks + 8 * g) * 2);
            __builtin_amdgcn_sched_barrier(0);
#pragma unroll
            for (int gi = 0; gi < 2; ++gi)
#pragma unroll
                for (int n2 = 0; n2 < 2; ++n2) { f32x4 a = (f32x4){0.f, 0.f, 0.f, 0.f};
#pragma unroll
                    for (int ks = 0; ks < 4; ++ks) a = MFMA16(kf[n2 * 4 + ks], qf[gi][ks], a);
                    sacc[gi][2 * hf + n2] = a; }
            __builtin_amdgcn_sched_barrier(0); }
        const bool far = (key0 + 63 + 128 <= t0 + 32 * w);
        const bool diag = isown && (64 * i + 63 > 32 * w);
#pragma unroll
        for (int gi = 0; gi < 2; ++gi) {
            const int tq = tq0 + 16 * gi; const bool sel = isown || ((selmask[gi] >> pblk) & 1u);
            float sv[16]; float mloc, m_new, alpha;
            if (far) {
                const float bfar = tab[127];
                float mx = fmaxf(fmaxf(sacc[gi][0][0], sacc[gi][0][1]), fmaxf(sacc[gi][0][2], sacc[gi][0][3]));
#pragma unroll
                for (int nb = 1; nb < 4; ++nb) mx = fmaxf(mx, fmaxf(fmaxf(sacc[gi][nb][0], sacc[gi][nb][1]), fmaxf(sacc[gi][nb][2], sacc[gi][nb][3])));
                mloc = sel ? (mx * SCL2 + bfar) : NEG_INF;
                mloc = fmaxf(mloc, __shfl_xor(mloc, 16)); mloc = fmaxf(mloc, __shfl_xor(mloc, 32));
                m_new = fmaxf(m_run[gi], mloc); alpha = __builtin_amdgcn_exp2f(m_run[gi] - m_new);
                const float cadd = sel ? (bfar - m_new) : NEG_INF;
#pragma unroll
                for (int nb = 0; nb < 4; ++nb)
#pragma unroll
                    for (int r = 0; r < 4; ++r) sv[nb * 4 + r] = __builtin_amdgcn_exp2f(sacc[gi][nb][r] * SCL2 + cadd);
            } else {
                const int relb = tq - key0 - 4 * g; float bias[16];
#pragma unroll
                for (int nb = 0; nb < 4; ++nb)
#pragma unroll
                    for (int r = 0; r < 4; ++r) { const int rel = relb - 16 * nb - r; int ri = rel < 0 ? 0 : rel; ri = ri > 127 ? 127 : ri; bias[nb * 4 + r] = tab[ri]; }
                PIN16(bias, 0);
                mloc = NEG_INF;
#pragma unroll
                for (int nb = 0; nb < 4; ++nb)
#pragma unroll
                    for (int r = 0; r < 4; ++r) { const int rel = relb - 16 * nb - r;
                        float s = sacc[gi][nb][r] * SCL2 + bias[nb * 4 + r]; s = (!sel || (diag && rel < 0)) ? NEG_INF : s; sv[nb * 4 + r] = s; mloc = fmaxf(mloc, s); }
                mloc = fmaxf(mloc, __shfl_xor(mloc, 16)); mloc = fmaxf(mloc, __shfl_xor(mloc, 32));
                m_new = fmaxf(m_run[gi], mloc); alpha = __builtin_amdgcn_exp2f(m_run[gi] - m_new);
#pragma unroll
                for (int e = 0; e < 16; ++e) sv[e] = __builtin_amdgcn_exp2f(sv[e] - m_new);
            }
            float psum = 0.f;
#pragma unroll
            for (int e = 0; e < 16; ++e) psum += sv[e];
            l_run[gi] = l_run[gi] * alpha + psum; m_run[gi] = m_new;
#pragma unroll
            for (int db = 0; db < 8; ++db) oacc[gi][db] = oacc[gi][db] * alpha;
            pf[gi][0] = pack8(sv); pf[gi][1] = pack8(sv + 8);
        }
        __builtin_amdgcn_sched_barrier(0);
        if (!late) A_PV(pf, lds + A_VB0 + vcur * A_VBS);
        }
        if (late) { skipp = skipw;
#pragma unroll
            for (int gi = 0; gi < 2; ++gi) { pfp[gi][0] = pf[gi][0]; pfp[gi][1] = pf[gi][1]; } }
        if (i + 1 < nT) A_STORE((i + 1) & 1);
        vprev = vcur; vcur = vnx;
        __syncthreads();
    }
    if (late && !skipp) A_PV(pfp, lds + A_VB0 + vprev * A_VBS);
#undef A_PV
    bf16* const MIXp = F.HN(); float* const ssqp = F.ssq();
#pragma unroll
    for (int gi = 0; gi < 2; ++gi) {
        const int tq = tq0 + 16 * gi;
        float l_tot = l_run[gi]; l_tot += __shfl_xor(l_tot, 16); l_tot += __shfl_xor(l_tot, 32);
        const float inv = 1.f / l_tot; float ssq = 0.f;
        unsigned char* orow = (unsigned char*)MIXp + (rowbase + tq) * DM + h * 128 + 4 * g;
#pragma unroll
        for (int db = 0; db < 8; ++db) { const f32x4 o = oacc[gi][db] * inv; ssq += (o.x * o.x + o.y * o.y) + (o.z * o.z + o.w * o.w); *(GAS unsigned*)(orow + 16 * db) = pk4_fp8(o.x * SA8, o.y * SA8, o.z * SA8, o.w * SA8); }
        ssq += __shfl_xor(ssq, 16); ssq += __shfl_xor(ssq, 32);
        if (g == 0 && doatom) unsafeAtomicAdd(ssqp + (rowbase + tq) * 4 + 1, ssq);
    }
#undef A_KEY0
#undef A_LOAD
#undef A_STORE
}

constexpr int XBC_W = CONV_CH;
__device__ __forceinline__ void conv_phase(Frame& F) {
    const bf16* const PROJ = F.PROJ(); bf16* const XBC = F.XBC(); const float* const cw = F.conv_w(); const float* const cb = F.conv_b();
    const int gt = blockIdx.x * (NWAVES * 64) + fresh_tid(), GT = F.G * NWAVES * 64;
    for (int task = gt; task < (MTOK / 32) * (CONV_CH / 8); task += GT) {
        const int r = task / (CONV_CH / 8), k = task % (CONV_CH / 8), ch = 8 * k, tok0 = 32 * r;
        float wv[4][8], bias[8];
#pragma unroll
        for (int t = 0; t < 4; ++t) { const f32x4 w0 = *(const GAS f32x4*)(cw + t * CONV_CH + ch), w1 = *(const GAS f32x4*)(cw + t * CONV_CH + ch + 4);
            wv[t][0] = w0.x; wv[t][1] = w0.y; wv[t][2] = w0.z; wv[t][3] = w0.w; wv[t][4] = w1.x; wv[t][5] = w1.y; wv[t][6] = w1.z; wv[t][7] = w1.w; }
        { const f32x4 b0 = *(const GAS f32x4*)(cb + ch), b1 = *(const GAS f32x4*)(cb + ch + 4); bias[0] = b0.x; bias[1] = b0.y; bias[2] = b0.z; bias[3] = b0.w; bias[4] = b1.x; bias[5] = b1.y; bias[6] = b1.z; bias[7] = b1.w; }
        const bf16* src = PROJ + (size_t)tok0 * NPROJ + COL_XBC + ch; bf16* dst = XBC + (size_t)tok0 * XBC_W + ch;
        v4u p0 = (v4u){0u, 0u, 0u, 0u}, p1 = p0, p2 = p0;
        if ((tok0 & (SEQ - 1)) != 0) { p0 = *(const GAS v4u*)(src - 3 * (ptrdiff_t)NPROJ); p1 = *(const GAS v4u*)(src - 2 * (ptrdiff_t)NPROJ); p2 = *(const GAS v4u*)(src - (ptrdiff_t)NPROJ); }
#pragma unroll 1
        for (int i0 = 0; i0 < 32; i0 += 8) {
            v4u cur[8];
#pragma unroll
            for (int i = 0; i < 8; ++i) cur[i] = *(const GAS v4u*)(src + (size_t)(i0 + i) * NPROJ);
#pragma unroll
            for (int i = 0; i < 8; ++i) {
                const v4u c = cur[i]; float acc[8];
                const unsigned a0[4] = {p0.x, p0.y, p0.z, p0.w}, a1[4] = {p1.x, p1.y, p1.z, p1.w}, a2[4] = {p2.x, p2.y, p2.z, p2.w}, a3[4] = {c.x, c.y, c.z, c.w};
#pragma unroll
                for (int j = 0; j < 4; ++j) {
                    acc[2 * j] = bias[2 * j] + wv[0][2 * j] * bflo(a0[j]) + wv[1][2 * j] * bflo(a1[j]) + wv[2][2 * j] * bflo(a2[j]) + wv[3][2 * j] * bflo(a3[j]);
                    acc[2 * j + 1] = bias[2 * j + 1] + wv[0][2 * j + 1] * bfhi(a0[j]) + wv[1][2 * j + 1] * bfhi(a1[j]) + wv[2][2 * j + 1] * bfhi(a2[j]) + wv[3][2 * j + 1] * bfhi(a3[j]); }
#pragma unroll
                for (int j = 0; j < 8; ++j) acc[j] = silu_f(acc[j]);
                v4u o; o.x = pk2(acc[0], acc[1]); o.y = pk2(acc[2], acc[3]); o.z = pk2(acc[4], acc[5]); o.w = pk2(acc[6], acc[7]);
                *(GAS v4u*)(dst + (size_t)(i0 + i) * XBC_W) = o;
                p0 = p1; p1 = p2; p2 = c; }
        }
    }
    { const float* const dtraw = F.dtraw(); float* const dt2 = F.DT2(); const float* const dtb = F.dt_bias();
      for (int i = gt; i < MTOK * 16; i += GT) { const float xr = dtraw[i] + dtb[i & 15]; dt2[i] = xr > 20.f ? xr : log1pf(__expf(xr)); } }
}

constexpr int S_BSTR = 272, S_XSTR = 144;
constexpr int S_BM = 0, S_CM = 128 * S_BSTR, S_X = 2 * 128 * S_BSTR, S_XW = S_X + 128 * S_XSTR, S_HB = S_XW + 128 * S_XSTR, S_DT = S_HB + 64 * S_BSTR, S_CS = S_DT + 512, S_DA = S_CS + 512, S_END = S_DA + 512;
static_assert(S_END <= RING_BYTES, "ssd LDS map");
__device__ __forceinline__ void ssd_unit(Frame& F, int b, int h, const bool doatom = true) {
    LAS unsigned char* lds = F.lds + RING_OFF;
    const int tid = fresh_tid(), lane = tid & 63, w = __builtin_amdgcn_readfirstlane(tid >> 6), g = lane >> 4, c16 = lane & 15, q4 = c16 >> 2, p4 = lane & 3;
    const int g8 = h >> 3, pbw = w & 3, nhw = w >> 2;
    const float a_h = -__expf(F.a_log()[h]), dsk = F.d_skip()[h];
    const bf16* const PROJ = F.PROJ(); bf16* const MIX = F.HN(); const float* const dt2 = F.DT2(); const bf16* const XBC = F.XBC(); float* const ssqp = F.ssq();
    LAS float* dtl = (LAS float*)(lds + S_DT); LAS float* csl = (LAS float*)(lds + S_CS); LAS float* dal = (LAS float*)(lds + S_DA);
    for (int i = tid; i < 64 * S_BSTR / 16; i += NWAVES * 64) ((LAS v4u*)(lds + S_HB))[i] = (v4u){0u, 0u, 0u, 0u};
    f32x4 hacc[4];
#pragma unroll
    for (int i = 0; i < 4; ++i) hacc[i] = (f32x4){0.f, 0.f, 0.f, 0.f};
    const int xl = tid >> 3, xc = tid & 7, bl = tid >> 4, bc = tid & 15;
    v4u xr[2], br[4], cr[4]; float dtv = 0.f;
#define S_PREFETCH(cc) do { const size_t t0_ = (size_t)b * SEQ + (size_t)(cc) * SSM_L; \
        _Pragma("unroll") for (int i_ = 0; i_ < 2; ++i_) xr[i_] = *(const GAS v4u*)(XBC + (t0_ + xl + 64 * i_) * XBC_W + h * 64 + 8 * xc); \
        _Pragma("unroll") for (int i_ = 0; i_ < 4; ++i_) { const bf16* p_ = XBC + (t0_ + bl + 32 * i_) * XBC_W + 1024 + g8 * 128 + 8 * bc; br[i_] = *(const GAS v4u*)p_; cr[i_] = *(const GAS v4u*)(p_ + 256); } \
        if (tid < 128) dtv = dt2[(t0_ + tid) * 16 + h]; } while (0)
    S_PREFETCH(0);
    for (int c = 0; c < SSM_NC; ++c) {
        const size_t tok0 = (size_t)b * SEQ + (size_t)c * SSM_L;
        if (tid < 128) { dtl[tid] = dtv; dal[tid] = dtv * a_h; }
        __syncthreads();
        { const float v0 = dal[2 * lane], v1 = dal[2 * lane + 1]; float s = v0 + v1;
#pragma unroll
            for (int o = 1; o < 64; o <<= 1) { const float t = __shfl_up(s, o); s += (lane >= o) ? t : 0.f; }
            csl[2 * lane] = s - v1; csl[2 * lane + 1] = s; }
        LDS_WAIT(); asm volatile("" ::: "memory");
        const float cs_last = csl[127];
#pragma unroll
        for (int i = 0; i < 2; ++i) { const int l = xl + 64 * i; const v4u v = xr[i]; *(LAS v4u*)(lds + S_X + l * S_XSTR + xc * 16) = v; const float wl = dtl[l] * __expf(cs_last - csl[l]);
            v4u o2; o2.x = pk2(bflo(v.x) * wl, bfhi(v.x) * wl); o2.y = pk2(bflo(v.y) * wl, bfhi(v.y) * wl); o2.z = pk2(bflo(v.z) * wl, bfhi(v.z) * wl); o2.w = pk2(bflo(v.w) * wl, bfhi(v.w) * wl);
            *(LAS v4u*)(lds + S_XW + l * S_XSTR + xc * 16) = o2; }
#pragma unroll
        for (int i = 0; i < 4; ++i) { const int l = bl + 32 * i; *(LAS v4u*)(lds + S_BM + l * S_BSTR + bc * 16) = br[i]; *(LAS v4u*)(lds + S_CM + l * S_BSTR + bc * 16) = cr[i]; }
        const int lrow = 16 * w + c16;
        v2u zr[4];
#pragma unroll
        for (int pb = 0; pb < 4; ++pb) zr[pb] = *(const GAS v2u*)(PROJ + (tok0 + lrow) * NPROJ + COL_Z + h * 64 + 16 * pb + 4 * g);
        if (c + 1 < SSM_NC) S_PREFETCH(c + 1);
        __syncthreads();
        bf16x8 cf[4];
#pragma unroll
        for (int ks = 0; ks < 4; ++ks) cf[ks] = *(const LAS bf16x8*)(lds + S_CM + lrow * S_BSTR + (32 * ks + 8 * g) * 2);
        f32x4 yacc[4];
        const float cs_l = csl[lrow]; const float el = __expf(cs_l);
#pragma unroll
        for (int pb = 0; pb < 4; ++pb) { yacc[pb] = (f32x4){0.f, 0.f, 0.f, 0.f};
#pragma unroll
            for (int ks = 0; ks < 4; ++ks) { const bf16x8 hf = *(const LAS bf16x8*)(lds + S_HB + (16 * pb + c16) * S_BSTR + (32 * ks + 8 * g) * 2); yacc[pb] = MFMA16(hf, cf[ks], yacc[pb]); }
            yacc[pb] = yacc[pb] * el; }
        for (int s2 = 0; s2 <= (w >> 1); ++s2) {
            const int sb0 = 2 * s2, sb1 = 2 * s2 + 1; const bool has1 = sb1 <= w;
            f32x4 cb0 = (f32x4){0.f, 0.f, 0.f, 0.f}, cb1 = (f32x4){0.f, 0.f, 0.f, 0.f};
#pragma unroll
            for (int ks = 0; ks < 4; ++ks) { const bf16x8 bf0 = *(const LAS bf16x8*)(lds + S_BM + (16 * sb0 + c16) * S_BSTR + (32 * ks + 8 * g) * 2); cb0 = MFMA16(bf0, cf[ks], cb0); }
            if (has1) {
#pragma unroll
                for (int ks = 0; ks < 4; ++ks) { const bf16x8 bf1 = *(const LAS bf16x8*)(lds + S_BM + (16 * sb1 + c16) * S_BSTR + (32 * ks + 8 * g) * 2); cb1 = MFMA16(bf1, cf[ks], cb1); } }
            float mv[8];
#pragma unroll
            for (int r = 0; r < 4; ++r) { const int s = 16 * sb0 + 4 * g + r; const float e = __expf(fminf(cs_l - csl[s], 0.f)) * dtl[s]; mv[r] = (s <= lrow) ? cb0[r] * e : 0.f; }
#pragma unroll
            for (int r = 0; r < 4; ++r) { const int s = 16 * sb1 + 4 * g + r; const int sc_ = s > 127 ? 127 : s; const float e = __expf(fminf(cs_l - csl[sc_], 0.f)) * dtl[sc_]; mv[4 + r] = (has1 && s <= lrow) ? cb1[r] * e : 0.f; }
            const bf16x8 pf = pack8(mv);
#pragma unroll
            for (int pb = 0; pb < 4; ++pb) { LAS unsigned char* xa = lds + S_X + (32 * s2 + 4 * g + q4) * S_XSTR + (16 * pb + 4 * p4) * 2;
                const s16x4 lo = TR16(xa), hi = TR16(xa + 16 * S_XSTR); const bf16x8 xf = __builtin_shufflevector(lo, hi, 0, 1, 2, 3, 4, 5, 6, 7);
                yacc[pb] = MFMA16(xf, pf, yacc[pb]); }
        }
        { const size_t tok = tok0 + lrow; float ssq = 0.f;
#pragma unroll
          for (int pb = 0; pb < 4; ++pb) { const int p0 = 16 * pb + 4 * g;
              const v2u xs_ = *(const LAS v2u*)(lds + S_X + lrow * S_XSTR + p0 * 2);
              const v2u zr_ = zr[pb];
              const float o0 = (yacc[pb].x + bflo(xs_.x) * dsk) * silu_f(bflo(zr_.x)), o1 = (yacc[pb].y + bfhi(xs_.x) * dsk) * silu_f(bfhi(zr_.x));
              const float o2 = (yacc[pb].z + bflo(xs_.y) * dsk) * silu_f(bflo(zr_.y)), o3 = (yacc[pb].w + bfhi(xs_.y) * dsk) * silu_f(bfhi(zr_.y));
              ssq += (o0 * o0 + o1 * o1) + (o2 * o2 + o3 * o3);
              *(GAS unsigned*)((unsigned char*)MIX + tok * DM + ATT_W + h * 64 + p0) = pk4_fp8(o0 * SS8, o1 * SS8, o2 * SS8, o3 * SS8); }
          ssq += __shfl_xor(ssq, 16); ssq += __shfl_xor(ssq, 32);
          if (g == 0 && doatom) unsafeAtomicAdd(ssqp + tok * 4 + 2 + g8, ssq); }
        { const float cdec = __expf(cs_last);
#pragma unroll
          for (int i = 0; i < 4; ++i) hacc[i] = hacc[i] * cdec;
#pragma unroll
          for (int ks = 0; ks < 4; ++ks) {
              LAS unsigned char* xa = lds + S_XW + (32 * ks + 8 * g + q4) * S_XSTR + (16 * pbw + 4 * p4) * 2;
              const s16x4 xlo = TR16(xa), xhi = TR16(xa + 4 * S_XSTR); const bf16x8 xf = __builtin_shufflevector(xlo, xhi, 0, 1, 2, 3, 4, 5, 6, 7);
#pragma unroll
              for (int i = 0; i < 4; ++i) { const int nb = 4 * nhw + i; LAS unsigned char* ba = lds + S_BM + (32 * ks + 8 * g + q4) * S_BSTR + (16 * nb + 4 * p4) * 2;
                  const s16x4 blo = TR16(ba), bhi = TR16(ba + 4 * S_BSTR); const bf16x8 bfr = __builtin_shufflevector(blo, bhi, 0, 1, 2, 3, 4, 5, 6, 7);
                  hacc[i] = MFMA16(bfr, xf, hacc[i]); } } }
        __syncthreads();
#pragma unroll
        for (int i = 0; i < 4; ++i) { const int nb = 4 * nhw + i; v2u o; o.x = pk2(hacc[i].x, hacc[i].y); o.y = pk2(hacc[i].z, hacc[i].w);
            *(LAS v2u*)(lds + S_HB + (16 * pbw + c16) * S_BSTR + (16 * nb + 4 * g) * 2) = o; }
    }
#undef S_PREFETCH
    __syncthreads();
}

__device__ __forceinline__ void mix_normalize(Frame& F) {
    const int tid_ = fresh_tid(), lane = tid_ & 63; const int gw = blockIdx.x * NWAVES + __builtin_amdgcn_readfirstlane(tid_ >> 6), NGW = F.G * NWAVES;
    const float* const ssqp = F.ssq(); bf16* const MIX = F.HN(); const float* const gatt = F.attn_out_norm(); const float* const gssm = F.ssm_out_norm();
    for (int m = gw; m < MTOK; m += NGW) {
        const float* sq = ssqp + (size_t)m * 4;
        const float s1 = __hip_atomic_load(sq + 1, RLX_AGENT), s2 = __hip_atomic_load(sq + 2, RLX_AGENT), s3 = __hip_atomic_load(sq + 3, RLX_AGENT);
        const float ra = 1.f / sqrtf(s1 * (1.f / 1024.f) + EPS), r0 = 1.f / sqrtf(s2 * (1.f / 512.f) + EPS), r1 = 1.f / sqrtf(s3 * (1.f / 512.f) + EPS);
        GAS v4u* row = (GAS v4u*)(MIX + (size_t)m * DM);
#pragma unroll
        for (int j = 0; j < 4; ++j) { const int idx = lane + 64 * j, col = 8 * idx; const float rs = (j < 2) ? ra : ((j == 2) ? r0 : r1);
            const float* gp = (j < 2) ? (gatt + col) : (gssm + (col - ATT_W));
            const f32x4 g0 = *(const GAS f32x4*)gp, g1 = *(const GAS f32x4*)(gp + 4); const v4u v = row[idx]; v4u o;
            o.x = pk2(bflo(v.x) * rs * g0.x, bfhi(v.x) * rs * g0.y); o.y = pk2(bflo(v.y) * rs * g0.z, bfhi(v.y) * rs * g0.w);
            o.z = pk2(bflo(v.z) * rs * g1.x, bfhi(v.z) * rs * g1.y); o.w = pk2(bflo(v.w) * rs * g1.z, bfhi(v.w) * rs * g1.w); row[idx] = o; }
    }
}

constexpr size_t TAB_UNIT = 1024;
static_assert((TAB_ITEMS / 8) % TAB_UNIT == 0 && TAB_ITEMS % TAB_UNIT == 0, "table filler units");
constexpr int P_EIDX = 0, P_GATE = 16384, P_LST = 32768  , P_HN4 = 32768  , P_ACT = 98304  , P_END = 114688;
static_assert(P_END <= RING_BYTES, "peer LDS map");
__constant__ unsigned char PEER_CAND[52] = {0, 1, 2, 3, 4, 5, 6, 7, 8, 9, 10, 11, 12, 13, 14, 15, 16, 17, 18, 19, 20, 21, 22, 23, 32, 33, 34, 35, 36, 48, 49, 50, 51, 64, 65, 66, 80, 81, 96, 97, 112, 113, 128, 144, 160, 176, 192, 208, 224, 240, 255, 255};
__device__ __forceinline__ unsigned f2ord(float f) { const unsigned u = __builtin_bit_cast(unsigned, f); return u ^ ((u >> 31) ? 0xFFFFFFFFu : 0x80000000u); }
__device__ __forceinline__ float ord2f(unsigned u) { return __builtin_bit_cast(float, u ^ ((u >> 31) ? 0x80000000u : 0xFFFFFFFFu)); }
#define CSWAPD(a, b) do { const unsigned hi_ = (a) > (b) ? (a) : (b), lo_ = (a) > (b) ? (b) : (a); (a) = hi_; (b) = lo_; } while (0)
template <int N> __device__ __forceinline__ void bitonic_sort_desc(unsigned (&v)[N]) {
#pragma unroll
    for (int k = 2; k <= N; k <<= 1)
#pragma unroll
        for (int j = k >> 1; j > 0; j >>= 1)
#pragma unroll
            for (int i = 0; i < N; ++i) { const int l = i ^ j; if (l > i) { if ((i & k) == 0) CSWAPD(v[i], v[l]); else CSWAPD(v[l], v[i]); } }
}
__device__ __forceinline__ void merge16_xor(unsigned (&v)[16], int dist) {
    unsigned o[16];
#pragma unroll
    for (int i = 0; i < 16; ++i) o[i] = (unsigned)__shfl_xor((int)v[i], dist);
#pragma unroll
    for (int i = 0; i < 16; ++i) v[i] = v[i] > o[15 - i] ? v[i] : o[15 - i];
#pragma unroll
    for (int j = 8; j > 0; j >>= 1)
#pragma unroll
        for (int i = 0; i < 16; ++i) { const int l = i ^ j; if (l > i) CSWAPD(v[i], v[l]); }
}
__device__ __forceinline__ float gelu_erf(float x) { return 0.5f * x * (1.f + erff(x * 0.70710678118654752f)); }
__device__ __forceinline__ float fp4_dec1(unsigned n) { const unsigned m = n & 7u; unsigned bits = (m >= 2u) ? (((126u + (m >> 1)) << 23) | ((m & 1u) << 22)) : (m ? 0x3F000000u : 0u); bits |= (n & 8u) << 28; return __builtin_bit_cast(float, bits); }
__device__ __forceinline__ f32x2 fp4_dec2(unsigned x) { f32x2 r; r.x = fp4_dec1(x & 15u); r.y = fp4_dec1((x >> 4) & 15u); return r; }
typedef long i64;
typedef int v8i __attribute__((ext_vector_type(8)));
typedef int v4i __attribute__((ext_vector_type(4)));
template <bool dry = false> __device__ __forceinline__ void peer_unit(Frame& F, int u) {
    LAS unsigned char* lds = F.lds + RING_OFF;
    const int tid_ = fresh_tid(), lane = tid_ & 63, w = __builtin_amdgcn_readfirstlane(tid_ >> 6), g = lane >> 4, c16 = lane & 15;
    const int T0 = 32 * u;
    LAS int* eidx = (LAS int*)(lds + P_EIDX); LAS float* gate = (LAS float*)(lds + P_GATE);
    LAS unsigned* lst = (LAS unsigned*)(lds + P_LST) + w * 1024;
    const bf16* const QP = F.QP(); const bf16* const SK = F.SK(); float* const outp = F.out(); const bf16* const X1B = F.X1B(); const float* const fgain = F.ffn_norm(); const float* const fing = F.final_norm(); const unsigned char* const U8 = F.U8(); const unsigned char* const V8 = F.V8();
#ifndef NO_ROUTE
    unsigned cpk[4];
    { unsigned cb[16];
#pragma unroll
      for (int k = 0; k < 13; ++k) cb[k] = PEER_CAND[4 * k + g];
      cb[13] = 255u; cb[14] = 255u; cb[15] = 255u;
#pragma unroll
      for (int q = 0; q < 4; ++q) cpk[q] = cb[4 * q] | (cb[4 * q + 1] << 8) | (cb[4 * q + 2] << 16) | (cb[4 * q + 3] << 24); }
    {
    bf16x8 qf[2][4];
#define QP_LOAD(dst, c_) do { _Pragma("unroll") for (int tb = 0; tb < 2; ++tb) { const unsigned qo = ((unsigned)(T0 + 16 * tb + c16) * (unsigned)DM + (unsigned)((2 * w + (c_)) * 128 + 8 * g)) * 2u; \
        _Pragma("unroll") for (int ks = 0; ks < 4; ++ks) dst[tb][ks] = __builtin_nontemporal_load((const GAS bf16x8*)((const unsigned char*)QP + (qo + 64u * ks))); } } while (0)
    QP_LOAD(qf, 0);
#pragma unroll
    for (int c = 0; c < 2; ++c) {
        const int p = 2 * w + c;
        unsigned key[2][32];
        bf16x8 sf[3][8];
        const unsigned so0 = ((unsigned)(p * 128 + c16) * 128u + 8u * (unsigned)g) * 2u;
#define SK_LOAD(buf, j_) do { _Pragma("unroll") for (int q = 0; q < 8; ++q) sf[buf][q] = *(const GAS bf16x8*)((const unsigned char*)SK + (so0 + (unsigned)(2 * (j_) + (q >> 2)) * 4096u + 64u * (q & 3))); } while (0)
        SK_LOAD(0, 0); SK_LOAD(1, 1);
#pragma unroll
        for (int j = 0; j < 4; ++j) {
            if (j + 2 < 4) SK_LOAD((j + 2) % 3, j + 2);
            __builtin_amdgcn_sched_barrier(0);
#pragma unroll
            for (int h2 = 0; h2 < 2; ++h2)
#pragma unroll
            for (int tb = 0; tb < 2; ++tb) { const int kb = 2 * j + h2; f32x4 acc = (f32x4){0.f, 0.f, 0.f, 0.f};
#pragma unroll
                for (int ks = 0; ks < 4; ++ks) acc = MFMA16(sf[j % 3][4 * h2 + ks], qf[tb][ks], acc);
#pragma unroll
                for (int r = 0; r < 4; ++r) key[tb][kb * 4 + r] = (f2ord(acc[r]) & ~0x7Fu) | (unsigned)(16 * kb + 4 * g + r); }
            __builtin_amdgcn_sched_barrier(0); }
#undef SK_LOAD
        if (c == 0) { QP_LOAD(qf, 1); __builtin_amdgcn_sched_barrier(0); }
#pragma unroll
        for (int tb = 0; tb < 2; ++tb) {
            bitonic_sort_desc<32>(key[tb]);
            unsigned top[16];
#pragma unroll
            for (int i = 0; i < 16; ++i) top[i] = key[tb][i];
            merge16_xor(top, 16); merge16_xor(top, 32);
            if (g == 0) { LAS v4u* d = (LAS v4u*)(lst + (c * 32 + 16 * tb + c16) * 16);
                d[0] = (v4u){top[0], top[1], top[2], top[3]}; d[1] = (v4u){top[4], top[5], top[6], top[7]}; d[2] = (v4u){top[8], top[9], top[10], top[11]}; d[3] = (v4u){top[12], top[13], top[14], top[15]}; } }
    }
#undef QP_LOAD
    }
    for (int tb = 0; tb < 2; ++tb) {
        LDS_WAIT();
        const LAS unsigned* l1 = lst + (16 * tb + c16) * 16; const LAS unsigned* l2 = lst + (32 + 16 * tb + c16) * 16;
        unsigned ck[16];
#pragma unroll
        for (int k = 0; k < 13; ++k) { const unsigned ab = (cpk[k >> 2] >> (8 * (k & 3))) & 255u; const unsigned a = ab >> 4, bq = ab & 15u;
            const float s = ord2f(l1[a] & ~0x7Fu) + ord2f(l2[bq] & ~0x7Fu); ck[k] = (ab == 255u) ? 0u : ((f2ord(s) & ~0xFFu) | ab); }
        ck[13] = 0u; ck[14] = 0u; ck[15] = 0u;
        bitonic_sort_desc<16>(ck);
        merge16_xor(ck, 16); merge16_xor(ck, 32);
        if (g == 0) { const int tl = 16 * tb + c16; const float m = ord2f(ck[0] & ~0xFFu); float e[16]; float sum = 0.f;
#pragma unroll
            for (int k = 0; k < 16; ++k) { e[k] = __expf(ord2f(ck[k] & ~0xFFu) - m); sum += e[k]; }
            const float inv = 1.f / sum;
#pragma unroll
            for (int k = 0; k < 16; ++k) { const unsigned a = (ck[k] >> 4) & 15u, bq = ck[k] & 15u; const int ex = (int)((l1[a] & 0x7Fu) * 128u + (l2[bq] & 0x7Fu));
                eidx[tl * 128 + w * 16 + k] = ex; gate[tl * 128 + w * 16 + k] = e[k] * inv; } }
    }
#endif
    __syncthreads();
    LAS unsigned char* hnb = lds + P_HN4 + w * 8192; LAS float* actl = (LAS float*)(lds + P_ACT) + w * 512;
    const LAS unsigned char* hb = hnb + 16 * g + ((c16 & 1) ? 1024 : 0) + ((c16 & 2) ? 64 : 0);
    v4u bA[8], bB[8];
#define U_ISSUE(buf, e_) do { const unsigned uo_ = (unsigned)(e_) * (unsigned)ROWB + 64u * (unsigned)(c16 & 1) + 16u * (unsigned)g; \
        _Pragma("unroll") for (int jj = 0; jj < 8; ++jj) buf[jj] = *(const GAS v4u*)(U8 + (uo_ + 128u * jj)); __builtin_amdgcn_sched_barrier(0); } while (0)
#define U_CONSUME(buf, ACC, HB) do { v4u bq_[8]; _Pragma("unroll") for (int jj = 0; jj < 8; ++jj) bq_[jj] = *(const LAS v4u*)((HB) + 128 * jj); \
        __builtin_amdgcn_sched_barrier(0); \
        _Pragma("unroll") for (int jj = 0; jj < 8; ++jj) { const v4u a_ = buf[jj]; \
            const v8i av_ = {(int)a_.x, (int)a_.y, (int)a_.z, (int)a_.w, 0, 0, 0, 0}; const v8i bv_ = {(int)bq_[jj].x, (int)bq_[jj].y, (int)bq_[jj].z, (int)bq_[jj].w, 0, 0, 0, 0}; \
            ACC = __builtin_amdgcn_mfma_scale_f32_16x16x128_f8f6f4(av_, bv_, ACC, 4, 4, 0, 0x7f7f7f7f, 0, 0x7f7f7f7f); } __builtin_amdgcn_sched_barrier(0); } while (0)
#define U_PRE(A_, PA, PB) do { const float x1_ = __shfl_down(A_.x, 1), z1_ = __shfl_down(A_.z, 1), y2_ = __shfl_down(A_.y, 2), w2_ = __shfl_down(A_.w, 2), y3_ = __shfl_down(A_.y, 3), w3_ = __shfl_down(A_.w, 3); \
        constexpr float ilo_ = 1.f / SLO4; PA = (A_.x + y2_) + (x1_ + y3_) * ilo_; PB = (A_.z + w2_) + (z1_ + w3_) * ilo_; } while (0)
#define U_ACT(grp_, TL, ACT) do { float pa0_, pb0_, pa1_, pb1_; U_PRE(acc0, pa0_, pb0_); U_PRE(acc1, pa1_, pb1_); \
        if (c16 == 0) { const int k0 = 16 * (grp_) + 2 * g; constexpr float isc = 1.f / (SU * SH4); \
            const f32x2 g0_ = *(const LAS f32x2*)(gate + (TL) * 128 + k0), g1_ = *(const LAS f32x2*)(gate + (TL) * 128 + k0 + 8); \
            f32x2 a0_, a1_; a0_.x = gelu_erf(pa0_ * isc) * g0_.x; a0_.y = gelu_erf(pb0_ * isc) * g0_.y; a1_.x = gelu_erf(pa1_ * isc) * g1_.x; a1_.y = gelu_erf(pb1_ * isc) * g1_.y; \
            *(LAS f32x2*)((ACT) + k0) = a0_; *(LAS f32x2*)((ACT) + k0 + 8) = a1_; } } while (0)
#define V_ISSUE(buf, TL, kb_) do { _Pragma("unroll") for (int kh = 0; kh < 2; ++kh) { const LAS v4i* ep_ = (const LAS v4i*)(eidx + (TL) * 128 + 8 * (kb_) + 4 * kh); const v4i e4_ = *ep_; const int ee_[4] = {e4_.x, e4_.y, e4_.z, e4_.w}; \
        _Pragma("unroll") for (int kk = 0; kk < 4; ++kk) { const unsigned vo_ = (unsigned)(ee_[kk] & emask) * (unsigned)ROWB + 16u * (unsigned)lane; buf[4 * kh + kk] = *(const GAS v4u*)(V8 + vo_); } \
        __builtin_amdgcn_sched_barrier(0); } } while (0)
#define PIN8x2(a, i) asm volatile("" : "+v"(a[i]), "+v"(a[i + 1]), "+v"(a[i + 2]), "+v"(a[i + 3]), "+v"(a[i + 4]), "+v"(a[i + 5]), "+v"(a[i + 6]), "+v"(a[i + 7]))
#define V_CONSUME(buf, kb_, O, ACT) do { _Pragma("unroll") for (int kk = 0; kk < 8; ++kk) { const float as_ = (ACT)[8 * (kb_) + kk]; const f32x2 a2_ = {as_, as_}; \
        const unsigned vw[4] = {buf[kk].x, buf[kk].y, buf[kk].z, buf[kk].w}; \
        _Pragma("unroll") for (int q = 0; q < 4; ++q) { \
            O[4 * q]     = __builtin_elementwise_fma(__builtin_amdgcn_cvt_scalef32_pk_f32_fp4(vw[q], 1.0f, 0), a2_, O[4 * q]); \
            O[4 * q + 1] = __builtin_elementwise_fma(__builtin_amdgcn_cvt_scalef32_pk_f32_fp4(vw[q], 1.0f, 1), a2_, O[4 * q + 1]); \
            O[4 * q + 2] = __builtin_elementwise_fma(__builtin_amdgcn_cvt_scalef32_pk_f32_fp4(vw[q], 1.0f, 2), a2_, O[4 * q + 2]); \
            O[4 * q + 3] = __builtin_elementwise_fma(__builtin_amdgcn_cvt_scalef32_pk_f32_fp4(vw[q], 1.0f, 3), a2_, O[4 * q + 3]); } \
        PIN8x2(O, 0); PIN8x2(O, 8); } } while (0)
#ifndef NO_GATHER
#ifdef PROBE_L2RES
    constexpr int emask = dry ? PROBE_L2RES : 16383;
#else
    constexpr int emask = 16383;
#endif
    {
    { unsigned k0[4], k1[4];
#pragma unroll
      for (int ti = 0; ti < 4; ++ti) { const int tl = w + 8 * ti; k0[ti] = ((unsigned)eidx[tl * 128 + lane] << 7) | (unsigned)lane; k1[ti] = ((unsigned)eidx[tl * 128 + 64 + lane] << 7) | (unsigned)(64 + lane); }
#pragma unroll
      for (int k = 2; k <= 128; k <<= 1)
#pragma unroll
        for (int j = k >> 1; j > 0; j >>= 1) {
            if (j == 64) {
#pragma unroll
                for (int ti = 0; ti < 4; ++ti) { const unsigned lo_ = k0[ti] < k1[ti] ? k0[ti] : k1[ti], hi_ = k0[ti] < k1[ti] ? k1[ti] : k0[ti]; k0[ti] = lo_; k1[ti] = hi_; }
            } else {
                const bool lower = (lane & j) == 0;
                const bool desc0 = (k == 64) ? false : ((k == 128) ? false : ((lane & k) != 0)), desc1 = (k == 64) ? true : desc0;
                const bool min0 = lower != desc0, min1 = lower != desc1;
#pragma unroll
                for (int ti = 0; ti < 4; ++ti) { const unsigned p0 = (unsigned)__shfl_xor((int)k0[ti], j), p1 = (unsigned)__shfl_xor((int)k1[ti], j);
                    const unsigned mn0 = k0[ti] < p0 ? k0[ti] : p0, mx0 = k0[ti] < p0 ? p0 : k0[ti], mn1 = k1[ti] < p1 ? k1[ti] : p1, mx1 = k1[ti] < p1 ? p1 : k1[ti];
                    k0[ti] = min0 ? mn0 : mx0; k1[ti] = min1 ? mn1 : mx1; }
            }
        }
      float g0[4], g1[4];
#pragma unroll
      for (int ti = 0; ti < 4; ++ti) { const int tl = w + 8 * ti; g0[ti] = gate[tl * 128 + (int)(k0[ti] & 127u)]; g1[ti] = gate[tl * 128 + (int)(k1[ti] & 127u)]; }
      LDS_WAIT(); asm volatile("" ::: "memory");
#pragma unroll
      for (int ti = 0; ti < 4; ++ti) { const int tl = w + 8 * ti; eidx[tl * 128 + lane] = (int)(k0[ti] >> 7); eidx[tl * 128 + 64 + lane] = (int)(k1[ti] >> 7); gate[tl * 128 + lane] = g0[ti]; gate[tl * 128 + 64 + lane] = g1[ti]; }
      LDS_WAIT(); asm volatile("" ::: "memory"); }
    v2u xn[8];
#define X_ISSUE(tok_) do { const unsigned xb_ = (unsigned)(tok_) * (unsigned)(DM * 2) + 8u * (unsigned)lane; _Pragma("unroll") for (int j = 0; j < 8; ++j) xn[j] = __builtin_nontemporal_load((const GAS v2u*)((const unsigned char*)X1B + (xb_ + 512u * j))); } while (0)
    X_ISSUE(T0 + w);
#pragma unroll 1
    for (int ti = 0; ti < 4; ++ti) {
        f32x4 xr[8]; float ss = 0.f;
#pragma unroll
        for (int j = 0; j < 8; ++j) { const v2u r = xn[j]; xr[j] = (f32x4){bflo(r.x), bfhi(r.x), bflo(r.y), bfhi(r.y)}; }
        X_ISSUE(T0 + w + 8 * (ti < 3 ? ti + 1 : 3));
#pragma unroll
        for (int j = 0; j < 8; ++j) ss += (xr[j].x * xr[j].x + xr[j].y * xr[j].y) + (xr[j].z * xr[j].z + xr[j].w * xr[j].w);
        const float rs2 = __builtin_amdgcn_rsqf(wave_sum(ss) * (1.f / DM) + EPS);
        const float* fg_ = fgain; asm volatile("" : "+s"(fg_));
        const unsigned char* gp = (const unsigned char*)fg_; const unsigned go = 16u * (unsigned)lane;
        unsigned hw[4], lw[4];
#pragma unroll
        for (int q = 0; q < 4; ++q) { unsigned wh = 0u, wl = 0u;
#pragma unroll
            for (int t = 0; t < 2; ++t) { const int j = 2 * q + t; const f32x4 gg = *(const GAS f32x4*)(gp + (go + 1024u * j)); const f32x4 hv = xr[j] * gg * (rs2 * SH4);
                const float h0 = clampf(hv.x, 6.f), h1 = clampf(hv.y, 6.f), h2 = clampf(hv.z, 6.f), h3 = clampf(hv.w, 6.f);
                const unsigned p0 = __builtin_amdgcn_cvt_scalef32_pk_fp4_f32(0u, h0, h1, 1.0f, 0), p1 = __builtin_amdgcn_cvt_scalef32_pk_fp4_f32(0u, h2, h3, 1.0f, 0);
                const f32x2 d0 = __builtin_amdgcn_cvt_scalef32_pk_f32_fp4(p0, 1.0f, 0), d1 = __builtin_amdgcn_cvt_scalef32_pk_f32_fp4(p1, 1.0f, 0);
                const unsigned r0 = __builtin_amdgcn_cvt_scalef32_pk_fp4_f32(0u, clampf((h0 - d0.x) * SLO4, 6.f), clampf((h1 - d0.y) * SLO4, 6.f), 1.0f, 0), r1 = __builtin_amdgcn_cvt_scalef32_pk_fp4_f32(0u, clampf((h2 - d1.x) * SLO4, 6.f), clampf((h3 - d1.y) * SLO4, 6.f), 1.0f, 0);
                wh |= ((p0 & 0xFFu) | ((p1 & 0xFFu) << 8)) << (16 * t); wl |= ((r0 & 0xFFu) | ((r1 & 0xFFu) << 8)) << (16 * t); }
            hw[q] = wh; lw[q] = wl; }
        *(LAS v4u*)(hnb + 2048 * ti + 16 * lane) = (v4u){hw[0], hw[1], hw[2], hw[3]}; *(LAS v4u*)(hnb + 2048 * ti + 1024 + 16 * lane) = (v4u){lw[0], lw[1], lw[2], lw[3]};
    }
    LDS_WAIT();
    { int e_c0 = eidx[w * 128 + (c16 >> 1)] & emask, e_c1 = eidx[w * 128 + 8 + (c16 >> 1)] & emask;
      U_ISSUE(bA, e_c0);
#pragma unroll 1
      for (int s_ = 0; s_ < 31; ++s_) {
          const int ti = s_ & 3, grp = s_ >> 2, tl = w + 8 * ti, sn = s_ + 1;
          const int eb_ = (w + 8 * (sn & 3)) * 128 + 16 * (sn >> 2) + (c16 >> 1);
          const int e_n0 = eidx[eb_] & emask, e_n1 = eidx[eb_ + 8] & emask;
          const LAS unsigned char* hbt = hb + 2048 * ti; LAS float* actt = actl + 128 * ti;
          f32x4 acc0 = (f32x4){0.f, 0.f, 0.f, 0.f}, acc1 = acc0;
          U_ISSUE(bB, e_c1); U_CONSUME(bA, acc0, hbt);
          U_ISSUE(bA, e_n0);
          U_CONSUME(bB, acc1, hbt);
          U_ACT(grp, tl, actt);
          e_c0 = e_n0; e_c1 = e_n1;
      }
      { const LAS unsigned char* hbt = hb + 2048 * 3; LAS float* actt = actl + 128 * 3;
        f32x4 acc0 = (f32x4){0.f, 0.f, 0.f, 0.f}, acc1 = acc0;
        U_ISSUE(bB, e_c1); U_CONSUME(bA, acc0, hbt);
        V_ISSUE(bA, w, 0);
        U_CONSUME(bB, acc1, hbt);
        U_ACT(7, w + 24, actt); } }
    LDS_WAIT();
    f32x2 o2[4][16];
#pragma unroll
    for (int ti = 0; ti < 4; ++ti)
#pragma unroll
        for (int i = 0; i < 16; ++i) o2[ti][i] = (f32x2){0.f, 0.f};
#pragma unroll 1
    for (int kb = 0; kb < 16; ++kb) {
        const int kn = kb < 15 ? kb + 1 : 15;
        V_ISSUE(bB, w + 8, kb);  V_CONSUME(bA, kb, o2[0], actl);
        V_ISSUE(bA, w + 16, kb); V_CONSUME(bB, kb, o2[1], actl + 128);
        V_ISSUE(bB, w + 24, kb); V_CONSUME(bA, kb, o2[2], actl + 256);
        V_ISSUE(bA, w, kn);      V_CONSUME(bB, kb, o2[3], actl + 384);
    }
    X_ISSUE(T0 + w);
#pragma unroll
    for (int ti = 0; ti < 4; ++ti) {
        const size_t token = (size_t)T0 + w + 8 * ti;
        const unsigned xo = (unsigned)token * (unsigned)(DM * 4) + 16u * (unsigned)lane;
        f32x4 xr[8];
#pragma unroll
        for (int j = 0; j < 8; ++j) { const v2u r = xn[j]; xr[j] = (f32x4){bflo(r.x), bfhi(r.x), bflo(r.y), bfhi(r.y)}; }
        if (ti < 3) X_ISSUE(T0 + w + 8 * (ti + 1));
        constexpr float isv = 1.f / SV; float s2 = 0.f;
#pragma unroll
        for (int j = 0; j < 8; ++j) { xr[j] = xr[j] + (f32x4){o2[ti][2 * j].x, o2[ti][2 * j].y, o2[ti][2 * j + 1].x, o2[ti][2 * j + 1].y} * isv;
            s2 += (xr[j].x * xr[j].x + xr[j].y * xr[j].y) + (xr[j].z * xr[j].z + xr[j].w * xr[j].w); }
        const float rf = __builtin_amdgcn_rsqf(wave_sum(s2) * (1.f / DM) + EPS);
        const float* fi_ = fing; asm volatile("" : "+s"(fi_));
        const unsigned char* fp = (const unsigned char*)fi_; unsigned char* op = (unsigned char*)outp; const unsigned fo = 16u * (unsigned)lane;
        if (!dry || rf == 1.2345e30f)
#pragma unroll
        for (int j = 0; j < 8; ++j) __builtin_nontemporal_store(xr[j] * rf * *(const GAS f32x4*)(fp + (fo + 1024u * j)), (GAS f32x4*)(op + (xo + 1024u * j)));
    }
    }
#endif
#undef U_ISSUE
#undef X_ISSUE
#undef U_ACT
#undef U_CONSUME
#undef V_ISSUE
#undef V_CONSUME
    __syncthreads();
}

__global__ void __launch_bounds__(NWAVES * 64, 2) hybrid_fwd(Args args) {
    extern __shared__ __attribute__((aligned(16))) unsigned char lds[];
    Frame F;
    F.lds = (LAS unsigned char*)lds;
    F.MISC = (volatile LAS unsigned*)(F.lds + MISC_OFF);
    F.tid = threadIdx.x; F.lane = F.tid & 63; F.wave = __builtin_amdgcn_readfirstlane(F.tid >> 6); F.G = gridDim.x;
    for (int u = F.tid; u < (LDS_BYTES - LDSCTL_OFF) / 4; u += NWAVES * 64) ((LAS unsigned*)(F.lds + LDSCTL_OFF))[u] = 0u;
    __syncthreads();
    (void)args;
    XcdBarrier bar = xcd_barrier_post(F.ctl() + CW_BAR, F.MISC + 8);

#ifndef NO_P0
#ifdef PROBE_P0X2
    { int reps = 2; asm volatile("" : "+s"(reps)); for (int rep = 0; rep < reps; ++rep) p0_prologue(F); }
#else
    p0_prologue(F);
#endif
#endif
    xcd_barrier(bar);
#ifndef NO_P1
#ifdef PROBE_GX2
    { int reps = 2; asm volatile("" : "+s"(reps)); for (int rep = 0; rep < reps; ++rep) {
#else
    { { const int rep = 0, reps = 1;
#endif
      pg8::Gemm gm{F.HN(), F.WinT(), MTOK, NB16, DM}; pg8::StaticOrder S; S.init(MTOK, NB16, F.G, (int)blockIdx.x);
      EpiProj E{F.PROJ(), F.dtraw(), (rep + 1 < reps) ? nullptr : F.kmean()};
      pg8::gemm_phase<EpiProj, pg8::StaticOrder, PG8_ALIGN, PG8_SP2>(F.lds + RING_OFF, gm, S, E); } }
    { const int nun = (MTOK / 256) * (NB16 / 256), rem = nun % F.G;
      if (rem && (int)blockIdx.x >= rem) tables_convert(F, tab_split(F.G), TAB_ITEMS, (size_t)((int)blockIdx.x - rem) * (NWAVES * 64) + fresh_tid(), (size_t)(F.G - rem) * (NWAVES * 64)); }
    __syncthreads();
    {
      pg8::Gemm gm{(const pg8::bf16_t*)F.HN8(), (const pg8::bf16_t*)F.WinT8(), MTOK, F8_HI - F8_LO, DM / 2}; pg8::StaticOrder S; S.init(MTOK, F8_HI - F8_LO, F.G, (int)blockIdx.x);
      EpiProj8 E{F.PROJ()};
      pg8::gemm_phase<EpiProj8, pg8::StaticOrder, PG8_ALIGN, PG8_SP2, true>(F.lds + RING_OFF, gm, S, E); }
#endif
    xcd_barrier(bar);
#ifdef PROBE_P15X2
    conv_phase(F);
#endif
    conv_phase(F);
    xcd_barrier(bar);
#ifdef PROBE_P2X2
    { int reps = 2; asm volatile("" : "+s"(reps)); for (int rep = 0; rep < reps; ++rep) {
#else
    { { const int rep = 0, reps = 1;
#endif
    const bool doatom = rep + 1 == reps;
    const int ntab = (int)(tab_split(F.G) / TAB_UNIT);
    for (;;) {
        if (F.tid == 0) F.MISC[0] = xb_add(F.ctl() + CW_Q2 + 64 * rep, 1u);
        __syncthreads();
        const int ui = (int)F.MISC[0];
        __syncthreads();
        if (ui >= 128 + 512 + W_SQ_UNITS + ntab) break;
        if (ui >= 128 + 512 && ui < 128 + 512 + W_SQ_UNITS) { sq_weight_items(F, ui - 640); __syncthreads(); continue; }
        if (ui >= 128 + 512 + W_SQ_UNITS) { const size_t lo = (size_t)(ui - 640 - W_SQ_UNITS) * TAB_UNIT; tables_convert(F, lo, lo + TAB_UNIT, (size_t)fresh_tid(), (size_t)(NWAVES * 64)); continue; }
#ifdef PROBE_P2_SSD
        if (ui < 128 || doatom)
#endif
#ifdef PROBE_P2_ATT
        if (ui >= 128 || doatom)
#endif
        {
        if (ui < 128) ssd_unit(F, ui >> 4, ui & 15, doatom);
        else { const int a = ui - 128; attn_unit(F, (a & 63) >> 3, a & 7, 7 - (a >> 6), doatom); }
        }
    } } }
    xcd_barrier(bar);
#ifndef NO_P3
#ifdef PROBE_GX2
    { int reps = 2; asm volatile("" : "+s"(reps)); for (int rep = 0; rep < reps; ++rep) {
#else
    { { const int rep = 0, reps = 1;
#endif
      pg8::Gemm gm{F.HN(), F.WoutT(), MTOK, DM, DM / 2}; pg8::StaticOrder S; S.init(MTOK, DM, F.G, (int)blockIdx.x);
      {
        const int t_ = fresh_tid(); const float* const sq = F.ssq();
#pragma unroll 1
        for (int ii = t_ >> 8; ii < 3; ii += 2) { pg8::Unit uu;
          if (S.next(ii, uu)) { const int row = uu.pm * 256 + (t_ & 255);
            const float q1 = __hip_atomic_load(sq + (size_t)row * 4 + 1, RLX_AGENT), q2 = __hip_atomic_load(sq + (size_t)row * 4 + 2, RLX_AGENT), q3 = __hip_atomic_load(sq + (size_t)row * 4 + 3, RLX_AGENT);
            const float sa = __builtin_amdgcn_rsqf(q1 * (1.f / 1024.f) + EPS), s0 = __builtin_amdgcn_rsqf(q2 * (1.f / 512.f) + EPS), s1 = __builtin_amdgcn_rsqf(q3 * (1.f / 512.f) + EPS);
            *(LAS f32x4*)(F.lds + SEGTAB_OFF + (ii * 256 + (t_ & 255)) * 16) = (f32x4){sa / s0 * (SS8 / SA8), s0 / s1, s1 * (1.f / (SS8 * SW8)), 0.f}; } }
        __syncthreads(); }
      EpiOut E{F.x(), F.X1B(), F.X18(), F.ssq(), rep + 1 == reps, (const LAS f32x4*)(F.lds + SEGTAB_OFF)};
      pg8::gemm_phase<EpiOut, pg8::StaticOrder, PG8_ALIGN, PG8_SP2, true>(F.lds + RING_OFF, gm, S, E); } }
#endif
    xcd_barrier(bar);
#ifndef NO_P4
#ifdef PROBE_GX2
    { int reps = 2; asm volatile("" : "+s"(reps)); for (int rep = 0; rep < reps; ++rep) {
#else
    { { const int rep = 0, reps = 1; (void)rep; (void)reps;
#endif
      pg8::Gemm gm{(const pg8::bf16_t*)F.X18(), F.WqT(), MTOK, DM, DM / 2}; pg8::StaticOrder S; S.init(MTOK, DM, F.G, (int)blockIdx.x);
      EpiQ E{F.QP(), F.ssq()};
      pg8::gemm_phase<EpiQ, pg8::StaticOrder, PG8_ALIGN, PG8_SP2, true>(F.lds + RING_OFF, gm, S, E); } }
#endif
    xcd_barrier(bar);
#ifndef NO_P5
#ifdef PROBE_P5X2
    { for (int u = blockIdx.x; u < MTOK / 32; u += F.G) peer_unit<true>(F, u);
      for (int u = blockIdx.x; u < MTOK / 32; u += F.G) peer_unit<false>(F, u); }
#else
    for (int u = blockIdx.x; u < MTOK / 32; u += F.G) peer_unit(F, u);
#endif
#endif
}

extern "C" void kernel_launch(void* const* d_in, const int* in_sizes, int n_in, void* d_out, int out_size, void* d_ws, size_t ws_size, hipStream_t stream) {
    static int grid = 0;
    if (grid == 0) {
        if (n_in != 18 || out_size != MTOK * DM || ws_size < WS_END) { fprintf(stderr, "kernel_launch: unexpected shapes (n_in %d, out %d, ws %zu)\n", n_in, out_size, ws_size); grid = -1; return; }
        int dev = 0, cus = 0, per_cu = 0;
        if (hipGetDevice(&dev) != hipSuccess || hipDeviceGetAttribute(&cus, hipDeviceAttributeMultiprocessorCount, dev) != hipSuccess) { grid = -1; return; }
        if (hipFuncSetAttribute((const void*)hybrid_fwd, hipFuncAttributeMaxDynamicSharedMemorySize, LDS_BYTES) != hipSuccess) { fprintf(stderr, "kernel_launch: hipFuncSetAttribute failed\n"); grid = -1; return; }
        if (hipOccupancyMaxActiveBlocksPerMultiprocessor(&per_cu, (const void*)hybrid_fwd, NWAVES * 64, LDS_BYTES) != hipSuccess || per_cu < 1)
            fprintf(stderr, "kernel_launch: note: occupancy query reports %d workgroups per CU\n", per_cu);
        (void)hipGetLastError();
        grid = cus;
    }
    if (grid < 0) return;
    if (hipMemsetAsync((char*)d_ws + WS_CTL, 0, CTL_ZERO_BYTES, stream) != hipSuccess) return;
    Args a{};
    for (int i = 0; i < 18; ++i) a.in[i] = (const float*)d_in[i];
    a.out = (float*)d_out; a.ws = (unsigned char*)d_ws;
    hipLaunchKernelGGL(hybrid_fwd, dim3(grid), dim3(NWAVES * 64), LDS_BYTES, stream, a);
}
```

```cpp
#include <hip/hip_runtime.h>
#include <cstdio>
#include <cstdint>
namespace pg8 {
#define PG8_LAS __attribute__((address_space(3)))
typedef unsigned short bf16_t;
typedef short bf16x8 __attribute__((ext_vector_type(8)));
typedef float f32x4 __attribute__((ext_vector_type(4)));
typedef unsigned u32x4 __attribute__((ext_vector_type(4)));
constexpr int BM = 256, BK = 64, HALF = 128, HTB = HALF * BK * 2  , STAGE_BYTES = 8 * HTB, NXCD = 8, WGM = 8;

__host__ __device__ __forceinline__ int lds_byte(int r, int c) { const int st = (r >> 4) * 2 + (c >> 5), rr = r & 15, cc = c & 31, ob = rr * 64 + cc * 2; return st * 1024 + (ob ^ (((ob >> 9) & 1) << 5)); }
__host__ __device__ __forceinline__ void stage_rc(int b, int& R, int& C) { const int st = b / 1024, sb = b % 1024, swz = sb ^ (((sb >> 9) & 1) << 5); R = (st >> 1) * 16 + swz / 64; C = (st & 1) * 32 + (swz % 64) / 2; }
__host__ __device__ __forceinline__ int perm32(int rho) { const int n = rho >> 4, i = rho & 15; return 8 * (i >> 2) + 4 * n + (i & 3); }

struct Unit { int pm, pn; };
struct Gemm { const bf16_t* A; const bf16_t* Bt; int M, N, K; };

struct StaticOrder {
    int nM, nN, nwg, G, c;
    __host__ __device__ void init(int M, int N, int G_, int c_) { nM = M / BM; nN = N / BM; nwg = nM * nN; G = G_; c = c_; }
    __host__ __device__ bool next(int i, Unit& u) const {
        const long L = (long)i * G + c; if (L >= nwg) return false;
        int wgid = (int)L; { const int q = nwg / NXCD, r = nwg % NXCD, xcd = wgid % NXCD, off = wgid / NXCD; wgid = (xcd < r ? xcd * (q + 1) : r * (q + 1) + (xcd - r) * q) + off; }
        const int nig = WGM * nN, gid = wgid / nig, fm = gid * WGM, gsz = (nM - fm) < WGM ? (nM - fm) : WGM;
        u.pm = fm + ((wgid % nig) % gsz); u.pn = (wgid % nig) / gsz; return true;
    }
    __device__ __forceinline__ void a_ready(const Unit&) const {}
    __device__ __forceinline__ void done(const Unit&) const {}
};

__device__ __forceinline__ unsigned cvt_pk_bf16(float lo, float hi) { unsigned r; asm volatile("v_cvt_pk_bf16_f32 %0, %1, %2" : "=v"(r) : "v"(lo), "v"(hi)); return r; }
typedef float f32x2 __attribute__((ext_vector_type(2)));
__device__ __forceinline__ f32x2 gelu_pk(f32x2 v) {
    const f32x2 av = __builtin_elementwise_abs(v), d = av * 0.2316418882f + 1.0f;
    f32x2 t; t.x = __builtin_amdgcn_rcpf(d.x); t.y = __builtin_amdgcn_rcpf(d.y);
    f32x2 q = t * 0.5307027145f + (-0.7265760135f); q = q * t + 0.7107068705f; q = q * t + (-0.142248368f); q = q * t + 0.127414796f; q = q * t;
    const f32x2 s = (v * v) * (-0.72134752044f);
    f32x2 e; e.x = __builtin_amdgcn_exp2f(s.x); e.y = __builtin_amdgcn_exp2f(s.y);
    const f32x2 m = v * (q * e), r = v - m;
    f32x2 o; o.x = v.x < 0.f ? m.x : r.x; o.y = v.y < 0.f ? m.y : r.y; return o;
}

template <int ACT  > struct EpiBf16 {
    static constexpr bool PERM = true, AFTER_DRAIN = false, SEG = false; static_assert(ACT == 0 || ACT == 1, "EpiBf16: ACT is 0 (none) or 1 (gelu_pk)");
    bf16_t* O; int ldc; const float* bias; int split_cols; size_t split_stride; float scale0;
    __device__ __forceinline__ void operator()(const f32x4 (&acc)[2][2][4][2], const Unit& u, int wr, int wc, int fr, int fq) const {
        const int row0 = u.pm * BM + wr * 64 + fr; int colt = u.pn * BM; bf16_t* base = O;
        float sc = 1.f; if (split_cols) { const int t = colt / split_cols; base += (size_t)t * split_stride; colt -= t * split_cols; if (t == 0) sc = scale0; }
        const int col0 = colt + wc * 32 + 8 * fq, bcol0 = u.pn * BM + wc * 32 + 8 * fq;
        f32x4 bv[2][2];
#pragma unroll
        for (int bj = 0; bj < 2; ++bj)
#pragma unroll
            for (int n = 0; n < 2; ++n) bv[bj][n] = bias ? *(const f32x4*)(bias + bcol0 + bj * HALF + 4 * n) : (f32x4){0.f, 0.f, 0.f, 0.f};
#pragma unroll
        for (int ai = 0; ai < 2; ++ai)
#pragma unroll
            for (int m = 0; m < 4; ++m) { bf16_t* rowp = base + (size_t)(row0 + ai * HALF + m * 16) * ldc + col0;
#pragma unroll
                for (int bj = 0; bj < 2; ++bj) { f32x4 v0 = acc[ai][bj][m][0] + bv[bj][0], v1 = acc[ai][bj][m][1] + bv[bj][1];
                    if (ACT == 1) { f32x2 a = gelu_pk((f32x2){v0[0], v0[1]}), b = gelu_pk((f32x2){v0[2], v0[3]}), c = gelu_pk((f32x2){v1[0], v1[1]}), d = gelu_pk((f32x2){v1[2], v1[3]});
                        v0 = (f32x4){a.x, a.y, b.x, b.y}; v1 = (f32x4){c.x, c.y, d.x, d.y}; }
                    v0 = v0 * sc; v1 = v1 * sc; u32x4 w; w.x = cvt_pk_bf16(v0[0], v0[1]); w.y = cvt_pk_bf16(v0[2], v0[3]); w.z = cvt_pk_bf16(v1[0], v1[1]); w.w = cvt_pk_bf16(v1[2], v1[3]);
                    *(u32x4*)(rowp + bj * HALF) = w; } }
    }
};
template <class Epi, class Sched, bool ALIGN_EPI = false, bool SP2 = false, bool F8 = false>
__device__ __forceinline__ void gemm_phase(PG8_LAS unsigned char* lds, const Gemm g, const Sched& S, const Epi& E) {
    int tid_ = threadIdx.x; asm volatile("" : "+v"(tid_));
    const int tid = tid_, wid = __builtin_amdgcn_readfirstlane(tid >> 6), lane = tid & 63, wr = wid >> 2, wc = wid & 3, fr = lane & 15, fq = lane >> 4;
    const int K = g.K, nt = K / BK;
    unsigned voffA[2], voffB[2];
#pragma unroll
    for (int i = 0; i < 2; ++i) { int R, C; stage_rc(tid * 16 + i * 8192, R, C); const int Rb = Epi::PERM ? ((R & ~31) + perm32(R & 31)) : R;
        voffA[i] = (unsigned)(R * K + C) * 2u; voffB[i] = (unsigned)(Rb * K + C) * 2u; }
    const size_t kstep = (size_t)(BK * 2);
    const size_t hstep = (size_t)HALF * K * 2;
    const size_t tstep = 2 * hstep;
    const unsigned ldsw = (unsigned)wid * 1024u;
    const int aoff = lds_byte(wr * 64 + fr, fq * 8), boff = lds_byte(wc * 32 + fr, fq * 8);
#define PG8_SA(b, h) (((b) * 2 + (h)) * HTB)
#define PG8_SB(b, h) ((4 + (b) * 2 + (h)) * HTB)
#define PG8_STAGE(bufoff, gbase, voff) do { _Pragma("unroll") for (int _i = 0; _i < 2; ++_i) \
        __builtin_amdgcn_global_load_lds((const unsigned*)((const char*)(gbase) + (voff)[_i]), (PG8_LAS unsigned*)(lds + (bufoff) + ldsw + _i * 8192), 16, 0, 0); } while (0)
#define PG8_LDA(dst, b, h) do { _Pragma("unroll") for (int m = 0; m < 4; ++m) _Pragma("unroll") for (int k = 0; k < 2; ++k) dst[m][k] = *(const PG8_LAS bf16x8*)(lds + PG8_SA(b, h) + aoff + m * 2048 + k * 1024); } while (0)
#define PG8_LDB(dst, b, h) do { _Pragma("unroll") for (int n = 0; n < 2; ++n) _Pragma("unroll") for (int k = 0; k < 2; ++k) dst[n][k] = *(const PG8_LAS bf16x8*)(lds + PG8_SB(b, h) + boff + n * 2048 + k * 1024); } while (0)
#define PG8_MMA(ai, bj, At, Bt) do { __builtin_amdgcn_s_setprio(1); _Pragma("unroll") for (int m = 0; m < 4; ++m) _Pragma("unroll") for (int n = 0; n < 2; ++n) { \
        if constexpr (F8) { typedef int v8i_ __attribute__((ext_vector_type(8))); typedef int v4i_ __attribute__((ext_vector_type(4))); \
            const v4i_ b0_ = __builtin_bit_cast(v4i_, Bt[n][0]), b1_ = __builtin_bit_cast(v4i_, Bt[n][1]), a0_ = __builtin_bit_cast(v4i_, At[m][0]), a1_ = __builtin_bit_cast(v4i_, At[m][1]); \
            const v8i_ bb_ = {b0_.x, b0_.y, b0_.z, b0_.w, b1_.x, b1_.y, b1_.z, b1_.w}, aa_ = {a0_.x, a0_.y, a0_.z, a0_.w, a1_.x, a1_.y, a1_.z, a1_.w}; \
            asm volatile("v_mfma_scale_f32_16x16x128_f8f6f4 %0, %1, %2, %0, %3, %3 op_sel_hi:[0,0,0]" : "+v"(acc[ai][bj][m][n]) : "v"(bb_), "v"(aa_), "v"(f8one)); } \
        else { _Pragma("unroll") for (int k = 0; k < 2; ++k) acc[ai][bj][m][n] = __builtin_amdgcn_mfma_f32_16x16x32_bf16(Bt[n][k], At[m][k], acc[ai][bj][m][n], 0, 0, 0); } } \
        __builtin_amdgcn_s_setprio(0); } while (0)
#define PG8_WAIT_V(n) asm volatile("s_waitcnt vmcnt(" #n ")" ::: "memory")
#define PG8_WAIT_L(n) asm volatile("s_waitcnt lgkmcnt(" #n ")" ::: "memory")
#define PG8_BAR __builtin_amdgcn_s_barrier()
#define PG8_SCHED __builtin_amdgcn_sched_barrier(0)
    Unit cur, nxt; int ui = 0;
    if (!S.next(0, cur)) return;
    f32x4 acc[2][2][4][2];
    const int f8one = 0x7f7f7f7f;
#pragma unroll
    for (int a = 0; a < 2; ++a)
#pragma unroll
        for (int b = 0; b < 2; ++b)
#pragma unroll
            for (int m = 0; m < 4; ++m)
#pragma unroll
                for (int n = 0; n < 2; ++n) acc[a][b][m][n] = (f32x4){0.f, 0.f, 0.f, 0.f};
    bf16x8 At[4][2], B0[2][2], B1[2][2];
    const char* cA = (const char*)g.A + (size_t)cur.pm * tstep; const char* cB = (const char*)g.Bt + (size_t)cur.pn * tstep;
    S.a_ready(cur);
    float segr[16];
    if constexpr (Epi::SEG) E.seg_load(ui, wr, fr, segr);
    if constexpr (SP2) {
        PG8_STAGE(PG8_SB(0, 0), cB, voffB); PG8_STAGE(PG8_SB(0, 1), cB + hstep, voffB); PG8_STAGE(PG8_SA(0, 0), cA, voffA); PG8_STAGE(PG8_SA(0, 1), cA + hstep, voffA);
        if (wr == 1) PG8_BAR;
        PG8_WAIT_V(2); PG8_BAR;
        PG8_STAGE(PG8_SB(1, 0), cB + kstep, voffB); PG8_STAGE(PG8_SA(1, 0), cA + kstep, voffA); PG8_STAGE(PG8_SB(1, 1), cB + hstep + kstep, voffB);
        PG8_WAIT_V(6); PG8_BAR;
    } else {
        PG8_STAGE(PG8_SB(0, 0), cB, voffB); PG8_STAGE(PG8_SA(0, 0), cA, voffA); PG8_STAGE(PG8_SB(0, 1), cB + hstep, voffB); PG8_STAGE(PG8_SA(0, 1), cA + hstep, voffA);
        if (wr == 1) PG8_BAR;
        PG8_WAIT_V(4); PG8_BAR;
        PG8_STAGE(PG8_SB(1, 0), cB + kstep, voffB); PG8_STAGE(PG8_SA(1, 0), cA + kstep, voffA); PG8_STAGE(PG8_SB(1, 1), cB + hstep + kstep, voffB);
        PG8_WAIT_V(6); PG8_BAR;
    }
    for (;;) {
        const bool has_next = S.next(ui + 1, nxt);
        const char* nA = has_next ? (const char*)g.A + (size_t)nxt.pm * tstep : cA; const char* nB = has_next ? (const char*)g.Bt + (size_t)nxt.pn * tstep : cB;
        int t = 0;
#pragma unroll 1
        for (int sgi = 0; sgi < (Epi::SEG ? 3 : 1); ++sgi) {
        int tend = nt; if constexpr (Epi::SEG) tend = (sgi == 0) ? Epi::SEG_T1 : ((sgi == 1) ? Epi::SEG_T2 : nt);
        for (; t < tend; t += 2) {
            const bool last = (t == nt - 2);
            const char* a1 = cA + (size_t)(t + 1) * kstep;
            const char* a2 = last ? nA : cA + (size_t)(t + 2) * kstep; const char* b2 = last ? nB : cB + (size_t)(t + 2) * kstep;
            const char* a3 = a2 + kstep; const char* b3 = b2 + kstep;
            if (last && has_next) S.a_ready(nxt);
            if constexpr (SP2) {
            PG8_LDB(B0, 0, 0); PG8_LDB(B1, 0, 1); PG8_SCHED; PG8_LDA(At, 0, 0); PG8_STAGE(PG8_SA(1, 1), a1 + hstep, voffA);
            PG8_WAIT_V(8); PG8_WAIT_L(0); PG8_BAR; PG8_MMA(0, 0, At, B0); PG8_MMA(0, 1, At, B1); PG8_BAR; PG8_SCHED;
            PG8_LDA(At, 0, 1); PG8_STAGE(PG8_SB(0, 0), b2, voffB); PG8_STAGE(PG8_SB(0, 1), b2 + hstep, voffB); PG8_STAGE(PG8_SA(0, 0), a2, voffA);
            PG8_WAIT_V(8); PG8_WAIT_L(0); PG8_BAR; PG8_MMA(1, 0, At, B0); PG8_MMA(1, 1, At, B1); PG8_BAR; PG8_SCHED;
            PG8_LDB(B0, 1, 0); PG8_LDB(B1, 1, 1); PG8_SCHED; PG8_LDA(At, 1, 0); PG8_STAGE(PG8_SA(0, 1), a2 + hstep, voffA);
            PG8_WAIT_V(8); PG8_WAIT_L(0); PG8_BAR; PG8_MMA(0, 0, At, B0); PG8_MMA(0, 1, At, B1); PG8_BAR; PG8_SCHED;
            PG8_LDA(At, 1, 1); PG8_STAGE(PG8_SB(1, 0), b3, voffB); PG8_STAGE(PG8_SB(1, 1), b3 + hstep, voffB); PG8_STAGE(PG8_SA(1, 0), a3, voffA);
            PG8_WAIT_V(8); PG8_WAIT_L(0); PG8_BAR; PG8_MMA(1, 0, At, B0); PG8_MMA(1, 1, At, B1); PG8_BAR; PG8_SCHED;
            } else {
            PG8_LDB(B0, 0, 0); PG8_SCHED; PG8_LDA(At, 0, 0); PG8_STAGE(PG8_SA(1, 1), a1 + hstep, voffA);
            PG8_WAIT_L(8); PG8_BAR; PG8_WAIT_L(0); PG8_MMA(0, 0, At, B0); PG8_BAR; PG8_SCHED;
            PG8_LDB(B1, 0, 1); PG8_STAGE(PG8_SB(0, 0), b2, voffB);
            PG8_BAR; PG8_WAIT_L(0); PG8_MMA(0, 1, At, B1); PG8_BAR;
            PG8_LDA(At, 0, 1); PG8_STAGE(PG8_SA(0, 0), a2, voffA);
            PG8_BAR; PG8_WAIT_L(0); PG8_MMA(1, 0, At, B0); PG8_BAR; PG8_SCHED;
            PG8_STAGE(PG8_SB(0, 1), b2 + hstep, voffB);
            PG8_WAIT_V(6); PG8_BAR; PG8_MMA(1, 1, At, B1); PG8_BAR;
            PG8_LDB(B0, 1, 0); PG8_SCHED; PG8_LDA(At, 1, 0); PG8_STAGE(PG8_SA(0, 1), a2 + hstep, voffA);
            PG8_WAIT_L(8); PG8_BAR; PG8_WAIT_L(0); PG8_MMA(0, 0, At, B0); PG8_BAR; PG8_SCHED;
            PG8_LDB(B1, 1, 1); PG8_STAGE(PG8_SB(1, 0), b3, voffB);
            PG8_BAR; PG8_WAIT_L(0); PG8_MMA(0, 1, At, B1); PG8_BAR;
            PG8_LDA(At, 1, 1); PG8_STAGE(PG8_SA(1, 0), a3, voffA);
            PG8_BAR; PG8_WAIT_L(0); PG8_MMA(1, 0, At, B0); PG8_BAR; PG8_SCHED;
            PG8_STAGE(PG8_SB(1, 1), b3 + hstep, voffB);
            PG8_WAIT_V(6); PG8_BAR; PG8_MMA(1, 1, At, B1); PG8_BAR;
            }
        }
        if constexpr (Epi::SEG) E.seg_apply(acc, segr, sgi);
        }
        if constexpr (ALIGN_EPI) { if (wr == 0) PG8_BAR; }
        if constexpr (!Epi::AFTER_DRAIN) { if constexpr (Epi::SEG) E(acc, cur, wr, wc, fr, fq, ui); else E(acc, cur, wr, wc, fr, fq); S.done(cur); }
        if (!has_next) break;
#pragma unroll
        for (int a = 0; a < 2; ++a)
#pragma unroll
            for (int b = 0; b < 2; ++b)
#pragma unroll
                for (int m = 0; m < 4; ++m)
#pragma unroll
                    for (int n = 0; n < 2; ++n) acc[a][b][m][n] = (f32x4){0.f, 0.f, 0.f, 0.f};
        cur = nxt; cA = nA; cB = nB; ++ui;
        if constexpr (Epi::SEG) E.seg_load(ui, wr, fr, segr);
        if constexpr (ALIGN_EPI) { if (wr == 1) PG8_BAR; }
    }
    PG8_WAIT_V(0);
    if constexpr (!ALIGN_EPI) { if (wr == 0) PG8_BAR; }
    PG8_BAR;
    if constexpr (Epi::AFTER_DRAIN) { E.fused(acc, cur, wr, wc, fr, fq, lds, wid, lane); S.done(cur); }
#undef PG8_SA
#undef PG8_SB
#undef PG8_STAGE
#undef PG8_LDA
#undef PG8_LDB
#undef PG8_MMA
#undef PG8_WAIT_V
#undef PG8_WAIT_L
#undef PG8_BAR
#undef PG8_SCHED
}
}
#ifndef PG8_SP2
#define PG8_SP2 true
#endif
#ifndef PG8_ALIGN
#define PG8_ALIGN true
#endif

constexpr int BATCH = 8, SEQ = 2048, DM = 2048, MTOK = BATCH * SEQ;
constexpr int ATT_W = 1024, ATT_H = 8, ATT_HD = 128, MOBA_BLK = 256, NBLK = SEQ / MOBA_BLK;
constexpr int SSM_W = 1024, SSM_H = 16, SSM_P = 64, SSM_N = 128, SSM_L = 128, SSM_NC = SEQ / SSM_L, CONV_CH = 1536;
constexpr int IN_PROJ = 5648, NPROJ = 5632  , NPAD = 5888  ;
constexpr int F8_LO = 2048, F8_HI = 4096, NB16 = NPAD - (F8_HI - F8_LO)  ;
constexpr float SH8 = 16.f;
constexpr int COL_Q = 0, COL_K = 1024, COL_V = 2048, COL_Z = 3072, COL_XBC = 4096;
constexpr int PEER_H = 8, PEER_NK = 128, PEER_K = 16, PEER_HK = 128;
constexpr float EPS = 1e-6f;
constexpr float SU = 64.f, SV = 4.f, SH = 16.f, SLO = 16.f;
constexpr float SX8 = 16.f, SW8 = 1024.f;
constexpr float SA8 = 32.f, SS8 = 8.f;
constexpr float SH4 = 1.5f, SLO4 = 4.f;
constexpr int ROWB = DM / 2;

constexpr size_t MiB = 1u << 20;
constexpr size_t WS_CTL = 0, CTL_ZERO_BYTES = 1 * MiB;
constexpr size_t WS_DT = 1 * MiB;
constexpr size_t WS_SK = 2 * MiB;
constexpr size_t WS_WIN = 4 * MiB;
constexpr size_t WS_WIN8 = 24 * MiB;
constexpr size_t WS_HN8 = 396 * MiB;
constexpr size_t WS_WOUT = 28 * MiB;
constexpr size_t WS_WQ = 36 * MiB;
constexpr size_t WS_HN = 44 * MiB;
constexpr size_t WS_PROJ = 108 * MiB;
constexpr size_t WS_X1B = WS_PROJ, WS_QP = WS_PROJ + 64 * MiB;
constexpr size_t WS_U8 = 284 * MiB, WS_V8 = 316 * MiB;
constexpr size_t WS_XBC = 348 * MiB;
constexpr size_t WS_DT2 = 3 * MiB;
constexpr size_t WS_X18 = 396 * MiB;
constexpr size_t WS_END = 428 * MiB;
constexpr int CW_BAR = 4096;
constexpr int CW_Q2 = 8192;
constexpr int CW_KMEAN = 32768;
constexpr int CW_SSQ = 131072;
static_assert((CW_SSQ + MTOK * 4) * 4 <= (int)CTL_ZERO_BYTES, "CTL words inside the memset region");

constexpr int RING_OFF = 0, RING_BYTES = 131072;
constexpr int LDSCTL_OFF = RING_BYTES, MISC_OFF = LDSCTL_OFF + 320;
constexpr int SEGTAB_OFF = LDSCTL_OFF + 1024;  static_assert(LDSCTL_OFF + 1024 + 3 * 256 * 16 <= 147456, "segment table inside the LDS allocation");
constexpr int LDS_BYTES = 147456;
constexpr int NWAVES = 8;

#define GAS __attribute__((address_space(1)))
#define LAS __attribute__((address_space(3)))
typedef unsigned short bf16;
typedef unsigned v4u __attribute__((ext_vector_type(4)));
typedef unsigned v2u __attribute__((ext_vector_type(2)));
typedef float f32x4 __attribute__((ext_vector_type(4)));
typedef float f32x2 __attribute__((ext_vector_type(2)));
typedef short bf16x8 __attribute__((ext_vector_type(8)));
typedef short s16x4 __attribute__((ext_vector_type(4)));
typedef GAS unsigned gu32;
#define RLX_AGENT __ATOMIC_RELAXED, __HIP_MEMORY_SCOPE_AGENT
#define LDS_WAIT() asm volatile("s_waitcnt lgkmcnt(0)" ::: "memory")
#define VM_WAIT() asm volatile("s_waitcnt vmcnt(0)" ::: "memory")
__device__ __forceinline__ unsigned f2bf(float f) { unsigned u = __builtin_bit_cast(unsigned, f); return (u + 0x7fffu + ((u >> 16) & 1u)) >> 16; }
typedef __bf16 bf16v2 __attribute__((ext_vector_type(2)));
__device__ __forceinline__ unsigned pk2(float lo, float hi) { bf16v2 v; v.x = (__bf16)lo; v.y = (__bf16)hi; return __builtin_bit_cast(unsigned, v); }
__device__ __forceinline__ float bflo(unsigned w) { return __builtin_bit_cast(float, w << 16); }
__device__ __forceinline__ float bfhi(unsigned w) { return __builtin_bit_cast(float, w & 0xffff0000u); }
__device__ __forceinline__ float wave_sum(float v) {
#pragma unroll
    for (int o = 1; o < 64; o <<= 1) v += __shfl_xor(v, o);
    return v;
}
__device__ __forceinline__ float silu_f(float x) { return x * __builtin_amdgcn_rcpf(1.f + __expf(-x)); }

#define XB_TMO      128
#define XB_XCNT(j)  (256  + 64 * (j))
#define XB_XSUB(j)  (1280 + 64 * (j))
#define XB_XGEN(j)  (2304 + 64 * (j))
#define XB_TOP      3328
#define XB_TOPGEN   3392
#define XCD_BAR_WORDS 3456
#define XB_SPIN_CAP (1u << 18)

__device__ __forceinline__ unsigned xb_ld(unsigned* p)              { return __hip_atomic_load(p, __ATOMIC_RELAXED, __HIP_MEMORY_SCOPE_AGENT); }
__device__ __forceinline__ unsigned xb_add(unsigned* p, unsigned v) { return __hip_atomic_fetch_add(p, v, __ATOMIC_RELAXED, __HIP_MEMORY_SCOPE_AGENT); }
__device__ __forceinline__ unsigned xb_xcc_id() { return (unsigned)__builtin_amdgcn_s_getreg((3 << 11) | 20) & 0xFu; }
#define XB_SPIN(cond, bar) do { unsigned _sp = 0; while (cond) { __builtin_amdgcn_s_sleep(1); \
    if ((++_sp & 255u) == 0u) { if (xb_ld(&(bar)[XB_TMO])) break; if (_sp > XB_SPIN_CAP) { atomicAdd(&(bar)[XB_TMO], 1u); break; } } } } while (0)

struct XcdBarrier {
    unsigned* bar; unsigned x;
    volatile LAS unsigned* st;
};
__device__ __forceinline__ XcdBarrier xcd_barrier_post(unsigned* bar, volatile LAS unsigned* st) {
    XcdBarrier b; b.bar = bar; b.x = xb_xcc_id(); b.st = st;
    if (threadIdx.x == 0) (void)xb_add(&bar[XB_XCNT(b.x)], 1u);
    return b;
}
__device__ __forceinline__ void xcd_barrier_complete(unsigned* bar, unsigned x, unsigned& nloc, unsigned& nx) {
    const unsigned G = gridDim.x * gridDim.y * gridDim.z;
    unsigned sum, cnt, mine, sp = 0u;
    for (;;) {
        sum = 0u; cnt = 0u; mine = 0u;
#pragma unroll
        for (unsigned j = 0; j < 16; ++j) { const unsigned c = xb_ld(&bar[XB_XCNT(j)]); sum += c; cnt += (c > 0u) ? 1u : 0u; mine = (j == x) ? c : mine; }
        if (sum == G) break;
        __builtin_amdgcn_s_sleep(1);
        if ((++sp & 255u) == 0u) { if (xb_ld(&bar[XB_TMO])) break; if (sp > XB_SPIN_CAP) { atomicAdd(&bar[XB_TMO], 1u); break; } }
    }
    nloc = mine > 0u ? mine : 1u; nx = cnt > 0u ? cnt : 1u;
}
__device__ __forceinline__ void xcd_barrier(const XcdBarrier& b) {
    asm volatile("s_waitcnt vmcnt(0)" ::: "memory");
    __syncthreads();
    if (threadIdx.x == 0) {
        unsigned* bar = b.bar;
        __builtin_amdgcn_s_waitcnt(0);
        unsigned nloc = b.st[0], nx = b.st[1];
        if (nloc == 0u) { xcd_barrier_complete(bar, b.x, nloc, nx); b.st[0] = nloc; b.st[1] = nx; }
        const unsigned old = xb_add(&bar[XB_XSUB(b.x)], 1u);
        const unsigned gen = old / nloc;
        if (old + 1u == (gen + 1u) * nloc) {
            __builtin_amdgcn_fence(__ATOMIC_RELEASE, "agent");
            asm volatile("s_waitcnt vmcnt(0)" ::: "memory");
            const unsigned og = xb_add(&bar[XB_TOP], 1u);
            const unsigned tg = og / nx;
            if (og + 1u == (tg + 1u) * nx) xb_add(&bar[XB_TOPGEN], 1u);
            else XB_SPIN(xb_ld(&bar[XB_TOPGEN]) == tg, bar);
            __builtin_amdgcn_fence(__ATOMIC_ACQUIRE, "agent");
            xb_add(&bar[XB_XGEN(b.x)], 1u);
            asm volatile("s_waitcnt vmcnt(0)" ::: "memory");
        } else {
            XB_SPIN(xb_ld(&bar[XB_XGEN(b.x)]) == gen, bar);
            __builtin_amdgcn_fence(__ATOMIC_ACQUIRE, "agent");
            asm volatile("s_waitcnt vmcnt(0)" ::: "memory");
        }
    }
    __syncthreads();
}

#define CAS __attribute__((address_space(4)))
struct Args { const float* in[18]; float* out; unsigned char* ws; };
__device__ __forceinline__ const CAS unsigned char* kargs() { const CAS unsigned char* p = (const CAS unsigned char*)__builtin_amdgcn_kernarg_segment_ptr(); asm volatile("" : "+s"(p)); return p; }
__device__ __forceinline__ const float* kin(int i) { return *(const float* const CAS*)(kargs() + 8 * i); }
__device__ __forceinline__ float* kout() { return *(float* const CAS*)(kargs() + 8 * 18); }
__device__ __forceinline__ unsigned char* kws() { return *(unsigned char* const CAS*)(kargs() + 8 * 19); }
__device__ __forceinline__ int fresh_tid() { int t = threadIdx.x; asm volatile("" : "+v"(t)); return t; }
struct Frame {
    LAS unsigned char* lds;
    volatile LAS unsigned* MISC;
    int tid, lane, wave, G;
    __device__ __forceinline__ const float* x() const { return kin(0); }
    __device__ __forceinline__ const float* attn_norm() const { return kin(1); }
    __device__ __forceinline__ const float* w_in() const { return kin(2); }
    __device__ __forceinline__ const float* conv_w() const { return kin(3); }
    __device__ __forceinline__ const float* conv_b() const { return kin(4); }
    __device__ __forceinline__ const float* dt_bias() const { return kin(5); }
    __device__ __forceinline__ const float* a_log() const { return kin(6); }
    __device__ __forceinline__ const float* d_skip() const { return kin(7); }
    __device__ __forceinline__ const float* rel_bias() const { return kin(8); }
    __device__ __forceinline__ const float* attn_out_norm() const { return kin(9); }
    __device__ __forceinline__ const float* ssm_out_norm() const { return kin(10); }
    __device__ __forceinline__ const float* w_out() const { return kin(11); }
    __device__ __forceinline__ const float* ffn_norm() const { return kin(12); }
    __device__ __forceinline__ const float* peer_wq() const { return kin(13); }
    __device__ __forceinline__ const float* peer_sk() const { return kin(14); }
    __device__ __forceinline__ const float* peer_u() const { return kin(15); }
    __device__ __forceinline__ const float* peer_v() const { return kin(16); }
    __device__ __forceinline__ const float* final_norm() const { return kin(17); }
    __device__ __forceinline__ float* out() const { return kout(); }
    __device__ __forceinline__ unsigned* ctl() const { return (unsigned*)(kws() + WS_CTL); }
    __device__ __forceinline__ float* dtraw() const { return (float*)(kws() + WS_DT); }
    __device__ __forceinline__ bf16* SK() const { return (bf16*)(kws() + WS_SK); }
    __device__ __forceinline__ bf16* WinT() const { return (bf16*)(kws() + WS_WIN); }
    __device__ __forceinline__ bf16* WoutT() const { return (bf16*)(kws() + WS_WOUT); }
    __device__ __forceinline__ bf16* WqT() const { return (bf16*)(kws() + WS_WQ); }
    __device__ __forceinline__ bf16* HN() const { return (bf16*)(kws() + WS_HN); }
    __device__ __forceinline__ bf16* PROJ() const { return (bf16*)(kws() + WS_PROJ); }
    __device__ __forceinline__ bf16* X1B() const { return (bf16*)(kws() + WS_X1B); }
    __device__ __forceinline__ bf16* QP() const { return (bf16*)(kws() + WS_QP); }
    __device__ __forceinline__ unsigned char* U8() const { return kws() + WS_U8; }
    __device__ __forceinline__ unsigned char* V8() const { return kws() + WS_V8; }
    __device__ __forceinline__ unsigned char* X18() const { return kws() + WS_X18; }
    __device__ __forceinline__ unsigned char* HN8() const { return kws() + WS_HN8; }
    __device__ __forceinline__ unsigned char* WinT8() const { return kws() + WS_WIN8; }
    __device__ __forceinline__ bf16* XBC() const { return (bf16*)(kws() + WS_XBC); }
    __device__ __forceinline__ float* DT2() const { return (float*)(kws() + WS_DT2); }
    __device__ __forceinline__ float* kmean() const { return (float*)(kws() + WS_CTL) + CW_KMEAN; }
    __device__ __forceinline__ float* ssq() const { return (float*)(kws() + WS_CTL) + CW_SSQ; }
};

__device__ __forceinline__ float clampf(float v, float lim);
__device__ __forceinline__ void p0_transpose_item(const float* W, int K, int N, bf16* WT, const float* gain, LAS float* scr, int item, int lane, const float f8scale = 0.f, const int nshift = 0) {
    const int nblk = (N + 31) / 32, kb = item / nblk, nb = item % nblk, k0 = 64 * kb, n0 = 32 * nb;
    const int kr = lane >> 3, nc = (lane & 7) * 4; const bool ok = (n0 + nc) < N;
    f32x4 v[8]; float gk[8];
#pragma unroll
    for (int i = 0; i < 8; ++i) { const int kk = 8 * i + kr; v[i] = ok ? *(const GAS f32x4*)(W + (size_t)(k0 + kk) * N + n0 + nc) : (f32x4){0.f, 0.f, 0.f, 0.f}; gk[i] = gain ? gain[k0 + kk] : 1.f; }
#pragma unroll
    for (int i = 0; i < 8; ++i) { const int kk = 8 * i + kr; LAS float* d = scr + kk * 33 + nc; d[0] = v[i].x * gk[i]; d[1] = v[i].y * gk[i]; d[2] = v[i].z * gk[i]; d[3] = v[i].w * gk[i]; }
    LDS_WAIT(); asm volatile("" ::: "memory");
    const int c = lane & 7;
#pragma unroll
    for (int j = 0; j < 4; ++j) { const int n = (lane >> 3) + 8 * j; const LAS float* s = scr + (8 * c) * 33 + n;
        v4u o; o.x = pk2(s[0 * 33], s[1 * 33]); o.y = pk2(s[2 * 33], s[3 * 33]); o.z = pk2(s[4 * 33], s[5 * 33]); o.w = pk2(s[6 * 33], s[7 * 33]);
        if (f8scale == 0.f) *(GAS v4u*)(WT + (size_t)(n0 + n - nshift) * K + k0 + 8 * c) = o;
        else { v2u o8; int w_;
            w_ = __builtin_amdgcn_cvt_pk_fp8_f32(clampf(s[0 * 33] * f8scale, 448.f), clampf(s[1 * 33] * f8scale, 448.f), 0, false); w_ = __builtin_amdgcn_cvt_pk_fp8_f32(clampf(s[2 * 33] * f8scale, 448.f), clampf(s[3 * 33] * f8scale, 448.f), w_, true); o8.x = (unsigned)w_;
            w_ = __builtin_amdgcn_cvt_pk_fp8_f32(clampf(s[4 * 33] * f8scale, 448.f), clampf(s[5 * 33] * f8scale, 448.f), 0, false); w_ = __builtin_amdgcn_cvt_pk_fp8_f32(clampf(s[6 * 33] * f8scale, 448.f), clampf(s[7 * 33] * f8scale, 448.f), w_, true); o8.y = (unsigned)w_;
            *(GAS v2u*)((unsigned char*)WT + (size_t)(n0 + n - nshift) * K + k0 + 8 * c) = o8; } }
    LDS_WAIT(); asm volatile("" ::: "memory");
}
__device__ __forceinline__ unsigned pk4_fp8(float a, float b, float c, float d) { int w = __builtin_amdgcn_cvt_pk_fp8_f32(clampf(a, 448.f), clampf(b, 448.f), 0, false); w = __builtin_amdgcn_cvt_pk_fp8_f32(clampf(c, 448.f), clampf(d, 448.f), w, true); return (unsigned)w; }
__device__ __forceinline__ void rms_2rows_to_bf16(const float* x0, const float* x1, const float* gain, bf16* o0, bf16* o1, unsigned char* q0, unsigned char* q1, int lane) {
    const GAS f32x4* xr0 = (const GAS f32x4*)x0 + lane; const GAS f32x4* xr1 = (const GAS f32x4*)x1 + lane; const GAS f32x4* gr = (const GAS f32x4*)gain + lane;
    f32x4 v[8], u[8]; float s = 0.f, t = 0.f;
#pragma unroll
    for (int j = 0; j < 8; ++j) { v[j] = xr0[64 * j]; u[j] = xr1[64 * j]; }
#pragma unroll
    for (int j = 0; j < 8; ++j) { s += (v[j].x * v[j].x + v[j].y * v[j].y) + (v[j].z * v[j].z + v[j].w * v[j].w); t += (u[j].x * u[j].x + u[j].y * u[j].y) + (u[j].z * u[j].z + u[j].w * u[j].w); }
    const float rs = __builtin_amdgcn_rsqf(wave_sum(s) * (1.f / DM) + EPS), rt = __builtin_amdgcn_rsqf(wave_sum(t) * (1.f / DM) + EPS);
    GAS v2u* p0 = (GAS v2u*)o0 + lane; GAS v2u* p1 = (GAS v2u*)o1 + lane; GAS unsigned* r0 = (GAS unsigned*)q0 + lane; GAS unsigned* r1 = (GAS unsigned*)q1 + lane;
#pragma unroll
    for (int j = 0; j < 8; ++j) { const f32x4 g = gr[64 * j]; v2u a, b;
        const f32x4 h0 = v[j] * g * rs, h1 = u[j] * g * rt;
        a.x = pk2(h0.x, h0.y); a.y = pk2(h0.z, h0.w); p0[64 * j] = a; r0[64 * j] = pk4_fp8(h0.x * SH8, h0.y * SH8, h0.z * SH8, h0.w * SH8);
        b.x = pk2(h1.x, h1.y); b.y = pk2(h1.z, h1.w); p1[64 * j] = b; r1[64 * j] = pk4_fp8(h1.x * SH8, h1.y * SH8, h1.z * SH8, h1.w * SH8); }
}
#ifdef PROBE_FP4EMU
__device__ __forceinline__ float fp4grid(float y) { const float a = fabsf(y); float r;
    if (a <= 2.f) r = rintf(a * 2.f) * 0.5f; else if (a <= 4.f) r = rintf(a); else r = (a < 5.f) ? 4.f : 6.f;
    return copysignf(r, y); }
__device__ __forceinline__ float clampf(float v, float lim) { if (lim == 448.5f) return fp4grid(v * (1.f / 16.f)) * 16.f; return fminf(fmaxf(v, -lim), lim); }
#else
__device__ __forceinline__ float clampf(float v, float lim) { return fminf(fmaxf(v, -lim), lim); }
#endif
template <int TAB = 0> __device__ __forceinline__ v4u cvt16_fp8(const f32x4 a, const f32x4 b, const f32x4 c, const f32x4 d, float sc) {
    v4u o; int w; constexpr float LIM = TAB ? 448.5f : 448.f;
    w = __builtin_amdgcn_cvt_pk_fp8_f32(clampf(a.x * sc, LIM), clampf(a.y * sc, LIM), 0, false); w = __builtin_amdgcn_cvt_pk_fp8_f32(clampf(a.z * sc, LIM), clampf(a.w * sc, LIM), w, true); o.x = (unsigned)w;
    w = __builtin_amdgcn_cvt_pk_fp8_f32(clampf(b.x * sc, LIM), clampf(b.y * sc, LIM), 0, false); w = __builtin_amdgcn_cvt_pk_fp8_f32(clampf(b.z * sc, LIM), clampf(b.w * sc, LIM), w, true); o.y = (unsigned)w;
    w = __builtin_amdgcn_cvt_pk_fp8_f32(clampf(c.x * sc, LIM), clampf(c.y * sc, LIM), 0, false); w = __builtin_amdgcn_cvt_pk_fp8_f32(clampf(c.z * sc, LIM), clampf(c.w * sc, LIM), w, true); o.z = (unsigned)w;
    w = __builtin_amdgcn_cvt_pk_fp8_f32(clampf(d.x * sc, LIM), clampf(d.y * sc, LIM), 0, false); w = __builtin_amdgcn_cvt_pk_fp8_f32(clampf(d.z * sc, LIM), clampf(d.w * sc, LIM), w, true); o.w = (unsigned)w;
    return o;
}
__device__ __forceinline__ void tables_convert(Frame& F, size_t lo, size_t hi, size_t tix, size_t ntx) {
      const GAS f32x4* su = (const GAS f32x4*)F.peer_u(); const GAS f32x4* sv = (const GAS f32x4*)F.peer_v(); GAS v4u* du = (GAS v4u*)F.U8(); GAS v4u* dv = (GAS v4u*)F.V8();
#pragma unroll 1
      for (int tab = 0; tab < 2; ++tab) { const GAS f32x4* src = tab ? sv : su; GAS v4u* dst = tab ? dv : du; const float sc = tab ? SV : SU;
        f32x4 nx[8]; const size_t i0 = lo + tix;
        if (i0 < hi) { const GAS f32x4* p = src + (i0 >> 6) * 512 + (i0 & 63);
#pragma unroll
            for (int j = 0; j < 8; ++j) nx[j] = p[64 * j]; }
#pragma unroll 1
        for (size_t i = i0; i < hi; i += ntx) { f32x4 v[8];
#pragma unroll
            for (int j = 0; j < 8; ++j) v[j] = nx[j];
            if (i + ntx < hi) { const size_t i2 = i + ntx; const GAS f32x4* p = src + (i2 >> 6) * 512 + (i2 & 63);
#pragma unroll
                for (int j = 0; j < 8; ++j) nx[j] = p[64 * j]; }
            unsigned wd[4];
#pragma unroll
            for (int q = 0; q < 4; ++q) { const f32x4 a = v[2 * q] * sc, b = v[2 * q + 1] * sc; unsigned w = 0u;
                w = __builtin_amdgcn_cvt_scalef32_pk_fp4_f32(w, clampf(a.x, 6.f), clampf(a.y, 6.f), 1.0f, 0); w = __builtin_amdgcn_cvt_scalef32_pk_fp4_f32(w, clampf(a.z, 6.f), clampf(a.w, 6.f), 1.0f, 1);
                w = __builtin_amdgcn_cvt_scalef32_pk_fp4_f32(w, clampf(b.x, 6.f), clampf(b.y, 6.f), 1.0f, 2); w = __builtin_amdgcn_cvt_scalef32_pk_fp4_f32(w, clampf(b.z, 6.f), clampf(b.w, 6.f), 1.0f, 3); wd[q] = w; }
            dst[i] = (v4u){wd[0], wd[1], wd[2], wd[3]}; } }
}
constexpr size_t TAB_ITEMS = (size_t)16384 * 64;
#ifndef TAB_HEAD8
#define TAB_HEAD8 4
#endif
__device__ __forceinline__ size_t tab_split(int G) { const int rem = ((MTOK / 256) * (NB16 / 256)) % G; return rem ? (TAB_ITEMS / 8) * TAB_HEAD8 : TAB_ITEMS; }
__device__ __forceinline__ unsigned fp4_code(float y) { const float a = fabsf(y);
    const unsigned m = (unsigned)(a >= 0.25f) + (unsigned)(a >= 0.75f) + (unsigned)(a >= 1.25f) + (unsigned)(a >= 1.75f) + (unsigned)(a >= 2.5f) + (unsigned)(a >= 3.5f) + (unsigned)(a >= 5.0f);
    return m | ((y < 0.f) ? 8u : 0u); }
constexpr int W_SQ_ITEMS = (DM / 64) * (DM / 32), W_SQ_PER_UNIT = 64, W_SQ_UNITS = 2 * W_SQ_ITEMS / W_SQ_PER_UNIT;
__device__ __forceinline__ void sq_weight_items(Frame& F, int unit) {
    const int tid = fresh_tid(), lane = tid & 63, wave = __builtin_amdgcn_readfirstlane(tid >> 6);
    LAS float* scr = (LAS float*)(F.lds + RING_OFF + wave * 16384);
    const float* const w_out = F.w_out(); const float* const wq = F.peer_wq(); const float* const fg = F.ffn_norm(); bf16* const WoutT = F.WoutT(); bf16* const WqT = F.WqT(); const float* const gatt = F.attn_out_norm(); const float* const gssm = F.ssm_out_norm();
#pragma unroll 1
    for (int k = 0; k < W_SQ_PER_UNIT / NWAVES; ++k) {
        int r = unit * W_SQ_PER_UNIT + k * NWAVES + wave;
        if (r < W_SQ_ITEMS) { const int k0_ = 64 * (r / (DM / 32)); p0_transpose_item(w_out, DM, DM, WoutT, (k0_ < ATT_W) ? gatt : (gssm - ATT_W), scr, r, lane, SW8); }
        else { r -= W_SQ_ITEMS; p0_transpose_item(wq, DM, DM, WqT, fg, scr, r, lane, SW8); }
    }
}
__device__ __forceinline__ void p0_prologue(Frame& F) {
    const int tid = fresh_tid(), lane = tid & 63, wave = __builtin_amdgcn_readfirstlane(tid >> 6);
    LAS float* scr = (LAS float*)(F.lds + RING_OFF + wave * 16384);
    const int gw = blockIdx.x * NWAVES + wave, NGW = F.G * NWAVES;
    constexpr int I_IN = (DM / 64) * ((IN_PROJ + 31) / 32), I_SQ = (DM / 64) * (DM / 32);
    constexpr int NITEMS = I_IN;
    { const float* const w_in = F.w_in(); const float* const w_out = F.w_out(); const float* const wq = F.peer_wq(); const float* const fg = F.ffn_norm(); bf16* const WinT = F.WinT(); unsigned char* const WinT8 = F.WinT8(); bf16* const WoutT = F.WoutT(); bf16* const WqT = F.WqT(); const float* const gatt = F.attn_out_norm(); const float* const gssm = F.ssm_out_norm();
      for (int it = gw; it < NITEMS; it += NGW) {
        int r = it;
        if (r < I_IN) { const int n0_ = 32 * (r % ((IN_PROJ + 31) / 32));
            if (n0_ >= F8_LO && n0_ < F8_HI) p0_transpose_item(w_in, DM, IN_PROJ, (bf16*)WinT8, nullptr, scr, r, lane, SW8, F8_LO);
            else p0_transpose_item(w_in, DM, IN_PROJ, WinT, nullptr, scr, r, lane, 0.f, (n0_ >= F8_HI) ? (F8_HI - F8_LO) : 0);
            continue; } r -= I_IN;
      } }
    const size_t gt = (size_t)blockIdx.x * (NWAVES * 64) + tid, GT = (size_t)F.G * NWAVES * 64;
    { const size_t z0 = (size_t)(5664 - (F8_HI - F8_LO)) * DM / 8, z1 = (size_t)NB16 * DM / 8; GAS v4u* p = (GAS v4u*)F.WinT(); for (size_t i = z0 + gt; i < z1; i += GT) p[i] = (v4u){0u, 0u, 0u, 0u}; }
    { const float* const s = F.peer_sk(); GAS v4u* d = (GAS v4u*)F.SK();
      for (size_t o = gt; o < (size_t)16 * 128 * 128 / 8; o += GT) { const int frag = (int)(o >> 6), l = (int)(o & 63), g_ = l >> 4, c_ = l & 15, p_ = frag >> 5, kb_ = (frag >> 2) & 7, ks_ = frag & 3;
          const GAS f32x4* sp = (const GAS f32x4*)(s + (size_t)(p_ * 128 + 16 * kb_ + c_) * 128 + 32 * ks_ + 8 * g_); const f32x4 a = sp[0], b = sp[1];
          v4u w; w.x = pk2(a.x, a.y); w.y = pk2(a.z, a.w); w.z = pk2(b.x, b.y); w.w = pk2(b.z, b.w); d[o] = w; } }
    { const float* const xg = F.x(); const float* const gn = F.attn_norm(); bf16* const hn = F.HN(); unsigned char* const hn8 = F.HN8();
      for (int m = gw; m < MTOK / 2; m += NGW) rms_2rows_to_bf16(xg + (size_t)(2 * m) * DM, xg + (size_t)(2 * m + 1) * DM, gn, hn + (size_t)(2 * m) * DM, hn + (size_t)(2 * m + 1) * DM, hn8 + (size_t)(2 * m) * DM, hn8 + (size_t)(2 * m + 1) * DM, lane); }
}

struct EpiProj {
    static constexpr bool PERM = true, AFTER_DRAIN = false, SEG = false;
    bf16* O; float* dtraw; float* kmean;
    __device__ __forceinline__ void operator()(const pg8::f32x4 (&acc)[2][2][4][2], const pg8::Unit& u, int wr, int wc, int fr, int fq) const {
        const int rpn = (u.pn < F8_LO / 256) ? u.pn : u.pn + (F8_HI - F8_LO) / 256;
        const int row0 = u.pm * 256 + wr * 64 + fr, col0 = rpn * 256 + wc * 32 + 8 * fq;
        if (rpn < 22) {
#pragma unroll
            for (int ai = 0; ai < 2; ++ai)
#pragma unroll
                for (int m = 0; m < 4; ++m) { bf16* rowp = O + (size_t)(row0 + ai * 128 + m * 16) * NPROJ + col0;
#pragma unroll
                    for (int bj = 0; bj < 2; ++bj) { const pg8::f32x4 v0 = acc[ai][bj][m][0], v1 = acc[ai][bj][m][1];
                        pg8::u32x4 w; w.x = pg8::cvt_pk_bf16(v0[0], v0[1]); w.y = pg8::cvt_pk_bf16(v0[2], v0[3]); w.z = pg8::cvt_pk_bf16(v1[0], v1[1]); w.w = pg8::cvt_pk_bf16(v1[2], v1[3]);
                        *(pg8::u32x4*)(rowp + bj * 128) = w; } }
        } else if (wc == 0 && fq < 2) {
#pragma unroll
            for (int ai = 0; ai < 2; ++ai)
#pragma unroll
                for (int m = 0; m < 4; ++m) { float* rp = dtraw + (size_t)(row0 + ai * 128 + m * 16) * 16 + 8 * fq;
                    *(pg8::f32x4*)rp = acc[ai][0][m][0]; *(pg8::f32x4*)(rp + 4) = acc[ai][0][m][1]; }
        }
        if (kmean && u.pn >= 4 && u.pn < 8) {
#pragma unroll
            for (int bj = 0; bj < 2; ++bj)
#pragma unroll
                for (int n = 0; n < 2; ++n)
#pragma unroll
                    for (int i = 0; i < 4; ++i) { float s = 0.f;
#pragma unroll
                        for (int ai = 0; ai < 2; ++ai)
#pragma unroll
                            for (int m = 0; m < 4; ++m) s += acc[ai][bj][m][n][i];
                        s += __shfl_xor(s, 1); s += __shfl_xor(s, 2); s += __shfl_xor(s, 4); s += __shfl_xor(s, 8);
                        if (fr == 0) unsafeAtomicAdd(kmean + (size_t)u.pm * 1024 + (col0 - 1024) + bj * 128 + 4 * n + i, s); }
        }
    }
};
struct EpiProj8 {
    static constexpr bool PERM = true, AFTER_DRAIN = false, SEG = false;
    bf16* O;
    __device__ __forceinline__ void operator()(const pg8::f32x4 (&acc)[2][2][4][2], const pg8::Unit& u, int wr, int wc, int fr, int fq) const {
        const int row0 = u.pm * 256 + wr * 64 + fr, col0 = F8_LO + u.pn * 256 + wc * 32 + 8 * fq; constexpr float sc = 1.f / (SH8 * SW8);
#pragma unroll
        for (int ai = 0; ai < 2; ++ai)
#pragma unroll
            for (int m = 0; m < 4; ++m) { bf16* rowp = O + (size_t)(row0 + ai * 128 + m * 16) * NPROJ + col0;
#pragma unroll
                for (int bj = 0; bj < 2; ++bj) { const pg8::f32x4 v0 = acc[ai][bj][m][0] * sc, v1 = acc[ai][bj][m][1] * sc;
                    pg8::u32x4 w; w.x = pg8::cvt_pk_bf16(v0[0], v0[1]); w.y = pg8::cvt_pk_bf16(v0[2], v0[3]); w.z = pg8::cvt_pk_bf16(v1[0], v1[1]); w.w = pg8::cvt_pk_bf16(v1[2], v1[3]);
                    *(pg8::u32x4*)(rowp + bj * 128) = w; } }
    }
};
struct EpiOut {
    static constexpr bool PERM = true, AFTER_DRAIN = false, SEG = true; static constexpr int SEG_T1 = 8, SEG_T2 = 12;
    const float* x; bf16* x1b; unsigned char* x18; float* ssq; bool doatom; const LAS f32x4* tab;
    __device__ __forceinline__ void seg_load(int ui, int wr, int fr, float (&sr)[16]) const {
#pragma unroll
        for (int i = 0; i < 8; ++i) { const int r = (i >> 2) * 128 + wr * 64 + (i & 3) * 16 + fr; const f32x2 q = *(const LAS f32x2*)(tab + ui * 256 + r); sr[2 * i] = q.x; sr[2 * i + 1] = q.y; }
        asm volatile("s_waitcnt lgkmcnt(0)" ::: "memory");
    }
    __device__ __forceinline__ void seg_apply(pg8::f32x4 (&acc)[2][2][4][2], const float (&sr)[16], int which) const {
#pragma unroll
        for (int ai = 0; ai < 2; ++ai)
#pragma unroll
            for (int m = 0; m < 4; ++m) { const float f = (which == 0) ? sr[2 * (ai * 4 + m)] : ((which == 1) ? sr[2 * (ai * 4 + m) + 1] : 1.0f);
#pragma unroll
                for (int bj = 0; bj < 2; ++bj)
#pragma unroll
                    for (int n = 0; n < 2; ++n) acc[ai][bj][m][n] = acc[ai][bj][m][n] * f; }
    }
    __device__ __forceinline__ void operator()(const pg8::f32x4 (&acc)[2][2][4][2], const pg8::Unit& u, int wr, int wc, int fr, int fq, int ui) const {
        const int row0 = u.pm * 256 + wr * 64 + fr, col0 = u.pn * 256 + wc * 32 + 8 * fq;
#pragma unroll
        for (int ai = 0; ai < 2; ++ai)
#pragma unroll
            for (int m = 0; m < 4; ++m) { const int row = row0 + ai * 128 + m * 16; const size_t off = (size_t)row * DM + col0; float s = 0.f;
                const float s1 = (*(const LAS f32x4*)(tab + ui * 256 + ai * 128 + wr * 64 + m * 16 + fr)).z;
#pragma unroll
                for (int bj = 0; bj < 2; ++bj) {
                    const pg8::f32x4 a0 = *(const pg8::f32x4*)(x + off + bj * 128), a1 = *(const pg8::f32x4*)(x + off + bj * 128 + 4);
                    const pg8::f32x4 v0 = acc[ai][bj][m][0] * s1 + a0, v1 = acc[ai][bj][m][1] * s1 + a1;
                    pg8::u32x4 w; w.x = pg8::cvt_pk_bf16(v0[0], v0[1]); w.y = pg8::cvt_pk_bf16(v0[2], v0[3]); w.z = pg8::cvt_pk_bf16(v1[0], v1[1]); w.w = pg8::cvt_pk_bf16(v1[2], v1[3]);
                    *(pg8::u32x4*)(x1b + off + bj * 128) = w;
                    { v2u o8; int w_; w_ = __builtin_amdgcn_cvt_pk_fp8_f32(clampf(v0[0] * SX8, 448.f), clampf(v0[1] * SX8, 448.f), 0, false); w_ = __builtin_amdgcn_cvt_pk_fp8_f32(clampf(v0[2] * SX8, 448.f), clampf(v0[3] * SX8, 448.f), w_, true); o8.x = (unsigned)w_;
                      w_ = __builtin_amdgcn_cvt_pk_fp8_f32(clampf(v1[0] * SX8, 448.f), clampf(v1[1] * SX8, 448.f), 0, false); w_ = __builtin_amdgcn_cvt_pk_fp8_f32(clampf(v1[2] * SX8, 448.f), clampf(v1[3] * SX8, 448.f), w_, true); o8.y = (unsigned)w_;
                      *(v2u*)(x18 + off + bj * 128) = o8; }
                    s += (v0[0] * v0[0] + v0[1] * v0[1]) + (v0[2] * v0[2] + v0[3] * v0[3]) + (v1[0] * v1[0] + v1[1] * v1[1]) + (v1[2] * v1[2] + v1[3] * v1[3]); }
                s += __shfl_xor(s, 16); s += __shfl_xor(s, 32);
                if (fq == 0 && doatom) unsafeAtomicAdd(ssq + (size_t)row * 4, s);
                asm volatile("" ::: "memory"); }
    }
};
struct EpiQ {
    static constexpr bool PERM = true, AFTER_DRAIN = false, SEG = false;
    bf16* O; const float* ssq;
    __device__ __forceinline__ void operator()(const pg8::f32x4 (&acc)[2][2][4][2], const pg8::Unit& u, int wr, int wc, int fr, int fq) const {
        const int row0 = u.pm * 256 + wr * 64 + fr, col0 = u.pn * 256 + wc * 32 + 8 * fq;
#pragma unroll
        for (int ai = 0; ai < 2; ++ai)
#pragma unroll
            for (int m = 0; m < 4; ++m) { const int row = row0 + ai * 128 + m * 16; bf16* rowp = O + (size_t)row * DM + col0;
                const float rs = (1.f / (SX8 * SW8)) / sqrtf(__hip_atomic_load(ssq + (size_t)row * 4, RLX_AGENT) * (1.f / DM) + EPS);
#pragma unroll
                for (int bj = 0; bj < 2; ++bj) { const pg8::f32x4 v0 = acc[ai][bj][m][0] * rs, v1 = acc[ai][bj][m][1] * rs;
                    pg8::u32x4 w; w.x = pg8::cvt_pk_bf16(v0[0], v0[1]); w.y = pg8::cvt_pk_bf16(v0[2], v0[3]); w.z = pg8::cvt_pk_bf16(v1[0], v1[1]); w.w = pg8::cvt_pk_bf16(v1[2], v1[3]);
                    *(pg8::u32x4*)(rowp + bj * 128) = w; } }
    }
};

constexpr int A_KSTR = 272, A_VSTR = 288;
constexpr int A_KB0 = 0, A_KB1 = 64 * A_KSTR, A_VB0 = 2 * 64 * A_KSTR, A_VBS = 64 * A_VSTR  , A_KM = A_VB0 + 3 * A_VBS, A_TAB = A_KM + 8 * 128 * 4, A_END = A_TAB + 128 * 4;
static_assert(A_END <= RING_BYTES && (A_KM % 16) == 0, "attention LDS map");
#define PIN16(a, i) asm volatile("" : "+v"(a[i]), "+v"(a[i + 1]), "+v"(a[i + 2]), "+v"(a[i + 3]), "+v"(a[i + 4]), "+v"(a[i + 5]), "+v"(a[i + 6]), "+v"(a[i + 7]), "+v"(a[i + 8]), "+v"(a[i + 9]), "+v"(a[i + 10]), "+v"(a[i + 11]), "+v"(a[i + 12]), "+v"(a[i + 13]), "+v"(a[i + 14]), "+v"(a[i + 15]))
#define TR16(p) __builtin_amdgcn_ds_read_tr16_b64_v4i16((LAS s16x4*)(p))
#define MFMA16(a, b, c) __builtin_amdgcn_mfma_f32_16x16x32_bf16((a), (b), (c), 0, 0, 0)
__device__ __forceinline__ bf16x8 pack8(const float* v) {
    const unsigned a = pk2(v[0], v[1]), b = pk2(v[2], v[3]), c = pk2(v[4], v[5]), d = pk2(v[6], v[7]);
    const v4u u = {a, b, c, d}; return __builtin_bit_cast(bf16x8, u);
}
__device__ __forceinline__ void attn_unit(Frame& F, int b, int h, int blk, const bool doatom = true) {
    LAS unsigned char* lds = F.lds + RING_OFF;
    const int tid = fresh_tid(), lane = tid & 63, w = __builtin_amdgcn_readfirstlane(tid >> 6), g = lane >> 4, c16 = lane & 15, q4 = c16 >> 2, p4 = lane & 3;
    const int own = blk, t0 = blk * 256, tq0 = t0 + 32 * w + c16;
    const size_t rowbase = (size_t)b * SEQ;
    const float NEG_INF = -__builtin_inff();
    constexpr float LOG2E = 1.4426950408889634f, SCL2 = 0.08838834764831845f * 1.4426950408889634f;
    LAS float* km = (LAS float*)(lds + A_KM); LAS float* tab = (LAS float*)(lds + A_TAB);
    const bf16* const PROJ = F.PROJ(); const float* const kmg = F.kmean(); const float* const relb = F.rel_bias();
    for (int i = tid; i < own * 128; i += NWAVES * 64) { const int n = i >> 7, d = i & 127; km[i] = kmg[(size_t)(b * 8 + n) * 1024 + h * 128 + d] * (1.f / 256.f); }
    if (tid < 128) { const int rel = tid; int bucket = rel; if (rel >= 16) { bucket = 16 + (int)(log2f((float)rel * (1.f / 16.f)) * (16.f / 3.f)); bucket = bucket > 31 ? 31 : bucket; }
        tab[tid] = relb[bucket * 8 + h] * LOG2E; }
    bf16x8 qf[2][4];
#pragma unroll
    for (int gi = 0; gi < 2; ++gi) { const bf16* qrow = PROJ + (rowbase + tq0 + 16 * gi) * NPROJ + COL_Q + h * 128 + 8 * g;
#pragma unroll
      for (int ks = 0; ks < 4; ++ks) qf[gi][ks] = *(const GAS bf16x8*)(qrow + 32 * ks); }
    __syncthreads();
    unsigned selmask[2];
    if (own <= 3) { selmask[0] = (1u << own) - 1u; selmask[1] = selmask[0]; }
    else {
#pragma unroll
      for (int gi = 0; gi < 2; ++gi) {
        float gate[7];
#pragma unroll
        for (int n = 0; n < 7; ++n) {
            float s = NEG_INF;
            if (n < own) { s = 0.f;
#pragma unroll
                for (int ks = 0; ks < 4; ++ks) { const LAS f32x4* kp = (const LAS f32x4*)(km + n * 128 + 32 * ks + 8 * g); const f32x4 k0 = kp[0], k1 = kp[1]; const v4u qu = __builtin_bit_cast(v4u, qf[gi][ks]);
                    s += bflo(qu.x) * k0.x + bfhi(qu.x) * k0.y + bflo(qu.y) * k0.z + bfhi(qu.y) * k0.w + bflo(qu.z) * k1.x + bfhi(qu.z) * k1.y + bflo(qu.w) * k1.z + bfhi(qu.w) * k1.w; }
                s += __shfl_xor(s, 16); s += __shfl_xor(s, 32); }
            gate[n] = s;
        }
        unsigned sm = 0u;
#pragma unroll
        for (int r = 0; r < 3; ++r) { float best = NEG_INF; int bi = 0;
#pragma unroll
            for (int n = 0; n < 7; ++n) { const bool cand = (n < own) && !((sm >> n) & 1u) && (gate[n] > best); best = cand ? gate[n] : best; bi = cand ? n : bi; }
            sm |= 1u << bi; }
        selmask[gi] = sm; }
    }
    const int nT = 4 + 4 * own;
    const int sr = tid >> 3, sc = (tid & 7) * 16;
#define A_KEY0(i) ((i) < 4 ? own * 256 + 64 * (i) : (((i) - 4) >> 2) * 256 + (((i) - 4) & 3) * 64)
    v4u kr0, kr1, vr0, vr1;
#define A_LOAD(i) do { const bf16* kp_ = PROJ + (rowbase + A_KEY0(i) + sr) * NPROJ + COL_K + h * 128 + sc; \
        kr0 = *(const GAS v4u*)kp_; kr1 = *(const GAS v4u*)(kp_ + 8); vr0 = *(const GAS v4u*)(kp_ + (COL_V - COL_K)); vr1 = *(const GAS v4u*)(kp_ + (COL_V - COL_K) + 8); } while (0)
#define A_STORE(bufi) do { LAS unsigned char* kd_ = lds + ((bufi) ? A_KB1 : A_KB0) + sr * A_KSTR + sc * 2; LAS unsigned char* vd_ = lds + A_VB0 + vnx * A_VBS + sr * A_VSTR + sc * 2; \
        *(LAS v4u*)kd_ = kr0; *(LAS v4u*)(kd_ + 16) = kr1; *(LAS v4u*)vd_ = vr0; *(LAS v4u*)(vd_ + 16) = vr1; } while (0)
    int vcur = 0, vnx = 0, vprev = 0;
#define A_PV(PF, Vb_) do { _Pragma("unroll") for (int s = 0; s < 2; ++s) { s16x4 vlo[8], vhi[8]; \
            _Pragma("unroll") for (int db = 0; db < 8; ++db) { LAS unsigned char* va = (Vb_) + (32 * s + 4 * g + q4) * A_VSTR + (16 * db + 4 * p4) * 2; vlo[db] = TR16(va); vhi[db] = TR16(va + 16 * A_VSTR); } \
            __builtin_amdgcn_sched_barrier(0); \
            _Pragma("unroll") for (int db = 0; db < 8; ++db) { const bf16x8 vf = __builtin_shufflevector(vlo[db], vhi[db], 0, 1, 2, 3, 4, 5, 6, 7); \
                oacc[0][db] = MFMA16(vf, PF[0][s], oacc[0][db]); oacc[1][db] = MFMA16(vf, PF[1][s], oacc[1][db]); } \
            __builtin_amdgcn_sched_barrier(0); } } while (0)
    A_LOAD(0); A_STORE(0);
    __syncthreads();
    const bool late = w >= 4;
    bf16x8 pfp[2][2]; bool skipp = true;
#pragma unroll
    for (int gi = 0; gi < 2; ++gi) { pfp[gi][0] = (bf16x8){0, 0, 0, 0, 0, 0, 0, 0}; pfp[gi][1] = pfp[gi][0]; }
    float m_run[2] = {NEG_INF, NEG_INF}, l_run[2] = {0.f, 0.f};
    f32x4 oacc[2][8];
#pragma unroll
    for (int gi = 0; gi < 2; ++gi)
#pragma unroll
        for (int db = 0; db < 8; ++db) oacc[gi][db] = (f32x4){0.f, 0.f, 0.f, 0.f};
    for (int i = 0; i < nT; ++i) {
        if (i + 1 < nT) A_LOAD(i + 1);
        vnx = (vcur == 2) ? 0 : vcur + 1;
        const int buf = i & 1, key0 = A_KEY0(i); const bool isown = i < 4; const int pblk = isown ? own : ((i - 4) >> 2);
        const bool skipw = isown && (64 * i > 32 * w + 31);
        if (late && !skipp) A_PV(pfp, lds + A_VB0 + vprev * A_VBS);
        bf16x8 pf[2][2];
        if (!skipw) {
        LAS unsigned char* Kb = lds + (buf ? A_KB1 : A_KB0);
        f32x4 sacc[2][4];
#pragma unroll
        for (int hf = 0; hf < 2; ++hf) { bf16x8 kf[8];
#pragma unroll
            for (int n2 = 0; n2 < 2; ++n2)
#pragma unroll
                for (int ks = 0; ks < 4; ++ks) kf[n2 * 4 + ks] = *(const LAS bf16x8*)(Kb + (16 * (2 * hf + n2) + c16) * A_KSTR + (32 * ks + 8 * g) * 2);
            __builtin_amdgcn_sched_barrier(0);
#pragma unroll
            for (int gi = 0; gi < 2; ++gi)
#pragma unroll
                for (int n2 = 0; n2 < 2; ++n2) { f32x4 a = (f32x4){0.f, 0.f, 0.f, 0.f};
#pragma unroll
                    for (int ks = 0; ks < 4; ++ks) a = MFMA16(kf[n2 * 4 + ks], qf[gi][ks], a);
                    sacc[gi][2 * hf + n2] = a; }
            __builtin_amdgcn_sched_barrier(0); }
        const bool far = (key0 + 63 + 128 <= t0 + 32 * w);
        const bool diag = isown && (64 * i + 63 > 32 * w);
#pragma unroll
        for (int gi = 0; gi < 2; ++gi) {
            const int tq = tq0 + 16 * gi; const bool sel = isown || ((selmask[gi] >> pblk) & 1u);
            float sv[16]; float mloc, m_new, alpha;
            if (far) {
                const float bfar = tab[127];
                float mx = fmaxf(fmaxf(sacc[gi][0][0], sacc[gi][0][1]), fmaxf(sacc[gi][0][2], sacc[gi][0][3]));
#pragma unroll
                for (int nb = 1; nb < 4; ++nb) mx = fmaxf(mx, fmaxf(fmaxf(sacc[gi][nb][0], sacc[gi][nb][1]), fmaxf(sacc[gi][nb][2], sacc[gi][nb][3])));
                mloc = sel ? (mx * SCL2 + bfar) : NEG_INF;
                mloc = fmaxf(mloc, __shfl_xor(mloc, 16)); mloc = fmaxf(mloc, __shfl_xor(mloc, 32));
                m_new = fmaxf(m_run[gi], mloc); alpha = __builtin_amdgcn_exp2f(m_run[gi] - m_new);
                const float cadd = sel ? (bfar - m_new) : NEG_INF;
#pragma unroll
                for (int nb = 0; nb < 4; ++nb)
#pragma unroll
                    for (int r = 0; r < 4; ++r) sv[nb * 4 + r] = __builtin_amdgcn_exp2f(sacc[gi][nb][r] * SCL2 + cadd);
            } else {
                const int relb = tq - key0 - 4 * g; float bias[16];
#pragma unroll
                for (int nb = 0; nb < 4; ++nb)
#pragma unroll
                    for (int r = 0; r < 4; ++r) { const int rel = relb - 16 * nb - r; int ri = rel < 0 ? 0 : rel; ri = ri > 127 ? 127 : ri; bias[nb * 4 + r] = tab[ri]; }
                PIN16(bias, 0);
                mloc = NEG_INF;
#pragma unroll
                for (int nb = 0; nb < 4; ++nb)
#pragma unroll
                    for (int r = 0; r < 4; ++r) { const int rel = relb - 16 * nb - r;
                        float s = sacc[gi][nb][r] * SCL2 + bias[nb * 4 + r]; s = (!sel || (diag && rel < 0)) ? NEG_INF : s; sv[nb * 4 + r] = s; mloc = fmaxf(mloc, s); }
                mloc = fmaxf(mloc, __shfl_xor(mloc, 16)); mloc = fmaxf(mloc, __shfl_xor(mloc, 32));
                m_new = fmaxf(m_run[gi], mloc); alpha = __builtin_amdgcn_exp2f(m_run[gi] - m_new);
#pragma unroll
                for (int e = 0; e < 16; ++e) sv[e] = __builtin_amdgcn_exp2f(sv[e] - m_new);
            }
            float psum = 0.f;
#pragma unroll
            for (int e = 0; e < 16; ++e) psum += sv[e];
            l_run[gi] = l_run[gi] * alpha + psum; m_run[gi] = m_new;
#pragma unroll
            for (int db = 0; db < 8; ++db) oacc[gi][db] = oacc[gi][db] * alpha;
            pf[gi][0] = pack8(sv); pf[gi][1] = pack8(sv + 8);
        }
        __builtin_amdgcn_sched_barrier(0);
        if (!late) A_PV(pf, lds + A_VB0 + vcur * A_VBS);
        }
        if (late) { skipp = skipw;
#pragma unroll
            for (int gi = 0; gi < 2; ++gi) { pfp[gi][0] = pf[gi][0]; pfp[gi][1] = pf[gi][1]; } }
        if (i + 1 < nT) A_STORE((i + 1) & 1);
        vprev = vcur; vcur = vnx;
        __syncthreads();
    }
    if (late && !skipp) A_PV(pfp, lds + A_VB0 + vprev * A_VBS);
#undef A_PV
    bf16* const MIXp = F.HN(); float* const ssqp = F.ssq();
#pragma unroll
    for (int gi = 0; gi < 2; ++gi) {
        const int tq = tq0 + 16 * gi;
        float l_tot = l_run[gi]; l_tot += __shfl_xor(l_tot, 16); l_tot += __shfl_xor(l_tot, 32);
        const float inv = 1.f / l_tot; float ssq = 0.f;
        unsigned char* orow = (unsigned char*)MIXp + (rowbase + tq) * DM + h * 128 + 4 * g;
#pragma unroll
        for (int db = 0; db < 8; ++db) { const f32x4 o = oacc[gi][db] * inv; ssq += (o.x * o.x + o.y * o.y) + (o.z * o.z + o.w * o.w); *(GAS unsigned*)(orow + 16 * db) = pk4_fp8(o.x * SA8, o.y * SA8, o.z * SA8, o.w * SA8); }
        ssq += __shfl_xor(ssq, 16); ssq += __shfl_xor(ssq, 32);
        if (g == 0 && doatom) unsafeAtomicAdd(ssqp + (rowbase + tq) * 4 + 1, ssq);
    }
#undef A_KEY0
#undef A_LOAD
#undef A_STORE
}

constexpr int XBC_W = CONV_CH;
__device__ __forceinline__ void conv_phase(Frame& F) {
    const bf16* const PROJ = F.PROJ(); bf16* const XBC = F.XBC(); const float* const cw = F.conv_w(); const float* const cb = F.conv_b();
    const int gt = blockIdx.x * (NWAVES * 64) + fresh_tid(), GT = F.G * NWAVES * 64;
    for (int task = gt; task < (MTOK / 32) * (CONV_CH / 8); task += GT) {
        const int r = task / (CONV_CH / 8), k = task % (CONV_CH / 8), ch = 8 * k, tok0 = 32 * r;
        float wv[4][8], bias[8];
#pragma unroll
        for (int t = 0; t < 4; ++t) { const f32x4 w0 = *(const GAS f32x4*)(cw + t * CONV_CH + ch), w1 = *(const GAS f32x4*)(cw + t * CONV_CH + ch + 4);
            wv[t][0] = w0.x; wv[t][1] = w0.y; wv[t][2] = w0.z; wv[t][3] = w0.w; wv[t][4] = w1.x; wv[t][5] = w1.y; wv[t][6] = w1.z; wv[t][7] = w1.w; }
        { const f32x4 b0 = *(const GAS f32x4*)(cb + ch), b1 = *(const GAS f32x4*)(cb + ch + 4); bias[0] = b0.x; bias[1] = b0.y; bias[2] = b0.z; bias[3] = b0.w; bias[4] = b1.x; bias[5] = b1.y; bias[6] = b1.z; bias[7] = b1.w; }
        const bf16* src = PROJ + (size_t)tok0 * NPROJ + COL_XBC + ch; bf16* dst = XBC + (size_t)tok0 * XBC_W + ch;
        v4u p0 = (v4u){0u, 0u, 0u, 0u}, p1 = p0, p2 = p0;
        if ((tok0 & (SEQ - 1)) != 0) { p0 = *(const GAS v4u*)(src - 3 * (ptrdiff_t)NPROJ); p1 = *(const GAS v4u*)(src - 2 * (ptrdiff_t)NPROJ); p2 = *(const GAS v4u*)(src - (ptrdiff_t)NPROJ); }
#pragma unroll 1
        for (int i0 = 0; i0 < 32; i0 += 8) {
            v4u cur[8];
#pragma unroll
            for (int i = 0; i < 8; ++i) cur[i] = *(const GAS v4u*)(src + (size_t)(i0 + i) * NPROJ);
#pragma unroll
            for (int i = 0; i < 8; ++i) {
                const v4u c = cur[i]; float acc[8];
                const unsigned a0[4] = {p0.x, p0.y, p0.z, p0.w}, a1[4] = {p1.x, p1.y, p1.z, p1.w}, a2[4] = {p2.x, p2.y, p2.z, p2.w}, a3[4] = {c.x, c.y, c.z, c.w};
#pragma unroll
                for (int j = 0; j < 4; ++j) {
                    acc[2 * j] = bias[2 * j] + wv[0][2 * j] * bflo(a0[j]) + wv[1][2 * j] * bflo(a1[j]) + wv[2][2 * j] * bflo(a2[j]) + wv[3][2 * j] * bflo(a3[j]);
                    acc[2 * j + 1] = bias[2 * j + 1] + wv[0][2 * j + 1] * bfhi(a0[j]) + wv[1][2 * j + 1] * bfhi(a1[j]) + wv[2][2 * j + 1] * bfhi(a2[j]) + wv[3][2 * j + 1] * bfhi(a3[j]); }
#pragma unroll
                for (int j = 0; j < 8; ++j) acc[j] = silu_f(acc[j]);
                v4u o; o.x = pk2(acc[0], acc[1]); o.y = pk2(acc[2], acc[3]); o.z = pk2(acc[4], acc[5]); o.w = pk2(acc[6], acc[7]);
                *(GAS v4u*)(dst + (size_t)(i0 + i) * XBC_W) = o;
                p0 = p1; p1 = p2; p2 = c; }
        }
    }
    { const float* const dtraw = F.dtraw(); float* const dt2 = F.DT2(); const float* const dtb = F.dt_bias();
      for (int i = gt; i < MTOK * 16; i += GT) { const float xr = dtraw[i] + dtb[i & 15]; dt2[i] = xr > 20.f ? xr : log1pf(__expf(xr)); } }
}

constexpr int S_BSTR = 272, S_XSTR = 144;
constexpr int S_BM = 0, S_CM = 128 * S_BSTR, S_X = 2 * 128 * S_BSTR, S_XW = S_X + 128 * S_XSTR, S_HB = S_XW + 128 * S_XSTR, S_DT = S_HB + 64 * S_BSTR, S_CS = S_DT + 512, S_DA = S_CS + 512, S_END = S_DA + 512;
static_assert(S_END <= RING_BYTES, "ssd LDS map");
__device__ __forceinline__ void ssd_unit(Frame& F, int b, int h, const bool doatom = true) {
    LAS unsigned char* lds = F.lds + RING_OFF;
    const int tid = fresh_tid(), lane = tid & 63, w = __builtin_amdgcn_readfirstlane(tid >> 6), g = lane >> 4, c16 = lane & 15, q4 = c16 >> 2, p4 = lane & 3;
    const int g8 = h >> 3, pbw = w & 3, nhw = w >> 2;
    const float a_h = -__expf(F.a_log()[h]), dsk = F.d_skip()[h];
    const bf16* const PROJ = F.PROJ(); bf16* const MIX = F.HN(); const float* const dt2 = F.DT2(); const bf16* const XBC = F.XBC(); float* const ssqp = F.ssq();
    LAS float* dtl = (LAS float*)(lds + S_DT); LAS float* csl = (LAS float*)(lds + S_CS); LAS float* dal = (LAS float*)(lds + S_DA);
    for (int i = tid; i < 64 * S_BSTR / 16; i += NWAVES * 64) ((LAS v4u*)(lds + S_HB))[i] = (v4u){0u, 0u, 0u, 0u};
    f32x4 hacc[4];
#pragma unroll
    for (int i = 0; i < 4; ++i) hacc[i] = (f32x4){0.f, 0.f, 0.f, 0.f};
    const int xl = tid >> 3, xc = tid & 7, bl = tid >> 4, bc = tid & 15;
    v4u xr[2], br[4], cr[4]; float dtv = 0.f;
#define S_PREFETCH(cc) do { const size_t t0_ = (size_t)b * SEQ + (size_t)(cc) * SSM_L; \
        _Pragma("unroll") for (int i_ = 0; i_ < 2; ++i_) xr[i_] = *(const GAS v4u*)(XBC + (t0_ + xl + 64 * i_) * XBC_W + h * 64 + 8 * xc); \
        _Pragma("unroll") for (int i_ = 0; i_ < 4; ++i_) { const bf16* p_ = XBC + (t0_ + bl + 32 * i_) * XBC_W + 1024 + g8 * 128 + 8 * bc; br[i_] = *(const GAS v4u*)p_; cr[i_] = *(const GAS v4u*)(p_ + 256); } \
        if (tid < 128) dtv = dt2[(t0_ + tid) * 16 + h]; } while (0)
    S_PREFETCH(0);
    for (int c = 0; c < SSM_NC; ++c) {
        const size_t tok0 = (size_t)b * SEQ + (size_t)c * SSM_L;
        if (tid < 128) { dtl[tid] = dtv; dal[tid] = dtv * a_h; }
        __syncthreads();
        { const float v0 = dal[2 * lane], v1 = dal[2 * lane + 1]; float s = v0 + v1;
#pragma unroll
            for (int o = 1; o < 64; o <<= 1) { const float t = __shfl_up(s, o); s += (lane >= o) ? t : 0.f; }
            csl[2 * lane] = s - v1; csl[2 * lane + 1] = s; }
        LDS_WAIT(); asm volatile("" ::: "memory");
        const float cs_last = csl[127];
#pragma unroll
        for (int i = 0; i < 2; ++i) { const int l = xl + 64 * i; const v4u v = xr[i]; *(LAS v4u*)(lds + S_X + l * S_XSTR + xc * 16) = v; const float wl = dtl[l] * __expf(cs_last - csl[l]);
            v4u o2; o2.x = pk2(bflo(v.x) * wl, bfhi(v.x) * wl); o2.y = pk2(bflo(v.y) * wl, bfhi(v.y) * wl); o2.z = pk2(bflo(v.z) * wl, bfhi(v.z) * wl); o2.w = pk2(bflo(v.w) * wl, bfhi(v.w) * wl);
            *(LAS v4u*)(lds + S_XW + l * S_XSTR + xc * 16) = o2; }
#pragma unroll
        for (int i = 0; i < 4; ++i) { const int l = bl + 32 * i; *(LAS v4u*)(lds + S_BM + l * S_BSTR + bc * 16) = br[i]; *(LAS v4u*)(lds + S_CM + l * S_BSTR + bc * 16) = cr[i]; }
        const int lrow = 16 * w + c16;
        v2u zr[4];
#pragma unroll
        for (int pb = 0; pb < 4; ++pb) zr[pb] = *(const GAS v2u*)(PROJ + (tok0 + lrow) * NPROJ + COL_Z + h * 64 + 16 * pb + 4 * g);
        if (c + 1 < SSM_NC) S_PREFETCH(c + 1);
        __syncthreads();
        bf16x8 cf[4];
#pragma unroll
        for (int ks = 0; ks < 4; ++ks) cf[ks] = *(const LAS bf16x8*)(lds + S_CM + lrow * S_BSTR + (32 * ks + 8 * g) * 2);
        f32x4 yacc[4];
        const float cs_l = csl[lrow]; const float el = __expf(cs_l);
#pragma unroll
        for (int pb = 0; pb < 4; ++pb) { yacc[pb] = (f32x4){0.f, 0.f, 0.f, 0.f};
#pragma unroll
            for (int ks = 0; ks < 4; ++ks) { const bf16x8 hf = *(const LAS bf16x8*)(lds + S_HB + (16 * pb + c16) * S_BSTR + (32 * ks + 8 * g) * 2); yacc[pb] = MFMA16(hf, cf[ks], yacc[pb]); }
            yacc[pb] = yacc[pb] * el; }
        for (int s2 = 0; s2 <= (w >> 1); ++s2) {
            const int sb0 = 2 * s2, sb1 = 2 * s2 + 1; const bool has1 = sb1 <= w;
            f32x4 cb0 = (f32x4){0.f, 0.f, 0.f, 0.f}, cb1 = (f32x4){0.f, 0.f, 0.f, 0.f};
#pragma unroll
            for (int ks = 0; ks < 4; ++ks) { const bf16x8 bf0 = *(const LAS bf16x8*)(lds + S_BM + (16 * sb0 + c16) * S_BSTR + (32 * ks + 8 * g) * 2); cb0 = MFMA16(bf0, cf[ks], cb0); }
            if (has1) {
#pragma unroll
                for (int ks = 0; ks < 4; ++ks) { const bf16x8 bf1 = *(const LAS bf16x8*)(lds + S_BM + (16 * sb1 + c16) * S_BSTR + (32 * ks + 8 * g) * 2); cb1 = MFMA16(bf1, cf[ks], cb1); } }
            float mv[8];
#pragma unroll
            for (int r = 0; r < 4; ++r) { const int s = 16 * sb0 + 4 * g + r; const float e = __expf(fminf(cs_l - csl[s], 0.f)) * dtl[s]; mv[r] = (s <= lrow) ? cb0[r] * e : 0.f; }
#pragma unroll
            for (int r = 0; r < 4; ++r) { const int s = 16 * sb1 + 4 * g + r; const int sc_ = s > 127 ? 127 : s; const float e = __expf(fminf(cs_l - csl[sc_], 0.f)) * dtl[sc_]; mv[4 + r] = (has1 && s <= lrow) ? cb1[r] * e : 0.f; }
            const bf16x8 pf = pack8(mv);
#pragma unroll
            for (int pb = 0; pb < 4; ++pb) { LAS unsigned char* xa = lds + S_X + (32 * s2 + 4 * g + q4) * S_XSTR + (16 * pb + 4 * p4) * 2;
                const s16x4 lo = TR16(xa), hi = TR16(xa + 16 * S_XSTR); const bf16x8 xf = __builtin_shufflevector(lo, hi, 0, 1, 2, 3, 4, 5, 6, 7);
                yacc[pb] = MFMA16(xf, pf, yacc[pb]); }
        }
        { const size_t tok = tok0 + lrow; float ssq = 0.f;
#pragma unroll
          for (int pb = 0; pb < 4; ++pb) { const int p0 = 16 * pb + 4 * g;
              const v2u xs_ = *(const LAS v2u*)(lds + S_X + lrow * S_XSTR + p0 * 2);
              const v2u zr_ = zr[pb];
              const float o0 = (yacc[pb].x + bflo(xs_.x) * dsk) * silu_f(bflo(zr_.x)), o1 = (yacc[pb].y + bfhi(xs_.x) * dsk) * silu_f(bfhi(zr_.x));
              const float o2 = (yacc[pb].z + bflo(xs_.y) * dsk) * silu_f(bflo(zr_.y)), o3 = (yacc[pb].w + bfhi(xs_.y) * dsk) * silu_f(bfhi(zr_.y));
              ssq += (o0 * o0 + o1 * o1) + (o2 * o2 + o3 * o3);
              *(GAS unsigned*)((unsigned char*)MIX + tok * DM + ATT_W + h * 64 + p0) = pk4_fp8(o0 * SS8, o1 * SS8, o2 * SS8, o3 * SS8); }
          ssq += __shfl_xor(ssq, 16); ssq += __shfl_xor(ssq, 32);
          if (g == 0 && doatom) unsafeAtomicAdd(ssqp + tok * 4 + 2 + g8, ssq); }
        { const float cdec = __expf(cs_last);
#pragma unroll
          for (int i = 0; i < 4; ++i) hacc[i] = hacc[i] * cdec;
#pragma unroll
          for (int ks = 0; ks < 4; ++ks) {
              LAS unsigned char* xa = lds + S_XW + (32 * ks + 8 * g + q4) * S_XSTR + (16 * pbw + 4 * p4) * 2;
              const s16x4 xlo = TR16(xa), xhi = TR16(xa + 4 * S_XSTR); const bf16x8 xf = __builtin_shufflevector(xlo, xhi, 0, 1, 2, 3, 4, 5, 6, 7);
#pragma unroll
              for (int i = 0; i < 4; ++i) { const int nb = 4 * nhw + i; LAS unsigned char* ba = lds + S_BM + (32 * ks + 8 * g + q4) * S_BSTR + (16 * nb + 4 * p4) * 2;
                  const s16x4 blo = TR16(ba), bhi = TR16(ba + 4 * S_BSTR); const bf16x8 bfr = __builtin_shufflevector(blo, bhi, 0, 1, 2, 3, 4, 5, 6, 7);
                  hacc[i] = MFMA16(bfr, xf, hacc[i]); } } }
        __syncthreads();
#pragma unroll
        for (int i = 0; i < 4; ++i) { const int nb = 4 * nhw + i; v2u o; o.x = pk2(hacc[i].x, hacc[i].y); o.y = pk2(hacc[i].z, hacc[i].w);
            *(LAS v2u*)(lds + S_HB + (16 * pbw + c16) * S_BSTR + (16 * nb + 4 * g) * 2) = o; }
    }
#undef S_PREFETCH
    __syncthreads();
}

__device__ __forceinline__ void mix_normalize(Frame& F) {
    const int tid_ = fresh_tid(), lane = tid_ & 63; const int gw = blockIdx.x * NWAVES + __builtin_amdgcn_readfirstlane(tid_ >> 6), NGW = F.G * NWAVES;
    const float* const ssqp = F.ssq(); bf16* const MIX = F.HN(); const float* const gatt = F.attn_out_norm(); const float* const gssm = F.ssm_out_norm();
    for (int m = gw; m < MTOK; m += NGW) {
        const float* sq = ssqp + (size_t)m * 4;
        const float s1 = __hip_atomic_load(sq + 1, RLX_AGENT), s2 = __hip_atomic_load(sq + 2, RLX_AGENT), s3 = __hip_atomic_load(sq + 3, RLX_AGENT);
        const float ra = 1.f / sqrtf(s1 * (1.f / 1024.f) + EPS), r0 = 1.f / sqrtf(s2 * (1.f / 512.f) + EPS), r1 = 1.f / sqrtf(s3 * (1.f / 512.f) + EPS);
        GAS v4u* row = (GAS v4u*)(MIX + (size_t)m * DM);
#pragma unroll
        for (int j = 0; j < 4; ++j) { const int idx = lane + 64 * j, col = 8 * idx; const float rs = (j < 2) ? ra : ((j == 2) ? r0 : r1);
            const float* gp = (j < 2) ? (gatt + col) : (gssm + (col - ATT_W));
            const f32x4 g0 = *(const GAS f32x4*)gp, g1 = *(const GAS f32x4*)(gp + 4); const v4u v = row[idx]; v4u o;
            o.x = pk2(bflo(v.x) * rs * g0.x, bfhi(v.x) * rs * g0.y); o.y = pk2(bflo(v.y) * rs * g0.z, bfhi(v.y) * rs * g0.w);
            o.z = pk2(bflo(v.z) * rs * g1.x, bfhi(v.z) * rs * g1.y); o.w = pk2(bflo(v.w) * rs * g1.z, bfhi(v.w) * rs * g1.w); row[idx] = o; }
    }
}

constexpr size_t TAB_UNIT = 1024;
static_assert((TAB_ITEMS / 8) % TAB_UNIT == 0 && TAB_ITEMS % TAB_UNIT == 0, "table filler units");
constexpr int P_EIDX = 0, P_GATE = 16384, P_LST = 32768  , P_HN4 = 32768  , P_ACT = 98304  , P_END = 114688;
static_assert(P_END <= RING_BYTES, "peer LDS map");
__constant__ unsigned char PEER_CAND[52] = {0, 1, 2, 3, 4, 5, 6, 7, 8, 9, 10, 11, 12, 13, 14, 15, 16, 17, 18, 19, 20, 21, 22, 23, 32, 33, 34, 35, 36, 48, 49, 50, 51, 64, 65, 66, 80, 81, 96, 97, 112, 113, 128, 144, 160, 176, 192, 208, 224, 240, 255, 255};
__device__ __forceinline__ unsigned f2ord(float f) { const unsigned u = __builtin_bit_cast(unsigned, f); return u ^ ((u >> 31) ? 0xFFFFFFFFu : 0x80000000u); }
__device__ __forceinline__ float ord2f(unsigned u) { return __builtin_bit_cast(float, u ^ ((u >> 31) ? 0x80000000u : 0xFFFFFFFFu)); }
#define CSWAPD(a, b) do { const unsigned hi_ = (a) > (b) ? (a) : (b), lo_ = (a) > (b) ? (b) : (a); (a) = hi_; (b) = lo_; } while (0)
template <int N> __device__ __forceinline__ void bitonic_sort_desc(unsigned (&v)[N]) {
#pragma unroll
    for (int k = 2; k <= N; k <<= 1)
#pragma unroll
        for (int j = k >> 1; j > 0; j >>= 1)
#pragma unroll
            for (int i = 0; i < N; ++i) { const int l = i ^ j; if (l > i) { if ((i & k) == 0) CSWAPD(v[i], v[l]); else CSWAPD(v[l], v[i]); } }
}
__device__ __forceinline__ void merge16_xor(unsigned (&v)[16], int dist) {
    unsigned o[16];
#pragma unroll
    for (int i = 0; i < 16; ++i) o[i] = (unsigned)__shfl_xor((int)v[i], dist);
#pragma unroll
    for (int i = 0; i < 16; ++i) v[i] = v[i] > o[15 - i] ? v[i] : o[15 - i];
#pragma unroll
    for (int j = 8; j > 0; j >>= 1)
#pragma unroll
        for (int i = 0; i < 16; ++i) { const int l = i ^ j; if (l > i) CSWAPD(v[i], v[l]); }
}
__device__ __forceinline__ float gelu_erf(float x) { return 0.5f * x * (1.f + erff(x * 0.70710678118654752f)); }
__device__ __forceinline__ float fp4_dec1(unsigned n) { const unsigned m = n & 7u; unsigned bits = (m >= 2u) ? (((126u + (m >> 1)) << 23) | ((m & 1u) << 22)) : (m ? 0x3F000000u : 0u); bits |= (n & 8u) << 28; return __builtin_bit_cast(float, bits); }
__device__ __forceinline__ f32x2 fp4_dec2(unsigned x) { f32x2 r; r.x = fp4_dec1(x & 15u); r.y = fp4_dec1((x >> 4) & 15u); return r; }
typedef long i64;
typedef int v8i __attribute__((ext_vector_type(8)));
typedef int v4i __attribute__((ext_vector_type(4)));
template <bool dry = false> __device__ __forceinline__ void peer_unit(Frame& F, int u) {
    LAS unsigned char* lds = F.lds + RING_OFF;
    const int tid_ = fresh_tid(), lane = tid_ & 63, w = __builtin_amdgcn_readfirstlane(tid_ >> 6), g = lane >> 4, c16 = lane & 15;
    const int T0 = 32 * u;
    LAS int* eidx = (LAS int*)(lds + P_EIDX); LAS float* gate = (LAS float*)(lds + P_GATE);
    LAS unsigned* lst = (LAS unsigned*)(lds + P_LST) + w * 1024;
    const bf16* const QP = F.QP(); const bf16* const SK = F.SK(); float* const outp = F.out(); const bf16* const X1B = F.X1B(); const float* const fgain = F.ffn_norm(); const float* const fing = F.final_norm(); const unsigned char* const U8 = F.U8(); const unsigned char* const V8 = F.V8();
#ifndef NO_ROUTE
    unsigned cpk[4];
    { unsigned cb[16];
#pragma unroll
      for (int k = 0; k < 13; ++k) cb[k] = PEER_CAND[4 * k + g];
      cb[13] = 255u; cb[14] = 255u; cb[15] = 255u;
#pragma unroll
      for (int q = 0; q < 4; ++q) cpk[q] = cb[4 * q] | (cb[4 * q + 1] << 8) | (cb[4 * q + 2] << 16) | (cb[4 * q + 3] << 24); }
    {
    bf16x8 qf[2][4];
#define QP_LOAD(dst, c_) do { _Pragma("unroll") for (int tb = 0; tb < 2; ++tb) { const unsigned qo = ((unsigned)(T0 + 16 * tb + c16) * (unsigned)DM + (unsigned)((2 * w + (c_)) * 128 + 8 * g)) * 2u; \
        _Pragma("unroll") for (int ks = 0; ks < 4; ++ks) dst[tb][ks] = __builtin_nontemporal_load((const GAS bf16x8*)((const unsigned char*)QP + (qo + 64u * ks))); } } while (0)
    QP_LOAD(qf, 0);
#pragma unroll
    for (int c = 0; c < 2; ++c) {
        const int p = 2 * w + c;
        unsigned key[2][32];
        bf16x8 sf[3][8];
        const unsigned so0 = (unsigned)p * 32768u + 16u * (unsigned)lane;
#define SK_LOAD(buf, j_) do { _Pragma("unroll") for (int q = 0; q < 8; ++q) sf[buf][q] = *(const GAS bf16x8*)((const unsigned char*)SK + (so0 + (unsigned)(2 * (j_) + (q >> 2)) * 4096u + 1024u * (q & 3))); } while (0)
        SK_LOAD(0, 0); SK_LOAD(1, 1);
#pragma unroll
        for (int j = 0; j < 4; ++j) {
            if (j + 2 < 4) SK_LOAD((j + 2) % 3, j + 2);
            __builtin_amdgcn_sched_barrier(0);
#pragma unroll
            for (int h2 = 0; h2 < 2; ++h2)
#pragma unroll
            for (int tb = 0; tb < 2; ++tb) { const int kb = 2 * j + h2; f32x4 acc = (f32x4){0.f, 0.f, 0.f, 0.f};
#pragma unroll
                for (int ks = 0; ks < 4; ++ks) acc = MFMA16(sf[j % 3][4 * h2 + ks], qf[tb][ks], acc);
#pragma unroll
                for (int r = 0; r < 4; ++r) key[tb][kb * 4 + r] = (f2ord(acc[r]) & ~0x7Fu) | (unsigned)(16 * kb + 4 * g + r); }
            __builtin_amdgcn_sched_barrier(0); }
#undef SK_LOAD
        if (c == 0) { QP_LOAD(qf, 1); __builtin_amdgcn_sched_barrier(0); }
#pragma unroll
        for (int tb = 0; tb < 2; ++tb) {
            bitonic_sort_desc<32>(key[tb]);
            unsigned top[16];
#pragma unroll
            for (int i = 0; i < 16; ++i) top[i] = key[tb][i];
            merge16_xor(top, 16); merge16_xor(top, 32);
            if (g == 0) { LAS v4u* d = (LAS v4u*)(lst + (c * 32 + 16 * tb + c16) * 16);
                d[0] = (v4u){top[0], top[1], top[2], top[3]}; d[1] = (v4u){top[4], top[5], top[6], top[7]}; d[2] = (v4u){top[8], top[9], top[10], top[11]}; d[3] = (v4u){top[12], top[13], top[14], top[15]}; } }
    }
#undef QP_LOAD
    }
    for (int tb = 0; tb < 2; ++tb) {
        LDS_WAIT();
        const LAS unsigned* l1 = lst + (16 * tb + c16) * 16; const LAS unsigned* l2 = lst + (32 + 16 * tb + c16) * 16;
        unsigned ck[16];
#pragma unroll
        for (int k = 0; k < 13; ++k) { const unsigned ab = (cpk[k >> 2] >> (8 * (k & 3))) & 255u; const unsigned a = ab >> 4, bq = ab & 15u;
            const float s = ord2f(l1[a] & ~0x7Fu) + ord2f(l2[bq] & ~0x7Fu); ck[k] = (ab == 255u) ? 0u : ((f2ord(s) & ~0xFFu) | ab); }
        ck[13] = 0u; ck[14] = 0u; ck[15] = 0u;
        bitonic_sort_desc<16>(ck);
        merge16_xor(ck, 16); merge16_xor(ck, 32);
        if (g == 0) { const int tl = 16 * tb + c16; const float m = ord2f(ck[0] & ~0xFFu); float e[16]; float sum = 0.f;
#pragma unroll
            for (int k = 0; k < 16; ++k) { e[k] = __expf(ord2f(ck[k] & ~0xFFu) - m); sum += e[k]; }
            const float inv = 1.f / sum;
#pragma unroll
            for (int k = 0; k < 16; ++k) { const unsigned a = (ck[k] >> 4) & 15u, bq = ck[k] & 15u; const int ex = (int)((l1[a] & 0x7Fu) * 128u + (l2[bq] & 0x7Fu));
                eidx[tl * 128 + w * 16 + k] = ex; gate[tl * 128 + w * 16 + k] = e[k] * inv; } }
    }
#endif
    __syncthreads();
    LAS unsigned char* hnb = lds + P_HN4 + w * 8192; LAS float* actl = (LAS float*)(lds + P_ACT) + w * 512;
    const LAS unsigned char* hb = hnb + 16 * g + ((c16 & 1) ? 1024 : 0) + ((c16 & 2) ? 64 : 0);
    v4u bA[8], bB[8];
#define U_ISSUE(buf, e_) do { const unsigned uo_ = (unsigned)(e_) * (unsigned)ROWB + 64u * (unsigned)(c16 & 1) + 16u * (unsigned)g; \
        _Pragma("unroll") for (int jj = 0; jj < 8; ++jj) buf[jj] = *(const GAS v4u*)(U8 + (uo_ + 128u * jj)); __builtin_amdgcn_sched_barrier(0); } while (0)
#define U_CONSUME(buf, ACC, HB) do { v4u bq_[8]; _Pragma("unroll") for (int jj = 0; jj < 8; ++jj) bq_[jj] = *(const LAS v4u*)((HB) + 128 * jj); \
        __builtin_amdgcn_sched_barrier(0); \
        _Pragma("unroll") for (int jj = 0; jj < 8; ++jj) { const v4u a_ = buf[jj]; \
            const v8i av_ = {(int)a_.x, (int)a_.y, (int)a_.z, (int)a_.w, 0, 0, 0, 0}; const v8i bv_ = {(int)bq_[jj].x, (int)bq_[jj].y, (int)bq_[jj].z, (int)bq_[jj].w, 0, 0, 0, 0}; \
            ACC = __builtin_amdgcn_mfma_scale_f32_16x16x128_f8f6f4(av_, bv_, ACC, 4, 4, 0, 0x7f7f7f7f, 0, 0x7f7f7f7f); } __builtin_amdgcn_sched_barrier(0); } while (0)
#define U_PRE(A_, PA, PB) do { const float x1_ = __shfl_down(A_.x, 1), z1_ = __shfl_down(A_.z, 1), y2_ = __shfl_down(A_.y, 2), w2_ = __shfl_down(A_.w, 2), y3_ = __shfl_down(A_.y, 3), w3_ = __shfl_down(A_.w, 3); \
        constexpr float ilo_ = 1.f / SLO4; PA = (A_.x + y2_) + (x1_ + y3_) * ilo_; PB = (A_.z + w2_) + (z1_ + w3_) * ilo_; } while (0)
#define U_ACT(grp_, TL, ACT) do { float pa0_, pb0_, pa1_, pb1_; U_PRE(acc0, pa0_, pb0_); U_PRE(acc1, pa1_, pb1_); \
        if (c16 == 0) { const int k0 = 16 * (grp_) + 2 * g; constexpr float isc = 1.f / (SU * SH4); \
            const f32x2 g0_ = *(const LAS f32x2*)(gate + (TL) * 128 + k0), g1_ = *(const LAS f32x2*)(gate + (TL) * 128 + k0 + 8); \
            f32x2 a0_, a1_; a0_.x = gelu_erf(pa0_ * isc) * g0_.x; a0_.y = gelu_erf(pb0_ * isc) * g0_.y; a1_.x = gelu_erf(pa1_ * isc) * g1_.x; a1_.y = gelu_erf(pb1_ * isc) * g1_.y; \
            *(LAS f32x2*)((ACT) + k0) = a0_; *(LAS f32x2*)((ACT) + k0 + 8) = a1_; } } while (0)
#define V_ISSUE(buf, TL, kb_) do { _Pragma("unroll") for (int kh = 0; kh < 2; ++kh) { const LAS v4i* ep_ = (const LAS v4i*)(eidx + (TL) * 128 + 8 * (kb_) + 4 * kh); const v4i e4_ = *ep_; const int ee_[4] = {e4_.x, e4_.y, e4_.z, e4_.w}; \
        _Pragma("unroll") for (int kk = 0; kk < 4; ++kk) { const unsigned vo_ = (unsigned)(ee_[kk] & emask) * (unsigned)ROWB + 16u * (unsigned)lane; buf[4 * kh + kk] = *(const GAS v4u*)(V8 + vo_); } \
        __builtin_amdgcn_sched_barrier(0); } } while (0)
#define PIN8x2(a, i) asm volatile("" : "+v"(a[i]), "+v"(a[i + 1]), "+v"(a[i + 2]), "+v"(a[i + 3]), "+v"(a[i + 4]), "+v"(a[i + 5]), "+v"(a[i + 6]), "+v"(a[i + 7]))
#define V_CONSUME(buf, kb_, O, ACT) do { _Pragma("unroll") for (int kk = 0; kk < 8; ++kk) { const float as_ = (ACT)[8 * (kb_) + kk]; const f32x2 a2_ = {as_, as_}; \
        const unsigned vw[4] = {buf[kk].x, buf[kk].y, buf[kk].z, buf[kk].w}; \
        _Pragma("unroll") for (int q = 0; q < 4; ++q) { \
            O[4 * q]     = __builtin_elementwise_fma(__builtin_amdgcn_cvt_scalef32_pk_f32_fp4(vw[q], 1.0f, 0), a2_, O[4 * q]); \
            O[4 * q + 1] = __builtin_elementwise_fma(__builtin_amdgcn_cvt_scalef32_pk_f32_fp4(vw[q], 1.0f, 1), a2_, O[4 * q + 1]); \
            O[4 * q + 2] = __builtin_elementwise_fma(__builtin_amdgcn_cvt_scalef32_pk_f32_fp4(vw[q], 1.0f, 2), a2_, O[4 * q + 2]); \
            O[4 * q + 3] = __builtin_elementwise_fma(__builtin_amdgcn_cvt_scalef32_pk_f32_fp4(vw[q], 1.0f, 3), a2_, O[4 * q + 3]); } \
        PIN8x2(O, 0); PIN8x2(O, 8); } } while (0)
#ifndef NO_GATHER
#ifdef PROBE_L2RES
    constexpr int emask = dry ? PROBE_L2RES : 16383;
#else
    constexpr int emask = 16383;
#endif
    {
    { unsigned k0[4], k1[4];
#pragma unroll
      for (int ti = 0; ti < 4; ++ti) { const int tl = w + 8 * ti; k0[ti] = ((unsigned)eidx[tl * 128 + lane] << 7) | (unsigned)lane; k1[ti] = ((unsigned)eidx[tl * 128 + 64 + lane] << 7) | (unsigned)(64 + lane); }
#pragma unroll
      for (int k = 2; k <= 128; k <<= 1)
#pragma unroll
        for (int j = k >> 1; j > 0; j >>= 1) {
            if (j == 64) {
#pragma unroll
                for (int ti = 0; ti < 4; ++ti) { const unsigned lo_ = k0[ti] < k1[ti] ? k0[ti] : k1[ti], hi_ = k0[ti] < k1[ti] ? k1[ti] : k0[ti]; k0[ti] = lo_; k1[ti] = hi_; }
            } else {
                const bool lower = (lane & j) == 0;
                const bool desc0 = (k == 64) ? false : ((k == 128) ? false : ((lane & k) != 0)), desc1 = (k == 64) ? true : desc0;
                const bool min0 = lower != desc0, min1 = lower != desc1;
#pragma unroll
                for (int ti = 0; ti < 4; ++ti) { const unsigned p0 = (unsigned)__shfl_xor((int)k0[ti], j), p1 = (unsigned)__shfl_xor((int)k1[ti], j);
                    const unsigned mn0 = k0[ti] < p0 ? k0[ti] : p0, mx0 = k0[ti] < p0 ? p0 : k0[ti], mn1 = k1[ti] < p1 ? k1[ti] : p1, mx1 = k1[ti] < p1 ? p1 : k1[ti];
                    k0[ti] = min0 ? mn0 : mx0; k1[ti] = min1 ? mn1 : mx1; }
            }
        }
      float g0[4], g1[4];
#pragma unroll
      for (int ti = 0; ti < 4; ++ti) { const int tl = w + 8 * ti; g0[ti] = gate[tl * 128 + (int)(k0[ti] & 127u)]; g1[ti] = gate[tl * 128 + (int)(k1[ti] & 127u)]; }
      LDS_WAIT(); asm volatile("" ::: "memory");
#pragma unroll
      for (int ti = 0; ti < 4; ++ti) { const int tl = w + 8 * ti; eidx[tl * 128 + lane] = (int)(k0[ti] >> 7); eidx[tl * 128 + 64 + lane] = (int)(k1[ti] >> 7); gate[tl * 128 + lane] = g0[ti]; gate[tl * 128 + 64 + lane] = g1[ti]; }
      LDS_WAIT(); asm volatile("" ::: "memory"); }
    v2u xn[8];
#define X_ISSUE(tok_) do { const unsigned xb_ = (unsigned)(tok_) * (unsigned)(DM * 2) + 8u * (unsigned)lane; _Pragma("unroll") for (int j = 0; j < 8; ++j) xn[j] = __builtin_nontemporal_load((const GAS v2u*)((const unsigned char*)X1B + (xb_ + 512u * j))); } while (0)
    X_ISSUE(T0 + w);
#pragma unroll 1
    for (int ti = 0; ti < 4; ++ti) {
        f32x4 xr[8]; float ss = 0.f;
#pragma unroll
        for (int j = 0; j < 8; ++j) { const v2u r = xn[j]; xr[j] = (f32x4){bflo(r.x), bfhi(r.x), bflo(r.y), bfhi(r.y)}; }
        X_ISSUE(T0 + w + 8 * (ti < 3 ? ti + 1 : 3));
#pragma unroll
        for (int j = 0; j < 8; ++j) ss += (xr[j].x * xr[j].x + xr[j].y * xr[j].y) + (xr[j].z * xr[j].z + xr[j].w * xr[j].w);
        const float rs2 = __builtin_amdgcn_rsqf(wave_sum(ss) * (1.f / DM) + EPS);
        const float* fg_ = fgain; asm volatile("" : "+s"(fg_));
        const unsigned char* gp = (const unsigned char*)fg_; const unsigned go = 16u * (unsigned)lane;
        unsigned hw[4], lw[4];
#pragma unroll
        for (int q = 0; q < 4; ++q) { unsigned wh = 0u, wl = 0u;
#pragma unroll
            for (int t = 0; t < 2; ++t) { const int j = 2 * q + t; const f32x4 gg = *(const GAS f32x4*)(gp + (go + 1024u * j)); const f32x4 hv = xr[j] * gg * (rs2 * SH4);
                const float h0 = clampf(hv.x, 6.f), h1 = clampf(hv.y, 6.f), h2 = clampf(hv.z, 6.f), h3 = clampf(hv.w, 6.f);
                const unsigned p0 = __builtin_amdgcn_cvt_scalef32_pk_fp4_f32(0u, h0, h1, 1.0f, 0), p1 = __builtin_amdgcn_cvt_scalef32_pk_fp4_f32(0u, h2, h3, 1.0f, 0);
                const f32x2 d0 = __builtin_amdgcn_cvt_scalef32_pk_f32_fp4(p0, 1.0f, 0), d1 = __builtin_amdgcn_cvt_scalef32_pk_f32_fp4(p1, 1.0f, 0);
                const unsigned r0 = __builtin_amdgcn_cvt_scalef32_pk_fp4_f32(0u, clampf((h0 - d0.x) * SLO4, 6.f), clampf((h1 - d0.y) * SLO4, 6.f), 1.0f, 0), r1 = __builtin_amdgcn_cvt_scalef32_pk_fp4_f32(0u, clampf((h2 - d1.x) * SLO4, 6.f), clampf((h3 - d1.y) * SLO4, 6.f), 1.0f, 0);
                wh |= ((p0 & 0xFFu) | ((p1 & 0xFFu) << 8)) << (16 * t); wl |= ((r0 & 0xFFu) | ((r1 & 0xFFu) << 8)) << (16 * t); }
            hw[q] = wh; lw[q] = wl; }
        *(LAS v4u*)(hnb + 2048 * ti + 16 * lane) = (v4u){hw[0], hw[1], hw[2], hw[3]}; *(LAS v4u*)(hnb + 2048 * ti + 1024 + 16 * lane) = (v4u){lw[0], lw[1], lw[2], lw[3]};
    }
    LDS_WAIT();
    { int e_c0 = eidx[w * 128 + (c16 >> 1)] & emask, e_c1 = eidx[w * 128 + 8 + (c16 >> 1)] & emask;
      U_ISSUE(bA, e_c0);
#pragma unroll 1
      for (int s_ = 0; s_ < 31; ++s_) {
          const int ti = s_ & 3, grp = s_ >> 2, tl = w + 8 * ti, sn = s_ + 1;
          const int eb_ = (w + 8 * (sn & 3)) * 128 + 16 * (sn >> 2) + (c16 >> 1);
          const int e_n0 = eidx[eb_] & emask, e_n1 = eidx[eb_ + 8] & emask;
          const LAS unsigned char* hbt = hb + 2048 * ti; LAS float* actt = actl + 128 * ti;
          f32x4 acc0 = (f32x4){0.f, 0.f, 0.f, 0.f}, acc1 = acc0;
          U_ISSUE(bB, e_c1); U_CONSUME(bA, acc0, hbt);
          U_ISSUE(bA, e_n0);
          U_CONSUME(bB, acc1, hbt);
          U_ACT(grp, tl, actt);
          e_c0 = e_n0; e_c1 = e_n1;
      }
      { const LAS unsigned char* hbt = hb + 2048 * 3; LAS float* actt = actl + 128 * 3;
        f32x4 acc0 = (f32x4){0.f, 0.f, 0.f, 0.f}, acc1 = acc0;
        U_ISSUE(bB, e_c1); U_CONSUME(bA, acc0, hbt);
        V_ISSUE(bA, w, 0);
        U_CONSUME(bB, acc1, hbt);
        U_ACT(7, w + 24, actt); } }
    LDS_WAIT();
    f32x2 o2[4][16];
#pragma unroll
    for (int ti = 0; ti < 4; ++ti)
#pragma unroll
        for (int i = 0; i < 16; ++i) o2[ti][i] = (f32x2){0.f, 0.f};
#pragma unroll 1
    for (int kb = 0; kb < 16; ++kb) {
        const int kn = kb < 15 ? kb + 1 : 15;
        V_ISSUE(bB, w + 8, kb);  V_CONSUME(bA, kb, o2[0], actl);
        V_ISSUE(bA, w + 16, kb); V_CONSUME(bB, kb, o2[1], actl + 128);
        V_ISSUE(bB, w + 24, kb); V_CONSUME(bA, kb, o2[2], actl + 256);
        V_ISSUE(bA, w, kn);      V_CONSUME(bB, kb, o2[3], actl + 384);
    }
    X_ISSUE(T0 + w);
#pragma unroll
    for (int ti = 0; ti < 4; ++ti) {
        const size_t token = (size_t)T0 + w + 8 * ti;
        const unsigned xo = (unsigned)token * (unsigned)(DM * 4) + 16u * (unsigned)lane;
        f32x4 xr[8];
#pragma unroll
        for (int j = 0; j < 8; ++j) { const v2u r = xn[j]; xr[j] = (f32x4){bflo(r.x), bfhi(r.x), bflo(r.y), bfhi(r.y)}; }
        if (ti < 3) X_ISSUE(T0 + w + 8 * (ti + 1));
        constexpr float isv = 1.f / SV; float s2 = 0.f;
#pragma unroll
        for (int j = 0; j < 8; ++j) { xr[j] = xr[j] + (f32x4){o2[ti][2 * j].x, o2[ti][2 * j].y, o2[ti][2 * j + 1].x, o2[ti][2 * j + 1].y} * isv;
            s2 += (xr[j].x * xr[j].x + xr[j].y * xr[j].y) + (xr[j].z * xr[j].z + xr[j].w * xr[j].w); }
        const float rf = __builtin_amdgcn_rsqf(wave_sum(s2) * (1.f / DM) + EPS);
        const float* fi_ = fing; asm volatile("" : "+s"(fi_));
        const unsigned char* fp = (const unsigned char*)fi_; unsigned char* op = (unsigned char*)outp; const unsigned fo = 16u * (unsigned)lane;
        if (!dry || rf == 1.2345e30f)
#pragma unroll
        for (int j = 0; j < 8; ++j) __builtin_nontemporal_store(xr[j] * rf * *(const GAS f32x4*)(fp + (fo + 1024u * j)), (GAS f32x4*)(op + (xo + 1024u * j)));
    }
    }
#endif
#undef U_ISSUE
#undef X_ISSUE
#undef U_ACT
#undef U_CONSUME
#undef V_ISSUE
#undef V_CONSUME
    __syncthreads();
}

__global__ void __launch_bounds__(NWAVES * 64, 2) hybrid_fwd(Args args) {
    extern __shared__ __attribute__((aligned(16))) unsigned char lds[];
    Frame F;
    F.lds = (LAS unsigned char*)lds;
    F.MISC = (volatile LAS unsigned*)(F.lds + MISC_OFF);
    F.tid = threadIdx.x; F.lane = F.tid & 63; F.wave = __builtin_amdgcn_readfirstlane(F.tid >> 6); F.G = gridDim.x;
    for (int u = F.tid; u < (LDS_BYTES - LDSCTL_OFF) / 4; u += NWAVES * 64) ((LAS unsigned*)(F.lds + LDSCTL_OFF))[u] = 0u;
    __syncthreads();
    (void)args;
    XcdBarrier bar = xcd_barrier_post(F.ctl() + CW_BAR, F.MISC + 8);

#ifndef NO_P0
#ifdef PROBE_P0X2
    { int reps = 2; asm volatile("" : "+s"(reps)); for (int rep = 0; rep < reps; ++rep) p0_prologue(F); }
#else
    p0_prologue(F);
#endif
#endif
    xcd_barrier(bar);
#ifndef NO_P1
#ifdef PROBE_GX2
    { int reps = 2; asm volatile("" : "+s"(reps)); for (int rep = 0; rep < reps; ++rep) {
#else
    { { const int rep = 0, reps = 1;
#endif
      pg8::Gemm gm{F.HN(), F.WinT(), MTOK, NB16, DM}; pg8::StaticOrder S; S.init(MTOK, NB16, F.G, (int)blockIdx.x);
      EpiProj E{F.PROJ(), F.dtraw(), (rep + 1 < reps) ? nullptr : F.kmean()};
      pg8::gemm_phase<EpiProj, pg8::StaticOrder, PG8_ALIGN, PG8_SP2>(F.lds + RING_OFF, gm, S, E); } }
    { const int nun = (MTOK / 256) * (NB16 / 256), rem = nun % F.G;
      if (rem && (int)blockIdx.x >= rem) tables_convert(F, tab_split(F.G), TAB_ITEMS, (size_t)((int)blockIdx.x - rem) * (NWAVES * 64) + fresh_tid(), (size_t)(F.G - rem) * (NWAVES * 64)); }
    __syncthreads();
    {
      pg8::Gemm gm{(const pg8::bf16_t*)F.HN8(), (const pg8::bf16_t*)F.WinT8(), MTOK, F8_HI - F8_LO, DM / 2}; pg8::StaticOrder S; S.init(MTOK, F8_HI - F8_LO, F.G, (int)blockIdx.x);
      EpiProj8 E{F.PROJ()};
      pg8::gemm_phase<EpiProj8, pg8::StaticOrder, PG8_ALIGN, PG8_SP2, true>(F.lds + RING_OFF, gm, S, E); }
#endif
    xcd_barrier(bar);
#ifdef PROBE_P15X2
    conv_phase(F);
#endif
    conv_phase(F);
    xcd_barrier(bar);
#ifdef PROBE_P2X2
    { int reps = 2; asm volatile("" : "+s"(reps)); for (int rep = 0; rep < reps; ++rep) {
#else
    { { const int rep = 0, reps = 1;
#endif
    const bool doatom = rep + 1 == reps;
    const int ntab = (int)(tab_split(F.G) / TAB_UNIT);
    for (;;) {
        if (F.tid == 0) F.MISC[0] = xb_add(F.ctl() + CW_Q2 + 64 * rep, 1u);
        __syncthreads();
        const int ui = (int)F.MISC[0];
        __syncthreads();
        if (ui >= 128 + 512 + W_SQ_UNITS + ntab) break;
        if (ui >= 128 + 512 && ui < 128 + 512 + W_SQ_UNITS) { sq_weight_items(F, ui - 640); __syncthreads(); continue; }
        if (ui >= 128 + 512 + W_SQ_UNITS) { const size_t lo = (size_t)(ui - 640 - W_SQ_UNITS) * TAB_UNIT; tables_convert(F, lo, lo + TAB_UNIT, (size_t)fresh_tid(), (size_t)(NWAVES * 64)); continue; }
#ifdef PROBE_P2_SSD
        if (ui < 128 || doatom)
#endif
#ifdef PROBE_P2_ATT
        if (ui >= 128 || doatom)
#endif
        {
        if (ui < 128) ssd_unit(F, ui >> 4, ui & 15, doatom);
        else { const int a = ui - 128; attn_unit(F, (a & 63) >> 3, a & 7, 7 - (a >> 6), doatom); }
        }
    } } }
    xcd_barrier(bar);
#ifndef NO_P3
#ifdef PROBE_GX2
    { int reps = 2; asm volatile("" : "+s"(reps)); for (int rep = 0; rep < reps; ++rep) {
#else
    { { const int rep = 0, reps = 1;
#endif
      pg8::Gemm gm{F.HN(), F.WoutT(), MTOK, DM, DM / 2}; pg8::StaticOrder S; S.init(MTOK, DM, F.G, (int)blockIdx.x);
      {
        const int t_ = fresh_tid(); const float* const sq = F.ssq();
#pragma unroll 1
        for (int ii = t_ >> 8; ii < 3; ii += 2) { pg8::Unit uu;
          if (S.next(ii, uu)) { const int row = uu.pm * 256 + (t_ & 255);
            const float q1 = __hip_atomic_load(sq + (size_t)row * 4 + 1, RLX_AGENT), q2 = __hip_atomic_load(sq + (size_t)row * 4 + 2, RLX_AGENT), q3 = __hip_atomic_load(sq + (size_t)row * 4 + 3, RLX_AGENT);
            const float sa = __builtin_amdgcn_rsqf(q1 * (1.f / 1024.f) + EPS), s0 = __builtin_amdgcn_rsqf(q2 * (1.f / 512.f) + EPS), s1 = __builtin_amdgcn_rsqf(q3 * (1.f / 512.f) + EPS);
            *(LAS f32x4*)(F.lds + SEGTAB_OFF + (ii * 256 + (t_ & 255)) * 16) = (f32x4){sa / s0 * (SS8 / SA8), s0 / s1, s1 * (1.f / (SS8 * SW8)), 0.f}; } }
        __syncthreads(); }
      EpiOut E{F.x(), F.X1B(), F.X18(), F.ssq(), rep + 1 == reps, (const LAS f32x4*)(F.lds + SEGTAB_OFF)};
      pg8::gemm_phase<EpiOut, pg8::StaticOrder, PG8_ALIGN, PG8_SP2, true>(F.lds + RING_OFF, gm, S, E); } }
#endif
    xcd_barrier(bar);
#ifndef NO_P4
#ifdef PROBE_GX2
    { int reps = 2; asm volatile("" : "+s"(reps)); for (int rep = 0; rep < reps; ++rep) {
#else
    { { const int rep = 0, reps = 1; (void)rep; (void)reps;
#endif
      pg8::Gemm gm{(const pg8::bf16_t*)F.X18(), F.WqT(), MTOK, DM, DM / 2}; pg8::StaticOrder S; S.init(MTOK, DM, F.G, (int)blockIdx.x);
      EpiQ E{F.QP(), F.ssq()};
      pg8::gemm_phase<EpiQ, pg8::StaticOrder, PG8_ALIGN, PG8_SP2, true>(F.lds + RING_OFF, gm, S, E); } }
#endif
    xcd_barrier(bar);
#ifndef NO_P5
#ifdef PROBE_P5X2
    { for (int u = blockIdx.x; u < MTOK / 32; u += F.G) peer_unit<true>(F, u);
      for (int u = blockIdx.x; u < MTOK / 32; u += F.G) peer_unit<false>(F, u); }
#else
    for (int u = blockIdx.x; u < MTOK / 32; u += F.G) peer_unit(F, u);
#endif
#endif
}

extern "C" void kernel_launch(void* const* d_in, const int* in_sizes, int n_in, void* d_out, int out_size, void* d_ws, size_t ws_size, hipStream_t stream) {
    static int grid = 0;
    if (grid == 0) {
        if (n_in != 18 || out_size != MTOK * DM || ws_size < WS_END) { fprintf(stderr, "kernel_launch: unexpected shapes (n_in %d, out %d, ws %zu)\n", n_in, out_size, ws_size); grid = -1; return; }
        int dev = 0, cus = 0, per_cu = 0;
        if (hipGetDevice(&dev) != hipSuccess || hipDeviceGetAttribute(&cus, hipDeviceAttributeMultiprocessorCount, dev) != hipSuccess) { grid = -1; return; }
        if (hipFuncSetAttribute((const void*)hybrid_fwd, hipFuncAttributeMaxDynamicSharedMemorySize, LDS_BYTES) != hipSuccess) { fprintf(stderr, "kernel_launch: hipFuncSetAttribute failed\n"); grid = -1; return; }
        if (hipOccupancyMaxActiveBlocksPerMultiprocessor(&per_cu, (const void*)hybrid_fwd, NWAVES * 64, LDS_BYTES) != hipSuccess || per_cu < 1)
            fprintf(stderr, "kernel_launch: note: occupancy query reports %d workgroups per CU\n", per_cu);
        (void)hipGetLastError();
        grid = cus;
    }
    if (grid < 0) return;
    if (hipMemsetAsync((char*)d_ws + WS_CTL, 0, CTL_ZERO_BYTES, stream) != hipSuccess) return;
    Args a{};
    for (int i = 0; i < 18; ++i) a.in[i] = (const float*)d_in[i];
    a.out = (float*)d_out; a.ws = (unsigned char*)d_ws;
    hipLaunchKernelGGL(hybrid_fwd, dim3(grid), dim3(NWAVES * 64), LDS_BYTES, stream, a);
}
```

```cpp
#include <hip/hip_runtime.h>
#include <cstdio>
#include <cstdint>
namespace pg8 {
#define PG8_LAS __attribute__((address_space(3)))
typedef unsigned short bf16_t;
typedef short bf16x8 __attribute__((ext_vector_type(8)));
typedef float f32x4 __attribute__((ext_vector_type(4)));
typedef unsigned u32x4 __attribute__((ext_vector_type(4)));
constexpr int BM = 256, BK = 64, HALF = 128, HTB = HALF * BK * 2  , STAGE_BYTES = 8 * HTB, NXCD = 8, WGM = 8;

__host__ __device__ __forceinline__ int lds_byte(int r, int c) { const int st = (r >> 4) * 2 + (c >> 5), rr = r & 15, cc = c & 31, ob = rr * 64 + cc * 2; return st * 1024 + (ob ^ (((ob >> 9) & 1) << 5)); }
__host__ __device__ __forceinline__ void stage_rc(int b, int& R, int& C) { const int st = b / 1024, sb = b % 1024, swz = sb ^ (((sb >> 9) & 1) << 5); R = (st >> 1) * 16 + swz / 64; C = (st & 1) * 32 + (swz % 64) / 2; }
__host__ __device__ __forceinline__ int perm32(int rho) { const int n = rho >> 4, i = rho & 15; return 8 * (i >> 2) + 4 * n + (i & 3); }

struct Unit { int pm, pn; };
struct Gemm { const bf16_t* A; const bf16_t* Bt; int M, N, K; };

struct StaticOrder {
    int nM, nN, nwg, G, c;
    __host__ __device__ void init(int M, int N, int G_, int c_) { nM = M / BM; nN = N / BM; nwg = nM * nN; G = G_; c = c_; }
    __host__ __device__ bool next(int i, Unit& u) const {
        const long L = (long)i * G + c; if (L >= nwg) return false;
        int wgid = (int)L; { const int q = nwg / NXCD, r = nwg % NXCD, xcd = wgid % NXCD, off = wgid / NXCD; wgid = (xcd < r ? xcd * (q + 1) : r * (q + 1) + (xcd - r) * q) + off; }
        const int nig = WGM * nN, gid = wgid / nig, fm = gid * WGM, gsz = (nM - fm) < WGM ? (nM - fm) : WGM;
        u.pm = fm + ((wgid % nig) % gsz); u.pn = (wgid % nig) / gsz; return true;
    }
    __device__ __forceinline__ void a_ready(const Unit&) const {}
    __device__ __forceinline__ void done(const Unit&) const {}
};

__device__ __forceinline__ unsigned cvt_pk_bf16(float lo, float hi) { unsigned r; asm volatile("v_cvt_pk_bf16_f32 %0, %1, %2" : "=v"(r) : "v"(lo), "v"(hi)); return r; }
typedef float f32x2 __attribute__((ext_vector_type(2)));
__device__ __forceinline__ f32x2 gelu_pk(f32x2 v) {
    const f32x2 av = __builtin_elementwise_abs(v), d = av * 0.2316418882f + 1.0f;
    f32x2 t; t.x = __builtin_amdgcn_rcpf(d.x); t.y = __builtin_amdgcn_rcpf(d.y);
    f32x2 q = t * 0.5307027145f + (-0.7265760135f); q = q * t + 0.7107068705f; q = q * t + (-0.142248368f); q = q * t + 0.127414796f; q = q * t;
    const f32x2 s = (v * v) * (-0.72134752044f);
    f32x2 e; e.x = __builtin_amdgcn_exp2f(s.x); e.y = __builtin_amdgcn_exp2f(s.y);
    const f32x2 m = v * (q * e), r = v - m;
    f32x2 o; o.x = v.x < 0.f ? m.x : r.x; o.y = v.y < 0.f ? m.y : r.y; return o;
}

template <int ACT  > struct EpiBf16 {
    static constexpr bool PERM = true, AFTER_DRAIN = false, SEG = false; static_assert(ACT == 0 || ACT == 1, "EpiBf16: ACT is 0 (none) or 1 (gelu_pk)");
    bf16_t* O; int ldc; const float* bias; int split_cols; size_t split_stride; float scale0;
    __device__ __forceinline__ void operator()(const f32x4 (&acc)[2][2][4][2], const Unit& u, int wr, int wc, int fr, int fq) const {
        const int row0 = u.pm * BM + wr * 64 + fr; int colt = u.pn * BM; bf16_t* base = O;
        float sc = 1.f; if (split_cols) { const int t = colt / split_cols; base += (size_t)t * split_stride; colt -= t * split_cols; if (t == 0) sc = scale0; }
        const int col0 = colt + wc * 32 + 8 * fq, bcol0 = u.pn * BM + wc * 32 + 8 * fq;
        f32x4 bv[2][2];
#pragma unroll
        for (int bj = 0; bj < 2; ++bj)
#pragma unroll
            for (int n = 0; n < 2; ++n) bv[bj][n] = bias ? *(const f32x4*)(bias + bcol0 + bj * HALF + 4 * n) : (f32x4){0.f, 0.f, 0.f, 0.f};
#pragma unroll
        for (int ai = 0; ai < 2; ++ai)
#pragma unroll
            for (int m = 0; m < 4; ++m) { bf16_t* rowp = base + (size_t)(row0 + ai * HALF + m * 16) * ldc + col0;
#pragma unroll
                for (int bj = 0; bj < 2; ++bj) { f32x4 v0 = acc[ai][bj][m][0] + bv[bj][0], v1 = acc[ai][bj][m][1] + bv[bj][1];
                    if (ACT == 1) { f32x2 a = gelu_pk((f32x2){v0[0], v0[1]}), b = gelu_pk((f32x2){v0[2], v0[3]}), c = gelu_pk((f32x2){v1[0], v1[1]}), d = gelu_pk((f32x2){v1[2], v1[3]});
                        v0 = (f32x4){a.x, a.y, b.x, b.y}; v1 = (f32x4){c.x, c.y, d.x, d.y}; }
                    v0 = v0 * sc; v1 = v1 * sc; u32x4 w; w.x = cvt_pk_bf16(v0[0], v0[1]); w.y = cvt_pk_bf16(v0[2], v0[3]); w.z = cvt_pk_bf16(v1[0], v1[1]); w.w = cvt_pk_bf16(v1[2], v1[3]);
                    *(u32x4*)(rowp + bj * HALF) = w; } }
    }
};
template <class Epi, class Sched, bool ALIGN_EPI = false, bool SP2 = false, bool F8 = false>
__device__ __forceinline__ void gemm_phase(PG8_LAS unsigned char* lds, const Gemm g, const Sched& S, const Epi& E) {
    int tid_ = threadIdx.x; asm volatile("" : "+v"(tid_));
    const int tid = tid_, wid = __builtin_amdgcn_readfirstlane(tid >> 6), lane = tid & 63, wr = wid >> 2, wc = wid & 3, fr = lane & 15, fq = lane >> 4;
    const int K = g.K, nt = K / BK;
    unsigned voffA[2], voffB[2];
#pragma unroll
    for (int i = 0; i < 2; ++i) { int R, C; stage_rc(tid * 16 + i * 8192, R, C); const int Rb = Epi::PERM ? ((R & ~31) + perm32(R & 31)) : R;
        voffA[i] = (unsigned)(R * K + C) * 2u; voffB[i] = (unsigned)(Rb * K + C) * 2u; }
    const size_t kstep = (size_t)(BK * 2);
    const size_t hstep = (size_t)HALF * K * 2;
    const size_t tstep = 2 * hstep;
    const unsigned ldsw = (unsigned)wid * 1024u;
    const int aoff = lds_byte(wr * 64 + fr, fq * 8), boff = lds_byte(wc * 32 + fr, fq * 8);
#define PG8_SA(b, h) (((b) * 2 + (h)) * HTB)
#define PG8_SB(b, h) ((4 + (b) * 2 + (h)) * HTB)
#define PG8_STAGE(bufoff, gbase, voff) do { _Pragma("unroll") for (int _i = 0; _i < 2; ++_i) \
        __builtin_amdgcn_global_load_lds((const unsigned*)((const char*)(gbase) + (voff)[_i]), (PG8_LAS unsigned*)(lds + (bufoff) + ldsw + _i * 8192), 16, 0, 0); } while (0)
#define PG8_LDA(dst, b, h) do { _Pragma("unroll") for (int m = 0; m < 4; ++m) _Pragma("unroll") for (int k = 0; k < 2; ++k) dst[m][k] = *(const PG8_LAS bf16x8*)(lds + PG8_SA(b, h) + aoff + m * 2048 + k * 1024); } while (0)
#define PG8_LDB(dst, b, h) do { _Pragma("unroll") for (int n = 0; n < 2; ++n) _Pragma("unroll") for (int k = 0; k < 2; ++k) dst[n][k] = *(const PG8_LAS bf16x8*)(lds + PG8_SB(b, h) + boff + n * 2048 + k * 1024); } while (0)
#define PG8_MMA(ai, bj, At, Bt) do { __builtin_amdgcn_s_setprio(1); _Pragma("unroll") for (int m = 0; m < 4; ++m) _Pragma("unroll") for (int n = 0; n < 2; ++n) { \
        if constexpr (F8) { typedef int v8i_ __attribute__((ext_vector_type(8))); typedef int v4i_ __attribute__((ext_vector_type(4))); \
            const v4i_ b0_ = __builtin_bit_cast(v4i_, Bt[n][0]), b1_ = __builtin_bit_cast(v4i_, Bt[n][1]), a0_ = __builtin_bit_cast(v4i_, At[m][0]), a1_ = __builtin_bit_cast(v4i_, At[m][1]); \
            const v8i_ bb_ = {b0_.x, b0_.y, b0_.z, b0_.w, b1_.x, b1_.y, b1_.z, b1_.w}, aa_ = {a0_.x, a0_.y, a0_.z, a0_.w, a1_.x, a1_.y, a1_.z, a1_.w}; \
            asm volatile("v_mfma_scale_f32_16x16x128_f8f6f4 %0, %1, %2, %0, %3, %3 op_sel_hi:[0,0,0]" : "+v"(acc[ai][bj][m][n]) : "v"(bb_), "v"(aa_), "v"(f8one)); } \
        else { _Pragma("unroll") for (int k = 0; k < 2; ++k) acc[ai][bj][m][n] = __builtin_amdgcn_mfma_f32_16x16x32_bf16(Bt[n][k], At[m][k], acc[ai][bj][m][n], 0, 0, 0); } } \
        __builtin_amdgcn_s_setprio(0); } while (0)
#define PG8_WAIT_V(n) asm volatile("s_waitcnt vmcnt(" #n ")" ::: "memory")
#define PG8_WAIT_L(n) asm volatile("s_waitcnt lgkmcnt(" #n ")" ::: "memory")
#define PG8_BAR __builtin_amdgcn_s_barrier()
#define PG8_SCHED __builtin_amdgcn_sched_barrier(0)
    Unit cur, nxt; int ui = 0;
    if (!S.next(0, cur)) return;
    f32x4 acc[2][2][4][2];
    const int f8one = 0x7f7f7f7f;
#pragma unroll
    for (int a = 0; a < 2; ++a)
#pragma unroll
        for (int b = 0; b < 2; ++b)
#pragma unroll
            for (int m = 0; m < 4; ++m)
#pragma unroll
                for (int n = 0; n < 2; ++n) acc[a][b][m][n] = (f32x4){0.f, 0.f, 0.f, 0.f};
    bf16x8 At[4][2], B0[2][2], B1[2][2];
    const char* cA = (const char*)g.A + (size_t)cur.pm * tstep; const char* cB = (const char*)g.Bt + (size_t)cur.pn * tstep;
    S.a_ready(cur);
    float segr[16];
    if constexpr (Epi::SEG) E.seg_load(ui, wr, fr, segr);
    if constexpr (SP2) {
        PG8_STAGE(PG8_SB(0, 0), cB, voffB); PG8_STAGE(PG8_SB(0, 1), cB + hstep, voffB); PG8_STAGE(PG8_SA(0, 0), cA, voffA); PG8_STAGE(PG8_SA(0, 1), cA + hstep, voffA);
        if (wr == 1) PG8_BAR;
        PG8_WAIT_V(2); PG8_BAR;
        PG8_STAGE(PG8_SB(1, 0), cB + kstep, voffB); PG8_STAGE(PG8_SA(1, 0), cA + kstep, voffA); PG8_STAGE(PG8_SB(1, 1), cB + hstep + kstep, voffB);
        PG8_WAIT_V(6); PG8_BAR;
    } else {
        PG8_STAGE(PG8_SB(0, 0), cB, voffB); PG8_STAGE(PG8_SA(0, 0), cA, voffA); PG8_STAGE(PG8_SB(0, 1), cB + hstep, voffB); PG8_STAGE(PG8_SA(0, 1), cA + hstep, voffA);
        if (wr == 1) PG8_BAR;
        PG8_WAIT_V(4); PG8_BAR;
        PG8_STAGE(PG8_SB(1, 0), cB + kstep, voffB); PG8_STAGE(PG8_SA(1, 0), cA + kstep, voffA); PG8_STAGE(PG8_SB(1, 1), cB + hstep + kstep, voffB);
        PG8_WAIT_V(6); PG8_BAR;
    }
    for (;;) {
        const bool has_next = S.next(ui + 1, nxt);
        const char* nA = has_next ? (const char*)g.A + (size_t)nxt.pm * tstep : cA; const char* nB = has_next ? (const char*)g.Bt + (size_t)nxt.pn * tstep : cB;
        int t = 0;
#pragma unroll 1
        for (int sgi = 0; sgi < (Epi::SEG ? 3 : 1); ++sgi) {
        int tend = nt; if constexpr (Epi::SEG) tend = (sgi == 0) ? Epi::SEG_T1 : ((sgi == 1) ? Epi::SEG_T2 : nt);
        for (; t < tend; t += 2) {
            const bool last = (t == nt - 2);
            const char* a1 = cA + (size_t)(t + 1) * kstep;
            const char* a2 = last ? nA : cA + (size_t)(t + 2) * kstep; const char* b2 = last ? nB : cB + (size_t)(t + 2) * kstep;
            const char* a3 = a2 + kstep; const char* b3 = b2 + kstep;
            if (last && has_next) S.a_ready(nxt);
            if constexpr (SP2) {
            PG8_LDB(B0, 0, 0); PG8_LDB(B1, 0, 1); PG8_SCHED; PG8_LDA(At, 0, 0); PG8_STAGE(PG8_SA(1, 1), a1 + hstep, voffA);
            PG8_WAIT_V(8); PG8_WAIT_L(0); PG8_BAR; PG8_MMA(0, 0, At, B0); PG8_MMA(0, 1, At, B1); PG8_BAR; PG8_SCHED;
            PG8_LDA(At, 0, 1); PG8_STAGE(PG8_SB(0, 0), b2, voffB); PG8_STAGE(PG8_SB(0, 1), b2 + hstep, voffB); PG8_STAGE(PG8_SA(0, 0), a2, voffA);
            PG8_WAIT_V(8); PG8_WAIT_L(0); PG8_BAR; PG8_MMA(1, 0, At, B0); PG8_MMA(1, 1, At, B1); PG8_BAR; PG8_SCHED;
            PG8_LDB(B0, 1, 0); PG8_LDB(B1, 1, 1); PG8_SCHED; PG8_LDA(At, 1, 0); PG8_STAGE(PG8_SA(0, 1), a2 + hstep, voffA);
            PG8_WAIT_V(8); PG8_WAIT_L(0); PG8_BAR; PG8_MMA(0, 0, At, B0); PG8_MMA(0, 1, At, B1); PG8_BAR; PG8_SCHED;
            PG8_LDA(At, 1, 1); PG8_STAGE(PG8_SB(1, 0), b3, voffB); PG8_STAGE(PG8_SB(1, 1), b3 + hstep, voffB); PG8_STAGE(PG8_SA(1, 0), a3, voffA);
            PG8_WAIT_V(8); PG8_WAIT_L(0); PG8_BAR; PG8_MMA(1, 0, At, B0); PG8_MMA(1, 1, At, B1); PG8_BAR; PG8_SCHED;
            } else {
            PG8_LDB(B0, 0, 0); PG8_SCHED; PG8_LDA(At, 0, 0); PG8_STAGE(PG8_SA(1, 1), a1 + hstep, voffA);
            PG8_WAIT_L(8); PG8_BAR; PG8_WAIT_L(0); PG8_MMA(0, 0, At, B0); PG8_BAR; PG8_SCHED;
            PG8_LDB(B1, 0, 1); PG8_STAGE(PG8_SB(0, 0), b2, voffB);
            PG8_BAR; PG8_WAIT_L(0); PG8_MMA(0, 1, At, B1); PG8_BAR;
            PG8_LDA(At, 0, 1); PG8_STAGE(PG8_SA(0, 0), a2, voffA);
            PG8_BAR; PG8_WAIT_L(0); PG8_MMA(1, 0, At, B0); PG8_BAR; PG8_SCHED;
            PG8_STAGE(PG8_SB(0, 1), b2 + hstep, voffB);
            PG8_WAIT_V(6); PG8_BAR; PG8_MMA(1, 1, At, B1); PG8_BAR;
            PG8_LDB(B0, 1, 0); PG8_SCHED; PG8_LDA(At, 1, 0); PG8_STAGE(PG8_SA(0, 1), a2 + hstep, voffA);
            PG8_WAIT_L(8); PG8_BAR; PG8_WAIT_L(0); PG8_MMA(0, 0, At, B0); PG8_BAR; PG8_SCHED;
            PG8_LDB(B1, 1, 1); PG8_STAGE(PG8_SB(1, 0), b3, voffB);
            PG8_BAR; PG8_WAIT_L(0); PG8_MMA(0, 1, At, B1); PG8_BAR;
            PG8_LDA(At, 1, 1); PG8_STAGE(PG8_SA(1, 0), a3, voffA);
            PG8_BAR; PG8_WAIT_L(0); PG8_MMA(1, 0, At, B0); PG8_BAR; PG8_SCHED;
            PG8_STAGE(PG8_SB(1, 1), b3 + hstep, voffB);
            PG8_WAIT_V(6); PG8_BAR; PG8_MMA(1, 1, At, B1); PG8_BAR;
            }
        }
        if constexpr (Epi::SEG) E.seg_apply(acc, segr, sgi);
        }
        if constexpr (ALIGN_EPI) { if (wr == 0) PG8_BAR; }
        if constexpr (!Epi::AFTER_DRAIN) { if constexpr (Epi::SEG) E(acc, cur, wr, wc, fr, fq, ui); else E(acc, cur, wr, wc, fr, fq); S.done(cur); }
        if (!has_next) break;
#pragma unroll
        for (int a = 0; a < 2; ++a)
#pragma unroll
            for (int b = 0; b < 2; ++b)
#pragma unroll
                for (int m = 0; m < 4; ++m)
#pragma unroll
                    for (int n = 0; n < 2; ++n) acc[a][b][m][n] = (f32x4){0.f, 0.f, 0.f, 0.f};
        cur = nxt; cA = nA; cB = nB; ++ui;
        if constexpr (Epi::SEG) E.seg_load(ui, wr, fr, segr);
        if constexpr (ALIGN_EPI) { if (wr == 1) PG8_BAR; }
    }
    PG8_WAIT_V(0);
    if constexpr (!ALIGN_EPI) { if (wr == 0) PG8_BAR; }
    PG8_BAR;
    if constexpr (Epi::AFTER_DRAIN) { E.fused(acc, cur, wr, wc, fr, fq, lds, wid, lane); S.done(cur); }
#undef PG8_SA
#undef PG8_SB
#undef PG8_STAGE
#undef PG8_LDA
#undef PG8_LDB
#undef PG8_MMA
#undef PG8_WAIT_V
#undef PG8_WAIT_L
#undef PG8_BAR
#undef PG8_SCHED
}
}
#ifndef PG8_SP2
#define PG8_SP2 true
#endif
#ifndef PG8_ALIGN
#define PG8_ALIGN true
#endif

constexpr int BATCH = 8, SEQ = 2048, DM = 2048, MTOK = BATCH * SEQ;
constexpr int ATT_W = 1024, ATT_H = 8, ATT_HD = 128, MOBA_BLK = 256, NBLK = SEQ / MOBA_BLK;
constexpr int SSM_W = 1024, SSM_H = 16, SSM_P = 64, SSM_N = 128, SSM_L = 128, SSM_NC = SEQ / SSM_L, CONV_CH = 1536;
constexpr int IN_PROJ = 5648, NPROJ = 5632  , NPAD = 5888  ;
constexpr int F8_LO = 2048, F8_HI = 4096, NB16 = NPAD - (F8_HI - F8_LO)  ;
constexpr float SH8 = 16.f;
constexpr int COL_Q = 0, COL_K = 1024, COL_V = 2048, COL_Z = 3072, COL_XBC = 4096;
constexpr int PEER_H = 8, PEER_NK = 128, PEER_K = 16, PEER_HK = 128;
constexpr float EPS = 1e-6f;
constexpr float SU = 64.f, SV = 4.f, SH = 16.f, SLO = 16.f;
constexpr float SX8 = 16.f, SW8 = 1024.f;
constexpr float SA8 = 32.f, SS8 = 8.f;
constexpr float SH4 = 1.5f, SLO4 = 4.f;
constexpr int ROWB = DM / 2;

constexpr size_t MiB = 1u << 20;
constexpr size_t WS_CTL = 0, CTL_ZERO_BYTES = 1 * MiB;
constexpr size_t WS_DT = 1 * MiB;
constexpr size_t WS_SK = 2 * MiB;
constexpr size_t WS_WIN = 4 * MiB;
constexpr size_t WS_WIN8 = 24 * MiB;
constexpr size_t WS_HN8 = 396 * MiB;
constexpr size_t WS_WOUT = 28 * MiB;
constexpr size_t WS_WQ = 36 * MiB;
constexpr size_t WS_HN = 44 * MiB;
constexpr size_t WS_PROJ = 108 * MiB;
constexpr size_t WS_X1B = WS_PROJ, WS_QP = WS_PROJ + 64 * MiB;
constexpr size_t WS_U8 = 284 * MiB, WS_V8 = 316 * MiB;
constexpr size_t WS_XBC = 348 * MiB;
constexpr size_t WS_DT2 = 3 * MiB;
constexpr size_t WS_X18 = 396 * MiB;
constexpr size_t WS_END = 428 * MiB;
constexpr int CW_BAR = 4096;
constexpr int CW_Q2 = 8192;
constexpr int CW_KMEAN = 32768;
constexpr int CW_SSQ = 131072;
static_assert((CW_SSQ + MTOK * 4) * 4 <= (int)CTL_ZERO_BYTES, "CTL words inside the memset region");

constexpr int RING_OFF = 0, RING_BYTES = 131072;
constexpr int LDSCTL_OFF = RING_BYTES, MISC_OFF = LDSCTL_OFF + 320;
constexpr int SEGTAB_OFF = LDSCTL_OFF + 1024;  static_assert(LDSCTL_OFF + 1024 + 3 * 256 * 16 <= 147456, "segment table inside the LDS allocation");
constexpr int LDS_BYTES = 147456;
constexpr int NWAVES = 8;

#define GAS __attribute__((address_space(1)))
#define LAS __attribute__((address_space(3)))
typedef unsigned short bf16;
typedef unsigned v4u __attribute__((ext_vector_type(4)));
typedef unsigned v2u __attribute__((ext_vector_type(2)));
typedef float f32x4 __attribute__((ext_vector_type(4)));
typedef float f32x2 __attribute__((ext_vector_type(2)));
typedef short bf16x8 __attribute__((ext_vector_type(8)));
typedef short s16x4 __attribute__((ext_vector_type(4)));
typedef GAS unsigned gu32;
#define RLX_AGENT __ATOMIC_RELAXED, __HIP_MEMORY_SCOPE_AGENT
#define LDS_WAIT() asm volatile("s_waitcnt lgkmcnt(0)" ::: "memory")
#define VM_WAIT() asm volatile("s_waitcnt vmcnt(0)" ::: "memory")
__device__ __forceinline__ unsigned f2bf(float f) { unsigned u = __builtin_bit_cast(unsigned, f); return (u + 0x7fffu + ((u >> 16) & 1u)) >> 16; }
typedef __bf16 bf16v2 __attribute__((ext_vector_type(2)));
__device__ __forceinline__ unsigned pk2(float lo, float hi) { bf16v2 v; v.x = (__bf16)lo; v.y = (__bf16)hi; return __builtin_bit_cast(unsigned, v); }
__device__ __forceinline__ float bflo(unsigned w) { return __builtin_bit_cast(float, w << 16); }
__device__ __forceinline__ float bfhi(unsigned w) { return __builtin_bit_cast(float, w & 0xffff0000u); }
__device__ __forceinline__ float wave_sum(float v) {
#pragma unroll
    for (int o = 1; o < 64; o <<= 1) v += __shfl_xor(v, o);
    return v;
}
__device__ __forceinline__ float silu_f(float x) { return x * __builtin_amdgcn_rcpf(1.f + __expf(-x)); }

#define XB_TMO      128
#define XB_XCNT(j)  (256  + 64 * (j))
#define XB_XSUB(j)  (1280 + 64 * (j))
#define XB_XGEN(j)  (2304 + 64 * (j))
#define XB_TOP      3328
#define XB_TOPGEN   3392
#define XCD_BAR_WORDS 3456
#define XB_SPIN_CAP (1u << 18)

__device__ __forceinline__ unsigned xb_ld(unsigned* p)              { return __hip_atomic_load(p, __ATOMIC_RELAXED, __HIP_MEMORY_SCOPE_AGENT); }
__device__ __forceinline__ unsigned xb_add(unsigned* p, unsigned v) { return __hip_atomic_fetch_add(p, v, __ATOMIC_RELAXED, __HIP_MEMORY_SCOPE_AGENT); }
__device__ __forceinline__ unsigned xb_xcc_id() { return (unsigned)__builtin_amdgcn_s_getreg((3 << 11) | 20) & 0xFu; }
#define XB_SPIN(cond, bar) do { unsigned _sp = 0; while (cond) { __builtin_amdgcn_s_sleep(1); \
    if ((++_sp & 255u) == 0u) { if (xb_ld(&(bar)[XB_TMO])) break; if (_sp > XB_SPIN_CAP) { atomicAdd(&(bar)[XB_TMO], 1u); break; } } } } while (0)

struct XcdBarrier {
    unsigned* bar; unsigned x;
    volatile LAS unsigned* st;
};
__device__ __forceinline__ XcdBarrier xcd_barrier_post(unsigned* bar, volatile LAS unsigned* st) {
    XcdBarrier b; b.bar = bar; b.x = xb_xcc_id(); b.st = st;
    if (threadIdx.x == 0) (void)xb_add(&bar[XB_XCNT(b.x)], 1u);
    return b;
}
__device__ __forceinline__ void xcd_barrier_complete(unsigned* bar, unsigned x, unsigned& nloc, unsigned& nx) {
    const unsigned G = gridDim.x * gridDim.y * gridDim.z;
    unsigned sum, cnt, mine, sp = 0u;
    for (;;) {
        sum = 0u; cnt = 0u; mine = 0u;
#pragma unroll
        for (unsigned j = 0; j < 16; ++j) { const unsigned c = xb_ld(&bar[XB_XCNT(j)]); sum += c; cnt += (c > 0u) ? 1u : 0u; mine = (j == x) ? c : mine; }
        if (sum == G) break;
        __builtin_amdgcn_s_sleep(1);
        if ((++sp & 255u) == 0u) { if (xb_ld(&bar[XB_TMO])) break; if (sp > XB_SPIN_CAP) { atomicAdd(&bar[XB_TMO], 1u); break; } }
    }
    nloc = mine > 0u ? mine : 1u; nx = cnt > 0u ? cnt : 1u;
}
__device__ __forceinline__ void xcd_barrier(const XcdBarrier& b) {
    asm volatile("s_waitcnt vmcnt(0)" ::: "memory");
    __syncthreads();
    if (threadIdx.x == 0) {
        unsigned* bar = b.bar;
        __builtin_amdgcn_s_waitcnt(0);
        unsigned nloc = b.st[0], nx = b.st[1];
        if (nloc == 0u) { xcd_barrier_complete(bar, b.x, nloc, nx); b.st[0] = nloc; b.st[1] = nx; }
        const unsigned old = xb_add(&bar[XB_XSUB(b.x)], 1u);
        const unsigned gen = old / nloc;
        if (old + 1u == (gen + 1u) * nloc) {
            __builtin_amdgcn_fence(__ATOMIC_RELEASE, "agent");
            asm volatile("s_waitcnt vmcnt(0)" ::: "memory");
            const unsigned og = xb_add(&bar[XB_TOP], 1u);
            const unsigned tg = og / nx;
            if (og + 1u == (tg + 1u) * nx) xb_add(&bar[XB_TOPGEN], 1u);
            else XB_SPIN(xb_ld(&bar[XB_TOPGEN]) == tg, bar);
            __builtin_amdgcn_fence(__ATOMIC_ACQUIRE, "agent");
            xb_add(&bar[XB_XGEN(b.x)], 1u);
            asm volatile("s_waitcnt vmcnt(0)" ::: "memory");
        } else {
            XB_SPIN(xb_ld(&bar[XB_XGEN(b.x)]) == gen, bar);
            __builtin_amdgcn_fence(__ATOMIC_ACQUIRE, "agent");
            asm volatile("s_waitcnt vmcnt(0)" ::: "memory");
        }
    }
    __syncthreads();
}

#define CAS __attribute__((address_space(4)))
struct Args { const float* in[18]; float* out; unsigned char* ws; };
__device__ __forceinline__ const CAS unsigned char* kargs() { const CAS unsigned char* p = (const CAS unsigned char*)__builtin_amdgcn_kernarg_segment_ptr(); asm volatile("" : "+s"(p)); return p; }
__device__ __forceinline__ const float* kin(int i) { return *(const float* const CAS*)(kargs() + 8 * i); }
__device__ __forceinline__ float* kout() { return *(float* const CAS*)(kargs() + 8 * 18); }
__device__ __forceinline__ unsigned char* kws() { return *(unsigned char* const CAS*)(kargs() + 8 * 19); }
__device__ __forceinline__ int fresh_tid() { int t = threadIdx.x; asm volatile("" : "+v"(t)); return t; }
struct Frame {
    LAS unsigned char* lds;
    volatile LAS unsigned* MISC;
    int tid, lane, wave, G;
    __device__ __forceinline__ const float* x() const { return kin(0); }
    __device__ __forceinline__ const float* attn_norm() const { return kin(1); }
    __device__ __forceinline__ const float* w_in() const { return kin(2); }
    __device__ __forceinline__ const float* conv_w() const { return kin(3); }
    __device__ __forceinline__ const float* conv_b() const { return kin(4); }
    __device__ __forceinline__ const float* dt_bias() const { return kin(5); }
    __device__ __forceinline__ const float* a_log() const { return kin(6); }
    __device__ __forceinline__ const float* d_skip() const { return kin(7); }
    __device__ __forceinline__ const float* rel_bias() const { return kin(8); }
    __device__ __forceinline__ const float* attn_out_norm() const { return kin(9); }
    __device__ __forceinline__ const float* ssm_out_norm() const { return kin(10); }
    __device__ __forceinline__ const float* w_out() const { return kin(11); }
    __device__ __forceinline__ const float* ffn_norm() const { return kin(12); }
    __device__ __forceinline__ const float* peer_wq() const { return kin(13); }
    __device__ __forceinline__ const float* peer_sk() const { return kin(14); }
    __device__ __forceinline__ const float* peer_u() const { return kin(15); }
    __device__ __forceinline__ const float* peer_v() const { return kin(16); }
    __device__ __forceinline__ const float* final_norm() const { return kin(17); }
    __device__ __forceinline__ float* out() const { return kout(); }
    __device__ __forceinline__ unsigned* ctl() const { return (unsigned*)(kws() + WS_CTL); }
    __device__ __forceinline__ float* dtraw() const { return (float*)(kws() + WS_DT); }
    __device__ __forceinline__ bf16* SK() const { return (bf16*)(kws() + WS_SK); }
    __device__ __forceinline__ bf16* WinT() const { return (bf16*)(kws() + WS_WIN); }
    __device__ __forceinline__ bf16* WoutT() const { return (bf16*)(kws() + WS_WOUT); }
    __device__ __forceinline__ bf16* WqT() const { return (bf16*)(kws() + WS_WQ); }
    __device__ __forceinline__ bf16* HN() const { return (bf16*)(kws() + WS_HN); }
    __device__ __forceinline__ bf16* PROJ() const { return (bf16*)(kws() + WS_PROJ); }
    __device__ __forceinline__ bf16* X1B() const { return (bf16*)(kws() + WS_X1B); }
    __device__ __forceinline__ bf16* QP() const { return (bf16*)(kws() + WS_QP); }
    __device__ __forceinline__ unsigned char* U8() const { return kws() + WS_U8; }
    __device__ __forceinline__ unsigned char* V8() const { return kws() + WS_V8; }
    __device__ __forceinline__ unsigned char* X18() const { return kws() + WS_X18; }
    __device__ __forceinline__ unsigned char* HN8() const { return kws() + WS_HN8; }
    __device__ __forceinline__ unsigned char* WinT8() const { return kws() + WS_WIN8; }
    __device__ __forceinline__ bf16* XBC() const { return (bf16*)(kws() + WS_XBC); }
    __device__ __forceinline__ float* DT2() const { return (float*)(kws() + WS_DT2); }
    __device__ __forceinline__ float* kmean() const { return (float*)(kws() + WS_CTL) + CW_KMEAN; }
    __device__ __forceinline__ float* ssq() const { return (float*)(kws() + WS_CTL) + CW_SSQ; }
};

__device__ __forceinline__ float clampf(float v, float lim);
__device__ __forceinline__ void p0_transpose_item(const float* W, int K, int N, bf16* WT, const float* gain, LAS float* scr, int item, int lane, const float f8scale = 0.f, const int nshift = 0) {
    const int nblk = (N + 31) / 32, kb = item / nblk, nb = item % nblk, k0 = 64 * kb, n0 = 32 * nb;
    const int kr = lane >> 3, nc = (lane & 7) * 4; const bool ok = (n0 + nc) < N;
    f32x4 v[8]; float gk[8];
#pragma unroll
    for (int i = 0; i < 8; ++i) { const int kk = 8 * i + kr; v[i] = ok ? *(const GAS f32x4*)(W + (size_t)(k0 + kk) * N + n0 + nc) : (f32x4){0.f, 0.f, 0.f, 0.f}; gk[i] = gain ? gain[k0 + kk] : 1.f; }
#pragma unroll
    for (int i = 0; i < 8; ++i) { const int kk = 8 * i + kr; LAS float* d = scr + kk * 33 + nc; d[0] = v[i].x * gk[i]; d[1] = v[i].y * gk[i]; d[2] = v[i].z * gk[i]; d[3] = v[i].w * gk[i]; }
    LDS_WAIT(); asm volatile("" ::: "memory");
    const int c = lane & 7;
#pragma unroll
    for (int j = 0; j < 4; ++j) { const int n = (lane >> 3) + 8 * j; const LAS float* s = scr + (8 * c) * 33 + n;
        v4u o; o.x = pk2(s[0 * 33], s[1 * 33]); o.y = pk2(s[2 * 33], s[3 * 33]); o.z = pk2(s[4 * 33], s[5 * 33]); o.w = pk2(s[6 * 33], s[7 * 33]);
        if (f8scale == 0.f) *(GAS v4u*)(WT + (size_t)(n0 + n - nshift) * K + k0 + 8 * c) = o;
        else { v2u o8; int w_;
            w_ = __builtin_amdgcn_cvt_pk_fp8_f32(clampf(s[0 * 33] * f8scale, 448.f), clampf(s[1 * 33] * f8scale, 448.f), 0, false); w_ = __builtin_amdgcn_cvt_pk_fp8_f32(clampf(s[2 * 33] * f8scale, 448.f), clampf(s[3 * 33] * f8scale, 448.f), w_, true); o8.x = (unsigned)w_;
            w_ = __builtin_amdgcn_cvt_pk_fp8_f32(clampf(s[4 * 33] * f8scale, 448.f), clampf(s[5 * 33] * f8scale, 448.f), 0, false); w_ = __builtin_amdgcn_cvt_pk_fp8_f32(clampf(s[6 * 33] * f8scale, 448.f), clampf(s[7 * 33] * f8scale, 448.f), w_, true); o8.y = (unsigned)w_;
            *(GAS v2u*)((unsigned char*)WT + (size_t)(n0 + n - nshift) * K + k0 + 8 * c) = o8; } }
    LDS_WAIT(); asm volatile("" ::: "memory");
}
__device__ __forceinline__ unsigned pk4_fp8(float a, float b, float c, float d) { int w = __builtin_amdgcn_cvt_pk_fp8_f32(clampf(a, 448.f), clampf(b, 448.f), 0, false); w = __builtin_amdgcn_cvt_pk_fp8_f32(clampf(c, 448.f), clampf(d, 448.f), w, true); return (unsigned)w; }
__device__ __forceinline__ void rms_2rows_to_bf16(const float* x0, const float* x1, const float* gain, bf16* o0, bf16* o1, unsigned char* q0, unsigned char* q1, int lane) {
    const GAS f32x4* xr0 = (const GAS f32x4*)x0 + lane; const GAS f32x4* xr1 = (const GAS f32x4*)x1 + lane; const GAS f32x4* gr = (const GAS f32x4*)gain + lane;
    f32x4 v[8], u[8]; float s = 0.f, t = 0.f;
#pragma unroll
    for (int j = 0; j < 8; ++j) { v[j] = xr0[64 * j]; u[j] = xr1[64 * j]; }
#pragma unroll
    for (int j = 0; j < 8; ++j) { s += (v[j].x * v[j].x + v[j].y * v[j].y) + (v[j].z * v[j].z + v[j].w * v[j].w); t += (u[j].x * u[j].x + u[j].y * u[j].y) + (u[j].z * u[j].z + u[j].w * u[j].w); }
    const float rs = __builtin_amdgcn_rsqf(wave_sum(s) * (1.f / DM) + EPS), rt = __builtin_amdgcn_rsqf(wave_sum(t) * (1.f / DM) + EPS);
    GAS v2u* p0 = (GAS v2u*)o0 + lane; GAS v2u* p1 = (GAS v2u*)o1 + lane; GAS unsigned* r0 = (GAS unsigned*)q0 + lane; GAS unsigned* r1 = (GAS unsigned*)q1 + lane;
#pragma unroll
    for (int j = 0; j < 8; ++j) { const f32x4 g = gr[64 * j]; v2u a, b;
        const f32x4 h0 = v[j] * g * rs, h1 = u[j] * g * rt;
        a.x = pk2(h0.x, h0.y); a.y = pk2(h0.z, h0.w); p0[64 * j] = a; r0[64 * j] = pk4_fp8(h0.x * SH8, h0.y * SH8, h0.z * SH8, h0.w * SH8);
        b.x = pk2(h1.x, h1.y); b.y = pk2(h1.z, h1.w); p1[64 * j] = b; r1[64 * j] = pk4_fp8(h1.x * SH8, h1.y * SH8, h1.z * SH8, h1.w * SH8); }
}
#ifdef PROBE_FP4EMU
__device__ __forceinline__ float fp4grid(float y) { const float a = fabsf(y); float r;
    if (a <= 2.f) r = rintf(a * 2.f) * 0.5f; else if (a <= 4.f) r = rintf(a); else r = (a < 5.f) ? 4.f : 6.f;
    return copysignf(r, y); }
__device__ __forceinline__ float clampf(float v, float lim) { if (lim == 448.5f) return fp4grid(v * (1.f / 16.f)) * 16.f; return fminf(fmaxf(v, -lim), lim); }
#else
__device__ __forceinline__ float clampf(float v, float lim) { return fminf(fmaxf(v, -lim), lim); }
#endif
template <int TAB = 0> __device__ __forceinline__ v4u cvt16_fp8(const f32x4 a, const f32x4 b, const f32x4 c, const f32x4 d, float sc) {
    v4u o; int w; constexpr float LIM = TAB ? 448.5f : 448.f;
    w = __builtin_amdgcn_cvt_pk_fp8_f32(clampf(a.x * sc, LIM), clampf(a.y * sc, LIM), 0, false); w = __builtin_amdgcn_cvt_pk_fp8_f32(clampf(a.z * sc, LIM), clampf(a.w * sc, LIM), w, true); o.x = (unsigned)w;
    w = __builtin_amdgcn_cvt_pk_fp8_f32(clampf(b.x * sc, LIM), clampf(b.y * sc, LIM), 0, false); w = __builtin_amdgcn_cvt_pk_fp8_f32(clampf(b.z * sc, LIM), clampf(b.w * sc, LIM), w, true); o.y = (unsigned)w;
    w = __builtin_amdgcn_cvt_pk_fp8_f32(clampf(c.x * sc, LIM), clampf(c.y * sc, LIM), 0, false); w = __builtin_amdgcn_cvt_pk_fp8_f32(clampf(c.z * sc, LIM), clampf(c.w * sc, LIM), w, true); o.z = (unsigned)w;
    w = __builtin_amdgcn_cvt_pk_fp8_f32(clampf(d.x * sc, LIM), clampf(d.y * sc, LIM), 0, false); w = __builtin_amdgcn_cvt_pk_fp8_f32(clampf(d.z * sc, LIM), clampf(d.w * sc, LIM), w, true); o.w = (unsigned)w;
    return o;
}
__device__ __forceinline__ void tables_convert(Frame& F, size_t lo, size_t hi, size_t tix, size_t ntx) {
      const GAS f32x4* su = (const GAS f32x4*)F.peer_u(); const GAS f32x4* sv = (const GAS f32x4*)F.peer_v(); GAS v4u* du = (GAS v4u*)F.U8(); GAS v4u* dv = (GAS v4u*)F.V8();
#pragma unroll 1
      for (int tab = 0; tab < 2; ++tab) { const GAS f32x4* src = tab ? sv : su; GAS v4u* dst = tab ? dv : du; const float sc = tab ? SV : SU;
        f32x4 nx[8]; const size_t i0 = lo + tix;
        if (i0 < hi) { const GAS f32x4* p = src + (i0 >> 6) * 512 + (i0 & 63);
#pragma unroll
            for (int j = 0; j < 8; ++j) nx[j] = p[64 * j]; }
#pragma unroll 1
        for (size_t i = i0; i < hi; i += ntx) { f32x4 v[8];
#pragma unroll
            for (int j = 0; j < 8; ++j) v[j] = nx[j];
            if (i + ntx < hi) { const size_t i2 = i + ntx; const GAS f32x4* p = src + (i2 >> 6) * 512 + (i2 & 63);
#pragma unroll
                for (int j = 0; j < 8; ++j) nx[j] = p[64 * j]; }
            unsigned wd[4];
#pragma unroll
            for (int q = 0; q < 4; ++q) { const f32x4 a = v[2 * q] * sc, b = v[2 * q + 1] * sc; unsigned w = 0u;
                w = __builtin_amdgcn_cvt_scalef32_pk_fp4_f32(w, clampf(a.x, 6.f), clampf(a.y, 6.f), 1.0f, 0); w = __builtin_amdgcn_cvt_scalef32_pk_fp4_f32(w, clampf(a.z, 6.f), clampf(a.w, 6.f), 1.0f, 1);
                w = __builtin_amdgcn_cvt_scalef32_pk_fp4_f32(w, clampf(b.x, 6.f), clampf(b.y, 6.f), 1.0f, 2); w = __builtin_amdgcn_cvt_scalef32_pk_fp4_f32(w, clampf(b.z, 6.f), clampf(b.w, 6.f), 1.0f, 3); wd[q] = w; }
            dst[i] = (v4u){wd[0], wd[1], wd[2], wd[3]}; } }
}
constexpr size_t TAB_ITEMS = (size_t)16384 * 64;
#ifndef TAB_HEAD8
#define TAB_HEAD8 4
#endif
__device__ __forceinline__ size_t tab_split(int G) { const int rem = ((MTOK / 256) * (NB16 / 256)) % G; return rem ? (TAB_ITEMS / 8) * TAB_HEAD8 : TAB_ITEMS; }
__device__ __forceinline__ unsigned fp4_code(float y) { const float a = fabsf(y);
    const unsigned m = (unsigned)(a >= 0.25f) + (unsigned)(a >= 0.75f) + (unsigned)(a >= 1.25f) + (unsigned)(a >= 1.75f) + (unsigned)(a >= 2.5f) + (unsigned)(a >= 3.5f) + (unsigned)(a >= 5.0f);
    return m | ((y < 0.f) ? 8u : 0u); }
constexpr int W_SQ_ITEMS = (DM / 64) * (DM / 32), W_SQ_PER_UNIT = 64, W_SQ_UNITS = 2 * W_SQ_ITEMS / W_SQ_PER_UNIT;
__device__ __forceinline__ void sq_weight_items(Frame& F, int unit) {
    const int tid = fresh_tid(), lane = tid & 63, wave = __builtin_amdgcn_readfirstlane(tid >> 6);
    LAS float* scr = (LAS float*)(F.lds + RING_OFF + wave * 16384);
    const float* const w_out = F.w_out(); const float* const wq = F.peer_wq(); const float* const fg = F.ffn_norm(); bf16* const WoutT = F.WoutT(); bf16* const WqT = F.WqT(); const float* const gatt = F.attn_out_norm(); const float* const gssm = F.ssm_out_norm();
#pragma unroll 1
    for (int k = 0; k < W_SQ_PER_UNIT / NWAVES; ++k) {
        int r = unit * W_SQ_PER_UNIT + k * NWAVES + wave;
        if (r < W_SQ_ITEMS) { const int k0_ = 64 * (r / (DM / 32)); p0_transpose_item(w_out, DM, DM, WoutT, (k0_ < ATT_W) ? gatt : (gssm - ATT_W), scr, r, lane, SW8); }
        else { r -= W_SQ_ITEMS; p0_transpose_item(wq, DM, DM, WqT, fg, scr, r, lane, SW8); }
    }
}
__device__ __forceinline__ void p0_prologue(Frame& F) {
    const int tid = fresh_tid(), lane = tid & 63, wave = __builtin_amdgcn_readfirstlane(tid >> 6);
    LAS float* scr = (LAS float*)(F.lds + RING_OFF + wave * 16384);
    const int gw = blockIdx.x * NWAVES + wave, NGW = F.G * NWAVES;
    constexpr int I_IN = (DM / 64) * ((IN_PROJ + 31) / 32), I_SQ = (DM / 64) * (DM / 32);
    constexpr int NITEMS = I_IN;
    { const float* const w_in = F.w_in(); const float* const w_out = F.w_out(); const float* const wq = F.peer_wq(); const float* const fg = F.ffn_norm(); bf16* const WinT = F.WinT(); unsigned char* const WinT8 = F.WinT8(); bf16* const WoutT = F.WoutT(); bf16* const WqT = F.WqT(); const float* const gatt = F.attn_out_norm(); const float* const gssm = F.ssm_out_norm();
      for (int it = gw; it < NITEMS; it += NGW) {
        int r = it;
        if (r < I_IN) { const int n0_ = 32 * (r % ((IN_PROJ + 31) / 32));
            if (n0_ >= F8_LO && n0_ < F8_HI) p0_transpose_item(w_in, DM, IN_PROJ, (bf16*)WinT8, nullptr, scr, r, lane, SW8, F8_LO);
            else p0_transpose_item(w_in, DM, IN_PROJ, WinT, nullptr, scr, r, lane, 0.f, (n0_ >= F8_HI) ? (F8_HI - F8_LO) : 0);
            continue; } r -= I_IN;
      } }
    const size_t gt = (size_t)blockIdx.x * (NWAVES * 64) + tid, GT = (size_t)F.G * NWAVES * 64;
    { const size_t z0 = (size_t)(5664 - (F8_HI - F8_LO)) * DM / 8, z1 = (size_t)NB16 * DM / 8; GAS v4u* p = (GAS v4u*)F.WinT(); for (size_t i = z0 + gt; i < z1; i += GT) p[i] = (v4u){0u, 0u, 0u, 0u}; }
    { const float* const s = F.peer_sk(); GAS v4u* d = (GAS v4u*)F.SK();
      for (size_t o = gt; o < (size_t)16 * 128 * 128 / 8; o += GT) { const int frag = (int)(o >> 6), l = (int)(o & 63), g_ = l >> 4, c_ = l & 15, p_ = frag >> 5, kb_ = (frag >> 2) & 7, ks_ = frag & 3;
          const GAS f32x4* sp = (const GAS f32x4*)(s + (size_t)(p_ * 128 + 16 * kb_ + c_) * 128 + 32 * ks_ + 8 * g_); const f32x4 a = sp[0], b = sp[1];
          v4u w; w.x = pk2(a.x, a.y); w.y = pk2(a.z, a.w); w.z = pk2(b.x, b.y); w.w = pk2(b.z, b.w); d[o] = w; } }
    { const float* const xg = F.x(); const float* const gn = F.attn_norm(); bf16* const hn = F.HN(); unsigned char* const hn8 = F.HN8();
      for (int m = gw; m < MTOK / 2; m += NGW) rms_2rows_to_bf16(xg + (size_t)(2 * m) * DM, xg + (size_t)(2 * m + 1) * DM, gn, hn + (size_t)(2 * m) * DM, hn + (size_t)(2 * m + 1) * DM, hn8 + (size_t)(2 * m) * DM, hn8 + (size_t)(2 * m + 1) * DM, lane); }
}

struct EpiProj {
    static constexpr bool PERM = true, AFTER_DRAIN = false, SEG = false;
    bf16* O; float* dtraw; float* kmean;
    __device__ __forceinline__ void operator()(const pg8::f32x4 (&acc)[2][2][4][2], const pg8::Unit& u, int wr, int wc, int fr, int fq) const {
        const int rpn = (u.pn < F8_LO / 256) ? u.pn : u.pn + (F8_HI - F8_LO) / 256;
        const int row0 = u.pm * 256 + wr * 64 + fr, col0 = rpn * 256 + wc * 32 + 8 * fq;
        if (rpn < 22) {
#pragma unroll
            for (int ai = 0; ai < 2; ++ai)
#pragma unroll
                for (int m = 0; m < 4; ++m) { bf16* rowp = O + (size_t)(row0 + ai * 128 + m * 16) * NPROJ + col0;
#pragma unroll
                    for (int bj = 0; bj < 2; ++bj) { const pg8::f32x4 v0 = acc[ai][bj][m][0], v1 = acc[ai][bj][m][1];
                        pg8::u32x4 w; w.x = pg8::cvt_pk_bf16(v0[0], v0[1]); w.y = pg8::cvt_pk_bf16(v0[2], v0[3]); w.z = pg8::cvt_pk_bf16(v1[0], v1[1]); w.w = pg8::cvt_pk_bf16(v1[2], v1[3]);
                        *(pg8::u32x4*)(rowp + bj * 128) = w; } }
        } else if (wc == 0 && fq < 2) {
#pragma unroll
            for (int ai = 0; ai < 2; ++ai)
#pragma unroll
                for (int m = 0; m < 4; ++m) { float* rp = dtraw + (size_t)(row0 + ai * 128 + m * 16) * 16 + 8 * fq;
                    *(pg8::f32x4*)rp = acc[ai][0][m][0]; *(pg8::f32x4*)(rp + 4) = acc[ai][0][m][1]; }
        }
        if (kmean && u.pn >= 4 && u.pn < 8) {
#pragma unroll
            for (int bj = 0; bj < 2; ++bj)
#pragma unroll
                for (int n = 0; n < 2; ++n)
#pragma unroll
                    for (int i = 0; i < 4; ++i) { float s = 0.f;
#pragma unroll
                        for (int ai = 0; ai < 2; ++ai)
#pragma unroll
                            for (int m = 0; m < 4; ++m) s += acc[ai][bj][m][n][i];
                        s += __shfl_xor(s, 1); s += __shfl_xor(s, 2); s += __shfl_xor(s, 4); s += __shfl_xor(s, 8);
                        if (fr == 0) unsafeAtomicAdd(kmean + (size_t)u.pm * 1024 + (col0 - 1024) + bj * 128 + 4 * n + i, s); }
        }
    }
};
struct EpiProj8 {
    static constexpr bool PERM = true, AFTER_DRAIN = false, SEG = false;
    bf16* O;
    __device__ __forceinline__ void operator()(const pg8::f32x4 (&acc)[2][2][4][2], const pg8::Unit& u, int wr, int wc, int fr, int fq) const {
        const int row0 = u.pm * 256 + wr * 64 + fr, col0 = F8_LO + u.pn * 256 + wc * 32 + 8 * fq; constexpr float sc = 1.f / (SH8 * SW8);
#pragma unroll
        for (int ai = 0; ai < 2; ++ai)
#pragma unroll
            for (int m = 0; m < 4; ++m) { bf16* rowp = O + (size_t)(row0 + ai * 128 + m * 16) * NPROJ + col0;
#pragma unroll
                for (int bj = 0; bj < 2; ++bj) { const pg8::f32x4 v0 = acc[ai][bj][m][0] * sc, v1 = acc[ai][bj][m][1] * sc;
                    pg8::u32x4 w; w.x = pg8::cvt_pk_bf16(v0[0], v0[1]); w.y = pg8::cvt_pk_bf16(v0[2], v0[3]); w.z = pg8::cvt_pk_bf16(v1[0], v1[1]); w.w = pg8::cvt_pk_bf16(v1[2], v1[3]);
                    *(pg8::u32x4*)(rowp + bj * 128) = w; } }
    }
};
struct EpiOut {
    static constexpr bool PERM = true, AFTER_DRAIN = false, SEG = true; static constexpr int SEG_T1 = 8, SEG_T2 = 12;
    const float* x; bf16* x1b; unsigned char* x18; float* ssq; bool doatom; const LAS f32x4* tab;
    __device__ __forceinline__ void seg_load(int ui, int wr, int fr, float (&sr)[16]) const {
#pragma unroll
        for (int i = 0; i < 8; ++i) { const int r = (i >> 2) * 128 + wr * 64 + (i & 3) * 16 + fr; const f32x2 q = *(const LAS f32x2*)(tab + ui * 256 + r); sr[2 * i] = q.x; sr[2 * i + 1] = q.y; }
        asm volatile("s_waitcnt lgkmcnt(0)" ::: "memory");
    }
    __device__ __forceinline__ void seg_apply(pg8::f32x4 (&acc)[2][2][4][2], const float (&sr)[16], int which) const {
#pragma unroll
        for (int ai = 0; ai < 2; ++ai)
#pragma unroll
            for (int m = 0; m < 4; ++m) { const float f = (which == 0) ? sr[2 * (ai * 4 + m)] : ((which == 1) ? sr[2 * (ai * 4 + m) + 1] : 1.0f);
#pragma unroll
                for (int bj = 0; bj < 2; ++bj)
#pragma unroll
                    for (int n = 0; n < 2; ++n) acc[ai][bj][m][n] = acc[ai][bj][m][n] * f; }
    }
    __device__ __forceinline__ void operator()(const pg8::f32x4 (&acc)[2][2][4][2], const pg8::Unit& u, int wr, int wc, int fr, int fq, int ui) const {
        const int row0 = u.pm * 256 + wr * 64 + fr, col0 = u.pn * 256 + wc * 32 + 8 * fq;
#pragma unroll
        for (int ai = 0; ai < 2; ++ai)
#pragma unroll
            for (int m = 0; m < 4; ++m) { const int row = row0 + ai * 128 + m * 16; const size_t off = (size_t)row * DM + col0; float s = 0.f;
                const float s1 = (*(const LAS f32x4*)(tab + ui * 256 + ai * 128 + wr * 64 + m * 16 + fr)).z;
#pragma unroll
                for (int bj = 0; bj < 2; ++bj) {
                    const pg8::f32x4 a0 = *(const pg8::f32x4*)(x + off + bj * 128), a1 = *(const pg8::f32x4*)(x + off + bj * 128 + 4);
                    const pg8::f32x4 v0 = acc[ai][bj][m][0] * s1 + a0, v1 = acc[ai][bj][m][1] * s1 + a1;
                    pg8::u32x4 w; w.x = pg8::cvt_pk_bf16(v0[0], v0[1]); w.y = pg8::cvt_pk_bf16(v0[2], v0[3]); w.z = pg8::cvt_pk_bf16(v1[0], v1[1]); w.w = pg8::cvt_pk_bf16(v1[2], v1[3]);
                    *(pg8::u32x4*)(x1b + off + bj * 128) = w;
                    { v2u o8; int w_; w_ = __builtin_amdgcn_cvt_pk_fp8_f32(clampf(v0[0] * SX8, 448.f), clampf(v0[1] * SX8, 448.f), 0, false); w_ = __builtin_amdgcn_cvt_pk_fp8_f32(clampf(v0[2] * SX8, 448.f), clampf(v0[3] * SX8, 448.f), w_, true); o8.x = (unsigned)w_;
                      w_ = __builtin_amdgcn_cvt_pk_fp8_f32(clampf(v1[0] * SX8, 448.f), clampf(v1[1] * SX8, 448.f), 0, false); w_ = __builtin_amdgcn_cvt_pk_fp8_f32(clampf(v1[2] * SX8, 448.f), clampf(v1[3] * SX8, 448.f), w_, true); o8.y = (unsigned)w_;
                      *(v2u*)(x18 + off + bj * 128) = o8; }
                    s += (v0[0] * v0[0] + v0[1] * v0[1]) + (v0[2] * v0[2] + v0[3] * v0[3]) + (v1[0] * v1[0] + v1[1] * v1[1]) + (v1[2] * v1[2] + v1[3] * v1[3]); }
                s += __shfl_xor(s, 16); s += __shfl_xor(s, 32);
                if (fq == 0 && doatom) unsafeAtomicAdd(ssq + (size_t)row * 4, s);
                asm volatile("" ::: "memory"); }
    }
};
struct EpiQ {
    static constexpr bool PERM = true, AFTER_DRAIN = false, SEG = false;
    bf16* O; const float* ssq;
    __device__ __forceinline__ void operator()(const pg8::f32x4 (&acc)[2][2][4][2], const pg8::Unit& u, int wr, int wc, int fr, int fq) const {
        const int row0 = u.pm * 256 + wr * 64 + fr, col0 = u.pn * 256 + wc * 32 + 8 * fq;
#pragma unroll
        for (int ai = 0; ai < 2; ++ai)
#pragma unroll
            for (int m = 0; m < 4; ++m) { const int row = row0 + ai * 128 + m * 16; bf16* rowp = O + (size_t)row * DM + col0;
                const float rs = (1.f / (SX8 * SW8)) / sqrtf(__hip_atomic_load(ssq + (size_t)row * 4, RLX_AGENT) * (1.f / DM) + EPS);
#pragma unroll
                for (int bj = 0; bj < 2; ++bj) { const pg8::f32x4 v0 = acc[ai][bj][m][0] * rs, v1 = acc[ai][bj][m][1] * rs;
                    pg8::u32x4 w; w.x = pg8::cvt_pk_bf16(v0[0], v0[1]); w.y = pg8::cvt_pk_bf16(v0[2], v0[3]); w.z = pg8::cvt_pk_bf16(v1[0], v1[1]); w.w = pg8::cvt_pk_bf16(v1[2], v1[3]);
                    *(pg8::u32x4*)(rowp + bj * 128) = w; } }
    }
};

constexpr int A_KSTR = 272, A_VSTR = 288;
constexpr int A_KB0 = 0, A_KB1 = 64 * A_KSTR, A_VB0 = 2 * 64 * A_KSTR, A_VBS = 64 * A_VSTR  , A_KM = A_VB0 + 3 * A_VBS, A_TAB = A_KM + 8 * 128 * 4, A_END = A_TAB + 128 * 4;
static_assert(A_END <= RING_BYTES && (A_KM % 16) == 0, "attention LDS map");
#define PIN16(a, i) asm volatile("" : "+v"(a[i]), "+v"(a[i + 1]), "+v"(a[i + 2]), "+v"(a[i + 3]), "+v"(a[i + 4]), "+v"(a[i + 5]), "+v"(a[i + 6]), "+v"(a[i + 7]), "+v"(a[i + 8]), "+v"(a[i + 9]), "+v"(a[i + 10]), "+v"(a[i + 11]), "+v"(a[i + 12]), "+v"(a[i + 13]), "+v"(a[i + 14]), "+v"(a[i + 15]))
#define TR16(p) __builtin_amdgcn_ds_read_tr16_b64_v4i16((LAS s16x4*)(p))
#define MFMA16(a, b, c) __builtin_amdgcn_mfma_f32_16x16x32_bf16((a), (b), (c), 0, 0, 0)
__device__ __forceinline__ bf16x8 pack8(const float* v) {
    const unsigned a = pk2(v[0], v[1]), b = pk2(v[2], v[3]), c = pk2(v[4], v[5]), d = pk2(v[6], v[7]);
    const v4u u = {a, b, c, d}; return __builtin_bit_cast(bf16x8, u);
}
__device__ __forceinline__ void attn_unit(Frame& F, int b, int h, int blk, const bool doatom = true) {
    LAS unsigned char* lds = F.lds + RING_OFF;
    const int tid = fresh_tid(), lane = tid & 63, w = __builtin_amdgcn_readfirstlane(tid >> 6), g = lane >> 4, c16 = lane & 15, q4 = c16 >> 2, p4 = lane & 3;
    const int own = blk, t0 = blk * 256, tq0 = t0 + 32 * w + c16;
    const size_t rowbase = (size_t)b * SEQ;
    const float NEG_INF = -__builtin_inff();
    constexpr float LOG2E = 1.4426950408889634f, SCL2 = 0.08838834764831845f * 1.4426950408889634f;
    LAS float* km = (LAS float*)(lds + A_KM); LAS float* tab = (LAS float*)(lds + A_TAB);
    const bf16* const PROJ = F.PROJ(); const float* const kmg = F.kmean(); const float* const relb = F.rel_bias();
    for (int i = tid; i < own * 128; i += NWAVES * 64) { const int n = i >> 7, d = i & 127; km[i] = kmg[(size_t)(b * 8 + n) * 1024 + h * 128 + d] * (1.f / 256.f); }
    if (tid < 128) { const int rel = tid; int bucket = rel; if (rel >= 16) { bucket = 16 + (int)(log2f((float)rel * (1.f / 16.f)) * (16.f / 3.f)); bucket = bucket > 31 ? 31 : bucket; }
        tab[tid] = relb[bucket * 8 + h] * LOG2E; }
    bf16x8 qf[2][4];
#pragma unroll
    for (int gi = 0; gi < 2; ++gi) { const bf16* qrow = PROJ + (rowbase + tq0 + 16 * gi) * NPROJ + COL_Q + h * 128 + 8 * g;
#pragma unroll
      for (int ks = 0; ks < 4; ++ks) qf[gi][ks] = *(const GAS bf16x8*)(qrow + 32 * ks); }
    __syncthreads();
    unsigned selmask[2];
    if (own <= 3) { selmask[0] = (1u << own) - 1u; selmask[1] = selmask[0]; }
    else {
#pragma unroll
      for (int gi = 0; gi < 2; ++gi) {
        float gate[7];
#pragma unroll
        for (int n = 0; n < 7; ++n) {
            float s = NEG_INF;
            if (n < own) { s = 0.f;
#pragma unroll
                for (int ks = 0; ks < 4; ++ks) { const LAS f32x4* kp = (const LAS f32x4*)(km + n * 128 + 32 * ks + 8 * g); const f32x4 k0 = kp[0], k1 = kp[1]; const v4u qu = __builtin_bit_cast(v4u, qf[gi][ks]);
                    s += bflo(qu.x) * k0.x + bfhi(qu.x) * k0.y + bflo(qu.y) * k0.z + bfhi(qu.y) * k0.w + bflo(qu.z) * k1.x + bfhi(qu.z) * k1.y + bflo(qu.w) * k1.z + bfhi(qu.w) * k1.w; }
                s += __shfl_xor(s, 16); s += __shfl_xor(s, 32); }
            gate[n] = s;
        }
        unsigned sm = 0u;
#pragma unroll
        for (int r = 0; r < 3; ++r) { float best = NEG_INF; int bi = 0;
#pragma unroll
            for (int n = 0; n < 7; ++n) { const bool cand = (n < own) && !((sm >> n) & 1u) && (gate[n] > best); best = cand ? gate[n] : best; bi = cand ? n : bi; }
            sm |= 1u << bi; }
        selmask[gi] = sm; }
    }
    const int nT = 4 + 4 * own;
    const int sr = tid >> 3, sc = (tid & 7) * 8;
#define A_KEY0(i) ((i) < 4 ? own * 256 + 64 * (i) : (((i) - 4) >> 2) * 256 + (((i) - 4) & 3) * 64)
    v4u kr0, kr1, vr0, vr1;
#define A_LOAD(i) do { const bf16* kp_ = PROJ + (rowbase + A_KEY0(i) + sr) * NPROJ + COL_K + h * 128 + sc; \
        kr0 = *(const GAS v4u*)kp_; kr1 = *(const GAS v4u*)(kp_ + 64); vr0 = *(const GAS v4u*)(kp_ + (COL_V - COL_K)); vr1 = *(const GAS v4u*)(kp_ + (COL_V - COL_K) + 64); } while (0)
#define A_STORE(bufi) do { LAS unsigned char* kd_ = lds + ((bufi) ? A_KB1 : A_KB0) + sr * A_KSTR + sc * 2; LAS unsigned char* vd_ = lds + A_VB0 + vnx * A_VBS + sr * A_VSTR + sc * 2; \
        *(LAS v4u*)kd_ = kr0; *(LAS v4u*)(kd_ + 128) = kr1; *(LAS v4u*)vd_ = vr0; *(LAS v4u*)(vd_ + 128) = vr1; } while (0)
    int vcur = 0, vnx = 0, vprev = 0;
#define A_PV(PF, Vb_) do { _Pragma("unroll") for (int s = 0; s < 2; ++s) { s16x4 vlo[8], vhi[8]; \
            _Pragma("unroll") for (int db = 0; db < 8; ++db) { LAS unsigned char* va = (Vb_) + (32 * s + 4 * g + q4) * A_VSTR + (16 * db + 4 * p4) * 2; vlo[db] = TR16(va); vhi[db] = TR16(va + 16 * A_VSTR); } \
            __builtin_amdgcn_sched_barrier(0); \
            _Pragma("unroll") for (int db = 0; db < 8; ++db) { const bf16x8 vf = __builtin_shufflevector(vlo[db], vhi[db], 0, 1, 2, 3, 4, 5, 6, 7); \
                oacc[0][db] = MFMA16(vf, PF[0][s], oacc[0][db]); oacc[1][db] = MFMA16(vf, PF[1][s], oacc[1][db]); } \
            __builtin_amdgcn_sched_barrier(0); } } while (0)
    A_LOAD(0); A_STORE(0);
    __syncthreads();
    const bool late = w >= 4;
    bf16x8 pfp[2][2]; bool skipp = true;
#pragma unroll
    for (int gi = 0; gi < 2; ++gi) { pfp[gi][0] = (bf16x8){0, 0, 0, 0, 0, 0, 0, 0}; pfp[gi][1] = pfp[gi][0]; }
    float m_run[2] = {NEG_INF, NEG_INF}, l_run[2] = {0.f, 0.f};
    f32x4 oacc[2][8];
#pragma unroll
    for (int gi = 0; gi < 2; ++gi)
#pragma unroll
        for (int db = 0; db < 8; ++db) oacc[gi][db] = (f32x4){0.f, 0.f, 0.f, 0.f};
    for (int i = 0; i < nT; ++i) {
        if (i + 1 < nT) A_LOAD(i + 1);
        vnx = (vcur == 2) ? 0 : vcur + 1;
        const int buf = i & 1, key0 = A_KEY0(i); const bool isown = i < 4; const int pblk = isown ? own : ((i - 4) >> 2);
        const bool skipw = isown && (64 * i > 32 * w + 31);
        if (late && !skipp) A_PV(pfp, lds + A_VB0 + vprev * A_VBS);
        bf16x8 pf[2][2];
        if (!skipw) {
        LAS unsigned char* Kb = lds + (buf ? A_KB1 : A_KB0);
        f32x4 sacc[2][4];
#pragma unroll
        for (int hf = 0; hf < 2; ++hf) { bf16x8 kf[8];
#pragma unroll
            for (int n2 = 0; n2 < 2; ++n2)
#pragma unroll
                for (int ks = 0; ks < 4; ++ks) kf[n2 * 4 + ks] = *(const LAS bf16x8*)(Kb + (16 * (2 * hf + n2) + c16) * A_KSTR + (32 * ks + 8 * g) * 2);
            __builtin_amdgcn_sched_barrier(0);
#pragma unroll
            for (int gi = 0; gi < 2; ++gi)
#pragma unroll
                for (int n2 = 0; n2 < 2; ++n2) { f32x4 a = (f32x4){0.f, 0.f, 0.f, 0.f};
#pragma unroll
                    for (int ks = 0; ks < 4; ++ks) a = MFMA16(kf[n2 * 4 + ks], qf[gi][ks], a);
                    sacc[gi][2 * hf + n2] = a; }
            __builtin_amdgcn_sched_barrier(0); }
        const bool far = (key0 + 63 + 128 <= t0 + 32 * w);
        const bool diag = isown && (64 * i + 63 > 32 * w);
#pragma unroll
        for (int gi = 0; gi < 2; ++gi) {
            const int tq = tq0 + 16 * gi; const bool sel = isown || ((selmask[gi] >> pblk) & 1u);
            float sv[16]; float mloc, m_new, alpha;
            if (far) {
                const float bfar = tab[127];
                float mx = fmaxf(fmaxf(sacc[gi][0][0], sacc[gi][0][1]), fmaxf(sacc[gi][0][2], sacc[gi][0][3]));
#pragma unroll
                for (int nb = 1; nb < 4; ++nb) mx = fmaxf(mx, fmaxf(fmaxf(sacc[gi][nb][0], sacc[gi][nb][1]), fmaxf(sacc[gi][nb][2], sacc[gi][nb][3])));
                mloc = sel ? (mx * SCL2 + bfar) : NEG_INF;
                mloc = fmaxf(mloc, __shfl_xor(mloc, 16)); mloc = fmaxf(mloc, __shfl_xor(mloc, 32));
                m_new = fmaxf(m_run[gi], mloc); alpha = __builtin_amdgcn_exp2f(m_run[gi] - m_new);
                const float cadd = sel ? (bfar - m_new) : NEG_INF;
#pragma unroll
                for (int nb = 0; nb < 4; ++nb)
#pragma unroll
                    for (int r = 0; r < 4; ++r) sv[nb * 4 + r] = __builtin_amdgcn_exp2f(sacc[gi][nb][r] * SCL2 + cadd);
            } else {
                const int relb = tq - key0 - 4 * g; float bias[16];
#pragma unroll
                for (int nb = 0; nb < 4; ++nb)
#pragma unroll
                    for (int r = 0; r < 4; ++r) { const int rel = relb - 16 * nb - r; int ri = rel < 0 ? 0 : rel; ri = ri > 127 ? 127 : ri; bias[nb * 4 + r] = tab[ri]; }
                PIN16(bias, 0);
                mloc = NEG_INF;
#pragma unroll
                for (int nb = 0; nb < 4; ++nb)
#pragma unroll
                    for (int r = 0; r < 4; ++r) { const int rel = relb - 16 * nb - r;
                        float s = sacc[gi][nb][r] * SCL2 + bias[nb * 4 + r]; s = (!sel || (diag && rel < 0)) ? NEG_INF : s; sv[nb * 4 + r] = s; mloc = fmaxf(mloc, s); }
                mloc = fmaxf(mloc, __shfl_xor(mloc, 16)); mloc = fmaxf(mloc, __shfl_xor(mloc, 32));
                m_new = fmaxf(m_run[gi], mloc); alpha = __builtin_amdgcn_exp2f(m_run[gi] - m_new);
#pragma unroll
                for (int e = 0; e < 16; ++e) sv[e] = __builtin_amdgcn_exp2f(sv[e] - m_new);
            }
            float psum = 0.f;
#pragma unroll
            for (int e = 0; e < 16; ++e) psum += sv[e];
            l_run[gi] = l_run[gi] * alpha + psum; m_run[gi] = m_new;
#pragma unroll
            for (int db = 0; db < 8; ++db) oacc[gi][db] = oacc[gi][db] * alpha;
            pf[gi][0] = pack8(sv); pf[gi][1] = pack8(sv + 8);
        }
        __builtin_amdgcn_sched_barrier(0);
        if (!late) A_PV(pf, lds + A_VB0 + vcur * A_VBS);
        }
        if (late) { skipp = skipw;
#pragma unroll
            for (int gi = 0; gi < 2; ++gi) { pfp[gi][0] = pf[gi][0]; pfp[gi][1] = pf[gi][1]; } }
        if (i + 1 < nT) A_STORE((i + 1) & 1);
        vprev = vcur; vcur = vnx;
        __syncthreads();
    }
    if (late && !skipp) A_PV(pfp, lds + A_VB0 + vprev * A_VBS);
#undef A_PV
    bf16* const MIXp = F.HN(); float* const ssqp = F.ssq();
#pragma unroll
    for (int gi = 0; gi < 2; ++gi) {
        const int tq = tq0 + 16 * gi;
        float l_tot = l_run[gi]; l_tot += __shfl_xor(l_tot, 16); l_tot += __shfl_xor(l_tot, 32);
        const float inv = 1.f / l_tot; float ssq = 0.f;
        unsigned char* orow = (unsigned char*)MIXp + (rowbase + tq) * DM + h * 128 + 4 * g;
#pragma unroll
        for (int db = 0; db < 8; ++db) { const f32x4 o = oacc[gi][db] * inv; ssq += (o.x * o.x + o.y * o.y) + (o.z * o.z + o.w * o.w); *(GAS unsigned*)(orow + 16 * db) = pk4_fp8(o.x * SA8, o.y * SA8, o.z * SA8, o.w * SA8); }
        ssq += __shfl_xor(ssq, 16); ssq += __shfl_xor(ssq, 32);
        if (g == 0 && doatom) unsafeAtomicAdd(ssqp + (rowbase + tq) * 4 + 1, ssq);
    }
#undef A_KEY0
#undef A_LOAD
#undef A_STORE
}

constexpr int XBC_W = CONV_CH;
__device__ __forceinline__ void conv_phase(Frame& F) {
    const bf16* const PROJ = F.PROJ(); bf16* const XBC = F.XBC(); const float* const cw = F.conv_w(); const float* const cb = F.conv_b();
    const int gt = blockIdx.x * (NWAVES * 64) + fresh_tid(), GT = F.G * NWAVES * 64;
    for (int task = gt; task < (MTOK / 32) * (CONV_CH / 8); task += GT) {
        const int r = task / (CONV_CH / 8), k = task % (CONV_CH / 8), ch = 8 * k, tok0 = 32 * r;
        float wv[4][8], bias[8];
#pragma unroll
        for (int t = 0; t < 4; ++t) { const f32x4 w0 = *(const GAS f32x4*)(cw + t * CONV_CH + ch), w1 = *(const GAS f32x4*)(cw + t * CONV_CH + ch + 4);
            wv[t][0] = w0.x; wv[t][1] = w0.y; wv[t][2] = w0.z; wv[t][3] = w0.w; wv[t][4] = w1.x; wv[t][5] = w1.y; wv[t][6] = w1.z; wv[t][7] = w1.w; }
        { const f32x4 b0 = *(const GAS f32x4*)(cb + ch), b1 = *(const GAS f32x4*)(cb + ch + 4); bias[0] = b0.x; bias[1] = b0.y; bias[2] = b0.z; bias[3] = b0.w; bias[4] = b1.x; bias[5] = b1.y; bias[6] = b1.z; bias[7] = b1.w; }
        const bf16* src = PROJ + (size_t)tok0 * NPROJ + COL_XBC + ch; bf16* dst = XBC + (size_t)tok0 * XBC_W + ch;
        v4u p0 = (v4u){0u, 0u, 0u, 0u}, p1 = p0, p2 = p0;
        if ((tok0 & (SEQ - 1)) != 0) { p0 = *(const GAS v4u*)(src - 3 * (ptrdiff_t)NPROJ); p1 = *(const GAS v4u*)(src - 2 * (ptrdiff_t)NPROJ); p2 = *(const GAS v4u*)(src - (ptrdiff_t)NPROJ); }
#pragma unroll 1
        for (int i0 = 0; i0 < 32; i0 += 8) {
            v4u cur[8];
#pragma unroll
            for (int i = 0; i < 8; ++i) cur[i] = *(const GAS v4u*)(src + (size_t)(i0 + i) * NPROJ);
#pragma unroll
            for (int i = 0; i < 8; ++i) {
                const v4u c = cur[i]; float acc[8];
                const unsigned a0[4] = {p0.x, p0.y, p0.z, p0.w}, a1[4] = {p1.x, p1.y, p1.z, p1.w}, a2[4] = {p2.x, p2.y, p2.z, p2.w}, a3[4] = {c.x, c.y, c.z, c.w};
#pragma unroll
                for (int j = 0; j < 4; ++j) {
                    acc[2 * j] = bias[2 * j] + wv[0][2 * j] * bflo(a0[j]) + wv[1][2 * j] * bflo(a1[j]) + wv[2][2 * j] * bflo(a2[j]) + wv[3][2 * j] * bflo(a3[j]);
                    acc[2 * j + 1] = bias[2 * j + 1] + wv[0][2 * j + 1] * bfhi(a0[j]) + wv[1][2 * j + 1] * bfhi(a1[j]) + wv[2][2 * j + 1] * bfhi(a2[j]) + wv[3][2 * j + 1] * bfhi(a3[j]); }
#pragma unroll
                for (int j = 0; j < 8; ++j) acc[j] = silu_f(acc[j]);
                v4u o; o.x = pk2(acc[0], acc[1]); o.y = pk2(acc[2], acc[3]); o.z = pk2(acc[4], acc[5]); o.w = pk2(acc[6], acc[7]);
                *(GAS v4u*)(dst + (size_t)(i0 + i) * XBC_W) = o;
                p0 = p1; p1 = p2; p2 = c; }
        }
    }
    { const float* const dtraw = F.dtraw(); float* const dt2 = F.DT2(); const float* const dtb = F.dt_bias();
      for (int i = gt; i < MTOK * 16; i += GT) { const float xr = dtraw[i] + dtb[i & 15]; dt2[i] = xr > 20.f ? xr : log1pf(__expf(xr)); } }
}

constexpr int S_BSTR = 272, S_XSTR = 144;
constexpr int S_BM = 0, S_CM = 128 * S_BSTR, S_X = 2 * 128 * S_BSTR, S_XW = S_X + 128 * S_XSTR, S_HB = S_XW + 128 * S_XSTR, S_DT = S_HB + 64 * S_BSTR, S_CS = S_DT + 512, S_DA = S_CS + 512, S_END = S_DA + 512;
static_assert(S_END <= RING_BYTES, "ssd LDS map");
__device__ __forceinline__ void ssd_unit(Frame& F, int b, int h, const bool doatom = true) {
    LAS unsigned char* lds = F.lds + RING_OFF;
    const int tid = fresh_tid(), lane = tid & 63, w = __builtin_amdgcn_readfirstlane(tid >> 6), g = lane >> 4, c16 = lane & 15, q4 = c16 >> 2, p4 = lane & 3;
    const int g8 = h >> 3, pbw = w & 3, nhw = w >> 2;
    const float a_h = -__expf(F.a_log()[h]), dsk = F.d_skip()[h];
    const bf16* const PROJ = F.PROJ(); bf16* const MIX = F.HN(); const float* const dt2 = F.DT2(); const bf16* const XBC = F.XBC(); float* const ssqp = F.ssq();
    LAS float* dtl = (LAS float*)(lds + S_DT); LAS float* csl = (LAS float*)(lds + S_CS); LAS float* dal = (LAS float*)(lds + S_DA);
    for (int i = tid; i < 64 * S_BSTR / 16; i += NWAVES * 64) ((LAS v4u*)(lds + S_HB))[i] = (v4u){0u, 0u, 0u, 0u};
    f32x4 hacc[4];
#pragma unroll
    for (int i = 0; i < 4; ++i) hacc[i] = (f32x4){0.f, 0.f, 0.f, 0.f};
    const int xl = tid >> 3, xc = tid & 7, bl = tid >> 4, bc = tid & 15;
    v4u xr[2], br[4], cr[4]; float dtv = 0.f;
#define S_PREFETCH(cc) do { const size_t t0_ = (size_t)b * SEQ + (size_t)(cc) * SSM_L; \
        _Pragma("unroll") for (int i_ = 0; i_ < 2; ++i_) xr[i_] = *(const GAS v4u*)(XBC + (t0_ + xl + 64 * i_) * XBC_W + h * 64 + 8 * xc); \
        _Pragma("unroll") for (int i_ = 0; i_ < 4; ++i_) { const bf16* p_ = XBC + (t0_ + bl + 32 * i_) * XBC_W + 1024 + g8 * 128 + 8 * bc; br[i_] = *(const GAS v4u*)p_; cr[i_] = *(const GAS v4u*)(p_ + 256); } \
        if (tid < 128) dtv = dt2[(t0_ + tid) * 16 + h]; } while (0)
    S_PREFETCH(0);
    for (int c = 0; c < SSM_NC; ++c) {
        const size_t tok0 = (size_t)b * SEQ + (size_t)c * SSM_L;
        if (tid < 128) { dtl[tid] = dtv; dal[tid] = dtv * a_h; }
        __syncthreads();
        { const float v0 = dal[2 * lane], v1 = dal[2 * lane + 1]; float s = v0 + v1;
#pragma unroll
            for (int o = 1; o < 64; o <<= 1) { const float t = __shfl_up(s, o); s += (lane >= o) ? t : 0.f; }
            csl[2 * lane] = s - v1; csl[2 * lane + 1] = s; }
        LDS_WAIT(); asm volatile("" ::: "memory");
        const float cs_last = csl[127];
#pragma unroll
        for (int i = 0; i < 2; ++i) { const int l = xl + 64 * i; const v4u v = xr[i]; *(LAS v4u*)(lds + S_X + l * S_XSTR + xc * 16) = v; const float wl = dtl[l] * __expf(cs_last - csl[l]);
            v4u o2; o2.x = pk2(bflo(v.x) * wl, bfhi(v.x) * wl); o2.y = pk2(bflo(v.y) * wl, bfhi(v.y) * wl); o2.z = pk2(bflo(v.z) * wl, bfhi(v.z) * wl); o2.w = pk2(bflo(v.w) * wl, bfhi(v.w) * wl);
            *(LAS v4u*)(lds + S_XW + l * S_XSTR + xc * 16) = o2; }
#pragma unroll
        for (int i = 0; i < 4; ++i) { const int l = bl + 32 * i; *(LAS v4u*)(lds + S_BM + l * S_BSTR + bc * 16) = br[i]; *(LAS v4u*)(lds + S_CM + l * S_BSTR + bc * 16) = cr[i]; }
        const int lrow = 16 * w + c16;
        v2u zr[4];
#pragma unroll
        for (int pb = 0; pb < 4; ++pb) zr[pb] = *(const GAS v2u*)(PROJ + (tok0 + lrow) * NPROJ + COL_Z + h * 64 + 16 * pb + 4 * g);
        if (c + 1 < SSM_NC) S_PREFETCH(c + 1);
        __syncthreads();
        bf16x8 cf[4];
#pragma unroll
        for (int ks = 0; ks < 4; ++ks) cf[ks] = *(const LAS bf16x8*)(lds + S_CM + lrow * S_BSTR + (32 * ks + 8 * g) * 2);
        f32x4 yacc[4];
        const float cs_l = csl[lrow]; const float el = __expf(cs_l);
#pragma unroll
        for (int pb = 0; pb < 4; ++pb) { yacc[pb] = (f32x4){0.f, 0.f, 0.f, 0.f};
#pragma unroll
            for (int ks = 0; ks < 4; ++ks) { const bf16x8 hf = *(const LAS bf16x8*)(lds + S_HB + (16 * pb + c16) * S_BSTR + (32 * ks + 8 * g) * 2); yacc[pb] = MFMA16(hf, cf[ks], yacc[pb]); }
            yacc[pb] = yacc[pb] * el; }
        for (int s2 = 0; s2 <= (w >> 1); ++s2) {
            const int sb0 = 2 * s2, sb1 = 2 * s2 + 1; const bool has1 = sb1 <= w;
            f32x4 cb0 = (f32x4){0.f, 0.f, 0.f, 0.f}, cb1 = (f32x4){0.f, 0.f, 0.f, 0.f};
#pragma unroll
            for (int ks = 0; ks < 4; ++ks) { const bf16x8 bf0 = *(const LAS bf16x8*)(lds + S_BM + (16 * sb0 + c16) * S_BSTR + (32 * ks + 8 * g) * 2); cb0 = MFMA16(bf0, cf[ks], cb0); }
            if (has1) {
#pragma unroll
                for (int ks = 0; ks < 4; ++ks) { const bf16x8 bf1 = *(const LAS bf16x8*)(lds + S_BM + (16 * sb1 + c16) * S_BSTR + (32 * ks + 8 * g) * 2); cb1 = MFMA16(bf1, cf[ks], cb1); } }
            float mv[8];
#pragma unroll
            for (int r = 0; r < 4; ++r) { const int s = 16 * sb0 + 4 * g + r; const float e = __expf(fminf(cs_l - csl[s], 0.f)) * dtl[s]; mv[r] = (s <= lrow) ? cb0[r] * e : 0.f; }
#pragma unroll
            for (int r = 0; r < 4; ++r) { const int s = 16 * sb1 + 4 * g + r; const int sc_ = s > 127 ? 127 : s; const float e = __expf(fminf(cs_l - csl[sc_], 0.f)) * dtl[sc_]; mv[4 + r] = (has1 && s <= lrow) ? cb1[r] * e : 0.f; }
            const bf16x8 pf = pack8(mv);
#pragma unroll
            for (int pb = 0; pb < 4; ++pb) { LAS unsigned char* xa = lds + S_X + (32 * s2 + 4 * g + q4) * S_XSTR + (16 * pb + 4 * p4) * 2;
                const s16x4 lo = TR16(xa), hi = TR16(xa + 16 * S_XSTR); const bf16x8 xf = __builtin_shufflevector(lo, hi, 0, 1, 2, 3, 4, 5, 6, 7);
                yacc[pb] = MFMA16(xf, pf, yacc[pb]); }
        }
        { const size_t tok = tok0 + lrow; float ssq = 0.f;
#pragma unroll
          for (int pb = 0; pb < 4; ++pb) { const int p0 = 16 * pb + 4 * g;
              const v2u xs_ = *(const LAS v2u*)(lds + S_X + lrow * S_XSTR + p0 * 2);
              const v2u zr_ = zr[pb];
              const float o0 = (yacc[pb].x + bflo(xs_.x) * dsk) * silu_f(bflo(zr_.x)), o1 = (yacc[pb].y + bfhi(xs_.x) * dsk) * silu_f(bfhi(zr_.x));
              const float o2 = (yacc[pb].z + bflo(xs_.y) * dsk) * silu_f(bflo(zr_.y)), o3 = (yacc[pb].w + bfhi(xs_.y) * dsk) * silu_f(bfhi(zr_.y));
              ssq += (o0 * o0 + o1 * o1) + (o2 * o2 + o3 * o3);
              *(GAS unsigned*)((unsigned char*)MIX + tok * DM + ATT_W + h * 64 + p0) = pk4_fp8(o0 * SS8, o1 * SS8, o2 * SS8, o3 * SS8); }
          ssq += __shfl_xor(ssq, 16); ssq += __shfl_xor(ssq, 32);
          if (g == 0 && doatom) unsafeAtomicAdd(ssqp + tok * 4 + 2 + g8, ssq); }
        { const float cdec = __expf(cs_last);
#pragma unroll
          for (int i = 0; i < 4; ++i) hacc[i] = hacc[i] * cdec;
#pragma unroll
          for (int ks = 0; ks < 4; ++ks) {
              LAS unsigned char* xa = lds + S_XW + (32 * ks + 8 * g + q4) * S_XSTR + (16 * pbw + 4 * p4) * 2;
              const s16x4 xlo = TR16(xa), xhi = TR16(xa + 4 * S_XSTR); const bf16x8 xf = __builtin_shufflevector(xlo, xhi, 0, 1, 2, 3, 4, 5, 6, 7);
#pragma unroll
              for (int i = 0; i < 4; ++i) { const int nb = 4 * nhw + i; LAS unsigned char* ba = lds + S_BM + (32 * ks + 8 * g + q4) * S_BSTR + (16 * nb + 4 * p4) * 2;
                  const s16x4 blo = TR16(ba), bhi = TR16(ba + 4 * S_BSTR); const bf16x8 bfr = __builtin_shufflevector(blo, bhi, 0, 1, 2, 3, 4, 5, 6, 7);
                  hacc[i] = MFMA16(bfr, xf, hacc[i]); } } }
        __syncthreads();
#pragma unroll
        for (int i = 0; i < 4; ++i) { const int nb = 4 * nhw + i; v2u o; o.x = pk2(hacc[i].x, hacc[i].y); o.y = pk2(hacc[i].z, hacc[i].w);
            *(LAS v2u*)(lds + S_HB + (16 * pbw + c16) * S_BSTR + (16 * nb + 4 * g) * 2) = o; }
    }
#undef S_PREFETCH
    __syncthreads();
}

__device__ __forceinline__ void mix_normalize(Frame& F) {
    const int tid_ = fresh_tid(), lane = tid_ & 63; const int gw = blockIdx.x * NWAVES + __builtin_amdgcn_readfirstlane(tid_ >> 6), NGW = F.G * NWAVES;
    const float* const ssqp = F.ssq(); bf16* const MIX = F.HN(); const float* const gatt = F.attn_out_norm(); const float* const gssm = F.ssm_out_norm();
    for (int m = gw; m < MTOK; m += NGW) {
        const float* sq = ssqp + (size_t)m * 4;
        const float s1 = __hip_atomic_load(sq + 1, RLX_AGENT), s2 = __hip_atomic_load(sq + 2, RLX_AGENT), s3 = __hip_atomic_load(sq + 3, RLX_AGENT);
        const float ra = 1.f / sqrtf(s1 * (1.f / 1024.f) + EPS), r0 = 1.f / sqrtf(s2 * (1.f / 512.f) + EPS), r1 = 1.f / sqrtf(s3 * (1.f / 512.f) + EPS);
        GAS v4u* row = (GAS v4u*)(MIX + (size_t)m * DM);
#pragma unroll
        for (int j = 0; j < 4; ++j) { const int idx = lane + 64 * j, col = 8 * idx; const float rs = (j < 2) ? ra : ((j == 2) ? r0 : r1);
            const float* gp = (j < 2) ? (gatt + col) : (gssm + (col - ATT_W));
            const f32x4 g0 = *(const GAS f32x4*)gp, g1 = *(const GAS f32x4*)(gp + 4); const v4u v = row[idx]; v4u o;
            o.x = pk2(bflo(v.x) * rs * g0.x, bfhi(v.x) * rs * g0.y); o.y = pk2(bflo(v.y) * rs * g0.z, bfhi(v.y) * rs * g0.w);
            o.z = pk2(bflo(v.z) * rs * g1.x, bfhi(v.z) * rs * g1.y); o.w = pk2(bflo(v.w) * rs * g1.z, bfhi(v.w) * rs * g1.w); row[idx] = o; }
    }
}

constexpr size_t TAB_UNIT = 1024;
static_assert((TAB_ITEMS / 8) % TAB_UNIT == 0 && TAB_ITEMS % TAB_UNIT == 0, "table filler units");
constexpr int P_EIDX = 0, P_GATE = 16384, P_LST = 32768  , P_HN4 = 32768  , P_ACT = 98304  , P_END = 114688;
static_assert(P_END <= RING_BYTES, "peer LDS map");
__constant__ unsigned char PEER_CAND[52] = {0, 1, 2, 3, 4, 5, 6, 7, 8, 9, 10, 11, 12, 13, 14, 15, 16, 17, 18, 19, 20, 21, 22, 23, 32, 33, 34, 35, 36, 48, 49, 50, 51, 64, 65, 66, 80, 81, 96, 97, 112, 113, 128, 144, 160, 176, 192, 208, 224, 240, 255, 255};
__device__ __forceinline__ unsigned f2ord(float f) { const unsigned u = __builtin_bit_cast(unsigned, f); return u ^ ((u >> 31) ? 0xFFFFFFFFu : 0x80000000u); }
__device__ __forceinline__ float ord2f(unsigned u) { return __builtin_bit_cast(float, u ^ ((u >> 31) ? 0x80000000u : 0xFFFFFFFFu)); }
#define CSWAPD(a, b) do { const unsigned hi_ = (a) > (b) ? (a) : (b), lo_ = (a) > (b) ? (b) : (a); (a) = hi_; (b) = lo_; } while (0)
template <int N> __device__ __forceinline__ void bitonic_sort_desc(unsigned (&v)[N]) {
#pragma unroll
    for (int k = 2; k <= N; k <<= 1)
#pragma unroll
        for (int j = k >> 1; j > 0; j >>= 1)
#pragma unroll
            for (int i = 0; i < N; ++i) { const int l = i ^ j; if (l > i) { if ((i & k) == 0) CSWAPD(v[i], v[l]); else CSWAPD(v[l], v[i]); } }
}
__device__ __forceinline__ void merge16_xor(unsigned (&v)[16], int dist) {
    unsigned o[16];
#pragma unroll
    for (int i = 0; i < 16; ++i) o[i] = (unsigned)__shfl_xor((int)v[i], dist);
#pragma unroll
    for (int i = 0; i < 16; ++i) v[i] = v[i] > o[15 - i] ? v[i] : o[15 - i];
#pragma unroll
    for (int j = 8; j > 0; j >>= 1)
#pragma unroll
        for (int i = 0; i < 16; ++i) { const int l = i ^ j; if (l > i) CSWAPD(v[i], v[l]); }
}
__device__ __forceinline__ float gelu_erf(float x) { return 0.5f * x * (1.f + erff(x * 0.70710678118654752f)); }
__device__ __forceinline__ float fp4_dec1(unsigned n) { const unsigned m = n & 7u; unsigned bits = (m >= 2u) ? (((126u + (m >> 1)) << 23) | ((m & 1u) << 22)) : (m ? 0x3F000000u : 0u); bits |= (n & 8u) << 28; return __builtin_bit_cast(float, bits); }
__device__ __forceinline__ f32x2 fp4_dec2(unsigned x) { f32x2 r; r.x = fp4_dec1(x & 15u); r.y = fp4_dec1((x >> 4) & 15u); return r; }
typedef long i64;
typedef int v8i __attribute__((ext_vector_type(8)));
typedef int v4i __attribute__((ext_vector_type(4)));
template <bool dry = false> __device__ __forceinline__ void peer_unit(Frame& F, int u) {
    LAS unsigned char* lds = F.lds + RING_OFF;
    const int tid_ = fresh_tid(), lane = tid_ & 63, w = __builtin_amdgcn_readfirstlane(tid_ >> 6), g = lane >> 4, c16 = lane & 15;
    const int T0 = 32 * u;
    LAS int* eidx = (LAS int*)(lds + P_EIDX); LAS float* gate = (LAS float*)(lds + P_GATE);
    LAS unsigned* lst = (LAS unsigned*)(lds + P_LST) + w * 1024;
    const bf16* const QP = F.QP(); const bf16* const SK = F.SK(); float* const outp = F.out(); const bf16* const X1B = F.X1B(); const float* const fgain = F.ffn_norm(); const float* const fing = F.final_norm(); const unsigned char* const U8 = F.U8(); const unsigned char* const V8 = F.V8();
#ifndef NO_ROUTE
    unsigned cpk[4];
    { unsigned cb[16];
#pragma unroll
      for (int k = 0; k < 13; ++k) cb[k] = PEER_CAND[4 * k + g];
      cb[13] = 255u; cb[14] = 255u; cb[15] = 255u;
#pragma unroll
      for (int q = 0; q < 4; ++q) cpk[q] = cb[4 * q] | (cb[4 * q + 1] << 8) | (cb[4 * q + 2] << 16) | (cb[4 * q + 3] << 24); }
    {
    bf16x8 qf[2][4];
#define QP_LOAD(dst, c_) do { _Pragma("unroll") for (int tb = 0; tb < 2; ++tb) { const unsigned qo = ((unsigned)(T0 + 16 * tb + c16) * (unsigned)DM + (unsigned)((2 * w + (c_)) * 128 + 8 * g)) * 2u; \
        _Pragma("unroll") for (int ks = 0; ks < 4; ++ks) dst[tb][ks] = __builtin_nontemporal_load((const GAS bf16x8*)((const unsigned char*)QP + (qo + 64u * ks))); } } while (0)
    QP_LOAD(qf, 0);
#pragma unroll
    for (int c = 0; c < 2; ++c) {
        const int p = 2 * w + c;
        unsigned key[2][32];
        bf16x8 sf[3][8];
        const unsigned so0 = (unsigned)p * 32768u + 16u * (unsigned)lane;
#define SK_LOAD(buf, j_) do { _Pragma("unroll") for (int q = 0; q < 8; ++q) sf[buf][q] = *(const GAS bf16x8*)((const unsigned char*)SK + (so0 + (unsigned)(2 * (j_) + (q >> 2)) * 4096u + 1024u * (q & 3))); } while (0)
        SK_LOAD(0, 0); SK_LOAD(1, 1);
#pragma unroll
        for (int j = 0; j < 4; ++j) {
            if (j + 2 < 4) SK_LOAD((j + 2) % 3, j + 2);
            __builtin_amdgcn_sched_barrier(0);
#pragma unroll
            for (int h2 = 0; h2 < 2; ++h2)
#pragma unroll
            for (int tb = 0; tb < 2; ++tb) { const int kb = 2 * j + h2; f32x4 acc = (f32x4){0.f, 0.f, 0.f, 0.f};
#pragma unroll
                for (int ks = 0; ks < 4; ++ks) acc = MFMA16(sf[j % 3][4 * h2 + ks], qf[tb][ks], acc);
#pragma unroll
                for (int r = 0; r < 4; ++r) key[tb][kb * 4 + r] = (f2ord(acc[r]) & ~0x7Fu) | (unsigned)(16 * kb + 4 * g + r); }
            __builtin_amdgcn_sched_barrier(0); }
#undef SK_LOAD
        if (c == 0) { QP_LOAD(qf, 1); __builtin_amdgcn_sched_barrier(0); }
#pragma unroll
        for (int tb = 0; tb < 2; ++tb) {
            bitonic_sort_desc<32>(key[tb]);
            unsigned top[16];
#pragma unroll
            for (int i = 0; i < 16; ++i) top[i] = key[tb][i];
            merge16_xor(top, 16); merge16_xor(top, 32);
            if (g == 0) { LAS v4u* d = (LAS v4u*)(lst + (c * 32 + 16 * tb + c16) * 16);
                d[0] = (v4u){top[0], top[1], top[2], top[3]}; d[1] = (v4u){top[4], top[5], top[6], top[7]}; d[2] = (v4u){top[8], top[9], top[10], top[11]}; d[3] = (v4u){top[12], top[13], top[14], top[15]}; } }
    }
#undef QP_LOAD
    }
    for (int tb = 0; tb < 2; ++tb) {
        LDS_WAIT();
        const LAS unsigned* l1 = lst + (16 * tb + c16) * 16; const LAS unsigned* l2 = lst + (32 + 16 * tb + c16) * 16;
        unsigned ck[16];
#pragma unroll
        for (int k = 0; k < 13; ++k) { const unsigned ab = (cpk[k >> 2] >> (8 * (k & 3))) & 255u; const unsigned a = ab >> 4, bq = ab & 15u;
            const float s = ord2f(l1[a] & ~0x7Fu) + ord2f(l2[bq] & ~0x7Fu); ck[k] = (ab == 255u) ? 0u : ((f2ord(s) & ~0xFFu) | ab); }
        ck[13] = 0u; ck[14] = 0u; ck[15] = 0u;
        bitonic_sort_desc<16>(ck);
        merge16_xor(ck, 16); merge16_xor(ck, 32);
        if (g == 0) { const int tl = 16 * tb + c16; const float m = ord2f(ck[0] & ~0xFFu); float e[16]; float sum = 0.f;
#pragma unroll
            for (int k = 0; k < 16; ++k) { e[k] = __expf(ord2f(ck[k] & ~0xFFu) - m); sum += e[k]; }
            const float inv = 1.f / sum;
#pragma unroll
            for (int k = 0; k < 16; ++k) { const unsigned a = (ck[k] >> 4) & 15u, bq = ck[k] & 15u; const int ex = (int)((l1[a] & 0x7Fu) * 128u + (l2[bq] & 0x7Fu));
                eidx[tl * 128 + w * 16 + k] = ex; gate[tl * 128 + w * 16 + k] = e[k] * inv; } }
    }
#endif
    __syncthreads();
    LAS unsigned char* hnb = lds + P_HN4 + w * 8192; LAS float* actl = (LAS float*)(lds + P_ACT) + w * 512;
    const LAS unsigned char* hb = hnb + 16 * g + ((c16 & 1) ? 1024 : 0) + ((c16 & 2) ? 64 : 0);
    v4u bA[8], bB[8];
#define U_ISSUE(buf, e_) do { const unsigned uo_ = (unsigned)(e_) * (unsigned)ROWB + 64u * (unsigned)(c16 & 1) + 16u * (unsigned)g; \
        _Pragma("unroll") for (int jj = 0; jj < 8; ++jj) buf[jj] = *(const GAS v4u*)(U8 + (uo_ + 128u * jj)); __builtin_amdgcn_sched_barrier(0); } while (0)
#define U_CONSUME(buf, ACC, HB) do { v4u bq_[8]; _Pragma("unroll") for (int jj = 0; jj < 8; ++jj) bq_[jj] = *(const LAS v4u*)((HB) + 128 * jj); \
        __builtin_amdgcn_sched_barrier(0); \
        _Pragma("unroll") for (int jj = 0; jj < 8; ++jj) { const v4u a_ = buf[jj]; \
            const v8i av_ = {(int)a_.x, (int)a_.y, (int)a_.z, (int)a_.w, 0, 0, 0, 0}; const v8i bv_ = {(int)bq_[jj].x, (int)bq_[jj].y, (int)bq_[jj].z, (int)bq_[jj].w, 0, 0, 0, 0}; \
            ACC = __builtin_amdgcn_mfma_scale_f32_16x16x128_f8f6f4(av_, bv_, ACC, 4, 4, 0, 0x7f7f7f7f, 0, 0x7f7f7f7f); } __builtin_amdgcn_sched_barrier(0); } while (0)
#define U_PRE(A_, PA, PB) do { const float x1_ = __shfl_down(A_.x, 1), z1_ = __shfl_down(A_.z, 1), y2_ = __shfl_down(A_.y, 2), w2_ = __shfl_down(A_.w, 2), y3_ = __shfl_down(A_.y, 3), w3_ = __shfl_down(A_.w, 3); \
        constexpr float ilo_ = 1.f / SLO4; PA = (A_.x + y2_) + (x1_ + y3_) * ilo_; PB = (A_.z + w2_) + (z1_ + w3_) * ilo_; } while (0)
#define U_ACT(grp_, TL, ACT) do { float pa0_, pb0_, pa1_, pb1_; U_PRE(acc0, pa0_, pb0_); U_PRE(acc1, pa1_, pb1_); \
        if (c16 == 0) { const int k0 = 16 * (grp_) + 2 * g; constexpr float isc = 1.f / (SU * SH4); \
            const f32x2 g0_ = *(const LAS f32x2*)(gate + (TL) * 128 + k0), g1_ = *(const LAS f32x2*)(gate + (TL) * 128 + k0 + 8); \
            f32x2 a0_, a1_; a0_.x = gelu_erf(pa0_ * isc) * g0_.x; a0_.y = gelu_erf(pb0_ * isc) * g0_.y; a1_.x = gelu_erf(pa1_ * isc) * g1_.x; a1_.y = gelu_erf(pb1_ * isc) * g1_.y; \
            *(LAS f32x2*)((ACT) + k0) = a0_; *(LAS f32x2*)((ACT) + k0 + 8) = a1_; } } while (0)
#define V_ISSUE(buf, TL, kb_) do { const LAS v4i* ep_ = (const LAS v4i*)(eidx + (TL) * 128 + 8 * (kb_)); const v4i e4a_ = ep_[0], e4b_ = ep_[1]; const int ee_[8] = {e4a_.x, e4a_.y, e4a_.z, e4a_.w, e4b_.x, e4b_.y, e4b_.z, e4b_.w}; \
        _Pragma("unroll") for (int kk = 0; kk < 8; ++kk) { const unsigned vo_ = (unsigned)(ee_[kk] & emask) * (unsigned)ROWB + 16u * (unsigned)lane; buf[kk] = *(const GAS v4u*)(V8 + vo_); } \
        __builtin_amdgcn_sched_barrier(0); } while (0)
#define PIN8x2(a, i) asm volatile("" : "+v"(a[i]), "+v"(a[i + 1]), "+v"(a[i + 2]), "+v"(a[i + 3]), "+v"(a[i + 4]), "+v"(a[i + 5]), "+v"(a[i + 6]), "+v"(a[i + 7]))
#define V_CONSUME(buf, kb_, O, ACT) do { const f32x4 al_ = *(const LAS f32x4*)((ACT) + 8 * (kb_)), ah_ = *(const LAS f32x4*)((ACT) + 8 * (kb_) + 4); const float a8_[8] = {al_.x, al_.y, al_.z, al_.w, ah_.x, ah_.y, ah_.z, ah_.w}; \
        _Pragma("unroll") for (int kk = 0; kk < 8; ++kk) { const float as_ = a8_[kk]; const f32x2 a2_ = {as_, as_}; \
        const unsigned vw[4] = {buf[kk].x, buf[kk].y, buf[kk].z, buf[kk].w}; \
        _Pragma("unroll") for (int q = 0; q < 4; ++q) { \
            O[4 * q]     = __builtin_elementwise_fma(__builtin_amdgcn_cvt_scalef32_pk_f32_fp4(vw[q], 1.0f, 0), a2_, O[4 * q]); \
            O[4 * q + 1] = __builtin_elementwise_fma(__builtin_amdgcn_cvt_scalef32_pk_f32_fp4(vw[q], 1.0f, 1), a2_, O[4 * q + 1]); \
            O[4 * q + 2] = __builtin_elementwise_fma(__builtin_amdgcn_cvt_scalef32_pk_f32_fp4(vw[q], 1.0f, 2), a2_, O[4 * q + 2]); \
            O[4 * q + 3] = __builtin_elementwise_fma(__builtin_amdgcn_cvt_scalef32_pk_f32_fp4(vw[q], 1.0f, 3), a2_, O[4 * q + 3]); } \
        PIN8x2(O, 0); PIN8x2(O, 8); } } while (0)
#ifndef NO_GATHER
#ifdef PROBE_L2RES
    constexpr int emask = dry ? PROBE_L2RES : 16383;
#else
    constexpr int emask = 16383;
#endif
    {
    { unsigned k0[4], k1[4];
#pragma unroll
      for (int ti = 0; ti < 4; ++ti) { const int tl = w + 8 * ti; k0[ti] = ((unsigned)eidx[tl * 128 + lane] << 7) | (unsigned)lane; k1[ti] = ((unsigned)eidx[tl * 128 + 64 + lane] << 7) | (unsigned)(64 + lane); }
#pragma unroll
      for (int k = 2; k <= 128; k <<= 1)
#pragma unroll
        for (int j = k >> 1; j > 0; j >>= 1) {
            if (j == 64) {
#pragma unroll
                for (int ti = 0; ti < 4; ++ti) { const unsigned lo_ = k0[ti] < k1[ti] ? k0[ti] : k1[ti], hi_ = k0[ti] < k1[ti] ? k1[ti] : k0[ti]; k0[ti] = lo_; k1[ti] = hi_; }
            } else {
                const bool lower = (lane & j) == 0;
                const bool desc0 = (k == 64) ? false : ((k == 128) ? false : ((lane & k) != 0)), desc1 = (k == 64) ? true : desc0;
                const bool min0 = lower != desc0, min1 = lower != desc1;
#pragma unroll
                for (int ti = 0; ti < 4; ++ti) { const unsigned p0 = (unsigned)__shfl_xor((int)k0[ti], j), p1 = (unsigned)__shfl_xor((int)k1[ti], j);
                    const unsigned mn0 = k0[ti] < p0 ? k0[ti] : p0, mx0 = k0[ti] < p0 ? p0 : k0[ti], mn1 = k1[ti] < p1 ? k1[ti] : p1, mx1 = k1[ti] < p1 ? p1 : k1[ti];
                    k0[ti] = min0 ? mn0 : mx0; k1[ti] = min1 ? mn1 : mx1; }
            }
        }
      float g0[4], g1[4];
#pragma unroll
      for (int ti = 0; ti < 4; ++ti) { const int tl = w + 8 * ti; g0[ti] = gate[tl * 128 + (int)(k0[ti] & 127u)]; g1[ti] = gate[tl * 128 + (int)(k1[ti] & 127u)]; }
      LDS_WAIT(); asm volatile("" ::: "memory");
#pragma unroll
      for (int ti = 0; ti < 4; ++ti) { const int tl = w + 8 * ti; eidx[tl * 128 + lane] = (int)(k0[ti] >> 7); eidx[tl * 128 + 64 + lane] = (int)(k1[ti] >> 7); gate[tl * 128 + lane] = g0[ti]; gate[tl * 128 + 64 + lane] = g1[ti]; }
      LDS_WAIT(); asm volatile("" ::: "memory"); }
    v2u xn[8];
#define X_ISSUE(tok_) do { const unsigned xb_ = (unsigned)(tok_) * (unsigned)(DM * 2) + 8u * (unsigned)lane; _Pragma("unroll") for (int j = 0; j < 8; ++j) xn[j] = __builtin_nontemporal_load((const GAS v2u*)((const unsigned char*)X1B + (xb_ + 512u * j))); } while (0)
    X_ISSUE(T0 + w);
#pragma unroll 1
    for (int ti = 0; ti < 4; ++ti) {
        f32x4 xr[8]; float ss = 0.f;
#pragma unroll
        for (int j = 0; j < 8; ++j) { const v2u r = xn[j]; xr[j] = (f32x4){bflo(r.x), bfhi(r.x), bflo(r.y), bfhi(r.y)}; }
        X_ISSUE(T0 + w + 8 * (ti < 3 ? ti + 1 : 3));
#pragma unroll
        for (int j = 0; j < 8; ++j) ss += (xr[j].x * xr[j].x + xr[j].y * xr[j].y) + (xr[j].z * xr[j].z + xr[j].w * xr[j].w);
        const float rs2 = __builtin_amdgcn_rsqf(wave_sum(ss) * (1.f / DM) + EPS);
        const float* fg_ = fgain; asm volatile("" : "+s"(fg_));
        const unsigned char* gp = (const unsigned char*)fg_; const unsigned go = 16u * (unsigned)lane;
        unsigned hw[4], lw[4];
#pragma unroll
        for (int q = 0; q < 4; ++q) { unsigned wh = 0u, wl = 0u;
#pragma unroll
            for (int t = 0; t < 2; ++t) { const int j = 2 * q + t; const f32x4 gg = *(const GAS f32x4*)(gp + (go + 1024u * j)); const f32x4 hv = xr[j] * gg * (rs2 * SH4);
                const float h0 = clampf(hv.x, 6.f), h1 = clampf(hv.y, 6.f), h2 = clampf(hv.z, 6.f), h3 = clampf(hv.w, 6.f);
                const unsigned p0 = __builtin_amdgcn_cvt_scalef32_pk_fp4_f32(0u, h0, h1, 1.0f, 0), p1 = __builtin_amdgcn_cvt_scalef32_pk_fp4_f32(0u, h2, h3, 1.0f, 0);
                const f32x2 d0 = __builtin_amdgcn_cvt_scalef32_pk_f32_fp4(p0, 1.0f, 0), d1 = __builtin_amdgcn_cvt_scalef32_pk_f32_fp4(p1, 1.0f, 0);
                const unsigned r0 = __builtin_amdgcn_cvt_scalef32_pk_fp4_f32(0u, clampf((h0 - d0.x) * SLO4, 6.f), clampf((h1 - d0.y) * SLO4, 6.f), 1.0f, 0), r1 = __builtin_amdgcn_cvt_scalef32_pk_fp4_f32(0u, clampf((h2 - d1.x) * SLO4, 6.f), clampf((h3 - d1.y) * SLO4, 6.f), 1.0f, 0);
                wh |= ((p0 & 0xFFu) | ((p1 & 0xFFu) << 8)) << (16 * t); wl |= ((r0 & 0xFFu) | ((r1 & 0xFFu) << 8)) << (16 * t); }
            hw[q] = wh; lw[q] = wl; }
        *(LAS v4u*)(hnb + 2048 * ti + 16 * lane) = (v4u){hw[0], hw[1], hw[2], hw[3]}; *(LAS v4u*)(hnb + 2048 * ti + 1024 + 16 * lane) = (v4u){lw[0], lw[1], lw[2], lw[3]};
    }
    LDS_WAIT();
    { int e_c0 = eidx[w * 128 + (c16 >> 1)] & emask, e_c1 = eidx[w * 128 + 8 + (c16 >> 1)] & emask;
      U_ISSUE(bA, e_c0);
#pragma unroll 1
      for (int s_ = 0; s_ < 31; ++s_) {
          const int ti = s_ & 3, grp = s_ >> 2, tl = w + 8 * ti, sn = s_ + 1;
          const int eb_ = (w + 8 * (sn & 3)) * 128 + 16 * (sn >> 2) + (c16 >> 1);
          const int e_n0 = eidx[eb_] & emask, e_n1 = eidx[eb_ + 8] & emask;
          const LAS unsigned char* hbt = hb + 2048 * ti; LAS float* actt = actl + 128 * ti;
          f32x4 acc0 = (f32x4){0.f, 0.f, 0.f, 0.f}, acc1 = acc0;
          U_ISSUE(bB, e_c1); U_CONSUME(bA, acc0, hbt);
          U_ISSUE(bA, e_n0);
          U_CONSUME(bB, acc1, hbt);
          U_ACT(grp, tl, actt);
          e_c0 = e_n0; e_c1 = e_n1;
      }
      { const LAS unsigned char* hbt = hb + 2048 * 3; LAS float* actt = actl + 128 * 3;
        f32x4 acc0 = (f32x4){0.f, 0.f, 0.f, 0.f}, acc1 = acc0;
        U_ISSUE(bB, e_c1); U_CONSUME(bA, acc0, hbt);
        V_ISSUE(bA, w, 0);
        U_CONSUME(bB, acc1, hbt);
        U_ACT(7, w + 24, actt); } }
    LDS_WAIT();
    f32x2 o2[4][16];
#pragma unroll
    for (int ti = 0; ti < 4; ++ti)
#pragma unroll
        for (int i = 0; i < 16; ++i) o2[ti][i] = (f32x2){0.f, 0.f};
#pragma unroll 1
    for (int kb = 0; kb < 16; ++kb) {
        const int kn = kb < 15 ? kb + 1 : 15;
        V_ISSUE(bB, w + 8, kb);  V_CONSUME(bA, kb, o2[0], actl);
        V_ISSUE(bA, w + 16, kb); V_CONSUME(bB, kb, o2[1], actl + 128);
        V_ISSUE(bB, w + 24, kb); V_CONSUME(bA, kb, o2[2], actl + 256);
        V_ISSUE(bA, w, kn);      V_CONSUME(bB, kb, o2[3], actl + 384);
    }
    X_ISSUE(T0 + w);
#pragma unroll
    for (int ti = 0; ti < 4; ++ti) {
        const size_t token = (size_t)T0 + w + 8 * ti;
        const unsigned xo = (unsigned)token * (unsigned)(DM * 4) + 16u * (unsigned)lane;
        f32x4 xr[8];
#pragma unroll
        for (int j = 0; j < 8; ++j) { const v2u r = xn[j]; xr[j] = (f32x4){bflo(r.x), bfhi(r.x), bflo(r.y), bfhi(r.y)}; }
        if (ti < 3) X_ISSUE(T0 + w + 8 * (ti + 1));
        constexpr float isv = 1.f / SV; float s2 = 0.f;
#pragma unroll
        for (int j = 0; j < 8; ++j) { xr[j] = xr[j] + (f32x4){o2[ti][2 * j].x, o2[ti][2 * j].y, o2[ti][2 * j + 1].x, o2[ti][2 * j + 1].y} * isv;
            s2 += (xr[j].x * xr[j].x + xr[j].y * xr[j].y) + (xr[j].z * xr[j].z + xr[j].w * xr[j].w); }
        const float rf = __builtin_amdgcn_rsqf(wave_sum(s2) * (1.f / DM) + EPS);
        const float* fi_ = fing; asm volatile("" : "+s"(fi_));
        const unsigned char* fp = (const unsigned char*)fi_; unsigned char* op = (unsigned char*)outp; const unsigned fo = 16u * (unsigned)lane;
        if (!dry || rf == 1.2345e30f)
#pragma unroll
        for (int j = 0; j < 8; ++j) __builtin_nontemporal_store(xr[j] * rf * *(const GAS f32x4*)(fp + (fo + 1024u * j)), (GAS f32x4*)(op + (xo + 1024u * j)));
    }
    }
#endif
#undef U_ISSUE
#undef X_ISSUE
#undef U_ACT
#undef U_CONSUME
#undef V_ISSUE
#undef V_CONSUME
    __syncthreads();
}

__global__ void __launch_bounds__(NWAVES * 64, 2) hybrid_fwd(Args args) {
    extern __shared__ __attribute__((aligned(16))) unsigned char lds[];
    Frame F;
    F.lds = (LAS unsigned char*)lds;
    F.MISC = (volatile LAS unsigned*)(F.lds + MISC_OFF);
    F.tid = threadIdx.x; F.lane = F.tid & 63; F.wave = __builtin_amdgcn_readfirstlane(F.tid >> 6); F.G = gridDim.x;
    for (int u = F.tid; u < (LDS_BYTES - LDSCTL_OFF) / 4; u += NWAVES * 64) ((LAS unsigned*)(F.lds + LDSCTL_OFF))[u] = 0u;
    __syncthreads();
    (void)args;
    XcdBarrier bar = xcd_barrier_post(F.ctl() + CW_BAR, F.MISC + 8);

#ifndef NO_P0
#ifdef PROBE_P0X2
    { int reps = 2; asm volatile("" : "+s"(reps)); for (int rep = 0; rep < reps; ++rep) p0_prologue(F); }
#else
    p0_prologue(F);
#endif
#endif
    xcd_barrier(bar);
#ifndef NO_P1
#ifdef PROBE_GX2
    { int reps = 2; asm volatile("" : "+s"(reps)); for (int rep = 0; rep < reps; ++rep) {
#else
    { { const int rep = 0, reps = 1;
#endif
      pg8::Gemm gm{F.HN(), F.WinT(), MTOK, NB16, DM}; pg8::StaticOrder S; S.init(MTOK, NB16, F.G, (int)blockIdx.x);
      EpiProj E{F.PROJ(), F.dtraw(), (rep + 1 < reps) ? nullptr : F.kmean()};
      pg8::gemm_phase<EpiProj, pg8::StaticOrder, PG8_ALIGN, PG8_SP2>(F.lds + RING_OFF, gm, S, E); } }
    { const int nun = (MTOK / 256) * (NB16 / 256), rem = nun % F.G;
      if (rem && (int)blockIdx.x >= rem) tables_convert(F, tab_split(F.G), TAB_ITEMS, (size_t)((int)blockIdx.x - rem) * (NWAVES * 64) + fresh_tid(), (size_t)(F.G - rem) * (NWAVES * 64)); }
    __syncthreads();
    {
      pg8::Gemm gm{(const pg8::bf16_t*)F.HN8(), (const pg8::bf16_t*)F.WinT8(), MTOK, F8_HI - F8_LO, DM / 2}; pg8::StaticOrder S; S.init(MTOK, F8_HI - F8_LO, F.G, (int)blockIdx.x);
      EpiProj8 E{F.PROJ()};
      pg8::gemm_phase<EpiProj8, pg8::StaticOrder, PG8_ALIGN, PG8_SP2, true>(F.lds + RING_OFF, gm, S, E); }
#endif
    xcd_barrier(bar);
#ifdef PROBE_P15X2
    conv_phase(F);
#endif
    conv_phase(F);
    xcd_barrier(bar);
#ifdef PROBE_P2X2
    { int reps = 2; asm volatile("" : "+s"(reps)); for (int rep = 0; rep < reps; ++rep) {
#else
    { { const int rep = 0, reps = 1;
#endif
    const bool doatom = rep + 1 == reps;
    const int ntab = (int)(tab_split(F.G) / TAB_UNIT);
    for (;;) {
        if (F.tid == 0) F.MISC[0] = xb_add(F.ctl() + CW_Q2 + 64 * rep, 1u);
        __syncthreads();
        const int ui = (int)F.MISC[0];
        __syncthreads();
        if (ui >= 128 + 512 + W_SQ_UNITS + ntab) break;
        if (ui >= 128 + 512 && ui < 128 + 512 + W_SQ_UNITS) { sq_weight_items(F, ui - 640); __syncthreads(); continue; }
        if (ui >= 128 + 512 + W_SQ_UNITS) { const size_t lo = (size_t)(ui - 640 - W_SQ_UNITS) * TAB_UNIT; tables_convert(F, lo, lo + TAB_UNIT, (size_t)fresh_tid(), (size_t)(NWAVES * 64)); continue; }
#ifdef PROBE_P2_SSD
        if (ui < 128 || doatom)
#endif
#ifdef PROBE_P2_ATT
        if (ui >= 128 || doatom)
#endif
        {
        if (ui < 128) ssd_unit(F, ui >> 4, ui & 15, doatom);
        else { const int a = ui - 128; attn_unit(F, (a & 63) >> 3, a & 7, 7 - (a >> 6), doatom); }
        }
    } } }
    xcd_barrier(bar);
#ifndef NO_P3
#ifdef PROBE_GX2
    { int reps = 2; asm volatile("" : "+s"(reps)); for (int rep = 0; rep < reps; ++rep) {
#else
    { { const int rep = 0, reps = 1;
#endif
      pg8::Gemm gm{F.HN(), F.WoutT(), MTOK, DM, DM / 2}; pg8::StaticOrder S; S.init(MTOK, DM, F.G, (int)blockIdx.x);
      {
        const int t_ = fresh_tid(); const float* const sq = F.ssq();
#pragma unroll 1
        for (int ii = t_ >> 8; ii < 3; ii += 2) { pg8::Unit uu;
          if (S.next(ii, uu)) { const int row = uu.pm * 256 + (t_ & 255);
            const float q1 = __hip_atomic_load(sq + (size_t)row * 4 + 1, RLX_AGENT), q2 = __hip_atomic_load(sq + (size_t)row * 4 + 2, RLX_AGENT), q3 = __hip_atomic_load(sq + (size_t)row * 4 + 3, RLX_AGENT);
            const float sa = __builtin_amdgcn_rsqf(q1 * (1.f / 1024.f) + EPS), s0 = __builtin_amdgcn_rsqf(q2 * (1.f / 512.f) + EPS), s1 = __builtin_amdgcn_rsqf(q3 * (1.f / 512.f) + EPS);
            *(LAS f32x4*)(F.lds + SEGTAB_OFF + (ii * 256 + (t_ & 255)) * 16) = (f32x4){sa / s0 * (SS8 / SA8), s0 / s1, s1 * (1.f / (SS8 * SW8)), 0.f}; } }
        __syncthreads(); }
      EpiOut E{F.x(), F.X1B(), F.X18(), F.ssq(), rep + 1 == reps, (const LAS f32x4*)(F.lds + SEGTAB_OFF)};
      pg8::gemm_phase<EpiOut, pg8::StaticOrder, PG8_ALIGN, PG8_SP2, true>(F.lds + RING_OFF, gm, S, E); } }
#endif
    xcd_barrier(bar);
#ifndef NO_P4
#ifdef PROBE_GX2
    { int reps = 2; asm volatile("" : "+s"(reps)); for (int rep = 0; rep < reps; ++rep) {
#else
    { { const int rep = 0, reps = 1; (void)rep; (void)reps;
#endif
      pg8::Gemm gm{(const pg8::bf16_t*)F.X18(), F.WqT(), MTOK, DM, DM / 2}; pg8::StaticOrder S; S.init(MTOK, DM, F.G, (int)blockIdx.x);
      EpiQ E{F.QP(), F.ssq()};
      pg8::gemm_phase<EpiQ, pg8::StaticOrder, PG8_ALIGN, PG8_SP2, true>(F.lds + RING_OFF, gm, S, E); } }
#endif
    xcd_barrier(bar);
#ifndef NO_P5
#ifdef PROBE_P5X2
    { for (int u = blockIdx.x; u < MTOK / 32; u += F.G) peer_unit<true>(F, u);
      for (int u = blockIdx.x; u < MTOK / 32; u += F.G) peer_unit<false>(F, u); }
#else
    for (int u = blockIdx.x; u < MTOK / 32; u += F.G) peer_unit(F, u);
#endif
#endif
}

extern "C" void kernel_launch(void* const* d_in, const int* in_sizes, int n_in, void* d_out, int out_size, void* d_ws, size_t ws_size, hipStream_t stream) {
    static int grid = 0;
    if (grid == 0) {
        if (n_in != 18 || out_size != MTOK * DM || ws_size < WS_END) { fprintf(stderr, "kernel_launch: unexpected shapes (n_in %d, out %d, ws %zu)\n", n_in, out_size, ws_size); grid = -1; return; }
        int dev = 0, cus = 0, per_cu = 0;
        if (hipGetDevice(&dev) != hipSuccess || hipDeviceGetAttribute(&cus, hipDeviceAttributeMultiprocessorCount, dev) != hipSuccess) { grid = -1; return; }
        if (hipFuncSetAttribute((const void*)hybrid_fwd, hipFuncAttributeMaxDynamicSharedMemorySize, LDS_BYTES) != hipSuccess) { fprintf(stderr, "kernel_launch: hipFuncSetAttribute failed\n"); grid = -1; return; }
        if (hipOccupancyMaxActiveBlocksPerMultiprocessor(&per_cu, (const void*)hybrid_fwd, NWAVES * 64, LDS_BYTES) != hipSuccess || per_cu < 1)
            fprintf(stderr, "kernel_launch: note: occupancy query reports %d workgroups per CU\n", per_cu);
        (void)hipGetLastError();
        grid = cus;
    }
    if (grid < 0) return;
    if (hipMemsetAsync((char*)d_ws + WS_CTL, 0, CTL_ZERO_BYTES, stream) != hipSuccess) return;
    Args a{};
    for (int i = 0; i < 18; ++i) a.in[i] = (const float*)d_in[i];
    a.out = (float*)d_out; a.ws = (unsigned char*)d_ws;
    hipLaunchKernelGGL(hybrid_fwd, dim3(grid), dim3(NWAVES * 64), LDS_BYTES, stream, a);
}
```

```cpp
#include <hip/hip_runtime.h>
#include <cstdio>
#include <cstdint>
namespace pg8 {
#define PG8_LAS __attribute__((address_space(3)))
typedef unsigned short bf16_t;
typedef short bf16x8 __attribute__((ext_vector_type(8)));
typedef float f32x4 __attribute__((ext_vector_type(4)));
typedef unsigned u32x4 __attribute__((ext_vector_type(4)));
constexpr int BM = 256, BK = 64, HALF = 128, HTB = HALF * BK * 2  , STAGE_BYTES = 8 * HTB, NXCD = 8, WGM = 8;

__host__ __device__ __forceinline__ int lds_byte(int r, int c) { const int st = (r >> 4) * 2 + (c >> 5), rr = r & 15, cc = c & 31, ob = rr * 64 + cc * 2; return st * 1024 + (ob ^ (((ob >> 9) & 1) << 5)); }
__host__ __device__ __forceinline__ void stage_rc(int b, int& R, int& C) { const int st = b / 1024, sb = b % 1024, swz = sb ^ (((sb >> 9) & 1) << 5); R = (st >> 1) * 16 + swz / 64; C = (st & 1) * 32 + (swz % 64) / 2; }
__host__ __device__ __forceinline__ int perm32(int rho) { const int n = rho >> 4, i = rho & 15; return 8 * (i >> 2) + 4 * n + (i & 3); }

struct Unit { int pm, pn; };
struct Gemm { const bf16_t* A; const bf16_t* Bt; int M, N, K; };

struct StaticOrder {
    int nM, nN, nwg, G, c;
    __host__ __device__ void init(int M, int N, int G_, int c_) { nM = M / BM; nN = N / BM; nwg = nM * nN; G = G_; c = c_; }
    __host__ __device__ bool next(int i, Unit& u) const {
        const long L = (long)i * G + c; if (L >= nwg) return false;
        int wgid = (int)L; { const int q = nwg / NXCD, r = nwg % NXCD, xcd = wgid % NXCD, off = wgid / NXCD; wgid = (xcd < r ? xcd * (q + 1) : r * (q + 1) + (xcd - r) * q) + off; }
        const int nig = WGM * nN, gid = wgid / nig, fm = gid * WGM, gsz = (nM - fm) < WGM ? (nM - fm) : WGM;
        u.pm = fm + ((wgid % nig) % gsz); u.pn = (wgid % nig) / gsz; return true;
    }
    __device__ __forceinline__ void a_ready(const Unit&) const {}
    __device__ __forceinline__ void done(const Unit&) const {}
};

__device__ __forceinline__ unsigned cvt_pk_bf16(float lo, float hi) { unsigned r; asm volatile("v_cvt_pk_bf16_f32 %0, %1, %2" : "=v"(r) : "v"(lo), "v"(hi)); return r; }
typedef float f32x2 __attribute__((ext_vector_type(2)));
__device__ __forceinline__ f32x2 gelu_pk(f32x2 v) {
    const f32x2 av = __builtin_elementwise_abs(v), d = av * 0.2316418882f + 1.0f;
    f32x2 t; t.x = __builtin_amdgcn_rcpf(d.x); t.y = __builtin_amdgcn_rcpf(d.y);
    f32x2 q = t * 0.5307027145f + (-0.7265760135f); q = q * t + 0.7107068705f; q = q * t + (-0.142248368f); q = q * t + 0.127414796f; q = q * t;
    const f32x2 s = (v * v) * (-0.72134752044f);
    f32x2 e; e.x = __builtin_amdgcn_exp2f(s.x); e.y = __builtin_amdgcn_exp2f(s.y);
    const f32x2 m = v * (q * e), r = v - m;
    f32x2 o; o.x = v.x < 0.f ? m.x : r.x; o.y = v.y < 0.f ? m.y : r.y; return o;
}

template <int ACT  > struct EpiBf16 {
    static constexpr bool PERM = true, AFTER_DRAIN = false, SEG = false; static_assert(ACT == 0 || ACT == 1, "EpiBf16: ACT is 0 (none) or 1 (gelu_pk)");
    bf16_t* O; int ldc; const float* bias; int split_cols; size_t split_stride; float scale0;
    __device__ __forceinline__ void operator()(const f32x4 (&acc)[2][2][4][2], const Unit& u, int wr, int wc, int fr, int fq) const {
        const int row0 = u.pm * BM + wr * 64 + fr; int colt = u.pn * BM; bf16_t* base = O;
        float sc = 1.f; if (split_cols) { const int t = colt / split_cols; base += (size_t)t * split_stride; colt -= t * split_cols; if (t == 0) sc = scale0; }
        const int col0 = colt + wc * 32 + 8 * fq, bcol0 = u.pn * BM + wc * 32 + 8 * fq;
        f32x4 bv[2][2];
#pragma unroll
        for (int bj = 0; bj < 2; ++bj)
#pragma unroll
            for (int n = 0; n < 2; ++n) bv[bj][n] = bias ? *(const f32x4*)(bias + bcol0 + bj * HALF + 4 * n) : (f32x4){0.f, 0.f, 0.f, 0.f};
#pragma unroll
        for (int ai = 0; ai < 2; ++ai)
#pragma unroll
            for (int m = 0; m < 4; ++m) { bf16_t* rowp = base + (size_t)(row0 + ai * HALF + m * 16) * ldc + col0;
#pragma unroll
                for (int bj = 0; bj < 2; ++bj) { f32x4 v0 = acc[ai][bj][m][0] + bv[bj][0], v1 = acc[ai][bj][m][1] + bv[bj][1];
                    if (ACT == 1) { f32x2 a = gelu_pk((f32x2){v0[0], v0[1]}), b = gelu_pk((f32x2){v0[2], v0[3]}), c = gelu_pk((f32x2){v1[0], v1[1]}), d = gelu_pk((f32x2){v1[2], v1[3]});
                        v0 = (f32x4){a.x, a.y, b.x, b.y}; v1 = (f32x4){c.x, c.y, d.x, d.y}; }
                    v0 = v0 * sc; v1 = v1 * sc; u32x4 w; w.x = cvt_pk_bf16(v0[0], v0[1]); w.y = cvt_pk_bf16(v0[2], v0[3]); w.z = cvt_pk_bf16(v1[0], v1[1]); w.w = cvt_pk_bf16(v1[2], v1[3]);
                    *(u32x4*)(rowp + bj * HALF) = w; } }
    }
};
template <class Epi, class Sched, bool ALIGN_EPI = false, bool SP2 = false, bool F8 = false>
__device__ __forceinline__ void gemm_phase(PG8_LAS unsigned char* lds, const Gemm g, const Sched& S, const Epi& E) {
    int tid_ = threadIdx.x; asm volatile("" : "+v"(tid_));
    const int tid = tid_, wid = __builtin_amdgcn_readfirstlane(tid >> 6), lane = tid & 63, wr = wid >> 2, wc = wid & 3, fr = lane & 15, fq = lane >> 4;
    const int K = g.K, nt = K / BK;
    unsigned voffA[2], voffB[2];
#pragma unroll
    for (int i = 0; i < 2; ++i) { int R, C; stage_rc(tid * 16 + i * 8192, R, C); const int Rb = Epi::PERM ? ((R & ~31) + perm32(R & 31)) : R;
        voffA[i] = (unsigned)(R * K + C) * 2u; voffB[i] = (unsigned)(Rb * K + C) * 2u; }
    const size_t kstep = (size_t)(BK * 2);
    const size_t hstep = (size_t)HALF * K * 2;
    const size_t tstep = 2 * hstep;
    const unsigned ldsw = (unsigned)wid * 1024u;
    const int aoff = lds_byte(wr * 64 + fr, fq * 8), boff = lds_byte(wc * 32 + fr, fq * 8);
#define PG8_SA(b, h) (((b) * 2 + (h)) * HTB)
#define PG8_SB(b, h) ((4 + (b) * 2 + (h)) * HTB)
#define PG8_STAGE(bufoff, gbase, voff) do { _Pragma("unroll") for (int _i = 0; _i < 2; ++_i) \
        __builtin_amdgcn_global_load_lds((const unsigned*)((const char*)(gbase) + (voff)[_i]), (PG8_LAS unsigned*)(lds + (bufoff) + ldsw + _i * 8192), 16, 0, 0); } while (0)
#define PG8_LDA(dst, b, h) do { _Pragma("unroll") for (int m = 0; m < 4; ++m) _Pragma("unroll") for (int k = 0; k < 2; ++k) dst[m][k] = *(const PG8_LAS bf16x8*)(lds + PG8_SA(b, h) + aoff + m * 2048 + k * 1024); } while (0)
#define PG8_LDB(dst, b, h) do { _Pragma("unroll") for (int n = 0; n < 2; ++n) _Pragma("unroll") for (int k = 0; k < 2; ++k) dst[n][k] = *(const PG8_LAS bf16x8*)(lds + PG8_SB(b, h) + boff + n * 2048 + k * 1024); } while (0)
#define PG8_MMA(ai, bj, At, Bt) do { __builtin_amdgcn_s_setprio(1); _Pragma("unroll") for (int m = 0; m < 4; ++m) _Pragma("unroll") for (int n = 0; n < 2; ++n) { \
        if constexpr (F8) { typedef int v8i_ __attribute__((ext_vector_type(8))); typedef int v4i_ __attribute__((ext_vector_type(4))); \
            const v4i_ b0_ = __builtin_bit_cast(v4i_, Bt[n][0]), b1_ = __builtin_bit_cast(v4i_, Bt[n][1]), a0_ = __builtin_bit_cast(v4i_, At[m][0]), a1_ = __builtin_bit_cast(v4i_, At[m][1]); \
            const v8i_ bb_ = {b0_.x, b0_.y, b0_.z, b0_.w, b1_.x, b1_.y, b1_.z, b1_.w}, aa_ = {a0_.x, a0_.y, a0_.z, a0_.w, a1_.x, a1_.y, a1_.z, a1_.w}; \
            asm volatile("v_mfma_scale_f32_16x16x128_f8f6f4 %0, %1, %2, %0, %3, %3 op_sel_hi:[0,0,0]" : "+v"(acc[ai][bj][m][n]) : "v"(bb_), "v"(aa_), "v"(f8one)); } \
        else { _Pragma("unroll") for (int k = 0; k < 2; ++k) acc[ai][bj][m][n] = __builtin_amdgcn_mfma_f32_16x16x32_bf16(Bt[n][k], At[m][k], acc[ai][bj][m][n], 0, 0, 0); } } \
        __builtin_amdgcn_s_setprio(0); } while (0)
#define PG8_WAIT_V(n) asm volatile("s_waitcnt vmcnt(" #n ")" ::: "memory")
#define PG8_WAIT_L(n) asm volatile("s_waitcnt lgkmcnt(" #n ")" ::: "memory")
#define PG8_BAR __builtin_amdgcn_s_barrier()
#define PG8_SCHED __builtin_amdgcn_sched_barrier(0)
    Unit cur, nxt; int ui = 0;
    if (!S.next(0, cur)) return;
    f32x4 acc[2][2][4][2];
    const int f8one = 0x7f7f7f7f;
#pragma unroll
    for (int a = 0; a < 2; ++a)
#pragma unroll
        for (int b = 0; b < 2; ++b)
#pragma unroll
            for (int m = 0; m < 4; ++m)
#pragma unroll
                for (int n = 0; n < 2; ++n) acc[a][b][m][n] = (f32x4){0.f, 0.f, 0.f, 0.f};
    bf16x8 At[4][2], B0[2][2], B1[2][2];
    const char* cA = (const char*)g.A + (size_t)cur.pm * tstep; const char* cB = (const char*)g.Bt + (size_t)cur.pn * tstep;
    S.a_ready(cur);
    float segr[16];
    if constexpr (Epi::SEG) E.seg_load(ui, wr, fr, segr);
    if constexpr (SP2) {
        PG8_STAGE(PG8_SB(0, 0), cB, voffB); PG8_STAGE(PG8_SB(0, 1), cB + hstep, voffB); PG8_STAGE(PG8_SA(0, 0), cA, voffA); PG8_STAGE(PG8_SA(0, 1), cA + hstep, voffA);
        if (wr == 1) PG8_BAR;
        PG8_WAIT_V(2); PG8_BAR;
        PG8_STAGE(PG8_SB(1, 0), cB + kstep, voffB); PG8_STAGE(PG8_SA(1, 0), cA + kstep, voffA); PG8_STAGE(PG8_SB(1, 1), cB + hstep + kstep, voffB);
        PG8_WAIT_V(6); PG8_BAR;
    } else {
        PG8_STAGE(PG8_SB(0, 0), cB, voffB); PG8_STAGE(PG8_SA(0, 0), cA, voffA); PG8_STAGE(PG8_SB(0, 1), cB + hstep, voffB); PG8_STAGE(PG8_SA(0, 1), cA + hstep, voffA);
        if (wr == 1) PG8_BAR;
        PG8_WAIT_V(4); PG8_BAR;
        PG8_STAGE(PG8_SB(1, 0), cB + kstep, voffB); PG8_STAGE(PG8_SA(1, 0), cA + kstep, voffA); PG8_STAGE(PG8_SB(1, 1), cB + hstep + kstep, voffB);
        PG8_WAIT_V(6); PG8_BAR;
    }
    for (;;) {
        const bool has_next = S.next(ui + 1, nxt);
        const char* nA = has_next ? (const char*)g.A + (size_t)nxt.pm * tstep : cA; const char* nB = has_next ? (const char*)g.Bt + (size_t)nxt.pn * tstep : cB;
        int t = 0;
#pragma unroll 1
        for (int sgi = 0; sgi < (Epi::SEG ? 3 : 1); ++sgi) {
        int tend = nt; if constexpr (Epi::SEG) tend = (sgi == 0) ? Epi::SEG_T1 : ((sgi == 1) ? Epi::SEG_T2 : nt);
        for (; t < tend; t += 2) {
            const bool last = (t == nt - 2);
            const char* a1 = cA + (size_t)(t + 1) * kstep;
            const char* a2 = last ? nA : cA + (size_t)(t + 2) * kstep; const char* b2 = last ? nB : cB + (size_t)(t + 2) * kstep;
            const char* a3 = a2 + kstep; const char* b3 = b2 + kstep;
            if (last && has_next) S.a_ready(nxt);
            if constexpr (SP2) {
            PG8_LDB(B0, 0, 0); PG8_LDB(B1, 0, 1); PG8_SCHED; PG8_LDA(At, 0, 0); PG8_STAGE(PG8_SA(1, 1), a1 + hstep, voffA);
            PG8_WAIT_V(8); PG8_WAIT_L(0); PG8_BAR; PG8_MMA(0, 0, At, B0); PG8_MMA(0, 1, At, B1); PG8_BAR; PG8_SCHED;
            PG8_LDA(At, 0, 1); PG8_STAGE(PG8_SB(0, 0), b2, voffB); PG8_STAGE(PG8_SB(0, 1), b2 + hstep, voffB); PG8_STAGE(PG8_SA(0, 0), a2, voffA);
            PG8_WAIT_V(8); PG8_WAIT_L(0); PG8_BAR; PG8_MMA(1, 0, At, B0); PG8_MMA(1, 1, At, B1); PG8_BAR; PG8_SCHED;
            PG8_LDB(B0, 1, 0); PG8_LDB(B1, 1, 1); PG8_SCHED; PG8_LDA(At, 1, 0); PG8_STAGE(PG8_SA(0, 1), a2 + hstep, voffA);
            PG8_WAIT_V(8); PG8_WAIT_L(0); PG8_BAR; PG8_MMA(0, 0, At, B0); PG8_MMA(0, 1, At, B1); PG8_BAR; PG8_SCHED;
            PG8_LDA(At, 1, 1); PG8_STAGE(PG8_SB(1, 0), b3, voffB); PG8_STAGE(PG8_SB(1, 1), b3 + hstep, voffB); PG8_STAGE(PG8_SA(1, 0), a3, voffA);
            PG8_WAIT_V(8); PG8_WAIT_L(0); PG8_BAR; PG8_MMA(1, 0, At, B0); PG8_MMA(1, 1, At, B1); PG8_BAR; PG8_SCHED;
            } else {
            PG8_LDB(B0, 0, 0); PG8_SCHED; PG8_LDA(At, 0, 0); PG8_STAGE(PG8_SA(1, 1), a1 + hstep, voffA);
            PG8_WAIT_L(8); PG8_BAR; PG8_WAIT_L(0); PG8_MMA(0, 0, At, B0); PG8_BAR; PG8_SCHED;
            PG8_LDB(B1, 0, 1); PG8_STAGE(PG8_SB(0, 0), b2, voffB);
            PG8_BAR; PG8_WAIT_L(0); PG8_MMA(0, 1, At, B1); PG8_BAR;
            PG8_LDA(At, 0, 1); PG8_STAGE(PG8_SA(0, 0), a2, voffA);
            PG8_BAR; PG8_WAIT_L(0); PG8_MMA(1, 0, At, B0); PG8_BAR; PG8_SCHED;
            PG8_STAGE(PG8_SB(0, 1), b2 + hstep, voffB);
            PG8_WAIT_V(6); PG8_BAR; PG8_MMA(1, 1, At, B1); PG8_BAR;
            PG8_LDB(B0, 1, 0); PG8_SCHED; PG8_LDA(At, 1, 0); PG8_STAGE(PG8_SA(0, 1), a2 + hstep, voffA);
            PG8_WAIT_L(8); PG8_BAR; PG8_WAIT_L(0); PG8_MMA(0, 0, At, B0); PG8_BAR; PG8_SCHED;
            PG8_LDB(B1, 1, 1); PG8_STAGE(PG8_SB(1, 0), b3, voffB);
            PG8_BAR; PG8_WAIT_L(0); PG8_MMA(0, 1, At, B1); PG8_BAR;
            PG8_LDA(At, 1, 1); PG8_STAGE(PG8_SA(1, 0), a3, voffA);
            PG8_BAR; PG8_WAIT_L(0); PG8_MMA(1, 0, At, B0); PG8_BAR; PG8_SCHED;
            PG8_STAGE(PG8_SB(1, 1), b3 + hstep, voffB);
            PG8_WAIT_V(6); PG8_BAR; PG8_MMA(1, 1, At, B1); PG8_BAR;
            }
        }
        if constexpr (Epi::SEG) E.seg_apply(acc, segr, sgi);
        }
        if constexpr (ALIGN_EPI) { if (wr == 0) PG8_BAR; }
        if constexpr (!Epi::AFTER_DRAIN) { if constexpr (Epi::SEG) E(acc, cur, wr, wc, fr, fq, ui); else E(acc, cur, wr, wc, fr, fq); S.done(cur); }
        if (!has_next) break;
#pragma unroll
        for (int a = 0; a < 2; ++a)
#pragma unroll
            for (int b = 0; b < 2; ++b)
#pragma unroll
                for (int m = 0; m < 4; ++m)
#pragma unroll
                    for (int n = 0; n < 2; ++n) acc[a][b][m][n] = (f32x4){0.f, 0.f, 0.f, 0.f};
        cur = nxt; cA = nA; cB = nB; ++ui;
        if constexpr (Epi::SEG) E.seg_load(ui, wr, fr, segr);
        if constexpr (ALIGN_EPI) { if (wr == 1) PG8_BAR; }
    }
    PG8_WAIT_V(0);
    if constexpr (!ALIGN_EPI) { if (wr == 0) PG8_BAR; }
    PG8_BAR;
    if constexpr (Epi::AFTER_DRAIN) { E.fused(acc, cur, wr, wc, fr, fq, lds, wid, lane); S.done(cur); }
#undef PG8_SA
#undef PG8_SB
#undef PG8_STAGE
#undef PG8_LDA
#undef PG8_LDB
#undef PG8_MMA
#undef PG8_WAIT_V
#undef PG8_WAIT_L
#undef PG8_BAR
#undef PG8_SCHED
}
}
#ifndef PG8_SP2
#define PG8_SP2 true
#endif
#ifndef PG8_ALIGN
#define PG8_ALIGN true
#endif

constexpr int BATCH = 8, SEQ = 2048, DM = 2048, MTOK = BATCH * SEQ;
constexpr int ATT_W = 1024, ATT_H = 8, ATT_HD = 128, MOBA_BLK = 256, NBLK = SEQ / MOBA_BLK;
constexpr int SSM_W = 1024, SSM_H = 16, SSM_P = 64, SSM_N = 128, SSM_L = 128, SSM_NC = SEQ / SSM_L, CONV_CH = 1536;
constexpr int IN_PROJ = 5648, NPROJ = 5632  , NPAD = 5888  ;
constexpr int F8_LO = 2048, F8_HI = 4096, NB16 = NPAD - (F8_HI - F8_LO)  ;
constexpr float SH8 = 16.f;
constexpr int COL_Q = 0, COL_K = 1024, COL_V = 2048, COL_Z = 3072, COL_XBC = 4096;
constexpr int PEER_H = 8, PEER_NK = 128, PEER_K = 16, PEER_HK = 128;
constexpr float EPS = 1e-6f;
constexpr float SU = 64.f, SV = 4.f, SH = 16.f, SLO = 16.f;
constexpr float SX8 = 16.f, SW8 = 1024.f;
constexpr float SA8 = 32.f, SS8 = 8.f;
constexpr float SH4 = 1.5f, SLO4 = 4.f;
constexpr int ROWB = DM / 2;

constexpr size_t MiB = 1u << 20;
constexpr size_t WS_CTL = 0, CTL_ZERO_BYTES = 1 * MiB;
constexpr size_t WS_DT = 1 * MiB;
constexpr size_t WS_SK = 2 * MiB;
constexpr size_t WS_WIN = 4 * MiB;
constexpr size_t WS_WIN8 = 24 * MiB;
constexpr size_t WS_HN8 = 396 * MiB;
constexpr size_t WS_WOUT = 28 * MiB;
constexpr size_t WS_WQ = 36 * MiB;
constexpr size_t WS_HN = 44 * MiB;
constexpr size_t WS_PROJ = 108 * MiB;
constexpr size_t WS_X1B = WS_PROJ, WS_QP = WS_PROJ + 64 * MiB;
constexpr size_t WS_U8 = 284 * MiB, WS_V8 = 316 * MiB;
constexpr size_t WS_XBC = 348 * MiB;
constexpr size_t WS_DT2 = 3 * MiB;
constexpr size_t WS_X18 = 396 * MiB;
constexpr size_t WS_END = 428 * MiB;
constexpr int CW_BAR = 4096;
constexpr int CW_Q2 = 8192;
constexpr int CW_KMEAN = 32768;
constexpr int CW_SSQ = 131072;
static_assert((CW_SSQ + MTOK * 4) * 4 <= (int)CTL_ZERO_BYTES, "CTL words inside the memset region");

constexpr int RING_OFF = 0, RING_BYTES = 131072;
constexpr int LDSCTL_OFF = RING_BYTES, MISC_OFF = LDSCTL_OFF + 320;
constexpr int SEGTAB_OFF = LDSCTL_OFF + 1024;  static_assert(LDSCTL_OFF + 1024 + 3 * 256 * 16 <= 147456, "segment table inside the LDS allocation");
constexpr int LDS_BYTES = 147456;
constexpr int NWAVES = 8;

#define GAS __attribute__((address_space(1)))
#define LAS __attribute__((address_space(3)))
typedef unsigned short bf16;
typedef unsigned v4u __attribute__((ext_vector_type(4)));
typedef unsigned v2u __attribute__((ext_vector_type(2)));
typedef float f32x4 __attribute__((ext_vector_type(4)));
typedef float f32x2 __attribute__((ext_vector_type(2)));
typedef short bf16x8 __attribute__((ext_vector_type(8)));
typedef short s16x4 __attribute__((ext_vector_type(4)));
typedef GAS unsigned gu32;
#define RLX_AGENT __ATOMIC_RELAXED, __HIP_MEMORY_SCOPE_AGENT
#define LDS_WAIT() asm volatile("s_waitcnt lgkmcnt(0)" ::: "memory")
#define VM_WAIT() asm volatile("s_waitcnt vmcnt(0)" ::: "memory")
__device__ __forceinline__ unsigned f2bf(float f) { unsigned u = __builtin_bit_cast(unsigned, f); return (u + 0x7fffu + ((u >> 16) & 1u)) >> 16; }
typedef __bf16 bf16v2 __attribute__((ext_vector_type(2)));
__device__ __forceinline__ unsigned pk2(float lo, float hi) { bf16v2 v; v.x = (__bf16)lo; v.y = (__bf16)hi; return __builtin_bit_cast(unsigned, v); }
__device__ __forceinline__ float bflo(unsigned w) { return __builtin_bit_cast(float, w << 16); }
__device__ __forceinline__ float bfhi(unsigned w) { return __builtin_bit_cast(float, w & 0xffff0000u); }
__device__ __forceinline__ float wave_sum(float v) {
#pragma unroll
    for (int o = 1; o < 64; o <<= 1) v += __shfl_xor(v, o);
    return v;
}
__device__ __forceinline__ float silu_f(float x) { return x * __builtin_amdgcn_rcpf(1.f + __expf(-x)); }

#define XB_TMO      128
#define XB_XCNT(j)  (256  + 64 * (j))
#define XB_XSUB(j)  (1280 + 64 * (j))
#define XB_XGEN(j)  (2304 + 64 * (j))
#define XB_TOP      3328
#define XB_TOPGEN   3392
#define XCD_BAR_WORDS 3456
#define XB_SPIN_CAP (1u << 18)

__device__ __forceinline__ unsigned xb_ld(unsigned* p)              { return __hip_atomic_load(p, __ATOMIC_RELAXED, __HIP_MEMORY_SCOPE_AGENT); }
__device__ __forceinline__ unsigned xb_add(unsigned* p, unsigned v) { return __hip_atomic_fetch_add(p, v, __ATOMIC_RELAXED, __HIP_MEMORY_SCOPE_AGENT); }
__device__ __forceinline__ unsigned xb_xcc_id() { return (unsigned)__builtin_amdgcn_s_getreg((3 << 11) | 20) & 0xFu; }
#define XB_SPIN(cond, bar) do { unsigned _sp = 0; while (cond) { __builtin_amdgcn_s_sleep(1); \
    if ((++_sp & 255u) == 0u) { if (xb_ld(&(bar)[XB_TMO])) break; if (_sp > XB_SPIN_CAP) { atomicAdd(&(bar)[XB_TMO], 1u); break; } } } } while (0)

struct XcdBarrier {
    unsigned* bar; unsigned x;
    volatile LAS unsigned* st;
};
__device__ __forceinline__ XcdBarrier xcd_barrier_post(unsigned* bar, volatile LAS unsigned* st) {
    XcdBarrier b; b.bar = bar; b.x = xb_xcc_id(); b.st = st;
    if (threadIdx.x == 0) (void)xb_add(&bar[XB_XCNT(b.x)], 1u);
    return b;
}
__device__ __forceinline__ void xcd_barrier_complete(unsigned* bar, unsigned x, unsigned& nloc, unsigned& nx) {
    const unsigned G = gridDim.x * gridDim.y * gridDim.z;
    unsigned sum, cnt, mine, sp = 0u;
    for (;;) {
        sum = 0u; cnt = 0u; mine = 0u;
#pragma unroll
        for (unsigned j = 0; j < 16; ++j) { const unsigned c = xb_ld(&bar[XB_XCNT(j)]); sum += c; cnt += (c > 0u) ? 1u : 0u; mine = (j == x) ? c : mine; }
        if (sum == G) break;
        __builtin_amdgcn_s_sleep(1);
        if ((++sp & 255u) == 0u) { if (xb_ld(&bar[XB_TMO])) break; if (sp > XB_SPIN_CAP) { atomicAdd(&bar[XB_TMO], 1u); break; } }
    }
    nloc = mine > 0u ? mine : 1u; nx = cnt > 0u ? cnt : 1u;
}
__device__ __forceinline__ void xcd_barrier(const XcdBarrier& b) {
    asm volatile("s_waitcnt vmcnt(0)" ::: "memory");
    __syncthreads();
    if (threadIdx.x == 0) {
        unsigned* bar = b.bar;
        __builtin_amdgcn_s_waitcnt(0);
        unsigned nloc = b.st[0], nx = b.st[1];
        if (nloc == 0u) { xcd_barrier_complete(bar, b.x, nloc, nx); b.st[0] = nloc; b.st[1] = nx; }
        const unsigned old = xb_add(&bar[XB_XSUB(b.x)], 1u);
        const unsigned gen = old / nloc;
        if (old + 1u == (gen + 1u) * nloc) {
            __builtin_amdgcn_fence(__ATOMIC_RELEASE, "agent");
            asm volatile("s_waitcnt vmcnt(0)" ::: "memory");
            const unsigned og = xb_add(&bar[XB_TOP], 1u);
            const unsigned tg = og / nx;
            if (og + 1u == (tg + 1u) * nx) xb_add(&bar[XB_TOPGEN], 1u);
            else XB_SPIN(xb_ld(&bar[XB_TOPGEN]) == tg, bar);
            __builtin_amdgcn_fence(__ATOMIC_ACQUIRE, "agent");
            xb_add(&bar[XB_XGEN(b.x)], 1u);
            asm volatile("s_waitcnt vmcnt(0)" ::: "memory");
        } else {
            XB_SPIN(xb_ld(&bar[XB_XGEN(b.x)]) == gen, bar);
            __builtin_amdgcn_fence(__ATOMIC_ACQUIRE, "agent");
            asm volatile("s_waitcnt vmcnt(0)" ::: "memory");
        }
    }
    __syncthreads();
}

#define CAS __attribute__((address_space(4)))
struct Args { const float* in[18]; float* out; unsigned char* ws; };
__device__ __forceinline__ const CAS unsigned char* kargs() { const CAS unsigned char* p = (const CAS unsigned char*)__builtin_amdgcn_kernarg_segment_ptr(); asm volatile("" : "+s"(p)); return p; }
__device__ __forceinline__ const float* kin(int i) { return *(const float* const CAS*)(kargs() + 8 * i); }
__device__ __forceinline__ float* kout() { return *(float* const CAS*)(kargs() + 8 * 18); }
__device__ __forceinline__ unsigned char* kws() { return *(unsigned char* const CAS*)(kargs() + 8 * 19); }
__device__ __forceinline__ int fresh_tid() { int t = threadIdx.x; asm volatile("" : "+v"(t)); return t; }
struct Frame {
    LAS unsigned char* lds;
    volatile LAS unsigned* MISC;
    int tid, lane, wave, G;
    __device__ __forceinline__ const float* x() const { return kin(0); }
    __device__ __forceinline__ const float* attn_norm() const { return kin(1); }
    __device__ __forceinline__ const float* w_in() const { return kin(2); }
    __device__ __forceinline__ const float* conv_w() const { return kin(3); }
    __device__ __forceinline__ const float* conv_b() const { return kin(4); }
    __device__ __forceinline__ const float* dt_bias() const { return kin(5); }
    __device__ __forceinline__ const float* a_log() const { return kin(6); }
    __device__ __forceinline__ const float* d_skip() const { return kin(7); }
    __device__ __forceinline__ const float* rel_bias() const { return kin(8); }
    __device__ __forceinline__ const float* attn_out_norm() const { return kin(9); }
    __device__ __forceinline__ const float* ssm_out_norm() const { return kin(10); }
    __device__ __forceinline__ const float* w_out() const { return kin(11); }
    __device__ __forceinline__ const float* ffn_norm() const { return kin(12); }
    __device__ __forceinline__ const float* peer_wq() const { return kin(13); }
    __device__ __forceinline__ const float* peer_sk() const { return kin(14); }
    __device__ __forceinline__ const float* peer_u() const { return kin(15); }
    __device__ __forceinline__ const float* peer_v() const { return kin(16); }
    __device__ __forceinline__ const float* final_norm() const { return kin(17); }
    __device__ __forceinline__ float* out() const { return kout(); }
    __device__ __forceinline__ unsigned* ctl() const { return (unsigned*)(kws() + WS_CTL); }
    __device__ __forceinline__ float* dtraw() const { return (float*)(kws() + WS_DT); }
    __device__ __forceinline__ bf16* SK() const { return (bf16*)(kws() + WS_SK); }
    __device__ __forceinline__ bf16* WinT() const { return (bf16*)(kws() + WS_WIN); }
    __device__ __forceinline__ bf16* WoutT() const { return (bf16*)(kws() + WS_WOUT); }
    __device__ __forceinline__ bf16* WqT() const { return (bf16*)(kws() + WS_WQ); }
    __device__ __forceinline__ bf16* HN() const { return (bf16*)(kws() + WS_HN); }
    __device__ __forceinline__ bf16* PROJ() const { return (bf16*)(kws() + WS_PROJ); }
    __device__ __forceinline__ bf16* X1B() const { return (bf16*)(kws() + WS_X1B); }
    __device__ __forceinline__ bf16* QP() const { return (bf16*)(kws() + WS_QP); }
    __device__ __forceinline__ unsigned char* U8() const { return kws() + WS_U8; }
    __device__ __forceinline__ unsigned char* V8() const { return kws() + WS_V8; }
    __device__ __forceinline__ unsigned char* X18() const { return kws() + WS_X18; }
    __device__ __forceinline__ unsigned char* HN8() const { return kws() + WS_HN8; }
    __device__ __forceinline__ unsigned char* WinT8() const { return kws() + WS_WIN8; }
    __device__ __forceinline__ bf16* XBC() const { return (bf16*)(kws() + WS_XBC); }
    __device__ __forceinline__ float* DT2() const { return (float*)(kws() + WS_DT2); }
    __device__ __forceinline__ float* kmean() const { return (float*)(kws() + WS_CTL) + CW_KMEAN; }
    __device__ __forceinline__ float* ssq() const { return (float*)(kws() + WS_CTL) + CW_SSQ; }
};

__device__ __forceinline__ float clampf(float v, float lim);
__device__ __forceinline__ void p0_transpose_item(const float* W, int K, int N, bf16* WT, const float* gain, LAS float* scr, int item, int lane, const float f8scale = 0.f, const int nshift = 0) {
    const int nblk = (N + 31) / 32, kb = item / nblk, nb = item % nblk, k0 = 64 * kb, n0 = 32 * nb;
    const int kr = lane >> 3, nc = (lane & 7) * 4; const bool ok = (n0 + nc) < N;
    f32x4 v[8]; float gk[8];
#pragma unroll
    for (int i = 0; i < 8; ++i) { const int kk = 8 * i + kr; v[i] = ok ? *(const GAS f32x4*)(W + (size_t)(k0 + kk) * N + n0 + nc) : (f32x4){0.f, 0.f, 0.f, 0.f}; gk[i] = gain ? gain[k0 + kk] : 1.f; }
#pragma unroll
    for (int i = 0; i < 8; ++i) { const int kk = 8 * i + kr; LAS float* d = scr + kk * 33 + nc; d[0] = v[i].x * gk[i]; d[1] = v[i].y * gk[i]; d[2] = v[i].z * gk[i]; d[3] = v[i].w * gk[i]; }
    LDS_WAIT(); asm volatile("" ::: "memory");
    const int c = lane & 7;
#pragma unroll
    for (int j = 0; j < 4; ++j) { const int n = (lane >> 3) + 8 * j; const LAS float* s = scr + (8 * c) * 33 + n;
        v4u o; o.x = pk2(s[0 * 33], s[1 * 33]); o.y = pk2(s[2 * 33], s[3 * 33]); o.z = pk2(s[4 * 33], s[5 * 33]); o.w = pk2(s[6 * 33], s[7 * 33]);
        if (f8scale == 0.f) *(GAS v4u*)(WT + (size_t)(n0 + n - nshift) * K + k0 + 8 * c) = o;
        else { v2u o8; int w_;
            w_ = __builtin_amdgcn_cvt_pk_fp8_f32(clampf(s[0 * 33] * f8scale, 448.f), clampf(s[1 * 33] * f8scale, 448.f), 0, false); w_ = __builtin_amdgcn_cvt_pk_fp8_f32(clampf(s[2 * 33] * f8scale, 448.f), clampf(s[3 * 33] * f8scale, 448.f), w_, true); o8.x = (unsigned)w_;
            w_ = __builtin_amdgcn_cvt_pk_fp8_f32(clampf(s[4 * 33] * f8scale, 448.f), clampf(s[5 * 33] * f8scale, 448.f), 0, false); w_ = __builtin_amdgcn_cvt_pk_fp8_f32(clampf(s[6 * 33] * f8scale, 448.f), clampf(s[7 * 33] * f8scale, 448.f), w_, true); o8.y = (unsigned)w_;
            *(GAS v2u*)((unsigned char*)WT + (size_t)(n0 + n - nshift) * K + k0 + 8 * c) = o8; } }
    LDS_WAIT(); asm volatile("" ::: "memory");
}
__device__ __forceinline__ unsigned pk4_fp8(float a, float b, float c, float d) { int w = __builtin_amdgcn_cvt_pk_fp8_f32(clampf(a, 448.f), clampf(b, 448.f), 0, false); w = __builtin_amdgcn_cvt_pk_fp8_f32(clampf(c, 448.f), clampf(d, 448.f), w, true); return (unsigned)w; }
__device__ __forceinline__ void rms_2rows_to_bf16(const float* x0, const float* x1, const float* gain, bf16* o0, bf16* o1, unsigned char* q0, unsigned char* q1, int lane) {
    const GAS f32x4* xr0 = (const GAS f32x4*)x0 + lane; const GAS f32x4* xr1 = (const GAS f32x4*)x1 + lane; const GAS f32x4* gr = (const GAS f32x4*)gain + lane;
    f32x4 v[8], u[8]; float s = 0.f, t = 0.f;
#pragma unroll
    for (int j = 0; j < 8; ++j) { v[j] = xr0[64 * j]; u[j] = xr1[64 * j]; }
#pragma unroll
    for (int j = 0; j < 8; ++j) { s += (v[j].x * v[j].x + v[j].y * v[j].y) + (v[j].z * v[j].z + v[j].w * v[j].w); t += (u[j].x * u[j].x + u[j].y * u[j].y) + (u[j].z * u[j].z + u[j].w * u[j].w); }
    const float rs = __builtin_amdgcn_rsqf(wave_sum(s) * (1.f / DM) + EPS), rt = __builtin_amdgcn_rsqf(wave_sum(t) * (1.f / DM) + EPS);
    GAS v2u* p0 = (GAS v2u*)o0 + lane; GAS v2u* p1 = (GAS v2u*)o1 + lane; GAS unsigned* r0 = (GAS unsigned*)q0 + lane; GAS unsigned* r1 = (GAS unsigned*)q1 + lane;
#pragma unroll
    for (int j = 0; j < 8; ++j) { const f32x4 g = gr[64 * j]; v2u a, b;
        const f32x4 h0 = v[j] * g * rs, h1 = u[j] * g * rt;
        a.x = pk2(h0.x, h0.y); a.y = pk2(h0.z, h0.w); p0[64 * j] = a; r0[64 * j] = pk4_fp8(h0.x * SH8, h0.y * SH8, h0.z * SH8, h0.w * SH8);
        b.x = pk2(h1.x, h1.y); b.y = pk2(h1.z, h1.w); p1[64 * j] = b; r1[64 * j] = pk4_fp8(h1.x * SH8, h1.y * SH8, h1.z * SH8, h1.w * SH8); }
}
#ifdef PROBE_FP4EMU
__device__ __forceinline__ float fp4grid(float y) { const float a = fabsf(y); float r;
    if (a <= 2.f) r = rintf(a * 2.f) * 0.5f; else if (a <= 4.f) r = rintf(a); else r = (a < 5.f) ? 4.f : 6.f;
    return copysignf(r, y); }
__device__ __forceinline__ float clampf(float v, float lim) { if (lim == 448.5f) return fp4grid(v * (1.f / 16.f)) * 16.f; return fminf(fmaxf(v, -lim), lim); }
#else
__device__ __forceinline__ float clampf(float v, float lim) { return fminf(fmaxf(v, -lim), lim); }
#endif
template <int TAB = 0> __device__ __forceinline__ v4u cvt16_fp8(const f32x4 a, const f32x4 b, const f32x4 c, const f32x4 d, float sc) {
    v4u o; int w; constexpr float LIM = TAB ? 448.5f : 448.f;
    w = __builtin_amdgcn_cvt_pk_fp8_f32(clampf(a.x * sc, LIM), clampf(a.y * sc, LIM), 0, false); w = __builtin_amdgcn_cvt_pk_fp8_f32(clampf(a.z * sc, LIM), clampf(a.w * sc, LIM), w, true); o.x = (unsigned)w;
    w = __builtin_amdgcn_cvt_pk_fp8_f32(clampf(b.x * sc, LIM), clampf(b.y * sc, LIM), 0, false); w = __builtin_amdgcn_cvt_pk_fp8_f32(clampf(b.z * sc, LIM), clampf(b.w * sc, LIM), w, true); o.y = (unsigned)w;
    w = __builtin_amdgcn_cvt_pk_fp8_f32(clampf(c.x * sc, LIM), clampf(c.y * sc, LIM), 0, false); w = __builtin_amdgcn_cvt_pk_fp8_f32(clampf(c.z * sc, LIM), clampf(c.w * sc, LIM), w, true); o.z = (unsigned)w;
    w = __builtin_amdgcn_cvt_pk_fp8_f32(clampf(d.x * sc, LIM), clampf(d.y * sc, LIM), 0, false); w = __builtin_amdgcn_cvt_pk_fp8_f32(clampf(d.z * sc, LIM), clampf(d.w * sc, LIM), w, true); o.w = (unsigned)w;
    return o;
}
__device__ __forceinline__ void tables_convert(Frame& F, size_t lo, size_t hi, size_t tix, size_t ntx) {
      const GAS f32x4* su = (const GAS f32x4*)F.peer_u(); const GAS f32x4* sv = (const GAS f32x4*)F.peer_v(); GAS v4u* du = (GAS v4u*)F.U8(); GAS v4u* dv = (GAS v4u*)F.V8();
#pragma unroll 1
      for (int tab = 0; tab < 2; ++tab) { const GAS f32x4* src = tab ? sv : su; GAS v4u* dst = tab ? dv : du; const float sc = tab ? SV : SU;
        f32x4 nx[8]; const size_t i0 = lo + tix;
        if (i0 < hi) { const GAS f32x4* p = src + (i0 >> 6) * 512 + (i0 & 63);
#pragma unroll
            for (int j = 0; j < 8; ++j) nx[j] = p[64 * j]; }
#pragma unroll 1
        for (size_t i = i0; i < hi; i += ntx) { f32x4 v[8];
#pragma unroll
            for (int j = 0; j < 8; ++j) v[j] = nx[j];
            if (i + ntx < hi) { const size_t i2 = i + ntx; const GAS f32x4* p = src + (i2 >> 6) * 512 + (i2 & 63);
#pragma unroll
                for (int j = 0; j < 8; ++j) nx[j] = p[64 * j]; }
            unsigned wd[4];
#pragma unroll
            for (int q = 0; q < 4; ++q) { const f32x4 a = v[2 * q] * sc, b = v[2 * q + 1] * sc; unsigned w = 0u;
                w = __builtin_amdgcn_cvt_scalef32_pk_fp4_f32(w, clampf(a.x, 6.f), clampf(a.y, 6.f), 1.0f, 0); w = __builtin_amdgcn_cvt_scalef32_pk_fp4_f32(w, clampf(a.z, 6.f), clampf(a.w, 6.f), 1.0f, 1);
                w = __builtin_amdgcn_cvt_scalef32_pk_fp4_f32(w, clampf(b.x, 6.f), clampf(b.y, 6.f), 1.0f, 2); w = __builtin_amdgcn_cvt_scalef32_pk_fp4_f32(w, clampf(b.z, 6.f), clampf(b.w, 6.f), 1.0f, 3); wd[q] = w; }
            dst[i] = (v4u){wd[0], wd[1], wd[2], wd[3]}; } }
}
constexpr size_t TAB_ITEMS = (size_t)16384 * 64;
#ifndef TAB_HEAD8
#define TAB_HEAD8 4
#endif
__device__ __forceinline__ size_t tab_split(int G) { const int rem = ((MTOK / 256) * (NB16 / 256)) % G; return rem ? (TAB_ITEMS / 8) * TAB_HEAD8 : TAB_ITEMS; }
__device__ __forceinline__ unsigned fp4_code(float y) { const float a = fabsf(y);
    const unsigned m = (unsigned)(a >= 0.25f) + (unsigned)(a >= 0.75f) + (unsigned)(a >= 1.25f) + (unsigned)(a >= 1.75f) + (unsigned)(a >= 2.5f) + (unsigned)(a >= 3.5f) + (unsigned)(a >= 5.0f);
    return m | ((y < 0.f) ? 8u : 0u); }
constexpr int W_SQ_ITEMS = (DM / 64) * (DM / 32), W_SQ_PER_UNIT = 64, W_SQ_UNITS = 2 * W_SQ_ITEMS / W_SQ_PER_UNIT;
__device__ __forceinline__ void sq_weight_items(Frame& F, int unit) {
    const int tid = fresh_tid(), lane = tid & 63, wave = __builtin_amdgcn_readfirstlane(tid >> 6);
    LAS float* scr = (LAS float*)(F.lds + RING_OFF + wave * 16384);
    const float* const w_out = F.w_out(); const float* const wq = F.peer_wq(); const float* const fg = F.ffn_norm(); bf16* const WoutT = F.WoutT(); bf16* const WqT = F.WqT(); const float* const gatt = F.attn_out_norm(); const float* const gssm = F.ssm_out_norm();
#pragma unroll 1
    for (int k = 0; k < W_SQ_PER_UNIT / NWAVES; ++k) {
        int r = unit * W_SQ_PER_UNIT + k * NWAVES + wave;
        if (r < W_SQ_ITEMS) { const int k0_ = 64 * (r / (DM / 32)); p0_transpose_item(w_out, DM, DM, WoutT, (k0_ < ATT_W) ? gatt : (gssm - ATT_W), scr, r, lane, SW8); }
        else { r -= W_SQ_ITEMS; p0_transpose_item(wq, DM, DM, WqT, fg, scr, r, lane, SW8); }
    }
}
__device__ __forceinline__ void p0_prologue(Frame& F) {
    const int tid = fresh_tid(), lane = tid & 63, wave = __builtin_amdgcn_readfirstlane(tid >> 6);
    LAS float* scr = (LAS float*)(F.lds + RING_OFF + wave * 16384);
    const int gw = blockIdx.x * NWAVES + wave, NGW = F.G * NWAVES;
    constexpr int I_IN = (DM / 64) * ((IN_PROJ + 31) / 32), I_SQ = (DM / 64) * (DM / 32);
    constexpr int NITEMS = I_IN;
    { const float* const w_in = F.w_in(); const float* const w_out = F.w_out(); const float* const wq = F.peer_wq(); const float* const fg = F.ffn_norm(); bf16* const WinT = F.WinT(); unsigned char* const WinT8 = F.WinT8(); bf16* const WoutT = F.WoutT(); bf16* const WqT = F.WqT(); const float* const gatt = F.attn_out_norm(); const float* const gssm = F.ssm_out_norm();
      for (int it = gw; it < NITEMS; it += NGW) {
        int r = it;
        if (r < I_IN) { const int n0_ = 32 * (r % ((IN_PROJ + 31) / 32));
            if (n0_ >= F8_LO && n0_ < F8_HI) p0_transpose_item(w_in, DM, IN_PROJ, (bf16*)WinT8, nullptr, scr, r, lane, SW8, F8_LO);
            else p0_transpose_item(w_in, DM, IN_PROJ, WinT, nullptr, scr, r, lane, 0.f, (n0_ >= F8_HI) ? (F8_HI - F8_LO) : 0);
            continue; } r -= I_IN;
      } }
    const size_t gt = (size_t)blockIdx.x * (NWAVES * 64) + tid, GT = (size_t)F.G * NWAVES * 64;
    { const size_t z0 = (size_t)(5664 - (F8_HI - F8_LO)) * DM / 8, z1 = (size_t)NB16 * DM / 8; GAS v4u* p = (GAS v4u*)F.WinT(); for (size_t i = z0 + gt; i < z1; i += GT) p[i] = (v4u){0u, 0u, 0u, 0u}; }
    { const float* const s = F.peer_sk(); GAS v4u* d = (GAS v4u*)F.SK();
      for (size_t o = gt; o < (size_t)16 * 128 * 128 / 8; o += GT) { const int frag = (int)(o >> 6), l = (int)(o & 63), g_ = l >> 4, c_ = l & 15, p_ = frag >> 5, kb_ = (frag >> 2) & 7, ks_ = frag & 3;
          const GAS f32x4* sp = (const GAS f32x4*)(s + (size_t)(p_ * 128 + 16 * kb_ + c_) * 128 + 32 * ks_ + 8 * g_); const f32x4 a = sp[0], b = sp[1];
          v4u w; w.x = pk2(a.x, a.y); w.y = pk2(a.z, a.w); w.z = pk2(b.x, b.y); w.w = pk2(b.z, b.w); d[o] = w; } }
    { const float* const xg = F.x(); const float* const gn = F.attn_norm(); bf16* const hn = F.HN(); unsigned char* const hn8 = F.HN8();
      for (int m = gw; m < MTOK / 2; m += NGW) rms_2rows_to_bf16(xg + (size_t)(2 * m) * DM, xg + (size_t)(2 * m + 1) * DM, gn, hn + (size_t)(2 * m) * DM, hn + (size_t)(2 * m + 1) * DM, hn8 + (size_t)(2 * m) * DM, hn8 + (size_t)(2 * m + 1) * DM, lane); }
}

struct EpiProj {
    static constexpr bool PERM = true, AFTER_DRAIN = false, SEG = false;
    bf16* O; float* dtraw; float* kmean;
    __device__ __forceinline__ void operator()(const pg8::f32x4 (&acc)[2][2][4][2], const pg8::Unit& u, int wr, int wc, int fr, int fq) const {
        const int rpn = (u.pn < F8_LO / 256) ? u.pn : u.pn + (F8_HI - F8_LO) / 256;
        const int row0 = u.pm * 256 + wr * 64 + fr, col0 = rpn * 256 + wc * 32 + 8 * fq;
        if (rpn < 22) {
#pragma unroll
            for (int ai = 0; ai < 2; ++ai)
#pragma unroll
                for (int m = 0; m < 4; ++m) { bf16* rowp = O + (size_t)(row0 + ai * 128 + m * 16) * NPROJ + col0;
#pragma unroll
                    for (int bj = 0; bj < 2; ++bj) { const pg8::f32x4 v0 = acc[ai][bj][m][0], v1 = acc[ai][bj][m][1];
                        pg8::u32x4 w; w.x = pg8::cvt_pk_bf16(v0[0], v0[1]); w.y = pg8::cvt_pk_bf16(v0[2], v0[3]); w.z = pg8::cvt_pk_bf16(v1[0], v1[1]); w.w = pg8::cvt_pk_bf16(v1[2], v1[3]);
                        *(pg8::u32x4*)(rowp + bj * 128) = w; } }
        } else if (wc == 0 && fq < 2) {
#pragma unroll
            for (int ai = 0; ai < 2; ++ai)
#pragma unroll
                for (int m = 0; m < 4; ++m) { float* rp = dtraw + (size_t)(row0 + ai * 128 + m * 16) * 16 + 8 * fq;
                    *(pg8::f32x4*)rp = acc[ai][0][m][0]; *(pg8::f32x4*)(rp + 4) = acc[ai][0][m][1]; }
        }
        if (kmean && u.pn >= 4 && u.pn < 8) {
#pragma unroll
            for (int bj = 0; bj < 2; ++bj)
#pragma unroll
                for (int n = 0; n < 2; ++n)
#pragma unroll
                    for (int i = 0; i < 4; ++i) { float s = 0.f;
#pragma unroll
                        for (int ai = 0; ai < 2; ++ai)
#pragma unroll
                            for (int m = 0; m < 4; ++m) s += acc[ai][bj][m][n][i];
                        s += __shfl_xor(s, 1); s += __shfl_xor(s, 2); s += __shfl_xor(s, 4); s += __shfl_xor(s, 8);
                        if (fr == 0) unsafeAtomicAdd(kmean + (size_t)u.pm * 1024 + (col0 - 1024) + bj * 128 + 4 * n + i, s); }
        }
    }
};
struct EpiProj8 {
    static constexpr bool PERM = true, AFTER_DRAIN = false, SEG = false;
    bf16* O;
    __device__ __forceinline__ void operator()(const pg8::f32x4 (&acc)[2][2][4][2], const pg8::Unit& u, int wr, int wc, int fr, int fq) const {
        const int row0 = u.pm * 256 + wr * 64 + fr, col0 = F8_LO + u.pn * 256 + wc * 32 + 8 * fq; constexpr float sc = 1.f / (SH8 * SW8);
#pragma unroll
        for (int ai = 0; ai < 2; ++ai)
#pragma unroll
            for (int m = 0; m < 4; ++m) { bf16* rowp = O + (size_t)(row0 + ai * 128 + m * 16) * NPROJ + col0;
#pragma unroll
                for (int bj = 0; bj < 2; ++bj) { const pg8::f32x4 v0 = acc[ai][bj][m][0] * sc, v1 = acc[ai][bj][m][1] * sc;
                    pg8::u32x4 w; w.x = pg8::cvt_pk_bf16(v0[0], v0[1]); w.y = pg8::cvt_pk_bf16(v0[2], v0[3]); w.z = pg8::cvt_pk_bf16(v1[0], v1[1]); w.w = pg8::cvt_pk_bf16(v1[2], v1[3]);
                    *(pg8::u32x4*)(rowp + bj * 128) = w; } }
    }
};
struct EpiOut {
    static constexpr bool PERM = true, AFTER_DRAIN = false, SEG = true; static constexpr int SEG_T1 = 8, SEG_T2 = 12;
    const float* x; bf16* x1b; unsigned char* x18; float* ssq; bool doatom; const LAS f32x4* tab;
    __device__ __forceinline__ void seg_load(int ui, int wr, int fr, float (&sr)[16]) const {
#pragma unroll
        for (int i = 0; i < 8; ++i) { const int r = (i >> 2) * 128 + wr * 64 + (i & 3) * 16 + fr; const f32x2 q = *(const LAS f32x2*)(tab + ui * 256 + r); sr[2 * i] = q.x; sr[2 * i + 1] = q.y; }
        asm volatile("s_waitcnt lgkmcnt(0)" ::: "memory");
    }
    __device__ __forceinline__ void seg_apply(pg8::f32x4 (&acc)[2][2][4][2], const float (&sr)[16], int which) const {
#pragma unroll
        for (int ai = 0; ai < 2; ++ai)
#pragma unroll
            for (int m = 0; m < 4; ++m) { const float f = (which == 0) ? sr[2 * (ai * 4 + m)] : ((which == 1) ? sr[2 * (ai * 4 + m) + 1] : 1.0f);
#pragma unroll
                for (int bj = 0; bj < 2; ++bj)
#pragma unroll
                    for (int n = 0; n < 2; ++n) acc[ai][bj][m][n] = acc[ai][bj][m][n] * f; }
    }
    __device__ __forceinline__ void operator()(const pg8::f32x4 (&acc)[2][2][4][2], const pg8::Unit& u, int wr, int wc, int fr, int fq, int ui) const {
        const int row0 = u.pm * 256 + wr * 64 + fr, col0 = u.pn * 256 + wc * 32 + 8 * fq;
#pragma unroll
        for (int ai = 0; ai < 2; ++ai)
#pragma unroll
            for (int m = 0; m < 4; ++m) { const int row = row0 + ai * 128 + m * 16; const size_t off = (size_t)row * DM + col0; float s = 0.f;
                const float s1 = (*(const LAS f32x4*)(tab + ui * 256 + ai * 128 + wr * 64 + m * 16 + fr)).z;
#pragma unroll
                for (int bj = 0; bj < 2; ++bj) {
                    const pg8::f32x4 a0 = *(const pg8::f32x4*)(x + off + bj * 128), a1 = *(const pg8::f32x4*)(x + off + bj * 128 + 4);
                    const pg8::f32x4 v0 = acc[ai][bj][m][0] * s1 + a0, v1 = acc[ai][bj][m][1] * s1 + a1;
                    pg8::u32x4 w; w.x = pg8::cvt_pk_bf16(v0[0], v0[1]); w.y = pg8::cvt_pk_bf16(v0[2], v0[3]); w.z = pg8::cvt_pk_bf16(v1[0], v1[1]); w.w = pg8::cvt_pk_bf16(v1[2], v1[3]);
                    *(pg8::u32x4*)(x1b + off + bj * 128) = w;
                    { v2u o8; int w_; w_ = __builtin_amdgcn_cvt_pk_fp8_f32(clampf(v0[0] * SX8, 448.f), clampf(v0[1] * SX8, 448.f), 0, false); w_ = __builtin_amdgcn_cvt_pk_fp8_f32(clampf(v0[2] * SX8, 448.f), clampf(v0[3] * SX8, 448.f), w_, true); o8.x = (unsigned)w_;
                      w_ = __builtin_amdgcn_cvt_pk_fp8_f32(clampf(v1[0] * SX8, 448.f), clampf(v1[1] * SX8, 448.f), 0, false); w_ = __builtin_amdgcn_cvt_pk_fp8_f32(clampf(v1[2] * SX8, 448.f), clampf(v1[3] * SX8, 448.f), w_, true); o8.y = (unsigned)w_;
                      *(v2u*)(x18 + off + bj * 128) = o8; }
                    s += (v0[0] * v0[0] + v0[1] * v0[1]) + (v0[2] * v0[2] + v0[3] * v0[3]) + (v1[0] * v1[0] + v1[1] * v1[1]) + (v1[2] * v1[2] + v1[3] * v1[3]); }
                s += __shfl_xor(s, 16); s += __shfl_xor(s, 32);
                if (fq == 0 && doatom) unsafeAtomicAdd(ssq + (size_t)row * 4, s);
                asm volatile("" ::: "memory"); }
    }
};
struct EpiQ {
    static constexpr bool PERM = true, AFTER_DRAIN = false, SEG = false;
    bf16* O; const float* ssq;
    __device__ __forceinline__ void operator()(const pg8::f32x4 (&acc)[2][2][4][2], const pg8::Unit& u, int wr, int wc, int fr, int fq) const {
        const int row0 = u.pm * 256 + wr * 64 + fr, col0 = u.pn * 256 + wc * 32 + 8 * fq;
#pragma unroll
        for (int ai = 0; ai < 2; ++ai)
#pragma unroll
            for (int m = 0; m < 4; ++m) { const int row = row0 + ai * 128 + m * 16; bf16* rowp = O + (size_t)row * DM + col0;
                const float rs = (1.f / (SX8 * SW8)) / sqrtf(__hip_atomic_load(ssq + (size_t)row * 4, RLX_AGENT) * (1.f / DM) + EPS);
#pragma unroll
                for (int bj = 0; bj < 2; ++bj) { const pg8::f32x4 v0 = acc[ai][bj][m][0] * rs, v1 = acc[ai][bj][m][1] * rs;
                    pg8::u32x4 w; w.x = pg8::cvt_pk_bf16(v0[0], v0[1]); w.y = pg8::cvt_pk_bf16(v0[2], v0[3]); w.z = pg8::cvt_pk_bf16(v1[0], v1[1]); w.w = pg8::cvt_pk_bf16(v1[2], v1[3]);
                    *(pg8::u32x4*)(rowp + bj * 128) = w; } }
    }
};

constexpr int A_KSTR = 272, A_VSTR = 288;
constexpr int A_KB0 = 0, A_KB1 = 64 * A_KSTR, A_VB0 = 2 * 64 * A_KSTR, A_VBS = 64 * A_VSTR  , A_KM = A_VB0 + 3 * A_VBS, A_TAB = A_KM + 8 * 128 * 4, A_END = A_TAB + 128 * 4;
static_assert(A_END <= RING_BYTES && (A_KM % 16) == 0, "attention LDS map");
#define PIN16(a, i) asm volatile("" : "+v"(a[i]), "+v"(a[i + 1]), "+v"(a[i + 2]), "+v"(a[i + 3]), "+v"(a[i + 4]), "+v"(a[i + 5]), "+v"(a[i + 6]), "+v"(a[i + 7]), "+v"(a[i + 8]), "+v"(a[i + 9]), "+v"(a[i + 10]), "+v"(a[i + 11]), "+v"(a[i + 12]), "+v"(a[i + 13]), "+v"(a[i + 14]), "+v"(a[i + 15]))
#define TR16(p) __builtin_amdgcn_ds_read_tr16_b64_v4i16((LAS s16x4*)(p))
#define MFMA16(a, b, c) __builtin_amdgcn_mfma_f32_16x16x32_bf16((a), (b), (c), 0, 0, 0)
__device__ __forceinline__ bf16x8 pack8(const float* v) {
    const unsigned a = pk2(v[0], v[1]), b = pk2(v[2], v[3]), c = pk2(v[4], v[5]), d = pk2(v[6], v[7]);
    const v4u u = {a, b, c, d}; return __builtin_bit_cast(bf16x8, u);
}
__device__ __forceinline__ void attn_unit(Frame& F, int b, int h, int blk, const bool doatom = true) {
    LAS unsigned char* lds = F.lds + RING_OFF;
    const int tid = fresh_tid(), lane = tid & 63, w = __builtin_amdgcn_readfirstlane(tid >> 6), g = lane >> 4, c16 = lane & 15, q4 = c16 >> 2, p4 = lane & 3;
    const int own = blk, t0 = blk * 256, tq0 = t0 + 32 * w + c16;
    const size_t rowbase = (size_t)b * SEQ;
    const float NEG_INF = -__builtin_inff();
    constexpr float LOG2E = 1.4426950408889634f, SCL2 = 0.08838834764831845f * 1.4426950408889634f;
    LAS float* km = (LAS float*)(lds + A_KM); LAS float* tab = (LAS float*)(lds + A_TAB);
    const bf16* const PROJ = F.PROJ(); const float* const kmg = F.kmean(); const float* const relb = F.rel_bias();
    for (int i = tid; i < own * 128; i += NWAVES * 64) { const int n = i >> 7, d = i & 127; km[i] = kmg[(size_t)(b * 8 + n) * 1024 + h * 128 + d] * (1.f / 256.f); }
    if (tid < 128) { const int rel = tid; int bucket = rel; if (rel >= 16) { bucket = 16 + (int)(log2f((float)rel * (1.f / 16.f)) * (16.f / 3.f)); bucket = bucket > 31 ? 31 : bucket; }
        tab[tid] = relb[bucket * 8 + h] * LOG2E; }
    bf16x8 qf[2][4];
#pragma unroll
    for (int gi = 0; gi < 2; ++gi) { const bf16* qrow = PROJ + (rowbase + tq0 + 16 * gi) * NPROJ + COL_Q + h * 128 + 8 * g;
#pragma unroll
      for (int ks = 0; ks < 4; ++ks) qf[gi][ks] = *(const GAS bf16x8*)(qrow + 32 * ks); }
    __syncthreads();
    unsigned selmask[2];
    if (own <= 3) { selmask[0] = (1u << own) - 1u; selmask[1] = selmask[0]; }
    else {
#pragma unroll
      for (int gi = 0; gi < 2; ++gi) {
        float gate[7];
#pragma unroll
        for (int n = 0; n < 7; ++n) {
            float s = NEG_INF;
            if (n < own) { s = 0.f;
#pragma unroll
                for (int ks = 0; ks < 4; ++ks) { const LAS f32x4* kp = (const LAS f32x4*)(km + n * 128 + 32 * ks + 8 * g); const f32x4 k0 = kp[0], k1 = kp[1]; const v4u qu = __builtin_bit_cast(v4u, qf[gi][ks]);
                    s += bflo(qu.x) * k0.x + bfhi(qu.x) * k0.y + bflo(qu.y) * k0.z + bfhi(qu.y) * k0.w + bflo(qu.z) * k1.x + bfhi(qu.z) * k1.y + bflo(qu.w) * k1.z + bfhi(qu.w) * k1.w; }
                s += __shfl_xor(s, 16); s += __shfl_xor(s, 32); }
            gate[n] = s;
        }
        unsigned sm = 0u;
#pragma unroll
        for (int r = 0; r < 3; ++r) { float best = NEG_INF; int bi = 0;
#pragma unroll
            for (int n = 0; n < 7; ++n) { const bool cand = (n < own) && !((sm >> n) & 1u) && (gate[n] > best); best = cand ? gate[n] : best; bi = cand ? n : bi; }
            sm |= 1u << bi; }
        selmask[gi] = sm; }
    }
    const int nT = 4 + 4 * own;
    const int sr = tid >> 3, sc = (tid & 7) * 8;
#define A_KEY0(i) ((i) < 4 ? own * 256 + 64 * (i) : (((i) - 4) >> 2) * 256 + (((i) - 4) & 3) * 64)
    v4u kr0, kr1, vr0, vr1;
#define A_LOAD(i) do { const bf16* kp_ = PROJ + (rowbase + A_KEY0(i) + sr) * NPROJ + COL_K + h * 128 + sc; \
        kr0 = *(const GAS v4u*)kp_; kr1 = *(const GAS v4u*)(kp_ + 64); vr0 = *(const GAS v4u*)(kp_ + (COL_V - COL_K)); vr1 = *(const GAS v4u*)(kp_ + (COL_V - COL_K) + 64); } while (0)
#define A_STORE(bufi) do { LAS unsigned char* kd_ = lds + ((bufi) ? A_KB1 : A_KB0) + sr * A_KSTR + sc * 2; LAS unsigned char* vd_ = lds + A_VB0 + vnx * A_VBS + sr * A_VSTR + sc * 2; \
        *(LAS v4u*)kd_ = kr0; *(LAS v4u*)(kd_ + 128) = kr1; *(LAS v4u*)vd_ = vr0; *(LAS v4u*)(vd_ + 128) = vr1; } while (0)
    int vcur = 0, vnx = 0, vprev = 0;
#define A_PV(PF, Vb_) do { _Pragma("unroll") for (int s = 0; s < 2; ++s) { s16x4 vlo[8], vhi[8]; \
            _Pragma("unroll") for (int db = 0; db < 8; ++db) { LAS unsigned char* va = (Vb_) + (32 * s + 4 * g + q4) * A_VSTR + (16 * db + 4 * p4) * 2; vlo[db] = TR16(va); vhi[db] = TR16(va + 16 * A_VSTR); } \
            __builtin_amdgcn_sched_barrier(0); \
            _Pragma("unroll") for (int db = 0; db < 8; ++db) { const bf16x8 vf = __builtin_shufflevector(vlo[db], vhi[db], 0, 1, 2, 3, 4, 5, 6, 7); \
                oacc[0][db] = MFMA16(vf, PF[0][s], oacc[0][db]); oacc[1][db] = MFMA16(vf, PF[1][s], oacc[1][db]); } \
            __builtin_amdgcn_sched_barrier(0); } } while (0)
    A_LOAD(0); A_STORE(0);
    __syncthreads();
    const bool late = w >= 4;
    bf16x8 pfp[2][2]; bool skipp = true;
#pragma unroll
    for (int gi = 0; gi < 2; ++gi) { pfp[gi][0] = (bf16x8){0, 0, 0, 0, 0, 0, 0, 0}; pfp[gi][1] = pfp[gi][0]; }
    float m_run[2] = {NEG_INF, NEG_INF}, l_run[2] = {0.f, 0.f};
    f32x4 oacc[2][8];
#pragma unroll
    for (int gi = 0; gi < 2; ++gi)
#pragma unroll
        for (int db = 0; db < 8; ++db) oacc[gi][db] = (f32x4){0.f, 0.f, 0.f, 0.f};
    for (int i = 0; i < nT; ++i) {
        if (i + 1 < nT) A_LOAD(i + 1);
        vnx = (vcur == 2) ? 0 : vcur + 1;
        const int buf = i & 1, key0 = A_KEY0(i); const bool isown = i < 4; const int pblk = isown ? own : ((i - 4) >> 2);
        const bool skipw = isown && (64 * i > 32 * w + 31);
        if (late && !skipp) A_PV(pfp, lds + A_VB0 + vprev * A_VBS);
        bf16x8 pf[2][2];
        if (!skipw) {
        LAS unsigned char* Kb = lds + (buf ? A_KB1 : A_KB0);
        f32x4 sacc[2][4];
#pragma unroll
        for (int hf = 0; hf < 2; ++hf) { bf16x8 kf[8];
#pragma unroll
            for (int n2 = 0; n2 < 2; ++n2)
#pragma unroll
                for (int ks = 0; ks < 4; ++ks) kf[n2 * 4 + ks] = *(const LAS bf16x8*)(Kb + (16 * (2 * hf + n2) + c16) * A_KSTR + (32 * ks + 8 * g) * 2);
            __builtin_amdgcn_sched_barrier(0);
#pragma unroll
            for (int gi = 0; gi < 2; ++gi)
#pragma unroll
                for (int n2 = 0; n2 < 2; ++n2) { f32x4 a = (f32x4){0.f, 0.f, 0.f, 0.f};
#pragma unroll
                    for (int ks = 0; ks < 4; ++ks) a = MFMA16(kf[n2 * 4 + ks], qf[gi][ks], a);
                    sacc[gi][2 * hf + n2] = a; }
            __builtin_amdgcn_sched_barrier(0); }
        const bool far = (key0 + 63 + 128 <= t0 + 32 * w);
        const bool diag = isown && (64 * i + 63 > 32 * w);
#pragma unroll
        for (int gi = 0; gi < 2; ++gi) {
            const int tq = tq0 + 16 * gi; const bool sel = isown || ((selmask[gi] >> pblk) & 1u);
            float sv[16]; float mloc, m_new, alpha;
            if (far) {
                const float bfar = tab[127];
                float mx = fmaxf(fmaxf(sacc[gi][0][0], sacc[gi][0][1]), fmaxf(sacc[gi][0][2], sacc[gi][0][3]));
#pragma unroll
                for (int nb = 1; nb < 4; ++nb) mx = fmaxf(mx, fmaxf(fmaxf(sacc[gi][nb][0], sacc[gi][nb][1]), fmaxf(sacc[gi][nb][2], sacc[gi][nb][3])));
                mloc = sel ? (mx * SCL2 + bfar) : NEG_INF;
                mloc = fmaxf(mloc, __shfl_xor(mloc, 16)); mloc = fmaxf(mloc, __shfl_xor(mloc, 32));
                m_new = fmaxf(m_run[gi], mloc); alpha = __builtin_amdgcn_exp2f(m_run[gi] - m_new);
                const float cadd = sel ? (bfar - m_new) : NEG_INF;
#pragma unroll
                for (int nb = 0; nb < 4; ++nb)
#pragma unroll
                    for (int r = 0; r < 4; ++r) sv[nb * 4 + r] = __builtin_amdgcn_exp2f(sacc[gi][nb][r] * SCL2 + cadd);
            } else {
                const int relb = tq - key0 - 4 * g; float bias[16];
#pragma unroll
                for (int nb = 0; nb < 4; ++nb)
#pragma unroll
                    for (int r = 0; r < 4; ++r) { const int rel = relb - 16 * nb - r; int ri = rel < 0 ? 0 : rel; ri = ri > 127 ? 127 : ri; bias[nb * 4 + r] = tab[ri]; }
                PIN16(bias, 0);
                mloc = NEG_INF;
#pragma unroll
                for (int nb = 0; nb < 4; ++nb)
#pragma unroll
                    for (int r = 0; r < 4; ++r) { const int rel = relb - 16 * nb - r;
                        float s = sacc[gi][nb][r] * SCL2 + bias[nb * 4 + r]; s = (!sel || (diag && rel < 0)) ? NEG_INF : s; sv[nb * 4 + r] = s; mloc = fmaxf(mloc, s); }
                mloc = fmaxf(mloc, __shfl_xor(mloc, 16)); mloc = fmaxf(mloc, __shfl_xor(mloc, 32));
                m_new = fmaxf(m_run[gi], mloc); alpha = __builtin_amdgcn_exp2f(m_run[gi] - m_new);
#pragma unroll
                for (int e = 0; e < 16; ++e) sv[e] = __builtin_amdgcn_exp2f(sv[e] - m_new);
            }
            float psum = 0.f;
#pragma unroll
            for (int e = 0; e < 16; ++e) psum += sv[e];
            l_run[gi] = l_run[gi] * alpha + psum; m_run[gi] = m_new;
#pragma unroll
            for (int db = 0; db < 8; ++db) oacc[gi][db] = oacc[gi][db] * alpha;
            pf[gi][0] = pack8(sv); pf[gi][1] = pack8(sv + 8);
        }
        __builtin_amdgcn_sched_barrier(0);
        if (!late) A_PV(pf, lds + A_VB0 + vcur * A_VBS);
        }
        if (late) { skipp = skipw;
#pragma unroll
            for (int gi = 0; gi < 2; ++gi) { pfp[gi][0] = pf[gi][0]; pfp[gi][1] = pf[gi][1]; } }
        if (i + 1 < nT) A_STORE((i + 1) & 1);
        vprev = vcur; vcur = vnx;
        __syncthreads();
    }
    if (late && !skipp) A_PV(pfp, lds + A_VB0 + vprev * A_VBS);
#undef A_PV
    bf16* const MIXp = F.HN(); float* const ssqp = F.ssq();
#pragma unroll
    for (int gi = 0; gi < 2; ++gi) {
        const int tq = tq0 + 16 * gi;
        float l_tot = l_run[gi]; l_tot += __shfl_xor(l_tot, 16); l_tot += __shfl_xor(l_tot, 32);
        const float inv = 1.f / l_tot; float ssq = 0.f;
        unsigned char* orow = (unsigned char*)MIXp + (rowbase + tq) * DM + h * 128 + 4 * g;
#pragma unroll
        for (int db = 0; db < 8; ++db) { const f32x4 o = oacc[gi][db] * inv; ssq += (o.x * o.x + o.y * o.y) + (o.z * o.z + o.w * o.w); *(GAS unsigned*)(orow + 16 * db) = pk4_fp8(o.x * SA8, o.y * SA8, o.z * SA8, o.w * SA8); }
        ssq += __shfl_xor(ssq, 16); ssq += __shfl_xor(ssq, 32);
        if (g == 0 && doatom) unsafeAtomicAdd(ssqp + (rowbase + tq) * 4 + 1, ssq);
    }
#undef A_KEY0
#undef A_LOAD
#undef A_STORE
}

constexpr int XBC_W = CONV_CH;
__device__ __forceinline__ void conv_phase(Frame& F) {
    const bf16* const PROJ = F.PROJ(); bf16* const XBC = F.XBC(); const float* const cw = F.conv_w(); const float* const cb = F.conv_b();
    const int gt = blockIdx.x * (NWAVES * 64) + fresh_tid(), GT = F.G * NWAVES * 64;
    for (int task = gt; task < (MTOK / 32) * (CONV_CH / 8); task += GT) {
        const int r = task / (CONV_CH / 8), k = task % (CONV_CH / 8), ch = 8 * k, tok0 = 32 * r;
        float wv[4][8], bias[8];
#pragma unroll
        for (int t = 0; t < 4; ++t) { const f32x4 w0 = *(const GAS f32x4*)(cw + t * CONV_CH + ch), w1 = *(const GAS f32x4*)(cw + t * CONV_CH + ch + 4);
            wv[t][0] = w0.x; wv[t][1] = w0.y; wv[t][2] = w0.z; wv[t][3] = w0.w; wv[t][4] = w1.x; wv[t][5] = w1.y; wv[t][6] = w1.z; wv[t][7] = w1.w; }
        { const f32x4 b0 = *(const GAS f32x4*)(cb + ch), b1 = *(const GAS f32x4*)(cb + ch + 4); bias[0] = b0.x; bias[1] = b0.y; bias[2] = b0.z; bias[3] = b0.w; bias[4] = b1.x; bias[5] = b1.y; bias[6] = b1.z; bias[7] = b1.w; }
        const bf16* src = PROJ + (size_t)tok0 * NPROJ + COL_XBC + ch; bf16* dst = XBC + (size_t)tok0 * XBC_W + ch;
        v4u p0 = (v4u){0u, 0u, 0u, 0u}, p1 = p0, p2 = p0;
        if ((tok0 & (SEQ - 1)) != 0) { p0 = *(const GAS v4u*)(src - 3 * (ptrdiff_t)NPROJ); p1 = *(const GAS v4u*)(src - 2 * (ptrdiff_t)NPROJ); p2 = *(const GAS v4u*)(src - (ptrdiff_t)NPROJ); }
#pragma unroll 1
        for (int i0 = 0; i0 < 32; i0 += 8) {
            v4u cur[8];
#pragma unroll
            for (int i = 0; i < 8; ++i) cur[i] = *(const GAS v4u*)(src + (size_t)(i0 + i) * NPROJ);
#pragma unroll
            for (int i = 0; i < 8; ++i) {
                const v4u c = cur[i]; float acc[8];
                const unsigned a0[4] = {p0.x, p0.y, p0.z, p0.w}, a1[4] = {p1.x, p1.y, p1.z, p1.w}, a2[4] = {p2.x, p2.y, p2.z, p2.w}, a3[4] = {c.x, c.y, c.z, c.w};
#pragma unroll
                for (int j = 0; j < 4; ++j) {
                    acc[2 * j] = bias[2 * j] + wv[0][2 * j] * bflo(a0[j]) + wv[1][2 * j] * bflo(a1[j]) + wv[2][2 * j] * bflo(a2[j]) + wv[3][2 * j] * bflo(a3[j]);
                    acc[2 * j + 1] = bias[2 * j + 1] + wv[0][2 * j + 1] * bfhi(a0[j]) + wv[1][2 * j + 1] * bfhi(a1[j]) + wv[2][2 * j + 1] * bfhi(a2[j]) + wv[3][2 * j + 1] * bfhi(a3[j]); }
#pragma unroll
                for (int j = 0; j < 8; ++j) acc[j] = silu_f(acc[j]);
                v4u o; o.x = pk2(acc[0], acc[1]); o.y = pk2(acc[2], acc[3]); o.z = pk2(acc[4], acc[5]); o.w = pk2(acc[6], acc[7]);
                *(GAS v4u*)(dst + (size_t)(i0 + i) * XBC_W) = o;
                p0 = p1; p1 = p2; p2 = c; }
        }
    }
    { const float* const dtraw = F.dtraw(); float* const dt2 = F.DT2(); const float* const dtb = F.dt_bias();
      for (int i = gt; i < MTOK * 16; i += GT) { const float xr = dtraw[i] + dtb[i & 15]; dt2[i] = xr > 20.f ? xr : log1pf(__expf(xr)); } }
}

constexpr int S_BSTR = 272, S_XSTR = 144;
constexpr int S_BM = 0, S_CM = 128 * S_BSTR, S_X = 2 * 128 * S_BSTR, S_XW = S_X + 128 * S_XSTR, S_HB = S_XW + 128 * S_XSTR, S_DT = S_HB + 64 * S_BSTR, S_CS = S_DT + 512, S_DA = S_CS + 512, S_END = S_DA + 512;
static_assert(S_END <= RING_BYTES, "ssd LDS map");
__device__ __forceinline__ void ssd_unit(Frame& F, int b, int h, const bool doatom = true) {
    LAS unsigned char* lds = F.lds + RING_OFF;
    const int tid = fresh_tid(), lane = tid & 63, w = __builtin_amdgcn_readfirstlane(tid >> 6), g = lane >> 4, c16 = lane & 15, q4 = c16 >> 2, p4 = lane & 3;
    const int g8 = h >> 3, pbw = w & 3, nhw = w >> 2;
    const float a_h = -__expf(F.a_log()[h]), dsk = F.d_skip()[h];
    const bf16* const PROJ = F.PROJ(); bf16* const MIX = F.HN(); const float* const dt2 = F.DT2(); const bf16* const XBC = F.XBC(); float* const ssqp = F.ssq();
    LAS float* dtl = (LAS float*)(lds + S_DT); LAS float* csl = (LAS float*)(lds + S_CS); LAS float* dal = (LAS float*)(lds + S_DA);
    for (int i = tid; i < 64 * S_BSTR / 16; i += NWAVES * 64) ((LAS v4u*)(lds + S_HB))[i] = (v4u){0u, 0u, 0u, 0u};
    f32x4 hacc[4];
#pragma unroll
    for (int i = 0; i < 4; ++i) hacc[i] = (f32x4){0.f, 0.f, 0.f, 0.f};
    const int xl = tid >> 3, xc = tid & 7, bl = tid >> 4, bc = tid & 15;
    v4u xr[2], br[4], cr[4]; float dtv = 0.f;
#define S_PREFETCH(cc) do { const size_t t0_ = (size_t)b * SEQ + (size_t)(cc) * SSM_L; \
        _Pragma("unroll") for (int i_ = 0; i_ < 2; ++i_) xr[i_] = *(const GAS v4u*)(XBC + (t0_ + xl + 64 * i_) * XBC_W + h * 64 + 8 * xc); \
        _Pragma("unroll") for (int i_ = 0; i_ < 4; ++i_) { const bf16* p_ = XBC + (t0_ + bl + 32 * i_) * XBC_W + 1024 + g8 * 128 + 8 * bc; br[i_] = *(const GAS v4u*)p_; cr[i_] = *(const GAS v4u*)(p_ + 256); } \
        if (tid < 128) dtv = dt2[(t0_ + tid) * 16 + h]; } while (0)
    S_PREFETCH(0);
    for (int c = 0; c < SSM_NC; ++c) {
        const size_t tok0 = (size_t)b * SEQ + (size_t)c * SSM_L;
        if (tid < 128) { dtl[tid] = dtv; dal[tid] = dtv * a_h; }
        __syncthreads();
        { const float v0 = dal[2 * lane], v1 = dal[2 * lane + 1]; float s = v0 + v1;
#pragma unroll
            for (int o = 1; o < 64; o <<= 1) { const float t = __shfl_up(s, o); s += (lane >= o) ? t : 0.f; }
            csl[2 * lane] = s - v1; csl[2 * lane + 1] = s; }
        LDS_WAIT(); asm volatile("" ::: "memory");
        const float cs_last = csl[127];
#pragma unroll
        for (int i = 0; i < 2; ++i) { const int l = xl + 64 * i; const v4u v = xr[i]; *(LAS v4u*)(lds + S_X + l * S_XSTR + xc * 16) = v; const float wl = dtl[l] * __expf(cs_last - csl[l]);
            v4u o2; o2.x = pk2(bflo(v.x) * wl, bfhi(v.x) * wl); o2.y = pk2(bflo(v.y) * wl, bfhi(v.y) * wl); o2.z = pk2(bflo(v.z) * wl, bfhi(v.z) * wl); o2.w = pk2(bflo(v.w) * wl, bfhi(v.w) * wl);
            *(LAS v4u*)(lds + S_XW + l * S_XSTR + xc * 16) = o2; }
#pragma unroll
        for (int i = 0; i < 4; ++i) { const int l = bl + 32 * i; *(LAS v4u*)(lds + S_BM + l * S_BSTR + bc * 16) = br[i]; *(LAS v4u*)(lds + S_CM + l * S_BSTR + bc * 16) = cr[i]; }
        const int lrow = 16 * w + c16;
        v2u zr[4];
#pragma unroll
        for (int pb = 0; pb < 4; ++pb) zr[pb] = *(const GAS v2u*)(PROJ + (tok0 + lrow) * NPROJ + COL_Z + h * 64 + 16 * pb + 4 * g);
        if (c + 1 < SSM_NC) S_PREFETCH(c + 1);
        __syncthreads();
        bf16x8 cf[4];
#pragma unroll
        for (int ks = 0; ks < 4; ++ks) cf[ks] = *(const LAS bf16x8*)(lds + S_CM + lrow * S_BSTR + (32 * ks + 8 * g) * 2);
        f32x4 yacc[4];
        const float cs_l = csl[lrow]; const float el = __expf(cs_l);
#pragma unroll
        for (int pb = 0; pb < 4; ++pb) { yacc[pb] = (f32x4){0.f, 0.f, 0.f, 0.f};
#pragma unroll
            for (int ks = 0; ks < 4; ++ks) { const bf16x8 hf = *(const LAS bf16x8*)(lds + S_HB + (16 * pb + c16) * S_BSTR + (32 * ks + 8 * g) * 2); yacc[pb] = MFMA16(hf, cf[ks], yacc[pb]); }
            yacc[pb] = yacc[pb] * el; }
        for (int s2 = 0; s2 <= (w >> 1); ++s2) {
            const int sb0 = 2 * s2, sb1 = 2 * s2 + 1; const bool has1 = sb1 <= w;
            f32x4 cb0 = (f32x4){0.f, 0.f, 0.f, 0.f}, cb1 = (f32x4){0.f, 0.f, 0.f, 0.f};
#pragma unroll
            for (int ks = 0; ks < 4; ++ks) { const bf16x8 bf0 = *(const LAS bf16x8*)(lds + S_BM + (16 * sb0 + c16) * S_BSTR + (32 * ks + 8 * g) * 2); cb0 = MFMA16(bf0, cf[ks], cb0); }
            if (has1) {
#pragma unroll
                for (int ks = 0; ks < 4; ++ks) { const bf16x8 bf1 = *(const LAS bf16x8*)(lds + S_BM + (16 * sb1 + c16) * S_BSTR + (32 * ks + 8 * g) * 2); cb1 = MFMA16(bf1, cf[ks], cb1); } }
            float mv[8];
#pragma unroll
            for (int r = 0; r < 4; ++r) { const int s = 16 * sb0 + 4 * g + r; const float e = __expf(fminf(cs_l - csl[s], 0.f)) * dtl[s]; mv[r] = (s <= lrow) ? cb0[r] * e : 0.f; }
#pragma unroll
            for (int r = 0; r < 4; ++r) { const int s = 16 * sb1 + 4 * g + r; const int sc_ = s > 127 ? 127 : s; const float e = __expf(fminf(cs_l - csl[sc_], 0.f)) * dtl[sc_]; mv[4 + r] = (has1 && s <= lrow) ? cb1[r] * e : 0.f; }
            const bf16x8 pf = pack8(mv);
#pragma unroll
            for (int pb = 0; pb < 4; ++pb) { LAS unsigned char* xa = lds + S_X + (32 * s2 + 4 * g + q4) * S_XSTR + (16 * pb + 4 * p4) * 2;
                const s16x4 lo = TR16(xa), hi = TR16(xa + 16 * S_XSTR); const bf16x8 xf = __builtin_shufflevector(lo, hi, 0, 1, 2, 3, 4, 5, 6, 7);
                yacc[pb] = MFMA16(xf, pf, yacc[pb]); }
        }
        { const size_t tok = tok0 + lrow; float ssq = 0.f;
#pragma unroll
          for (int pb = 0; pb < 4; ++pb) { const int p0 = 16 * pb + 4 * g;
              const v2u xs_ = *(const LAS v2u*)(lds + S_X + lrow * S_XSTR + p0 * 2);
              const v2u zr_ = zr[pb];
              const float o0 = (yacc[pb].x + bflo(xs_.x) * dsk) * silu_f(bflo(zr_.x)), o1 = (yacc[pb].y + bfhi(xs_.x) * dsk) * silu_f(bfhi(zr_.x));
              const float o2 = (yacc[pb].z + bflo(xs_.y) * dsk) * silu_f(bflo(zr_.y)), o3 = (yacc[pb].w + bfhi(xs_.y) * dsk) * silu_f(bfhi(zr_.y));
              ssq += (o0 * o0 + o1 * o1) + (o2 * o2 + o3 * o3);
              *(GAS unsigned*)((unsigned char*)MIX + tok * DM + ATT_W + h * 64 + p0) = pk4_fp8(o0 * SS8, o1 * SS8, o2 * SS8, o3 * SS8); }
          ssq += __shfl_xor(ssq, 16); ssq += __shfl_xor(ssq, 32);
          if (g == 0 && doatom) unsafeAtomicAdd(ssqp + tok * 4 + 2 + g8, ssq); }
        { const float cdec = __expf(cs_last);
#pragma unroll
          for (int i = 0; i < 4; ++i) hacc[i] = hacc[i] * cdec;
#pragma unroll
          for (int ks = 0; ks < 4; ++ks) {
              LAS unsigned char* xa = lds + S_XW + (32 * ks + 8 * g + q4) * S_XSTR + (16 * pbw + 4 * p4) * 2;
              const s16x4 xlo = TR16(xa), xhi = TR16(xa + 4 * S_XSTR); const bf16x8 xf = __builtin_shufflevector(xlo, xhi, 0, 1, 2, 3, 4, 5, 6, 7);
#pragma unroll
              for (int i = 0; i < 4; ++i) { const int nb = 4 * nhw + i; LAS unsigned char* ba = lds + S_BM + (32 * ks + 8 * g + q4) * S_BSTR + (16 * nb + 4 * p4) * 2;
                  const s16x4 blo = TR16(ba), bhi = TR16(ba + 4 * S_BSTR); const bf16x8 bfr = __builtin_shufflevector(blo, bhi, 0, 1, 2, 3, 4, 5, 6, 7);
                  hacc[i] = MFMA16(bfr, xf, hacc[i]); } } }
        __syncthreads();
#pragma unroll
        for (int i = 0; i < 4; ++i) { const int nb = 4 * nhw + i; v2u o; o.x = pk2(hacc[i].x, hacc[i].y); o.y = pk2(hacc[i].z, hacc[i].w);
            *(LAS v2u*)(lds + S_HB + (16 * pbw + c16) * S_BSTR + (16 * nb + 4 * g) * 2) = o; }
    }
#undef S_PREFETCH
    __syncthreads();
}

__device__ __forceinline__ void mix_normalize(Frame& F) {
    const int tid_ = fresh_tid(), lane = tid_ & 63; const int gw = blockIdx.x * NWAVES + __builtin_amdgcn_readfirstlane(tid_ >> 6), NGW = F.G * NWAVES;
    const float* const ssqp = F.ssq(); bf16* const MIX = F.HN(); const float* const gatt = F.attn_out_norm(); const float* const gssm = F.ssm_out_norm();
    for (int m = gw; m < MTOK; m += NGW) {
        const float* sq = ssqp + (size_t)m * 4;
        const float s1 = __hip_atomic_load(sq + 1, RLX_AGENT), s2 = __hip_atomic_load(sq + 2, RLX_AGENT), s3 = __hip_atomic_load(sq + 3, RLX_AGENT);
        const float ra = 1.f / sqrtf(s1 * (1.f / 1024.f) + EPS), r0 = 1.f / sqrtf(s2 * (1.f / 512.f) + EPS), r1 = 1.f / sqrtf(s3 * (1.f / 512.f) + EPS);
        GAS v4u* row = (GAS v4u*)(MIX + (size_t)m * DM);
#pragma unroll
        for (int j = 0; j < 4; ++j) { const int idx = lane + 64 * j, col = 8 * idx; const float rs = (j < 2) ? ra : ((j == 2) ? r0 : r1);
            const float* gp = (j < 2) ? (gatt + col) : (gssm + (col - ATT_W));
            const f32x4 g0 = *(const GAS f32x4*)gp, g1 = *(const GAS f32x4*)(gp + 4); const v4u v = row[idx]; v4u o;
            o.x = pk2(bflo(v.x) * rs * g0.x, bfhi(v.x) * rs * g0.y); o.y = pk2(bflo(v.y) * rs * g0.z, bfhi(v.y) * rs * g0.w);
            o.z = pk2(bflo(v.z) * rs * g1.x, bfhi(v.z) * rs * g1.y); o.w = pk2(bflo(v.w) * rs * g1.z, bfhi(v.w) * rs * g1.w); row[idx] = o; }
    }
}

constexpr size_t TAB_UNIT = 1024;
static_assert((TAB_ITEMS / 8) % TAB_UNIT == 0 && TAB_ITEMS % TAB_UNIT == 0, "table filler units");
constexpr int P_EIDX = 0, P_GATE = 16384, P_LST = 32768  , P_HN4 = 32768  , P_ACT = 98304  , P_END = 114688;
static_assert(P_END <= RING_BYTES, "peer LDS map");
__constant__ unsigned char PEER_CAND[52] = {0, 1, 2, 3, 4, 5, 6, 7, 8, 9, 10, 11, 12, 13, 14, 15, 16, 17, 18, 19, 20, 21, 22, 23, 32, 33, 34, 35, 36, 48, 49, 50, 51, 64, 65, 66, 80, 81, 96, 97, 112, 113, 128, 144, 160, 176, 192, 208, 224, 240, 255, 255};
__device__ __forceinline__ unsigned f2ord(float f) { const unsigned u = __builtin_bit_cast(unsigned, f); return u ^ ((u >> 31) ? 0xFFFFFFFFu : 0x80000000u); }
__device__ __forceinline__ float ord2f(unsigned u) { return __builtin_bit_cast(float, u ^ ((u >> 31) ? 0x80000000u : 0xFFFFFFFFu)); }
#define CSWAPD(a, b) do { const unsigned hi_ = (a) > (b) ? (a) : (b), lo_ = (a) > (b) ? (b) : (a); (a) = hi_; (b) = lo_; } while (0)
template <int N> __device__ __forceinline__ void bitonic_sort_desc(unsigned (&v)[N]) {
#pragma unroll
    for (int k = 2; k <= N; k <<= 1)
#pragma unroll
        for (int j = k >> 1; j > 0; j >>= 1)
#pragma unroll
            for (int i = 0; i < N; ++i) { const int l = i ^ j; if (l > i) { if ((i & k) == 0) CSWAPD(v[i], v[l]); else CSWAPD(v[l], v[i]); } }
}
__device__ __forceinline__ void merge16_xor(unsigned (&v)[16], int dist) {
    unsigned o[16];
#pragma unroll
    for (int i = 0; i < 16; ++i) o[i] = (unsigned)__shfl_xor((int)v[i], dist);
#pragma unroll
    for (int i = 0; i < 16; ++i) v[i] = v[i] > o[15 - i] ? v[i] : o[15 - i];
#pragma unroll
    for (int j = 8; j > 0; j >>= 1)
#pragma unroll
        for (int i = 0; i < 16; ++i) { const int l = i ^ j; if (l > i) CSWAPD(v[i], v[l]); }
}
__device__ __forceinline__ float gelu_erf(float x) { return 0.5f * x * (1.f + erff(x * 0.70710678118654752f)); }
__device__ __forceinline__ float fp4_dec1(unsigned n) { const unsigned m = n & 7u; unsigned bits = (m >= 2u) ? (((126u + (m >> 1)) << 23) | ((m & 1u) << 22)) : (m ? 0x3F000000u : 0u); bits |= (n & 8u) << 28; return __builtin_bit_cast(float, bits); }
__device__ __forceinline__ f32x2 fp4_dec2(unsigned x) { f32x2 r; r.x = fp4_dec1(x & 15u); r.y = fp4_dec1((x >> 4) & 15u); return r; }
typedef long i64;
typedef int v8i __attribute__((ext_vector_type(8)));
typedef int v4i __attribute__((ext_vector_type(4)));
template <bool dry = false> __device__ __forceinline__ void peer_unit(Frame& F, int u) {
    LAS unsigned char* lds = F.lds + RING_OFF;
    const int tid_ = fresh_tid(), lane = tid_ & 63, w = __builtin_amdgcn_readfirstlane(tid_ >> 6), g = lane >> 4, c16 = lane & 15;
    const int T0 = 32 * u;
    LAS int* eidx = (LAS int*)(lds + P_EIDX); LAS float* gate = (LAS float*)(lds + P_GATE);
    LAS unsigned* lst = (LAS unsigned*)(lds + P_LST) + w * 1024;
    const bf16* const QP = F.QP(); const bf16* const SK = F.SK(); float* const outp = F.out(); const bf16* const X1B = F.X1B(); const float* const fgain = F.ffn_norm(); const float* const fing = F.final_norm(); const unsigned char* const U8 = F.U8(); const unsigned char* const V8 = F.V8();
#ifndef NO_ROUTE
    unsigned cpk[4];
    { unsigned cb[16];
#pragma unroll
      for (int k = 0; k < 13; ++k) cb[k] = PEER_CAND[4 * k + g];
      cb[13] = 255u; cb[14] = 255u; cb[15] = 255u;
#pragma unroll
      for (int q = 0; q < 4; ++q) cpk[q] = cb[4 * q] | (cb[4 * q + 1] << 8) | (cb[4 * q + 2] << 16) | (cb[4 * q + 3] << 24); }
    {
    bf16x8 qf[2][4];
#define QP_LOAD(dst, c_) do { _Pragma("unroll") for (int tb = 0; tb < 2; ++tb) { const unsigned qo = ((unsigned)(T0 + 16 * tb + c16) * (unsigned)DM + (unsigned)((2 * w + (c_)) * 128 + 8 * g)) * 2u; \
        _Pragma("unroll") for (int ks = 0; ks < 4; ++ks) dst[tb][ks] = __builtin_nontemporal_load((const GAS bf16x8*)((const unsigned char*)QP + (qo + 64u * ks))); } } while (0)
    QP_LOAD(qf, 0);
#pragma unroll
    for (int c = 0; c < 2; ++c) {
        const int p = 2 * w + c;
        unsigned key[2][32];
        bf16x8 sf[3][8];
        const unsigned so0 = (unsigned)p * 32768u + 16u * (unsigned)lane;
#define SK_LOAD(buf, j_) do { _Pragma("unroll") for (int q = 0; q < 8; ++q) sf[buf][q] = *(const GAS bf16x8*)((const unsigned char*)SK + (so0 + (unsigned)(2 * (j_) + (q >> 2)) * 4096u + 1024u * (q & 3))); } while (0)
        SK_LOAD(0, 0); SK_LOAD(1, 1);
#pragma unroll
        for (int j = 0; j < 4; ++j) {
            if (j + 2 < 4) SK_LOAD((j + 2) % 3, j + 2);
            __builtin_amdgcn_sched_barrier(0);
#pragma unroll
            for (int h2 = 0; h2 < 2; ++h2)
#pragma unroll
            for (int tb = 0; tb < 2; ++tb) { const int kb = 2 * j + h2; f32x4 acc = (f32x4){0.f, 0.f, 0.f, 0.f};
#pragma unroll
                for (int ks = 0; ks < 4; ++ks) acc = MFMA16(sf[j % 3][4 * h2 + ks], qf[tb][ks], acc);
#pragma unroll
                for (int r = 0; r < 4; ++r) key[tb][kb * 4 + r] = (f2ord(acc[r]) & ~0x7Fu) | (unsigned)(16 * kb + 4 * g + r); }
            __builtin_amdgcn_sched_barrier(0); }
#undef SK_LOAD
        if (c == 0) { QP_LOAD(qf, 1); __builtin_amdgcn_sched_barrier(0); }
#pragma unroll
        for (int tb = 0; tb < 2; ++tb) {
            bitonic_sort_desc<32>(key[tb]);
            unsigned top[16];
#pragma unroll
            for (int i = 0; i < 16; ++i) top[i] = key[tb][i];
            merge16_xor(top, 16); merge16_xor(top, 32);
            if (g == 0) { LAS v4u* d = (LAS v4u*)(lst + (c * 32 + 16 * tb + c16) * 16);
                d[0] = (v4u){top[0], top[1], top[2], top[3]}; d[1] = (v4u){top[4], top[5], top[6], top[7]}; d[2] = (v4u){top[8], top[9], top[10], top[11]}; d[3] = (v4u){top[12], top[13], top[14], top[15]}; } }
    }
#undef QP_LOAD
    }
    for (int tb = 0; tb < 2; ++tb) {
        LDS_WAIT();
        const LAS unsigned* l1 = lst + (16 * tb + c16) * 16; const LAS unsigned* l2 = lst + (32 + 16 * tb + c16) * 16;
        unsigned ck[16];
#pragma unroll
        for (int k = 0; k < 13; ++k) { const unsigned ab = (cpk[k >> 2] >> (8 * (k & 3))) & 255u; const unsigned a = ab >> 4, bq = ab & 15u;
            const float s = ord2f(l1[a] & ~0x7Fu) + ord2f(l2[bq] & ~0x7Fu); ck[k] = (ab == 255u) ? 0u : ((f2ord(s) & ~0xFFu) | ab); }
        ck[13] = 0u; ck[14] = 0u; ck[15] = 0u;
        bitonic_sort_desc<16>(ck);
        merge16_xor(ck, 16); merge16_xor(ck, 32);
        if (g == 0) { const int tl = 16 * tb + c16; const float m = ord2f(ck[0] & ~0xFFu); float e[16]; float sum = 0.f;
#pragma unroll
            for (int k = 0; k < 16; ++k) { e[k] = __expf(ord2f(ck[k] & ~0xFFu) - m); sum += e[k]; }
            const float inv = 1.f / sum;
#pragma unroll
            for (int k = 0; k < 16; ++k) { const unsigned a = (ck[k] >> 4) & 15u, bq = ck[k] & 15u; const int ex = (int)((l1[a] & 0x7Fu) * 128u + (l2[bq] & 0x7Fu));
                eidx[tl * 128 + w * 16 + k] = ex; gate[tl * 128 + w * 16 + k] = e[k] * inv; } }
    }
#endif
    __syncthreads();
    LAS unsigned char* hnb = lds + P_HN4 + w * 8192; LAS float* actl = (LAS float*)(lds + P_ACT) + w * 512;
    const LAS unsigned char* hb = hnb + 16 * g + ((c16 & 1) ? 1024 : 0) + ((c16 & 2) ? 64 : 0);
    v4u bA[8], bB[8];
#define U_ISSUE(buf, e_) do { const unsigned uo_ = (unsigned)(e_) * (unsigned)ROWB + 64u * (unsigned)(c16 & 1) + 16u * (unsigned)g; \
        _Pragma("unroll") for (int jj = 0; jj < 8; ++jj) buf[jj] = *(const GAS v4u*)(U8 + (uo_ + 128u * jj)); __builtin_amdgcn_sched_barrier(0); } while (0)
#define U_CONSUME(buf, ACC, HB) do { v4u bq_[8]; _Pragma("unroll") for (int jj = 0; jj < 8; ++jj) bq_[jj] = *(const LAS v4u*)((HB) + 128 * jj); \
        __builtin_amdgcn_sched_barrier(0); \
        _Pragma("unroll") for (int jj = 0; jj < 8; ++jj) { const v4u a_ = buf[jj]; \
            const v8i av_ = {(int)a_.x, (int)a_.y, (int)a_.z, (int)a_.w, 0, 0, 0, 0}; const v8i bv_ = {(int)bq_[jj].x, (int)bq_[jj].y, (int)bq_[jj].z, (int)bq_[jj].w, 0, 0, 0, 0}; \
            ACC = __builtin_amdgcn_mfma_scale_f32_16x16x128_f8f6f4(av_, bv_, ACC, 4, 4, 0, 0x7f7f7f7f, 0, 0x7f7f7f7f); } __builtin_amdgcn_sched_barrier(0); } while (0)
#define U_PRE(A_, PA, PB) do { const float x1_ = __shfl_down(A_.x, 1), z1_ = __shfl_down(A_.z, 1), y2_ = __shfl_down(A_.y, 2), w2_ = __shfl_down(A_.w, 2), y3_ = __shfl_down(A_.y, 3), w3_ = __shfl_down(A_.w, 3); \
        constexpr float ilo_ = 1.f / SLO4; PA = (A_.x + y2_) + (x1_ + y3_) * ilo_; PB = (A_.z + w2_) + (z1_ + w3_) * ilo_; } while (0)
#define U_ACT8(hg_, TL, ACT) do { float pa_, pb_; U_PRE(acc, pa_, pb_); \
        if (c16 == 0) { const int k0 = 8 * (hg_) + 2 * g; constexpr float isc = 1.f / (SU * SH4); const f32x2 g0_ = *(const LAS f32x2*)(gate + (TL) * 128 + k0); \
            f32x2 a0_; a0_.x = gelu_erf(pa_ * isc) * g0_.x; a0_.y = gelu_erf(pb_ * isc) * g0_.y; *(LAS f32x2*)((ACT) + k0) = a0_; } } while (0)
#define V_ISSUE(buf, TL, kb_) do { const LAS v4i* ep_ = (const LAS v4i*)(eidx + (TL) * 128 + 8 * (kb_)); const v4i e4a_ = ep_[0], e4b_ = ep_[1]; const int ee_[8] = {e4a_.x, e4a_.y, e4a_.z, e4a_.w, e4b_.x, e4b_.y, e4b_.z, e4b_.w}; \
        _Pragma("unroll") for (int kk = 0; kk < 8; ++kk) { const unsigned vo_ = (unsigned)(ee_[kk] & emask) * (unsigned)ROWB + 16u * (unsigned)lane; buf[kk] = *(const GAS v4u*)(V8 + vo_); } \
        __builtin_amdgcn_sched_barrier(0); } while (0)
#define PIN8x2(a, i) asm volatile("" : "+v"(a[i]), "+v"(a[i + 1]), "+v"(a[i + 2]), "+v"(a[i + 3]), "+v"(a[i + 4]), "+v"(a[i + 5]), "+v"(a[i + 6]), "+v"(a[i + 7]))
#define V_CONSUME(buf, kb_, O, ACT) do { const f32x4 al_ = *(const LAS f32x4*)((ACT) + 8 * (kb_)), ah_ = *(const LAS f32x4*)((ACT) + 8 * (kb_) + 4); const float a8_[8] = {al_.x, al_.y, al_.z, al_.w, ah_.x, ah_.y, ah_.z, ah_.w}; \
        _Pragma("unroll") for (int kk = 0; kk < 8; ++kk) { const float as_ = a8_[kk]; const f32x2 a2_ = {as_, as_}; \
        const unsigned vw[4] = {buf[kk].x, buf[kk].y, buf[kk].z, buf[kk].w}; \
        _Pragma("unroll") for (int q = 0; q < 4; ++q) { \
            O[4 * q]     = __builtin_elementwise_fma(__builtin_amdgcn_cvt_scalef32_pk_f32_fp4(vw[q], 1.0f, 0), a2_, O[4 * q]); \
            O[4 * q + 1] = __builtin_elementwise_fma(__builtin_amdgcn_cvt_scalef32_pk_f32_fp4(vw[q], 1.0f, 1), a2_, O[4 * q + 1]); \
            O[4 * q + 2] = __builtin_elementwise_fma(__builtin_amdgcn_cvt_scalef32_pk_f32_fp4(vw[q], 1.0f, 2), a2_, O[4 * q + 2]); \
            O[4 * q + 3] = __builtin_elementwise_fma(__builtin_amdgcn_cvt_scalef32_pk_f32_fp4(vw[q], 1.0f, 3), a2_, O[4 * q + 3]); } \
        PIN8x2(O, 0); PIN8x2(O, 8); } } while (0)
#ifndef NO_GATHER
#ifdef PROBE_L2RES
    constexpr int emask = dry ? PROBE_L2RES : 16383;
#else
    constexpr int emask = 16383;
#endif
    {
    { unsigned k0[4], k1[4];
#pragma unroll
      for (int ti = 0; ti < 4; ++ti) { const int tl = w + 8 * ti; k0[ti] = ((unsigned)eidx[tl * 128 + lane] << 7) | (unsigned)lane; k1[ti] = ((unsigned)eidx[tl * 128 + 64 + lane] << 7) | (unsigned)(64 + lane); }
#pragma unroll
      for (int k = 2; k <= 128; k <<= 1)
#pragma unroll
        for (int j = k >> 1; j > 0; j >>= 1) {
            if (j == 64) {
#pragma unroll
                for (int ti = 0; ti < 4; ++ti) { const unsigned lo_ = k0[ti] < k1[ti] ? k0[ti] : k1[ti], hi_ = k0[ti] < k1[ti] ? k1[ti] : k0[ti]; k0[ti] = lo_; k1[ti] = hi_; }
            } else {
                const bool lower = (lane & j) == 0;
                const bool desc0 = (k == 64) ? false : ((k == 128) ? false : ((lane & k) != 0)), desc1 = (k == 64) ? true : desc0;
                const bool min0 = lower != desc0, min1 = lower != desc1;
#pragma unroll
                for (int ti = 0; ti < 4; ++ti) { const unsigned p0 = (unsigned)__shfl_xor((int)k0[ti], j), p1 = (unsigned)__shfl_xor((int)k1[ti], j);
                    const unsigned mn0 = k0[ti] < p0 ? k0[ti] : p0, mx0 = k0[ti] < p0 ? p0 : k0[ti], mn1 = k1[ti] < p1 ? k1[ti] : p1, mx1 = k1[ti] < p1 ? p1 : k1[ti];
                    k0[ti] = min0 ? mn0 : mx0; k1[ti] = min1 ? mn1 : mx1; }
            }
        }
      float g0[4], g1[4];
#pragma unroll
      for (int ti = 0; ti < 4; ++ti) { const int tl = w + 8 * ti; g0[ti] = gate[tl * 128 + (int)(k0[ti] & 127u)]; g1[ti] = gate[tl * 128 + (int)(k1[ti] & 127u)]; }
      LDS_WAIT(); asm volatile("" ::: "memory");
#pragma unroll
      for (int ti = 0; ti < 4; ++ti) { const int tl = w + 8 * ti; eidx[tl * 128 + lane] = (int)(k0[ti] >> 7); eidx[tl * 128 + 64 + lane] = (int)(k1[ti] >> 7); gate[tl * 128 + lane] = g0[ti]; gate[tl * 128 + 64 + lane] = g1[ti]; }
      LDS_WAIT(); asm volatile("" ::: "memory"); }
    v2u xn[8];
#define X_ISSUE(tok_) do { const unsigned xb_ = (unsigned)(tok_) * (unsigned)(DM * 2) + 8u * (unsigned)lane; _Pragma("unroll") for (int j = 0; j < 8; ++j) xn[j] = __builtin_nontemporal_load((const GAS v2u*)((const unsigned char*)X1B + (xb_ + 512u * j))); } while (0)
    X_ISSUE(T0 + w);
#pragma unroll 1
    for (int ti = 0; ti < 4; ++ti) {
        f32x4 xr[8]; float ss = 0.f;
#pragma unroll
        for (int j = 0; j < 8; ++j) { const v2u r = xn[j]; xr[j] = (f32x4){bflo(r.x), bfhi(r.x), bflo(r.y), bfhi(r.y)}; }
        X_ISSUE(T0 + w + 8 * (ti < 3 ? ti + 1 : 3));
#pragma unroll
        for (int j = 0; j < 8; ++j) ss += (xr[j].x * xr[j].x + xr[j].y * xr[j].y) + (xr[j].z * xr[j].z + xr[j].w * xr[j].w);
        const float rs2 = __builtin_amdgcn_rsqf(wave_sum(ss) * (1.f / DM) + EPS);
        const float* fg_ = fgain; asm volatile("" : "+s"(fg_));
        const unsigned char* gp = (const unsigned char*)fg_; const unsigned go = 16u * (unsigned)lane;
        unsigned hw[4], lw[4];
#pragma unroll
        for (int q = 0; q < 4; ++q) { unsigned wh = 0u, wl = 0u;
#pragma unroll
            for (int t = 0; t < 2; ++t) { const int j = 2 * q + t; const f32x4 gg = *(const GAS f32x4*)(gp + (go + 1024u * j)); const f32x4 hv = xr[j] * gg * (rs2 * SH4);
                const float h0 = clampf(hv.x, 6.f), h1 = clampf(hv.y, 6.f), h2 = clampf(hv.z, 6.f), h3 = clampf(hv.w, 6.f);
                const unsigned p0 = __builtin_amdgcn_cvt_scalef32_pk_fp4_f32(0u, h0, h1, 1.0f, 0), p1 = __builtin_amdgcn_cvt_scalef32_pk_fp4_f32(0u, h2, h3, 1.0f, 0);
                const f32x2 d0 = __builtin_amdgcn_cvt_scalef32_pk_f32_fp4(p0, 1.0f, 0), d1 = __builtin_amdgcn_cvt_scalef32_pk_f32_fp4(p1, 1.0f, 0);
                const unsigned r0 = __builtin_amdgcn_cvt_scalef32_pk_fp4_f32(0u, clampf((h0 - d0.x) * SLO4, 6.f), clampf((h1 - d0.y) * SLO4, 6.f), 1.0f, 0), r1 = __builtin_amdgcn_cvt_scalef32_pk_fp4_f32(0u, clampf((h2 - d1.x) * SLO4, 6.f), clampf((h3 - d1.y) * SLO4, 6.f), 1.0f, 0);
                wh |= ((p0 & 0xFFu) | ((p1 & 0xFFu) << 8)) << (16 * t); wl |= ((r0 & 0xFFu) | ((r1 & 0xFFu) << 8)) << (16 * t); }
            hw[q] = wh; lw[q] = wl; }
        *(LAS v4u*)(hnb + 2048 * ti + 16 * lane) = (v4u){hw[0], hw[1], hw[2], hw[3]}; *(LAS v4u*)(hnb + 2048 * ti + 1024 + 16 * lane) = (v4u){lw[0], lw[1], lw[2], lw[3]};
    }
    LDS_WAIT();
    { const int r8 = c16 >> 1;
#define U_STEP(BUFN, EN_ISSUE, BUFC, TI, HG) do { EN_ISSUE; f32x4 acc = (f32x4){0.f, 0.f, 0.f, 0.f}; U_CONSUME(BUFC, acc, hb + 2048 * (TI)); U_ACT8(HG, w + 8 * (TI), actl + 128 * (TI)); } while (0)
      { const int e0 = eidx[w * 128 + r8] & emask; U_ISSUE(bA, e0); }
#pragma unroll 1
      for (int hg = 0; hg < 15; ++hg) {
          if ((hg & 7) == 0) __builtin_amdgcn_s_barrier();
          const int e1 = eidx[(w + 8) * 128 + 8 * hg + r8] & emask, e2 = eidx[(w + 16) * 128 + 8 * hg + r8] & emask, e3 = eidx[(w + 24) * 128 + 8 * hg + r8] & emask, e0n = eidx[w * 128 + 8 * (hg + 1) + r8] & emask;
          U_STEP(bB, U_ISSUE(bB, e1), bA, 0, hg);
          U_STEP(bA, U_ISSUE(bA, e2), bB, 1, hg);
          U_STEP(bB, U_ISSUE(bB, e3), bA, 2, hg);
          U_STEP(bA, U_ISSUE(bA, e0n), bB, 3, hg);
      }
      { const int e1 = eidx[(w + 8) * 128 + 120 + r8] & emask, e2 = eidx[(w + 16) * 128 + 120 + r8] & emask, e3 = eidx[(w + 24) * 128 + 120 + r8] & emask;
          U_STEP(bB, U_ISSUE(bB, e1), bA, 0, 15);
          U_STEP(bA, U_ISSUE(bA, e2), bB, 1, 15);
          U_STEP(bB, U_ISSUE(bB, e3), bA, 2, 15);
          U_STEP(bA, V_ISSUE(bA, w, 0), bB, 3, 15); }
#undef U_STEP
    }
    LDS_WAIT();
    f32x2 o2[4][16];
#pragma unroll
    for (int ti = 0; ti < 4; ++ti)
#pragma unroll
        for (int i = 0; i < 16; ++i) o2[ti][i] = (f32x2){0.f, 0.f};
#pragma unroll 1
    for (int kb = 0; kb < 16; ++kb) {
        if ((kb & 7) == 0) __builtin_amdgcn_s_barrier();
        const int kn = kb < 15 ? kb + 1 : 15;
        V_ISSUE(bB, w + 8, kb);  V_CONSUME(bA, kb, o2[0], actl);
        V_ISSUE(bA, w + 16, kb); V_CONSUME(bB, kb, o2[1], actl + 128);
        V_ISSUE(bB, w + 24, kb); V_CONSUME(bA, kb, o2[2], actl + 256);
        V_ISSUE(bA, w, kn);      V_CONSUME(bB, kb, o2[3], actl + 384);
    }
    X_ISSUE(T0 + w);
#pragma unroll
    for (int ti = 0; ti < 4; ++ti) {
        const size_t token = (size_t)T0 + w + 8 * ti;
        const unsigned xo = (unsigned)token * (unsigned)(DM * 4) + 16u * (unsigned)lane;
        f32x4 xr[8];
#pragma unroll
        for (int j = 0; j < 8; ++j) { const v2u r = xn[j]; xr[j] = (f32x4){bflo(r.x), bfhi(r.x), bflo(r.y), bfhi(r.y)}; }
        if (ti < 3) X_ISSUE(T0 + w + 8 * (ti + 1));
        constexpr float isv = 1.f / SV; float s2 = 0.f;
#pragma unroll
        for (int j = 0; j < 8; ++j) { xr[j] = xr[j] + (f32x4){o2[ti][2 * j].x, o2[ti][2 * j].y, o2[ti][2 * j + 1].x, o2[ti][2 * j + 1].y} * isv;
            s2 += (xr[j].x * xr[j].x + xr[j].y * xr[j].y) + (xr[j].z * xr[j].z + xr[j].w * xr[j].w); }
        const float rf = __builtin_amdgcn_rsqf(wave_sum(s2) * (1.f / DM) + EPS);
        const float* fi_ = fing; asm volatile("" : "+s"(fi_));
        const unsigned char* fp = (const unsigned char*)fi_; unsigned char* op = (unsigned char*)outp; const unsigned fo = 16u * (unsigned)lane;
        if (!dry || rf == 1.2345e30f)
#pragma unroll
        for (int j = 0; j < 8; ++j) __builtin_nontemporal_store(xr[j] * rf * *(const GAS f32x4*)(fp + (fo + 1024u * j)), (GAS f32x4*)(op + (xo + 1024u * j)));
    }
    }
#endif
#undef U_ISSUE
#undef X_ISSUE
#undef U_ACT
#undef U_CONSUME
#undef V_ISSUE
#undef V_CONSUME
    __syncthreads();
}

__global__ void __launch_bounds__(NWAVES * 64, 2) hybrid_fwd(Args args) {
    extern __shared__ __attribute__((aligned(16))) unsigned char lds[];
    Frame F;
    F.lds = (LAS unsigned char*)lds;
    F.MISC = (volatile LAS unsigned*)(F.lds + MISC_OFF);
    F.tid = threadIdx.x; F.lane = F.tid & 63; F.wave = __builtin_amdgcn_readfirstlane(F.tid >> 6); F.G = gridDim.x;
    for (int u = F.tid; u < (LDS_BYTES - LDSCTL_OFF) / 4; u += NWAVES * 64) ((LAS unsigned*)(F.lds + LDSCTL_OFF))[u] = 0u;
    __syncthreads();
    (void)args;
    XcdBarrier bar = xcd_barrier_post(F.ctl() + CW_BAR, F.MISC + 8);

#ifndef NO_P0
#ifdef PROBE_P0X2
    { int reps = 2; asm volatile("" : "+s"(reps)); for (int rep = 0; rep < reps; ++rep) p0_prologue(F); }
#else
    p0_prologue(F);
#endif
#endif
    xcd_barrier(bar);
#ifndef NO_P1
#ifdef PROBE_GX2
    { int reps = 2; asm volatile("" : "+s"(reps)); for (int rep = 0; rep < reps; ++rep) {
#else
    { { const int rep = 0, reps = 1;
#endif
      pg8::Gemm gm{F.HN(), F.WinT(), MTOK, NB16, DM}; pg8::StaticOrder S; S.init(MTOK, NB16, F.G, (int)blockIdx.x);
      EpiProj E{F.PROJ(), F.dtraw(), (rep + 1 < reps) ? nullptr : F.kmean()};
      pg8::gemm_phase<EpiProj, pg8::StaticOrder, PG8_ALIGN, PG8_SP2>(F.lds + RING_OFF, gm, S, E); } }
    { const int nun = (MTOK / 256) * (NB16 / 256), rem = nun % F.G;
      if (rem && (int)blockIdx.x >= rem) tables_convert(F, tab_split(F.G), TAB_ITEMS, (size_t)((int)blockIdx.x - rem) * (NWAVES * 64) + fresh_tid(), (size_t)(F.G - rem) * (NWAVES * 64)); }
    __syncthreads();
    {
      pg8::Gemm gm{(const pg8::bf16_t*)F.HN8(), (const pg8::bf16_t*)F.WinT8(), MTOK, F8_HI - F8_LO, DM / 2}; pg8::StaticOrder S; S.init(MTOK, F8_HI - F8_LO, F.G, (int)blockIdx.x);
      EpiProj8 E{F.PROJ()};
      pg8::gemm_phase<EpiProj8, pg8::StaticOrder, PG8_ALIGN, PG8_SP2, true>(F.lds + RING_OFF, gm, S, E); }
#endif
    xcd_barrier(bar);
#ifdef PROBE_P15X2
    conv_phase(F);
#endif
    conv_phase(F);
    xcd_barrier(bar);
#ifdef PROBE_P2X2
    { int reps = 2; asm volatile("" : "+s"(reps)); for (int rep = 0; rep < reps; ++rep) {
#else
    { { const int rep = 0, reps = 1;
#endif
    const bool doatom = rep + 1 == reps;
    const int ntab = (int)(tab_split(F.G) / TAB_UNIT);
    for (;;) {
        if (F.tid == 0) F.MISC[0] = xb_add(F.ctl() + CW_Q2 + 64 * rep, 1u);
        __syncthreads();
        const int ui = (int)F.MISC[0];
        __syncthreads();
        if (ui >= 128 + 512 + W_SQ_UNITS + ntab) break;
        if (ui >= 128 + 512 && ui < 128 + 512 + W_SQ_UNITS) { sq_weight_items(F, ui - 640); __syncthreads(); continue; }
        if (ui >= 128 + 512 + W_SQ_UNITS) { const size_t lo = (size_t)(ui - 640 - W_SQ_UNITS) * TAB_UNIT; tables_convert(F, lo, lo + TAB_UNIT, (size_t)fresh_tid(), (size_t)(NWAVES * 64)); continue; }
#ifdef PROBE_P2_SSD
        if (ui < 128 || doatom)
#endif
#ifdef PROBE_P2_ATT
        if (ui >= 128 || doatom)
#endif
        {
        if (ui < 128) ssd_unit(F, ui >> 4, ui & 15, doatom);
        else { const int a = ui - 128; attn_unit(F, (a & 63) >> 3, a & 7, 7 - (a >> 6), doatom); }
        }
    } } }
    xcd_barrier(bar);
#ifndef NO_P3
#ifdef PROBE_GX2
    { int reps = 2; asm volatile("" : "+s"(reps)); for (int rep = 0; rep < reps; ++rep) {
#else
    { { const int rep = 0, reps = 1;
#endif
      pg8::Gemm gm{F.HN(), F.WoutT(), MTOK, DM, DM / 2}; pg8::StaticOrder S; S.init(MTOK, DM, F.G, (int)blockIdx.x);
      {
        const int t_ = fresh_tid(); const float* const sq = F.ssq();
#pragma unroll 1
        for (int ii = t_ >> 8; ii < 3; ii += 2) { pg8::Unit uu;
          if (S.next(ii, uu)) { const int row = uu.pm * 256 + (t_ & 255);
            const float q1 = __hip_atomic_load(sq + (size_t)row * 4 + 1, RLX_AGENT), q2 = __hip_atomic_load(sq + (size_t)row * 4 + 2, RLX_AGENT), q3 = __hip_atomic_load(sq + (size_t)row * 4 + 3, RLX_AGENT);
            const float sa = __builtin_amdgcn_rsqf(q1 * (1.f / 1024.f) + EPS), s0 = __builtin_amdgcn_rsqf(q2 * (1.f / 512.f) + EPS), s1 = __builtin_amdgcn_rsqf(q3 * (1.f / 512.f) + EPS);
            *(LAS f32x4*)(F.lds + SEGTAB_OFF + (ii * 256 + (t_ & 255)) * 16) = (f32x4){sa / s0 * (SS8 / SA8), s0 / s1, s1 * (1.f / (SS8 * SW8)), 0.f}; } }
        __syncthreads(); }
      EpiOut E{F.x(), F.X1B(), F.X18(), F.ssq(), rep + 1 == reps, (const LAS f32x4*)(F.lds + SEGTAB_OFF)};
      pg8::gemm_phase<EpiOut, pg8::StaticOrder, PG8_ALIGN, PG8_SP2, true>(F.lds + RING_OFF, gm, S, E); } }
#endif
    xcd_barrier(bar);
#ifndef NO_P4
#ifdef PROBE_GX2
    { int reps = 2; asm volatile("" : "+s"(reps)); for (int rep = 0; rep < reps; ++rep) {
#else
    { { const int rep = 0, reps = 1; (void)rep; (void)reps;
#endif
      pg8::Gemm gm{(const pg8::bf16_t*)F.X18(), F.WqT(), MTOK, DM, DM / 2}; pg8::StaticOrder S; S.init(MTOK, DM, F.G, (int)blockIdx.x);
      EpiQ E{F.QP(), F.ssq()};
      pg8::gemm_phase<EpiQ, pg8::StaticOrder, PG8_ALIGN, PG8_SP2, true>(F.lds + RING_OFF, gm, S, E); } }
#endif
    xcd_barrier(bar);
#ifndef NO_P5
#ifdef PROBE_P5X2
    { for (int u = blockIdx.x; u < MTOK / 32; u += F.G) peer_unit<true>(F, u);
      for (int u = blockIdx.x; u < MTOK / 32; u += F.G) peer_unit<false>(F, u); }
#else
    for (int u = blockIdx.x; u < MTOK / 32; u += F.G) peer_unit(F, u);
#endif
#endif
}

extern "C" void kernel_launch(void* const* d_in, const int* in_sizes, int n_in, void* d_out, int out_size, void* d_ws, size_t ws_size, hipStream_t stream) {
    static int grid = 0;
    if (grid == 0) {
        if (n_in != 18 || out_size != MTOK * DM || ws_size < WS_END) { fprintf(stderr, "kernel_launch: unexpected shapes (n_in %d, out %d, ws %zu)\n", n_in, out_size, ws_size); grid = -1; return; }
        int dev = 0, cus = 0, per_cu = 0;
        if (hipGetDevice(&dev) != hipSuccess || hipDeviceGetAttribute(&cus, hipDeviceAttributeMultiprocessorCount, dev) != hipSuccess) { grid = -1; return; }
        if (hipFuncSetAttribute((const void*)hybrid_fwd, hipFuncAttributeMaxDynamicSharedMemorySize, LDS_BYTES) != hipSuccess) { fprintf(stderr, "kernel_launch: hipFuncSetAttribute failed\n"); grid = -1; return; }
        if (hipOccupancyMaxActiveBlocksPerMultiprocessor(&per_cu, (const void*)hybrid_fwd, NWAVES * 64, LDS_BYTES) != hipSuccess || per_cu < 1)
            fprintf(stderr, "kernel_launch: note: occupancy query reports %d workgroups per CU\n", per_cu);
        (void)hipGetLastError();
        grid = cus;
    }
    if (grid < 0) return;
    if (hipMemsetAsync((char*)d_ws + WS_CTL, 0, CTL_ZERO_BYTES, stream) != hipSuccess) return;
    Args a{};
    for (int i = 0; i < 18; ++i) a.in[i] = (const float*)d_in[i];
    a.out = (float*)d_out; a.ws = (unsigned char*)d_ws;
    hipLaunchKernelGGL(hybrid_fwd, dim3(grid), dim3(NWAVES * 64), LDS_BYTES, stream, a);
}
```

```cpp
#include <hip/hip_runtime.h>
#include <cstdio>
#include <cstdint>
namespace pg8 {
#define PG8_LAS __attribute__((address_space(3)))
typedef unsigned short bf16_t;
typedef short bf16x8 __attribute__((ext_vector_type(8)));
typedef float f32x4 __attribute__((ext_vector_type(4)));
typedef unsigned u32x4 __attribute__((ext_vector_type(4)));
constexpr int BM = 256, BK = 64, HALF = 128, HTB = HALF * BK * 2  , STAGE_BYTES = 8 * HTB, NXCD = 8, WGM = 8;

__host__ __device__ __forceinline__ int lds_byte(int r, int c) { const int st = (r >> 4) * 2 + (c >> 5), rr = r & 15, cc = c & 31, ob = rr * 64 + cc * 2; return st * 1024 + (ob ^ (((ob >> 9) & 1) << 5)); }
__host__ __device__ __forceinline__ void stage_rc(int b, int& R, int& C) { const int st = b / 1024, sb = b % 1024, swz = sb ^ (((sb >> 9) & 1) << 5); R = (st >> 1) * 16 + swz / 64; C = (st & 1) * 32 + (swz % 64) / 2; }
__host__ __device__ __forceinline__ int perm32(int rho) { const int n = rho >> 4, i = rho & 15; return 8 * (i >> 2) + 4 * n + (i & 3); }

struct Unit { int pm, pn; };
struct Gemm { const bf16_t* A; const bf16_t* Bt; int M, N, K; };

struct StaticOrder {
    int nM, nN, nwg, G, c;
    __host__ __device__ void init(int M, int N, int G_, int c_) { nM = M / BM; nN = N / BM; nwg = nM * nN; G = G_; c = c_; }
    __host__ __device__ bool next(int i, Unit& u) const {
        const long L = (long)i * G + c; if (L >= nwg) return false;
        int wgid = (int)L; { const int q = nwg / NXCD, r = nwg % NXCD, xcd = wgid % NXCD, off = wgid / NXCD; wgid = (xcd < r ? xcd * (q + 1) : r * (q + 1) + (xcd - r) * q) + off; }
        const int nig = WGM * nN, gid = wgid / nig, fm = gid * WGM, gsz = (nM - fm) < WGM ? (nM - fm) : WGM;
        u.pm = fm + ((wgid % nig) % gsz); u.pn = (wgid % nig) / gsz; return true;
    }
    __device__ __forceinline__ void a_ready(const Unit&) const {}
    __device__ __forceinline__ void done(const Unit&) const {}
};

__device__ __forceinline__ unsigned cvt_pk_bf16(float lo, float hi) { unsigned r; asm volatile("v_cvt_pk_bf16_f32 %0, %1, %2" : "=v"(r) : "v"(lo), "v"(hi)); return r; }
typedef float f32x2 __attribute__((ext_vector_type(2)));
__device__ __forceinline__ f32x2 gelu_pk(f32x2 v) {
    const f32x2 av = __builtin_elementwise_abs(v), d = av * 0.2316418882f + 1.0f;
    f32x2 t; t.x = __builtin_amdgcn_rcpf(d.x); t.y = __builtin_amdgcn_rcpf(d.y);
    f32x2 q = t * 0.5307027145f + (-0.7265760135f); q = q * t + 0.7107068705f; q = q * t + (-0.142248368f); q = q * t + 0.127414796f; q = q * t;
    const f32x2 s = (v * v) * (-0.72134752044f);
    f32x2 e; e.x = __builtin_amdgcn_exp2f(s.x); e.y = __builtin_amdgcn_exp2f(s.y);
    const f32x2 m = v * (q * e), r = v - m;
    f32x2 o; o.x = v.x < 0.f ? m.x : r.x; o.y = v.y < 0.f ? m.y : r.y; return o;
}

template <int ACT  > struct EpiBf16 {
    static constexpr bool PERM = true, AFTER_DRAIN = false, SEG = false; static_assert(ACT == 0 || ACT == 1, "EpiBf16: ACT is 0 (none) or 1 (gelu_pk)");
    bf16_t* O; int ldc; const float* bias; int split_cols; size_t split_stride; float scale0;
    __device__ __forceinline__ void operator()(const f32x4 (&acc)[2][2][4][2], const Unit& u, int wr, int wc, int fr, int fq) const {
        const int row0 = u.pm * BM + wr * 64 + fr; int colt = u.pn * BM; bf16_t* base = O;
        float sc = 1.f; if (split_cols) { const int t = colt / split_cols; base += (size_t)t * split_stride; colt -= t * split_cols; if (t == 0) sc = scale0; }
        const int col0 = colt + wc * 32 + 8 * fq, bcol0 = u.pn * BM + wc * 32 + 8 * fq;
        f32x4 bv[2][2];
#pragma unroll
        for (int bj = 0; bj < 2; ++bj)
#pragma unroll
            for (int n = 0; n < 2; ++n) bv[bj][n] = bias ? *(const f32x4*)(bias + bcol0 + bj * HALF + 4 * n) : (f32x4){0.f, 0.f, 0.f, 0.f};
#pragma unroll
        for (int ai = 0; ai < 2; ++ai)
#pragma unroll
            for (int m = 0; m < 4; ++m) { bf16_t* rowp = base + (size_t)(row0 + ai * HALF + m * 16) * ldc + col0;
#pragma unroll
                for (int bj = 0; bj < 2; ++bj) { f32x4 v0 = acc[ai][bj][m][0] + bv[bj][0], v1 = acc[ai][bj][m][1] + bv[bj][1];
                    if (ACT == 1) { f32x2 a = gelu_pk((f32x2){v0[0], v0[1]}), b = gelu_pk((f32x2){v0[2], v0[3]}), c = gelu_pk((f32x2){v1[0], v1[1]}), d = gelu_pk((f32x2){v1[2], v1[3]});
                        v0 = (f32x4){a.x, a.y, b.x, b.y}; v1 = (f32x4){c.x, c.y, d.x, d.y}; }
                    v0 = v0 * sc; v1 = v1 * sc; u32x4 w; w.x = cvt_pk_bf16(v0[0], v0[1]); w.y = cvt_pk_bf16(v0[2], v0[3]); w.z = cvt_pk_bf16(v1[0], v1[1]); w.w = cvt_pk_bf16(v1[2], v1[3]);
                    *(u32x4*)(rowp + bj * HALF) = w; } }
    }
};
template <class Epi, class Sched, bool ALIGN_EPI = false, bool SP2 = false, bool F8 = false>
__device__ __forceinline__ void gemm_phase(PG8_LAS unsigned char* lds, const Gemm g, const Sched& S, const Epi& E) {
    int tid_ = threadIdx.x; asm volatile("" : "+v"(tid_));
    const int tid = tid_, wid = __builtin_amdgcn_readfirstlane(tid >> 6), lane = tid & 63, wr = wid >> 2, wc = wid & 3, fr = lane & 15, fq = lane >> 4;
    const int K = g.K, nt = K / BK;
    unsigned voffA[2], voffB[2];
#pragma unroll
    for (int i = 0; i < 2; ++i) { int R, C; stage_rc(tid * 16 + i * 8192, R, C); const int Rb = Epi::PERM ? ((R & ~31) + perm32(R & 31)) : R;
        voffA[i] = (unsigned)(R * K + C) * 2u; voffB[i] = (unsigned)(Rb * K + C) * 2u; }
    const size_t kstep = (size_t)(BK * 2);
    const size_t hstep = (size_t)HALF * K * 2;
    const size_t tstep = 2 * hstep;
    const unsigned ldsw = (unsigned)wid * 1024u;
    const int aoff = lds_byte(wr * 64 + fr, fq * 8), boff = lds_byte(wc * 32 + fr, fq * 8);
#define PG8_SA(b, h) (((b) * 2 + (h)) * HTB)
#define PG8_SB(b, h) ((4 + (b) * 2 + (h)) * HTB)
#define PG8_STAGE(bufoff, gbase, voff) do { _Pragma("unroll") for (int _i = 0; _i < 2; ++_i) \
        __builtin_amdgcn_global_load_lds((const unsigned*)((const char*)(gbase) + (voff)[_i]), (PG8_LAS unsigned*)(lds + (bufoff) + ldsw + _i * 8192), 16, 0, 0); } while (0)
#define PG8_LDA(dst, b, h) do { _Pragma("unroll") for (int m = 0; m < 4; ++m) _Pragma("unroll") for (int k = 0; k < 2; ++k) dst[m][k] = *(const PG8_LAS bf16x8*)(lds + PG8_SA(b, h) + aoff + m * 2048 + k * 1024); } while (0)
#define PG8_LDB(dst, b, h) do { _Pragma("unroll") for (int n = 0; n < 2; ++n) _Pragma("unroll") for (int k = 0; k < 2; ++k) dst[n][k] = *(const PG8_LAS bf16x8*)(lds + PG8_SB(b, h) + boff + n * 2048 + k * 1024); } while (0)
#define PG8_MMA(ai, bj, At, Bt) do { __builtin_amdgcn_s_setprio(1); _Pragma("unroll") for (int m = 0; m < 4; ++m) _Pragma("unroll") for (int n = 0; n < 2; ++n) { \
        if constexpr (F8) { typedef int v8i_ __attribute__((ext_vector_type(8))); typedef int v4i_ __attribute__((ext_vector_type(4))); \
            const v4i_ b0_ = __builtin_bit_cast(v4i_, Bt[n][0]), b1_ = __builtin_bit_cast(v4i_, Bt[n][1]), a0_ = __builtin_bit_cast(v4i_, At[m][0]), a1_ = __builtin_bit_cast(v4i_, At[m][1]); \
            const v8i_ bb_ = {b0_.x, b0_.y, b0_.z, b0_.w, b1_.x, b1_.y, b1_.z, b1_.w}, aa_ = {a0_.x, a0_.y, a0_.z, a0_.w, a1_.x, a1_.y, a1_.z, a1_.w}; \
            asm volatile("v_mfma_scale_f32_16x16x128_f8f6f4 %0, %1, %2, %0, %3, %3 op_sel_hi:[0,0,0]" : "+v"(acc[ai][bj][m][n]) : "v"(bb_), "v"(aa_), "v"(f8one)); } \
        else { _Pragma("unroll") for (int k = 0; k < 2; ++k) acc[ai][bj][m][n] = __builtin_amdgcn_mfma_f32_16x16x32_bf16(Bt[n][k], At[m][k], acc[ai][bj][m][n], 0, 0, 0); } } \
        __builtin_amdgcn_s_setprio(0); } while (0)
#define PG8_WAIT_V(n) asm volatile("s_waitcnt vmcnt(" #n ")" ::: "memory")
#define PG8_WAIT_L(n) asm volatile("s_waitcnt lgkmcnt(" #n ")" ::: "memory")
#define PG8_BAR __builtin_amdgcn_s_barrier()
#define PG8_SCHED __builtin_amdgcn_sched_barrier(0)
    Unit cur, nxt; int ui = 0;
    if (!S.next(0, cur)) return;
    f32x4 acc[2][2][4][2];
    const int f8one = 0x7f7f7f7f;
#pragma unroll
    for (int a = 0; a < 2; ++a)
#pragma unroll
        for (int b = 0; b < 2; ++b)
#pragma unroll
            for (int m = 0; m < 4; ++m)
#pragma unroll
                for (int n = 0; n < 2; ++n) acc[a][b][m][n] = (f32x4){0.f, 0.f, 0.f, 0.f};
    bf16x8 At[4][2], B0[2][2], B1[2][2];
    const char* cA = (const char*)g.A + (size_t)cur.pm * tstep; const char* cB = (const char*)g.Bt + (size_t)cur.pn * tstep;
    S.a_ready(cur);
    float segr[16];
    if constexpr (Epi::SEG) E.seg_load(ui, wr, fr, segr);
    if constexpr (SP2) {
        PG8_STAGE(PG8_SB(0, 0), cB, voffB); PG8_STAGE(PG8_SB(0, 1), cB + hstep, voffB); PG8_STAGE(PG8_SA(0, 0), cA, voffA); PG8_STAGE(PG8_SA(0, 1), cA + hstep, voffA);
        if (wr == 1) PG8_BAR;
        PG8_WAIT_V(2); PG8_BAR;
        PG8_STAGE(PG8_SB(1, 0), cB + kstep, voffB); PG8_STAGE(PG8_SA(1, 0), cA + kstep, voffA); PG8_STAGE(PG8_SB(1, 1), cB + hstep + kstep, voffB);
        PG8_WAIT_V(6); PG8_BAR;
    } else {
        PG8_STAGE(PG8_SB(0, 0), cB, voffB); PG8_STAGE(PG8_SA(0, 0), cA, voffA); PG8_STAGE(PG8_SB(0, 1), cB + hstep, voffB); PG8_STAGE(PG8_SA(0, 1), cA + hstep, voffA);
        if (wr == 1) PG8_BAR;
        PG8_WAIT_V(4); PG8_BAR;
        PG8_STAGE(PG8_SB(1, 0), cB + kstep, voffB); PG8_STAGE(PG8_SA(1, 0), cA + kstep, voffA); PG8_STAGE(PG8_SB(1, 1), cB + hstep + kstep, voffB);
        PG8_WAIT_V(6); PG8_BAR;
    }
    for (;;) {
        const bool has_next = S.next(ui + 1, nxt);
        const char* nA = has_next ? (const char*)g.A + (size_t)nxt.pm * tstep : cA; const char* nB = has_next ? (const char*)g.Bt + (size_t)nxt.pn * tstep : cB;
        int t = 0;
#pragma unroll 1
        for (int sgi = 0; sgi < (Epi::SEG ? 3 : 1); ++sgi) {
        int tend = nt; if constexpr (Epi::SEG) tend = (sgi == 0) ? Epi::SEG_T1 : ((sgi == 1) ? Epi::SEG_T2 : nt);
        for (; t < tend; t += 2) {
            const bool last = (t == nt - 2);
            const char* a1 = cA + (size_t)(t + 1) * kstep;
            const char* a2 = last ? nA : cA + (size_t)(t + 2) * kstep; const char* b2 = last ? nB : cB + (size_t)(t + 2) * kstep;
            const char* a3 = a2 + kstep; const char* b3 = b2 + kstep;
            if (last && has_next) S.a_ready(nxt);
            if constexpr (SP2) {
            PG8_LDB(B0, 0, 0); PG8_LDB(B1, 0, 1); PG8_SCHED; PG8_LDA(At, 0, 0); PG8_STAGE(PG8_SA(1, 1), a1 + hstep, voffA);
            PG8_WAIT_V(8); PG8_WAIT_L(0); PG8_BAR; PG8_MMA(0, 0, At, B0); PG8_MMA(0, 1, At, B1); PG8_BAR; PG8_SCHED;
            PG8_LDA(At, 0, 1); PG8_STAGE(PG8_SB(0, 0), b2, voffB); PG8_STAGE(PG8_SB(0, 1), b2 + hstep, voffB); PG8_STAGE(PG8_SA(0, 0), a2, voffA);
            PG8_WAIT_V(8); PG8_WAIT_L(0); PG8_BAR; PG8_MMA(1, 0, At, B0); PG8_MMA(1, 1, At, B1); PG8_BAR; PG8_SCHED;
            PG8_LDB(B0, 1, 0); PG8_LDB(B1, 1, 1); PG8_SCHED; PG8_LDA(At, 1, 0); PG8_STAGE(PG8_SA(0, 1), a2 + hstep, voffA);
            PG8_WAIT_V(8); PG8_WAIT_L(0); PG8_BAR; PG8_MMA(0, 0, At, B0); PG8_MMA(0, 1, At, B1); PG8_BAR; PG8_SCHED;
            PG8_LDA(At, 1, 1); PG8_STAGE(PG8_SB(1, 0), b3, voffB); PG8_STAGE(PG8_SB(1, 1), b3 + hstep, voffB); PG8_STAGE(PG8_SA(1, 0), a3, voffA);
            PG8_WAIT_V(8); PG8_WAIT_L(0); PG8_BAR; PG8_MMA(1, 0, At, B0); PG8_MMA(1, 1, At, B1); PG8_BAR; PG8_SCHED;
            } else {
            PG8_LDB(B0, 0, 0); PG8_SCHED; PG8_LDA(At, 0, 0); PG8_STAGE(PG8_SA(1, 1), a1 + hstep, voffA);
            PG8_WAIT_L(8); PG8_BAR; PG8_WAIT_L(0); PG8_MMA(0, 0, At, B0); PG8_BAR; PG8_SCHED;
            PG8_LDB(B1, 0, 1); PG8_STAGE(PG8_SB(0, 0), b2, voffB);
            PG8_BAR; PG8_WAIT_L(0); PG8_MMA(0, 1, At, B1); PG8_BAR;
            PG8_LDA(At, 0, 1); PG8_STAGE(PG8_SA(0, 0), a2, voffA);
            PG8_BAR; PG8_WAIT_L(0); PG8_MMA(1, 0, At, B0); PG8_BAR; PG8_SCHED;
            PG8_STAGE(PG8_SB(0, 1), b2 + hstep, voffB);
            PG8_WAIT_V(6); PG8_BAR; PG8_MMA(1, 1, At, B1); PG8_BAR;
            PG8_LDB(B0, 1, 0); PG8_SCHED; PG8_LDA(At, 1, 0); PG8_STAGE(PG8_SA(0, 1), a2 + hstep, voffA);
            PG8_WAIT_L(8); PG8_BAR; PG8_WAIT_L(0); PG8_MMA(0, 0, At, B0); PG8_BAR; PG8_SCHED;
            PG8_LDB(B1, 1, 1); PG8_STAGE(PG8_SB(1, 0), b3, voffB);
            PG8_BAR; PG8_WAIT_L(0); PG8_MMA(0, 1, At, B1); PG8_BAR;
            PG8_LDA(At, 1, 1); PG8_STAGE(PG8_SA(1, 0), a3, voffA);
            PG8_BAR; PG8_WAIT_L(0); PG8_MMA(1, 0, At, B0); PG8_BAR; PG8_SCHED;
            PG8_STAGE(PG8_SB(1, 1), b3 + hstep, voffB);
            PG8_WAIT_V(6); PG8_BAR; PG8_MMA(1, 1, At, B1); PG8_BAR;
            }
        }
        if constexpr (Epi::SEG) E.seg_apply(acc, segr, sgi);
        }
        if constexpr (ALIGN_EPI) { if (wr == 0) PG8_BAR; }
        if constexpr (!Epi::AFTER_DRAIN) { if constexpr (Epi::SEG) E(acc, cur, wr, wc, fr, fq, ui); else E(acc, cur, wr, wc, fr, fq); S.done(cur); }
        if (!has_next) break;
#pragma unroll
        for (int a = 0; a < 2; ++a)
#pragma unroll
            for (int b = 0; b < 2; ++b)
#pragma unroll
                for (int m = 0; m < 4; ++m)
#pragma unroll
                    for (int n = 0; n < 2; ++n) acc[a][b][m][n] = (f32x4){0.f, 0.f, 0.f, 0.f};
        cur = nxt; cA = nA; cB = nB; ++ui;
        if constexpr (Epi::SEG) E.seg_load(ui, wr, fr, segr);
        if constexpr (ALIGN_EPI) { if (wr == 1) PG8_BAR; }
    }
    PG8_WAIT_V(0);
    if constexpr (!ALIGN_EPI) { if (wr == 0) PG8_BAR; }
    PG8_BAR;
    if constexpr (Epi::AFTER_DRAIN) { E.fused(acc, cur, wr, wc, fr, fq, lds, wid, lane); S.done(cur); }
#undef PG8_SA
#undef PG8_SB
#undef PG8_STAGE
#undef PG8_LDA
#undef PG8_LDB
#undef PG8_MMA
#undef PG8_WAIT_V
#undef PG8_WAIT_L
#undef PG8_BAR
#undef PG8_SCHED
}
}
#ifndef PG8_SP2
#define PG8_SP2 true
#endif
#ifndef PG8_ALIGN
#define PG8_ALIGN true
#endif

constexpr int BATCH = 8, SEQ = 2048, DM = 2048, MTOK = BATCH * SEQ;
constexpr int ATT_W = 1024, ATT_H = 8, ATT_HD = 128, MOBA_BLK = 256, NBLK = SEQ / MOBA_BLK;
constexpr int SSM_W = 1024, SSM_H = 16, SSM_P = 64, SSM_N = 128, SSM_L = 128, SSM_NC = SEQ / SSM_L, CONV_CH = 1536;
constexpr int IN_PROJ = 5648, NPROJ = 5632  , NPAD = 5888  ;
constexpr int F8_LO = 2048, F8_HI = 4096, NB16 = NPAD - (F8_HI - F8_LO)  ;
constexpr float SH8 = 16.f;
constexpr int COL_Q = 0, COL_K = 1024, COL_V = 2048, COL_Z = 3072, COL_XBC = 4096;
constexpr int PEER_H = 8, PEER_NK = 128, PEER_K = 16, PEER_HK = 128;
constexpr float EPS = 1e-6f;
constexpr float SU = 64.f, SV = 4.f, SH = 16.f, SLO = 16.f;
constexpr float SX8 = 16.f, SW8 = 1024.f;
constexpr float SA8 = 32.f, SS8 = 8.f;
constexpr float SH4 = 1.5f, SLO4 = 4.f;
constexpr int ROWB = DM / 2;

constexpr size_t MiB = 1u << 20;
constexpr size_t WS_CTL = 0, CTL_ZERO_BYTES = 1 * MiB;
constexpr size_t WS_DT = 1 * MiB;
constexpr size_t WS_SK = 2 * MiB;
constexpr size_t WS_WIN = 4 * MiB;
constexpr size_t WS_WIN8 = 24 * MiB;
constexpr size_t WS_HN8 = 396 * MiB;
constexpr size_t WS_WOUT = 28 * MiB;
constexpr size_t WS_WQ = 36 * MiB;
constexpr size_t WS_HN = 44 * MiB;
constexpr size_t WS_PROJ = 108 * MiB;
constexpr size_t WS_X1B = WS_PROJ, WS_QP = WS_PROJ + 64 * MiB;
constexpr size_t WS_U8 = 284 * MiB, WS_V8 = 316 * MiB;
constexpr size_t WS_XBC = 348 * MiB;
constexpr size_t WS_DT2 = 3 * MiB;
constexpr size_t WS_X18 = 396 * MiB;
constexpr size_t WS_END = 428 * MiB;
constexpr int CW_BAR = 4096;
constexpr int CW_Q2 = 8192;
constexpr int CW_KMEAN = 32768;
constexpr int CW_SSQ = 131072;
static_assert((CW_SSQ + MTOK * 4) * 4 <= (int)CTL_ZERO_BYTES, "CTL words inside the memset region");

constexpr int RING_OFF = 0, RING_BYTES = 131072;
constexpr int LDSCTL_OFF = RING_BYTES, MISC_OFF = LDSCTL_OFF + 320;
constexpr int SEGTAB_OFF = LDSCTL_OFF + 1024;  static_assert(LDSCTL_OFF + 1024 + 3 * 256 * 16 <= 147456, "segment table inside the LDS allocation");
constexpr int LDS_BYTES = 147456;
constexpr int NWAVES = 8;

#define GAS __attribute__((address_space(1)))
#define LAS __attribute__((address_space(3)))
typedef unsigned short bf16;
typedef unsigned v4u __attribute__((ext_vector_type(4)));
typedef unsigned v2u __attribute__((ext_vector_type(2)));
typedef float f32x4 __attribute__((ext_vector_type(4)));
typedef float f32x2 __attribute__((ext_vector_type(2)));
typedef short bf16x8 __attribute__((ext_vector_type(8)));
typedef short s16x4 __attribute__((ext_vector_type(4)));
typedef GAS unsigned gu32;
#define RLX_AGENT __ATOMIC_RELAXED, __HIP_MEMORY_SCOPE_AGENT
#define LDS_WAIT() asm volatile("s_waitcnt lgkmcnt(0)" ::: "memory")
#define VM_WAIT() asm volatile("s_waitcnt vmcnt(0)" ::: "memory")
__device__ __forceinline__ unsigned f2bf(float f) { unsigned u = __builtin_bit_cast(unsigned, f); return (u + 0x7fffu + ((u >> 16) & 1u)) >> 16; }
typedef __bf16 bf16v2 __attribute__((ext_vector_type(2)));
__device__ __forceinline__ unsigned pk2(float lo, float hi) { bf16v2 v; v.x = (__bf16)lo; v.y = (__bf16)hi; return __builtin_bit_cast(unsigned, v); }
__device__ __forceinline__ float bflo(unsigned w) { return __builtin_bit_cast(float, w << 16); }
__device__ __forceinline__ float bfhi(unsigned w) { return __builtin_bit_cast(float, w & 0xffff0000u); }
__device__ __forceinline__ float wave_sum(float v) {
#pragma unroll
    for (int o = 1; o < 64; o <<= 1) v += __shfl_xor(v, o);
    return v;
}
__device__ __forceinline__ float silu_f(float x) { return x * __builtin_amdgcn_rcpf(1.f + __expf(-x)); }

#define XB_TMO      128
#define XB_XCNT(j)  (256  + 64 * (j))
#define XB_XSUB(j)  (1280 + 64 * (j))
#define XB_XGEN(j)  (2304 + 64 * (j))
#define XB_TOP      3328
#define XB_TOPGEN   3392
#define XCD_BAR_WORDS 3456
#define XB_SPIN_CAP (1u << 18)

__device__ __forceinline__ unsigned xb_ld(unsigned* p)              { return __hip_atomic_load(p, __ATOMIC_RELAXED, __HIP_MEMORY_SCOPE_AGENT); }
__device__ __forceinline__ unsigned xb_add(unsigned* p, unsigned v) { return __hip_atomic_fetch_add(p, v, __ATOMIC_RELAXED, __HIP_MEMORY_SCOPE_AGENT); }
__device__ __forceinline__ unsigned xb_xcc_id() { return (unsigned)__builtin_amdgcn_s_getreg((3 << 11) | 20) & 0xFu; }
#define XB_SPIN(cond, bar) do { unsigned _sp = 0; while (cond) { __builtin_amdgcn_s_sleep(1); \
    if ((++_sp & 255u) == 0u) { if (xb_ld(&(bar)[XB_TMO])) break; if (_sp > XB_SPIN_CAP) { atomicAdd(&(bar)[XB_TMO], 1u); break; } } } } while (0)

struct XcdBarrier {
    unsigned* bar; unsigned x;
    volatile LAS unsigned* st;
};
__device__ __forceinline__ XcdBarrier xcd_barrier_post(unsigned* bar, volatile LAS unsigned* st) {
    XcdBarrier b; b.bar = bar; b.x = xb_xcc_id(); b.st = st;
    if (threadIdx.x == 0) (void)xb_add(&bar[XB_XCNT(b.x)], 1u);
    return b;
}
__device__ __forceinline__ void xcd_barrier_complete(unsigned* bar, unsigned x, unsigned& nloc, unsigned& nx) {
    const unsigned G = gridDim.x * gridDim.y * gridDim.z;
    unsigned sum, cnt, mine, sp = 0u;
    for (;;) {
        sum = 0u; cnt = 0u; mine = 0u;
#pragma unroll
        for (unsigned j = 0; j < 16; ++j) { const unsigned c = xb_ld(&bar[XB_XCNT(j)]); sum += c; cnt += (c > 0u) ? 1u : 0u; mine = (j == x) ? c : mine; }
        if (sum == G) break;
        __builtin_amdgcn_s_sleep(1);
        if ((++sp & 255u) == 0u) { if (xb_ld(&bar[XB_TMO])) break; if (sp > XB_SPIN_CAP) { atomicAdd(&bar[XB_TMO], 1u); break; } }
    }
    nloc = mine > 0u ? mine : 1u; nx = cnt > 0u ? cnt : 1u;
}
__device__ __forceinline__ void xcd_barrier(const XcdBarrier& b) {
    asm volatile("s_waitcnt vmcnt(0)" ::: "memory");
    __syncthreads();
    if (threadIdx.x == 0) {
        unsigned* bar = b.bar;
        __builtin_amdgcn_s_waitcnt(0);
        unsigned nloc = b.st[0], nx = b.st[1];
        if (nloc == 0u) { xcd_barrier_complete(bar, b.x, nloc, nx); b.st[0] = nloc; b.st[1] = nx; }
        const unsigned old = xb_add(&bar[XB_XSUB(b.x)], 1u);
        const unsigned gen = old / nloc;
        if (old + 1u == (gen + 1u) * nloc) {
            __builtin_amdgcn_fence(__ATOMIC_RELEASE, "agent");
            asm volatile("s_waitcnt vmcnt(0)" ::: "memory");
            const unsigned og = xb_add(&bar[XB_TOP], 1u);
            const unsigned tg = og / nx;
            if (og + 1u == (tg + 1u) * nx) xb_add(&bar[XB_TOPGEN], 1u);
            else XB_SPIN(xb_ld(&bar[XB_TOPGEN]) == tg, bar);
            __builtin_amdgcn_fence(__ATOMIC_ACQUIRE, "agent");
            xb_add(&bar[XB_XGEN(b.x)], 1u);
            asm volatile("s_waitcnt vmcnt(0)" ::: "memory");
        } else {
            XB_SPIN(xb_ld(&bar[XB_XGEN(b.x)]) == gen, bar);
            __builtin_amdgcn_fence(__ATOMIC_ACQUIRE, "agent");
            asm volatile("s_waitcnt vmcnt(0)" ::: "memory");
        }
    }
    __syncthreads();
}

#define CAS __attribute__((address_space(4)))
struct Args { const float* in[18]; float* out; unsigned char* ws; };
__device__ __forceinline__ const CAS unsigned char* kargs() { const CAS unsigned char* p = (const CAS unsigned char*)__builtin_amdgcn_kernarg_segment_ptr(); asm volatile("" : "+s"(p)); return p; }
__device__ __forceinline__ const float* kin(int i) { return *(const float* const CAS*)(kargs() + 8 * i); }
__device__ __forceinline__ float* kout() { return *(float* const CAS*)(kargs() + 8 * 18); }
__device__ __forceinline__ unsigned char* kws() { return *(unsigned char* const CAS*)(kargs() + 8 * 19); }
__device__ __forceinline__ int fresh_tid() { int t = threadIdx.x; asm volatile("" : "+v"(t)); return t; }
struct Frame {
    LAS unsigned char* lds;
    volatile LAS unsigned* MISC;
    int tid, lane, wave, G;
    __device__ __forceinline__ const float* x() const { return kin(0); }
    __device__ __forceinline__ const float* attn_norm() const { return kin(1); }
    __device__ __forceinline__ const float* w_in() const { return kin(2); }
    __device__ __forceinline__ const float* conv_w() const { return kin(3); }
    __device__ __forceinline__ const float* conv_b() const { return kin(4); }
    __device__ __forceinline__ const float* dt_bias() const { return kin(5); }
    __device__ __forceinline__ const float* a_log() const { return kin(6); }
    __device__ __forceinline__ const float* d_skip() const { return kin(7); }
    __device__ __forceinline__ const float* rel_bias() const { return kin(8); }
    __device__ __forceinline__ const float* attn_out_norm() const { return kin(9); }
    __device__ __forceinline__ const float* ssm_out_norm() const { return kin(10); }
    __device__ __forceinline__ const float* w_out() const { return kin(11); }
    __device__ __forceinline__ const float* ffn_norm() const { return kin(12); }
    __device__ __forceinline__ const float* peer_wq() const { return kin(13); }
    __device__ __forceinline__ const float* peer_sk() const { return kin(14); }
    __device__ __forceinline__ const float* peer_u() const { return kin(15); }
    __device__ __forceinline__ const float* peer_v() const { return kin(16); }
    __device__ __forceinline__ const float* final_norm() const { return kin(17); }
    __device__ __forceinline__ float* out() const { return kout(); }
    __device__ __forceinline__ unsigned* ctl() const { return (unsigned*)(kws() + WS_CTL); }
    __device__ __forceinline__ float* dtraw() const { return (float*)(kws() + WS_DT); }
    __device__ __forceinline__ bf16* SK() const { return (bf16*)(kws() + WS_SK); }
    __device__ __forceinline__ bf16* WinT() const { return (bf16*)(kws() + WS_WIN); }
    __device__ __forceinline__ bf16* WoutT() const { return (bf16*)(kws() + WS_WOUT); }
    __device__ __forceinline__ bf16* WqT() const { return (bf16*)(kws() + WS_WQ); }
    __device__ __forceinline__ bf16* HN() const { return (bf16*)(kws() + WS_HN); }
    __device__ __forceinline__ bf16* PROJ() const { return (bf16*)(kws() + WS_PROJ); }
    __device__ __forceinline__ bf16* X1B() const { return (bf16*)(kws() + WS_X1B); }
    __device__ __forceinline__ bf16* QP() const { return (bf16*)(kws() + WS_QP); }
    __device__ __forceinline__ unsigned char* U8() const { return kws() + WS_U8; }
    __device__ __forceinline__ unsigned char* V8() const { return kws() + WS_V8; }
    __device__ __forceinline__ unsigned char* X18() const { return kws() + WS_X18; }
    __device__ __forceinline__ unsigned char* HN8() const { return kws() + WS_HN8; }
    __device__ __forceinline__ unsigned char* WinT8() const { return kws() + WS_WIN8; }
    __device__ __forceinline__ bf16* XBC() const { return (bf16*)(kws() + WS_XBC); }
    __device__ __forceinline__ float* DT2() const { return (float*)(kws() + WS_DT2); }
    __device__ __forceinline__ float* kmean() const { return (float*)(kws() + WS_CTL) + CW_KMEAN; }
    __device__ __forceinline__ float* ssq() const { return (float*)(kws() + WS_CTL) + CW_SSQ; }
};

__device__ __forceinline__ float clampf(float v, float lim);
__device__ __forceinline__ void p0_transpose_item(const float* W, int K, int N, bf16* WT, const float* gain, LAS float* scr, int item, int lane, const float f8scale = 0.f, const int nshift = 0, const bool kperm = false) {
    const int nblk = (N + 31) / 32, kb = item / nblk, nb = item % nblk, k0 = 64 * kb, n0 = 32 * nb;
    const int kr = lane >> 3, nc = (lane & 7) * 4; const bool ok = (n0 + nc) < N;
    f32x4 v[8]; float gk[8];
#pragma unroll
    for (int i = 0; i < 8; ++i) { const int kk = 8 * i + kr; v[i] = ok ? *(const GAS f32x4*)(W + (size_t)(k0 + kk) * N + n0 + nc) : (f32x4){0.f, 0.f, 0.f, 0.f}; gk[i] = gain ? gain[k0 + kk] : 1.f; }
#pragma unroll
    for (int i = 0; i < 8; ++i) { const int kk = 8 * i + kr; LAS float* d = scr + kk * 33 + nc; d[0] = v[i].x * gk[i]; d[1] = v[i].y * gk[i]; d[2] = v[i].z * gk[i]; d[3] = v[i].w * gk[i]; }
    LDS_WAIT(); asm volatile("" ::: "memory");
    const int c = lane & 7;
#pragma unroll
    for (int j = 0; j < 4; ++j) { const int n = (lane >> 3) + 8 * j; const LAS float* s = scr + (8 * c) * 33 + n;
        v4u o; o.x = pk2(s[0 * 33], s[1 * 33]); o.y = pk2(s[2 * 33], s[3 * 33]); o.z = pk2(s[4 * 33], s[5 * 33]); o.w = pk2(s[6 * 33], s[7 * 33]);
        if (f8scale == 0.f) *(GAS v4u*)(WT + (size_t)(n0 + n - nshift) * K + k0 + 8 * c) = o;
        else { v2u o8; int w_;
            w_ = __builtin_amdgcn_cvt_pk_fp8_f32(clampf(s[0 * 33] * f8scale, 448.f), clampf(s[1 * 33] * f8scale, 448.f), 0, false); w_ = __builtin_amdgcn_cvt_pk_fp8_f32(clampf(s[2 * 33] * f8scale, 448.f), clampf(s[3 * 33] * f8scale, 448.f), w_, true); o8.x = (unsigned)w_;
            w_ = __builtin_amdgcn_cvt_pk_fp8_f32(clampf(s[4 * 33] * f8scale, 448.f), clampf(s[5 * 33] * f8scale, 448.f), 0, false); w_ = __builtin_amdgcn_cvt_pk_fp8_f32(clampf(s[6 * 33] * f8scale, 448.f), clampf(s[7 * 33] * f8scale, 448.f), w_, true); o8.y = (unsigned)w_;
            if (!kperm) *(GAS v2u*)((unsigned char*)WT + (size_t)(n0 + n - nshift) * K + k0 + 8 * c) = o8;
            else { unsigned char* rowp = (unsigned char*)WT + (size_t)(n0 + n - nshift) * K + k0 + 4 * (c >> 1);
                *(GAS unsigned*)(rowp + 32 * (c & 1)) = o8.x; *(GAS unsigned*)(rowp + 32 * (c & 1) + 16) = o8.y; } } }
    LDS_WAIT(); asm volatile("" ::: "memory");
}
__device__ __forceinline__ unsigned pk4_fp8(float a, float b, float c, float d) { int w = __builtin_amdgcn_cvt_pk_fp8_f32(clampf(a, 448.f), clampf(b, 448.f), 0, false); w = __builtin_amdgcn_cvt_pk_fp8_f32(clampf(c, 448.f), clampf(d, 448.f), w, true); return (unsigned)w; }
__device__ __forceinline__ void rms_2rows_to_bf16(const float* x0, const float* x1, const float* gain, bf16* o0, bf16* o1, unsigned char* q0, unsigned char* q1, int lane) {
    const GAS f32x4* xr0 = (const GAS f32x4*)x0 + lane; const GAS f32x4* xr1 = (const GAS f32x4*)x1 + lane; const GAS f32x4* gr = (const GAS f32x4*)gain + lane;
    f32x4 v[8], u[8]; float s = 0.f, t = 0.f;
#pragma unroll
    for (int j = 0; j < 8; ++j) { v[j] = xr0[64 * j]; u[j] = xr1[64 * j]; }
#pragma unroll
    for (int j = 0; j < 8; ++j) { s += (v[j].x * v[j].x + v[j].y * v[j].y) + (v[j].z * v[j].z + v[j].w * v[j].w); t += (u[j].x * u[j].x + u[j].y * u[j].y) + (u[j].z * u[j].z + u[j].w * u[j].w); }
    const float rs = __builtin_amdgcn_rsqf(wave_sum(s) * (1.f / DM) + EPS), rt = __builtin_amdgcn_rsqf(wave_sum(t) * (1.f / DM) + EPS);
    GAS v2u* p0 = (GAS v2u*)o0 + lane; GAS v2u* p1 = (GAS v2u*)o1 + lane; GAS unsigned* r0 = (GAS unsigned*)q0 + lane; GAS unsigned* r1 = (GAS unsigned*)q1 + lane;
#pragma unroll
    for (int j = 0; j < 8; ++j) { const f32x4 g = gr[64 * j]; v2u a, b;
        const f32x4 h0 = v[j] * g * rs, h1 = u[j] * g * rt;
        a.x = pk2(h0.x, h0.y); a.y = pk2(h0.z, h0.w); p0[64 * j] = a; r0[64 * j] = pk4_fp8(h0.x * SH8, h0.y * SH8, h0.z * SH8, h0.w * SH8);
        b.x = pk2(h1.x, h1.y); b.y = pk2(h1.z, h1.w); p1[64 * j] = b; r1[64 * j] = pk4_fp8(h1.x * SH8, h1.y * SH8, h1.z * SH8, h1.w * SH8); }
}
#ifdef PROBE_FP4EMU
__device__ __forceinline__ float fp4grid(float y) { const float a = fabsf(y); float r;
    if (a <= 2.f) r = rintf(a * 2.f) * 0.5f; else if (a <= 4.f) r = rintf(a); else r = (a < 5.f) ? 4.f : 6.f;
    return copysignf(r, y); }
__device__ __forceinline__ float clampf(float v, float lim) { if (lim == 448.5f) return fp4grid(v * (1.f / 16.f)) * 16.f; return fminf(fmaxf(v, -lim), lim); }
#else
__device__ __forceinline__ float clampf(float v, float lim) { return fminf(fmaxf(v, -lim), lim); }
#endif
template <int TAB = 0> __device__ __forceinline__ v4u cvt16_fp8(const f32x4 a, const f32x4 b, const f32x4 c, const f32x4 d, float sc) {
    v4u o; int w; constexpr float LIM = TAB ? 448.5f : 448.f;
    w = __builtin_amdgcn_cvt_pk_fp8_f32(clampf(a.x * sc, LIM), clampf(a.y * sc, LIM), 0, false); w = __builtin_amdgcn_cvt_pk_fp8_f32(clampf(a.z * sc, LIM), clampf(a.w * sc, LIM), w, true); o.x = (unsigned)w;
    w = __builtin_amdgcn_cvt_pk_fp8_f32(clampf(b.x * sc, LIM), clampf(b.y * sc, LIM), 0, false); w = __builtin_amdgcn_cvt_pk_fp8_f32(clampf(b.z * sc, LIM), clampf(b.w * sc, LIM), w, true); o.y = (unsigned)w;
    w = __builtin_amdgcn_cvt_pk_fp8_f32(clampf(c.x * sc, LIM), clampf(c.y * sc, LIM), 0, false); w = __builtin_amdgcn_cvt_pk_fp8_f32(clampf(c.z * sc, LIM), clampf(c.w * sc, LIM), w, true); o.z = (unsigned)w;
    w = __builtin_amdgcn_cvt_pk_fp8_f32(clampf(d.x * sc, LIM), clampf(d.y * sc, LIM), 0, false); w = __builtin_amdgcn_cvt_pk_fp8_f32(clampf(d.z * sc, LIM), clampf(d.w * sc, LIM), w, true); o.w = (unsigned)w;
    return o;
}
__device__ __forceinline__ void tables_convert(Frame& F, size_t lo, size_t hi, size_t tix, size_t ntx) {
      const GAS f32x4* su = (const GAS f32x4*)F.peer_u(); const GAS f32x4* sv = (const GAS f32x4*)F.peer_v(); GAS v4u* du = (GAS v4u*)F.U8(); GAS v4u* dv = (GAS v4u*)F.V8();
#pragma unroll 1
      for (int tab = 0; tab < 2; ++tab) { const GAS f32x4* src = tab ? sv : su; GAS v4u* dst = tab ? dv : du; const float sc = tab ? SV : SU;
        f32x4 nx[8]; const size_t i0 = lo + tix;
        if (i0 < hi) { const GAS f32x4* p = src + (i0 >> 6) * 512 + (i0 & 63);
#pragma unroll
            for (int j = 0; j < 8; ++j) nx[j] = p[64 * j]; }
#pragma unroll 1
        for (size_t i = i0; i < hi; i += ntx) { f32x4 v[8];
#pragma unroll
            for (int j = 0; j < 8; ++j) v[j] = nx[j];
            if (i + ntx < hi) { const size_t i2 = i + ntx; const GAS f32x4* p = src + (i2 >> 6) * 512 + (i2 & 63);
#pragma unroll
                for (int j = 0; j < 8; ++j) nx[j] = p[64 * j]; }
            unsigned wd[4];
#pragma unroll
            for (int q = 0; q < 4; ++q) { const f32x4 a = v[2 * q] * sc, b = v[2 * q + 1] * sc; unsigned w = 0u;
                w = __builtin_amdgcn_cvt_scalef32_pk_fp4_f32(w, clampf(a.x, 6.f), clampf(a.y, 6.f), 1.0f, 0); w = __builtin_amdgcn_cvt_scalef32_pk_fp4_f32(w, clampf(a.z, 6.f), clampf(a.w, 6.f), 1.0f, 1);
                w = __builtin_amdgcn_cvt_scalef32_pk_fp4_f32(w, clampf(b.x, 6.f), clampf(b.y, 6.f), 1.0f, 2); w = __builtin_amdgcn_cvt_scalef32_pk_fp4_f32(w, clampf(b.z, 6.f), clampf(b.w, 6.f), 1.0f, 3); wd[q] = w; }
            dst[i] = (v4u){wd[0], wd[1], wd[2], wd[3]}; } }
}
constexpr size_t TAB_ITEMS = (size_t)16384 * 64;
#ifndef TAB_HEAD8
#define TAB_HEAD8 4
#endif
__device__ __forceinline__ size_t tab_split(int G) { const int rem = ((MTOK / 256) * (NB16 / 256)) % G; return rem ? (TAB_ITEMS / 8) * TAB_HEAD8 : TAB_ITEMS; }
__device__ __forceinline__ unsigned fp4_code(float y) { const float a = fabsf(y);
    const unsigned m = (unsigned)(a >= 0.25f) + (unsigned)(a >= 0.75f) + (unsigned)(a >= 1.25f) + (unsigned)(a >= 1.75f) + (unsigned)(a >= 2.5f) + (unsigned)(a >= 3.5f) + (unsigned)(a >= 5.0f);
    return m | ((y < 0.f) ? 8u : 0u); }
constexpr int W_SQ_ITEMS = (DM / 64) * (DM / 32), W_SQ_PER_UNIT = 64, W_SQ_UNITS = 2 * W_SQ_ITEMS / W_SQ_PER_UNIT;
__device__ __forceinline__ void sq_weight_items(Frame& F, int unit) {
    const int tid = fresh_tid(), lane = tid & 63, wave = __builtin_amdgcn_readfirstlane(tid >> 6);
    LAS float* scr = (LAS float*)(F.lds + RING_OFF + wave * 16384);
    const float* const w_out = F.w_out(); const float* const wq = F.peer_wq(); const float* const fg = F.ffn_norm(); bf16* const WoutT = F.WoutT(); bf16* const WqT = F.WqT(); const float* const gatt = F.attn_out_norm(); const float* const gssm = F.ssm_out_norm();
#pragma unroll 1
    for (int k = 0; k < W_SQ_PER_UNIT / NWAVES; ++k) {
        int r = unit * W_SQ_PER_UNIT + k * NWAVES + wave;
        if (r < W_SQ_ITEMS) { const int k0_ = 64 * (r / (DM / 32)); p0_transpose_item(w_out, DM, DM, WoutT, (k0_ < ATT_W) ? gatt : (gssm - ATT_W), scr, r, lane, SW8, 0, true); }
        else { r -= W_SQ_ITEMS; p0_transpose_item(wq, DM, DM, WqT, fg, scr, r, lane, SW8); }
    }
}
__device__ __forceinline__ void p0_prologue(Frame& F) {
    const int tid = fresh_tid(), lane = tid & 63, wave = __builtin_amdgcn_readfirstlane(tid >> 6);
    LAS float* scr = (LAS float*)(F.lds + RING_OFF + wave * 16384);
    const int gw = blockIdx.x * NWAVES + wave, NGW = F.G * NWAVES;
    constexpr int I_IN = (DM / 64) * ((IN_PROJ + 31) / 32), I_SQ = (DM / 64) * (DM / 32);
    constexpr int NITEMS = I_IN;
    { const float* const w_in = F.w_in(); const float* const w_out = F.w_out(); const float* const wq = F.peer_wq(); const float* const fg = F.ffn_norm(); bf16* const WinT = F.WinT(); unsigned char* const WinT8 = F.WinT8(); bf16* const WoutT = F.WoutT(); bf16* const WqT = F.WqT(); const float* const gatt = F.attn_out_norm(); const float* const gssm = F.ssm_out_norm();
      for (int it = gw; it < NITEMS; it += NGW) {
        int r = it;
        if (r < I_IN) { const int n0_ = 32 * (r % ((IN_PROJ + 31) / 32));
            if (n0_ >= F8_LO && n0_ < F8_HI) p0_transpose_item(w_in, DM, IN_PROJ, (bf16*)WinT8, nullptr, scr, r, lane, SW8, F8_LO);
            else p0_transpose_item(w_in, DM, IN_PROJ, WinT, nullptr, scr, r, lane, 0.f, (n0_ >= F8_HI) ? (F8_HI - F8_LO) : 0);
            continue; } r -= I_IN;
      } }
    const size_t gt = (size_t)blockIdx.x * (NWAVES * 64) + tid, GT = (size_t)F.G * NWAVES * 64;
    { const size_t z0 = (size_t)(5664 - (F8_HI - F8_LO)) * DM / 8, z1 = (size_t)NB16 * DM / 8; GAS v4u* p = (GAS v4u*)F.WinT(); for (size_t i = z0 + gt; i < z1; i += GT) p[i] = (v4u){0u, 0u, 0u, 0u}; }
    { const float* const s = F.peer_sk(); GAS v4u* d = (GAS v4u*)F.SK();
      for (size_t o = gt; o < (size_t)16 * 128 * 128 / 8; o += GT) { const int frag = (int)(o >> 6), l = (int)(o & 63), g_ = l >> 4, c_ = l & 15, p_ = frag >> 5, kb_ = (frag >> 2) & 7, ks_ = frag & 3;
          const GAS f32x4* sp = (const GAS f32x4*)(s + (size_t)(p_ * 128 + 16 * kb_ + c_) * 128 + 32 * ks_ + 8 * g_); const f32x4 a = sp[0], b = sp[1];
          v4u w; w.x = pk2(a.x, a.y); w.y = pk2(a.z, a.w); w.z = pk2(b.x, b.y); w.w = pk2(b.z, b.w); d[o] = w; } }
    { const float* const xg = F.x(); const float* const gn = F.attn_norm(); bf16* const hn = F.HN(); unsigned char* const hn8 = F.HN8();
      for (int m = gw; m < MTOK / 2; m += NGW) rms_2rows_to_bf16(xg + (size_t)(2 * m) * DM, xg + (size_t)(2 * m + 1) * DM, gn, hn + (size_t)(2 * m) * DM, hn + (size_t)(2 * m + 1) * DM, hn8 + (size_t)(2 * m) * DM, hn8 + (size_t)(2 * m + 1) * DM, lane); }
}

struct EpiProj {
    static constexpr bool PERM = true, AFTER_DRAIN = false, SEG = false;
    bf16* O; float* dtraw; float* kmean;
    __device__ __forceinline__ void operator()(const pg8::f32x4 (&acc)[2][2][4][2], const pg8::Unit& u, int wr, int wc, int fr, int fq) const {
        const int rpn = (u.pn < F8_LO / 256) ? u.pn : u.pn + (F8_HI - F8_LO) / 256;
        const int row0 = u.pm * 256 + wr * 64 + fr, col0 = rpn * 256 + wc * 32 + 8 * fq;
        if (rpn < 22) {
#pragma unroll
            for (int ai = 0; ai < 2; ++ai)
#pragma unroll
                for (int m = 0; m < 4; ++m) { bf16* rowp = O + (size_t)(row0 + ai * 128 + m * 16) * NPROJ + col0;
#pragma unroll
                    for (int bj = 0; bj < 2; ++bj) { const pg8::f32x4 v0 = acc[ai][bj][m][0], v1 = acc[ai][bj][m][1];
                        pg8::u32x4 w; w.x = pg8::cvt_pk_bf16(v0[0], v0[1]); w.y = pg8::cvt_pk_bf16(v0[2], v0[3]); w.z = pg8::cvt_pk_bf16(v1[0], v1[1]); w.w = pg8::cvt_pk_bf16(v1[2], v1[3]);
                        *(pg8::u32x4*)(rowp + bj * 128) = w; } }
        } else if (wc == 0 && fq < 2) {
#pragma unroll
            for (int ai = 0; ai < 2; ++ai)
#pragma unroll
                for (int m = 0; m < 4; ++m) { float* rp = dtraw + (size_t)(row0 + ai * 128 + m * 16) * 16 + 8 * fq;
                    *(pg8::f32x4*)rp = acc[ai][0][m][0]; *(pg8::f32x4*)(rp + 4) = acc[ai][0][m][1]; }
        }
        if (kmean && u.pn >= 4 && u.pn < 8) {
#pragma unroll
            for (int bj = 0; bj < 2; ++bj)
#pragma unroll
                for (int n = 0; n < 2; ++n)
#pragma unroll
                    for (int i = 0; i < 4; ++i) { float s = 0.f;
#pragma unroll
                        for (int ai = 0; ai < 2; ++ai)
#pragma unroll
                            for (int m = 0; m < 4; ++m) s += acc[ai][bj][m][n][i];
                        s += __shfl_xor(s, 1); s += __shfl_xor(s, 2); s += __shfl_xor(s, 4); s += __shfl_xor(s, 8);
                        if (fr == 0) unsafeAtomicAdd(kmean + (size_t)u.pm * 1024 + (col0 - 1024) + bj * 128 + 4 * n + i, s); }
        }
    }
};
struct EpiProj8 {
    static constexpr bool PERM = true, AFTER_DRAIN = false, SEG = false;
    bf16* O;
    __device__ __forceinline__ void operator()(const pg8::f32x4 (&acc)[2][2][4][2], const pg8::Unit& u, int wr, int wc, int fr, int fq) const {
        const int row0 = u.pm * 256 + wr * 64 + fr, col0 = F8_LO + u.pn * 256 + wc * 32 + 8 * fq; constexpr float sc = 1.f / (SH8 * SW8);
#pragma unroll
        for (int ai = 0; ai < 2; ++ai)
#pragma unroll
            for (int m = 0; m < 4; ++m) { bf16* rowp = O + (size_t)(row0 + ai * 128 + m * 16) * NPROJ + col0;
#pragma unroll
                for (int bj = 0; bj < 2; ++bj) { const pg8::f32x4 v0 = acc[ai][bj][m][0] * sc, v1 = acc[ai][bj][m][1] * sc;
                    pg8::u32x4 w; w.x = pg8::cvt_pk_bf16(v0[0], v0[1]); w.y = pg8::cvt_pk_bf16(v0[2], v0[3]); w.z = pg8::cvt_pk_bf16(v1[0], v1[1]); w.w = pg8::cvt_pk_bf16(v1[2], v1[3]);
                    *(pg8::u32x4*)(rowp + bj * 128) = w; } }
    }
};
struct EpiOut {
    static constexpr bool PERM = true, AFTER_DRAIN = false, SEG = true; static constexpr int SEG_T1 = 8, SEG_T2 = 12;
    const float* x; bf16* x1b; unsigned char* x18; float* ssq; bool doatom; const LAS f32x4* tab;
    __device__ __forceinline__ void seg_load(int ui, int wr, int fr, float (&sr)[16]) const {
#pragma unroll
        for (int i = 0; i < 8; ++i) { const int r = (i >> 2) * 128 + wr * 64 + (i & 3) * 16 + fr; const f32x2 q = *(const LAS f32x2*)(tab + ui * 256 + r); sr[2 * i] = q.x; sr[2 * i + 1] = q.y; }
        asm volatile("s_waitcnt lgkmcnt(0)" ::: "memory");
    }
    __device__ __forceinline__ void seg_apply(pg8::f32x4 (&acc)[2][2][4][2], const float (&sr)[16], int which) const {
#pragma unroll
        for (int ai = 0; ai < 2; ++ai)
#pragma unroll
            for (int m = 0; m < 4; ++m) { const float f = (which == 0) ? sr[2 * (ai * 4 + m)] : ((which == 1) ? sr[2 * (ai * 4 + m) + 1] : 1.0f);
#pragma unroll
                for (int bj = 0; bj < 2; ++bj)
#pragma unroll
                    for (int n = 0; n < 2; ++n) acc[ai][bj][m][n] = acc[ai][bj][m][n] * f; }
    }
    __device__ __forceinline__ void operator()(const pg8::f32x4 (&acc)[2][2][4][2], const pg8::Unit& u, int wr, int wc, int fr, int fq, int ui) const {
        const int row0 = u.pm * 256 + wr * 64 + fr, col0 = u.pn * 256 + wc * 32 + 8 * fq;
#pragma unroll
        for (int ai = 0; ai < 2; ++ai)
#pragma unroll
            for (int m = 0; m < 4; ++m) { const int row = row0 + ai * 128 + m * 16; const size_t off = (size_t)row * DM + col0; float s = 0.f;
                const float s1 = (*(const LAS f32x4*)(tab + ui * 256 + ai * 128 + wr * 64 + m * 16 + fr)).z;
#pragma unroll
                for (int bj = 0; bj < 2; ++bj) {
                    const pg8::f32x4 a0 = *(const pg8::f32x4*)(x + off + bj * 128), a1 = *(const pg8::f32x4*)(x + off + bj * 128 + 4);
                    const pg8::f32x4 v0 = acc[ai][bj][m][0] * s1 + a0, v1 = acc[ai][bj][m][1] * s1 + a1;
                    pg8::u32x4 w; w.x = pg8::cvt_pk_bf16(v0[0], v0[1]); w.y = pg8::cvt_pk_bf16(v0[2], v0[3]); w.z = pg8::cvt_pk_bf16(v1[0], v1[1]); w.w = pg8::cvt_pk_bf16(v1[2], v1[3]);
                    *(pg8::u32x4*)(x1b + off + bj * 128) = w;
                    { v2u o8; int w_; w_ = __builtin_amdgcn_cvt_pk_fp8_f32(clampf(v0[0] * SX8, 448.f), clampf(v0[1] * SX8, 448.f), 0, false); w_ = __builtin_amdgcn_cvt_pk_fp8_f32(clampf(v0[2] * SX8, 448.f), clampf(v0[3] * SX8, 448.f), w_, true); o8.x = (unsigned)w_;
                      w_ = __builtin_amdgcn_cvt_pk_fp8_f32(clampf(v1[0] * SX8, 448.f), clampf(v1[1] * SX8, 448.f), 0, false); w_ = __builtin_amdgcn_cvt_pk_fp8_f32(clampf(v1[2] * SX8, 448.f), clampf(v1[3] * SX8, 448.f), w_, true); o8.y = (unsigned)w_;
                      *(v2u*)(x18 + off + bj * 128) = o8; }
                    s += (v0[0] * v0[0] + v0[1] * v0[1]) + (v0[2] * v0[2] + v0[3] * v0[3]) + (v1[0] * v1[0] + v1[1] * v1[1]) + (v1[2] * v1[2] + v1[3] * v1[3]); }
                s += __shfl_xor(s, 16); s += __shfl_xor(s, 32);
                if (fq == 0 && doatom) unsafeAtomicAdd(ssq + (size_t)row * 4, s);
                asm volatile("" ::: "memory"); }
    }
};
struct EpiQ {
    static constexpr bool PERM = true, AFTER_DRAIN = false, SEG = false;
    bf16* O; const float* ssq;
    __device__ __forceinline__ void operator()(const pg8::f32x4 (&acc)[2][2][4][2], const pg8::Unit& u, int wr, int wc, int fr, int fq) const {
        const int row0 = u.pm * 256 + wr * 64 + fr, col0 = u.pn * 256 + wc * 32 + 8 * fq;
#pragma unroll
        for (int ai = 0; ai < 2; ++ai)
#pragma unroll
            for (int m = 0; m < 4; ++m) { const int row = row0 + ai * 128 + m * 16; bf16* rowp = O + (size_t)row * DM + col0;
                const float rs = (1.f / (SX8 * SW8)) / sqrtf(__hip_atomic_load(ssq + (size_t)row * 4, RLX_AGENT) * (1.f / DM) + EPS);
#pragma unroll
                for (int bj = 0; bj < 2; ++bj) { const pg8::f32x4 v0 = acc[ai][bj][m][0] * rs, v1 = acc[ai][bj][m][1] * rs;
                    pg8::u32x4 w; w.x = pg8::cvt_pk_bf16(v0[0], v0[1]); w.y = pg8::cvt_pk_bf16(v0[2], v0[3]); w.z = pg8::cvt_pk_bf16(v1[0], v1[1]); w.w = pg8::cvt_pk_bf16(v1[2], v1[3]);
                    *(pg8::u32x4*)(rowp + bj * 128) = w; } }
    }
};

constexpr int A_KSTR = 272, A_VSTR = 288;
constexpr int A_KB0 = 0, A_KB1 = 64 * A_KSTR, A_VB0 = 2 * 64 * A_KSTR, A_VBS = 64 * A_VSTR  , A_KM = A_VB0 + 3 * A_VBS, A_TAB = A_KM + 8 * 128 * 4, A_END = A_TAB + 128 * 4;
static_assert(A_END <= RING_BYTES && (A_KM % 16) == 0, "attention LDS map");
#define PIN16(a, i) asm volatile("" : "+v"(a[i]), "+v"(a[i + 1]), "+v"(a[i + 2]), "+v"(a[i + 3]), "+v"(a[i + 4]), "+v"(a[i + 5]), "+v"(a[i + 6]), "+v"(a[i + 7]), "+v"(a[i + 8]), "+v"(a[i + 9]), "+v"(a[i + 10]), "+v"(a[i + 11]), "+v"(a[i + 12]), "+v"(a[i + 13]), "+v"(a[i + 14]), "+v"(a[i + 15]))
#define TR16(p) __builtin_amdgcn_ds_read_tr16_b64_v4i16((LAS s16x4*)(p))
#define MFMA16(a, b, c) __builtin_amdgcn_mfma_f32_16x16x32_bf16((a), (b), (c), 0, 0, 0)
__device__ __forceinline__ bf16x8 pack8(const float* v) {
    const unsigned a = pk2(v[0], v[1]), b = pk2(v[2], v[3]), c = pk2(v[4], v[5]), d = pk2(v[6], v[7]);
    const v4u u = {a, b, c, d}; return __builtin_bit_cast(bf16x8, u);
}
__device__ __forceinline__ void attn_unit(Frame& F, int b, int h, int blk, const bool doatom = true) {
    LAS unsigned char* lds = F.lds + RING_OFF;
    const int tid = fresh_tid(), lane = tid & 63, w = __builtin_amdgcn_readfirstlane(tid >> 6), g = lane >> 4, c16 = lane & 15, q4 = c16 >> 2, p4 = lane & 3;
    const int own = blk, t0 = blk * 256, tq0 = t0 + 32 * w + c16;
    const size_t rowbase = (size_t)b * SEQ;
    const float NEG_INF = -__builtin_inff();
    constexpr float LOG2E = 1.4426950408889634f, SCL2 = 0.08838834764831845f * 1.4426950408889634f;
    LAS float* km = (LAS float*)(lds + A_KM); LAS float* tab = (LAS float*)(lds + A_TAB);
    const bf16* const PROJ = F.PROJ(); const float* const kmg = F.kmean(); const float* const relb = F.rel_bias();
    for (int i = tid; i < own * 128; i += NWAVES * 64) { const int n = i >> 7, d = i & 127; km[i] = kmg[(size_t)(b * 8 + n) * 1024 + h * 128 + d] * (1.f / 256.f); }
    if (tid < 128) { const int rel = tid; int bucket = rel; if (rel >= 16) { bucket = 16 + (int)(log2f((float)rel * (1.f / 16.f)) * (16.f / 3.f)); bucket = bucket > 31 ? 31 : bucket; }
        tab[tid] = relb[bucket * 8 + h] * LOG2E; }
    bf16x8 qf[2][4];
#pragma unroll
    for (int gi = 0; gi < 2; ++gi) { const bf16* qrow = PROJ + (rowbase + tq0 + 16 * gi) * NPROJ + COL_Q + h * 128 + 8 * g;
#pragma unroll
      for (int ks = 0; ks < 4; ++ks) qf[gi][ks] = *(const GAS bf16x8*)(qrow + 32 * ks); }
    __syncthreads();
    unsigned selmask[2];
    if (own <= 3) { selmask[0] = (1u << own) - 1u; selmask[1] = selmask[0]; }
    else {
#pragma unroll
      for (int gi = 0; gi < 2; ++gi) {
        float gate[7];
#pragma unroll
        for (int n = 0; n < 7; ++n) {
            float s = NEG_INF;
            if (n < own) { s = 0.f;
#pragma unroll
                for (int ks = 0; ks < 4; ++ks) { const LAS f32x4* kp = (const LAS f32x4*)(km + n * 128 + 32 * ks + 8 * g); const f32x4 k0 = kp[0], k1 = kp[1]; const v4u qu = __builtin_bit_cast(v4u, qf[gi][ks]);
                    s += bflo(qu.x) * k0.x + bfhi(qu.x) * k0.y + bflo(qu.y) * k0.z + bfhi(qu.y) * k0.w + bflo(qu.z) * k1.x + bfhi(qu.z) * k1.y + bflo(qu.w) * k1.z + bfhi(qu.w) * k1.w; }
                s += __shfl_xor(s, 16); s += __shfl_xor(s, 32); }
            gate[n] = s;
        }
        unsigned sm = 0u;
#pragma unroll
        for (int r = 0; r < 3; ++r) { float best = NEG_INF; int bi = 0;
#pragma unroll
            for (int n = 0; n < 7; ++n) { const bool cand = (n < own) && !((sm >> n) & 1u) && (gate[n] > best); best = cand ? gate[n] : best; bi = cand ? n : bi; }
            sm |= 1u << bi; }
        selmask[gi] = sm; }
    }
    const int nT = 4 + 4 * own;
    const int sr = tid >> 3, sc = (tid & 7) * 8;
#define A_KEY0(i) ((i) < 4 ? own * 256 + 64 * (i) : (((i) - 4) >> 2) * 256 + (((i) - 4) & 3) * 64)
    v4u kr0, kr1, vr0, vr1;
#define A_LOAD(i) do { const bf16* kp_ = PROJ + (rowbase + A_KEY0(i) + sr) * NPROJ + COL_K + h * 128 + sc; \
        kr0 = *(const GAS v4u*)kp_; kr1 = *(const GAS v4u*)(kp_ + 64); vr0 = *(const GAS v4u*)(kp_ + (COL_V - COL_K)); vr1 = *(const GAS v4u*)(kp_ + (COL_V - COL_K) + 64); } while (0)
#define A_STORE(bufi) do { LAS unsigned char* kd_ = lds + ((bufi) ? A_KB1 : A_KB0) + sr * A_KSTR + sc * 2; LAS unsigned char* vd_ = lds + A_VB0 + vnx * A_VBS + sr * A_VSTR + sc * 2; \
        *(LAS v4u*)kd_ = kr0; *(LAS v4u*)(kd_ + 128) = kr1; *(LAS v4u*)vd_ = vr0; *(LAS v4u*)(vd_ + 128) = vr1; } while (0)
    int vcur = 0, vnx = 0, vprev = 0;
#define A_PV(PF, Vb_) do { _Pragma("unroll") for (int s = 0; s < 2; ++s) { s16x4 vlo[8], vhi[8]; \
            _Pragma("unroll") for (int db = 0; db < 8; ++db) { LAS unsigned char* va = (Vb_) + (32 * s + 4 * g + q4) * A_VSTR + (16 * db + 4 * p4) * 2; vlo[db] = TR16(va); vhi[db] = TR16(va + 16 * A_VSTR); } \
            __builtin_amdgcn_sched_barrier(0); \
            _Pragma("unroll") for (int db = 0; db < 8; ++db) { const bf16x8 vf = __builtin_shufflevector(vlo[db], vhi[db], 0, 1, 2, 3, 4, 5, 6, 7); \
                oacc[0][db] = MFMA16(vf, PF[0][s], oacc[0][db]); oacc[1][db] = MFMA16(vf, PF[1][s], oacc[1][db]); } \
            __builtin_amdgcn_sched_barrier(0); } } while (0)
    A_LOAD(0); A_STORE(0);
    __syncthreads();
    const bool late = w >= 4;
    bf16x8 pfp[2][2]; bool skipp = true;
#pragma unroll
    for (int gi = 0; gi < 2; ++gi) { pfp[gi][0] = (bf16x8){0, 0, 0, 0, 0, 0, 0, 0}; pfp[gi][1] = pfp[gi][0]; }
    float m_run[2] = {NEG_INF, NEG_INF}, l_run[2] = {0.f, 0.f};
    f32x4 oacc[2][8];
#pragma unroll
    for (int gi = 0; gi < 2; ++gi)
#pragma unroll
        for (int db = 0; db < 8; ++db) oacc[gi][db] = (f32x4){0.f, 0.f, 0.f, 0.f};
    for (int i = 0; i < nT; ++i) {
        if (i + 1 < nT) A_LOAD(i + 1);
        vnx = (vcur == 2) ? 0 : vcur + 1;
        const int buf = i & 1, key0 = A_KEY0(i); const bool isown = i < 4; const int pblk = isown ? own : ((i - 4) >> 2);
        const bool skipw = isown && (64 * i > 32 * w + 31);
        if (late && !skipp) A_PV(pfp, lds + A_VB0 + vprev * A_VBS);
        bf16x8 pf[2][2];
        if (!skipw) {
        LAS unsigned char* Kb = lds + (buf ? A_KB1 : A_KB0);
        f32x4 sacc[2][4];
#pragma unroll
        for (int hf = 0; hf < 2; ++hf) { bf16x8 kf[8];
#pragma unroll
            for (int n2 = 0; n2 < 2; ++n2)
#pragma unroll
                for (int ks = 0; ks < 4; ++ks) kf[n2 * 4 + ks] = *(const LAS bf16x8*)(Kb + (16 * (2 * hf + n2) + c16) * A_KSTR + (32 * ks + 8 * g) * 2);
            __builtin_amdgcn_sched_barrier(0);
#pragma unroll
            for (int gi = 0; gi < 2; ++gi)
#pragma unroll
                for (int n2 = 0; n2 < 2; ++n2) { f32x4 a = (f32x4){0.f, 0.f, 0.f, 0.f};
#pragma unroll
                    for (int ks = 0; ks < 4; ++ks) a = MFMA16(kf[n2 * 4 + ks], qf[gi][ks], a);
                    sacc[gi][2 * hf + n2] = a; }
            __builtin_amdgcn_sched_barrier(0); }
        const bool far = (key0 + 63 + 128 <= t0 + 32 * w);
        const bool diag = isown && (64 * i + 63 > 32 * w);
#pragma unroll
        for (int gi = 0; gi < 2; ++gi) {
            const int tq = tq0 + 16 * gi; const bool sel = isown || ((selmask[gi] >> pblk) & 1u);
            float sv[16]; float mloc, m_new, alpha;
            if (far) {
                const float bfar = tab[127];
                float mx = fmaxf(fmaxf(sacc[gi][0][0], sacc[gi][0][1]), fmaxf(sacc[gi][0][2], sacc[gi][0][3]));
#pragma unroll
                for (int nb = 1; nb < 4; ++nb) mx = fmaxf(mx, fmaxf(fmaxf(sacc[gi][nb][0], sacc[gi][nb][1]), fmaxf(sacc[gi][nb][2], sacc[gi][nb][3])));
                mloc = sel ? (mx * SCL2 + bfar) : NEG_INF;
                mloc = fmaxf(mloc, __shfl_xor(mloc, 16)); mloc = fmaxf(mloc, __shfl_xor(mloc, 32));
                m_new = fmaxf(m_run[gi], mloc); alpha = __builtin_amdgcn_exp2f(m_run[gi] - m_new);
                const float cadd = sel ? (bfar - m_new) : NEG_INF;
#pragma unroll
                for (int nb = 0; nb < 4; ++nb)
#pragma unroll
                    for (int r = 0; r < 4; ++r) sv[nb * 4 + r] = __builtin_amdgcn_exp2f(sacc[gi][nb][r] * SCL2 + cadd);
            } else {
                const int relb = tq - key0 - 4 * g; float bias[16];
#pragma unroll
                for (int nb = 0; nb < 4; ++nb)
#pragma unroll
                    for (int r = 0; r < 4; ++r) { const int rel = relb - 16 * nb - r; int ri = rel < 0 ? 0 : rel; ri = ri > 127 ? 127 : ri; bias[nb * 4 + r] = tab[ri]; }
                PIN16(bias, 0);
                mloc = NEG_INF;
#pragma unroll
                for (int nb = 0; nb < 4; ++nb)
#pragma unroll
                    for (int r = 0; r < 4; ++r) { const int rel = relb - 16 * nb - r;
                        float s = sacc[gi][nb][r] * SCL2 + bias[nb * 4 + r]; s = (!sel || (diag && rel < 0)) ? NEG_INF : s; sv[nb * 4 + r] = s; mloc = fmaxf(mloc, s); }
                mloc = fmaxf(mloc, __shfl_xor(mloc, 16)); mloc = fmaxf(mloc, __shfl_xor(mloc, 32));
                m_new = fmaxf(m_run[gi], mloc); alpha = __builtin_amdgcn_exp2f(m_run[gi] - m_new);
#pragma unroll
                for (int e = 0; e < 16; ++e) sv[e] = __builtin_amdgcn_exp2f(sv[e] - m_new);
            }
            float psum = 0.f;
#pragma unroll
            for (int e = 0; e < 16; ++e) psum += sv[e];
            l_run[gi] = l_run[gi] * alpha + psum; m_run[gi] = m_new;
#pragma unroll
            for (int db = 0; db < 8; ++db) oacc[gi][db] = oacc[gi][db] * alpha;
            pf[gi][0] = pack8(sv); pf[gi][1] = pack8(sv + 8);
        }
        __builtin_amdgcn_sched_barrier(0);
        if (!late) A_PV(pf, lds + A_VB0 + vcur * A_VBS);
        }
        if (late) { skipp = skipw;
#pragma unroll
            for (int gi = 0; gi < 2; ++gi) { pfp[gi][0] = pf[gi][0]; pfp[gi][1] = pf[gi][1]; } }
        if (i + 1 < nT) A_STORE((i + 1) & 1);
        vprev = vcur; vcur = vnx;
        __syncthreads();
    }
    if (late && !skipp) A_PV(pfp, lds + A_VB0 + vprev * A_VBS);
#undef A_PV
    bf16* const MIXp = F.HN(); float* const ssqp = F.ssq();
#pragma unroll
    for (int gi = 0; gi < 2; ++gi) {
        const int tq = tq0 + 16 * gi;
        float l_tot = l_run[gi]; l_tot += __shfl_xor(l_tot, 16); l_tot += __shfl_xor(l_tot, 32);
        const float inv = 1.f / l_tot; float ssq = 0.f;
        unsigned char* orow = (unsigned char*)MIXp + (rowbase + tq) * DM + h * 128 + 16 * g;
        unsigned ow[8];
#pragma unroll
        for (int db = 0; db < 8; ++db) { const f32x4 o = oacc[gi][db] * inv; ssq += (o.x * o.x + o.y * o.y) + (o.z * o.z + o.w * o.w); ow[db] = pk4_fp8(o.x * SA8, o.y * SA8, o.z * SA8, o.w * SA8); }
        *(GAS v4u*)orow = (v4u){ow[0], ow[1], ow[2], ow[3]}; *(GAS v4u*)(orow + 64) = (v4u){ow[4], ow[5], ow[6], ow[7]};
        ssq += __shfl_xor(ssq, 16); ssq += __shfl_xor(ssq, 32);
        if (g == 0 && doatom) unsafeAtomicAdd(ssqp + (rowbase + tq) * 4 + 1, ssq);
    }
#undef A_KEY0
#undef A_LOAD
#undef A_STORE
}

constexpr int XBC_W = CONV_CH;
__device__ __forceinline__ void conv_phase(Frame& F) {
    const bf16* const PROJ = F.PROJ(); bf16* const XBC = F.XBC(); const float* const cw = F.conv_w(); const float* const cb = F.conv_b();
    const int gt = blockIdx.x * (NWAVES * 64) + fresh_tid(), GT = F.G * NWAVES * 64;
    for (int task = gt; task < (MTOK / 32) * (CONV_CH / 8); task += GT) {
        const int r = task / (CONV_CH / 8), k = task % (CONV_CH / 8), ch = 8 * k, tok0 = 32 * r;
        float wv[4][8], bias[8];
#pragma unroll
        for (int t = 0; t < 4; ++t) { const f32x4 w0 = *(const GAS f32x4*)(cw + t * CONV_CH + ch), w1 = *(const GAS f32x4*)(cw + t * CONV_CH + ch + 4);
            wv[t][0] = w0.x; wv[t][1] = w0.y; wv[t][2] = w0.z; wv[t][3] = w0.w; wv[t][4] = w1.x; wv[t][5] = w1.y; wv[t][6] = w1.z; wv[t][7] = w1.w; }
        { const f32x4 b0 = *(const GAS f32x4*)(cb + ch), b1 = *(const GAS f32x4*)(cb + ch + 4); bias[0] = b0.x; bias[1] = b0.y; bias[2] = b0.z; bias[3] = b0.w; bias[4] = b1.x; bias[5] = b1.y; bias[6] = b1.z; bias[7] = b1.w; }
        const bf16* src = PROJ + (size_t)tok0 * NPROJ + COL_XBC + ch; bf16* dst = XBC + (size_t)tok0 * XBC_W + ch;
        v4u p0 = (v4u){0u, 0u, 0u, 0u}, p1 = p0, p2 = p0;
        if ((tok0 & (SEQ - 1)) != 0) { p0 = *(const GAS v4u*)(src - 3 * (ptrdiff_t)NPROJ); p1 = *(const GAS v4u*)(src - 2 * (ptrdiff_t)NPROJ); p2 = *(const GAS v4u*)(src - (ptrdiff_t)NPROJ); }
#pragma unroll 1
        for (int i0 = 0; i0 < 32; i0 += 8) {
            v4u cur[8];
#pragma unroll
            for (int i = 0; i < 8; ++i) cur[i] = *(const GAS v4u*)(src + (size_t)(i0 + i) * NPROJ);
#pragma unroll
            for (int i = 0; i < 8; ++i) {
                const v4u c = cur[i]; float acc[8];
                const unsigned a0[4] = {p0.x, p0.y, p0.z, p0.w}, a1[4] = {p1.x, p1.y, p1.z, p1.w}, a2[4] = {p2.x, p2.y, p2.z, p2.w}, a3[4] = {c.x, c.y, c.z, c.w};
#pragma unroll
                for (int j = 0; j < 4; ++j) {
                    acc[2 * j] = bias[2 * j] + wv[0][2 * j] * bflo(a0[j]) + wv[1][2 * j] * bflo(a1[j]) + wv[2][2 * j] * bflo(a2[j]) + wv[3][2 * j] * bflo(a3[j]);
                    acc[2 * j + 1] = bias[2 * j + 1] + wv[0][2 * j + 1] * bfhi(a0[j]) + wv[1][2 * j + 1] * bfhi(a1[j]) + wv[2][2 * j + 1] * bfhi(a2[j]) + wv[3][2 * j + 1] * bfhi(a3[j]); }
#pragma unroll
                for (int j = 0; j < 8; ++j) acc[j] = silu_f(acc[j]);
                v4u o; o.x = pk2(acc[0], acc[1]); o.y = pk2(acc[2], acc[3]); o.z = pk2(acc[4], acc[5]); o.w = pk2(acc[6], acc[7]);
                *(GAS v4u*)(dst + (size_t)(i0 + i) * XBC_W) = o;
                p0 = p1; p1 = p2; p2 = c; }
        }
    }
    { const float* const dtraw = F.dtraw(); float* const dt2 = F.DT2(); const float* const dtb = F.dt_bias();
      for (int i = gt; i < MTOK * 16; i += GT) { const float xr = dtraw[i] + dtb[i & 15]; dt2[i] = xr > 20.f ? xr : log1pf(__expf(xr)); } }
}

constexpr int S_BSTR = 272, S_XSTR = 144;
constexpr int S_BM = 0, S_CM = 128 * S_BSTR, S_X = 2 * 128 * S_BSTR, S_XW = S_X + 128 * S_XSTR, S_HB = S_XW + 128 * S_XSTR, S_DT = S_HB + 64 * S_BSTR, S_CS = S_DT + 512, S_DA = S_CS + 512, S_END = S_DA + 512;
static_assert(S_END <= RING_BYTES, "ssd LDS map");
__device__ __forceinline__ void ssd_unit(Frame& F, int b, int h, const bool doatom = true) {
    LAS unsigned char* lds = F.lds + RING_OFF;
    const int tid = fresh_tid(), lane = tid & 63, w = __builtin_amdgcn_readfirstlane(tid >> 6), g = lane >> 4, c16 = lane & 15, q4 = c16 >> 2, p4 = lane & 3;
    const int g8 = h >> 3, pbw = w & 3, nhw = w >> 2;
    const float a_h = -__expf(F.a_log()[h]), dsk = F.d_skip()[h];
    const bf16* const PROJ = F.PROJ(); bf16* const MIX = F.HN(); const float* const dt2 = F.DT2(); const bf16* const XBC = F.XBC(); float* const ssqp = F.ssq();
    LAS float* dtl = (LAS float*)(lds + S_DT); LAS float* csl = (LAS float*)(lds + S_CS); LAS float* dal = (LAS float*)(lds + S_DA);
    for (int i = tid; i < 64 * S_BSTR / 16; i += NWAVES * 64) ((LAS v4u*)(lds + S_HB))[i] = (v4u){0u, 0u, 0u, 0u};
    f32x4 hacc[4];
#pragma unroll
    for (int i = 0; i < 4; ++i) hacc[i] = (f32x4){0.f, 0.f, 0.f, 0.f};
    const int xl = tid >> 3, xc = tid & 7, bl = tid >> 4, bc = tid & 15;
    v4u xr[2], br[4], cr[4]; float dtv = 0.f;
#define S_PREFETCH(cc) do { const size_t t0_ = (size_t)b * SEQ + (size_t)(cc) * SSM_L; \
        _Pragma("unroll") for (int i_ = 0; i_ < 2; ++i_) xr[i_] = *(const GAS v4u*)(XBC + (t0_ + xl + 64 * i_) * XBC_W + h * 64 + 8 * xc); \
        _Pragma("unroll") for (int i_ = 0; i_ < 4; ++i_) { const bf16* p_ = XBC + (t0_ + bl + 32 * i_) * XBC_W + 1024 + g8 * 128 + 8 * bc; br[i_] = *(const GAS v4u*)p_; cr[i_] = *(const GAS v4u*)(p_ + 256); } \
        if (tid < 128) dtv = dt2[(t0_ + tid) * 16 + h]; } while (0)
    S_PREFETCH(0);
    for (int c = 0; c < SSM_NC; ++c) {
        const size_t tok0 = (size_t)b * SEQ + (size_t)c * SSM_L;
        if (tid < 128) { dtl[tid] = dtv; dal[tid] = dtv * a_h; }
        __syncthreads();
        { const float v0 = dal[2 * lane], v1 = dal[2 * lane + 1]; float s = v0 + v1;
#pragma unroll
            for (int o = 1; o < 64; o <<= 1) { const float t = __shfl_up(s, o); s += (lane >= o) ? t : 0.f; }
            csl[2 * lane] = s - v1; csl[2 * lane + 1] = s; }
        LDS_WAIT(); asm volatile("" ::: "memory");
        const float cs_last = csl[127];
#pragma unroll
        for (int i = 0; i < 2; ++i) { const int l = xl + 64 * i; const v4u v = xr[i]; *(LAS v4u*)(lds + S_X + l * S_XSTR + xc * 16) = v; const float wl = dtl[l] * __expf(cs_last - csl[l]);
            v4u o2; o2.x = pk2(bflo(v.x) * wl, bfhi(v.x) * wl); o2.y = pk2(bflo(v.y) * wl, bfhi(v.y) * wl); o2.z = pk2(bflo(v.z) * wl, bfhi(v.z) * wl); o2.w = pk2(bflo(v.w) * wl, bfhi(v.w) * wl);
            *(LAS v4u*)(lds + S_XW + l * S_XSTR + xc * 16) = o2; }
#pragma unroll
        for (int i = 0; i < 4; ++i) { const int l = bl + 32 * i; *(LAS v4u*)(lds + S_BM + l * S_BSTR + bc * 16) = br[i]; *(LAS v4u*)(lds + S_CM + l * S_BSTR + bc * 16) = cr[i]; }
        const int lrow = 16 * w + c16;
        v2u zr[4];
#pragma unroll
        for (int pb = 0; pb < 4; ++pb) zr[pb] = *(const GAS v2u*)(PROJ + (tok0 + lrow) * NPROJ + COL_Z + h * 64 + 16 * pb + 4 * g);
        if (c + 1 < SSM_NC) S_PREFETCH(c + 1);
        __syncthreads();
        bf16x8 cf[4];
#pragma unroll
        for (int ks = 0; ks < 4; ++ks) cf[ks] = *(const LAS bf16x8*)(lds + S_CM + lrow * S_BSTR + (32 * ks + 8 * g) * 2);
        f32x4 yacc[4];
        const float cs_l = csl[lrow]; const float el = __expf(cs_l);
#pragma unroll
        for (int pb = 0; pb < 4; ++pb) { yacc[pb] = (f32x4){0.f, 0.f, 0.f, 0.f};
#pragma unroll
            for (int ks = 0; ks < 4; ++ks) { const bf16x8 hf = *(const LAS bf16x8*)(lds + S_HB + (16 * pb + c16) * S_BSTR + (32 * ks + 8 * g) * 2); yacc[pb] = MFMA16(hf, cf[ks], yacc[pb]); }
            yacc[pb] = yacc[pb] * el; }
        for (int s2 = 0; s2 <= (w >> 1); ++s2) {
            const int sb0 = 2 * s2, sb1 = 2 * s2 + 1; const bool has1 = sb1 <= w;
            f32x4 cb0 = (f32x4){0.f, 0.f, 0.f, 0.f}, cb1 = (f32x4){0.f, 0.f, 0.f, 0.f};
#pragma unroll
            for (int ks = 0; ks < 4; ++ks) { const bf16x8 bf0 = *(const LAS bf16x8*)(lds + S_BM + (16 * sb0 + c16) * S_BSTR + (32 * ks + 8 * g) * 2); cb0 = MFMA16(bf0, cf[ks], cb0); }
            if (has1) {
#pragma unroll
                for (int ks = 0; ks < 4; ++ks) { const bf16x8 bf1 = *(const LAS bf16x8*)(lds + S_BM + (16 * sb1 + c16) * S_BSTR + (32 * ks + 8 * g) * 2); cb1 = MFMA16(bf1, cf[ks], cb1); } }
            float mv[8];
#pragma unroll
            for (int r = 0; r < 4; ++r) { const int s = 16 * sb0 + 4 * g + r; const float e = __expf(fminf(cs_l - csl[s], 0.f)) * dtl[s]; mv[r] = (s <= lrow) ? cb0[r] * e : 0.f; }
#pragma unroll
            for (int r = 0; r < 4; ++r) { const int s = 16 * sb1 + 4 * g + r; const int sc_ = s > 127 ? 127 : s; const float e = __expf(fminf(cs_l - csl[sc_], 0.f)) * dtl[sc_]; mv[4 + r] = (has1 && s <= lrow) ? cb1[r] * e : 0.f; }
            const bf16x8 pf = pack8(mv);
#pragma unroll
            for (int pb = 0; pb < 4; ++pb) { LAS unsigned char* xa = lds + S_X + (32 * s2 + 4 * g + q4) * S_XSTR + (16 * pb + 4 * p4) * 2;
                const s16x4 lo = TR16(xa), hi = TR16(xa + 16 * S_XSTR); const bf16x8 xf = __builtin_shufflevector(lo, hi, 0, 1, 2, 3, 4, 5, 6, 7);
                yacc[pb] = MFMA16(xf, pf, yacc[pb]); }
        }
        { const size_t tok = tok0 + lrow; float ssq = 0.f; unsigned ow[4];
#pragma unroll
          for (int pb = 0; pb < 4; ++pb) { const int p0 = 16 * pb + 4 * g;
              const v2u xs_ = *(const LAS v2u*)(lds + S_X + lrow * S_XSTR + p0 * 2);
              const v2u zr_ = zr[pb];
              const float o0 = (yacc[pb].x + bflo(xs_.x) * dsk) * silu_f(bflo(zr_.x)), o1 = (yacc[pb].y + bfhi(xs_.x) * dsk) * silu_f(bfhi(zr_.x));
              const float o2 = (yacc[pb].z + bflo(xs_.y) * dsk) * silu_f(bflo(zr_.y)), o3 = (yacc[pb].w + bfhi(xs_.y) * dsk) * silu_f(bfhi(zr_.y));
              ssq += (o0 * o0 + o1 * o1) + (o2 * o2 + o3 * o3);
              ow[pb] = pk4_fp8(o0 * SS8, o1 * SS8, o2 * SS8, o3 * SS8); }
          *(GAS v4u*)((unsigned char*)MIX + tok * DM + ATT_W + h * 64 + 16 * g) = (v4u){ow[0], ow[1], ow[2], ow[3]};
          ssq += __shfl_xor(ssq, 16); ssq += __shfl_xor(ssq, 32);
          if (g == 0 && doatom) unsafeAtomicAdd(ssqp + tok * 4 + 2 + g8, ssq); }
        { const float cdec = __expf(cs_last);
#pragma unroll
          for (int i = 0; i < 4; ++i) hacc[i] = hacc[i] * cdec;
#pragma unroll
          for (int ks = 0; ks < 4; ++ks) {
              LAS unsigned char* xa = lds + S_XW + (32 * ks + 8 * g + q4) * S_XSTR + (16 * pbw + 4 * p4) * 2;
              const s16x4 xlo = TR16(xa), xhi = TR16(xa + 4 * S_XSTR); const bf16x8 xf = __builtin_shufflevector(xlo, xhi, 0, 1, 2, 3, 4, 5, 6, 7);
#pragma unroll
              for (int i = 0; i < 4; ++i) { const int nb = 4 * nhw + i; LAS unsigned char* ba = lds + S_BM + (32 * ks + 8 * g + q4) * S_BSTR + (16 * nb + 4 * p4) * 2;
                  const s16x4 blo = TR16(ba), bhi = TR16(ba + 4 * S_BSTR); const bf16x8 bfr = __builtin_shufflevector(blo, bhi, 0, 1, 2, 3, 4, 5, 6, 7);
                  hacc[i] = MFMA16(bfr, xf, hacc[i]); } } }
        __syncthreads();
#pragma unroll
        for (int i = 0; i < 4; ++i) { const int nb = 4 * nhw + i; v2u o; o.x = pk2(hacc[i].x, hacc[i].y); o.y = pk2(hacc[i].z, hacc[i].w);
            *(LAS v2u*)(lds + S_HB + (16 * pbw + c16) * S_BSTR + (16 * nb + 4 * g) * 2) = o; }
    }
#undef S_PREFETCH
    __syncthreads();
}

__device__ __forceinline__ void mix_normalize(Frame& F) {
    const int tid_ = fresh_tid(), lane = tid_ & 63; const int gw = blockIdx.x * NWAVES + __builtin_amdgcn_readfirstlane(tid_ >> 6), NGW = F.G * NWAVES;
    const float* const ssqp = F.ssq(); bf16* const MIX = F.HN(); const float* const gatt = F.attn_out_norm(); const float* const gssm = F.ssm_out_norm();
    for (int m = gw; m < MTOK; m += NGW) {
        const float* sq = ssqp + (size_t)m * 4;
        const float s1 = __hip_atomic_load(sq + 1, RLX_AGENT), s2 = __hip_atomic_load(sq + 2, RLX_AGENT), s3 = __hip_atomic_load(sq + 3, RLX_AGENT);
        const float ra = 1.f / sqrtf(s1 * (1.f / 1024.f) + EPS), r0 = 1.f / sqrtf(s2 * (1.f / 512.f) + EPS), r1 = 1.f / sqrtf(s3 * (1.f / 512.f) + EPS);
        GAS v4u* row = (GAS v4u*)(MIX + (size_t)m * DM);
#pragma unroll
        for (int j = 0; j < 4; ++j) { const int idx = lane + 64 * j, col = 8 * idx; const float rs = (j < 2) ? ra : ((j == 2) ? r0 : r1);
            const float* gp = (j < 2) ? (gatt + col) : (gssm + (col - ATT_W));
            const f32x4 g0 = *(const GAS f32x4*)gp, g1 = *(const GAS f32x4*)(gp + 4); const v4u v = row[idx]; v4u o;
            o.x = pk2(bflo(v.x) * rs * g0.x, bfhi(v.x) * rs * g0.y); o.y = pk2(bflo(v.y) * rs * g0.z, bfhi(v.y) * rs * g0.w);
            o.z = pk2(bflo(v.z) * rs * g1.x, bfhi(v.z) * rs * g1.y); o.w = pk2(bflo(v.w) * rs * g1.z, bfhi(v.w) * rs * g1.w); row[idx] = o; }
    }
}

constexpr size_t TAB_UNIT = 1024;
static_assert((TAB_ITEMS / 8) % TAB_UNIT == 0 && TAB_ITEMS % TAB_UNIT == 0, "table filler units");
constexpr int P_EIDX = 0, P_GATE = 16384, P_LST = 32768  , P_HN4 = 32768  , P_ACT = 98304  , P_END = 114688;
static_assert(P_END <= RING_BYTES, "peer LDS map");
__constant__ unsigned char PEER_CAND[52] = {0, 1, 2, 3, 4, 5, 6, 7, 8, 9, 10, 11, 12, 13, 14, 15, 16, 17, 18, 19, 20, 21, 22, 23, 32, 33, 34, 35, 36, 48, 49, 50, 51, 64, 65, 66, 80, 81, 96, 97, 112, 113, 128, 144, 160, 176, 192, 208, 224, 240, 255, 255};
__device__ __forceinline__ unsigned f2ord(float f) { const unsigned u = __builtin_bit_cast(unsigned, f); return u ^ ((u >> 31) ? 0xFFFFFFFFu : 0x80000000u); }
__device__ __forceinline__ float ord2f(unsigned u) { return __builtin_bit_cast(float, u ^ ((u >> 31) ? 0x80000000u : 0xFFFFFFFFu)); }
#define CSWAPD(a, b) do { const unsigned hi_ = (a) > (b) ? (a) : (b), lo_ = (a) > (b) ? (b) : (a); (a) = hi_; (b) = lo_; } while (0)
template <int N> __device__ __forceinline__ void bitonic_sort_desc(unsigned (&v)[N]) {
#pragma unroll
    for (int k = 2; k <= N; k <<= 1)
#pragma unroll
        for (int j = k >> 1; j > 0; j >>= 1)
#pragma unroll
            for (int i = 0; i < N; ++i) { const int l = i ^ j; if (l > i) { if ((i & k) == 0) CSWAPD(v[i], v[l]); else CSWAPD(v[l], v[i]); } }
}
__device__ __forceinline__ void merge16_xor(unsigned (&v)[16], int dist) {
    unsigned o[16];
#pragma unroll
    for (int i = 0; i < 16; ++i) o[i] = (unsigned)__shfl_xor((int)v[i], dist);
#pragma unroll
    for (int i = 0; i < 16; ++i) v[i] = v[i] > o[15 - i] ? v[i] : o[15 - i];
#pragma unroll
    for (int j = 8; j > 0; j >>= 1)
#pragma unroll
        for (int i = 0; i < 16; ++i) { const int l = i ^ j; if (l > i) CSWAPD(v[i], v[l]); }
}
__device__ __forceinline__ float gelu_erf(float x) { return 0.5f * x * (1.f + erff(x * 0.70710678118654752f)); }
__device__ __forceinline__ float fp4_dec1(unsigned n) { const unsigned m = n & 7u; unsigned bits = (m >= 2u) ? (((126u + (m >> 1)) << 23) | ((m & 1u) << 22)) : (m ? 0x3F000000u : 0u); bits |= (n & 8u) << 28; return __builtin_bit_cast(float, bits); }
__device__ __forceinline__ f32x2 fp4_dec2(unsigned x) { f32x2 r; r.x = fp4_dec1(x & 15u); r.y = fp4_dec1((x >> 4) & 15u); return r; }
typedef long i64;
typedef int v8i __attribute__((ext_vector_type(8)));
typedef int v4i __attribute__((ext_vector_type(4)));
template <bool dry = false> __device__ __forceinline__ void peer_unit(Frame& F, int u) {
    LAS unsigned char* lds = F.lds + RING_OFF;
    const int tid_ = fresh_tid(), lane = tid_ & 63, w = __builtin_amdgcn_readfirstlane(tid_ >> 6), g = lane >> 4, c16 = lane & 15;
    const int T0 = 32 * u;
    LAS int* eidx = (LAS int*)(lds + P_EIDX); LAS float* gate = (LAS float*)(lds + P_GATE);
    LAS unsigned* lst = (LAS unsigned*)(lds + P_LST) + w * 1024;
    const bf16* const QP = F.QP(); const bf16* const SK = F.SK(); float* const outp = F.out(); const bf16* const X1B = F.X1B(); const float* const fgain = F.ffn_norm(); const float* const fing = F.final_norm(); const unsigned char* const U8 = F.U8(); const unsigned char* const V8 = F.V8();
#ifndef NO_ROUTE
    unsigned cpk[4];
    { unsigned cb[16];
#pragma unroll
      for (int k = 0; k < 13; ++k) cb[k] = PEER_CAND[4 * k + g];
      cb[13] = 255u; cb[14] = 255u; cb[15] = 255u;
#pragma unroll
      for (int q = 0; q < 4; ++q) cpk[q] = cb[4 * q] | (cb[4 * q + 1] << 8) | (cb[4 * q + 2] << 16) | (cb[4 * q + 3] << 24); }
    {
    bf16x8 qf[2][4];
#define QP_LOAD(dst, c_) do { _Pragma("unroll") for (int tb = 0; tb < 2; ++tb) { const unsigned qo = ((unsigned)(T0 + 16 * tb + c16) * (unsigned)DM + (unsigned)((2 * w + (c_)) * 128 + 8 * g)) * 2u; \
        _Pragma("unroll") for (int ks = 0; ks < 4; ++ks) dst[tb][ks] = __builtin_nontemporal_load((const GAS bf16x8*)((const unsigned char*)QP + (qo + 64u * ks))); } } while (0)
    QP_LOAD(qf, 0);
#pragma unroll
    for (int c = 0; c < 2; ++c) {
        const int p = 2 * w + c;
        unsigned key[2][32];
        bf16x8 sf[3][8];
        const unsigned so0 = (unsigned)p * 32768u + 16u * (unsigned)lane;
#define SK_LOAD(buf, j_) do { _Pragma("unroll") for (int q = 0; q < 8; ++q) sf[buf][q] = *(const GAS bf16x8*)((const unsigned char*)SK + (so0 + (unsigned)(2 * (j_) + (q >> 2)) * 4096u + 1024u * (q & 3))); } while (0)
        SK_LOAD(0, 0); SK_LOAD(1, 1);
#pragma unroll
        for (int j = 0; j < 4; ++j) {
            if (j + 2 < 4) SK_LOAD((j + 2) % 3, j + 2);
            __builtin_amdgcn_sched_barrier(0);
#pragma unroll
            for (int h2 = 0; h2 < 2; ++h2)
#pragma unroll
            for (int tb = 0; tb < 2; ++tb) { const int kb = 2 * j + h2; f32x4 acc = (f32x4){0.f, 0.f, 0.f, 0.f};
#pragma unroll
                for (int ks = 0; ks < 4; ++ks) acc = MFMA16(sf[j % 3][4 * h2 + ks], qf[tb][ks], acc);
#pragma unroll
                for (int r = 0; r < 4; ++r) key[tb][kb * 4 + r] = (f2ord(acc[r]) & ~0x7Fu) | (unsigned)(16 * kb + 4 * g + r); }
            __builtin_amdgcn_sched_barrier(0); }
#undef SK_LOAD
        if (c == 0) { QP_LOAD(qf, 1); __builtin_amdgcn_sched_barrier(0); }
#pragma unroll
        for (int tb = 0; tb < 2; ++tb) {
            bitonic_sort_desc<32>(key[tb]);
            unsigned top[16];
#pragma unroll
            for (int i = 0; i < 16; ++i) top[i] = key[tb][i];
            merge16_xor(top, 16); merge16_xor(top, 32);
            if (g == 0) { LAS v4u* d = (LAS v4u*)(lst + (c * 32 + 16 * tb + c16) * 16);
                d[0] = (v4u){top[0], top[1], top[2], top[3]}; d[1] = (v4u){top[4], top[5], top[6], top[7]}; d[2] = (v4u){top[8], top[9], top[10], top[11]}; d[3] = (v4u){top[12], top[13], top[14], top[15]}; } }
    }
#undef QP_LOAD
    }
    for (int tb = 0; tb < 2; ++tb) {
        LDS_WAIT();
        const LAS unsigned* l1 = lst + (16 * tb + c16) * 16; const LAS unsigned* l2 = lst + (32 + 16 * tb + c16) * 16;
        unsigned ck[16];
#pragma unroll
        for (int k = 0; k < 13; ++k) { const unsigned ab = (cpk[k >> 2] >> (8 * (k & 3))) & 255u; const unsigned a = ab >> 4, bq = ab & 15u;
            const float s = ord2f(l1[a] & ~0x7Fu) + ord2f(l2[bq] & ~0x7Fu); ck[k] = (ab == 255u) ? 0u : ((f2ord(s) & ~0xFFu) | ab); }
        ck[13] = 0u; ck[14] = 0u; ck[15] = 0u;
        bitonic_sort_desc<16>(ck);
        merge16_xor(ck, 16); merge16_xor(ck, 32);
        if (g == 0) { const int tl = 16 * tb + c16; const float m = ord2f(ck[0] & ~0xFFu); float e[16]; float sum = 0.f;
#pragma unroll
            for (int k = 0; k < 16; ++k) { e[k] = __expf(ord2f(ck[k] & ~0xFFu) - m); sum += e[k]; }
            const float inv = 1.f / sum;
#pragma unroll
            for (int k = 0; k < 16; ++k) { const unsigned a = (ck[k] >> 4) & 15u, bq = ck[k] & 15u; const int ex = (int)((l1[a] & 0x7Fu) * 128u + (l2[bq] & 0x7Fu));
                eidx[tl * 128 + w * 16 + k] = ex; gate[tl * 128 + w * 16 + k] = e[k] * inv; } }
    }
#endif
    __syncthreads();
    LAS unsigned char* hnb = lds + P_HN4 + w * 8192; LAS float* actl = (LAS float*)(lds + P_ACT) + w * 512;
    const LAS unsigned char* hb = hnb + 16 * g + ((c16 & 1) ? 1024 : 0) + ((c16 & 2) ? 64 : 0);
    v4u bA[8], bB[8];
#define U_ISSUE(buf, e_) do { const unsigned uo_ = (unsigned)(e_) * (unsigned)ROWB + 64u * (unsigned)(c16 & 1) + 16u * (unsigned)g; \
        _Pragma("unroll") for (int jj = 0; jj < 8; ++jj) buf[jj] = *(const GAS v4u*)(U8 + (uo_ + 128u * jj)); __builtin_amdgcn_sched_barrier(0); } while (0)
#define U_CONSUME(buf, ACC, HB) do { v4u bq_[8]; _Pragma("unroll") for (int jj = 0; jj < 8; ++jj) bq_[jj] = *(const LAS v4u*)((HB) + 128 * jj); \
        __builtin_amdgcn_sched_barrier(0); \
        _Pragma("unroll") for (int jj = 0; jj < 8; ++jj) { const v4u a_ = buf[jj]; \
            const v8i av_ = {(int)a_.x, (int)a_.y, (int)a_.z, (int)a_.w, 0, 0, 0, 0}; const v8i bv_ = {(int)bq_[jj].x, (int)bq_[jj].y, (int)bq_[jj].z, (int)bq_[jj].w, 0, 0, 0, 0}; \
            ACC = __builtin_amdgcn_mfma_scale_f32_16x16x128_f8f6f4(av_, bv_, ACC, 4, 4, 0, 0x7f7f7f7f, 0, 0x7f7f7f7f); } __builtin_amdgcn_sched_barrier(0); } while (0)
#define U_PRE(A_, PA, PB) do { const float x1_ = __shfl_down(A_.x, 1), z1_ = __shfl_down(A_.z, 1), y2_ = __shfl_down(A_.y, 2), w2_ = __shfl_down(A_.w, 2), y3_ = __shfl_down(A_.y, 3), w3_ = __shfl_down(A_.w, 3); \
        constexpr float ilo_ = 1.f / SLO4; PA = (A_.x + y2_) + (x1_ + y3_) * ilo_; PB = (A_.z + w2_) + (z1_ + w3_) * ilo_; } while (0)
#define U_ACT8(hg_, TL, ACT) do { float pa_, pb_; U_PRE(acc, pa_, pb_); \
        if (c16 == 0) { const int k0 = 8 * (hg_) + 2 * g; constexpr float isc = 1.f / (SU * SH4); const f32x2 g0_ = *(const LAS f32x2*)(gate + (TL) * 128 + k0); \
            f32x2 a0_; a0_.x = gelu_erf(pa_ * isc) * g0_.x; a0_.y = gelu_erf(pb_ * isc) * g0_.y; *(LAS f32x2*)((ACT) + k0) = a0_; } } while (0)
#define V_ISSUE(buf, TL, kb_) do { const LAS v4i* ep_ = (const LAS v4i*)(eidx + (TL) * 128 + 8 * (kb_)); const v4i e4a_ = ep_[0], e4b_ = ep_[1]; const int ee_[8] = {e4a_.x, e4a_.y, e4a_.z, e4a_.w, e4b_.x, e4b_.y, e4b_.z, e4b_.w}; \
        _Pragma("unroll") for (int kk = 0; kk < 8; ++kk) { const unsigned vo_ = (unsigned)(ee_[kk] & emask) * (unsigned)ROWB + 16u * (unsigned)lane; buf[kk] = *(const GAS v4u*)(V8 + vo_); } \
        __builtin_amdgcn_sched_barrier(0); } while (0)
#define PIN8x2(a, i) asm volatile("" : "+v"(a[i]), "+v"(a[i + 1]), "+v"(a[i + 2]), "+v"(a[i + 3]), "+v"(a[i + 4]), "+v"(a[i + 5]), "+v"(a[i + 6]), "+v"(a[i + 7]))
#define V_CONSUME(buf, kb_, O, ACT) do { const f32x4 al_ = *(const LAS f32x4*)((ACT) + 8 * (kb_)), ah_ = *(const LAS f32x4*)((ACT) + 8 * (kb_) + 4); const float a8_[8] = {al_.x, al_.y, al_.z, al_.w, ah_.x, ah_.y, ah_.z, ah_.w}; \
        _Pragma("unroll") for (int kk = 0; kk < 8; ++kk) { const float as_ = a8_[kk]; const f32x2 a2_ = {as_, as_}; \
        const unsigned vw[4] = {buf[kk].x, buf[kk].y, buf[kk].z, buf[kk].w}; \
        _Pragma("unroll") for (int q = 0; q < 4; ++q) { \
            O[4 * q]     = __builtin_elementwise_fma(__builtin_amdgcn_cvt_scalef32_pk_f32_fp4(vw[q], 1.0f, 0), a2_, O[4 * q]); \
            O[4 * q + 1] = __builtin_elementwise_fma(__builtin_amdgcn_cvt_scalef32_pk_f32_fp4(vw[q], 1.0f, 1), a2_, O[4 * q + 1]); \
            O[4 * q + 2] = __builtin_elementwise_fma(__builtin_amdgcn_cvt_scalef32_pk_f32_fp4(vw[q], 1.0f, 2), a2_, O[4 * q + 2]); \
            O[4 * q + 3] = __builtin_elementwise_fma(__builtin_amdgcn_cvt_scalef32_pk_f32_fp4(vw[q], 1.0f, 3), a2_, O[4 * q + 3]); } \
        PIN8x2(O, 0); PIN8x2(O, 8); } } while (0)
#ifndef NO_GATHER
#ifdef PROBE_L2RES
    constexpr int emask = dry ? PROBE_L2RES : 16383;
#else
    constexpr int emask = 16383;
#endif
    {
    { unsigned k0[4], k1[4];
#pragma unroll
      for (int ti = 0; ti < 4; ++ti) { const int tl = w + 8 * ti; k0[ti] = ((unsigned)eidx[tl * 128 + lane] << 7) | (unsigned)lane; k1[ti] = ((unsigned)eidx[tl * 128 + 64 + lane] << 7) | (unsigned)(64 + lane); }
#pragma unroll
      for (int k = 2; k <= 128; k <<= 1)
#pragma unroll
        for (int j = k >> 1; j > 0; j >>= 1) {
            if (j == 64) {
#pragma unroll
                for (int ti = 0; ti < 4; ++ti) { const unsigned lo_ = k0[ti] < k1[ti] ? k0[ti] : k1[ti], hi_ = k0[ti] < k1[ti] ? k1[ti] : k0[ti]; k0[ti] = lo_; k1[ti] = hi_; }
            } else {
                const bool lower = (lane & j) == 0;
                const bool desc0 = (k == 64) ? false : ((k == 128) ? false : ((lane & k) != 0)), desc1 = (k == 64) ? true : desc0;
                const bool min0 = lower != desc0, min1 = lower != desc1;
#pragma unroll
                for (int ti = 0; ti < 4; ++ti) { const unsigned p0 = (unsigned)__shfl_xor((int)k0[ti], j), p1 = (unsigned)__shfl_xor((int)k1[ti], j);
                    const unsigned mn0 = k0[ti] < p0 ? k0[ti] : p0, mx0 = k0[ti] < p0 ? p0 : k0[ti], mn1 = k1[ti] < p1 ? k1[ti] : p1, mx1 = k1[ti] < p1 ? p1 : k1[ti];
                    k0[ti] = min0 ? mn0 : mx0; k1[ti] = min1 ? mn1 : mx1; }
            }
        }
      float g0[4], g1[4];
#pragma unroll
      for (int ti = 0; ti < 4; ++ti) { const int tl = w + 8 * ti; g0[ti] = gate[tl * 128 + (int)(k0[ti] & 127u)]; g1[ti] = gate[tl * 128 + (int)(k1[ti] & 127u)]; }
      LDS_WAIT(); asm volatile("" ::: "memory");
#pragma unroll
      for (int ti = 0; ti < 4; ++ti) { const int tl = w + 8 * ti; eidx[tl * 128 + lane] = (int)(k0[ti] >> 7); eidx[tl * 128 + 64 + lane] = (int)(k1[ti] >> 7); gate[tl * 128 + lane] = g0[ti]; gate[tl * 128 + 64 + lane] = g1[ti]; }
      LDS_WAIT(); asm volatile("" ::: "memory"); }
    v2u xn[8];
#define X_ISSUE(tok_) do { const unsigned xb_ = (unsigned)(tok_) * (unsigned)(DM * 2) + 8u * (unsigned)lane; _Pragma("unroll") for (int j = 0; j < 8; ++j) xn[j] = __builtin_nontemporal_load((const GAS v2u*)((const unsigned char*)X1B + (xb_ + 512u * j))); } while (0)
    X_ISSUE(T0 + w);
#pragma unroll 1
    for (int ti = 0; ti < 4; ++ti) {
        f32x4 xr[8]; float ss = 0.f;
#pragma unroll
        for (int j = 0; j < 8; ++j) { const v2u r = xn[j]; xr[j] = (f32x4){bflo(r.x), bfhi(r.x), bflo(r.y), bfhi(r.y)}; }
        X_ISSUE(T0 + w + 8 * (ti < 3 ? ti + 1 : 3));
#pragma unroll
        for (int j = 0; j < 8; ++j) ss += (xr[j].x * xr[j].x + xr[j].y * xr[j].y) + (xr[j].z * xr[j].z + xr[j].w * xr[j].w);
        const float rs2 = __builtin_amdgcn_rsqf(wave_sum(ss) * (1.f / DM) + EPS);
        const float* fg_ = fgain; asm volatile("" : "+s"(fg_));
        const unsigned char* gp = (const unsigned char*)fg_; const unsigned go = 16u * (unsigned)lane;
        unsigned hw[4], lw[4];
#pragma unroll
        for (int q = 0; q < 4; ++q) { unsigned wh = 0u, wl = 0u;
#pragma unroll
            for (int t = 0; t < 2; ++t) { const int j = 2 * q + t; const f32x4 gg = *(const GAS f32x4*)(gp + (go + 1024u * j)); const f32x4 hv = xr[j] * gg * (rs2 * SH4);
                const float h0 = clampf(hv.x, 6.f), h1 = clampf(hv.y, 6.f), h2 = clampf(hv.z, 6.f), h3 = clampf(hv.w, 6.f);
                const unsigned p0 = __builtin_amdgcn_cvt_scalef32_pk_fp4_f32(0u, h0, h1, 1.0f, 0), p1 = __builtin_amdgcn_cvt_scalef32_pk_fp4_f32(0u, h2, h3, 1.0f, 0);
                const f32x2 d0 = __builtin_amdgcn_cvt_scalef32_pk_f32_fp4(p0, 1.0f, 0), d1 = __builtin_amdgcn_cvt_scalef32_pk_f32_fp4(p1, 1.0f, 0);
                const unsigned r0 = __builtin_amdgcn_cvt_scalef32_pk_fp4_f32(0u, clampf((h0 - d0.x) * SLO4, 6.f), clampf((h1 - d0.y) * SLO4, 6.f), 1.0f, 0), r1 = __builtin_amdgcn_cvt_scalef32_pk_fp4_f32(0u, clampf((h2 - d1.x) * SLO4, 6.f), clampf((h3 - d1.y) * SLO4, 6.f), 1.0f, 0);
                wh |= ((p0 & 0xFFu) | ((p1 & 0xFFu) << 8)) << (16 * t); wl |= ((r0 & 0xFFu) | ((r1 & 0xFFu) << 8)) << (16 * t); }
            hw[q] = wh; lw[q] = wl; }
        *(LAS v4u*)(hnb + 2048 * ti + 16 * lane) = (v4u){hw[0], hw[1], hw[2], hw[3]}; *(LAS v4u*)(hnb + 2048 * ti + 1024 + 16 * lane) = (v4u){lw[0], lw[1], lw[2], lw[3]};
    }
    LDS_WAIT();
    { const int r8 = c16 >> 1;
#define U_STEP(BUFN, EN_ISSUE, BUFC, TI, HG) do { EN_ISSUE; f32x4 acc = (f32x4){0.f, 0.f, 0.f, 0.f}; U_CONSUME(BUFC, acc, hb + 2048 * (TI)); U_ACT8(HG, w + 8 * (TI), actl + 128 * (TI)); } while (0)
      { const int e0 = eidx[w * 128 + r8] & emask; U_ISSUE(bA, e0); }
#pragma unroll 1
      for (int hg = 0; hg < 15; ++hg) {
          if ((hg & 7) == 0) __builtin_amdgcn_s_barrier();
          const int e1 = eidx[(w + 8) * 128 + 8 * hg + r8] & emask, e2 = eidx[(w + 16) * 128 + 8 * hg + r8] & emask, e3 = eidx[(w + 24) * 128 + 8 * hg + r8] & emask, e0n = eidx[w * 128 + 8 * (hg + 1) + r8] & emask;
          U_STEP(bB, U_ISSUE(bB, e1), bA, 0, hg);
          U_STEP(bA, U_ISSUE(bA, e2), bB, 1, hg);
          U_STEP(bB, U_ISSUE(bB, e3), bA, 2, hg);
          U_STEP(bA, U_ISSUE(bA, e0n), bB, 3, hg);
      }
      { const int e1 = eidx[(w + 8) * 128 + 120 + r8] & emask, e2 = eidx[(w + 16) * 128 + 120 + r8] & emask, e3 = eidx[(w + 24) * 128 + 120 + r8] & emask;
          U_STEP(bB, U_ISSUE(bB, e1), bA, 0, 15);
          U_STEP(bA, U_ISSUE(bA, e2), bB, 1, 15);
          U_STEP(bB, U_ISSUE(bB, e3), bA, 2, 15);
          U_STEP(bA, V_ISSUE(bA, w, 0), bB, 3, 15); }
#undef U_STEP
    }
    LDS_WAIT();
    f32x2 o2[4][16];
#pragma unroll
    for (int ti = 0; ti < 4; ++ti)
#pragma unroll
        for (int i = 0; i < 16; ++i) o2[ti][i] = (f32x2){0.f, 0.f};
#pragma unroll 1
    for (int kb = 0; kb < 16; ++kb) {
        if ((kb & 7) == 0) __builtin_amdgcn_s_barrier();
        const int kn = kb < 15 ? kb + 1 : 15;
        V_ISSUE(bB, w + 8, kb);  V_CONSUME(bA, kb, o2[0], actl);
        V_ISSUE(bA, w + 16, kb); V_CONSUME(bB, kb, o2[1], actl + 128);
        V_ISSUE(bB, w + 24, kb); V_CONSUME(bA, kb, o2[2], actl + 256);
        V_ISSUE(bA, w, kn);      V_CONSUME(bB, kb, o2[3], actl + 384);
    }
    X_ISSUE(T0 + w);
#pragma unroll
    for (int ti = 0; ti < 4; ++ti) {
        const size_t token = (size_t)T0 + w + 8 * ti;
        const unsigned xo = (unsigned)token * (unsigned)(DM * 4) + 16u * (unsigned)lane;
        f32x4 xr[8];
#pragma unroll
        for (int j = 0; j < 8; ++j) { const v2u r = xn[j]; xr[j] = (f32x4){bflo(r.x), bfhi(r.x), bflo(r.y), bfhi(r.y)}; }
        if (ti < 3) X_ISSUE(T0 + w + 8 * (ti + 1));
        constexpr float isv = 1.f / SV; float s2 = 0.f;
#pragma unroll
        for (int j = 0; j < 8; ++j) { xr[j] = xr[j] + (f32x4){o2[ti][2 * j].x, o2[ti][2 * j].y, o2[ti][2 * j + 1].x, o2[ti][2 * j + 1].y} * isv;
            s2 += (xr[j].x * xr[j].x + xr[j].y * xr[j].y) + (xr[j].z * xr[j].z + xr[j].w * xr[j].w); }
        const float rf = __builtin_amdgcn_rsqf(wave_sum(s2) * (1.f / DM) + EPS);
        const float* fi_ = fing; asm volatile("" : "+s"(fi_));
        const unsigned char* fp = (const unsigned char*)fi_; unsigned char* op = (unsigned char*)outp; const unsigned fo = 16u * (unsigned)lane;
        if (!dry || rf == 1.2345e30f)
#pragma unroll
        for (int j = 0; j < 8; ++j) __builtin_nontemporal_store(xr[j] * rf * *(const GAS f32x4*)(fp + (fo + 1024u * j)), (GAS f32x4*)(op + (xo + 1024u * j)));
    }
    }
#endif
#undef U_ISSUE
#undef X_ISSUE
#undef U_ACT
#undef U_CONSUME
#undef V_ISSUE
#undef V_CONSUME
    __syncthreads();
}

__global__ void __launch_bounds__(NWAVES * 64, 2) hybrid_fwd(Args args) {
    extern __shared__ __attribute__((aligned(16))) unsigned char lds[];
    Frame F;
    F.lds = (LAS unsigned char*)lds;
    F.MISC = (volatile LAS unsigned*)(F.lds + MISC_OFF);
    F.tid = threadIdx.x; F.lane = F.tid & 63; F.wave = __builtin_amdgcn_readfirstlane(F.tid >> 6); F.G = gridDim.x;
    for (int u = F.tid; u < (LDS_BYTES - LDSCTL_OFF) / 4; u += NWAVES * 64) ((LAS unsigned*)(F.lds + LDSCTL_OFF))[u] = 0u;
    __syncthreads();
    (void)args;
    XcdBarrier bar = xcd_barrier_post(F.ctl() + CW_BAR, F.MISC + 8);

#ifndef NO_P0
#ifdef PROBE_P0X2
    { int reps = 2; asm volatile("" : "+s"(reps)); for (int rep = 0; rep < reps; ++rep) p0_prologue(F); }
#else
    p0_prologue(F);
#endif
#endif
    xcd_barrier(bar);
#ifndef NO_P1
#ifdef PROBE_GX2
    { int reps = 2; asm volatile("" : "+s"(reps)); for (int rep = 0; rep < reps; ++rep) {
#else
    { { const int rep = 0, reps = 1;
#endif
      pg8::Gemm gm{F.HN(), F.WinT(), MTOK, NB16, DM}; pg8::StaticOrder S; S.init(MTOK, NB16, F.G, (int)blockIdx.x);
      EpiProj E{F.PROJ(), F.dtraw(), (rep + 1 < reps) ? nullptr : F.kmean()};
      pg8::gemm_phase<EpiProj, pg8::StaticOrder, PG8_ALIGN, PG8_SP2>(F.lds + RING_OFF, gm, S, E); } }
    { const int nun = (MTOK / 256) * (NB16 / 256), rem = nun % F.G;
      if (rem && (int)blockIdx.x >= rem) tables_convert(F, tab_split(F.G), TAB_ITEMS, (size_t)((int)blockIdx.x - rem) * (NWAVES * 64) + fresh_tid(), (size_t)(F.G - rem) * (NWAVES * 64)); }
    __syncthreads();
    {
      pg8::Gemm gm{(const pg8::bf16_t*)F.HN8(), (const pg8::bf16_t*)F.WinT8(), MTOK, F8_HI - F8_LO, DM / 2}; pg8::StaticOrder S; S.init(MTOK, F8_HI - F8_LO, F.G, (int)blockIdx.x);
      EpiProj8 E{F.PROJ()};
      pg8::gemm_phase<EpiProj8, pg8::StaticOrder, PG8_ALIGN, PG8_SP2, true>(F.lds + RING_OFF, gm, S, E); }
#endif
    xcd_barrier(bar);
#ifdef PROBE_P15X2
    conv_phase(F);
#endif
    conv_phase(F);
    xcd_barrier(bar);
#ifdef PROBE_P2X2
    { int reps = 2; asm volatile("" : "+s"(reps)); for (int rep = 0; rep < reps; ++rep) {
#else
    { { const int rep = 0, reps = 1;
#endif
    const bool doatom = rep + 1 == reps;
    const int ntab = (int)(tab_split(F.G) / TAB_UNIT);
    for (;;) {
        if (F.tid == 0) F.MISC[0] = xb_add(F.ctl() + CW_Q2 + 64 * rep, 1u);
        __syncthreads();
        const int ui = (int)F.MISC[0];
        __syncthreads();
        if (ui >= 128 + 512 + W_SQ_UNITS + ntab) break;
        if (ui >= 128 + 512 && ui < 128 + 512 + W_SQ_UNITS) { sq_weight_items(F, ui - 640); __syncthreads(); continue; }
        if (ui >= 128 + 512 + W_SQ_UNITS) { const size_t lo = (size_t)(ui - 640 - W_SQ_UNITS) * TAB_UNIT; tables_convert(F, lo, lo + TAB_UNIT, (size_t)fresh_tid(), (size_t)(NWAVES * 64)); continue; }
#ifdef PROBE_P2_SSD
        if (ui < 128 || doatom)
#endif
#ifdef PROBE_P2_ATT
        if (ui >= 128 || doatom)
#endif
        {
        if (ui < 128) ssd_unit(F, ui >> 4, ui & 15, doatom);
        else { const int a = ui - 128; attn_unit(F, (a & 63) >> 3, a & 7, 7 - (a >> 6), doatom); }
        }
    } } }
    xcd_barrier(bar);
#ifndef NO_P3
#ifdef PROBE_GX2
    { int reps = 2; asm volatile("" : "+s"(reps)); for (int rep = 0; rep < reps; ++rep) {
#else
    { { const int rep = 0, reps = 1;
#endif
      pg8::Gemm gm{F.HN(), F.WoutT(), MTOK, DM, DM / 2}; pg8::StaticOrder S; S.init(MTOK, DM, F.G, (int)blockIdx.x);
      {
        const int t_ = fresh_tid(); const float* const sq = F.ssq();
#pragma unroll 1
        for (int ii = t_ >> 8; ii < 3; ii += 2) { pg8::Unit uu;
          if (S.next(ii, uu)) { const int row = uu.pm * 256 + (t_ & 255);
            const float q1 = __hip_atomic_load(sq + (size_t)row * 4 + 1, RLX_AGENT), q2 = __hip_atomic_load(sq + (size_t)row * 4 + 2, RLX_AGENT), q3 = __hip_atomic_load(sq + (size_t)row * 4 + 3, RLX_AGENT);
            const float sa = __builtin_amdgcn_rsqf(q1 * (1.f / 1024.f) + EPS), s0 = __builtin_amdgcn_rsqf(q2 * (1.f / 512.f) + EPS), s1 = __builtin_amdgcn_rsqf(q3 * (1.f / 512.f) + EPS);
            *(LAS f32x4*)(F.lds + SEGTAB_OFF + (ii * 256 + (t_ & 255)) * 16) = (f32x4){sa / s0 * (SS8 / SA8), s0 / s1, s1 * (1.f / (SS8 * SW8)), 0.f}; } }
        __syncthreads(); }
      EpiOut E{F.x(), F.X1B(), F.X18(), F.ssq(), rep + 1 == reps, (const LAS f32x4*)(F.lds + SEGTAB_OFF)};
      pg8::gemm_phase<EpiOut, pg8::StaticOrder, PG8_ALIGN, PG8_SP2, true>(F.lds + RING_OFF, gm, S, E); } }
#endif
    xcd_barrier(bar);
#ifndef NO_P4
#ifdef PROBE_GX2
    { int reps = 2; asm volatile("" : "+s"(reps)); for (int rep = 0; rep < reps; ++rep) {
#else
    { { const int rep = 0, reps = 1; (void)rep; (void)reps;
#endif
      pg8::Gemm gm{(const pg8::bf16_t*)F.X18(), F.WqT(), MTOK, DM, DM / 2}; pg8::StaticOrder S; S.init(MTOK, DM, F.G, (int)blockIdx.x);
      EpiQ E{F.QP(), F.ssq()};
      pg8::gemm_phase<EpiQ, pg8::StaticOrder, PG8_ALIGN, PG8_SP2, true>(F.lds + RING_OFF, gm, S, E); } }
#endif
    xcd_barrier(bar);
#ifndef NO_P5
#ifdef PROBE_P5X2
    { for (int u = blockIdx.x; u < MTOK / 32; u += F.G) peer_unit<true>(F, u);
      for (int u = blockIdx.x; u < MTOK / 32; u += F.G) peer_unit<false>(F, u); }
#else
    for (int u = blockIdx.x; u < MTOK / 32; u += F.G) peer_unit(F, u);
#endif
#endif
}

extern "C" void kernel_launch(void* const* d_in, const int* in_sizes, int n_in, void* d_out, int out_size, void* d_ws, size_t ws_size, hipStream_t stream) {
    static int grid = 0;
    if (grid == 0) {
        if (n_in != 18 || out_size != MTOK * DM || ws_size < WS_END) { fprintf(stderr, "kernel_launch: unexpected shapes (n_in %d, out %d, ws %zu)\n", n_in, out_size, ws_size); grid = -1; return; }
        int dev = 0, cus = 0, per_cu = 0;
        if (hipGetDevice(&dev) != hipSuccess || hipDeviceGetAttribute(&cus, hipDeviceAttributeMultiprocessorCount, dev) != hipSuccess) { grid = -1; return; }
        if (hipFuncSetAttribute((const void*)hybrid_fwd, hipFuncAttributeMaxDynamicSharedMemorySize, LDS_BYTES) != hipSuccess) { fprintf(stderr, "kernel_launch: hipFuncSetAttribute failed\n"); grid = -1; return; }
        if (hipOccupancyMaxActiveBlocksPerMultiprocessor(&per_cu, (const void*)hybrid_fwd, NWAVES * 64, LDS_BYTES) != hipSuccess || per_cu < 1)
            fprintf(stderr, "kernel_launch: note: occupancy query reports %d workgroups per CU\n", per_cu);
        (void)hipGetLastError();
        grid = cus;
    }
    if (grid < 0) return;
    if (hipMemsetAsync((char*)d_ws + WS_CTL, 0, CTL_ZERO_BYTES, stream) != hipSuccess) return;
    Args a{};
    for (int i = 0; i < 18; ++i) a.in[i] = (const float*)d_in[i];
    a.out = (float*)d_out; a.ws = (unsigned char*)d_ws;
    hipLaunchKernelGGL(hybrid_fwd, dim3(grid), dim3(NWAVES * 64), LDS_BYTES, stream, a);
}
```

```cpp
#define PAD_P5 8
#include <hip/hip_runtime.h>
#include <cstdio>
#include <cstdint>
namespace pg8 {
#define PG8_LAS __attribute__((address_space(3)))
typedef unsigned short bf16_t;
typedef short bf16x8 __attribute__((ext_vector_type(8)));
typedef float f32x4 __attribute__((ext_vector_type(4)));
typedef unsigned u32x4 __attribute__((ext_vector_type(4)));
constexpr int BM = 256, BK = 64, HALF = 128, HTB = HALF * BK * 2  , STAGE_BYTES = 8 * HTB, NXCD = 8, WGM = 8;

__host__ __device__ __forceinline__ int lds_byte(int r, int c) { const int st = (r >> 4) * 2 + (c >> 5), rr = r & 15, cc = c & 31, ob = rr * 64 + cc * 2; return st * 1024 + (ob ^ (((ob >> 9) & 1) << 5)); }
__host__ __device__ __forceinline__ void stage_rc(int b, int& R, int& C) { const int st = b / 1024, sb = b % 1024, swz = sb ^ (((sb >> 9) & 1) << 5); R = (st >> 1) * 16 + swz / 64; C = (st & 1) * 32 + (swz % 64) / 2; }
__host__ __device__ __forceinline__ int perm32(int rho) { const int n = rho >> 4, i = rho & 15; return 8 * (i >> 2) + 4 * n + (i & 3); }

struct Unit { int pm, pn; };
struct Gemm { const bf16_t* A; const bf16_t* Bt; int M, N, K; };

struct StaticOrder {
    int nM, nN, nwg, G, c;
    __host__ __device__ void init(int M, int N, int G_, int c_) { nM = M / BM; nN = N / BM; nwg = nM * nN; G = G_; c = c_; }
    __host__ __device__ bool next(int i, Unit& u) const {
        const long L = (long)i * G + c; if (L >= nwg) return false;
        int wgid = (int)L; { const int q = nwg / NXCD, r = nwg % NXCD, xcd = wgid % NXCD, off = wgid / NXCD; wgid = (xcd < r ? xcd * (q + 1) : r * (q + 1) + (xcd - r) * q) + off; }
        const int nig = WGM * nN, gid = wgid / nig, fm = gid * WGM, gsz = (nM - fm) < WGM ? (nM - fm) : WGM;
        u.pm = fm + ((wgid % nig) % gsz); u.pn = (wgid % nig) / gsz; return true;
    }
    __device__ __forceinline__ void a_ready(const Unit&) const {}
    __device__ __forceinline__ void done(const Unit&) const {}
};

__device__ __forceinline__ unsigned cvt_pk_bf16(float lo, float hi) { unsigned r; asm volatile("v_cvt_pk_bf16_f32 %0, %1, %2" : "=v"(r) : "v"(lo), "v"(hi)); return r; }
typedef float f32x2 __attribute__((ext_vector_type(2)));
__device__ __forceinline__ f32x2 gelu_pk(f32x2 v) {
    const f32x2 av = __builtin_elementwise_abs(v), d = av * 0.2316418882f + 1.0f;
    f32x2 t; t.x = __builtin_amdgcn_rcpf(d.x); t.y = __builtin_amdgcn_rcpf(d.y);
    f32x2 q = t * 0.5307027145f + (-0.7265760135f); q = q * t + 0.7107068705f; q = q * t + (-0.142248368f); q = q * t + 0.127414796f; q = q * t;
    const f32x2 s = (v * v) * (-0.72134752044f);
    f32x2 e; e.x = __builtin_amdgcn_exp2f(s.x); e.y = __builtin_amdgcn_exp2f(s.y);
    const f32x2 m = v * (q * e), r = v - m;
    f32x2 o; o.x = v.x < 0.f ? m.x : r.x; o.y = v.y < 0.f ? m.y : r.y; return o;
}

template <int ACT  > struct EpiBf16 {
    static constexpr bool PERM = true, AFTER_DRAIN = false, SEG = false; static_assert(ACT == 0 || ACT == 1, "EpiBf16: ACT is 0 (none) or 1 (gelu_pk)");
    bf16_t* O; int ldc; const float* bias; int split_cols; size_t split_stride; float scale0;
    __device__ __forceinline__ void operator()(const f32x4 (&acc)[2][2][4][2], const Unit& u, int wr, int wc, int fr, int fq) const {
        const int row0 = u.pm * BM + wr * 64 + fr; int colt = u.pn * BM; bf16_t* base = O;
        float sc = 1.f; if (split_cols) { const int t = colt / split_cols; base += (size_t)t * split_stride; colt -= t * split_cols; if (t == 0) sc = scale0; }
        const int col0 = colt + wc * 32 + 8 * fq, bcol0 = u.pn * BM + wc * 32 + 8 * fq;
        f32x4 bv[2][2];
#pragma unroll
        for (int bj = 0; bj < 2; ++bj)
#pragma unroll
            for (int n = 0; n < 2; ++n) bv[bj][n] = bias ? *(const f32x4*)(bias + bcol0 + bj * HALF + 4 * n) : (f32x4){0.f, 0.f, 0.f, 0.f};
#pragma unroll
        for (int ai = 0; ai < 2; ++ai)
#pragma unroll
            for (int m = 0; m < 4; ++m) { bf16_t* rowp = base + (size_t)(row0 + ai * HALF + m * 16) * ldc + col0;
#pragma unroll
                for (int bj = 0; bj < 2; ++bj) { f32x4 v0 = acc[ai][bj][m][0] + bv[bj][0], v1 = acc[ai][bj][m][1] + bv[bj][1];
                    if (ACT == 1) { f32x2 a = gelu_pk((f32x2){v0[0], v0[1]}), b = gelu_pk((f32x2){v0[2], v0[3]}), c = gelu_pk((f32x2){v1[0], v1[1]}), d = gelu_pk((f32x2){v1[2], v1[3]});
                        v0 = (f32x4){a.x, a.y, b.x, b.y}; v1 = (f32x4){c.x, c.y, d.x, d.y}; }
                    v0 = v0 * sc; v1 = v1 * sc; u32x4 w; w.x = cvt_pk_bf16(v0[0], v0[1]); w.y = cvt_pk_bf16(v0[2], v0[3]); w.z = cvt_pk_bf16(v1[0], v1[1]); w.w = cvt_pk_bf16(v1[2], v1[3]);
                    *(u32x4*)(rowp + bj * HALF) = w; } }
    }
};
template <class Epi, class Sched, bool ALIGN_EPI = false, bool SP2 = false, bool F8 = false>
__device__ __forceinline__ void gemm_phase(PG8_LAS unsigned char* lds, const Gemm g, const Sched& S, const Epi& E) {
    int tid_ = threadIdx.x; asm volatile("" : "+v"(tid_));
    const int tid = tid_, wid = __builtin_amdgcn_readfirstlane(tid >> 6), lane = tid & 63, wr = wid >> 2, wc = wid & 3, fr = lane & 15, fq = lane >> 4;
    const int K = g.K, nt = K / BK;
    unsigned voffA[2], voffB[2];
#pragma unroll
    for (int i = 0; i < 2; ++i) { int R, C; stage_rc(tid * 16 + i * 8192, R, C); const int Rb = Epi::PERM ? ((R & ~31) + perm32(R & 31)) : R;
        voffA[i] = (unsigned)(R * K + C) * 2u; voffB[i] = (unsigned)(Rb * K + C) * 2u; }
    const size_t kstep = (size_t)(BK * 2);
    const size_t hstep = (size_t)HALF * K * 2;
    const size_t tstep = 2 * hstep;
    const unsigned ldsw = (unsigned)wid * 1024u;
    const int aoff = lds_byte(wr * 64 + fr, fq * 8), boff = lds_byte(wc * 32 + fr, fq * 8);
#define PG8_SA(b, h) (((b) * 2 + (h)) * HTB)
#define PG8_SB(b, h) ((4 + (b) * 2 + (h)) * HTB)
#define PG8_STAGE(bufoff, gbase, voff) do { _Pragma("unroll") for (int _i = 0; _i < 2; ++_i) \
        __builtin_amdgcn_global_load_lds((const unsigned*)((const char*)(gbase) + (voff)[_i]), (PG8_LAS unsigned*)(lds + (bufoff) + ldsw + _i * 8192), 16, 0, 0); } while (0)
#define PG8_LDA(dst, b, h) do { _Pragma("unroll") for (int m = 0; m < 4; ++m) _Pragma("unroll") for (int k = 0; k < 2; ++k) dst[m][k] = *(const PG8_LAS bf16x8*)(lds + PG8_SA(b, h) + aoff + m * 2048 + k * 1024); } while (0)
#define PG8_LDB(dst, b, h) do { _Pragma("unroll") for (int n = 0; n < 2; ++n) _Pragma("unroll") for (int k = 0; k < 2; ++k) dst[n][k] = *(const PG8_LAS bf16x8*)(lds + PG8_SB(b, h) + boff + n * 2048 + k * 1024); } while (0)
#define PG8_MMA(ai, bj, At, Bt) do { __builtin_amdgcn_s_setprio(1); _Pragma("unroll") for (int m = 0; m < 4; ++m) _Pragma("unroll") for (int n = 0; n < 2; ++n) { \
        if constexpr (F8) { typedef int v8i_ __attribute__((ext_vector_type(8))); typedef int v4i_ __attribute__((ext_vector_type(4))); \
            const v4i_ b0_ = __builtin_bit_cast(v4i_, Bt[n][0]), b1_ = __builtin_bit_cast(v4i_, Bt[n][1]), a0_ = __builtin_bit_cast(v4i_, At[m][0]), a1_ = __builtin_bit_cast(v4i_, At[m][1]); \
            const v8i_ bb_ = {b0_.x, b0_.y, b0_.z, b0_.w, b1_.x, b1_.y, b1_.z, b1_.w}, aa_ = {a0_.x, a0_.y, a0_.z, a0_.w, a1_.x, a1_.y, a1_.z, a1_.w}; \
            asm volatile("v_mfma_scale_f32_16x16x128_f8f6f4 %0, %1, %2, %0, %3, %3 op_sel_hi:[0,0,0]" : "+v"(acc[ai][bj][m][n]) : "v"(bb_), "v"(aa_), "v"(f8one)); } \
        else { _Pragma("unroll") for (int k = 0; k < 2; ++k) acc[ai][bj][m][n] = __builtin_amdgcn_mfma_f32_16x16x32_bf16(Bt[n][k], At[m][k], acc[ai][bj][m][n], 0, 0, 0); } } \
        __builtin_amdgcn_s_setprio(0); } while (0)
#define PG8_WAIT_V(n) asm volatile("s_waitcnt vmcnt(" #n ")" ::: "memory")
#define PG8_WAIT_L(n) asm volatile("s_waitcnt lgkmcnt(" #n ")" ::: "memory")
#define PG8_BAR __builtin_amdgcn_s_barrier()
#define PG8_SCHED __builtin_amdgcn_sched_barrier(0)
    Unit cur, nxt; int ui = 0;
    if (!S.next(0, cur)) return;
    f32x4 acc[2][2][4][2];
    const int f8one = 0x7f7f7f7f;
#pragma unroll
    for (int a = 0; a < 2; ++a)
#pragma unroll
        for (int b = 0; b < 2; ++b)
#pragma unroll
            for (int m = 0; m < 4; ++m)
#pragma unroll
                for (int n = 0; n < 2; ++n) acc[a][b][m][n] = (f32x4){0.f, 0.f, 0.f, 0.f};
    bf16x8 At[4][2], B0[2][2], B1[2][2];
    const char* cA = (const char*)g.A + (size_t)cur.pm * tstep; const char* cB = (const char*)g.Bt + (size_t)cur.pn * tstep;
    S.a_ready(cur);
    float segr[16];
    if constexpr (Epi::SEG) E.seg_load(ui, wr, fr, segr);
    if constexpr (SP2) {
        PG8_STAGE(PG8_SB(0, 0), cB, voffB); PG8_STAGE(PG8_SB(0, 1), cB + hstep, voffB); PG8_STAGE(PG8_SA(0, 0), cA, voffA); PG8_STAGE(PG8_SA(0, 1), cA + hstep, voffA);
        if (wr == 1) PG8_BAR;
        PG8_WAIT_V(2); PG8_BAR;
        PG8_STAGE(PG8_SB(1, 0), cB + kstep, voffB); PG8_STAGE(PG8_SA(1, 0), cA + kstep, voffA); PG8_STAGE(PG8_SB(1, 1), cB + hstep + kstep, voffB);
        PG8_WAIT_V(6); PG8_BAR;
    } else {
        PG8_STAGE(PG8_SB(0, 0), cB, voffB); PG8_STAGE(PG8_SA(0, 0), cA, voffA); PG8_STAGE(PG8_SB(0, 1), cB + hstep, voffB); PG8_STAGE(PG8_SA(0, 1), cA + hstep, voffA);
        if (wr == 1) PG8_BAR;
        PG8_WAIT_V(4); PG8_BAR;
        PG8_STAGE(PG8_SB(1, 0), cB + kstep, voffB); PG8_STAGE(PG8_SA(1, 0), cA + kstep, voffA); PG8_STAGE(PG8_SB(1, 1), cB + hstep + kstep, voffB);
        PG8_WAIT_V(6); PG8_BAR;
    }
    for (;;) {
        const bool has_next = S.next(ui + 1, nxt);
        const char* nA = has_next ? (const char*)g.A + (size_t)nxt.pm * tstep : cA; const char* nB = has_next ? (const char*)g.Bt + (size_t)nxt.pn * tstep : cB;
        int t = 0;
#pragma unroll 1
        for (int sgi = 0; sgi < (Epi::SEG ? 3 : 1); ++sgi) {
        int tend = nt; if constexpr (Epi::SEG) tend = (sgi == 0) ? Epi::SEG_T1 : ((sgi == 1) ? Epi::SEG_T2 : nt);
        for (; t < tend; t += 2) {
            const bool last = (t == nt - 2);
            const char* a1 = cA + (size_t)(t + 1) * kstep;
            const char* a2 = last ? nA : cA + (size_t)(t + 2) * kstep; const char* b2 = last ? nB : cB + (size_t)(t + 2) * kstep;
            const char* a3 = a2 + kstep; const char* b3 = b2 + kstep;
            if (last && has_next) S.a_ready(nxt);
            if constexpr (SP2) {
            PG8_LDB(B0, 0, 0); PG8_LDB(B1, 0, 1); PG8_SCHED; PG8_LDA(At, 0, 0); PG8_STAGE(PG8_SA(1, 1), a1 + hstep, voffA);
            PG8_WAIT_V(8); PG8_WAIT_L(0); PG8_BAR; PG8_MMA(0, 0, At, B0); PG8_MMA(0, 1, At, B1); PG8_BAR; PG8_SCHED;
            PG8_LDA(At, 0, 1); PG8_STAGE(PG8_SB(0, 0), b2, voffB); PG8_STAGE(PG8_SB(0, 1), b2 + hstep, voffB); PG8_STAGE(PG8_SA(0, 0), a2, voffA);
            PG8_WAIT_V(8); PG8_WAIT_L(0); PG8_BAR; PG8_MMA(1, 0, At, B0); PG8_MMA(1, 1, At, B1); PG8_BAR; PG8_SCHED;
            PG8_LDB(B0, 1, 0); PG8_LDB(B1, 1, 1); PG8_SCHED; PG8_LDA(At, 1, 0); PG8_STAGE(PG8_SA(0, 1), a2 + hstep, voffA);
            PG8_WAIT_V(8); PG8_WAIT_L(0); PG8_BAR; PG8_MMA(0, 0, At, B0); PG8_MMA(0, 1, At, B1); PG8_BAR; PG8_SCHED;
            PG8_LDA(At, 1, 1); PG8_STAGE(PG8_SB(1, 0), b3, voffB); PG8_STAGE(PG8_SB(1, 1), b3 + hstep, voffB); PG8_STAGE(PG8_SA(1, 0), a3, voffA);
            PG8_WAIT_V(8); PG8_WAIT_L(0); PG8_BAR; PG8_MMA(1, 0, At, B0); PG8_MMA(1, 1, At, B1); PG8_BAR; PG8_SCHED;
            } else {
            PG8_LDB(B0, 0, 0); PG8_SCHED; PG8_LDA(At, 0, 0); PG8_STAGE(PG8_SA(1, 1), a1 + hstep, voffA);
            PG8_WAIT_L(8); PG8_BAR; PG8_WAIT_L(0); PG8_MMA(0, 0, At, B0); PG8_BAR; PG8_SCHED;
            PG8_LDB(B1, 0, 1); PG8_STAGE(PG8_SB(0, 0), b2, voffB);
            PG8_BAR; PG8_WAIT_L(0); PG8_MMA(0, 1, At, B1); PG8_BAR;
            PG8_LDA(At, 0, 1); PG8_STAGE(PG8_SA(0, 0), a2, voffA);
            PG8_BAR; PG8_WAIT_L(0); PG8_MMA(1, 0, At, B0); PG8_BAR; PG8_SCHED;
            PG8_STAGE(PG8_SB(0, 1), b2 + hstep, voffB);
            PG8_WAIT_V(6); PG8_BAR; PG8_MMA(1, 1, At, B1); PG8_BAR;
            PG8_LDB(B0, 1, 0); PG8_SCHED; PG8_LDA(At, 1, 0); PG8_STAGE(PG8_SA(0, 1), a2 + hstep, voffA);
            PG8_WAIT_L(8); PG8_BAR; PG8_WAIT_L(0); PG8_MMA(0, 0, At, B0); PG8_BAR; PG8_SCHED;
            PG8_LDB(B1, 1, 1); PG8_STAGE(PG8_SB(1, 0), b3, voffB);
            PG8_BAR; PG8_WAIT_L(0); PG8_MMA(0, 1, At, B1); PG8_BAR;
            PG8_LDA(At, 1, 1); PG8_STAGE(PG8_SA(1, 0), a3, voffA);
            PG8_BAR; PG8_WAIT_L(0); PG8_MMA(1, 0, At, B0); PG8_BAR; PG8_SCHED;
            PG8_STAGE(PG8_SB(1, 1), b3 + hstep, voffB);
            PG8_WAIT_V(6); PG8_BAR; PG8_MMA(1, 1, At, B1); PG8_BAR;
            }
        }
        if constexpr (Epi::SEG) E.seg_apply(acc, segr, sgi);
        }
        if constexpr (ALIGN_EPI) { if (wr == 0) PG8_BAR; }
        if constexpr (!Epi::AFTER_DRAIN) { if constexpr (Epi::SEG) E(acc, cur, wr, wc, fr, fq, ui); else E(acc, cur, wr, wc, fr, fq); S.done(cur); }
        if (!has_next) break;
#pragma unroll
        for (int a = 0; a < 2; ++a)
#pragma unroll
            for (int b = 0; b < 2; ++b)
#pragma unroll
                for (int m = 0; m < 4; ++m)
#pragma unroll
                    for (int n = 0; n < 2; ++n) acc[a][b][m][n] = (f32x4){0.f, 0.f, 0.f, 0.f};
        cur = nxt; cA = nA; cB = nB; ++ui;
        if constexpr (Epi::SEG) E.seg_load(ui, wr, fr, segr);
        if constexpr (ALIGN_EPI) { if (wr == 1) PG8_BAR; }
    }
    PG8_WAIT_V(0);
    if constexpr (!ALIGN_EPI) { if (wr == 0) PG8_BAR; }
    PG8_BAR;
    if constexpr (Epi::AFTER_DRAIN) { E.fused(acc, cur, wr, wc, fr, fq, lds, wid, lane); S.done(cur); }
#undef PG8_SA
#undef PG8_SB
#undef PG8_STAGE
#undef PG8_LDA
#undef PG8_LDB
#undef PG8_MMA
#undef PG8_WAIT_V
#undef PG8_WAIT_L
#undef PG8_BAR
#undef PG8_SCHED
}
}
#ifndef PG8_SP2
#define PG8_SP2 true
#endif
#ifndef PG8_ALIGN
#define PG8_ALIGN true
#endif

constexpr int BATCH = 8, SEQ = 2048, DM = 2048, MTOK = BATCH * SEQ;
constexpr int ATT_W = 1024, ATT_H = 8, ATT_HD = 128, MOBA_BLK = 256, NBLK = SEQ / MOBA_BLK;
constexpr int SSM_W = 1024, SSM_H = 16, SSM_P = 64, SSM_N = 128, SSM_L = 128, SSM_NC = SEQ / SSM_L, CONV_CH = 1536;
constexpr int IN_PROJ = 5648, NPROJ = 5632  , NPAD = 5888  ;
constexpr int F8_LO = 2048, F8_HI = 4096, NB16 = NPAD - (F8_HI - F8_LO)  ;
constexpr float SH8 = 16.f;
constexpr int COL_Q = 0, COL_K = 1024, COL_V = 2048, COL_Z = 3072, COL_XBC = 4096;
constexpr int PEER_H = 8, PEER_NK = 128, PEER_K = 16, PEER_HK = 128;
constexpr float EPS = 1e-6f;
constexpr float SU = 64.f, SV = 4.f, SH = 16.f, SLO = 16.f;
constexpr float SX8 = 16.f, SW8 = 1024.f;
constexpr float SA8 = 32.f, SS8 = 8.f;
constexpr float SH4 = 1.5f, SLO4 = 4.f;
constexpr int ROWB = DM / 2;

constexpr size_t MiB = 1u << 20;
constexpr size_t WS_CTL = 0, CTL_ZERO_BYTES = 1 * MiB;
constexpr size_t WS_DT = 1 * MiB;
constexpr size_t WS_SK = 2 * MiB;
constexpr size_t WS_WIN = 4 * MiB;
constexpr size_t WS_WIN8 = 24 * MiB;
constexpr size_t WS_HN8 = 396 * MiB;
constexpr size_t WS_WOUT = 28 * MiB;
constexpr size_t WS_WQ = 36 * MiB;
constexpr size_t WS_HN = 44 * MiB;
constexpr size_t WS_PROJ = 108 * MiB;
constexpr size_t WS_X1B = WS_PROJ, WS_QP = WS_PROJ + 64 * MiB;
constexpr size_t WS_U8 = 284 * MiB, WS_V8 = 316 * MiB;
constexpr size_t WS_XBC = 348 * MiB;
constexpr size_t WS_DT2 = 3 * MiB;
constexpr size_t WS_X18 = 396 * MiB;
constexpr size_t WS_END = 428 * MiB;
constexpr int CW_BAR = 4096;
constexpr int CW_Q2 = 8192;
constexpr int CW_KMEAN = 32768;
constexpr int CW_SSQ = 131072;
static_assert((CW_SSQ + MTOK * 4) * 4 <= (int)CTL_ZERO_BYTES, "CTL words inside the memset region");

constexpr int RING_OFF = 0, RING_BYTES = 131072;
constexpr int LDSCTL_OFF = RING_BYTES, MISC_OFF = LDSCTL_OFF + 320;
constexpr int SEGTAB_OFF = LDSCTL_OFF + 1024;  static_assert(LDSCTL_OFF + 1024 + 3 * 256 * 16 <= 147456, "segment table inside the LDS allocation");
constexpr int LDS_BYTES = 147456;
constexpr int NWAVES = 8;

#define GAS __attribute__((address_space(1)))
#define LAS __attribute__((address_space(3)))
typedef unsigned short bf16;
typedef unsigned v4u __attribute__((ext_vector_type(4)));
typedef unsigned v2u __attribute__((ext_vector_type(2)));
typedef float f32x4 __attribute__((ext_vector_type(4)));
typedef float f32x2 __attribute__((ext_vector_type(2)));
typedef short bf16x8 __attribute__((ext_vector_type(8)));
typedef short s16x4 __attribute__((ext_vector_type(4)));
typedef GAS unsigned gu32;
#define RLX_AGENT __ATOMIC_RELAXED, __HIP_MEMORY_SCOPE_AGENT
#define LDS_WAIT() asm volatile("s_waitcnt lgkmcnt(0)" ::: "memory")
#define VM_WAIT() asm volatile("s_waitcnt vmcnt(0)" ::: "memory")
__device__ __forceinline__ unsigned f2bf(float f) { unsigned u = __builtin_bit_cast(unsigned, f); return (u + 0x7fffu + ((u >> 16) & 1u)) >> 16; }
typedef __bf16 bf16v2 __attribute__((ext_vector_type(2)));
__device__ __forceinline__ unsigned pk2(float lo, float hi) { bf16v2 v; v.x = (__bf16)lo; v.y = (__bf16)hi; return __builtin_bit_cast(unsigned, v); }
__device__ __forceinline__ float bflo(unsigned w) { return __builtin_bit_cast(float, w << 16); }
__device__ __forceinline__ float bfhi(unsigned w) { return __builtin_bit_cast(float, w & 0xffff0000u); }
__device__ __forceinline__ float wave_sum(float v) {
#pragma unroll
    for (int o = 1; o < 64; o <<= 1) v += __shfl_xor(v, o);
    return v;
}
__device__ __forceinline__ float silu_f(float x) { return x * __builtin_amdgcn_rcpf(1.f + __expf(-x)); }

#define XB_TMO      128
#define XB_XCNT(j)  (256  + 64 * (j))
#define XB_XSUB(j)  (1280 + 64 * (j))
#define XB_XGEN(j)  (2304 + 64 * (j))
#define XB_TOP      3328
#define XB_TOPGEN   3392
#define XCD_BAR_WORDS 3456
#define XB_SPIN_CAP (1u << 18)

__device__ __forceinline__ unsigned xb_ld(unsigned* p)              { return __hip_atomic_load(p, __ATOMIC_RELAXED, __HIP_MEMORY_SCOPE_AGENT); }
__device__ __forceinline__ unsigned xb_add(unsigned* p, unsigned v) { return __hip_atomic_fetch_add(p, v, __ATOMIC_RELAXED, __HIP_MEMORY_SCOPE_AGENT); }
__device__ __forceinline__ unsigned xb_xcc_id() { return (unsigned)__builtin_amdgcn_s_getreg((3 << 11) | 20) & 0xFu; }
#define XB_SPIN(cond, bar) do { unsigned _sp = 0; while (cond) { __builtin_amdgcn_s_sleep(1); \
    if ((++_sp & 255u) == 0u) { if (xb_ld(&(bar)[XB_TMO])) break; if (_sp > XB_SPIN_CAP) { atomicAdd(&(bar)[XB_TMO], 1u); break; } } } } while (0)

struct XcdBarrier {
    unsigned* bar; unsigned x;
    volatile LAS unsigned* st;
};
__device__ __forceinline__ XcdBarrier xcd_barrier_post(unsigned* bar, volatile LAS unsigned* st) {
    XcdBarrier b; b.bar = bar; b.x = xb_xcc_id(); b.st = st;
    if (threadIdx.x == 0) (void)xb_add(&bar[XB_XCNT(b.x)], 1u);
    return b;
}
__device__ __forceinline__ void xcd_barrier_complete(unsigned* bar, unsigned x, unsigned& nloc, unsigned& nx) {
    const unsigned G = gridDim.x * gridDim.y * gridDim.z;
    unsigned sum, cnt, mine, sp = 0u;
    for (;;) {
        sum = 0u; cnt = 0u; mine = 0u;
#pragma unroll
        for (unsigned j = 0; j < 16; ++j) { const unsigned c = xb_ld(&bar[XB_XCNT(j)]); sum += c; cnt += (c > 0u) ? 1u : 0u; mine = (j == x) ? c : mine; }
        if (sum == G) break;
        __builtin_amdgcn_s_sleep(1);
        if ((++sp & 255u) == 0u) { if (xb_ld(&bar[XB_TMO])) break; if (sp > XB_SPIN_CAP) { atomicAdd(&bar[XB_TMO], 1u); break; } }
    }
    nloc = mine > 0u ? mine : 1u; nx = cnt > 0u ? cnt : 1u;
}
__device__ __forceinline__ void xcd_barrier(const XcdBarrier& b) {
    asm volatile("s_waitcnt vmcnt(0)" ::: "memory");
    __syncthreads();
    if (threadIdx.x == 0) {
        unsigned* bar = b.bar;
        __builtin_amdgcn_s_waitcnt(0);
        unsigned nloc = b.st[0], nx = b.st[1];
        if (nloc == 0u) { xcd_barrier_complete(bar, b.x, nloc, nx); b.st[0] = nloc; b.st[1] = nx; }
        const unsigned old = xb_add(&bar[XB_XSUB(b.x)], 1u);
        const unsigned gen = old / nloc;
        if (old + 1u == (gen + 1u) * nloc) {
            __builtin_amdgcn_fence(__ATOMIC_RELEASE, "agent");
            asm volatile("s_waitcnt vmcnt(0)" ::: "memory");
            const unsigned og = xb_add(&bar[XB_TOP], 1u);
            const unsigned tg = og / nx;
            if (og + 1u == (tg + 1u) * nx) xb_add(&bar[XB_TOPGEN], 1u);
            else XB_SPIN(xb_ld(&bar[XB_TOPGEN]) == tg, bar);
            __builtin_amdgcn_fence(__ATOMIC_ACQUIRE, "agent");
            xb_add(&bar[XB_XGEN(b.x)], 1u);
            asm volatile("s_waitcnt vmcnt(0)" ::: "memory");
        } else {
            XB_SPIN(xb_ld(&bar[XB_XGEN(b.x)]) == gen, bar);
            __builtin_amdgcn_fence(__ATOMIC_ACQUIRE, "agent");
            asm volatile("s_waitcnt vmcnt(0)" ::: "memory");
        }
    }
    __syncthreads();
}

#define CAS __attribute__((address_space(4)))
struct Args { const float* in[18]; float* out; unsigned char* ws; };
__device__ __forceinline__ const CAS unsigned char* kargs() { const CAS unsigned char* p = (const CAS unsigned char*)__builtin_amdgcn_kernarg_segment_ptr(); asm volatile("" : "+s"(p)); return p; }
__device__ __forceinline__ const float* kin(int i) { return *(const float* const CAS*)(kargs() + 8 * i); }
__device__ __forceinline__ float* kout() { return *(float* const CAS*)(kargs() + 8 * 18); }
__device__ __forceinline__ unsigned char* kws() { return *(unsigned char* const CAS*)(kargs() + 8 * 19); }
__device__ __forceinline__ float xrow16_max(float x) {
    auto s = __builtin_amdgcn_permlane16_swap(__builtin_bit_cast(unsigned, x), __builtin_bit_cast(unsigned, x), false, false);
    x = fmaxf(__builtin_bit_cast(float, (unsigned)s[0]), __builtin_bit_cast(float, (unsigned)s[1]));
    auto t = __builtin_amdgcn_permlane32_swap(__builtin_bit_cast(unsigned, x), __builtin_bit_cast(unsigned, x), false, false);
    return fmaxf(__builtin_bit_cast(float, (unsigned)t[0]), __builtin_bit_cast(float, (unsigned)t[1]));
}
__device__ __forceinline__ float xrow16_sum(float x) {
    auto s = __builtin_amdgcn_permlane16_swap(__builtin_bit_cast(unsigned, x), __builtin_bit_cast(unsigned, x), false, false);
    x = __builtin_bit_cast(float, (unsigned)s[0]) + __builtin_bit_cast(float, (unsigned)s[1]);
    auto t = __builtin_amdgcn_permlane32_swap(__builtin_bit_cast(unsigned, x), __builtin_bit_cast(unsigned, x), false, false);
    return __builtin_bit_cast(float, (unsigned)t[0]) + __builtin_bit_cast(float, (unsigned)t[1]);
}
__device__ __forceinline__ int fresh_tid() { int t = threadIdx.x; asm volatile("" : "+v"(t)); return t; }
struct Frame {
    LAS unsigned char* lds;
    volatile LAS unsigned* MISC;
    int tid, lane, wave, G;
    __device__ __forceinline__ const float* x() const { return kin(0); }
    __device__ __forceinline__ const float* attn_norm() const { return kin(1); }
    __device__ __forceinline__ const float* w_in() const { return kin(2); }
    __device__ __forceinline__ const float* conv_w() const { return kin(3); }
    __device__ __forceinline__ const float* conv_b() const { return kin(4); }
    __device__ __forceinline__ const float* dt_bias() const { return kin(5); }
    __device__ __forceinline__ const float* a_log() const { return kin(6); }
    __device__ __forceinline__ const float* d_skip() const { return kin(7); }
    __device__ __forceinline__ const float* rel_bias() const { return kin(8); }
    __device__ __forceinline__ const float* attn_out_norm() const { return kin(9); }
    __device__ __forceinline__ const float* ssm_out_norm() const { return kin(10); }
    __device__ __forceinline__ const float* w_out() const { return kin(11); }
    __device__ __forceinline__ const float* ffn_norm() const { return kin(12); }
    __device__ __forceinline__ const float* peer_wq() const { return kin(13); }
    __device__ __forceinline__ const float* peer_sk() const { return kin(14); }
    __device__ __forceinline__ const float* peer_u() const { return kin(15); }
    __device__ __forceinline__ const float* peer_v() const { return kin(16); }
    __device__ __forceinline__ const float* final_norm() const { return kin(17); }
    __device__ __forceinline__ float* out() const { return kout(); }
    __device__ __forceinline__ unsigned* ctl() const { return (unsigned*)(kws() + WS_CTL); }
    __device__ __forceinline__ float* dtraw() const { return (float*)(kws() + WS_DT); }
    __device__ __forceinline__ bf16* SK() const { return (bf16*)(kws() + WS_SK); }
    __device__ __forceinline__ bf16* WinT() const { return (bf16*)(kws() + WS_WIN); }
    __device__ __forceinline__ bf16* WoutT() const { return (bf16*)(kws() + WS_WOUT); }
    __device__ __forceinline__ bf16* WqT() const { return (bf16*)(kws() + WS_WQ); }
    __device__ __forceinline__ bf16* HN() const { return (bf16*)(kws() + WS_HN); }
    __device__ __forceinline__ bf16* PROJ() const { return (bf16*)(kws() + WS_PROJ); }
    __device__ __forceinline__ bf16* X1B() const { return (bf16*)(kws() + WS_X1B); }
    __device__ __forceinline__ bf16* QP() const { return (bf16*)(kws() + WS_QP); }
    __device__ __forceinline__ unsigned char* U8() const { return kws() + WS_U8; }
    __device__ __forceinline__ unsigned char* V8() const { return kws() + WS_V8; }
    __device__ __forceinline__ unsigned char* X18() const { return kws() + WS_X18; }
    __device__ __forceinline__ unsigned char* HN8() const { return kws() + WS_HN8; }
    __device__ __forceinline__ unsigned char* WinT8() const { return kws() + WS_WIN8; }
    __device__ __forceinline__ bf16* XBC() const { return (bf16*)(kws() + WS_XBC); }
    __device__ __forceinline__ float* DT2() const { return (float*)(kws() + WS_DT2); }
    __device__ __forceinline__ float* kmean() const { return (float*)(kws() + WS_CTL) + CW_KMEAN; }
    __device__ __forceinline__ float* ssq() const { return (float*)(kws() + WS_CTL) + CW_SSQ; }
};

__device__ __forceinline__ float clampf(float v, float lim);
__device__ __forceinline__ void p0_transpose_item(const float* W, int K, int N, bf16* WT, const float* gain, LAS float* scr, int item, int lane, const float f8scale = 0.f, const int nshift = 0, const bool kperm = false) {
    const int nblk = (N + 31) / 32, kb = item / nblk, nb = item % nblk, k0 = 64 * kb, n0 = 32 * nb;
    const int kr = lane >> 3, nc = (lane & 7) * 4; const bool ok = (n0 + nc) < N;
    f32x4 v[8]; float gk[8];
#pragma unroll
    for (int i = 0; i < 8; ++i) { const int kk = 8 * i + kr; v[i] = ok ? *(const GAS f32x4*)(W + (size_t)(k0 + kk) * N + n0 + nc) : (f32x4){0.f, 0.f, 0.f, 0.f}; gk[i] = gain ? gain[k0 + kk] : 1.f; }
#pragma unroll
    for (int i = 0; i < 8; ++i) { const int kk = 8 * i + kr; LAS float* d = scr + kk * 33 + nc; d[0] = v[i].x * gk[i]; d[1] = v[i].y * gk[i]; d[2] = v[i].z * gk[i]; d[3] = v[i].w * gk[i]; }
    LDS_WAIT(); asm volatile("" ::: "memory");
    const int c = lane & 7;
#pragma unroll
    for (int j = 0; j < 4; ++j) { const int n = (lane >> 3) + 8 * j; const LAS float* s = scr + (8 * c) * 33 + n;
        v4u o; o.x = pk2(s[0 * 33], s[1 * 33]); o.y = pk2(s[2 * 33], s[3 * 33]); o.z = pk2(s[4 * 33], s[5 * 33]); o.w = pk2(s[6 * 33], s[7 * 33]);
        if (f8scale == 0.f) *(GAS v4u*)(WT + (size_t)(n0 + n - nshift) * K + k0 + 8 * c) = o;
        else { v2u o8; int w_;
            w_ = __builtin_amdgcn_cvt_pk_fp8_f32(clampf(s[0 * 33] * f8scale, 448.f), clampf(s[1 * 33] * f8scale, 448.f), 0, false); w_ = __builtin_amdgcn_cvt_pk_fp8_f32(clampf(s[2 * 33] * f8scale, 448.f), clampf(s[3 * 33] * f8scale, 448.f), w_, true); o8.x = (unsigned)w_;
            w_ = __builtin_amdgcn_cvt_pk_fp8_f32(clampf(s[4 * 33] * f8scale, 448.f), clampf(s[5 * 33] * f8scale, 448.f), 0, false); w_ = __builtin_amdgcn_cvt_pk_fp8_f32(clampf(s[6 * 33] * f8scale, 448.f), clampf(s[7 * 33] * f8scale, 448.f), w_, true); o8.y = (unsigned)w_;
            if (!kperm) *(GAS v2u*)((unsigned char*)WT + (size_t)(n0 + n - nshift) * K + k0 + 8 * c) = o8;
            else { unsigned char* rowp = (unsigned char*)WT + (size_t)(n0 + n - nshift) * K + k0 + 4 * (c >> 1);
                *(GAS unsigned*)(rowp + 32 * (c & 1)) = o8.x; *(GAS unsigned*)(rowp + 32 * (c & 1) + 16) = o8.y; } } }
    LDS_WAIT(); asm volatile("" ::: "memory");
}
__device__ __forceinline__ unsigned pk4_fp8(float a, float b, float c, float d) { int w = __builtin_amdgcn_cvt_pk_fp8_f32(clampf(a, 448.f), clampf(b, 448.f), 0, false); w = __builtin_amdgcn_cvt_pk_fp8_f32(clampf(c, 448.f), clampf(d, 448.f), w, true); return (unsigned)w; }
__device__ __forceinline__ void rms_2rows_to_bf16(const float* x0, const float* x1, const float* gain, bf16* o0, bf16* o1, unsigned char* q0, unsigned char* q1, int lane) {
    const GAS f32x4* xr0 = (const GAS f32x4*)x0 + lane; const GAS f32x4* xr1 = (const GAS f32x4*)x1 + lane; const GAS f32x4* gr = (const GAS f32x4*)gain + lane;
    f32x4 v[8], u[8]; float s = 0.f, t = 0.f;
#pragma unroll
    for (int j = 0; j < 8; ++j) { v[j] = xr0[64 * j]; u[j] = xr1[64 * j]; }
#pragma unroll
    for (int j = 0; j < 8; ++j) { s += (v[j].x * v[j].x + v[j].y * v[j].y) + (v[j].z * v[j].z + v[j].w * v[j].w); t += (u[j].x * u[j].x + u[j].y * u[j].y) + (u[j].z * u[j].z + u[j].w * u[j].w); }
    const float rs = __builtin_amdgcn_rsqf(wave_sum(s) * (1.f / DM) + EPS), rt = __builtin_amdgcn_rsqf(wave_sum(t) * (1.f / DM) + EPS);
    GAS v2u* p0 = (GAS v2u*)o0 + lane; GAS v2u* p1 = (GAS v2u*)o1 + lane; GAS unsigned* r0 = (GAS unsigned*)q0 + lane; GAS unsigned* r1 = (GAS unsigned*)q1 + lane;
#pragma unroll
    for (int j = 0; j < 8; ++j) { const f32x4 g = gr[64 * j]; v2u a, b;
        const f32x4 h0 = v[j] * g * rs, h1 = u[j] * g * rt;
        a.x = pk2(h0.x, h0.y); a.y = pk2(h0.z, h0.w); p0[64 * j] = a; r0[64 * j] = pk4_fp8(h0.x * SH8, h0.y * SH8, h0.z * SH8, h0.w * SH8);
        b.x = pk2(h1.x, h1.y); b.y = pk2(h1.z, h1.w); p1[64 * j] = b; r1[64 * j] = pk4_fp8(h1.x * SH8, h1.y * SH8, h1.z * SH8, h1.w * SH8); }
}
#ifdef PROBE_FP4EMU
__device__ __forceinline__ float fp4grid(float y) { const float a = fabsf(y); float r;
    if (a <= 2.f) r = rintf(a * 2.f) * 0.5f; else if (a <= 4.f) r = rintf(a); else r = (a < 5.f) ? 4.f : 6.f;
    return copysignf(r, y); }
__device__ __forceinline__ float clampf(float v, float lim) { if (lim == 448.5f) return fp4grid(v * (1.f / 16.f)) * 16.f; return fminf(fmaxf(v, -lim), lim); }
#else
__device__ __forceinline__ float clampf(float v, float lim) { return fminf(fmaxf(v, -lim), lim); }
#endif
template <int TAB = 0> __device__ __forceinline__ v4u cvt16_fp8(const f32x4 a, const f32x4 b, const f32x4 c, const f32x4 d, float sc) {
    v4u o; int w; constexpr float LIM = TAB ? 448.5f : 448.f;
    w = __builtin_amdgcn_cvt_pk_fp8_f32(clampf(a.x * sc, LIM), clampf(a.y * sc, LIM), 0, false); w = __builtin_amdgcn_cvt_pk_fp8_f32(clampf(a.z * sc, LIM), clampf(a.w * sc, LIM), w, true); o.x = (unsigned)w;
    w = __builtin_amdgcn_cvt_pk_fp8_f32(clampf(b.x * sc, LIM), clampf(b.y * sc, LIM), 0, false); w = __builtin_amdgcn_cvt_pk_fp8_f32(clampf(b.z * sc, LIM), clampf(b.w * sc, LIM), w, true); o.y = (unsigned)w;
    w = __builtin_amdgcn_cvt_pk_fp8_f32(clampf(c.x * sc, LIM), clampf(c.y * sc, LIM), 0, false); w = __builtin_amdgcn_cvt_pk_fp8_f32(clampf(c.z * sc, LIM), clampf(c.w * sc, LIM), w, true); o.z = (unsigned)w;
    w = __builtin_amdgcn_cvt_pk_fp8_f32(clampf(d.x * sc, LIM), clampf(d.y * sc, LIM), 0, false); w = __builtin_amdgcn_cvt_pk_fp8_f32(clampf(d.z * sc, LIM), clampf(d.w * sc, LIM), w, true); o.w = (unsigned)w;
    return o;
}
__device__ __forceinline__ void tables_convert(Frame& F, size_t lo, size_t hi, size_t tix, size_t ntx) {
      const GAS f32x4* su = (const GAS f32x4*)F.peer_u(); const GAS f32x4* sv = (const GAS f32x4*)F.peer_v(); GAS v4u* du = (GAS v4u*)F.U8(); GAS v4u* dv = (GAS v4u*)F.V8();
#pragma unroll 1
      for (int tab = 0; tab < 2; ++tab) { const GAS f32x4* src = tab ? sv : su; GAS v4u* dst = tab ? dv : du; const float sc = tab ? SV : SU;
        f32x4 nx[8]; const size_t i0 = lo + tix;
        if (i0 < hi) { const GAS f32x4* p = src + (i0 >> 6) * 512 + (i0 & 63);
#pragma unroll
            for (int j = 0; j < 8; ++j) nx[j] = __builtin_nontemporal_load(p + 64 * j); }
#pragma unroll 1
        for (size_t i = i0; i < hi; i += ntx) { f32x4 v[8];
#pragma unroll
            for (int j = 0; j < 8; ++j) v[j] = nx[j];
            if (i + ntx < hi) { const size_t i2 = i + ntx; const GAS f32x4* p = src + (i2 >> 6) * 512 + (i2 & 63);
#pragma unroll
                for (int j = 0; j < 8; ++j) nx[j] = __builtin_nontemporal_load(p + 64 * j); }
            unsigned wd[4];
#pragma unroll
            for (int q = 0; q < 4; ++q) { const f32x4 a = v[2 * q] * sc, b = v[2 * q + 1] * sc; unsigned w = 0u;
                w = __builtin_amdgcn_cvt_scalef32_pk_fp4_f32(w, clampf(a.x, 6.f), clampf(a.y, 6.f), 1.0f, 0); w = __builtin_amdgcn_cvt_scalef32_pk_fp4_f32(w, clampf(a.z, 6.f), clampf(a.w, 6.f), 1.0f, 1);
                w = __builtin_amdgcn_cvt_scalef32_pk_fp4_f32(w, clampf(b.x, 6.f), clampf(b.y, 6.f), 1.0f, 2); w = __builtin_amdgcn_cvt_scalef32_pk_fp4_f32(w, clampf(b.z, 6.f), clampf(b.w, 6.f), 1.0f, 3); wd[q] = w; }
            dst[i] = (v4u){wd[0], wd[1], wd[2], wd[3]}; } }
}
constexpr size_t TAB_ITEMS = (size_t)16384 * 64;
constexpr size_t TAB_P0_LO = (TAB_ITEMS / 8) * 7;
#ifndef TAB_HEAD8
#define TAB_HEAD8 4
#endif
__device__ __forceinline__ size_t tab_split(int G) { const int rem = ((MTOK / 256) * (NB16 / 256)) % G; return rem ? (TAB_ITEMS / 8) * TAB_HEAD8 : TAB_ITEMS; }
__device__ __forceinline__ unsigned fp4_code(float y) { const float a = fabsf(y);
    const unsigned m = (unsigned)(a >= 0.25f) + (unsigned)(a >= 0.75f) + (unsigned)(a >= 1.25f) + (unsigned)(a >= 1.75f) + (unsigned)(a >= 2.5f) + (unsigned)(a >= 3.5f) + (unsigned)(a >= 5.0f);
    return m | ((y < 0.f) ? 8u : 0u); }
constexpr int W_SQ_ITEMS = (DM / 64) * (DM / 32), W_SQ_PER_UNIT = 64, W_SQ_UNITS = 2 * W_SQ_ITEMS / W_SQ_PER_UNIT;
__device__ __forceinline__ void sq_weight_items(Frame& F, int unit) {
    const int tid = fresh_tid(), lane = tid & 63, wave = __builtin_amdgcn_readfirstlane(tid >> 6);
    LAS float* scr = (LAS float*)(F.lds + RING_OFF + wave * 16384);
    const float* const w_out = F.w_out(); const float* const wq = F.peer_wq(); const float* const fg = F.ffn_norm(); bf16* const WoutT = F.WoutT(); bf16* const WqT = F.WqT(); const float* const gatt = F.attn_out_norm(); const float* const gssm = F.ssm_out_norm();
#pragma unroll 1
    for (int k = 0; k < W_SQ_PER_UNIT / NWAVES; ++k) {
        int r = unit * W_SQ_PER_UNIT + k * NWAVES + wave;
        if (r < W_SQ_ITEMS) { const int k0_ = 64 * (r / (DM / 32)); p0_transpose_item(w_out, DM, DM, WoutT, (k0_ < ATT_W) ? gatt : (gssm - ATT_W), scr, r, lane, SW8, 0, true); }
        else { r -= W_SQ_ITEMS; p0_transpose_item(wq, DM, DM, WqT, fg, scr, r, lane, SW8); }
    }
}
__device__ __forceinline__ void p0_prologue(Frame& F) {
    const int tid = fresh_tid(), lane = tid & 63, wave = __builtin_amdgcn_readfirstlane(tid >> 6);
    LAS float* scr = (LAS float*)(F.lds + RING_OFF + wave * 16384);
    const int gw = blockIdx.x * NWAVES + wave, NGW = F.G * NWAVES;
    constexpr int I_IN = (DM / 64) * ((IN_PROJ + 31) / 32), I_SQ = (DM / 64) * (DM / 32);
    constexpr int NITEMS = I_IN;
    { const float* const w_in = F.w_in(); const float* const w_out = F.w_out(); const float* const wq = F.peer_wq(); const float* const fg = F.ffn_norm(); bf16* const WinT = F.WinT(); unsigned char* const WinT8 = F.WinT8(); bf16* const WoutT = F.WoutT(); bf16* const WqT = F.WqT(); const float* const gatt = F.attn_out_norm(); const float* const gssm = F.ssm_out_norm();
      for (int it = gw; it < NITEMS; it += NGW) {
        int r = it;
        if (r < I_IN) { const int n0_ = 32 * (r % ((IN_PROJ + 31) / 32));
            if (n0_ >= F8_LO && n0_ < F8_HI) p0_transpose_item(w_in, DM, IN_PROJ, (bf16*)WinT8, nullptr, scr, r, lane, SW8, F8_LO);
            else p0_transpose_item(w_in, DM, IN_PROJ, WinT, nullptr, scr, r, lane, 0.f, (n0_ >= F8_HI) ? (F8_HI - F8_LO) : 0);
            continue; } r -= I_IN;
      } }
    const size_t gt = (size_t)blockIdx.x * (NWAVES * 64) + tid, GT = (size_t)F.G * NWAVES * 64;
    { const size_t z0 = (size_t)(5664 - (F8_HI - F8_LO)) * DM / 8, z1 = (size_t)NB16 * DM / 8; GAS v4u* p = (GAS v4u*)F.WinT(); for (size_t i = z0 + gt; i < z1; i += GT) p[i] = (v4u){0u, 0u, 0u, 0u}; }
    { const float* const s = F.peer_sk(); GAS v4u* d = (GAS v4u*)F.SK();
      for (size_t o = gt; o < (size_t)16 * 128 * 128 / 8; o += GT) { const int frag = (int)(o >> 6), l = (int)(o & 63), g_ = l >> 4, c_ = l & 15, p_ = frag >> 5, kb_ = (frag >> 2) & 7, ks_ = frag & 3;
          const GAS f32x4* sp = (const GAS f32x4*)(s + (size_t)(p_ * 128 + 16 * kb_ + c_) * 128 + 32 * ks_ + 8 * g_); const f32x4 a = sp[0], b = sp[1];
          v4u w; w.x = pk2(a.x, a.y); w.y = pk2(a.z, a.w); w.z = pk2(b.x, b.y); w.w = pk2(b.z, b.w); d[o] = w; } }
    { const float* const xg = F.x(); const float* const gn = F.attn_norm(); bf16* const hn = F.HN(); unsigned char* const hn8 = F.HN8();
      for (int m = gw; m < MTOK / 2; m += NGW) rms_2rows_to_bf16(xg + (size_t)(2 * m) * DM, xg + (size_t)(2 * m + 1) * DM, gn, hn + (size_t)(2 * m) * DM, hn + (size_t)(2 * m + 1) * DM, hn8 + (size_t)(2 * m) * DM, hn8 + (size_t)(2 * m + 1) * DM, lane); }
    if (tab_split(F.G) < TAB_ITEMS) tables_convert(F, TAB_P0_LO, TAB_ITEMS, gt, GT);
}

struct EpiProj {
    static constexpr bool PERM = true, AFTER_DRAIN = false, SEG = false;
    bf16* O; float* dtraw; float* kmean;
    __device__ __forceinline__ void operator()(const pg8::f32x4 (&acc)[2][2][4][2], const pg8::Unit& u, int wr, int wc, int fr, int fq) const {
        const int rpn = (u.pn < F8_LO / 256) ? u.pn : u.pn + (F8_HI - F8_LO) / 256;
        const int row0 = u.pm * 256 + wr * 64 + fr, col0 = rpn * 256 + wc * 32 + 8 * fq;
        if (rpn < 22) {
#pragma unroll
            for (int ai = 0; ai < 2; ++ai)
#pragma unroll
                for (int m = 0; m < 4; ++m) { bf16* rowp = O + (size_t)(row0 + ai * 128 + m * 16) * NPROJ + col0;
#pragma unroll
                    for (int bj = 0; bj < 2; ++bj) { const pg8::f32x4 v0 = acc[ai][bj][m][0], v1 = acc[ai][bj][m][1];
                        pg8::u32x4 w; w.x = pg8::cvt_pk_bf16(v0[0], v0[1]); w.y = pg8::cvt_pk_bf16(v0[2], v0[3]); w.z = pg8::cvt_pk_bf16(v1[0], v1[1]); w.w = pg8::cvt_pk_bf16(v1[2], v1[3]);
                        *(pg8::u32x4*)(rowp + bj * 128) = w; } }
        } else if (wc == 0 && fq < 2) {
#pragma unroll
            for (int ai = 0; ai < 2; ++ai)
#pragma unroll
                for (int m = 0; m < 4; ++m) { float* rp = dtraw + (size_t)(row0 + ai * 128 + m * 16) * 16 + 8 * fq;
                    *(pg8::f32x4*)rp = acc[ai][0][m][0]; *(pg8::f32x4*)(rp + 4) = acc[ai][0][m][1]; }
        }
        if (kmean && u.pn >= 4 && u.pn < 8) {
#pragma unroll
            for (int bj = 0; bj < 2; ++bj)
#pragma unroll
                for (int n = 0; n < 2; ++n)
#pragma unroll
                    for (int i = 0; i < 4; ++i) { float s = 0.f;
#pragma unroll
                        for (int ai = 0; ai < 2; ++ai)
#pragma unroll
                            for (int m = 0; m < 4; ++m) s += acc[ai][bj][m][n][i];
                        s += __shfl_xor(s, 1); s += __shfl_xor(s, 2); s += __shfl_xor(s, 4); s += __shfl_xor(s, 8);
                        if (fr == 0) unsafeAtomicAdd(kmean + (size_t)u.pm * 1024 + (col0 - 1024) + bj * 128 + 4 * n + i, s); }
        }
    }
};
struct EpiProj8 {
    static constexpr bool PERM = true, AFTER_DRAIN = false, SEG = false;
    bf16* O;
    __device__ __forceinline__ void operator()(const pg8::f32x4 (&acc)[2][2][4][2], const pg8::Unit& u, int wr, int wc, int fr, int fq) const {
        const int row0 = u.pm * 256 + wr * 64 + fr, col0 = F8_LO + u.pn * 256 + wc * 32 + 8 * fq; constexpr float sc = 1.f / (SH8 * SW8);
#pragma unroll
        for (int ai = 0; ai < 2; ++ai)
#pragma unroll
            for (int m = 0; m < 4; ++m) { bf16* rowp = O + (size_t)(row0 + ai * 128 + m * 16) * NPROJ + col0;
#pragma unroll
                for (int bj = 0; bj < 2; ++bj) { const pg8::f32x4 v0 = acc[ai][bj][m][0] * sc, v1 = acc[ai][bj][m][1] * sc;
                    pg8::u32x4 w; w.x = pg8::cvt_pk_bf16(v0[0], v0[1]); w.y = pg8::cvt_pk_bf16(v0[2], v0[3]); w.z = pg8::cvt_pk_bf16(v1[0], v1[1]); w.w = pg8::cvt_pk_bf16(v1[2], v1[3]);
                    *(pg8::u32x4*)(rowp + bj * 128) = w; } }
    }
};
struct EpiOut {
    static constexpr bool PERM = true, AFTER_DRAIN = false, SEG = true; static constexpr int SEG_T1 = 8, SEG_T2 = 12;
    const float* x; bf16* x1b; unsigned char* x18; float* ssq; bool doatom; const LAS f32x4* tab;
    __device__ __forceinline__ void seg_load(int ui, int wr, int fr, float (&sr)[16]) const {
#pragma unroll
        for (int i = 0; i < 8; ++i) { const int r = (i >> 2) * 128 + wr * 64 + (i & 3) * 16 + fr; const f32x2 q = *(const LAS f32x2*)(tab + ui * 256 + r); sr[2 * i] = q.x; sr[2 * i + 1] = q.y; }
        asm volatile("s_waitcnt lgkmcnt(0)" ::: "memory");
    }
    __device__ __forceinline__ void seg_apply(pg8::f32x4 (&acc)[2][2][4][2], const float (&sr)[16], int which) const {
#pragma unroll
        for (int ai = 0; ai < 2; ++ai)
#pragma unroll
            for (int m = 0; m < 4; ++m) { const float f = (which == 0) ? sr[2 * (ai * 4 + m)] : ((which == 1) ? sr[2 * (ai * 4 + m) + 1] : 1.0f);
#pragma unroll
                for (int bj = 0; bj < 2; ++bj)
#pragma unroll
                    for (int n = 0; n < 2; ++n) acc[ai][bj][m][n] = acc[ai][bj][m][n] * f; }
    }
    __device__ __forceinline__ void operator()(const pg8::f32x4 (&acc)[2][2][4][2], const pg8::Unit& u, int wr, int wc, int fr, int fq, int ui) const {
        const int row0 = u.pm * 256 + wr * 64 + fr, col0 = u.pn * 256 + wc * 32 + 8 * fq;
#pragma unroll
        for (int ai = 0; ai < 2; ++ai)
#pragma unroll
            for (int m = 0; m < 4; ++m) { const int row = row0 + ai * 128 + m * 16; const size_t off = (size_t)row * DM + col0; float s = 0.f;
                const float s1 = (*(const LAS f32x4*)(tab + ui * 256 + ai * 128 + wr * 64 + m * 16 + fr)).z;
#pragma unroll
                for (int bj = 0; bj < 2; ++bj) {
                    const pg8::f32x4 a0 = *(const pg8::f32x4*)(x + off + bj * 128), a1 = *(const pg8::f32x4*)(x + off + bj * 128 + 4);
                    const pg8::f32x4 v0 = acc[ai][bj][m][0] * s1 + a0, v1 = acc[ai][bj][m][1] * s1 + a1;
                    pg8::u32x4 w; w.x = pg8::cvt_pk_bf16(v0[0], v0[1]); w.y = pg8::cvt_pk_bf16(v0[2], v0[3]); w.z = pg8::cvt_pk_bf16(v1[0], v1[1]); w.w = pg8::cvt_pk_bf16(v1[2], v1[3]);
                    *(pg8::u32x4*)(x1b + off + bj * 128) = w;
                    { v2u o8; int w_; w_ = __builtin_amdgcn_cvt_pk_fp8_f32(clampf(v0[0] * SX8, 448.f), clampf(v0[1] * SX8, 448.f), 0, false); w_ = __builtin_amdgcn_cvt_pk_fp8_f32(clampf(v0[2] * SX8, 448.f), clampf(v0[3] * SX8, 448.f), w_, true); o8.x = (unsigned)w_;
                      w_ = __builtin_amdgcn_cvt_pk_fp8_f32(clampf(v1[0] * SX8, 448.f), clampf(v1[1] * SX8, 448.f), 0, false); w_ = __builtin_amdgcn_cvt_pk_fp8_f32(clampf(v1[2] * SX8, 448.f), clampf(v1[3] * SX8, 448.f), w_, true); o8.y = (unsigned)w_;
                      *(v2u*)(x18 + off + bj * 128) = o8; }
                    s += (v0[0] * v0[0] + v0[1] * v0[1]) + (v0[2] * v0[2] + v0[3] * v0[3]) + (v1[0] * v1[0] + v1[1] * v1[1]) + (v1[2] * v1[2] + v1[3] * v1[3]); }
                s = xrow16_sum(s);
                if (fq == 0 && doatom) unsafeAtomicAdd(ssq + (size_t)row * 4, s);
                asm volatile("" ::: "memory"); }
    }
};
struct EpiQ {
    static constexpr bool PERM = true, AFTER_DRAIN = false, SEG = false;
    bf16* O; const float* ssq;
    __device__ __forceinline__ void operator()(const pg8::f32x4 (&acc)[2][2][4][2], const pg8::Unit& u, int wr, int wc, int fr, int fq) const {
        const int row0 = u.pm * 256 + wr * 64 + fr, col0 = u.pn * 256 + wc * 32 + 8 * fq;
#pragma unroll
        for (int ai = 0; ai < 2; ++ai)
#pragma unroll
            for (int m = 0; m < 4; ++m) { const int row = row0 + ai * 128 + m * 16; bf16* rowp = O + (size_t)row * DM + col0;
                const float rs = (1.f / (SX8 * SW8)) / sqrtf(__hip_atomic_load(ssq + (size_t)row * 4, RLX_AGENT) * (1.f / DM) + EPS);
#pragma unroll
                for (int bj = 0; bj < 2; ++bj) { const pg8::f32x4 v0 = acc[ai][bj][m][0] * rs, v1 = acc[ai][bj][m][1] * rs;
                    pg8::u32x4 w; w.x = pg8::cvt_pk_bf16(v0[0], v0[1]); w.y = pg8::cvt_pk_bf16(v0[2], v0[3]); w.z = pg8::cvt_pk_bf16(v1[0], v1[1]); w.w = pg8::cvt_pk_bf16(v1[2], v1[3]);
                    *(pg8::u32x4*)(rowp + bj * 128) = w; } }
    }
};

constexpr int A_KSTR = 272, A_VSTR = 288;
constexpr int A_KB0 = 0, A_KB1 = 64 * A_KSTR, A_VB0 = 2 * 64 * A_KSTR, A_VBS = 64 * A_VSTR  , A_KM = A_VB0 + 3 * A_VBS, A_TAB = A_KM + 8 * 128 * 4, A_END = A_TAB + 128 * 4;
static_assert(A_END <= RING_BYTES && (A_KM % 16) == 0, "attention LDS map");
#define PIN16(a, i) asm volatile("" : "+v"(a[i]), "+v"(a[i + 1]), "+v"(a[i + 2]), "+v"(a[i + 3]), "+v"(a[i + 4]), "+v"(a[i + 5]), "+v"(a[i + 6]), "+v"(a[i + 7]), "+v"(a[i + 8]), "+v"(a[i + 9]), "+v"(a[i + 10]), "+v"(a[i + 11]), "+v"(a[i + 12]), "+v"(a[i + 13]), "+v"(a[i + 14]), "+v"(a[i + 15]))
#define TR16(p) __builtin_amdgcn_ds_read_tr16_b64_v4i16((LAS s16x4*)(p))
#define MFMA16(a, b, c) __builtin_amdgcn_mfma_f32_16x16x32_bf16((a), (b), (c), 0, 0, 0)
__device__ __forceinline__ bf16x8 pack8(const float* v) {
    const unsigned a = pk2(v[0], v[1]), b = pk2(v[2], v[3]), c = pk2(v[4], v[5]), d = pk2(v[6], v[7]);
    const v4u u = {a, b, c, d}; return __builtin_bit_cast(bf16x8, u);
}
__device__ __forceinline__ void attn_unit(Frame& F, int b, int h, int blk, const bool doatom = true) {
    LAS unsigned char* lds = F.lds + RING_OFF;
    const int tid = fresh_tid(), lane = tid & 63, w = __builtin_amdgcn_readfirstlane(tid >> 6), g = lane >> 4, c16 = lane & 15, q4 = c16 >> 2, p4 = lane & 3;
    const int own = blk, t0 = blk * 256, tq0 = t0 + 32 * w + c16;
    const size_t rowbase = (size_t)b * SEQ;
    const float NEG_INF = -__builtin_inff();
    constexpr float LOG2E = 1.4426950408889634f, SCL2 = 0.08838834764831845f * 1.4426950408889634f;
    LAS float* km = (LAS float*)(lds + A_KM); LAS float* tab = (LAS float*)(lds + A_TAB);
    const bf16* const PROJ = F.PROJ(); const float* const kmg = F.kmean(); const float* const relb = F.rel_bias();
    for (int i = tid; i < own * 128; i += NWAVES * 64) { const int n = i >> 7, d = i & 127; km[i] = kmg[(size_t)(b * 8 + n) * 1024 + h * 128 + d] * (1.f / 256.f); }
    if (tid < 128) { const int rel = tid; int bucket = rel; if (rel >= 16) { bucket = 16 + (int)(log2f((float)rel * (1.f / 16.f)) * (16.f / 3.f)); bucket = bucket > 31 ? 31 : bucket; }
        tab[tid] = relb[bucket * 8 + h] * LOG2E; }
    bf16x8 qf[2][4];
#pragma unroll
    for (int gi = 0; gi < 2; ++gi) { const bf16* qrow = PROJ + (rowbase + tq0 + 16 * gi) * NPROJ + COL_Q + h * 128 + 8 * g;
#pragma unroll
      for (int ks = 0; ks < 4; ++ks) qf[gi][ks] = *(const GAS bf16x8*)(qrow + 32 * ks); }
    __syncthreads();
    unsigned selmask[2];
    if (own <= 3) { selmask[0] = (1u << own) - 1u; selmask[1] = selmask[0]; }
    else {
#pragma unroll
      for (int gi = 0; gi < 2; ++gi) {
        float gate[7];
#pragma unroll
        for (int n = 0; n < 7; ++n) {
            float s = NEG_INF;
            if (n < own) { s = 0.f;
#pragma unroll
                for (int ks = 0; ks < 4; ++ks) { const LAS f32x4* kp = (const LAS f32x4*)(km + n * 128 + 32 * ks + 8 * g); const f32x4 k0 = kp[0], k1 = kp[1]; const v4u qu = __builtin_bit_cast(v4u, qf[gi][ks]);
                    s += bflo(qu.x) * k0.x + bfhi(qu.x) * k0.y + bflo(qu.y) * k0.z + bfhi(qu.y) * k0.w + bflo(qu.z) * k1.x + bfhi(qu.z) * k1.y + bflo(qu.w) * k1.z + bfhi(qu.w) * k1.w; }
                s = xrow16_sum(s); }
            gate[n] = s;
        }
        unsigned sm = 0u;
#pragma unroll
        for (int r = 0; r < 3; ++r) { float best = NEG_INF; int bi = 0;
#pragma unroll
            for (int n = 0; n < 7; ++n) { const bool cand = (n < own) && !((sm >> n) & 1u) && (gate[n] > best); best = cand ? gate[n] : best; bi = cand ? n : bi; }
            sm |= 1u << bi; }
        selmask[gi] = sm; }
    }
    const int nT = 4 + 4 * own;
    const int sr = tid >> 3, sc = (tid & 7) * 8;
#define A_KEY0(i) ((i) < 4 ? own * 256 + 64 * (i) : (((i) - 4) >> 2) * 256 + (((i) - 4) & 3) * 64)
    v4u kr0, kr1, vr0, vr1;
#define A_LOAD(i) do { const bf16* kp_ = PROJ + (rowbase + A_KEY0(i) + sr) * NPROJ + COL_K + h * 128 + sc; \
        kr0 = *(const GAS v4u*)kp_; kr1 = *(const GAS v4u*)(kp_ + 64); vr0 = *(const GAS v4u*)(kp_ + (COL_V - COL_K)); vr1 = *(const GAS v4u*)(kp_ + (COL_V - COL_K) + 64); } while (0)
#define A_STORE(bufi) do { LAS unsigned char* kd_ = lds + ((bufi) ? A_KB1 : A_KB0) + sr * A_KSTR + sc * 2; LAS unsigned char* vd_ = lds + A_VB0 + vnx * A_VBS + sr * A_VSTR + sc * 2; \
        *(LAS v4u*)kd_ = kr0; *(LAS v4u*)(kd_ + 128) = kr1; *(LAS v4u*)vd_ = vr0; *(LAS v4u*)(vd_ + 128) = vr1; } while (0)
    int vcur = 0, vnx = 0, vprev = 0;
#define A_PV(PF, Vb_) do { _Pragma("unroll") for (int s = 0; s < 2; ++s) { s16x4 vlo[8], vhi[8]; \
            _Pragma("unroll") for (int db = 0; db < 8; ++db) { LAS unsigned char* va = (Vb_) + (32 * s + 4 * g + q4) * A_VSTR + (16 * db + 4 * p4) * 2; vlo[db] = TR16(va); vhi[db] = TR16(va + 16 * A_VSTR); } \
            __builtin_amdgcn_sched_barrier(0); \
            _Pragma("unroll") for (int db = 0; db < 8; ++db) { const bf16x8 vf = __builtin_shufflevector(vlo[db], vhi[db], 0, 1, 2, 3, 4, 5, 6, 7); \
                oacc[0][db] = MFMA16(vf, PF[0][s], oacc[0][db]); oacc[1][db] = MFMA16(vf, PF[1][s], oacc[1][db]); } \
            __builtin_amdgcn_sched_barrier(0); } } while (0)
    A_LOAD(0); A_STORE(0);
    __syncthreads();
    const bool late = w >= 4;
    bf16x8 pfp[2][2]; bool skipp = true;
#pragma unroll
    for (int gi = 0; gi < 2; ++gi) { pfp[gi][0] = (bf16x8){0, 0, 0, 0, 0, 0, 0, 0}; pfp[gi][1] = pfp[gi][0]; }
    float m_run[2] = {NEG_INF, NEG_INF}, l_run[2] = {0.f, 0.f};
    f32x4 oacc[2][8];
#pragma unroll
    for (int gi = 0; gi < 2; ++gi)
#pragma unroll
        for (int db = 0; db < 8; ++db) oacc[gi][db] = (f32x4){0.f, 0.f, 0.f, 0.f};
    for (int i = 0; i < nT; ++i) {
        if (i + 1 < nT) A_LOAD(i + 1);
        vnx = (vcur == 2) ? 0 : vcur + 1;
        const int buf = i & 1, key0 = A_KEY0(i); const bool isown = i < 4; const int pblk = isown ? own : ((i - 4) >> 2);
        const bool skipw = isown && (64 * i > 32 * w + 31);
        if (late && !skipp) A_PV(pfp, lds + A_VB0 + vprev * A_VBS);
        bf16x8 pf[2][2];
        if (!skipw) {
        LAS unsigned char* Kb = lds + (buf ? A_KB1 : A_KB0);
        f32x4 sacc[2][4];
#pragma unroll
        for (int hf = 0; hf < 2; ++hf) { bf16x8 kf[8];
#pragma unroll
            for (int n2 = 0; n2 < 2; ++n2)
#pragma unroll
                for (int ks = 0; ks < 4; ++ks) kf[n2 * 4 + ks] = *(const LAS bf16x8*)(Kb + (16 * (2 * hf + n2) + c16) * A_KSTR + (32 * ks + 8 * g) * 2);
            __builtin_amdgcn_sched_barrier(0);
#pragma unroll
            for (int gi = 0; gi < 2; ++gi)
#pragma unroll
                for (int n2 = 0; n2 < 2; ++n2) { f32x4 a = (f32x4){0.f, 0.f, 0.f, 0.f};
#pragma unroll
                    for (int ks = 0; ks < 4; ++ks) a = MFMA16(kf[n2 * 4 + ks], qf[gi][ks], a);
                    sacc[gi][2 * hf + n2] = a; }
            __builtin_amdgcn_sched_barrier(0); }
        const bool far = (key0 + 63 + 128 <= t0 + 32 * w);
        const bool diag = isown && (64 * i + 63 > 32 * w);
#pragma unroll
        for (int gi = 0; gi < 2; ++gi) {
            const int tq = tq0 + 16 * gi; const bool sel = isown || ((selmask[gi] >> pblk) & 1u);
            float sv[16]; float mloc, m_new, alpha;
            if (far) {
                const float bfar = tab[127];
                float mx = fmaxf(fmaxf(sacc[gi][0][0], sacc[gi][0][1]), fmaxf(sacc[gi][0][2], sacc[gi][0][3]));
#pragma unroll
                for (int nb = 1; nb < 4; ++nb) mx = fmaxf(mx, fmaxf(fmaxf(sacc[gi][nb][0], sacc[gi][nb][1]), fmaxf(sacc[gi][nb][2], sacc[gi][nb][3])));
                mloc = sel ? (mx * SCL2 + bfar) : NEG_INF;
                mloc = xrow16_max(mloc);
                m_new = fmaxf(m_run[gi], mloc); alpha = __builtin_amdgcn_exp2f(m_run[gi] - m_new);
                const float cadd = sel ? (bfar - m_new) : NEG_INF;
#pragma unroll
                for (int nb = 0; nb < 4; ++nb)
#pragma unroll
                    for (int r = 0; r < 4; ++r) sv[nb * 4 + r] = __builtin_amdgcn_exp2f(sacc[gi][nb][r] * SCL2 + cadd);
            } else {
                const int relb = tq - key0 - 4 * g; float bias[16];
#pragma unroll
                for (int nb = 0; nb < 4; ++nb)
#pragma unroll
                    for (int r = 0; r < 4; ++r) { const int rel = relb - 16 * nb - r; int ri = rel < 0 ? 0 : rel; ri = ri > 127 ? 127 : ri; bias[nb * 4 + r] = tab[ri]; }
                PIN16(bias, 0);
                mloc = NEG_INF;
#pragma unroll
                for (int nb = 0; nb < 4; ++nb)
#pragma unroll
                    for (int r = 0; r < 4; ++r) { const int rel = relb - 16 * nb - r;
                        float s = sacc[gi][nb][r] * SCL2 + bias[nb * 4 + r]; s = (!sel || (diag && rel < 0)) ? NEG_INF : s; sv[nb * 4 + r] = s; mloc = fmaxf(mloc, s); }
                mloc = xrow16_max(mloc);
                m_new = fmaxf(m_run[gi], mloc); alpha = __builtin_amdgcn_exp2f(m_run[gi] - m_new);
#pragma unroll
                for (int e = 0; e < 16; ++e) sv[e] = __builtin_amdgcn_exp2f(sv[e] - m_new);
            }
            float psum = 0.f;
#pragma unroll
            for (int e = 0; e < 16; ++e) psum += sv[e];
            l_run[gi] = l_run[gi] * alpha + psum; m_run[gi] = m_new;
#pragma unroll
            for (int db = 0; db < 8; ++db) oacc[gi][db] = oacc[gi][db] * alpha;
            pf[gi][0] = pack8(sv); pf[gi][1] = pack8(sv + 8);
        }
        __builtin_amdgcn_sched_barrier(0);
        if (!late) A_PV(pf, lds + A_VB0 + vcur * A_VBS);
        }
        if (late) { skipp = skipw;
#pragma unroll
            for (int gi = 0; gi < 2; ++gi) { pfp[gi][0] = pf[gi][0]; pfp[gi][1] = pf[gi][1]; } }
        if (i + 1 < nT) A_STORE((i + 1) & 1);
        vprev = vcur; vcur = vnx;
        __syncthreads();
    }
    if (late && !skipp) A_PV(pfp, lds + A_VB0 + vprev * A_VBS);
#undef A_PV
    bf16* const MIXp = F.HN(); float* const ssqp = F.ssq();
#pragma unroll
    for (int gi = 0; gi < 2; ++gi) {
        const int tq = tq0 + 16 * gi;
        const float l_tot = xrow16_sum(l_run[gi]);
        const float inv = 1.f / l_tot; float ssq = 0.f;
        unsigned char* orow = (unsigned char*)MIXp + (rowbase + tq) * DM + h * 128 + 16 * g;
        unsigned ow[8];
#pragma unroll
        for (int db = 0; db < 8; ++db) { const f32x4 o = oacc[gi][db] * inv; ssq += (o.x * o.x + o.y * o.y) + (o.z * o.z + o.w * o.w); ow[db] = pk4_fp8(o.x * SA8, o.y * SA8, o.z * SA8, o.w * SA8); }
        *(GAS v4u*)orow = (v4u){ow[0], ow[1], ow[2], ow[3]}; *(GAS v4u*)(orow + 64) = (v4u){ow[4], ow[5], ow[6], ow[7]};
        ssq = xrow16_sum(ssq);
        if (g == 0 && doatom) unsafeAtomicAdd(ssqp + (rowbase + tq) * 4 + 1, ssq);
    }
#undef A_KEY0
#undef A_LOAD
#undef A_STORE
}

constexpr int XBC_W = CONV_CH;
__device__ __forceinline__ void conv_phase(Frame& F) {
    const bf16* const PROJ = F.PROJ(); bf16* const XBC = F.XBC(); const float* const cw = F.conv_w(); const float* const cb = F.conv_b();
    const int gt = blockIdx.x * (NWAVES * 64) + fresh_tid(), GT = F.G * NWAVES * 64;
    for (int task = gt; task < (MTOK / 32) * (CONV_CH / 8); task += GT) {
        const int r = task / (CONV_CH / 8), k = task % (CONV_CH / 8), ch = 8 * k, tok0 = 32 * r;
        float wv[4][8], bias[8];
#pragma unroll
        for (int t = 0; t < 4; ++t) { const f32x4 w0 = *(const GAS f32x4*)(cw + t * CONV_CH + ch), w1 = *(const GAS f32x4*)(cw + t * CONV_CH + ch + 4);
            wv[t][0] = w0.x; wv[t][1] = w0.y; wv[t][2] = w0.z; wv[t][3] = w0.w; wv[t][4] = w1.x; wv[t][5] = w1.y; wv[t][6] = w1.z; wv[t][7] = w1.w; }
        { const f32x4 b0 = *(const GAS f32x4*)(cb + ch), b1 = *(const GAS f32x4*)(cb + ch + 4); bias[0] = b0.x; bias[1] = b0.y; bias[2] = b0.z; bias[3] = b0.w; bias[4] = b1.x; bias[5] = b1.y; bias[6] = b1.z; bias[7] = b1.w; }
        const bf16* src = PROJ + (size_t)tok0 * NPROJ + COL_XBC + ch; bf16* dst = XBC + (size_t)tok0 * XBC_W + ch;
        v4u p0 = (v4u){0u, 0u, 0u, 0u}, p1 = p0, p2 = p0;
        if ((tok0 & (SEQ - 1)) != 0) { p0 = *(const GAS v4u*)(src - 3 * (ptrdiff_t)NPROJ); p1 = *(const GAS v4u*)(src - 2 * (ptrdiff_t)NPROJ); p2 = *(const GAS v4u*)(src - (ptrdiff_t)NPROJ); }
#pragma unroll 1
        for (int i0 = 0; i0 < 32; i0 += 8) {
            v4u cur[8];
#pragma unroll
            for (int i = 0; i < 8; ++i) cur[i] = *(const GAS v4u*)(src + (size_t)(i0 + i) * NPROJ);
#pragma unroll
            for (int i = 0; i < 8; ++i) {
                const v4u c = cur[i]; float acc[8];
                const unsigned a0[4] = {p0.x, p0.y, p0.z, p0.w}, a1[4] = {p1.x, p1.y, p1.z, p1.w}, a2[4] = {p2.x, p2.y, p2.z, p2.w}, a3[4] = {c.x, c.y, c.z, c.w};
#pragma unroll
                for (int j = 0; j < 4; ++j) {
                    acc[2 * j] = bias[2 * j] + wv[0][2 * j] * bflo(a0[j]) + wv[1][2 * j] * bflo(a1[j]) + wv[2][2 * j] * bflo(a2[j]) + wv[3][2 * j] * bflo(a3[j]);
                    acc[2 * j + 1] = bias[2 * j + 1] + wv[0][2 * j + 1] * bfhi(a0[j]) + wv[1][2 * j + 1] * bfhi(a1[j]) + wv[2][2 * j + 1] * bfhi(a2[j]) + wv[3][2 * j + 1] * bfhi(a3[j]); }
#pragma unroll
                for (int j = 0; j < 8; ++j) acc[j] = silu_f(acc[j]);
                v4u o; o.x = pk2(acc[0], acc[1]); o.y = pk2(acc[2], acc[3]); o.z = pk2(acc[4], acc[5]); o.w = pk2(acc[6], acc[7]);
                *(GAS v4u*)(dst + (size_t)(i0 + i) * XBC_W) = o;
                p0 = p1; p1 = p2; p2 = c; }
        }
    }
    { const float* const dtraw = F.dtraw(); float* const dt2 = F.DT2(); const float* const dtb = F.dt_bias();
      for (int i = gt; i < MTOK * 16; i += GT) { const float xr = dtraw[i] + dtb[i & 15]; dt2[i] = xr > 20.f ? xr : log1pf(__expf(xr)); } }
}

constexpr int S_BSTR = 272, S_XSTR = 144;
constexpr int S_BM = 0, S_CM = 128 * S_BSTR, S_X = 2 * 128 * S_BSTR, S_XW = S_X + 128 * S_XSTR, S_HB = S_XW + 128 * S_XSTR, S_DT = S_HB + 64 * S_BSTR, S_CS = S_DT + 512, S_DA = S_CS + 512, S_END = S_DA + 512;
static_assert(S_END <= RING_BYTES, "ssd LDS map");
__device__ __forceinline__ void ssd_unit(Frame& F, int b, int h, const bool doatom = true) {
    LAS unsigned char* lds = F.lds + RING_OFF;
    const int tid = fresh_tid(), lane = tid & 63, w = __builtin_amdgcn_readfirstlane(tid >> 6), g = lane >> 4, c16 = lane & 15, q4 = c16 >> 2, p4 = lane & 3;
    const int g8 = h >> 3, pbw = w & 3, nhw = w >> 2;
    const float a_h = -__expf(F.a_log()[h]), dsk = F.d_skip()[h];
    const bf16* const PROJ = F.PROJ(); bf16* const MIX = F.HN(); const float* const dt2 = F.DT2(); const bf16* const XBC = F.XBC(); float* const ssqp = F.ssq();
    LAS float* dtl = (LAS float*)(lds + S_DT); LAS float* csl = (LAS float*)(lds + S_CS); LAS float* dal = (LAS float*)(lds + S_DA);
    for (int i = tid; i < 64 * S_BSTR / 16; i += NWAVES * 64) ((LAS v4u*)(lds + S_HB))[i] = (v4u){0u, 0u, 0u, 0u};
    f32x4 hacc[4];
#pragma unroll
    for (int i = 0; i < 4; ++i) hacc[i] = (f32x4){0.f, 0.f, 0.f, 0.f};
    const int xl = tid >> 3, xc = tid & 7, bl = tid >> 4, bc = tid & 15;
    v4u xr[2], br[4], cr[4]; float dtv = 0.f;
#define S_PREFETCH(cc) do { const size_t t0_ = (size_t)b * SEQ + (size_t)(cc) * SSM_L; \
        _Pragma("unroll") for (int i_ = 0; i_ < 2; ++i_) xr[i_] = *(const GAS v4u*)(XBC + (t0_ + xl + 64 * i_) * XBC_W + h * 64 + 8 * xc); \
        _Pragma("unroll") for (int i_ = 0; i_ < 4; ++i_) { const bf16* p_ = XBC + (t0_ + bl + 32 * i_) * XBC_W + 1024 + g8 * 128 + 8 * bc; br[i_] = *(const GAS v4u*)p_; cr[i_] = *(const GAS v4u*)(p_ + 256); } \
        if (tid < 128) dtv = dt2[(t0_ + tid) * 16 + h]; } while (0)
    S_PREFETCH(0);
    for (int c = 0; c < SSM_NC; ++c) {
        const size_t tok0 = (size_t)b * SEQ + (size_t)c * SSM_L;
        if (tid < 128) { dtl[tid] = dtv; dal[tid] = dtv * a_h; }
        __syncthreads();
        { const float v0 = dal[2 * lane], v1 = dal[2 * lane + 1]; float s = v0 + v1;
#define DPP_SHR(x, n) __builtin_bit_cast(float, __builtin_amdgcn_update_dpp(0, __builtin_bit_cast(int, (x)), 0x110 + (n), 0xf, 0xf, false))
            s += DPP_SHR(s, 1); s += DPP_SHR(s, 2); s += DPP_SHR(s, 4); s += DPP_SHR(s, 8);
#undef DPP_SHR
            const float t0 = __builtin_bit_cast(float, __builtin_amdgcn_readlane(__builtin_bit_cast(int, s), 15)), t1 = __builtin_bit_cast(float, __builtin_amdgcn_readlane(__builtin_bit_cast(int, s), 31)), t2 = __builtin_bit_cast(float, __builtin_amdgcn_readlane(__builtin_bit_cast(int, s), 47));
            s += (lane >= 16 ? t0 : 0.f) + (lane >= 32 ? t1 : 0.f) + (lane >= 48 ? t2 : 0.f);
            csl[2 * lane] = s - v1; csl[2 * lane + 1] = s; }
        LDS_WAIT(); asm volatile("" ::: "memory");
        const float cs_last = csl[127];
#pragma unroll
        for (int i = 0; i < 2; ++i) { const int l = xl + 64 * i; const v4u v = xr[i]; *(LAS v4u*)(lds + S_X + l * S_XSTR + xc * 16) = v; const float wl = dtl[l] * __expf(cs_last - csl[l]);
            v4u o2; o2.x = pk2(bflo(v.x) * wl, bfhi(v.x) * wl); o2.y = pk2(bflo(v.y) * wl, bfhi(v.y) * wl); o2.z = pk2(bflo(v.z) * wl, bfhi(v.z) * wl); o2.w = pk2(bflo(v.w) * wl, bfhi(v.w) * wl);
            *(LAS v4u*)(lds + S_XW + l * S_XSTR + xc * 16) = o2; }
#pragma unroll
        for (int i = 0; i < 4; ++i) { const int l = bl + 32 * i; *(LAS v4u*)(lds + S_BM + l * S_BSTR + bc * 16) = br[i]; *(LAS v4u*)(lds + S_CM + l * S_BSTR + bc * 16) = cr[i]; }
        const int lrow = 16 * w + c16;
        v2u zr[4];
#pragma unroll
        for (int pb = 0; pb < 4; ++pb) zr[pb] = *(const GAS v2u*)(PROJ + (tok0 + lrow) * NPROJ + COL_Z + h * 64 + 16 * pb + 4 * g);
        if (c + 1 < SSM_NC) S_PREFETCH(c + 1);
        __syncthreads();
        bf16x8 cf[4];
#pragma unroll
        for (int ks = 0; ks < 4; ++ks) cf[ks] = *(const LAS bf16x8*)(lds + S_CM + lrow * S_BSTR + (32 * ks + 8 * g) * 2);
        f32x4 yacc[4];
        const float cs_l = csl[lrow]; const float el = __expf(cs_l);
#pragma unroll
        for (int pb = 0; pb < 4; ++pb) { yacc[pb] = (f32x4){0.f, 0.f, 0.f, 0.f};
#pragma unroll
            for (int ks = 0; ks < 4; ++ks) { const bf16x8 hf = *(const LAS bf16x8*)(lds + S_HB + (16 * pb + c16) * S_BSTR + (32 * ks + 8 * g) * 2); yacc[pb] = MFMA16(hf, cf[ks], yacc[pb]); }
            yacc[pb] = yacc[pb] * el; }
        for (int s2 = 0; s2 <= (w >> 1); ++s2) {
            const int sb0 = 2 * s2, sb1 = 2 * s2 + 1; const bool has1 = sb1 <= w;
            f32x4 cb0 = (f32x4){0.f, 0.f, 0.f, 0.f}, cb1 = (f32x4){0.f, 0.f, 0.f, 0.f};
#pragma unroll
            for (int ks = 0; ks < 4; ++ks) { const bf16x8 bf0 = *(const LAS bf16x8*)(lds + S_BM + (16 * sb0 + c16) * S_BSTR + (32 * ks + 8 * g) * 2); cb0 = MFMA16(bf0, cf[ks], cb0); }
            if (has1) {
#pragma unroll
                for (int ks = 0; ks < 4; ++ks) { const bf16x8 bf1 = *(const LAS bf16x8*)(lds + S_BM + (16 * sb1 + c16) * S_BSTR + (32 * ks + 8 * g) * 2); cb1 = MFMA16(bf1, cf[ks], cb1); } }
            float mv[8];
#pragma unroll
            for (int r = 0; r < 4; ++r) { const int s = 16 * sb0 + 4 * g + r; const float e = __expf(fminf(cs_l - csl[s], 0.f)) * dtl[s]; mv[r] = (s <= lrow) ? cb0[r] * e : 0.f; }
#pragma unroll
            for (int r = 0; r < 4; ++r) { const int s = 16 * sb1 + 4 * g + r; const int sc_ = s > 127 ? 127 : s; const float e = __expf(fminf(cs_l - csl[sc_], 0.f)) * dtl[sc_]; mv[4 + r] = (has1 && s <= lrow) ? cb1[r] * e : 0.f; }
            const bf16x8 pf = pack8(mv);
#pragma unroll
            for (int pb = 0; pb < 4; ++pb) { LAS unsigned char* xa = lds + S_X + (32 * s2 + 4 * g + q4) * S_XSTR + (16 * pb + 4 * p4) * 2;
                const s16x4 lo = TR16(xa), hi = TR16(xa + 16 * S_XSTR); const bf16x8 xf = __builtin_shufflevector(lo, hi, 0, 1, 2, 3, 4, 5, 6, 7);
                yacc[pb] = MFMA16(xf, pf, yacc[pb]); }
        }
        { const size_t tok = tok0 + lrow; float ssq = 0.f; unsigned ow[4];
#pragma unroll
          for (int pb = 0; pb < 4; ++pb) { const int p0 = 16 * pb + 4 * g;
              const v2u xs_ = *(const LAS v2u*)(lds + S_X + lrow * S_XSTR + p0 * 2);
              const v2u zr_ = zr[pb];
              const float o0 = (yacc[pb].x + bflo(xs_.x) * dsk) * silu_f(bflo(zr_.x)), o1 = (yacc[pb].y + bfhi(xs_.x) * dsk) * silu_f(bfhi(zr_.x));
              const float o2 = (yacc[pb].z + bflo(xs_.y) * dsk) * silu_f(bflo(zr_.y)), o3 = (yacc[pb].w + bfhi(xs_.y) * dsk) * silu_f(bfhi(zr_.y));
              ssq += (o0 * o0 + o1 * o1) + (o2 * o2 + o3 * o3);
              ow[pb] = pk4_fp8(o0 * SS8, o1 * SS8, o2 * SS8, o3 * SS8); }
          *(GAS v4u*)((unsigned char*)MIX + tok * DM + ATT_W + h * 64 + 16 * g) = (v4u){ow[0], ow[1], ow[2], ow[3]};
          ssq = xrow16_sum(ssq);
          if (g == 0 && doatom) unsafeAtomicAdd(ssqp + tok * 4 + 2 + g8, ssq); }
        { const float cdec = __expf(cs_last);
#pragma unroll
          for (int i = 0; i < 4; ++i) hacc[i] = hacc[i] * cdec;
#pragma unroll
          for (int ks = 0; ks < 4; ++ks) {
              LAS unsigned char* xa = lds + S_XW + (32 * ks + 8 * g + q4) * S_XSTR + (16 * pbw + 4 * p4) * 2;
              const s16x4 xlo = TR16(xa), xhi = TR16(xa + 4 * S_XSTR); const bf16x8 xf = __builtin_shufflevector(xlo, xhi, 0, 1, 2, 3, 4, 5, 6, 7);
#pragma unroll
              for (int i = 0; i < 4; ++i) { const int nb = 4 * nhw + i; LAS unsigned char* ba = lds + S_BM + (32 * ks + 8 * g + q4) * S_BSTR + (16 * nb + 4 * p4) * 2;
                  const s16x4 blo = TR16(ba), bhi = TR16(ba + 4 * S_BSTR); const bf16x8 bfr = __builtin_shufflevector(blo, bhi, 0, 1, 2, 3, 4, 5, 6, 7);
                  hacc[i] = MFMA16(bfr, xf, hacc[i]); } } }
        __syncthreads();
#pragma unroll
        for (int i = 0; i < 4; ++i) { const int nb = 4 * nhw + i; v2u o; o.x = pk2(hacc[i].x, hacc[i].y); o.y = pk2(hacc[i].z, hacc[i].w);
            *(LAS v2u*)(lds + S_HB + (16 * pbw + c16) * S_BSTR + (16 * nb + 4 * g) * 2) = o; }
    }
#undef S_PREFETCH
    __syncthreads();
}

__device__ __forceinline__ void mix_normalize(Frame& F) {
    const int tid_ = fresh_tid(), lane = tid_ & 63; const int gw = blockIdx.x * NWAVES + __builtin_amdgcn_readfirstlane(tid_ >> 6), NGW = F.G * NWAVES;
    const float* const ssqp = F.ssq(); bf16* const MIX = F.HN(); const float* const gatt = F.attn_out_norm(); const float* const gssm = F.ssm_out_norm();
    for (int m = gw; m < MTOK; m += NGW) {
        const float* sq = ssqp + (size_t)m * 4;
        const float s1 = __hip_atomic_load(sq + 1, RLX_AGENT), s2 = __hip_atomic_load(sq + 2, RLX_AGENT), s3 = __hip_atomic_load(sq + 3, RLX_AGENT);
        const float ra = 1.f / sqrtf(s1 * (1.f / 1024.f) + EPS), r0 = 1.f / sqrtf(s2 * (1.f / 512.f) + EPS), r1 = 1.f / sqrtf(s3 * (1.f / 512.f) + EPS);
        GAS v4u* row = (GAS v4u*)(MIX + (size_t)m * DM);
#pragma unroll
        for (int j = 0; j < 4; ++j) { const int idx = lane + 64 * j, col = 8 * idx; const float rs = (j < 2) ? ra : ((j == 2) ? r0 : r1);
            const float* gp = (j < 2) ? (gatt + col) : (gssm + (col - ATT_W));
            const f32x4 g0 = *(const GAS f32x4*)gp, g1 = *(const GAS f32x4*)(gp + 4); const v4u v = row[idx]; v4u o;
            o.x = pk2(bflo(v.x) * rs * g0.x, bfhi(v.x) * rs * g0.y); o.y = pk2(bflo(v.y) * rs * g0.z, bfhi(v.y) * rs * g0.w);
            o.z = pk2(bflo(v.z) * rs * g1.x, bfhi(v.z) * rs * g1.y); o.w = pk2(bflo(v.w) * rs * g1.z, bfhi(v.w) * rs * g1.w); row[idx] = o; }
    }
}

constexpr size_t TAB_UNIT = 1024;
static_assert((TAB_ITEMS / 8) % TAB_UNIT == 0 && TAB_ITEMS % TAB_UNIT == 0, "table filler units");
constexpr int P_EIDX = 0, P_GATE = 16384, P_LST = 32768  , P_HN4 = 32768  , P_ACT = 98304  , P_END = 114688;
static_assert(P_END <= RING_BYTES, "peer LDS map");
__constant__ unsigned char PEER_CAND[52] = {0, 1, 2, 3, 4, 5, 6, 7, 8, 9, 10, 11, 12, 13, 14, 15, 16, 17, 18, 19, 20, 21, 22, 23, 32, 33, 34, 35, 36, 48, 49, 50, 51, 64, 65, 66, 80, 81, 96, 97, 112, 113, 128, 144, 160, 176, 192, 208, 224, 240, 255, 255};
__device__ __forceinline__ unsigned f2ord(float f) { const unsigned u = __builtin_bit_cast(unsigned, f); return u ^ ((u >> 31) ? 0xFFFFFFFFu : 0x80000000u); }
__device__ __forceinline__ float ord2f(unsigned u) { return __builtin_bit_cast(float, u ^ ((u >> 31) ? 0x80000000u : 0xFFFFFFFFu)); }
#define CSWAPD(a, b) do { const unsigned hi_ = (a) > (b) ? (a) : (b), lo_ = (a) > (b) ? (b) : (a); (a) = hi_; (b) = lo_; } while (0)
template <int N> __device__ __forceinline__ void bitonic_sort_desc(unsigned (&v)[N]) {
#pragma unroll
    for (int k = 2; k <= N; k <<= 1)
#pragma unroll
        for (int j = k >> 1; j > 0; j >>= 1)
#pragma unroll
            for (int i = 0; i < N; ++i) { const int l = i ^ j; if (l > i) { if ((i & k) == 0) CSWAPD(v[i], v[l]); else CSWAPD(v[l], v[i]); } }
}
__device__ __forceinline__ void merge16_xor(unsigned (&v)[16], int dist) {
    unsigned o[16];
#pragma unroll
    for (int i = 0; i < 16; ++i) o[i] = (unsigned)__shfl_xor((int)v[i], dist);
#pragma unroll
    for (int i = 0; i < 16; ++i) v[i] = v[i] > o[15 - i] ? v[i] : o[15 - i];
#pragma unroll
    for (int j = 8; j > 0; j >>= 1)
#pragma unroll
        for (int i = 0; i < 16; ++i) { const int l = i ^ j; if (l > i) CSWAPD(v[i], v[l]); }
}
__device__ __forceinline__ float erf_as(float x) {
    const float ax = fabsf(x), t = __builtin_amdgcn_rcpf(__builtin_fmaf(0.3275911f, ax, 1.f));
    float p = __builtin_fmaf(1.061405429f, t, -1.453152027f); p = __builtin_fmaf(p, t, 1.421413741f); p = __builtin_fmaf(p, t, -0.284496736f); p = __builtin_fmaf(p, t, 0.254829592f);
    const float r = 1.f - p * t * __builtin_amdgcn_exp2f(ax * ax * -1.4426950408889634f);
    return __builtin_copysignf(r, x);
}
__device__ __forceinline__ float gelu_erf(float x) { return 0.5f * x * (1.f + erf_as(x * 0.70710678118654752f)); }
__device__ __forceinline__ float fp4_dec1(unsigned n) { const unsigned m = n & 7u; unsigned bits = (m >= 2u) ? (((126u + (m >> 1)) << 23) | ((m & 1u) << 22)) : (m ? 0x3F000000u : 0u); bits |= (n & 8u) << 28; return __builtin_bit_cast(float, bits); }
__device__ __forceinline__ f32x2 fp4_dec2(unsigned x) { f32x2 r; r.x = fp4_dec1(x & 15u); r.y = fp4_dec1((x >> 4) & 15u); return r; }
typedef long i64;
typedef int v8i __attribute__((ext_vector_type(8)));
typedef int v4i __attribute__((ext_vector_type(4)));
template <int J> __device__ __forceinline__ void xor_pair(unsigned v, unsigned& a, unsigned& b) {
    if constexpr (J == 1) { a = v; b = (unsigned)__builtin_amdgcn_mov_dpp((int)v, 0xB1, 0xf, 0xf, true); }
    else if constexpr (J == 2) { a = v; b = (unsigned)__builtin_amdgcn_mov_dpp((int)v, 0x4E, 0xf, 0xf, true); }
    else if constexpr (J == 4) { a = v; const int t = __builtin_amdgcn_mov_dpp((int)v, 0x141, 0xf, 0xf, true); b = (unsigned)__builtin_amdgcn_mov_dpp(t, 0x1B, 0xf, 0xf, true); }
    else if constexpr (J == 8) { a = v; b = (unsigned)__builtin_amdgcn_mov_dpp((int)v, 0x128, 0xf, 0xf, true); }
    else if constexpr (J == 16) { auto r = __builtin_amdgcn_permlane16_swap(v, v, false, false); a = r[0]; b = r[1]; }
    else { auto r = __builtin_amdgcn_permlane32_swap(v, v, false, false); a = r[0]; b = r[1]; }
}
template <bool dry = false> __device__ __forceinline__ void peer_unit(Frame& F, int u) {
    LAS unsigned char* lds = F.lds + RING_OFF;
    const int tid_ = fresh_tid(), lane = tid_ & 63, w = __builtin_amdgcn_readfirstlane(tid_ >> 6), g = lane >> 4, c16 = lane & 15;
    const int T0 = 32 * u;
    LAS int* eidx = (LAS int*)(lds + P_EIDX); LAS float* gate = (LAS float*)(lds + P_GATE);
    LAS unsigned* lst = (LAS unsigned*)(lds + P_LST) + w * 1024;
    const bf16* const QP = F.QP(); const bf16* const SK = F.SK(); float* const outp = F.out(); const bf16* const X1B = F.X1B(); const float* const fgain = F.ffn_norm(); const float* const fing = F.final_norm(); const unsigned char* const U8 = F.U8(); const unsigned char* const V8 = F.V8();
#ifndef NO_ROUTE
    unsigned cpk[4];
    { unsigned cb[16];
#pragma unroll
      for (int k = 0; k < 13; ++k) cb[k] = PEER_CAND[4 * k + g];
      cb[13] = 255u; cb[14] = 255u; cb[15] = 255u;
#pragma unroll
      for (int q = 0; q < 4; ++q) cpk[q] = cb[4 * q] | (cb[4 * q + 1] << 8) | (cb[4 * q + 2] << 16) | (cb[4 * q + 3] << 24); }
    {
    bf16x8 qf[2][4];
#define QP_LOAD(dst, c_) do { _Pragma("unroll") for (int tb = 0; tb < 2; ++tb) { const unsigned qo = ((unsigned)(T0 + 16 * tb + c16) * (unsigned)DM + (unsigned)((2 * w + (c_)) * 128 + 8 * g)) * 2u; \
        _Pragma("unroll") for (int ks = 0; ks < 4; ++ks) dst[tb][ks] = __builtin_nontemporal_load((const GAS bf16x8*)((const unsigned char*)QP + (qo + 64u * ks))); } } while (0)
    QP_LOAD(qf, 0);
#pragma unroll
    for (int c = 0; c < 2; ++c) {
        const int p = 2 * w + c;
        unsigned key[2][32];
        bf16x8 sf[3][8];
        const unsigned so0 = (unsigned)p * 32768u + 16u * (unsigned)lane;
#define SK_LOAD(buf, j_) do { _Pragma("unroll") for (int q = 0; q < 8; ++q) sf[buf][q] = *(const GAS bf16x8*)((const unsigned char*)SK + (so0 + (unsigned)(2 * (j_) + (q >> 2)) * 4096u + 1024u * (q & 3))); } while (0)
        SK_LOAD(0, 0); SK_LOAD(1, 1);
#pragma unroll
        for (int j = 0; j < 4; ++j) {
            if (j + 2 < 4) SK_LOAD((j + 2) % 3, j + 2);
            __builtin_amdgcn_sched_barrier(0);
#pragma unroll
            for (int h2 = 0; h2 < 2; ++h2)
#pragma unroll
            for (int tb = 0; tb < 2; ++tb) { const int kb = 2 * j + h2; f32x4 acc = (f32x4){0.f, 0.f, 0.f, 0.f};
#pragma unroll
                for (int ks = 0; ks < 4; ++ks) acc = MFMA16(sf[j % 3][4 * h2 + ks], qf[tb][ks], acc);
#pragma unroll
                for (int r = 0; r < 4; ++r) key[tb][kb * 4 + r] = (f2ord(acc[r]) & ~0x7Fu) | (unsigned)(16 * kb + 4 * g + r); }
            __builtin_amdgcn_sched_barrier(0); }
#undef SK_LOAD
        if (c == 0) { QP_LOAD(qf, 1); __builtin_amdgcn_sched_barrier(0); }
#pragma unroll
        for (int tb = 0; tb < 2; ++tb) {
            bitonic_sort_desc<32>(key[tb]);
            unsigned top[16];
#pragma unroll
            for (int i = 0; i < 16; ++i) top[i] = key[tb][i];
            merge16_xor(top, 16); merge16_xor(top, 32);
            if (g == 0) { LAS v4u* d = (LAS v4u*)(lst + (c * 32 + 16 * tb + c16) * 16);
                d[0] = (v4u){top[0], top[1], top[2], top[3]}; d[1] = (v4u){top[4], top[5], top[6], top[7]}; d[2] = (v4u){top[8], top[9], top[10], top[11]}; d[3] = (v4u){top[12], top[13], top[14], top[15]}; } }
    }
#undef QP_LOAD
    }
    for (int tb = 0; tb < 2; ++tb) {
        LDS_WAIT();
        const LAS unsigned* l1 = lst + (16 * tb + c16) * 16; const LAS unsigned* l2 = lst + (32 + 16 * tb + c16) * 16;
        unsigned ck[16];
#pragma unroll
        for (int k = 0; k < 13; ++k) { const unsigned ab = (cpk[k >> 2] >> (8 * (k & 3))) & 255u; const unsigned a = ab >> 4, bq = ab & 15u;
            const float s = ord2f(l1[a] & ~0x7Fu) + ord2f(l2[bq] & ~0x7Fu); ck[k] = (ab == 255u) ? 0u : ((f2ord(s) & ~0xFFu) | ab); }
        ck[13] = 0u; ck[14] = 0u; ck[15] = 0u;
        bitonic_sort_desc<16>(ck);
        merge16_xor(ck, 16); merge16_xor(ck, 32);
        if (g == 0) { const int tl = 16 * tb + c16; const float m = ord2f(ck[0] & ~0xFFu); float e[16]; float sum = 0.f;
#pragma unroll
            for (int k = 0; k < 16; ++k) { e[k] = __expf(ord2f(ck[k] & ~0xFFu) - m); sum += e[k]; }
            const float inv = 1.f / sum;
#pragma unroll
            for (int k = 0; k < 16; ++k) { const unsigned a = (ck[k] >> 4) & 15u, bq = ck[k] & 15u; const int ex = (int)((l1[a] & 0x7Fu) * 128u + (l2[bq] & 0x7Fu));
                eidx[tl * 128 + w * 16 + k] = ex; gate[tl * 128 + w * 16 + k] = e[k] * inv; } }
    }
#endif
    __syncthreads();
    LAS unsigned char* hnb = lds + P_HN4 + w * 8192; LAS float* actl = (LAS float*)(lds + P_ACT) + w * 512;
    const LAS unsigned char* hb = hnb + 16 * g + ((c16 & 1) ? 1024 : 0) + ((c16 & 2) ? 64 : 0);
    v4u bA[8], bB[8];
#define U_ISSUE(buf, e_) do { const unsigned uo_ = (unsigned)(e_) * (unsigned)ROWB + 64u * (unsigned)(c16 & 1) + 16u * (unsigned)g; \
        _Pragma("unroll") for (int jj = 0; jj < 8; ++jj) buf[jj] = *(const GAS v4u*)(U8 + (uo_ + 128u * jj)); __builtin_amdgcn_sched_barrier(0); } while (0)
#define U_CONSUME(buf, ACC, HB) do { v4u bq_[8]; _Pragma("unroll") for (int jj = 0; jj < 8; ++jj) bq_[jj] = *(const LAS v4u*)((HB) + 128 * jj); \
        __builtin_amdgcn_sched_barrier(0); \
        _Pragma("unroll") for (int jj = 0; jj < 8; ++jj) { const v4u a_ = buf[jj]; \
            const v8i av_ = {(int)a_.x, (int)a_.y, (int)a_.z, (int)a_.w, 0, 0, 0, 0}; const v8i bv_ = {(int)bq_[jj].x, (int)bq_[jj].y, (int)bq_[jj].z, (int)bq_[jj].w, 0, 0, 0, 0}; \
            ACC = __builtin_amdgcn_mfma_scale_f32_16x16x128_f8f6f4(av_, bv_, ACC, 4, 4, 0, 0x7f7f7f7f, 0, 0x7f7f7f7f); } __builtin_amdgcn_sched_barrier(0); } while (0)
#define U_PRE(A_, PA, PB) do { const float x1_ = __shfl_down(A_.x, 1), z1_ = __shfl_down(A_.z, 1), y2_ = __shfl_down(A_.y, 2), w2_ = __shfl_down(A_.w, 2), y3_ = __shfl_down(A_.y, 3), w3_ = __shfl_down(A_.w, 3); \
        constexpr float ilo_ = 1.f / SLO4; PA = (A_.x + y2_) + (x1_ + y3_) * ilo_; PB = (A_.z + w2_) + (z1_ + w3_) * ilo_; } while (0)
#define U_ACT8(hg_, TL, ACT) do { float pa_, pb_; U_PRE(acc, pa_, pb_); \
        if (c16 == 0) { const int k0 = 8 * (hg_) + 2 * g; constexpr float isc = 1.f / (SU * SH4); const f32x2 g0_ = *(const LAS f32x2*)(gate + (TL) * 128 + k0); \
            f32x2 a0_; a0_.x = gelu_erf(pa_ * isc) * g0_.x; a0_.y = gelu_erf(pb_ * isc) * g0_.y; *(LAS f32x2*)((ACT) + k0) = a0_; } } while (0)
#define V_ISSUE(buf, TL, kb_) do { const LAS v4i* ep_ = (const LAS v4i*)(eidx + (TL) * 128 + 8 * (kb_)); const v4i e4a_ = ep_[0], e4b_ = ep_[1]; const int ee_[8] = {e4a_.x, e4a_.y, e4a_.z, e4a_.w, e4b_.x, e4b_.y, e4b_.z, e4b_.w}; \
        _Pragma("unroll") for (int kk = 0; kk < 8; ++kk) { const unsigned vo_ = (unsigned)(ee_[kk] & emask) * (unsigned)ROWB + 16u * (unsigned)lane; buf[kk] = *(const GAS v4u*)(V8 + vo_); } \
        __builtin_amdgcn_sched_barrier(0); } while (0)
#define PIN8x2(a, i) asm volatile("" : "+v"(a[i]), "+v"(a[i + 1]), "+v"(a[i + 2]), "+v"(a[i + 3]), "+v"(a[i + 4]), "+v"(a[i + 5]), "+v"(a[i + 6]), "+v"(a[i + 7]))
#define V_ACTLD(AL, AH, ACT, kb_) do { AL = *(const LAS f32x4*)((ACT) + 8 * (kb_)); AH = *(const LAS f32x4*)((ACT) + 8 * (kb_) + 4); } while (0)
#define V_CONSUME(buf, AL, AH, O) do { const float a8_[8] = {AL.x, AL.y, AL.z, AL.w, AH.x, AH.y, AH.z, AH.w}; \
        _Pragma("unroll") for (int kk = 0; kk < 8; ++kk) { const float as_ = a8_[kk]; const f32x2 a2_ = {as_, as_}; \
        const unsigned vw[4] = {buf[kk].x, buf[kk].y, buf[kk].z, buf[kk].w}; \
        _Pragma("unroll") for (int q = 0; q < 4; ++q) { \
            O[4 * q]     = __builtin_elementwise_fma(__builtin_amdgcn_cvt_scalef32_pk_f32_fp4(vw[q], 1.0f, 0), a2_, O[4 * q]); \
            O[4 * q + 1] = __builtin_elementwise_fma(__builtin_amdgcn_cvt_scalef32_pk_f32_fp4(vw[q], 1.0f, 1), a2_, O[4 * q + 1]); \
            O[4 * q + 2] = __builtin_elementwise_fma(__builtin_amdgcn_cvt_scalef32_pk_f32_fp4(vw[q], 1.0f, 2), a2_, O[4 * q + 2]); \
            O[4 * q + 3] = __builtin_elementwise_fma(__builtin_amdgcn_cvt_scalef32_pk_f32_fp4(vw[q], 1.0f, 3), a2_, O[4 * q + 3]); } \
        PIN8x2(O, 0); PIN8x2(O, 8); } } while (0)
#ifndef NO_GATHER
#ifdef PROBE_L2RES
    constexpr int emask = dry ? PROBE_L2RES : 16383;
#else
    constexpr int emask = 16383;
#endif
    {
    { unsigned k0[4], k1[4];
#pragma unroll
      for (int ti = 0; ti < 4; ++ti) { const int tl = w + 8 * ti; k0[ti] = ((unsigned)eidx[tl * 128 + lane] << 7) | (unsigned)lane; k1[ti] = ((unsigned)eidx[tl * 128 + 64 + lane] << 7) | (unsigned)(64 + lane); }
#pragma unroll
      for (int k = 2; k <= 128; k <<= 1)
#pragma unroll
        for (int j = k >> 1; j > 0; j >>= 1) {
            if (j == 64) {
#pragma unroll
                for (int ti = 0; ti < 4; ++ti) { const unsigned lo_ = k0[ti] < k1[ti] ? k0[ti] : k1[ti], hi_ = k0[ti] < k1[ti] ? k1[ti] : k0[ti]; k0[ti] = lo_; k1[ti] = hi_; }
            } else {
                const bool lower = (lane & j) == 0;
                const bool desc0 = (k == 64) ? false : ((k == 128) ? false : ((lane & k) != 0)), desc1 = (k == 64) ? true : desc0;
                const bool min0 = lower != desc0, min1 = lower != desc1;
#pragma unroll
                for (int ti = 0; ti < 4; ++ti) { unsigned a0, b0, a1, b1;
                    if (j == 1) { xor_pair<1>(k0[ti], a0, b0); xor_pair<1>(k1[ti], a1, b1); } else if (j == 2) { xor_pair<2>(k0[ti], a0, b0); xor_pair<2>(k1[ti], a1, b1); }
                    else if (j == 4) { xor_pair<4>(k0[ti], a0, b0); xor_pair<4>(k1[ti], a1, b1); } else if (j == 8) { xor_pair<8>(k0[ti], a0, b0); xor_pair<8>(k1[ti], a1, b1); }
                    else if (j == 16) { xor_pair<16>(k0[ti], a0, b0); xor_pair<16>(k1[ti], a1, b1); } else { xor_pair<32>(k0[ti], a0, b0); xor_pair<32>(k1[ti], a1, b1); }
                    const unsigned mn0 = a0 < b0 ? a0 : b0, mx0 = a0 < b0 ? b0 : a0, mn1 = a1 < b1 ? a1 : b1, mx1 = a1 < b1 ? b1 : a1;
                    k0[ti] = min0 ? mn0 : mx0; k1[ti] = min1 ? mn1 : mx1; }
            }
        }
      float g0[4], g1[4];
#pragma unroll
      for (int ti = 0; ti < 4; ++ti) { const int tl = w + 8 * ti; g0[ti] = gate[tl * 128 + (int)(k0[ti] & 127u)]; g1[ti] = gate[tl * 128 + (int)(k1[ti] & 127u)]; }
      LDS_WAIT(); asm volatile("" ::: "memory");
#pragma unroll
      for (int ti = 0; ti < 4; ++ti) { const int tl = w + 8 * ti; eidx[tl * 128 + lane] = (int)(k0[ti] >> 7); eidx[tl * 128 + 64 + lane] = (int)(k1[ti] >> 7); gate[tl * 128 + lane] = g0[ti]; gate[tl * 128 + 64 + lane] = g1[ti]; }
      LDS_WAIT(); asm volatile("" ::: "memory"); }
    v2u xn[8];
#define X_ISSUE(tok_) do { const unsigned xb_ = (unsigned)(tok_) * (unsigned)(DM * 2) + 8u * (unsigned)lane; _Pragma("unroll") for (int j = 0; j < 8; ++j) xn[j] = __builtin_nontemporal_load((const GAS v2u*)((const unsigned char*)X1B + (xb_ + 512u * j))); } while (0)
    X_ISSUE(T0 + w);
#pragma unroll 1
    for (int ti = 0; ti < 4; ++ti) {
        f32x4 xr[8]; float ss = 0.f;
#pragma unroll
        for (int j = 0; j < 8; ++j) { const v2u r = xn[j]; xr[j] = (f32x4){bflo(r.x), bfhi(r.x), bflo(r.y), bfhi(r.y)}; }
        X_ISSUE(T0 + w + 8 * (ti < 3 ? ti + 1 : 3));
#pragma unroll
        for (int j = 0; j < 8; ++j) ss += (xr[j].x * xr[j].x + xr[j].y * xr[j].y) + (xr[j].z * xr[j].z + xr[j].w * xr[j].w);
        const float rs2 = __builtin_amdgcn_rsqf(wave_sum(ss) * (1.f / DM) + EPS);
        const float* fg_ = fgain; asm volatile("" : "+s"(fg_));
        const unsigned char* gp = (const unsigned char*)fg_; const unsigned go = 16u * (unsigned)lane;
        unsigned hw[4], lw[4];
#pragma unroll
        for (int q = 0; q < 4; ++q) { unsigned wh = 0u, wl = 0u;
#pragma unroll
            for (int t = 0; t < 2; ++t) { const int j = 2 * q + t; const f32x4 gg = *(const GAS f32x4*)(gp + (go + 1024u * j)); const f32x4 hv = xr[j] * gg * (rs2 * SH4);
                const float h0 = clampf(hv.x, 6.f), h1 = clampf(hv.y, 6.f), h2 = clampf(hv.z, 6.f), h3 = clampf(hv.w, 6.f);
                const unsigned p0 = __builtin_amdgcn_cvt_scalef32_pk_fp4_f32(0u, h0, h1, 1.0f, 0), p1 = __builtin_amdgcn_cvt_scalef32_pk_fp4_f32(0u, h2, h3, 1.0f, 0);
                const f32x2 d0 = __builtin_amdgcn_cvt_scalef32_pk_f32_fp4(p0, 1.0f, 0), d1 = __builtin_amdgcn_cvt_scalef32_pk_f32_fp4(p1, 1.0f, 0);
                const unsigned r0 = __builtin_amdgcn_cvt_scalef32_pk_fp4_f32(0u, clampf((h0 - d0.x) * SLO4, 6.f), clampf((h1 - d0.y) * SLO4, 6.f), 1.0f, 0), r1 = __builtin_amdgcn_cvt_scalef32_pk_fp4_f32(0u, clampf((h2 - d1.x) * SLO4, 6.f), clampf((h3 - d1.y) * SLO4, 6.f), 1.0f, 0);
                wh |= ((p0 & 0xFFu) | ((p1 & 0xFFu) << 8)) << (16 * t); wl |= ((r0 & 0xFFu) | ((r1 & 0xFFu) << 8)) << (16 * t); }
            hw[q] = wh; lw[q] = wl; }
        *(LAS v4u*)(hnb + 2048 * ti + 16 * lane) = (v4u){hw[0], hw[1], hw[2], hw[3]}; *(LAS v4u*)(hnb + 2048 * ti + 1024 + 16 * lane) = (v4u){lw[0], lw[1], lw[2], lw[3]};
    }
    LDS_WAIT();
    { const int r8 = c16 >> 1;
#define U_STEP(BUFN, EN_ISSUE, BUFC, TI, HG) do { EN_ISSUE; f32x4 acc = (f32x4){0.f, 0.f, 0.f, 0.f}; U_CONSUME(BUFC, acc, hb + 2048 * (TI)); U_ACT8(HG, w + 8 * (TI), actl + 128 * (TI)); } while (0)
      { const int e0 = eidx[w * 128 + r8] & emask; U_ISSUE(bA, e0); }
#pragma unroll 1
      for (int hg = 0; hg < 15; ++hg) {
          if ((hg & 7) == 0) __builtin_amdgcn_s_barrier();
          const int e1 = eidx[(w + 8) * 128 + 8 * hg + r8] & emask, e2 = eidx[(w + 16) * 128 + 8 * hg + r8] & emask, e3 = eidx[(w + 24) * 128 + 8 * hg + r8] & emask, e0n = eidx[w * 128 + 8 * (hg + 1) + r8] & emask;
          U_STEP(bB, U_ISSUE(bB, e1), bA, 0, hg);
          U_STEP(bA, U_ISSUE(bA, e2), bB, 1, hg);
          U_STEP(bB, U_ISSUE(bB, e3), bA, 2, hg);
          U_STEP(bA, U_ISSUE(bA, e0n), bB, 3, hg);
      }
      { const int e1 = eidx[(w + 8) * 128 + 120 + r8] & emask, e2 = eidx[(w + 16) * 128 + 120 + r8] & emask, e3 = eidx[(w + 24) * 128 + 120 + r8] & emask;
          U_STEP(bB, U_ISSUE(bB, e1), bA, 0, 15);
          U_STEP(bA, U_ISSUE(bA, e2), bB, 1, 15);
          U_STEP(bB, U_ISSUE(bB, e3), bA, 2, 15);
          U_STEP(bA, V_ISSUE(bA, w, 0), bB, 3, 15); }
#undef U_STEP
    }
    LDS_WAIT();
    f32x2 o2[4][16];
#pragma unroll
    for (int ti = 0; ti < 4; ++ti)
#pragma unroll
        for (int i = 0; i < 16; ++i) o2[ti][i] = (f32x2){0.f, 0.f};
    f32x4 alA, ahA, alB, ahB; V_ACTLD(alA, ahA, actl, 0);
#pragma unroll 1
    for (int kb = 0; kb < 16; ++kb) {
        if ((kb & 7) == 0) __builtin_amdgcn_s_barrier();
        const int kn = kb < 15 ? kb + 1 : 15;
        V_ISSUE(bB, w + 8, kb);  V_ACTLD(alB, ahB, actl + 128, kb); V_CONSUME(bA, alA, ahA, o2[0]);
        V_ISSUE(bA, w + 16, kb); V_ACTLD(alA, ahA, actl + 256, kb); V_CONSUME(bB, alB, ahB, o2[1]);
        V_ISSUE(bB, w + 24, kb); V_ACTLD(alB, ahB, actl + 384, kb); V_CONSUME(bA, alA, ahA, o2[2]);
        V_ISSUE(bA, w, kn);      V_ACTLD(alA, ahA, actl, kn);       V_CONSUME(bB, alB, ahB, o2[3]);
    }
    const bf16* X1Bf = X1B; asm volatile("" : "+s"(X1Bf));
#define X_ISSUE2(tok_) do { const unsigned xb_ = (unsigned)(tok_) * (unsigned)(DM * 2) + 8u * (unsigned)lane; _Pragma("unroll") for (int j = 0; j < 8; ++j) xn[j] = __builtin_nontemporal_load((const GAS v2u*)((const unsigned char*)X1Bf + (xb_ + 512u * j))); } while (0)
    X_ISSUE2(T0 + w);
#pragma unroll
    for (int ti = 0; ti < 4; ++ti) {
        const size_t token = (size_t)T0 + w + 8 * ti;
        const unsigned xo = (unsigned)token * (unsigned)(DM * 4) + 16u * (unsigned)lane;
        f32x4 xr[8];
#pragma unroll
        for (int j = 0; j < 8; ++j) { const v2u r = xn[j]; xr[j] = (f32x4){bflo(r.x), bfhi(r.x), bflo(r.y), bfhi(r.y)}; }
        if (ti < 3) X_ISSUE2(T0 + w + 8 * (ti + 1));
        constexpr float isv = 1.f / SV; float s2 = 0.f;
#pragma unroll
        for (int j = 0; j < 8; ++j) { xr[j] = xr[j] + (f32x4){o2[ti][2 * j].x, o2[ti][2 * j].y, o2[ti][2 * j + 1].x, o2[ti][2 * j + 1].y} * isv;
            s2 += (xr[j].x * xr[j].x + xr[j].y * xr[j].y) + (xr[j].z * xr[j].z + xr[j].w * xr[j].w); }
        const float rf = __builtin_amdgcn_rsqf(wave_sum(s2) * (1.f / DM) + EPS);
        const float* fi_ = fing; asm volatile("" : "+s"(fi_));
        const unsigned char* fp = (const unsigned char*)fi_; unsigned char* op = (unsigned char*)outp; const unsigned fo = 16u * (unsigned)lane;
        if (!dry || rf == 1.2345e30f)
#pragma unroll
        for (int j = 0; j < 8; ++j) __builtin_nontemporal_store(xr[j] * rf * *(const GAS f32x4*)(fp + (fo + 1024u * j)), (GAS f32x4*)(op + (xo + 1024u * j)));
    }
    }
#endif
#undef X_ISSUE2
#undef U_ISSUE
#undef X_ISSUE
#undef U_ACT
#undef U_CONSUME
#undef V_ISSUE
#undef V_CONSUME
    __syncthreads();
}

#define PADSTR_(x) #x
#define PADSTR(x) PADSTR_(x)
__global__ void __launch_bounds__(NWAVES * 64, 2) hybrid_fwd(Args args) {
    extern __shared__ __attribute__((aligned(16))) unsigned char lds[];
    Frame F;
    F.lds = (LAS unsigned char*)lds;
    F.MISC = (volatile LAS unsigned*)(F.lds + MISC_OFF);
    F.tid = threadIdx.x; F.lane = F.tid & 63; F.wave = __builtin_amdgcn_readfirstlane(F.tid >> 6); F.G = gridDim.x;
    for (int u = F.tid; u < (LDS_BYTES - LDSCTL_OFF) / 4; u += NWAVES * 64) ((LAS unsigned*)(F.lds + LDSCTL_OFF))[u] = 0u;
    __syncthreads();
    (void)args;
    XcdBarrier bar = xcd_barrier_post(F.ctl() + CW_BAR, F.MISC + 8);

#ifndef NO_P0
#ifdef PROBE_P0X2
    { int reps = 2; asm volatile("" : "+s"(reps)); for (int rep = 0; rep < reps; ++rep) p0_prologue(F); }
#else
    p0_prologue(F);
#endif
#endif
    xcd_barrier(bar);
#ifndef NO_P1
#ifdef PROBE_GX2
    { int reps = 2; asm volatile("" : "+s"(reps)); for (int rep = 0; rep < reps; ++rep) {
#else
    { { const int rep = 0, reps = 1;
#endif
      pg8::Gemm gm{F.HN(), F.WinT(), MTOK, NB16, DM}; pg8::StaticOrder S; S.init(MTOK, NB16, F.G, (int)blockIdx.x);
      EpiProj E{F.PROJ(), F.dtraw(), (rep + 1 < reps) ? nullptr : F.kmean()};
      pg8::gemm_phase<EpiProj, pg8::StaticOrder, PG8_ALIGN, PG8_SP2>(F.lds + RING_OFF, gm, S, E); } }
    { const int nun = (MTOK / 256) * (NB16 / 256), rem = nun % F.G;
      if (rem && (int)blockIdx.x >= rem) tables_convert(F, tab_split(F.G), TAB_P0_LO, (size_t)((int)blockIdx.x - rem) * (NWAVES * 64) + fresh_tid(), (size_t)(F.G - rem) * (NWAVES * 64)); }
    __syncthreads();
    {
      pg8::Gemm gm{(const pg8::bf16_t*)F.HN8(), (const pg8::bf16_t*)F.WinT8(), MTOK, F8_HI - F8_LO, DM / 2}; pg8::StaticOrder S; S.init(MTOK, F8_HI - F8_LO, F.G, (int)blockIdx.x);
      EpiProj8 E{F.PROJ()};
      pg8::gemm_phase<EpiProj8, pg8::StaticOrder, PG8_ALIGN, PG8_SP2, true>(F.lds + RING_OFF, gm, S, E); }
#endif
    xcd_barrier(bar);
#ifdef PROBE_P15X2
    conv_phase(F);
#endif
    conv_phase(F);
    xcd_barrier(bar);
#ifdef PROBE_P2X2
    { int reps = 2; asm volatile("" : "+s"(reps)); for (int rep = 0; rep < reps; ++rep) {
#else
    { { const int rep = 0, reps = 1;
#endif
    const bool doatom = rep + 1 == reps;
    const int ntab = (int)(tab_split(F.G) / TAB_UNIT);
    for (;;) {
        if (F.tid == 0) F.MISC[0] = xb_add(F.ctl() + CW_Q2 + 64 * rep, 1u);
        __syncthreads();
        const int ui = (int)F.MISC[0];
        __syncthreads();
        if (ui >= 128 + 512 + W_SQ_UNITS + ntab) break;
        if (ui >= 128 + 512 && ui < 128 + 512 + W_SQ_UNITS) { sq_weight_items(F, ui - 640); __syncthreads(); continue; }
        if (ui >= 128 + 512 + W_SQ_UNITS) { const size_t lo = (size_t)(ui - 640 - W_SQ_UNITS) * TAB_UNIT; tables_convert(F, lo, lo + TAB_UNIT, (size_t)fresh_tid(), (size_t)(NWAVES * 64)); continue; }
#ifdef PROBE_P2_SSD
        if (ui < 128 || doatom)
#endif
#ifdef PROBE_P2_ATT
        if (ui >= 128 || doatom)
#endif
        {
        if (ui < 128) ssd_unit(F, ui >> 4, ui & 15, doatom);
        else { const int a = ui - 128; attn_unit(F, (a & 63) >> 3, a & 7, 7 - (a >> 6), doatom); }
        }
    } } }
    xcd_barrier(bar);
#ifndef NO_P3
#ifdef PROBE_GX2
    { int reps = 2; asm volatile("" : "+s"(reps)); for (int rep = 0; rep < reps; ++rep) {
#else
    { { const int rep = 0, reps = 1;
#endif
      pg8::Gemm gm{F.HN(), F.WoutT(), MTOK, DM, DM / 2}; pg8::StaticOrder S; S.init(MTOK, DM, F.G, (int)blockIdx.x);
      {
        const int t_ = fresh_tid(); const float* const sq = F.ssq();
#pragma unroll 1
        for (int ii = t_ >> 8; ii < 3; ii += 2) { pg8::Unit uu;
          if (S.next(ii, uu)) { const int row = uu.pm * 256 + (t_ & 255);
            const float q1 = __hip_atomic_load(sq + (size_t)row * 4 + 1, RLX_AGENT), q2 = __hip_atomic_load(sq + (size_t)row * 4 + 2, RLX_AGENT), q3 = __hip_atomic_load(sq + (size_t)row * 4 + 3, RLX_AGENT);
            const float sa = __builtin_amdgcn_rsqf(q1 * (1.f / 1024.f) + EPS), s0 = __builtin_amdgcn_rsqf(q2 * (1.f / 512.f) + EPS), s1 = __builtin_amdgcn_rsqf(q3 * (1.f / 512.f) + EPS);
            *(LAS f32x4*)(F.lds + SEGTAB_OFF + (ii * 256 + (t_ & 255)) * 16) = (f32x4){sa / s0 * (SS8 / SA8), s0 / s1, s1 * (1.f / (SS8 * SW8)), 0.f}; } }
        __syncthreads(); }
      EpiOut E{F.x(), F.X1B(), F.X18(), F.ssq(), rep + 1 == reps, (const LAS f32x4*)(F.lds + SEGTAB_OFF)};
      pg8::gemm_phase<EpiOut, pg8::StaticOrder, PG8_ALIGN, PG8_SP2, true>(F.lds + RING_OFF, gm, S, E); } }
#endif
    xcd_barrier(bar);
#ifndef NO_P4
#ifdef PROBE_GX2
    { int reps = 2; asm volatile("" : "+s"(reps)); for (int rep = 0; rep < reps; ++rep) {
#else
    { { const int rep = 0, reps = 1; (void)rep; (void)reps;
#endif
      pg8::Gemm gm{(const pg8::bf16_t*)F.X18(), F.WqT(), MTOK, DM, DM / 2}; pg8::StaticOrder S; S.init(MTOK, DM, F.G, (int)blockIdx.x);
      EpiQ E{F.QP(), F.ssq()};
      pg8::gemm_phase<EpiQ, pg8::StaticOrder, PG8_ALIGN, PG8_SP2, true>(F.lds + RING_OFF, gm, S, E); } }
#endif
    xcd_barrier(bar);
#ifdef PAD_P5
    asm volatile(".rept " PADSTR(PAD_P5) "\n\ts_nop 0\n\t.endr");
#endif
#ifndef NO_P5
#ifdef PROBE_P5X2
    { for (int u = blockIdx.x; u < MTOK / 32; u += F.G) peer_unit<true>(F, u);
      for (int u = blockIdx.x; u < MTOK / 32; u += F.G) peer_unit<false>(F, u); }
#else
    for (int u = blockIdx.x; u < MTOK / 32; u += F.G) peer_unit(F, u);
#endif
#endif
}

extern "C" void kernel_launch(void* const* d_in, const int* in_sizes, int n_in, void* d_out, int out_size, void* d_ws, size_t ws_size, hipStream_t stream) {
    static int grid = 0;
    if (grid == 0) {
        if (n_in != 18 || out_size != MTOK * DM || ws_size < WS_END) { fprintf(stderr, "kernel_launch: unexpected shapes (n_in %d, out %d, ws %zu)\n", n_in, out_size, ws_size); grid = -1; return; }
        int dev = 0, cus = 0, per_cu = 0;
        if (hipGetDevice(&dev) != hipSuccess || hipDeviceGetAttribute(&cus, hipDeviceAttributeMultiprocessorCount, dev) != hipSuccess) { grid = -1; return; }
        if (hipFuncSetAttribute((const void*)hybrid_fwd, hipFuncAttributeMaxDynamicSharedMemorySize, LDS_BYTES) != hipSuccess) { fprintf(stderr, "kernel_launch: hipFuncSetAttribute failed\n"); grid = -1; return; }
        if (hipOccupancyMaxActiveBlocksPerMultiprocessor(&per_cu, (const void*)hybrid_fwd, NWAVES * 64, LDS_BYTES) != hipSuccess || per_cu < 1)
            fprintf(stderr, "kernel_launch: note: occupancy query reports %d workgroups per CU\n", per_cu);
        (void)hipGetLastError();
        grid = cus;
    }
    if (grid < 0) return;
    if (hipMemsetAsync((char*)d_ws + WS_CTL, 0, CTL_ZERO_BYTES, stream) != hipSuccess) return;
    Args a{};
    for (int i = 0; i < 18; ++i) a.in[i] = (const float*)d_in[i];
    a.out = (float*)d_out; a.ws = (unsigned char*)d_ws;
    hipLaunchKernelGGL(hybrid_fwd, dim3(grid), dim3(NWAVES * 64), LDS_BYTES, stream, a);
}
```
